# Optimizing an MI355X kernel written in HIP

```python
import math
import jax, jax.numpy as jnp
from jax import lax
import numpy as np


D_MODEL = 2048
BATCH = 2
SEQ = 4096
DEPTH = 1

HEAD_DIM = 64
NSA_HEADS = 16
NSA_GROUPS = 4
NSA_HPG = NSA_HEADS // NSA_GROUPS
SB_HEADS = 16
CMP_LEN = 32
CMP_STRIDE = 16
CMP_HIDDEN = 128
SEL_LEN = 64
SEL_TOPK = 16
N_LOCAL_SEL = 2
SEL_FORCE_BONUS = 1e4
WINDOW = 512
Q_BLOCK = 128
REL_BUCKETS = 32
REL_MAX_DIST = 1024
PEER_HEADS = 8
PEER_KEYS = 128
PEER_EXPERTS = PEER_KEYS * PEER_KEYS
PEER_QDIM = 256
PEER_TOPK = 16
TOKEN_CHUNK = 128
EPS = 1e-6
NEG = -1e30

NSA_Q = NSA_HEADS * HEAD_DIM
NSA_KV = NSA_GROUPS * HEAD_DIM
SB_W = SB_HEADS * HEAD_DIM
IN_COLS = NSA_Q + 6 * NSA_KV + 3 * NSA_HEADS + 3 * SB_W + 2 * D_MODEL

kernel_name = 'hybrid_nsa_stickbreak_peer_block'


def _in_splits():
    sizes = [NSA_Q] + [NSA_KV] * 6 + [3 * NSA_HEADS, SB_W, SB_W, SB_W, D_MODEL, D_MODEL]
    out, acc = [], 0
    for s in sizes[:-1]:
        acc += s
        out.append(acc)
    return out


def rmsnorm(x, g):
    xf = x.astype(jnp.float32)
    y = xf * lax.rsqrt(jnp.mean(xf * xf, axis=-1, keepdims=True) + EPS)
    return (y * g.astype(jnp.float32)).astype(x.dtype)


def rel_bucket(dist):
    dist = jnp.maximum(dist, 0)
    n_exact = REL_BUCKETS // 2
    d_f = jnp.maximum(dist, 1).astype(jnp.float32)
    large = n_exact + (jnp.log(d_f / n_exact) / math.log(REL_MAX_DIST / n_exact)
                       * (REL_BUCKETS - n_exact)).astype(jnp.int32)
    large = jnp.minimum(large, REL_BUCKETS - 1)
    return jnp.where(dist < n_exact, dist, large)


def compress_tokens(tok, pe, w1, w2):
    B, T, G, d = tok.shape
    n_cmp = (T - CMP_LEN) // CMP_STRIDE + 1
    idx = jnp.arange(n_cmp)[:, None] * CMP_STRIDE + jnp.arange(CMP_LEN)[None, :]
    blk = tok[:, idx] + pe[None, None, :, None, :]
    blk = jnp.transpose(blk, (0, 1, 3, 2, 4)).reshape(B, n_cmp, G, CMP_LEN * d)
    return jax.nn.gelu(blk @ w1) @ w2


def nsa_compressed(q, kc, vc, rel_table):
    B, T, G, Hg, d = q.shape
    n_cmp = kc.shape[1]
    blk_end = jnp.arange(n_cmp)[None, :] * CMP_STRIDE + CMP_LEN - 1
    dist = jnp.arange(T)[:, None] - blk_end
    valid = dist >= 0
    bias = jnp.transpose(rel_table[rel_bucket(dist)], (2, 0, 1)).reshape(G, Hg, T, n_cmp)
    s = jnp.einsum('btghd,bngd->bghtn', q, kc).astype(jnp.float32) * (HEAD_DIM ** -0.5) + bias
    s = jnp.where(valid, s, NEG)
    p = jnp.where(valid, jax.nn.softmax(s, axis=-1), 0.0)
    o = jnp.einsum('bghtn,bngd->btghd', p.astype(vc.dtype), vc)
    return o, p


def nsa_select_indices(p_cmp, T):
    n_cmp = p_cmp.shape[-1]
    n_sel = T // SEL_LEN
    c_start = jnp.arange(n_cmp) * CMP_STRIDE
    s_start = jnp.arange(n_sel) * SEL_LEN
    overlap = jnp.maximum(jnp.minimum(c_start[:, None] + CMP_LEN, s_start[None, :] + SEL_LEN)
                          - jnp.maximum(c_start[:, None], s_start[None, :]), 0).astype(jnp.float32) / CMP_LEN
    imp = jnp.einsum('bghtn,nj->bgtj', p_cmp, overlap)
    cur = jnp.arange(T)[:, None] // SEL_LEN
    j = jnp.arange(n_sel)[None, :]
    valid = j <= cur
    forced = (j == 0) | ((cur - j >= 0) & (cur - j < N_LOCAL_SEL))
    score = jnp.where(valid, imp + SEL_FORCE_BONUS * forced.astype(jnp.float32), -jnp.inf)
    top_s, top_i = lax.top_k(score, min(SEL_TOPK, n_sel))
    return top_i, jnp.isfinite(top_s)


def nsa_selected(q, ks, vs, sel_idx, sel_ok, rel_table):
    B, T, G, Hg, d = q.shape
    n_sel = T // SEL_LEN
    k = sel_idx.shape[-1]
    nq = T // Q_BLOCK
    kb = ks.reshape(B, n_sel, SEL_LEN, G, d).transpose(0, 3, 1, 2, 4)
    vb = vs.reshape(B, n_sel, SEL_LEN, G, d).transpose(0, 3, 1, 2, 4)
    table_g = rel_table.reshape(REL_BUCKETS, G, Hg).transpose(1, 0, 2)
    qs = q.reshape(B, nq, Q_BLOCK, G, Hg, d).transpose(1, 0, 2, 3, 4, 5)
    idx_s = sel_idx.reshape(B, G, nq, Q_BLOCK, k).transpose(2, 0, 1, 3, 4)
    ok_s = sel_ok.reshape(B, G, nq, Q_BLOCK, k).transpose(2, 0, 1, 3, 4)
    b_ix = jnp.arange(B)[:, None, None, None]
    g_ix = jnp.arange(G)[None, :, None, None]

    def body(args):
        qi, ii, oki, blk = args
        kg = kb[b_ix, g_ix, ii].reshape(B, G, Q_BLOCK, k * SEL_LEN, d)
        vg = vb[b_ix, g_ix, ii].reshape(B, G, Q_BLOCK, k * SEL_LEN, d)
        pos = (ii[..., None] * SEL_LEN + jnp.arange(SEL_LEN)).reshape(B, G, Q_BLOCK, k * SEL_LEN)
        t = blk * Q_BLOCK + jnp.arange(Q_BLOCK)
        dist = t[None, None, :, None] - pos
        mask = (dist >= 0) & jnp.repeat(oki, SEL_LEN, axis=-1)
        bias = jax.vmap(lambda tab, bk: tab[bk], in_axes=(0, 1), out_axes=1)(table_g, rel_bucket(dist))
        s = (jnp.einsum('bqghd,bgqsd->bghqs', qi, kg).astype(jnp.float32) * (HEAD_DIM ** -0.5)
             + bias.transpose(0, 1, 4, 2, 3))
        m = mask[:, :, None]
        p = jnp.where(m, jax.nn.softmax(jnp.where(m, s, NEG), axis=-1), 0.0)
        return jnp.einsum('bghqs,bgqsd->bqghd', p.astype(vg.dtype), vg)

    out = lax.map(body, (qs, idx_s, ok_s, jnp.arange(nq)))
    return out.transpose(1, 0, 2, 3, 4, 5).reshape(B, T, G, Hg, d)


def nsa_window(q, kw, vw, rel_table):
    B, T, G, Hg, d = q.shape
    nq = T // Q_BLOCK
    S = WINDOW + Q_BLOCK
    kp = jnp.pad(kw, ((0, 0), (WINDOW, 0), (0, 0), (0, 0)))
    vp = jnp.pad(vw, ((0, 0), (WINDOW, 0), (0, 0), (0, 0)))
    qs = q.reshape(B, nq, Q_BLOCK, G, Hg, d).transpose(1, 0, 2, 3, 4, 5)
    rel = jnp.arange(Q_BLOCK)[:, None] + WINDOW - jnp.arange(S)[None, :]
    bias = jnp.transpose(rel_table[rel_bucket(rel)], (2, 0, 1)).reshape(G, Hg, Q_BLOCK, S)

    def body(args):
        qi, blk = args
        start = blk * Q_BLOCK
        kk = lax.dynamic_slice_in_dim(kp, start, S, axis=1)
        vv = lax.dynamic_slice_in_dim(vp, start, S, axis=1)
        key_pos = start - WINDOW + jnp.arange(S)
        mask = (rel >= 0) & (rel < WINDOW) & (key_pos[None, :] >= 0)
        s = jnp.einsum('bqghd,bsgd->bghqs', qi, kk).astype(jnp.float32) * (HEAD_DIM ** -0.5) + bias
        p = jax.nn.softmax(jnp.where(mask, s, NEG), axis=-1)
        return jnp.einsum('bghqs,bsgd->bqghd', p.astype(vv.dtype), vv)

    out = lax.map(body, (qs, jnp.arange(nq)))
    return out.transpose(1, 0, 2, 3, 4, 5).reshape(B, T, G, Hg, d)


def stick_breaking(q, k, v):
    B, T, H, d = q.shape
    nq = T // Q_BLOCK
    qs = q.reshape(B, nq, Q_BLOCK, H, d).transpose(1, 0, 2, 3, 4)
    key_pos = jnp.arange(T)

    def body(args):
        qi, blk = args
        t = blk * Q_BLOCK + jnp.arange(Q_BLOCK)
        mask = key_pos[None, :] < t[:, None]
        z = jnp.einsum('bqhd,bshd->bhqs', qi, k).astype(jnp.float32) * (HEAD_DIM ** -0.5)
        log_beta = jax.nn.log_sigmoid(z)
        log_rem = jnp.where(mask, log_beta - z, 0.0)
        suffix = lax.cumsum(log_rem, axis=3, reverse=True) - log_rem
        a = jnp.where(mask, jnp.exp(log_beta + suffix), 0.0)
        return jnp.einsum('bhqs,bshd->bqhd', a.astype(v.dtype), v)

    out = lax.map(body, (qs, jnp.arange(nq)))
    return out.transpose(1, 0, 2, 3, 4).reshape(B, T, H * d)


def peer_ffn(x, w_q, sub_keys, u, v):
    B, T, D = x.shape
    N = B * T
    xf = x.reshape(N, D)
    q = (xf @ w_q).reshape(N, PEER_HEADS, 2, PEER_QDIM // 2)
    s = jnp.einsum('nhpc,hpkc->nhpk', q, sub_keys).astype(jnp.float32)
    top_v, top_i = lax.top_k(s, PEER_TOPK)
    cand = top_v[:, :, 0, :, None] + top_v[:, :, 1, None, :]
    cand_i = top_i[:, :, 0, :, None] * PEER_KEYS + top_i[:, :, 1, None, :]
    best_s, best_j = lax.top_k(cand.reshape(N, PEER_HEADS, PEER_TOPK * PEER_TOPK), PEER_TOPK)
    expert = jnp.take_along_axis(cand_i.reshape(N, PEER_HEADS, PEER_TOPK * PEER_TOPK), best_j, axis=-1)
    gate = jax.nn.softmax(best_s, axis=-1)
    nc = N // TOKEN_CHUNK
    E = PEER_HEADS * PEER_TOPK
    xs = (xf.reshape(nc, TOKEN_CHUNK, D), expert.reshape(nc, TOKEN_CHUNK, E), gate.reshape(nc, TOKEN_CHUNK, E))

    def body(args):
        xc, ec, gc = args
        act = jax.nn.gelu(jnp.einsum('cd,ced->ce', xc, u[ec]))
        return jnp.einsum('ce,ced->cd', (gc * act).astype(v.dtype), v[ec])

    return lax.map(body, xs).reshape(B, T, D)


def hybrid_layer(h, attn_g, w_in, ck_pe, ck_w1, ck_w2, cv_pe, cv_w1, cv_w2, rel_table,
                 w_br_nsa, w_br_sb, w_out, ffn_g, pq, psk, pu, pv):
    B, T, _ = h.shape
    a = rmsnorm(h, attn_g)
    proj = a @ w_in
    (q_n, kc, vc, ks, vs, kw, vw, g_br, q_b, k_b, v_b, g_a, g_b) = jnp.split(proj, _in_splits(), axis=-1)
    G, Hg, d = NSA_GROUPS, NSA_HPG, HEAD_DIM
    q_n = q_n.reshape(B, T, G, Hg, d)
    kv = lambda z: z.reshape(B, T, G, d)
    kc_blk = compress_tokens(kv(kc), ck_pe, ck_w1, ck_w2)
    vc_blk = compress_tokens(kv(vc), cv_pe, cv_w1, cv_w2)
    o_c, p_c = nsa_compressed(q_n, kc_blk, vc_blk, rel_table)
    sel_idx, sel_ok = nsa_select_indices(p_c, T)
    o_s = nsa_selected(q_n, kv(ks), kv(vs), sel_idx, sel_ok, rel_table)
    o_w = nsa_window(q_n, kv(kw), kv(vw), rel_table)
    gb = jax.nn.sigmoid(g_br).reshape(B, T, 3, G, Hg, 1)
    o_nsa = (gb[:, :, 0] * o_c + gb[:, :, 1] * o_s + gb[:, :, 2] * o_w).reshape(B, T, NSA_Q)
    shp = (B, T, SB_HEADS, HEAD_DIM)
    o_sb = stick_breaking(q_b.reshape(shp), k_b.reshape(shp), v_b.reshape(shp))
    merged = jax.nn.sigmoid(g_a) * (o_nsa @ w_br_nsa) + jax.nn.sigmoid(g_b) * (o_sb @ w_br_sb)
    h = h + merged @ w_out
    h = h + peer_ffn(rmsnorm(h, ffn_g), pq, psk, pu, pv)
    return h


def setup_inputs(seed: int = 0) -> dict:
    key = jax.random.key(seed)
    ks = jax.random.split(key, 20)
    f32 = jnp.float32
    nrm = lambda k, shape, s: jax.random.normal(k, shape, f32) * s
    L = DEPTH
    return {
        'x': nrm(ks[0], (BATCH, SEQ, D_MODEL), 1.0),
        'attn_norm_g': 1.0 + nrm(ks[1], (L, D_MODEL), 0.01),
        'w_in': nrm(ks[2], (L, D_MODEL, IN_COLS), D_MODEL ** -0.5),
        'cmp_k_pe': nrm(ks[3], (L, CMP_LEN, HEAD_DIM), 0.1),
        'cmp_k_w1': nrm(ks[4], (L, CMP_LEN * HEAD_DIM, CMP_HIDDEN), (CMP_LEN * HEAD_DIM) ** -0.5),
        'cmp_k_w2': nrm(ks[5], (L, CMP_HIDDEN, HEAD_DIM), CMP_HIDDEN ** -0.5),
        'cmp_v_pe': nrm(ks[6], (L, CMP_LEN, HEAD_DIM), 0.1),
        'cmp_v_w1': nrm(ks[7], (L, CMP_LEN * HEAD_DIM, CMP_HIDDEN), (CMP_LEN * HEAD_DIM) ** -0.5),
        'cmp_v_w2': nrm(ks[8], (L, CMP_HIDDEN, HEAD_DIM), CMP_HIDDEN ** -0.5),
        'rel_bias_table': nrm(ks[9], (REL_BUCKETS, NSA_HEADS), 0.2),
        'w_branch_nsa': nrm(ks[10], (L, NSA_Q, D_MODEL), NSA_Q ** -0.5),
        'w_branch_sb': nrm(ks[11], (L, SB_W, D_MODEL), SB_W ** -0.5),
        'w_out': nrm(ks[12], (L, D_MODEL, D_MODEL), D_MODEL ** -0.5),
        'ffn_norm_g': 1.0 + nrm(ks[13], (L, D_MODEL), 0.01),
        'peer_w_q': nrm(ks[14], (L, D_MODEL, PEER_HEADS * PEER_QDIM), D_MODEL ** -0.5),
        'peer_sub_keys': nrm(ks[15], (L, PEER_HEADS, 2, PEER_KEYS, PEER_QDIM // 2), (PEER_QDIM // 2) ** -0.5),
        'peer_u': nrm(ks[16], (L, PEER_EXPERTS, D_MODEL), D_MODEL ** -0.5),
        'peer_v': nrm(ks[17], (L, PEER_EXPERTS, D_MODEL), PEER_HEADS ** -0.5),
        'final_norm_g': 1.0 + nrm(ks[18], (D_MODEL,), 0.01),
    }


def reference(x, attn_norm_g, w_in, cmp_k_pe, cmp_k_w1, cmp_k_w2, cmp_v_pe, cmp_v_w1, cmp_v_w2,
              rel_bias_table, w_branch_nsa, w_branch_sb, w_out, ffn_norm_g, peer_w_q, peer_sub_keys,
              peer_u, peer_v, final_norm_g):
    h = x
    for l in range(DEPTH):
        h = hybrid_layer(h, attn_norm_g[l], w_in[l], cmp_k_pe[l], cmp_k_w1[l], cmp_k_w2[l],
                         cmp_v_pe[l], cmp_v_w1[l], cmp_v_w2[l], rel_bias_table,
                         w_branch_nsa[l], w_branch_sb[l], w_out[l], ffn_norm_g[l],
                         peer_w_q[l], peer_sub_keys[l], peer_u[l], peer_v[l])
    return rmsnorm(h, final_norm_g)
```

```cpp
#include <hip/hip_runtime.h>
#include <cstdio>
#include <cstdint>
#include <cmath>
namespace pg8 {
#define PG8_LAS __attribute__((address_space(3)))
typedef unsigned short bf16_t;
typedef short bf16x8 __attribute__((ext_vector_type(8)));
typedef float f32x4 __attribute__((ext_vector_type(4)));
typedef unsigned u32x4 __attribute__((ext_vector_type(4)));
constexpr int BM = 256, BK = 64, HALF = 128, HTB = HALF * BK * 2  , STAGE_BYTES = 8 * HTB, NXCD = 8, WGM = 8;

__host__ __device__ __forceinline__ int lds_byte(int r, int c) { const int st = (r >> 4) * 2 + (c >> 5), rr = r & 15, cc = c & 31, ob = rr * 64 + cc * 2; return st * 1024 + (ob ^ (((ob >> 9) & 1) << 5)); }
__host__ __device__ __forceinline__ void stage_rc(int b, int& R, int& C) { const int st = b / 1024, sb = b % 1024, swz = sb ^ (((sb >> 9) & 1) << 5); R = (st >> 1) * 16 + swz / 64; C = (st & 1) * 32 + (swz % 64) / 2; }
__host__ __device__ __forceinline__ int perm32(int rho) { const int n = rho >> 4, i = rho & 15; return 8 * (i >> 2) + 4 * n + (i & 3); }

struct Unit { int pm, pn; };
struct Gemm { const bf16_t* A; const bf16_t* Bt; int M, N, K; };

struct StaticOrder {
    int nM, nN, nwg, G, c;
    __host__ __device__ void init(int M, int N, int G_, int c_) { nM = M / BM; nN = N / BM; nwg = nM * nN; G = G_; c = c_; }
    __host__ __device__ bool next(int i, Unit& u) const {
        const long L = (long)i * G + c; if (L >= nwg) return false;
        int wgid = (int)L; { const int q = nwg / NXCD, r = nwg % NXCD, xcd = wgid % NXCD, off = wgid / NXCD; wgid = (xcd < r ? xcd * (q + 1) : r * (q + 1) + (xcd - r) * q) + off; }
        const int nig = WGM * nN, gid = wgid / nig, fm = gid * WGM, gsz = (nM - fm) < WGM ? (nM - fm) : WGM;
        u.pm = fm + ((wgid % nig) % gsz); u.pn = (wgid % nig) / gsz; return true;
    }
    __device__ __forceinline__ void a_ready(const Unit&) const {}
    __device__ __forceinline__ void done(const Unit&) const {}
};

__device__ __forceinline__ unsigned cvt_pk_bf16(float lo, float hi) { unsigned r; asm volatile("v_cvt_pk_bf16_f32 %0, %1, %2" : "=v"(r) : "v"(lo), "v"(hi)); return r; }
typedef float f32x2 __attribute__((ext_vector_type(2)));
__device__ __forceinline__ f32x2 gelu_pk(f32x2 v) {
    const f32x2 av = __builtin_elementwise_abs(v), d = av * 0.2316418882f + 1.0f;
    f32x2 t; t.x = __builtin_amdgcn_rcpf(d.x); t.y = __builtin_amdgcn_rcpf(d.y);
    f32x2 q = t * 0.5307027145f + (-0.7265760135f); q = q * t + 0.7107068705f; q = q * t + (-0.142248368f); q = q * t + 0.127414796f; q = q * t;
    const f32x2 s = (v * v) * (-0.72134752044f);
    f32x2 e; e.x = __builtin_amdgcn_exp2f(s.x); e.y = __builtin_amdgcn_exp2f(s.y);
    const f32x2 m = v * (q * e), r = v - m;
    f32x2 o; o.x = v.x < 0.f ? m.x : r.x; o.y = v.y < 0.f ? m.y : r.y; return o;
}

template <int ACT  > struct EpiBf16 {
    static constexpr bool PERM = true, AFTER_DRAIN = false; static_assert(ACT == 0 || ACT == 1, "EpiBf16: ACT is 0 (none) or 1 (gelu_pk)");
    bf16_t* O; int ldc; const float* bias; int split_cols; size_t split_stride; float scale0;
    __device__ __forceinline__ void operator()(const f32x4 (&acc)[2][2][4][2], const Unit& u, int wr, int wc, int fr, int fq) const {
        const int row0 = u.pm * BM + wr * 64 + fr; int colt = u.pn * BM; bf16_t* base = O;
        float sc = 1.f; if (split_cols) { const int t = colt / split_cols; base += (size_t)t * split_stride; colt -= t * split_cols; if (t == 0) sc = scale0; }
        const int col0 = colt + wc * 32 + 8 * fq, bcol0 = u.pn * BM + wc * 32 + 8 * fq;
        f32x4 bv[2][2];
#pragma unroll
        for (int bj = 0; bj < 2; ++bj)
#pragma unroll
            for (int n = 0; n < 2; ++n) bv[bj][n] = bias ? *(const f32x4*)(bias + bcol0 + bj * HALF + 4 * n) : (f32x4){0.f, 0.f, 0.f, 0.f};
#pragma unroll
        for (int ai = 0; ai < 2; ++ai)
#pragma unroll
            for (int m = 0; m < 4; ++m) { bf16_t* rowp = base + (size_t)(row0 + ai * HALF + m * 16) * ldc + col0;
#pragma unroll
                for (int bj = 0; bj < 2; ++bj) { f32x4 v0 = acc[ai][bj][m][0] + bv[bj][0], v1 = acc[ai][bj][m][1] + bv[bj][1];
                    if (ACT == 1) { f32x2 a = gelu_pk((f32x2){v0[0], v0[1]}), b = gelu_pk((f32x2){v0[2], v0[3]}), c = gelu_pk((f32x2){v1[0], v1[1]}), d = gelu_pk((f32x2){v1[2], v1[3]});
                        v0 = (f32x4){a.x, a.y, b.x, b.y}; v1 = (f32x4){c.x, c.y, d.x, d.y}; }
                    v0 = v0 * sc; v1 = v1 * sc; u32x4 w; w.x = cvt_pk_bf16(v0[0], v0[1]); w.y = cvt_pk_bf16(v0[2], v0[3]); w.z = cvt_pk_bf16(v1[0], v1[1]); w.w = cvt_pk_bf16(v1[2], v1[3]);
                    *(u32x4*)(rowp + bj * HALF) = w; } }
    }
};

struct PanelStats {
    unsigned* xbuf;
    unsigned* cnt;
    unsigned* tmo;
    int ntn; float eps;
    unsigned code;
    __device__ __forceinline__ bool run(const f32x4 (&v)[2][2][4][2], const Unit& u, int wr, int wc, int fr, int fq, PG8_LAS unsigned char* lds, int wid, int lane) const {
        typedef float f32x2v __attribute__((ext_vector_type(2)));
        PG8_LAS f32x2v* P = (PG8_LAS f32x2v*)lds;
        PG8_LAS f32x2v* S = (PG8_LAS f32x2v*)(lds + 8192);
        PG8_LAS unsigned* flag = (PG8_LAS unsigned*)(lds + 8192 + 2048);
#pragma unroll
        for (int ai = 0; ai < 2; ++ai)
#pragma unroll
            for (int m = 0; m < 4; ++m) {
                float s = 0.f;
#pragma unroll
                for (int bj = 0; bj < 2; ++bj)
#pragma unroll
                    for (int n = 0; n < 2; ++n) { const f32x4 x = v[ai][bj][m][n]; s += (x[0] + x[1]) + (x[2] + x[3]); }
                s += __shfl_xor(s, 16); s += __shfl_xor(s, 32);
                const float mw = s * (1.0f / 64.0f); float q = 0.f;
#pragma unroll
                for (int bj = 0; bj < 2; ++bj)
#pragma unroll
                    for (int n = 0; n < 2; ++n) { const f32x4 d = v[ai][bj][m][n] - mw; q += (d[0] * d[0] + d[1] * d[1]) + (d[2] * d[2] + d[3] * d[3]); }
                q += __shfl_xor(q, 16); q += __shfl_xor(q, 32);
                if (fq == 0) P[(ai * HALF + wr * 64 + m * 16 + fr) * 4 + wc] = (f32x2v){mw, q};
            }
        asm volatile("s_waitcnt lgkmcnt(0)" ::: "memory"); __builtin_amdgcn_s_barrier(); asm volatile("" ::: "memory");
#if defined(BROKEN_EXCHANGE_NO_WAIT)
#warning BROKEN CONTROL BUILD: the row-statistics exchange does not wait; results are wrong by design
        if (blockIdx.x >= 64) { const long long t0_ = clock64(); while (clock64() - t0_ < 60000) __builtin_amdgcn_s_sleep(8); }
#endif
        const int row = wid * 32 + (lane & 31);
        if (lane < 32) {
            const f32x2v a = P[row * 4 + 0], b = P[row * 4 + 1], c = P[row * 4 + 2], d = P[row * 4 + 3];
            const float mt = (a.x + b.x + c.x + d.x) * 0.25f;
            const float da = a.x - mt, db = b.x - mt, dc = c.x - mt, dd = d.x - mt;
            const float m2 = (a.y + b.y) + (c.y + d.y) + 64.0f * ((da * da + db * db) + (dc * dc + dd * dd));
            unsigned long long* slot = (unsigned long long*)xbuf + ((size_t)(u.pm * BM + row) * 4 + u.pn);
            __hip_atomic_store(slot, ((unsigned long long)__float_as_uint(m2) << 32) | __float_as_uint(mt), __ATOMIC_RELAXED, __HIP_MEMORY_SCOPE_AGENT);
        }
        asm volatile("s_waitcnt vmcnt(0)" ::: "memory");
        if (lane == 0) __hip_atomic_fetch_add(cnt + 64 * u.pm, 1u, __ATOMIC_RELAXED, __HIP_MEMORY_SCOPE_AGENT);
        if (wid == 0) {
            bool dead = false; const unsigned long long t0 = __builtin_amdgcn_s_memrealtime(); const unsigned want = 8u * (unsigned)ntn;
            for (;;) {
#if defined(BROKEN_EXCHANGE_NO_WAIT)
                break;
#endif
                if ((unsigned)__builtin_amdgcn_readfirstlane(__hip_atomic_load(cnt + 64 * u.pm, __ATOMIC_RELAXED, __HIP_MEMORY_SCOPE_AGENT)) >= want) break;
                if (__builtin_amdgcn_s_memrealtime() - t0 > 2000000ull) {
                    if (lane == 0) { unsigned expect = 0u; __hip_atomic_compare_exchange_strong(tmo + 1, &expect, code | (unsigned)(u.pm & 0xff), __ATOMIC_RELAXED, __ATOMIC_RELAXED, __HIP_MEMORY_SCOPE_AGENT);
                                     __hip_atomic_store(tmo, 1u, __ATOMIC_RELAXED, __HIP_MEMORY_SCOPE_AGENT); }
                    dead = true; break; }
                __builtin_amdgcn_s_sleep(2);
            }
            __builtin_amdgcn_fence(__ATOMIC_ACQUIRE, "agent");
            if (lane == 0) flag[0] = dead ? 1u : 0u;
        }
        asm volatile("s_waitcnt vmcnt(0) lgkmcnt(0)" ::: "memory"); __builtin_amdgcn_s_barrier(); asm volatile("" ::: "memory");
        const bool bad = flag[0] != 0u;
        if (lane < 32) {
            const unsigned long long* slot = (const unsigned long long*)xbuf + (size_t)(u.pm * BM + row) * 4; float mt[4], m2[4]; float ms = 0.f;
#pragma unroll
            for (int t = 0; t < 4; ++t) { if (t < ntn) { const unsigned long long w = __hip_atomic_load(slot + t, __ATOMIC_RELAXED, __HIP_MEMORY_SCOPE_AGENT); mt[t] = __uint_as_float((unsigned)w); m2[t] = __uint_as_float((unsigned)(w >> 32)); } else { mt[t] = 0.f; m2[t] = 0.f; } ms += mt[t]; }
            const float mean = ms / (float)ntn; float q = 0.f;
#pragma unroll
            for (int t = 0; t < 4; ++t) if (t < ntn) { const float dm = mt[t] - mean; q += m2[t] + 256.0f * dm * dm; }
            S[row] = (f32x2v){mean, 1.0f / sqrtf(q / (256.0f * (float)ntn) + eps)};
        }
        asm volatile("s_waitcnt lgkmcnt(0)" ::: "memory"); __builtin_amdgcn_s_barrier(); asm volatile("" ::: "memory");
        return bad;
    }
};
struct EpiLnRes {
    static constexpr bool PERM = false, AFTER_DRAIN = true;
    const float* base; float* out; int ldc; const float* bias; PanelStats st; unsigned poison;
    __device__ __forceinline__ void fused(f32x4 (&acc)[2][2][4][2], const Unit& u, int wr, int wc, int fr, int fq, PG8_LAS unsigned char* lds, int wid, int lane) const {
        typedef float f32x2v __attribute__((ext_vector_type(2)));
        const PG8_LAS f32x2v* S = (const PG8_LAS f32x2v*)(lds + 8192);
        const int col0 = u.pn * BM + wc * 32 + 4 * fq;
#pragma unroll
        for (int bj = 0; bj < 2; ++bj)
#pragma unroll
            for (int n = 0; n < 2; ++n) { const f32x4 bv = bias ? *(const f32x4*)(bias + col0 + bj * HALF + n * 16) : (f32x4){0.f, 0.f, 0.f, 0.f};
#pragma unroll
                for (int ai = 0; ai < 2; ++ai)
#pragma unroll
                    for (int m = 0; m < 4; ++m) acc[ai][bj][m][n] += bv; }
        f32x4 pre[4][2][2];
#pragma unroll
        for (int m = 0; m < 4; ++m) { const size_t off = (size_t)(u.pm * BM + wr * 64 + m * 16 + fr) * ldc + col0;
#pragma unroll
            for (int bj = 0; bj < 2; ++bj)
#pragma unroll
                for (int n = 0; n < 2; ++n) pre[m][bj][n] = *(const f32x4*)(base + off + bj * HALF + n * 16); }
        const bool bad = st.run(acc, u, wr, wc, fr, fq, lds, wid, lane) || poison != 0u;
        const float qnan = __builtin_nanf("");
#pragma unroll
        for (int ai = 0; ai < 2; ++ai)
#pragma unroll
            for (int m = 0; m < 4; ++m) { const int r = ai * HALF + wr * 64 + m * 16 + fr; const f32x2v sr = S[r]; const size_t off = (size_t)(u.pm * BM + r) * ldc + col0;
#pragma unroll
                for (int bj = 0; bj < 2; ++bj)
#pragma unroll
                    for (int n = 0; n < 2; ++n) { const f32x4 bs = ai == 0 ? pre[m][bj][n] : *(const f32x4*)(base + off + bj * HALF + n * 16); f32x4 o = bs + (acc[ai][bj][m][n] - sr.x) * sr.y;
                        if (bad) o = (f32x4){qnan, qnan, qnan, qnan}; *(f32x4*)(out + off + bj * HALF + n * 16) = o; }
                if (m & 1) asm volatile("" ::: "memory"); }
    }
};
struct EpiLnResLn {
    static constexpr bool PERM = false, AFTER_DRAIN = true;
    const float* base; float* out; bf16_t* xn; int ldc; const float* bias; PanelStats st1, st2; unsigned poison;
    __device__ __forceinline__ void fused(f32x4 (&acc)[2][2][4][2], const Unit& u, int wr, int wc, int fr, int fq, PG8_LAS unsigned char* lds, int wid, int lane) const {
        typedef float f32x2v __attribute__((ext_vector_type(2))); typedef unsigned u32x2v __attribute__((ext_vector_type(2)));
        const PG8_LAS f32x2v* S = (const PG8_LAS f32x2v*)(lds + 8192);
        const int col0 = u.pn * BM + wc * 32 + 4 * fq;
#pragma unroll
        for (int bj = 0; bj < 2; ++bj)
#pragma unroll
            for (int n = 0; n < 2; ++n) { const f32x4 bv = bias ? *(const f32x4*)(bias + col0 + bj * HALF + n * 16) : (f32x4){0.f, 0.f, 0.f, 0.f};
#pragma unroll
                for (int ai = 0; ai < 2; ++ai)
#pragma unroll
                    for (int m = 0; m < 4; ++m) acc[ai][bj][m][n] += bv; }
        bool bad = st1.run(acc, u, wr, wc, fr, fq, lds, wid, lane) || poison != 0u;
        const float qnan = __builtin_nanf("");
#pragma unroll
        for (int ai = 0; ai < 2; ++ai)
#pragma unroll
            for (int m = 0; m < 4; ++m) { const int r = ai * HALF + wr * 64 + m * 16 + fr; const f32x2v sr = S[r]; const size_t off = (size_t)(u.pm * BM + r) * ldc + col0;
#pragma unroll
                for (int bj = 0; bj < 2; ++bj)
#pragma unroll
                    for (int n = 0; n < 2; ++n) { const f32x4 bs = *(const f32x4*)(base + off + bj * HALF + n * 16); acc[ai][bj][m][n] = bs + (acc[ai][bj][m][n] - sr.x) * sr.y; }
                asm volatile("" : "+v"(acc[ai][0][m][0]), "+v"(acc[ai][0][m][1]), "+v"(acc[ai][1][m][0]), "+v"(acc[ai][1][m][1]));
                if (m & 1) asm volatile("" ::: "memory"); }
        const bool bad1 = bad;
        bad = st2.run(acc, u, wr, wc, fr, fq, lds, wid, lane) || bad;
#pragma unroll
        for (int ai = 0; ai < 2; ++ai)
#pragma unroll
            for (int m = 0; m < 4; ++m) { const int r = ai * HALF + wr * 64 + m * 16 + fr; const f32x2v sr = S[r]; const size_t off = (size_t)(u.pm * BM + r) * ldc + col0;
#pragma unroll
                for (int bj = 0; bj < 2; ++bj)
#pragma unroll
                    for (int n = 0; n < 2; ++n) { const f32x4 x1 = acc[ai][bj][m][n]; *(f32x4*)(out + off + bj * HALF + n * 16) = bad1 ? (f32x4){qnan, qnan, qnan, qnan} : x1;
                        const f32x4 o = (x1 - sr.x) * sr.y; u32x2v w; w.x = cvt_pk_bf16(o[0], o[1]); w.y = cvt_pk_bf16(o[2], o[3]);
                        if (bad) { w.x = 0x7fc07fc0u; w.y = 0x7fc07fc0u; } *(u32x2v*)(xn + off + bj * HALF + n * 16) = w; }
                asm volatile("" ::: "memory"); }
    }
};

template <class Epi, class Sched, bool ALIGN_EPI = false, bool SP2 = false>
__device__ __forceinline__ void gemm_phase(PG8_LAS unsigned char* lds, const Gemm g, const Sched& S, const Epi& E) {
    const int tid = threadIdx.x, wid = __builtin_amdgcn_readfirstlane(tid >> 6), lane = tid & 63, wr = wid >> 2, wc = wid & 3, fr = lane & 15, fq = lane >> 4;
    const int K = g.K, nt = K / BK;
    unsigned voffA[2], voffB[2];
#pragma unroll
    for (int i = 0; i < 2; ++i) { int R, C; stage_rc(tid * 16 + i * 8192, R, C); const int Rb = Epi::PERM ? ((R & ~31) + perm32(R & 31)) : R;
        voffA[i] = (unsigned)(R * K + C) * 2u; voffB[i] = (unsigned)(Rb * K + C) * 2u; }
    const size_t kstep = (size_t)(BK * 2);
    const size_t hstep = (size_t)HALF * K * 2;
    const size_t tstep = 2 * hstep;
    const unsigned ldsw = (unsigned)wid * 1024u;
    const int aoff = lds_byte(wr * 64 + fr, fq * 8), boff = lds_byte(wc * 32 + fr, fq * 8);
#define PG8_SA(b, h) (((b) * 2 + (h)) * HTB)
#define PG8_SB(b, h) ((4 + (b) * 2 + (h)) * HTB)
#define PG8_STAGE(bufoff, gbase, voff) do { _Pragma("unroll") for (int _i = 0; _i < 2; ++_i) \
        __builtin_amdgcn_global_load_lds((const unsigned*)((const char*)(gbase) + (voff)[_i]), (PG8_LAS unsigned*)(lds + (bufoff) + ldsw + _i * 8192), 16, 0, 0); } while (0)
#define PG8_LDA(dst, b, h) do { _Pragma("unroll") for (int m = 0; m < 4; ++m) _Pragma("unroll") for (int k = 0; k < 2; ++k) dst[m][k] = *(const PG8_LAS bf16x8*)(lds + PG8_SA(b, h) + aoff + m * 2048 + k * 1024); } while (0)
#define PG8_LDB(dst, b, h) do { _Pragma("unroll") for (int n = 0; n < 2; ++n) _Pragma("unroll") for (int k = 0; k < 2; ++k) dst[n][k] = *(const PG8_LAS bf16x8*)(lds + PG8_SB(b, h) + boff + n * 2048 + k * 1024); } while (0)
#define PG8_MMA(ai, bj, At, Bt) do { __builtin_amdgcn_s_setprio(1); _Pragma("unroll") for (int m = 0; m < 4; ++m) _Pragma("unroll") for (int n = 0; n < 2; ++n) _Pragma("unroll") for (int k = 0; k < 2; ++k) \
        acc[ai][bj][m][n] = __builtin_amdgcn_mfma_f32_16x16x32_bf16(Bt[n][k], At[m][k], acc[ai][bj][m][n], 0, 0, 0); __builtin_amdgcn_s_setprio(0); } while (0)
#define PG8_WAIT_V(n) asm volatile("s_waitcnt vmcnt(" #n ")" ::: "memory")
#define PG8_WAIT_L(n) asm volatile("s_waitcnt lgkmcnt(" #n ")" ::: "memory")
#define PG8_BAR __builtin_amdgcn_s_barrier()
#define PG8_SCHED __builtin_amdgcn_sched_barrier(0)
    Unit cur, nxt; int ui = 0;
    if (!S.next(0, cur)) return;
    f32x4 acc[2][2][4][2];
#pragma unroll
    for (int a = 0; a < 2; ++a)
#pragma unroll
        for (int b = 0; b < 2; ++b)
#pragma unroll
            for (int m = 0; m < 4; ++m)
#pragma unroll
                for (int n = 0; n < 2; ++n) acc[a][b][m][n] = (f32x4){0.f, 0.f, 0.f, 0.f};
    bf16x8 At[4][2], B0[2][2], B1[2][2];
    const char* cA = (const char*)g.A + (size_t)cur.pm * tstep; const char* cB = (const char*)g.Bt + (size_t)cur.pn * tstep;
    S.a_ready(cur);
    if constexpr (SP2) {
        PG8_STAGE(PG8_SB(0, 0), cB, voffB); PG8_STAGE(PG8_SB(0, 1), cB + hstep, voffB); PG8_STAGE(PG8_SA(0, 0), cA, voffA); PG8_STAGE(PG8_SA(0, 1), cA + hstep, voffA);
        if (wr == 1) PG8_BAR;
        PG8_WAIT_V(2); PG8_BAR;
        PG8_STAGE(PG8_SB(1, 0), cB + kstep, voffB); PG8_STAGE(PG8_SA(1, 0), cA + kstep, voffA); PG8_STAGE(PG8_SB(1, 1), cB + hstep + kstep, voffB);
        PG8_WAIT_V(6); PG8_BAR;
    } else {
        PG8_STAGE(PG8_SB(0, 0), cB, voffB); PG8_STAGE(PG8_SA(0, 0), cA, voffA); PG8_STAGE(PG8_SB(0, 1), cB + hstep, voffB); PG8_STAGE(PG8_SA(0, 1), cA + hstep, voffA);
        if (wr == 1) PG8_BAR;
        PG8_WAIT_V(4); PG8_BAR;
        PG8_STAGE(PG8_SB(1, 0), cB + kstep, voffB); PG8_STAGE(PG8_SA(1, 0), cA + kstep, voffA); PG8_STAGE(PG8_SB(1, 1), cB + hstep + kstep, voffB);
        PG8_WAIT_V(6); PG8_BAR;
    }
    for (;;) {
        const bool has_next = S.next(ui + 1, nxt);
        const char* nA = has_next ? (const char*)g.A + (size_t)nxt.pm * tstep : cA; const char* nB = has_next ? (const char*)g.Bt + (size_t)nxt.pn * tstep : cB;
        for (int t = 0; t < nt; t += 2) {
            const bool last = (t == nt - 2);
            const char* a1 = cA + (size_t)(t + 1) * kstep;
            const char* a2 = last ? nA : cA + (size_t)(t + 2) * kstep; const char* b2 = last ? nB : cB + (size_t)(t + 2) * kstep;
            const char* a3 = a2 + kstep; const char* b3 = b2 + kstep;
            if (last && has_next) S.a_ready(nxt);
            if constexpr (SP2) {
            PG8_LDB(B0, 0, 0); PG8_LDB(B1, 0, 1); PG8_SCHED; PG8_LDA(At, 0, 0); PG8_STAGE(PG8_SA(1, 1), a1 + hstep, voffA);
            PG8_WAIT_V(8); PG8_WAIT_L(0); PG8_BAR; PG8_MMA(0, 0, At, B0); PG8_MMA(0, 1, At, B1); PG8_BAR; PG8_SCHED;
            PG8_LDA(At, 0, 1); PG8_STAGE(PG8_SB(0, 0), b2, voffB); PG8_STAGE(PG8_SB(0, 1), b2 + hstep, voffB); PG8_STAGE(PG8_SA(0, 0), a2, voffA);
            PG8_WAIT_V(8); PG8_WAIT_L(0); PG8_BAR; PG8_MMA(1, 0, At, B0); PG8_MMA(1, 1, At, B1); PG8_BAR; PG8_SCHED;
            PG8_LDB(B0, 1, 0); PG8_LDB(B1, 1, 1); PG8_SCHED; PG8_LDA(At, 1, 0); PG8_STAGE(PG8_SA(0, 1), a2 + hstep, voffA);
            PG8_WAIT_V(8); PG8_WAIT_L(0); PG8_BAR; PG8_MMA(0, 0, At, B0); PG8_MMA(0, 1, At, B1); PG8_BAR; PG8_SCHED;
            PG8_LDA(At, 1, 1); PG8_STAGE(PG8_SB(1, 0), b3, voffB); PG8_STAGE(PG8_SB(1, 1), b3 + hstep, voffB); PG8_STAGE(PG8_SA(1, 0), a3, voffA);
            PG8_WAIT_V(8); PG8_WAIT_L(0); PG8_BAR; PG8_MMA(1, 0, At, B0); PG8_MMA(1, 1, At, B1); PG8_BAR; PG8_SCHED;
            } else {
            PG8_LDB(B0, 0, 0); PG8_SCHED; PG8_LDA(At, 0, 0); PG8_STAGE(PG8_SA(1, 1), a1 + hstep, voffA);
            PG8_WAIT_L(8); PG8_BAR; PG8_WAIT_L(0); PG8_MMA(0, 0, At, B0); PG8_BAR; PG8_SCHED;
            PG8_LDB(B1, 0, 1); PG8_STAGE(PG8_SB(0, 0), b2, voffB);
            PG8_BAR; PG8_WAIT_L(0); PG8_MMA(0, 1, At, B1); PG8_BAR;
            PG8_LDA(At, 0, 1); PG8_STAGE(PG8_SA(0, 0), a2, voffA);
            PG8_BAR; PG8_WAIT_L(0); PG8_MMA(1, 0, At, B0); PG8_BAR; PG8_SCHED;
            PG8_STAGE(PG8_SB(0, 1), b2 + hstep, voffB);
            PG8_WAIT_V(6); PG8_BAR; PG8_MMA(1, 1, At, B1); PG8_BAR;
            PG8_LDB(B0, 1, 0); PG8_SCHED; PG8_LDA(At, 1, 0); PG8_STAGE(PG8_SA(0, 1), a2 + hstep, voffA);
            PG8_WAIT_L(8); PG8_BAR; PG8_WAIT_L(0); PG8_MMA(0, 0, At, B0); PG8_BAR; PG8_SCHED;
            PG8_LDB(B1, 1, 1); PG8_STAGE(PG8_SB(1, 0), b3, voffB);
            PG8_BAR; PG8_WAIT_L(0); PG8_MMA(0, 1, At, B1); PG8_BAR;
            PG8_LDA(At, 1, 1); PG8_STAGE(PG8_SA(1, 0), a3, voffA);
            PG8_BAR; PG8_WAIT_L(0); PG8_MMA(1, 0, At, B0); PG8_BAR; PG8_SCHED;
            PG8_STAGE(PG8_SB(1, 1), b3 + hstep, voffB);
            PG8_WAIT_V(6); PG8_BAR; PG8_MMA(1, 1, At, B1); PG8_BAR;
            }
        }
        if constexpr (ALIGN_EPI) { if (wr == 0) PG8_BAR; }
        if constexpr (!Epi::AFTER_DRAIN) { E(acc, cur, wr, wc, fr, fq); S.done(cur); }
        if (!has_next) break;
#pragma unroll
        for (int a = 0; a < 2; ++a)
#pragma unroll
            for (int b = 0; b < 2; ++b)
#pragma unroll
                for (int m = 0; m < 4; ++m)
#pragma unroll
                    for (int n = 0; n < 2; ++n) acc[a][b][m][n] = (f32x4){0.f, 0.f, 0.f, 0.f};
        cur = nxt; cA = nA; cB = nB; ++ui;
        if constexpr (ALIGN_EPI) { if (wr == 1) PG8_BAR; }
    }
    PG8_WAIT_V(0);
    if constexpr (!ALIGN_EPI) { if (wr == 0) PG8_BAR; }
    PG8_BAR;
    if constexpr (Epi::AFTER_DRAIN) { E.fused(acc, cur, wr, wc, fr, fq, lds, wid, lane); S.done(cur); }
#undef PG8_SA
#undef PG8_SB
#undef PG8_STAGE
#undef PG8_LDA
#undef PG8_LDB
#undef PG8_MMA
#undef PG8_WAIT_V
#undef PG8_WAIT_L
#undef PG8_BAR
#undef PG8_SCHED
}
}
namespace pg8 {
__device__ __forceinline__ float bf2f(unsigned short b) { return __uint_as_float(((unsigned)b) << 16); }
__device__ __forceinline__ float bflo(unsigned w) { return __uint_as_float(w << 16); }
__device__ __forceinline__ float bfhi(unsigned w) { return __uint_as_float(w & 0xffff0000u); }
__device__ __forceinline__ float sigm(float x) { return 1.f / (1.f + __expf(-x)); }
template <int MODE> struct EpiGate {
    static constexpr bool PERM = true, AFTER_DRAIN = false;
    bf16_t* O; int ldc; const bf16_t* G; int ldg;
    __device__ __forceinline__ void operator()(const f32x4 (&acc)[2][2][4][2], const Unit& u, int wr, int wc, int fr, int fq) const {
        const int row0 = u.pm * BM + wr * 64 + fr, col0 = u.pn * BM + wc * 32 + 8 * fq;
#pragma unroll
        for (int ai = 0; ai < 2; ++ai)
#pragma unroll
            for (int m = 0; m < 4; ++m) { const size_t row = (size_t)(row0 + ai * HALF + m * 16);
#pragma unroll
                for (int bj = 0; bj < 2; ++bj) {
                    const u32x4 gw = *(const u32x4*)(G + row * ldg + col0 + bj * HALF);
                    f32x4 v0 = acc[ai][bj][m][0], v1 = acc[ai][bj][m][1];
                    v0[0] *= sigm(bflo(gw.x)); v0[1] *= sigm(bfhi(gw.x)); v0[2] *= sigm(bflo(gw.y)); v0[3] *= sigm(bfhi(gw.y));
                    v1[0] *= sigm(bflo(gw.z)); v1[1] *= sigm(bfhi(gw.z)); v1[2] *= sigm(bflo(gw.w)); v1[3] *= sigm(bfhi(gw.w));
                    bf16_t* op = O + row * ldc + col0 + bj * HALF;
                    if (MODE == 1) { const u32x4 ow = *(const u32x4*)op;
                        v0[0] += bflo(ow.x); v0[1] += bfhi(ow.x); v0[2] += bflo(ow.y); v0[3] += bfhi(ow.y);
                        v1[0] += bflo(ow.z); v1[1] += bfhi(ow.z); v1[2] += bflo(ow.w); v1[3] += bfhi(ow.w); }
                    u32x4 w; w.x = cvt_pk_bf16(v0[0], v0[1]); w.y = cvt_pk_bf16(v0[2], v0[3]); w.z = cvt_pk_bf16(v1[0], v1[1]); w.w = cvt_pk_bf16(v1[2], v1[3]);
                    *(u32x4*)op = w; } }
    }
};
struct EpiResid {
    static constexpr bool PERM = true, AFTER_DRAIN = false;
    const float* R; float* Hf; bf16_t* Hb; float* ss; int ldc;
    __device__ __forceinline__ void operator()(const f32x4 (&acc)[2][2][4][2], const Unit& u, int wr, int wc, int fr, int fq) const {
        const int row0 = u.pm * BM + wr * 64 + fr, col0 = u.pn * BM + wc * 32 + 8 * fq;
#pragma unroll
        for (int ai = 0; ai < 2; ++ai)
#pragma unroll
            for (int m = 0; m < 4; ++m) { const size_t row = (size_t)(row0 + ai * HALF + m * 16); float sq = 0.f;
#pragma unroll
                for (int bj = 0; bj < 2; ++bj) {
                    const size_t off = row * ldc + col0 + bj * HALF;
                    const f32x4 r0 = *(const f32x4*)(R + off), r1 = *(const f32x4*)(R + off + 4);
                    const f32x4 v0 = acc[ai][bj][m][0] + r0, v1 = acc[ai][bj][m][1] + r1;
                    *(f32x4*)(Hf + off) = v0; *(f32x4*)(Hf + off + 4) = v1;
                    u32x4 w; w.x = cvt_pk_bf16(v0[0], v0[1]); w.y = cvt_pk_bf16(v0[2], v0[3]); w.z = cvt_pk_bf16(v1[0], v1[1]); w.w = cvt_pk_bf16(v1[2], v1[3]);
                    *(u32x4*)(Hb + off) = w;
                    sq += (v0[0] * v0[0] + v0[1] * v0[1]) + (v0[2] * v0[2] + v0[3] * v0[3]) + (v1[0] * v1[0] + v1[1] * v1[1]) + (v1[2] * v1[2] + v1[3] * v1[3]); }
                sq += __shfl_xor(sq, 16); sq += __shfl_xor(sq, 32);
                if (fq == 0) atomicAdd(ss + row, sq); }
    }
};
struct EpiRowScale {
    static constexpr bool PERM = true, AFTER_DRAIN = false;
    bf16_t* O; int ldc; const float* ss; float inv_n, eps;
    __device__ __forceinline__ void operator()(const f32x4 (&acc)[2][2][4][2], const Unit& u, int wr, int wc, int fr, int fq) const {
        const int row0 = u.pm * BM + wr * 64 + fr, col0 = u.pn * BM + wc * 32 + 8 * fq;
#pragma unroll
        for (int ai = 0; ai < 2; ++ai)
#pragma unroll
            for (int m = 0; m < 4; ++m) { const size_t row = (size_t)(row0 + ai * HALF + m * 16);
                const float sc = rsqrtf(__hip_atomic_load(ss + row, __ATOMIC_RELAXED, __HIP_MEMORY_SCOPE_AGENT) * inv_n + eps);
#pragma unroll
                for (int bj = 0; bj < 2; ++bj) { const f32x4 v0 = acc[ai][bj][m][0] * sc, v1 = acc[ai][bj][m][1] * sc;
                    u32x4 w; w.x = cvt_pk_bf16(v0[0], v0[1]); w.y = cvt_pk_bf16(v0[2], v0[3]); w.z = cvt_pk_bf16(v1[0], v1[1]); w.w = cvt_pk_bf16(v1[2], v1[3]);
                    *(u32x4*)(O + row * ldc + col0 + bj * HALF) = w; } }
    }
};
}
constexpr int D_MODEL = 2048, BATCH = 2, SEQ = 4096, NTOK = BATCH * SEQ;
constexpr int HD = 64, NCMP = 255, CMP_STRIDE = 16, CMP_LEN = 32, CMP_HID = 128;
constexpr int SEL_LEN = 64, SEL_TOPK = 16, WINDOW = 512;
constexpr int PEER_KEYS = 128, PEER_E = 128;
constexpr int NSA_Q = 1024, SB_W = 1024;
constexpr int IN_COLS = 9776, PLD = 9984;
constexpr int C_QN = 0, C_KC = 1024, C_VC = 1280, C_KS = 1536, C_VS = 1792, C_KW = 2048, C_VW = 2304, C_GBR = 2560,
              C_QB = 2608, C_KB = 3632, C_VB = 4656, C_GA = 5680, C_GB = 7728;
constexpr float EPS = 1e-6f, NEGF = -1e30f;
constexpr int NWAVES = 8, NTHR = 512;

constexpr size_t MiB = 1u << 20;
constexpr size_t WS_CTL = 0, CTL_ZERO_BYTES = 1 * MiB;
constexpr size_t WS_WIN = 2 * MiB;
constexpr size_t WS_WBN = 42 * MiB, WS_WBS = 46 * MiB;
constexpr size_t WS_WOUT = 50 * MiB, WS_WPQ = 58 * MiB;
constexpr size_t WS_MISC = 66 * MiB;
constexpr size_t WS_XN = 70 * MiB;
constexpr size_t WS_PROJ = 102 * MiB;
constexpr size_t WS_ONSA = 258 * MiB, WS_OSB = 274 * MiB;
constexpr size_t WS_H = 290 * MiB;
constexpr size_t WS_HB = 354 * MiB;
constexpr size_t WS_END = 386 * MiB;
constexpr size_t WS_UB = 102 * MiB, WS_VB = 166 * MiB, WS_QP = 230 * MiB, WS_EXP = 262 * MiB, WS_GATE = 266 * MiB;
constexpr size_t MISC_KCB = 0, MISC_VCB = 1 * MiB;
constexpr int CW_BAR = 4096;
constexpr int CW_SS = 32768;

#define GAS __attribute__((address_space(1)))
#define LAS __attribute__((address_space(3)))
typedef unsigned short bf16;
typedef unsigned v4u __attribute__((ext_vector_type(4)));
typedef unsigned v2u __attribute__((ext_vector_type(2)));
typedef float f32x4 __attribute__((ext_vector_type(4)));
#define RLX_AGENT __ATOMIC_RELAXED, __HIP_MEMORY_SCOPE_AGENT
__device__ __forceinline__ unsigned f2bf(float f) { unsigned u = __builtin_bit_cast(unsigned, f); return (u + 0x7fffu + ((u >> 16) & 1u)) >> 16; }
__device__ __forceinline__ unsigned pk2(float lo, float hi) { return f2bf(lo) | (f2bf(hi) << 16); }
__device__ __forceinline__ float bf2f(bf16 b) { return __uint_as_float(((unsigned)b) << 16); }
__device__ __forceinline__ float bflo(unsigned w) { return __uint_as_float(w << 16); }
__device__ __forceinline__ float bfhi(unsigned w) { return __uint_as_float(w & 0xffff0000u); }

#define XB_TMO      128
#define XB_XCNT(j)  (256  + 64 * (j))
#define XB_XSUB(j)  (1280 + 64 * (j))
#define XB_XGEN(j)  (2304 + 64 * (j))
#define XB_TOP      3328
#define XB_TOPGEN   3392
#define XCD_BAR_WORDS 3456
#define XB_SPIN_CAP (1u << 24)
__device__ __forceinline__ unsigned xb_ld(unsigned* p)              { return __hip_atomic_load(p, __ATOMIC_RELAXED, __HIP_MEMORY_SCOPE_AGENT); }
__device__ __forceinline__ unsigned xb_add(unsigned* p, unsigned v) { return __hip_atomic_fetch_add(p, v, __ATOMIC_RELAXED, __HIP_MEMORY_SCOPE_AGENT); }
__device__ __forceinline__ unsigned xb_xcc_id() { return (unsigned)__builtin_amdgcn_s_getreg((3 << 11) | 20) & 0xFu; }
#define XB_SPIN(cond, bar) do { unsigned _sp = 0; while (cond) { __builtin_amdgcn_s_sleep(1); \
    if ((++_sp & 255u) == 0u) { if (xb_ld(&(bar)[XB_TMO])) break; if (_sp > XB_SPIN_CAP) { atomicAdd(&(bar)[XB_TMO], 1u); break; } } } } while (0)
struct XcdBarrier { unsigned* bar; unsigned x; volatile LAS unsigned* st; };
__device__ __forceinline__ XcdBarrier xcd_barrier_post(unsigned* bar, volatile LAS unsigned* st) {
    XcdBarrier b; b.bar = bar; b.x = xb_xcc_id(); b.st = st;
    if (threadIdx.x == 0) (void)xb_add(&bar[XB_XCNT(b.x)], 1u);
    return b;
}
__device__ __forceinline__ void xcd_barrier_complete(unsigned* bar, unsigned x, unsigned& nloc, unsigned& nx) {
    const unsigned G = gridDim.x * gridDim.y * gridDim.z;
    unsigned sum, cnt, mine, sp = 0u;
    for (;;) {
        sum = 0u; cnt = 0u; mine = 0u;
#pragma unroll
        for (unsigned j = 0; j < 16; ++j) { const unsigned c = xb_ld(&bar[XB_XCNT(j)]); sum += c; cnt += (c > 0u) ? 1u : 0u; mine = (j == x) ? c : mine; }
        if (sum == G) break;
        __builtin_amdgcn_s_sleep(1);
        if ((++sp & 255u) == 0u) { if (xb_ld(&bar[XB_TMO])) break; if (sp > XB_SPIN_CAP) { atomicAdd(&bar[XB_TMO], 1u); break; } }
    }
    nloc = mine > 0u ? mine : 1u; nx = cnt > 0u ? cnt : 1u;
}
__device__ __forceinline__ void xcd_barrier(const XcdBarrier& b) {
    asm volatile("s_waitcnt vmcnt(0)" ::: "memory");
    __syncthreads();
    if (threadIdx.x == 0) {
        unsigned* bar = b.bar;
        __builtin_amdgcn_s_waitcnt(0);
        unsigned nloc = b.st[0], nx = b.st[1];
        if (nloc == 0u) { xcd_barrier_complete(bar, b.x, nloc, nx); b.st[0] = nloc; b.st[1] = nx; }
        const unsigned old = xb_add(&bar[XB_XSUB(b.x)], 1u);
        const unsigned gen = old / nloc;
        if (old + 1u == (gen + 1u) * nloc) {
            __builtin_amdgcn_fence(__ATOMIC_RELEASE, "agent");
            asm volatile("s_waitcnt vmcnt(0)" ::: "memory");
            const unsigned og = xb_add(&bar[XB_TOP], 1u);
            const unsigned tg = og / nx;
            if (og + 1u == (tg + 1u) * nx) xb_add(&bar[XB_TOPGEN], 1u);
            else XB_SPIN(xb_ld(&bar[XB_TOPGEN]) == tg, bar);
            __builtin_amdgcn_fence(__ATOMIC_ACQUIRE, "agent");
            xb_add(&bar[XB_XGEN(b.x)], 1u);
            asm volatile("s_waitcnt vmcnt(0)" ::: "memory");
        } else {
            XB_SPIN(xb_ld(&bar[XB_XGEN(b.x)]) == gen, bar);
            __builtin_amdgcn_fence(__ATOMIC_ACQUIRE, "agent");
            asm volatile("s_waitcnt vmcnt(0)" ::: "memory");
        }
    }
    __syncthreads();
}

__device__ __forceinline__ int rel_bucket(int d) {
    if (d < 16) return d < 0 ? 0 : d;
    int b = 16;
    b += (d >= 21); b += (d >= 27); b += (d >= 35); b += (d >= 46); b += (d >= 59); b += (d >= 77); b += (d >= 99); b += (d >= 128);
    b += (d >= 166); b += (d >= 216); b += (d >= 280); b += (d >= 363); b += (d >= 470); b += (d >= 609); b += (d >= 790);
    return b;
}
__device__ __forceinline__ float gelu_tanh(float x) { const float k = 0.7978845608028654f; return 0.5f * x * (1.f + tanhf(k * (x + 0.044715f * x * x * x))); }
__device__ __forceinline__ float sigmoidf_(float x) { return 1.f / (1.f + expf(-x)); }
__device__ __forceinline__ float wave_sum(float v) {
#pragma unroll
    for (int o = 32; o >= 1; o >>= 1) v += __shfl_xor(v, o);
    return v;
}
__device__ __forceinline__ float wave_max(float v) {
#pragma unroll
    for (int o = 32; o >= 1; o >>= 1) v = fmaxf(v, __shfl_xor(v, o));
    return v;
}
__device__ __forceinline__ float half_sum(float v, float* red) {
    v = wave_sum(v);
    __syncthreads();
    if ((threadIdx.x & 63) == 0) red[(threadIdx.x >> 6) & 3] = v;
    __syncthreads();
    return red[0] + red[1] + red[2] + red[3];
}
__device__ __forceinline__ float half_max(float v, float* red) {
    v = wave_max(v);
    __syncthreads();
    if ((threadIdx.x & 63) == 0) red[(threadIdx.x >> 6) & 3] = v;
    __syncthreads();
    return fmaxf(fmaxf(red[0], red[1]), fmaxf(red[2], red[3]));
}

struct Args {
    const float* in[19]; float* out; unsigned char* ws; int ph_lo, ph_hi;
};

__device__ __forceinline__ void p0_transpose_item(const float* W, int K, int N, bf16* WT, const float* gk, LAS float* scr, int item, int lane) {
    const int nblk = (N + 31) / 32, kb = item / nblk, nb = item % nblk, k0 = 64 * kb, n0 = 32 * nb;
    const bool cok = (n0 + (lane & 31)) < N;
#pragma unroll 8
    for (int i = 0; i < 32; ++i) { const int kk = 2 * i + (lane >> 5); float v = cok ? W[(size_t)(k0 + kk) * N + n0 + (lane & 31)] : 0.f; if (gk) v *= gk[k0 + kk]; scr[kk * 33 + (lane & 31)] = v; }
    asm volatile("s_waitcnt lgkmcnt(0)" ::: "memory");
    const int c = lane & 7;
#pragma unroll
    for (int j = 0; j < 4; ++j) { const int n = (lane >> 3) + 8 * j; const LAS float* s = scr + (8 * c) * 33 + n;
        v4u o; o.x = pk2(s[0 * 33], s[1 * 33]); o.y = pk2(s[2 * 33], s[3 * 33]); o.z = pk2(s[4 * 33], s[5 * 33]); o.w = pk2(s[6 * 33], s[7 * 33]);
        if (n0 + n < N) *(v4u*)(WT + (size_t)(n0 + n) * K + k0 + 8 * c) = o; }
    asm volatile("s_waitcnt lgkmcnt(0)" ::: "memory");
}
__device__ __forceinline__ void rms_row_to_bf16(const float* xrow, const float* g, bf16* orow, int lane) {
    const f32x4* xr = (const f32x4*)xrow + lane; const f32x4* gr = (const f32x4*)g + lane;
    f32x4 v[8]; float s = 0.f;
#pragma unroll
    for (int j = 0; j < 8; ++j) { v[j] = xr[64 * j]; s += (v[j].x * v[j].x + v[j].y * v[j].y) + (v[j].z * v[j].z + v[j].w * v[j].w); }
    const float r = rsqrtf(wave_sum(s) * (1.f / D_MODEL) + EPS);
    v2u* o8 = (v2u*)orow + lane;
#pragma unroll
    for (int j = 0; j < 8; ++j) { const f32x4 gv = gr[64 * j]; v2u w; w.x = pk2(v[j].x * r * gv.x, v[j].y * r * gv.y); w.y = pk2(v[j].z * r * gv.z, v[j].w * r * gv.w); o8[64 * j] = w; }
}
__device__ __forceinline__ void cvt_flat(const float* src, bf16* dst, size_t n, size_t gthread, size_t nthreads) {
    for (size_t i = gthread * 8; i < n; i += nthreads * 8) {
        const f32x4 a = *(const f32x4*)(src + i), b = *(const f32x4*)(src + i + 4);
        v4u o; o.x = pk2(a.x, a.y); o.y = pk2(a.z, a.w); o.z = pk2(b.x, b.y); o.w = pk2(b.z, b.w);
        *(v4u*)(dst + i) = o;
    }
}
__device__ __forceinline__ void ph_compress_naive(const bf16* PROJ, const float* const* in, float* KCB, float* VCB, float* ldsf, int bid, int G) {
    const int tid = threadIdx.x, grp = tid >> 7, gt = tid & 127;
    float* blk = ldsf + grp * 2048; float* hid = ldsf + 4 * 2048 + grp * 128;
    const int per = BATCH * NCMP * 4, nitems = 2 * per;
    for (int base = bid * 4; base < nitems; base += G * 4) {
        const int item = base + grp; const bool ok = item < nitems;
        const int kv = ok ? item / per : 0, idx = ok ? item % per : 0;
        const int g = idx & 3, n = (idx >> 2) % NCMP, b = (idx >> 2) / NCMP;
        const float* pe = in[kv ? 6 : 3]; const float* w1 = in[kv ? 7 : 4]; const float* w2 = in[kv ? 8 : 5];
        const int coff = kv ? C_VC : C_KC;
        if (ok) for (int i = gt; i < CMP_LEN * HD; i += 128) { const int l = i >> 6, dd = i & 63; blk[i] = bf2f(PROJ[(size_t)(b * SEQ + n * CMP_STRIDE + l) * PLD + coff + g * HD + dd]) + pe[i]; }
        __syncthreads();
        if (ok) { float a = 0.f;
#pragma unroll 8
            for (int k = 0; k < CMP_LEN * HD; ++k) a += blk[k] * w1[(size_t)k * CMP_HID + gt];
            hid[gt] = gelu_tanh(a); }
        __syncthreads();
        if (ok && gt < HD) { float o = 0.f;
#pragma unroll 8
            for (int k = 0; k < CMP_HID; ++k) o += hid[k] * w2[k * HD + gt];
            (kv ? VCB : KCB)[(size_t)idx * HD + gt] = o; }
        __syncthreads();
    }
}

__device__ __forceinline__ void ph_nsa_naive(const bf16* PROJ, const float* KCB, const float* VCB, const float* rel, bf16* ONSA, float* ldsf, int bid, int G) {
    const int tid = threadIdx.x, hb = tid >> 8, ht = tid & 255;
    float* base = ldsf + hb * 5376;
    float (*q)[64] = (float (*)[64])(base);
    float (*sc)[1024] = (float (*)[1024])(base + 256);
    float* red = base + 256 + 4096;
    float* imp = red + 8;
    int* selblk = (int*)(imp + 64);
    int* nselp = selblk + 16;
    float (*oacc)[4][64] = (float (*)[4][64])(base + 256 + 4096 + 8 + 64 + 32);
    const int nitems = BATCH * 4 * SEQ;
    for (int ibase = bid * 2; ibase < nitems; ibase += G * 2) {
        const int item = ibase + hb;
        const int t = item % SEQ, g = (item / SEQ) & 3, b = item / (SEQ * 4);
        const size_t rowq = (size_t)(b * SEQ + t) * PLD;
        __syncthreads();
        q[ht >> 6][ht & 63] = bf2f(PROJ[rowq + C_QN + g * 256 + ht]);
        __syncthreads();
        const int hh = ht >> 6, dd = ht & 63;
        {
            const int n = ht;
            const bool valid = (n < NCMP) && (t - (n * CMP_STRIDE + CMP_LEN - 1) >= 0);
            float s0 = NEGF, s1 = NEGF, s2 = NEGF, s3 = NEGF;
            if (valid) {
                const float* kr = KCB + ((size_t)(b * NCMP + n) * 4 + g) * HD;
                float a0 = 0.f, a1 = 0.f, a2 = 0.f, a3 = 0.f;
#pragma unroll 4
                for (int c = 0; c < 64; ++c) { const float kv = kr[c]; a0 += q[0][c] * kv; a1 += q[1][c] * kv; a2 += q[2][c] * kv; a3 += q[3][c] * kv; }
                const int bk = rel_bucket(t - (n * CMP_STRIDE + CMP_LEN - 1));
                s0 = a0 * 0.125f + rel[bk * 16 + g * 4 + 0]; s1 = a1 * 0.125f + rel[bk * 16 + g * 4 + 1];
                s2 = a2 * 0.125f + rel[bk * 16 + g * 4 + 2]; s3 = a3 * 0.125f + rel[bk * 16 + g * 4 + 3];
            }
#define CMP_SOFTMAX(H, S) { const float mx = half_max(S, red); const float e = valid ? expf(S - mx) : 0.f; const float sum = half_sum(e, red); sc[H][n] = (valid && sum > 0.f) ? e / sum : 0.f; }
            CMP_SOFTMAX(0, s0) CMP_SOFTMAX(1, s1) CMP_SOFTMAX(2, s2) CMP_SOFTMAX(3, s3)
#undef CMP_SOFTMAX
            __syncthreads();
            float o = 0.f;
#pragma unroll 4
            for (int n2 = 0; n2 < NCMP; ++n2) o += sc[hh][n2] * VCB[((size_t)(b * NCMP + n2) * 4 + g) * HD + dd];
            oacc[0][hh][dd] = o;
            if (ht < 64) {
                const int j = ht; float im = 0.f;
                for (int h = 0; h < 4; ++h)
                    for (int n2 = 4 * j - 1; n2 <= 4 * j + 3; ++n2) {
                        if (n2 < 0 || n2 >= NCMP) continue;
                        im += (((n2 & 3) == 3) ? 0.5f : 1.f) * sc[h][n2];
                    }
                imp[j] = im;
            }
            __syncthreads();
            if (ht < 64) {
                const int cur = t / SEL_LEN, j = ht;
                const bool jv = j <= cur;
                const bool forced = (j == 0) || (cur - j >= 0 && cur - j < 2);
                const float myscore = jv ? imp[j] + (forced ? 1e4f : 0.f) : -INFINITY;
                int rank = 0;
                for (int k = 0; k < 64; ++k) {
                    const bool kvd = k <= cur; const bool kf = (k == 0) || (cur - k >= 0 && cur - k < 2);
                    const float ks = kvd ? imp[k] + (kf ? 1e4f : 0.f) : -INFINITY;
                    if (ks > myscore || (ks == myscore && k < j)) ++rank;
                }
                const bool sel = jv && rank < SEL_TOPK;
                const unsigned long long m = __ballot(sel);
                if (ht == 0) { int c = 0; unsigned long long mm = m; while (mm) { const int bpos = __ffsll((long long)mm) - 1; selblk[c++] = bpos; mm &= mm - 1; } *nselp = c; }
            }
            __syncthreads();
        }
#pragma unroll 1
        for (int br = 1; br <= 2; ++br) {
            const int lo = (t - (WINDOW - 1)) > 0 ? (t - (WINDOW - 1)) : 0;
            const int nk = (br == 1) ? (*nselp) * 64 : (t - lo + 1);
            const int kcol = (br == 1) ? C_KS : C_KW, vcol = (br == 1) ? C_VS : C_VW;
            float m0 = NEGF, m1 = NEGF, m2 = NEGF, m3 = NEGF;
            for (int ki = ht; ki < nk; ki += 256) {
                const int pos = (br == 1) ? (selblk[ki >> 6] * 64 + (ki & 63)) : (lo + ki);
                float s0 = NEGF, s1 = NEGF, s2 = NEGF, s3 = NEGF;
                if (pos <= t) {
                    const bf16* kr = PROJ + (size_t)(b * SEQ + pos) * PLD + kcol + g * HD;
                    float a0 = 0.f, a1 = 0.f, a2 = 0.f, a3 = 0.f;
#pragma unroll 4
                    for (int c = 0; c < 64; ++c) { const float kv = bf2f(kr[c]); a0 += q[0][c] * kv; a1 += q[1][c] * kv; a2 += q[2][c] * kv; a3 += q[3][c] * kv; }
                    const int bk = rel_bucket(t - pos);
                    s0 = a0 * 0.125f + rel[bk * 16 + g * 4 + 0]; s1 = a1 * 0.125f + rel[bk * 16 + g * 4 + 1];
                    s2 = a2 * 0.125f + rel[bk * 16 + g * 4 + 2]; s3 = a3 * 0.125f + rel[bk * 16 + g * 4 + 3];
                }
                sc[0][ki] = s0; sc[1][ki] = s1; sc[2][ki] = s2; sc[3][ki] = s3;
                m0 = fmaxf(m0, s0); m1 = fmaxf(m1, s1); m2 = fmaxf(m2, s2); m3 = fmaxf(m3, s3);
            }
            float inv0, inv1, inv2, inv3;
#define SEL_SOFTMAX(H, MX, INV) { const float mx = half_max(MX, red); float ls = 0.f; \
                for (int ki = ht; ki < nk; ki += 256) { const float sv = sc[H][ki]; const float e = (sv > -1e29f) ? expf(sv - mx) : 0.f; sc[H][ki] = e; ls += e; } \
                const float sum = half_sum(ls, red); INV = 1.f / sum; }
            SEL_SOFTMAX(0, m0, inv0) SEL_SOFTMAX(1, m1, inv1) SEL_SOFTMAX(2, m2, inv2) SEL_SOFTMAX(3, m3, inv3)
#undef SEL_SOFTMAX
            __syncthreads();
            float o = 0.f;
            for (int ki = 0; ki < nk; ++ki) {
                const int pos = (br == 1) ? (selblk[ki >> 6] * 64 + (ki & 63)) : (lo + ki);
                if (pos <= t) o += sc[hh][ki] * bf2f(PROJ[(size_t)(b * SEQ + pos) * PLD + vcol + g * HD + dd]);
            }
            const float invh = hh == 0 ? inv0 : hh == 1 ? inv1 : hh == 2 ? inv2 : inv3;
            oacc[br][hh][dd] = o * invh;
            __syncthreads();
        }
        {
            const int head = g * 4 + hh;
            const float g0 = sigmoidf_(bf2f(PROJ[rowq + C_GBR + 0 * 16 + head])), g1 = sigmoidf_(bf2f(PROJ[rowq + C_GBR + 1 * 16 + head])), g2 = sigmoidf_(bf2f(PROJ[rowq + C_GBR + 2 * 16 + head]));
            ONSA[(size_t)(b * SEQ + t) * NSA_Q + head * HD + dd] = (bf16)f2bf(g0 * oacc[0][hh][dd] + g1 * oacc[1][hh][dd] + g2 * oacc[2][hh][dd]);
        }
    }
    __syncthreads();
}

__device__ __forceinline__ void ph_stick_naive(const bf16* PROJ, bf16* OSB, int bid, int G) {
    const int lane = threadIdx.x & 63, gw = bid * NWAVES + (threadIdx.x >> 6), NGW = G * NWAVES;
    for (int row = gw; row < BATCH * 16 * SEQ; row += NGW) {
        const int t = row % SEQ, h = (row / SEQ) & 15, b = row / (SEQ * 16);
        const float qv = bf2f(PROJ[(size_t)(b * SEQ + t) * PLD + C_QB + h * HD + lane]);
        float acc = 0.f, suffix = 0.f;
        for (int s = t - 1; s >= 0; --s) {
            const bf16* kr = PROJ + (size_t)(b * SEQ + s) * PLD;
            const float z = wave_sum(qv * bf2f(kr[C_KB + h * HD + lane])) * 0.125f;
            const float lb = fminf(z, 0.f) - log1pf(expf(-fabsf(z)));
            acc += expf(lb + suffix) * bf2f(kr[C_VB + h * HD + lane]);
            suffix += lb - z;
            if (suffix < -80.f) break;
        }
        OSB[(size_t)(b * SEQ + t) * SB_W + h * HD + lane] = (bf16)f2bf(acc);
    }
}

__device__ __forceinline__ void ph_route_naive(const bf16* QP, const float* subk, int* EXPERT, float* GATE, float* ldsf, int bid, int G) {
    const int tid = threadIdx.x, hb = tid >> 8, ht = tid & 255;
    float* base = ldsf + hb * 4608;
    float* qs = base; float (*s)[128] = (float (*)[128])(base + 2048); float (*tv)[16] = (float (*)[16])(base + 4096); int (*ti)[16] = (int (*)[16])(base + 4352);
    for (int nb = bid * 2; nb < NTOK; nb += G * 2) {
        const int n = nb + hb;
        __syncthreads();
        for (int i = ht; i < 2048; i += 256) qs[i] = bf2f(QP[(size_t)n * 2048 + i]);
        __syncthreads();
#pragma unroll 1
        for (int r = 0; r < 8; ++r) {
            const int idx = ht + 256 * r, list = idx >> 7, k = idx & 127;
            const float* kr = subk + ((size_t)list * 128 + k) * 128;
            float a = 0.f;
#pragma unroll 8
            for (int c = 0; c < 128; ++c) a += qs[list * 128 + c] * kr[c];
            s[list][k] = a;
        }
        __syncthreads();
        if (ht < 16) {
            const int l = ht;
#pragma unroll 1
            for (int r = 0; r < 16; ++r) {
                float best = -INFINITY; int bi = 0;
                for (int k = 0; k < 128; ++k) { const float v = s[l][k]; if (v > best) { best = v; bi = k; } }
                tv[l][r] = best; ti[l][r] = bi; s[l][bi] = -INFINITY;
            }
        }
        __syncthreads();
        if (ht < 8) {
            const int h = ht;
            unsigned long long used0 = 0, used1 = 0, used2 = 0, used3 = 0;
            float bsv = 0.f, mx = 0.f, sum = 0.f;
#pragma unroll 1
            for (int r = 0; r < 16; ++r) {
                float best = -INFINITY; int bidx = 0;
                for (int j = 0; j < 256; ++j) {
                    const unsigned long long u = (j < 64) ? used0 : (j < 128) ? used1 : (j < 192) ? used2 : used3;
                    if ((u >> (j & 63)) & 1ull) continue;
                    const float v = tv[2 * h][j >> 4] + tv[2 * h + 1][j & 15];
                    if (v > best) { best = v; bidx = j; }
                }
                if (bidx < 64) used0 |= 1ull << bidx; else if (bidx < 128) used1 |= 1ull << (bidx & 63); else if (bidx < 192) used2 |= 1ull << (bidx & 63); else used3 |= 1ull << (bidx & 63);
                if (r == 0) mx = best;
                const float e = expf(best - mx); sum += e; bsv = e;
                EXPERT[(size_t)n * PEER_E + h * 16 + r] = ti[2 * h][bidx >> 4] * PEER_KEYS + ti[2 * h + 1][bidx & 15];
                GATE[(size_t)n * PEER_E + h * 16 + r] = bsv;
            }
            const float inv = 1.f / sum;
            for (int r = 0; r < 16; ++r) GATE[(size_t)n * PEER_E + h * 16 + r] *= inv;
        }
    }
    __syncthreads();
}

__device__ __forceinline__ void ph_ffn_naive(const float* H, const float* ss, const float* gffn, const int* EXPERT, const float* GATE, const bf16* UB, const bf16* VB,
                                             const float* gfin, float* out, float* ldsf, int bid, int G) {
    const int tid = threadIdx.x, hb = tid >> 8, ht = tid & 255, w = ht >> 6, lane = tid & 63;
    float* part = ldsf + hb * (4 * 2048 + 8); float* red = part + 4 * 2048;
    for (int nb = bid * 2; nb < NTOK; nb += G * 2) {
        const int n = nb + hb;
        const float rstd = rsqrtf(ss[n] * (1.f / D_MODEL) + EPS);
        float xv[32], acc[32];
#pragma unroll
        for (int j = 0; j < 4; ++j) {
            const float* hp = H + (size_t)n * 2048 + j * 512 + lane * 8; const float* gp = gffn + j * 512 + lane * 8;
            const f32x4 a = *(const f32x4*)hp, b2 = *(const f32x4*)(hp + 4), ga = *(const f32x4*)gp, gb = *(const f32x4*)(gp + 4);
            xv[8 * j + 0] = a.x * rstd * ga.x; xv[8 * j + 1] = a.y * rstd * ga.y; xv[8 * j + 2] = a.z * rstd * ga.z; xv[8 * j + 3] = a.w * rstd * ga.w;
            xv[8 * j + 4] = b2.x * rstd * gb.x; xv[8 * j + 5] = b2.y * rstd * gb.y; xv[8 * j + 6] = b2.z * rstd * gb.z; xv[8 * j + 7] = b2.w * rstd * gb.w;
        }
#pragma unroll
        for (int j = 0; j < 32; ++j) acc[j] = 0.f;
#pragma unroll 1
        for (int e = 0; e < 32; ++e) {
            const int ei = EXPERT[(size_t)n * PEER_E + w * 32 + e];
            const float gt = GATE[(size_t)n * PEER_E + w * 32 + e];
            const bf16* ur = UB + (size_t)ei * 2048 + lane * 8; const bf16* vr = VB + (size_t)ei * 2048 + lane * 8;
            float d = 0.f;
#pragma unroll
            for (int j = 0; j < 4; ++j) { const v4u u4 = *(const v4u*)(ur + j * 512);
                d += xv[8 * j + 0] * bflo(u4.x) + xv[8 * j + 1] * bfhi(u4.x) + xv[8 * j + 2] * bflo(u4.y) + xv[8 * j + 3] * bfhi(u4.y)
                   + xv[8 * j + 4] * bflo(u4.z) + xv[8 * j + 5] * bfhi(u4.z) + xv[8 * j + 6] * bflo(u4.w) + xv[8 * j + 7] * bfhi(u4.w); }
            d = wave_sum(d);
            const float wgt = gt * gelu_tanh(d);
#pragma unroll
            for (int j = 0; j < 4; ++j) { const v4u v4 = *(const v4u*)(vr + j * 512);
                acc[8 * j + 0] += wgt * bflo(v4.x); acc[8 * j + 1] += wgt * bfhi(v4.x); acc[8 * j + 2] += wgt * bflo(v4.y); acc[8 * j + 3] += wgt * bfhi(v4.y);
                acc[8 * j + 4] += wgt * bflo(v4.z); acc[8 * j + 5] += wgt * bfhi(v4.z); acc[8 * j + 6] += wgt * bflo(v4.w); acc[8 * j + 7] += wgt * bfhi(v4.w); }
        }
        __syncthreads();
#pragma unroll
        for (int j = 0; j < 4; ++j)
#pragma unroll
            for (int e = 0; e < 8; ++e) part[w * 2048 + j * 512 + lane * 8 + e] = acc[8 * j + e];
        __syncthreads();
        float y[8]; float sq = 0.f;
#pragma unroll
        for (int j = 0; j < 8; ++j) { const int c = ht + 256 * j; y[j] = H[(size_t)n * 2048 + c] + part[c] + part[2048 + c] + part[4096 + c] + part[6144 + c]; sq += y[j] * y[j]; }
        const float tot = half_sum(sq, red);
        const float r = rsqrtf(tot * (1.f / D_MODEL) + EPS);
#pragma unroll
        for (int j = 0; j < 8; ++j) { const int c = ht + 256 * j; out[(size_t)n * 2048 + c] = y[j] * r * gfin[c]; }
    }
    __syncthreads();
}
constexpr int RING_BYTES = 131072, LDSCTL_OFF = RING_BYTES, MISC_OFF = LDSCTL_OFF + 320, LDS_BYTES = 147456;
constexpr int N_PHASES = 8;
#ifndef MK_N_LAUNCHES
#define MK_N_LAUNCHES 1
#endif

__global__ void __launch_bounds__(NTHR, 2) fwd_megakernel(Args args) {
    extern __shared__ __attribute__((aligned(16))) unsigned char lds[];
    LAS unsigned char* lds3 = (LAS unsigned char*)lds;
    const int tid = threadIdx.x, lane = tid & 63, wave = __builtin_amdgcn_readfirstlane(tid >> 6);
    const int G = gridDim.x, bid = blockIdx.x;
    unsigned char* ws = args.ws;
    unsigned* ctl = (unsigned*)(ws + WS_CTL);
    const float* x = args.in[0];
    bf16* WinT = (bf16*)(ws + WS_WIN); bf16* WbnT = (bf16*)(ws + WS_WBN); bf16* WbsT = (bf16*)(ws + WS_WBS); bf16* WoutT = (bf16*)(ws + WS_WOUT); bf16* WpqT = (bf16*)(ws + WS_WPQ);
    bf16* XN = (bf16*)(ws + WS_XN); bf16* MERGED = XN; bf16* PROJ = (bf16*)(ws + WS_PROJ);
    bf16* ONSA = (bf16*)(ws + WS_ONSA); bf16* OSB = (bf16*)(ws + WS_OSB);
    float* H = (float*)(ws + WS_H); bf16* HB = (bf16*)(ws + WS_HB);
    bf16* UB = (bf16*)(ws + WS_UB); bf16* VB = (bf16*)(ws + WS_VB); bf16* QP = (bf16*)(ws + WS_QP);
    int* EXPERT = (int*)(ws + WS_EXP); float* GATE = (float*)(ws + WS_GATE);
    float* KCB = (float*)(ws + WS_MISC + MISC_KCB); float* VCB = (float*)(ws + WS_MISC + MISC_VCB);
    float* SS = (float*)(ctl + CW_SS);

    for (int u = tid; u < (LDS_BYTES - LDSCTL_OFF) / 4; u += NTHR) ((LAS unsigned*)(lds3 + LDSCTL_OFF))[u] = 0u;
    __syncthreads();
    const int lo = args.ph_lo, hi = args.ph_hi;
    XcdBarrier bar; bar.bar = ctl + CW_BAR; bar.x = 0; bar.st = nullptr;
    if (hi - lo > 1) bar = xcd_barrier_post(ctl + CW_BAR, (volatile LAS unsigned*)(lds3 + MISC_OFF) + 8);
#define IN(k) (lo <= (k) && (k) < hi)
#define SEAM(k) do { if (IN(k) && IN((k) + 1)) xcd_barrier(bar); } while (0)
    const int gw = bid * NWAVES + wave, NGW = G * NWAVES;

    if (IN(0)) {
        LAS float* scr = (LAS float*)(lds3 + wave * 16384);
        constexpr int I_IN = (D_MODEL / 64) * ((IN_COLS + 31) / 32), I_BR = (1024 / 64) * (D_MODEL / 32), I_SQ = (D_MODEL / 64) * (D_MODEL / 32);
        constexpr int NITEMS = I_IN + 2 * I_BR + 2 * I_SQ;
        for (int it = gw; it < NITEMS; it += NGW) {
            int r = it;
            if (r < I_IN) { p0_transpose_item(args.in[2], D_MODEL, IN_COLS, WinT, nullptr, scr, r, lane); continue; } r -= I_IN;
            if (r < I_BR) { p0_transpose_item(args.in[10], 1024, D_MODEL, WbnT, nullptr, scr, r, lane); continue; } r -= I_BR;
            if (r < I_BR) { p0_transpose_item(args.in[11], 1024, D_MODEL, WbsT, nullptr, scr, r, lane); continue; } r -= I_BR;
            if (r < I_SQ) { p0_transpose_item(args.in[12], D_MODEL, D_MODEL, WoutT, nullptr, scr, r, lane); continue; } r -= I_SQ;
            p0_transpose_item(args.in[14], D_MODEL, D_MODEL, WpqT, args.in[13], scr, r, lane);
        }
        {
            v4u z = {0u, 0u, 0u, 0u}; bf16* p = WinT + (size_t)IN_COLS * D_MODEL; const size_t nz = (size_t)(PLD - IN_COLS) * D_MODEL;
            for (size_t i = ((size_t)bid * NTHR + tid) * 8; i < nz; i += (size_t)G * NTHR * 8) *(v4u*)(p + i) = z;
        }
        for (int m = gw; m < NTOK; m += NGW) rms_row_to_bf16(x + (size_t)m * D_MODEL, args.in[1], XN + (size_t)m * D_MODEL, lane);
    }
    SEAM(0);
    if (IN(1)) {
        pg8::Gemm g{XN, WinT, NTOK, PLD, D_MODEL}; pg8::StaticOrder S; S.init(NTOK, PLD, G, bid);
        pg8::EpiBf16<0> E{PROJ, PLD, nullptr, 0, 0, 1.f};
        pg8::gemm_phase<pg8::EpiBf16<0>, pg8::StaticOrder, true, true>(lds3, g, S, E);
    }
    SEAM(1);
    if (IN(2)) ph_compress_naive(PROJ, args.in, KCB, VCB, (float*)lds, bid, G);
    SEAM(2);
    if (IN(3)) {
        ph_nsa_naive(PROJ, KCB, VCB, args.in[9], ONSA, (float*)lds, bid, G);
        ph_stick_naive(PROJ, OSB, bid, G);
    }
    SEAM(3);
    if (IN(4)) {
        { pg8::Gemm g{ONSA, WbnT, NTOK, D_MODEL, 1024}; pg8::StaticOrder S; S.init(NTOK, D_MODEL, G, bid);
          pg8::EpiGate<0> E{MERGED, D_MODEL, PROJ + C_GA, PLD};
          pg8::gemm_phase<pg8::EpiGate<0>, pg8::StaticOrder, false, true>(lds3, g, S, E); }
        { pg8::Gemm g{OSB, WbsT, NTOK, D_MODEL, 1024}; pg8::StaticOrder S; S.init(NTOK, D_MODEL, G, bid);
          pg8::EpiGate<1> E{MERGED, D_MODEL, PROJ + C_GB, PLD};
          pg8::gemm_phase<pg8::EpiGate<1>, pg8::StaticOrder, false, true>(lds3, g, S, E); }
    }
    SEAM(4);
    if (IN(5)) {
        { pg8::Gemm g{MERGED, WoutT, NTOK, D_MODEL, D_MODEL}; pg8::StaticOrder S; S.init(NTOK, D_MODEL, G, bid);
          pg8::EpiResid E{x, H, HB, SS, D_MODEL};
          pg8::gemm_phase<pg8::EpiResid, pg8::StaticOrder, false, true>(lds3, g, S, E); }
        const size_t ne = (size_t)16384 * 2048;
        cvt_flat(args.in[16], UB, ne, (size_t)bid * NTHR + tid, (size_t)G * NTHR);
        cvt_flat(args.in[17], VB, ne, (size_t)bid * NTHR + tid, (size_t)G * NTHR);
    }
    SEAM(5);
    if (IN(6)) {
        pg8::Gemm g{HB, WpqT, NTOK, D_MODEL, D_MODEL}; pg8::StaticOrder S; S.init(NTOK, D_MODEL, G, bid);
        pg8::EpiRowScale E{QP, D_MODEL, SS, 1.f / D_MODEL, EPS};
        pg8::gemm_phase<pg8::EpiRowScale, pg8::StaticOrder, false, true>(lds3, g, S, E);
    }
    SEAM(6);
    if (IN(7)) {
        ph_route_naive(QP, args.in[15], EXPERT, GATE, (float*)lds, bid, G);
        asm volatile("s_waitcnt vmcnt(0)" ::: "memory"); __syncthreads();
        ph_ffn_naive(H, SS, args.in[13], EXPERT, GATE, UB, VB, args.in[18], args.out, (float*)lds, bid, G);
    }
#undef IN
#undef SEAM
}

extern "C" void kernel_launch(void* const* d_in, const int* in_sizes, int n_in, void* d_out, int out_size, void* d_ws, size_t ws_size, hipStream_t stream) {
    static int grid = 0;
    if (grid == 0) {
        if (n_in != 19 || ws_size < WS_END) { fprintf(stderr, "kernel_launch: unexpected inputs (%d) or workspace (%zu < %zu)\n", n_in, ws_size, (size_t)WS_END); grid = -1; return; }
        int dev = 0, cus = 0, per_cu = 0;
        hipGetDevice(&dev); hipDeviceGetAttribute(&cus, hipDeviceAttributeMultiprocessorCount, dev);
        if (hipFuncSetAttribute((const void*)fwd_megakernel, hipFuncAttributeMaxDynamicSharedMemorySize, LDS_BYTES) != hipSuccess) { fprintf(stderr, "hipFuncSetAttribute failed\n"); grid = -1; return; }
        if (hipOccupancyMaxActiveBlocksPerMultiprocessor(&per_cu, (const void*)fwd_megakernel, NTHR, LDS_BYTES) != hipSuccess || per_cu < 1) { fprintf(stderr, "occupancy query: %d\n", per_cu); per_cu = 1; }
        (void)hipGetLastError();
        grid = cus;
        if (grid > cus * per_cu) grid = cus * per_cu;
    }
    if (grid < 0) return;
    hipMemsetAsync((char*)d_ws + WS_CTL, 0, CTL_ZERO_BYTES, stream);
    Args a{};
    for (int i = 0; i < 19; ++i) a.in[i] = (const float*)d_in[i];
    a.out = (float*)d_out; a.ws = (unsigned char*)d_ws;
    if (MK_N_LAUNCHES == 1) {
        a.ph_lo = 0; a.ph_hi = N_PHASES;
        void* kargs[] = {&a};
        hipError_t e = hipLaunchCooperativeKernel((const void*)fwd_megakernel, dim3(grid), dim3(NTHR), kargs, LDS_BYTES, stream);
        if (e != hipSuccess) fprintf(stderr, "cooperative launch failed: %s (grid %d)\n", hipGetErrorString(e), grid);
    } else {
        for (int p = 0; p < N_PHASES; ++p) { a.ph_lo = p; a.ph_hi = p + 1; hipLaunchKernelGGL(fwd_megakernel, dim3(grid), dim3(NTHR), LDS_BYTES, stream, a); }
    }
}
```

```cpp
#include <hip/hip_runtime.h>
#include <cstdio>
#include <cstdint>
#include <cmath>
namespace pg8 {
#define PG8_LAS __attribute__((address_space(3)))
typedef unsigned short bf16_t;
typedef short bf16x8 __attribute__((ext_vector_type(8)));
typedef float f32x4 __attribute__((ext_vector_type(4)));
typedef unsigned u32x4 __attribute__((ext_vector_type(4)));
constexpr int BM = 256, BK = 64, HALF = 128, HTB = HALF * BK * 2  , STAGE_BYTES = 8 * HTB, NXCD = 8, WGM = 8;

__host__ __device__ __forceinline__ int lds_byte(int r, int c) { const int st = (r >> 4) * 2 + (c >> 5), rr = r & 15, cc = c & 31, ob = rr * 64 + cc * 2; return st * 1024 + (ob ^ (((ob >> 9) & 1) << 5)); }
__host__ __device__ __forceinline__ void stage_rc(int b, int& R, int& C) { const int st = b / 1024, sb = b % 1024, swz = sb ^ (((sb >> 9) & 1) << 5); R = (st >> 1) * 16 + swz / 64; C = (st & 1) * 32 + (swz % 64) / 2; }
__host__ __device__ __forceinline__ int perm32(int rho) { const int n = rho >> 4, i = rho & 15; return 8 * (i >> 2) + 4 * n + (i & 3); }

struct Unit { int pm, pn; };
struct Gemm { const bf16_t* A; const bf16_t* Bt; int M, N, K; };

struct StaticOrder {
    int nM, nN, nwg, G, c;
    __host__ __device__ void init(int M, int N, int G_, int c_) { nM = M / BM; nN = N / BM; nwg = nM * nN; G = G_; c = c_; }
    __host__ __device__ bool next(int i, Unit& u) const {
        const long L = (long)i * G + c; if (L >= nwg) return false;
        int wgid = (int)L; { const int q = nwg / NXCD, r = nwg % NXCD, xcd = wgid % NXCD, off = wgid / NXCD; wgid = (xcd < r ? xcd * (q + 1) : r * (q + 1) + (xcd - r) * q) + off; }
        const int nig = WGM * nN, gid = wgid / nig, fm = gid * WGM, gsz = (nM - fm) < WGM ? (nM - fm) : WGM;
        u.pm = fm + ((wgid % nig) % gsz); u.pn = (wgid % nig) / gsz; return true;
    }
    __device__ __forceinline__ void a_ready(const Unit&) const {}
    __device__ __forceinline__ void done(const Unit&) const {}
};

__device__ __forceinline__ unsigned cvt_pk_bf16(float lo, float hi) { unsigned r; asm volatile("v_cvt_pk_bf16_f32 %0, %1, %2" : "=v"(r) : "v"(lo), "v"(hi)); return r; }
typedef float f32x2 __attribute__((ext_vector_type(2)));
__device__ __forceinline__ f32x2 gelu_pk(f32x2 v) {
    const f32x2 av = __builtin_elementwise_abs(v), d = av * 0.2316418882f + 1.0f;
    f32x2 t; t.x = __builtin_amdgcn_rcpf(d.x); t.y = __builtin_amdgcn_rcpf(d.y);
    f32x2 q = t * 0.5307027145f + (-0.7265760135f); q = q * t + 0.7107068705f; q = q * t + (-0.142248368f); q = q * t + 0.127414796f; q = q * t;
    const f32x2 s = (v * v) * (-0.72134752044f);
    f32x2 e; e.x = __builtin_amdgcn_exp2f(s.x); e.y = __builtin_amdgcn_exp2f(s.y);
    const f32x2 m = v * (q * e), r = v - m;
    f32x2 o; o.x = v.x < 0.f ? m.x : r.x; o.y = v.y < 0.f ? m.y : r.y; return o;
}

template <int ACT  > struct EpiBf16 {
    static constexpr bool PERM = true, AFTER_DRAIN = false; static_assert(ACT == 0 || ACT == 1, "EpiBf16: ACT is 0 (none) or 1 (gelu_pk)");
    bf16_t* O; int ldc; const float* bias; int split_cols; size_t split_stride; float scale0;
    __device__ __forceinline__ void operator()(const f32x4 (&acc)[2][2][4][2], const Unit& u, int wr, int wc, int fr, int fq) const {
        const int row0 = u.pm * BM + wr * 64 + fr; int colt = u.pn * BM; bf16_t* base = O;
        float sc = 1.f; if (split_cols) { const int t = colt / split_cols; base += (size_t)t * split_stride; colt -= t * split_cols; if (t == 0) sc = scale0; }
        const int col0 = colt + wc * 32 + 8 * fq, bcol0 = u.pn * BM + wc * 32 + 8 * fq;
        f32x4 bv[2][2];
#pragma unroll
        for (int bj = 0; bj < 2; ++bj)
#pragma unroll
            for (int n = 0; n < 2; ++n) bv[bj][n] = bias ? *(const f32x4*)(bias + bcol0 + bj * HALF + 4 * n) : (f32x4){0.f, 0.f, 0.f, 0.f};
#pragma unroll
        for (int ai = 0; ai < 2; ++ai)
#pragma unroll
            for (int m = 0; m < 4; ++m) { bf16_t* rowp = base + (size_t)(row0 + ai * HALF + m * 16) * ldc + col0;
#pragma unroll
                for (int bj = 0; bj < 2; ++bj) { f32x4 v0 = acc[ai][bj][m][0] + bv[bj][0], v1 = acc[ai][bj][m][1] + bv[bj][1];
                    if (ACT == 1) { f32x2 a = gelu_pk((f32x2){v0[0], v0[1]}), b = gelu_pk((f32x2){v0[2], v0[3]}), c = gelu_pk((f32x2){v1[0], v1[1]}), d = gelu_pk((f32x2){v1[2], v1[3]});
                        v0 = (f32x4){a.x, a.y, b.x, b.y}; v1 = (f32x4){c.x, c.y, d.x, d.y}; }
                    v0 = v0 * sc; v1 = v1 * sc; u32x4 w; w.x = cvt_pk_bf16(v0[0], v0[1]); w.y = cvt_pk_bf16(v0[2], v0[3]); w.z = cvt_pk_bf16(v1[0], v1[1]); w.w = cvt_pk_bf16(v1[2], v1[3]);
                    *(u32x4*)(rowp + bj * HALF) = w; } }
    }
};

struct PanelStats {
    unsigned* xbuf;
    unsigned* cnt;
    unsigned* tmo;
    int ntn; float eps;
    unsigned code;
    __device__ __forceinline__ bool run(const f32x4 (&v)[2][2][4][2], const Unit& u, int wr, int wc, int fr, int fq, PG8_LAS unsigned char* lds, int wid, int lane) const {
        typedef float f32x2v __attribute__((ext_vector_type(2)));
        PG8_LAS f32x2v* P = (PG8_LAS f32x2v*)lds;
        PG8_LAS f32x2v* S = (PG8_LAS f32x2v*)(lds + 8192);
        PG8_LAS unsigned* flag = (PG8_LAS unsigned*)(lds + 8192 + 2048);
#pragma unroll
        for (int ai = 0; ai < 2; ++ai)
#pragma unroll
            for (int m = 0; m < 4; ++m) {
                float s = 0.f;
#pragma unroll
                for (int bj = 0; bj < 2; ++bj)
#pragma unroll
                    for (int n = 0; n < 2; ++n) { const f32x4 x = v[ai][bj][m][n]; s += (x[0] + x[1]) + (x[2] + x[3]); }
                s += __shfl_xor(s, 16); s += __shfl_xor(s, 32);
                const float mw = s * (1.0f / 64.0f); float q = 0.f;
#pragma unroll
                for (int bj = 0; bj < 2; ++bj)
#pragma unroll
                    for (int n = 0; n < 2; ++n) { const f32x4 d = v[ai][bj][m][n] - mw; q += (d[0] * d[0] + d[1] * d[1]) + (d[2] * d[2] + d[3] * d[3]); }
                q += __shfl_xor(q, 16); q += __shfl_xor(q, 32);
                if (fq == 0) P[(ai * HALF + wr * 64 + m * 16 + fr) * 4 + wc] = (f32x2v){mw, q};
            }
        asm volatile("s_waitcnt lgkmcnt(0)" ::: "memory"); __builtin_amdgcn_s_barrier(); asm volatile("" ::: "memory");
#if defined(BROKEN_EXCHANGE_NO_WAIT)
#warning BROKEN CONTROL BUILD: the row-statistics exchange does not wait; results are wrong by design
        if (blockIdx.x >= 64) { const long long t0_ = clock64(); while (clock64() - t0_ < 60000) __builtin_amdgcn_s_sleep(8); }
#endif
        const int row = wid * 32 + (lane & 31);
        if (lane < 32) {
            const f32x2v a = P[row * 4 + 0], b = P[row * 4 + 1], c = P[row * 4 + 2], d = P[row * 4 + 3];
            const float mt = (a.x + b.x + c.x + d.x) * 0.25f;
            const float da = a.x - mt, db = b.x - mt, dc = c.x - mt, dd = d.x - mt;
            const float m2 = (a.y + b.y) + (c.y + d.y) + 64.0f * ((da * da + db * db) + (dc * dc + dd * dd));
            unsigned long long* slot = (unsigned long long*)xbuf + ((size_t)(u.pm * BM + row) * 4 + u.pn);
            __hip_atomic_store(slot, ((unsigned long long)__float_as_uint(m2) << 32) | __float_as_uint(mt), __ATOMIC_RELAXED, __HIP_MEMORY_SCOPE_AGENT);
        }
        asm volatile("s_waitcnt vmcnt(0)" ::: "memory");
        if (lane == 0) __hip_atomic_fetch_add(cnt + 64 * u.pm, 1u, __ATOMIC_RELAXED, __HIP_MEMORY_SCOPE_AGENT);
        if (wid == 0) {
            bool dead = false; const unsigned long long t0 = __builtin_amdgcn_s_memrealtime(); const unsigned want = 8u * (unsigned)ntn;
            for (;;) {
#if defined(BROKEN_EXCHANGE_NO_WAIT)
                break;
#endif
                if ((unsigned)__builtin_amdgcn_readfirstlane(__hip_atomic_load(cnt + 64 * u.pm, __ATOMIC_RELAXED, __HIP_MEMORY_SCOPE_AGENT)) >= want) break;
                if (__builtin_amdgcn_s_memrealtime() - t0 > 2000000ull) {
                    if (lane == 0) { unsigned expect = 0u; __hip_atomic_compare_exchange_strong(tmo + 1, &expect, code | (unsigned)(u.pm & 0xff), __ATOMIC_RELAXED, __ATOMIC_RELAXED, __HIP_MEMORY_SCOPE_AGENT);
                                     __hip_atomic_store(tmo, 1u, __ATOMIC_RELAXED, __HIP_MEMORY_SCOPE_AGENT); }
                    dead = true; break; }
                __builtin_amdgcn_s_sleep(2);
            }
            __builtin_amdgcn_fence(__ATOMIC_ACQUIRE, "agent");
            if (lane == 0) flag[0] = dead ? 1u : 0u;
        }
        asm volatile("s_waitcnt vmcnt(0) lgkmcnt(0)" ::: "memory"); __builtin_amdgcn_s_barrier(); asm volatile("" ::: "memory");
        const bool bad = flag[0] != 0u;
        if (lane < 32) {
            const unsigned long long* slot = (const unsigned long long*)xbuf + (size_t)(u.pm * BM + row) * 4; float mt[4], m2[4]; float ms = 0.f;
#pragma unroll
            for (int t = 0; t < 4; ++t) { if (t < ntn) { const unsigned long long w = __hip_atomic_load(slot + t, __ATOMIC_RELAXED, __HIP_MEMORY_SCOPE_AGENT); mt[t] = __uint_as_float((unsigned)w); m2[t] = __uint_as_float((unsigned)(w >> 32)); } else { mt[t] = 0.f; m2[t] = 0.f; } ms += mt[t]; }
            const float mean = ms / (float)ntn; float q = 0.f;
#pragma unroll
            for (int t = 0; t < 4; ++t) if (t < ntn) { const float dm = mt[t] - mean; q += m2[t] + 256.0f * dm * dm; }
            S[row] = (f32x2v){mean, 1.0f / sqrtf(q / (256.0f * (float)ntn) + eps)};
        }
        asm volatile("s_waitcnt lgkmcnt(0)" ::: "memory"); __builtin_amdgcn_s_barrier(); asm volatile("" ::: "memory");
        return bad;
    }
};
struct EpiLnRes {
    static constexpr bool PERM = false, AFTER_DRAIN = true;
    const float* base; float* out; int ldc; const float* bias; PanelStats st; unsigned poison;
    __device__ __forceinline__ void fused(f32x4 (&acc)[2][2][4][2], const Unit& u, int wr, int wc, int fr, int fq, PG8_LAS unsigned char* lds, int wid, int lane) const {
        typedef float f32x2v __attribute__((ext_vector_type(2)));
        const PG8_LAS f32x2v* S = (const PG8_LAS f32x2v*)(lds + 8192);
        const int col0 = u.pn * BM + wc * 32 + 4 * fq;
#pragma unroll
        for (int bj = 0; bj < 2; ++bj)
#pragma unroll
            for (int n = 0; n < 2; ++n) { const f32x4 bv = bias ? *(const f32x4*)(bias + col0 + bj * HALF + n * 16) : (f32x4){0.f, 0.f, 0.f, 0.f};
#pragma unroll
                for (int ai = 0; ai < 2; ++ai)
#pragma unroll
                    for (int m = 0; m < 4; ++m) acc[ai][bj][m][n] += bv; }
        f32x4 pre[4][2][2];
#pragma unroll
        for (int m = 0; m < 4; ++m) { const size_t off = (size_t)(u.pm * BM + wr * 64 + m * 16 + fr) * ldc + col0;
#pragma unroll
            for (int bj = 0; bj < 2; ++bj)
#pragma unroll
                for (int n = 0; n < 2; ++n) pre[m][bj][n] = *(const f32x4*)(base + off + bj * HALF + n * 16); }
        const bool bad = st.run(acc, u, wr, wc, fr, fq, lds, wid, lane) || poison != 0u;
        const float qnan = __builtin_nanf("");
#pragma unroll
        for (int ai = 0; ai < 2; ++ai)
#pragma unroll
            for (int m = 0; m < 4; ++m) { const int r = ai * HALF + wr * 64 + m * 16 + fr; const f32x2v sr = S[r]; const size_t off = (size_t)(u.pm * BM + r) * ldc + col0;
#pragma unroll
                for (int bj = 0; bj < 2; ++bj)
#pragma unroll
                    for (int n = 0; n < 2; ++n) { const f32x4 bs = ai == 0 ? pre[m][bj][n] : *(const f32x4*)(base + off + bj * HALF + n * 16); f32x4 o = bs + (acc[ai][bj][m][n] - sr.x) * sr.y;
                        if (bad) o = (f32x4){qnan, qnan, qnan, qnan}; *(f32x4*)(out + off + bj * HALF + n * 16) = o; }
                if (m & 1) asm volatile("" ::: "memory"); }
    }
};
struct EpiLnResLn {
    static constexpr bool PERM = false, AFTER_DRAIN = true;
    const float* base; float* out; bf16_t* xn; int ldc; const float* bias; PanelStats st1, st2; unsigned poison;
    __device__ __forceinline__ void fused(f32x4 (&acc)[2][2][4][2], const Unit& u, int wr, int wc, int fr, int fq, PG8_LAS unsigned char* lds, int wid, int lane) const {
        typedef float f32x2v __attribute__((ext_vector_type(2))); typedef unsigned u32x2v __attribute__((ext_vector_type(2)));
        const PG8_LAS f32x2v* S = (const PG8_LAS f32x2v*)(lds + 8192);
        const int col0 = u.pn * BM + wc * 32 + 4 * fq;
#pragma unroll
        for (int bj = 0; bj < 2; ++bj)
#pragma unroll
            for (int n = 0; n < 2; ++n) { const f32x4 bv = bias ? *(const f32x4*)(bias + col0 + bj * HALF + n * 16) : (f32x4){0.f, 0.f, 0.f, 0.f};
#pragma unroll
                for (int ai = 0; ai < 2; ++ai)
#pragma unroll
                    for (int m = 0; m < 4; ++m) acc[ai][bj][m][n] += bv; }
        bool bad = st1.run(acc, u, wr, wc, fr, fq, lds, wid, lane) || poison != 0u;
        const float qnan = __builtin_nanf("");
#pragma unroll
        for (int ai = 0; ai < 2; ++ai)
#pragma unroll
            for (int m = 0; m < 4; ++m) { const int r = ai * HALF + wr * 64 + m * 16 + fr; const f32x2v sr = S[r]; const size_t off = (size_t)(u.pm * BM + r) * ldc + col0;
#pragma unroll
                for (int bj = 0; bj < 2; ++bj)
#pragma unroll
                    for (int n = 0; n < 2; ++n) { const f32x4 bs = *(const f32x4*)(base + off + bj * HALF + n * 16); acc[ai][bj][m][n] = bs + (acc[ai][bj][m][n] - sr.x) * sr.y; }
                asm volatile("" : "+v"(acc[ai][0][m][0]), "+v"(acc[ai][0][m][1]), "+v"(acc[ai][1][m][0]), "+v"(acc[ai][1][m][1]));
                if (m & 1) asm volatile("" ::: "memory"); }
        const bool bad1 = bad;
        bad = st2.run(acc, u, wr, wc, fr, fq, lds, wid, lane) || bad;
#pragma unroll
        for (int ai = 0; ai < 2; ++ai)
#pragma unroll
            for (int m = 0; m < 4; ++m) { const int r = ai * HALF + wr * 64 + m * 16 + fr; const f32x2v sr = S[r]; const size_t off = (size_t)(u.pm * BM + r) * ldc + col0;
#pragma unroll
                for (int bj = 0; bj < 2; ++bj)
#pragma unroll
                    for (int n = 0; n < 2; ++n) { const f32x4 x1 = acc[ai][bj][m][n]; *(f32x4*)(out + off + bj * HALF + n * 16) = bad1 ? (f32x4){qnan, qnan, qnan, qnan} : x1;
                        const f32x4 o = (x1 - sr.x) * sr.y; u32x2v w; w.x = cvt_pk_bf16(o[0], o[1]); w.y = cvt_pk_bf16(o[2], o[3]);
                        if (bad) { w.x = 0x7fc07fc0u; w.y = 0x7fc07fc0u; } *(u32x2v*)(xn + off + bj * HALF + n * 16) = w; }
                asm volatile("" ::: "memory"); }
    }
};

template <class Epi, class Sched, bool ALIGN_EPI = false, bool SP2 = false>
__device__ __forceinline__ void gemm_phase(PG8_LAS unsigned char* lds, const Gemm g, const Sched& S, const Epi& E) {
    const int tid = threadIdx.x, wid = __builtin_amdgcn_readfirstlane(tid >> 6), lane = tid & 63, wr = wid >> 2, wc = wid & 3, fr = lane & 15, fq = lane >> 4;
    const int K = g.K, nt = K / BK;
    unsigned voffA[2], voffB[2];
#pragma unroll
    for (int i = 0; i < 2; ++i) { int R, C; stage_rc(tid * 16 + i * 8192, R, C); const int Rb = Epi::PERM ? ((R & ~31) + perm32(R & 31)) : R;
        voffA[i] = (unsigned)(R * K + C) * 2u; voffB[i] = (unsigned)(Rb * K + C) * 2u; }
    const size_t kstep = (size_t)(BK * 2);
    const size_t hstep = (size_t)HALF * K * 2;
    const size_t tstep = 2 * hstep;
    const unsigned ldsw = (unsigned)wid * 1024u;
    const int aoff = lds_byte(wr * 64 + fr, fq * 8), boff = lds_byte(wc * 32 + fr, fq * 8);
#define PG8_SA(b, h) (((b) * 2 + (h)) * HTB)
#define PG8_SB(b, h) ((4 + (b) * 2 + (h)) * HTB)
#define PG8_STAGE(bufoff, gbase, voff) do { _Pragma("unroll") for (int _i = 0; _i < 2; ++_i) \
        __builtin_amdgcn_global_load_lds((const unsigned*)((const char*)(gbase) + (voff)[_i]), (PG8_LAS unsigned*)(lds + (bufoff) + ldsw + _i * 8192), 16, 0, 0); } while (0)
#define PG8_LDA(dst, b, h) do { _Pragma("unroll") for (int m = 0; m < 4; ++m) _Pragma("unroll") for (int k = 0; k < 2; ++k) dst[m][k] = *(const PG8_LAS bf16x8*)(lds + PG8_SA(b, h) + aoff + m * 2048 + k * 1024); } while (0)
#define PG8_LDB(dst, b, h) do { _Pragma("unroll") for (int n = 0; n < 2; ++n) _Pragma("unroll") for (int k = 0; k < 2; ++k) dst[n][k] = *(const PG8_LAS bf16x8*)(lds + PG8_SB(b, h) + boff + n * 2048 + k * 1024); } while (0)
#define PG8_MMA(ai, bj, At, Bt) do { __builtin_amdgcn_s_setprio(1); _Pragma("unroll") for (int m = 0; m < 4; ++m) _Pragma("unroll") for (int n = 0; n < 2; ++n) _Pragma("unroll") for (int k = 0; k < 2; ++k) \
        acc[ai][bj][m][n] = __builtin_amdgcn_mfma_f32_16x16x32_bf16(Bt[n][k], At[m][k], acc[ai][bj][m][n], 0, 0, 0); __builtin_amdgcn_s_setprio(0); } while (0)
#define PG8_WAIT_V(n) asm volatile("s_waitcnt vmcnt(" #n ")" ::: "memory")
#define PG8_WAIT_L(n) asm volatile("s_waitcnt lgkmcnt(" #n ")" ::: "memory")
#define PG8_BAR __builtin_amdgcn_s_barrier()
#define PG8_SCHED __builtin_amdgcn_sched_barrier(0)
    Unit cur, nxt; int ui = 0;
    if (!S.next(0, cur)) return;
    f32x4 acc[2][2][4][2];
#pragma unroll
    for (int a = 0; a < 2; ++a)
#pragma unroll
        for (int b = 0; b < 2; ++b)
#pragma unroll
            for (int m = 0; m < 4; ++m)
#pragma unroll
                for (int n = 0; n < 2; ++n) acc[a][b][m][n] = (f32x4){0.f, 0.f, 0.f, 0.f};
    bf16x8 At[4][2], B0[2][2], B1[2][2];
    const char* cA = (const char*)g.A + (size_t)cur.pm * tstep; const char* cB = (const char*)g.Bt + (size_t)cur.pn * tstep;
    S.a_ready(cur);
    if constexpr (SP2) {
        PG8_STAGE(PG8_SB(0, 0), cB, voffB); PG8_STAGE(PG8_SB(0, 1), cB + hstep, voffB); PG8_STAGE(PG8_SA(0, 0), cA, voffA); PG8_STAGE(PG8_SA(0, 1), cA + hstep, voffA);
        if (wr == 1) PG8_BAR;
        PG8_WAIT_V(2); PG8_BAR;
        PG8_STAGE(PG8_SB(1, 0), cB + kstep, voffB); PG8_STAGE(PG8_SA(1, 0), cA + kstep, voffA); PG8_STAGE(PG8_SB(1, 1), cB + hstep + kstep, voffB);
        PG8_WAIT_V(6); PG8_BAR;
    } else {
        PG8_STAGE(PG8_SB(0, 0), cB, voffB); PG8_STAGE(PG8_SA(0, 0), cA, voffA); PG8_STAGE(PG8_SB(0, 1), cB + hstep, voffB); PG8_STAGE(PG8_SA(0, 1), cA + hstep, voffA);
        if (wr == 1) PG8_BAR;
        PG8_WAIT_V(4); PG8_BAR;
        PG8_STAGE(PG8_SB(1, 0), cB + kstep, voffB); PG8_STAGE(PG8_SA(1, 0), cA + kstep, voffA); PG8_STAGE(PG8_SB(1, 1), cB + hstep + kstep, voffB);
        PG8_WAIT_V(6); PG8_BAR;
    }
    for (;;) {
        const bool has_next = S.next(ui + 1, nxt);
        const char* nA = has_next ? (const char*)g.A + (size_t)nxt.pm * tstep : cA; const char* nB = has_next ? (const char*)g.Bt + (size_t)nxt.pn * tstep : cB;
        for (int t = 0; t < nt; t += 2) {
            const bool last = (t == nt - 2);
            const char* a1 = cA + (size_t)(t + 1) * kstep;
            const char* a2 = last ? nA : cA + (size_t)(t + 2) * kstep; const char* b2 = last ? nB : cB + (size_t)(t + 2) * kstep;
            const char* a3 = a2 + kstep; const char* b3 = b2 + kstep;
            if (last && has_next) S.a_ready(nxt);
            if constexpr (SP2) {
            PG8_LDB(B0, 0, 0); PG8_LDB(B1, 0, 1); PG8_SCHED; PG8_LDA(At, 0, 0); PG8_STAGE(PG8_SA(1, 1), a1 + hstep, voffA);
            PG8_WAIT_V(8); PG8_WAIT_L(0); PG8_BAR; PG8_MMA(0, 0, At, B0); PG8_MMA(0, 1, At, B1); PG8_BAR; PG8_SCHED;
            PG8_LDA(At, 0, 1); PG8_STAGE(PG8_SB(0, 0), b2, voffB); PG8_STAGE(PG8_SB(0, 1), b2 + hstep, voffB); PG8_STAGE(PG8_SA(0, 0), a2, voffA);
            PG8_WAIT_V(8); PG8_WAIT_L(0); PG8_BAR; PG8_MMA(1, 0, At, B0); PG8_MMA(1, 1, At, B1); PG8_BAR; PG8_SCHED;
            PG8_LDB(B0, 1, 0); PG8_LDB(B1, 1, 1); PG8_SCHED; PG8_LDA(At, 1, 0); PG8_STAGE(PG8_SA(0, 1), a2 + hstep, voffA);
            PG8_WAIT_V(8); PG8_WAIT_L(0); PG8_BAR; PG8_MMA(0, 0, At, B0); PG8_MMA(0, 1, At, B1); PG8_BAR; PG8_SCHED;
            PG8_LDA(At, 1, 1); PG8_STAGE(PG8_SB(1, 0), b3, voffB); PG8_STAGE(PG8_SB(1, 1), b3 + hstep, voffB); PG8_STAGE(PG8_SA(1, 0), a3, voffA);
            PG8_WAIT_V(8); PG8_WAIT_L(0); PG8_BAR; PG8_MMA(1, 0, At, B0); PG8_MMA(1, 1, At, B1); PG8_BAR; PG8_SCHED;
            } else {
            PG8_LDB(B0, 0, 0); PG8_SCHED; PG8_LDA(At, 0, 0); PG8_STAGE(PG8_SA(1, 1), a1 + hstep, voffA);
            PG8_WAIT_L(8); PG8_BAR; PG8_WAIT_L(0); PG8_MMA(0, 0, At, B0); PG8_BAR; PG8_SCHED;
            PG8_LDB(B1, 0, 1); PG8_STAGE(PG8_SB(0, 0), b2, voffB);
            PG8_BAR; PG8_WAIT_L(0); PG8_MMA(0, 1, At, B1); PG8_BAR;
            PG8_LDA(At, 0, 1); PG8_STAGE(PG8_SA(0, 0), a2, voffA);
            PG8_BAR; PG8_WAIT_L(0); PG8_MMA(1, 0, At, B0); PG8_BAR; PG8_SCHED;
            PG8_STAGE(PG8_SB(0, 1), b2 + hstep, voffB);
            PG8_WAIT_V(6); PG8_BAR; PG8_MMA(1, 1, At, B1); PG8_BAR;
            PG8_LDB(B0, 1, 0); PG8_SCHED; PG8_LDA(At, 1, 0); PG8_STAGE(PG8_SA(0, 1), a2 + hstep, voffA);
            PG8_WAIT_L(8); PG8_BAR; PG8_WAIT_L(0); PG8_MMA(0, 0, At, B0); PG8_BAR; PG8_SCHED;
            PG8_LDB(B1, 1, 1); PG8_STAGE(PG8_SB(1, 0), b3, voffB);
            PG8_BAR; PG8_WAIT_L(0); PG8_MMA(0, 1, At, B1); PG8_BAR;
            PG8_LDA(At, 1, 1); PG8_STAGE(PG8_SA(1, 0), a3, voffA);
            PG8_BAR; PG8_WAIT_L(0); PG8_MMA(1, 0, At, B0); PG8_BAR; PG8_SCHED;
            PG8_STAGE(PG8_SB(1, 1), b3 + hstep, voffB);
            PG8_WAIT_V(6); PG8_BAR; PG8_MMA(1, 1, At, B1); PG8_BAR;
            }
        }
        if constexpr (ALIGN_EPI) { if (wr == 0) PG8_BAR; }
        if constexpr (!Epi::AFTER_DRAIN) { E(acc, cur, wr, wc, fr, fq); S.done(cur); }
        if (!has_next) break;
#pragma unroll
        for (int a = 0; a < 2; ++a)
#pragma unroll
            for (int b = 0; b < 2; ++b)
#pragma unroll
                for (int m = 0; m < 4; ++m)
#pragma unroll
                    for (int n = 0; n < 2; ++n) acc[a][b][m][n] = (f32x4){0.f, 0.f, 0.f, 0.f};
        cur = nxt; cA = nA; cB = nB; ++ui;
        if constexpr (ALIGN_EPI) { if (wr == 1) PG8_BAR; }
    }
    PG8_WAIT_V(0);
    if constexpr (!ALIGN_EPI) { if (wr == 0) PG8_BAR; }
    PG8_BAR;
    if constexpr (Epi::AFTER_DRAIN) { E.fused(acc, cur, wr, wc, fr, fq, lds, wid, lane); S.done(cur); }
#undef PG8_SA
#undef PG8_SB
#undef PG8_STAGE
#undef PG8_LDA
#undef PG8_LDB
#undef PG8_MMA
#undef PG8_WAIT_V
#undef PG8_WAIT_L
#undef PG8_BAR
#undef PG8_SCHED
}
}
namespace pg8 {
__device__ __forceinline__ float bf2f(unsigned short b) { return __uint_as_float(((unsigned)b) << 16); }
__device__ __forceinline__ float bflo(unsigned w) { return __uint_as_float(w << 16); }
__device__ __forceinline__ float bfhi(unsigned w) { return __uint_as_float(w & 0xffff0000u); }
__device__ __forceinline__ float sigm(float x) { return 1.f / (1.f + __expf(-x)); }
template <int MODE> struct EpiGate {
    static constexpr bool PERM = true, AFTER_DRAIN = false;
    bf16_t* O; int ldc; const bf16_t* G; int ldg;
    __device__ __forceinline__ void operator()(const f32x4 (&acc)[2][2][4][2], const Unit& u, int wr, int wc, int fr, int fq) const {
        const int row0 = u.pm * BM + wr * 64 + fr, col0 = u.pn * BM + wc * 32 + 8 * fq;
#pragma unroll
        for (int ai = 0; ai < 2; ++ai)
#pragma unroll
            for (int m = 0; m < 4; ++m) { const size_t row = (size_t)(row0 + ai * HALF + m * 16);
#pragma unroll
                for (int bj = 0; bj < 2; ++bj) {
                    const u32x4 gw = *(const u32x4*)(G + row * ldg + col0 + bj * HALF);
                    f32x4 v0 = acc[ai][bj][m][0], v1 = acc[ai][bj][m][1];
                    v0[0] *= sigm(bflo(gw.x)); v0[1] *= sigm(bfhi(gw.x)); v0[2] *= sigm(bflo(gw.y)); v0[3] *= sigm(bfhi(gw.y));
                    v1[0] *= sigm(bflo(gw.z)); v1[1] *= sigm(bfhi(gw.z)); v1[2] *= sigm(bflo(gw.w)); v1[3] *= sigm(bfhi(gw.w));
                    bf16_t* op = O + row * ldc + col0 + bj * HALF;
                    if (MODE == 1) { const u32x4 ow = *(const u32x4*)op;
                        v0[0] += bflo(ow.x); v0[1] += bfhi(ow.x); v0[2] += bflo(ow.y); v0[3] += bfhi(ow.y);
                        v1[0] += bflo(ow.z); v1[1] += bfhi(ow.z); v1[2] += bflo(ow.w); v1[3] += bfhi(ow.w); }
                    u32x4 w; w.x = cvt_pk_bf16(v0[0], v0[1]); w.y = cvt_pk_bf16(v0[2], v0[3]); w.z = cvt_pk_bf16(v1[0], v1[1]); w.w = cvt_pk_bf16(v1[2], v1[3]);
                    *(u32x4*)op = w; } }
    }
};
struct EpiResid {
    static constexpr bool PERM = true, AFTER_DRAIN = false;
    const float* R; float* Hf; bf16_t* Hb; float* ss; int ldc;
    __device__ __forceinline__ void operator()(const f32x4 (&acc)[2][2][4][2], const Unit& u, int wr, int wc, int fr, int fq) const {
        const int row0 = u.pm * BM + wr * 64 + fr, col0 = u.pn * BM + wc * 32 + 8 * fq;
#pragma unroll
        for (int ai = 0; ai < 2; ++ai)
#pragma unroll
            for (int m = 0; m < 4; ++m) { const size_t row = (size_t)(row0 + ai * HALF + m * 16); float sq = 0.f;
#pragma unroll
                for (int bj = 0; bj < 2; ++bj) {
                    const size_t off = row * ldc + col0 + bj * HALF;
                    const f32x4 r0 = *(const f32x4*)(R + off), r1 = *(const f32x4*)(R + off + 4);
                    const f32x4 v0 = acc[ai][bj][m][0] + r0, v1 = acc[ai][bj][m][1] + r1;
                    *(f32x4*)(Hf + off) = v0; *(f32x4*)(Hf + off + 4) = v1;
                    u32x4 w; w.x = cvt_pk_bf16(v0[0], v0[1]); w.y = cvt_pk_bf16(v0[2], v0[3]); w.z = cvt_pk_bf16(v1[0], v1[1]); w.w = cvt_pk_bf16(v1[2], v1[3]);
                    *(u32x4*)(Hb + off) = w;
                    sq += (v0[0] * v0[0] + v0[1] * v0[1]) + (v0[2] * v0[2] + v0[3] * v0[3]) + (v1[0] * v1[0] + v1[1] * v1[1]) + (v1[2] * v1[2] + v1[3] * v1[3]); }
                sq += __shfl_xor(sq, 16); sq += __shfl_xor(sq, 32);
                if (fq == 0) atomicAdd(ss + row, sq); }
    }
};
struct EpiRowScale {
    static constexpr bool PERM = true, AFTER_DRAIN = false;
    bf16_t* O; int ldc; const float* ss; float inv_n, eps;
    __device__ __forceinline__ void operator()(const f32x4 (&acc)[2][2][4][2], const Unit& u, int wr, int wc, int fr, int fq) const {
        const int row0 = u.pm * BM + wr * 64 + fr, col0 = u.pn * BM + wc * 32 + 8 * fq;
#pragma unroll
        for (int ai = 0; ai < 2; ++ai)
#pragma unroll
            for (int m = 0; m < 4; ++m) { const size_t row = (size_t)(row0 + ai * HALF + m * 16);
                const float sc = rsqrtf(__hip_atomic_load(ss + row, __ATOMIC_RELAXED, __HIP_MEMORY_SCOPE_AGENT) * inv_n + eps);
#pragma unroll
                for (int bj = 0; bj < 2; ++bj) { const f32x4 v0 = acc[ai][bj][m][0] * sc, v1 = acc[ai][bj][m][1] * sc;
                    u32x4 w; w.x = cvt_pk_bf16(v0[0], v0[1]); w.y = cvt_pk_bf16(v0[2], v0[3]); w.z = cvt_pk_bf16(v1[0], v1[1]); w.w = cvt_pk_bf16(v1[2], v1[3]);
                    *(u32x4*)(O + row * ldc + col0 + bj * HALF) = w; } }
    }
};
}
constexpr int D_MODEL = 2048, BATCH = 2, SEQ = 4096, NTOK = BATCH * SEQ;
constexpr int HD = 64, NCMP = 255, CMP_STRIDE = 16, CMP_LEN = 32, CMP_HID = 128;
constexpr int SEL_LEN = 64, SEL_TOPK = 16, WINDOW = 512;
constexpr int PEER_KEYS = 128, PEER_E = 128;
constexpr int NSA_Q = 1024, SB_W = 1024;
constexpr int IN_COLS = 9776, PLD = 9984;
constexpr int C_QN = 0, C_KC = 1024, C_VC = 1280, C_KS = 1536, C_VS = 1792, C_KW = 2048, C_VW = 2304, C_GBR = 2560,
              C_QB = 2608, C_KB = 3632, C_VB = 4656, C_GA = 5680, C_GB = 7728;
constexpr float EPS = 1e-6f, NEGF = -1e30f;
constexpr int NWAVES = 8, NTHR = 512;

constexpr size_t MiB = 1u << 20;
constexpr size_t WS_CTL = 0, CTL_ZERO_BYTES = 1 * MiB;
constexpr size_t WS_WIN = 2 * MiB;
constexpr size_t WS_WBN = 42 * MiB, WS_WBS = 46 * MiB;
constexpr size_t WS_WOUT = 50 * MiB, WS_WPQ = 58 * MiB;
constexpr size_t WS_MISC = 66 * MiB;
constexpr size_t WS_XN = 70 * MiB;
constexpr size_t WS_PROJ = 102 * MiB;
constexpr size_t WS_ONSA = 258 * MiB, WS_OSB = 274 * MiB;
constexpr size_t WS_H = 290 * MiB;
constexpr size_t WS_HB = 354 * MiB;
constexpr size_t WS_END = 386 * MiB;
constexpr size_t WS_UB = 102 * MiB, WS_VB = 166 * MiB, WS_QP = 230 * MiB, WS_EXP = 262 * MiB, WS_GATE = 266 * MiB;
constexpr size_t MISC_KCB = 0, MISC_VCB = 1 * MiB, MISC_SKB = 2 * MiB;
constexpr int CW_BAR = 4096;
constexpr int CW_SS = 32768;

#define GAS __attribute__((address_space(1)))
#define LAS __attribute__((address_space(3)))
typedef unsigned short bf16;
typedef unsigned v4u __attribute__((ext_vector_type(4)));
typedef unsigned v2u __attribute__((ext_vector_type(2)));
typedef float f32x4 __attribute__((ext_vector_type(4)));
#define RLX_AGENT __ATOMIC_RELAXED, __HIP_MEMORY_SCOPE_AGENT
__device__ __forceinline__ unsigned f2bf(float f) { unsigned u = __builtin_bit_cast(unsigned, f); return (u + 0x7fffu + ((u >> 16) & 1u)) >> 16; }
__device__ __forceinline__ unsigned pk2(float lo, float hi) { return f2bf(lo) | (f2bf(hi) << 16); }
__device__ __forceinline__ float bf2f(bf16 b) { return __uint_as_float(((unsigned)b) << 16); }
__device__ __forceinline__ float bflo(unsigned w) { return __uint_as_float(w << 16); }
__device__ __forceinline__ float bfhi(unsigned w) { return __uint_as_float(w & 0xffff0000u); }

#define XB_TMO      128
#define XB_XCNT(j)  (256  + 64 * (j))
#define XB_XSUB(j)  (1280 + 64 * (j))
#define XB_XGEN(j)  (2304 + 64 * (j))
#define XB_TOP      3328
#define XB_TOPGEN   3392
#define XCD_BAR_WORDS 3456
#define XB_SPIN_CAP (1u << 24)
__device__ __forceinline__ unsigned xb_ld(unsigned* p)              { return __hip_atomic_load(p, __ATOMIC_RELAXED, __HIP_MEMORY_SCOPE_AGENT); }
__device__ __forceinline__ unsigned xb_add(unsigned* p, unsigned v) { return __hip_atomic_fetch_add(p, v, __ATOMIC_RELAXED, __HIP_MEMORY_SCOPE_AGENT); }
__device__ __forceinline__ unsigned xb_xcc_id() { return (unsigned)__builtin_amdgcn_s_getreg((3 << 11) | 20) & 0xFu; }
#define XB_SPIN(cond, bar) do { unsigned _sp = 0; while (cond) { __builtin_amdgcn_s_sleep(1); \
    if ((++_sp & 255u) == 0u) { if (xb_ld(&(bar)[XB_TMO])) break; if (_sp > XB_SPIN_CAP) { atomicAdd(&(bar)[XB_TMO], 1u); break; } } } } while (0)
struct XcdBarrier { unsigned* bar; unsigned x; volatile LAS unsigned* st; };
__device__ __forceinline__ XcdBarrier xcd_barrier_post(unsigned* bar, volatile LAS unsigned* st) {
    XcdBarrier b; b.bar = bar; b.x = xb_xcc_id(); b.st = st;
    if (threadIdx.x == 0) (void)xb_add(&bar[XB_XCNT(b.x)], 1u);
    return b;
}
__device__ __forceinline__ void xcd_barrier_complete(unsigned* bar, unsigned x, unsigned& nloc, unsigned& nx) {
    const unsigned G = gridDim.x * gridDim.y * gridDim.z;
    unsigned sum, cnt, mine, sp = 0u;
    for (;;) {
        sum = 0u; cnt = 0u; mine = 0u;
#pragma unroll
        for (unsigned j = 0; j < 16; ++j) { const unsigned c = xb_ld(&bar[XB_XCNT(j)]); sum += c; cnt += (c > 0u) ? 1u : 0u; mine = (j == x) ? c : mine; }
        if (sum == G) break;
        __builtin_amdgcn_s_sleep(1);
        if ((++sp & 255u) == 0u) { if (xb_ld(&bar[XB_TMO])) break; if (sp > XB_SPIN_CAP) { atomicAdd(&bar[XB_TMO], 1u); break; } }
    }
    nloc = mine > 0u ? mine : 1u; nx = cnt > 0u ? cnt : 1u;
}
__device__ __forceinline__ void xcd_barrier(const XcdBarrier& b) {
    asm volatile("s_waitcnt vmcnt(0)" ::: "memory");
    __syncthreads();
    if (threadIdx.x == 0) {
        unsigned* bar = b.bar;
        const unsigned bx = xb_xcc_id();
        __builtin_amdgcn_s_waitcnt(0);
        unsigned nloc = b.st[0], nx = b.st[1];
        if (nloc == 0u) { xcd_barrier_complete(bar, bx, nloc, nx); b.st[0] = nloc; b.st[1] = nx; }
        const unsigned old = xb_add(&bar[XB_XSUB(bx)], 1u);
        const unsigned gen = old / nloc;
        if (old + 1u == (gen + 1u) * nloc) {
            __builtin_amdgcn_fence(__ATOMIC_RELEASE, "agent");
            asm volatile("s_waitcnt vmcnt(0)" ::: "memory");
            const unsigned og = xb_add(&bar[XB_TOP], 1u);
            const unsigned tg = og / nx;
            if (og + 1u == (tg + 1u) * nx) xb_add(&bar[XB_TOPGEN], 1u);
            else XB_SPIN(xb_ld(&bar[XB_TOPGEN]) == tg, bar);
            __builtin_amdgcn_fence(__ATOMIC_ACQUIRE, "agent");
            xb_add(&bar[XB_XGEN(bx)], 1u);
            asm volatile("s_waitcnt vmcnt(0)" ::: "memory");
        } else {
            XB_SPIN(xb_ld(&bar[XB_XGEN(bx)]) == gen, bar);
            __builtin_amdgcn_fence(__ATOMIC_ACQUIRE, "agent");
            asm volatile("s_waitcnt vmcnt(0)" ::: "memory");
        }
    }
    __syncthreads();
}

__device__ __forceinline__ int rel_bucket(int d) {
    if (d < 16) return d < 0 ? 0 : d;
    int b = 16;
    b += (d >= 21); b += (d >= 27); b += (d >= 35); b += (d >= 46); b += (d >= 59); b += (d >= 77); b += (d >= 99); b += (d >= 128);
    b += (d >= 166); b += (d >= 216); b += (d >= 280); b += (d >= 363); b += (d >= 470); b += (d >= 609); b += (d >= 790);
    return b;
}
__device__ __forceinline__ float gelu_tanh(float x) { const float k = 0.7978845608028654f; return 0.5f * x * (1.f + tanhf(k * (x + 0.044715f * x * x * x))); }
__device__ __forceinline__ float sigmoidf_(float x) { return 1.f / (1.f + expf(-x)); }
__device__ __forceinline__ float wave_sum(float v) {
#pragma unroll
    for (int o = 32; o >= 1; o >>= 1) v += __shfl_xor(v, o);
    return v;
}
__device__ __forceinline__ float wave_max(float v) {
#pragma unroll
    for (int o = 32; o >= 1; o >>= 1) v = fmaxf(v, __shfl_xor(v, o));
    return v;
}
__device__ __forceinline__ float half_sum(float v, float* red) {
    v = wave_sum(v);
    __syncthreads();
    if ((threadIdx.x & 63) == 0) red[(threadIdx.x >> 6) & 3] = v;
    __syncthreads();
    return red[0] + red[1] + red[2] + red[3];
}
__device__ __forceinline__ float half_max(float v, float* red) {
    v = wave_max(v);
    __syncthreads();
    if ((threadIdx.x & 63) == 0) red[(threadIdx.x >> 6) & 3] = v;
    __syncthreads();
    return fmaxf(fmaxf(red[0], red[1]), fmaxf(red[2], red[3]));
}

struct Args {
    const float* in[19]; float* out; unsigned char* ws; int ph_lo, ph_hi;
};

__device__ __forceinline__ void p0_transpose_item(const float* W, int K, int N, bf16* WT, const float* gk, LAS float* scr, int item, int lane) {
    const int nblk = (N + 31) / 32, kb = item / nblk, nb = item % nblk, k0 = 64 * kb, n0 = 32 * nb;
    const bool cok = (n0 + (lane & 31)) < N;
#pragma unroll 8
    for (int i = 0; i < 32; ++i) { const int kk = 2 * i + (lane >> 5); float v = cok ? W[(size_t)(k0 + kk) * N + n0 + (lane & 31)] : 0.f; if (gk) v *= gk[k0 + kk]; scr[kk * 33 + (lane & 31)] = v; }
    asm volatile("s_waitcnt lgkmcnt(0)" ::: "memory");
    const int c = lane & 7;
#pragma unroll
    for (int j = 0; j < 4; ++j) { const int n = (lane >> 3) + 8 * j; const LAS float* s = scr + (8 * c) * 33 + n;
        v4u o; o.x = pk2(s[0 * 33], s[1 * 33]); o.y = pk2(s[2 * 33], s[3 * 33]); o.z = pk2(s[4 * 33], s[5 * 33]); o.w = pk2(s[6 * 33], s[7 * 33]);
        if (n0 + n < N) *(v4u*)(WT + (size_t)(n0 + n) * K + k0 + 8 * c) = o; }
    asm volatile("s_waitcnt lgkmcnt(0)" ::: "memory");
}
__device__ __forceinline__ void rms_row_to_bf16(const float* xrow, const float* g, bf16* orow, int lane) {
    const f32x4* xr = (const f32x4*)xrow + lane; const f32x4* gr = (const f32x4*)g + lane;
    f32x4 v[8]; float s = 0.f;
#pragma unroll
    for (int j = 0; j < 8; ++j) { v[j] = xr[64 * j]; s += (v[j].x * v[j].x + v[j].y * v[j].y) + (v[j].z * v[j].z + v[j].w * v[j].w); }
    const float r = rsqrtf(wave_sum(s) * (1.f / D_MODEL) + EPS);
    v2u* o8 = (v2u*)orow + lane;
#pragma unroll
    for (int j = 0; j < 8; ++j) { const f32x4 gv = gr[64 * j]; v2u w; w.x = pk2(v[j].x * r * gv.x, v[j].y * r * gv.y); w.y = pk2(v[j].z * r * gv.z, v[j].w * r * gv.w); o8[64 * j] = w; }
}
__device__ __forceinline__ void cvt_flat(const float* src, bf16* dst, size_t n, size_t gthread, size_t nthreads) {
    for (size_t i = gthread * 8; i < n; i += nthreads * 8) {
        const f32x4 a = *(const f32x4*)(src + i), b = *(const f32x4*)(src + i + 4);
        v4u o; o.x = pk2(a.x, a.y); o.y = pk2(a.z, a.w); o.z = pk2(b.x, b.y); o.w = pk2(b.z, b.w);
        *(v4u*)(dst + i) = o;
    }
}
__device__ __forceinline__ void ph_compress_naive(const bf16* PROJ, const float* const* in, bf16* KCB, bf16* VCB, float* ldsf, int bid, int G) {
    const int tid = threadIdx.x, grp = tid >> 7, gt = tid & 127;
    if (bid == 0) for (int i = tid; i < 2 * 8 * HD; i += NTHR) { bf16* dst = (i >= 8 * HD) ? VCB : KCB; const int k = i & (8 * HD - 1); dst[(size_t)((k >> 6) * 256 + 255) * HD + (k & 63)] = 0; }
    float* blk = ldsf + grp * 2048; float* hid = ldsf + 4 * 2048 + grp * 128;
    const int per = BATCH * NCMP * 4, nitems = 2 * per;
    for (int base = bid * 4; base < nitems; base += G * 4) {
        const int item = base + grp; const bool ok = item < nitems;
        const int kv = ok ? item / per : 0, idx = ok ? item % per : 0;
        const int g = idx & 3, n = (idx >> 2) % NCMP, b = (idx >> 2) / NCMP;
        const float* pe = in[kv ? 6 : 3]; const float* w1 = in[kv ? 7 : 4]; const float* w2 = in[kv ? 8 : 5];
        const int coff = kv ? C_VC : C_KC;
        if (ok) for (int i = gt; i < CMP_LEN * HD; i += 128) { const int l = i >> 6, dd = i & 63; blk[i] = bf2f(PROJ[(size_t)(b * SEQ + n * CMP_STRIDE + l) * PLD + coff + g * HD + dd]) + pe[i]; }
        __syncthreads();
        if (ok) { float a = 0.f;
#pragma unroll 8
            for (int k = 0; k < CMP_LEN * HD; ++k) a += blk[k] * w1[(size_t)k * CMP_HID + gt];
            hid[gt] = gelu_tanh(a); }
        __syncthreads();
        if (ok && gt < HD) { float o = 0.f;
#pragma unroll 8
            for (int k = 0; k < CMP_HID; ++k) o += hid[k] * w2[k * HD + gt];
            (kv ? VCB : KCB)[(size_t)((b * 4 + g) * 256 + n) * HD + gt] = (bf16)f2bf(o); }
        __syncthreads();
    }
}

__device__ __forceinline__ void ph_stick_naive(const bf16* PROJ, bf16* OSB, int bid, int G) {
    const int lane = threadIdx.x & 63, gw = bid * NWAVES + (threadIdx.x >> 6), NGW = G * NWAVES;
    for (int row = gw; row < BATCH * 16 * SEQ; row += NGW) {
        const int t = row % SEQ, h = (row / SEQ) & 15, b = row / (SEQ * 16);
        const float qv = bf2f(PROJ[(size_t)(b * SEQ + t) * PLD + C_QB + h * HD + lane]);
        float acc = 0.f, suffix = 0.f;
        for (int s = t - 1; s >= 0; --s) {
            const bf16* kr = PROJ + (size_t)(b * SEQ + s) * PLD;
            const float z = wave_sum(qv * bf2f(kr[C_KB + h * HD + lane])) * 0.125f;
            const float lb = fminf(z, 0.f) - log1pf(expf(-fabsf(z)));
            acc += expf(lb + suffix) * bf2f(kr[C_VB + h * HD + lane]);
            suffix += lb - z;
            if (suffix < -80.f) break;
        }
        OSB[(size_t)(b * SEQ + t) * SB_W + h * HD + lane] = (bf16)f2bf(acc);
    }
}

__device__ __forceinline__ void ph_route_naive(const bf16* QP, const float* subk, int* EXPERT, float* GATE, float* ldsf, int bid, int G) {
    const int tid = threadIdx.x, hb = tid >> 8, ht = tid & 255;
    float* base = ldsf + hb * 4608;
    float* qs = base; float (*s)[128] = (float (*)[128])(base + 2048); float (*tv)[16] = (float (*)[16])(base + 4096); int (*ti)[16] = (int (*)[16])(base + 4352);
    for (int nb = bid * 2; nb < NTOK; nb += G * 2) {
        const int n = nb + hb;
        __syncthreads();
        for (int i = ht; i < 2048; i += 256) qs[i] = bf2f(QP[(size_t)n * 2048 + i]);
        __syncthreads();
#pragma unroll 1
        for (int r = 0; r < 8; ++r) {
            const int idx = ht + 256 * r, list = idx >> 7, k = idx & 127;
            const float* kr = subk + ((size_t)list * 128 + k) * 128;
            float a = 0.f;
#pragma unroll 8
            for (int c = 0; c < 128; ++c) a += qs[list * 128 + c] * kr[c];
            s[list][k] = a;
        }
        __syncthreads();
        if (ht < 16) {
            const int l = ht;
#pragma unroll 1
            for (int r = 0; r < 16; ++r) {
                float best = -INFINITY; int bi = 0;
                for (int k = 0; k < 128; ++k) { const float v = s[l][k]; if (v > best) { best = v; bi = k; } }
                tv[l][r] = best; ti[l][r] = bi; s[l][bi] = -INFINITY;
            }
        }
        __syncthreads();
        if (ht < 8) {
            const int h = ht;
            unsigned long long used0 = 0, used1 = 0, used2 = 0, used3 = 0;
            float bsv = 0.f, mx = 0.f, sum = 0.f;
#pragma unroll 1
            for (int r = 0; r < 16; ++r) {
                float best = -INFINITY; int bidx = 0;
                for (int j = 0; j < 256; ++j) {
                    const unsigned long long u = (j < 64) ? used0 : (j < 128) ? used1 : (j < 192) ? used2 : used3;
                    if ((u >> (j & 63)) & 1ull) continue;
                    const float v = tv[2 * h][j >> 4] + tv[2 * h + 1][j & 15];
                    if (v > best) { best = v; bidx = j; }
                }
                if (bidx < 64) used0 |= 1ull << bidx; else if (bidx < 128) used1 |= 1ull << (bidx & 63); else if (bidx < 192) used2 |= 1ull << (bidx & 63); else used3 |= 1ull << (bidx & 63);
                if (r == 0) mx = best;
                const float e = expf(best - mx); sum += e; bsv = e;
                EXPERT[(size_t)n * PEER_E + h * 16 + r] = ti[2 * h][bidx >> 4] * PEER_KEYS + ti[2 * h + 1][bidx & 15];
                GATE[(size_t)n * PEER_E + h * 16 + r] = bsv;
            }
            const float inv = 1.f / sum;
            for (int r = 0; r < 16; ++r) GATE[(size_t)n * PEER_E + h * 16 + r] *= inv;
        }
    }
    __syncthreads();
}

__device__ __forceinline__ void ph_ffn_naive(const float* H, const float* ss, const float* gffn, const int* EXPERT, const float* GATE, const bf16* UB, const bf16* VB,
                                             const float* gfin, float* out, float* ldsf, int bid, int G) {
    const int tid = threadIdx.x, hb = tid >> 8, ht = tid & 255, w = ht >> 6, lane = tid & 63;
    float* part = ldsf + hb * (4 * 2048 + 8); float* red = part + 4 * 2048;
    for (int nb = bid * 2; nb < NTOK; nb += G * 2) {
        const int n = nb + hb;
        const float rstd = rsqrtf(ss[n] * (1.f / D_MODEL) + EPS);
        float xv[32], acc[32];
#pragma unroll
        for (int j = 0; j < 4; ++j) {
            const float* hp = H + (size_t)n * 2048 + j * 512 + lane * 8; const float* gp = gffn + j * 512 + lane * 8;
            const f32x4 a = *(const f32x4*)hp, b2 = *(const f32x4*)(hp + 4), ga = *(const f32x4*)gp, gb = *(const f32x4*)(gp + 4);
            xv[8 * j + 0] = a.x * rstd * ga.x; xv[8 * j + 1] = a.y * rstd * ga.y; xv[8 * j + 2] = a.z * rstd * ga.z; xv[8 * j + 3] = a.w * rstd * ga.w;
            xv[8 * j + 4] = b2.x * rstd * gb.x; xv[8 * j + 5] = b2.y * rstd * gb.y; xv[8 * j + 6] = b2.z * rstd * gb.z; xv[8 * j + 7] = b2.w * rstd * gb.w;
        }
#pragma unroll
        for (int j = 0; j < 32; ++j) acc[j] = 0.f;
#pragma unroll 1
        for (int e = 0; e < 32; ++e) {
            const int ei = EXPERT[(size_t)n * PEER_E + w * 32 + e];
            const float gt = GATE[(size_t)n * PEER_E + w * 32 + e];
            const bf16* ur = UB + (size_t)ei * 2048 + lane * 8; const bf16* vr = VB + (size_t)ei * 2048 + lane * 8;
            float d = 0.f;
#pragma unroll
            for (int j = 0; j < 4; ++j) { const v4u u4 = *(const v4u*)(ur + j * 512);
                d += xv[8 * j + 0] * bflo(u4.x) + xv[8 * j + 1] * bfhi(u4.x) + xv[8 * j + 2] * bflo(u4.y) + xv[8 * j + 3] * bfhi(u4.y)
                   + xv[8 * j + 4] * bflo(u4.z) + xv[8 * j + 5] * bfhi(u4.z) + xv[8 * j + 6] * bflo(u4.w) + xv[8 * j + 7] * bfhi(u4.w); }
            d = wave_sum(d);
            const float wgt = gt * gelu_tanh(d);
#pragma unroll
            for (int j = 0; j < 4; ++j) { const v4u v4 = *(const v4u*)(vr + j * 512);
                acc[8 * j + 0] += wgt * bflo(v4.x); acc[8 * j + 1] += wgt * bfhi(v4.x); acc[8 * j + 2] += wgt * bflo(v4.y); acc[8 * j + 3] += wgt * bfhi(v4.y);
                acc[8 * j + 4] += wgt * bflo(v4.z); acc[8 * j + 5] += wgt * bfhi(v4.z); acc[8 * j + 6] += wgt * bflo(v4.w); acc[8 * j + 7] += wgt * bfhi(v4.w); }
        }
        __syncthreads();
#pragma unroll
        for (int j = 0; j < 4; ++j)
#pragma unroll
            for (int e = 0; e < 8; ++e) part[w * 2048 + j * 512 + lane * 8 + e] = acc[8 * j + e];
        __syncthreads();
        float y[8]; float sq = 0.f;
#pragma unroll
        for (int j = 0; j < 8; ++j) { const int c = ht + 256 * j; y[j] = H[(size_t)n * 2048 + c] + part[c] + part[2048 + c] + part[4096 + c] + part[6144 + c]; sq += y[j] * y[j]; }
        const float tot = half_sum(sq, red);
        const float r = rsqrtf(tot * (1.f / D_MODEL) + EPS);
#pragma unroll
        for (int j = 0; j < 8; ++j) { const int c = ht + 256 * j; out[(size_t)n * 2048 + c] = y[j] * r * gfin[c]; }
    }
    __syncthreads();
}
namespace nsa {
typedef short bf16x8 __attribute__((ext_vector_type(8)));
typedef short s16x4 __attribute__((ext_vector_type(4)));
typedef float f32x16 __attribute__((ext_vector_type(16)));
typedef unsigned u32x4 __attribute__((ext_vector_type(4)));
typedef __attribute__((address_space(3))) const char* lds_cptr;
typedef __attribute__((address_space(3))) unsigned char* lds_ptr;
constexpr int SLOTB = 16384;
constexpr int L_RING = 0, L_OV = 49152, L_BT = 81920, L_WSF = 94720, L_MASK = 96768, L_MISC = 97280, L_X = 97408, L_END = L_X + 32768;
constexpr int BT_N = 800;
constexpr float LOG2E = 1.4426950408889634f, SC2 = 0.125f * LOG2E, NEG2 = -1e30f;
static_assert(L_END <= 131072, "nsa LDS map");
__device__ __forceinline__ int crow(int r, int hi) { return (r & 3) + 8 * (r >> 2) + 4 * hi; }
__device__ __forceinline__ void glds16(const void* gsrc, unsigned lds_dst) { unsigned keep;
    asm volatile("s_mov_b32 %0, m0\n\ts_mov_b32 m0, %2\n\ts_nop 0\n\tglobal_load_lds_dwordx4 %1, off\n\ts_mov_b32 m0, %0" : "=&s"(keep) : "v"(gsrc), "s"(lds_dst) : "memory"); }
typedef float f32x2_t __attribute__((ext_vector_type(2))); typedef __bf16 bf16x2_t __attribute__((ext_vector_type(2)));
__device__ __forceinline__ unsigned cvtpk_s(float lo, float hi) { f32x2_t v = {lo, hi}; bf16x2_t b = __builtin_convertvector(v, bf16x2_t); return __builtin_bit_cast(unsigned, b); }
#define NSA_WAIT_BAR(N) asm volatile("s_waitcnt vmcnt(" #N ") lgkmcnt(0)\n\ts_barrier" ::: "memory")
#define NSA_SBAR() __builtin_amdgcn_sched_barrier(0)

__device__ __forceinline__ void qkt(f32x16& p0, f32x16& p1, lds_cptr Kslot, const bf16x8* qr, int r32, int hi) {
    lds_cptr kb = Kslot + hi * 1024 + r32 * 16;
    const f32x16 z = {};
#pragma unroll
    for (int d0 = 0; d0 < 4; ++d0) {
        const bf16x8 b0 = *(const __attribute__((address_space(3))) bf16x8*)(kb + d0 * 2048);
        const bf16x8 b1 = *(const __attribute__((address_space(3))) bf16x8*)(kb + d0 * 2048 + 512);
        if (d0 == 0) { p0 = __builtin_amdgcn_mfma_f32_32x32x16_bf16(b0, qr[0], z, 0, 0, 0); p1 = __builtin_amdgcn_mfma_f32_32x32x16_bf16(b1, qr[0], z, 0, 0, 0); }
        else { p0 = __builtin_amdgcn_mfma_f32_32x32x16_bf16(b0, qr[d0], p0, 0, 0, 0); p1 = __builtin_amdgcn_mfma_f32_32x32x16_bf16(b1, qr[d0], p1, 0, 0, 0); }
    }
}
__device__ __forceinline__ void pv(f32x16* o, int vb, bf16x8 pa0, bf16x8 pa1, bf16x8 pa2, bf16x8 pa3) {
#pragma unroll
    for (int d0 = 0; d0 < 2; ++d0) { s16x4 lo[4], hi[4];
#pragma unroll
        for (int ks = 0; ks < 4; ++ks) {
            asm volatile("ds_read_b64_tr_b16 %0,%1 offset:%c2" : "=&v"(lo[ks]) : "v"(vb), "i"(d0 * 4096 + ks * 1024) : "memory");
            asm volatile("ds_read_b64_tr_b16 %0,%1 offset:%c2" : "=&v"(hi[ks]) : "v"(vb), "i"(d0 * 4096 + ks * 1024 + 512) : "memory"); }
        asm volatile("s_waitcnt lgkmcnt(0)" ::: "memory"); NSA_SBAR();
#define NSA_PK(k) (bf16x8){lo[k][0], lo[k][1], lo[k][2], lo[k][3], hi[k][0], hi[k][1], hi[k][2], hi[k][3]}
        o[d0] = __builtin_amdgcn_mfma_f32_32x32x16_bf16(pa0, NSA_PK(0), o[d0], 0, 0, 0);
        o[d0] = __builtin_amdgcn_mfma_f32_32x32x16_bf16(pa1, NSA_PK(1), o[d0], 0, 0, 0);
        o[d0] = __builtin_amdgcn_mfma_f32_32x32x16_bf16(pa2, NSA_PK(2), o[d0], 0, 0, 0);
        o[d0] = __builtin_amdgcn_mfma_f32_32x32x16_bf16(pa3, NSA_PK(3), o[d0], 0, 0, 0);
#undef NSA_PK
    }
}
__device__ __forceinline__ float rowmax32(const f32x16& p0, const f32x16& p1) {
    float a = fmaxf(p0[0], p1[0]);
#pragma unroll
    for (int r = 1; r < 16; ++r) a = fmaxf(a, fmaxf(p0[r], p1[r]));
    auto rr = __builtin_amdgcn_permlane32_swap(__float_as_uint(a), __float_as_uint(a), false, false);
    return fmaxf(__uint_as_float(rr[0]), __uint_as_float(rr[1]));
}
__device__ __forceinline__ float swap_add(float v) {
    auto rr = __builtin_amdgcn_permlane32_swap(__float_as_uint(v), __float_as_uint(v), false, false);
    return __uint_as_float(rr[0]) + __uint_as_float(rr[1]);
}

struct PassCtx {
    lds_ptr lds3; unsigned lds0;
    int lane, r32, hi, wid;
    int tq;
    const __attribute__((address_space(3))) float* bt;
    __attribute__((address_space(3))) float* wsf;
    int vboff;
};

template <int MODE>
__device__ __forceinline__ void run_pass(const PassCtx& c, int NT, int first, const bf16* Kb, const bf16* Vb, int pitch, const bf16x8* qr,
                                         unsigned mask_lo, unsigned mask_hi, f32x16 (&o)[2], f32x16 (&im)[2], float& m, float& l) {
    const __attribute__((address_space(3))) unsigned char* TL = (const __attribute__((address_space(3))) unsigned char*)(c.lds3 + L_MISC);
#define NSA_TID(i) ((MODE == 0) ? (i) : (MODE == 2) ? (first + (i)) : (int)TL[(i)])
#define NSA_ISSUE(i, slot) do { const int id_ = __builtin_amdgcn_readfirstlane(NSA_TID(i)); \
        const bf16* ks_ = Kb + (size_t)(64 * id_ + c.lane) * pitch + 8 * c.wid; \
        const bf16* vs_ = Vb + (size_t)(64 * id_ + 16 * (c.wid & 3) + (c.lane >> 2)) * pitch + 32 * (c.wid >> 2) + 8 * (c.lane & 3); \
        glds16(ks_, (unsigned)__builtin_amdgcn_readfirstlane(c.lds0 + L_RING + (slot) * SLOTB + c.wid * 1024)); \
        glds16(vs_, (unsigned)__builtin_amdgcn_readfirstlane(c.lds0 + L_RING + (slot) * SLOTB + 8192 + c.wid * 1024)); } while (0)
    if (NT > 0) NSA_ISSUE(0, 0);
    if (NT > 1) NSA_ISSUE(1, 1);
    int slot = 0;
    for (int i = 0; i < NT; ++i) {
        if (i + 1 < NT) NSA_WAIT_BAR(2); else NSA_WAIT_BAR(0);
        if (i + 2 < NT) { const int s2 = (slot == 0) ? 2 : slot - 1; NSA_ISSUE(i + 2, s2); }
        const int id = __builtin_amdgcn_readfirstlane(NSA_TID(i));
        f32x16 p0, p1;
        qkt(p0, p1, (lds_cptr)(c.lds3 + L_RING + slot * SLOTB), qr, c.r32, c.hi);
        const int dbase = (MODE == 0) ? (c.tq - 31 - 1024 * id) : (c.tq - 64 * id);
        bool selb = true;
        if (MODE == 1) selb = ((id < 32 ? (mask_lo >> id) : (mask_hi >> (id - 32))) & 1u) != 0u;
#pragma unroll
        for (int r = 0; r < 16; ++r) {
            const int k0 = crow(r, c.hi);
            const int d0 = (MODE == 0) ? (dbase - 16 * k0) : (dbase - k0);
            const int d1 = (MODE == 0) ? (d0 - 512) : (d0 - 32);
            bool v0 = d0 >= 0, v1 = d1 >= 0;
            if (MODE == 2) { v0 = v0 && d0 < WINDOW; v1 = v1 && d1 < WINDOW; }
            if (MODE == 1) { v0 = v0 && selb; v1 = v1 && selb; }
            const int i0 = d0 < 0 ? 0 : (d0 > 790 ? 790 : d0), i1 = d1 < 0 ? 0 : (d1 > 790 ? 790 : d1);
            const float s0 = p0[r] * SC2 + c.bt[i0], s1 = p1[r] * SC2 + c.bt[i1];
            p0[r] = v0 ? s0 : NEG2; p1[r] = v1 ? s1 : NEG2;
        }
        const float mt = rowmax32(p0, p1);
        const float mnew = fmaxf(m, mt);
        const float alpha = __builtin_amdgcn_exp2f(m - mnew);
        m = mnew;
        float rs = 0.f;
#pragma unroll
        for (int r = 0; r < 16; ++r) {
            const float e0 = (p0[r] > -1e29f) ? __builtin_amdgcn_exp2f(p0[r] - mnew) : 0.f;
            const float e1 = (p1[r] > -1e29f) ? __builtin_amdgcn_exp2f(p1[r] - mnew) : 0.f;
            p0[r] = e0; p1[r] = e1; rs += e0 + e1;
        }
        l = l * alpha + rs;
        if (!__all(alpha == 1.f)) {
            if (c.hi == 0) c.wsf[c.r32] = alpha;
            asm volatile("s_waitcnt lgkmcnt(0)" ::: "memory");
#pragma unroll
            for (int r = 0; r < 16; ++r) { const float a = c.wsf[crow(r, c.hi)]; o[0][r] *= a; o[1][r] *= a; if (MODE == 0) { im[0][r] *= a; im[1][r] *= a; } }
        }
        u32x4 pw0, pw1, pw2, pw3;
        pw0 = (u32x4){cvtpk_s(p0[0], p0[1]), cvtpk_s(p0[2], p0[3]), cvtpk_s(p0[4], p0[5]), cvtpk_s(p0[6], p0[7])};
        pw1 = (u32x4){cvtpk_s(p0[8], p0[9]), cvtpk_s(p0[10], p0[11]), cvtpk_s(p0[12], p0[13]), cvtpk_s(p0[14], p0[15])};
        pw2 = (u32x4){cvtpk_s(p1[0], p1[1]), cvtpk_s(p1[2], p1[3]), cvtpk_s(p1[4], p1[5]), cvtpk_s(p1[6], p1[7])};
        pw3 = (u32x4){cvtpk_s(p1[8], p1[9]), cvtpk_s(p1[10], p1[11]), cvtpk_s(p1[12], p1[13]), cvtpk_s(p1[14], p1[15])};
        NSA_SBAR();
        pv(o, (int)(c.lds0 + L_RING + slot * SLOTB + 8192) + c.vboff, __builtin_bit_cast(bf16x8, pw0), __builtin_bit_cast(bf16x8, pw1), __builtin_bit_cast(bf16x8, pw2), __builtin_bit_cast(bf16x8, pw3));
        if (MODE == 0) pv(im, (int)(c.lds0 + L_OV + id * 8192) + c.vboff, __builtin_bit_cast(bf16x8, pw0), __builtin_bit_cast(bf16x8, pw1), __builtin_bit_cast(bf16x8, pw2), __builtin_bit_cast(bf16x8, pw3));
        slot = (slot == 2) ? 0 : slot + 1;
    }
    asm volatile("s_waitcnt vmcnt(0) lgkmcnt(0)\n\ts_barrier" ::: "memory");
#undef NSA_TID
#undef NSA_ISSUE
}

__device__ __forceinline__ void build_ov(lds_ptr lds3) {
    for (int idx = threadIdx.x; idx < 4 * 4096; idx += NTHR) {
        const int kt = idx >> 12, nl = (idx >> 6) & 63, jc = idx & 63, n = 64 * kt + nl;
        unsigned short v = 0;
        if ((n & 3) != 3) { if (jc == (n >> 2)) v = 0x3F80; } else { if (jc == (n >> 2) || jc == (n >> 2) + 1) v = 0x3F00; }
        *(__attribute__((address_space(3))) unsigned short*)(lds3 + L_OV + kt * 8192 + ((jc >> 5) * 4 + (nl >> 4)) * 1024 + (nl & 15) * 64 + (jc & 31) * 2) = v;
    }
}

__device__ __forceinline__ void nsa_unit(int b, int g, int qt, const bf16* PROJ, const bf16* KCBb, const bf16* VCBb, const float* rel, bf16* ONSA, lds_ptr lds3, unsigned lds0) {
    const int tid = threadIdx.x, lane = tid & 63, r32 = lane & 31, hi = lane >> 5;
    const int wid = __builtin_amdgcn_readfirstlane(tid >> 6), hh = wid & 3, th = wid >> 2;
    const int t0 = qt * 64, tq = t0 + 32 * th + r32, cur = qt;
    __attribute__((address_space(3))) float* BT = (__attribute__((address_space(3))) float*)(lds3 + L_BT);
    __attribute__((address_space(3))) unsigned* MASK = (__attribute__((address_space(3))) unsigned*)(lds3 + L_MASK);
    for (int i = tid; i < 4 * BT_N; i += NTHR) { const int hq = i / BT_N, d = i - hq * BT_N; BT[i] = rel[rel_bucket(d) * 16 + g * 4 + hq] * LOG2E; }
    if (tid < 128) MASK[tid] = 0u;
    PassCtx c; c.lds3 = lds3; c.lds0 = lds0; c.lane = lane; c.r32 = r32; c.hi = hi; c.wid = wid; c.tq = tq;
    c.bt = BT + hh * BT_N; c.wsf = (__attribute__((address_space(3))) float*)(lds3 + L_WSF) + wid * 64;
    c.vboff = ((lane >> 4) & 1) * 32 + (lane & 3) * 8 + (4 * hi + ((lane & 15) >> 2)) * 64;
    const size_t qrow = (size_t)(b * SEQ + tq) * PLD;
    bf16x8 qr[4];
#pragma unroll
    for (int d0 = 0; d0 < 4; ++d0) qr[d0] = *(const bf16x8*)(PROJ + qrow + C_QN + (g * 4 + hh) * HD + d0 * 16 + hi * 8);
    const float gate0 = 1.f / (1.f + __expf(-bf2f(PROJ[qrow + C_GBR + 0 * 16 + g * 4 + hh])));
    const float gate1 = 1.f / (1.f + __expf(-bf2f(PROJ[qrow + C_GBR + 1 * 16 + g * 4 + hh])));
    const float gate2 = 1.f / (1.f + __expf(-bf2f(PROJ[qrow + C_GBR + 2 * 16 + g * 4 + hh])));
    asm volatile("s_waitcnt vmcnt(0) lgkmcnt(0)" ::: "memory");
    __syncthreads();
    f32x16 oc[2] = {}, o[2] = {}, im[2] = {};
    float m = NEG2, l = 0.f;
    {
        int cnt = (t0 + 32) / 16 + 1; if (cnt > NCMP) cnt = NCMP;
        const int NT = (cnt + 63) >> 6;
        run_pass<0>(c, NT, 0, KCBb + (size_t)(b * 4 + g) * 256 * HD, VCBb + (size_t)(b * 4 + g) * 256 * HD, HD, qr, 0u, 0u, o, im, m, l);
        const float lt = swap_add(l);
        const float inv = lt > 0.f ? 1.f / lt : 0.f;
        if (hi == 0) { c.wsf[r32] = inv * gate0; c.wsf[32 + r32] = inv; }
        asm volatile("s_waitcnt lgkmcnt(0)" ::: "memory");
#pragma unroll
        for (int r = 0; r < 16; ++r) { const float a = c.wsf[crow(r, hi)], a2 = c.wsf[32 + crow(r, hi)]; oc[0][r] = o[0][r] * a; oc[1][r] = o[1][r] * a; im[0][r] *= a2; im[1][r] *= a2; }
        __attribute__((address_space(3))) float* X = (__attribute__((address_space(3))) float*)(lds3 + L_X);
        const int area = (hh >> 1) * 2 + th;
        if (hh & 1) {
#pragma unroll
            for (int d0 = 0; d0 < 2; ++d0)
#pragma unroll
                for (int r = 0; r < 16; ++r) X[area * 2048 + crow(r, hi) * 64 + d0 * 32 + r32] = im[d0][r];
        }
        asm volatile("s_waitcnt lgkmcnt(0)" ::: "memory"); __syncthreads();
        if (!(hh & 1)) {
#pragma unroll
            for (int d0 = 0; d0 < 2; ++d0)
#pragma unroll
                for (int r = 0; r < 16; ++r) { im[d0][r] += X[area * 2048 + crow(r, hi) * 64 + d0 * 32 + r32]; if (hh == 2) X[area * 2048 + crow(r, hi) * 64 + d0 * 32 + r32] = im[d0][r]; }
        }
        asm volatile("s_waitcnt lgkmcnt(0)" ::: "memory"); __syncthreads();
        __attribute__((address_space(3))) float* T = (__attribute__((address_space(3))) float*)(lds3 + L_RING);
        if (hh == 0) {
#pragma unroll
            for (int d0 = 0; d0 < 2; ++d0)
#pragma unroll
                for (int r = 0; r < 16; ++r) T[(32 * th + crow(r, hi)) * 65 + d0 * 32 + r32] = im[d0][r] + X[(2 + th) * 2048 + crow(r, hi) * 64 + d0 * 32 + r32];
        }
        asm volatile("s_waitcnt lgkmcnt(0)" ::: "memory"); __syncthreads();
        {
            const int tok = tid & 63, jg = wid;
            float v[8]; int rank[8];
#pragma unroll
            for (int e = 0; e < 8; ++e) { const int j = 8 * jg + e; const bool forced = (j == 0) || (cur - j >= 0 && cur - j < 2);
                v[e] = (j <= cur) ? T[tok * 65 + j] + (forced ? 1e4f : 0.f) : -INFINITY; rank[e] = 0; }
            for (int j2 = 0; j2 < 64; ++j2) {
                const bool f2 = (j2 == 0) || (cur - j2 >= 0 && cur - j2 < 2);
                const float sv = (j2 <= cur) ? T[tok * 65 + j2] + (f2 ? 1e4f : 0.f) : -INFINITY;
#pragma unroll
                for (int e = 0; e < 8; ++e) { const int j = 8 * jg + e; rank[e] += (sv > v[e] || (sv == v[e] && j2 < j)) ? 1 : 0; }
            }
            unsigned bits = 0u;
#pragma unroll
            for (int e = 0; e < 8; ++e) { const int j = 8 * jg + e; if (j <= cur && rank[e] < SEL_TOPK) bits |= 1u << e; }
            if (bits) atomicOr((unsigned*)(MASK + tok * 2 + (jg >> 2)), bits << ((jg & 3) * 8));
        }
        asm volatile("s_waitcnt lgkmcnt(0)" ::: "memory"); __syncthreads();
        if (wid == 0) {
            unsigned ulo = MASK[lane * 2], uhi = MASK[lane * 2 + 1];
#pragma unroll
            for (int ofs = 32; ofs >= 1; ofs >>= 1) { ulo |= __shfl_xor(ulo, ofs); uhi |= __shfl_xor(uhi, ofs); }
            if (lane == 0) {
                __attribute__((address_space(3))) unsigned char* TL = (__attribute__((address_space(3))) unsigned char*)(lds3 + L_MISC);
                int n = 0; unsigned long long mm = ((unsigned long long)uhi << 32) | ulo;
                while (mm) { const int bp = __ffsll((long long)mm) - 1; TL[n++] = (unsigned char)bp; mm &= mm - 1; }
                *(__attribute__((address_space(3))) int*)(lds3 + L_MISC + 64) = n;
            }
        }
        asm volatile("s_waitcnt lgkmcnt(0)" ::: "memory"); __syncthreads();
    }
    {
        const unsigned mlo = MASK[(32 * th + r32) * 2], mhi = MASK[(32 * th + r32) * 2 + 1];
        const int NT = __builtin_amdgcn_readfirstlane(*(__attribute__((address_space(3))) int*)(lds3 + L_MISC + 64));
        o[0] = f32x16{}; o[1] = f32x16{}; m = NEG2; l = 0.f;
        run_pass<1>(c, NT, 0, PROJ + (size_t)b * SEQ * PLD + C_KS + g * HD, PROJ + (size_t)b * SEQ * PLD + C_VS + g * HD, PLD, qr, mlo, mhi, o, im, m, l);
        const float lt = swap_add(l);
        const float inv = lt > 0.f ? 1.f / lt : 0.f;
        if (hi == 0) c.wsf[r32] = inv * gate1;
        asm volatile("s_waitcnt lgkmcnt(0)" ::: "memory");
#pragma unroll
        for (int r = 0; r < 16; ++r) { const float a = c.wsf[crow(r, hi)]; oc[0][r] += o[0][r] * a; oc[1][r] += o[1][r] * a; }
    }
    {
        const int jlo = (qt - 8) > 0 ? (qt - 8) : 0, NT = qt - jlo + 1;
        o[0] = f32x16{}; o[1] = f32x16{}; m = NEG2; l = 0.f;
        run_pass<2>(c, NT, jlo, PROJ + (size_t)b * SEQ * PLD + C_KW + g * HD, PROJ + (size_t)b * SEQ * PLD + C_VW + g * HD, PLD, qr, 0u, 0u, o, im, m, l);
        const float lt = swap_add(l);
        const float inv = lt > 0.f ? 1.f / lt : 0.f;
        if (hi == 0) c.wsf[r32] = inv * gate2;
        asm volatile("s_waitcnt lgkmcnt(0)" ::: "memory");
#pragma unroll
        for (int r = 0; r < 16; ++r) { const float a = c.wsf[crow(r, hi)]; oc[0][r] += o[0][r] * a; oc[1][r] += o[1][r] * a; }
    }
    {
        __attribute__((address_space(3))) unsigned short* stg = (__attribute__((address_space(3))) unsigned short*)(lds3 + L_X) + wid * 2048;
#pragma unroll
        for (int r = 0; r < 16; ++r) { const int orow = crow(r, hi);
#pragma unroll
            for (int d0 = 0; d0 < 2; ++d0) stg[orow * 64 + d0 * 32 + r32] = (unsigned short)f2bf(oc[d0][r]); }
        asm volatile("s_waitcnt lgkmcnt(0)" ::: "memory");
        bf16* Ow = ONSA + (size_t)(b * SEQ + t0 + 32 * th) * NSA_Q + (g * 4 + hh) * HD;
#pragma unroll
        for (int i = 0; i < 4; ++i) { const int row = i * 8 + (lane >> 3), ch = lane & 7;
            const u32x4 vv = *(const __attribute__((address_space(3))) u32x4*)(stg + row * 64 + ch * 8);
            *(u32x4*)(Ow + (size_t)row * NSA_Q + ch * 8) = vv; }
    }
    asm volatile("s_waitcnt vmcnt(0) lgkmcnt(0)" ::: "memory");
    __syncthreads();
}

__device__ __forceinline__ void nsa_phase(const bf16* PROJ, const bf16* KCBb, const bf16* VCBb, const float* rel, bf16* ONSA, lds_ptr lds3, int vcu, int G) {
    const unsigned lds0 = (unsigned)(uintptr_t)lds3;
    build_ov(lds3);
    __syncthreads();
    for (int i = vcu; i < 512; i += G) {
        const int k = i & 255, bg = k >> 5, s = k & 31, qt = (i < 256) ? s : 63 - s;
        nsa_unit(bg >> 2, bg & 3, qt, PROJ, KCBb, VCBb, rel, ONSA, lds3, lds0);
    }
}
#undef NSA_WAIT_BAR
#undef NSA_SBAR
}
namespace nsa {
constexpr float STICK_THR = 50.f, LN2F = 0.6931471805599453f;
#define NSA_WAIT_BAR(N) asm volatile("s_waitcnt vmcnt(" #N ") lgkmcnt(0)\n\ts_barrier" ::: "memory")
__device__ __forceinline__ void stick_unit(int tid, int b, int h, int qb, const bf16* PROJ, bf16* OSB, lds_ptr lds3, unsigned lds0, const bf16x8 (&tri)[2]) {
    const int lane = tid & 63, r32 = lane & 31, hi = lane >> 5;
    const int wid = __builtin_amdgcn_readfirstlane(tid >> 6);
    const int q0 = qb * 256, t = q0 + 32 * wid + r32;
    const bf16* Kb = PROJ + (size_t)b * SEQ * PLD + C_KB + h * HD;
    const bf16* Vb = PROJ + (size_t)b * SEQ * PLD + C_VB + h * HD;
    __attribute__((address_space(3))) int* DONE = (__attribute__((address_space(3))) int*)(lds3 + L_MISC);
    bf16x8 qr[4];
#pragma unroll
    for (int d0 = 0; d0 < 4; ++d0) qr[d0] = *(const bf16x8*)(PROJ + (size_t)(b * SEQ + t) * PLD + C_QB + h * HD + d0 * 16 + hi * 8);
    if (tid < 8) DONE[tid] = 0x7fffffff;
    asm volatile("s_waitcnt vmcnt(0) lgkmcnt(0)" ::: "memory");
    __syncthreads();
    const int jhi = 4 * qb + 3, NT = jhi + 1;
    const int jw = (q0 + 32 * wid + 30) >> 6;
    const int vboff = ((lane >> 4) & 1) * 32 + (lane & 3) * 8 + (4 * hi + ((lane & 15) >> 2)) * 64;
    f32x16 o[2] = {};
    float carry = 0.f; bool mydone = false;
#define STK_ISSUE(i, slot) do { const int id_ = jhi - (i); \
        const bf16* ks_ = Kb + (size_t)(64 * id_ + lane) * PLD + 8 * wid; \
        const bf16* vs_ = Vb + (size_t)(64 * id_ + 16 * (wid & 3) + (lane >> 2)) * PLD + 32 * (wid >> 2) + 8 * (lane & 3); \
        glds16(ks_, (unsigned)__builtin_amdgcn_readfirstlane(lds0 + L_RING + (slot) * SLOTB + wid * 1024)); \
        glds16(vs_, (unsigned)__builtin_amdgcn_readfirstlane(lds0 + L_RING + (slot) * SLOTB + 8192 + wid * 1024)); } while (0)
    STK_ISSUE(0, 0);
    if (NT > 1) STK_ISSUE(1, 1);
    int slot = 0;
    for (int i = 0; i < NT; ++i) {
        if (i + 1 < NT) NSA_WAIT_BAR(2); else NSA_WAIT_BAR(0);
        bool alld = true;
#pragma unroll
        for (int w = 0; w < 8; ++w) alld = alld && (DONE[w] < i);
        if (__builtin_amdgcn_readfirstlane((int)alld)) break;
        if (i + 2 < NT) { const int s2 = (slot == 0) ? 2 : slot - 1; STK_ISSUE(i + 2, s2); }
        const int j = jhi - i;
        if (!mydone && j <= jw) {
            f32x16 p0, p1, x0, x1;
            qkt(p0, p1, (lds_cptr)(lds3 + L_RING + slot * SLOTB), qr, r32, hi);
            float s0 = 0.f, s1 = 0.f;
#pragma unroll
            for (int r = 0; r < 16; ++r) {
                const int pos0 = 64 * j + crow(r, hi);
                const float z0 = p0[r] * 0.125f, z1 = p1[r] * 0.125f;
                const float L0 = __builtin_amdgcn_logf(1.f + __builtin_amdgcn_exp2f(-fabsf(z0) * LOG2E)) * LN2F;
                const float L1 = __builtin_amdgcn_logf(1.f + __builtin_amdgcn_exp2f(-fabsf(z1) * LOG2E)) * LN2F;
                p0[r] = fminf(z0, 0.f) - L0; p1[r] = fminf(z1, 0.f) - L1;
                x0[r] = (pos0 < t) ? (-fmaxf(z0, 0.f) - L0) : 0.f; x1[r] = (pos0 + 32 < t) ? (-fmaxf(z1, 0.f) - L1) : 0.f;
                s0 += x0[r]; s1 += x1[r];
            }
            const float tot0 = swap_add(s0), tot1 = swap_add(s1);
            u32x4 h0a, h0b, l0a, l0b, h1a, h1b, l1a, l1b;
#define STK_SPLIT(X, HA, HB, LA, LB) do { unsigned hw_[8]; float lo_[16]; \
                _Pragma("unroll") for (int q_ = 0; q_ < 8; ++q_) { hw_[q_] = cvtpk_s(X[2 * q_], X[2 * q_ + 1]); \
                    lo_[2 * q_] = X[2 * q_] - __uint_as_float(hw_[q_] << 16); lo_[2 * q_ + 1] = X[2 * q_ + 1] - __uint_as_float(hw_[q_] & 0xffff0000u); } \
                HA = (u32x4){hw_[0], hw_[1], hw_[2], hw_[3]}; HB = (u32x4){hw_[4], hw_[5], hw_[6], hw_[7]}; \
                LA = (u32x4){cvtpk_s(lo_[0], lo_[1]), cvtpk_s(lo_[2], lo_[3]), cvtpk_s(lo_[4], lo_[5]), cvtpk_s(lo_[6], lo_[7])}; \
                LB = (u32x4){cvtpk_s(lo_[8], lo_[9]), cvtpk_s(lo_[10], lo_[11]), cvtpk_s(lo_[12], lo_[13]), cvtpk_s(lo_[14], lo_[15])}; } while (0)
            STK_SPLIT(x0, h0a, h0b, l0a, l0b);
            STK_SPLIT(x1, h1a, h1b, l1a, l1b);
#undef STK_SPLIT
            f32x16 y0, y1;
#pragma unroll
            for (int r = 0; r < 16; ++r) { y0[r] = carry + tot1; y1[r] = carry; }
            y0 = __builtin_amdgcn_mfma_f32_32x32x16_bf16(tri[0], __builtin_bit_cast(bf16x8, h0a), y0, 0, 0, 0);
            y0 = __builtin_amdgcn_mfma_f32_32x32x16_bf16(tri[1], __builtin_bit_cast(bf16x8, h0b), y0, 0, 0, 0);
            y0 = __builtin_amdgcn_mfma_f32_32x32x16_bf16(tri[0], __builtin_bit_cast(bf16x8, l0a), y0, 0, 0, 0);
            y0 = __builtin_amdgcn_mfma_f32_32x32x16_bf16(tri[1], __builtin_bit_cast(bf16x8, l0b), y0, 0, 0, 0);
            y1 = __builtin_amdgcn_mfma_f32_32x32x16_bf16(tri[0], __builtin_bit_cast(bf16x8, h1a), y1, 0, 0, 0);
            y1 = __builtin_amdgcn_mfma_f32_32x32x16_bf16(tri[1], __builtin_bit_cast(bf16x8, h1b), y1, 0, 0, 0);
            y1 = __builtin_amdgcn_mfma_f32_32x32x16_bf16(tri[0], __builtin_bit_cast(bf16x8, l1a), y1, 0, 0, 0);
            y1 = __builtin_amdgcn_mfma_f32_32x32x16_bf16(tri[1], __builtin_bit_cast(bf16x8, l1b), y1, 0, 0, 0);
#pragma unroll
            for (int r = 0; r < 16; ++r) {
                const int pos0 = 64 * j + crow(r, hi);
                y0[r] = (pos0 < t) ? __builtin_amdgcn_exp2f((p0[r] + y0[r]) * LOG2E) : 0.f;
                y1[r] = (pos0 + 32 < t) ? __builtin_amdgcn_exp2f((p1[r] + y1[r]) * LOG2E) : 0.f;
            }
            carry += tot0 + tot1;
            u32x4 pw0, pw1, pw2, pw3;
            pw0 = (u32x4){cvtpk_s(y0[0], y0[1]), cvtpk_s(y0[2], y0[3]), cvtpk_s(y0[4], y0[5]), cvtpk_s(y0[6], y0[7])};
            pw1 = (u32x4){cvtpk_s(y0[8], y0[9]), cvtpk_s(y0[10], y0[11]), cvtpk_s(y0[12], y0[13]), cvtpk_s(y0[14], y0[15])};
            pw2 = (u32x4){cvtpk_s(y1[0], y1[1]), cvtpk_s(y1[2], y1[3]), cvtpk_s(y1[4], y1[5]), cvtpk_s(y1[6], y1[7])};
            pw3 = (u32x4){cvtpk_s(y1[8], y1[9]), cvtpk_s(y1[10], y1[11]), cvtpk_s(y1[12], y1[13]), cvtpk_s(y1[14], y1[15])};
            __builtin_amdgcn_sched_barrier(0);
            pv(o, (int)(lds0 + L_RING + slot * SLOTB + 8192) + vboff, __builtin_bit_cast(bf16x8, pw0), __builtin_bit_cast(bf16x8, pw1), __builtin_bit_cast(bf16x8, pw2), __builtin_bit_cast(bf16x8, pw3));
            mydone = __all(carry < -STICK_THR) != 0;
            if (mydone && lane == 0) DONE[wid] = i;
        }
        slot = (slot == 2) ? 0 : slot + 1;
    }
    asm volatile("s_waitcnt vmcnt(0) lgkmcnt(0)\n\ts_barrier" ::: "memory");
#undef STK_ISSUE
    {
        __attribute__((address_space(3))) unsigned short* stg = (__attribute__((address_space(3))) unsigned short*)(lds3 + L_X) + wid * 2048;
#pragma unroll
        for (int r = 0; r < 16; ++r) { const int orow = crow(r, hi);
#pragma unroll
            for (int d0 = 0; d0 < 2; ++d0) stg[orow * 64 + d0 * 32 + r32] = (unsigned short)f2bf(o[d0][r]); }
        asm volatile("s_waitcnt lgkmcnt(0)" ::: "memory");
        bf16* Ow = OSB + (size_t)(b * SEQ + q0 + 32 * wid) * SB_W + h * HD;
#pragma unroll
        for (int i = 0; i < 4; ++i) { const int row = i * 8 + (lane >> 3), ch = lane & 7;
            const u32x4 vv = *(const __attribute__((address_space(3))) u32x4*)(stg + row * 64 + ch * 8);
            *(u32x4*)(Ow + (size_t)row * SB_W + ch * 8) = vv; }
    }
    asm volatile("s_waitcnt vmcnt(0) lgkmcnt(0)" ::: "memory");
    __syncthreads();
}
__device__ __forceinline__ void stick_phase(const bf16* PROJ, bf16* OSB, lds_ptr lds3, int vcu, int G) {
    const unsigned lds0 = (unsigned)(uintptr_t)lds3;
    int tid = threadIdx.x; asm volatile("" : "+v"(tid));
    const int lane = tid & 63, r32 = lane & 31, hi = lane >> 5;
    bf16x8 tri[2];
#pragma unroll
    for (int s = 0; s < 2; ++s)
#pragma unroll
        for (int j = 0; j < 8; ++j) tri[s][j] = ((16 * s + 8 * (j >> 2) + 4 * hi + (j & 3)) > r32) ? (short)0x3F80 : (short)0;
    for (int i = vcu; i < 512; i += G) {
        const int bh = i >> 4, qb = i & 15;
        stick_unit(tid, bh >> 4, bh & 15, qb, PROJ, OSB, lds3, lds0, tri);
    }
}
#undef NSA_WAIT_BAR
}
namespace peer {
typedef short bf16x8 __attribute__((ext_vector_type(8)));
typedef float f32x16 __attribute__((ext_vector_type(16)));
typedef __bf16 b2_t __attribute__((ext_vector_type(2)));
constexpr int L_EX = 0, L_GT = 16384;
__device__ __forceinline__ int crow(int r, int hi) { return (r & 3) + 8 * (r >> 2) + 4 * hi; }
__device__ __forceinline__ unsigned mono(float f) { const unsigned u = __float_as_uint(f); return (u & 0x80000000u) ? ~u : (u | 0x80000000u); }
__device__ __forceinline__ float unmono(unsigned k) { return __uint_as_float((k & 0x80000000u) ? (k & 0x7fffffffu) : ~k); }
__device__ __forceinline__ float dot2(unsigned a, unsigned b, float c) { return __builtin_amdgcn_fdot2_f32_bf16(__builtin_bit_cast(b2_t, a), __builtin_bit_cast(b2_t, b), c, false); }
#define PEER_CE(key, slot) do { const unsigned hi_ = (key) > (slot) ? (key) : (slot); (key) = (key) > (slot) ? (slot) : (key); (slot) = hi_; } while (0)

__device__ __forceinline__ void route_list(const bf16* QP, const bf16* SKB, int L, int tok0, int r32, int hi, unsigned (&out)[16]) {
    f32x16 acc[4] = {};
    const bf16* qp = QP + (size_t)(tok0 + r32) * 2048 + L * 128 + hi * 8;
    const bf16* kp = SKB + ((size_t)L * 128 + r32) * 128 + hi * 8;
    int hi4 = 4 * hi;
    asm volatile("" : "+v"(qp), "+v"(kp), "+v"(hi4));
#pragma unroll
    for (int ks = 0; ks < 8; ++ks) {
        const bf16x8 bq = *(const bf16x8*)(qp + ks * 16);
#pragma unroll
        for (int kt = 0; kt < 4; ++kt) { const bf16x8 a = *(const bf16x8*)(kp + (size_t)kt * 32 * 128 + ks * 16); acc[kt] = __builtin_amdgcn_mfma_f32_32x32x16_bf16(a, bq, acc[kt], 0, 0, 0); }
    }
    unsigned t[16];
#pragma unroll
    for (int k = 0; k < 16; ++k) t[k] = 0u;
#pragma unroll
    for (int kt = 0; kt < 4; ++kt)
#pragma unroll
        for (int r = 0; r < 16; ++r) {
            unsigned key = ((mono(acc[kt][r]) & ~127u) | (unsigned)(127 - (32 * kt + (r & 3) + 8 * (r >> 2)))) - (unsigned)hi4;
#pragma unroll
            for (int k = 0; k < 16; ++k) PEER_CE(key, t[k]);
            __builtin_amdgcn_sched_barrier(0);
        }
    unsigned u[16];
#pragma unroll
    for (int k = 0; k < 16; ++k) { auto rr = __builtin_amdgcn_permlane32_swap(t[k], t[k], false, false); u[k] = hi ? rr[0] : rr[1]; }
#pragma unroll
    for (int k = 0; k < 16; ++k) out[k] = t[k] > u[15 - k] ? t[k] : u[15 - k];
#pragma unroll
    for (int st = 8; st >= 1; st >>= 1)
#pragma unroll
        for (int k = 0; k < 16; ++k) if ((k & st) == 0) { const unsigned a = out[k], b = out[k | st]; out[k] = a > b ? a : b; out[k | st] = a > b ? b : a; }
}

__device__ __forceinline__ void route_head(const bf16* QP, const bf16* SKB, int h, int tok0, int lane, __attribute__((address_space(3))) unsigned char* lds3) {
    asm volatile("" : "+v"(lane));
    const int r32 = lane & 31, hi = lane >> 5;
    unsigned A[16], B[16];
    route_list(QP, SKB, 2 * h, tok0, r32, hi, A);
    route_list(QP, SKB, 2 * h + 1, tok0, r32, hi, B);
    float va[16], vb[16]; int ia[16], ib[16];
#pragma unroll
    for (int k = 0; k < 16; ++k) { va[k] = unmono((A[k] & ~127u) | 64u); vb[k] = unmono((B[k] & ~127u) | 64u); ia[k] = 127 - (int)(A[k] & 127u); ib[k] = 127 - (int)(B[k] & 127u); }
    unsigned s[16], sp[16];
#pragma unroll
    for (int k = 0; k < 16; ++k) { s[k] = 0u; sp[k] = 0u; }
#pragma unroll
    for (int i = 0; i < 16; ++i)
#pragma unroll
        for (int j = 0; j < 16; ++j) if ((i + 1) * (j + 1) <= 16) {
            unsigned key = mono(va[i] + vb[j]); unsigned pay = (unsigned)(ia[i] * PEER_KEYS + ib[j]);
#pragma unroll
            for (int k = (i + 1) * (j + 1) - 1; k < 16; ++k) { const bool gt = key > s[k]; const unsigned ts = s[k], tp = sp[k]; s[k] = gt ? key : ts; sp[k] = gt ? pay : tp; key = gt ? ts : key; pay = gt ? tp : pay; }
            __builtin_amdgcn_sched_barrier(0);
        }
    const float mx = unmono(s[0]);
    float e[16], sum = 0.f;
#pragma unroll
    for (int k = 0; k < 16; ++k) { e[k] = __expf(unmono(s[k]) - mx); sum += e[k]; }
    const float inv = 1.f / sum;
    if (hi == 0) {
        __attribute__((address_space(3))) int* EX = (__attribute__((address_space(3))) int*)(lds3 + L_EX);
        __attribute__((address_space(3))) float* GT = (__attribute__((address_space(3))) float*)(lds3 + L_GT);
#pragma unroll
        for (int k = 0; k < 16; ++k) { EX[(h * 16 + k) * 32 + r32] = (int)sp[k]; GT[(h * 16 + k) * 32 + r32] = e[k] * inv; }
    }
}

__device__ __forceinline__ void ffn_token(int n, int tl, const float* H, const float* SS, const float* gffn, const bf16* UB, const bf16* VB, const float* gfin, float* out,
                                          int lane, __attribute__((address_space(3))) unsigned char* lds3) {
    const __attribute__((address_space(3))) int* EX = (const __attribute__((address_space(3))) int*)(lds3 + L_EX);
    const __attribute__((address_space(3))) float* GT = (const __attribute__((address_space(3))) float*)(lds3 + L_GT);
    const float rstd = rsqrtf(SS[n] * (1.f / D_MODEL) + EPS);
    unsigned xq[16];
#pragma unroll
    for (int j = 0; j < 4; ++j) {
        const float* hp = H + (size_t)n * 2048 + j * 512 + lane * 8; const float* gp = gffn + j * 512 + lane * 8;
        const f32x4 a = *(const f32x4*)hp, b = *(const f32x4*)(hp + 4), ga = *(const f32x4*)gp, gb = *(const f32x4*)(gp + 4);
        xq[4 * j + 0] = pk2(a.x * rstd * ga.x, a.y * rstd * ga.y); xq[4 * j + 1] = pk2(a.z * rstd * ga.z, a.w * rstd * ga.w);
        xq[4 * j + 2] = pk2(b.x * rstd * gb.x, b.y * rstd * gb.y); xq[4 * j + 3] = pk2(b.z * rstd * gb.z, b.w * rstd * gb.w);
    }
    float acc[32];
#pragma unroll
    for (int j = 0; j < 32; ++j) acc[j] = 0.f;
#pragma unroll 1
    for (int e0 = 0; e0 < PEER_E; e0 += 4) {
        int ei[4]; float gt[4];
#pragma unroll
        for (int k = 0; k < 4; ++k) { ei[k] = __builtin_amdgcn_readfirstlane(EX[(e0 + k) * 32 + tl]); gt[k] = __uint_as_float(__builtin_amdgcn_readfirstlane(__float_as_uint(GT[(e0 + k) * 32 + tl]))); }
        float d[4];
#pragma unroll
        for (int k = 0; k < 4; ++k) {
            const bf16* ur = UB + (size_t)ei[k] * 2048 + lane * 8; float dk = 0.f;
#pragma unroll
            for (int j = 0; j < 4; ++j) { const v4u u4 = *(const v4u*)(ur + j * 512);
                dk = dot2(xq[4 * j + 0], u4.x, dk);
                dk = dot2(xq[4 * j + 1], u4.y, dk);
                dk = dot2(xq[4 * j + 2], u4.z, dk);
                dk = dot2(xq[4 * j + 3], u4.w, dk); }
            d[k] = dk;
        }
        const bool b5 = (lane & 32) != 0, b4 = (lane & 16) != 0;
        float a01 = (b5 ? d[1] : d[0]) + __shfl_xor(b5 ? d[0] : d[1], 32);
        float a23 = (b5 ? d[3] : d[2]) + __shfl_xor(b5 ? d[2] : d[3], 32);
        float t = (b4 ? a23 : a01) + __shfl_xor(b4 ? a01 : a23, 16);
        t += __shfl_xor(t, 8); t += __shfl_xor(t, 4); t += __shfl_xor(t, 2); t += __shfl_xor(t, 1);
        const float gsel = b5 ? (b4 ? gt[3] : gt[1]) : (b4 ? gt[2] : gt[0]);
        const float wv = gsel * gelu_tanh(t);
        float w[4];
        w[0] = __uint_as_float(__builtin_amdgcn_readlane(__float_as_uint(wv), 0));
        w[2] = __uint_as_float(__builtin_amdgcn_readlane(__float_as_uint(wv), 16));
        w[1] = __uint_as_float(__builtin_amdgcn_readlane(__float_as_uint(wv), 32));
        w[3] = __uint_as_float(__builtin_amdgcn_readlane(__float_as_uint(wv), 48));
#pragma unroll
        for (int k = 0; k < 4; ++k) {
            const bf16* vr = VB + (size_t)ei[k] * 2048 + lane * 8;
#pragma unroll
            for (int j = 0; j < 4; ++j) { const v4u v4 = *(const v4u*)(vr + j * 512);
                acc[8 * j + 0] += w[k] * bflo(v4.x); acc[8 * j + 1] += w[k] * bfhi(v4.x); acc[8 * j + 2] += w[k] * bflo(v4.y); acc[8 * j + 3] += w[k] * bfhi(v4.y);
                acc[8 * j + 4] += w[k] * bflo(v4.z); acc[8 * j + 5] += w[k] * bfhi(v4.z); acc[8 * j + 6] += w[k] * bflo(v4.w); acc[8 * j + 7] += w[k] * bfhi(v4.w); }
        }
    }
    float sq = 0.f;
#pragma unroll
    for (int j = 0; j < 4; ++j) {
        const float* hp = H + (size_t)n * 2048 + j * 512 + lane * 8;
        const f32x4 a = *(const f32x4*)hp, b = *(const f32x4*)(hp + 4);
        acc[8 * j + 0] += a.x; acc[8 * j + 1] += a.y; acc[8 * j + 2] += a.z; acc[8 * j + 3] += a.w; acc[8 * j + 4] += b.x; acc[8 * j + 5] += b.y; acc[8 * j + 6] += b.z; acc[8 * j + 7] += b.w;
#pragma unroll
        for (int e = 0; e < 8; ++e) sq += acc[8 * j + e] * acc[8 * j + e];
    }
    const float r = rsqrtf(wave_sum(sq) * (1.f / D_MODEL) + EPS);
#pragma unroll
    for (int j = 0; j < 4; ++j) {
        const float* gp = gfin + j * 512 + lane * 8; float* op = out + (size_t)n * 2048 + j * 512 + lane * 8;
        const f32x4 ga = *(const f32x4*)gp, gb = *(const f32x4*)(gp + 4);
        *(f32x4*)op = (f32x4){acc[8 * j + 0] * r * ga.x, acc[8 * j + 1] * r * ga.y, acc[8 * j + 2] * r * ga.z, acc[8 * j + 3] * r * ga.w};
        *(f32x4*)(op + 4) = (f32x4){acc[8 * j + 4] * r * gb.x, acc[8 * j + 5] * r * gb.y, acc[8 * j + 6] * r * gb.z, acc[8 * j + 7] * r * gb.w};
    }
}

__device__ __forceinline__ void peer_phase(const bf16* QP, const bf16* SKB, const float* H, const float* SS, const float* gffn, const bf16* UB, const bf16* VB, const float* gfin, float* out,
                                           __attribute__((address_space(3))) unsigned char* lds3, int bid, int G) {
    const int lane = threadIdx.x & 63, wid = __builtin_amdgcn_readfirstlane(threadIdx.x >> 6);
    for (int unit = bid; unit < NTOK / 32; unit += G) {
        const int tok0 = unit * 32;
        route_head(QP, SKB, wid, tok0, lane, lds3);
        asm volatile("s_waitcnt lgkmcnt(0)" ::: "memory"); __syncthreads();
#pragma unroll 1
        for (int tk = 0; tk < 4; ++tk) ffn_token(tok0 + wid * 4 + tk, wid * 4 + tk, H, SS, gffn, UB, VB, gfin, out, lane, lds3);
        __syncthreads();
    }
}
__device__ __forceinline__ void route_only_phase(const bf16* QP, const bf16* SKB, int* EXPERT, float* GATE, __attribute__((address_space(3))) unsigned char* lds3, int bid, int G) {
    const int lane = threadIdx.x & 63, wid = __builtin_amdgcn_readfirstlane(threadIdx.x >> 6);
    for (int unit = bid; unit < NTOK / 32; unit += G) {
        const int tok0 = unit * 32;
        route_head(QP, SKB, wid, tok0, lane, lds3);
        asm volatile("s_waitcnt lgkmcnt(0)" ::: "memory"); __syncthreads();
        const __attribute__((address_space(3))) int* EX = (const __attribute__((address_space(3))) int*)(lds3 + L_EX);
        const __attribute__((address_space(3))) float* GT = (const __attribute__((address_space(3))) float*)(lds3 + L_GT);
        for (int i = threadIdx.x; i < 32 * 128; i += NTHR) { const int tl = i >> 7, slot = i & 127; EXPERT[(size_t)(tok0 + tl) * PEER_E + slot] = EX[slot * 32 + tl]; GATE[(size_t)(tok0 + tl) * PEER_E + slot] = GT[slot * 32 + tl]; }
        __syncthreads();
    }
}
__device__ __forceinline__ void ffn_only_phase(const int* EXPERT, const float* GATE, const float* H, const float* SS, const float* gffn, const bf16* UB, const bf16* VB, const float* gfin, float* out,
                                           __attribute__((address_space(3))) unsigned char* lds3, int bid, int G) {
    const int lane = threadIdx.x & 63, wid = __builtin_amdgcn_readfirstlane(threadIdx.x >> 6);
    for (int unit = bid; unit < NTOK / 32; unit += G) {
        const int tok0 = unit * 32;
        __attribute__((address_space(3))) int* EX = (__attribute__((address_space(3))) int*)(lds3 + L_EX);
        __attribute__((address_space(3))) float* GT = (__attribute__((address_space(3))) float*)(lds3 + L_GT);
        for (int i = threadIdx.x; i < 32 * 128; i += NTHR) { const int tl = i >> 7, slot = i & 127; EX[slot * 32 + tl] = EXPERT[(size_t)(tok0 + tl) * PEER_E + slot]; GT[slot * 32 + tl] = GATE[(size_t)(tok0 + tl) * PEER_E + slot]; }
        asm volatile("s_waitcnt lgkmcnt(0)" ::: "memory"); __syncthreads();
#pragma unroll 1
        for (int tk = 0; tk < 4; ++tk) ffn_token(tok0 + wid * 4 + tk, wid * 4 + tk, H, SS, gffn, UB, VB, gfin, out, lane, lds3);
        __syncthreads();
    }
}
#undef PEER_CE
}
constexpr int RING_BYTES = 131072, LDSCTL_OFF = RING_BYTES, MISC_OFF = LDSCTL_OFF + 320, LDS_BYTES = 147456;
constexpr int N_PHASES = 8;
#ifndef MK_N_LAUNCHES
#define MK_N_LAUNCHES 1
#endif

__global__ void __launch_bounds__(NTHR, 2) fwd_megakernel(Args args) {
    extern __shared__ __attribute__((aligned(16))) unsigned char lds[];
    LAS unsigned char* lds3 = (LAS unsigned char*)lds;
    const int tid = threadIdx.x, lane = tid & 63, wave = __builtin_amdgcn_readfirstlane(tid >> 6);
    const int G = gridDim.x, bid = blockIdx.x;
    unsigned char* ws = args.ws;
    unsigned* ctl = (unsigned*)(ws + WS_CTL);
    const float* x = args.in[0];
    bf16* WinT = (bf16*)(ws + WS_WIN); bf16* WbnT = (bf16*)(ws + WS_WBN); bf16* WbsT = (bf16*)(ws + WS_WBS); bf16* WoutT = (bf16*)(ws + WS_WOUT); bf16* WpqT = (bf16*)(ws + WS_WPQ);
    bf16* XN = (bf16*)(ws + WS_XN); bf16* MERGED = XN; bf16* PROJ = (bf16*)(ws + WS_PROJ);
    bf16* ONSA = (bf16*)(ws + WS_ONSA); bf16* OSB = (bf16*)(ws + WS_OSB);
    float* H = (float*)(ws + WS_H); bf16* HB = (bf16*)(ws + WS_HB);
    bf16* UB = (bf16*)(ws + WS_UB); bf16* VB = (bf16*)(ws + WS_VB); bf16* QP = (bf16*)(ws + WS_QP);
    int* EXPERT = (int*)(ws + WS_EXP); float* GATE = (float*)(ws + WS_GATE);
    bf16* KCB = (bf16*)(ws + WS_MISC + MISC_KCB); bf16* VCB = (bf16*)(ws + WS_MISC + MISC_VCB);
    float* SS = (float*)(ctl + CW_SS);
    bf16* SKB = (bf16*)(ws + WS_MISC + MISC_SKB);

    for (int u = tid; u < (LDS_BYTES - LDSCTL_OFF) / 4; u += NTHR) ((LAS unsigned*)(lds3 + LDSCTL_OFF))[u] = 0u;
    __syncthreads();
    const int lo = args.ph_lo, hi = args.ph_hi;
    XcdBarrier bar; bar.bar = ctl + CW_BAR; bar.x = 0; bar.st = nullptr;
    if (hi - lo > 1) bar = xcd_barrier_post(ctl + CW_BAR, (volatile LAS unsigned*)(lds3 + MISC_OFF) + 8);
#define IN(k) (lo <= (k) && (k) < hi)
#define SEAM(k) do { if (IN(k) && IN((k) + 1)) xcd_barrier(bar); } while (0)
    const int gw = bid * NWAVES + wave, NGW = G * NWAVES;
    const int vcu = (G % 8 == 0) ? (bid % 8) * (G / 8) + bid / 8 : bid;

    if (IN(0)) {
        LAS float* scr = (LAS float*)(lds3 + wave * 16384);
        constexpr int I_IN = (D_MODEL / 64) * ((IN_COLS + 31) / 32), I_BR = (1024 / 64) * (D_MODEL / 32), I_SQ = (D_MODEL / 64) * (D_MODEL / 32);
        constexpr int NITEMS = I_IN + 2 * I_BR + 2 * I_SQ;
        for (int it = gw; it < NITEMS; it += NGW) {
            int r = it;
            if (r < I_IN) { p0_transpose_item(args.in[2], D_MODEL, IN_COLS, WinT, nullptr, scr, r, lane); continue; } r -= I_IN;
            if (r < I_BR) { p0_transpose_item(args.in[10], 1024, D_MODEL, WbnT, nullptr, scr, r, lane); continue; } r -= I_BR;
            if (r < I_BR) { p0_transpose_item(args.in[11], 1024, D_MODEL, WbsT, nullptr, scr, r, lane); continue; } r -= I_BR;
            if (r < I_SQ) { p0_transpose_item(args.in[12], D_MODEL, D_MODEL, WoutT, nullptr, scr, r, lane); continue; } r -= I_SQ;
            p0_transpose_item(args.in[14], D_MODEL, D_MODEL, WpqT, args.in[13], scr, r, lane);
        }
        {
            v4u z = {0u, 0u, 0u, 0u}; bf16* p = WinT + (size_t)IN_COLS * D_MODEL; const size_t nz = (size_t)(PLD - IN_COLS) * D_MODEL;
            for (size_t i = ((size_t)bid * NTHR + tid) * 8; i < nz; i += (size_t)G * NTHR * 8) *(v4u*)(p + i) = z;
        }
        cvt_flat(args.in[15], SKB, (size_t)16 * 128 * 128, (size_t)bid * NTHR + tid, (size_t)G * NTHR);
        for (int m = gw; m < NTOK; m += NGW) rms_row_to_bf16(x + (size_t)m * D_MODEL, args.in[1], XN + (size_t)m * D_MODEL, lane);
    }
    SEAM(0);
    if (IN(1)) {
        pg8::Gemm g{XN, WinT, NTOK, PLD, D_MODEL}; pg8::StaticOrder S; S.init(NTOK, PLD, G, bid);
        pg8::EpiBf16<0> E{PROJ, PLD, nullptr, 0, 0, 1.f};
        pg8::gemm_phase<pg8::EpiBf16<0>, pg8::StaticOrder, true, true>(lds3, g, S, E);
    }
    SEAM(1);
    if (IN(2)) ph_compress_naive(PROJ, args.in, KCB, VCB, (float*)lds, bid, G);
    SEAM(2);
    if (IN(3)) {
        nsa::nsa_phase(PROJ, KCB, VCB, args.in[9], ONSA, lds3, vcu, G);
        nsa::stick_phase(PROJ, OSB, lds3, vcu, G);
    }
    SEAM(3);
    if (IN(4)) {
        { pg8::Gemm g{ONSA, WbnT, NTOK, D_MODEL, 1024}; pg8::StaticOrder S; S.init(NTOK, D_MODEL, G, bid);
          pg8::EpiGate<0> E{MERGED, D_MODEL, PROJ + C_GA, PLD};
          pg8::gemm_phase<pg8::EpiGate<0>, pg8::StaticOrder, false, true>(lds3, g, S, E); }
        { pg8::Gemm g{OSB, WbsT, NTOK, D_MODEL, 1024}; pg8::StaticOrder S; S.init(NTOK, D_MODEL, G, bid);
          pg8::EpiGate<1> E{MERGED, D_MODEL, PROJ + C_GB, PLD};
          pg8::gemm_phase<pg8::EpiGate<1>, pg8::StaticOrder, false, true>(lds3, g, S, E); }
    }
    SEAM(4);
    if (IN(5)) {
        { pg8::Gemm g{MERGED, WoutT, NTOK, D_MODEL, D_MODEL}; pg8::StaticOrder S; S.init(NTOK, D_MODEL, G, bid);
          pg8::EpiResid E{x, H, HB, SS, D_MODEL};
          pg8::gemm_phase<pg8::EpiResid, pg8::StaticOrder, false, true>(lds3, g, S, E); }
        const size_t ne = (size_t)16384 * 2048;
        cvt_flat(args.in[16], UB, ne, (size_t)bid * NTHR + tid, (size_t)G * NTHR);
        cvt_flat(args.in[17], VB, ne, (size_t)bid * NTHR + tid, (size_t)G * NTHR);
    }
    SEAM(5);
    if (IN(6)) {
        pg8::Gemm g{HB, WpqT, NTOK, D_MODEL, D_MODEL}; pg8::StaticOrder S; S.init(NTOK, D_MODEL, G, bid);
        pg8::EpiRowScale E{QP, D_MODEL, SS, 1.f / D_MODEL, EPS};
        pg8::gemm_phase<pg8::EpiRowScale, pg8::StaticOrder, false, true>(lds3, g, S, E);
    }
    SEAM(6);
    if (IN(7)) {
        peer::peer_phase(QP, SKB, H, SS, args.in[13], UB, VB, args.in[18], args.out, lds3, bid, G);
    }
#undef IN
#undef SEAM
}

#if defined(DBG_FFN) || defined(DBG_ROUTE)
__global__ void __launch_bounds__(NTHR, 2) dbg_route(Args args) {
    extern __shared__ __attribute__((aligned(16))) unsigned char lds[];
    unsigned char* ws = args.ws;
    bf16* QP = (bf16*)(ws + WS_QP); int* EXPERT = (int*)(ws + WS_EXP); float* GATE = (float*)(ws + WS_GATE); bf16* SKB = (bf16*)(ws + WS_MISC + MISC_SKB);
#if defined(DBG_ROUTE)
    peer::route_only_phase(QP, SKB, EXPERT, GATE, (LAS unsigned char*)lds, blockIdx.x, gridDim.x);
#else
    ph_route_naive(QP, args.in[15], EXPERT, GATE, (float*)lds, blockIdx.x, gridDim.x);
#endif
}
__global__ void __launch_bounds__(NTHR, 2) dbg_ffn(Args args) {
    extern __shared__ __attribute__((aligned(16))) unsigned char lds[];
    unsigned char* ws = args.ws;
    int* EXPERT = (int*)(ws + WS_EXP); float* GATE = (float*)(ws + WS_GATE); float* H = (float*)(ws + WS_H); float* SS = (float*)((unsigned*)(ws + WS_CTL) + CW_SS);
    bf16* UB = (bf16*)(ws + WS_UB); bf16* VB = (bf16*)(ws + WS_VB);
#if defined(DBG_ROUTE)
    ph_ffn_naive(H, SS, args.in[13], EXPERT, GATE, UB, VB, args.in[18], args.out, (float*)lds, blockIdx.x, gridDim.x);
#else
    peer::ffn_only_phase(EXPERT, GATE, H, SS, args.in[13], UB, VB, args.in[18], args.out, (LAS unsigned char*)lds, blockIdx.x, gridDim.x);
#endif
}
#endif
extern "C" void kernel_launch(void* const* d_in, const int* in_sizes, int n_in, void* d_out, int out_size, void* d_ws, size_t ws_size, hipStream_t stream) {
    static int grid = 0;
    if (grid == 0) {
        if (n_in != 19 || ws_size < WS_END) { fprintf(stderr, "kernel_launch: unexpected inputs (%d) or workspace (%zu < %zu)\n", n_in, ws_size, (size_t)WS_END); grid = -1; return; }
        int dev = 0, cus = 0, per_cu = 0;
        hipGetDevice(&dev); hipDeviceGetAttribute(&cus, hipDeviceAttributeMultiprocessorCount, dev);
        if (hipFuncSetAttribute((const void*)fwd_megakernel, hipFuncAttributeMaxDynamicSharedMemorySize, LDS_BYTES) != hipSuccess) { fprintf(stderr, "hipFuncSetAttribute failed\n"); grid = -1; return; }
        if (hipOccupancyMaxActiveBlocksPerMultiprocessor(&per_cu, (const void*)fwd_megakernel, NTHR, LDS_BYTES) != hipSuccess || per_cu < 1) { fprintf(stderr, "occupancy query: %d\n", per_cu); per_cu = 1; }
        (void)hipGetLastError();
        grid = cus;
        if (grid > cus * per_cu) grid = cus * per_cu;
    }
    if (grid < 0) return;
    hipMemsetAsync((char*)d_ws + WS_CTL, 0, CTL_ZERO_BYTES, stream);
    Args a{};
    for (int i = 0; i < 19; ++i) a.in[i] = (const float*)d_in[i];
    a.out = (float*)d_out; a.ws = (unsigned char*)d_ws;
#if defined(DBG_FFN) || defined(DBG_ROUTE)
    {
        a.ph_lo = 0; a.ph_hi = N_PHASES - 1;
        void* kargs[] = {&a};
        (void)hipFuncSetAttribute((const void*)dbg_route, hipFuncAttributeMaxDynamicSharedMemorySize, LDS_BYTES);
        (void)hipFuncSetAttribute((const void*)dbg_ffn, hipFuncAttributeMaxDynamicSharedMemorySize, LDS_BYTES);
        (void)hipLaunchCooperativeKernel((const void*)fwd_megakernel, dim3(grid), dim3(NTHR), kargs, LDS_BYTES, stream);
        hipLaunchKernelGGL(dbg_route, dim3(grid), dim3(NTHR), LDS_BYTES, stream, a);
        hipLaunchKernelGGL(dbg_ffn, dim3(grid), dim3(NTHR), LDS_BYTES, stream, a);
        return;
    }
#endif
    if (MK_N_LAUNCHES == 1) {
        a.ph_lo = 0; a.ph_hi = N_PHASES;
        void* kargs[] = {&a};
        hipError_t e = hipLaunchCooperativeKernel((const void*)fwd_megakernel, dim3(grid), dim3(NTHR), kargs, LDS_BYTES, stream);
        if (e != hipSuccess) fprintf(stderr, "cooperative launch failed: %s (grid %d)\n", hipGetErrorString(e), grid);
    } else {
        for (int p = 0; p < N_PHASES; ++p) { a.ph_lo = p; a.ph_hi = p + 1; hipLaunchKernelGGL(fwd_megakernel, dim3(grid), dim3(NTHR), LDS_BYTES, stream, a); }
    }
}
```

```cpp
#include <hip/hip_runtime.h>
#include <cstdio>
#include <cstdint>
#include <cmath>
namespace pg8 {
#define PG8_LAS __attribute__((address_space(3)))
typedef unsigned short bf16_t;
typedef short bf16x8 __attribute__((ext_vector_type(8)));
typedef float f32x4 __attribute__((ext_vector_type(4)));
typedef unsigned u32x4 __attribute__((ext_vector_type(4)));
constexpr int BM = 256, BK = 64, HALF = 128, HTB = HALF * BK * 2  , STAGE_BYTES = 8 * HTB, NXCD = 8, WGM = 8;

__host__ __device__ __forceinline__ int lds_byte(int r, int c) { const int st = (r >> 4) * 2 + (c >> 5), rr = r & 15, cc = c & 31, ob = rr * 64 + cc * 2; return st * 1024 + (ob ^ (((ob >> 9) & 1) << 5)); }
__host__ __device__ __forceinline__ void stage_rc(int b, int& R, int& C) { const int st = b / 1024, sb = b % 1024, swz = sb ^ (((sb >> 9) & 1) << 5); R = (st >> 1) * 16 + swz / 64; C = (st & 1) * 32 + (swz % 64) / 2; }
__host__ __device__ __forceinline__ int perm32(int rho) { const int n = rho >> 4, i = rho & 15; return 8 * (i >> 2) + 4 * n + (i & 3); }

struct Unit { int pm, pn; };
struct Gemm { const bf16_t* A; const bf16_t* Bt; int M, N, K; };

struct StaticOrder {
    int nM, nN, nwg, G, c;
    __host__ __device__ void init(int M, int N, int G_, int c_) { nM = M / BM; nN = N / BM; nwg = nM * nN; G = G_; c = c_; }
    __host__ __device__ bool next(int i, Unit& u) const {
        const long L = (long)i * G + c; if (L >= nwg) return false;
        int wgid = (int)L; { const int q = nwg / NXCD, r = nwg % NXCD, xcd = wgid % NXCD, off = wgid / NXCD; wgid = (xcd < r ? xcd * (q + 1) : r * (q + 1) + (xcd - r) * q) + off; }
        const int nig = WGM * nN, gid = wgid / nig, fm = gid * WGM, gsz = (nM - fm) < WGM ? (nM - fm) : WGM;
        u.pm = fm + ((wgid % nig) % gsz); u.pn = (wgid % nig) / gsz; return true;
    }
    __device__ __forceinline__ void a_ready(const Unit&) const {}
    __device__ __forceinline__ void done(const Unit&) const {}
};

__device__ __forceinline__ unsigned cvt_pk_bf16(float lo, float hi) { unsigned r; asm volatile("v_cvt_pk_bf16_f32 %0, %1, %2" : "=v"(r) : "v"(lo), "v"(hi)); return r; }
typedef float f32x2 __attribute__((ext_vector_type(2)));
__device__ __forceinline__ f32x2 gelu_pk(f32x2 v) {
    const f32x2 av = __builtin_elementwise_abs(v), d = av * 0.2316418882f + 1.0f;
    f32x2 t; t.x = __builtin_amdgcn_rcpf(d.x); t.y = __builtin_amdgcn_rcpf(d.y);
    f32x2 q = t * 0.5307027145f + (-0.7265760135f); q = q * t + 0.7107068705f; q = q * t + (-0.142248368f); q = q * t + 0.127414796f; q = q * t;
    const f32x2 s = (v * v) * (-0.72134752044f);
    f32x2 e; e.x = __builtin_amdgcn_exp2f(s.x); e.y = __builtin_amdgcn_exp2f(s.y);
    const f32x2 m = v * (q * e), r = v - m;
    f32x2 o; o.x = v.x < 0.f ? m.x : r.x; o.y = v.y < 0.f ? m.y : r.y; return o;
}

template <int ACT  > struct EpiBf16 {
    static constexpr bool PERM = true, AFTER_DRAIN = false; static_assert(ACT == 0 || ACT == 1, "EpiBf16: ACT is 0 (none) or 1 (gelu_pk)");
    bf16_t* O; int ldc; const float* bias; int split_cols; size_t split_stride; float scale0;
    __device__ __forceinline__ void operator()(const f32x4 (&acc)[2][2][4][2], const Unit& u, int wr, int wc, int fr, int fq) const {
        const int row0 = u.pm * BM + wr * 64 + fr; int colt = u.pn * BM; bf16_t* base = O;
        float sc = 1.f; if (split_cols) { const int t = colt / split_cols; base += (size_t)t * split_stride; colt -= t * split_cols; if (t == 0) sc = scale0; }
        const int col0 = colt + wc * 32 + 8 * fq, bcol0 = u.pn * BM + wc * 32 + 8 * fq;
        f32x4 bv[2][2];
#pragma unroll
        for (int bj = 0; bj < 2; ++bj)
#pragma unroll
            for (int n = 0; n < 2; ++n) bv[bj][n] = bias ? *(const f32x4*)(bias + bcol0 + bj * HALF + 4 * n) : (f32x4){0.f, 0.f, 0.f, 0.f};
#pragma unroll
        for (int ai = 0; ai < 2; ++ai)
#pragma unroll
            for (int m = 0; m < 4; ++m) { bf16_t* rowp = base + (size_t)(row0 + ai * HALF + m * 16) * ldc + col0;
#pragma unroll
                for (int bj = 0; bj < 2; ++bj) { f32x4 v0 = acc[ai][bj][m][0] + bv[bj][0], v1 = acc[ai][bj][m][1] + bv[bj][1];
                    if (ACT == 1) { f32x2 a = gelu_pk((f32x2){v0[0], v0[1]}), b = gelu_pk((f32x2){v0[2], v0[3]}), c = gelu_pk((f32x2){v1[0], v1[1]}), d = gelu_pk((f32x2){v1[2], v1[3]});
                        v0 = (f32x4){a.x, a.y, b.x, b.y}; v1 = (f32x4){c.x, c.y, d.x, d.y}; }
                    v0 = v0 * sc; v1 = v1 * sc; u32x4 w; w.x = cvt_pk_bf16(v0[0], v0[1]); w.y = cvt_pk_bf16(v0[2], v0[3]); w.z = cvt_pk_bf16(v1[0], v1[1]); w.w = cvt_pk_bf16(v1[2], v1[3]);
                    *(u32x4*)(rowp + bj * HALF) = w; } }
    }
};

struct PanelStats {
    unsigned* xbuf;
    unsigned* cnt;
    unsigned* tmo;
    int ntn; float eps;
    unsigned code;
    __device__ __forceinline__ bool run(const f32x4 (&v)[2][2][4][2], const Unit& u, int wr, int wc, int fr, int fq, PG8_LAS unsigned char* lds, int wid, int lane) const {
        typedef float f32x2v __attribute__((ext_vector_type(2)));
        PG8_LAS f32x2v* P = (PG8_LAS f32x2v*)lds;
        PG8_LAS f32x2v* S = (PG8_LAS f32x2v*)(lds + 8192);
        PG8_LAS unsigned* flag = (PG8_LAS unsigned*)(lds + 8192 + 2048);
#pragma unroll
        for (int ai = 0; ai < 2; ++ai)
#pragma unroll
            for (int m = 0; m < 4; ++m) {
                float s = 0.f;
#pragma unroll
                for (int bj = 0; bj < 2; ++bj)
#pragma unroll
                    for (int n = 0; n < 2; ++n) { const f32x4 x = v[ai][bj][m][n]; s += (x[0] + x[1]) + (x[2] + x[3]); }
                s += __shfl_xor(s, 16); s += __shfl_xor(s, 32);
                const float mw = s * (1.0f / 64.0f); float q = 0.f;
#pragma unroll
                for (int bj = 0; bj < 2; ++bj)
#pragma unroll
                    for (int n = 0; n < 2; ++n) { const f32x4 d = v[ai][bj][m][n] - mw; q += (d[0] * d[0] + d[1] * d[1]) + (d[2] * d[2] + d[3] * d[3]); }
                q += __shfl_xor(q, 16); q += __shfl_xor(q, 32);
                if (fq == 0) P[(ai * HALF + wr * 64 + m * 16 + fr) * 4 + wc] = (f32x2v){mw, q};
            }
        asm volatile("s_waitcnt lgkmcnt(0)" ::: "memory"); __builtin_amdgcn_s_barrier(); asm volatile("" ::: "memory");
#if defined(BROKEN_EXCHANGE_NO_WAIT)
#warning BROKEN CONTROL BUILD: the row-statistics exchange does not wait; results are wrong by design
        if (blockIdx.x >= 64) { const long long t0_ = clock64(); while (clock64() - t0_ < 60000) __builtin_amdgcn_s_sleep(8); }
#endif
        const int row = wid * 32 + (lane & 31);
        if (lane < 32) {
            const f32x2v a = P[row * 4 + 0], b = P[row * 4 + 1], c = P[row * 4 + 2], d = P[row * 4 + 3];
            const float mt = (a.x + b.x + c.x + d.x) * 0.25f;
            const float da = a.x - mt, db = b.x - mt, dc = c.x - mt, dd = d.x - mt;
            const float m2 = (a.y + b.y) + (c.y + d.y) + 64.0f * ((da * da + db * db) + (dc * dc + dd * dd));
            unsigned long long* slot = (unsigned long long*)xbuf + ((size_t)(u.pm * BM + row) * 4 + u.pn);
            __hip_atomic_store(slot, ((unsigned long long)__float_as_uint(m2) << 32) | __float_as_uint(mt), __ATOMIC_RELAXED, __HIP_MEMORY_SCOPE_AGENT);
        }
        asm volatile("s_waitcnt vmcnt(0)" ::: "memory");
        if (lane == 0) __hip_atomic_fetch_add(cnt + 64 * u.pm, 1u, __ATOMIC_RELAXED, __HIP_MEMORY_SCOPE_AGENT);
        if (wid == 0) {
            bool dead = false; const unsigned long long t0 = __builtin_amdgcn_s_memrealtime(); const unsigned want = 8u * (unsigned)ntn;
            for (;;) {
#if defined(BROKEN_EXCHANGE_NO_WAIT)
                break;
#endif
                if ((unsigned)__builtin_amdgcn_readfirstlane(__hip_atomic_load(cnt + 64 * u.pm, __ATOMIC_RELAXED, __HIP_MEMORY_SCOPE_AGENT)) >= want) break;
                if (__builtin_amdgcn_s_memrealtime() - t0 > 2000000ull) {
                    if (lane == 0) { unsigned expect = 0u; __hip_atomic_compare_exchange_strong(tmo + 1, &expect, code | (unsigned)(u.pm & 0xff), __ATOMIC_RELAXED, __ATOMIC_RELAXED, __HIP_MEMORY_SCOPE_AGENT);
                                     __hip_atomic_store(tmo, 1u, __ATOMIC_RELAXED, __HIP_MEMORY_SCOPE_AGENT); }
                    dead = true; break; }
                __builtin_amdgcn_s_sleep(2);
            }
            __builtin_amdgcn_fence(__ATOMIC_ACQUIRE, "agent");
            if (lane == 0) flag[0] = dead ? 1u : 0u;
        }
        asm volatile("s_waitcnt vmcnt(0) lgkmcnt(0)" ::: "memory"); __builtin_amdgcn_s_barrier(); asm volatile("" ::: "memory");
        const bool bad = flag[0] != 0u;
        if (lane < 32) {
            const unsigned long long* slot = (const unsigned long long*)xbuf + (size_t)(u.pm * BM + row) * 4; float mt[4], m2[4]; float ms = 0.f;
#pragma unroll
            for (int t = 0; t < 4; ++t) { if (t < ntn) { const unsigned long long w = __hip_atomic_load(slot + t, __ATOMIC_RELAXED, __HIP_MEMORY_SCOPE_AGENT); mt[t] = __uint_as_float((unsigned)w); m2[t] = __uint_as_float((unsigned)(w >> 32)); } else { mt[t] = 0.f; m2[t] = 0.f; } ms += mt[t]; }
            const float mean = ms / (float)ntn; float q = 0.f;
#pragma unroll
            for (int t = 0; t < 4; ++t) if (t < ntn) { const float dm = mt[t] - mean; q += m2[t] + 256.0f * dm * dm; }
            S[row] = (f32x2v){mean, 1.0f / sqrtf(q / (256.0f * (float)ntn) + eps)};
        }
        asm volatile("s_waitcnt lgkmcnt(0)" ::: "memory"); __builtin_amdgcn_s_barrier(); asm volatile("" ::: "memory");
        return bad;
    }
};
struct EpiLnRes {
    static constexpr bool PERM = false, AFTER_DRAIN = true;
    const float* base; float* out; int ldc; const float* bias; PanelStats st; unsigned poison;
    __device__ __forceinline__ void fused(f32x4 (&acc)[2][2][4][2], const Unit& u, int wr, int wc, int fr, int fq, PG8_LAS unsigned char* lds, int wid, int lane) const {
        typedef float f32x2v __attribute__((ext_vector_type(2)));
        const PG8_LAS f32x2v* S = (const PG8_LAS f32x2v*)(lds + 8192);
        const int col0 = u.pn * BM + wc * 32 + 4 * fq;
#pragma unroll
        for (int bj = 0; bj < 2; ++bj)
#pragma unroll
            for (int n = 0; n < 2; ++n) { const f32x4 bv = bias ? *(const f32x4*)(bias + col0 + bj * HALF + n * 16) : (f32x4){0.f, 0.f, 0.f, 0.f};
#pragma unroll
                for (int ai = 0; ai < 2; ++ai)
#pragma unroll
                    for (int m = 0; m < 4; ++m) acc[ai][bj][m][n] += bv; }
        f32x4 pre[4][2][2];
#pragma unroll
        for (int m = 0; m < 4; ++m) { const size_t off = (size_t)(u.pm * BM + wr * 64 + m * 16 + fr) * ldc + col0;
#pragma unroll
            for (int bj = 0; bj < 2; ++bj)
#pragma unroll
                for (int n = 0; n < 2; ++n) pre[m][bj][n] = *(const f32x4*)(base + off + bj * HALF + n * 16); }
        const bool bad = st.run(acc, u, wr, wc, fr, fq, lds, wid, lane) || poison != 0u;
        const float qnan = __builtin_nanf("");
#pragma unroll
        for (int ai = 0; ai < 2; ++ai)
#pragma unroll
            for (int m = 0; m < 4; ++m) { const int r = ai * HALF + wr * 64 + m * 16 + fr; const f32x2v sr = S[r]; const size_t off = (size_t)(u.pm * BM + r) * ldc + col0;
#pragma unroll
                for (int bj = 0; bj < 2; ++bj)
#pragma unroll
                    for (int n = 0; n < 2; ++n) { const f32x4 bs = ai == 0 ? pre[m][bj][n] : *(const f32x4*)(base + off + bj * HALF + n * 16); f32x4 o = bs + (acc[ai][bj][m][n] - sr.x) * sr.y;
                        if (bad) o = (f32x4){qnan, qnan, qnan, qnan}; *(f32x4*)(out + off + bj * HALF + n * 16) = o; }
                if (m & 1) asm volatile("" ::: "memory"); }
    }
};
struct EpiLnResLn {
    static constexpr bool PERM = false, AFTER_DRAIN = true;
    const float* base; float* out; bf16_t* xn; int ldc; const float* bias; PanelStats st1, st2; unsigned poison;
    __device__ __forceinline__ void fused(f32x4 (&acc)[2][2][4][2], const Unit& u, int wr, int wc, int fr, int fq, PG8_LAS unsigned char* lds, int wid, int lane) const {
        typedef float f32x2v __attribute__((ext_vector_type(2))); typedef unsigned u32x2v __attribute__((ext_vector_type(2)));
        const PG8_LAS f32x2v* S = (const PG8_LAS f32x2v*)(lds + 8192);
        const int col0 = u.pn * BM + wc * 32 + 4 * fq;
#pragma unroll
        for (int bj = 0; bj < 2; ++bj)
#pragma unroll
            for (int n = 0; n < 2; ++n) { const f32x4 bv = bias ? *(const f32x4*)(bias + col0 + bj * HALF + n * 16) : (f32x4){0.f, 0.f, 0.f, 0.f};
#pragma unroll
                for (int ai = 0; ai < 2; ++ai)
#pragma unroll
                    for (int m = 0; m < 4; ++m) acc[ai][bj][m][n] += bv; }
        bool bad = st1.run(acc, u, wr, wc, fr, fq, lds, wid, lane) || poison != 0u;
        const float qnan = __builtin_nanf("");
#pragma unroll
        for (int ai = 0; ai < 2; ++ai)
#pragma unroll
            for (int m = 0; m < 4; ++m) { const int r = ai * HALF + wr * 64 + m * 16 + fr; const f32x2v sr = S[r]; const size_t off = (size_t)(u.pm * BM + r) * ldc + col0;
#pragma unroll
                for (int bj = 0; bj < 2; ++bj)
#pragma unroll
                    for (int n = 0; n < 2; ++n) { const f32x4 bs = *(const f32x4*)(base + off + bj * HALF + n * 16); acc[ai][bj][m][n] = bs + (acc[ai][bj][m][n] - sr.x) * sr.y; }
                asm volatile("" : "+v"(acc[ai][0][m][0]), "+v"(acc[ai][0][m][1]), "+v"(acc[ai][1][m][0]), "+v"(acc[ai][1][m][1]));
                if (m & 1) asm volatile("" ::: "memory"); }
        const bool bad1 = bad;
        bad = st2.run(acc, u, wr, wc, fr, fq, lds, wid, lane) || bad;
#pragma unroll
        for (int ai = 0; ai < 2; ++ai)
#pragma unroll
            for (int m = 0; m < 4; ++m) { const int r = ai * HALF + wr * 64 + m * 16 + fr; const f32x2v sr = S[r]; const size_t off = (size_t)(u.pm * BM + r) * ldc + col0;
#pragma unroll
                for (int bj = 0; bj < 2; ++bj)
#pragma unroll
                    for (int n = 0; n < 2; ++n) { const f32x4 x1 = acc[ai][bj][m][n]; *(f32x4*)(out + off + bj * HALF + n * 16) = bad1 ? (f32x4){qnan, qnan, qnan, qnan} : x1;
                        const f32x4 o = (x1 - sr.x) * sr.y; u32x2v w; w.x = cvt_pk_bf16(o[0], o[1]); w.y = cvt_pk_bf16(o[2], o[3]);
                        if (bad) { w.x = 0x7fc07fc0u; w.y = 0x7fc07fc0u; } *(u32x2v*)(xn + off + bj * HALF + n * 16) = w; }
                asm volatile("" ::: "memory"); }
    }
};

template <class Epi, class Sched, bool ALIGN_EPI = false, bool SP2 = false>
__device__ __forceinline__ void gemm_phase(PG8_LAS unsigned char* lds, const Gemm g, const Sched& S, const Epi& E) {
    const int tid = threadIdx.x, wid = __builtin_amdgcn_readfirstlane(tid >> 6), lane = tid & 63, wr = wid >> 2, wc = wid & 3, fr = lane & 15, fq = lane >> 4;
    const int K = g.K, nt = K / BK;
    unsigned voffA[2], voffB[2];
#pragma unroll
    for (int i = 0; i < 2; ++i) { int R, C; stage_rc(tid * 16 + i * 8192, R, C); const int Rb = Epi::PERM ? ((R & ~31) + perm32(R & 31)) : R;
        voffA[i] = (unsigned)(R * K + C) * 2u; voffB[i] = (unsigned)(Rb * K + C) * 2u; }
    const size_t kstep = (size_t)(BK * 2);
    const size_t hstep = (size_t)HALF * K * 2;
    const size_t tstep = 2 * hstep;
    const unsigned ldsw = (unsigned)wid * 1024u;
    const int aoff = lds_byte(wr * 64 + fr, fq * 8), boff = lds_byte(wc * 32 + fr, fq * 8);
#define PG8_SA(b, h) (((b) * 2 + (h)) * HTB)
#define PG8_SB(b, h) ((4 + (b) * 2 + (h)) * HTB)
#define PG8_STAGE(bufoff, gbase, voff) do { _Pragma("unroll") for (int _i = 0; _i < 2; ++_i) \
        __builtin_amdgcn_global_load_lds((const unsigned*)((const char*)(gbase) + (voff)[_i]), (PG8_LAS unsigned*)(lds + (bufoff) + ldsw + _i * 8192), 16, 0, 0); } while (0)
#define PG8_LDA(dst, b, h) do { _Pragma("unroll") for (int m = 0; m < 4; ++m) _Pragma("unroll") for (int k = 0; k < 2; ++k) dst[m][k] = *(const PG8_LAS bf16x8*)(lds + PG8_SA(b, h) + aoff + m * 2048 + k * 1024); } while (0)
#define PG8_LDB(dst, b, h) do { _Pragma("unroll") for (int n = 0; n < 2; ++n) _Pragma("unroll") for (int k = 0; k < 2; ++k) dst[n][k] = *(const PG8_LAS bf16x8*)(lds + PG8_SB(b, h) + boff + n * 2048 + k * 1024); } while (0)
#define PG8_MMA(ai, bj, At, Bt) do { __builtin_amdgcn_s_setprio(1); _Pragma("unroll") for (int m = 0; m < 4; ++m) _Pragma("unroll") for (int n = 0; n < 2; ++n) _Pragma("unroll") for (int k = 0; k < 2; ++k) \
        acc[ai][bj][m][n] = __builtin_amdgcn_mfma_f32_16x16x32_bf16(Bt[n][k], At[m][k], acc[ai][bj][m][n], 0, 0, 0); __builtin_amdgcn_s_setprio(0); } while (0)
#define PG8_WAIT_V(n) asm volatile("s_waitcnt vmcnt(" #n ")" ::: "memory")
#define PG8_WAIT_L(n) asm volatile("s_waitcnt lgkmcnt(" #n ")" ::: "memory")
#define PG8_BAR __builtin_amdgcn_s_barrier()
#define PG8_SCHED __builtin_amdgcn_sched_barrier(0)
    Unit cur, nxt; int ui = 0;
    if (!S.next(0, cur)) return;
    f32x4 acc[2][2][4][2];
#pragma unroll
    for (int a = 0; a < 2; ++a)
#pragma unroll
        for (int b = 0; b < 2; ++b)
#pragma unroll
            for (int m = 0; m < 4; ++m)
#pragma unroll
                for (int n = 0; n < 2; ++n) acc[a][b][m][n] = (f32x4){0.f, 0.f, 0.f, 0.f};
    bf16x8 At[4][2], B0[2][2], B1[2][2];
    const char* cA = (const char*)g.A + (size_t)cur.pm * tstep; const char* cB = (const char*)g.Bt + (size_t)cur.pn * tstep;
    S.a_ready(cur);
    if constexpr (SP2) {
        PG8_STAGE(PG8_SB(0, 0), cB, voffB); PG8_STAGE(PG8_SB(0, 1), cB + hstep, voffB); PG8_STAGE(PG8_SA(0, 0), cA, voffA); PG8_STAGE(PG8_SA(0, 1), cA + hstep, voffA);
        if (wr == 1) PG8_BAR;
        PG8_WAIT_V(2); PG8_BAR;
        PG8_STAGE(PG8_SB(1, 0), cB + kstep, voffB); PG8_STAGE(PG8_SA(1, 0), cA + kstep, voffA); PG8_STAGE(PG8_SB(1, 1), cB + hstep + kstep, voffB);
        PG8_WAIT_V(6); PG8_BAR;
    } else {
        PG8_STAGE(PG8_SB(0, 0), cB, voffB); PG8_STAGE(PG8_SA(0, 0), cA, voffA); PG8_STAGE(PG8_SB(0, 1), cB + hstep, voffB); PG8_STAGE(PG8_SA(0, 1), cA + hstep, voffA);
        if (wr == 1) PG8_BAR;
        PG8_WAIT_V(4); PG8_BAR;
        PG8_STAGE(PG8_SB(1, 0), cB + kstep, voffB); PG8_STAGE(PG8_SA(1, 0), cA + kstep, voffA); PG8_STAGE(PG8_SB(1, 1), cB + hstep + kstep, voffB);
        PG8_WAIT_V(6); PG8_BAR;
    }
    for (;;) {
        const bool has_next = S.next(ui + 1, nxt);
        const char* nA = has_next ? (const char*)g.A + (size_t)nxt.pm * tstep : cA; const char* nB = has_next ? (const char*)g.Bt + (size_t)nxt.pn * tstep : cB;
        for (int t = 0; t < nt; t += 2) {
            const bool last = (t == nt - 2);
            const char* a1 = cA + (size_t)(t + 1) * kstep;
            const char* a2 = last ? nA : cA + (size_t)(t + 2) * kstep; const char* b2 = last ? nB : cB + (size_t)(t + 2) * kstep;
            const char* a3 = a2 + kstep; const char* b3 = b2 + kstep;
            if (last && has_next) S.a_ready(nxt);
            if constexpr (SP2) {
            PG8_LDB(B0, 0, 0); PG8_LDB(B1, 0, 1); PG8_SCHED; PG8_LDA(At, 0, 0); PG8_STAGE(PG8_SA(1, 1), a1 + hstep, voffA);
            PG8_WAIT_V(8); PG8_WAIT_L(0); PG8_BAR; PG8_MMA(0, 0, At, B0); PG8_MMA(0, 1, At, B1); PG8_BAR; PG8_SCHED;
            PG8_LDA(At, 0, 1); PG8_STAGE(PG8_SB(0, 0), b2, voffB); PG8_STAGE(PG8_SB(0, 1), b2 + hstep, voffB); PG8_STAGE(PG8_SA(0, 0), a2, voffA);
            PG8_WAIT_V(8); PG8_WAIT_L(0); PG8_BAR; PG8_MMA(1, 0, At, B0); PG8_MMA(1, 1, At, B1); PG8_BAR; PG8_SCHED;
            PG8_LDB(B0, 1, 0); PG8_LDB(B1, 1, 1); PG8_SCHED; PG8_LDA(At, 1, 0); PG8_STAGE(PG8_SA(0, 1), a2 + hstep, voffA);
            PG8_WAIT_V(8); PG8_WAIT_L(0); PG8_BAR; PG8_MMA(0, 0, At, B0); PG8_MMA(0, 1, At, B1); PG8_BAR; PG8_SCHED;
            PG8_LDA(At, 1, 1); PG8_STAGE(PG8_SB(1, 0), b3, voffB); PG8_STAGE(PG8_SB(1, 1), b3 + hstep, voffB); PG8_STAGE(PG8_SA(1, 0), a3, voffA);
            PG8_WAIT_V(8); PG8_WAIT_L(0); PG8_BAR; PG8_MMA(1, 0, At, B0); PG8_MMA(1, 1, At, B1); PG8_BAR; PG8_SCHED;
            } else {
            PG8_LDB(B0, 0, 0); PG8_SCHED; PG8_LDA(At, 0, 0); PG8_STAGE(PG8_SA(1, 1), a1 + hstep, voffA);
            PG8_WAIT_L(8); PG8_BAR; PG8_WAIT_L(0); PG8_MMA(0, 0, At, B0); PG8_BAR; PG8_SCHED;
            PG8_LDB(B1, 0, 1); PG8_STAGE(PG8_SB(0, 0), b2, voffB);
            PG8_BAR; PG8_WAIT_L(0); PG8_MMA(0, 1, At, B1); PG8_BAR;
            PG8_LDA(At, 0, 1); PG8_STAGE(PG8_SA(0, 0), a2, voffA);
            PG8_BAR; PG8_WAIT_L(0); PG8_MMA(1, 0, At, B0); PG8_BAR; PG8_SCHED;
            PG8_STAGE(PG8_SB(0, 1), b2 + hstep, voffB);
            PG8_WAIT_V(6); PG8_BAR; PG8_MMA(1, 1, At, B1); PG8_BAR;
            PG8_LDB(B0, 1, 0); PG8_SCHED; PG8_LDA(At, 1, 0); PG8_STAGE(PG8_SA(0, 1), a2 + hstep, voffA);
            PG8_WAIT_L(8); PG8_BAR; PG8_WAIT_L(0); PG8_MMA(0, 0, At, B0); PG8_BAR; PG8_SCHED;
            PG8_LDB(B1, 1, 1); PG8_STAGE(PG8_SB(1, 0), b3, voffB);
            PG8_BAR; PG8_WAIT_L(0); PG8_MMA(0, 1, At, B1); PG8_BAR;
            PG8_LDA(At, 1, 1); PG8_STAGE(PG8_SA(1, 0), a3, voffA);
            PG8_BAR; PG8_WAIT_L(0); PG8_MMA(1, 0, At, B0); PG8_BAR; PG8_SCHED;
            PG8_STAGE(PG8_SB(1, 1), b3 + hstep, voffB);
            PG8_WAIT_V(6); PG8_BAR; PG8_MMA(1, 1, At, B1); PG8_BAR;
            }
        }
        if constexpr (ALIGN_EPI) { if (wr == 0) PG8_BAR; }
        if constexpr (!Epi::AFTER_DRAIN) { E(acc, cur, wr, wc, fr, fq); S.done(cur); }
        if (!has_next) break;
#pragma unroll
        for (int a = 0; a < 2; ++a)
#pragma unroll
            for (int b = 0; b < 2; ++b)
#pragma unroll
                for (int m = 0; m < 4; ++m)
#pragma unroll
                    for (int n = 0; n < 2; ++n) acc[a][b][m][n] = (f32x4){0.f, 0.f, 0.f, 0.f};
        cur = nxt; cA = nA; cB = nB; ++ui;
        if constexpr (ALIGN_EPI) { if (wr == 1) PG8_BAR; }
    }
    PG8_WAIT_V(0);
    if constexpr (!ALIGN_EPI) { if (wr == 0) PG8_BAR; }
    PG8_BAR;
    if constexpr (Epi::AFTER_DRAIN) { E.fused(acc, cur, wr, wc, fr, fq, lds, wid, lane); S.done(cur); }
#undef PG8_SA
#undef PG8_SB
#undef PG8_STAGE
#undef PG8_LDA
#undef PG8_LDB
#undef PG8_MMA
#undef PG8_WAIT_V
#undef PG8_WAIT_L
#undef PG8_BAR
#undef PG8_SCHED
}
}
namespace pg8 {
__device__ __forceinline__ float bf2f(unsigned short b) { return __uint_as_float(((unsigned)b) << 16); }
__device__ __forceinline__ float bflo(unsigned w) { return __uint_as_float(w << 16); }
__device__ __forceinline__ float bfhi(unsigned w) { return __uint_as_float(w & 0xffff0000u); }
__device__ __forceinline__ float sigm(float x) { return 1.f / (1.f + __expf(-x)); }
template <int MODE> struct EpiGate {
    static constexpr bool PERM = true, AFTER_DRAIN = false;
    bf16_t* O; int ldc; const bf16_t* G; int ldg;
    __device__ __forceinline__ void operator()(const f32x4 (&acc)[2][2][4][2], const Unit& u, int wr, int wc, int fr, int fq) const {
        const int row0 = u.pm * BM + wr * 64 + fr, col0 = u.pn * BM + wc * 32 + 8 * fq;
#pragma unroll
        for (int ai = 0; ai < 2; ++ai)
#pragma unroll
            for (int m = 0; m < 4; ++m) { const size_t row = (size_t)(row0 + ai * HALF + m * 16);
#pragma unroll
                for (int bj = 0; bj < 2; ++bj) {
                    const u32x4 gw = *(const u32x4*)(G + row * ldg + col0 + bj * HALF);
                    f32x4 v0 = acc[ai][bj][m][0], v1 = acc[ai][bj][m][1];
                    v0[0] *= sigm(bflo(gw.x)); v0[1] *= sigm(bfhi(gw.x)); v0[2] *= sigm(bflo(gw.y)); v0[3] *= sigm(bfhi(gw.y));
                    v1[0] *= sigm(bflo(gw.z)); v1[1] *= sigm(bfhi(gw.z)); v1[2] *= sigm(bflo(gw.w)); v1[3] *= sigm(bfhi(gw.w));
                    bf16_t* op = O + row * ldc + col0 + bj * HALF;
                    if (MODE == 1) { const u32x4 ow = *(const u32x4*)op;
                        v0[0] += bflo(ow.x); v0[1] += bfhi(ow.x); v0[2] += bflo(ow.y); v0[3] += bfhi(ow.y);
                        v1[0] += bflo(ow.z); v1[1] += bfhi(ow.z); v1[2] += bflo(ow.w); v1[3] += bfhi(ow.w); }
                    u32x4 w; w.x = cvt_pk_bf16(v0[0], v0[1]); w.y = cvt_pk_bf16(v0[2], v0[3]); w.z = cvt_pk_bf16(v1[0], v1[1]); w.w = cvt_pk_bf16(v1[2], v1[3]);
                    *(u32x4*)op = w; } }
    }
};
struct EpiResid {
    static constexpr bool PERM = true, AFTER_DRAIN = false;
    const float* R; float* Hf; bf16_t* Hb; float* ss; int ldc;
    __device__ __forceinline__ void operator()(const f32x4 (&acc)[2][2][4][2], const Unit& u, int wr, int wc, int fr, int fq) const {
        const int row0 = u.pm * BM + wr * 64 + fr, col0 = u.pn * BM + wc * 32 + 8 * fq;
#pragma unroll
        for (int ai = 0; ai < 2; ++ai)
#pragma unroll
            for (int m = 0; m < 4; ++m) { const size_t row = (size_t)(row0 + ai * HALF + m * 16); float sq = 0.f;
#pragma unroll
                for (int bj = 0; bj < 2; ++bj) {
                    const size_t off = row * ldc + col0 + bj * HALF;
                    const f32x4 r0 = *(const f32x4*)(R + off), r1 = *(const f32x4*)(R + off + 4);
                    const f32x4 v0 = acc[ai][bj][m][0] + r0, v1 = acc[ai][bj][m][1] + r1;
                    *(f32x4*)(Hf + off) = v0; *(f32x4*)(Hf + off + 4) = v1;
                    u32x4 w; w.x = cvt_pk_bf16(v0[0], v0[1]); w.y = cvt_pk_bf16(v0[2], v0[3]); w.z = cvt_pk_bf16(v1[0], v1[1]); w.w = cvt_pk_bf16(v1[2], v1[3]);
                    *(u32x4*)(Hb + off) = w;
                    sq += (v0[0] * v0[0] + v0[1] * v0[1]) + (v0[2] * v0[2] + v0[3] * v0[3]) + (v1[0] * v1[0] + v1[1] * v1[1]) + (v1[2] * v1[2] + v1[3] * v1[3]); }
                sq += __shfl_xor(sq, 16); sq += __shfl_xor(sq, 32);
                if (fq == 0) atomicAdd(ss + row, sq); }
    }
};
struct EpiRowScale {
    static constexpr bool PERM = true, AFTER_DRAIN = false;
    bf16_t* O; int ldc; const float* ss; float inv_n, eps;
    __device__ __forceinline__ void operator()(const f32x4 (&acc)[2][2][4][2], const Unit& u, int wr, int wc, int fr, int fq) const {
        const int row0 = u.pm * BM + wr * 64 + fr, col0 = u.pn * BM + wc * 32 + 8 * fq;
#pragma unroll
        for (int ai = 0; ai < 2; ++ai)
#pragma unroll
            for (int m = 0; m < 4; ++m) { const size_t row = (size_t)(row0 + ai * HALF + m * 16);
                const float sc = rsqrtf(__hip_atomic_load(ss + row, __ATOMIC_RELAXED, __HIP_MEMORY_SCOPE_AGENT) * inv_n + eps);
#pragma unroll
                for (int bj = 0; bj < 2; ++bj) { const f32x4 v0 = acc[ai][bj][m][0] * sc, v1 = acc[ai][bj][m][1] * sc;
                    u32x4 w; w.x = cvt_pk_bf16(v0[0], v0[1]); w.y = cvt_pk_bf16(v0[2], v0[3]); w.z = cvt_pk_bf16(v1[0], v1[1]); w.w = cvt_pk_bf16(v1[2], v1[3]);
                    *(u32x4*)(O + row * ldc + col0 + bj * HALF) = w; } }
    }
};
}
constexpr int D_MODEL = 2048, BATCH = 2, SEQ = 4096, NTOK = BATCH * SEQ;
constexpr int HD = 64, NCMP = 255, CMP_STRIDE = 16, CMP_LEN = 32, CMP_HID = 128;
constexpr int SEL_LEN = 64, SEL_TOPK = 16, WINDOW = 512;
constexpr int PEER_KEYS = 128, PEER_E = 128;
constexpr int NSA_Q = 1024, SB_W = 1024;
constexpr int IN_COLS = 9776, PLD = 9984;
constexpr int C_QN = 0, C_KC = 1024, C_VC = 1280, C_KS = 1536, C_VS = 1792, C_KW = 2048, C_VW = 2304, C_GBR = 2560,
              C_QB = 2608, C_KB = 3632, C_VB = 4656, C_GA = 5680, C_GB = 7728;
constexpr float EPS = 1e-6f, NEGF = -1e30f;
constexpr int NWAVES = 8, NTHR = 512;

constexpr size_t MiB = 1u << 20;
constexpr size_t WS_CTL = 0, CTL_ZERO_BYTES = 1 * MiB;
constexpr size_t WS_WIN = 2 * MiB;
constexpr size_t WS_WBN = 42 * MiB, WS_WBS = 46 * MiB;
constexpr size_t WS_WOUT = 50 * MiB, WS_WPQ = 58 * MiB;
constexpr size_t WS_MISC = 66 * MiB;
constexpr size_t WS_XN = 70 * MiB;
constexpr size_t WS_PROJ = 102 * MiB;
constexpr size_t WS_ONSA = 258 * MiB, WS_OSB = 274 * MiB;
constexpr size_t WS_H = 290 * MiB;
constexpr size_t WS_HB = 354 * MiB;
constexpr size_t WS_END = 386 * MiB;
constexpr size_t WS_UB = 102 * MiB, WS_VB = 166 * MiB, WS_QP = 230 * MiB, WS_EXP = 262 * MiB, WS_GATE = 266 * MiB;
constexpr size_t MISC_KCB = 0, MISC_VCB = 1 * MiB, MISC_SKB = 2 * MiB, MISC_W1T = 2 * MiB + 512 * 1024, MISC_B1 = 3 * MiB + 512 * 1024;
constexpr int CW_BAR = 4096;
constexpr int CW_SS = 32768;

#define GAS __attribute__((address_space(1)))
#define LAS __attribute__((address_space(3)))
typedef unsigned short bf16;
typedef unsigned v4u __attribute__((ext_vector_type(4)));
typedef unsigned v2u __attribute__((ext_vector_type(2)));
typedef float f32x4 __attribute__((ext_vector_type(4)));
#define RLX_AGENT __ATOMIC_RELAXED, __HIP_MEMORY_SCOPE_AGENT
__device__ __forceinline__ unsigned f2bf(float f) { unsigned u = __builtin_bit_cast(unsigned, f); return (u + 0x7fffu + ((u >> 16) & 1u)) >> 16; }
__device__ __forceinline__ unsigned pk2(float lo, float hi) { return f2bf(lo) | (f2bf(hi) << 16); }
__device__ __forceinline__ float bf2f(bf16 b) { return __uint_as_float(((unsigned)b) << 16); }
__device__ __forceinline__ float bflo(unsigned w) { return __uint_as_float(w << 16); }
__device__ __forceinline__ float bfhi(unsigned w) { return __uint_as_float(w & 0xffff0000u); }

#define XB_TMO      128
#define XB_XCNT(j)  (256  + 64 * (j))
#define XB_XSUB(j)  (1280 + 64 * (j))
#define XB_XGEN(j)  (2304 + 64 * (j))
#define XB_TOP      3328
#define XB_TOPGEN   3392
#define XCD_BAR_WORDS 3456
#define XB_SPIN_CAP (1u << 24)
__device__ __forceinline__ unsigned xb_ld(unsigned* p)              { return __hip_atomic_load(p, __ATOMIC_RELAXED, __HIP_MEMORY_SCOPE_AGENT); }
__device__ __forceinline__ unsigned xb_add(unsigned* p, unsigned v) { return __hip_atomic_fetch_add(p, v, __ATOMIC_RELAXED, __HIP_MEMORY_SCOPE_AGENT); }
__device__ __forceinline__ unsigned xb_xcc_id() { return (unsigned)__builtin_amdgcn_s_getreg((3 << 11) | 20) & 0xFu; }
#define XB_SPIN(cond, bar) do { unsigned _sp = 0; while (cond) { __builtin_amdgcn_s_sleep(1); \
    if ((++_sp & 255u) == 0u) { if (xb_ld(&(bar)[XB_TMO])) break; if (_sp > XB_SPIN_CAP) { atomicAdd(&(bar)[XB_TMO], 1u); break; } } } } while (0)
struct XcdBarrier { unsigned* bar; unsigned x; volatile LAS unsigned* st; };
__device__ __forceinline__ XcdBarrier xcd_barrier_post(unsigned* bar, volatile LAS unsigned* st) {
    XcdBarrier b; b.bar = bar; b.x = xb_xcc_id(); b.st = st;
    if (threadIdx.x == 0) (void)xb_add(&bar[XB_XCNT(b.x)], 1u);
    return b;
}
__device__ __forceinline__ void xcd_barrier_complete(unsigned* bar, unsigned x, unsigned& nloc, unsigned& nx) {
    const unsigned G = gridDim.x * gridDim.y * gridDim.z;
    unsigned sum, cnt, mine, sp = 0u;
    for (;;) {
        sum = 0u; cnt = 0u; mine = 0u;
#pragma unroll
        for (unsigned j = 0; j < 16; ++j) { const unsigned c = xb_ld(&bar[XB_XCNT(j)]); sum += c; cnt += (c > 0u) ? 1u : 0u; mine = (j == x) ? c : mine; }
        if (sum == G) break;
        __builtin_amdgcn_s_sleep(1);
        if ((++sp & 255u) == 0u) { if (xb_ld(&bar[XB_TMO])) break; if (sp > XB_SPIN_CAP) { atomicAdd(&bar[XB_TMO], 1u); break; } }
    }
    nloc = mine > 0u ? mine : 1u; nx = cnt > 0u ? cnt : 1u;
}
__device__ __forceinline__ void xcd_barrier(const XcdBarrier& b) {
    asm volatile("s_waitcnt vmcnt(0)" ::: "memory");
    __syncthreads();
    if (threadIdx.x == 0) {
        unsigned* bar = b.bar;
        const unsigned bx = xb_xcc_id();
        __builtin_amdgcn_s_waitcnt(0);
        unsigned nloc = b.st[0], nx = b.st[1];
        if (nloc == 0u) { xcd_barrier_complete(bar, bx, nloc, nx); b.st[0] = nloc; b.st[1] = nx; }
        const unsigned old = xb_add(&bar[XB_XSUB(bx)], 1u);
        const unsigned gen = old / nloc;
        if (old + 1u == (gen + 1u) * nloc) {
            __builtin_amdgcn_fence(__ATOMIC_RELEASE, "agent");
            asm volatile("s_waitcnt vmcnt(0)" ::: "memory");
            const unsigned og = xb_add(&bar[XB_TOP], 1u);
            const unsigned tg = og / nx;
            if (og + 1u == (tg + 1u) * nx) xb_add(&bar[XB_TOPGEN], 1u);
            else XB_SPIN(xb_ld(&bar[XB_TOPGEN]) == tg, bar);
            __builtin_amdgcn_fence(__ATOMIC_ACQUIRE, "agent");
            xb_add(&bar[XB_XGEN(bx)], 1u);
            asm volatile("s_waitcnt vmcnt(0)" ::: "memory");
        } else {
            XB_SPIN(xb_ld(&bar[XB_XGEN(bx)]) == gen, bar);
            __builtin_amdgcn_fence(__ATOMIC_ACQUIRE, "agent");
            asm volatile("s_waitcnt vmcnt(0)" ::: "memory");
        }
    }
    __syncthreads();
}

__device__ __forceinline__ int rel_bucket(int d) {
    if (d < 16) return d < 0 ? 0 : d;
    int b = 16;
    b += (d >= 21); b += (d >= 27); b += (d >= 35); b += (d >= 46); b += (d >= 59); b += (d >= 77); b += (d >= 99); b += (d >= 128);
    b += (d >= 166); b += (d >= 216); b += (d >= 280); b += (d >= 363); b += (d >= 470); b += (d >= 609); b += (d >= 790);
    return b;
}
__device__ __forceinline__ float gelu_tanh(float x) { const float k = 0.7978845608028654f; return 0.5f * x * (1.f + tanhf(k * (x + 0.044715f * x * x * x))); }
__device__ __forceinline__ float sigmoidf_(float x) { return 1.f / (1.f + expf(-x)); }
__device__ __forceinline__ float wave_sum(float v) {
#pragma unroll
    for (int o = 32; o >= 1; o >>= 1) v += __shfl_xor(v, o);
    return v;
}
__device__ __forceinline__ float wave_max(float v) {
#pragma unroll
    for (int o = 32; o >= 1; o >>= 1) v = fmaxf(v, __shfl_xor(v, o));
    return v;
}
__device__ __forceinline__ float half_sum(float v, float* red) {
    v = wave_sum(v);
    __syncthreads();
    if ((threadIdx.x & 63) == 0) red[(threadIdx.x >> 6) & 3] = v;
    __syncthreads();
    return red[0] + red[1] + red[2] + red[3];
}
__device__ __forceinline__ float half_max(float v, float* red) {
    v = wave_max(v);
    __syncthreads();
    if ((threadIdx.x & 63) == 0) red[(threadIdx.x >> 6) & 3] = v;
    __syncthreads();
    return fmaxf(fmaxf(red[0], red[1]), fmaxf(red[2], red[3]));
}

struct Args {
    const float* in[19]; float* out; unsigned char* ws; int ph_lo, ph_hi;
};

__device__ __forceinline__ void p0_transpose_item(const float* W, int K, int N, bf16* WT, const float* gk, LAS float* scr, int item, int lane) {
    const int nblk = (N + 31) / 32, kb = item / nblk, nb = item % nblk, k0 = 64 * kb, n0 = 32 * nb;
    const bool cok = (n0 + (lane & 31)) < N;
#pragma unroll 8
    for (int i = 0; i < 32; ++i) { const int kk = 2 * i + (lane >> 5); float v = cok ? W[(size_t)(k0 + kk) * N + n0 + (lane & 31)] : 0.f; if (gk) v *= gk[k0 + kk]; scr[kk * 33 + (lane & 31)] = v; }
    asm volatile("s_waitcnt lgkmcnt(0)" ::: "memory");
    const int c = lane & 7;
#pragma unroll
    for (int j = 0; j < 4; ++j) { const int n = (lane >> 3) + 8 * j; const LAS float* s = scr + (8 * c) * 33 + n;
        v4u o; o.x = pk2(s[0 * 33], s[1 * 33]); o.y = pk2(s[2 * 33], s[3 * 33]); o.z = pk2(s[4 * 33], s[5 * 33]); o.w = pk2(s[6 * 33], s[7 * 33]);
        if (n0 + n < N) *(v4u*)(WT + (size_t)(n0 + n) * K + k0 + 8 * c) = o; }
    asm volatile("s_waitcnt lgkmcnt(0)" ::: "memory");
}
__device__ __forceinline__ void rms_row_to_bf16(const float* xrow, const float* g, bf16* orow, int lane) {
    const f32x4* xr = (const f32x4*)xrow + lane; const f32x4* gr = (const f32x4*)g + lane;
    f32x4 v[8]; float s = 0.f;
#pragma unroll
    for (int j = 0; j < 8; ++j) { v[j] = xr[64 * j]; s += (v[j].x * v[j].x + v[j].y * v[j].y) + (v[j].z * v[j].z + v[j].w * v[j].w); }
    const float r = rsqrtf(wave_sum(s) * (1.f / D_MODEL) + EPS);
    v2u* o8 = (v2u*)orow + lane;
#pragma unroll
    for (int j = 0; j < 8; ++j) { const f32x4 gv = gr[64 * j]; v2u w; w.x = pk2(v[j].x * r * gv.x, v[j].y * r * gv.y); w.y = pk2(v[j].z * r * gv.z, v[j].w * r * gv.w); o8[64 * j] = w; }
}
__device__ __forceinline__ void cvt_flat(const float* src, bf16* dst, size_t n, size_t gthread, size_t nthreads) {
    for (size_t i = gthread * 8; i < n; i += nthreads * 8) {
        const f32x4 a = *(const f32x4*)(src + i), b = *(const f32x4*)(src + i + 4);
        v4u o; o.x = pk2(a.x, a.y); o.y = pk2(a.z, a.w); o.z = pk2(b.x, b.y); o.w = pk2(b.z, b.w);
        *(v4u*)(dst + i) = o;
    }
}
__device__ __forceinline__ void ph_compress_naive(const bf16* PROJ, const float* const* in, bf16* KCB, bf16* VCB, float* ldsf, int bid, int G) {
    const int tid = threadIdx.x, grp = tid >> 7, gt = tid & 127;
    if (bid == 0) for (int i = tid; i < 2 * 8 * HD; i += NTHR) { bf16* dst = (i >= 8 * HD) ? VCB : KCB; const int k = i & (8 * HD - 1); dst[(size_t)((k >> 6) * 256 + 255) * HD + (k & 63)] = 0; }
    float* blk = ldsf + grp * 2048; float* hid = ldsf + 4 * 2048 + grp * 128;
    const int per = BATCH * NCMP * 4, nitems = 2 * per;
    for (int base = bid * 4; base < nitems; base += G * 4) {
        const int item = base + grp; const bool ok = item < nitems;
        const int kv = ok ? item / per : 0, idx = ok ? item % per : 0;
        const int g = idx & 3, n = (idx >> 2) % NCMP, b = (idx >> 2) / NCMP;
        const float* pe = in[kv ? 6 : 3]; const float* w1 = in[kv ? 7 : 4]; const float* w2 = in[kv ? 8 : 5];
        const int coff = kv ? C_VC : C_KC;
        if (ok) for (int i = gt; i < CMP_LEN * HD; i += 128) { const int l = i >> 6, dd = i & 63; blk[i] = bf2f(PROJ[(size_t)(b * SEQ + n * CMP_STRIDE + l) * PLD + coff + g * HD + dd]) + pe[i]; }
        __syncthreads();
        if (ok) { float a = 0.f;
#pragma unroll 8
            for (int k = 0; k < CMP_LEN * HD; ++k) a += blk[k] * w1[(size_t)k * CMP_HID + gt];
            hid[gt] = gelu_tanh(a); }
        __syncthreads();
        if (ok && gt < HD) { float o = 0.f;
#pragma unroll 8
            for (int k = 0; k < CMP_HID; ++k) o += hid[k] * w2[k * HD + gt];
            (kv ? VCB : KCB)[(size_t)((b * 4 + g) * 256 + n) * HD + gt] = (bf16)f2bf(o); }
        __syncthreads();
    }
}

__device__ __forceinline__ void ph_stick_naive(const bf16* PROJ, bf16* OSB, int bid, int G) {
    const int lane = threadIdx.x & 63, gw = bid * NWAVES + (threadIdx.x >> 6), NGW = G * NWAVES;
    for (int row = gw; row < BATCH * 16 * SEQ; row += NGW) {
        const int t = row % SEQ, h = (row / SEQ) & 15, b = row / (SEQ * 16);
        const float qv = bf2f(PROJ[(size_t)(b * SEQ + t) * PLD + C_QB + h * HD + lane]);
        float acc = 0.f, suffix = 0.f;
        for (int s = t - 1; s >= 0; --s) {
            const bf16* kr = PROJ + (size_t)(b * SEQ + s) * PLD;
            const float z = wave_sum(qv * bf2f(kr[C_KB + h * HD + lane])) * 0.125f;
            const float lb = fminf(z, 0.f) - log1pf(expf(-fabsf(z)));
            acc += expf(lb + suffix) * bf2f(kr[C_VB + h * HD + lane]);
            suffix += lb - z;
            if (suffix < -80.f) break;
        }
        OSB[(size_t)(b * SEQ + t) * SB_W + h * HD + lane] = (bf16)f2bf(acc);
    }
}

__device__ __forceinline__ void ph_route_naive(const bf16* QP, const float* subk, int* EXPERT, float* GATE, float* ldsf, int bid, int G) {
    const int tid = threadIdx.x, hb = tid >> 8, ht = tid & 255;
    float* base = ldsf + hb * 4608;
    float* qs = base; float (*s)[128] = (float (*)[128])(base + 2048); float (*tv)[16] = (float (*)[16])(base + 4096); int (*ti)[16] = (int (*)[16])(base + 4352);
    for (int nb = bid * 2; nb < NTOK; nb += G * 2) {
        const int n = nb + hb;
        __syncthreads();
        for (int i = ht; i < 2048; i += 256) qs[i] = bf2f(QP[(size_t)n * 2048 + i]);
        __syncthreads();
#pragma unroll 1
        for (int r = 0; r < 8; ++r) {
            const int idx = ht + 256 * r, list = idx >> 7, k = idx & 127;
            const float* kr = subk + ((size_t)list * 128 + k) * 128;
            float a = 0.f;
#pragma unroll 8
            for (int c = 0; c < 128; ++c) a += qs[list * 128 + c] * kr[c];
            s[list][k] = a;
        }
        __syncthreads();
        if (ht < 16) {
            const int l = ht;
#pragma unroll 1
            for (int r = 0; r < 16; ++r) {
                float best = -INFINITY; int bi = 0;
                for (int k = 0; k < 128; ++k) { const float v = s[l][k]; if (v > best) { best = v; bi = k; } }
                tv[l][r] = best; ti[l][r] = bi; s[l][bi] = -INFINITY;
            }
        }
        __syncthreads();
        if (ht < 8) {
            const int h = ht;
            unsigned long long used0 = 0, used1 = 0, used2 = 0, used3 = 0;
            float bsv = 0.f, mx = 0.f, sum = 0.f;
#pragma unroll 1
            for (int r = 0; r < 16; ++r) {
                float best = -INFINITY; int bidx = 0;
                for (int j = 0; j < 256; ++j) {
                    const unsigned long long u = (j < 64) ? used0 : (j < 128) ? used1 : (j < 192) ? used2 : used3;
                    if ((u >> (j & 63)) & 1ull) continue;
                    const float v = tv[2 * h][j >> 4] + tv[2 * h + 1][j & 15];
                    if (v > best) { best = v; bidx = j; }
                }
                if (bidx < 64) used0 |= 1ull << bidx; else if (bidx < 128) used1 |= 1ull << (bidx & 63); else if (bidx < 192) used2 |= 1ull << (bidx & 63); else used3 |= 1ull << (bidx & 63);
                if (r == 0) mx = best;
                const float e = expf(best - mx); sum += e; bsv = e;
                EXPERT[(size_t)n * PEER_E + h * 16 + r] = ti[2 * h][bidx >> 4] * PEER_KEYS + ti[2 * h + 1][bidx & 15];
                GATE[(size_t)n * PEER_E + h * 16 + r] = bsv;
            }
            const float inv = 1.f / sum;
            for (int r = 0; r < 16; ++r) GATE[(size_t)n * PEER_E + h * 16 + r] *= inv;
        }
    }
    __syncthreads();
}

__device__ __forceinline__ void ph_ffn_naive(const float* H, const float* ss, const float* gffn, const int* EXPERT, const float* GATE, const bf16* UB, const bf16* VB,
                                             const float* gfin, float* out, float* ldsf, int bid, int G) {
    const int tid = threadIdx.x, hb = tid >> 8, ht = tid & 255, w = ht >> 6, lane = tid & 63;
    float* part = ldsf + hb * (4 * 2048 + 8); float* red = part + 4 * 2048;
    for (int nb = bid * 2; nb < NTOK; nb += G * 2) {
        const int n = nb + hb;
        const float rstd = rsqrtf(ss[n] * (1.f / D_MODEL) + EPS);
        float xv[32], acc[32];
#pragma unroll
        for (int j = 0; j < 4; ++j) {
            const float* hp = H + (size_t)n * 2048 + j * 512 + lane * 8; const float* gp = gffn + j * 512 + lane * 8;
            const f32x4 a = *(const f32x4*)hp, b2 = *(const f32x4*)(hp + 4), ga = *(const f32x4*)gp, gb = *(const f32x4*)(gp + 4);
            xv[8 * j + 0] = a.x * rstd * ga.x; xv[8 * j + 1] = a.y * rstd * ga.y; xv[8 * j + 2] = a.z * rstd * ga.z; xv[8 * j + 3] = a.w * rstd * ga.w;
            xv[8 * j + 4] = b2.x * rstd * gb.x; xv[8 * j + 5] = b2.y * rstd * gb.y; xv[8 * j + 6] = b2.z * rstd * gb.z; xv[8 * j + 7] = b2.w * rstd * gb.w;
        }
#pragma unroll
        for (int j = 0; j < 32; ++j) acc[j] = 0.f;
#pragma unroll 1
        for (int e = 0; e < 32; ++e) {
            const int ei = EXPERT[(size_t)n * PEER_E + w * 32 + e];
            const float gt = GATE[(size_t)n * PEER_E + w * 32 + e];
            const bf16* ur = UB + (size_t)ei * 2048 + lane * 8; const bf16* vr = VB + (size_t)ei * 2048 + lane * 8;
            float d = 0.f;
#pragma unroll
            for (int j = 0; j < 4; ++j) { const v4u u4 = *(const v4u*)(ur + j * 512);
                d += xv[8 * j + 0] * bflo(u4.x) + xv[8 * j + 1] * bfhi(u4.x) + xv[8 * j + 2] * bflo(u4.y) + xv[8 * j + 3] * bfhi(u4.y)
                   + xv[8 * j + 4] * bflo(u4.z) + xv[8 * j + 5] * bfhi(u4.z) + xv[8 * j + 6] * bflo(u4.w) + xv[8 * j + 7] * bfhi(u4.w); }
            d = wave_sum(d);
            const float wgt = gt * gelu_tanh(d);
#pragma unroll
            for (int j = 0; j < 4; ++j) { const v4u v4 = *(const v4u*)(vr + j * 512);
                acc[8 * j + 0] += wgt * bflo(v4.x); acc[8 * j + 1] += wgt * bfhi(v4.x); acc[8 * j + 2] += wgt * bflo(v4.y); acc[8 * j + 3] += wgt * bfhi(v4.y);
                acc[8 * j + 4] += wgt * bflo(v4.z); acc[8 * j + 5] += wgt * bfhi(v4.z); acc[8 * j + 6] += wgt * bflo(v4.w); acc[8 * j + 7] += wgt * bfhi(v4.w); }
        }
        __syncthreads();
#pragma unroll
        for (int j = 0; j < 4; ++j)
#pragma unroll
            for (int e = 0; e < 8; ++e) part[w * 2048 + j * 512 + lane * 8 + e] = acc[8 * j + e];
        __syncthreads();
        float y[8]; float sq = 0.f;
#pragma unroll
        for (int j = 0; j < 8; ++j) { const int c = ht + 256 * j; y[j] = H[(size_t)n * 2048 + c] + part[c] + part[2048 + c] + part[4096 + c] + part[6144 + c]; sq += y[j] * y[j]; }
        const float tot = half_sum(sq, red);
        const float r = rsqrtf(tot * (1.f / D_MODEL) + EPS);
#pragma unroll
        for (int j = 0; j < 8; ++j) { const int c = ht + 256 * j; out[(size_t)n * 2048 + c] = y[j] * r * gfin[c]; }
    }
    __syncthreads();
}
namespace cmpr {
typedef short bf16x8 __attribute__((ext_vector_type(8)));
typedef float f32x4v __attribute__((ext_vector_type(4)));
__device__ __forceinline__ void compress_phase(const bf16* PROJ, const bf16* W1T, const float* BIAS1, const float* const* in, bf16* KCB, bf16* VCB,
                                               __attribute__((address_space(3))) unsigned char* lds3, int bid, int G) {
    int tid = threadIdx.x; asm volatile("" : "+v"(tid));
    const int lane = tid & 63, wid = __builtin_amdgcn_readfirstlane(tid >> 6), r16 = lane & 15, kq = lane >> 4;
    __attribute__((address_space(3))) float* PART = (__attribute__((address_space(3))) float*)lds3;
    __attribute__((address_space(3))) float* HID = (__attribute__((address_space(3))) float*)(lds3 + 65536);
    for (int unit = bid; unit < 256; unit += G) {
        const int c = unit & 15, g = (unit >> 4) & 3, b = (unit >> 6) & 1, kv = unit >> 7, n0 = 16 * c;
        const int coff = kv ? C_VC : C_KC;
        int nn = n0 + r16; if (nn > NCMP - 1) nn = NCMP - 1;
        const bf16* ap = PROJ + (size_t)(b * SEQ + 16 * nn + 4 * wid) * PLD + coff + g * HD + 8 * kq;
        const bf16* bp = W1T + (size_t)kv * CMP_HID * 2048 + (size_t)r16 * 2048 + 256 * wid + 8 * kq;
        f32x4v acc[8] = {};
#pragma unroll
        for (int ks = 0; ks < 8; ++ks) {
            const bf16x8 a = *(const bf16x8*)(ap + (size_t)(ks >> 1) * PLD + (ks & 1) * 32);
#pragma unroll
            for (int nt = 0; nt < 8; ++nt) { const bf16x8 w = *(const bf16x8*)(bp + (size_t)nt * 16 * 2048 + ks * 32); acc[nt] = __builtin_amdgcn_mfma_f32_16x16x32_bf16(a, w, acc[nt], 0, 0, 0); }
        }
#pragma unroll
        for (int nt = 0; nt < 8; ++nt)
#pragma unroll
            for (int r = 0; r < 4; ++r) PART[wid * 2048 + (kq * 4 + r) * 128 + nt * 16 + r16] = acc[nt][r];
        asm volatile("s_waitcnt lgkmcnt(0)" ::: "memory"); __syncthreads();
#pragma unroll
        for (int i = 0; i < 4; ++i) { const int e = tid + NTHR * i; float s = BIAS1[kv * CMP_HID + (e & 127)];
#pragma unroll
            for (int w = 0; w < 8; ++w) s += PART[w * 2048 + e];
            HID[e] = gelu_tanh(s); }
        asm volatile("s_waitcnt lgkmcnt(0)" ::: "memory"); __syncthreads();
        {
            const int nl = tid >> 5, d = (tid & 31) * 2; const float* w2 = in[kv ? 8 : 5];
            float o0 = 0.f, o1 = 0.f;
#pragma unroll 8
            for (int j = 0; j < CMP_HID; ++j) { const float hv = HID[nl * 128 + j]; const float2 wv = *(const float2*)(w2 + j * HD + d); o0 += hv * wv.x; o1 += hv * wv.y; }
            const int n = n0 + nl;
            const unsigned pk = (n < NCMP) ? pk2(o0, o1) : 0u;
            *(unsigned*)((kv ? VCB : KCB) + (size_t)((b * 4 + g) * 256 + n) * HD + d) = pk;
        }
        __syncthreads();
    }
}
}
namespace nsa {
typedef short bf16x8 __attribute__((ext_vector_type(8)));
typedef short s16x4 __attribute__((ext_vector_type(4)));
typedef float f32x16 __attribute__((ext_vector_type(16)));
typedef unsigned u32x4 __attribute__((ext_vector_type(4)));
typedef __attribute__((address_space(3))) const char* lds_cptr;
typedef __attribute__((address_space(3))) unsigned char* lds_ptr;
constexpr int SLOTB = 16384;
constexpr int L_RING = 0, L_OV = 49152, L_BT = 81920, L_WSF = 94720, L_MASK = 96768, L_MISC = 97280, L_X = 97408, L_END = L_X + 32768;
constexpr int BT_N = 800;
constexpr float LOG2E = 1.4426950408889634f, SC2 = 0.125f * LOG2E, NEG2 = -1e30f;
static_assert(L_END <= 131072, "nsa LDS map");
__device__ __forceinline__ int crow(int r, int hi) { return (r & 3) + 8 * (r >> 2) + 4 * hi; }
__device__ __forceinline__ void glds16(const void* gsrc, unsigned lds_dst) { unsigned keep;
    asm volatile("s_mov_b32 %0, m0\n\ts_mov_b32 m0, %2\n\ts_nop 0\n\tglobal_load_lds_dwordx4 %1, off\n\ts_mov_b32 m0, %0" : "=&s"(keep) : "v"(gsrc), "s"(lds_dst) : "memory"); }
typedef float f32x2_t __attribute__((ext_vector_type(2))); typedef __bf16 bf16x2_t __attribute__((ext_vector_type(2)));
__device__ __forceinline__ unsigned cvtpk_s(float lo, float hi) { f32x2_t v = {lo, hi}; bf16x2_t b = __builtin_convertvector(v, bf16x2_t); return __builtin_bit_cast(unsigned, b); }
#define NSA_WAIT_BAR(N) asm volatile("s_waitcnt vmcnt(" #N ") lgkmcnt(0)\n\ts_barrier" ::: "memory")
#define NSA_SBAR() __builtin_amdgcn_sched_barrier(0)

__device__ __forceinline__ void qkt(f32x16& p0, f32x16& p1, lds_cptr Kslot, const bf16x8* qr, int r32, int hi) {
    lds_cptr kb = Kslot + hi * 1024 + r32 * 16;
    const f32x16 z = {};
#pragma unroll
    for (int d0 = 0; d0 < 4; ++d0) {
        const bf16x8 b0 = *(const __attribute__((address_space(3))) bf16x8*)(kb + d0 * 2048);
        const bf16x8 b1 = *(const __attribute__((address_space(3))) bf16x8*)(kb + d0 * 2048 + 512);
        if (d0 == 0) { p0 = __builtin_amdgcn_mfma_f32_32x32x16_bf16(b0, qr[0], z, 0, 0, 0); p1 = __builtin_amdgcn_mfma_f32_32x32x16_bf16(b1, qr[0], z, 0, 0, 0); }
        else { p0 = __builtin_amdgcn_mfma_f32_32x32x16_bf16(b0, qr[d0], p0, 0, 0, 0); p1 = __builtin_amdgcn_mfma_f32_32x32x16_bf16(b1, qr[d0], p1, 0, 0, 0); }
    }
}
__device__ __forceinline__ void pv(f32x16* o, int vb, bf16x8 pa0, bf16x8 pa1, bf16x8 pa2, bf16x8 pa3) {
#pragma unroll
    for (int d0 = 0; d0 < 2; ++d0) { s16x4 lo[4], hi[4];
#pragma unroll
        for (int ks = 0; ks < 4; ++ks) {
            asm volatile("ds_read_b64_tr_b16 %0,%1 offset:%c2" : "=&v"(lo[ks]) : "v"(vb), "i"(d0 * 4096 + ks * 1024) : "memory");
            asm volatile("ds_read_b64_tr_b16 %0,%1 offset:%c2" : "=&v"(hi[ks]) : "v"(vb), "i"(d0 * 4096 + ks * 1024 + 512) : "memory"); }
        asm volatile("s_waitcnt lgkmcnt(0)" ::: "memory"); NSA_SBAR();
#define NSA_PK(k) (bf16x8){lo[k][0], lo[k][1], lo[k][2], lo[k][3], hi[k][0], hi[k][1], hi[k][2], hi[k][3]}
        o[d0] = __builtin_amdgcn_mfma_f32_32x32x16_bf16(pa0, NSA_PK(0), o[d0], 0, 0, 0);
        o[d0] = __builtin_amdgcn_mfma_f32_32x32x16_bf16(pa1, NSA_PK(1), o[d0], 0, 0, 0);
        o[d0] = __builtin_amdgcn_mfma_f32_32x32x16_bf16(pa2, NSA_PK(2), o[d0], 0, 0, 0);
        o[d0] = __builtin_amdgcn_mfma_f32_32x32x16_bf16(pa3, NSA_PK(3), o[d0], 0, 0, 0);
#undef NSA_PK
    }
}
__device__ __forceinline__ float rowmax32(const f32x16& p0, const f32x16& p1) {
    float a = fmaxf(p0[0], p1[0]);
#pragma unroll
    for (int r = 1; r < 16; ++r) a = fmaxf(a, fmaxf(p0[r], p1[r]));
    auto rr = __builtin_amdgcn_permlane32_swap(__float_as_uint(a), __float_as_uint(a), false, false);
    return fmaxf(__uint_as_float(rr[0]), __uint_as_float(rr[1]));
}
__device__ __forceinline__ float swap_add(float v) {
    auto rr = __builtin_amdgcn_permlane32_swap(__float_as_uint(v), __float_as_uint(v), false, false);
    return __uint_as_float(rr[0]) + __uint_as_float(rr[1]);
}

struct PassCtx {
    lds_ptr lds3; unsigned lds0;
    int lane, r32, hi, wid;
    int tq;
    const __attribute__((address_space(3))) float* bt;
    __attribute__((address_space(3))) float* wsf;
    int vboff;
};

template <int MODE>
__device__ __forceinline__ void run_pass(const PassCtx& c, int NT, int first, const bf16* Kb, const bf16* Vb, int pitch, const bf16x8* qr,
                                         unsigned mask_lo, unsigned mask_hi, f32x16 (&o)[2], f32x16 (&im)[2], float& m, float& l) {
    const __attribute__((address_space(3))) unsigned char* TL = (const __attribute__((address_space(3))) unsigned char*)(c.lds3 + L_MISC);
#define NSA_TID(i) ((MODE == 0) ? (i) : (MODE == 2) ? (first + (i)) : (int)TL[(i)])
#define NSA_ISSUE(i, slot) do { const int id_ = __builtin_amdgcn_readfirstlane(NSA_TID(i)); \
        const bf16* ks_ = Kb + (size_t)(64 * id_ + c.lane) * pitch + 8 * c.wid; \
        const bf16* vs_ = Vb + (size_t)(64 * id_ + 16 * (c.wid & 3) + (c.lane >> 2)) * pitch + 32 * (c.wid >> 2) + 8 * (c.lane & 3); \
        glds16(ks_, (unsigned)__builtin_amdgcn_readfirstlane(c.lds0 + L_RING + (slot) * SLOTB + c.wid * 1024)); \
        glds16(vs_, (unsigned)__builtin_amdgcn_readfirstlane(c.lds0 + L_RING + (slot) * SLOTB + 8192 + c.wid * 1024)); } while (0)
    if (NT > 0) NSA_ISSUE(0, 0);
    if (NT > 1) NSA_ISSUE(1, 1);
    int slot = 0;
    for (int i = 0; i < NT; ++i) {
        if (i + 1 < NT) NSA_WAIT_BAR(2); else NSA_WAIT_BAR(0);
        if (i + 2 < NT) { const int s2 = (slot == 0) ? 2 : slot - 1; NSA_ISSUE(i + 2, s2); }
        const int id = __builtin_amdgcn_readfirstlane(NSA_TID(i));
        f32x16 p0, p1;
        qkt(p0, p1, (lds_cptr)(c.lds3 + L_RING + slot * SLOTB), qr, c.r32, c.hi);
        const int dbase = (MODE == 0) ? (c.tq - 31 - 1024 * id) : (c.tq - 64 * id);
        bool selb = true;
        if (MODE == 1) selb = ((id < 32 ? (mask_lo >> id) : (mask_hi >> (id - 32))) & 1u) != 0u;
#pragma unroll
        for (int r = 0; r < 16; ++r) {
            const int k0 = crow(r, c.hi);
            const int d0 = (MODE == 0) ? (dbase - 16 * k0) : (dbase - k0);
            const int d1 = (MODE == 0) ? (d0 - 512) : (d0 - 32);
            bool v0 = d0 >= 0, v1 = d1 >= 0;
            if (MODE == 2) { v0 = v0 && d0 < WINDOW; v1 = v1 && d1 < WINDOW; }
            if (MODE == 1) { v0 = v0 && selb; v1 = v1 && selb; }
            const int i0 = d0 < 0 ? 0 : (d0 > 790 ? 790 : d0), i1 = d1 < 0 ? 0 : (d1 > 790 ? 790 : d1);
            const float s0 = p0[r] * SC2 + c.bt[i0], s1 = p1[r] * SC2 + c.bt[i1];
            p0[r] = v0 ? s0 : NEG2; p1[r] = v1 ? s1 : NEG2;
        }
        const float mt = rowmax32(p0, p1);
        const float mnew = fmaxf(m, mt);
        const float alpha = __builtin_amdgcn_exp2f(m - mnew);
        m = mnew;
        float rs = 0.f;
#pragma unroll
        for (int r = 0; r < 16; ++r) {
            const float e0 = (p0[r] > -1e29f) ? __builtin_amdgcn_exp2f(p0[r] - mnew) : 0.f;
            const float e1 = (p1[r] > -1e29f) ? __builtin_amdgcn_exp2f(p1[r] - mnew) : 0.f;
            p0[r] = e0; p1[r] = e1; rs += e0 + e1;
        }
        l = l * alpha + rs;
        if (!__all(alpha == 1.f)) {
            if (c.hi == 0) c.wsf[c.r32] = alpha;
            asm volatile("s_waitcnt lgkmcnt(0)" ::: "memory");
#pragma unroll
            for (int r = 0; r < 16; ++r) { const float a = c.wsf[crow(r, c.hi)]; o[0][r] *= a; o[1][r] *= a; if (MODE == 0) { im[0][r] *= a; im[1][r] *= a; } }
        }
        u32x4 pw0, pw1, pw2, pw3;
        pw0 = (u32x4){cvtpk_s(p0[0], p0[1]), cvtpk_s(p0[2], p0[3]), cvtpk_s(p0[4], p0[5]), cvtpk_s(p0[6], p0[7])};
        pw1 = (u32x4){cvtpk_s(p0[8], p0[9]), cvtpk_s(p0[10], p0[11]), cvtpk_s(p0[12], p0[13]), cvtpk_s(p0[14], p0[15])};
        pw2 = (u32x4){cvtpk_s(p1[0], p1[1]), cvtpk_s(p1[2], p1[3]), cvtpk_s(p1[4], p1[5]), cvtpk_s(p1[6], p1[7])};
        pw3 = (u32x4){cvtpk_s(p1[8], p1[9]), cvtpk_s(p1[10], p1[11]), cvtpk_s(p1[12], p1[13]), cvtpk_s(p1[14], p1[15])};
        NSA_SBAR();
        pv(o, (int)(c.lds0 + L_RING + slot * SLOTB + 8192) + c.vboff, __builtin_bit_cast(bf16x8, pw0), __builtin_bit_cast(bf16x8, pw1), __builtin_bit_cast(bf16x8, pw2), __builtin_bit_cast(bf16x8, pw3));
        if (MODE == 0) pv(im, (int)(c.lds0 + L_OV + id * 8192) + c.vboff, __builtin_bit_cast(bf16x8, pw0), __builtin_bit_cast(bf16x8, pw1), __builtin_bit_cast(bf16x8, pw2), __builtin_bit_cast(bf16x8, pw3));
        slot = (slot == 2) ? 0 : slot + 1;
    }
    asm volatile("s_waitcnt vmcnt(0) lgkmcnt(0)\n\ts_barrier" ::: "memory");
#undef NSA_TID
#undef NSA_ISSUE
}

__device__ __forceinline__ void build_ov(lds_ptr lds3) {
    for (int idx = threadIdx.x; idx < 4 * 4096; idx += NTHR) {
        const int kt = idx >> 12, nl = (idx >> 6) & 63, jc = idx & 63, n = 64 * kt + nl;
        unsigned short v = 0;
        if ((n & 3) != 3) { if (jc == (n >> 2)) v = 0x3F80; } else { if (jc == (n >> 2) || jc == (n >> 2) + 1) v = 0x3F00; }
        *(__attribute__((address_space(3))) unsigned short*)(lds3 + L_OV + kt * 8192 + ((jc >> 5) * 4 + (nl >> 4)) * 1024 + (nl & 15) * 64 + (jc & 31) * 2) = v;
    }
}

__device__ __forceinline__ void nsa_unit(int b, int g, int qt, const bf16* PROJ, const bf16* KCBb, const bf16* VCBb, const float* rel, bf16* ONSA, lds_ptr lds3, unsigned lds0) {
    const int tid = threadIdx.x, lane = tid & 63, r32 = lane & 31, hi = lane >> 5;
    const int wid = __builtin_amdgcn_readfirstlane(tid >> 6), hh = wid & 3, th = wid >> 2;
    const int t0 = qt * 64, tq = t0 + 32 * th + r32, cur = qt;
    __attribute__((address_space(3))) float* BT = (__attribute__((address_space(3))) float*)(lds3 + L_BT);
    __attribute__((address_space(3))) unsigned* MASK = (__attribute__((address_space(3))) unsigned*)(lds3 + L_MASK);
    for (int i = tid; i < 4 * BT_N; i += NTHR) { const int hq = i / BT_N, d = i - hq * BT_N; BT[i] = rel[rel_bucket(d) * 16 + g * 4 + hq] * LOG2E; }
    if (tid < 128) MASK[tid] = 0u;
    PassCtx c; c.lds3 = lds3; c.lds0 = lds0; c.lane = lane; c.r32 = r32; c.hi = hi; c.wid = wid; c.tq = tq;
    c.bt = BT + hh * BT_N; c.wsf = (__attribute__((address_space(3))) float*)(lds3 + L_WSF) + wid * 64;
    c.vboff = ((lane >> 4) & 1) * 32 + (lane & 3) * 8 + (4 * hi + ((lane & 15) >> 2)) * 64;
    const size_t qrow = (size_t)(b * SEQ + tq) * PLD;
    bf16x8 qr[4];
#pragma unroll
    for (int d0 = 0; d0 < 4; ++d0) qr[d0] = *(const bf16x8*)(PROJ + qrow + C_QN + (g * 4 + hh) * HD + d0 * 16 + hi * 8);
    const float gate0 = 1.f / (1.f + __expf(-bf2f(PROJ[qrow + C_GBR + 0 * 16 + g * 4 + hh])));
    const float gate1 = 1.f / (1.f + __expf(-bf2f(PROJ[qrow + C_GBR + 1 * 16 + g * 4 + hh])));
    const float gate2 = 1.f / (1.f + __expf(-bf2f(PROJ[qrow + C_GBR + 2 * 16 + g * 4 + hh])));
    asm volatile("s_waitcnt vmcnt(0) lgkmcnt(0)" ::: "memory");
    __syncthreads();
    f32x16 oc[2] = {}, o[2] = {}, im[2] = {};
    float m = NEG2, l = 0.f;
    {
        int cnt = (t0 + 32) / 16 + 1; if (cnt > NCMP) cnt = NCMP;
        const int NT = (cnt + 63) >> 6;
        run_pass<0>(c, NT, 0, KCBb + (size_t)(b * 4 + g) * 256 * HD, VCBb + (size_t)(b * 4 + g) * 256 * HD, HD, qr, 0u, 0u, o, im, m, l);
        const float lt = swap_add(l);
        const float inv = lt > 0.f ? 1.f / lt : 0.f;
        if (hi == 0) { c.wsf[r32] = inv * gate0; c.wsf[32 + r32] = inv; }
        asm volatile("s_waitcnt lgkmcnt(0)" ::: "memory");
#pragma unroll
        for (int r = 0; r < 16; ++r) { const float a = c.wsf[crow(r, hi)], a2 = c.wsf[32 + crow(r, hi)]; oc[0][r] = o[0][r] * a; oc[1][r] = o[1][r] * a; im[0][r] *= a2; im[1][r] *= a2; }
        __attribute__((address_space(3))) float* X = (__attribute__((address_space(3))) float*)(lds3 + L_X);
        const int area = (hh >> 1) * 2 + th;
        if (hh & 1) {
#pragma unroll
            for (int d0 = 0; d0 < 2; ++d0)
#pragma unroll
                for (int r = 0; r < 16; ++r) X[area * 2048 + crow(r, hi) * 64 + d0 * 32 + r32] = im[d0][r];
        }
        asm volatile("s_waitcnt lgkmcnt(0)" ::: "memory"); __syncthreads();
        if (!(hh & 1)) {
#pragma unroll
            for (int d0 = 0; d0 < 2; ++d0)
#pragma unroll
                for (int r = 0; r < 16; ++r) { im[d0][r] += X[area * 2048 + crow(r, hi) * 64 + d0 * 32 + r32]; if (hh == 2) X[area * 2048 + crow(r, hi) * 64 + d0 * 32 + r32] = im[d0][r]; }
        }
        asm volatile("s_waitcnt lgkmcnt(0)" ::: "memory"); __syncthreads();
        __attribute__((address_space(3))) float* T = (__attribute__((address_space(3))) float*)(lds3 + L_RING);
        if (hh == 0) {
#pragma unroll
            for (int d0 = 0; d0 < 2; ++d0)
#pragma unroll
                for (int r = 0; r < 16; ++r) T[(32 * th + crow(r, hi)) * 65 + d0 * 32 + r32] = im[d0][r] + X[(2 + th) * 2048 + crow(r, hi) * 64 + d0 * 32 + r32];
        }
        asm volatile("s_waitcnt lgkmcnt(0)" ::: "memory"); __syncthreads();
        {
            const int tok = tid & 63, jg = wid;
            float v[8]; int rank[8];
#pragma unroll
            for (int e = 0; e < 8; ++e) { const int j = 8 * jg + e; const bool forced = (j == 0) || (cur - j >= 0 && cur - j < 2);
                v[e] = (j <= cur) ? T[tok * 65 + j] + (forced ? 1e4f : 0.f) : -INFINITY; rank[e] = 0; }
            for (int j2 = 0; j2 < 64; ++j2) {
                const bool f2 = (j2 == 0) || (cur - j2 >= 0 && cur - j2 < 2);
                const float sv = (j2 <= cur) ? T[tok * 65 + j2] + (f2 ? 1e4f : 0.f) : -INFINITY;
#pragma unroll
                for (int e = 0; e < 8; ++e) { const int j = 8 * jg + e; rank[e] += (sv > v[e] || (sv == v[e] && j2 < j)) ? 1 : 0; }
            }
            unsigned bits = 0u;
#pragma unroll
            for (int e = 0; e < 8; ++e) { const int j = 8 * jg + e; if (j <= cur && rank[e] < SEL_TOPK) bits |= 1u << e; }
            if (bits) atomicOr((unsigned*)(MASK + tok * 2 + (jg >> 2)), bits << ((jg & 3) * 8));
        }
        asm volatile("s_waitcnt lgkmcnt(0)" ::: "memory"); __syncthreads();
        if (wid == 0) {
            unsigned ulo = MASK[lane * 2], uhi = MASK[lane * 2 + 1];
#pragma unroll
            for (int ofs = 32; ofs >= 1; ofs >>= 1) { ulo |= __shfl_xor(ulo, ofs); uhi |= __shfl_xor(uhi, ofs); }
            if (lane == 0) {
                __attribute__((address_space(3))) unsigned char* TL = (__attribute__((address_space(3))) unsigned char*)(lds3 + L_MISC);
                int n = 0; unsigned long long mm = ((unsigned long long)uhi << 32) | ulo;
                while (mm) { const int bp = __ffsll((long long)mm) - 1; TL[n++] = (unsigned char)bp; mm &= mm - 1; }
                *(__attribute__((address_space(3))) int*)(lds3 + L_MISC + 64) = n;
            }
        }
        asm volatile("s_waitcnt lgkmcnt(0)" ::: "memory"); __syncthreads();
    }
    {
        const unsigned mlo = MASK[(32 * th + r32) * 2], mhi = MASK[(32 * th + r32) * 2 + 1];
        const int NT = __builtin_amdgcn_readfirstlane(*(__attribute__((address_space(3))) int*)(lds3 + L_MISC + 64));
        o[0] = f32x16{}; o[1] = f32x16{}; m = NEG2; l = 0.f;
        run_pass<1>(c, NT, 0, PROJ + (size_t)b * SEQ * PLD + C_KS + g * HD, PROJ + (size_t)b * SEQ * PLD + C_VS + g * HD, PLD, qr, mlo, mhi, o, im, m, l);
        const float lt = swap_add(l);
        const float inv = lt > 0.f ? 1.f / lt : 0.f;
        if (hi == 0) c.wsf[r32] = inv * gate1;
        asm volatile("s_waitcnt lgkmcnt(0)" ::: "memory");
#pragma unroll
        for (int r = 0; r < 16; ++r) { const float a = c.wsf[crow(r, hi)]; oc[0][r] += o[0][r] * a; oc[1][r] += o[1][r] * a; }
    }
    {
        const int jlo = (qt - 8) > 0 ? (qt - 8) : 0, NT = qt - jlo + 1;
        o[0] = f32x16{}; o[1] = f32x16{}; m = NEG2; l = 0.f;
        run_pass<2>(c, NT, jlo, PROJ + (size_t)b * SEQ * PLD + C_KW + g * HD, PROJ + (size_t)b * SEQ * PLD + C_VW + g * HD, PLD, qr, 0u, 0u, o, im, m, l);
        const float lt = swap_add(l);
        const float inv = lt > 0.f ? 1.f / lt : 0.f;
        if (hi == 0) c.wsf[r32] = inv * gate2;
        asm volatile("s_waitcnt lgkmcnt(0)" ::: "memory");
#pragma unroll
        for (int r = 0; r < 16; ++r) { const float a = c.wsf[crow(r, hi)]; oc[0][r] += o[0][r] * a; oc[1][r] += o[1][r] * a; }
    }
    {
        __attribute__((address_space(3))) unsigned short* stg = (__attribute__((address_space(3))) unsigned short*)(lds3 + L_X) + wid * 2048;
#pragma unroll
        for (int r = 0; r < 16; ++r) { const int orow = crow(r, hi);
#pragma unroll
            for (int d0 = 0; d0 < 2; ++d0) stg[orow * 64 + d0 * 32 + r32] = (unsigned short)f2bf(oc[d0][r]); }
        asm volatile("s_waitcnt lgkmcnt(0)" ::: "memory");
        bf16* Ow = ONSA + (size_t)(b * SEQ + t0 + 32 * th) * NSA_Q + (g * 4 + hh) * HD;
#pragma unroll
        for (int i = 0; i < 4; ++i) { const int row = i * 8 + (lane >> 3), ch = lane & 7;
            const u32x4 vv = *(const __attribute__((address_space(3))) u32x4*)(stg + row * 64 + ch * 8);
            *(u32x4*)(Ow + (size_t)row * NSA_Q + ch * 8) = vv; }
    }
    asm volatile("s_waitcnt vmcnt(0) lgkmcnt(0)" ::: "memory");
    __syncthreads();
}

__device__ __forceinline__ void nsa_phase(const bf16* PROJ, const bf16* KCBb, const bf16* VCBb, const float* rel, bf16* ONSA, lds_ptr lds3, int vcu, int G) {
    const unsigned lds0 = (unsigned)(uintptr_t)lds3;
    build_ov(lds3);
    __syncthreads();
    for (int i = vcu; i < 512; i += G) {
        const int k = i & 255, bg = k >> 5, s = k & 31, qt = (i < 256) ? s : 63 - s;
        nsa_unit(bg >> 2, bg & 3, qt, PROJ, KCBb, VCBb, rel, ONSA, lds3, lds0);
    }
}
#undef NSA_WAIT_BAR
#undef NSA_SBAR
}
namespace nsa {
constexpr float STICK_THR = 50.f, LN2F = 0.6931471805599453f;
#define NSA_WAIT_BAR(N) asm volatile("s_waitcnt vmcnt(" #N ") lgkmcnt(0)\n\ts_barrier" ::: "memory")
__device__ __forceinline__ void stick_unit(int tid, int b, int h, int qb, const bf16* PROJ, bf16* OSB, lds_ptr lds3, unsigned lds0, const bf16x8 (&tri)[2]) {
    const int lane = tid & 63, r32 = lane & 31, hi = lane >> 5;
    const int wid = __builtin_amdgcn_readfirstlane(tid >> 6);
    const int q0 = qb * 256, t = q0 + 32 * wid + r32;
    const bf16* Kb = PROJ + (size_t)b * SEQ * PLD + C_KB + h * HD;
    const bf16* Vb = PROJ + (size_t)b * SEQ * PLD + C_VB + h * HD;
    __attribute__((address_space(3))) int* DONE = (__attribute__((address_space(3))) int*)(lds3 + L_MISC);
    bf16x8 qr[4];
#pragma unroll
    for (int d0 = 0; d0 < 4; ++d0) qr[d0] = *(const bf16x8*)(PROJ + (size_t)(b * SEQ + t) * PLD + C_QB + h * HD + d0 * 16 + hi * 8);
    if (tid < 8) DONE[tid] = 0x7fffffff;
    asm volatile("s_waitcnt vmcnt(0) lgkmcnt(0)" ::: "memory");
    __syncthreads();
    const int jhi = 4 * qb + 3, NT = jhi + 1;
    const int jw = (q0 + 32 * wid + 30) >> 6;
    const int vboff = ((lane >> 4) & 1) * 32 + (lane & 3) * 8 + (4 * hi + ((lane & 15) >> 2)) * 64;
    f32x16 o[2] = {};
    float carry = 0.f; bool mydone = false;
#define STK_ISSUE(i, slot) do { const int id_ = jhi - (i); \
        const bf16* ks_ = Kb + (size_t)(64 * id_ + lane) * PLD + 8 * wid; \
        const bf16* vs_ = Vb + (size_t)(64 * id_ + 16 * (wid & 3) + (lane >> 2)) * PLD + 32 * (wid >> 2) + 8 * (lane & 3); \
        glds16(ks_, (unsigned)__builtin_amdgcn_readfirstlane(lds0 + L_RING + (slot) * SLOTB + wid * 1024)); \
        glds16(vs_, (unsigned)__builtin_amdgcn_readfirstlane(lds0 + L_RING + (slot) * SLOTB + 8192 + wid * 1024)); } while (0)
    STK_ISSUE(0, 0);
    if (NT > 1) STK_ISSUE(1, 1);
    int slot = 0;
    for (int i = 0; i < NT; ++i) {
        if (i + 1 < NT) NSA_WAIT_BAR(2); else NSA_WAIT_BAR(0);
        bool alld = true;
#pragma unroll
        for (int w = 0; w < 8; ++w) alld = alld && (DONE[w] < i);
        if (__builtin_amdgcn_readfirstlane((int)alld)) break;
        if (i + 2 < NT) { const int s2 = (slot == 0) ? 2 : slot - 1; STK_ISSUE(i + 2, s2); }
        const int j = jhi - i;
        if (!mydone && j <= jw) {
            f32x16 p0, p1, x0, x1;
            qkt(p0, p1, (lds_cptr)(lds3 + L_RING + slot * SLOTB), qr, r32, hi);
            float s0 = 0.f, s1 = 0.f;
#pragma unroll
            for (int r = 0; r < 16; ++r) {
                const int pos0 = 64 * j + crow(r, hi);
                const float z0 = p0[r] * 0.125f, z1 = p1[r] * 0.125f;
                const float L0 = __builtin_amdgcn_logf(1.f + __builtin_amdgcn_exp2f(-fabsf(z0) * LOG2E)) * LN2F;
                const float L1 = __builtin_amdgcn_logf(1.f + __builtin_amdgcn_exp2f(-fabsf(z1) * LOG2E)) * LN2F;
                p0[r] = fminf(z0, 0.f) - L0; p1[r] = fminf(z1, 0.f) - L1;
                x0[r] = (pos0 < t) ? (-fmaxf(z0, 0.f) - L0) : 0.f; x1[r] = (pos0 + 32 < t) ? (-fmaxf(z1, 0.f) - L1) : 0.f;
                s0 += x0[r]; s1 += x1[r];
            }
            const float tot0 = swap_add(s0), tot1 = swap_add(s1);
            u32x4 h0a, h0b, l0a, l0b, h1a, h1b, l1a, l1b;
#define STK_SPLIT(X, HA, HB, LA, LB) do { unsigned hw_[8]; float lo_[16]; \
                _Pragma("unroll") for (int q_ = 0; q_ < 8; ++q_) { hw_[q_] = cvtpk_s(X[2 * q_], X[2 * q_ + 1]); \
                    lo_[2 * q_] = X[2 * q_] - __uint_as_float(hw_[q_] << 16); lo_[2 * q_ + 1] = X[2 * q_ + 1] - __uint_as_float(hw_[q_] & 0xffff0000u); } \
                HA = (u32x4){hw_[0], hw_[1], hw_[2], hw_[3]}; HB = (u32x4){hw_[4], hw_[5], hw_[6], hw_[7]}; \
                LA = (u32x4){cvtpk_s(lo_[0], lo_[1]), cvtpk_s(lo_[2], lo_[3]), cvtpk_s(lo_[4], lo_[5]), cvtpk_s(lo_[6], lo_[7])}; \
                LB = (u32x4){cvtpk_s(lo_[8], lo_[9]), cvtpk_s(lo_[10], lo_[11]), cvtpk_s(lo_[12], lo_[13]), cvtpk_s(lo_[14], lo_[15])}; } while (0)
            STK_SPLIT(x0, h0a, h0b, l0a, l0b);
            STK_SPLIT(x1, h1a, h1b, l1a, l1b);
#undef STK_SPLIT
            f32x16 y0, y1;
#pragma unroll
            for (int r = 0; r < 16; ++r) { y0[r] = carry + tot1; y1[r] = carry; }
            y0 = __builtin_amdgcn_mfma_f32_32x32x16_bf16(tri[0], __builtin_bit_cast(bf16x8, h0a), y0, 0, 0, 0);
            y0 = __builtin_amdgcn_mfma_f32_32x32x16_bf16(tri[1], __builtin_bit_cast(bf16x8, h0b), y0, 0, 0, 0);
            y0 = __builtin_amdgcn_mfma_f32_32x32x16_bf16(tri[0], __builtin_bit_cast(bf16x8, l0a), y0, 0, 0, 0);
            y0 = __builtin_amdgcn_mfma_f32_32x32x16_bf16(tri[1], __builtin_bit_cast(bf16x8, l0b), y0, 0, 0, 0);
            y1 = __builtin_amdgcn_mfma_f32_32x32x16_bf16(tri[0], __builtin_bit_cast(bf16x8, h1a), y1, 0, 0, 0);
            y1 = __builtin_amdgcn_mfma_f32_32x32x16_bf16(tri[1], __builtin_bit_cast(bf16x8, h1b), y1, 0, 0, 0);
            y1 = __builtin_amdgcn_mfma_f32_32x32x16_bf16(tri[0], __builtin_bit_cast(bf16x8, l1a), y1, 0, 0, 0);
            y1 = __builtin_amdgcn_mfma_f32_32x32x16_bf16(tri[1], __builtin_bit_cast(bf16x8, l1b), y1, 0, 0, 0);
#pragma unroll
            for (int r = 0; r < 16; ++r) {
                const int pos0 = 64 * j + crow(r, hi);
                y0[r] = (pos0 < t) ? __builtin_amdgcn_exp2f((p0[r] + y0[r]) * LOG2E) : 0.f;
                y1[r] = (pos0 + 32 < t) ? __builtin_amdgcn_exp2f((p1[r] + y1[r]) * LOG2E) : 0.f;
            }
            carry += tot0 + tot1;
            u32x4 pw0, pw1, pw2, pw3;
            pw0 = (u32x4){cvtpk_s(y0[0], y0[1]), cvtpk_s(y0[2], y0[3]), cvtpk_s(y0[4], y0[5]), cvtpk_s(y0[6], y0[7])};
            pw1 = (u32x4){cvtpk_s(y0[8], y0[9]), cvtpk_s(y0[10], y0[11]), cvtpk_s(y0[12], y0[13]), cvtpk_s(y0[14], y0[15])};
            pw2 = (u32x4){cvtpk_s(y1[0], y1[1]), cvtpk_s(y1[2], y1[3]), cvtpk_s(y1[4], y1[5]), cvtpk_s(y1[6], y1[7])};
            pw3 = (u32x4){cvtpk_s(y1[8], y1[9]), cvtpk_s(y1[10], y1[11]), cvtpk_s(y1[12], y1[13]), cvtpk_s(y1[14], y1[15])};
            __builtin_amdgcn_sched_barrier(0);
            pv(o, (int)(lds0 + L_RING + slot * SLOTB + 8192) + vboff, __builtin_bit_cast(bf16x8, pw0), __builtin_bit_cast(bf16x8, pw1), __builtin_bit_cast(bf16x8, pw2), __builtin_bit_cast(bf16x8, pw3));
            mydone = __all(carry < -STICK_THR) != 0;
            if (mydone && lane == 0) DONE[wid] = i;
        }
        slot = (slot == 2) ? 0 : slot + 1;
    }
    asm volatile("s_waitcnt vmcnt(0) lgkmcnt(0)\n\ts_barrier" ::: "memory");
#undef STK_ISSUE
    {
        __attribute__((address_space(3))) unsigned short* stg = (__attribute__((address_space(3))) unsigned short*)(lds3 + L_X) + wid * 2048;
#pragma unroll
        for (int r = 0; r < 16; ++r) { const int orow = crow(r, hi);
#pragma unroll
            for (int d0 = 0; d0 < 2; ++d0) stg[orow * 64 + d0 * 32 + r32] = (unsigned short)f2bf(o[d0][r]); }
        asm volatile("s_waitcnt lgkmcnt(0)" ::: "memory");
        bf16* Ow = OSB + (size_t)(b * SEQ + q0 + 32 * wid) * SB_W + h * HD;
#pragma unroll
        for (int i = 0; i < 4; ++i) { const int row = i * 8 + (lane >> 3), ch = lane & 7;
            const u32x4 vv = *(const __attribute__((address_space(3))) u32x4*)(stg + row * 64 + ch * 8);
            *(u32x4*)(Ow + (size_t)row * SB_W + ch * 8) = vv; }
    }
    asm volatile("s_waitcnt vmcnt(0) lgkmcnt(0)" ::: "memory");
    __syncthreads();
}
__device__ __forceinline__ void stick_phase(const bf16* PROJ, bf16* OSB, lds_ptr lds3, int vcu, int G) {
    const unsigned lds0 = (unsigned)(uintptr_t)lds3;
    int tid = threadIdx.x; asm volatile("" : "+v"(tid));
    const int lane = tid & 63, r32 = lane & 31, hi = lane >> 5;
    bf16x8 tri[2];
#pragma unroll
    for (int s = 0; s < 2; ++s)
#pragma unroll
        for (int j = 0; j < 8; ++j) tri[s][j] = ((16 * s + 8 * (j >> 2) + 4 * hi + (j & 3)) > r32) ? (short)0x3F80 : (short)0;
    for (int i = vcu; i < 512; i += G) {
        const int bh = i >> 4, qb = i & 15;
        stick_unit(tid, bh >> 4, bh & 15, qb, PROJ, OSB, lds3, lds0, tri);
    }
}
#undef NSA_WAIT_BAR
}
namespace peer {
typedef short bf16x8 __attribute__((ext_vector_type(8)));
typedef float f32x16 __attribute__((ext_vector_type(16)));
typedef __bf16 b2_t __attribute__((ext_vector_type(2)));
constexpr int L_EX = 0, L_GT = 16384;
__device__ __forceinline__ int crow(int r, int hi) { return (r & 3) + 8 * (r >> 2) + 4 * hi; }
__device__ __forceinline__ unsigned mono(float f) { const unsigned u = __float_as_uint(f); return (u & 0x80000000u) ? ~u : (u | 0x80000000u); }
__device__ __forceinline__ float unmono(unsigned k) { return __uint_as_float((k & 0x80000000u) ? (k & 0x7fffffffu) : ~k); }
__device__ __forceinline__ float dot2(unsigned a, unsigned b, float c) { return __builtin_amdgcn_fdot2_f32_bf16(__builtin_bit_cast(b2_t, a), __builtin_bit_cast(b2_t, b), c, false); }
#define PEER_CE(key, slot) do { const unsigned hi_ = (key) > (slot) ? (key) : (slot); (key) = (key) > (slot) ? (slot) : (key); (slot) = hi_; } while (0)

__device__ __forceinline__ void route_list(const bf16* QP, const bf16* SKB, int L, int tok0, int r32, int hi, unsigned (&out)[16]) {
    f32x16 acc[4] = {};
    const bf16* qp = QP + (size_t)(tok0 + r32) * 2048 + L * 128 + hi * 8;
    const bf16* kp = SKB + ((size_t)L * 128 + r32) * 128 + hi * 8;
    int hi4 = 4 * hi;
    asm volatile("" : "+v"(qp), "+v"(kp), "+v"(hi4));
#pragma unroll
    for (int ks = 0; ks < 8; ++ks) {
        const bf16x8 bq = *(const bf16x8*)(qp + ks * 16);
#pragma unroll
        for (int kt = 0; kt < 4; ++kt) { const bf16x8 a = *(const bf16x8*)(kp + (size_t)kt * 32 * 128 + ks * 16); acc[kt] = __builtin_amdgcn_mfma_f32_32x32x16_bf16(a, bq, acc[kt], 0, 0, 0); }
    }
    unsigned t[16];
#pragma unroll
    for (int k = 0; k < 16; ++k) t[k] = 0u;
#pragma unroll
    for (int kt = 0; kt < 4; ++kt)
#pragma unroll
        for (int r = 0; r < 16; ++r) {
            unsigned key = ((mono(acc[kt][r]) & ~127u) | (unsigned)(127 - (32 * kt + (r & 3) + 8 * (r >> 2)))) - (unsigned)hi4;
#pragma unroll
            for (int k = 0; k < 16; ++k) PEER_CE(key, t[k]);
            __builtin_amdgcn_sched_barrier(0);
        }
    unsigned u[16];
#pragma unroll
    for (int k = 0; k < 16; ++k) { auto rr = __builtin_amdgcn_permlane32_swap(t[k], t[k], false, false); u[k] = hi ? rr[0] : rr[1]; }
#pragma unroll
    for (int k = 0; k < 16; ++k) out[k] = t[k] > u[15 - k] ? t[k] : u[15 - k];
#pragma unroll
    for (int st = 8; st >= 1; st >>= 1)
#pragma unroll
        for (int k = 0; k < 16; ++k) if ((k & st) == 0) { const unsigned a = out[k], b = out[k | st]; out[k] = a > b ? a : b; out[k | st] = a > b ? b : a; }
}

__device__ __forceinline__ void route_head(const bf16* QP, const bf16* SKB, int h, int tok0, int lane, __attribute__((address_space(3))) unsigned char* lds3) {
    asm volatile("" : "+v"(lane));
    const int r32 = lane & 31, hi = lane >> 5;
    unsigned A[16], B[16];
    route_list(QP, SKB, 2 * h, tok0, r32, hi, A);
    route_list(QP, SKB, 2 * h + 1, tok0, r32, hi, B);
    float va[16], vb[16]; int ia[16], ib[16];
#pragma unroll
    for (int k = 0; k < 16; ++k) { va[k] = unmono((A[k] & ~127u) | 64u); vb[k] = unmono((B[k] & ~127u) | 64u); ia[k] = 127 - (int)(A[k] & 127u); ib[k] = 127 - (int)(B[k] & 127u); }
    unsigned s[16], sp[16];
#pragma unroll
    for (int k = 0; k < 16; ++k) { s[k] = 0u; sp[k] = 0u; }
#pragma unroll
    for (int i = 0; i < 16; ++i)
#pragma unroll
        for (int j = 0; j < 16; ++j) if ((i + 1) * (j + 1) <= 16) {
            unsigned key = mono(va[i] + vb[j]); unsigned pay = (unsigned)(ia[i] * PEER_KEYS + ib[j]);
#pragma unroll
            for (int k = (i + 1) * (j + 1) - 1; k < 16; ++k) { const bool gt = key > s[k]; const unsigned ts = s[k], tp = sp[k]; s[k] = gt ? key : ts; sp[k] = gt ? pay : tp; key = gt ? ts : key; pay = gt ? tp : pay; }
            __builtin_amdgcn_sched_barrier(0);
        }
    const float mx = unmono(s[0]);
    float e[16], sum = 0.f;
#pragma unroll
    for (int k = 0; k < 16; ++k) { e[k] = __expf(unmono(s[k]) - mx); sum += e[k]; }
    const float inv = 1.f / sum;
    if (hi == 0) {
        __attribute__((address_space(3))) int* EX = (__attribute__((address_space(3))) int*)(lds3 + L_EX);
        __attribute__((address_space(3))) float* GT = (__attribute__((address_space(3))) float*)(lds3 + L_GT);
#pragma unroll
        for (int k = 0; k < 16; ++k) { EX[(h * 16 + k) * 32 + r32] = (int)sp[k]; GT[(h * 16 + k) * 32 + r32] = e[k] * inv; }
    }
}

__device__ __forceinline__ void cvt_row_fp8(const float* src, unsigned char* dst, float* inv_scale, int row, int lane) {
    const float* p = src + (size_t)row * 2048 + lane * 16;
    f32x4 v[8]; float am = 0.f;
#pragma unroll
    for (int j = 0; j < 2; ++j)
#pragma unroll
        for (int c = 0; c < 4; ++c) { v[4 * j + c] = *(const f32x4*)(p + j * 1024 + 4 * c);
            am = fmaxf(am, fmaxf(fmaxf(fabsf(v[4 * j + c].x), fabsf(v[4 * j + c].y)), fmaxf(fabsf(v[4 * j + c].z), fabsf(v[4 * j + c].w)))); }
    am = wave_max(am);
    const float sc = am > 0.f ? 384.f / am : 1.f;
#pragma unroll
    for (int j = 0; j < 2; ++j) { v4u o;
#pragma unroll
        for (int c = 0; c < 4; ++c) { int w = 0; w = __builtin_amdgcn_cvt_pk_fp8_f32(v[4 * j + c].x * sc, v[4 * j + c].y * sc, w, false); w = __builtin_amdgcn_cvt_pk_fp8_f32(v[4 * j + c].z * sc, v[4 * j + c].w * sc, w, true); o[c] = (unsigned)w; }
        *(v4u*)(dst + (size_t)row * 2048 + j * 1024 + lane * 16) = o; }
    if (lane == 0) inv_scale[row] = am > 0.f ? am / 384.f : 1.f;
}
typedef float f32x2v __attribute__((ext_vector_type(2)));
__device__ __forceinline__ unsigned cvtpk_bf(float lo, float hi) { typedef __bf16 b2v __attribute__((ext_vector_type(2))); f32x2v v = {lo, hi}; b2v b = __builtin_convertvector(v, b2v); return __builtin_bit_cast(unsigned, b); }
__device__ __forceinline__ float dot32_fp8(const unsigned (&x)[16], v4u q0, v4u q1) {
    float d = 0.f;
#pragma unroll
    for (int c = 0; c < 4; ++c) { const int w0 = (int)q0[c], w1 = (int)q1[c];
        const f32x2v a = __builtin_amdgcn_cvt_pk_f32_fp8(w0, false), b = __builtin_amdgcn_cvt_pk_f32_fp8(w0, true), e = __builtin_amdgcn_cvt_pk_f32_fp8(w1, false), f = __builtin_amdgcn_cvt_pk_f32_fp8(w1, true);
        d = dot2(x[2 * c + 0], cvtpk_bf(a.x, a.y), d); d = dot2(x[2 * c + 1], cvtpk_bf(b.x, b.y), d);
        d = dot2(x[8 + 2 * c + 0], cvtpk_bf(e.x, e.y), d); d = dot2(x[8 + 2 * c + 1], cvtpk_bf(f.x, f.y), d); }
    return d;
}
__device__ __forceinline__ void axpy32_fp8(float (&acc)[32], float w, v4u q0, v4u q1) {
#pragma unroll
    for (int c = 0; c < 4; ++c) { const int w0 = (int)q0[c], w1 = (int)q1[c];
        const f32x2v a = __builtin_amdgcn_cvt_pk_f32_fp8(w0, false), b = __builtin_amdgcn_cvt_pk_f32_fp8(w0, true), e = __builtin_amdgcn_cvt_pk_f32_fp8(w1, false), f = __builtin_amdgcn_cvt_pk_f32_fp8(w1, true);
        acc[4 * c + 0] += w * a.x; acc[4 * c + 1] += w * a.y; acc[4 * c + 2] += w * b.x; acc[4 * c + 3] += w * b.y;
        acc[16 + 4 * c + 0] += w * e.x; acc[16 + 4 * c + 1] += w * e.y; acc[16 + 4 * c + 2] += w * f.x; acc[16 + 4 * c + 3] += w * f.y; }
}
constexpr int L_SK = 32768, L_W = 49152;

__device__ __forceinline__ void ffn_wave(int tok0, int wid, int lane, const float* H, const float* SS, const float* gffn, const unsigned char* U8, const unsigned char* V8,
                                         const float* IU, const float* IV, const float* gfin, float* out, __attribute__((address_space(3))) unsigned char* lds3, unsigned rot) {
    asm volatile("" : "+v"(lane));
    const __attribute__((address_space(3))) int* EX = (const __attribute__((address_space(3))) int*)(lds3 + L_EX);
    const __attribute__((address_space(3))) float* GT = (const __attribute__((address_space(3))) float*)(lds3 + L_GT);
    __attribute__((address_space(3))) unsigned* SK = (__attribute__((address_space(3))) unsigned*)(lds3 + L_SK) + wid * 512;
    __attribute__((address_space(3))) float* WW = (__attribute__((address_space(3))) float*)(lds3 + L_W) + wid * 512;
#pragma unroll
    for (int i = 0; i < 8; ++i) { const int p = lane + 64 * i; const unsigned e = (unsigned)EX[(p & 127) * 32 + 4 * wid + (p >> 7)]; SK[p] = (((e - rot) & 16383u) << 9) | (unsigned)p; }
    asm volatile("s_waitcnt lgkmcnt(0)" ::: "memory");
#pragma unroll 1
    for (int k = 2; k <= 512; k <<= 1)
#pragma unroll 1
        for (int j = k >> 1; j > 0; j >>= 1) {
#pragma unroll
            for (int t = 0; t < 4; ++t) { const int mth = lane + 64 * t; const int i = ((mth & ~(j - 1)) << 1) | (mth & (j - 1)); const int pr = i | j;
                const unsigned a = SK[i], b = SK[pr]; const bool asc = (i & k) == 0; const bool sw = (a > b) == asc;
                SK[i] = sw ? b : a; SK[pr] = sw ? a : b; }
            asm volatile("s_waitcnt lgkmcnt(0)" ::: "memory");
        }
    unsigned x0[16], x1[16], x2[16], x3[16];
#define PEER_LOADX(XR, TK) do { const int n_ = tok0 + 4 * wid + (TK); const float rs_ = rsqrtf(SS[n_] * (1.f / D_MODEL) + EPS); \
        _Pragma("unroll") for (int j = 0; j < 2; ++j) _Pragma("unroll") for (int c = 0; c < 4; ++c) { \
            const f32x4 hv_ = *(const f32x4*)(H + (size_t)n_ * 2048 + j * 1024 + lane * 16 + 4 * c), gv_ = *(const f32x4*)(gffn + j * 1024 + lane * 16 + 4 * c); \
            XR[8 * j + 2 * c + 0] = pk2(hv_.x * rs_ * gv_.x, hv_.y * rs_ * gv_.y); XR[8 * j + 2 * c + 1] = pk2(hv_.z * rs_ * gv_.z, hv_.w * rs_ * gv_.w); } } while (0)
    PEER_LOADX(x0, 0); __builtin_amdgcn_sched_barrier(0); PEER_LOADX(x1, 1); __builtin_amdgcn_sched_barrier(0); PEER_LOADX(x2, 2); __builtin_amdgcn_sched_barrier(0); PEER_LOADX(x3, 3); __builtin_amdgcn_sched_barrier(0);
#undef PEER_LOADX
    const bool b5 = (lane & 32) != 0, b4 = (lane & 16) != 0;
#pragma unroll 1
    for (int i0 = 0; i0 < 512; i0 += 4) {
        int e[4], p[4]; v4u q0[4], q1[4];
#pragma unroll
        for (int k = 0; k < 4; ++k) { const unsigned key = (unsigned)__builtin_amdgcn_readfirstlane((int)SK[i0 + k]); e[k] = (int)(((key >> 9) + rot) & 16383u); p[k] = (int)(key & 511u);
            const unsigned char* ur = U8 + (size_t)e[k] * 2048 + lane * 16; q0[k] = *(const v4u*)ur; q1[k] = *(const v4u*)(ur + 1024); }
        float d[4];
#pragma unroll
        for (int k = 0; k < 4; ++k) { const int tk = p[k] >> 7; d[k] = 0.f;
            if (tk == 0) d[k] = dot32_fp8(x0, q0[k], q1[k]);
            if (tk == 1) d[k] = dot32_fp8(x1, q0[k], q1[k]);
            if (tk == 2) d[k] = dot32_fp8(x2, q0[k], q1[k]);
            if (tk == 3) d[k] = dot32_fp8(x3, q0[k], q1[k]); }
        float a01 = (b5 ? d[1] : d[0]) + __shfl_xor(b5 ? d[0] : d[1], 32);
        float a23 = (b5 ? d[3] : d[2]) + __shfl_xor(b5 ? d[2] : d[3], 32);
        float t = (b4 ? a23 : a01) + __shfl_xor(b4 ? a01 : a23, 16);
        t += __shfl_xor(t, 8); t += __shfl_xor(t, 4); t += __shfl_xor(t, 2); t += __shfl_xor(t, 1);
        float iu[4], iv[4], gt[4];
#pragma unroll
        for (int k = 0; k < 4; ++k) { iu[k] = IU[e[k]]; iv[k] = IV[e[k]]; gt[k] = GT[(p[k] & 127) * 32 + 4 * wid + (p[k] >> 7)]; }
        const float ius = b5 ? (b4 ? iu[3] : iu[1]) : (b4 ? iu[2] : iu[0]);
        const float ivs = b5 ? (b4 ? iv[3] : iv[1]) : (b4 ? iv[2] : iv[0]);
        const float gts = b5 ? (b4 ? gt[3] : gt[1]) : (b4 ? gt[2] : gt[0]);
        const int ksel = b5 ? (b4 ? 3 : 1) : (b4 ? 2 : 0);
        const float wv = gts * gelu_tanh(t * ius) * ivs;
        if ((lane & 15) == 0) WW[i0 + ksel] = wv;
    }
    asm volatile("s_waitcnt lgkmcnt(0)" ::: "memory");
    float a0[32], a1[32], a2[32], a3[32];
#pragma unroll
    for (int j = 0; j < 32; ++j) { a0[j] = 0.f; a1[j] = 0.f; a2[j] = 0.f; a3[j] = 0.f; }
#pragma unroll 1
    for (int i0 = 0; i0 < 512; i0 += 2) {
        int p[2]; float w[2]; v4u q0[2], q1[2];
#pragma unroll
        for (int k = 0; k < 2; ++k) { const unsigned key = (unsigned)__builtin_amdgcn_readfirstlane((int)SK[i0 + k]); const int e = (int)(((key >> 9) + rot) & 16383u); p[k] = (int)(key & 511u);
            w[k] = __uint_as_float(__builtin_amdgcn_readfirstlane(__float_as_uint(WW[i0 + k])));
            const unsigned char* vr = V8 + (size_t)e * 2048 + lane * 16; q0[k] = *(const v4u*)vr; q1[k] = *(const v4u*)(vr + 1024); }
#pragma unroll
        for (int k = 0; k < 2; ++k) { const int tk = p[k] >> 7;
            const float w0 = tk == 0 ? w[k] : 0.f, w1 = tk == 1 ? w[k] : 0.f, w2 = tk == 2 ? w[k] : 0.f, w3 = tk == 3 ? w[k] : 0.f;
#pragma unroll
            for (int c = 0; c < 4; ++c) { const int u0 = (int)q0[k][c], u1 = (int)q1[k][c];
                const f32x2v a = __builtin_amdgcn_cvt_pk_f32_fp8(u0, false), b = __builtin_amdgcn_cvt_pk_f32_fp8(u0, true), e = __builtin_amdgcn_cvt_pk_f32_fp8(u1, false), f = __builtin_amdgcn_cvt_pk_f32_fp8(u1, true);
#define PEER_AX(AR, WT) AR[4 * c + 0] += WT * a.x; AR[4 * c + 1] += WT * a.y; AR[4 * c + 2] += WT * b.x; AR[4 * c + 3] += WT * b.y; AR[16 + 4 * c + 0] += WT * e.x; AR[16 + 4 * c + 1] += WT * e.y; AR[16 + 4 * c + 2] += WT * f.x; AR[16 + 4 * c + 3] += WT * f.y;
                PEER_AX(a0, w0) PEER_AX(a1, w1) PEER_AX(a2, w2) PEER_AX(a3, w3)
#undef PEER_AX
            } }
    }
#define PEER_FIN(AR, TK) do { const int n_ = tok0 + 4 * wid + (TK); float sq_ = 0.f; \
        _Pragma("unroll") for (int j = 0; j < 2; ++j) _Pragma("unroll") for (int c = 0; c < 4; ++c) { const f32x4 hv_ = *(const f32x4*)(H + (size_t)n_ * 2048 + j * 1024 + lane * 16 + 4 * c); \
            AR[16 * j + 4 * c + 0] += hv_.x; AR[16 * j + 4 * c + 1] += hv_.y; AR[16 * j + 4 * c + 2] += hv_.z; AR[16 * j + 4 * c + 3] += hv_.w; } \
        _Pragma("unroll") for (int j = 0; j < 32; ++j) sq_ += AR[j] * AR[j]; \
        const float r_ = rsqrtf(wave_sum(sq_) * (1.f / D_MODEL) + EPS); \
        _Pragma("unroll") for (int j = 0; j < 2; ++j) _Pragma("unroll") for (int c = 0; c < 4; ++c) { const f32x4 gv_ = *(const f32x4*)(gfin + j * 1024 + lane * 16 + 4 * c); \
            *(f32x4*)(out + (size_t)n_ * 2048 + j * 1024 + lane * 16 + 4 * c) = (f32x4){AR[16 * j + 4 * c + 0] * r_ * gv_.x, AR[16 * j + 4 * c + 1] * r_ * gv_.y, AR[16 * j + 4 * c + 2] * r_ * gv_.z, AR[16 * j + 4 * c + 3] * r_ * gv_.w}; } } while (0)
    asm volatile("" : "+v"(lane));
    PEER_FIN(a0, 0); __builtin_amdgcn_sched_barrier(0); PEER_FIN(a1, 1); __builtin_amdgcn_sched_barrier(0); PEER_FIN(a2, 2); __builtin_amdgcn_sched_barrier(0); PEER_FIN(a3, 3);
#undef PEER_FIN
}

__device__ __forceinline__ void peer_phase(const bf16* QP, const bf16* SKB, const float* H, const float* SS, const float* gffn, const unsigned char* U8, const unsigned char* V8, const float* IU, const float* IV,
                                           const float* gfin, float* out, __attribute__((address_space(3))) unsigned char* lds3, int bid, int G) {
    int tid = threadIdx.x; asm volatile("" : "+v"(tid));
    const int lane = tid & 63, wid = __builtin_amdgcn_readfirstlane(tid >> 6);
    const unsigned rot = (xb_xcc_id() & 7u) * 2048u;
    for (int unit = bid; unit < NTOK / 32; unit += G) {
        const int tok0 = unit * 32;
        route_head(QP, SKB, wid, tok0, lane, lds3);
        asm volatile("s_waitcnt lgkmcnt(0)" ::: "memory"); __syncthreads();
        ffn_wave(tok0, wid, lane, H, SS, gffn, U8, V8, IU, IV, gfin, out, lds3, rot);
        __syncthreads();
    }
}
#undef PEER_CE
}
constexpr int RING_BYTES = 131072, LDSCTL_OFF = RING_BYTES, MISC_OFF = LDSCTL_OFF + 320, LDS_BYTES = 147456;
constexpr int N_PHASES = 8;
#ifndef MK_N_LAUNCHES
#define MK_N_LAUNCHES 1
#endif

__global__ void __launch_bounds__(NTHR, 2) fwd_megakernel(Args args) {
    extern __shared__ __attribute__((aligned(16))) unsigned char lds[];
    LAS unsigned char* lds3 = (LAS unsigned char*)lds;
    const int tid = threadIdx.x, lane = tid & 63, wave = __builtin_amdgcn_readfirstlane(tid >> 6);
    const int G = gridDim.x, bid = blockIdx.x;
    unsigned char* ws = args.ws;
    unsigned* ctl = (unsigned*)(ws + WS_CTL);
    const float* x = args.in[0];
    bf16* WinT = (bf16*)(ws + WS_WIN); bf16* WbnT = (bf16*)(ws + WS_WBN); bf16* WbsT = (bf16*)(ws + WS_WBS); bf16* WoutT = (bf16*)(ws + WS_WOUT); bf16* WpqT = (bf16*)(ws + WS_WPQ);
    bf16* XN = (bf16*)(ws + WS_XN); bf16* MERGED = XN; bf16* PROJ = (bf16*)(ws + WS_PROJ);
    bf16* ONSA = (bf16*)(ws + WS_ONSA); bf16* OSB = (bf16*)(ws + WS_OSB);
    float* H = (float*)(ws + WS_H); bf16* HB = (bf16*)(ws + WS_HB);
    unsigned char* U8 = ws + WS_UB; unsigned char* V8 = ws + WS_VB; float* IU = (float*)(ws + WS_UB + 48 * MiB); float* IV = (float*)(ws + WS_VB + 48 * MiB); bf16* QP = (bf16*)(ws + WS_QP);
    int* EXPERT = (int*)(ws + WS_EXP); float* GATE = (float*)(ws + WS_GATE);
    bf16* KCB = (bf16*)(ws + WS_MISC + MISC_KCB); bf16* VCB = (bf16*)(ws + WS_MISC + MISC_VCB);
    float* SS = (float*)(ctl + CW_SS);
    bf16* W1T = (bf16*)(ws + WS_MISC + MISC_W1T); float* BIAS1 = (float*)(ws + WS_MISC + MISC_B1);
    bf16* SKB = (bf16*)(ws + WS_MISC + MISC_SKB);

    for (int u = tid; u < (LDS_BYTES - LDSCTL_OFF) / 4; u += NTHR) ((LAS unsigned*)(lds3 + LDSCTL_OFF))[u] = 0u;
    __syncthreads();
    const int lo = args.ph_lo, hi = args.ph_hi;
    XcdBarrier bar; bar.bar = ctl + CW_BAR; bar.x = 0; bar.st = nullptr;
    if (hi - lo > 1) bar = xcd_barrier_post(ctl + CW_BAR, (volatile LAS unsigned*)(lds3 + MISC_OFF) + 8);
#define IN(k) (lo <= (k) && (k) < hi)
#define SEAM(k) do { if (IN(k) && IN((k) + 1)) xcd_barrier(bar); } while (0)
    const int gw = bid * NWAVES + wave, NGW = G * NWAVES;
    const int vcu = (G % 8 == 0) ? (bid % 8) * (G / 8) + bid / 8 : bid;

    if (IN(0)) {
        LAS float* scr = (LAS float*)(lds3 + wave * 16384);
        constexpr int I_IN = (D_MODEL / 64) * ((IN_COLS + 31) / 32), I_BR = (1024 / 64) * (D_MODEL / 32), I_SQ = (D_MODEL / 64) * (D_MODEL / 32);
        constexpr int I_C1 = (2048 / 64) * (CMP_HID / 32);
        constexpr int NITEMS = I_IN + 2 * I_BR + 2 * I_SQ + 2 * I_C1;
        for (int it = gw; it < NITEMS; it += NGW) {
            int r = it;
            if (r < I_IN) { p0_transpose_item(args.in[2], D_MODEL, IN_COLS, WinT, nullptr, scr, r, lane); continue; } r -= I_IN;
            if (r < I_BR) { p0_transpose_item(args.in[10], 1024, D_MODEL, WbnT, nullptr, scr, r, lane); continue; } r -= I_BR;
            if (r < I_BR) { p0_transpose_item(args.in[11], 1024, D_MODEL, WbsT, nullptr, scr, r, lane); continue; } r -= I_BR;
            if (r < I_SQ) { p0_transpose_item(args.in[12], D_MODEL, D_MODEL, WoutT, nullptr, scr, r, lane); continue; } r -= I_SQ;
            if (r < I_SQ) { p0_transpose_item(args.in[14], D_MODEL, D_MODEL, WpqT, args.in[13], scr, r, lane); continue; } r -= I_SQ;
            if (r < I_C1) { p0_transpose_item(args.in[4], 2048, CMP_HID, W1T, nullptr, scr, r, lane); continue; } r -= I_C1;
            p0_transpose_item(args.in[7], 2048, CMP_HID, W1T + (size_t)CMP_HID * 2048, nullptr, scr, r, lane);
        }
        {
            v4u z = {0u, 0u, 0u, 0u}; bf16* p = WinT + (size_t)IN_COLS * D_MODEL; const size_t nz = (size_t)(PLD - IN_COLS) * D_MODEL;
            for (size_t i = ((size_t)bid * NTHR + tid) * 8; i < nz; i += (size_t)G * NTHR * 8) *(v4u*)(p + i) = z;
        }
        if (gw < 2 * CMP_HID) {
            const int kv = gw >> 7, j = gw & 127; const float* pe = args.in[kv ? 6 : 3]; const float* w1 = args.in[kv ? 7 : 4];
            float s = 0.f;
            for (int k2 = lane; k2 < 2048; k2 += 64) s += pe[k2] * w1[(size_t)k2 * CMP_HID + j];
            s = wave_sum(s);
            if (lane == 0) BIAS1[gw] = s;
        }
        cvt_flat(args.in[15], SKB, (size_t)16 * 128 * 128, (size_t)bid * NTHR + tid, (size_t)G * NTHR);
        for (int m = gw; m < NTOK; m += NGW) rms_row_to_bf16(x + (size_t)m * D_MODEL, args.in[1], XN + (size_t)m * D_MODEL, lane);
    }
    SEAM(0);
    if (IN(1)) {
        pg8::Gemm g{XN, WinT, NTOK, PLD, D_MODEL}; pg8::StaticOrder S; S.init(NTOK, PLD, G, bid);
        pg8::EpiBf16<0> E{PROJ, PLD, nullptr, 0, 0, 1.f};
        pg8::gemm_phase<pg8::EpiBf16<0>, pg8::StaticOrder, true, true>(lds3, g, S, E);
    }
    SEAM(1);
    if (IN(2)) cmpr::compress_phase(PROJ, W1T, BIAS1, args.in, KCB, VCB, lds3, bid, G);
    SEAM(2);
    if (IN(3)) {
        nsa::nsa_phase(PROJ, KCB, VCB, args.in[9], ONSA, lds3, vcu, G);
#if defined(PROBE_P3A)
        nsa::nsa_phase(PROJ, KCB, VCB, args.in[9], ONSA, lds3, vcu, G);
#endif
        nsa::stick_phase(PROJ, OSB, lds3, vcu, G);
#if defined(PROBE_P3B)
        nsa::stick_phase(PROJ, OSB, lds3, vcu, G);
#endif
    }
    SEAM(3);
    if (IN(4)) {
        { pg8::Gemm g{ONSA, WbnT, NTOK, D_MODEL, 1024}; pg8::StaticOrder S; S.init(NTOK, D_MODEL, G, bid);
          pg8::EpiGate<0> E{MERGED, D_MODEL, PROJ + C_GA, PLD};
          pg8::gemm_phase<pg8::EpiGate<0>, pg8::StaticOrder, false, true>(lds3, g, S, E); }
        { pg8::Gemm g{OSB, WbsT, NTOK, D_MODEL, 1024}; pg8::StaticOrder S; S.init(NTOK, D_MODEL, G, bid);
          pg8::EpiGate<1> E{MERGED, D_MODEL, PROJ + C_GB, PLD};
          pg8::gemm_phase<pg8::EpiGate<1>, pg8::StaticOrder, false, true>(lds3, g, S, E); }
    }
    SEAM(4);
    if (IN(5)) {
        { pg8::Gemm g{MERGED, WoutT, NTOK, D_MODEL, D_MODEL}; pg8::StaticOrder S; S.init(NTOK, D_MODEL, G, bid);
          pg8::EpiResid E{x, H, HB, SS, D_MODEL};
          pg8::gemm_phase<pg8::EpiResid, pg8::StaticOrder, false, true>(lds3, g, S, E); }
        for (int r = gw; r < 2 * 16384; r += NGW) { if (r < 16384) peer::cvt_row_fp8(args.in[16], U8, IU, r, lane); else peer::cvt_row_fp8(args.in[17], V8, IV, r - 16384, lane); }
    }
    SEAM(5);
    if (IN(6)) {
        pg8::Gemm g{HB, WpqT, NTOK, D_MODEL, D_MODEL}; pg8::StaticOrder S; S.init(NTOK, D_MODEL, G, bid);
        pg8::EpiRowScale E{QP, D_MODEL, SS, 1.f / D_MODEL, EPS};
        pg8::gemm_phase<pg8::EpiRowScale, pg8::StaticOrder, false, true>(lds3, g, S, E);
    }
    SEAM(6);
    if (IN(7)) {
        peer::peer_phase(QP, SKB, H, SS, args.in[13], U8, V8, IU, IV, args.in[18], args.out, lds3, bid, G);
#if defined(PROBE_P7)
        peer::peer_phase(QP, SKB, H, SS, args.in[13], U8, V8, IU, IV, args.in[18], args.out, lds3, bid, G);
#endif
    }
#undef IN
#undef SEAM
}

extern "C" void kernel_launch(void* const* d_in, const int* in_sizes, int n_in, void* d_out, int out_size, void* d_ws, size_t ws_size, hipStream_t stream) {
    static int grid = 0;
    if (grid == 0) {
        if (n_in != 19 || ws_size < WS_END) { fprintf(stderr, "kernel_launch: unexpected inputs (%d) or workspace (%zu < %zu)\n", n_in, ws_size, (size_t)WS_END); grid = -1; return; }
        int dev = 0, cus = 0, per_cu = 0;
        hipGetDevice(&dev); hipDeviceGetAttribute(&cus, hipDeviceAttributeMultiprocessorCount, dev);
        if (hipFuncSetAttribute((const void*)fwd_megakernel, hipFuncAttributeMaxDynamicSharedMemorySize, LDS_BYTES) != hipSuccess) { fprintf(stderr, "hipFuncSetAttribute failed\n"); grid = -1; return; }
        if (hipOccupancyMaxActiveBlocksPerMultiprocessor(&per_cu, (const void*)fwd_megakernel, NTHR, LDS_BYTES) != hipSuccess || per_cu < 1) { fprintf(stderr, "occupancy query: %d\n", per_cu); per_cu = 1; }
        (void)hipGetLastError();
        grid = cus;
        if (grid > cus * per_cu) grid = cus * per_cu;
    }
    if (grid < 0) return;
    hipMemsetAsync((char*)d_ws + WS_CTL, 0, CTL_ZERO_BYTES, stream);
    Args a{};
    for (int i = 0; i < 19; ++i) a.in[i] = (const float*)d_in[i];
    a.out = (float*)d_out; a.ws = (unsigned char*)d_ws;
    if (MK_N_LAUNCHES == 1) {
        a.ph_lo = 0; a.ph_hi = N_PHASES;
        void* kargs[] = {&a};
        hipError_t e = hipLaunchCooperativeKernel((const void*)fwd_megakernel, dim3(grid), dim3(NTHR), kargs, LDS_BYTES, stream);
        if (e != hipSuccess) fprintf(stderr, "cooperative launch failed: %s (grid %d)\n", hipGetErrorString(e), grid);
    } else {
        for (int p = 0; p < N_PHASES; ++p) { a.ph_lo = p; a.ph_hi = p + 1; hipLaunchKernelGGL(fwd_megakernel, dim3(grid), dim3(NTHR), LDS_BYTES, stream, a); }
    }
}
```

```cpp
#include <hip/hip_runtime.h>
#include <cstdio>
#include <cstdint>
#include <cmath>
namespace pg8 {
#define PG8_LAS __attribute__((address_space(3)))
typedef unsigned short bf16_t;
typedef short bf16x8 __attribute__((ext_vector_type(8)));
typedef float f32x4 __attribute__((ext_vector_type(4)));
typedef unsigned u32x4 __attribute__((ext_vector_type(4)));
constexpr int BM = 256, BK = 64, HALF = 128, HTB = HALF * BK * 2  , STAGE_BYTES = 8 * HTB, NXCD = 8, WGM = 8;

__host__ __device__ __forceinline__ int lds_byte(int r, int c) { const int st = (r >> 4) * 2 + (c >> 5), rr = r & 15, cc = c & 31, ob = rr * 64 + cc * 2; return st * 1024 + (ob ^ (((ob >> 9) & 1) << 5)); }
__host__ __device__ __forceinline__ void stage_rc(int b, int& R, int& C) { const int st = b / 1024, sb = b % 1024, swz = sb ^ (((sb >> 9) & 1) << 5); R = (st >> 1) * 16 + swz / 64; C = (st & 1) * 32 + (swz % 64) / 2; }
__host__ __device__ __forceinline__ int perm32(int rho) { const int n = rho >> 4, i = rho & 15; return 8 * (i >> 2) + 4 * n + (i & 3); }

struct Unit { int pm, pn; };
struct Gemm { const bf16_t* A; const bf16_t* Bt; int M, N, K; };

struct StaticOrder {
    int nM, nN, nwg, G, c;
    __host__ __device__ void init(int M, int N, int G_, int c_) { nM = M / BM; nN = N / BM; nwg = nM * nN; G = G_; c = c_; }
    __host__ __device__ bool next(int i, Unit& u) const {
        const long L = (long)i * G + c; if (L >= nwg) return false;
        int wgid = (int)L; { const int q = nwg / NXCD, r = nwg % NXCD, xcd = wgid % NXCD, off = wgid / NXCD; wgid = (xcd < r ? xcd * (q + 1) : r * (q + 1) + (xcd - r) * q) + off; }
        const int nig = WGM * nN, gid = wgid / nig, fm = gid * WGM, gsz = (nM - fm) < WGM ? (nM - fm) : WGM;
        u.pm = fm + ((wgid % nig) % gsz); u.pn = (wgid % nig) / gsz; return true;
    }
    __device__ __forceinline__ void a_ready(const Unit&) const {}
    __device__ __forceinline__ void done(const Unit&) const {}
};

__device__ __forceinline__ unsigned cvt_pk_bf16(float lo, float hi) { unsigned r; asm volatile("v_cvt_pk_bf16_f32 %0, %1, %2" : "=v"(r) : "v"(lo), "v"(hi)); return r; }
typedef float f32x2 __attribute__((ext_vector_type(2)));
__device__ __forceinline__ f32x2 gelu_pk(f32x2 v) {
    const f32x2 av = __builtin_elementwise_abs(v), d = av * 0.2316418882f + 1.0f;
    f32x2 t; t.x = __builtin_amdgcn_rcpf(d.x); t.y = __builtin_amdgcn_rcpf(d.y);
    f32x2 q = t * 0.5307027145f + (-0.7265760135f); q = q * t + 0.7107068705f; q = q * t + (-0.142248368f); q = q * t + 0.127414796f; q = q * t;
    const f32x2 s = (v * v) * (-0.72134752044f);
    f32x2 e; e.x = __builtin_amdgcn_exp2f(s.x); e.y = __builtin_amdgcn_exp2f(s.y);
    const f32x2 m = v * (q * e), r = v - m;
    f32x2 o; o.x = v.x < 0.f ? m.x : r.x; o.y = v.y < 0.f ? m.y : r.y; return o;
}

template <int ACT  > struct EpiBf16 {
    static constexpr bool PERM = true, AFTER_DRAIN = false; static_assert(ACT == 0 || ACT == 1, "EpiBf16: ACT is 0 (none) or 1 (gelu_pk)");
    bf16_t* O; int ldc; const float* bias; int split_cols; size_t split_stride; float scale0;
    __device__ __forceinline__ void operator()(const f32x4 (&acc)[2][2][4][2], const Unit& u, int wr, int wc, int fr, int fq) const {
        const int row0 = u.pm * BM + wr * 64 + fr; int colt = u.pn * BM; bf16_t* base = O;
        float sc = 1.f; if (split_cols) { const int t = colt / split_cols; base += (size_t)t * split_stride; colt -= t * split_cols; if (t == 0) sc = scale0; }
        const int col0 = colt + wc * 32 + 8 * fq, bcol0 = u.pn * BM + wc * 32 + 8 * fq;
        f32x4 bv[2][2];
#pragma unroll
        for (int bj = 0; bj < 2; ++bj)
#pragma unroll
            for (int n = 0; n < 2; ++n) bv[bj][n] = bias ? *(const f32x4*)(bias + bcol0 + bj * HALF + 4 * n) : (f32x4){0.f, 0.f, 0.f, 0.f};
#pragma unroll
        for (int ai = 0; ai < 2; ++ai)
#pragma unroll
            for (int m = 0; m < 4; ++m) { bf16_t* rowp = base + (size_t)(row0 + ai * HALF + m * 16) * ldc + col0;
#pragma unroll
                for (int bj = 0; bj < 2; ++bj) { f32x4 v0 = acc[ai][bj][m][0] + bv[bj][0], v1 = acc[ai][bj][m][1] + bv[bj][1];
                    if (ACT == 1) { f32x2 a = gelu_pk((f32x2){v0[0], v0[1]}), b = gelu_pk((f32x2){v0[2], v0[3]}), c = gelu_pk((f32x2){v1[0], v1[1]}), d = gelu_pk((f32x2){v1[2], v1[3]});
                        v0 = (f32x4){a.x, a.y, b.x, b.y}; v1 = (f32x4){c.x, c.y, d.x, d.y}; }
                    v0 = v0 * sc; v1 = v1 * sc; u32x4 w; w.x = cvt_pk_bf16(v0[0], v0[1]); w.y = cvt_pk_bf16(v0[2], v0[3]); w.z = cvt_pk_bf16(v1[0], v1[1]); w.w = cvt_pk_bf16(v1[2], v1[3]);
                    *(u32x4*)(rowp + bj * HALF) = w; } }
    }
};

struct PanelStats {
    unsigned* xbuf;
    unsigned* cnt;
    unsigned* tmo;
    int ntn; float eps;
    unsigned code;
    __device__ __forceinline__ bool run(const f32x4 (&v)[2][2][4][2], const Unit& u, int wr, int wc, int fr, int fq, PG8_LAS unsigned char* lds, int wid, int lane) const {
        typedef float f32x2v __attribute__((ext_vector_type(2)));
        PG8_LAS f32x2v* P = (PG8_LAS f32x2v*)lds;
        PG8_LAS f32x2v* S = (PG8_LAS f32x2v*)(lds + 8192);
        PG8_LAS unsigned* flag = (PG8_LAS unsigned*)(lds + 8192 + 2048);
#pragma unroll
        for (int ai = 0; ai < 2; ++ai)
#pragma unroll
            for (int m = 0; m < 4; ++m) {
                float s = 0.f;
#pragma unroll
                for (int bj = 0; bj < 2; ++bj)
#pragma unroll
                    for (int n = 0; n < 2; ++n) { const f32x4 x = v[ai][bj][m][n]; s += (x[0] + x[1]) + (x[2] + x[3]); }
                s += __shfl_xor(s, 16); s += __shfl_xor(s, 32);
                const float mw = s * (1.0f / 64.0f); float q = 0.f;
#pragma unroll
                for (int bj = 0; bj < 2; ++bj)
#pragma unroll
                    for (int n = 0; n < 2; ++n) { const f32x4 d = v[ai][bj][m][n] - mw; q += (d[0] * d[0] + d[1] * d[1]) + (d[2] * d[2] + d[3] * d[3]); }
                q += __shfl_xor(q, 16); q += __shfl_xor(q, 32);
                if (fq == 0) P[(ai * HALF + wr * 64 + m * 16 + fr) * 4 + wc] = (f32x2v){mw, q};
            }
        asm volatile("s_waitcnt lgkmcnt(0)" ::: "memory"); __builtin_amdgcn_s_barrier(); asm volatile("" ::: "memory");
#if defined(BROKEN_EXCHANGE_NO_WAIT)
#warning BROKEN CONTROL BUILD: the row-statistics exchange does not wait; results are wrong by design
        if (blockIdx.x >= 64) { const long long t0_ = clock64(); while (clock64() - t0_ < 60000) __builtin_amdgcn_s_sleep(8); }
#endif
        const int row = wid * 32 + (lane & 31);
        if (lane < 32) {
            const f32x2v a = P[row * 4 + 0], b = P[row * 4 + 1], c = P[row * 4 + 2], d = P[row * 4 + 3];
            const float mt = (a.x + b.x + c.x + d.x) * 0.25f;
            const float da = a.x - mt, db = b.x - mt, dc = c.x - mt, dd = d.x - mt;
            const float m2 = (a.y + b.y) + (c.y + d.y) + 64.0f * ((da * da + db * db) + (dc * dc + dd * dd));
            unsigned long long* slot = (unsigned long long*)xbuf + ((size_t)(u.pm * BM + row) * 4 + u.pn);
            __hip_atomic_store(slot, ((unsigned long long)__float_as_uint(m2) << 32) | __float_as_uint(mt), __ATOMIC_RELAXED, __HIP_MEMORY_SCOPE_AGENT);
        }
        asm volatile("s_waitcnt vmcnt(0)" ::: "memory");
        if (lane == 0) __hip_atomic_fetch_add(cnt + 64 * u.pm, 1u, __ATOMIC_RELAXED, __HIP_MEMORY_SCOPE_AGENT);
        if (wid == 0) {
            bool dead = false; const unsigned long long t0 = __builtin_amdgcn_s_memrealtime(); const unsigned want = 8u * (unsigned)ntn;
            for (;;) {
#if defined(BROKEN_EXCHANGE_NO_WAIT)
                break;
#endif
                if ((unsigned)__builtin_amdgcn_readfirstlane(__hip_atomic_load(cnt + 64 * u.pm, __ATOMIC_RELAXED, __HIP_MEMORY_SCOPE_AGENT)) >= want) break;
                if (__builtin_amdgcn_s_memrealtime() - t0 > 2000000ull) {
                    if (lane == 0) { unsigned expect = 0u; __hip_atomic_compare_exchange_strong(tmo + 1, &expect, code | (unsigned)(u.pm & 0xff), __ATOMIC_RELAXED, __ATOMIC_RELAXED, __HIP_MEMORY_SCOPE_AGENT);
                                     __hip_atomic_store(tmo, 1u, __ATOMIC_RELAXED, __HIP_MEMORY_SCOPE_AGENT); }
                    dead = true; break; }
                __builtin_amdgcn_s_sleep(2);
            }
            __builtin_amdgcn_fence(__ATOMIC_ACQUIRE, "agent");
            if (lane == 0) flag[0] = dead ? 1u : 0u;
        }
        asm volatile("s_waitcnt vmcnt(0) lgkmcnt(0)" ::: "memory"); __builtin_amdgcn_s_barrier(); asm volatile("" ::: "memory");
        const bool bad = flag[0] != 0u;
        if (lane < 32) {
            const unsigned long long* slot = (const unsigned long long*)xbuf + (size_t)(u.pm * BM + row) * 4; float mt[4], m2[4]; float ms = 0.f;
#pragma unroll
            for (int t = 0; t < 4; ++t) { if (t < ntn) { const unsigned long long w = __hip_atomic_load(slot + t, __ATOMIC_RELAXED, __HIP_MEMORY_SCOPE_AGENT); mt[t] = __uint_as_float((unsigned)w); m2[t] = __uint_as_float((unsigned)(w >> 32)); } else { mt[t] = 0.f; m2[t] = 0.f; } ms += mt[t]; }
            const float mean = ms / (float)ntn; float q = 0.f;
#pragma unroll
            for (int t = 0; t < 4; ++t) if (t < ntn) { const float dm = mt[t] - mean; q += m2[t] + 256.0f * dm * dm; }
            S[row] = (f32x2v){mean, 1.0f / sqrtf(q / (256.0f * (float)ntn) + eps)};
        }
        asm volatile("s_waitcnt lgkmcnt(0)" ::: "memory"); __builtin_amdgcn_s_barrier(); asm volatile("" ::: "memory");
        return bad;
    }
};
struct EpiLnRes {
    static constexpr bool PERM = false, AFTER_DRAIN = true;
    const float* base; float* out; int ldc; const float* bias; PanelStats st; unsigned poison;
    __device__ __forceinline__ void fused(f32x4 (&acc)[2][2][4][2], const Unit& u, int wr, int wc, int fr, int fq, PG8_LAS unsigned char* lds, int wid, int lane) const {
        typedef float f32x2v __attribute__((ext_vector_type(2)));
        const PG8_LAS f32x2v* S = (const PG8_LAS f32x2v*)(lds + 8192);
        const int col0 = u.pn * BM + wc * 32 + 4 * fq;
#pragma unroll
        for (int bj = 0; bj < 2; ++bj)
#pragma unroll
            for (int n = 0; n < 2; ++n) { const f32x4 bv = bias ? *(const f32x4*)(bias + col0 + bj * HALF + n * 16) : (f32x4){0.f, 0.f, 0.f, 0.f};
#pragma unroll
                for (int ai = 0; ai < 2; ++ai)
#pragma unroll
                    for (int m = 0; m < 4; ++m) acc[ai][bj][m][n] += bv; }
        f32x4 pre[4][2][2];
#pragma unroll
        for (int m = 0; m < 4; ++m) { const size_t off = (size_t)(u.pm * BM + wr * 64 + m * 16 + fr) * ldc + col0;
#pragma unroll
            for (int bj = 0; bj < 2; ++bj)
#pragma unroll
                for (int n = 0; n < 2; ++n) pre[m][bj][n] = *(const f32x4*)(base + off + bj * HALF + n * 16); }
        const bool bad = st.run(acc, u, wr, wc, fr, fq, lds, wid, lane) || poison != 0u;
        const float qnan = __builtin_nanf("");
#pragma unroll
        for (int ai = 0; ai < 2; ++ai)
#pragma unroll
            for (int m = 0; m < 4; ++m) { const int r = ai * HALF + wr * 64 + m * 16 + fr; const f32x2v sr = S[r]; const size_t off = (size_t)(u.pm * BM + r) * ldc + col0;
#pragma unroll
                for (int bj = 0; bj < 2; ++bj)
#pragma unroll
                    for (int n = 0; n < 2; ++n) { const f32x4 bs = ai == 0 ? pre[m][bj][n] : *(const f32x4*)(base + off + bj * HALF + n * 16); f32x4 o = bs + (acc[ai][bj][m][n] - sr.x) * sr.y;
                        if (bad) o = (f32x4){qnan, qnan, qnan, qnan}; *(f32x4*)(out + off + bj * HALF + n * 16) = o; }
                if (m & 1) asm volatile("" ::: "memory"); }
    }
};
struct EpiLnResLn {
    static constexpr bool PERM = false, AFTER_DRAIN = true;
    const float* base; float* out; bf16_t* xn; int ldc; const float* bias; PanelStats st1, st2; unsigned poison;
    __device__ __forceinline__ void fused(f32x4 (&acc)[2][2][4][2], const Unit& u, int wr, int wc, int fr, int fq, PG8_LAS unsigned char* lds, int wid, int lane) const {
        typedef float f32x2v __attribute__((ext_vector_type(2))); typedef unsigned u32x2v __attribute__((ext_vector_type(2)));
        const PG8_LAS f32x2v* S = (const PG8_LAS f32x2v*)(lds + 8192);
        const int col0 = u.pn * BM + wc * 32 + 4 * fq;
#pragma unroll
        for (int bj = 0; bj < 2; ++bj)
#pragma unroll
            for (int n = 0; n < 2; ++n) { const f32x4 bv = bias ? *(const f32x4*)(bias + col0 + bj * HALF + n * 16) : (f32x4){0.f, 0.f, 0.f, 0.f};
#pragma unroll
                for (int ai = 0; ai < 2; ++ai)
#pragma unroll
                    for (int m = 0; m < 4; ++m) acc[ai][bj][m][n] += bv; }
        bool bad = st1.run(acc, u, wr, wc, fr, fq, lds, wid, lane) || poison != 0u;
        const float qnan = __builtin_nanf("");
#pragma unroll
        for (int ai = 0; ai < 2; ++ai)
#pragma unroll
            for (int m = 0; m < 4; ++m) { const int r = ai * HALF + wr * 64 + m * 16 + fr; const f32x2v sr = S[r]; const size_t off = (size_t)(u.pm * BM + r) * ldc + col0;
#pragma unroll
                for (int bj = 0; bj < 2; ++bj)
#pragma unroll
                    for (int n = 0; n < 2; ++n) { const f32x4 bs = *(const f32x4*)(base + off + bj * HALF + n * 16); acc[ai][bj][m][n] = bs + (acc[ai][bj][m][n] - sr.x) * sr.y; }
                asm volatile("" : "+v"(acc[ai][0][m][0]), "+v"(acc[ai][0][m][1]), "+v"(acc[ai][1][m][0]), "+v"(acc[ai][1][m][1]));
                if (m & 1) asm volatile("" ::: "memory"); }
        const bool bad1 = bad;
        bad = st2.run(acc, u, wr, wc, fr, fq, lds, wid, lane) || bad;
#pragma unroll
        for (int ai = 0; ai < 2; ++ai)
#pragma unroll
            for (int m = 0; m < 4; ++m) { const int r = ai * HALF + wr * 64 + m * 16 + fr; const f32x2v sr = S[r]; const size_t off = (size_t)(u.pm * BM + r) * ldc + col0;
#pragma unroll
                for (int bj = 0; bj < 2; ++bj)
#pragma unroll
                    for (int n = 0; n < 2; ++n) { const f32x4 x1 = acc[ai][bj][m][n]; *(f32x4*)(out + off + bj * HALF + n * 16) = bad1 ? (f32x4){qnan, qnan, qnan, qnan} : x1;
                        const f32x4 o = (x1 - sr.x) * sr.y; u32x2v w; w.x = cvt_pk_bf16(o[0], o[1]); w.y = cvt_pk_bf16(o[2], o[3]);
                        if (bad) { w.x = 0x7fc07fc0u; w.y = 0x7fc07fc0u; } *(u32x2v*)(xn + off + bj * HALF + n * 16) = w; }
                asm volatile("" ::: "memory"); }
    }
};

template <class Epi, class Sched, bool ALIGN_EPI = false, bool SP2 = false>
__device__ __forceinline__ void gemm_phase(PG8_LAS unsigned char* lds, const Gemm g, const Sched& S, const Epi& E) {
    const int tid = threadIdx.x, wid = __builtin_amdgcn_readfirstlane(tid >> 6), lane = tid & 63, wr = wid >> 2, wc = wid & 3, fr = lane & 15, fq = lane >> 4;
    const int K = g.K, nt = K / BK;
    unsigned voffA[2], voffB[2];
#pragma unroll
    for (int i = 0; i < 2; ++i) { int R, C; stage_rc(tid * 16 + i * 8192, R, C); const int Rb = Epi::PERM ? ((R & ~31) + perm32(R & 31)) : R;
        voffA[i] = (unsigned)(R * K + C) * 2u; voffB[i] = (unsigned)(Rb * K + C) * 2u; }
    const size_t kstep = (size_t)(BK * 2);
    const size_t hstep = (size_t)HALF * K * 2;
    const size_t tstep = 2 * hstep;
    const unsigned ldsw = (unsigned)wid * 1024u;
    const int aoff = lds_byte(wr * 64 + fr, fq * 8), boff = lds_byte(wc * 32 + fr, fq * 8);
#define PG8_SA(b, h) (((b) * 2 + (h)) * HTB)
#define PG8_SB(b, h) ((4 + (b) * 2 + (h)) * HTB)
#define PG8_STAGE(bufoff, gbase, voff) do { _Pragma("unroll") for (int _i = 0; _i < 2; ++_i) \
        __builtin_amdgcn_global_load_lds((const unsigned*)((const char*)(gbase) + (voff)[_i]), (PG8_LAS unsigned*)(lds + (bufoff) + ldsw + _i * 8192), 16, 0, 0); } while (0)
#define PG8_LDA(dst, b, h) do { _Pragma("unroll") for (int m = 0; m < 4; ++m) _Pragma("unroll") for (int k = 0; k < 2; ++k) dst[m][k] = *(const PG8_LAS bf16x8*)(lds + PG8_SA(b, h) + aoff + m * 2048 + k * 1024); } while (0)
#define PG8_LDB(dst, b, h) do { _Pragma("unroll") for (int n = 0; n < 2; ++n) _Pragma("unroll") for (int k = 0; k < 2; ++k) dst[n][k] = *(const PG8_LAS bf16x8*)(lds + PG8_SB(b, h) + boff + n * 2048 + k * 1024); } while (0)
#define PG8_MMA(ai, bj, At, Bt) do { __builtin_amdgcn_s_setprio(1); _Pragma("unroll") for (int m = 0; m < 4; ++m) _Pragma("unroll") for (int n = 0; n < 2; ++n) _Pragma("unroll") for (int k = 0; k < 2; ++k) \
        acc[ai][bj][m][n] = __builtin_amdgcn_mfma_f32_16x16x32_bf16(Bt[n][k], At[m][k], acc[ai][bj][m][n], 0, 0, 0); __builtin_amdgcn_s_setprio(0); } while (0)
#define PG8_WAIT_V(n) asm volatile("s_waitcnt vmcnt(" #n ")" ::: "memory")
#define PG8_WAIT_L(n) asm volatile("s_waitcnt lgkmcnt(" #n ")" ::: "memory")
#define PG8_BAR __builtin_amdgcn_s_barrier()
#define PG8_SCHED __builtin_amdgcn_sched_barrier(0)
    Unit cur, nxt; int ui = 0;
    if (!S.next(0, cur)) return;
    f32x4 acc[2][2][4][2];
#pragma unroll
    for (int a = 0; a < 2; ++a)
#pragma unroll
        for (int b = 0; b < 2; ++b)
#pragma unroll
            for (int m = 0; m < 4; ++m)
#pragma unroll
                for (int n = 0; n < 2; ++n) acc[a][b][m][n] = (f32x4){0.f, 0.f, 0.f, 0.f};
    bf16x8 At[4][2], B0[2][2], B1[2][2];
    const char* cA = (const char*)g.A + (size_t)cur.pm * tstep; const char* cB = (const char*)g.Bt + (size_t)cur.pn * tstep;
    S.a_ready(cur);
    if constexpr (SP2) {
        PG8_STAGE(PG8_SB(0, 0), cB, voffB); PG8_STAGE(PG8_SB(0, 1), cB + hstep, voffB); PG8_STAGE(PG8_SA(0, 0), cA, voffA); PG8_STAGE(PG8_SA(0, 1), cA + hstep, voffA);
        if (wr == 1) PG8_BAR;
        PG8_WAIT_V(2); PG8_BAR;
        PG8_STAGE(PG8_SB(1, 0), cB + kstep, voffB); PG8_STAGE(PG8_SA(1, 0), cA + kstep, voffA); PG8_STAGE(PG8_SB(1, 1), cB + hstep + kstep, voffB);
        PG8_WAIT_V(6); PG8_BAR;
    } else {
        PG8_STAGE(PG8_SB(0, 0), cB, voffB); PG8_STAGE(PG8_SA(0, 0), cA, voffA); PG8_STAGE(PG8_SB(0, 1), cB + hstep, voffB); PG8_STAGE(PG8_SA(0, 1), cA + hstep, voffA);
        if (wr == 1) PG8_BAR;
        PG8_WAIT_V(4); PG8_BAR;
        PG8_STAGE(PG8_SB(1, 0), cB + kstep, voffB); PG8_STAGE(PG8_SA(1, 0), cA + kstep, voffA); PG8_STAGE(PG8_SB(1, 1), cB + hstep + kstep, voffB);
        PG8_WAIT_V(6); PG8_BAR;
    }
    for (;;) {
        const bool has_next = S.next(ui + 1, nxt);
        const char* nA = has_next ? (const char*)g.A + (size_t)nxt.pm * tstep : cA; const char* nB = has_next ? (const char*)g.Bt + (size_t)nxt.pn * tstep : cB;
        for (int t = 0; t < nt; t += 2) {
            const bool last = (t == nt - 2);
            const char* a1 = cA + (size_t)(t + 1) * kstep;
            const char* a2 = last ? nA : cA + (size_t)(t + 2) * kstep; const char* b2 = last ? nB : cB + (size_t)(t + 2) * kstep;
            const char* a3 = a2 + kstep; const char* b3 = b2 + kstep;
            if (last && has_next) S.a_ready(nxt);
            if constexpr (SP2) {
            PG8_LDB(B0, 0, 0); PG8_LDB(B1, 0, 1); PG8_SCHED; PG8_LDA(At, 0, 0); PG8_STAGE(PG8_SA(1, 1), a1 + hstep, voffA);
            PG8_WAIT_V(8); PG8_WAIT_L(0); PG8_BAR; PG8_MMA(0, 0, At, B0); PG8_MMA(0, 1, At, B1); PG8_BAR; PG8_SCHED;
            PG8_LDA(At, 0, 1); PG8_STAGE(PG8_SB(0, 0), b2, voffB); PG8_STAGE(PG8_SB(0, 1), b2 + hstep, voffB); PG8_STAGE(PG8_SA(0, 0), a2, voffA);
            PG8_WAIT_V(8); PG8_WAIT_L(0); PG8_BAR; PG8_MMA(1, 0, At, B0); PG8_MMA(1, 1, At, B1); PG8_BAR; PG8_SCHED;
            PG8_LDB(B0, 1, 0); PG8_LDB(B1, 1, 1); PG8_SCHED; PG8_LDA(At, 1, 0); PG8_STAGE(PG8_SA(0, 1), a2 + hstep, voffA);
            PG8_WAIT_V(8); PG8_WAIT_L(0); PG8_BAR; PG8_MMA(0, 0, At, B0); PG8_MMA(0, 1, At, B1); PG8_BAR; PG8_SCHED;
            PG8_LDA(At, 1, 1); PG8_STAGE(PG8_SB(1, 0), b3, voffB); PG8_STAGE(PG8_SB(1, 1), b3 + hstep, voffB); PG8_STAGE(PG8_SA(1, 0), a3, voffA);
            PG8_WAIT_V(8); PG8_WAIT_L(0); PG8_BAR; PG8_MMA(1, 0, At, B0); PG8_MMA(1, 1, At, B1); PG8_BAR; PG8_SCHED;
            } else {
            PG8_LDB(B0, 0, 0); PG8_SCHED; PG8_LDA(At, 0, 0); PG8_STAGE(PG8_SA(1, 1), a1 + hstep, voffA);
            PG8_WAIT_L(8); PG8_BAR; PG8_WAIT_L(0); PG8_MMA(0, 0, At, B0); PG8_BAR; PG8_SCHED;
            PG8_LDB(B1, 0, 1); PG8_STAGE(PG8_SB(0, 0), b2, voffB);
            PG8_BAR; PG8_WAIT_L(0); PG8_MMA(0, 1, At, B1); PG8_BAR;
            PG8_LDA(At, 0, 1); PG8_STAGE(PG8_SA(0, 0), a2, voffA);
            PG8_BAR; PG8_WAIT_L(0); PG8_MMA(1, 0, At, B0); PG8_BAR; PG8_SCHED;
            PG8_STAGE(PG8_SB(0, 1), b2 + hstep, voffB);
            PG8_WAIT_V(6); PG8_BAR; PG8_MMA(1, 1, At, B1); PG8_BAR;
            PG8_LDB(B0, 1, 0); PG8_SCHED; PG8_LDA(At, 1, 0); PG8_STAGE(PG8_SA(0, 1), a2 + hstep, voffA);
            PG8_WAIT_L(8); PG8_BAR; PG8_WAIT_L(0); PG8_MMA(0, 0, At, B0); PG8_BAR; PG8_SCHED;
            PG8_LDB(B1, 1, 1); PG8_STAGE(PG8_SB(1, 0), b3, voffB);
            PG8_BAR; PG8_WAIT_L(0); PG8_MMA(0, 1, At, B1); PG8_BAR;
            PG8_LDA(At, 1, 1); PG8_STAGE(PG8_SA(1, 0), a3, voffA);
            PG8_BAR; PG8_WAIT_L(0); PG8_MMA(1, 0, At, B0); PG8_BAR; PG8_SCHED;
            PG8_STAGE(PG8_SB(1, 1), b3 + hstep, voffB);
            PG8_WAIT_V(6); PG8_BAR; PG8_MMA(1, 1, At, B1); PG8_BAR;
            }
        }
        if constexpr (ALIGN_EPI) { if (wr == 0) PG8_BAR; }
        if constexpr (!Epi::AFTER_DRAIN) { E(acc, cur, wr, wc, fr, fq); S.done(cur); }
        if (!has_next) break;
#pragma unroll
        for (int a = 0; a < 2; ++a)
#pragma unroll
            for (int b = 0; b < 2; ++b)
#pragma unroll
                for (int m = 0; m < 4; ++m)
#pragma unroll
                    for (int n = 0; n < 2; ++n) acc[a][b][m][n] = (f32x4){0.f, 0.f, 0.f, 0.f};
        cur = nxt; cA = nA; cB = nB; ++ui;
        if constexpr (ALIGN_EPI) { if (wr == 1) PG8_BAR; }
    }
    PG8_WAIT_V(0);
    if constexpr (!ALIGN_EPI) { if (wr == 0) PG8_BAR; }
    PG8_BAR;
    if constexpr (Epi::AFTER_DRAIN) { E.fused(acc, cur, wr, wc, fr, fq, lds, wid, lane); S.done(cur); }
#undef PG8_SA
#undef PG8_SB
#undef PG8_STAGE
#undef PG8_LDA
#undef PG8_LDB
#undef PG8_MMA
#undef PG8_WAIT_V
#undef PG8_WAIT_L
#undef PG8_BAR
#undef PG8_SCHED
}
}
namespace pg8 {
__device__ __forceinline__ float bf2f(unsigned short b) { return __uint_as_float(((unsigned)b) << 16); }
__device__ __forceinline__ float bflo(unsigned w) { return __uint_as_float(w << 16); }
__device__ __forceinline__ float bfhi(unsigned w) { return __uint_as_float(w & 0xffff0000u); }
__device__ __forceinline__ float sigm(float x) { return 1.f / (1.f + __expf(-x)); }
template <int MODE> struct EpiGate {
    static constexpr bool PERM = true, AFTER_DRAIN = false;
    bf16_t* O; int ldc; const bf16_t* G; int ldg;
    __device__ __forceinline__ void operator()(const f32x4 (&acc)[2][2][4][2], const Unit& u, int wr, int wc, int fr, int fq) const {
        const int row0 = u.pm * BM + wr * 64 + fr, col0 = u.pn * BM + wc * 32 + 8 * fq;
#pragma unroll
        for (int ai = 0; ai < 2; ++ai)
#pragma unroll
            for (int m = 0; m < 4; ++m) { const size_t row = (size_t)(row0 + ai * HALF + m * 16);
#pragma unroll
                for (int bj = 0; bj < 2; ++bj) {
                    const u32x4 gw = *(const u32x4*)(G + row * ldg + col0 + bj * HALF);
                    f32x4 v0 = acc[ai][bj][m][0], v1 = acc[ai][bj][m][1];
                    v0[0] *= sigm(bflo(gw.x)); v0[1] *= sigm(bfhi(gw.x)); v0[2] *= sigm(bflo(gw.y)); v0[3] *= sigm(bfhi(gw.y));
                    v1[0] *= sigm(bflo(gw.z)); v1[1] *= sigm(bfhi(gw.z)); v1[2] *= sigm(bflo(gw.w)); v1[3] *= sigm(bfhi(gw.w));
                    bf16_t* op = O + row * ldc + col0 + bj * HALF;
                    if (MODE == 1) { const u32x4 ow = *(const u32x4*)op;
                        v0[0] += bflo(ow.x); v0[1] += bfhi(ow.x); v0[2] += bflo(ow.y); v0[3] += bfhi(ow.y);
                        v1[0] += bflo(ow.z); v1[1] += bfhi(ow.z); v1[2] += bflo(ow.w); v1[3] += bfhi(ow.w); }
                    u32x4 w; w.x = cvt_pk_bf16(v0[0], v0[1]); w.y = cvt_pk_bf16(v0[2], v0[3]); w.z = cvt_pk_bf16(v1[0], v1[1]); w.w = cvt_pk_bf16(v1[2], v1[3]);
                    *(u32x4*)op = w; } }
    }
};
struct BranchOrder {
    StaticOrder base; int dm, dn;
    __host__ __device__ void init(int M, int N, int G_, int c_) { base.init(M, N, G_, c_); dm = M / BM; dn = N / BM; }
    __host__ __device__ bool next(int i, Unit& u) const { if (!base.next(i >> 1, u)) return false; if (i & 1) { u.pm += dm; u.pn += dn; } return true; }
    __device__ __forceinline__ void a_ready(const Unit&) const {}
    __device__ __forceinline__ void done(const Unit&) const {}
};
struct EpiGate2 {
    static constexpr bool PERM = true, AFTER_DRAIN = false;
    bf16_t* O; int ldc; const bf16_t* G0; const bf16_t* G1; int ldg; int dm, dn;
    __device__ __forceinline__ void operator()(const f32x4 (&acc)[2][2][4][2], const Unit& u, int wr, int wc, int fr, int fq) const {
        const bool second = u.pm >= dm;
        Unit v = u; if (second) { v.pm -= dm; v.pn -= dn; }
        if (second) { EpiGate<1> e{O, ldc, G1, ldg}; e(acc, v, wr, wc, fr, fq); } else { EpiGate<0> e{O, ldc, G0, ldg}; e(acc, v, wr, wc, fr, fq); }
    }
};
struct EpiResid {
    static constexpr bool PERM = true, AFTER_DRAIN = false;
    const float* R; float* Hf; bf16_t* Hb; float* ss; int ldc;
    __device__ __forceinline__ void operator()(const f32x4 (&acc)[2][2][4][2], const Unit& u, int wr, int wc, int fr, int fq) const {
        const int row0 = u.pm * BM + wr * 64 + fr, col0 = u.pn * BM + wc * 32 + 8 * fq;
#pragma unroll
        for (int ai = 0; ai < 2; ++ai)
#pragma unroll
            for (int m = 0; m < 4; ++m) { const size_t row = (size_t)(row0 + ai * HALF + m * 16); float sq = 0.f;
#pragma unroll
                for (int bj = 0; bj < 2; ++bj) {
                    const size_t off = row * ldc + col0 + bj * HALF;
                    const f32x4 r0 = *(const f32x4*)(R + off), r1 = *(const f32x4*)(R + off + 4);
                    const f32x4 v0 = acc[ai][bj][m][0] + r0, v1 = acc[ai][bj][m][1] + r1;
                    *(f32x4*)(Hf + off) = v0; *(f32x4*)(Hf + off + 4) = v1;
                    u32x4 w; w.x = cvt_pk_bf16(v0[0], v0[1]); w.y = cvt_pk_bf16(v0[2], v0[3]); w.z = cvt_pk_bf16(v1[0], v1[1]); w.w = cvt_pk_bf16(v1[2], v1[3]);
                    *(u32x4*)(Hb + off) = w;
                    sq += (v0[0] * v0[0] + v0[1] * v0[1]) + (v0[2] * v0[2] + v0[3] * v0[3]) + (v1[0] * v1[0] + v1[1] * v1[1]) + (v1[2] * v1[2] + v1[3] * v1[3]); }
                sq += __shfl_xor(sq, 16); sq += __shfl_xor(sq, 32);
                if (fq == 0) atomicAdd(ss + row, sq); }
    }
};
struct EpiRowScale {
    static constexpr bool PERM = true, AFTER_DRAIN = false;
    bf16_t* O; int ldc; const float* ss; float inv_n, eps;
    __device__ __forceinline__ void operator()(const f32x4 (&acc)[2][2][4][2], const Unit& u, int wr, int wc, int fr, int fq) const {
        const int row0 = u.pm * BM + wr * 64 + fr, col0 = u.pn * BM + wc * 32 + 8 * fq;
#pragma unroll
        for (int ai = 0; ai < 2; ++ai)
#pragma unroll
            for (int m = 0; m < 4; ++m) { const size_t row = (size_t)(row0 + ai * HALF + m * 16);
                const float sc = rsqrtf(__hip_atomic_load(ss + row, __ATOMIC_RELAXED, __HIP_MEMORY_SCOPE_AGENT) * inv_n + eps);
#pragma unroll
                for (int bj = 0; bj < 2; ++bj) { const f32x4 v0 = acc[ai][bj][m][0] * sc, v1 = acc[ai][bj][m][1] * sc;
                    u32x4 w; w.x = cvt_pk_bf16(v0[0], v0[1]); w.y = cvt_pk_bf16(v0[2], v0[3]); w.z = cvt_pk_bf16(v1[0], v1[1]); w.w = cvt_pk_bf16(v1[2], v1[3]);
                    *(u32x4*)(O + row * ldc + col0 + bj * HALF) = w; } }
    }
};
}
constexpr int D_MODEL = 2048, BATCH = 2, SEQ = 4096, NTOK = BATCH * SEQ;
constexpr int HD = 64, NCMP = 255, CMP_STRIDE = 16, CMP_LEN = 32, CMP_HID = 128;
constexpr int SEL_LEN = 64, SEL_TOPK = 16, WINDOW = 512;
constexpr int PEER_KEYS = 128, PEER_E = 128;
constexpr int NSA_Q = 1024, SB_W = 1024;
constexpr int IN_COLS = 9776, PLD = 9984;
constexpr int C_QN = 0, C_KC = 1024, C_VC = 1280, C_KS = 1536, C_VS = 1792, C_KW = 2048, C_VW = 2304, C_GBR = 2560,
              C_QB = 2608, C_KB = 3632, C_VB = 4656, C_GA = 5680, C_GB = 7728;
constexpr float EPS = 1e-6f, NEGF = -1e30f;
constexpr int NWAVES = 8, NTHR = 512;

constexpr size_t MiB = 1u << 20;
constexpr size_t WS_CTL = 0, CTL_ZERO_BYTES = 1 * MiB;
constexpr size_t WS_WIN = 2 * MiB;
constexpr size_t WS_WBN = 42 * MiB, WS_WBS = 46 * MiB;
constexpr size_t WS_WOUT = 50 * MiB, WS_WPQ = 58 * MiB;
constexpr size_t WS_MISC = 66 * MiB;
constexpr size_t WS_XN = 70 * MiB;
constexpr size_t WS_PROJ = 102 * MiB;
constexpr size_t WS_ONSA = 258 * MiB, WS_OSB = 274 * MiB;
constexpr size_t WS_H = 290 * MiB;
constexpr size_t WS_HB = 354 * MiB;
constexpr size_t WS_END = 386 * MiB;
constexpr size_t WS_UB = 102 * MiB, WS_VB = 166 * MiB, WS_QP = 230 * MiB, WS_EXP = 262 * MiB, WS_GATE = 266 * MiB;
constexpr size_t MISC_KCB = 0, MISC_VCB = 1 * MiB, MISC_SKB = 2 * MiB, MISC_W1T = 2 * MiB + 512 * 1024, MISC_B1 = 3 * MiB + 512 * 1024;
constexpr int CW_BAR = 4096;
constexpr int CW_SS = 32768;

#define GAS __attribute__((address_space(1)))
#define LAS __attribute__((address_space(3)))
typedef unsigned short bf16;
typedef unsigned v4u __attribute__((ext_vector_type(4)));
typedef unsigned v2u __attribute__((ext_vector_type(2)));
typedef float f32x4 __attribute__((ext_vector_type(4)));
#define RLX_AGENT __ATOMIC_RELAXED, __HIP_MEMORY_SCOPE_AGENT
__device__ __forceinline__ unsigned f2bf(float f) { unsigned u = __builtin_bit_cast(unsigned, f); return (u + 0x7fffu + ((u >> 16) & 1u)) >> 16; }
__device__ __forceinline__ unsigned pk2(float lo, float hi) { return f2bf(lo) | (f2bf(hi) << 16); }
__device__ __forceinline__ float bf2f(bf16 b) { return __uint_as_float(((unsigned)b) << 16); }
__device__ __forceinline__ float bflo(unsigned w) { return __uint_as_float(w << 16); }
__device__ __forceinline__ float bfhi(unsigned w) { return __uint_as_float(w & 0xffff0000u); }

#define XB_TMO      128
#define XB_XCNT(j)  (256  + 64 * (j))
#define XB_XSUB(j)  (1280 + 64 * (j))
#define XB_XGEN(j)  (2304 + 64 * (j))
#define XB_TOP      3328
#define XB_TOPGEN   3392
#define XCD_BAR_WORDS 3456
#define XB_SPIN_CAP (1u << 24)
__device__ __forceinline__ unsigned xb_ld(unsigned* p)              { return __hip_atomic_load(p, __ATOMIC_RELAXED, __HIP_MEMORY_SCOPE_AGENT); }
__device__ __forceinline__ unsigned xb_add(unsigned* p, unsigned v) { return __hip_atomic_fetch_add(p, v, __ATOMIC_RELAXED, __HIP_MEMORY_SCOPE_AGENT); }
__device__ __forceinline__ unsigned xb_xcc_id() { return (unsigned)__builtin_amdgcn_s_getreg((3 << 11) | 20) & 0xFu; }
#define XB_SPIN(cond, bar) do { unsigned _sp = 0; while (cond) { __builtin_amdgcn_s_sleep(1); \
    if ((++_sp & 255u) == 0u) { if (xb_ld(&(bar)[XB_TMO])) break; if (_sp > XB_SPIN_CAP) { atomicAdd(&(bar)[XB_TMO], 1u); break; } } } } while (0)
struct XcdBarrier { unsigned* bar; unsigned x; volatile LAS unsigned* st; };
__device__ __forceinline__ XcdBarrier xcd_barrier_post(unsigned* bar, volatile LAS unsigned* st) {
    XcdBarrier b; b.bar = bar; b.x = xb_xcc_id(); b.st = st;
    if (threadIdx.x == 0) (void)xb_add(&bar[XB_XCNT(b.x)], 1u);
    return b;
}
__device__ __forceinline__ void xcd_barrier_complete(unsigned* bar, unsigned x, unsigned& nloc, unsigned& nx) {
    const unsigned G = gridDim.x * gridDim.y * gridDim.z;
    unsigned sum, cnt, mine, sp = 0u;
    for (;;) {
        sum = 0u; cnt = 0u; mine = 0u;
#pragma unroll
        for (unsigned j = 0; j < 16; ++j) { const unsigned c = xb_ld(&bar[XB_XCNT(j)]); sum += c; cnt += (c > 0u) ? 1u : 0u; mine = (j == x) ? c : mine; }
        if (sum == G) break;
        __builtin_amdgcn_s_sleep(1);
        if ((++sp & 255u) == 0u) { if (xb_ld(&bar[XB_TMO])) break; if (sp > XB_SPIN_CAP) { atomicAdd(&bar[XB_TMO], 1u); break; } }
    }
    nloc = mine > 0u ? mine : 1u; nx = cnt > 0u ? cnt : 1u;
}
__device__ __forceinline__ void xcd_barrier(const XcdBarrier& b) {
    asm volatile("s_waitcnt vmcnt(0)" ::: "memory");
    __syncthreads();
    if (threadIdx.x == 0) {
        unsigned* bar = b.bar;
        const unsigned bx = xb_xcc_id();
        __builtin_amdgcn_s_waitcnt(0);
        unsigned nloc = b.st[0], nx = b.st[1];
        if (nloc == 0u) { xcd_barrier_complete(bar, bx, nloc, nx); b.st[0] = nloc; b.st[1] = nx; }
        const unsigned old = xb_add(&bar[XB_XSUB(bx)], 1u);
        const unsigned gen = old / nloc;
        if (old + 1u == (gen + 1u) * nloc) {
            __builtin_amdgcn_fence(__ATOMIC_RELEASE, "agent");
            asm volatile("s_waitcnt vmcnt(0)" ::: "memory");
            const unsigned og = xb_add(&bar[XB_TOP], 1u);
            const unsigned tg = og / nx;
            if (og + 1u == (tg + 1u) * nx) xb_add(&bar[XB_TOPGEN], 1u);
            else XB_SPIN(xb_ld(&bar[XB_TOPGEN]) == tg, bar);
            __builtin_amdgcn_fence(__ATOMIC_ACQUIRE, "agent");
            xb_add(&bar[XB_XGEN(bx)], 1u);
            asm volatile("s_waitcnt vmcnt(0)" ::: "memory");
        } else {
            XB_SPIN(xb_ld(&bar[XB_XGEN(bx)]) == gen, bar);
            __builtin_amdgcn_fence(__ATOMIC_ACQUIRE, "agent");
            asm volatile("s_waitcnt vmcnt(0)" ::: "memory");
        }
    }
    __syncthreads();
}

__device__ __forceinline__ int rel_bucket(int d) {
    if (d < 16) return d < 0 ? 0 : d;
    int b = 16;
    b += (d >= 21); b += (d >= 27); b += (d >= 35); b += (d >= 46); b += (d >= 59); b += (d >= 77); b += (d >= 99); b += (d >= 128);
    b += (d >= 166); b += (d >= 216); b += (d >= 280); b += (d >= 363); b += (d >= 470); b += (d >= 609); b += (d >= 790);
    return b;
}
__device__ __forceinline__ float gelu_tanh(float x) { const float k = 0.7978845608028654f; return 0.5f * x * (1.f + tanhf(k * (x + 0.044715f * x * x * x))); }
__device__ __forceinline__ float sigmoidf_(float x) { return 1.f / (1.f + expf(-x)); }
__device__ __forceinline__ float wave_sum(float v) {
#pragma unroll
    for (int o = 32; o >= 1; o >>= 1) v += __shfl_xor(v, o);
    return v;
}
__device__ __forceinline__ float wave_max(float v) {
#pragma unroll
    for (int o = 32; o >= 1; o >>= 1) v = fmaxf(v, __shfl_xor(v, o));
    return v;
}
__device__ __forceinline__ float half_sum(float v, float* red) {
    v = wave_sum(v);
    __syncthreads();
    if ((threadIdx.x & 63) == 0) red[(threadIdx.x >> 6) & 3] = v;
    __syncthreads();
    return red[0] + red[1] + red[2] + red[3];
}
__device__ __forceinline__ float half_max(float v, float* red) {
    v = wave_max(v);
    __syncthreads();
    if ((threadIdx.x & 63) == 0) red[(threadIdx.x >> 6) & 3] = v;
    __syncthreads();
    return fmaxf(fmaxf(red[0], red[1]), fmaxf(red[2], red[3]));
}

struct Args {
    const float* in[19]; float* out; unsigned char* ws; int ph_lo, ph_hi;
};

__device__ __forceinline__ void p0_transpose_item(const float* W, int K, int N, bf16* WT, const float* gk, LAS float* scr, int item, int lane) {
    const int nblk = (N + 31) / 32, kb = item / nblk, nb = item % nblk, k0 = 64 * kb, n0 = 32 * nb;
    const int c4 = (lane & 7) * 4, r8 = lane >> 3;
    const bool cok = (n0 + c4) < N;
    f32x4 v[8];
#pragma unroll
    for (int i = 0; i < 8; ++i) { const int kk = 8 * i + r8; v[i] = cok ? *(const f32x4*)(W + (size_t)(k0 + kk) * N + n0 + c4) : (f32x4){0.f, 0.f, 0.f, 0.f}; }
#pragma unroll
    for (int i = 0; i < 8; ++i) { const int kk = 8 * i + r8; const float g = gk ? gk[k0 + kk] : 1.f;
        scr[kk * 33 + c4 + 0] = v[i].x * g; scr[kk * 33 + c4 + 1] = v[i].y * g; scr[kk * 33 + c4 + 2] = v[i].z * g; scr[kk * 33 + c4 + 3] = v[i].w * g; }
    asm volatile("s_waitcnt lgkmcnt(0)" ::: "memory");
    const int c = lane & 7;
#pragma unroll
    for (int j = 0; j < 4; ++j) { const int n = (lane >> 3) + 8 * j; const LAS float* s = scr + (8 * c) * 33 + n;
        v4u o; o.x = pk2(s[0 * 33], s[1 * 33]); o.y = pk2(s[2 * 33], s[3 * 33]); o.z = pk2(s[4 * 33], s[5 * 33]); o.w = pk2(s[6 * 33], s[7 * 33]);
        if (n0 + n < N) *(v4u*)(WT + (size_t)(n0 + n) * K + k0 + 8 * c) = o; }
    asm volatile("s_waitcnt lgkmcnt(0)" ::: "memory");
}
__device__ __forceinline__ void rms_row_to_bf16(const float* xrow, const float* g, bf16* orow, int lane) {
    const f32x4* xr = (const f32x4*)xrow + lane; const f32x4* gr = (const f32x4*)g + lane;
    f32x4 v[8]; float s = 0.f;
#pragma unroll
    for (int j = 0; j < 8; ++j) { v[j] = xr[64 * j]; s += (v[j].x * v[j].x + v[j].y * v[j].y) + (v[j].z * v[j].z + v[j].w * v[j].w); }
    const float r = rsqrtf(wave_sum(s) * (1.f / D_MODEL) + EPS);
    v2u* o8 = (v2u*)orow + lane;
#pragma unroll
    for (int j = 0; j < 8; ++j) { const f32x4 gv = gr[64 * j]; v2u w; w.x = pk2(v[j].x * r * gv.x, v[j].y * r * gv.y); w.y = pk2(v[j].z * r * gv.z, v[j].w * r * gv.w); o8[64 * j] = w; }
}
__device__ __forceinline__ void cvt_flat(const float* src, bf16* dst, size_t n, size_t gthread, size_t nthreads) {
    for (size_t i = gthread * 8; i < n; i += nthreads * 8) {
        const f32x4 a = *(const f32x4*)(src + i), b = *(const f32x4*)(src + i + 4);
        v4u o; o.x = pk2(a.x, a.y); o.y = pk2(a.z, a.w); o.z = pk2(b.x, b.y); o.w = pk2(b.z, b.w);
        *(v4u*)(dst + i) = o;
    }
}
__device__ __forceinline__ void ph_compress_naive(const bf16* PROJ, const float* const* in, bf16* KCB, bf16* VCB, float* ldsf, int bid, int G) {
    const int tid = threadIdx.x, grp = tid >> 7, gt = tid & 127;
    if (bid == 0) for (int i = tid; i < 2 * 8 * HD; i += NTHR) { bf16* dst = (i >= 8 * HD) ? VCB : KCB; const int k = i & (8 * HD - 1); dst[(size_t)((k >> 6) * 256 + 255) * HD + (k & 63)] = 0; }
    float* blk = ldsf + grp * 2048; float* hid = ldsf + 4 * 2048 + grp * 128;
    const int per = BATCH * NCMP * 4, nitems = 2 * per;
    for (int base = bid * 4; base < nitems; base += G * 4) {
        const int item = base + grp; const bool ok = item < nitems;
        const int kv = ok ? item / per : 0, idx = ok ? item % per : 0;
        const int g = idx & 3, n = (idx >> 2) % NCMP, b = (idx >> 2) / NCMP;
        const float* pe = in[kv ? 6 : 3]; const float* w1 = in[kv ? 7 : 4]; const float* w2 = in[kv ? 8 : 5];
        const int coff = kv ? C_VC : C_KC;
        if (ok) for (int i = gt; i < CMP_LEN * HD; i += 128) { const int l = i >> 6, dd = i & 63; blk[i] = bf2f(PROJ[(size_t)(b * SEQ + n * CMP_STRIDE + l) * PLD + coff + g * HD + dd]) + pe[i]; }
        __syncthreads();
        if (ok) { float a = 0.f;
#pragma unroll 8
            for (int k = 0; k < CMP_LEN * HD; ++k) a += blk[k] * w1[(size_t)k * CMP_HID + gt];
            hid[gt] = gelu_tanh(a); }
        __syncthreads();
        if (ok && gt < HD) { float o = 0.f;
#pragma unroll 8
            for (int k = 0; k < CMP_HID; ++k) o += hid[k] * w2[k * HD + gt];
            (kv ? VCB : KCB)[(size_t)((b * 4 + g) * 256 + n) * HD + gt] = (bf16)f2bf(o); }
        __syncthreads();
    }
}

__device__ __forceinline__ void ph_stick_naive(const bf16* PROJ, bf16* OSB, int bid, int G) {
    const int lane = threadIdx.x & 63, gw = bid * NWAVES + (threadIdx.x >> 6), NGW = G * NWAVES;
    for (int row = gw; row < BATCH * 16 * SEQ; row += NGW) {
        const int t = row % SEQ, h = (row / SEQ) & 15, b = row / (SEQ * 16);
        const float qv = bf2f(PROJ[(size_t)(b * SEQ + t) * PLD + C_QB + h * HD + lane]);
        float acc = 0.f, suffix = 0.f;
        for (int s = t - 1; s >= 0; --s) {
            const bf16* kr = PROJ + (size_t)(b * SEQ + s) * PLD;
            const float z = wave_sum(qv * bf2f(kr[C_KB + h * HD + lane])) * 0.125f;
            const float lb = fminf(z, 0.f) - log1pf(expf(-fabsf(z)));
            acc += expf(lb + suffix) * bf2f(kr[C_VB + h * HD + lane]);
            suffix += lb - z;
            if (suffix < -80.f) break;
        }
        OSB[(size_t)(b * SEQ + t) * SB_W + h * HD + lane] = (bf16)f2bf(acc);
    }
}

__device__ __forceinline__ void ph_route_naive(const bf16* QP, const float* subk, int* EXPERT, float* GATE, float* ldsf, int bid, int G) {
    const int tid = threadIdx.x, hb = tid >> 8, ht = tid & 255;
    float* base = ldsf + hb * 4608;
    float* qs = base; float (*s)[128] = (float (*)[128])(base + 2048); float (*tv)[16] = (float (*)[16])(base + 4096); int (*ti)[16] = (int (*)[16])(base + 4352);
    for (int nb = bid * 2; nb < NTOK; nb += G * 2) {
        const int n = nb + hb;
        __syncthreads();
        for (int i = ht; i < 2048; i += 256) qs[i] = bf2f(QP[(size_t)n * 2048 + i]);
        __syncthreads();
#pragma unroll 1
        for (int r = 0; r < 8; ++r) {
            const int idx = ht + 256 * r, list = idx >> 7, k = idx & 127;
            const float* kr = subk + ((size_t)list * 128 + k) * 128;
            float a = 0.f;
#pragma unroll 8
            for (int c = 0; c < 128; ++c) a += qs[list * 128 + c] * kr[c];
            s[list][k] = a;
        }
        __syncthreads();
        if (ht < 16) {
            const int l = ht;
#pragma unroll 1
            for (int r = 0; r < 16; ++r) {
                float best = -INFINITY; int bi = 0;
                for (int k = 0; k < 128; ++k) { const float v = s[l][k]; if (v > best) { best = v; bi = k; } }
                tv[l][r] = best; ti[l][r] = bi; s[l][bi] = -INFINITY;
            }
        }
        __syncthreads();
        if (ht < 8) {
            const int h = ht;
            unsigned long long used0 = 0, used1 = 0, used2 = 0, used3 = 0;
            float bsv = 0.f, mx = 0.f, sum = 0.f;
#pragma unroll 1
            for (int r = 0; r < 16; ++r) {
                float best = -INFINITY; int bidx = 0;
                for (int j = 0; j < 256; ++j) {
                    const unsigned long long u = (j < 64) ? used0 : (j < 128) ? used1 : (j < 192) ? used2 : used3;
                    if ((u >> (j & 63)) & 1ull) continue;
                    const float v = tv[2 * h][j >> 4] + tv[2 * h + 1][j & 15];
                    if (v > best) { best = v; bidx = j; }
                }
                if (bidx < 64) used0 |= 1ull << bidx; else if (bidx < 128) used1 |= 1ull << (bidx & 63); else if (bidx < 192) used2 |= 1ull << (bidx & 63); else used3 |= 1ull << (bidx & 63);
                if (r == 0) mx = best;
                const float e = expf(best - mx); sum += e; bsv = e;
                EXPERT[(size_t)n * PEER_E + h * 16 + r] = ti[2 * h][bidx >> 4] * PEER_KEYS + ti[2 * h + 1][bidx & 15];
                GATE[(size_t)n * PEER_E + h * 16 + r] = bsv;
            }
            const float inv = 1.f / sum;
            for (int r = 0; r < 16; ++r) GATE[(size_t)n * PEER_E + h * 16 + r] *= inv;
        }
    }
    __syncthreads();
}

__device__ __forceinline__ void ph_ffn_naive(const float* H, const float* ss, const float* gffn, const int* EXPERT, const float* GATE, const bf16* UB, const bf16* VB,
                                             const float* gfin, float* out, float* ldsf, int bid, int G) {
    const int tid = threadIdx.x, hb = tid >> 8, ht = tid & 255, w = ht >> 6, lane = tid & 63;
    float* part = ldsf + hb * (4 * 2048 + 8); float* red = part + 4 * 2048;
    for (int nb = bid * 2; nb < NTOK; nb += G * 2) {
        const int n = nb + hb;
        const float rstd = rsqrtf(ss[n] * (1.f / D_MODEL) + EPS);
        float xv[32], acc[32];
#pragma unroll
        for (int j = 0; j < 4; ++j) {
            const float* hp = H + (size_t)n * 2048 + j * 512 + lane * 8; const float* gp = gffn + j * 512 + lane * 8;
            const f32x4 a = *(const f32x4*)hp, b2 = *(const f32x4*)(hp + 4), ga = *(const f32x4*)gp, gb = *(const f32x4*)(gp + 4);
            xv[8 * j + 0] = a.x * rstd * ga.x; xv[8 * j + 1] = a.y * rstd * ga.y; xv[8 * j + 2] = a.z * rstd * ga.z; xv[8 * j + 3] = a.w * rstd * ga.w;
            xv[8 * j + 4] = b2.x * rstd * gb.x; xv[8 * j + 5] = b2.y * rstd * gb.y; xv[8 * j + 6] = b2.z * rstd * gb.z; xv[8 * j + 7] = b2.w * rstd * gb.w;
        }
#pragma unroll
        for (int j = 0; j < 32; ++j) acc[j] = 0.f;
#pragma unroll 1
        for (int e = 0; e < 32; ++e) {
            const int ei = EXPERT[(size_t)n * PEER_E + w * 32 + e];
            const float gt = GATE[(size_t)n * PEER_E + w * 32 + e];
            const bf16* ur = UB + (size_t)ei * 2048 + lane * 8; const bf16* vr = VB + (size_t)ei * 2048 + lane * 8;
            float d = 0.f;
#pragma unroll
            for (int j = 0; j < 4; ++j) { const v4u u4 = *(const v4u*)(ur + j * 512);
                d += xv[8 * j + 0] * bflo(u4.x) + xv[8 * j + 1] * bfhi(u4.x) + xv[8 * j + 2] * bflo(u4.y) + xv[8 * j + 3] * bfhi(u4.y)
                   + xv[8 * j + 4] * bflo(u4.z) + xv[8 * j + 5] * bfhi(u4.z) + xv[8 * j + 6] * bflo(u4.w) + xv[8 * j + 7] * bfhi(u4.w); }
            d = wave_sum(d);
            const float wgt = gt * gelu_tanh(d);
#pragma unroll
            for (int j = 0; j < 4; ++j) { const v4u v4 = *(const v4u*)(vr + j * 512);
                acc[8 * j + 0] += wgt * bflo(v4.x); acc[8 * j + 1] += wgt * bfhi(v4.x); acc[8 * j + 2] += wgt * bflo(v4.y); acc[8 * j + 3] += wgt * bfhi(v4.y);
                acc[8 * j + 4] += wgt * bflo(v4.z); acc[8 * j + 5] += wgt * bfhi(v4.z); acc[8 * j + 6] += wgt * bflo(v4.w); acc[8 * j + 7] += wgt * bfhi(v4.w); }
        }
        __syncthreads();
#pragma unroll
        for (int j = 0; j < 4; ++j)
#pragma unroll
            for (int e = 0; e < 8; ++e) part[w * 2048 + j * 512 + lane * 8 + e] = acc[8 * j + e];
        __syncthreads();
        float y[8]; float sq = 0.f;
#pragma unroll
        for (int j = 0; j < 8; ++j) { const int c = ht + 256 * j; y[j] = H[(size_t)n * 2048 + c] + part[c] + part[2048 + c] + part[4096 + c] + part[6144 + c]; sq += y[j] * y[j]; }
        const float tot = half_sum(sq, red);
        const float r = rsqrtf(tot * (1.f / D_MODEL) + EPS);
#pragma unroll
        for (int j = 0; j < 8; ++j) { const int c = ht + 256 * j; out[(size_t)n * 2048 + c] = y[j] * r * gfin[c]; }
    }
    __syncthreads();
}
namespace cmpr {
typedef short bf16x8 __attribute__((ext_vector_type(8)));
typedef float f32x4v __attribute__((ext_vector_type(4)));
__device__ __forceinline__ void compress_phase(const bf16* PROJ, const bf16* W1T, const float* BIAS1, const float* const* in, bf16* KCB, bf16* VCB,
                                               __attribute__((address_space(3))) unsigned char* lds3, int bid, int G) {
    int tid = threadIdx.x; asm volatile("" : "+v"(tid));
    const int lane = tid & 63, wid = __builtin_amdgcn_readfirstlane(tid >> 6), r16 = lane & 15, kq = lane >> 4;
    __attribute__((address_space(3))) float* PART = (__attribute__((address_space(3))) float*)lds3;
    __attribute__((address_space(3))) float* HID = (__attribute__((address_space(3))) float*)(lds3 + 65536);
    for (int unit = bid; unit < 256; unit += G) {
        const int c = unit & 15, g = (unit >> 4) & 3, b = (unit >> 6) & 1, kv = unit >> 7, n0 = 16 * c;
        const int coff = kv ? C_VC : C_KC;
        int nn = n0 + r16; if (nn > NCMP - 1) nn = NCMP - 1;
        const bf16* ap = PROJ + (size_t)(b * SEQ + 16 * nn + 4 * wid) * PLD + coff + g * HD + 8 * kq;
        const bf16* bp = W1T + (size_t)kv * CMP_HID * 2048 + (size_t)r16 * 2048 + 256 * wid + 8 * kq;
        f32x4v acc[8] = {};
#pragma unroll
        for (int ks = 0; ks < 8; ++ks) {
            const bf16x8 a = *(const bf16x8*)(ap + (size_t)(ks >> 1) * PLD + (ks & 1) * 32);
#pragma unroll
            for (int nt = 0; nt < 8; ++nt) { const bf16x8 w = *(const bf16x8*)(bp + (size_t)nt * 16 * 2048 + ks * 32); acc[nt] = __builtin_amdgcn_mfma_f32_16x16x32_bf16(a, w, acc[nt], 0, 0, 0); }
        }
#pragma unroll
        for (int nt = 0; nt < 8; ++nt)
#pragma unroll
            for (int r = 0; r < 4; ++r) PART[wid * 2048 + (kq * 4 + r) * 128 + nt * 16 + r16] = acc[nt][r];
        asm volatile("s_waitcnt lgkmcnt(0)" ::: "memory"); __syncthreads();
#pragma unroll
        for (int i = 0; i < 4; ++i) { const int e = tid + NTHR * i; float s = BIAS1[kv * CMP_HID + (e & 127)];
#pragma unroll
            for (int w = 0; w < 8; ++w) s += PART[w * 2048 + e];
            HID[e] = gelu_tanh(s); }
        asm volatile("s_waitcnt lgkmcnt(0)" ::: "memory"); __syncthreads();
        {
            const int nl = tid >> 5, d = (tid & 31) * 2; const float* w2 = in[kv ? 8 : 5];
            float o0 = 0.f, o1 = 0.f;
#pragma unroll 8
            for (int j = 0; j < CMP_HID; ++j) { const float hv = HID[nl * 128 + j]; const float2 wv = *(const float2*)(w2 + j * HD + d); o0 += hv * wv.x; o1 += hv * wv.y; }
            const int n = n0 + nl;
            const unsigned pk = (n < NCMP) ? pk2(o0, o1) : 0u;
            *(unsigned*)((kv ? VCB : KCB) + (size_t)((b * 4 + g) * 256 + n) * HD + d) = pk;
        }
        __syncthreads();
    }
}
}
#ifndef NSA_FAR
#define NSA_FAR 1
#endif
namespace nsa {
typedef short bf16x8 __attribute__((ext_vector_type(8)));
typedef short s16x4 __attribute__((ext_vector_type(4)));
typedef float f32x16 __attribute__((ext_vector_type(16)));
typedef unsigned u32x4 __attribute__((ext_vector_type(4)));
typedef __attribute__((address_space(3))) const char* lds_cptr;
typedef __attribute__((address_space(3))) unsigned char* lds_ptr;
constexpr int SLOTB = 16384;
constexpr int L_RING = 0, L_OV = 49152, L_BT = 81920, L_WSF = 94720, L_MASK = 96768, L_MISC = 97280, L_X = 97408, L_END = L_X + 32768;
constexpr int BT_N = 800;
constexpr float LOG2E = 1.4426950408889634f, SC2 = 0.125f * LOG2E, NEG2 = -1e30f;
static_assert(L_END <= 131072, "nsa LDS map");
__device__ __forceinline__ int crow(int r, int hi) { return (r & 3) + 8 * (r >> 2) + 4 * hi; }
__device__ __forceinline__ void glds16(const void* gsrc, unsigned lds_dst) { unsigned keep;
    asm volatile("s_mov_b32 %0, m0\n\ts_mov_b32 m0, %2\n\ts_nop 0\n\tglobal_load_lds_dwordx4 %1, off\n\ts_mov_b32 m0, %0" : "=&s"(keep) : "v"(gsrc), "s"(lds_dst) : "memory"); }
typedef float f32x2_t __attribute__((ext_vector_type(2))); typedef __bf16 bf16x2_t __attribute__((ext_vector_type(2)));
__device__ __forceinline__ unsigned cvtpk_s(float lo, float hi) { f32x2_t v = {lo, hi}; bf16x2_t b = __builtin_convertvector(v, bf16x2_t); return __builtin_bit_cast(unsigned, b); }
#define NSA_WAIT_BAR(N) asm volatile("s_waitcnt vmcnt(" #N ") lgkmcnt(0)\n\ts_barrier" ::: "memory")
#define NSA_SBAR() __builtin_amdgcn_sched_barrier(0)

__device__ __forceinline__ void qkt(f32x16& p0, f32x16& p1, lds_cptr Kslot, const bf16x8* qr, int r32, int hi) {
    lds_cptr kb = Kslot + hi * 1024 + r32 * 16;
    const f32x16 z = {};
#pragma unroll
    for (int d0 = 0; d0 < 4; ++d0) {
        const bf16x8 b0 = *(const __attribute__((address_space(3))) bf16x8*)(kb + d0 * 2048);
        const bf16x8 b1 = *(const __attribute__((address_space(3))) bf16x8*)(kb + d0 * 2048 + 512);
        if (d0 == 0) { p0 = __builtin_amdgcn_mfma_f32_32x32x16_bf16(b0, qr[0], z, 0, 0, 0); p1 = __builtin_amdgcn_mfma_f32_32x32x16_bf16(b1, qr[0], z, 0, 0, 0); }
        else { p0 = __builtin_amdgcn_mfma_f32_32x32x16_bf16(b0, qr[d0], p0, 0, 0, 0); p1 = __builtin_amdgcn_mfma_f32_32x32x16_bf16(b1, qr[d0], p1, 0, 0, 0); }
    }
}
__device__ __forceinline__ void pv(f32x16* o, int vb, bf16x8 pa0, bf16x8 pa1, bf16x8 pa2, bf16x8 pa3) {
#pragma unroll
    for (int d0 = 0; d0 < 2; ++d0) { s16x4 lo[4], hi[4];
#pragma unroll
        for (int ks = 0; ks < 4; ++ks) {
            asm volatile("ds_read_b64_tr_b16 %0,%1 offset:%c2" : "=&v"(lo[ks]) : "v"(vb), "i"(d0 * 4096 + ks * 1024) : "memory");
            asm volatile("ds_read_b64_tr_b16 %0,%1 offset:%c2" : "=&v"(hi[ks]) : "v"(vb), "i"(d0 * 4096 + ks * 1024 + 512) : "memory"); }
        asm volatile("s_waitcnt lgkmcnt(0)" ::: "memory"); NSA_SBAR();
#define NSA_PK(k) (bf16x8){lo[k][0], lo[k][1], lo[k][2], lo[k][3], hi[k][0], hi[k][1], hi[k][2], hi[k][3]}
        o[d0] = __builtin_amdgcn_mfma_f32_32x32x16_bf16(pa0, NSA_PK(0), o[d0], 0, 0, 0);
        o[d0] = __builtin_amdgcn_mfma_f32_32x32x16_bf16(pa1, NSA_PK(1), o[d0], 0, 0, 0);
        o[d0] = __builtin_amdgcn_mfma_f32_32x32x16_bf16(pa2, NSA_PK(2), o[d0], 0, 0, 0);
        o[d0] = __builtin_amdgcn_mfma_f32_32x32x16_bf16(pa3, NSA_PK(3), o[d0], 0, 0, 0);
#undef NSA_PK
    }
}
__device__ __forceinline__ float rowmax32(const f32x16& p0, const f32x16& p1) {
    float a = fmaxf(p0[0], p1[0]);
#pragma unroll
    for (int r = 1; r < 16; ++r) a = fmaxf(a, fmaxf(p0[r], p1[r]));
    auto rr = __builtin_amdgcn_permlane32_swap(__float_as_uint(a), __float_as_uint(a), false, false);
    return fmaxf(__uint_as_float(rr[0]), __uint_as_float(rr[1]));
}
__device__ __forceinline__ float swap_add(float v) {
    auto rr = __builtin_amdgcn_permlane32_swap(__float_as_uint(v), __float_as_uint(v), false, false);
    return __uint_as_float(rr[0]) + __uint_as_float(rr[1]);
}

struct PassCtx {
    lds_ptr lds3; unsigned lds0;
    int lane, r32, hi, wid;
    int tq;
    const __attribute__((address_space(3))) float* bt;
    __attribute__((address_space(3))) float* wsf;
    int vboff;
};

template <int MODE>
__device__ __forceinline__ void run_pass(const PassCtx& c, int NT, int first, const bf16* Kb, const bf16* Vb, int pitch, const bf16x8* qr,
                                         unsigned mask_lo, unsigned mask_hi, f32x16 (&o)[2], f32x16 (&im)[2], float& m, float& l) {
    const __attribute__((address_space(3))) unsigned char* TL = (const __attribute__((address_space(3))) unsigned char*)(c.lds3 + L_MISC);
#define NSA_TID(i) ((MODE == 0) ? (i) : (MODE == 2) ? (first + (i)) : (int)TL[(i)])
#define NSA_ISSUE(i, slot) do { const int id_ = __builtin_amdgcn_readfirstlane(NSA_TID(i)); \
        const bf16* ks_ = Kb + (size_t)(64 * id_ + c.lane) * pitch + 8 * c.wid; \
        const bf16* vs_ = Vb + (size_t)(64 * id_ + 16 * (c.wid & 3) + (c.lane >> 2)) * pitch + 32 * (c.wid >> 2) + 8 * (c.lane & 3); \
        glds16(ks_, (unsigned)__builtin_amdgcn_readfirstlane(c.lds0 + L_RING + (slot) * SLOTB + c.wid * 1024)); \
        glds16(vs_, (unsigned)__builtin_amdgcn_readfirstlane(c.lds0 + L_RING + (slot) * SLOTB + 8192 + c.wid * 1024)); } while (0)
    if (NT > 0) NSA_ISSUE(0, 0);
    if (NT > 1) NSA_ISSUE(1, 1);
    int slot = 0;
    for (int i = 0; i < NT; ++i) {
        if (i + 1 < NT) NSA_WAIT_BAR(2); else NSA_WAIT_BAR(0);
        if (i + 2 < NT) { const int s2 = (slot == 0) ? 2 : slot - 1; NSA_ISSUE(i + 2, s2); }
        const int id = __builtin_amdgcn_readfirstlane(NSA_TID(i));
        f32x16 p0, p1;
        qkt(p0, p1, (lds_cptr)(c.lds3 + L_RING + slot * SLOTB), qr, c.r32, c.hi);
        const int dbase = (MODE == 0) ? (c.tq - 31 - 1024 * id) : (c.tq - 64 * id);
        bool selb = true;
        if (MODE == 1) selb = ((id < 32 ? (mask_lo >> id) : (mask_hi >> (id - 32))) & 1u) != 0u;
        if (NSA_FAR && MODE == 1 && __builtin_amdgcn_readfirstlane(c.tq - c.r32) - (64 * id + 63) >= 790) {
            const float bfar = c.bt[790];
#pragma unroll
            for (int r = 0; r < 16; ++r) { p0[r] = selb ? (p0[r] * SC2 + bfar) : NEG2; p1[r] = selb ? (p1[r] * SC2 + bfar) : NEG2; }
        } else {
        int dbh = dbase - ((MODE == 0) ? 64 * c.hi : 4 * c.hi);
        asm volatile("" : "+v"(dbh));
#pragma unroll
        for (int r = 0; r < 16; ++r) {
            const int d0 = dbh - ((MODE == 0) ? 16 * ((r & 3) + 8 * (r >> 2)) : ((r & 3) + 8 * (r >> 2)));
            const int d1 = (MODE == 0) ? (d0 - 512) : (d0 - 32);
            bool v0 = d0 >= 0, v1 = d1 >= 0;
            if (MODE == 2) { v0 = v0 && d0 < WINDOW; v1 = v1 && d1 < WINDOW; }
            if (MODE == 1) { v0 = v0 && selb; v1 = v1 && selb; }
            const int i0 = d0 < 0 ? 0 : (d0 > 790 ? 790 : d0), i1 = d1 < 0 ? 0 : (d1 > 790 ? 790 : d1);
            const float s0 = p0[r] * SC2 + c.bt[i0], s1 = p1[r] * SC2 + c.bt[i1];
            p0[r] = v0 ? s0 : NEG2; p1[r] = v1 ? s1 : NEG2;
        }
        }
        const float mt = rowmax32(p0, p1);
        const float mnew = fmaxf(m, mt);
        const float alpha = __builtin_amdgcn_exp2f(m - mnew);
        m = mnew;
        float rs = 0.f;
#pragma unroll
        for (int r = 0; r < 16; ++r) {
            const float e0 = (p0[r] > -1e29f) ? __builtin_amdgcn_exp2f(p0[r] - mnew) : 0.f;
            const float e1 = (p1[r] > -1e29f) ? __builtin_amdgcn_exp2f(p1[r] - mnew) : 0.f;
            p0[r] = e0; p1[r] = e1; rs += e0 + e1;
        }
        l = l * alpha + rs;
        if (!__all(alpha == 1.f)) {
            if (c.hi == 0) c.wsf[c.r32] = alpha;
            asm volatile("s_waitcnt lgkmcnt(0)" ::: "memory");
#pragma unroll
            for (int r = 0; r < 16; ++r) { const float a = c.wsf[crow(r, c.hi)]; o[0][r] *= a; o[1][r] *= a; if (MODE == 0) { im[0][r] *= a; im[1][r] *= a; } }
        }
        u32x4 pw0, pw1, pw2, pw3;
        pw0 = (u32x4){cvtpk_s(p0[0], p0[1]), cvtpk_s(p0[2], p0[3]), cvtpk_s(p0[4], p0[5]), cvtpk_s(p0[6], p0[7])};
        pw1 = (u32x4){cvtpk_s(p0[8], p0[9]), cvtpk_s(p0[10], p0[11]), cvtpk_s(p0[12], p0[13]), cvtpk_s(p0[14], p0[15])};
        pw2 = (u32x4){cvtpk_s(p1[0], p1[1]), cvtpk_s(p1[2], p1[3]), cvtpk_s(p1[4], p1[5]), cvtpk_s(p1[6], p1[7])};
        pw3 = (u32x4){cvtpk_s(p1[8], p1[9]), cvtpk_s(p1[10], p1[11]), cvtpk_s(p1[12], p1[13]), cvtpk_s(p1[14], p1[15])};
        NSA_SBAR();
        pv(o, (int)(c.lds0 + L_RING + slot * SLOTB + 8192) + c.vboff, __builtin_bit_cast(bf16x8, pw0), __builtin_bit_cast(bf16x8, pw1), __builtin_bit_cast(bf16x8, pw2), __builtin_bit_cast(bf16x8, pw3));
        if (MODE == 0) pv(im, (int)(c.lds0 + L_OV + id * 8192) + c.vboff, __builtin_bit_cast(bf16x8, pw0), __builtin_bit_cast(bf16x8, pw1), __builtin_bit_cast(bf16x8, pw2), __builtin_bit_cast(bf16x8, pw3));
        slot = (slot == 2) ? 0 : slot + 1;
    }
    asm volatile("s_waitcnt vmcnt(0) lgkmcnt(0)\n\ts_barrier" ::: "memory");
#undef NSA_TID
#undef NSA_ISSUE
}

__device__ __forceinline__ void build_ov(lds_ptr lds3) {
    for (int idx = threadIdx.x; idx < 4 * 4096; idx += NTHR) {
        const int kt = idx >> 12, nl = (idx >> 6) & 63, jc = idx & 63, n = 64 * kt + nl;
        unsigned short v = 0;
        if ((n & 3) != 3) { if (jc == (n >> 2)) v = 0x3F80; } else { if (jc == (n >> 2) || jc == (n >> 2) + 1) v = 0x3F00; }
        *(__attribute__((address_space(3))) unsigned short*)(lds3 + L_OV + kt * 8192 + ((jc >> 5) * 4 + (nl >> 4)) * 1024 + (nl & 15) * 64 + (jc & 31) * 2) = v;
    }
}

__device__ __forceinline__ void nsa_unit(bool build_bt, int b, int g, int qt, const bf16* PROJ, const bf16* KCBb, const bf16* VCBb, const float* rel, bf16* ONSA, lds_ptr lds3, unsigned lds0) {
    const int tid = threadIdx.x, lane = tid & 63, r32 = lane & 31, hi = lane >> 5;
    const int wid = __builtin_amdgcn_readfirstlane(tid >> 6), hh = wid & 3, th = wid >> 2;
    const int t0 = qt * 64, tq = t0 + 32 * th + r32, cur = qt;
    __attribute__((address_space(3))) float* BT = (__attribute__((address_space(3))) float*)(lds3 + L_BT);
    __attribute__((address_space(3))) unsigned* MASK = (__attribute__((address_space(3))) unsigned*)(lds3 + L_MASK);
    if (build_bt) for (int i = tid; i < 4 * BT_N; i += NTHR) { const int hq = i / BT_N, d = i - hq * BT_N; BT[i] = rel[rel_bucket(d) * 16 + g * 4 + hq] * LOG2E; }
    if (tid < 128) MASK[tid] = 0u;
    PassCtx c; c.lds3 = lds3; c.lds0 = lds0; c.lane = lane; c.r32 = r32; c.hi = hi; c.wid = wid; c.tq = tq;
    c.bt = BT + hh * BT_N; c.wsf = (__attribute__((address_space(3))) float*)(lds3 + L_WSF) + wid * 64;
    c.vboff = ((lane >> 4) & 1) * 32 + (lane & 3) * 8 + (4 * hi + ((lane & 15) >> 2)) * 64;
    const size_t qrow = (size_t)(b * SEQ + tq) * PLD;
    bf16x8 qr[4];
#pragma unroll
    for (int d0 = 0; d0 < 4; ++d0) qr[d0] = *(const bf16x8*)(PROJ + qrow + C_QN + (g * 4 + hh) * HD + d0 * 16 + hi * 8);
    const float gate0 = 1.f / (1.f + __expf(-bf2f(PROJ[qrow + C_GBR + 0 * 16 + g * 4 + hh])));
    const float gate1 = 1.f / (1.f + __expf(-bf2f(PROJ[qrow + C_GBR + 1 * 16 + g * 4 + hh])));
    const float gate2 = 1.f / (1.f + __expf(-bf2f(PROJ[qrow + C_GBR + 2 * 16 + g * 4 + hh])));
    asm volatile("s_waitcnt vmcnt(0) lgkmcnt(0)" ::: "memory");
    __syncthreads();
    f32x16 oc[2] = {}, o[2] = {}, im[2] = {};
    float m = NEG2, l = 0.f;
    {
        int cnt = (t0 + 32) / 16 + 1; if (cnt > NCMP) cnt = NCMP;
        const int NT = (cnt + 63) >> 6;
#if defined(PROBE_NSA_CMP2)
        run_pass<0>(c, NT, 0, KCBb + (size_t)(b * 4 + g) * 256 * HD, VCBb + (size_t)(b * 4 + g) * 256 * HD, HD, qr, 0u, 0u, o, im, m, l);
        o[0] = f32x16{}; o[1] = f32x16{}; im[0] = f32x16{}; im[1] = f32x16{}; m = NEG2; l = 0.f;
#endif
        run_pass<0>(c, NT, 0, KCBb + (size_t)(b * 4 + g) * 256 * HD, VCBb + (size_t)(b * 4 + g) * 256 * HD, HD, qr, 0u, 0u, o, im, m, l);
        const float lt = swap_add(l);
        const float inv = lt > 0.f ? 1.f / lt : 0.f;
        if (hi == 0) { c.wsf[r32] = inv * gate0; c.wsf[32 + r32] = inv; }
        asm volatile("s_waitcnt lgkmcnt(0)" ::: "memory");
#pragma unroll
        for (int r = 0; r < 16; ++r) { const float a = c.wsf[crow(r, hi)], a2 = c.wsf[32 + crow(r, hi)]; oc[0][r] = o[0][r] * a; oc[1][r] = o[1][r] * a; im[0][r] *= a2; im[1][r] *= a2; }
        __attribute__((address_space(3))) float* X = (__attribute__((address_space(3))) float*)(lds3 + L_X);
        const int area = (hh >> 1) * 2 + th;
        if (hh & 1) {
#pragma unroll
            for (int d0 = 0; d0 < 2; ++d0)
#pragma unroll
                for (int r = 0; r < 16; ++r) X[area * 2048 + crow(r, hi) * 64 + d0 * 32 + r32] = im[d0][r];
        }
        asm volatile("s_waitcnt lgkmcnt(0)" ::: "memory"); __syncthreads();
        if (!(hh & 1)) {
#pragma unroll
            for (int d0 = 0; d0 < 2; ++d0)
#pragma unroll
                for (int r = 0; r < 16; ++r) { im[d0][r] += X[area * 2048 + crow(r, hi) * 64 + d0 * 32 + r32]; if (hh == 2) X[area * 2048 + crow(r, hi) * 64 + d0 * 32 + r32] = im[d0][r]; }
        }
        asm volatile("s_waitcnt lgkmcnt(0)" ::: "memory"); __syncthreads();
        __attribute__((address_space(3))) float* T = (__attribute__((address_space(3))) float*)(lds3 + L_RING);
        if (hh == 0) {
#pragma unroll
            for (int d0 = 0; d0 < 2; ++d0)
#pragma unroll
                for (int r = 0; r < 16; ++r) T[(32 * th + crow(r, hi)) * 65 + d0 * 32 + r32] = im[d0][r] + X[(2 + th) * 2048 + crow(r, hi) * 64 + d0 * 32 + r32];
        }
        asm volatile("s_waitcnt lgkmcnt(0)" ::: "memory"); __syncthreads();
        {
            const int tok = tid & 63, jg = wid;
            float v[8]; int rank[8];
#pragma unroll
            for (int e = 0; e < 8; ++e) { const int j = 8 * jg + e; const bool forced = (j == 0) || (cur - j >= 0 && cur - j < 2);
                v[e] = (j <= cur) ? T[tok * 65 + j] + (forced ? 1e4f : 0.f) : -INFINITY; rank[e] = 0; }
#pragma unroll 2
            for (int j2 = 0; j2 < 64; ++j2) {
                const bool f2 = (j2 == 0) || (cur - j2 >= 0 && cur - j2 < 2);
                const float sv = (j2 <= cur) ? T[tok * 65 + j2] + (f2 ? 1e4f : 0.f) : -INFINITY;
#pragma unroll
                for (int e = 0; e < 8; ++e) { const int j = 8 * jg + e; rank[e] += (sv > v[e] || (sv == v[e] && j2 < j)) ? 1 : 0; }
            }
            unsigned bits = 0u;
#pragma unroll
            for (int e = 0; e < 8; ++e) { const int j = 8 * jg + e; if (j <= cur && rank[e] < SEL_TOPK) bits |= 1u << e; }
            if (bits) atomicOr((unsigned*)(MASK + tok * 2 + (jg >> 2)), bits << ((jg & 3) * 8));
        }
        asm volatile("s_waitcnt lgkmcnt(0)" ::: "memory"); __syncthreads();
        if (wid == 0) {
            unsigned ulo = MASK[lane * 2], uhi = MASK[lane * 2 + 1];
#pragma unroll
            for (int ofs = 32; ofs >= 1; ofs >>= 1) { ulo |= __shfl_xor(ulo, ofs); uhi |= __shfl_xor(uhi, ofs); }
            {
                __attribute__((address_space(3))) unsigned char* TL = (__attribute__((address_space(3))) unsigned char*)(lds3 + L_MISC);
                const unsigned long long mm = ((unsigned long long)uhi << 32) | ulo;
                int ln = lane; asm volatile("" : "+v"(ln));
                if ((mm >> ln) & 1ull) TL[__popcll(mm & ((1ull << ln) - 1ull))] = (unsigned char)ln;
                if (lane == 0) *(__attribute__((address_space(3))) int*)(lds3 + L_MISC + 64) = __popcll(mm);
            }
        }
        asm volatile("s_waitcnt lgkmcnt(0)" ::: "memory"); __syncthreads();
    }
    {
        const unsigned mlo = MASK[(32 * th + r32) * 2], mhi = MASK[(32 * th + r32) * 2 + 1];
        const int NT = __builtin_amdgcn_readfirstlane(*(__attribute__((address_space(3))) int*)(lds3 + L_MISC + 64));
#if defined(PROBE_NSA_SEL2)
        o[0] = f32x16{}; o[1] = f32x16{}; m = NEG2; l = 0.f;
        run_pass<1>(c, NT, 0, PROJ + (size_t)b * SEQ * PLD + C_KS + g * HD, PROJ + (size_t)b * SEQ * PLD + C_VS + g * HD, PLD, qr, mlo, mhi, o, im, m, l);
#endif
        o[0] = f32x16{}; o[1] = f32x16{}; m = NEG2; l = 0.f;
        run_pass<1>(c, NT, 0, PROJ + (size_t)b * SEQ * PLD + C_KS + g * HD, PROJ + (size_t)b * SEQ * PLD + C_VS + g * HD, PLD, qr, mlo, mhi, o, im, m, l);
        const float lt = swap_add(l);
        const float inv = lt > 0.f ? 1.f / lt : 0.f;
        if (hi == 0) c.wsf[r32] = inv * gate1;
        asm volatile("s_waitcnt lgkmcnt(0)" ::: "memory");
#pragma unroll
        for (int r = 0; r < 16; ++r) { const float a = c.wsf[crow(r, hi)]; oc[0][r] += o[0][r] * a; oc[1][r] += o[1][r] * a; }
    }
    {
        const int jlo = (qt - 8) > 0 ? (qt - 8) : 0, NT = qt - jlo + 1;
#if defined(PROBE_NSA_WIN2)
        o[0] = f32x16{}; o[1] = f32x16{}; m = NEG2; l = 0.f;
        run_pass<2>(c, NT, jlo, PROJ + (size_t)b * SEQ * PLD + C_KW + g * HD, PROJ + (size_t)b * SEQ * PLD + C_VW + g * HD, PLD, qr, 0u, 0u, o, im, m, l);
#endif
        o[0] = f32x16{}; o[1] = f32x16{}; m = NEG2; l = 0.f;
        run_pass<2>(c, NT, jlo, PROJ + (size_t)b * SEQ * PLD + C_KW + g * HD, PROJ + (size_t)b * SEQ * PLD + C_VW + g * HD, PLD, qr, 0u, 0u, o, im, m, l);
        const float lt = swap_add(l);
        const float inv = lt > 0.f ? 1.f / lt : 0.f;
        if (hi == 0) c.wsf[r32] = inv * gate2;
        asm volatile("s_waitcnt lgkmcnt(0)" ::: "memory");
#pragma unroll
        for (int r = 0; r < 16; ++r) { const float a = c.wsf[crow(r, hi)]; oc[0][r] += o[0][r] * a; oc[1][r] += o[1][r] * a; }
    }
    {
        __attribute__((address_space(3))) unsigned short* stg = (__attribute__((address_space(3))) unsigned short*)(lds3 + L_X) + wid * 2048;
#pragma unroll
        for (int r = 0; r < 16; ++r) { const int orow = crow(r, hi);
#pragma unroll
            for (int d0 = 0; d0 < 2; ++d0) stg[orow * 64 + d0 * 32 + r32] = (unsigned short)f2bf(oc[d0][r]); }
        asm volatile("s_waitcnt lgkmcnt(0)" ::: "memory");
        bf16* Ow = ONSA + (size_t)(b * SEQ + t0 + 32 * th) * NSA_Q + (g * 4 + hh) * HD;
#pragma unroll
        for (int i = 0; i < 4; ++i) { const int row = i * 8 + (lane >> 3), ch = lane & 7;
            const u32x4 vv = *(const __attribute__((address_space(3))) u32x4*)(stg + row * 64 + ch * 8);
            *(u32x4*)(Ow + (size_t)row * NSA_Q + ch * 8) = vv; }
    }
    asm volatile("s_waitcnt vmcnt(0) lgkmcnt(0)" ::: "memory");
    __syncthreads();
}

__device__ __forceinline__ void nsa_phase(const bf16* PROJ, const bf16* KCBb, const bf16* VCBb, const float* rel, bf16* ONSA, lds_ptr lds3, int vcu, int G) {
    const unsigned lds0 = (unsigned)(uintptr_t)lds3;
    build_ov(lds3);
    __syncthreads();
    int last_g = -1;
#ifndef NSA_REP
#define NSA_REP 1
#endif
#pragma unroll 1
    for (int rep_ = 0; rep_ < NSA_REP; ++rep_)
#pragma unroll 1
    for (int i = vcu; i < 512; i += G) {
        const int k = i & 255, bg = k >> 5, s = k & 31, qt = (i < 256) ? s : 63 - s;
        nsa_unit((bg & 3) != last_g, bg >> 2, bg & 3, qt, PROJ, KCBb, VCBb, rel, ONSA, lds3, lds0);
        last_g = bg & 3;
    }
}
#undef NSA_WAIT_BAR
#undef NSA_SBAR
}
namespace nsa {
constexpr float STICK_THR = 50.f, LN2F = 0.6931471805599453f;
#define NSA_WAIT_BAR(N) asm volatile("s_waitcnt vmcnt(" #N ") lgkmcnt(0)\n\ts_barrier" ::: "memory")
__device__ __forceinline__ void stick_unit(int tid, int b, int h, int qb, const bf16* PROJ, bf16* OSB, lds_ptr lds3, unsigned lds0, const bf16x8 (&tri)[2]) {
    const int lane = tid & 63, r32 = lane & 31, hi = lane >> 5;
    const int wid = __builtin_amdgcn_readfirstlane(tid >> 6);
    const int q0 = qb * 256, t = q0 + 32 * wid + r32;
    const bf16* Kb = PROJ + (size_t)b * SEQ * PLD + C_KB + h * HD;
    const bf16* Vb = PROJ + (size_t)b * SEQ * PLD + C_VB + h * HD;
    __attribute__((address_space(3))) int* DONE = (__attribute__((address_space(3))) int*)(lds3 + L_MISC);
    bf16x8 qr[4];
#pragma unroll
    for (int d0 = 0; d0 < 4; ++d0) qr[d0] = *(const bf16x8*)(PROJ + (size_t)(b * SEQ + t) * PLD + C_QB + h * HD + d0 * 16 + hi * 8);
    if (tid < 8) DONE[tid] = 0x7fffffff;
    asm volatile("s_waitcnt vmcnt(0) lgkmcnt(0)" ::: "memory");
    __syncthreads();
    const int jhi = 4 * qb + 3, NT = jhi + 1;
    const int jw = (q0 + 32 * wid + 30) >> 6;
    const int vboff = ((lane >> 4) & 1) * 32 + (lane & 3) * 8 + (4 * hi + ((lane & 15) >> 2)) * 64;
    f32x16 o[2] = {};
    float carry = 0.f; bool mydone = false;
#define STK_ISSUE(i, slot) do { const int id_ = jhi - (i); \
        const bf16* ks_ = Kb + (size_t)(64 * id_ + lane) * PLD + 8 * wid; \
        const bf16* vs_ = Vb + (size_t)(64 * id_ + 16 * (wid & 3) + (lane >> 2)) * PLD + 32 * (wid >> 2) + 8 * (lane & 3); \
        glds16(ks_, (unsigned)__builtin_amdgcn_readfirstlane(lds0 + L_RING + (slot) * SLOTB + wid * 1024)); \
        glds16(vs_, (unsigned)__builtin_amdgcn_readfirstlane(lds0 + L_RING + (slot) * SLOTB + 8192 + wid * 1024)); } while (0)
    STK_ISSUE(0, 0);
    if (NT > 1) STK_ISSUE(1, 1);
    int slot = 0;
    for (int i = 0; i < NT; ++i) {
        if (i + 1 < NT) NSA_WAIT_BAR(2); else NSA_WAIT_BAR(0);
        bool alld = true;
#pragma unroll
        for (int w = 0; w < 8; ++w) alld = alld && (DONE[w] < i);
        if (__builtin_amdgcn_readfirstlane((int)alld)) break;
        if (i + 2 < NT) { const int s2 = (slot == 0) ? 2 : slot - 1; STK_ISSUE(i + 2, s2); }
        const int j = jhi - i;
        if (!mydone && j <= jw) {
            f32x16 p0, p1, x0, x1;
            qkt(p0, p1, (lds_cptr)(lds3 + L_RING + slot * SLOTB), qr, r32, hi);
            float s0 = 0.f, s1 = 0.f;
#pragma unroll
            for (int r = 0; r < 16; ++r) {
                const int pos0 = 64 * j + crow(r, hi);
                const float z0 = p0[r] * 0.125f, z1 = p1[r] * 0.125f;
                const float L0 = __builtin_amdgcn_logf(1.f + __builtin_amdgcn_exp2f(-fabsf(z0) * LOG2E)) * LN2F;
                const float L1 = __builtin_amdgcn_logf(1.f + __builtin_amdgcn_exp2f(-fabsf(z1) * LOG2E)) * LN2F;
                p0[r] = fminf(z0, 0.f) - L0; p1[r] = fminf(z1, 0.f) - L1;
                x0[r] = (pos0 < t) ? (-fmaxf(z0, 0.f) - L0) : 0.f; x1[r] = (pos0 + 32 < t) ? (-fmaxf(z1, 0.f) - L1) : 0.f;
                s0 += x0[r]; s1 += x1[r];
            }
            const float tot0 = swap_add(s0), tot1 = swap_add(s1);
            u32x4 h0a, h0b, l0a, l0b, h1a, h1b, l1a, l1b;
#define STK_SPLIT(X, HA, HB, LA, LB) do { unsigned hw_[8]; float lo_[16]; \
                _Pragma("unroll") for (int q_ = 0; q_ < 8; ++q_) { hw_[q_] = cvtpk_s(X[2 * q_], X[2 * q_ + 1]); \
                    lo_[2 * q_] = X[2 * q_] - __uint_as_float(hw_[q_] << 16); lo_[2 * q_ + 1] = X[2 * q_ + 1] - __uint_as_float(hw_[q_] & 0xffff0000u); } \
                HA = (u32x4){hw_[0], hw_[1], hw_[2], hw_[3]}; HB = (u32x4){hw_[4], hw_[5], hw_[6], hw_[7]}; \
                LA = (u32x4){cvtpk_s(lo_[0], lo_[1]), cvtpk_s(lo_[2], lo_[3]), cvtpk_s(lo_[4], lo_[5]), cvtpk_s(lo_[6], lo_[7])}; \
                LB = (u32x4){cvtpk_s(lo_[8], lo_[9]), cvtpk_s(lo_[10], lo_[11]), cvtpk_s(lo_[12], lo_[13]), cvtpk_s(lo_[14], lo_[15])}; } while (0)
            STK_SPLIT(x0, h0a, h0b, l0a, l0b);
            STK_SPLIT(x1, h1a, h1b, l1a, l1b);
#undef STK_SPLIT
            f32x16 y0, y1;
#pragma unroll
            for (int r = 0; r < 16; ++r) { y0[r] = carry + tot1; y1[r] = carry; }
            y0 = __builtin_amdgcn_mfma_f32_32x32x16_bf16(tri[0], __builtin_bit_cast(bf16x8, h0a), y0, 0, 0, 0);
            y0 = __builtin_amdgcn_mfma_f32_32x32x16_bf16(tri[1], __builtin_bit_cast(bf16x8, h0b), y0, 0, 0, 0);
            y0 = __builtin_amdgcn_mfma_f32_32x32x16_bf16(tri[0], __builtin_bit_cast(bf16x8, l0a), y0, 0, 0, 0);
            y0 = __builtin_amdgcn_mfma_f32_32x32x16_bf16(tri[1], __builtin_bit_cast(bf16x8, l0b), y0, 0, 0, 0);
            y1 = __builtin_amdgcn_mfma_f32_32x32x16_bf16(tri[0], __builtin_bit_cast(bf16x8, h1a), y1, 0, 0, 0);
            y1 = __builtin_amdgcn_mfma_f32_32x32x16_bf16(tri[1], __builtin_bit_cast(bf16x8, h1b), y1, 0, 0, 0);
            y1 = __builtin_amdgcn_mfma_f32_32x32x16_bf16(tri[0], __builtin_bit_cast(bf16x8, l1a), y1, 0, 0, 0);
            y1 = __builtin_amdgcn_mfma_f32_32x32x16_bf16(tri[1], __builtin_bit_cast(bf16x8, l1b), y1, 0, 0, 0);
#pragma unroll
            for (int r = 0; r < 16; ++r) {
                const int pos0 = 64 * j + crow(r, hi);
                y0[r] = (pos0 < t) ? __builtin_amdgcn_exp2f((p0[r] + y0[r]) * LOG2E) : 0.f;
                y1[r] = (pos0 + 32 < t) ? __builtin_amdgcn_exp2f((p1[r] + y1[r]) * LOG2E) : 0.f;
            }
            carry += tot0 + tot1;
            u32x4 pw0, pw1, pw2, pw3;
            pw0 = (u32x4){cvtpk_s(y0[0], y0[1]), cvtpk_s(y0[2], y0[3]), cvtpk_s(y0[4], y0[5]), cvtpk_s(y0[6], y0[7])};
            pw1 = (u32x4){cvtpk_s(y0[8], y0[9]), cvtpk_s(y0[10], y0[11]), cvtpk_s(y0[12], y0[13]), cvtpk_s(y0[14], y0[15])};
            pw2 = (u32x4){cvtpk_s(y1[0], y1[1]), cvtpk_s(y1[2], y1[3]), cvtpk_s(y1[4], y1[5]), cvtpk_s(y1[6], y1[7])};
            pw3 = (u32x4){cvtpk_s(y1[8], y1[9]), cvtpk_s(y1[10], y1[11]), cvtpk_s(y1[12], y1[13]), cvtpk_s(y1[14], y1[15])};
            __builtin_amdgcn_sched_barrier(0);
            pv(o, (int)(lds0 + L_RING + slot * SLOTB + 8192) + vboff, __builtin_bit_cast(bf16x8, pw0), __builtin_bit_cast(bf16x8, pw1), __builtin_bit_cast(bf16x8, pw2), __builtin_bit_cast(bf16x8, pw3));
            mydone = __all(carry < -STICK_THR) != 0;
            if (mydone && lane == 0) DONE[wid] = i;
        }
        slot = (slot == 2) ? 0 : slot + 1;
    }
    asm volatile("s_waitcnt vmcnt(0) lgkmcnt(0)\n\ts_barrier" ::: "memory");
#undef STK_ISSUE
    {
        __attribute__((address_space(3))) unsigned short* stg = (__attribute__((address_space(3))) unsigned short*)(lds3 + L_X) + wid * 2048;
#pragma unroll
        for (int r = 0; r < 16; ++r) { const int orow = crow(r, hi);
#pragma unroll
            for (int d0 = 0; d0 < 2; ++d0) stg[orow * 64 + d0 * 32 + r32] = (unsigned short)f2bf(o[d0][r]); }
        asm volatile("s_waitcnt lgkmcnt(0)" ::: "memory");
        bf16* Ow = OSB + (size_t)(b * SEQ + q0 + 32 * wid) * SB_W + h * HD;
#pragma unroll
        for (int i = 0; i < 4; ++i) { const int row = i * 8 + (lane >> 3), ch = lane & 7;
            const u32x4 vv = *(const __attribute__((address_space(3))) u32x4*)(stg + row * 64 + ch * 8);
            *(u32x4*)(Ow + (size_t)row * SB_W + ch * 8) = vv; }
    }
    asm volatile("s_waitcnt vmcnt(0) lgkmcnt(0)" ::: "memory");
    __syncthreads();
}
__device__ __forceinline__ void stick_phase(const bf16* PROJ, bf16* OSB, lds_ptr lds3, int vcu, int G) {
    const unsigned lds0 = (unsigned)(uintptr_t)lds3;
    int tid = threadIdx.x; asm volatile("" : "+v"(tid));
    const int lane = tid & 63, r32 = lane & 31, hi = lane >> 5;
    bf16x8 tri[2];
#pragma unroll
    for (int s = 0; s < 2; ++s)
#pragma unroll
        for (int j = 0; j < 8; ++j) tri[s][j] = ((16 * s + 8 * (j >> 2) + 4 * hi + (j & 3)) > r32) ? (short)0x3F80 : (short)0;
    for (int i = vcu; i < 512; i += G) {
        const int bh = i >> 4, qb = i & 15;
        stick_unit(tid, bh >> 4, bh & 15, qb, PROJ, OSB, lds3, lds0, tri);
    }
}
#undef NSA_WAIT_BAR
}
namespace peer {
typedef short bf16x8 __attribute__((ext_vector_type(8)));
typedef float f32x16 __attribute__((ext_vector_type(16)));
typedef __bf16 b2_t __attribute__((ext_vector_type(2)));
constexpr int L_EX = 0, L_GT = 16384;
__device__ __forceinline__ int crow(int r, int hi) { return (r & 3) + 8 * (r >> 2) + 4 * hi; }
__device__ __forceinline__ unsigned mono(float f) { const unsigned u = __float_as_uint(f); return (u & 0x80000000u) ? ~u : (u | 0x80000000u); }
__device__ __forceinline__ float unmono(unsigned k) { return __uint_as_float((k & 0x80000000u) ? (k & 0x7fffffffu) : ~k); }
__device__ __forceinline__ float dot2(unsigned a, unsigned b, float c) { return __builtin_amdgcn_fdot2_f32_bf16(__builtin_bit_cast(b2_t, a), __builtin_bit_cast(b2_t, b), c, false); }
#define PEER_CE(key, slot) do { const unsigned hi_ = (key) > (slot) ? (key) : (slot); (key) = (key) > (slot) ? (slot) : (key); (slot) = hi_; } while (0)

__device__ __forceinline__ void route_list(const bf16* QP, const bf16* SKB, int L, int tok0, int r32, int hi, unsigned (&out)[16]) {
    f32x16 acc[4] = {};
    const bf16* qp = QP + (size_t)(tok0 + r32) * 2048 + L * 128 + hi * 8;
    const bf16* kp = SKB + ((size_t)L * 128 + r32) * 128 + hi * 8;
    int hi4 = 4 * hi;
    asm volatile("" : "+v"(qp), "+v"(kp), "+v"(hi4));
#pragma unroll
    for (int ks = 0; ks < 8; ++ks) {
        const bf16x8 bq = *(const bf16x8*)(qp + ks * 16);
#pragma unroll
        for (int kt = 0; kt < 4; ++kt) { const bf16x8 a = *(const bf16x8*)(kp + (size_t)kt * 32 * 128 + ks * 16); acc[kt] = __builtin_amdgcn_mfma_f32_32x32x16_bf16(a, bq, acc[kt], 0, 0, 0); }
    }
    unsigned t[16];
#pragma unroll
    for (int k = 0; k < 16; ++k) t[k] = 0u;
#pragma unroll
    for (int kt = 0; kt < 4; ++kt)
#pragma unroll
        for (int r = 0; r < 16; ++r) {
            unsigned key = ((mono(acc[kt][r]) & ~127u) | (unsigned)(127 - (32 * kt + (r & 3) + 8 * (r >> 2)))) - (unsigned)hi4;
#pragma unroll
            for (int k = 0; k < 16; ++k) PEER_CE(key, t[k]);
            __builtin_amdgcn_sched_barrier(0);
        }
    unsigned u[16];
#pragma unroll
    for (int k = 0; k < 16; ++k) { auto rr = __builtin_amdgcn_permlane32_swap(t[k], t[k], false, false); u[k] = hi ? rr[0] : rr[1]; }
#pragma unroll
    for (int k = 0; k < 16; ++k) out[k] = t[k] > u[15 - k] ? t[k] : u[15 - k];
#pragma unroll
    for (int st = 8; st >= 1; st >>= 1)
#pragma unroll
        for (int k = 0; k < 16; ++k) if ((k & st) == 0) { const unsigned a = out[k], b = out[k | st]; out[k] = a > b ? a : b; out[k | st] = a > b ? b : a; }
}

__device__ __forceinline__ void route_head(const bf16* QP, const bf16* SKB, int h, int tok0, int lane, __attribute__((address_space(3))) unsigned char* lds3) {
    asm volatile("" : "+v"(lane));
    const int r32 = lane & 31, hi = lane >> 5;
    unsigned A[16], B[16];
    route_list(QP, SKB, 2 * h, tok0, r32, hi, A);
    route_list(QP, SKB, 2 * h + 1, tok0, r32, hi, B);
    float va[16], vb[16]; int ia[16], ib[16];
#pragma unroll
    for (int k = 0; k < 16; ++k) { va[k] = unmono((A[k] & ~127u) | 64u); vb[k] = unmono((B[k] & ~127u) | 64u); ia[k] = 127 - (int)(A[k] & 127u); ib[k] = 127 - (int)(B[k] & 127u); }
    unsigned s[16], sp[16];
#pragma unroll
    for (int k = 0; k < 16; ++k) { s[k] = 0u; sp[k] = 0u; }
#pragma unroll
    for (int i = 0; i < 16; ++i)
#pragma unroll
        for (int j = 0; j < 16; ++j) if ((i + 1) * (j + 1) <= 16) {
            unsigned key = mono(va[i] + vb[j]); unsigned pay = (unsigned)(ia[i] * PEER_KEYS + ib[j]);
#pragma unroll
            for (int k = (i + 1) * (j + 1) - 1; k < 16; ++k) { const bool gt = key > s[k]; const unsigned ts = s[k], tp = sp[k]; s[k] = gt ? key : ts; sp[k] = gt ? pay : tp; key = gt ? ts : key; pay = gt ? tp : pay; }
            __builtin_amdgcn_sched_barrier(0);
        }
    const float mx = unmono(s[0]);
    float e[16], sum = 0.f;
#pragma unroll
    for (int k = 0; k < 16; ++k) { e[k] = __expf(unmono(s[k]) - mx); sum += e[k]; }
    const float inv = 1.f / sum;
    if (hi == 0) {
        __attribute__((address_space(3))) int* EX = (__attribute__((address_space(3))) int*)(lds3 + L_EX);
        __attribute__((address_space(3))) float* GT = (__attribute__((address_space(3))) float*)(lds3 + L_GT);
#pragma unroll
        for (int k = 0; k < 16; ++k) { EX[(h * 16 + k) * 32 + r32] = (int)sp[k]; GT[(h * 16 + k) * 32 + r32] = e[k] * inv; }
    }
}

__device__ __forceinline__ void cvt_row_fp8(const float* src, unsigned char* dst, float* inv_scale, int row, int lane) {
    const float* p = src + (size_t)row * 2048 + lane * 16;
    f32x4 v[8]; float am = 0.f;
#pragma unroll
    for (int j = 0; j < 2; ++j)
#pragma unroll
        for (int c = 0; c < 4; ++c) { v[4 * j + c] = *(const f32x4*)(p + j * 1024 + 4 * c);
            am = fmaxf(am, fmaxf(fmaxf(fabsf(v[4 * j + c].x), fabsf(v[4 * j + c].y)), fmaxf(fabsf(v[4 * j + c].z), fabsf(v[4 * j + c].w)))); }
    am = wave_max(am);
    const float sc = am > 0.f ? 384.f / am : 1.f;
#pragma unroll
    for (int j = 0; j < 2; ++j) { v4u o;
#pragma unroll
        for (int c = 0; c < 4; ++c) { int w = 0; w = __builtin_amdgcn_cvt_pk_fp8_f32(v[4 * j + c].x * sc, v[4 * j + c].y * sc, w, false); w = __builtin_amdgcn_cvt_pk_fp8_f32(v[4 * j + c].z * sc, v[4 * j + c].w * sc, w, true); o[c] = (unsigned)w; }
        *(v4u*)(dst + (size_t)row * 2048 + j * 1024 + lane * 16) = o; }
    if (lane == 0) inv_scale[row] = am > 0.f ? am / 384.f : 1.f;
}
typedef float f32x2v __attribute__((ext_vector_type(2)));
__device__ __forceinline__ unsigned cvtpk_bf(float lo, float hi) { typedef __bf16 b2v __attribute__((ext_vector_type(2))); f32x2v v = {lo, hi}; b2v b = __builtin_convertvector(v, b2v); return __builtin_bit_cast(unsigned, b); }
__device__ __forceinline__ float dot32_fp8(const unsigned (&x)[16], v4u q0, v4u q1) {
    float d = 0.f;
#pragma unroll
    for (int c = 0; c < 4; ++c) { const int w0 = (int)q0[c], w1 = (int)q1[c];
        const f32x2v a = __builtin_amdgcn_cvt_pk_f32_fp8(w0, false), b = __builtin_amdgcn_cvt_pk_f32_fp8(w0, true), e = __builtin_amdgcn_cvt_pk_f32_fp8(w1, false), f = __builtin_amdgcn_cvt_pk_f32_fp8(w1, true);
        d = dot2(x[2 * c + 0], cvtpk_bf(a.x, a.y), d); d = dot2(x[2 * c + 1], cvtpk_bf(b.x, b.y), d);
        d = dot2(x[8 + 2 * c + 0], cvtpk_bf(e.x, e.y), d); d = dot2(x[8 + 2 * c + 1], cvtpk_bf(f.x, f.y), d); }
    return d;
}
__device__ __forceinline__ void axpy32_fp8(float (&acc)[32], float w, v4u q0, v4u q1) {
#pragma unroll
    for (int c = 0; c < 4; ++c) { const int w0 = (int)q0[c], w1 = (int)q1[c];
        const f32x2v a = __builtin_amdgcn_cvt_pk_f32_fp8(w0, false), b = __builtin_amdgcn_cvt_pk_f32_fp8(w0, true), e = __builtin_amdgcn_cvt_pk_f32_fp8(w1, false), f = __builtin_amdgcn_cvt_pk_f32_fp8(w1, true);
        acc[4 * c + 0] += w * a.x; acc[4 * c + 1] += w * a.y; acc[4 * c + 2] += w * b.x; acc[4 * c + 3] += w * b.y;
        acc[16 + 4 * c + 0] += w * e.x; acc[16 + 4 * c + 1] += w * e.y; acc[16 + 4 * c + 2] += w * f.x; acc[16 + 4 * c + 3] += w * f.y; }
}
#if defined(PROBE_NOSORT)
constexpr int PEER_SORT_N = 1;
#else
constexpr int PEER_SORT_N = 512;
#endif
constexpr int L_SK = 32768, L_W = 49152;

__device__ __forceinline__ void ffn_wave(int tok0, int wid, int lane, const float* H, const float* SS, const float* gffn, const unsigned char* U8, const unsigned char* V8,
                                         const float* IU, const float* IV, const float* gfin, float* out, __attribute__((address_space(3))) unsigned char* lds3, unsigned rot) {
    asm volatile("" : "+v"(lane));
    const __attribute__((address_space(3))) int* EX = (const __attribute__((address_space(3))) int*)(lds3 + L_EX);
    const __attribute__((address_space(3))) float* GT = (const __attribute__((address_space(3))) float*)(lds3 + L_GT);
    __attribute__((address_space(3))) unsigned* SK = (__attribute__((address_space(3))) unsigned*)(lds3 + L_SK) + wid * 512;
    __attribute__((address_space(3))) float* WW = (__attribute__((address_space(3))) float*)(lds3 + L_W) + wid * 512;
#pragma unroll
    for (int i = 0; i < 8; ++i) { const int p = lane + 64 * i; const unsigned e = (unsigned)EX[(p & 127) * 32 + 4 * wid + (p >> 7)]; SK[p] = (((e - rot) & 16383u) << 9) | (unsigned)p; }
    asm volatile("s_waitcnt lgkmcnt(0)" ::: "memory");
#pragma unroll 1
    for (int k = 2; k <= PEER_SORT_N; k <<= 1)
#pragma unroll 1
        for (int j = k >> 1; j > 0; j >>= 1) {
#pragma unroll
            for (int t = 0; t < 4; ++t) { const int mth = lane + 64 * t; const int i = ((mth & ~(j - 1)) << 1) | (mth & (j - 1)); const int pr = i | j;
                const unsigned a = SK[i], b = SK[pr]; const bool asc = (i & k) == 0; const bool sw = (a > b) == asc;
                SK[i] = sw ? b : a; SK[pr] = sw ? a : b; }
            asm volatile("s_waitcnt lgkmcnt(0)" ::: "memory");
        }
    unsigned x0[16], x1[16], x2[16], x3[16];
#define PEER_LOADX(XR, TK) do { const int n_ = tok0 + 4 * wid + (TK); const float rs_ = rsqrtf(SS[n_] * (1.f / D_MODEL) + EPS); \
        _Pragma("unroll") for (int j = 0; j < 2; ++j) _Pragma("unroll") for (int c = 0; c < 4; ++c) { \
            const f32x4 hv_ = *(const f32x4*)(H + (size_t)n_ * 2048 + j * 1024 + lane * 16 + 4 * c), gv_ = *(const f32x4*)(gffn + j * 1024 + lane * 16 + 4 * c); \
            XR[8 * j + 2 * c + 0] = pk2(hv_.x * rs_ * gv_.x, hv_.y * rs_ * gv_.y); XR[8 * j + 2 * c + 1] = pk2(hv_.z * rs_ * gv_.z, hv_.w * rs_ * gv_.w); } } while (0)
    PEER_LOADX(x0, 0); __builtin_amdgcn_sched_barrier(0); PEER_LOADX(x1, 1); __builtin_amdgcn_sched_barrier(0); PEER_LOADX(x2, 2); __builtin_amdgcn_sched_barrier(0); PEER_LOADX(x3, 3); __builtin_amdgcn_sched_barrier(0);
#undef PEER_LOADX
    const bool b5 = (lane & 32) != 0, b4 = (lane & 16) != 0;
#pragma unroll 1
    for (int i0 = 0; i0 < 512; i0 += 4) {
        int e[4], p[4]; v4u q0[4], q1[4];
#pragma unroll
        for (int k = 0; k < 4; ++k) { const unsigned key = (unsigned)__builtin_amdgcn_readfirstlane((int)SK[i0 + k]); e[k] = (int)(((key >> 9) + rot) & 16383u); p[k] = (int)(key & 511u);
            const unsigned char* ur = U8 + (size_t)e[k] * 2048 + lane * 16; q0[k] = *(const v4u*)ur; q1[k] = *(const v4u*)(ur + 1024); }
        float d[4];
#pragma unroll
        for (int k = 0; k < 4; ++k) { const int tk = p[k] >> 7; d[k] = 0.f;
            if (tk == 0) d[k] = dot32_fp8(x0, q0[k], q1[k]);
            if (tk == 1) d[k] = dot32_fp8(x1, q0[k], q1[k]);
            if (tk == 2) d[k] = dot32_fp8(x2, q0[k], q1[k]);
            if (tk == 3) d[k] = dot32_fp8(x3, q0[k], q1[k]); }
        float a01 = (b5 ? d[1] : d[0]) + __shfl_xor(b5 ? d[0] : d[1], 32);
        float a23 = (b5 ? d[3] : d[2]) + __shfl_xor(b5 ? d[2] : d[3], 32);
        float t = (b4 ? a23 : a01) + __shfl_xor(b4 ? a01 : a23, 16);
        t += __shfl_xor(t, 8); t += __shfl_xor(t, 4); t += __shfl_xor(t, 2); t += __shfl_xor(t, 1);
        float iu[4], iv[4], gt[4];
#pragma unroll
        for (int k = 0; k < 4; ++k) { iu[k] = IU[e[k]]; iv[k] = IV[e[k]]; gt[k] = GT[(p[k] & 127) * 32 + 4 * wid + (p[k] >> 7)]; }
        const float ius = b5 ? (b4 ? iu[3] : iu[1]) : (b4 ? iu[2] : iu[0]);
        const float ivs = b5 ? (b4 ? iv[3] : iv[1]) : (b4 ? iv[2] : iv[0]);
        const float gts = b5 ? (b4 ? gt[3] : gt[1]) : (b4 ? gt[2] : gt[0]);
        const int ksel = b5 ? (b4 ? 3 : 1) : (b4 ? 2 : 0);
        const float wv = gts * gelu_tanh(t * ius) * ivs;
        if ((lane & 15) == 0) WW[i0 + ksel] = wv;
    }
    asm volatile("s_waitcnt lgkmcnt(0)" ::: "memory");
    float a0[32], a1[32], a2[32], a3[32];
#pragma unroll
    for (int j = 0; j < 32; ++j) { a0[j] = 0.f; a1[j] = 0.f; a2[j] = 0.f; a3[j] = 0.f; }
#pragma unroll 1
    for (int i0 = 0; i0 < 512; i0 += 2) {
        int p[2]; float w[2]; v4u q0[2], q1[2];
#pragma unroll
        for (int k = 0; k < 2; ++k) { const unsigned key = (unsigned)__builtin_amdgcn_readfirstlane((int)SK[i0 + k]); const int e = (int)(((key >> 9) + rot) & 16383u); p[k] = (int)(key & 511u);
            w[k] = __uint_as_float(__builtin_amdgcn_readfirstlane(__float_as_uint(WW[i0 + k])));
            const unsigned char* vr = V8 + (size_t)e * 2048 + lane * 16; q0[k] = *(const v4u*)vr; q1[k] = *(const v4u*)(vr + 1024); }
#pragma unroll
        for (int k = 0; k < 2; ++k) { const int tk = p[k] >> 7;
            const float w0 = tk == 0 ? w[k] : 0.f, w1 = tk == 1 ? w[k] : 0.f, w2 = tk == 2 ? w[k] : 0.f, w3 = tk == 3 ? w[k] : 0.f;
#pragma unroll
            for (int c = 0; c < 4; ++c) { const int u0 = (int)q0[k][c], u1 = (int)q1[k][c];
                const f32x2v a = __builtin_amdgcn_cvt_pk_f32_fp8(u0, false), b = __builtin_amdgcn_cvt_pk_f32_fp8(u0, true), e = __builtin_amdgcn_cvt_pk_f32_fp8(u1, false), f = __builtin_amdgcn_cvt_pk_f32_fp8(u1, true);
#define PEER_AX(AR, WT) AR[4 * c + 0] += WT * a.x; AR[4 * c + 1] += WT * a.y; AR[4 * c + 2] += WT * b.x; AR[4 * c + 3] += WT * b.y; AR[16 + 4 * c + 0] += WT * e.x; AR[16 + 4 * c + 1] += WT * e.y; AR[16 + 4 * c + 2] += WT * f.x; AR[16 + 4 * c + 3] += WT * f.y;
                PEER_AX(a0, w0) PEER_AX(a1, w1) PEER_AX(a2, w2) PEER_AX(a3, w3)
#undef PEER_AX
            } }
    }
#define PEER_FIN(AR, TK) do { const int n_ = tok0 + 4 * wid + (TK); float sq_ = 0.f; \
        _Pragma("unroll") for (int j = 0; j < 2; ++j) _Pragma("unroll") for (int c = 0; c < 4; ++c) { const f32x4 hv_ = *(const f32x4*)(H + (size_t)n_ * 2048 + j * 1024 + lane * 16 + 4 * c); \
            AR[16 * j + 4 * c + 0] += hv_.x; AR[16 * j + 4 * c + 1] += hv_.y; AR[16 * j + 4 * c + 2] += hv_.z; AR[16 * j + 4 * c + 3] += hv_.w; } \
        _Pragma("unroll") for (int j = 0; j < 32; ++j) sq_ += AR[j] * AR[j]; \
        const float r_ = rsqrtf(wave_sum(sq_) * (1.f / D_MODEL) + EPS); \
        _Pragma("unroll") for (int j = 0; j < 2; ++j) _Pragma("unroll") for (int c = 0; c < 4; ++c) { const f32x4 gv_ = *(const f32x4*)(gfin + j * 1024 + lane * 16 + 4 * c); \
            *(f32x4*)(out + (size_t)n_ * 2048 + j * 1024 + lane * 16 + 4 * c) = (f32x4){AR[16 * j + 4 * c + 0] * r_ * gv_.x, AR[16 * j + 4 * c + 1] * r_ * gv_.y, AR[16 * j + 4 * c + 2] * r_ * gv_.z, AR[16 * j + 4 * c + 3] * r_ * gv_.w}; } } while (0)
    asm volatile("" : "+v"(lane));
    PEER_FIN(a0, 0); __builtin_amdgcn_sched_barrier(0); PEER_FIN(a1, 1); __builtin_amdgcn_sched_barrier(0); PEER_FIN(a2, 2); __builtin_amdgcn_sched_barrier(0); PEER_FIN(a3, 3);
#undef PEER_FIN
}

__device__ __forceinline__ void peer_phase(const bf16* QP, const bf16* SKB, const float* H, const float* SS, const float* gffn, const unsigned char* U8, const unsigned char* V8, const float* IU, const float* IV,
                                           const float* gfin, float* out, __attribute__((address_space(3))) unsigned char* lds3, int bid, int G) {
    int tid = threadIdx.x; asm volatile("" : "+v"(tid));
    const int lane = tid & 63, wid = __builtin_amdgcn_readfirstlane(tid >> 6);
    const unsigned rot = (xb_xcc_id() & 7u) * 2048u;
    for (int unit = bid; unit < NTOK / 32; unit += G) {
        const int tok0 = unit * 32;
        route_head(QP, SKB, wid, tok0, lane, lds3);
        asm volatile("s_waitcnt lgkmcnt(0)" ::: "memory"); __syncthreads();
        ffn_wave(tok0, wid, lane, H, SS, gffn, U8, V8, IU, IV, gfin, out, lds3, rot);
        __syncthreads();
    }
}
#undef PEER_CE
}
constexpr int RING_BYTES = 131072, LDSCTL_OFF = RING_BYTES, MISC_OFF = LDSCTL_OFF + 320, LDS_BYTES = 147456;
constexpr int N_PHASES = 8;
#ifndef MK_N_LAUNCHES
#define MK_N_LAUNCHES 1
#endif

__global__ void __launch_bounds__(NTHR, 2) fwd_megakernel(Args args) {
    extern __shared__ __attribute__((aligned(16))) unsigned char lds[];
    LAS unsigned char* lds3 = (LAS unsigned char*)lds;
    int tid_ = threadIdx.x; asm volatile("" : "+v"(tid_));
    const int tid = tid_, lane = tid & 63, wave = __builtin_amdgcn_readfirstlane(tid >> 6);
    const int G = gridDim.x, bid = blockIdx.x;
    unsigned char* ws = args.ws;
    unsigned* ctl = (unsigned*)(ws + WS_CTL);
    const float* x = args.in[0];
    bf16* WinT = (bf16*)(ws + WS_WIN); bf16* WbnT = (bf16*)(ws + WS_WBN); bf16* WbsT = (bf16*)(ws + WS_WBS); bf16* WoutT = (bf16*)(ws + WS_WOUT); bf16* WpqT = (bf16*)(ws + WS_WPQ);
    bf16* XN = (bf16*)(ws + WS_XN); bf16* MERGED = XN; bf16* PROJ = (bf16*)(ws + WS_PROJ);
    bf16* ONSA = (bf16*)(ws + WS_ONSA); bf16* OSB = (bf16*)(ws + WS_OSB);
    float* H = (float*)(ws + WS_H); bf16* HB = (bf16*)(ws + WS_HB);
    unsigned char* U8 = ws + WS_UB; unsigned char* V8 = ws + WS_VB; float* IU = (float*)(ws + WS_UB + 48 * MiB); float* IV = (float*)(ws + WS_VB + 48 * MiB); bf16* QP = (bf16*)(ws + WS_QP);
    int* EXPERT = (int*)(ws + WS_EXP); float* GATE = (float*)(ws + WS_GATE);
    bf16* KCB = (bf16*)(ws + WS_MISC + MISC_KCB); bf16* VCB = (bf16*)(ws + WS_MISC + MISC_VCB);
    float* SS = (float*)(ctl + CW_SS);
    bf16* W1T = (bf16*)(ws + WS_MISC + MISC_W1T); float* BIAS1 = (float*)(ws + WS_MISC + MISC_B1);
    bf16* SKB = (bf16*)(ws + WS_MISC + MISC_SKB);

    for (int u = tid; u < (LDS_BYTES - LDSCTL_OFF) / 4; u += NTHR) ((LAS unsigned*)(lds3 + LDSCTL_OFF))[u] = 0u;
    __syncthreads();
    const int lo = args.ph_lo, hi = args.ph_hi;
    XcdBarrier bar; bar.bar = ctl + CW_BAR; bar.x = 0; bar.st = nullptr;
    if (hi - lo > 1) bar = xcd_barrier_post(ctl + CW_BAR, (volatile LAS unsigned*)(lds3 + MISC_OFF) + 8);
#define IN(k) (lo <= (k) && (k) < hi)
#ifndef REP_BAR
#define REP_BAR 1
#endif
#define SEAM(k) do { if (IN(k) && IN((k) + 1)) for (int rb_ = 0; rb_ < REP_BAR; ++rb_) xcd_barrier(bar); } while (0)
    const int gw = bid * NWAVES + wave, NGW = G * NWAVES;
    const int vcu = (G % 8 == 0) ? (bid % 8) * (G / 8) + bid / 8 : bid;

#ifndef REP_P0
#define REP_P0 1
#endif
#ifndef REP_P1
#define REP_P1 1
#endif
#ifndef REP_P4
#define REP_P4 1
#endif
#ifndef REP_P6
#define REP_P6 1
#endif
#ifndef REP_P5C
#define REP_P5C 1
#endif
    if (IN(0)) for (int rep_ = 0; rep_ < REP_P0; ++rep_) {
        LAS float* scr = (LAS float*)(lds3 + wave * 16384);
        constexpr int I_IN = (D_MODEL / 64) * ((IN_COLS + 31) / 32), I_BR = (1024 / 64) * (D_MODEL / 32), I_SQ = (D_MODEL / 64) * (D_MODEL / 32);
        constexpr int I_C1 = (2048 / 64) * (CMP_HID / 32);
        constexpr int NITEMS = I_IN + 2 * I_BR + 2 * I_SQ + 2 * I_C1;
        for (int it = gw; it < NITEMS; it += NGW) {
            int r = it;
            if (r < I_IN) { p0_transpose_item(args.in[2], D_MODEL, IN_COLS, WinT, nullptr, scr, r, lane); continue; } r -= I_IN;
            if (r < I_BR) { p0_transpose_item(args.in[10], 1024, D_MODEL, WbnT, nullptr, scr, r, lane); continue; } r -= I_BR;
            if (r < I_BR) { p0_transpose_item(args.in[11], 1024, D_MODEL, WbsT, nullptr, scr, r, lane); continue; } r -= I_BR;
            if (r < I_SQ) { p0_transpose_item(args.in[12], D_MODEL, D_MODEL, WoutT, nullptr, scr, r, lane); continue; } r -= I_SQ;
            if (r < I_SQ) { p0_transpose_item(args.in[14], D_MODEL, D_MODEL, WpqT, args.in[13], scr, r, lane); continue; } r -= I_SQ;
            if (r < I_C1) { p0_transpose_item(args.in[4], 2048, CMP_HID, W1T, nullptr, scr, r, lane); continue; } r -= I_C1;
            p0_transpose_item(args.in[7], 2048, CMP_HID, W1T + (size_t)CMP_HID * 2048, nullptr, scr, r, lane);
        }
        {
            v4u z = {0u, 0u, 0u, 0u}; bf16* p = WinT + (size_t)IN_COLS * D_MODEL; const size_t nz = (size_t)(PLD - IN_COLS) * D_MODEL;
            for (size_t i = ((size_t)bid * NTHR + tid) * 8; i < nz; i += (size_t)G * NTHR * 8) *(v4u*)(p + i) = z;
        }
        if (gw < 2 * CMP_HID) {
            const int kv = gw >> 7, j = gw & 127; const float* pe = args.in[kv ? 6 : 3]; const float* w1 = args.in[kv ? 7 : 4];
            float s = 0.f;
            for (int k2 = lane; k2 < 2048; k2 += 64) s += pe[k2] * w1[(size_t)k2 * CMP_HID + j];
            s = wave_sum(s);
            if (lane == 0) BIAS1[gw] = s;
        }
        cvt_flat(args.in[15], SKB, (size_t)16 * 128 * 128, (size_t)bid * NTHR + tid, (size_t)G * NTHR);
        for (int m = gw; m < NTOK; m += NGW) rms_row_to_bf16(x + (size_t)m * D_MODEL, args.in[1], XN + (size_t)m * D_MODEL, lane);
    }
    SEAM(0);
    if (IN(1)) for (int rep_ = 0; rep_ < REP_P1; ++rep_) {
        pg8::Gemm g{XN, WinT, NTOK, PLD, D_MODEL}; pg8::StaticOrder S; S.init(NTOK, PLD, G, bid);
        pg8::EpiBf16<0> E{PROJ, PLD, nullptr, 0, 0, 1.f};
        pg8::gemm_phase<pg8::EpiBf16<0>, pg8::StaticOrder, true, true>(lds3, g, S, E);
    }
    SEAM(1);
    if (IN(2)) cmpr::compress_phase(PROJ, W1T, BIAS1, args.in, KCB, VCB, lds3, bid, G);
    SEAM(2);
    if (IN(3)) {
        nsa::nsa_phase(PROJ, KCB, VCB, args.in[9], ONSA, lds3, vcu, G);
#if defined(PROBE_P3A)
        nsa::nsa_phase(PROJ, KCB, VCB, args.in[9], ONSA, lds3, vcu, G);
#endif
        nsa::stick_phase(PROJ, OSB, lds3, vcu, G);
#if defined(PROBE_P3B)
        nsa::stick_phase(PROJ, OSB, lds3, vcu, G);
#endif
    }
    SEAM(3);
    if (IN(4)) for (int rep_ = 0; rep_ < REP_P4; ++rep_) {
        static_assert(WS_OSB == WS_ONSA + (size_t)NTOK * NSA_Q * 2 && WS_WBS == WS_WBN + (size_t)D_MODEL * 1024 * 2, "branch operands must be contiguous");
        pg8::Gemm g{ONSA, WbnT, 2 * NTOK, 2 * D_MODEL, 1024}; pg8::BranchOrder S; S.init(NTOK, D_MODEL, G, bid);
        pg8::EpiGate2 E{MERGED, D_MODEL, PROJ + C_GA, PROJ + C_GB, PLD, NTOK / 256, D_MODEL / 256};
        pg8::gemm_phase<pg8::EpiGate2, pg8::BranchOrder, true, true>(lds3, g, S, E);
    }
    SEAM(4);
    if (IN(5)) {
        { pg8::Gemm g{MERGED, WoutT, NTOK, D_MODEL, D_MODEL}; pg8::StaticOrder S; S.init(NTOK, D_MODEL, G, bid);
          pg8::EpiResid E{x, H, HB, SS, D_MODEL};
          pg8::gemm_phase<pg8::EpiResid, pg8::StaticOrder, false, true>(lds3, g, S, E); }
        int t5 = threadIdx.x; asm volatile("" : "+v"(t5));
        const int lane5 = t5 & 63, gw5 = bid * NWAVES + __builtin_amdgcn_readfirstlane(t5 >> 6);
        for (int rep_ = 0; rep_ < REP_P5C; ++rep_) for (int r = gw5; r < 2 * 16384; r += NGW) { if (r < 16384) peer::cvt_row_fp8(args.in[16], U8, IU, r, lane5); else peer::cvt_row_fp8(args.in[17], V8, IV, r - 16384, lane5); }
    }
    SEAM(5);
    if (IN(6)) for (int rep_ = 0; rep_ < REP_P6; ++rep_) {
        pg8::Gemm g{HB, WpqT, NTOK, D_MODEL, D_MODEL}; pg8::StaticOrder S; S.init(NTOK, D_MODEL, G, bid);
        pg8::EpiRowScale E{QP, D_MODEL, SS, 1.f / D_MODEL, EPS};
        pg8::gemm_phase<pg8::EpiRowScale, pg8::StaticOrder, false, true>(lds3, g, S, E);
    }
    SEAM(6);
    if (IN(7)) {
        peer::peer_phase(QP, SKB, H, SS, args.in[13], U8, V8, IU, IV, args.in[18], args.out, lds3, bid, G);
#if defined(PROBE_P7)
        peer::peer_phase(QP, SKB, H, SS, args.in[13], U8, V8, IU, IV, args.in[18], args.out, lds3, bid, G);
#endif
    }
#undef IN
#undef SEAM
}

extern "C" void kernel_launch(void* const* d_in, const int* in_sizes, int n_in, void* d_out, int out_size, void* d_ws, size_t ws_size, hipStream_t stream) {
    static int grid = 0;
    if (grid == 0) {
        if (n_in != 19 || ws_size < WS_END) { fprintf(stderr, "kernel_launch: unexpected inputs (%d) or workspace (%zu < %zu)\n", n_in, ws_size, (size_t)WS_END); grid = -1; return; }
        int dev = 0, cus = 0, per_cu = 0;
        hipGetDevice(&dev); hipDeviceGetAttribute(&cus, hipDeviceAttributeMultiprocessorCount, dev);
        if (hipFuncSetAttribute((const void*)fwd_megakernel, hipFuncAttributeMaxDynamicSharedMemorySize, LDS_BYTES) != hipSuccess) { fprintf(stderr, "hipFuncSetAttribute failed\n"); grid = -1; return; }
        if (hipOccupancyMaxActiveBlocksPerMultiprocessor(&per_cu, (const void*)fwd_megakernel, NTHR, LDS_BYTES) != hipSuccess || per_cu < 1) { fprintf(stderr, "occupancy query: %d\n", per_cu); per_cu = 1; }
        (void)hipGetLastError();
        grid = cus;
        if (grid > cus * per_cu) grid = cus * per_cu;
    }
    if (grid < 0) return;
    hipMemsetAsync((char*)d_ws + WS_CTL, 0, CTL_ZERO_BYTES, stream);
    Args a{};
    for (int i = 0; i < 19; ++i) a.in[i] = (const float*)d_in[i];
    a.out = (float*)d_out; a.ws = (unsigned char*)d_ws;
    if (MK_N_LAUNCHES == 1) {
        a.ph_lo = 0; a.ph_hi = N_PHASES;
        void* kargs[] = {&a};
#if defined(USE_COOP_LAUNCH)
        hipError_t e = hipLaunchCooperativeKernel((const void*)fwd_megakernel, dim3(grid), dim3(NTHR), kargs, LDS_BYTES, stream);
        if (e != hipSuccess) fprintf(stderr, "cooperative launch failed: %s (grid %d)\n", hipGetErrorString(e), grid);
#else
        (void)kargs;
        hipLaunchKernelGGL(fwd_megakernel, dim3(grid), dim3(NTHR), LDS_BYTES, stream, a);
#endif
    } else {
        for (int p = 0; p < N_PHASES; ++p) { a.ph_lo = p; a.ph_hi = p + 1; hipLaunchKernelGGL(fwd_megakernel, dim3(grid), dim3(NTHR), LDS_BYTES, stream, a); }
    }
}
```

```cpp
#include <hip/hip_runtime.h>
#include <cstdio>
#include <cstdint>
#include <cmath>
namespace pg8 {
#define PG8_LAS __attribute__((address_space(3)))
typedef unsigned short bf16_t;
typedef short bf16x8 __attribute__((ext_vector_type(8)));
typedef float f32x4 __attribute__((ext_vector_type(4)));
typedef unsigned u32x4 __attribute__((ext_vector_type(4)));
constexpr int BM = 256, BK = 64, HALF = 128, HTB = HALF * BK * 2  , STAGE_BYTES = 8 * HTB, NXCD = 8, WGM = 8;

__host__ __device__ __forceinline__ int lds_byte(int r, int c) { const int st = (r >> 4) * 2 + (c >> 5), rr = r & 15, cc = c & 31, ob = rr * 64 + cc * 2; return st * 1024 + (ob ^ (((ob >> 9) & 1) << 5)); }
__host__ __device__ __forceinline__ void stage_rc(int b, int& R, int& C) { const int st = b / 1024, sb = b % 1024, swz = sb ^ (((sb >> 9) & 1) << 5); R = (st >> 1) * 16 + swz / 64; C = (st & 1) * 32 + (swz % 64) / 2; }
__host__ __device__ __forceinline__ int perm32(int rho) { const int n = rho >> 4, i = rho & 15; return 8 * (i >> 2) + 4 * n + (i & 3); }

struct Unit { int pm, pn; };
struct Gemm { const bf16_t* A; const bf16_t* Bt; int M, N, K; };

struct StaticOrder {
    int nM, nN, nwg, G, c;
    __host__ __device__ void init(int M, int N, int G_, int c_) { nM = M / BM; nN = N / BM; nwg = nM * nN; G = G_; c = c_; }
    __host__ __device__ bool next(int i, Unit& u) const {
        const long L = (long)i * G + c; if (L >= nwg) return false;
        int wgid = (int)L; { const int q = nwg / NXCD, r = nwg % NXCD, xcd = wgid % NXCD, off = wgid / NXCD; wgid = (xcd < r ? xcd * (q + 1) : r * (q + 1) + (xcd - r) * q) + off; }
        const int nig = WGM * nN, gid = wgid / nig, fm = gid * WGM, gsz = (nM - fm) < WGM ? (nM - fm) : WGM;
        u.pm = fm + ((wgid % nig) % gsz); u.pn = (wgid % nig) / gsz; return true;
    }
    __device__ __forceinline__ void a_ready(const Unit&) const {}
    __device__ __forceinline__ void done(const Unit&) const {}
};

__device__ __forceinline__ unsigned cvt_pk_bf16(float lo, float hi) { unsigned r; asm volatile("v_cvt_pk_bf16_f32 %0, %1, %2" : "=v"(r) : "v"(lo), "v"(hi)); return r; }
typedef float f32x2 __attribute__((ext_vector_type(2)));
__device__ __forceinline__ f32x2 gelu_pk(f32x2 v) {
    const f32x2 av = __builtin_elementwise_abs(v), d = av * 0.2316418882f + 1.0f;
    f32x2 t; t.x = __builtin_amdgcn_rcpf(d.x); t.y = __builtin_amdgcn_rcpf(d.y);
    f32x2 q = t * 0.5307027145f + (-0.7265760135f); q = q * t + 0.7107068705f; q = q * t + (-0.142248368f); q = q * t + 0.127414796f; q = q * t;
    const f32x2 s = (v * v) * (-0.72134752044f);
    f32x2 e; e.x = __builtin_amdgcn_exp2f(s.x); e.y = __builtin_amdgcn_exp2f(s.y);
    const f32x2 m = v * (q * e), r = v - m;
    f32x2 o; o.x = v.x < 0.f ? m.x : r.x; o.y = v.y < 0.f ? m.y : r.y; return o;
}

template <int ACT  > struct EpiBf16 {
    static constexpr bool PERM = true, AFTER_DRAIN = false; static_assert(ACT == 0 || ACT == 1, "EpiBf16: ACT is 0 (none) or 1 (gelu_pk)");
    bf16_t* O; int ldc; const float* bias; int split_cols; size_t split_stride; float scale0;
    __device__ __forceinline__ void operator()(const f32x4 (&acc)[2][2][4][2], const Unit& u, int wr, int wc, int fr, int fq) const {
        const int row0 = u.pm * BM + wr * 64 + fr; int colt = u.pn * BM; bf16_t* base = O;
        float sc = 1.f; if (split_cols) { const int t = colt / split_cols; base += (size_t)t * split_stride; colt -= t * split_cols; if (t == 0) sc = scale0; }
        const int col0 = colt + wc * 32 + 8 * fq, bcol0 = u.pn * BM + wc * 32 + 8 * fq;
        f32x4 bv[2][2];
#pragma unroll
        for (int bj = 0; bj < 2; ++bj)
#pragma unroll
            for (int n = 0; n < 2; ++n) bv[bj][n] = bias ? *(const f32x4*)(bias + bcol0 + bj * HALF + 4 * n) : (f32x4){0.f, 0.f, 0.f, 0.f};
#pragma unroll
        for (int ai = 0; ai < 2; ++ai)
#pragma unroll
            for (int m = 0; m < 4; ++m) { bf16_t* rowp = base + (size_t)(row0 + ai * HALF + m * 16) * ldc + col0;
#pragma unroll
                for (int bj = 0; bj < 2; ++bj) { f32x4 v0 = acc[ai][bj][m][0] + bv[bj][0], v1 = acc[ai][bj][m][1] + bv[bj][1];
                    if (ACT == 1) { f32x2 a = gelu_pk((f32x2){v0[0], v0[1]}), b = gelu_pk((f32x2){v0[2], v0[3]}), c = gelu_pk((f32x2){v1[0], v1[1]}), d = gelu_pk((f32x2){v1[2], v1[3]});
                        v0 = (f32x4){a.x, a.y, b.x, b.y}; v1 = (f32x4){c.x, c.y, d.x, d.y}; }
                    v0 = v0 * sc; v1 = v1 * sc; u32x4 w; w.x = cvt_pk_bf16(v0[0], v0[1]); w.y = cvt_pk_bf16(v0[2], v0[3]); w.z = cvt_pk_bf16(v1[0], v1[1]); w.w = cvt_pk_bf16(v1[2], v1[3]);
                    *(u32x4*)(rowp + bj * HALF) = w; } }
    }
};

struct PanelStats {
    unsigned* xbuf;
    unsigned* cnt;
    unsigned* tmo;
    int ntn; float eps;
    unsigned code;
    __device__ __forceinline__ bool run(const f32x4 (&v)[2][2][4][2], const Unit& u, int wr, int wc, int fr, int fq, PG8_LAS unsigned char* lds, int wid, int lane) const {
        typedef float f32x2v __attribute__((ext_vector_type(2)));
        PG8_LAS f32x2v* P = (PG8_LAS f32x2v*)lds;
        PG8_LAS f32x2v* S = (PG8_LAS f32x2v*)(lds + 8192);
        PG8_LAS unsigned* flag = (PG8_LAS unsigned*)(lds + 8192 + 2048);
#pragma unroll
        for (int ai = 0; ai < 2; ++ai)
#pragma unroll
            for (int m = 0; m < 4; ++m) {
                float s = 0.f;
#pragma unroll
                for (int bj = 0; bj < 2; ++bj)
#pragma unroll
                    for (int n = 0; n < 2; ++n) { const f32x4 x = v[ai][bj][m][n]; s += (x[0] + x[1]) + (x[2] + x[3]); }
                s += __shfl_xor(s, 16); s += __shfl_xor(s, 32);
                const float mw = s * (1.0f / 64.0f); float q = 0.f;
#pragma unroll
                for (int bj = 0; bj < 2; ++bj)
#pragma unroll
                    for (int n = 0; n < 2; ++n) { const f32x4 d = v[ai][bj][m][n] - mw; q += (d[0] * d[0] + d[1] * d[1]) + (d[2] * d[2] + d[3] * d[3]); }
                q += __shfl_xor(q, 16); q += __shfl_xor(q, 32);
                if (fq == 0) P[(ai * HALF + wr * 64 + m * 16 + fr) * 4 + wc] = (f32x2v){mw, q};
            }
        asm volatile("s_waitcnt lgkmcnt(0)" ::: "memory"); __builtin_amdgcn_s_barrier(); asm volatile("" ::: "memory");
#if defined(BROKEN_EXCHANGE_NO_WAIT)
#warning BROKEN CONTROL BUILD: the row-statistics exchange does not wait; results are wrong by design
        if (blockIdx.x >= 64) { const long long t0_ = clock64(); while (clock64() - t0_ < 60000) __builtin_amdgcn_s_sleep(8); }
#endif
        const int row = wid * 32 + (lane & 31);
        if (lane < 32) {
            const f32x2v a = P[row * 4 + 0], b = P[row * 4 + 1], c = P[row * 4 + 2], d = P[row * 4 + 3];
            const float mt = (a.x + b.x + c.x + d.x) * 0.25f;
            const float da = a.x - mt, db = b.x - mt, dc = c.x - mt, dd = d.x - mt;
            const float m2 = (a.y + b.y) + (c.y + d.y) + 64.0f * ((da * da + db * db) + (dc * dc + dd * dd));
            unsigned long long* slot = (unsigned long long*)xbuf + ((size_t)(u.pm * BM + row) * 4 + u.pn);
            __hip_atomic_store(slot, ((unsigned long long)__float_as_uint(m2) << 32) | __float_as_uint(mt), __ATOMIC_RELAXED, __HIP_MEMORY_SCOPE_AGENT);
        }
        asm volatile("s_waitcnt vmcnt(0)" ::: "memory");
        if (lane == 0) __hip_atomic_fetch_add(cnt + 64 * u.pm, 1u, __ATOMIC_RELAXED, __HIP_MEMORY_SCOPE_AGENT);
        if (wid == 0) {
            bool dead = false; const unsigned long long t0 = __builtin_amdgcn_s_memrealtime(); const unsigned want = 8u * (unsigned)ntn;
            for (;;) {
#if defined(BROKEN_EXCHANGE_NO_WAIT)
                break;
#endif
                if ((unsigned)__builtin_amdgcn_readfirstlane(__hip_atomic_load(cnt + 64 * u.pm, __ATOMIC_RELAXED, __HIP_MEMORY_SCOPE_AGENT)) >= want) break;
                if (__builtin_amdgcn_s_memrealtime() - t0 > 2000000ull) {
                    if (lane == 0) { unsigned expect = 0u; __hip_atomic_compare_exchange_strong(tmo + 1, &expect, code | (unsigned)(u.pm & 0xff), __ATOMIC_RELAXED, __ATOMIC_RELAXED, __HIP_MEMORY_SCOPE_AGENT);
                                     __hip_atomic_store(tmo, 1u, __ATOMIC_RELAXED, __HIP_MEMORY_SCOPE_AGENT); }
                    dead = true; break; }
                __builtin_amdgcn_s_sleep(2);
            }
            __builtin_amdgcn_fence(__ATOMIC_ACQUIRE, "agent");
            if (lane == 0) flag[0] = dead ? 1u : 0u;
        }
        asm volatile("s_waitcnt vmcnt(0) lgkmcnt(0)" ::: "memory"); __builtin_amdgcn_s_barrier(); asm volatile("" ::: "memory");
        const bool bad = flag[0] != 0u;
        if (lane < 32) {
            const unsigned long long* slot = (const unsigned long long*)xbuf + (size_t)(u.pm * BM + row) * 4; float mt[4], m2[4]; float ms = 0.f;
#pragma unroll
            for (int t = 0; t < 4; ++t) { if (t < ntn) { const unsigned long long w = __hip_atomic_load(slot + t, __ATOMIC_RELAXED, __HIP_MEMORY_SCOPE_AGENT); mt[t] = __uint_as_float((unsigned)w); m2[t] = __uint_as_float((unsigned)(w >> 32)); } else { mt[t] = 0.f; m2[t] = 0.f; } ms += mt[t]; }
            const float mean = ms / (float)ntn; float q = 0.f;
#pragma unroll
            for (int t = 0; t < 4; ++t) if (t < ntn) { const float dm = mt[t] - mean; q += m2[t] + 256.0f * dm * dm; }
            S[row] = (f32x2v){mean, 1.0f / sqrtf(q / (256.0f * (float)ntn) + eps)};
        }
        asm volatile("s_waitcnt lgkmcnt(0)" ::: "memory"); __builtin_amdgcn_s_barrier(); asm volatile("" ::: "memory");
        return bad;
    }
};
struct EpiLnRes {
    static constexpr bool PERM = false, AFTER_DRAIN = true;
    const float* base; float* out; int ldc; const float* bias; PanelStats st; unsigned poison;
    __device__ __forceinline__ void fused(f32x4 (&acc)[2][2][4][2], const Unit& u, int wr, int wc, int fr, int fq, PG8_LAS unsigned char* lds, int wid, int lane) const {
        typedef float f32x2v __attribute__((ext_vector_type(2)));
        const PG8_LAS f32x2v* S = (const PG8_LAS f32x2v*)(lds + 8192);
        const int col0 = u.pn * BM + wc * 32 + 4 * fq;
#pragma unroll
        for (int bj = 0; bj < 2; ++bj)
#pragma unroll
            for (int n = 0; n < 2; ++n) { const f32x4 bv = bias ? *(const f32x4*)(bias + col0 + bj * HALF + n * 16) : (f32x4){0.f, 0.f, 0.f, 0.f};
#pragma unroll
                for (int ai = 0; ai < 2; ++ai)
#pragma unroll
                    for (int m = 0; m < 4; ++m) acc[ai][bj][m][n] += bv; }
        f32x4 pre[4][2][2];
#pragma unroll
        for (int m = 0; m < 4; ++m) { const size_t off = (size_t)(u.pm * BM + wr * 64 + m * 16 + fr) * ldc + col0;
#pragma unroll
            for (int bj = 0; bj < 2; ++bj)
#pragma unroll
                for (int n = 0; n < 2; ++n) pre[m][bj][n] = *(const f32x4*)(base + off + bj * HALF + n * 16); }
        const bool bad = st.run(acc, u, wr, wc, fr, fq, lds, wid, lane) || poison != 0u;
        const float qnan = __builtin_nanf("");
#pragma unroll
        for (int ai = 0; ai < 2; ++ai)
#pragma unroll
            for (int m = 0; m < 4; ++m) { const int r = ai * HALF + wr * 64 + m * 16 + fr; const f32x2v sr = S[r]; const size_t off = (size_t)(u.pm * BM + r) * ldc + col0;
#pragma unroll
                for (int bj = 0; bj < 2; ++bj)
#pragma unroll
                    for (int n = 0; n < 2; ++n) { const f32x4 bs = ai == 0 ? pre[m][bj][n] : *(const f32x4*)(base + off + bj * HALF + n * 16); f32x4 o = bs + (acc[ai][bj][m][n] - sr.x) * sr.y;
                        if (bad) o = (f32x4){qnan, qnan, qnan, qnan}; *(f32x4*)(out + off + bj * HALF + n * 16) = o; }
                if (m & 1) asm volatile("" ::: "memory"); }
    }
};
struct EpiLnResLn {
    static constexpr bool PERM = false, AFTER_DRAIN = true;
    const float* base; float* out; bf16_t* xn; int ldc; const float* bias; PanelStats st1, st2; unsigned poison;
    __device__ __forceinline__ void fused(f32x4 (&acc)[2][2][4][2], const Unit& u, int wr, int wc, int fr, int fq, PG8_LAS unsigned char* lds, int wid, int lane) const {
        typedef float f32x2v __attribute__((ext_vector_type(2))); typedef unsigned u32x2v __attribute__((ext_vector_type(2)));
        const PG8_LAS f32x2v* S = (const PG8_LAS f32x2v*)(lds + 8192);
        const int col0 = u.pn * BM + wc * 32 + 4 * fq;
#pragma unroll
        for (int bj = 0; bj < 2; ++bj)
#pragma unroll
            for (int n = 0; n < 2; ++n) { const f32x4 bv = bias ? *(const f32x4*)(bias + col0 + bj * HALF + n * 16) : (f32x4){0.f, 0.f, 0.f, 0.f};
#pragma unroll
                for (int ai = 0; ai < 2; ++ai)
#pragma unroll
                    for (int m = 0; m < 4; ++m) acc[ai][bj][m][n] += bv; }
        bool bad = st1.run(acc, u, wr, wc, fr, fq, lds, wid, lane) || poison != 0u;
        const float qnan = __builtin_nanf("");
#pragma unroll
        for (int ai = 0; ai < 2; ++ai)
#pragma unroll
            for (int m = 0; m < 4; ++m) { const int r = ai * HALF + wr * 64 + m * 16 + fr; const f32x2v sr = S[r]; const size_t off = (size_t)(u.pm * BM + r) * ldc + col0;
#pragma unroll
                for (int bj = 0; bj < 2; ++bj)
#pragma unroll
                    for (int n = 0; n < 2; ++n) { const f32x4 bs = *(const f32x4*)(base + off + bj * HALF + n * 16); acc[ai][bj][m][n] = bs + (acc[ai][bj][m][n] - sr.x) * sr.y; }
                asm volatile("" : "+v"(acc[ai][0][m][0]), "+v"(acc[ai][0][m][1]), "+v"(acc[ai][1][m][0]), "+v"(acc[ai][1][m][1]));
                if (m & 1) asm volatile("" ::: "memory"); }
        const bool bad1 = bad;
        bad = st2.run(acc, u, wr, wc, fr, fq, lds, wid, lane) || bad;
#pragma unroll
        for (int ai = 0; ai < 2; ++ai)
#pragma unroll
            for (int m = 0; m < 4; ++m) { const int r = ai * HALF + wr * 64 + m * 16 + fr; const f32x2v sr = S[r]; const size_t off = (size_t)(u.pm * BM + r) * ldc + col0;
#pragma unroll
                for (int bj = 0; bj < 2; ++bj)
#pragma unroll
                    for (int n = 0; n < 2; ++n) { const f32x4 x1 = acc[ai][bj][m][n]; *(f32x4*)(out + off + bj * HALF + n * 16) = bad1 ? (f32x4){qnan, qnan, qnan, qnan} : x1;
                        const f32x4 o = (x1 - sr.x) * sr.y; u32x2v w; w.x = cvt_pk_bf16(o[0], o[1]); w.y = cvt_pk_bf16(o[2], o[3]);
                        if (bad) { w.x = 0x7fc07fc0u; w.y = 0x7fc07fc0u; } *(u32x2v*)(xn + off + bj * HALF + n * 16) = w; }
                asm volatile("" ::: "memory"); }
    }
};

template <class Epi, class Sched, bool ALIGN_EPI = false, bool SP2 = false>
__device__ __forceinline__ void gemm_phase(PG8_LAS unsigned char* lds, const Gemm g, const Sched& S, const Epi& E) {
    const int tid = threadIdx.x, wid = __builtin_amdgcn_readfirstlane(tid >> 6), lane = tid & 63, wr = wid >> 2, wc = wid & 3, fr = lane & 15, fq = lane >> 4;
    const int K = g.K, nt = K / BK;
    unsigned voffA[2], voffB[2];
#pragma unroll
    for (int i = 0; i < 2; ++i) { int R, C; stage_rc(tid * 16 + i * 8192, R, C); const int Rb = Epi::PERM ? ((R & ~31) + perm32(R & 31)) : R;
        voffA[i] = (unsigned)(R * K + C) * 2u; voffB[i] = (unsigned)(Rb * K + C) * 2u; }
    const size_t kstep = (size_t)(BK * 2);
    const size_t hstep = (size_t)HALF * K * 2;
    const size_t tstep = 2 * hstep;
    const unsigned ldsw = (unsigned)wid * 1024u;
    const int aoff = lds_byte(wr * 64 + fr, fq * 8), boff = lds_byte(wc * 32 + fr, fq * 8);
#define PG8_SA(b, h) (((b) * 2 + (h)) * HTB)
#define PG8_SB(b, h) ((4 + (b) * 2 + (h)) * HTB)
#define PG8_STAGE(bufoff, gbase, voff) do { _Pragma("unroll") for (int _i = 0; _i < 2; ++_i) \
        __builtin_amdgcn_global_load_lds((const unsigned*)((const char*)(gbase) + (voff)[_i]), (PG8_LAS unsigned*)(lds + (bufoff) + ldsw + _i * 8192), 16, 0, 0); } while (0)
#define PG8_LDA(dst, b, h) do { _Pragma("unroll") for (int m = 0; m < 4; ++m) _Pragma("unroll") for (int k = 0; k < 2; ++k) dst[m][k] = *(const PG8_LAS bf16x8*)(lds + PG8_SA(b, h) + aoff + m * 2048 + k * 1024); } while (0)
#define PG8_LDB(dst, b, h) do { _Pragma("unroll") for (int n = 0; n < 2; ++n) _Pragma("unroll") for (int k = 0; k < 2; ++k) dst[n][k] = *(const PG8_LAS bf16x8*)(lds + PG8_SB(b, h) + boff + n * 2048 + k * 1024); } while (0)
#define PG8_MMA(ai, bj, At, Bt) do { __builtin_amdgcn_s_setprio(1); _Pragma("unroll") for (int m = 0; m < 4; ++m) _Pragma("unroll") for (int n = 0; n < 2; ++n) _Pragma("unroll") for (int k = 0; k < 2; ++k) \
        acc[ai][bj][m][n] = __builtin_amdgcn_mfma_f32_16x16x32_bf16(Bt[n][k], At[m][k], acc[ai][bj][m][n], 0, 0, 0); __builtin_amdgcn_s_setprio(0); } while (0)
#define PG8_WAIT_V(n) asm volatile("s_waitcnt vmcnt(" #n ")" ::: "memory")
#define PG8_WAIT_L(n) asm volatile("s_waitcnt lgkmcnt(" #n ")" ::: "memory")
#define PG8_BAR __builtin_amdgcn_s_barrier()
#define PG8_SCHED __builtin_amdgcn_sched_barrier(0)
    Unit cur, nxt; int ui = 0;
    if (!S.next(0, cur)) return;
    f32x4 acc[2][2][4][2];
#pragma unroll
    for (int a = 0; a < 2; ++a)
#pragma unroll
        for (int b = 0; b < 2; ++b)
#pragma unroll
            for (int m = 0; m < 4; ++m)
#pragma unroll
                for (int n = 0; n < 2; ++n) acc[a][b][m][n] = (f32x4){0.f, 0.f, 0.f, 0.f};
    bf16x8 At[4][2], B0[2][2], B1[2][2];
    const char* cA = (const char*)g.A + (size_t)cur.pm * tstep; const char* cB = (const char*)g.Bt + (size_t)cur.pn * tstep;
    S.a_ready(cur);
    if constexpr (SP2) {
        PG8_STAGE(PG8_SB(0, 0), cB, voffB); PG8_STAGE(PG8_SB(0, 1), cB + hstep, voffB); PG8_STAGE(PG8_SA(0, 0), cA, voffA); PG8_STAGE(PG8_SA(0, 1), cA + hstep, voffA);
        if (wr == 1) PG8_BAR;
        PG8_WAIT_V(2); PG8_BAR;
        PG8_STAGE(PG8_SB(1, 0), cB + kstep, voffB); PG8_STAGE(PG8_SA(1, 0), cA + kstep, voffA); PG8_STAGE(PG8_SB(1, 1), cB + hstep + kstep, voffB);
        PG8_WAIT_V(6); PG8_BAR;
    } else {
        PG8_STAGE(PG8_SB(0, 0), cB, voffB); PG8_STAGE(PG8_SA(0, 0), cA, voffA); PG8_STAGE(PG8_SB(0, 1), cB + hstep, voffB); PG8_STAGE(PG8_SA(0, 1), cA + hstep, voffA);
        if (wr == 1) PG8_BAR;
        PG8_WAIT_V(4); PG8_BAR;
        PG8_STAGE(PG8_SB(1, 0), cB + kstep, voffB); PG8_STAGE(PG8_SA(1, 0), cA + kstep, voffA); PG8_STAGE(PG8_SB(1, 1), cB + hstep + kstep, voffB);
        PG8_WAIT_V(6); PG8_BAR;
    }
    for (;;) {
        const bool has_next = S.next(ui + 1, nxt);
        const char* nA = has_next ? (const char*)g.A + (size_t)nxt.pm * tstep : cA; const char* nB = has_next ? (const char*)g.Bt + (size_t)nxt.pn * tstep : cB;
        for (int t = 0; t < nt; t += 2) {
            const bool last = (t == nt - 2);
            const char* a1 = cA + (size_t)(t + 1) * kstep;
            const char* a2 = last ? nA : cA + (size_t)(t + 2) * kstep; const char* b2 = last ? nB : cB + (size_t)(t + 2) * kstep;
            const char* a3 = a2 + kstep; const char* b3 = b2 + kstep;
            if (last && has_next) S.a_ready(nxt);
            if constexpr (SP2) {
            PG8_LDB(B0, 0, 0); PG8_LDB(B1, 0, 1); PG8_SCHED; PG8_LDA(At, 0, 0); PG8_STAGE(PG8_SA(1, 1), a1 + hstep, voffA);
            PG8_WAIT_V(8); PG8_WAIT_L(0); PG8_BAR; PG8_MMA(0, 0, At, B0); PG8_MMA(0, 1, At, B1); PG8_BAR; PG8_SCHED;
            PG8_LDA(At, 0, 1); PG8_STAGE(PG8_SB(0, 0), b2, voffB); PG8_STAGE(PG8_SB(0, 1), b2 + hstep, voffB); PG8_STAGE(PG8_SA(0, 0), a2, voffA);
            PG8_WAIT_V(8); PG8_WAIT_L(0); PG8_BAR; PG8_MMA(1, 0, At, B0); PG8_MMA(1, 1, At, B1); PG8_BAR; PG8_SCHED;
            PG8_LDB(B0, 1, 0); PG8_LDB(B1, 1, 1); PG8_SCHED; PG8_LDA(At, 1, 0); PG8_STAGE(PG8_SA(0, 1), a2 + hstep, voffA);
            PG8_WAIT_V(8); PG8_WAIT_L(0); PG8_BAR; PG8_MMA(0, 0, At, B0); PG8_MMA(0, 1, At, B1); PG8_BAR; PG8_SCHED;
            PG8_LDA(At, 1, 1); PG8_STAGE(PG8_SB(1, 0), b3, voffB); PG8_STAGE(PG8_SB(1, 1), b3 + hstep, voffB); PG8_STAGE(PG8_SA(1, 0), a3, voffA);
            PG8_WAIT_V(8); PG8_WAIT_L(0); PG8_BAR; PG8_MMA(1, 0, At, B0); PG8_MMA(1, 1, At, B1); PG8_BAR; PG8_SCHED;
            } else {
            PG8_LDB(B0, 0, 0); PG8_SCHED; PG8_LDA(At, 0, 0); PG8_STAGE(PG8_SA(1, 1), a1 + hstep, voffA);
            PG8_WAIT_L(8); PG8_BAR; PG8_WAIT_L(0); PG8_MMA(0, 0, At, B0); PG8_BAR; PG8_SCHED;
            PG8_LDB(B1, 0, 1); PG8_STAGE(PG8_SB(0, 0), b2, voffB);
            PG8_BAR; PG8_WAIT_L(0); PG8_MMA(0, 1, At, B1); PG8_BAR;
            PG8_LDA(At, 0, 1); PG8_STAGE(PG8_SA(0, 0), a2, voffA);
            PG8_BAR; PG8_WAIT_L(0); PG8_MMA(1, 0, At, B0); PG8_BAR; PG8_SCHED;
            PG8_STAGE(PG8_SB(0, 1), b2 + hstep, voffB);
            PG8_WAIT_V(6); PG8_BAR; PG8_MMA(1, 1, At, B1); PG8_BAR;
            PG8_LDB(B0, 1, 0); PG8_SCHED; PG8_LDA(At, 1, 0); PG8_STAGE(PG8_SA(0, 1), a2 + hstep, voffA);
            PG8_WAIT_L(8); PG8_BAR; PG8_WAIT_L(0); PG8_MMA(0, 0, At, B0); PG8_BAR; PG8_SCHED;
            PG8_LDB(B1, 1, 1); PG8_STAGE(PG8_SB(1, 0), b3, voffB);
            PG8_BAR; PG8_WAIT_L(0); PG8_MMA(0, 1, At, B1); PG8_BAR;
            PG8_LDA(At, 1, 1); PG8_STAGE(PG8_SA(1, 0), a3, voffA);
            PG8_BAR; PG8_WAIT_L(0); PG8_MMA(1, 0, At, B0); PG8_BAR; PG8_SCHED;
            PG8_STAGE(PG8_SB(1, 1), b3 + hstep, voffB);
            PG8_WAIT_V(6); PG8_BAR; PG8_MMA(1, 1, At, B1); PG8_BAR;
            }
        }
        if constexpr (ALIGN_EPI) { if (wr == 0) PG8_BAR; }
        if constexpr (!Epi::AFTER_DRAIN) { E(acc, cur, wr, wc, fr, fq); S.done(cur); }
        if (!has_next) break;
#pragma unroll
        for (int a = 0; a < 2; ++a)
#pragma unroll
            for (int b = 0; b < 2; ++b)
#pragma unroll
                for (int m = 0; m < 4; ++m)
#pragma unroll
                    for (int n = 0; n < 2; ++n) acc[a][b][m][n] = (f32x4){0.f, 0.f, 0.f, 0.f};
        cur = nxt; cA = nA; cB = nB; ++ui;
        if constexpr (ALIGN_EPI) { if (wr == 1) PG8_BAR; }
    }
    PG8_WAIT_V(0);
    if constexpr (!ALIGN_EPI) { if (wr == 0) PG8_BAR; }
    PG8_BAR;
    if constexpr (Epi::AFTER_DRAIN) { E.fused(acc, cur, wr, wc, fr, fq, lds, wid, lane); S.done(cur); }
#undef PG8_SA
#undef PG8_SB
#undef PG8_STAGE
#undef PG8_LDA
#undef PG8_LDB
#undef PG8_MMA
#undef PG8_WAIT_V
#undef PG8_WAIT_L
#undef PG8_BAR
#undef PG8_SCHED
}
}
namespace pg8 {
__device__ __forceinline__ float bf2f(unsigned short b) { return __uint_as_float(((unsigned)b) << 16); }
__device__ __forceinline__ float bflo(unsigned w) { return __uint_as_float(w << 16); }
__device__ __forceinline__ float bfhi(unsigned w) { return __uint_as_float(w & 0xffff0000u); }
__device__ __forceinline__ float sigm(float x) { return 1.f / (1.f + __expf(-x)); }
template <int MODE> struct EpiGate {
    static constexpr bool PERM = true, AFTER_DRAIN = false;
    bf16_t* O; int ldc; const bf16_t* G; int ldg;
    __device__ __forceinline__ void operator()(const f32x4 (&acc)[2][2][4][2], const Unit& u, int wr, int wc, int fr, int fq) const {
        const int row0 = u.pm * BM + wr * 64 + fr, col0 = u.pn * BM + wc * 32 + 8 * fq;
#pragma unroll
        for (int ai = 0; ai < 2; ++ai)
#pragma unroll
            for (int m = 0; m < 4; ++m) { const size_t row = (size_t)(row0 + ai * HALF + m * 16);
#pragma unroll
                for (int bj = 0; bj < 2; ++bj) {
                    const u32x4 gw = *(const u32x4*)(G + row * ldg + col0 + bj * HALF);
                    f32x4 v0 = acc[ai][bj][m][0], v1 = acc[ai][bj][m][1];
                    v0[0] *= sigm(bflo(gw.x)); v0[1] *= sigm(bfhi(gw.x)); v0[2] *= sigm(bflo(gw.y)); v0[3] *= sigm(bfhi(gw.y));
                    v1[0] *= sigm(bflo(gw.z)); v1[1] *= sigm(bfhi(gw.z)); v1[2] *= sigm(bflo(gw.w)); v1[3] *= sigm(bfhi(gw.w));
                    bf16_t* op = O + row * ldc + col0 + bj * HALF;
                    if (MODE == 1) { const u32x4 ow = *(const u32x4*)op;
                        v0[0] += bflo(ow.x); v0[1] += bfhi(ow.x); v0[2] += bflo(ow.y); v0[3] += bfhi(ow.y);
                        v1[0] += bflo(ow.z); v1[1] += bfhi(ow.z); v1[2] += bflo(ow.w); v1[3] += bfhi(ow.w); }
                    u32x4 w; w.x = cvt_pk_bf16(v0[0], v0[1]); w.y = cvt_pk_bf16(v0[2], v0[3]); w.z = cvt_pk_bf16(v1[0], v1[1]); w.w = cvt_pk_bf16(v1[2], v1[3]);
                    *(u32x4*)op = w; } }
    }
};
struct BranchOrder {
    StaticOrder base; int dm, dn;
    __host__ __device__ void init(int M, int N, int G_, int c_) { base.init(M, N, G_, c_); dm = M / BM; dn = N / BM; }
    __host__ __device__ bool next(int i, Unit& u) const { if (!base.next(i >> 1, u)) return false; if (i & 1) { u.pm += dm; u.pn += dn; } return true; }
    __device__ __forceinline__ void a_ready(const Unit&) const {}
    __device__ __forceinline__ void done(const Unit&) const {}
};
struct EpiGate2 {
    static constexpr bool PERM = true, AFTER_DRAIN = false;
    bf16_t* O; int ldc; const bf16_t* G0; const bf16_t* G1; int ldg; int dm, dn;
    __device__ __forceinline__ void operator()(const f32x4 (&acc)[2][2][4][2], const Unit& u, int wr, int wc, int fr, int fq) const {
        const bool second = u.pm >= dm;
        Unit v = u; if (second) { v.pm -= dm; v.pn -= dn; }
        if (second) { EpiGate<1> e{O, ldc, G1, ldg}; e(acc, v, wr, wc, fr, fq); } else { EpiGate<0> e{O, ldc, G0, ldg}; e(acc, v, wr, wc, fr, fq); }
    }
};
struct EpiResid {
    static constexpr bool PERM = true, AFTER_DRAIN = false;
    const float* R; float* Hf; bf16_t* Hb; float* ss; int ldc;
    __device__ __forceinline__ void operator()(const f32x4 (&acc)[2][2][4][2], const Unit& u, int wr, int wc, int fr, int fq) const {
        const int row0 = u.pm * BM + wr * 64 + fr, col0 = u.pn * BM + wc * 32 + 8 * fq;
#pragma unroll
        for (int ai = 0; ai < 2; ++ai)
#pragma unroll
            for (int m = 0; m < 4; ++m) { const size_t row = (size_t)(row0 + ai * HALF + m * 16); float sq = 0.f;
#pragma unroll
                for (int bj = 0; bj < 2; ++bj) {
                    const size_t off = row * ldc + col0 + bj * HALF;
                    const f32x4 r0 = *(const f32x4*)(R + off), r1 = *(const f32x4*)(R + off + 4);
                    const f32x4 v0 = acc[ai][bj][m][0] + r0, v1 = acc[ai][bj][m][1] + r1;
                    *(f32x4*)(Hf + off) = v0; *(f32x4*)(Hf + off + 4) = v1;
                    u32x4 w; w.x = cvt_pk_bf16(v0[0], v0[1]); w.y = cvt_pk_bf16(v0[2], v0[3]); w.z = cvt_pk_bf16(v1[0], v1[1]); w.w = cvt_pk_bf16(v1[2], v1[3]);
                    *(u32x4*)(Hb + off) = w;
                    sq += (v0[0] * v0[0] + v0[1] * v0[1]) + (v0[2] * v0[2] + v0[3] * v0[3]) + (v1[0] * v1[0] + v1[1] * v1[1]) + (v1[2] * v1[2] + v1[3] * v1[3]); }
                sq += __shfl_xor(sq, 16); sq += __shfl_xor(sq, 32);
                if (fq == 0) atomicAdd(ss + row, sq); }
    }
};
struct EpiRowScale {
    static constexpr bool PERM = true, AFTER_DRAIN = false;
    bf16_t* O; int ldc; const float* ss; float inv_n, eps;
    __device__ __forceinline__ void operator()(const f32x4 (&acc)[2][2][4][2], const Unit& u, int wr, int wc, int fr, int fq) const {
        const int row0 = u.pm * BM + wr * 64 + fr, col0 = u.pn * BM + wc * 32 + 8 * fq;
#pragma unroll
        for (int ai = 0; ai < 2; ++ai)
#pragma unroll
            for (int m = 0; m < 4; ++m) { const size_t row = (size_t)(row0 + ai * HALF + m * 16);
                const float sc = rsqrtf(__hip_atomic_load(ss + row, __ATOMIC_RELAXED, __HIP_MEMORY_SCOPE_AGENT) * inv_n + eps);
#pragma unroll
                for (int bj = 0; bj < 2; ++bj) { const f32x4 v0 = acc[ai][bj][m][0] * sc, v1 = acc[ai][bj][m][1] * sc;
                    u32x4 w; w.x = cvt_pk_bf16(v0[0], v0[1]); w.y = cvt_pk_bf16(v0[2], v0[3]); w.z = cvt_pk_bf16(v1[0], v1[1]); w.w = cvt_pk_bf16(v1[2], v1[3]);
                    *(u32x4*)(O + row * ldc + col0 + bj * HALF) = w; } }
    }
};
}
constexpr int D_MODEL = 2048, BATCH = 2, SEQ = 4096, NTOK = BATCH * SEQ;
constexpr int HD = 64, NCMP = 255, CMP_STRIDE = 16, CMP_LEN = 32, CMP_HID = 128;
constexpr int SEL_LEN = 64, SEL_TOPK = 16, WINDOW = 512;
constexpr int PEER_KEYS = 128, PEER_E = 128;
constexpr int NSA_Q = 1024, SB_W = 1024;
constexpr int IN_COLS = 9776, PLD = 9984;
constexpr int C_QN = 0, C_KC = 1024, C_VC = 1280, C_KS = 1536, C_VS = 1792, C_KW = 2048, C_VW = 2304, C_GBR = 2560,
              C_QB = 2608, C_KB = 3632, C_VB = 4656, C_GA = 5680, C_GB = 7728;
constexpr float EPS = 1e-6f, NEGF = -1e30f;
constexpr int NWAVES = 8, NTHR = 512;

constexpr size_t MiB = 1u << 20;
constexpr size_t WS_CTL = 0, CTL_ZERO_BYTES = 1 * MiB;
constexpr size_t WS_WIN = 2 * MiB;
constexpr size_t WS_WBN = 42 * MiB, WS_WBS = 46 * MiB;
constexpr size_t WS_WOUT = 50 * MiB, WS_WPQ = 58 * MiB;
constexpr size_t WS_MISC = 66 * MiB;
constexpr size_t WS_XN = 70 * MiB;
constexpr size_t WS_PROJ = 102 * MiB;
constexpr size_t WS_ONSA = 258 * MiB, WS_OSB = 274 * MiB;
constexpr size_t WS_H = 290 * MiB;
constexpr size_t WS_HB = 354 * MiB;
constexpr size_t WS_END = 386 * MiB;
constexpr size_t WS_UB = 102 * MiB, WS_VB = 166 * MiB, WS_QP = 230 * MiB, WS_EXP = 262 * MiB, WS_GATE = 266 * MiB;
constexpr size_t MISC_KCB = 0, MISC_VCB = 1 * MiB, MISC_SKB = 2 * MiB, MISC_W1T = 2 * MiB + 512 * 1024, MISC_B1 = 3 * MiB + 512 * 1024;
constexpr int CW_BAR = 4096;
constexpr int CW_SS = 32768;

#define GAS __attribute__((address_space(1)))
#define LAS __attribute__((address_space(3)))
typedef unsigned short bf16;
typedef unsigned v4u __attribute__((ext_vector_type(4)));
typedef unsigned v2u __attribute__((ext_vector_type(2)));
typedef float f32x4 __attribute__((ext_vector_type(4)));
#define RLX_AGENT __ATOMIC_RELAXED, __HIP_MEMORY_SCOPE_AGENT
__device__ __forceinline__ unsigned f2bf(float f) { unsigned u = __builtin_bit_cast(unsigned, f); return (u + 0x7fffu + ((u >> 16) & 1u)) >> 16; }
__device__ __forceinline__ unsigned pk2(float lo, float hi) { return f2bf(lo) | (f2bf(hi) << 16); }
__device__ __forceinline__ float bf2f(bf16 b) { return __uint_as_float(((unsigned)b) << 16); }
__device__ __forceinline__ float bflo(unsigned w) { return __uint_as_float(w << 16); }
__device__ __forceinline__ float bfhi(unsigned w) { return __uint_as_float(w & 0xffff0000u); }

#define XB_TMO      128
#define XB_XCNT(j)  (256  + 64 * (j))
#define XB_XSUB(j)  (1280 + 64 * (j))
#define XB_XGEN(j)  (2304 + 64 * (j))
#define XB_TOP      3328
#define XB_TOPGEN   3392
#define XCD_BAR_WORDS 3456
#define XB_SPIN_CAP (1u << 24)
__device__ __forceinline__ unsigned xb_ld(unsigned* p)              { return __hip_atomic_load(p, __ATOMIC_RELAXED, __HIP_MEMORY_SCOPE_AGENT); }
__device__ __forceinline__ unsigned xb_add(unsigned* p, unsigned v) { return __hip_atomic_fetch_add(p, v, __ATOMIC_RELAXED, __HIP_MEMORY_SCOPE_AGENT); }
__device__ __forceinline__ unsigned xb_xcc_id() { return (unsigned)__builtin_amdgcn_s_getreg((3 << 11) | 20) & 0xFu; }
#define XB_SPIN(cond, bar) do { unsigned _sp = 0; while (cond) { __builtin_amdgcn_s_sleep(1); \
    if ((++_sp & 255u) == 0u) { if (xb_ld(&(bar)[XB_TMO])) break; if (_sp > XB_SPIN_CAP) { atomicAdd(&(bar)[XB_TMO], 1u); break; } } } } while (0)
struct XcdBarrier { unsigned* bar; unsigned x; volatile LAS unsigned* st; };
__device__ __forceinline__ XcdBarrier xcd_barrier_post(unsigned* bar, volatile LAS unsigned* st) {
    XcdBarrier b; b.bar = bar; b.x = xb_xcc_id(); b.st = st;
    if (threadIdx.x == 0) (void)xb_add(&bar[XB_XCNT(b.x)], 1u);
    return b;
}
__device__ __forceinline__ void xcd_barrier_complete(unsigned* bar, unsigned x, unsigned& nloc, unsigned& nx) {
    const unsigned G = gridDim.x * gridDim.y * gridDim.z;
    unsigned sum, cnt, mine, sp = 0u;
    for (;;) {
        sum = 0u; cnt = 0u; mine = 0u;
#pragma unroll
        for (unsigned j = 0; j < 16; ++j) { const unsigned c = xb_ld(&bar[XB_XCNT(j)]); sum += c; cnt += (c > 0u) ? 1u : 0u; mine = (j == x) ? c : mine; }
        if (sum == G) break;
        __builtin_amdgcn_s_sleep(1);
        if ((++sp & 255u) == 0u) { if (xb_ld(&bar[XB_TMO])) break; if (sp > XB_SPIN_CAP) { atomicAdd(&bar[XB_TMO], 1u); break; } }
    }
    nloc = mine > 0u ? mine : 1u; nx = cnt > 0u ? cnt : 1u;
}
__device__ __forceinline__ void xcd_barrier(const XcdBarrier& b) {
    asm volatile("s_waitcnt vmcnt(0)" ::: "memory");
    __syncthreads();
    if (threadIdx.x == 0) {
        unsigned* bar = b.bar;
        const unsigned bx = xb_xcc_id();
        __builtin_amdgcn_s_waitcnt(0);
        unsigned nloc = b.st[0], nx = b.st[1];
        if (nloc == 0u) { xcd_barrier_complete(bar, bx, nloc, nx); b.st[0] = nloc; b.st[1] = nx; }
        const unsigned old = xb_add(&bar[XB_XSUB(bx)], 1u);
        const unsigned gen = old / nloc;
        if (old + 1u == (gen + 1u) * nloc) {
            __builtin_amdgcn_fence(__ATOMIC_RELEASE, "agent");
            asm volatile("s_waitcnt vmcnt(0)" ::: "memory");
            const unsigned og = xb_add(&bar[XB_TOP], 1u);
            const unsigned tg = og / nx;
            if (og + 1u == (tg + 1u) * nx) xb_add(&bar[XB_TOPGEN], 1u);
            else XB_SPIN(xb_ld(&bar[XB_TOPGEN]) == tg, bar);
            __builtin_amdgcn_fence(__ATOMIC_ACQUIRE, "agent");
            xb_add(&bar[XB_XGEN(bx)], 1u);
            asm volatile("s_waitcnt vmcnt(0)" ::: "memory");
        } else {
            XB_SPIN(xb_ld(&bar[XB_XGEN(bx)]) == gen, bar);
            __builtin_amdgcn_fence(__ATOMIC_ACQUIRE, "agent");
            asm volatile("s_waitcnt vmcnt(0)" ::: "memory");
        }
    }
    __syncthreads();
}

__device__ __forceinline__ int rel_bucket(int d) {
    if (d < 16) return d < 0 ? 0 : d;
    int b = 16;
    b += (d >= 21); b += (d >= 27); b += (d >= 35); b += (d >= 46); b += (d >= 59); b += (d >= 77); b += (d >= 99); b += (d >= 128);
    b += (d >= 166); b += (d >= 216); b += (d >= 280); b += (d >= 363); b += (d >= 470); b += (d >= 609); b += (d >= 790);
    return b;
}
__device__ __forceinline__ float gelu_tanh(float x) { const float k = 0.7978845608028654f; return 0.5f * x * (1.f + tanhf(k * (x + 0.044715f * x * x * x))); }
__device__ __forceinline__ float sigmoidf_(float x) { return 1.f / (1.f + expf(-x)); }
__device__ __forceinline__ float wave_sum(float v) {
#pragma unroll
    for (int o = 32; o >= 1; o >>= 1) v += __shfl_xor(v, o);
    return v;
}
__device__ __forceinline__ float wave_max(float v) {
#pragma unroll
    for (int o = 32; o >= 1; o >>= 1) v = fmaxf(v, __shfl_xor(v, o));
    return v;
}
__device__ __forceinline__ float half_sum(float v, float* red) {
    v = wave_sum(v);
    __syncthreads();
    if ((threadIdx.x & 63) == 0) red[(threadIdx.x >> 6) & 3] = v;
    __syncthreads();
    return red[0] + red[1] + red[2] + red[3];
}
__device__ __forceinline__ float half_max(float v, float* red) {
    v = wave_max(v);
    __syncthreads();
    if ((threadIdx.x & 63) == 0) red[(threadIdx.x >> 6) & 3] = v;
    __syncthreads();
    return fmaxf(fmaxf(red[0], red[1]), fmaxf(red[2], red[3]));
}

struct Args {
    const float* in[19]; float* out; unsigned char* ws; int ph_lo, ph_hi;
};

__device__ __forceinline__ void p0_transpose_item(const float* W, int K, int N, bf16* WT, const float* gk, LAS float* scr, int item, int lane) {
    const int nblk = (N + 31) / 32, kb = item / nblk, nb = item % nblk, k0 = 64 * kb, n0 = 32 * nb;
    const int c4 = (lane & 7) * 4, r8 = lane >> 3;
    const bool cok = (n0 + c4) < N;
    f32x4 v[8];
#pragma unroll
    for (int i = 0; i < 8; ++i) { const int kk = 8 * i + r8; v[i] = cok ? *(const f32x4*)(W + (size_t)(k0 + kk) * N + n0 + c4) : (f32x4){0.f, 0.f, 0.f, 0.f}; }
#pragma unroll
    for (int i = 0; i < 8; ++i) { const int kk = 8 * i + r8; const float g = gk ? gk[k0 + kk] : 1.f;
        scr[kk * 33 + c4 + 0] = v[i].x * g; scr[kk * 33 + c4 + 1] = v[i].y * g; scr[kk * 33 + c4 + 2] = v[i].z * g; scr[kk * 33 + c4 + 3] = v[i].w * g; }
    asm volatile("s_waitcnt lgkmcnt(0)" ::: "memory");
    const int c = lane & 7;
#pragma unroll
    for (int j = 0; j < 4; ++j) { const int n = (lane >> 3) + 8 * j; const LAS float* s = scr + (8 * c) * 33 + n;
        v4u o; o.x = pk2(s[0 * 33], s[1 * 33]); o.y = pk2(s[2 * 33], s[3 * 33]); o.z = pk2(s[4 * 33], s[5 * 33]); o.w = pk2(s[6 * 33], s[7 * 33]);
        if (n0 + n < N) *(v4u*)(WT + (size_t)(n0 + n) * K + k0 + 8 * c) = o; }
    asm volatile("s_waitcnt lgkmcnt(0)" ::: "memory");
}
__device__ __forceinline__ void rms_row_to_bf16(const float* xrow, const float* g, bf16* orow, int lane) {
    const f32x4* xr = (const f32x4*)xrow + lane; const f32x4* gr = (const f32x4*)g + lane;
    f32x4 v[8]; float s = 0.f;
#pragma unroll
    for (int j = 0; j < 8; ++j) { v[j] = xr[64 * j]; s += (v[j].x * v[j].x + v[j].y * v[j].y) + (v[j].z * v[j].z + v[j].w * v[j].w); }
    const float r = rsqrtf(wave_sum(s) * (1.f / D_MODEL) + EPS);
    v2u* o8 = (v2u*)orow + lane;
#pragma unroll
    for (int j = 0; j < 8; ++j) { const f32x4 gv = gr[64 * j]; v2u w; w.x = pk2(v[j].x * r * gv.x, v[j].y * r * gv.y); w.y = pk2(v[j].z * r * gv.z, v[j].w * r * gv.w); o8[64 * j] = w; }
}
__device__ __forceinline__ void cvt_flat(const float* src, bf16* dst, size_t n, size_t gthread, size_t nthreads) {
    for (size_t i = gthread * 8; i < n; i += nthreads * 8) {
        const f32x4 a = *(const f32x4*)(src + i), b = *(const f32x4*)(src + i + 4);
        v4u o; o.x = pk2(a.x, a.y); o.y = pk2(a.z, a.w); o.z = pk2(b.x, b.y); o.w = pk2(b.z, b.w);
        *(v4u*)(dst + i) = o;
    }
}
__device__ __forceinline__ void ph_compress_naive(const bf16* PROJ, const float* const* in, bf16* KCB, bf16* VCB, float* ldsf, int bid, int G) {
    const int tid = threadIdx.x, grp = tid >> 7, gt = tid & 127;
    if (bid == 0) for (int i = tid; i < 2 * 8 * HD; i += NTHR) { bf16* dst = (i >= 8 * HD) ? VCB : KCB; const int k = i & (8 * HD - 1); dst[(size_t)((k >> 6) * 256 + 255) * HD + (k & 63)] = 0; }
    float* blk = ldsf + grp * 2048; float* hid = ldsf + 4 * 2048 + grp * 128;
    const int per = BATCH * NCMP * 4, nitems = 2 * per;
    for (int base = bid * 4; base < nitems; base += G * 4) {
        const int item = base + grp; const bool ok = item < nitems;
        const int kv = ok ? item / per : 0, idx = ok ? item % per : 0;
        const int g = idx & 3, n = (idx >> 2) % NCMP, b = (idx >> 2) / NCMP;
        const float* pe = in[kv ? 6 : 3]; const float* w1 = in[kv ? 7 : 4]; const float* w2 = in[kv ? 8 : 5];
        const int coff = kv ? C_VC : C_KC;
        if (ok) for (int i = gt; i < CMP_LEN * HD; i += 128) { const int l = i >> 6, dd = i & 63; blk[i] = bf2f(PROJ[(size_t)(b * SEQ + n * CMP_STRIDE + l) * PLD + coff + g * HD + dd]) + pe[i]; }
        __syncthreads();
        if (ok) { float a = 0.f;
#pragma unroll 8
            for (int k = 0; k < CMP_LEN * HD; ++k) a += blk[k] * w1[(size_t)k * CMP_HID + gt];
            hid[gt] = gelu_tanh(a); }
        __syncthreads();
        if (ok && gt < HD) { float o = 0.f;
#pragma unroll 8
            for (int k = 0; k < CMP_HID; ++k) o += hid[k] * w2[k * HD + gt];
            (kv ? VCB : KCB)[(size_t)((b * 4 + g) * 256 + n) * HD + gt] = (bf16)f2bf(o); }
        __syncthreads();
    }
}

__device__ __forceinline__ void ph_stick_naive(const bf16* PROJ, bf16* OSB, int bid, int G) {
    const int lane = threadIdx.x & 63, gw = bid * NWAVES + (threadIdx.x >> 6), NGW = G * NWAVES;
    for (int row = gw; row < BATCH * 16 * SEQ; row += NGW) {
        const int t = row % SEQ, h = (row / SEQ) & 15, b = row / (SEQ * 16);
        const float qv = bf2f(PROJ[(size_t)(b * SEQ + t) * PLD + C_QB + h * HD + lane]);
        float acc = 0.f, suffix = 0.f;
        for (int s = t - 1; s >= 0; --s) {
            const bf16* kr = PROJ + (size_t)(b * SEQ + s) * PLD;
            const float z = wave_sum(qv * bf2f(kr[C_KB + h * HD + lane])) * 0.125f;
            const float lb = fminf(z, 0.f) - log1pf(expf(-fabsf(z)));
            acc += expf(lb + suffix) * bf2f(kr[C_VB + h * HD + lane]);
            suffix += lb - z;
            if (suffix < -80.f) break;
        }
        OSB[(size_t)(b * SEQ + t) * SB_W + h * HD + lane] = (bf16)f2bf(acc);
    }
}

__device__ __forceinline__ void ph_route_naive(const bf16* QP, const float* subk, int* EXPERT, float* GATE, float* ldsf, int bid, int G) {
    const int tid = threadIdx.x, hb = tid >> 8, ht = tid & 255;
    float* base = ldsf + hb * 4608;
    float* qs = base; float (*s)[128] = (float (*)[128])(base + 2048); float (*tv)[16] = (float (*)[16])(base + 4096); int (*ti)[16] = (int (*)[16])(base + 4352);
    for (int nb = bid * 2; nb < NTOK; nb += G * 2) {
        const int n = nb + hb;
        __syncthreads();
        for (int i = ht; i < 2048; i += 256) qs[i] = bf2f(QP[(size_t)n * 2048 + i]);
        __syncthreads();
#pragma unroll 1
        for (int r = 0; r < 8; ++r) {
            const int idx = ht + 256 * r, list = idx >> 7, k = idx & 127;
            const float* kr = subk + ((size_t)list * 128 + k) * 128;
            float a = 0.f;
#pragma unroll 8
            for (int c = 0; c < 128; ++c) a += qs[list * 128 + c] * kr[c];
            s[list][k] = a;
        }
        __syncthreads();
        if (ht < 16) {
            const int l = ht;
#pragma unroll 1
            for (int r = 0; r < 16; ++r) {
                float best = -INFINITY; int bi = 0;
                for (int k = 0; k < 128; ++k) { const float v = s[l][k]; if (v > best) { best = v; bi = k; } }
                tv[l][r] = best; ti[l][r] = bi; s[l][bi] = -INFINITY;
            }
        }
        __syncthreads();
        if (ht < 8) {
            const int h = ht;
            unsigned long long used0 = 0, used1 = 0, used2 = 0, used3 = 0;
            float bsv = 0.f, mx = 0.f, sum = 0.f;
#pragma unroll 1
            for (int r = 0; r < 16; ++r) {
                float best = -INFINITY; int bidx = 0;
                for (int j = 0; j < 256; ++j) {
                    const unsigned long long u = (j < 64) ? used0 : (j < 128) ? used1 : (j < 192) ? used2 : used3;
                    if ((u >> (j & 63)) & 1ull) continue;
                    const float v = tv[2 * h][j >> 4] + tv[2 * h + 1][j & 15];
                    if (v > best) { best = v; bidx = j; }
                }
                if (bidx < 64) used0 |= 1ull << bidx; else if (bidx < 128) used1 |= 1ull << (bidx & 63); else if (bidx < 192) used2 |= 1ull << (bidx & 63); else used3 |= 1ull << (bidx & 63);
                if (r == 0) mx = best;
                const float e = expf(best - mx); sum += e; bsv = e;
                EXPERT[(size_t)n * PEER_E + h * 16 + r] = ti[2 * h][bidx >> 4] * PEER_KEYS + ti[2 * h + 1][bidx & 15];
                GATE[(size_t)n * PEER_E + h * 16 + r] = bsv;
            }
            const float inv = 1.f / sum;
            for (int r = 0; r < 16; ++r) GATE[(size_t)n * PEER_E + h * 16 + r] *= inv;
        }
    }
    __syncthreads();
}

__device__ __forceinline__ void ph_ffn_naive(const float* H, const float* ss, const float* gffn, const int* EXPERT, const float* GATE, const bf16* UB, const bf16* VB,
                                             const float* gfin, float* out, float* ldsf, int bid, int G) {
    const int tid = threadIdx.x, hb = tid >> 8, ht = tid & 255, w = ht >> 6, lane = tid & 63;
    float* part = ldsf + hb * (4 * 2048 + 8); float* red = part + 4 * 2048;
    for (int nb = bid * 2; nb < NTOK; nb += G * 2) {
        const int n = nb + hb;
        const float rstd = rsqrtf(ss[n] * (1.f / D_MODEL) + EPS);
        float xv[32], acc[32];
#pragma unroll
        for (int j = 0; j < 4; ++j) {
            const float* hp = H + (size_t)n * 2048 + j * 512 + lane * 8; const float* gp = gffn + j * 512 + lane * 8;
            const f32x4 a = *(const f32x4*)hp, b2 = *(const f32x4*)(hp + 4), ga = *(const f32x4*)gp, gb = *(const f32x4*)(gp + 4);
            xv[8 * j + 0] = a.x * rstd * ga.x; xv[8 * j + 1] = a.y * rstd * ga.y; xv[8 * j + 2] = a.z * rstd * ga.z; xv[8 * j + 3] = a.w * rstd * ga.w;
            xv[8 * j + 4] = b2.x * rstd * gb.x; xv[8 * j + 5] = b2.y * rstd * gb.y; xv[8 * j + 6] = b2.z * rstd * gb.z; xv[8 * j + 7] = b2.w * rstd * gb.w;
        }
#pragma unroll
        for (int j = 0; j < 32; ++j) acc[j] = 0.f;
#pragma unroll 1
        for (int e = 0; e < 32; ++e) {
            const int ei = EXPERT[(size_t)n * PEER_E + w * 32 + e];
            const float gt = GATE[(size_t)n * PEER_E + w * 32 + e];
            const bf16* ur = UB + (size_t)ei * 2048 + lane * 8; const bf16* vr = VB + (size_t)ei * 2048 + lane * 8;
            float d = 0.f;
#pragma unroll
            for (int j = 0; j < 4; ++j) { const v4u u4 = *(const v4u*)(ur + j * 512);
                d += xv[8 * j + 0] * bflo(u4.x) + xv[8 * j + 1] * bfhi(u4.x) + xv[8 * j + 2] * bflo(u4.y) + xv[8 * j + 3] * bfhi(u4.y)
                   + xv[8 * j + 4] * bflo(u4.z) + xv[8 * j + 5] * bfhi(u4.z) + xv[8 * j + 6] * bflo(u4.w) + xv[8 * j + 7] * bfhi(u4.w); }
            d = wave_sum(d);
            const float wgt = gt * gelu_tanh(d);
#pragma unroll
            for (int j = 0; j < 4; ++j) { const v4u v4 = *(const v4u*)(vr + j * 512);
                acc[8 * j + 0] += wgt * bflo(v4.x); acc[8 * j + 1] += wgt * bfhi(v4.x); acc[8 * j + 2] += wgt * bflo(v4.y); acc[8 * j + 3] += wgt * bfhi(v4.y);
                acc[8 * j + 4] += wgt * bflo(v4.z); acc[8 * j + 5] += wgt * bfhi(v4.z); acc[8 * j + 6] += wgt * bflo(v4.w); acc[8 * j + 7] += wgt * bfhi(v4.w); }
        }
        __syncthreads();
#pragma unroll
        for (int j = 0; j < 4; ++j)
#pragma unroll
            for (int e = 0; e < 8; ++e) part[w * 2048 + j * 512 + lane * 8 + e] = acc[8 * j + e];
        __syncthreads();
        float y[8]; float sq = 0.f;
#pragma unroll
        for (int j = 0; j < 8; ++j) { const int c = ht + 256 * j; y[j] = H[(size_t)n * 2048 + c] + part[c] + part[2048 + c] + part[4096 + c] + part[6144 + c]; sq += y[j] * y[j]; }
        const float tot = half_sum(sq, red);
        const float r = rsqrtf(tot * (1.f / D_MODEL) + EPS);
#pragma unroll
        for (int j = 0; j < 8; ++j) { const int c = ht + 256 * j; out[(size_t)n * 2048 + c] = y[j] * r * gfin[c]; }
    }
    __syncthreads();
}
namespace cmpr {
typedef short bf16x8 __attribute__((ext_vector_type(8)));
typedef float f32x4v __attribute__((ext_vector_type(4)));
__device__ __forceinline__ void compress_phase(const bf16* PROJ, const bf16* W1T, const float* BIAS1, const float* const* in, bf16* KCB, bf16* VCB,
                                               __attribute__((address_space(3))) unsigned char* lds3, int bid, int G) {
    int tid = threadIdx.x; asm volatile("" : "+v"(tid));
    const int lane = tid & 63, wid = __builtin_amdgcn_readfirstlane(tid >> 6), r16 = lane & 15, kq = lane >> 4;
    __attribute__((address_space(3))) float* PART = (__attribute__((address_space(3))) float*)lds3;
    __attribute__((address_space(3))) float* HID = (__attribute__((address_space(3))) float*)(lds3 + 65536);
    for (int unit = bid; unit < 256; unit += G) {
        const int c = unit & 15, g = (unit >> 4) & 3, b = (unit >> 6) & 1, kv = unit >> 7, n0 = 16 * c;
        const int coff = kv ? C_VC : C_KC;
        int nn = n0 + r16; if (nn > NCMP - 1) nn = NCMP - 1;
        const bf16* ap = PROJ + (size_t)(b * SEQ + 16 * nn + 4 * wid) * PLD + coff + g * HD + 8 * kq;
        const bf16* bp = W1T + (size_t)kv * CMP_HID * 2048 + (size_t)r16 * 2048 + 256 * wid + 8 * kq;
        f32x4v acc[8] = {};
#pragma unroll
        for (int ks = 0; ks < 8; ++ks) {
            const bf16x8 a = *(const bf16x8*)(ap + (size_t)(ks >> 1) * PLD + (ks & 1) * 32);
#pragma unroll
            for (int nt = 0; nt < 8; ++nt) { const bf16x8 w = *(const bf16x8*)(bp + (size_t)nt * 16 * 2048 + ks * 32); acc[nt] = __builtin_amdgcn_mfma_f32_16x16x32_bf16(a, w, acc[nt], 0, 0, 0); }
        }
#pragma unroll
        for (int nt = 0; nt < 8; ++nt)
#pragma unroll
            for (int r = 0; r < 4; ++r) PART[wid * 2048 + (kq * 4 + r) * 128 + nt * 16 + r16] = acc[nt][r];
        asm volatile("s_waitcnt lgkmcnt(0)" ::: "memory"); __syncthreads();
#pragma unroll
        for (int i = 0; i < 4; ++i) { const int e = tid + NTHR * i; float s = BIAS1[kv * CMP_HID + (e & 127)];
#pragma unroll
            for (int w = 0; w < 8; ++w) s += PART[w * 2048 + e];
            HID[e] = gelu_tanh(s); }
        asm volatile("s_waitcnt lgkmcnt(0)" ::: "memory"); __syncthreads();
        {
            const int nl = tid >> 5, d = (tid & 31) * 2; const float* w2 = in[kv ? 8 : 5];
            float o0 = 0.f, o1 = 0.f;
#pragma unroll 8
            for (int j = 0; j < CMP_HID; ++j) { const float hv = HID[nl * 128 + j]; const float2 wv = *(const float2*)(w2 + j * HD + d); o0 += hv * wv.x; o1 += hv * wv.y; }
            const int n = n0 + nl;
            const unsigned pk = (n < NCMP) ? pk2(o0, o1) : 0u;
            *(unsigned*)((kv ? VCB : KCB) + (size_t)((b * 4 + g) * 256 + n) * HD + d) = pk;
        }
        __syncthreads();
    }
}
}
#ifndef NSA_FAR
#define NSA_FAR 1
#endif
namespace nsa {
typedef short bf16x8 __attribute__((ext_vector_type(8)));
typedef short s16x4 __attribute__((ext_vector_type(4)));
typedef float f32x16 __attribute__((ext_vector_type(16)));
typedef unsigned u32x4 __attribute__((ext_vector_type(4)));
typedef __attribute__((address_space(3))) const char* lds_cptr;
typedef __attribute__((address_space(3))) unsigned char* lds_ptr;
constexpr int SLOTB = 16384;
constexpr int L_RING = 0, L_OV = 49152, L_BT = 81920, L_WSF = 94720, L_MASK = 96768, L_MISC = 97280, L_X = 97408, L_END = L_X + 32768;
constexpr int BT_N = 800;
constexpr float LOG2E = 1.4426950408889634f, SC2 = 0.125f * LOG2E, NEG2 = -1e30f;
static_assert(L_END <= 131072, "nsa LDS map");
__device__ __forceinline__ int crow(int r, int hi) { return (r & 3) + 8 * (r >> 2) + 4 * hi; }
__device__ __forceinline__ void glds16(const void* gsrc, unsigned lds_dst) { unsigned keep;
    asm volatile("s_mov_b32 %0, m0\n\ts_mov_b32 m0, %2\n\ts_nop 0\n\tglobal_load_lds_dwordx4 %1, off\n\ts_mov_b32 m0, %0" : "=&s"(keep) : "v"(gsrc), "s"(lds_dst) : "memory"); }
typedef float f32x2_t __attribute__((ext_vector_type(2))); typedef __bf16 bf16x2_t __attribute__((ext_vector_type(2)));
__device__ __forceinline__ unsigned cvtpk_s(float lo, float hi) { f32x2_t v = {lo, hi}; bf16x2_t b = __builtin_convertvector(v, bf16x2_t); return __builtin_bit_cast(unsigned, b); }
#define NSA_WAIT_BAR(N) asm volatile("s_waitcnt vmcnt(" #N ") lgkmcnt(0)\n\ts_barrier" ::: "memory")
#define NSA_SBAR() __builtin_amdgcn_sched_barrier(0)

__device__ __forceinline__ void qkt(f32x16& p0, f32x16& p1, lds_cptr Kslot, const bf16x8* qr, int r32, int hi) {
    lds_cptr kb = Kslot + hi * 1024 + r32 * 16;
    const f32x16 z = {};
#pragma unroll
    for (int d0 = 0; d0 < 4; ++d0) {
        const bf16x8 b0 = *(const __attribute__((address_space(3))) bf16x8*)(kb + d0 * 2048);
        const bf16x8 b1 = *(const __attribute__((address_space(3))) bf16x8*)(kb + d0 * 2048 + 512);
        if (d0 == 0) { p0 = __builtin_amdgcn_mfma_f32_32x32x16_bf16(b0, qr[0], z, 0, 0, 0); p1 = __builtin_amdgcn_mfma_f32_32x32x16_bf16(b1, qr[0], z, 0, 0, 0); }
        else { p0 = __builtin_amdgcn_mfma_f32_32x32x16_bf16(b0, qr[d0], p0, 0, 0, 0); p1 = __builtin_amdgcn_mfma_f32_32x32x16_bf16(b1, qr[d0], p1, 0, 0, 0); }
    }
}
__device__ __forceinline__ void pv(f32x16* o, int vb, bf16x8 pa0, bf16x8 pa1, bf16x8 pa2, bf16x8 pa3) {
#pragma unroll
    for (int d0 = 0; d0 < 2; ++d0) { s16x4 lo[4], hi[4];
#pragma unroll
        for (int ks = 0; ks < 4; ++ks) {
            asm volatile("ds_read_b64_tr_b16 %0,%1 offset:%c2" : "=&v"(lo[ks]) : "v"(vb), "i"(d0 * 4096 + ks * 1024) : "memory");
            asm volatile("ds_read_b64_tr_b16 %0,%1 offset:%c2" : "=&v"(hi[ks]) : "v"(vb), "i"(d0 * 4096 + ks * 1024 + 512) : "memory"); }
        asm volatile("s_waitcnt lgkmcnt(0)" ::: "memory"); NSA_SBAR();
#define NSA_PK(k) (bf16x8){lo[k][0], lo[k][1], lo[k][2], lo[k][3], hi[k][0], hi[k][1], hi[k][2], hi[k][3]}
        o[d0] = __builtin_amdgcn_mfma_f32_32x32x16_bf16(pa0, NSA_PK(0), o[d0], 0, 0, 0);
        o[d0] = __builtin_amdgcn_mfma_f32_32x32x16_bf16(pa1, NSA_PK(1), o[d0], 0, 0, 0);
        o[d0] = __builtin_amdgcn_mfma_f32_32x32x16_bf16(pa2, NSA_PK(2), o[d0], 0, 0, 0);
        o[d0] = __builtin_amdgcn_mfma_f32_32x32x16_bf16(pa3, NSA_PK(3), o[d0], 0, 0, 0);
#undef NSA_PK
    }
}
__device__ __forceinline__ float rowmax32(const f32x16& p0, const f32x16& p1) {
    float a = fmaxf(p0[0], p1[0]), b = fmaxf(p0[1], p1[1]);
#pragma unroll
    for (int r = 2; r < 16; r += 2) { a = fmaxf(fmaxf(a, p0[r]), p1[r]); b = fmaxf(fmaxf(b, p0[r + 1]), p1[r + 1]); }
    a = fmaxf(a, b);
    auto rr = __builtin_amdgcn_permlane32_swap(__float_as_uint(a), __float_as_uint(a), false, false);
    return fmaxf(__uint_as_float(rr[0]), __uint_as_float(rr[1]));
}
__device__ __forceinline__ float swap_add(float v) {
    auto rr = __builtin_amdgcn_permlane32_swap(__float_as_uint(v), __float_as_uint(v), false, false);
    return __uint_as_float(rr[0]) + __uint_as_float(rr[1]);
}

struct PassCtx {
    lds_ptr lds3; unsigned lds0;
    int lane, r32, hi, wid;
    int tq;
    const __attribute__((address_space(3))) float* bt;
    __attribute__((address_space(3))) float* wsf;
    int vboff;
};

template <int MODE>
__device__ __forceinline__ void run_pass(const PassCtx& c, int NT, int first, const bf16* Kb, const bf16* Vb, int pitch, const bf16x8* qr,
                                         unsigned mask_lo, unsigned mask_hi, f32x16 (&o)[2], f32x16 (&im)[2], float& m, float& l) {
    const __attribute__((address_space(3))) unsigned char* TL = (const __attribute__((address_space(3))) unsigned char*)(c.lds3 + L_MISC);
#define NSA_TID(i) ((MODE == 0) ? (i) : (MODE == 2) ? (first + (i)) : (int)TL[(i)])
#define NSA_ISSUE(i, slot) do { const int id_ = __builtin_amdgcn_readfirstlane(NSA_TID(i)); \
        const bf16* ks_ = Kb + (size_t)(64 * id_ + c.lane) * pitch + 8 * c.wid; \
        const bf16* vs_ = Vb + (size_t)(64 * id_ + 16 * (c.wid & 3) + (c.lane >> 2)) * pitch + 32 * (c.wid >> 2) + 8 * (c.lane & 3); \
        glds16(ks_, (unsigned)__builtin_amdgcn_readfirstlane(c.lds0 + L_RING + (slot) * SLOTB + c.wid * 1024)); \
        glds16(vs_, (unsigned)__builtin_amdgcn_readfirstlane(c.lds0 + L_RING + (slot) * SLOTB + 8192 + c.wid * 1024)); } while (0)
    if (NT > 0) NSA_ISSUE(0, 0);
    if (NT > 1) NSA_ISSUE(1, 1);
    int slot = 0;
    for (int i = 0; i < NT; ++i) {
        if (i + 1 < NT) NSA_WAIT_BAR(2); else NSA_WAIT_BAR(0);
        if (i + 2 < NT) { const int s2 = (slot == 0) ? 2 : slot - 1; NSA_ISSUE(i + 2, s2); }
        const int id = __builtin_amdgcn_readfirstlane(NSA_TID(i));
        f32x16 p0, p1;
        qkt(p0, p1, (lds_cptr)(c.lds3 + L_RING + slot * SLOTB), qr, c.r32, c.hi);
        const int dbase = (MODE == 0) ? (c.tq - 31 - 1024 * id) : (c.tq - 64 * id);
        bool selb = true;
        if (MODE == 1) selb = ((id < 32 ? (mask_lo >> id) : (mask_hi >> (id - 32))) & 1u) != 0u;
        float alpha, rs = 0.f;
        if (NSA_FAR && MODE == 1 && __builtin_amdgcn_readfirstlane(c.tq - c.r32) - (64 * id + 63) >= 790) {
            const float lofs = selb ? c.bt[790] : -INFINITY;
            const float mt = rowmax32(p0, p1) * SC2 + lofs;
            const float mnew = fmaxf(m, mt);
            alpha = __builtin_amdgcn_exp2f(m - mnew);
            m = mnew;
            const float off = lofs - mnew;
#pragma unroll
            for (int r = 0; r < 16; ++r) { p0[r] = __builtin_amdgcn_exp2f(p0[r] * SC2 + off); p1[r] = __builtin_amdgcn_exp2f(p1[r] * SC2 + off); rs += p0[r] + p1[r]; }
        } else {
        int dbh = dbase - ((MODE == 0) ? 64 * c.hi : 4 * c.hi);
        asm volatile("" : "+v"(dbh));
#pragma unroll
        for (int r = 0; r < 16; ++r) {
            const int d0 = dbh - ((MODE == 0) ? 16 * ((r & 3) + 8 * (r >> 2)) : ((r & 3) + 8 * (r >> 2)));
            const int d1 = (MODE == 0) ? (d0 - 512) : (d0 - 32);
            bool v0 = d0 >= 0, v1 = d1 >= 0;
            if (MODE == 2) { v0 = v0 && d0 < WINDOW; v1 = v1 && d1 < WINDOW; }
            if (MODE == 1) { v0 = v0 && selb; v1 = v1 && selb; }
            const int i0 = d0 < 0 ? 0 : (d0 > 790 ? 790 : d0), i1 = d1 < 0 ? 0 : (d1 > 790 ? 790 : d1);
            const float s0 = p0[r] * SC2 + c.bt[i0], s1 = p1[r] * SC2 + c.bt[i1];
            p0[r] = v0 ? s0 : -INFINITY; p1[r] = v1 ? s1 : -INFINITY;
        }
        const float mt = rowmax32(p0, p1);
        const float mnew = fmaxf(m, mt);
        alpha = __builtin_amdgcn_exp2f(m - mnew);
        m = mnew;
#pragma unroll
        for (int r = 0; r < 16; ++r) {
            const float e0 = __builtin_amdgcn_exp2f(p0[r] - mnew), e1 = __builtin_amdgcn_exp2f(p1[r] - mnew);
            p0[r] = e0; p1[r] = e1; rs += e0 + e1;
        }
        }
        l = l * alpha + rs;
        if (!__all(alpha == 1.f)) {
            if (c.hi == 0) c.wsf[c.r32] = alpha;
            asm volatile("s_waitcnt lgkmcnt(0)" ::: "memory");
#pragma unroll
            for (int r = 0; r < 16; ++r) { const float a = c.wsf[crow(r, c.hi)]; o[0][r] *= a; o[1][r] *= a; if (MODE == 0) { im[0][r] *= a; im[1][r] *= a; } }
        }
        u32x4 pw0, pw1, pw2, pw3;
        pw0 = (u32x4){cvtpk_s(p0[0], p0[1]), cvtpk_s(p0[2], p0[3]), cvtpk_s(p0[4], p0[5]), cvtpk_s(p0[6], p0[7])};
        pw1 = (u32x4){cvtpk_s(p0[8], p0[9]), cvtpk_s(p0[10], p0[11]), cvtpk_s(p0[12], p0[13]), cvtpk_s(p0[14], p0[15])};
        pw2 = (u32x4){cvtpk_s(p1[0], p1[1]), cvtpk_s(p1[2], p1[3]), cvtpk_s(p1[4], p1[5]), cvtpk_s(p1[6], p1[7])};
        pw3 = (u32x4){cvtpk_s(p1[8], p1[9]), cvtpk_s(p1[10], p1[11]), cvtpk_s(p1[12], p1[13]), cvtpk_s(p1[14], p1[15])};
        NSA_SBAR();
        pv(o, (int)(c.lds0 + L_RING + slot * SLOTB + 8192) + c.vboff, __builtin_bit_cast(bf16x8, pw0), __builtin_bit_cast(bf16x8, pw1), __builtin_bit_cast(bf16x8, pw2), __builtin_bit_cast(bf16x8, pw3));
        if (MODE == 0) pv(im, (int)(c.lds0 + L_OV + id * 8192) + c.vboff, __builtin_bit_cast(bf16x8, pw0), __builtin_bit_cast(bf16x8, pw1), __builtin_bit_cast(bf16x8, pw2), __builtin_bit_cast(bf16x8, pw3));
        slot = (slot == 2) ? 0 : slot + 1;
    }
    asm volatile("s_waitcnt vmcnt(0) lgkmcnt(0)\n\ts_barrier" ::: "memory");
#undef NSA_TID
#undef NSA_ISSUE
}

__device__ __forceinline__ void build_ov(lds_ptr lds3) {
    for (int idx = threadIdx.x; idx < 4 * 4096; idx += NTHR) {
        const int kt = idx >> 12, nl = (idx >> 6) & 63, jc = idx & 63, n = 64 * kt + nl;
        unsigned short v = 0;
        if ((n & 3) != 3) { if (jc == (n >> 2)) v = 0x3F80; } else { if (jc == (n >> 2) || jc == (n >> 2) + 1) v = 0x3F00; }
        *(__attribute__((address_space(3))) unsigned short*)(lds3 + L_OV + kt * 8192 + ((jc >> 5) * 4 + (nl >> 4)) * 1024 + (nl & 15) * 64 + (jc & 31) * 2) = v;
    }
}

__device__ __forceinline__ void nsa_unit(bool build_bt, int b, int g, int qt, const bf16* PROJ, const bf16* KCBb, const bf16* VCBb, const float* rel, bf16* ONSA, lds_ptr lds3, unsigned lds0) {
    const int tid = threadIdx.x, lane = tid & 63, r32 = lane & 31, hi = lane >> 5;
    const int wid = __builtin_amdgcn_readfirstlane(tid >> 6), hh = wid & 3, th = wid >> 2;
    const int t0 = qt * 64, tq = t0 + 32 * th + r32, cur = qt;
    __attribute__((address_space(3))) float* BT = (__attribute__((address_space(3))) float*)(lds3 + L_BT);
    __attribute__((address_space(3))) unsigned* MASK = (__attribute__((address_space(3))) unsigned*)(lds3 + L_MASK);
    if (build_bt) for (int i = tid; i < 4 * BT_N; i += NTHR) { const int hq = i / BT_N, d = i - hq * BT_N; BT[i] = rel[rel_bucket(d) * 16 + g * 4 + hq] * LOG2E; }
    if (tid < 128) MASK[tid] = 0u;
    PassCtx c; c.lds3 = lds3; c.lds0 = lds0; c.lane = lane; c.r32 = r32; c.hi = hi; c.wid = wid; c.tq = tq;
    c.bt = BT + hh * BT_N; c.wsf = (__attribute__((address_space(3))) float*)(lds3 + L_WSF) + wid * 64;
    c.vboff = ((lane >> 4) & 1) * 32 + (lane & 3) * 8 + (4 * hi + ((lane & 15) >> 2)) * 64;
    const size_t qrow = (size_t)(b * SEQ + tq) * PLD;
    bf16x8 qr[4];
#pragma unroll
    for (int d0 = 0; d0 < 4; ++d0) qr[d0] = *(const bf16x8*)(PROJ + qrow + C_QN + (g * 4 + hh) * HD + d0 * 16 + hi * 8);
    const float gate0 = 1.f / (1.f + __expf(-bf2f(PROJ[qrow + C_GBR + 0 * 16 + g * 4 + hh])));
    const float gate1 = 1.f / (1.f + __expf(-bf2f(PROJ[qrow + C_GBR + 1 * 16 + g * 4 + hh])));
    const float gate2 = 1.f / (1.f + __expf(-bf2f(PROJ[qrow + C_GBR + 2 * 16 + g * 4 + hh])));
    asm volatile("s_waitcnt vmcnt(0) lgkmcnt(0)" ::: "memory");
    __syncthreads();
    f32x16 oc[2] = {}, o[2] = {}, im[2] = {};
    float m = NEG2, l = 0.f;
    {
        int cnt = (t0 + 32) / 16 + 1; if (cnt > NCMP) cnt = NCMP;
        const int NT = (cnt + 63) >> 6;
#if defined(PROBE_NSA_CMP2)
        run_pass<0>(c, NT, 0, KCBb + (size_t)(b * 4 + g) * 256 * HD, VCBb + (size_t)(b * 4 + g) * 256 * HD, HD, qr, 0u, 0u, o, im, m, l);
        o[0] = f32x16{}; o[1] = f32x16{}; im[0] = f32x16{}; im[1] = f32x16{}; m = NEG2; l = 0.f;
#endif
        run_pass<0>(c, NT, 0, KCBb + (size_t)(b * 4 + g) * 256 * HD, VCBb + (size_t)(b * 4 + g) * 256 * HD, HD, qr, 0u, 0u, o, im, m, l);
        const float lt = swap_add(l);
        const float inv = lt > 0.f ? 1.f / lt : 0.f;
        if (hi == 0) { c.wsf[r32] = inv * gate0; c.wsf[32 + r32] = inv; }
        asm volatile("s_waitcnt lgkmcnt(0)" ::: "memory");
#pragma unroll
        for (int r = 0; r < 16; ++r) { const float a = c.wsf[crow(r, hi)], a2 = c.wsf[32 + crow(r, hi)]; oc[0][r] = o[0][r] * a; oc[1][r] = o[1][r] * a; im[0][r] *= a2; im[1][r] *= a2; }
        __attribute__((address_space(3))) float* X = (__attribute__((address_space(3))) float*)(lds3 + L_X);
        const int area = (hh >> 1) * 2 + th;
        if (hh & 1) {
#pragma unroll
            for (int d0 = 0; d0 < 2; ++d0)
#pragma unroll
                for (int r = 0; r < 16; ++r) X[area * 2048 + crow(r, hi) * 64 + d0 * 32 + r32] = im[d0][r];
        }
        asm volatile("s_waitcnt lgkmcnt(0)" ::: "memory"); __syncthreads();
        if (!(hh & 1)) {
#pragma unroll
            for (int d0 = 0; d0 < 2; ++d0)
#pragma unroll
                for (int r = 0; r < 16; ++r) { im[d0][r] += X[area * 2048 + crow(r, hi) * 64 + d0 * 32 + r32]; if (hh == 2) X[area * 2048 + crow(r, hi) * 64 + d0 * 32 + r32] = im[d0][r]; }
        }
        asm volatile("s_waitcnt lgkmcnt(0)" ::: "memory"); __syncthreads();
        __attribute__((address_space(3))) float* T = (__attribute__((address_space(3))) float*)(lds3 + L_RING);
        if (hh == 0) {
#pragma unroll
            for (int d0 = 0; d0 < 2; ++d0)
#pragma unroll
                for (int r = 0; r < 16; ++r) T[(32 * th + crow(r, hi)) * 65 + d0 * 32 + r32] = im[d0][r] + X[(2 + th) * 2048 + crow(r, hi) * 64 + d0 * 32 + r32];
        }
        asm volatile("s_waitcnt lgkmcnt(0)" ::: "memory"); __syncthreads();
        {
            const int tok = tid & 63, jg = wid;
            float v[8]; int rank[8];
#pragma unroll
            for (int e = 0; e < 8; ++e) { const int j = 8 * jg + e; const bool forced = (j == 0) || (cur - j >= 0 && cur - j < 2);
                v[e] = (j <= cur) ? T[tok * 65 + j] + (forced ? 1e4f : 0.f) : -INFINITY; rank[e] = 0; }
#pragma unroll 2
            for (int j2 = 0; j2 < 64; ++j2) {
                const bool f2 = (j2 == 0) || (cur - j2 >= 0 && cur - j2 < 2);
                const float sv = (j2 <= cur) ? T[tok * 65 + j2] + (f2 ? 1e4f : 0.f) : -INFINITY;
#pragma unroll
                for (int e = 0; e < 8; ++e) { const int j = 8 * jg + e; rank[e] += (sv > v[e] || (sv == v[e] && j2 < j)) ? 1 : 0; }
            }
            unsigned bits = 0u;
#pragma unroll
            for (int e = 0; e < 8; ++e) { const int j = 8 * jg + e; if (j <= cur && rank[e] < SEL_TOPK) bits |= 1u << e; }
            if (bits) atomicOr((unsigned*)(MASK + tok * 2 + (jg >> 2)), bits << ((jg & 3) * 8));
        }
        asm volatile("s_waitcnt lgkmcnt(0)" ::: "memory"); __syncthreads();
        if (wid == 0) {
            unsigned ulo = MASK[lane * 2], uhi = MASK[lane * 2 + 1];
#pragma unroll
            for (int ofs = 32; ofs >= 1; ofs >>= 1) { ulo |= __shfl_xor(ulo, ofs); uhi |= __shfl_xor(uhi, ofs); }
            {
                __attribute__((address_space(3))) unsigned char* TL = (__attribute__((address_space(3))) unsigned char*)(lds3 + L_MISC);
                const unsigned long long mm = ((unsigned long long)uhi << 32) | ulo;
                int ln = lane; asm volatile("" : "+v"(ln));
                if ((mm >> ln) & 1ull) TL[__popcll(mm & ((1ull << ln) - 1ull))] = (unsigned char)ln;
                if (lane == 0) *(__attribute__((address_space(3))) int*)(lds3 + L_MISC + 64) = __popcll(mm);
            }
        }
        asm volatile("s_waitcnt lgkmcnt(0)" ::: "memory"); __syncthreads();
    }
    {
        const unsigned mlo = MASK[(32 * th + r32) * 2], mhi = MASK[(32 * th + r32) * 2 + 1];
        const int NT = __builtin_amdgcn_readfirstlane(*(__attribute__((address_space(3))) int*)(lds3 + L_MISC + 64));
#if defined(PROBE_NSA_SEL2)
        o[0] = f32x16{}; o[1] = f32x16{}; m = NEG2; l = 0.f;
        run_pass<1>(c, NT, 0, PROJ + (size_t)b * SEQ * PLD + C_KS + g * HD, PROJ + (size_t)b * SEQ * PLD + C_VS + g * HD, PLD, qr, mlo, mhi, o, im, m, l);
#endif
        o[0] = f32x16{}; o[1] = f32x16{}; m = NEG2; l = 0.f;
        run_pass<1>(c, NT, 0, PROJ + (size_t)b * SEQ * PLD + C_KS + g * HD, PROJ + (size_t)b * SEQ * PLD + C_VS + g * HD, PLD, qr, mlo, mhi, o, im, m, l);
        const float lt = swap_add(l);
        const float inv = lt > 0.f ? 1.f / lt : 0.f;
        if (hi == 0) c.wsf[r32] = inv * gate1;
        asm volatile("s_waitcnt lgkmcnt(0)" ::: "memory");
#pragma unroll
        for (int r = 0; r < 16; ++r) { const float a = c.wsf[crow(r, hi)]; oc[0][r] += o[0][r] * a; oc[1][r] += o[1][r] * a; }
    }
    {
        const int jlo = (qt - 8) > 0 ? (qt - 8) : 0, NT = qt - jlo + 1;
#if defined(PROBE_NSA_WIN2)
        o[0] = f32x16{}; o[1] = f32x16{}; m = NEG2; l = 0.f;
        run_pass<2>(c, NT, jlo, PROJ + (size_t)b * SEQ * PLD + C_KW + g * HD, PROJ + (size_t)b * SEQ * PLD + C_VW + g * HD, PLD, qr, 0u, 0u, o, im, m, l);
#endif
        o[0] = f32x16{}; o[1] = f32x16{}; m = NEG2; l = 0.f;
        run_pass<2>(c, NT, jlo, PROJ + (size_t)b * SEQ * PLD + C_KW + g * HD, PROJ + (size_t)b * SEQ * PLD + C_VW + g * HD, PLD, qr, 0u, 0u, o, im, m, l);
        const float lt = swap_add(l);
        const float inv = lt > 0.f ? 1.f / lt : 0.f;
        if (hi == 0) c.wsf[r32] = inv * gate2;
        asm volatile("s_waitcnt lgkmcnt(0)" ::: "memory");
#pragma unroll
        for (int r = 0; r < 16; ++r) { const float a = c.wsf[crow(r, hi)]; oc[0][r] += o[0][r] * a; oc[1][r] += o[1][r] * a; }
    }
    {
        __attribute__((address_space(3))) unsigned short* stg = (__attribute__((address_space(3))) unsigned short*)(lds3 + L_X) + wid * 2048;
#pragma unroll
        for (int r = 0; r < 16; ++r) { const int orow = crow(r, hi);
#pragma unroll
            for (int d0 = 0; d0 < 2; ++d0) stg[orow * 64 + d0 * 32 + r32] = (unsigned short)f2bf(oc[d0][r]); }
        asm volatile("s_waitcnt lgkmcnt(0)" ::: "memory");
        bf16* Ow = ONSA + (size_t)(b * SEQ + t0 + 32 * th) * NSA_Q + (g * 4 + hh) * HD;
#pragma unroll
        for (int i = 0; i < 4; ++i) { const int row = i * 8 + (lane >> 3), ch = lane & 7;
            const u32x4 vv = *(const __attribute__((address_space(3))) u32x4*)(stg + row * 64 + ch * 8);
            *(u32x4*)(Ow + (size_t)row * NSA_Q + ch * 8) = vv; }
    }
    asm volatile("s_waitcnt vmcnt(0) lgkmcnt(0)" ::: "memory");
    __syncthreads();
}

__device__ __forceinline__ void nsa_phase(const bf16* PROJ, const bf16* KCBb, const bf16* VCBb, const float* rel, bf16* ONSA, lds_ptr lds3, int vcu, int G) {
    const unsigned lds0 = (unsigned)(uintptr_t)lds3;
    build_ov(lds3);
    __syncthreads();
    int last_g = -1;
#ifndef NSA_REP
#define NSA_REP 1
#endif
#pragma unroll 1
    for (int rep_ = 0; rep_ < NSA_REP; ++rep_)
#pragma unroll 1
    for (int i = vcu; i < 512; i += G) {
        const int k = i & 255, bg = k >> 5, s = k & 31, qt = (i < 256) ? s : 63 - s;
        nsa_unit((bg & 3) != last_g, bg >> 2, bg & 3, qt, PROJ, KCBb, VCBb, rel, ONSA, lds3, lds0);
        last_g = bg & 3;
    }
}
#undef NSA_WAIT_BAR
#undef NSA_SBAR
}
namespace nsa {
constexpr float STICK_THR = 50.f, LN2F = 0.6931471805599453f;
#define NSA_WAIT_BAR(N) asm volatile("s_waitcnt vmcnt(" #N ") lgkmcnt(0)\n\ts_barrier" ::: "memory")
__device__ __forceinline__ void stick_unit(int tid, int b, int h, int qb, const bf16* PROJ, bf16* OSB, lds_ptr lds3, unsigned lds0, const bf16x8 (&tri)[2]) {
    const int lane = tid & 63, r32 = lane & 31, hi = lane >> 5;
    const int wid = __builtin_amdgcn_readfirstlane(tid >> 6);
    const int q0 = qb * 256, t = q0 + 32 * wid + r32;
    const bf16* Kb = PROJ + (size_t)b * SEQ * PLD + C_KB + h * HD;
    const bf16* Vb = PROJ + (size_t)b * SEQ * PLD + C_VB + h * HD;
    __attribute__((address_space(3))) int* DONE = (__attribute__((address_space(3))) int*)(lds3 + L_MISC);
    bf16x8 qr[4];
#pragma unroll
    for (int d0 = 0; d0 < 4; ++d0) qr[d0] = *(const bf16x8*)(PROJ + (size_t)(b * SEQ + t) * PLD + C_QB + h * HD + d0 * 16 + hi * 8);
    if (tid < 8) DONE[tid] = 0x7fffffff;
    asm volatile("s_waitcnt vmcnt(0) lgkmcnt(0)" ::: "memory");
    __syncthreads();
    const int jhi = 4 * qb + 3, NT = jhi + 1;
    const int jw = (q0 + 32 * wid + 30) >> 6;
    const int vboff = ((lane >> 4) & 1) * 32 + (lane & 3) * 8 + (4 * hi + ((lane & 15) >> 2)) * 64;
    f32x16 o[2] = {};
    float carry = 0.f; bool mydone = false;
#define STK_ISSUE(i, slot) do { const int id_ = jhi - (i); \
        const bf16* ks_ = Kb + (size_t)(64 * id_ + lane) * PLD + 8 * wid; \
        const bf16* vs_ = Vb + (size_t)(64 * id_ + 16 * (wid & 3) + (lane >> 2)) * PLD + 32 * (wid >> 2) + 8 * (lane & 3); \
        glds16(ks_, (unsigned)__builtin_amdgcn_readfirstlane(lds0 + L_RING + (slot) * SLOTB + wid * 1024)); \
        glds16(vs_, (unsigned)__builtin_amdgcn_readfirstlane(lds0 + L_RING + (slot) * SLOTB + 8192 + wid * 1024)); } while (0)
    STK_ISSUE(0, 0);
    if (NT > 1) STK_ISSUE(1, 1);
    int slot = 0;
    for (int i = 0; i < NT; ++i) {
        if (i + 1 < NT) NSA_WAIT_BAR(2); else NSA_WAIT_BAR(0);
        bool alld = true;
#pragma unroll
        for (int w = 0; w < 8; ++w) alld = alld && (DONE[w] < i);
        if (__builtin_amdgcn_readfirstlane((int)alld)) break;
        if (i + 2 < NT) { const int s2 = (slot == 0) ? 2 : slot - 1; STK_ISSUE(i + 2, s2); }
        const int j = jhi - i;
        if (!mydone && j <= jw) {
            f32x16 p0, p1, x0, x1;
            qkt(p0, p1, (lds_cptr)(lds3 + L_RING + slot * SLOTB), qr, r32, hi);
            float s0 = 0.f, s1 = 0.f;
#pragma unroll
            for (int r = 0; r < 16; ++r) {
                const int pos0 = 64 * j + crow(r, hi);
                const float z0 = p0[r] * 0.125f, z1 = p1[r] * 0.125f;
                const float L0 = __builtin_amdgcn_logf(1.f + __builtin_amdgcn_exp2f(-fabsf(z0) * LOG2E)) * LN2F;
                const float L1 = __builtin_amdgcn_logf(1.f + __builtin_amdgcn_exp2f(-fabsf(z1) * LOG2E)) * LN2F;
                p0[r] = fminf(z0, 0.f) - L0; p1[r] = fminf(z1, 0.f) - L1;
                x0[r] = (pos0 < t) ? (-fmaxf(z0, 0.f) - L0) : 0.f; x1[r] = (pos0 + 32 < t) ? (-fmaxf(z1, 0.f) - L1) : 0.f;
                s0 += x0[r]; s1 += x1[r];
            }
            const float tot0 = swap_add(s0), tot1 = swap_add(s1);
            u32x4 h0a, h0b, l0a, l0b, h1a, h1b, l1a, l1b;
#define STK_SPLIT(X, HA, HB, LA, LB) do { unsigned hw_[8]; float lo_[16]; \
                _Pragma("unroll") for (int q_ = 0; q_ < 8; ++q_) { hw_[q_] = cvtpk_s(X[2 * q_], X[2 * q_ + 1]); \
                    lo_[2 * q_] = X[2 * q_] - __uint_as_float(hw_[q_] << 16); lo_[2 * q_ + 1] = X[2 * q_ + 1] - __uint_as_float(hw_[q_] & 0xffff0000u); } \
                HA = (u32x4){hw_[0], hw_[1], hw_[2], hw_[3]}; HB = (u32x4){hw_[4], hw_[5], hw_[6], hw_[7]}; \
                LA = (u32x4){cvtpk_s(lo_[0], lo_[1]), cvtpk_s(lo_[2], lo_[3]), cvtpk_s(lo_[4], lo_[5]), cvtpk_s(lo_[6], lo_[7])}; \
                LB = (u32x4){cvtpk_s(lo_[8], lo_[9]), cvtpk_s(lo_[10], lo_[11]), cvtpk_s(lo_[12], lo_[13]), cvtpk_s(lo_[14], lo_[15])}; } while (0)
            STK_SPLIT(x0, h0a, h0b, l0a, l0b);
            STK_SPLIT(x1, h1a, h1b, l1a, l1b);
#undef STK_SPLIT
            f32x16 y0, y1;
#pragma unroll
            for (int r = 0; r < 16; ++r) { y0[r] = carry + tot1; y1[r] = carry; }
            y0 = __builtin_amdgcn_mfma_f32_32x32x16_bf16(tri[0], __builtin_bit_cast(bf16x8, h0a), y0, 0, 0, 0);
            y0 = __builtin_amdgcn_mfma_f32_32x32x16_bf16(tri[1], __builtin_bit_cast(bf16x8, h0b), y0, 0, 0, 0);
            y0 = __builtin_amdgcn_mfma_f32_32x32x16_bf16(tri[0], __builtin_bit_cast(bf16x8, l0a), y0, 0, 0, 0);
            y0 = __builtin_amdgcn_mfma_f32_32x32x16_bf16(tri[1], __builtin_bit_cast(bf16x8, l0b), y0, 0, 0, 0);
            y1 = __builtin_amdgcn_mfma_f32_32x32x16_bf16(tri[0], __builtin_bit_cast(bf16x8, h1a), y1, 0, 0, 0);
            y1 = __builtin_amdgcn_mfma_f32_32x32x16_bf16(tri[1], __builtin_bit_cast(bf16x8, h1b), y1, 0, 0, 0);
            y1 = __builtin_amdgcn_mfma_f32_32x32x16_bf16(tri[0], __builtin_bit_cast(bf16x8, l1a), y1, 0, 0, 0);
            y1 = __builtin_amdgcn_mfma_f32_32x32x16_bf16(tri[1], __builtin_bit_cast(bf16x8, l1b), y1, 0, 0, 0);
#pragma unroll
            for (int r = 0; r < 16; ++r) {
                const int pos0 = 64 * j + crow(r, hi);
                y0[r] = (pos0 < t) ? __builtin_amdgcn_exp2f((p0[r] + y0[r]) * LOG2E) : 0.f;
                y1[r] = (pos0 + 32 < t) ? __builtin_amdgcn_exp2f((p1[r] + y1[r]) * LOG2E) : 0.f;
            }
            carry += tot0 + tot1;
            u32x4 pw0, pw1, pw2, pw3;
            pw0 = (u32x4){cvtpk_s(y0[0], y0[1]), cvtpk_s(y0[2], y0[3]), cvtpk_s(y0[4], y0[5]), cvtpk_s(y0[6], y0[7])};
            pw1 = (u32x4){cvtpk_s(y0[8], y0[9]), cvtpk_s(y0[10], y0[11]), cvtpk_s(y0[12], y0[13]), cvtpk_s(y0[14], y0[15])};
            pw2 = (u32x4){cvtpk_s(y1[0], y1[1]), cvtpk_s(y1[2], y1[3]), cvtpk_s(y1[4], y1[5]), cvtpk_s(y1[6], y1[7])};
            pw3 = (u32x4){cvtpk_s(y1[8], y1[9]), cvtpk_s(y1[10], y1[11]), cvtpk_s(y1[12], y1[13]), cvtpk_s(y1[14], y1[15])};
            __builtin_amdgcn_sched_barrier(0);
            pv(o, (int)(lds0 + L_RING + slot * SLOTB + 8192) + vboff, __builtin_bit_cast(bf16x8, pw0), __builtin_bit_cast(bf16x8, pw1), __builtin_bit_cast(bf16x8, pw2), __builtin_bit_cast(bf16x8, pw3));
            mydone = __all(carry < -STICK_THR) != 0;
            if (mydone && lane == 0) DONE[wid] = i;
        }
        slot = (slot == 2) ? 0 : slot + 1;
    }
    asm volatile("s_waitcnt vmcnt(0) lgkmcnt(0)\n\ts_barrier" ::: "memory");
#undef STK_ISSUE
    {
        __attribute__((address_space(3))) unsigned short* stg = (__attribute__((address_space(3))) unsigned short*)(lds3 + L_X) + wid * 2048;
#pragma unroll
        for (int r = 0; r < 16; ++r) { const int orow = crow(r, hi);
#pragma unroll
            for (int d0 = 0; d0 < 2; ++d0) stg[orow * 64 + d0 * 32 + r32] = (unsigned short)f2bf(o[d0][r]); }
        asm volatile("s_waitcnt lgkmcnt(0)" ::: "memory");
        bf16* Ow = OSB + (size_t)(b * SEQ + q0 + 32 * wid) * SB_W + h * HD;
#pragma unroll
        for (int i = 0; i < 4; ++i) { const int row = i * 8 + (lane >> 3), ch = lane & 7;
            const u32x4 vv = *(const __attribute__((address_space(3))) u32x4*)(stg + row * 64 + ch * 8);
            *(u32x4*)(Ow + (size_t)row * SB_W + ch * 8) = vv; }
    }
    asm volatile("s_waitcnt vmcnt(0) lgkmcnt(0)" ::: "memory");
    __syncthreads();
}
__device__ __forceinline__ void stick_phase(const bf16* PROJ, bf16* OSB, lds_ptr lds3, int vcu, int G) {
    const unsigned lds0 = (unsigned)(uintptr_t)lds3;
    int tid = threadIdx.x; asm volatile("" : "+v"(tid));
    const int lane = tid & 63, r32 = lane & 31, hi = lane >> 5;
    bf16x8 tri[2];
#pragma unroll
    for (int s = 0; s < 2; ++s)
#pragma unroll
        for (int j = 0; j < 8; ++j) tri[s][j] = ((16 * s + 8 * (j >> 2) + 4 * hi + (j & 3)) > r32) ? (short)0x3F80 : (short)0;
    for (int i = vcu; i < 512; i += G) {
        const int bh = i >> 4, qb = i & 15;
        stick_unit(tid, bh >> 4, bh & 15, qb, PROJ, OSB, lds3, lds0, tri);
    }
}
#undef NSA_WAIT_BAR
}
namespace peer {
typedef short bf16x8 __attribute__((ext_vector_type(8)));
typedef float f32x16 __attribute__((ext_vector_type(16)));
typedef __bf16 b2_t __attribute__((ext_vector_type(2)));
constexpr int L_EX = 0, L_GT = 16384;
__device__ __forceinline__ int crow(int r, int hi) { return (r & 3) + 8 * (r >> 2) + 4 * hi; }
__device__ __forceinline__ unsigned mono(float f) { const unsigned u = __float_as_uint(f); return (u & 0x80000000u) ? ~u : (u | 0x80000000u); }
__device__ __forceinline__ float unmono(unsigned k) { return __uint_as_float((k & 0x80000000u) ? (k & 0x7fffffffu) : ~k); }
__device__ __forceinline__ float dot2(unsigned a, unsigned b, float c) { return __builtin_amdgcn_fdot2_f32_bf16(__builtin_bit_cast(b2_t, a), __builtin_bit_cast(b2_t, b), c, false); }
#define PEER_CE(key, slot) do { const unsigned hi_ = (key) > (slot) ? (key) : (slot); (key) = (key) > (slot) ? (slot) : (key); (slot) = hi_; } while (0)

__device__ __forceinline__ void route_list(const bf16* QP, const bf16* SKB, int L, int tok0, int r32, int hi, unsigned (&out)[16]) {
    f32x16 acc[4] = {};
    const bf16* qp = QP + (size_t)(tok0 + r32) * 2048 + L * 128 + hi * 8;
    const bf16* kp = SKB + ((size_t)L * 128 + r32) * 128 + hi * 8;
    int hi4 = 4 * hi;
    asm volatile("" : "+v"(qp), "+v"(kp), "+v"(hi4));
#pragma unroll
    for (int ks = 0; ks < 8; ++ks) {
        const bf16x8 bq = *(const bf16x8*)(qp + ks * 16);
#pragma unroll
        for (int kt = 0; kt < 4; ++kt) { const bf16x8 a = *(const bf16x8*)(kp + (size_t)kt * 32 * 128 + ks * 16); acc[kt] = __builtin_amdgcn_mfma_f32_32x32x16_bf16(a, bq, acc[kt], 0, 0, 0); }
    }
    unsigned t[16];
#pragma unroll
    for (int k = 0; k < 16; ++k) t[k] = 0u;
#pragma unroll
    for (int kt = 0; kt < 4; ++kt)
#pragma unroll
        for (int r = 0; r < 16; ++r) {
            unsigned key = ((mono(acc[kt][r]) & ~127u) | (unsigned)(127 - (32 * kt + (r & 3) + 8 * (r >> 2)))) - (unsigned)hi4;
#pragma unroll
            for (int k = 0; k < 16; ++k) PEER_CE(key, t[k]);
            __builtin_amdgcn_sched_barrier(0);
        }
    unsigned u[16];
#pragma unroll
    for (int k = 0; k < 16; ++k) { auto rr = __builtin_amdgcn_permlane32_swap(t[k], t[k], false, false); u[k] = hi ? rr[0] : rr[1]; }
#pragma unroll
    for (int k = 0; k < 16; ++k) out[k] = t[k] > u[15 - k] ? t[k] : u[15 - k];
#pragma unroll
    for (int st = 8; st >= 1; st >>= 1)
#pragma unroll
        for (int k = 0; k < 16; ++k) if ((k & st) == 0) { const unsigned a = out[k], b = out[k | st]; out[k] = a > b ? a : b; out[k | st] = a > b ? b : a; }
}

__device__ __forceinline__ void route_head(const bf16* QP, const bf16* SKB, int h, int tok0, int lane, __attribute__((address_space(3))) unsigned char* lds3) {
    asm volatile("" : "+v"(lane));
    const int r32 = lane & 31, hi = lane >> 5;
    unsigned A[16], B[16];
    route_list(QP, SKB, 2 * h, tok0, r32, hi, A);
    route_list(QP, SKB, 2 * h + 1, tok0, r32, hi, B);
    float va[16], vb[16]; int ia[16], ib[16];
#pragma unroll
    for (int k = 0; k < 16; ++k) { va[k] = unmono((A[k] & ~127u) | 64u); vb[k] = unmono((B[k] & ~127u) | 64u); ia[k] = 127 - (int)(A[k] & 127u); ib[k] = 127 - (int)(B[k] & 127u); }
    unsigned s[16], sp[16];
#pragma unroll
    for (int k = 0; k < 16; ++k) { s[k] = 0u; sp[k] = 0u; }
#pragma unroll
    for (int i = 0; i < 16; ++i)
#pragma unroll
        for (int j = 0; j < 16; ++j) if ((i + 1) * (j + 1) <= 16) {
            unsigned key = mono(va[i] + vb[j]); unsigned pay = (unsigned)(ia[i] * PEER_KEYS + ib[j]);
#pragma unroll
            for (int k = (i + 1) * (j + 1) - 1; k < 16; ++k) { const bool gt = key > s[k]; const unsigned ts = s[k], tp = sp[k]; s[k] = gt ? key : ts; sp[k] = gt ? pay : tp; key = gt ? ts : key; pay = gt ? tp : pay; }
            __builtin_amdgcn_sched_barrier(0);
        }
    const float mx = unmono(s[0]);
    float e[16], sum = 0.f;
#pragma unroll
    for (int k = 0; k < 16; ++k) { e[k] = __expf(unmono(s[k]) - mx); sum += e[k]; }
    const float inv = 1.f / sum;
    if (hi == 0) {
        __attribute__((address_space(3))) int* EX = (__attribute__((address_space(3))) int*)(lds3 + L_EX);
        __attribute__((address_space(3))) float* GT = (__attribute__((address_space(3))) float*)(lds3 + L_GT);
#pragma unroll
        for (int k = 0; k < 16; ++k) { EX[(h * 16 + k) * 32 + r32] = (int)sp[k]; GT[(h * 16 + k) * 32 + r32] = e[k] * inv; }
    }
}

__device__ __forceinline__ void cvt_row_fp8(const float* src, unsigned char* dst, float* inv_scale, int row, int lane) {
    const float* p = src + (size_t)row * 2048 + lane * 16;
    f32x4 v[8]; float am = 0.f;
#pragma unroll
    for (int j = 0; j < 2; ++j)
#pragma unroll
        for (int c = 0; c < 4; ++c) { v[4 * j + c] = *(const f32x4*)(p + j * 1024 + 4 * c);
            am = fmaxf(am, fmaxf(fmaxf(fabsf(v[4 * j + c].x), fabsf(v[4 * j + c].y)), fmaxf(fabsf(v[4 * j + c].z), fabsf(v[4 * j + c].w)))); }
    am = wave_max(am);
    const float sc = am > 0.f ? 384.f / am : 1.f;
#pragma unroll
    for (int j = 0; j < 2; ++j) { v4u o;
#pragma unroll
        for (int c = 0; c < 4; ++c) { int w = 0; w = __builtin_amdgcn_cvt_pk_fp8_f32(v[4 * j + c].x * sc, v[4 * j + c].y * sc, w, false); w = __builtin_amdgcn_cvt_pk_fp8_f32(v[4 * j + c].z * sc, v[4 * j + c].w * sc, w, true); o[c] = (unsigned)w; }
        *(v4u*)(dst + (size_t)row * 2048 + j * 1024 + lane * 16) = o; }
    if (lane == 0) inv_scale[row] = am > 0.f ? am / 384.f : 1.f;
}
typedef float f32x2v __attribute__((ext_vector_type(2)));
__device__ __forceinline__ unsigned cvtpk_bf(float lo, float hi) { typedef __bf16 b2v __attribute__((ext_vector_type(2))); f32x2v v = {lo, hi}; b2v b = __builtin_convertvector(v, b2v); return __builtin_bit_cast(unsigned, b); }
__device__ __forceinline__ float dot32_fp8(const unsigned (&x)[16], v4u q0, v4u q1) {
    float d = 0.f;
#pragma unroll
    for (int c = 0; c < 4; ++c) { const int w0 = (int)q0[c], w1 = (int)q1[c];
        const f32x2v a = __builtin_amdgcn_cvt_pk_f32_fp8(w0, false), b = __builtin_amdgcn_cvt_pk_f32_fp8(w0, true), e = __builtin_amdgcn_cvt_pk_f32_fp8(w1, false), f = __builtin_amdgcn_cvt_pk_f32_fp8(w1, true);
        d = dot2(x[2 * c + 0], cvtpk_bf(a.x, a.y), d); d = dot2(x[2 * c + 1], cvtpk_bf(b.x, b.y), d);
        d = dot2(x[8 + 2 * c + 0], cvtpk_bf(e.x, e.y), d); d = dot2(x[8 + 2 * c + 1], cvtpk_bf(f.x, f.y), d); }
    return d;
}
__device__ __forceinline__ void axpy32_fp8(float (&acc)[32], float w, v4u q0, v4u q1) {
#pragma unroll
    for (int c = 0; c < 4; ++c) { const int w0 = (int)q0[c], w1 = (int)q1[c];
        const f32x2v a = __builtin_amdgcn_cvt_pk_f32_fp8(w0, false), b = __builtin_amdgcn_cvt_pk_f32_fp8(w0, true), e = __builtin_amdgcn_cvt_pk_f32_fp8(w1, false), f = __builtin_amdgcn_cvt_pk_f32_fp8(w1, true);
        acc[4 * c + 0] += w * a.x; acc[4 * c + 1] += w * a.y; acc[4 * c + 2] += w * b.x; acc[4 * c + 3] += w * b.y;
        acc[16 + 4 * c + 0] += w * e.x; acc[16 + 4 * c + 1] += w * e.y; acc[16 + 4 * c + 2] += w * f.x; acc[16 + 4 * c + 3] += w * f.y; }
}
#if defined(PROBE_NOSORT)
constexpr int PEER_SORT_N = 1;
#else
constexpr int PEER_SORT_N = 512;
#endif
constexpr int L_SK = 32768, L_W = 49152;

__device__ __forceinline__ void ffn_wave(int tok0, int wid, int lane, const float* H, const float* SS, const float* gffn, const unsigned char* U8, const unsigned char* V8,
                                         const float* IU, const float* IV, const float* gfin, float* out, __attribute__((address_space(3))) unsigned char* lds3, unsigned rot) {
    asm volatile("" : "+v"(lane));
    const __attribute__((address_space(3))) int* EX = (const __attribute__((address_space(3))) int*)(lds3 + L_EX);
    const __attribute__((address_space(3))) float* GT = (const __attribute__((address_space(3))) float*)(lds3 + L_GT);
    __attribute__((address_space(3))) unsigned* SK = (__attribute__((address_space(3))) unsigned*)(lds3 + L_SK) + wid * 512;
    __attribute__((address_space(3))) float* WW = (__attribute__((address_space(3))) float*)(lds3 + L_W) + wid * 512;
#pragma unroll
    for (int i = 0; i < 8; ++i) { const int p = lane + 64 * i; const unsigned e = (unsigned)EX[(p & 127) * 32 + 4 * wid + (p >> 7)]; SK[p] = (((e - rot) & 16383u) << 9) | (unsigned)p; }
    asm volatile("s_waitcnt lgkmcnt(0)" ::: "memory");
#pragma unroll 1
    for (int k = 2; k <= PEER_SORT_N; k <<= 1)
#pragma unroll 1
        for (int j = k >> 1; j > 0; j >>= 1) {
#pragma unroll
            for (int t = 0; t < 4; ++t) { const int mth = lane + 64 * t; const int i = ((mth & ~(j - 1)) << 1) | (mth & (j - 1)); const int pr = i | j;
                const unsigned a = SK[i], b = SK[pr]; const bool asc = (i & k) == 0; const bool sw = (a > b) == asc;
                SK[i] = sw ? b : a; SK[pr] = sw ? a : b; }
            asm volatile("s_waitcnt lgkmcnt(0)" ::: "memory");
        }
    unsigned x0[16], x1[16], x2[16], x3[16];
#define PEER_LOADX(XR, TK) do { const int n_ = tok0 + 4 * wid + (TK); const float rs_ = rsqrtf(SS[n_] * (1.f / D_MODEL) + EPS); \
        _Pragma("unroll") for (int j = 0; j < 2; ++j) _Pragma("unroll") for (int c = 0; c < 4; ++c) { \
            const f32x4 hv_ = *(const f32x4*)(H + (size_t)n_ * 2048 + j * 1024 + lane * 16 + 4 * c), gv_ = *(const f32x4*)(gffn + j * 1024 + lane * 16 + 4 * c); \
            XR[8 * j + 2 * c + 0] = pk2(hv_.x * rs_ * gv_.x, hv_.y * rs_ * gv_.y); XR[8 * j + 2 * c + 1] = pk2(hv_.z * rs_ * gv_.z, hv_.w * rs_ * gv_.w); } } while (0)
    PEER_LOADX(x0, 0); __builtin_amdgcn_sched_barrier(0); PEER_LOADX(x1, 1); __builtin_amdgcn_sched_barrier(0); PEER_LOADX(x2, 2); __builtin_amdgcn_sched_barrier(0); PEER_LOADX(x3, 3); __builtin_amdgcn_sched_barrier(0);
#undef PEER_LOADX
    const bool b5 = (lane & 32) != 0, b4 = (lane & 16) != 0;
#pragma unroll 1
    for (int i0 = 0; i0 < 512; i0 += 4) {
        int e[4], p[4]; v4u q0[4], q1[4];
#pragma unroll
        for (int k = 0; k < 4; ++k) { const unsigned key = (unsigned)__builtin_amdgcn_readfirstlane((int)SK[i0 + k]); e[k] = (int)(((key >> 9) + rot) & 16383u); p[k] = (int)(key & 511u);
            const unsigned char* ur = U8 + (size_t)e[k] * 2048 + lane * 16; q0[k] = *(const v4u*)ur; q1[k] = *(const v4u*)(ur + 1024); }
        float d[4];
#pragma unroll
        for (int k = 0; k < 4; ++k) { const int tk = p[k] >> 7; d[k] = 0.f;
            if (tk == 0) d[k] = dot32_fp8(x0, q0[k], q1[k]);
            if (tk == 1) d[k] = dot32_fp8(x1, q0[k], q1[k]);
            if (tk == 2) d[k] = dot32_fp8(x2, q0[k], q1[k]);
            if (tk == 3) d[k] = dot32_fp8(x3, q0[k], q1[k]); }
        float a01 = (b5 ? d[1] : d[0]) + __shfl_xor(b5 ? d[0] : d[1], 32);
        float a23 = (b5 ? d[3] : d[2]) + __shfl_xor(b5 ? d[2] : d[3], 32);
        float t = (b4 ? a23 : a01) + __shfl_xor(b4 ? a01 : a23, 16);
        t += __shfl_xor(t, 8); t += __shfl_xor(t, 4); t += __shfl_xor(t, 2); t += __shfl_xor(t, 1);
        float iu[4], iv[4], gt[4];
#pragma unroll
        for (int k = 0; k < 4; ++k) { iu[k] = IU[e[k]]; iv[k] = IV[e[k]]; gt[k] = GT[(p[k] & 127) * 32 + 4 * wid + (p[k] >> 7)]; }
        const float ius = b5 ? (b4 ? iu[3] : iu[1]) : (b4 ? iu[2] : iu[0]);
        const float ivs = b5 ? (b4 ? iv[3] : iv[1]) : (b4 ? iv[2] : iv[0]);
        const float gts = b5 ? (b4 ? gt[3] : gt[1]) : (b4 ? gt[2] : gt[0]);
        const int ksel = b5 ? (b4 ? 3 : 1) : (b4 ? 2 : 0);
        const float wv = gts * gelu_tanh(t * ius) * ivs;
        if ((lane & 15) == 0) WW[i0 + ksel] = wv;
    }
    asm volatile("s_waitcnt lgkmcnt(0)" ::: "memory");
    float a0[32], a1[32], a2[32], a3[32];
#pragma unroll
    for (int j = 0; j < 32; ++j) { a0[j] = 0.f; a1[j] = 0.f; a2[j] = 0.f; a3[j] = 0.f; }
#pragma unroll 1
    for (int i0 = 0; i0 < 512; i0 += 2) {
        int p[2]; float w[2]; v4u q0[2], q1[2];
#pragma unroll
        for (int k = 0; k < 2; ++k) { const unsigned key = (unsigned)__builtin_amdgcn_readfirstlane((int)SK[i0 + k]); const int e = (int)(((key >> 9) + rot) & 16383u); p[k] = (int)(key & 511u);
            w[k] = __uint_as_float(__builtin_amdgcn_readfirstlane(__float_as_uint(WW[i0 + k])));
            const unsigned char* vr = V8 + (size_t)e * 2048 + lane * 16; q0[k] = *(const v4u*)vr; q1[k] = *(const v4u*)(vr + 1024); }
#pragma unroll
        for (int k = 0; k < 2; ++k) { const int tk = p[k] >> 7;
            const float w0 = tk == 0 ? w[k] : 0.f, w1 = tk == 1 ? w[k] : 0.f, w2 = tk == 2 ? w[k] : 0.f, w3 = tk == 3 ? w[k] : 0.f;
#pragma unroll
            for (int c = 0; c < 4; ++c) { const int u0 = (int)q0[k][c], u1 = (int)q1[k][c];
                const f32x2v a = __builtin_amdgcn_cvt_pk_f32_fp8(u0, false), b = __builtin_amdgcn_cvt_pk_f32_fp8(u0, true), e = __builtin_amdgcn_cvt_pk_f32_fp8(u1, false), f = __builtin_amdgcn_cvt_pk_f32_fp8(u1, true);
#define PEER_AX(AR, WT) AR[4 * c + 0] += WT * a.x; AR[4 * c + 1] += WT * a.y; AR[4 * c + 2] += WT * b.x; AR[4 * c + 3] += WT * b.y; AR[16 + 4 * c + 0] += WT * e.x; AR[16 + 4 * c + 1] += WT * e.y; AR[16 + 4 * c + 2] += WT * f.x; AR[16 + 4 * c + 3] += WT * f.y;
                PEER_AX(a0, w0) PEER_AX(a1, w1) PEER_AX(a2, w2) PEER_AX(a3, w3)
#undef PEER_AX
            } }
    }
#define PEER_FIN(AR, TK) do { const int n_ = tok0 + 4 * wid + (TK); float sq_ = 0.f; \
        _Pragma("unroll") for (int j = 0; j < 2; ++j) _Pragma("unroll") for (int c = 0; c < 4; ++c) { const f32x4 hv_ = *(const f32x4*)(H + (size_t)n_ * 2048 + j * 1024 + lane * 16 + 4 * c); \
            AR[16 * j + 4 * c + 0] += hv_.x; AR[16 * j + 4 * c + 1] += hv_.y; AR[16 * j + 4 * c + 2] += hv_.z; AR[16 * j + 4 * c + 3] += hv_.w; } \
        _Pragma("unroll") for (int j = 0; j < 32; ++j) sq_ += AR[j] * AR[j]; \
        const float r_ = rsqrtf(wave_sum(sq_) * (1.f / D_MODEL) + EPS); \
        _Pragma("unroll") for (int j = 0; j < 2; ++j) _Pragma("unroll") for (int c = 0; c < 4; ++c) { const f32x4 gv_ = *(const f32x4*)(gfin + j * 1024 + lane * 16 + 4 * c); \
            *(f32x4*)(out + (size_t)n_ * 2048 + j * 1024 + lane * 16 + 4 * c) = (f32x4){AR[16 * j + 4 * c + 0] * r_ * gv_.x, AR[16 * j + 4 * c + 1] * r_ * gv_.y, AR[16 * j + 4 * c + 2] * r_ * gv_.z, AR[16 * j + 4 * c + 3] * r_ * gv_.w}; } } while (0)
    asm volatile("" : "+v"(lane));
    PEER_FIN(a0, 0); __builtin_amdgcn_sched_barrier(0); PEER_FIN(a1, 1); __builtin_amdgcn_sched_barrier(0); PEER_FIN(a2, 2); __builtin_amdgcn_sched_barrier(0); PEER_FIN(a3, 3);
#undef PEER_FIN
}

__device__ __forceinline__ void ffn_token8(int n, int tl, int lane, const float* H, const float* SS, const float* gffn, const unsigned char* U8, const unsigned char* V8,
                                           const float* IU, const float* IV, const float* gfin, float* out, __attribute__((address_space(3))) unsigned char* lds3) {
    const __attribute__((address_space(3))) int* EX = (const __attribute__((address_space(3))) int*)(lds3 + L_EX);
    const __attribute__((address_space(3))) float* GT = (const __attribute__((address_space(3))) float*)(lds3 + L_GT);
    unsigned xq[16];
    { const float rs_ = rsqrtf(SS[n] * (1.f / D_MODEL) + EPS);
#pragma unroll
      for (int j = 0; j < 2; ++j)
#pragma unroll
        for (int c = 0; c < 4; ++c) { const f32x4 hv_ = *(const f32x4*)(H + (size_t)n * 2048 + j * 1024 + lane * 16 + 4 * c), gv_ = *(const f32x4*)(gffn + j * 1024 + lane * 16 + 4 * c);
            xq[8 * j + 2 * c + 0] = pk2(hv_.x * rs_ * gv_.x, hv_.y * rs_ * gv_.y); xq[8 * j + 2 * c + 1] = pk2(hv_.z * rs_ * gv_.z, hv_.w * rs_ * gv_.w); } }
    float acc[32];
#pragma unroll
    for (int j = 0; j < 32; ++j) acc[j] = 0.f;
    const bool b5 = (lane & 32) != 0, b4 = (lane & 16) != 0;
#pragma unroll 1
    for (int e0 = 0; e0 < PEER_E; e0 += 4) {
        int ei[4]; float gt[4], iu[4], iv[4]; v4u u0[4], u1[4], v0[4], v1[4];
#pragma unroll
        for (int k = 0; k < 4; ++k) { ei[k] = __builtin_amdgcn_readfirstlane(EX[(e0 + k) * 32 + tl]); gt[k] = GT[(e0 + k) * 32 + tl];
            const unsigned char* ur = U8 + (size_t)ei[k] * 2048 + lane * 16; u0[k] = *(const v4u*)ur; u1[k] = *(const v4u*)(ur + 1024);
            const unsigned char* vr = V8 + (size_t)ei[k] * 2048 + lane * 16; v0[k] = *(const v4u*)vr; v1[k] = *(const v4u*)(vr + 1024);
            iu[k] = IU[ei[k]]; iv[k] = IV[ei[k]]; }
        float d[4];
#pragma unroll
        for (int k = 0; k < 4; ++k) d[k] = dot32_fp8(xq, u0[k], u1[k]);
        float a01 = (b5 ? d[1] : d[0]) + __shfl_xor(b5 ? d[0] : d[1], 32);
        float a23 = (b5 ? d[3] : d[2]) + __shfl_xor(b5 ? d[2] : d[3], 32);
        float t = (b4 ? a23 : a01) + __shfl_xor(b4 ? a01 : a23, 16);
        t += __shfl_xor(t, 8); t += __shfl_xor(t, 4); t += __shfl_xor(t, 2); t += __shfl_xor(t, 1);
        const float ius = b5 ? (b4 ? iu[3] : iu[1]) : (b4 ? iu[2] : iu[0]);
        const float ivs = b5 ? (b4 ? iv[3] : iv[1]) : (b4 ? iv[2] : iv[0]);
        const float gts = b5 ? (b4 ? gt[3] : gt[1]) : (b4 ? gt[2] : gt[0]);
        const float wv = gts * gelu_tanh(t * ius) * ivs;
        float w[4];
        w[0] = __uint_as_float(__builtin_amdgcn_readlane(__float_as_uint(wv), 0));
        w[2] = __uint_as_float(__builtin_amdgcn_readlane(__float_as_uint(wv), 16));
        w[1] = __uint_as_float(__builtin_amdgcn_readlane(__float_as_uint(wv), 32));
        w[3] = __uint_as_float(__builtin_amdgcn_readlane(__float_as_uint(wv), 48));
#pragma unroll
        for (int k = 0; k < 4; ++k) axpy32_fp8(acc, w[k], v0[k], v1[k]);
    }
    float sq = 0.f;
#pragma unroll
    for (int j = 0; j < 2; ++j)
#pragma unroll
        for (int c = 0; c < 4; ++c) { const f32x4 hv_ = *(const f32x4*)(H + (size_t)n * 2048 + j * 1024 + lane * 16 + 4 * c);
            acc[16 * j + 4 * c + 0] += hv_.x; acc[16 * j + 4 * c + 1] += hv_.y; acc[16 * j + 4 * c + 2] += hv_.z; acc[16 * j + 4 * c + 3] += hv_.w; }
#pragma unroll
    for (int j = 0; j < 32; ++j) sq += acc[j] * acc[j];
    const float r_ = rsqrtf(wave_sum(sq) * (1.f / D_MODEL) + EPS);
#pragma unroll
    for (int j = 0; j < 2; ++j)
#pragma unroll
        for (int c = 0; c < 4; ++c) { const f32x4 gv_ = *(const f32x4*)(gfin + j * 1024 + lane * 16 + 4 * c);
            *(f32x4*)(out + (size_t)n * 2048 + j * 1024 + lane * 16 + 4 * c) = (f32x4){acc[16 * j + 4 * c + 0] * r_ * gv_.x, acc[16 * j + 4 * c + 1] * r_ * gv_.y, acc[16 * j + 4 * c + 2] * r_ * gv_.z, acc[16 * j + 4 * c + 3] * r_ * gv_.w}; }
}

#ifndef FP6_IDX
#define FP6_IDX(i) (((i) & 1) ? 16 + ((i) >> 1) : ((i) >> 1))
#endif
typedef float v16f_t __attribute__((ext_vector_type(16)));
typedef float v32f_t __attribute__((ext_vector_type(32)));
typedef unsigned v6u_t __attribute__((ext_vector_type(6)));
__device__ __forceinline__ void cvt_row_fp6(const float* src, unsigned char* dst, float* inv_scale, int row, int lane) {
    const float* p = src + (size_t)row * 2048 + lane * 16;
    f32x4 v[8]; float am = 0.f;
#pragma unroll
    for (int j = 0; j < 2; ++j)
#pragma unroll
        for (int c = 0; c < 4; ++c) { v[4 * j + c] = *(const f32x4*)(p + j * 1024 + 4 * c);
            am = fmaxf(am, fmaxf(fmaxf(fabsf(v[4 * j + c].x), fabsf(v[4 * j + c].y)), fmaxf(fabsf(v[4 * j + c].z), fabsf(v[4 * j + c].w)))); }
    am = wave_max(am);
    const float sc = am > 0.f ? 7.f / am : 1.f;
    v16f_t a, b;
#pragma unroll
    for (int c = 0; c < 4; ++c) { a[4 * c + 0] = v[c].x * sc; a[4 * c + 1] = v[c].y * sc; a[4 * c + 2] = v[c].z * sc; a[4 * c + 3] = v[c].w * sc;
        b[4 * c + 0] = v[4 + c].x * sc; b[4 * c + 1] = v[4 + c].y * sc; b[4 * c + 2] = v[4 + c].z * sc; b[4 * c + 3] = v[4 + c].w * sc; }
    const v6u_t q = __builtin_amdgcn_cvt_scalef32_2xpk16_fp6_f32(a, b, 1.0f);
    unsigned char* d = dst + (size_t)row * 1536;
    *(v4u*)(d + lane * 16) = (v4u){q[0], q[1], q[2], q[3]};
    *(v2u*)(d + 1024 + lane * 8) = (v2u){q[4], q[5]};
    if (lane == 0) inv_scale[row] = am > 0.f ? am / 7.f : 1.f;
}
__device__ __forceinline__ void ffn_token6(int n, int tl, int lane, const float* H, const float* SS, const float* gffn, const unsigned char* U6, const unsigned char* V6,
                                           const float* IU, const float* IV, const float* gfin, float* out, __attribute__((address_space(3))) unsigned char* lds3) {
    const __attribute__((address_space(3))) int* EX = (const __attribute__((address_space(3))) int*)(lds3 + L_EX);
    const __attribute__((address_space(3))) float* GT = (const __attribute__((address_space(3))) float*)(lds3 + L_GT);
    float xf[32];
    { const float rs_ = rsqrtf(SS[n] * (1.f / D_MODEL) + EPS);
#pragma unroll
      for (int j = 0; j < 2; ++j)
#pragma unroll
        for (int c = 0; c < 4; ++c) { const f32x4 hv_ = *(const f32x4*)(H + (size_t)n * 2048 + j * 1024 + lane * 16 + 4 * c), gv_ = *(const f32x4*)(gffn + j * 1024 + lane * 16 + 4 * c);
            xf[16 * j + 4 * c + 0] = hv_.x * rs_ * gv_.x; xf[16 * j + 4 * c + 1] = hv_.y * rs_ * gv_.y; xf[16 * j + 4 * c + 2] = hv_.z * rs_ * gv_.z; xf[16 * j + 4 * c + 3] = hv_.w * rs_ * gv_.w; } }
    float acc[32];
#pragma unroll
    for (int j = 0; j < 32; ++j) acc[j] = 0.f;
    const bool b5 = (lane & 32) != 0, b4 = (lane & 16) != 0;
#pragma unroll 1
    for (int e0 = 0; e0 < PEER_E; e0 += 4) {
        int ei[4]; float gt[4], iu[4], iv[4]; v4u ua[4], va[4]; v2u ub[4], vb[4];
#pragma unroll
        for (int k = 0; k < 4; ++k) { ei[k] = __builtin_amdgcn_readfirstlane(EX[(e0 + k) * 32 + tl]); gt[k] = GT[(e0 + k) * 32 + tl];
            const unsigned char* ur = U6 + (size_t)ei[k] * 1536; ua[k] = *(const v4u*)(ur + lane * 16); ub[k] = *(const v2u*)(ur + 1024 + lane * 8);
            const unsigned char* vr = V6 + (size_t)ei[k] * 1536; va[k] = *(const v4u*)(vr + lane * 16); vb[k] = *(const v2u*)(vr + 1024 + lane * 8);
            iu[k] = IU[ei[k]]; iv[k] = IV[ei[k]]; }
        float d[4];
#pragma unroll
        for (int k = 0; k < 4; ++k) { const v6u_t q = {ua[k].x, ua[k].y, ua[k].z, ua[k].w, ub[k].x, ub[k].y}; const v32f_t f = __builtin_amdgcn_cvt_scalef32_pk32_f32_fp6(q, 1.0f);
            float dk = 0.f;
#pragma unroll
            for (int i = 0; i < 32; ++i) dk += xf[FP6_IDX(i)] * f[i];
            d[k] = dk; __builtin_amdgcn_sched_barrier(0); }
        float a01 = (b5 ? d[1] : d[0]) + __shfl_xor(b5 ? d[0] : d[1], 32);
        float a23 = (b5 ? d[3] : d[2]) + __shfl_xor(b5 ? d[2] : d[3], 32);
        float t = (b4 ? a23 : a01) + __shfl_xor(b4 ? a01 : a23, 16);
        t += __shfl_xor(t, 8); t += __shfl_xor(t, 4); t += __shfl_xor(t, 2); t += __shfl_xor(t, 1);
        const float ius = b5 ? (b4 ? iu[3] : iu[1]) : (b4 ? iu[2] : iu[0]);
        const float ivs = b5 ? (b4 ? iv[3] : iv[1]) : (b4 ? iv[2] : iv[0]);
        const float gts = b5 ? (b4 ? gt[3] : gt[1]) : (b4 ? gt[2] : gt[0]);
        const float wv = gts * gelu_tanh(t * ius) * ivs;
        float w[4];
        w[0] = __uint_as_float(__builtin_amdgcn_readlane(__float_as_uint(wv), 0));
        w[2] = __uint_as_float(__builtin_amdgcn_readlane(__float_as_uint(wv), 16));
        w[1] = __uint_as_float(__builtin_amdgcn_readlane(__float_as_uint(wv), 32));
        w[3] = __uint_as_float(__builtin_amdgcn_readlane(__float_as_uint(wv), 48));
#pragma unroll
        for (int k = 0; k < 4; ++k) { const v6u_t q = {va[k].x, va[k].y, va[k].z, va[k].w, vb[k].x, vb[k].y}; const v32f_t f = __builtin_amdgcn_cvt_scalef32_pk32_f32_fp6(q, 1.0f);
#pragma unroll
            for (int i = 0; i < 32; ++i) acc[FP6_IDX(i)] += w[k] * f[i]; __builtin_amdgcn_sched_barrier(0); }
    }
    float sq = 0.f;
#pragma unroll
    for (int j = 0; j < 2; ++j)
#pragma unroll
        for (int c = 0; c < 4; ++c) { const f32x4 hv_ = *(const f32x4*)(H + (size_t)n * 2048 + j * 1024 + lane * 16 + 4 * c);
            acc[16 * j + 4 * c + 0] += hv_.x; acc[16 * j + 4 * c + 1] += hv_.y; acc[16 * j + 4 * c + 2] += hv_.z; acc[16 * j + 4 * c + 3] += hv_.w; }
#pragma unroll
    for (int j = 0; j < 32; ++j) sq += acc[j] * acc[j];
    const float r_ = rsqrtf(wave_sum(sq) * (1.f / D_MODEL) + EPS);
#pragma unroll
    for (int j = 0; j < 2; ++j)
#pragma unroll
        for (int c = 0; c < 4; ++c) { const f32x4 gv_ = *(const f32x4*)(gfin + j * 1024 + lane * 16 + 4 * c);
            *(f32x4*)(out + (size_t)n * 2048 + j * 1024 + lane * 16 + 4 * c) = (f32x4){acc[16 * j + 4 * c + 0] * r_ * gv_.x, acc[16 * j + 4 * c + 1] * r_ * gv_.y, acc[16 * j + 4 * c + 2] * r_ * gv_.z, acc[16 * j + 4 * c + 3] * r_ * gv_.w}; }
}

__device__ __forceinline__ void peer_phase(const bf16* QP, const bf16* SKB, const float* H, const float* SS, const float* gffn, const unsigned char* U8, const unsigned char* V8, const float* IU, const float* IV,
                                           const float* gfin, float* out, __attribute__((address_space(3))) unsigned char* lds3, int bid, int G) {
    int tid = threadIdx.x; asm volatile("" : "+v"(tid));
    const int lane = tid & 63, wid = __builtin_amdgcn_readfirstlane(tid >> 6);
    const unsigned rot = (xb_xcc_id() & 7u) * 2048u;
    for (int unit = bid; unit < NTOK / 32; unit += G) {
        const int tok0 = unit * 32;
        route_head(QP, SKB, wid, tok0, lane, lds3);
        asm volatile("s_waitcnt lgkmcnt(0)" ::: "memory"); __syncthreads();
#if defined(PEER_SORTED_SWEEPS)
        ffn_wave(tok0, wid, lane, H, SS, gffn, U8, V8, IU, IV, gfin, out, lds3, rot);
#else
        { int ln = lane; asm volatile("" : "+v"(ln));
#pragma unroll 1
#if defined(PEER_FP8)
          for (int tk = 0; tk < 4; ++tk) ffn_token8(tok0 + wid * 4 + tk, wid * 4 + tk, ln, H, SS, gffn, U8, V8, IU, IV, gfin, out, lds3); }
#else
          for (int tk = 0; tk < 4; ++tk) ffn_token6(tok0 + wid * 4 + tk, wid * 4 + tk, ln, H, SS, gffn, U8, V8, IU, IV, gfin, out, lds3); }
#endif
#endif
        __syncthreads();
    }
}
#undef PEER_CE
}
constexpr int RING_BYTES = 131072, LDSCTL_OFF = RING_BYTES, MISC_OFF = LDSCTL_OFF + 320, LDS_BYTES = 147456;
constexpr int N_PHASES = 8;
#ifndef MK_N_LAUNCHES
#define MK_N_LAUNCHES 1
#endif

__global__ void __launch_bounds__(NTHR, 2) fwd_megakernel(Args args) {
    extern __shared__ __attribute__((aligned(16))) unsigned char lds[];
    LAS unsigned char* lds3 = (LAS unsigned char*)lds;
    int tid_ = threadIdx.x; asm volatile("" : "+v"(tid_));
    const int tid = tid_, lane = tid & 63, wave = __builtin_amdgcn_readfirstlane(tid >> 6);
    const int G = gridDim.x, bid = blockIdx.x;
    unsigned char* ws = args.ws;
    unsigned* ctl = (unsigned*)(ws + WS_CTL);
    const float* x = args.in[0];
    bf16* WinT = (bf16*)(ws + WS_WIN); bf16* WbnT = (bf16*)(ws + WS_WBN); bf16* WbsT = (bf16*)(ws + WS_WBS); bf16* WoutT = (bf16*)(ws + WS_WOUT); bf16* WpqT = (bf16*)(ws + WS_WPQ);
    bf16* XN = (bf16*)(ws + WS_XN); bf16* MERGED = XN; bf16* PROJ = (bf16*)(ws + WS_PROJ);
    bf16* ONSA = (bf16*)(ws + WS_ONSA); bf16* OSB = (bf16*)(ws + WS_OSB);
    float* H = (float*)(ws + WS_H); bf16* HB = (bf16*)(ws + WS_HB);
    unsigned char* U8 = ws + WS_UB; unsigned char* V8 = ws + WS_VB; float* IU = (float*)(ws + WS_UB + 48 * MiB); float* IV = (float*)(ws + WS_VB + 48 * MiB); bf16* QP = (bf16*)(ws + WS_QP);
    int* EXPERT = (int*)(ws + WS_EXP); float* GATE = (float*)(ws + WS_GATE);
    bf16* KCB = (bf16*)(ws + WS_MISC + MISC_KCB); bf16* VCB = (bf16*)(ws + WS_MISC + MISC_VCB);
    float* SS = (float*)(ctl + CW_SS);
    bf16* W1T = (bf16*)(ws + WS_MISC + MISC_W1T); float* BIAS1 = (float*)(ws + WS_MISC + MISC_B1);
    bf16* SKB = (bf16*)(ws + WS_MISC + MISC_SKB);

    for (int u = tid; u < (LDS_BYTES - LDSCTL_OFF) / 4; u += NTHR) ((LAS unsigned*)(lds3 + LDSCTL_OFF))[u] = 0u;
    __syncthreads();
    const int lo = args.ph_lo, hi = args.ph_hi;
    XcdBarrier bar; bar.bar = ctl + CW_BAR; bar.x = 0; bar.st = nullptr;
    if (hi - lo > 1) bar = xcd_barrier_post(ctl + CW_BAR, (volatile LAS unsigned*)(lds3 + MISC_OFF) + 8);
#define IN(k) (lo <= (k) && (k) < hi)
#ifndef REP_BAR
#define REP_BAR 1
#endif
#define SEAM(k) do { if (IN(k) && IN((k) + 1)) for (int rb_ = 0; rb_ < REP_BAR; ++rb_) xcd_barrier(bar); } while (0)
    const int gw = bid * NWAVES + wave, NGW = G * NWAVES;
    const int vcu = (G % 8 == 0) ? (bid % 8) * (G / 8) + bid / 8 : bid;

#if defined(TS_PHASE)
    unsigned long long ts0_ = 0;
#define TS_BEGIN(k) do { if (TS_PHASE == (k)) ts0_ = __builtin_amdgcn_s_memrealtime(); } while (0)
#define TS_END(k) do { if (TS_PHASE == (k)) { const unsigned dt_ = (unsigned)(__builtin_amdgcn_s_memrealtime() - ts0_); if (tid == 0) atomicMax(ctl + 64, dt_); } } while (0)
#else
#define TS_BEGIN(k) do {} while (0)
#define TS_END(k) do {} while (0)
#endif
#ifndef REP_P0
#define REP_P0 1
#endif
#ifndef REP_P1
#define REP_P1 1
#endif
#ifndef REP_P4
#define REP_P4 1
#endif
#ifndef REP_P6
#define REP_P6 1
#endif
#ifndef REP_P5C
#define REP_P5C 1
#endif
    TS_BEGIN(0);
    if (IN(0)) for (int rep_ = 0; rep_ < REP_P0; ++rep_) {
        LAS float* scr = (LAS float*)(lds3 + wave * 16384);
        constexpr int I_IN = (D_MODEL / 64) * ((IN_COLS + 31) / 32), I_BR = (1024 / 64) * (D_MODEL / 32), I_SQ = (D_MODEL / 64) * (D_MODEL / 32);
        constexpr int I_C1 = (2048 / 64) * (CMP_HID / 32);
        constexpr int NITEMS = I_IN + 2 * I_BR + 2 * I_SQ + 2 * I_C1;
        for (int it = gw; it < NITEMS; it += NGW) {
            int r = it;
            if (r < I_IN) { p0_transpose_item(args.in[2], D_MODEL, IN_COLS, WinT, nullptr, scr, r, lane); continue; } r -= I_IN;
            if (r < I_BR) { p0_transpose_item(args.in[10], 1024, D_MODEL, WbnT, nullptr, scr, r, lane); continue; } r -= I_BR;
            if (r < I_BR) { p0_transpose_item(args.in[11], 1024, D_MODEL, WbsT, nullptr, scr, r, lane); continue; } r -= I_BR;
            if (r < I_SQ) { p0_transpose_item(args.in[12], D_MODEL, D_MODEL, WoutT, nullptr, scr, r, lane); continue; } r -= I_SQ;
            if (r < I_SQ) { p0_transpose_item(args.in[14], D_MODEL, D_MODEL, WpqT, args.in[13], scr, r, lane); continue; } r -= I_SQ;
            if (r < I_C1) { p0_transpose_item(args.in[4], 2048, CMP_HID, W1T, nullptr, scr, r, lane); continue; } r -= I_C1;
            p0_transpose_item(args.in[7], 2048, CMP_HID, W1T + (size_t)CMP_HID * 2048, nullptr, scr, r, lane);
        }
        {
            v4u z = {0u, 0u, 0u, 0u}; bf16* p = WinT + (size_t)IN_COLS * D_MODEL; const size_t nz = (size_t)(PLD - IN_COLS) * D_MODEL;
            for (size_t i = ((size_t)bid * NTHR + tid) * 8; i < nz; i += (size_t)G * NTHR * 8) *(v4u*)(p + i) = z;
        }
        if (gw < 2 * CMP_HID) {
            const int kv = gw >> 7, j = gw & 127; const float* pe = args.in[kv ? 6 : 3]; const float* w1 = args.in[kv ? 7 : 4];
            float s = 0.f;
            for (int k2 = lane; k2 < 2048; k2 += 64) s += pe[k2] * w1[(size_t)k2 * CMP_HID + j];
            s = wave_sum(s);
            if (lane == 0) BIAS1[gw] = s;
        }
        cvt_flat(args.in[15], SKB, (size_t)16 * 128 * 128, (size_t)bid * NTHR + tid, (size_t)G * NTHR);
        for (int m = gw; m < NTOK; m += NGW) rms_row_to_bf16(x + (size_t)m * D_MODEL, args.in[1], XN + (size_t)m * D_MODEL, lane);
    }
    TS_END(0);
    SEAM(0);
    TS_BEGIN(1);
    if (IN(1)) for (int rep_ = 0; rep_ < REP_P1; ++rep_) {
        pg8::Gemm g{XN, WinT, NTOK, PLD, D_MODEL}; pg8::StaticOrder S; S.init(NTOK, PLD, G, bid);
        pg8::EpiBf16<0> E{PROJ, PLD, nullptr, 0, 0, 1.f};
        pg8::gemm_phase<pg8::EpiBf16<0>, pg8::StaticOrder, true, true>(lds3, g, S, E);
    }
    TS_END(1);
    SEAM(1);
    TS_BEGIN(2);
    if (IN(2)) cmpr::compress_phase(PROJ, W1T, BIAS1, args.in, KCB, VCB, lds3, bid, G);
    TS_END(2);
    SEAM(2);
    TS_BEGIN(3);
    if (IN(3)) {
        TS_BEGIN(30);
        nsa::nsa_phase(PROJ, KCB, VCB, args.in[9], ONSA, lds3, vcu, G);
        TS_END(30);
#if defined(PROBE_P3A)
        nsa::nsa_phase(PROJ, KCB, VCB, args.in[9], ONSA, lds3, vcu, G);
#endif
        TS_BEGIN(31);
        nsa::stick_phase(PROJ, OSB, lds3, vcu, G);
        TS_END(31);
#if defined(PROBE_P3B)
        nsa::stick_phase(PROJ, OSB, lds3, vcu, G);
#endif
    }
    TS_END(3);
    SEAM(3);
    TS_BEGIN(4);
    if (IN(4)) for (int rep_ = 0; rep_ < REP_P4; ++rep_) {
        static_assert(WS_OSB == WS_ONSA + (size_t)NTOK * NSA_Q * 2 && WS_WBS == WS_WBN + (size_t)D_MODEL * 1024 * 2, "branch operands must be contiguous");
        pg8::Gemm g{ONSA, WbnT, 2 * NTOK, 2 * D_MODEL, 1024}; pg8::BranchOrder S; S.init(NTOK, D_MODEL, G, bid);
        pg8::EpiGate2 E{MERGED, D_MODEL, PROJ + C_GA, PROJ + C_GB, PLD, NTOK / 256, D_MODEL / 256};
        pg8::gemm_phase<pg8::EpiGate2, pg8::BranchOrder, true, true>(lds3, g, S, E);
    }
    TS_END(4);
    SEAM(4);
    TS_BEGIN(5);
    if (IN(5)) {
        { pg8::Gemm g{MERGED, WoutT, NTOK, D_MODEL, D_MODEL}; pg8::StaticOrder S; S.init(NTOK, D_MODEL, G, bid);
          pg8::EpiResid E{x, H, HB, SS, D_MODEL};
          pg8::gemm_phase<pg8::EpiResid, pg8::StaticOrder, false, true>(lds3, g, S, E); }
        int t5 = threadIdx.x; asm volatile("" : "+v"(t5));
        const int lane5 = t5 & 63, gw5 = bid * NWAVES + __builtin_amdgcn_readfirstlane(t5 >> 6);
        for (int rep_ = 0; rep_ < REP_P5C; ++rep_) for (int r = gw5; r < 2 * 16384; r += NGW) {
#if defined(PEER_FP8)
            if (r < 16384) peer::cvt_row_fp8(args.in[16], U8, IU, r, lane5); else peer::cvt_row_fp8(args.in[17], V8, IV, r - 16384, lane5);
#else
            if (r < 16384) peer::cvt_row_fp6(args.in[16], U8, IU, r, lane5); else peer::cvt_row_fp6(args.in[17], V8, IV, r - 16384, lane5);
#endif
        }
    }
    TS_END(5);
    SEAM(5);
    TS_BEGIN(6);
    if (IN(6)) for (int rep_ = 0; rep_ < REP_P6; ++rep_) {
        pg8::Gemm g{HB, WpqT, NTOK, D_MODEL, D_MODEL}; pg8::StaticOrder S; S.init(NTOK, D_MODEL, G, bid);
        pg8::EpiRowScale E{QP, D_MODEL, SS, 1.f / D_MODEL, EPS};
        pg8::gemm_phase<pg8::EpiRowScale, pg8::StaticOrder, false, true>(lds3, g, S, E);
    }
    TS_END(6);
    SEAM(6);
    TS_BEGIN(7);
    if (IN(7)) {
        peer::peer_phase(QP, SKB, H, SS, args.in[13], U8, V8, IU, IV, args.in[18], args.out, lds3, bid, G);
#if defined(PROBE_P7)
        peer::peer_phase(QP, SKB, H, SS, args.in[13], U8, V8, IU, IV, args.in[18], args.out, lds3, bid, G);
#endif
    }
    TS_END(7);
#if defined(TS_PHASE)
    xcd_barrier(bar);
    if (bid == 0) { const unsigned dt_ = __hip_atomic_load(ctl + 64, RLX_AGENT); const int K_ = (int)((float)dt_ * 0.01f * 16.777216f * 2.f);
        for (int i = tid; i < K_; i += NTHR) args.out[i] += 1.0f; }
#endif
#undef IN
#undef SEAM
}

extern "C" void kernel_launch(void* const* d_in, const int* in_sizes, int n_in, void* d_out, int out_size, void* d_ws, size_t ws_size, hipStream_t stream) {
    static int grid = 0;
    if (grid == 0) {
        if (n_in != 19 || ws_size < WS_END) { fprintf(stderr, "kernel_launch: unexpected inputs (%d) or workspace (%zu < %zu)\n", n_in, ws_size, (size_t)WS_END); grid = -1; return; }
        int dev = 0, cus = 0, per_cu = 0;
        hipGetDevice(&dev); hipDeviceGetAttribute(&cus, hipDeviceAttributeMultiprocessorCount, dev);
        if (hipFuncSetAttribute((const void*)fwd_megakernel, hipFuncAttributeMaxDynamicSharedMemorySize, LDS_BYTES) != hipSuccess) { fprintf(stderr, "hipFuncSetAttribute failed\n"); grid = -1; return; }
        if (hipOccupancyMaxActiveBlocksPerMultiprocessor(&per_cu, (const void*)fwd_megakernel, NTHR, LDS_BYTES) != hipSuccess || per_cu < 1) { fprintf(stderr, "occupancy query: %d\n", per_cu); per_cu = 1; }
        (void)hipGetLastError();
        grid = cus;
        if (grid > cus * per_cu) grid = cus * per_cu;
    }
    if (grid < 0) return;
    hipMemsetAsync((char*)d_ws + WS_CTL, 0, (size_t)(CW_SS + NTOK) * 4, stream);
    Args a{};
    for (int i = 0; i < 19; ++i) a.in[i] = (const float*)d_in[i];
    a.out = (float*)d_out; a.ws = (unsigned char*)d_ws;
    if (MK_N_LAUNCHES == 1) {
        a.ph_lo = 0; a.ph_hi = N_PHASES;
        void* kargs[] = {&a};
#if defined(USE_COOP_LAUNCH)
        hipError_t e = hipLaunchCooperativeKernel((const void*)fwd_megakernel, dim3(grid), dim3(NTHR), kargs, LDS_BYTES, stream);
        if (e != hipSuccess) fprintf(stderr, "cooperative launch failed: %s (grid %d)\n", hipGetErrorString(e), grid);
#else
        (void)kargs;
        hipLaunchKernelGGL(fwd_megakernel, dim3(grid), dim3(NTHR), LDS_BYTES, stream, a);
#endif
    } else {
        for (int p = 0; p < N_PHASES; ++p) { a.ph_lo = p; a.ph_hi = p + 1; hipLaunchKernelGGL(fwd_megakernel, dim3(grid), dim3(NTHR), LDS_BYTES, stream, a); }
    }
}
```

```cpp
#include <hip/hip_runtime.h>
#include <cstdio>
#include <cstdint>
#include <cmath>
namespace pg8 {
#define PG8_LAS __attribute__((address_space(3)))
typedef unsigned short bf16_t;
typedef short bf16x8 __attribute__((ext_vector_type(8)));
typedef float f32x4 __attribute__((ext_vector_type(4)));
typedef unsigned u32x4 __attribute__((ext_vector_type(4)));
constexpr int BM = 256, BK = 64, HALF = 128, HTB = HALF * BK * 2  , STAGE_BYTES = 8 * HTB, NXCD = 8, WGM = 8;

__host__ __device__ __forceinline__ int lds_byte(int r, int c) { const int st = (r >> 4) * 2 + (c >> 5), rr = r & 15, cc = c & 31, ob = rr * 64 + cc * 2; return st * 1024 + (ob ^ (((ob >> 9) & 1) << 5)); }
__host__ __device__ __forceinline__ void stage_rc(int b, int& R, int& C) { const int st = b / 1024, sb = b % 1024, swz = sb ^ (((sb >> 9) & 1) << 5); R = (st >> 1) * 16 + swz / 64; C = (st & 1) * 32 + (swz % 64) / 2; }
__host__ __device__ __forceinline__ int perm32(int rho) { const int n = rho >> 4, i = rho & 15; return 8 * (i >> 2) + 4 * n + (i & 3); }

struct Unit { int pm, pn; };
struct Gemm { const bf16_t* A; const bf16_t* Bt; int M, N, K; };

struct StaticOrder {
    int nM, nN, nwg, G, c;
    __host__ __device__ void init(int M, int N, int G_, int c_) { nM = M / BM; nN = N / BM; nwg = nM * nN; G = G_; c = c_; }
    __host__ __device__ bool next(int i, Unit& u) const {
        const long L = (long)i * G + c; if (L >= nwg) return false;
        int wgid = (int)L; { const int q = nwg / NXCD, r = nwg % NXCD, xcd = wgid % NXCD, off = wgid / NXCD; wgid = (xcd < r ? xcd * (q + 1) : r * (q + 1) + (xcd - r) * q) + off; }
        const int nig = WGM * nN, gid = wgid / nig, fm = gid * WGM, gsz = (nM - fm) < WGM ? (nM - fm) : WGM;
        u.pm = fm + ((wgid % nig) % gsz); u.pn = (wgid % nig) / gsz; return true;
    }
    __device__ __forceinline__ void a_ready(const Unit&) const {}
    __device__ __forceinline__ void done(const Unit&) const {}
};

__device__ __forceinline__ unsigned cvt_pk_bf16(float lo, float hi) { unsigned r; asm volatile("v_cvt_pk_bf16_f32 %0, %1, %2" : "=v"(r) : "v"(lo), "v"(hi)); return r; }
typedef float f32x2 __attribute__((ext_vector_type(2)));
__device__ __forceinline__ f32x2 gelu_pk(f32x2 v) {
    const f32x2 av = __builtin_elementwise_abs(v), d = av * 0.2316418882f + 1.0f;
    f32x2 t; t.x = __builtin_amdgcn_rcpf(d.x); t.y = __builtin_amdgcn_rcpf(d.y);
    f32x2 q = t * 0.5307027145f + (-0.7265760135f); q = q * t + 0.7107068705f; q = q * t + (-0.142248368f); q = q * t + 0.127414796f; q = q * t;
    const f32x2 s = (v * v) * (-0.72134752044f);
    f32x2 e; e.x = __builtin_amdgcn_exp2f(s.x); e.y = __builtin_amdgcn_exp2f(s.y);
    const f32x2 m = v * (q * e), r = v - m;
    f32x2 o; o.x = v.x < 0.f ? m.x : r.x; o.y = v.y < 0.f ? m.y : r.y; return o;
}

template <int ACT  > struct EpiBf16 {
    static constexpr bool PERM = true, AFTER_DRAIN = false; static_assert(ACT == 0 || ACT == 1, "EpiBf16: ACT is 0 (none) or 1 (gelu_pk)");
    bf16_t* O; int ldc; const float* bias; int split_cols; size_t split_stride; float scale0;
    __device__ __forceinline__ void operator()(const f32x4 (&acc)[2][2][4][2], const Unit& u, int wr, int wc, int fr, int fq) const {
        const int row0 = u.pm * BM + wr * 64 + fr; int colt = u.pn * BM; bf16_t* base = O;
        float sc = 1.f; if (split_cols) { const int t = colt / split_cols; base += (size_t)t * split_stride; colt -= t * split_cols; if (t == 0) sc = scale0; }
        const int col0 = colt + wc * 32 + 8 * fq, bcol0 = u.pn * BM + wc * 32 + 8 * fq;
        f32x4 bv[2][2];
#pragma unroll
        for (int bj = 0; bj < 2; ++bj)
#pragma unroll
            for (int n = 0; n < 2; ++n) bv[bj][n] = bias ? *(const f32x4*)(bias + bcol0 + bj * HALF + 4 * n) : (f32x4){0.f, 0.f, 0.f, 0.f};
#pragma unroll
        for (int ai = 0; ai < 2; ++ai)
#pragma unroll
            for (int m = 0; m < 4; ++m) { bf16_t* rowp = base + (size_t)(row0 + ai * HALF + m * 16) * ldc + col0;
#pragma unroll
                for (int bj = 0; bj < 2; ++bj) { f32x4 v0 = acc[ai][bj][m][0] + bv[bj][0], v1 = acc[ai][bj][m][1] + bv[bj][1];
                    if (ACT == 1) { f32x2 a = gelu_pk((f32x2){v0[0], v0[1]}), b = gelu_pk((f32x2){v0[2], v0[3]}), c = gelu_pk((f32x2){v1[0], v1[1]}), d = gelu_pk((f32x2){v1[2], v1[3]});
                        v0 = (f32x4){a.x, a.y, b.x, b.y}; v1 = (f32x4){c.x, c.y, d.x, d.y}; }
                    v0 = v0 * sc; v1 = v1 * sc; u32x4 w; w.x = cvt_pk_bf16(v0[0], v0[1]); w.y = cvt_pk_bf16(v0[2], v0[3]); w.z = cvt_pk_bf16(v1[0], v1[1]); w.w = cvt_pk_bf16(v1[2], v1[3]);
                    *(u32x4*)(rowp + bj * HALF) = w; } }
    }
};

struct PanelStats {
    unsigned* xbuf;
    unsigned* cnt;
    unsigned* tmo;
    int ntn; float eps;
    unsigned code;
    __device__ __forceinline__ bool run(const f32x4 (&v)[2][2][4][2], const Unit& u, int wr, int wc, int fr, int fq, PG8_LAS unsigned char* lds, int wid, int lane) const {
        typedef float f32x2v __attribute__((ext_vector_type(2)));
        PG8_LAS f32x2v* P = (PG8_LAS f32x2v*)lds;
        PG8_LAS f32x2v* S = (PG8_LAS f32x2v*)(lds + 8192);
        PG8_LAS unsigned* flag = (PG8_LAS unsigned*)(lds + 8192 + 2048);
#pragma unroll
        for (int ai = 0; ai < 2; ++ai)
#pragma unroll
            for (int m = 0; m < 4; ++m) {
                float s = 0.f;
#pragma unroll
                for (int bj = 0; bj < 2; ++bj)
#pragma unroll
                    for (int n = 0; n < 2; ++n) { const f32x4 x = v[ai][bj][m][n]; s += (x[0] + x[1]) + (x[2] + x[3]); }
                s += __shfl_xor(s, 16); s += __shfl_xor(s, 32);
                const float mw = s * (1.0f / 64.0f); float q = 0.f;
#pragma unroll
                for (int bj = 0; bj < 2; ++bj)
#pragma unroll
                    for (int n = 0; n < 2; ++n) { const f32x4 d = v[ai][bj][m][n] - mw; q += (d[0] * d[0] + d[1] * d[1]) + (d[2] * d[2] + d[3] * d[3]); }
                q += __shfl_xor(q, 16); q += __shfl_xor(q, 32);
                if (fq == 0) P[(ai * HALF + wr * 64 + m * 16 + fr) * 4 + wc] = (f32x2v){mw, q};
            }
        asm volatile("s_waitcnt lgkmcnt(0)" ::: "memory"); __builtin_amdgcn_s_barrier(); asm volatile("" ::: "memory");
#if defined(BROKEN_EXCHANGE_NO_WAIT)
#warning BROKEN CONTROL BUILD: the row-statistics exchange does not wait; results are wrong by design
        if (blockIdx.x >= 64) { const long long t0_ = clock64(); while (clock64() - t0_ < 60000) __builtin_amdgcn_s_sleep(8); }
#endif
        const int row = wid * 32 + (lane & 31);
        if (lane < 32) {
            const f32x2v a = P[row * 4 + 0], b = P[row * 4 + 1], c = P[row * 4 + 2], d = P[row * 4 + 3];
            const float mt = (a.x + b.x + c.x + d.x) * 0.25f;
            const float da = a.x - mt, db = b.x - mt, dc = c.x - mt, dd = d.x - mt;
            const float m2 = (a.y + b.y) + (c.y + d.y) + 64.0f * ((da * da + db * db) + (dc * dc + dd * dd));
            unsigned long long* slot = (unsigned long long*)xbuf + ((size_t)(u.pm * BM + row) * 4 + u.pn);
            __hip_atomic_store(slot, ((unsigned long long)__float_as_uint(m2) << 32) | __float_as_uint(mt), __ATOMIC_RELAXED, __HIP_MEMORY_SCOPE_AGENT);
        }
        asm volatile("s_waitcnt vmcnt(0)" ::: "memory");
        if (lane == 0) __hip_atomic_fetch_add(cnt + 64 * u.pm, 1u, __ATOMIC_RELAXED, __HIP_MEMORY_SCOPE_AGENT);
        if (wid == 0) {
            bool dead = false; const unsigned long long t0 = __builtin_amdgcn_s_memrealtime(); const unsigned want = 8u * (unsigned)ntn;
            for (;;) {
#if defined(BROKEN_EXCHANGE_NO_WAIT)
                break;
#endif
                if ((unsigned)__builtin_amdgcn_readfirstlane(__hip_atomic_load(cnt + 64 * u.pm, __ATOMIC_RELAXED, __HIP_MEMORY_SCOPE_AGENT)) >= want) break;
                if (__builtin_amdgcn_s_memrealtime() - t0 > 2000000ull) {
                    if (lane == 0) { unsigned expect = 0u; __hip_atomic_compare_exchange_strong(tmo + 1, &expect, code | (unsigned)(u.pm & 0xff), __ATOMIC_RELAXED, __ATOMIC_RELAXED, __HIP_MEMORY_SCOPE_AGENT);
                                     __hip_atomic_store(tmo, 1u, __ATOMIC_RELAXED, __HIP_MEMORY_SCOPE_AGENT); }
                    dead = true; break; }
                __builtin_amdgcn_s_sleep(2);
            }
            __builtin_amdgcn_fence(__ATOMIC_ACQUIRE, "agent");
            if (lane == 0) flag[0] = dead ? 1u : 0u;
        }
        asm volatile("s_waitcnt vmcnt(0) lgkmcnt(0)" ::: "memory"); __builtin_amdgcn_s_barrier(); asm volatile("" ::: "memory");
        const bool bad = flag[0] != 0u;
        if (lane < 32) {
            const unsigned long long* slot = (const unsigned long long*)xbuf + (size_t)(u.pm * BM + row) * 4; float mt[4], m2[4]; float ms = 0.f;
#pragma unroll
            for (int t = 0; t < 4; ++t) { if (t < ntn) { const unsigned long long w = __hip_atomic_load(slot + t, __ATOMIC_RELAXED, __HIP_MEMORY_SCOPE_AGENT); mt[t] = __uint_as_float((unsigned)w); m2[t] = __uint_as_float((unsigned)(w >> 32)); } else { mt[t] = 0.f; m2[t] = 0.f; } ms += mt[t]; }
            const float mean = ms / (float)ntn; float q = 0.f;
#pragma unroll
            for (int t = 0; t < 4; ++t) if (t < ntn) { const float dm = mt[t] - mean; q += m2[t] + 256.0f * dm * dm; }
            S[row] = (f32x2v){mean, 1.0f / sqrtf(q / (256.0f * (float)ntn) + eps)};
        }
        asm volatile("s_waitcnt lgkmcnt(0)" ::: "memory"); __builtin_amdgcn_s_barrier(); asm volatile("" ::: "memory");
        return bad;
    }
};
struct EpiLnRes {
    static constexpr bool PERM = false, AFTER_DRAIN = true;
    const float* base; float* out; int ldc; const float* bias; PanelStats st; unsigned poison;
    __device__ __forceinline__ void fused(f32x4 (&acc)[2][2][4][2], const Unit& u, int wr, int wc, int fr, int fq, PG8_LAS unsigned char* lds, int wid, int lane) const {
        typedef float f32x2v __attribute__((ext_vector_type(2)));
        const PG8_LAS f32x2v* S = (const PG8_LAS f32x2v*)(lds + 8192);
        const int col0 = u.pn * BM + wc * 32 + 4 * fq;
#pragma unroll
        for (int bj = 0; bj < 2; ++bj)
#pragma unroll
            for (int n = 0; n < 2; ++n) { const f32x4 bv = bias ? *(const f32x4*)(bias + col0 + bj * HALF + n * 16) : (f32x4){0.f, 0.f, 0.f, 0.f};
#pragma unroll
                for (int ai = 0; ai < 2; ++ai)
#pragma unroll
                    for (int m = 0; m < 4; ++m) acc[ai][bj][m][n] += bv; }
        f32x4 pre[4][2][2];
#pragma unroll
        for (int m = 0; m < 4; ++m) { const size_t off = (size_t)(u.pm * BM + wr * 64 + m * 16 + fr) * ldc + col0;
#pragma unroll
            for (int bj = 0; bj < 2; ++bj)
#pragma unroll
                for (int n = 0; n < 2; ++n) pre[m][bj][n] = *(const f32x4*)(base + off + bj * HALF + n * 16); }
        const bool bad = st.run(acc, u, wr, wc, fr, fq, lds, wid, lane) || poison != 0u;
        const float qnan = __builtin_nanf("");
#pragma unroll
        for (int ai = 0; ai < 2; ++ai)
#pragma unroll
            for (int m = 0; m < 4; ++m) { const int r = ai * HALF + wr * 64 + m * 16 + fr; const f32x2v sr = S[r]; const size_t off = (size_t)(u.pm * BM + r) * ldc + col0;
#pragma unroll
                for (int bj = 0; bj < 2; ++bj)
#pragma unroll
                    for (int n = 0; n < 2; ++n) { const f32x4 bs = ai == 0 ? pre[m][bj][n] : *(const f32x4*)(base + off + bj * HALF + n * 16); f32x4 o = bs + (acc[ai][bj][m][n] - sr.x) * sr.y;
                        if (bad) o = (f32x4){qnan, qnan, qnan, qnan}; *(f32x4*)(out + off + bj * HALF + n * 16) = o; }
                if (m & 1) asm volatile("" ::: "memory"); }
    }
};
struct EpiLnResLn {
    static constexpr bool PERM = false, AFTER_DRAIN = true;
    const float* base; float* out; bf16_t* xn; int ldc; const float* bias; PanelStats st1, st2; unsigned poison;
    __device__ __forceinline__ void fused(f32x4 (&acc)[2][2][4][2], const Unit& u, int wr, int wc, int fr, int fq, PG8_LAS unsigned char* lds, int wid, int lane) const {
        typedef float f32x2v __attribute__((ext_vector_type(2))); typedef unsigned u32x2v __attribute__((ext_vector_type(2)));
        const PG8_LAS f32x2v* S = (const PG8_LAS f32x2v*)(lds + 8192);
        const int col0 = u.pn * BM + wc * 32 + 4 * fq;
#pragma unroll
        for (int bj = 0; bj < 2; ++bj)
#pragma unroll
            for (int n = 0; n < 2; ++n) { const f32x4 bv = bias ? *(const f32x4*)(bias + col0 + bj * HALF + n * 16) : (f32x4){0.f, 0.f, 0.f, 0.f};
#pragma unroll
                for (int ai = 0; ai < 2; ++ai)
#pragma unroll
                    for (int m = 0; m < 4; ++m) acc[ai][bj][m][n] += bv; }
        bool bad = st1.run(acc, u, wr, wc, fr, fq, lds, wid, lane) || poison != 0u;
        const float qnan = __builtin_nanf("");
#pragma unroll
        for (int ai = 0; ai < 2; ++ai)
#pragma unroll
            for (int m = 0; m < 4; ++m) { const int r = ai * HALF + wr * 64 + m * 16 + fr; const f32x2v sr = S[r]; const size_t off = (size_t)(u.pm * BM + r) * ldc + col0;
#pragma unroll
                for (int bj = 0; bj < 2; ++bj)
#pragma unroll
                    for (int n = 0; n < 2; ++n) { const f32x4 bs = *(const f32x4*)(base + off + bj * HALF + n * 16); acc[ai][bj][m][n] = bs + (acc[ai][bj][m][n] - sr.x) * sr.y; }
                asm volatile("" : "+v"(acc[ai][0][m][0]), "+v"(acc[ai][0][m][1]), "+v"(acc[ai][1][m][0]), "+v"(acc[ai][1][m][1]));
                if (m & 1) asm volatile("" ::: "memory"); }
        const bool bad1 = bad;
        bad = st2.run(acc, u, wr, wc, fr, fq, lds, wid, lane) || bad;
#pragma unroll
        for (int ai = 0; ai < 2; ++ai)
#pragma unroll
            for (int m = 0; m < 4; ++m) { const int r = ai * HALF + wr * 64 + m * 16 + fr; const f32x2v sr = S[r]; const size_t off = (size_t)(u.pm * BM + r) * ldc + col0;
#pragma unroll
                for (int bj = 0; bj < 2; ++bj)
#pragma unroll
                    for (int n = 0; n < 2; ++n) { const f32x4 x1 = acc[ai][bj][m][n]; *(f32x4*)(out + off + bj * HALF + n * 16) = bad1 ? (f32x4){qnan, qnan, qnan, qnan} : x1;
                        const f32x4 o = (x1 - sr.x) * sr.y; u32x2v w; w.x = cvt_pk_bf16(o[0], o[1]); w.y = cvt_pk_bf16(o[2], o[3]);
                        if (bad) { w.x = 0x7fc07fc0u; w.y = 0x7fc07fc0u; } *(u32x2v*)(xn + off + bj * HALF + n * 16) = w; }
                asm volatile("" ::: "memory"); }
    }
};

template <class Epi, class Sched, bool ALIGN_EPI = false, bool SP2 = false>
__device__ __forceinline__ void gemm_phase(PG8_LAS unsigned char* lds, const Gemm g, const Sched& S, const Epi& E) {
    const int tid = threadIdx.x, wid = __builtin_amdgcn_readfirstlane(tid >> 6), lane = tid & 63, wr = wid >> 2, wc = wid & 3, fr = lane & 15, fq = lane >> 4;
    const int K = g.K, nt = K / BK;
    unsigned voffA[2], voffB[2];
#pragma unroll
    for (int i = 0; i < 2; ++i) { int R, C; stage_rc(tid * 16 + i * 8192, R, C); const int Rb = Epi::PERM ? ((R & ~31) + perm32(R & 31)) : R;
        voffA[i] = (unsigned)(R * K + C) * 2u; voffB[i] = (unsigned)(Rb * K + C) * 2u; }
    const size_t kstep = (size_t)(BK * 2);
    const size_t hstep = (size_t)HALF * K * 2;
    const size_t tstep = 2 * hstep;
    const unsigned ldsw = (unsigned)wid * 1024u;
    const int aoff = lds_byte(wr * 64 + fr, fq * 8), boff = lds_byte(wc * 32 + fr, fq * 8);
#define PG8_SA(b, h) (((b) * 2 + (h)) * HTB)
#define PG8_SB(b, h) ((4 + (b) * 2 + (h)) * HTB)
#define PG8_STAGE(bufoff, gbase, voff) do { _Pragma("unroll") for (int _i = 0; _i < 2; ++_i) \
        __builtin_amdgcn_global_load_lds((const unsigned*)((const char*)(gbase) + (voff)[_i]), (PG8_LAS unsigned*)(lds + (bufoff) + ldsw + _i * 8192), 16, 0, 0); } while (0)
#define PG8_LDA(dst, b, h) do { _Pragma("unroll") for (int m = 0; m < 4; ++m) _Pragma("unroll") for (int k = 0; k < 2; ++k) dst[m][k] = *(const PG8_LAS bf16x8*)(lds + PG8_SA(b, h) + aoff + m * 2048 + k * 1024); } while (0)
#define PG8_LDB(dst, b, h) do { _Pragma("unroll") for (int n = 0; n < 2; ++n) _Pragma("unroll") for (int k = 0; k < 2; ++k) dst[n][k] = *(const PG8_LAS bf16x8*)(lds + PG8_SB(b, h) + boff + n * 2048 + k * 1024); } while (0)
#define PG8_MMA(ai, bj, At, Bt) do { __builtin_amdgcn_s_setprio(1); _Pragma("unroll") for (int m = 0; m < 4; ++m) _Pragma("unroll") for (int n = 0; n < 2; ++n) _Pragma("unroll") for (int k = 0; k < 2; ++k) \
        acc[ai][bj][m][n] = __builtin_amdgcn_mfma_f32_16x16x32_bf16(Bt[n][k], At[m][k], acc[ai][bj][m][n], 0, 0, 0); __builtin_amdgcn_s_setprio(0); } while (0)
#define PG8_WAIT_V(n) asm volatile("s_waitcnt vmcnt(" #n ")" ::: "memory")
#define PG8_WAIT_L(n) asm volatile("s_waitcnt lgkmcnt(" #n ")" ::: "memory")
#define PG8_BAR __builtin_amdgcn_s_barrier()
#define PG8_SCHED __builtin_amdgcn_sched_barrier(0)
    Unit cur, nxt; int ui = 0;
    if (!S.next(0, cur)) return;
    f32x4 acc[2][2][4][2];
#pragma unroll
    for (int a = 0; a < 2; ++a)
#pragma unroll
        for (int b = 0; b < 2; ++b)
#pragma unroll
            for (int m = 0; m < 4; ++m)
#pragma unroll
                for (int n = 0; n < 2; ++n) acc[a][b][m][n] = (f32x4){0.f, 0.f, 0.f, 0.f};
    bf16x8 At[4][2], B0[2][2], B1[2][2];
    const char* cA = (const char*)g.A + (size_t)cur.pm * tstep; const char* cB = (const char*)g.Bt + (size_t)cur.pn * tstep;
    S.a_ready(cur);
    if constexpr (SP2) {
        PG8_STAGE(PG8_SB(0, 0), cB, voffB); PG8_STAGE(PG8_SB(0, 1), cB + hstep, voffB); PG8_STAGE(PG8_SA(0, 0), cA, voffA); PG8_STAGE(PG8_SA(0, 1), cA + hstep, voffA);
        if (wr == 1) PG8_BAR;
        PG8_WAIT_V(2); PG8_BAR;
        PG8_STAGE(PG8_SB(1, 0), cB + kstep, voffB); PG8_STAGE(PG8_SA(1, 0), cA + kstep, voffA); PG8_STAGE(PG8_SB(1, 1), cB + hstep + kstep, voffB);
        PG8_WAIT_V(6); PG8_BAR;
    } else {
        PG8_STAGE(PG8_SB(0, 0), cB, voffB); PG8_STAGE(PG8_SA(0, 0), cA, voffA); PG8_STAGE(PG8_SB(0, 1), cB + hstep, voffB); PG8_STAGE(PG8_SA(0, 1), cA + hstep, voffA);
        if (wr == 1) PG8_BAR;
        PG8_WAIT_V(4); PG8_BAR;
        PG8_STAGE(PG8_SB(1, 0), cB + kstep, voffB); PG8_STAGE(PG8_SA(1, 0), cA + kstep, voffA); PG8_STAGE(PG8_SB(1, 1), cB + hstep + kstep, voffB);
        PG8_WAIT_V(6); PG8_BAR;
    }
    for (;;) {
        const bool has_next = S.next(ui + 1, nxt);
        const char* nA = has_next ? (const char*)g.A + (size_t)nxt.pm * tstep : cA; const char* nB = has_next ? (const char*)g.Bt + (size_t)nxt.pn * tstep : cB;
        for (int t = 0; t < nt; t += 2) {
            const bool last = (t == nt - 2);
            const char* a1 = cA + (size_t)(t + 1) * kstep;
            const char* a2 = last ? nA : cA + (size_t)(t + 2) * kstep; const char* b2 = last ? nB : cB + (size_t)(t + 2) * kstep;
            const char* a3 = a2 + kstep; const char* b3 = b2 + kstep;
            if (last && has_next) S.a_ready(nxt);
            if constexpr (SP2) {
            PG8_LDB(B0, 0, 0); PG8_LDB(B1, 0, 1); PG8_SCHED; PG8_LDA(At, 0, 0); PG8_STAGE(PG8_SA(1, 1), a1 + hstep, voffA);
            PG8_WAIT_V(8); PG8_WAIT_L(0); PG8_BAR; PG8_MMA(0, 0, At, B0); PG8_MMA(0, 1, At, B1); PG8_BAR; PG8_SCHED;
            PG8_LDA(At, 0, 1); PG8_STAGE(PG8_SB(0, 0), b2, voffB); PG8_STAGE(PG8_SB(0, 1), b2 + hstep, voffB); PG8_STAGE(PG8_SA(0, 0), a2, voffA);
            PG8_WAIT_V(8); PG8_WAIT_L(0); PG8_BAR; PG8_MMA(1, 0, At, B0); PG8_MMA(1, 1, At, B1); PG8_BAR; PG8_SCHED;
            PG8_LDB(B0, 1, 0); PG8_LDB(B1, 1, 1); PG8_SCHED; PG8_LDA(At, 1, 0); PG8_STAGE(PG8_SA(0, 1), a2 + hstep, voffA);
            PG8_WAIT_V(8); PG8_WAIT_L(0); PG8_BAR; PG8_MMA(0, 0, At, B0); PG8_MMA(0, 1, At, B1); PG8_BAR; PG8_SCHED;
            PG8_LDA(At, 1, 1); PG8_STAGE(PG8_SB(1, 0), b3, voffB); PG8_STAGE(PG8_SB(1, 1), b3 + hstep, voffB); PG8_STAGE(PG8_SA(1, 0), a3, voffA);
            PG8_WAIT_V(8); PG8_WAIT_L(0); PG8_BAR; PG8_MMA(1, 0, At, B0); PG8_MMA(1, 1, At, B1); PG8_BAR; PG8_SCHED;
            } else {
            PG8_LDB(B0, 0, 0); PG8_SCHED; PG8_LDA(At, 0, 0); PG8_STAGE(PG8_SA(1, 1), a1 + hstep, voffA);
            PG8_WAIT_L(8); PG8_BAR; PG8_WAIT_L(0); PG8_MMA(0, 0, At, B0); PG8_BAR; PG8_SCHED;
            PG8_LDB(B1, 0, 1); PG8_STAGE(PG8_SB(0, 0), b2, voffB);
            PG8_BAR; PG8_WAIT_L(0); PG8_MMA(0, 1, At, B1); PG8_BAR;
            PG8_LDA(At, 0, 1); PG8_STAGE(PG8_SA(0, 0), a2, voffA);
            PG8_BAR; PG8_WAIT_L(0); PG8_MMA(1, 0, At, B0); PG8_BAR; PG8_SCHED;
            PG8_STAGE(PG8_SB(0, 1), b2 + hstep, voffB);
            PG8_WAIT_V(6); PG8_BAR; PG8_MMA(1, 1, At, B1); PG8_BAR;
            PG8_LDB(B0, 1, 0); PG8_SCHED; PG8_LDA(At, 1, 0); PG8_STAGE(PG8_SA(0, 1), a2 + hstep, voffA);
            PG8_WAIT_L(8); PG8_BAR; PG8_WAIT_L(0); PG8_MMA(0, 0, At, B0); PG8_BAR; PG8_SCHED;
            PG8_LDB(B1, 1, 1); PG8_STAGE(PG8_SB(1, 0), b3, voffB);
            PG8_BAR; PG8_WAIT_L(0); PG8_MMA(0, 1, At, B1); PG8_BAR;
            PG8_LDA(At, 1, 1); PG8_STAGE(PG8_SA(1, 0), a3, voffA);
            PG8_BAR; PG8_WAIT_L(0); PG8_MMA(1, 0, At, B0); PG8_BAR; PG8_SCHED;
            PG8_STAGE(PG8_SB(1, 1), b3 + hstep, voffB);
            PG8_WAIT_V(6); PG8_BAR; PG8_MMA(1, 1, At, B1); PG8_BAR;
            }
        }
        if constexpr (ALIGN_EPI) { if (wr == 0) PG8_BAR; }
        if constexpr (!Epi::AFTER_DRAIN) { E(acc, cur, wr, wc, fr, fq); S.done(cur); }
        if (!has_next) break;
#pragma unroll
        for (int a = 0; a < 2; ++a)
#pragma unroll
            for (int b = 0; b < 2; ++b)
#pragma unroll
                for (int m = 0; m < 4; ++m)
#pragma unroll
                    for (int n = 0; n < 2; ++n) acc[a][b][m][n] = (f32x4){0.f, 0.f, 0.f, 0.f};
        cur = nxt; cA = nA; cB = nB; ++ui;
        if constexpr (ALIGN_EPI) { if (wr == 1) PG8_BAR; }
    }
    PG8_WAIT_V(0);
    if constexpr (!ALIGN_EPI) { if (wr == 0) PG8_BAR; }
    PG8_BAR;
    if constexpr (Epi::AFTER_DRAIN) { E.fused(acc, cur, wr, wc, fr, fq, lds, wid, lane); S.done(cur); }
#undef PG8_SA
#undef PG8_SB
#undef PG8_STAGE
#undef PG8_LDA
#undef PG8_LDB
#undef PG8_MMA
#undef PG8_WAIT_V
#undef PG8_WAIT_L
#undef PG8_BAR
#undef PG8_SCHED
}
}
namespace pg8 {
__device__ __forceinline__ float bf2f(unsigned short b) { return __uint_as_float(((unsigned)b) << 16); }
__device__ __forceinline__ float bflo(unsigned w) { return __uint_as_float(w << 16); }
__device__ __forceinline__ float bfhi(unsigned w) { return __uint_as_float(w & 0xffff0000u); }
__device__ __forceinline__ float sigm(float x) { return 1.f / (1.f + __expf(-x)); }
template <int MODE> struct EpiGate {
    static constexpr bool PERM = true, AFTER_DRAIN = false;
    bf16_t* O; int ldc; const bf16_t* G; int ldg; size_t gtile;
    __device__ __forceinline__ void operator()(const f32x4 (&acc)[2][2][4][2], const Unit& u, int wr, int wc, int fr, int fq) const {
        const int row0 = u.pm * BM + wr * 64 + fr, col0 = u.pn * BM + wc * 32 + 8 * fq;
#pragma unroll
        for (int ai = 0; ai < 2; ++ai)
#pragma unroll
            for (int m = 0; m < 4; ++m) { const size_t row = (size_t)(row0 + ai * HALF + m * 16);
#pragma unroll
                for (int bj = 0; bj < 2; ++bj) {
                    const u32x4 gw = *(const u32x4*)(G + (size_t)u.pn * gtile + row * ldg + col0 + bj * HALF);
                    f32x4 v0 = acc[ai][bj][m][0], v1 = acc[ai][bj][m][1];
                    v0[0] *= sigm(bflo(gw.x)); v0[1] *= sigm(bfhi(gw.x)); v0[2] *= sigm(bflo(gw.y)); v0[3] *= sigm(bfhi(gw.y));
                    v1[0] *= sigm(bflo(gw.z)); v1[1] *= sigm(bfhi(gw.z)); v1[2] *= sigm(bflo(gw.w)); v1[3] *= sigm(bfhi(gw.w));
                    bf16_t* op = O + row * ldc + col0 + bj * HALF;
                    if (MODE == 1) { const u32x4 ow = *(const u32x4*)op;
                        v0[0] += bflo(ow.x); v0[1] += bfhi(ow.x); v0[2] += bflo(ow.y); v0[3] += bfhi(ow.y);
                        v1[0] += bflo(ow.z); v1[1] += bfhi(ow.z); v1[2] += bflo(ow.w); v1[3] += bfhi(ow.w); }
                    u32x4 w; w.x = cvt_pk_bf16(v0[0], v0[1]); w.y = cvt_pk_bf16(v0[2], v0[3]); w.z = cvt_pk_bf16(v1[0], v1[1]); w.w = cvt_pk_bf16(v1[2], v1[3]);
                    *(u32x4*)op = w; } }
    }
};
struct BranchOrder {
    StaticOrder base; int dm, dn;
    __host__ __device__ void init(int M, int N, int G_, int c_) { base.init(M, N, G_, c_); dm = M / BM; dn = N / BM; }
    __host__ __device__ bool next(int i, Unit& u) const { if (!base.next(i >> 1, u)) return false; if (i & 1) { u.pm += dm; u.pn += dn; } return true; }
    __device__ __forceinline__ void a_ready(const Unit&) const {}
    __device__ __forceinline__ void done(const Unit&) const {}
};
struct EpiGate2 {
    static constexpr bool PERM = true, AFTER_DRAIN = false;
    bf16_t* O; int ldc; const bf16_t* G0; const bf16_t* G1; int ldg; size_t gtile; int dm, dn;
    __device__ __forceinline__ void operator()(const f32x4 (&acc)[2][2][4][2], const Unit& u, int wr, int wc, int fr, int fq) const {
        const bool second = u.pm >= dm;
        Unit v = u; if (second) { v.pm -= dm; v.pn -= dn; }
        if (second) { EpiGate<1> e{O, ldc, G1, ldg, gtile}; e(acc, v, wr, wc, fr, fq); } else { EpiGate<0> e{O, ldc, G0, ldg, gtile}; e(acc, v, wr, wc, fr, fq); }
    }
};
struct EpiResid {
    static constexpr bool PERM = true, AFTER_DRAIN = false;
    const float* R; float* Hf; bf16_t* Hb; float* ss; int ldc;
    __device__ __forceinline__ void operator()(const f32x4 (&acc)[2][2][4][2], const Unit& u, int wr, int wc, int fr, int fq) const {
        const int row0 = u.pm * BM + wr * 64 + fr, col0 = u.pn * BM + wc * 32 + 8 * fq;
#pragma unroll
        for (int ai = 0; ai < 2; ++ai)
#pragma unroll
            for (int m = 0; m < 4; ++m) { const size_t row = (size_t)(row0 + ai * HALF + m * 16); float sq = 0.f;
#pragma unroll
                for (int bj = 0; bj < 2; ++bj) {
                    const size_t off = row * ldc + col0 + bj * HALF;
                    const f32x4 r0 = *(const f32x4*)(R + off), r1 = *(const f32x4*)(R + off + 4);
                    const f32x4 v0 = acc[ai][bj][m][0] + r0, v1 = acc[ai][bj][m][1] + r1;
                    *(f32x4*)(Hf + off) = v0; *(f32x4*)(Hf + off + 4) = v1;
                    u32x4 w; w.x = cvt_pk_bf16(v0[0], v0[1]); w.y = cvt_pk_bf16(v0[2], v0[3]); w.z = cvt_pk_bf16(v1[0], v1[1]); w.w = cvt_pk_bf16(v1[2], v1[3]);
                    *(u32x4*)(Hb + off) = w;
                    sq += (v0[0] * v0[0] + v0[1] * v0[1]) + (v0[2] * v0[2] + v0[3] * v0[3]) + (v1[0] * v1[0] + v1[1] * v1[1]) + (v1[2] * v1[2] + v1[3] * v1[3]); }
                sq += __shfl_xor(sq, 16); sq += __shfl_xor(sq, 32);
                if (fq == 0) atomicAdd(ss + row, sq); }
    }
};
struct EpiRowScale {
    static constexpr bool PERM = true, AFTER_DRAIN = false;
    bf16_t* O; int ldc; const float* ss; float inv_n, eps;
    __device__ __forceinline__ void operator()(const f32x4 (&acc)[2][2][4][2], const Unit& u, int wr, int wc, int fr, int fq) const {
        const int row0 = u.pm * BM + wr * 64 + fr, col0 = u.pn * BM + wc * 32 + 8 * fq;
#pragma unroll
        for (int ai = 0; ai < 2; ++ai)
#pragma unroll
            for (int m = 0; m < 4; ++m) { const size_t row = (size_t)(row0 + ai * HALF + m * 16);
                const float sc = rsqrtf(__hip_atomic_load(ss + row, __ATOMIC_RELAXED, __HIP_MEMORY_SCOPE_AGENT) * inv_n + eps);
#pragma unroll
                for (int bj = 0; bj < 2; ++bj) { const f32x4 v0 = acc[ai][bj][m][0] * sc, v1 = acc[ai][bj][m][1] * sc;
                    u32x4 w; w.x = cvt_pk_bf16(v0[0], v0[1]); w.y = cvt_pk_bf16(v0[2], v0[3]); w.z = cvt_pk_bf16(v1[0], v1[1]); w.w = cvt_pk_bf16(v1[2], v1[3]);
                    *(u32x4*)(O + row * ldc + col0 + bj * HALF) = w; } }
    }
};
}
constexpr int D_MODEL = 2048, BATCH = 2, SEQ = 4096, NTOK = BATCH * SEQ;
constexpr int HD = 64, NCMP = 255, CMP_STRIDE = 16, CMP_LEN = 32, CMP_HID = 128;
constexpr int SEL_LEN = 64, SEL_TOPK = 16, WINDOW = 512;
constexpr int PEER_KEYS = 128, PEER_E = 128;
constexpr int NSA_Q = 1024, SB_W = 1024;
constexpr int IN_COLS = 9776, PLD = 9984;
constexpr int C_SHIFT_FROM = 2608, C_SHIFT = 208, PP = 256;
constexpr int P_QN = 0, P_KC = 4, P_VC = 5, P_KS = 6, P_VS = 7, P_KW = 8, P_VW = 9, P_GBR = 10, P_QB = 11, P_KB = 15, P_VB = 19, P_GA = 23, P_GB = 31;
#define PNL(P, p) ((P) + (size_t)(p) * NTOK * PP)
constexpr float EPS = 1e-6f, NEGF = -1e30f;
constexpr int NWAVES = 8, NTHR = 512;

constexpr size_t MiB = 1u << 20;
constexpr size_t WS_CTL = 0, CTL_ZERO_BYTES = 1 * MiB;
constexpr size_t WS_WIN = 2 * MiB;
constexpr size_t WS_WBN = 42 * MiB, WS_WBS = 46 * MiB;
constexpr size_t WS_WOUT = 50 * MiB, WS_WPQ = 58 * MiB;
constexpr size_t WS_MISC = 66 * MiB;
constexpr size_t WS_XN = 70 * MiB;
constexpr size_t WS_PROJ = 102 * MiB;
constexpr size_t WS_ONSA = 258 * MiB, WS_OSB = 274 * MiB;
constexpr size_t WS_H = 290 * MiB;
constexpr size_t WS_HB = 354 * MiB;
constexpr size_t WS_END = 386 * MiB;
constexpr size_t WS_UB = 102 * MiB, WS_VB = 166 * MiB, WS_QP = 230 * MiB, WS_EXP = 262 * MiB, WS_GATE = 266 * MiB;
constexpr size_t MISC_KCB = 0, MISC_VCB = 1 * MiB, MISC_SKB = 2 * MiB, MISC_W1T = 2 * MiB + 512 * 1024, MISC_B1 = 3 * MiB + 512 * 1024;
constexpr int CW_BAR = 4096;
constexpr int CW_SS = 32768;

#define GAS __attribute__((address_space(1)))
#define LAS __attribute__((address_space(3)))
typedef unsigned short bf16;
typedef unsigned v4u __attribute__((ext_vector_type(4)));
typedef unsigned v2u __attribute__((ext_vector_type(2)));
typedef float f32x4 __attribute__((ext_vector_type(4)));
#define RLX_AGENT __ATOMIC_RELAXED, __HIP_MEMORY_SCOPE_AGENT
__device__ __forceinline__ unsigned f2bf(float f) { unsigned u = __builtin_bit_cast(unsigned, f); return (u + 0x7fffu + ((u >> 16) & 1u)) >> 16; }
__device__ __forceinline__ unsigned pk2(float lo, float hi) { return f2bf(lo) | (f2bf(hi) << 16); }
__device__ __forceinline__ float bf2f(bf16 b) { return __uint_as_float(((unsigned)b) << 16); }
__device__ __forceinline__ float bflo(unsigned w) { return __uint_as_float(w << 16); }
__device__ __forceinline__ float bfhi(unsigned w) { return __uint_as_float(w & 0xffff0000u); }

#define XB_TMO      128
#define XB_XCNT(j)  (256  + 64 * (j))
#define XB_XSUB(j)  (1280 + 64 * (j))
#define XB_XGEN(j)  (2304 + 64 * (j))
#define XB_TOP      3328
#define XB_TOPGEN   3392
#define XCD_BAR_WORDS 3456
#define XB_SPIN_CAP (1u << 24)
__device__ __forceinline__ unsigned xb_ld(unsigned* p)              { return __hip_atomic_load(p, __ATOMIC_RELAXED, __HIP_MEMORY_SCOPE_AGENT); }
__device__ __forceinline__ unsigned xb_add(unsigned* p, unsigned v) { return __hip_atomic_fetch_add(p, v, __ATOMIC_RELAXED, __HIP_MEMORY_SCOPE_AGENT); }
__device__ __forceinline__ unsigned xb_xcc_id() { return (unsigned)__builtin_amdgcn_s_getreg((3 << 11) | 20) & 0xFu; }
#define XB_SPIN(cond, bar) do { unsigned _sp = 0; while (cond) { __builtin_amdgcn_s_sleep(1); \
    if ((++_sp & 255u) == 0u) { if (xb_ld(&(bar)[XB_TMO])) break; if (_sp > XB_SPIN_CAP) { atomicAdd(&(bar)[XB_TMO], 1u); break; } } } } while (0)
struct XcdBarrier { unsigned* bar; unsigned x; volatile LAS unsigned* st; };
__device__ __forceinline__ XcdBarrier xcd_barrier_post(unsigned* bar, volatile LAS unsigned* st) {
    XcdBarrier b; b.bar = bar; b.x = xb_xcc_id(); b.st = st;
    if (threadIdx.x == 0) (void)xb_add(&bar[XB_XCNT(b.x)], 1u);
    return b;
}
__device__ __forceinline__ void xcd_barrier_complete(unsigned* bar, unsigned x, unsigned& nloc, unsigned& nx) {
    const unsigned G = gridDim.x * gridDim.y * gridDim.z;
    unsigned sum, cnt, mine, sp = 0u;
    for (;;) {
        sum = 0u; cnt = 0u; mine = 0u;
#pragma unroll
        for (unsigned j = 0; j < 16; ++j) { const unsigned c = xb_ld(&bar[XB_XCNT(j)]); sum += c; cnt += (c > 0u) ? 1u : 0u; mine = (j == x) ? c : mine; }
        if (sum == G) break;
        __builtin_amdgcn_s_sleep(1);
        if ((++sp & 255u) == 0u) { if (xb_ld(&bar[XB_TMO])) break; if (sp > XB_SPIN_CAP) { atomicAdd(&bar[XB_TMO], 1u); break; } }
    }
    nloc = mine > 0u ? mine : 1u; nx = cnt > 0u ? cnt : 1u;
}
__device__ __forceinline__ void xcd_barrier(const XcdBarrier& b) {
    asm volatile("s_waitcnt vmcnt(0)" ::: "memory");
    __syncthreads();
    if (threadIdx.x == 0) {
        unsigned* bar = b.bar;
        const unsigned bx = xb_xcc_id();
        __builtin_amdgcn_s_waitcnt(0);
        unsigned nloc = b.st[0], nx = b.st[1];
        if (nloc == 0u) { xcd_barrier_complete(bar, bx, nloc, nx); b.st[0] = nloc; b.st[1] = nx; }
        const unsigned old = xb_add(&bar[XB_XSUB(bx)], 1u);
        const unsigned gen = old / nloc;
        if (old + 1u == (gen + 1u) * nloc) {
            __builtin_amdgcn_fence(__ATOMIC_RELEASE, "agent");
            asm volatile("s_waitcnt vmcnt(0)" ::: "memory");
            const unsigned og = xb_add(&bar[XB_TOP], 1u);
            const unsigned tg = og / nx;
            if (og + 1u == (tg + 1u) * nx) xb_add(&bar[XB_TOPGEN], 1u);
            else XB_SPIN(xb_ld(&bar[XB_TOPGEN]) == tg, bar);
            __builtin_amdgcn_fence(__ATOMIC_ACQUIRE, "agent");
            xb_add(&bar[XB_XGEN(bx)], 1u);
            asm volatile("s_waitcnt vmcnt(0)" ::: "memory");
        } else {
            XB_SPIN(xb_ld(&bar[XB_XGEN(bx)]) == gen, bar);
            __builtin_amdgcn_fence(__ATOMIC_ACQUIRE, "agent");
            asm volatile("s_waitcnt vmcnt(0)" ::: "memory");
        }
    }
    __syncthreads();
}

__device__ __forceinline__ int rel_bucket(int d) {
    if (d < 16) return d < 0 ? 0 : d;
    int b = 16;
    b += (d >= 21); b += (d >= 27); b += (d >= 35); b += (d >= 46); b += (d >= 59); b += (d >= 77); b += (d >= 99); b += (d >= 128);
    b += (d >= 166); b += (d >= 216); b += (d >= 280); b += (d >= 363); b += (d >= 470); b += (d >= 609); b += (d >= 790);
    return b;
}
__device__ __forceinline__ float gelu_tanh(float x) { const float k = 0.7978845608028654f; return 0.5f * x * (1.f + tanhf(k * (x + 0.044715f * x * x * x))); }
__device__ __forceinline__ float sigmoidf_(float x) { return 1.f / (1.f + expf(-x)); }
__device__ __forceinline__ float wave_sum(float v) {
#pragma unroll
    for (int o = 32; o >= 1; o >>= 1) v += __shfl_xor(v, o);
    return v;
}
__device__ __forceinline__ float wave_max(float v) {
#pragma unroll
    for (int o = 32; o >= 1; o >>= 1) v = fmaxf(v, __shfl_xor(v, o));
    return v;
}
__device__ __forceinline__ float half_sum(float v, float* red) {
    v = wave_sum(v);
    __syncthreads();
    if ((threadIdx.x & 63) == 0) red[(threadIdx.x >> 6) & 3] = v;
    __syncthreads();
    return red[0] + red[1] + red[2] + red[3];
}
__device__ __forceinline__ float half_max(float v, float* red) {
    v = wave_max(v);
    __syncthreads();
    if ((threadIdx.x & 63) == 0) red[(threadIdx.x >> 6) & 3] = v;
    __syncthreads();
    return fmaxf(fmaxf(red[0], red[1]), fmaxf(red[2], red[3]));
}

struct Args {
    const float* in[19]; float* out; unsigned char* ws; int ph_lo, ph_hi; int variant, pad;
};

__device__ __forceinline__ void p0_transpose_item(const float* W, int K, int N, bf16* WT, const float* gk, LAS float* scr, int item, int lane, int shift_from = 0x7fffffff, int shift = 0) {
    const int nblk = (N + 31) / 32, kb = item / nblk, nb = item % nblk, k0 = 64 * kb, n0 = 32 * nb;
    const int c4 = (lane & 7) * 4, r8 = lane >> 3;
    const bool cok = (n0 + c4) < N;
    f32x4 v[8];
#pragma unroll
    for (int i = 0; i < 8; ++i) { const int kk = 8 * i + r8; v[i] = cok ? *(const f32x4*)(W + (size_t)(k0 + kk) * N + n0 + c4) : (f32x4){0.f, 0.f, 0.f, 0.f}; }
#pragma unroll
    for (int i = 0; i < 8; ++i) { const int kk = 8 * i + r8; const float g = gk ? gk[k0 + kk] : 1.f;
        scr[kk * 33 + c4 + 0] = v[i].x * g; scr[kk * 33 + c4 + 1] = v[i].y * g; scr[kk * 33 + c4 + 2] = v[i].z * g; scr[kk * 33 + c4 + 3] = v[i].w * g; }
    asm volatile("s_waitcnt lgkmcnt(0)" ::: "memory");
    const int c = lane & 7;
#pragma unroll
    for (int j = 0; j < 4; ++j) { const int n = (lane >> 3) + 8 * j; const LAS float* s = scr + (8 * c) * 33 + n;
        v4u o; o.x = pk2(s[0 * 33], s[1 * 33]); o.y = pk2(s[2 * 33], s[3 * 33]); o.z = pk2(s[4 * 33], s[5 * 33]); o.w = pk2(s[6 * 33], s[7 * 33]);
        const int nd = n0 + n + ((n0 + n >= shift_from) ? shift : 0);
        if (n0 + n < N) *(v4u*)(WT + (size_t)nd * K + k0 + 8 * c) = o; }
    asm volatile("s_waitcnt lgkmcnt(0)" ::: "memory");
}
__device__ __forceinline__ void rms_row_to_bf16(const float* xrow, const float* g, bf16* orow, int lane) {
    const f32x4* xr = (const f32x4*)xrow + lane; const f32x4* gr = (const f32x4*)g + lane;
    f32x4 v[8]; float s = 0.f;
#pragma unroll
    for (int j = 0; j < 8; ++j) { v[j] = xr[64 * j]; s += (v[j].x * v[j].x + v[j].y * v[j].y) + (v[j].z * v[j].z + v[j].w * v[j].w); }
    const float r = rsqrtf(wave_sum(s) * (1.f / D_MODEL) + EPS);
    v2u* o8 = (v2u*)orow + lane;
#pragma unroll
    for (int j = 0; j < 8; ++j) { const f32x4 gv = gr[64 * j]; v2u w; w.x = pk2(v[j].x * r * gv.x, v[j].y * r * gv.y); w.y = pk2(v[j].z * r * gv.z, v[j].w * r * gv.w); o8[64 * j] = w; }
}
__device__ __forceinline__ void cvt_flat(const float* src, bf16* dst, size_t n, size_t gthread, size_t nthreads) {
    for (size_t i = gthread * 8; i < n; i += nthreads * 8) {
        const f32x4 a = *(const f32x4*)(src + i), b = *(const f32x4*)(src + i + 4);
        v4u o; o.x = pk2(a.x, a.y); o.y = pk2(a.z, a.w); o.z = pk2(b.x, b.y); o.w = pk2(b.z, b.w);
        *(v4u*)(dst + i) = o;
    }
}
namespace cmpr {
typedef short bf16x8 __attribute__((ext_vector_type(8)));
typedef float f32x4v __attribute__((ext_vector_type(4)));
__device__ __forceinline__ void compress_phase(const bf16* PROJ, const bf16* W1T, const float* BIAS1, const float* const* in, bf16* KCB, bf16* VCB,
                                               __attribute__((address_space(3))) unsigned char* lds3, int bid, int G) {
    int tid = threadIdx.x; asm volatile("" : "+v"(tid));
    const int lane = tid & 63, wid = __builtin_amdgcn_readfirstlane(tid >> 6), r16 = lane & 15, kq = lane >> 4;
    __attribute__((address_space(3))) float* PART = (__attribute__((address_space(3))) float*)lds3;
    __attribute__((address_space(3))) float* HID = (__attribute__((address_space(3))) float*)(lds3 + 65536);
    for (int unit = bid; unit < 256; unit += G) {
        const int c = unit & 15, g = (unit >> 4) & 3, b = (unit >> 6) & 1, kv = unit >> 7, n0 = 16 * c;
        int nn = n0 + r16; if (nn > NCMP - 1) nn = NCMP - 1;
        const bf16* ap = PNL(PROJ, kv ? P_VC : P_KC) + (size_t)(b * SEQ + 16 * nn + 4 * wid) * PP + g * HD + 8 * kq;
        const bf16* bp = W1T + (size_t)kv * CMP_HID * 2048 + (size_t)r16 * 2048 + 256 * wid + 8 * kq;
        f32x4v acc[8] = {};
        bf16x8 af[8];
#pragma unroll
        for (int ks = 0; ks < 8; ++ks) af[ks] = *(const bf16x8*)(ap + (size_t)(ks >> 1) * PP + (ks & 1) * 32);
        bf16x8 wa[8], wb[8];
#define CMP_LOADW(W, KS) do { _Pragma("unroll") for (int nt = 0; nt < 8; ++nt) W[nt] = *(const bf16x8*)(bp + (size_t)nt * 16 * 2048 + (KS) * 32); } while (0)
#define CMP_MMA(W, KS) do { _Pragma("unroll") for (int nt = 0; nt < 8; ++nt) acc[nt] = __builtin_amdgcn_mfma_f32_16x16x32_bf16(af[KS], W[nt], acc[nt], 0, 0, 0); } while (0)
        CMP_LOADW(wa, 0);
#pragma unroll
        for (int ks = 0; ks < 8; ks += 2) {
            CMP_LOADW(wb, ks + 1); __builtin_amdgcn_sched_barrier(0);
            CMP_MMA(wa, ks); __builtin_amdgcn_sched_barrier(0);
            if (ks + 2 < 8) CMP_LOADW(wa, ks + 2);
            __builtin_amdgcn_sched_barrier(0);
            CMP_MMA(wb, ks + 1); __builtin_amdgcn_sched_barrier(0);
        }
#undef CMP_LOADW
#undef CMP_MMA
#pragma unroll
        for (int nt = 0; nt < 8; ++nt)
#pragma unroll
            for (int r = 0; r < 4; ++r) PART[wid * 2048 + (kq * 4 + r) * 128 + nt * 16 + r16] = acc[nt][r];
        asm volatile("s_waitcnt lgkmcnt(0)" ::: "memory"); __syncthreads();
#pragma unroll
        for (int i = 0; i < 4; ++i) { const int e = tid + NTHR * i; float s = BIAS1[kv * CMP_HID + (e & 127)];
#pragma unroll
            for (int w = 0; w < 8; ++w) s += PART[w * 2048 + e];
            HID[e] = gelu_tanh(s); }
        asm volatile("s_waitcnt lgkmcnt(0)" ::: "memory"); __syncthreads();
        {
            const int nl = tid >> 5, d = (tid & 31) * 2; const float* w2 = in[kv ? 8 : 5];
            float o0 = 0.f, o1 = 0.f;
#pragma unroll 8
            for (int j = 0; j < CMP_HID; ++j) { const float hv = HID[nl * 128 + j]; const float2 wv = *(const float2*)(w2 + j * HD + d); o0 += hv * wv.x; o1 += hv * wv.y; }
            const int n = n0 + nl;
            const unsigned pk = (n < NCMP) ? pk2(o0, o1) : 0u;
            *(unsigned*)((kv ? VCB : KCB) + (size_t)((b * 4 + g) * 256 + n) * HD + d) = pk;
        }
        __syncthreads();
    }
}
}
#ifndef NSA_FAR
#define NSA_FAR 1
#endif
namespace nsa {
typedef short bf16x8 __attribute__((ext_vector_type(8)));
typedef short s16x4 __attribute__((ext_vector_type(4)));
typedef float f32x16 __attribute__((ext_vector_type(16)));
typedef unsigned u32x4 __attribute__((ext_vector_type(4)));
typedef __attribute__((address_space(3))) const char* lds_cptr;
typedef __attribute__((address_space(3))) unsigned char* lds_ptr;
constexpr int SLOTB = 16384;
constexpr int NSLOT = 4;
constexpr int L_RING = 0, L_OV = 65536, L_BT = 98304, L_WSF = 111104, L_MASK = 113152, L_MISC = 113664, L_X = 113792, L_END = L_X + 32768;
constexpr int BT_N = 800;
constexpr float LOG2E = 1.4426950408889634f, SC2 = 0.125f * LOG2E, NEG2 = -1e30f;
static_assert(L_END <= 162816, "nsa LDS map");
__device__ __forceinline__ int crow(int r, int hi) { return (r & 3) + 8 * (r >> 2) + 4 * hi; }
__device__ __forceinline__ void glds16(const void* gsrc, unsigned lds_dst) { unsigned keep;
    asm volatile("s_mov_b32 %0, m0\n\ts_mov_b32 m0, %2\n\ts_nop 0\n\tglobal_load_lds_dwordx4 %1, off\n\ts_mov_b32 m0, %0" : "=&s"(keep) : "v"(gsrc), "s"(lds_dst) : "memory"); }
typedef float f32x2_t __attribute__((ext_vector_type(2))); typedef __bf16 bf16x2_t __attribute__((ext_vector_type(2)));
__device__ __forceinline__ unsigned cvtpk_s(float lo, float hi) { f32x2_t v = {lo, hi}; bf16x2_t b = __builtin_convertvector(v, bf16x2_t); return __builtin_bit_cast(unsigned, b); }
#define NSA_WAIT_BAR(N) asm volatile("s_waitcnt vmcnt(" #N ") lgkmcnt(0)\n\ts_barrier" ::: "memory")
#define NSA_SBAR() __builtin_amdgcn_sched_barrier(0)

__device__ __forceinline__ void qkt(f32x16& p0, f32x16& p1, lds_cptr Kslot, const bf16x8* qr, int r32, int hi) {
    lds_cptr kb = Kslot + hi * 1024 + r32 * 16;
    const f32x16 z = {};
#pragma unroll
    for (int d0 = 0; d0 < 4; ++d0) {
        const bf16x8 b0 = *(const __attribute__((address_space(3))) bf16x8*)(kb + d0 * 2048);
        const bf16x8 b1 = *(const __attribute__((address_space(3))) bf16x8*)(kb + d0 * 2048 + 512);
        if (d0 == 0) { p0 = __builtin_amdgcn_mfma_f32_32x32x16_bf16(b0, qr[0], z, 0, 0, 0); p1 = __builtin_amdgcn_mfma_f32_32x32x16_bf16(b1, qr[0], z, 0, 0, 0); }
        else { p0 = __builtin_amdgcn_mfma_f32_32x32x16_bf16(b0, qr[d0], p0, 0, 0, 0); p1 = __builtin_amdgcn_mfma_f32_32x32x16_bf16(b1, qr[d0], p1, 0, 0, 0); }
    }
}
__device__ __forceinline__ void pv(f32x16* o, int vb, bf16x8 pa0, bf16x8 pa1, bf16x8 pa2, bf16x8 pa3) {
#pragma unroll
    for (int d0 = 0; d0 < 2; ++d0) { s16x4 lo[4], hi[4];
#pragma unroll
        for (int ks = 0; ks < 4; ++ks) {
            asm volatile("ds_read_b64_tr_b16 %0,%1 offset:%c2" : "=&v"(lo[ks]) : "v"(vb), "i"(d0 * 4096 + ks * 1024) : "memory");
            asm volatile("ds_read_b64_tr_b16 %0,%1 offset:%c2" : "=&v"(hi[ks]) : "v"(vb), "i"(d0 * 4096 + ks * 1024 + 512) : "memory"); }
        asm volatile("s_waitcnt lgkmcnt(0)" ::: "memory"); NSA_SBAR();
#define NSA_PK(k) (bf16x8){lo[k][0], lo[k][1], lo[k][2], lo[k][3], hi[k][0], hi[k][1], hi[k][2], hi[k][3]}
        o[d0] = __builtin_amdgcn_mfma_f32_32x32x16_bf16(pa0, NSA_PK(0), o[d0], 0, 0, 0);
        o[d0] = __builtin_amdgcn_mfma_f32_32x32x16_bf16(pa1, NSA_PK(1), o[d0], 0, 0, 0);
        o[d0] = __builtin_amdgcn_mfma_f32_32x32x16_bf16(pa2, NSA_PK(2), o[d0], 0, 0, 0);
        o[d0] = __builtin_amdgcn_mfma_f32_32x32x16_bf16(pa3, NSA_PK(3), o[d0], 0, 0, 0);
#undef NSA_PK
    }
}
__device__ __forceinline__ float rowmax32(const f32x16& p0, const f32x16& p1) {
    float a = fmaxf(p0[0], p1[0]), b = fmaxf(p0[1], p1[1]);
#pragma unroll
    for (int r = 2; r < 16; r += 2) { a = fmaxf(fmaxf(a, p0[r]), p1[r]); b = fmaxf(fmaxf(b, p0[r + 1]), p1[r + 1]); }
    a = fmaxf(a, b);
    auto rr = __builtin_amdgcn_permlane32_swap(__float_as_uint(a), __float_as_uint(a), false, false);
    return fmaxf(__uint_as_float(rr[0]), __uint_as_float(rr[1]));
}
__device__ __forceinline__ float swap_add(float v) {
    auto rr = __builtin_amdgcn_permlane32_swap(__float_as_uint(v), __float_as_uint(v), false, false);
    return __uint_as_float(rr[0]) + __uint_as_float(rr[1]);
}

struct PassCtx {
    lds_ptr lds3; unsigned lds0;
    int lane, r32, hi, wid;
    int tq;
    const __attribute__((address_space(3))) float* bt;
    __attribute__((address_space(3))) float* wsf;
    int vboff;
};

template <int MODE>
__device__ __forceinline__ void run_pass(const PassCtx& c, int NT, int first, const bf16* Kb, const bf16* Vb, int pitch, const bf16x8* qr,
                                         unsigned mask_lo, unsigned mask_hi, f32x16 (&o)[2], f32x16 (&im)[2], float& m, float& l) {
    const __attribute__((address_space(3))) unsigned char* TL = (const __attribute__((address_space(3))) unsigned char*)(c.lds3 + L_MISC);
#define NSA_TID(i) ((MODE == 0) ? (i) : (MODE == 2) ? (first + (i)) : (int)TL[NT - 1 - (i)])
#define NSA_ISSUE(i, slot) do { const int id_ = __builtin_amdgcn_readfirstlane(NSA_TID(i)); \
        const bf16* ks_ = Kb + (size_t)(64 * id_ + c.lane) * pitch + 8 * c.wid; \
        const bf16* vs_ = Vb + (size_t)(64 * id_ + 16 * (c.wid & 3) + (c.lane >> 2)) * pitch + 32 * (c.wid >> 2) + 8 * (c.lane & 3); \
        glds16(ks_, (unsigned)__builtin_amdgcn_readfirstlane(c.lds0 + L_RING + (slot) * SLOTB + c.wid * 1024)); \
        glds16(vs_, (unsigned)__builtin_amdgcn_readfirstlane(c.lds0 + L_RING + (slot) * SLOTB + 8192 + c.wid * 1024)); } while (0)
    if (NT > 0) NSA_ISSUE(0, 0);
    if (NT > 1) NSA_ISSUE(1, 1);
    if (NT > 2) NSA_ISSUE(2, 2);
    int slot = 0;
    for (int i = 0; i < NT; ++i) {
        if (i + 2 < NT) NSA_WAIT_BAR(4); else if (i + 1 < NT) NSA_WAIT_BAR(2); else NSA_WAIT_BAR(0);
        if (i + 3 < NT) { const int s3 = (slot == 0) ? 3 : slot - 1; NSA_ISSUE(i + 3, s3); }
        const int id = __builtin_amdgcn_readfirstlane(NSA_TID(i));
        f32x16 p0, p1;
        qkt(p0, p1, (lds_cptr)(c.lds3 + L_RING + slot * SLOTB), qr, c.r32, c.hi);
        const int dbase = (MODE == 0) ? (c.tq - 31 - 1024 * id) : (c.tq - 64 * id);
        bool selb = true;
        if (MODE == 1) selb = ((id < 32 ? (mask_lo >> id) : (mask_hi >> (id - 32))) & 1u) != 0u;
        float alpha, rs = 0.f;
        if (NSA_FAR && MODE == 1 && __builtin_amdgcn_readfirstlane(c.tq - c.r32) - (64 * id + 63) >= 790) {
            const float lofs = selb ? c.bt[790] : -INFINITY;
            const float mt = rowmax32(p0, p1) * SC2 + lofs;
            const float mnew = fmaxf(m, mt);
            alpha = __builtin_amdgcn_exp2f(m - mnew);
            m = mnew;
            const float off = lofs - mnew;
#pragma unroll
            for (int r = 0; r < 16; ++r) { p0[r] = __builtin_amdgcn_exp2f(p0[r] * SC2 + off); p1[r] = __builtin_amdgcn_exp2f(p1[r] * SC2 + off); rs += p0[r] + p1[r]; }
        } else {
        int dbh = dbase - ((MODE == 0) ? 64 * c.hi : 4 * c.hi);
        asm volatile("" : "+v"(dbh));
#pragma unroll
        for (int r = 0; r < 16; ++r) {
            const int d0 = dbh - ((MODE == 0) ? 16 * ((r & 3) + 8 * (r >> 2)) : ((r & 3) + 8 * (r >> 2)));
            const int d1 = (MODE == 0) ? (d0 - 512) : (d0 - 32);
            bool v0 = d0 >= 0, v1 = d1 >= 0;
            if (MODE == 2) { v0 = v0 && d0 < WINDOW; v1 = v1 && d1 < WINDOW; }
            if (MODE == 1) { v0 = v0 && selb; v1 = v1 && selb; }
            const int i0 = d0 < 0 ? 0 : (d0 > 790 ? 790 : d0), i1 = d1 < 0 ? 0 : (d1 > 790 ? 790 : d1);
            const float s0 = p0[r] * SC2 + c.bt[i0], s1 = p1[r] * SC2 + c.bt[i1];
            p0[r] = v0 ? s0 : -INFINITY; p1[r] = v1 ? s1 : -INFINITY;
        }
        const float mt = rowmax32(p0, p1);
        const float mnew = fmaxf(m, mt);
        alpha = __builtin_amdgcn_exp2f(m - mnew);
        m = mnew;
#pragma unroll
        for (int r = 0; r < 16; ++r) {
            const float e0 = __builtin_amdgcn_exp2f(p0[r] - mnew), e1 = __builtin_amdgcn_exp2f(p1[r] - mnew);
            p0[r] = e0; p1[r] = e1; rs += e0 + e1;
        }
        }
        l = l * alpha + rs;
        if (!__all(alpha == 1.f)) {
            if (c.hi == 0) c.wsf[c.r32] = alpha;
            asm volatile("s_waitcnt lgkmcnt(0)" ::: "memory");
#pragma unroll
            for (int r = 0; r < 16; ++r) { const float a = c.wsf[crow(r, c.hi)]; o[0][r] *= a; o[1][r] *= a; if (MODE == 0) { im[0][r] *= a; im[1][r] *= a; } }
        }
        u32x4 pw0, pw1, pw2, pw3;
        pw0 = (u32x4){cvtpk_s(p0[0], p0[1]), cvtpk_s(p0[2], p0[3]), cvtpk_s(p0[4], p0[5]), cvtpk_s(p0[6], p0[7])};
        pw1 = (u32x4){cvtpk_s(p0[8], p0[9]), cvtpk_s(p0[10], p0[11]), cvtpk_s(p0[12], p0[13]), cvtpk_s(p0[14], p0[15])};
        pw2 = (u32x4){cvtpk_s(p1[0], p1[1]), cvtpk_s(p1[2], p1[3]), cvtpk_s(p1[4], p1[5]), cvtpk_s(p1[6], p1[7])};
        pw3 = (u32x4){cvtpk_s(p1[8], p1[9]), cvtpk_s(p1[10], p1[11]), cvtpk_s(p1[12], p1[13]), cvtpk_s(p1[14], p1[15])};
        NSA_SBAR();
        pv(o, (int)(c.lds0 + L_RING + slot * SLOTB + 8192) + c.vboff, __builtin_bit_cast(bf16x8, pw0), __builtin_bit_cast(bf16x8, pw1), __builtin_bit_cast(bf16x8, pw2), __builtin_bit_cast(bf16x8, pw3));
        if (MODE == 0) pv(im, (int)(c.lds0 + L_OV + id * 8192) + c.vboff, __builtin_bit_cast(bf16x8, pw0), __builtin_bit_cast(bf16x8, pw1), __builtin_bit_cast(bf16x8, pw2), __builtin_bit_cast(bf16x8, pw3));
        slot = (slot == NSLOT - 1) ? 0 : slot + 1;
    }
    asm volatile("s_waitcnt vmcnt(0) lgkmcnt(0)\n\ts_barrier" ::: "memory");
#undef NSA_TID
#undef NSA_ISSUE
}

__device__ __forceinline__ void build_ov(lds_ptr lds3) {
    for (int idx = threadIdx.x; idx < 4 * 4096; idx += NTHR) {
        const int kt = idx >> 12, nl = (idx >> 6) & 63, jc = idx & 63, n = 64 * kt + nl;
        unsigned short v = 0;
        if ((n & 3) != 3) { if (jc == (n >> 2)) v = 0x3F80; } else { if (jc == (n >> 2) || jc == (n >> 2) + 1) v = 0x3F00; }
        *(__attribute__((address_space(3))) unsigned short*)(lds3 + L_OV + kt * 8192 + ((jc >> 5) * 4 + (nl >> 4)) * 1024 + (nl & 15) * 64 + (jc & 31) * 2) = v;
    }
}

__device__ __forceinline__ void nsa_unit(int variant, bool build_bt, int b, int g, int qt, const bf16* PROJ, const bf16* KCBb, const bf16* VCBb, const float* rel, bf16* ONSA, lds_ptr lds3, unsigned lds0) {
    const int tid = threadIdx.x, lane = tid & 63, r32 = lane & 31, hi = lane >> 5;
    const int wid = __builtin_amdgcn_readfirstlane(tid >> 6), hh = wid & 3, th = wid >> 2;
    const int t0 = qt * 64, tq = t0 + 32 * th + r32, cur = qt;
    __attribute__((address_space(3))) float* BT = (__attribute__((address_space(3))) float*)(lds3 + L_BT);
    __attribute__((address_space(3))) unsigned* MASK = (__attribute__((address_space(3))) unsigned*)(lds3 + L_MASK);
    if (build_bt) for (int i = tid; i < 4 * BT_N; i += NTHR) { const int hq = i / BT_N, d = i - hq * BT_N; BT[i] = rel[rel_bucket(d) * 16 + g * 4 + hq] * LOG2E; }
    if (tid < 128) MASK[tid] = 0u;
    PassCtx c; c.lds3 = lds3; c.lds0 = lds0; c.lane = lane; c.r32 = r32; c.hi = hi; c.wid = wid; c.tq = tq;
    c.bt = BT + hh * BT_N; c.wsf = (__attribute__((address_space(3))) float*)(lds3 + L_WSF) + wid * 64;
    c.vboff = ((lane >> 4) & 1) * 32 + (lane & 3) * 8 + (4 * hi + ((lane & 15) >> 2)) * 64;
    const size_t qrow = (size_t)(b * SEQ + tq) * PP;
    bf16x8 qr[4];
#pragma unroll
    for (int d0 = 0; d0 < 4; ++d0) qr[d0] = *(const bf16x8*)(PNL(PROJ, P_QN + g) + qrow + hh * HD + d0 * 16 + hi * 8);
    const float gate0 = 1.f / (1.f + __expf(-bf2f(PNL(PROJ, P_GBR)[qrow + 0 * 16 + g * 4 + hh])));
    const float gate1 = 1.f / (1.f + __expf(-bf2f(PNL(PROJ, P_GBR)[qrow + 1 * 16 + g * 4 + hh])));
    const float gate2 = 1.f / (1.f + __expf(-bf2f(PNL(PROJ, P_GBR)[qrow + 2 * 16 + g * 4 + hh])));
    asm volatile("s_waitcnt vmcnt(0) lgkmcnt(0)" ::: "memory");
    __syncthreads();
    f32x16 oc[2] = {}, o[2] = {}, im[2] = {};
    float m = NEG2, l = 0.f;
    {
        int cnt = (t0 + 32) / 16 + 1; if (cnt > NCMP) cnt = NCMP;
        const int NT = (variant & 4) ? 0 : ((cnt + 63) >> 6);
#if defined(PROBE_NSA_CMP2)
        run_pass<0>(c, NT, 0, KCBb + (size_t)(b * 4 + g) * 256 * HD, VCBb + (size_t)(b * 4 + g) * 256 * HD, HD, qr, 0u, 0u, o, im, m, l);
        o[0] = f32x16{}; o[1] = f32x16{}; im[0] = f32x16{}; im[1] = f32x16{}; m = NEG2; l = 0.f;
#endif
        run_pass<0>(c, NT, 0, KCBb + (size_t)(b * 4 + g) * 256 * HD, VCBb + (size_t)(b * 4 + g) * 256 * HD, HD, qr, 0u, 0u, o, im, m, l);
        const float lt = swap_add(l);
        const float inv = lt > 0.f ? 1.f / lt : 0.f;
        if (hi == 0) { c.wsf[r32] = inv * gate0; c.wsf[32 + r32] = inv; }
        asm volatile("s_waitcnt lgkmcnt(0)" ::: "memory");
#pragma unroll
        for (int r = 0; r < 16; ++r) { const float a = c.wsf[crow(r, hi)], a2 = c.wsf[32 + crow(r, hi)]; oc[0][r] = o[0][r] * a; oc[1][r] = o[1][r] * a; im[0][r] *= a2; im[1][r] *= a2; }
        if (!(variant & 8)) {
        {
            __attribute__((address_space(3))) float* PW = (__attribute__((address_space(3))) float*)(lds3 + L_RING) + wid * 2048;
#pragma unroll
            for (int d0 = 0; d0 < 2; ++d0)
#pragma unroll
                for (int r = 0; r < 16; ++r) PW[crow(r, hi) * 64 + d0 * 32 + r32] = im[d0][r];
        }
        asm volatile("s_waitcnt lgkmcnt(0)" ::: "memory"); __syncthreads();
        __attribute__((address_space(3))) float* T = (__attribute__((address_space(3))) float*)(lds3 + L_X);
        {
            const __attribute__((address_space(3))) float* PA = (const __attribute__((address_space(3))) float*)(lds3 + L_RING);
            int tx = tid; asm volatile("" : "+v"(tx));
            const int j = tx & 63, tb = (tx >> 6) * 8;
#pragma unroll
            for (int e = 0; e < 8; ++e) { const int tok = tb + e, w0 = (tok >> 5) * 4, q = tok & 31;
                T[tok * 65 + j] = (PA[(w0 + 0) * 2048 + q * 64 + j] + PA[(w0 + 1) * 2048 + q * 64 + j]) + (PA[(w0 + 2) * 2048 + q * 64 + j] + PA[(w0 + 3) * 2048 + q * 64 + j]); }
        }
        asm volatile("s_waitcnt lgkmcnt(0)" ::: "memory"); __syncthreads();
        {
            int ty = tid; asm volatile("" : "+v"(ty));
            const int tok = ty & 63, jg = wid, jlo = 8 * jg;
            float v[8]; int rank[8];
#pragma unroll
            for (int e = 0; e < 8; ++e) { const int j = jlo + e; const bool forced = (j == 0) || (j == cur) || (j == cur - 1);
                v[e] = (j <= cur) ? T[tok * 65 + j] + (forced ? 1e4f : 0.f) : -INFINITY; rank[e] = 0; }
            const int nA = jlo < cur + 1 ? jlo : cur + 1, nB = (jlo + 8) < cur + 1 ? (jlo + 8) : cur + 1;
#pragma unroll 2
            for (int j2 = 0; j2 < nA; ++j2) {
                const float sv = T[tok * 65 + j2] + (((j2 == 0) || (j2 == cur) || (j2 == cur - 1)) ? 1e4f : 0.f);
#pragma unroll
                for (int e = 0; e < 8; ++e) rank[e] += (sv >= v[e]) ? 1 : 0;
            }
            for (int j2 = jlo; j2 < nB; ++j2) {
                const float sv = T[tok * 65 + j2] + (((j2 == 0) || (j2 == cur) || (j2 == cur - 1)) ? 1e4f : 0.f);
#pragma unroll
                for (int e = 0; e < 8; ++e) rank[e] += (sv > v[e] || (sv == v[e] && j2 < jlo + e)) ? 1 : 0;
            }
#pragma unroll 2
            for (int j2 = jlo + 8; j2 <= cur; ++j2) {
                const float sv = T[tok * 65 + j2] + (((j2 == 0) || (j2 == cur) || (j2 == cur - 1)) ? 1e4f : 0.f);
#pragma unroll
                for (int e = 0; e < 8; ++e) rank[e] += (sv > v[e]) ? 1 : 0;
            }
            unsigned bits = 0u;
#pragma unroll
            for (int e = 0; e < 8; ++e) { const int j = jlo + e; if (j <= cur && rank[e] < SEL_TOPK) bits |= 1u << e; }
            if (bits) atomicOr((unsigned*)(MASK + tok * 2 + (jg >> 2)), bits << ((jg & 3) * 8));
        }
        asm volatile("s_waitcnt lgkmcnt(0)" ::: "memory"); __syncthreads();
        if (wid == 0) {
            unsigned ulo = MASK[lane * 2], uhi = MASK[lane * 2 + 1];
#pragma unroll
            for (int ofs = 32; ofs >= 1; ofs >>= 1) { ulo |= __shfl_xor(ulo, ofs); uhi |= __shfl_xor(uhi, ofs); }
            {
                __attribute__((address_space(3))) unsigned char* TL = (__attribute__((address_space(3))) unsigned char*)(lds3 + L_MISC);
                const unsigned long long mm = ((unsigned long long)uhi << 32) | ulo;
                int ln = lane; asm volatile("" : "+v"(ln));
                if ((mm >> ln) & 1ull) TL[__popcll(mm & ((1ull << ln) - 1ull))] = (unsigned char)ln;
                if (lane == 0) *(__attribute__((address_space(3))) int*)(lds3 + L_MISC + 64) = __popcll(mm);
            }
        }
        asm volatile("s_waitcnt lgkmcnt(0)" ::: "memory"); __syncthreads();
        }
    }
    {
        const unsigned mlo = MASK[(32 * th + r32) * 2], mhi = MASK[(32 * th + r32) * 2 + 1];
        const int NT = (variant & 1) ? 0 : __builtin_amdgcn_readfirstlane(*(__attribute__((address_space(3))) int*)(lds3 + L_MISC + 64));
#if defined(PROBE_NSA_SEL2)
        o[0] = f32x16{}; o[1] = f32x16{}; m = NEG2; l = 0.f;
        run_pass<1>(c, NT, 0, PNL(PROJ, P_KS) + (size_t)b * SEQ * PP + g * HD, PNL(PROJ, P_VS) + (size_t)b * SEQ * PP + g * HD, PP, qr, mlo, mhi, o, im, m, l);
#endif
        o[0] = f32x16{}; o[1] = f32x16{}; m = NEG2; l = 0.f;
        run_pass<1>(c, NT, 0, PNL(PROJ, P_KS) + (size_t)b * SEQ * PP + g * HD, PNL(PROJ, P_VS) + (size_t)b * SEQ * PP + g * HD, PP, qr, mlo, mhi, o, im, m, l);
        const float lt = swap_add(l);
        const float inv = lt > 0.f ? 1.f / lt : 0.f;
        if (hi == 0) c.wsf[r32] = inv * gate1;
        asm volatile("s_waitcnt lgkmcnt(0)" ::: "memory");
#pragma unroll
        for (int r = 0; r < 16; ++r) { const float a = c.wsf[crow(r, hi)]; oc[0][r] += o[0][r] * a; oc[1][r] += o[1][r] * a; }
    }
    {
        const int jlo = (qt - 8) > 0 ? (qt - 8) : 0, NT = (variant & 2) ? 0 : (qt - jlo + 1);
#if defined(PROBE_NSA_WIN2)
        o[0] = f32x16{}; o[1] = f32x16{}; m = NEG2; l = 0.f;
        run_pass<2>(c, NT, jlo, PNL(PROJ, P_KW) + (size_t)b * SEQ * PP + g * HD, PNL(PROJ, P_VW) + (size_t)b * SEQ * PP + g * HD, PP, qr, 0u, 0u, o, im, m, l);
#endif
        o[0] = f32x16{}; o[1] = f32x16{}; m = NEG2; l = 0.f;
        run_pass<2>(c, NT, jlo, PNL(PROJ, P_KW) + (size_t)b * SEQ * PP + g * HD, PNL(PROJ, P_VW) + (size_t)b * SEQ * PP + g * HD, PP, qr, 0u, 0u, o, im, m, l);
        const float lt = swap_add(l);
        const float inv = lt > 0.f ? 1.f / lt : 0.f;
        if (hi == 0) c.wsf[r32] = inv * gate2;
        asm volatile("s_waitcnt lgkmcnt(0)" ::: "memory");
#pragma unroll
        for (int r = 0; r < 16; ++r) { const float a = c.wsf[crow(r, hi)]; oc[0][r] += o[0][r] * a; oc[1][r] += o[1][r] * a; }
    }
    {
        __attribute__((address_space(3))) unsigned short* stg = (__attribute__((address_space(3))) unsigned short*)(lds3 + L_X) + wid * 2048;
#pragma unroll
        for (int r = 0; r < 16; ++r) { const int orow = crow(r, hi);
#pragma unroll
            for (int d0 = 0; d0 < 2; ++d0) stg[orow * 64 + d0 * 32 + r32] = (unsigned short)f2bf(oc[d0][r]); }
        asm volatile("s_waitcnt lgkmcnt(0)" ::: "memory");
        bf16* Ow = ONSA + (size_t)(b * SEQ + t0 + 32 * th) * NSA_Q + (g * 4 + hh) * HD;
#pragma unroll
        for (int i = 0; i < 4; ++i) { const int row = i * 8 + (lane >> 3), ch = lane & 7;
            const u32x4 vv = *(const __attribute__((address_space(3))) u32x4*)(stg + row * 64 + ch * 8);
            *(u32x4*)(Ow + (size_t)row * NSA_Q + ch * 8) = vv; }
    }
    asm volatile("s_waitcnt vmcnt(0) lgkmcnt(0)" ::: "memory");
    __syncthreads();
}

__device__ __forceinline__ void nsa_phase(const bf16* PROJ, const bf16* KCBb, const bf16* VCBb, const float* rel, bf16* ONSA, lds_ptr lds3, int vcu, int G, int variant) {
    const unsigned lds0 = (unsigned)(uintptr_t)lds3;
    build_ov(lds3);
    __syncthreads();
    int last_g = -1;
#ifndef NSA_REP
#define NSA_REP 1
#endif
#pragma unroll 1
    for (int rep_ = 0; rep_ < NSA_REP; ++rep_)
#pragma unroll 1
    for (int i = vcu; i < 512; i += G) {
        const int k = i & 255, bg = k >> 5, s = k & 31, qt = (i < 256) ? s : 63 - s;
        if (!(variant & 16)) nsa_unit(variant, (bg & 3) != last_g, bg >> 2, bg & 3, qt, PROJ, KCBb, VCBb, rel, ONSA, lds3, lds0);
        last_g = bg & 3;
    }
}
#undef NSA_WAIT_BAR
#undef NSA_SBAR
}
namespace nsa {
constexpr float STICK_THR = 50.f, LN2F = 0.6931471805599453f;
#define NSA_WAIT_BAR(N) asm volatile("s_waitcnt vmcnt(" #N ") lgkmcnt(0)\n\ts_barrier" ::: "memory")
__device__ __forceinline__ void stick_unit(int tid, int b, int h, int qb, const bf16* PROJ, bf16* OSB, lds_ptr lds3, unsigned lds0, const bf16x8 (&tri)[2]) {
    const int lane = tid & 63, r32 = lane & 31, hi = lane >> 5;
    const int wid = __builtin_amdgcn_readfirstlane(tid >> 6);
    const int q0 = qb * 256, t = q0 + 32 * wid + r32;
    const bf16* Kb = PNL(PROJ, P_KB + (h >> 2)) + (size_t)b * SEQ * PP + (h & 3) * HD;
    const bf16* Vb = PNL(PROJ, P_VB + (h >> 2)) + (size_t)b * SEQ * PP + (h & 3) * HD;
    __attribute__((address_space(3))) int* DONE = (__attribute__((address_space(3))) int*)(lds3 + L_MISC);
    bf16x8 qr[4];
#pragma unroll
    for (int d0 = 0; d0 < 4; ++d0) qr[d0] = *(const bf16x8*)(PNL(PROJ, P_QB + (h >> 2)) + (size_t)(b * SEQ + t) * PP + (h & 3) * HD + d0 * 16 + hi * 8);
    if (tid < 8) DONE[tid] = 0x7fffffff;
    asm volatile("s_waitcnt vmcnt(0) lgkmcnt(0)" ::: "memory");
    __syncthreads();
    const int jhi = 4 * qb + 3, NT = jhi + 1;
    const int jw = (q0 + 32 * wid + 30) >> 6;
    const int vboff = ((lane >> 4) & 1) * 32 + (lane & 3) * 8 + (4 * hi + ((lane & 15) >> 2)) * 64;
    f32x16 o[2] = {};
    float carry = 0.f; bool mydone = false;
#define STK_ISSUE(i, slot) do { const int id_ = jhi - (i); \
        const bf16* ks_ = Kb + (size_t)(64 * id_ + lane) * PP + 8 * wid; \
        const bf16* vs_ = Vb + (size_t)(64 * id_ + 16 * (wid & 3) + (lane >> 2)) * PP + 32 * (wid >> 2) + 8 * (lane & 3); \
        glds16(ks_, (unsigned)__builtin_amdgcn_readfirstlane(lds0 + L_RING + (slot) * SLOTB + wid * 1024)); \
        glds16(vs_, (unsigned)__builtin_amdgcn_readfirstlane(lds0 + L_RING + (slot) * SLOTB + 8192 + wid * 1024)); } while (0)
    STK_ISSUE(0, 0);
    if (NT > 1) STK_ISSUE(1, 1);
    int slot = 0;
    for (int i = 0; i < NT; ++i) {
        if (i + 1 < NT) NSA_WAIT_BAR(2); else NSA_WAIT_BAR(0);
        bool alld = true;
#pragma unroll
        for (int w = 0; w < 8; ++w) alld = alld && (DONE[w] < i);
        if (__builtin_amdgcn_readfirstlane((int)alld)) break;
        if (i + 2 < NT) { const int s2 = (slot == 0) ? 2 : slot - 1; STK_ISSUE(i + 2, s2); }
        const int j = jhi - i;
        if (!mydone && j <= jw) {
            f32x16 p0, p1, x0, x1;
            qkt(p0, p1, (lds_cptr)(lds3 + L_RING + slot * SLOTB), qr, r32, hi);
            float s0 = 0.f, s1 = 0.f;
#pragma unroll
            for (int r = 0; r < 16; ++r) {
                const int pos0 = 64 * j + crow(r, hi);
                const float z0 = p0[r] * 0.125f, z1 = p1[r] * 0.125f;
                const float L0 = __builtin_amdgcn_logf(1.f + __builtin_amdgcn_exp2f(-fabsf(z0) * LOG2E)) * LN2F;
                const float L1 = __builtin_amdgcn_logf(1.f + __builtin_amdgcn_exp2f(-fabsf(z1) * LOG2E)) * LN2F;
                p0[r] = fminf(z0, 0.f) - L0; p1[r] = fminf(z1, 0.f) - L1;
                x0[r] = (pos0 < t) ? (-fmaxf(z0, 0.f) - L0) : 0.f; x1[r] = (pos0 + 32 < t) ? (-fmaxf(z1, 0.f) - L1) : 0.f;
                s0 += x0[r]; s1 += x1[r];
            }
            const float tot0 = swap_add(s0), tot1 = swap_add(s1);
            u32x4 h0a, h0b, l0a, l0b, h1a, h1b, l1a, l1b;
#define STK_SPLIT(X, HA, HB, LA, LB) do { unsigned hw_[8]; float lo_[16]; \
                _Pragma("unroll") for (int q_ = 0; q_ < 8; ++q_) { hw_[q_] = cvtpk_s(X[2 * q_], X[2 * q_ + 1]); \
                    lo_[2 * q_] = X[2 * q_] - __uint_as_float(hw_[q_] << 16); lo_[2 * q_ + 1] = X[2 * q_ + 1] - __uint_as_float(hw_[q_] & 0xffff0000u); } \
                HA = (u32x4){hw_[0], hw_[1], hw_[2], hw_[3]}; HB = (u32x4){hw_[4], hw_[5], hw_[6], hw_[7]}; \
                LA = (u32x4){cvtpk_s(lo_[0], lo_[1]), cvtpk_s(lo_[2], lo_[3]), cvtpk_s(lo_[4], lo_[5]), cvtpk_s(lo_[6], lo_[7])}; \
                LB = (u32x4){cvtpk_s(lo_[8], lo_[9]), cvtpk_s(lo_[10], lo_[11]), cvtpk_s(lo_[12], lo_[13]), cvtpk_s(lo_[14], lo_[15])}; } while (0)
            STK_SPLIT(x0, h0a, h0b, l0a, l0b);
            STK_SPLIT(x1, h1a, h1b, l1a, l1b);
#undef STK_SPLIT
            f32x16 y0, y1;
#pragma unroll
            for (int r = 0; r < 16; ++r) { y0[r] = carry + tot1; y1[r] = carry; }
            y0 = __builtin_amdgcn_mfma_f32_32x32x16_bf16(tri[0], __builtin_bit_cast(bf16x8, h0a), y0, 0, 0, 0);
            y0 = __builtin_amdgcn_mfma_f32_32x32x16_bf16(tri[1], __builtin_bit_cast(bf16x8, h0b), y0, 0, 0, 0);
            y0 = __builtin_amdgcn_mfma_f32_32x32x16_bf16(tri[0], __builtin_bit_cast(bf16x8, l0a), y0, 0, 0, 0);
            y0 = __builtin_amdgcn_mfma_f32_32x32x16_bf16(tri[1], __builtin_bit_cast(bf16x8, l0b), y0, 0, 0, 0);
            y1 = __builtin_amdgcn_mfma_f32_32x32x16_bf16(tri[0], __builtin_bit_cast(bf16x8, h1a), y1, 0, 0, 0);
            y1 = __builtin_amdgcn_mfma_f32_32x32x16_bf16(tri[1], __builtin_bit_cast(bf16x8, h1b), y1, 0, 0, 0);
            y1 = __builtin_amdgcn_mfma_f32_32x32x16_bf16(tri[0], __builtin_bit_cast(bf16x8, l1a), y1, 0, 0, 0);
            y1 = __builtin_amdgcn_mfma_f32_32x32x16_bf16(tri[1], __builtin_bit_cast(bf16x8, l1b), y1, 0, 0, 0);
#pragma unroll
            for (int r = 0; r < 16; ++r) {
                const int pos0 = 64 * j + crow(r, hi);
                y0[r] = (pos0 < t) ? __builtin_amdgcn_exp2f((p0[r] + y0[r]) * LOG2E) : 0.f;
                y1[r] = (pos0 + 32 < t) ? __builtin_amdgcn_exp2f((p1[r] + y1[r]) * LOG2E) : 0.f;
            }
            carry += tot0 + tot1;
            u32x4 pw0, pw1, pw2, pw3;
            pw0 = (u32x4){cvtpk_s(y0[0], y0[1]), cvtpk_s(y0[2], y0[3]), cvtpk_s(y0[4], y0[5]), cvtpk_s(y0[6], y0[7])};
            pw1 = (u32x4){cvtpk_s(y0[8], y0[9]), cvtpk_s(y0[10], y0[11]), cvtpk_s(y0[12], y0[13]), cvtpk_s(y0[14], y0[15])};
            pw2 = (u32x4){cvtpk_s(y1[0], y1[1]), cvtpk_s(y1[2], y1[3]), cvtpk_s(y1[4], y1[5]), cvtpk_s(y1[6], y1[7])};
            pw3 = (u32x4){cvtpk_s(y1[8], y1[9]), cvtpk_s(y1[10], y1[11]), cvtpk_s(y1[12], y1[13]), cvtpk_s(y1[14], y1[15])};
            __builtin_amdgcn_sched_barrier(0);
            pv(o, (int)(lds0 + L_RING + slot * SLOTB + 8192) + vboff, __builtin_bit_cast(bf16x8, pw0), __builtin_bit_cast(bf16x8, pw1), __builtin_bit_cast(bf16x8, pw2), __builtin_bit_cast(bf16x8, pw3));
            mydone = __all(carry < -STICK_THR) != 0;
            if (mydone && lane == 0) DONE[wid] = i;
        }
        slot = (slot == 2) ? 0 : slot + 1;
    }
    asm volatile("s_waitcnt vmcnt(0) lgkmcnt(0)\n\ts_barrier" ::: "memory");
#undef STK_ISSUE
    {
        __attribute__((address_space(3))) unsigned short* stg = (__attribute__((address_space(3))) unsigned short*)(lds3 + L_X) + wid * 2048;
#pragma unroll
        for (int r = 0; r < 16; ++r) { const int orow = crow(r, hi);
#pragma unroll
            for (int d0 = 0; d0 < 2; ++d0) stg[orow * 64 + d0 * 32 + r32] = (unsigned short)f2bf(o[d0][r]); }
        asm volatile("s_waitcnt lgkmcnt(0)" ::: "memory");
        bf16* Ow = OSB + (size_t)(b * SEQ + q0 + 32 * wid) * SB_W + h * HD;
#pragma unroll
        for (int i = 0; i < 4; ++i) { const int row = i * 8 + (lane >> 3), ch = lane & 7;
            const u32x4 vv = *(const __attribute__((address_space(3))) u32x4*)(stg + row * 64 + ch * 8);
            *(u32x4*)(Ow + (size_t)row * SB_W + ch * 8) = vv; }
    }
    asm volatile("s_waitcnt vmcnt(0) lgkmcnt(0)" ::: "memory");
    __syncthreads();
}
__device__ __forceinline__ void stick_phase(const bf16* PROJ, bf16* OSB, lds_ptr lds3, int vcu, int G) {
    const unsigned lds0 = (unsigned)(uintptr_t)lds3;
    int tid = threadIdx.x; asm volatile("" : "+v"(tid));
    const int lane = tid & 63, r32 = lane & 31, hi = lane >> 5;
    bf16x8 tri[2];
#pragma unroll
    for (int s = 0; s < 2; ++s)
#pragma unroll
        for (int j = 0; j < 8; ++j) tri[s][j] = ((16 * s + 8 * (j >> 2) + 4 * hi + (j & 3)) > r32) ? (short)0x3F80 : (short)0;
    for (int i = vcu; i < 512; i += G) {
        const int bh = i >> 4, qb = i & 15;
        stick_unit(tid, bh >> 4, bh & 15, qb, PROJ, OSB, lds3, lds0, tri);
    }
}
#undef NSA_WAIT_BAR
}
namespace peer {
typedef short bf16x8 __attribute__((ext_vector_type(8)));
typedef float f32x16 __attribute__((ext_vector_type(16)));
typedef __bf16 b2_t __attribute__((ext_vector_type(2)));
constexpr int L_EX = 0, L_GT = 16384;
__device__ __forceinline__ int crow(int r, int hi) { return (r & 3) + 8 * (r >> 2) + 4 * hi; }
__device__ __forceinline__ unsigned mono(float f) { const unsigned u = __float_as_uint(f); return (u & 0x80000000u) ? ~u : (u | 0x80000000u); }
__device__ __forceinline__ float unmono(unsigned k) { return __uint_as_float((k & 0x80000000u) ? (k & 0x7fffffffu) : ~k); }
__device__ __forceinline__ float dot2(unsigned a, unsigned b, float c) { return __builtin_amdgcn_fdot2_f32_bf16(__builtin_bit_cast(b2_t, a), __builtin_bit_cast(b2_t, b), c, false); }
#define PEER_CE(key, slot) do { const unsigned hi_ = (key) > (slot) ? (key) : (slot); (key) = (key) > (slot) ? (slot) : (key); (slot) = hi_; } while (0)

__device__ __forceinline__ void route_list(const bf16* QP, const bf16* SKB, int L, int tok0, int r32, int hi, unsigned (&out)[16]) {
    f32x16 acc[4] = {};
    const bf16* qp = QP + (size_t)(tok0 + r32) * 2048 + L * 128 + hi * 8;
    const bf16* kp = SKB + ((size_t)L * 128 + r32) * 128 + hi * 8;
    int hi4 = 4 * hi;
    asm volatile("" : "+v"(qp), "+v"(kp), "+v"(hi4));
#pragma unroll
    for (int ks = 0; ks < 8; ++ks) {
        const bf16x8 bq = *(const bf16x8*)(qp + ks * 16);
#pragma unroll
        for (int kt = 0; kt < 4; ++kt) { const bf16x8 a = *(const bf16x8*)(kp + (size_t)kt * 32 * 128 + ks * 16); acc[kt] = __builtin_amdgcn_mfma_f32_32x32x16_bf16(a, bq, acc[kt], 0, 0, 0); }
    }
    unsigned t[16];
#pragma unroll
    for (int k = 0; k < 16; ++k) t[k] = 0u;
#pragma unroll
    for (int kt = 0; kt < 4; ++kt)
#pragma unroll
        for (int r = 0; r < 16; ++r) {
            unsigned key = ((mono(acc[kt][r]) & ~127u) | (unsigned)(127 - (32 * kt + (r & 3) + 8 * (r >> 2)))) - (unsigned)hi4;
#pragma unroll
            for (int k = 0; k < 16; ++k) PEER_CE(key, t[k]);
            __builtin_amdgcn_sched_barrier(0);
        }
    unsigned u[16];
#pragma unroll
    for (int k = 0; k < 16; ++k) { auto rr = __builtin_amdgcn_permlane32_swap(t[k], t[k], false, false); u[k] = hi ? rr[0] : rr[1]; }
#pragma unroll
    for (int k = 0; k < 16; ++k) out[k] = t[k] > u[15 - k] ? t[k] : u[15 - k];
#pragma unroll
    for (int st = 8; st >= 1; st >>= 1)
#pragma unroll
        for (int k = 0; k < 16; ++k) if ((k & st) == 0) { const unsigned a = out[k], b = out[k | st]; out[k] = a > b ? a : b; out[k | st] = a > b ? b : a; }
}

__device__ __forceinline__ void route_head(const bf16* QP, const bf16* SKB, int h, int tok0, int lane, __attribute__((address_space(3))) unsigned char* lds3) {
    asm volatile("" : "+v"(lane));
    const int r32 = lane & 31, hi = lane >> 5;
    unsigned A[16], B[16];
    route_list(QP, SKB, 2 * h, tok0, r32, hi, A);
    route_list(QP, SKB, 2 * h + 1, tok0, r32, hi, B);
    float va[16], vb[16]; int ia[16], ib[16];
#pragma unroll
    for (int k = 0; k < 16; ++k) { va[k] = unmono((A[k] & ~127u) | 64u); vb[k] = unmono((B[k] & ~127u) | 64u); ia[k] = 127 - (int)(A[k] & 127u); ib[k] = 127 - (int)(B[k] & 127u); }
    unsigned s[16], sp[16];
#pragma unroll
    for (int k = 0; k < 16; ++k) { s[k] = 0u; sp[k] = 0u; }
#pragma unroll
    for (int i = 0; i < 16; ++i)
#pragma unroll
        for (int j = 0; j < 16; ++j) if ((i + 1) * (j + 1) <= 16) {
            unsigned key = mono(va[i] + vb[j]); unsigned pay = (unsigned)(ia[i] * PEER_KEYS + ib[j]);
#pragma unroll
            for (int k = (i + 1) * (j + 1) - 1; k < 16; ++k) { const bool gt = key > s[k]; const unsigned ts = s[k], tp = sp[k]; s[k] = gt ? key : ts; sp[k] = gt ? pay : tp; key = gt ? ts : key; pay = gt ? tp : pay; }
            __builtin_amdgcn_sched_barrier(0);
        }
    const float mx = unmono(s[0]);
    float e[16], sum = 0.f;
#pragma unroll
    for (int k = 0; k < 16; ++k) { e[k] = __expf(unmono(s[k]) - mx); sum += e[k]; }
    const float inv = 1.f / sum;
    if (hi == 0) {
        __attribute__((address_space(3))) int* EX = (__attribute__((address_space(3))) int*)(lds3 + L_EX);
        __attribute__((address_space(3))) float* GT = (__attribute__((address_space(3))) float*)(lds3 + L_GT);
#pragma unroll
        for (int k = 0; k < 16; ++k) { EX[(h * 16 + k) * 32 + r32] = (int)sp[k]; GT[(h * 16 + k) * 32 + r32] = e[k] * inv; }
    }
}

__device__ __forceinline__ void cvt_row_fp8(const float* src, unsigned char* dst, float* inv_scale, int row, int lane) {
    const float* p = src + (size_t)row * 2048 + lane * 16;
    f32x4 v[8]; float am = 0.f;
#pragma unroll
    for (int j = 0; j < 2; ++j)
#pragma unroll
        for (int c = 0; c < 4; ++c) { v[4 * j + c] = *(const f32x4*)(p + j * 1024 + 4 * c);
            am = fmaxf(am, fmaxf(fmaxf(fabsf(v[4 * j + c].x), fabsf(v[4 * j + c].y)), fmaxf(fabsf(v[4 * j + c].z), fabsf(v[4 * j + c].w)))); }
    am = wave_max(am);
    const float sc = am > 0.f ? 384.f / am : 1.f;
#pragma unroll
    for (int j = 0; j < 2; ++j) { v4u o;
#pragma unroll
        for (int c = 0; c < 4; ++c) { int w = 0; w = __builtin_amdgcn_cvt_pk_fp8_f32(v[4 * j + c].x * sc, v[4 * j + c].y * sc, w, false); w = __builtin_amdgcn_cvt_pk_fp8_f32(v[4 * j + c].z * sc, v[4 * j + c].w * sc, w, true); o[c] = (unsigned)w; }
        *(v4u*)(dst + (size_t)row * 2048 + j * 1024 + lane * 16) = o; }
    if (lane == 0) inv_scale[row] = am > 0.f ? am / 384.f : 1.f;
}
typedef float f32x2v __attribute__((ext_vector_type(2)));
__device__ __forceinline__ unsigned cvtpk_bf(float lo, float hi) { typedef __bf16 b2v __attribute__((ext_vector_type(2))); f32x2v v = {lo, hi}; b2v b = __builtin_convertvector(v, b2v); return __builtin_bit_cast(unsigned, b); }
__device__ __forceinline__ float dot32_fp8(const unsigned (&x)[16], v4u q0, v4u q1) {
    float d = 0.f;
#pragma unroll
    for (int c = 0; c < 4; ++c) { const int w0 = (int)q0[c], w1 = (int)q1[c];
        const f32x2v a = __builtin_amdgcn_cvt_pk_f32_fp8(w0, false), b = __builtin_amdgcn_cvt_pk_f32_fp8(w0, true), e = __builtin_amdgcn_cvt_pk_f32_fp8(w1, false), f = __builtin_amdgcn_cvt_pk_f32_fp8(w1, true);
        d = dot2(x[2 * c + 0], cvtpk_bf(a.x, a.y), d); d = dot2(x[2 * c + 1], cvtpk_bf(b.x, b.y), d);
        d = dot2(x[8 + 2 * c + 0], cvtpk_bf(e.x, e.y), d); d = dot2(x[8 + 2 * c + 1], cvtpk_bf(f.x, f.y), d); }
    return d;
}
__device__ __forceinline__ void axpy32_fp8(float (&acc)[32], float w, v4u q0, v4u q1) {
#pragma unroll
    for (int c = 0; c < 4; ++c) { const int w0 = (int)q0[c], w1 = (int)q1[c];
        const f32x2v a = __builtin_amdgcn_cvt_pk_f32_fp8(w0, false), b = __builtin_amdgcn_cvt_pk_f32_fp8(w0, true), e = __builtin_amdgcn_cvt_pk_f32_fp8(w1, false), f = __builtin_amdgcn_cvt_pk_f32_fp8(w1, true);
        acc[4 * c + 0] += w * a.x; acc[4 * c + 1] += w * a.y; acc[4 * c + 2] += w * b.x; acc[4 * c + 3] += w * b.y;
        acc[16 + 4 * c + 0] += w * e.x; acc[16 + 4 * c + 1] += w * e.y; acc[16 + 4 * c + 2] += w * f.x; acc[16 + 4 * c + 3] += w * f.y; }
}
#if defined(PROBE_NOSORT)
constexpr int PEER_SORT_N = 1;
#else
constexpr int PEER_SORT_N = 512;
#endif
constexpr int L_SK = 32768, L_W = 49152;

__device__ __forceinline__ void ffn_wave(int tok0, int wid, int lane, const float* H, const float* SS, const float* gffn, const unsigned char* U8, const unsigned char* V8,
                                         const float* IU, const float* IV, const float* gfin, float* out, __attribute__((address_space(3))) unsigned char* lds3, unsigned rot) {
    asm volatile("" : "+v"(lane));
    const __attribute__((address_space(3))) int* EX = (const __attribute__((address_space(3))) int*)(lds3 + L_EX);
    const __attribute__((address_space(3))) float* GT = (const __attribute__((address_space(3))) float*)(lds3 + L_GT);
    __attribute__((address_space(3))) unsigned* SK = (__attribute__((address_space(3))) unsigned*)(lds3 + L_SK) + wid * 512;
    __attribute__((address_space(3))) float* WW = (__attribute__((address_space(3))) float*)(lds3 + L_W) + wid * 512;
#pragma unroll
    for (int i = 0; i < 8; ++i) { const int p = lane + 64 * i; const unsigned e = (unsigned)EX[(p & 127) * 32 + 4 * wid + (p >> 7)]; SK[p] = (((e - rot) & 16383u) << 9) | (unsigned)p; }
    asm volatile("s_waitcnt lgkmcnt(0)" ::: "memory");
#pragma unroll 1
    for (int k = 2; k <= PEER_SORT_N; k <<= 1)
#pragma unroll 1
        for (int j = k >> 1; j > 0; j >>= 1) {
#pragma unroll
            for (int t = 0; t < 4; ++t) { const int mth = lane + 64 * t; const int i = ((mth & ~(j - 1)) << 1) | (mth & (j - 1)); const int pr = i | j;
                const unsigned a = SK[i], b = SK[pr]; const bool asc = (i & k) == 0; const bool sw = (a > b) == asc;
                SK[i] = sw ? b : a; SK[pr] = sw ? a : b; }
            asm volatile("s_waitcnt lgkmcnt(0)" ::: "memory");
        }
    unsigned x0[16], x1[16], x2[16], x3[16];
#define PEER_LOADX(XR, TK) do { const int n_ = tok0 + 4 * wid + (TK); const float rs_ = rsqrtf(SS[n_] * (1.f / D_MODEL) + EPS); \
        _Pragma("unroll") for (int j = 0; j < 2; ++j) _Pragma("unroll") for (int c = 0; c < 4; ++c) { \
            const f32x4 hv_ = *(const f32x4*)(H + (size_t)n_ * 2048 + j * 1024 + lane * 16 + 4 * c), gv_ = *(const f32x4*)(gffn + j * 1024 + lane * 16 + 4 * c); \
            XR[8 * j + 2 * c + 0] = pk2(hv_.x * rs_ * gv_.x, hv_.y * rs_ * gv_.y); XR[8 * j + 2 * c + 1] = pk2(hv_.z * rs_ * gv_.z, hv_.w * rs_ * gv_.w); } } while (0)
    PEER_LOADX(x0, 0); __builtin_amdgcn_sched_barrier(0); PEER_LOADX(x1, 1); __builtin_amdgcn_sched_barrier(0); PEER_LOADX(x2, 2); __builtin_amdgcn_sched_barrier(0); PEER_LOADX(x3, 3); __builtin_amdgcn_sched_barrier(0);
#undef PEER_LOADX
    const bool b5 = (lane & 32) != 0, b4 = (lane & 16) != 0;
#pragma unroll 1
    for (int i0 = 0; i0 < 512; i0 += 4) {
        int e[4], p[4]; v4u q0[4], q1[4];
#pragma unroll
        for (int k = 0; k < 4; ++k) { const unsigned key = (unsigned)__builtin_amdgcn_readfirstlane((int)SK[i0 + k]); e[k] = (int)(((key >> 9) + rot) & 16383u); p[k] = (int)(key & 511u);
            const unsigned char* ur = U8 + (size_t)e[k] * 2048 + lane * 16; q0[k] = *(const v4u*)ur; q1[k] = *(const v4u*)(ur + 1024); }
        float d[4];
#pragma unroll
        for (int k = 0; k < 4; ++k) { const int tk = p[k] >> 7; d[k] = 0.f;
            if (tk == 0) d[k] = dot32_fp8(x0, q0[k], q1[k]);
            if (tk == 1) d[k] = dot32_fp8(x1, q0[k], q1[k]);
            if (tk == 2) d[k] = dot32_fp8(x2, q0[k], q1[k]);
            if (tk == 3) d[k] = dot32_fp8(x3, q0[k], q1[k]); }
        float a01 = (b5 ? d[1] : d[0]) + __shfl_xor(b5 ? d[0] : d[1], 32);
        float a23 = (b5 ? d[3] : d[2]) + __shfl_xor(b5 ? d[2] : d[3], 32);
        float t = (b4 ? a23 : a01) + __shfl_xor(b4 ? a01 : a23, 16);
        t += __shfl_xor(t, 8); t += __shfl_xor(t, 4); t += __shfl_xor(t, 2); t += __shfl_xor(t, 1);
        float iu[4], iv[4], gt[4];
#pragma unroll
        for (int k = 0; k < 4; ++k) { iu[k] = IU[e[k]]; iv[k] = IV[e[k]]; gt[k] = GT[(p[k] & 127) * 32 + 4 * wid + (p[k] >> 7)]; }
        const float ius = b5 ? (b4 ? iu[3] : iu[1]) : (b4 ? iu[2] : iu[0]);
        const float ivs = b5 ? (b4 ? iv[3] : iv[1]) : (b4 ? iv[2] : iv[0]);
        const float gts = b5 ? (b4 ? gt[3] : gt[1]) : (b4 ? gt[2] : gt[0]);
        const int ksel = b5 ? (b4 ? 3 : 1) : (b4 ? 2 : 0);
        const float wv = gts * gelu_tanh(t * ius) * ivs;
        if ((lane & 15) == 0) WW[i0 + ksel] = wv;
    }
    asm volatile("s_waitcnt lgkmcnt(0)" ::: "memory");
    float a0[32], a1[32], a2[32], a3[32];
#pragma unroll
    for (int j = 0; j < 32; ++j) { a0[j] = 0.f; a1[j] = 0.f; a2[j] = 0.f; a3[j] = 0.f; }
#pragma unroll 1
    for (int i0 = 0; i0 < 512; i0 += 2) {
        int p[2]; float w[2]; v4u q0[2], q1[2];
#pragma unroll
        for (int k = 0; k < 2; ++k) { const unsigned key = (unsigned)__builtin_amdgcn_readfirstlane((int)SK[i0 + k]); const int e = (int)(((key >> 9) + rot) & 16383u); p[k] = (int)(key & 511u);
            w[k] = __uint_as_float(__builtin_amdgcn_readfirstlane(__float_as_uint(WW[i0 + k])));
            const unsigned char* vr = V8 + (size_t)e * 2048 + lane * 16; q0[k] = *(const v4u*)vr; q1[k] = *(const v4u*)(vr + 1024); }
#pragma unroll
        for (int k = 0; k < 2; ++k) { const int tk = p[k] >> 7;
            const float w0 = tk == 0 ? w[k] : 0.f, w1 = tk == 1 ? w[k] : 0.f, w2 = tk == 2 ? w[k] : 0.f, w3 = tk == 3 ? w[k] : 0.f;
#pragma unroll
            for (int c = 0; c < 4; ++c) { const int u0 = (int)q0[k][c], u1 = (int)q1[k][c];
                const f32x2v a = __builtin_amdgcn_cvt_pk_f32_fp8(u0, false), b = __builtin_amdgcn_cvt_pk_f32_fp8(u0, true), e = __builtin_amdgcn_cvt_pk_f32_fp8(u1, false), f = __builtin_amdgcn_cvt_pk_f32_fp8(u1, true);
#define PEER_AX(AR, WT) AR[4 * c + 0] += WT * a.x; AR[4 * c + 1] += WT * a.y; AR[4 * c + 2] += WT * b.x; AR[4 * c + 3] += WT * b.y; AR[16 + 4 * c + 0] += WT * e.x; AR[16 + 4 * c + 1] += WT * e.y; AR[16 + 4 * c + 2] += WT * f.x; AR[16 + 4 * c + 3] += WT * f.y;
                PEER_AX(a0, w0) PEER_AX(a1, w1) PEER_AX(a2, w2) PEER_AX(a3, w3)
#undef PEER_AX
            } }
    }
#define PEER_FIN(AR, TK) do { const int n_ = tok0 + 4 * wid + (TK); float sq_ = 0.f; \
        _Pragma("unroll") for (int j = 0; j < 2; ++j) _Pragma("unroll") for (int c = 0; c < 4; ++c) { const f32x4 hv_ = *(const f32x4*)(H + (size_t)n_ * 2048 + j * 1024 + lane * 16 + 4 * c); \
            AR[16 * j + 4 * c + 0] += hv_.x; AR[16 * j + 4 * c + 1] += hv_.y; AR[16 * j + 4 * c + 2] += hv_.z; AR[16 * j + 4 * c + 3] += hv_.w; } \
        _Pragma("unroll") for (int j = 0; j < 32; ++j) sq_ += AR[j] * AR[j]; \
        const float r_ = rsqrtf(wave_sum(sq_) * (1.f / D_MODEL) + EPS); \
        _Pragma("unroll") for (int j = 0; j < 2; ++j) _Pragma("unroll") for (int c = 0; c < 4; ++c) { const f32x4 gv_ = *(const f32x4*)(gfin + j * 1024 + lane * 16 + 4 * c); \
            *(f32x4*)(out + (size_t)n_ * 2048 + j * 1024 + lane * 16 + 4 * c) = (f32x4){AR[16 * j + 4 * c + 0] * r_ * gv_.x, AR[16 * j + 4 * c + 1] * r_ * gv_.y, AR[16 * j + 4 * c + 2] * r_ * gv_.z, AR[16 * j + 4 * c + 3] * r_ * gv_.w}; } } while (0)
    asm volatile("" : "+v"(lane));
    PEER_FIN(a0, 0); __builtin_amdgcn_sched_barrier(0); PEER_FIN(a1, 1); __builtin_amdgcn_sched_barrier(0); PEER_FIN(a2, 2); __builtin_amdgcn_sched_barrier(0); PEER_FIN(a3, 3);
#undef PEER_FIN
}

__device__ __forceinline__ void ffn_token8(int n, int tl, int lane, const float* H, const float* SS, const float* gffn, const unsigned char* U8, const unsigned char* V8,
                                           const float* IU, const float* IV, const float* gfin, float* out, __attribute__((address_space(3))) unsigned char* lds3) {
    const __attribute__((address_space(3))) int* EX = (const __attribute__((address_space(3))) int*)(lds3 + L_EX);
    const __attribute__((address_space(3))) float* GT = (const __attribute__((address_space(3))) float*)(lds3 + L_GT);
    unsigned xq[16];
    { const float rs_ = rsqrtf(SS[n] * (1.f / D_MODEL) + EPS);
#pragma unroll
      for (int j = 0; j < 2; ++j)
#pragma unroll
        for (int c = 0; c < 4; ++c) { const f32x4 hv_ = *(const f32x4*)(H + (size_t)n * 2048 + j * 1024 + lane * 16 + 4 * c), gv_ = *(const f32x4*)(gffn + j * 1024 + lane * 16 + 4 * c);
            xq[8 * j + 2 * c + 0] = pk2(hv_.x * rs_ * gv_.x, hv_.y * rs_ * gv_.y); xq[8 * j + 2 * c + 1] = pk2(hv_.z * rs_ * gv_.z, hv_.w * rs_ * gv_.w); } }
    float acc[32];
#pragma unroll
    for (int j = 0; j < 32; ++j) acc[j] = 0.f;
    const bool b5 = (lane & 32) != 0, b4 = (lane & 16) != 0;
#pragma unroll 1
    for (int e0 = 0; e0 < PEER_E; e0 += 4) {
        int ei[4]; float gt[4], iu[4], iv[4]; v4u u0[4], u1[4], v0[4], v1[4];
#pragma unroll
        for (int k = 0; k < 4; ++k) { ei[k] = __builtin_amdgcn_readfirstlane(EX[(e0 + k) * 32 + tl]); gt[k] = GT[(e0 + k) * 32 + tl];
            const unsigned char* ur = U8 + (size_t)ei[k] * 2048 + lane * 16; u0[k] = *(const v4u*)ur; u1[k] = *(const v4u*)(ur + 1024);
            const unsigned char* vr = V8 + (size_t)ei[k] * 2048 + lane * 16; v0[k] = *(const v4u*)vr; v1[k] = *(const v4u*)(vr + 1024);
            iu[k] = IU[ei[k]]; iv[k] = IV[ei[k]]; }
        float d[4];
#pragma unroll
        for (int k = 0; k < 4; ++k) d[k] = dot32_fp8(xq, u0[k], u1[k]);
        float a01 = (b5 ? d[1] : d[0]) + __shfl_xor(b5 ? d[0] : d[1], 32);
        float a23 = (b5 ? d[3] : d[2]) + __shfl_xor(b5 ? d[2] : d[3], 32);
        float t = (b4 ? a23 : a01) + __shfl_xor(b4 ? a01 : a23, 16);
        t += __shfl_xor(t, 8); t += __shfl_xor(t, 4); t += __shfl_xor(t, 2); t += __shfl_xor(t, 1);
        const float ius = b5 ? (b4 ? iu[3] : iu[1]) : (b4 ? iu[2] : iu[0]);
        const float ivs = b5 ? (b4 ? iv[3] : iv[1]) : (b4 ? iv[2] : iv[0]);
        const float gts = b5 ? (b4 ? gt[3] : gt[1]) : (b4 ? gt[2] : gt[0]);
        const float wv = gts * gelu_tanh(t * ius) * ivs;
        float w[4];
        w[0] = __uint_as_float(__builtin_amdgcn_readlane(__float_as_uint(wv), 0));
        w[2] = __uint_as_float(__builtin_amdgcn_readlane(__float_as_uint(wv), 16));
        w[1] = __uint_as_float(__builtin_amdgcn_readlane(__float_as_uint(wv), 32));
        w[3] = __uint_as_float(__builtin_amdgcn_readlane(__float_as_uint(wv), 48));
#pragma unroll
        for (int k = 0; k < 4; ++k) axpy32_fp8(acc, w[k], v0[k], v1[k]);
    }
    float sq = 0.f;
#pragma unroll
    for (int j = 0; j < 2; ++j)
#pragma unroll
        for (int c = 0; c < 4; ++c) { const f32x4 hv_ = *(const f32x4*)(H + (size_t)n * 2048 + j * 1024 + lane * 16 + 4 * c);
            acc[16 * j + 4 * c + 0] += hv_.x; acc[16 * j + 4 * c + 1] += hv_.y; acc[16 * j + 4 * c + 2] += hv_.z; acc[16 * j + 4 * c + 3] += hv_.w; }
#pragma unroll
    for (int j = 0; j < 32; ++j) sq += acc[j] * acc[j];
    const float r_ = rsqrtf(wave_sum(sq) * (1.f / D_MODEL) + EPS);
#pragma unroll
    for (int j = 0; j < 2; ++j)
#pragma unroll
        for (int c = 0; c < 4; ++c) { const f32x4 gv_ = *(const f32x4*)(gfin + j * 1024 + lane * 16 + 4 * c);
            *(f32x4*)(out + (size_t)n * 2048 + j * 1024 + lane * 16 + 4 * c) = (f32x4){acc[16 * j + 4 * c + 0] * r_ * gv_.x, acc[16 * j + 4 * c + 1] * r_ * gv_.y, acc[16 * j + 4 * c + 2] * r_ * gv_.z, acc[16 * j + 4 * c + 3] * r_ * gv_.w}; }
}

#ifndef FP6_IDX
#define FP6_IDX(i) (((i) & 1) ? 16 + ((i) >> 1) : ((i) >> 1))
#endif
typedef float v16f_t __attribute__((ext_vector_type(16)));
typedef float v32f_t __attribute__((ext_vector_type(32)));
typedef unsigned v6u_t __attribute__((ext_vector_type(6)));
__device__ __forceinline__ void cvt_row_fp6(const float* src, unsigned char* dst, float* inv_scale, int row, int lane) {
    const float* p = src + (size_t)row * 2048 + lane * 16;
    f32x4 v[8]; float am = 0.f;
#pragma unroll
    for (int j = 0; j < 2; ++j)
#pragma unroll
        for (int c = 0; c < 4; ++c) { v[4 * j + c] = *(const f32x4*)(p + j * 1024 + 4 * c);
            am = fmaxf(am, fmaxf(fmaxf(fabsf(v[4 * j + c].x), fabsf(v[4 * j + c].y)), fmaxf(fabsf(v[4 * j + c].z), fabsf(v[4 * j + c].w)))); }
    am = wave_max(am);
    const float sc = am > 0.f ? 7.f / am : 1.f;
    v16f_t a, b;
#pragma unroll
    for (int c = 0; c < 4; ++c) { a[4 * c + 0] = v[c].x * sc; a[4 * c + 1] = v[c].y * sc; a[4 * c + 2] = v[c].z * sc; a[4 * c + 3] = v[c].w * sc;
        b[4 * c + 0] = v[4 + c].x * sc; b[4 * c + 1] = v[4 + c].y * sc; b[4 * c + 2] = v[4 + c].z * sc; b[4 * c + 3] = v[4 + c].w * sc; }
    const v6u_t q = __builtin_amdgcn_cvt_scalef32_2xpk16_fp6_f32(a, b, 1.0f);
    unsigned char* d = dst + (size_t)row * 1536;
    *(v4u*)(d + lane * 16) = (v4u){q[0], q[1], q[2], q[3]};
    *(v2u*)(d + 1024 + lane * 8) = (v2u){q[4], q[5]};
    if (lane == 0) inv_scale[row] = am > 0.f ? am / 7.f : 1.f;
}
__device__ __forceinline__ void ffn_token6(int n, int tl, int lane, const float* H, const float* SS, const float* gffn, const unsigned char* U6, const unsigned char* V6,
                                           const float* IU, const float* IV, const float* gfin, float* out, __attribute__((address_space(3))) unsigned char* lds3) {
    const __attribute__((address_space(3))) int* EX = (const __attribute__((address_space(3))) int*)(lds3 + L_EX);
    const __attribute__((address_space(3))) float* GT = (const __attribute__((address_space(3))) float*)(lds3 + L_GT);
    float xf[32];
    { const float rs_ = rsqrtf(SS[n] * (1.f / D_MODEL) + EPS);
#pragma unroll
      for (int j = 0; j < 2; ++j)
#pragma unroll
        for (int c = 0; c < 4; ++c) { const f32x4 hv_ = *(const f32x4*)(H + (size_t)n * 2048 + j * 1024 + lane * 16 + 4 * c), gv_ = *(const f32x4*)(gffn + j * 1024 + lane * 16 + 4 * c);
            xf[16 * j + 4 * c + 0] = hv_.x * rs_ * gv_.x; xf[16 * j + 4 * c + 1] = hv_.y * rs_ * gv_.y; xf[16 * j + 4 * c + 2] = hv_.z * rs_ * gv_.z; xf[16 * j + 4 * c + 3] = hv_.w * rs_ * gv_.w; } }
    float acc[32];
#pragma unroll
    for (int j = 0; j < 32; ++j) acc[j] = 0.f;
    const bool b5 = (lane & 32) != 0, b4 = (lane & 16) != 0;
#pragma unroll 1
    for (int e0 = 0; e0 < PEER_E; e0 += 4) {
        int ei[4]; float gt[4], iu[4], iv[4]; v4u ua[4], va[4]; v2u ub[4], vb[4];
#pragma unroll
        for (int k = 0; k < 4; ++k) { ei[k] = __builtin_amdgcn_readfirstlane(EX[(e0 + k) * 32 + tl]); gt[k] = GT[(e0 + k) * 32 + tl];
            const unsigned char* ur = U6 + (size_t)ei[k] * 1536; ua[k] = *(const v4u*)(ur + lane * 16); ub[k] = *(const v2u*)(ur + 1024 + lane * 8);
            const unsigned char* vr = V6 + (size_t)ei[k] * 1536; va[k] = *(const v4u*)(vr + lane * 16); vb[k] = *(const v2u*)(vr + 1024 + lane * 8);
            iu[k] = IU[ei[k]]; iv[k] = IV[ei[k]]; }
        float d[4];
#pragma unroll
        for (int k = 0; k < 4; ++k) { const v6u_t q = {ua[k].x, ua[k].y, ua[k].z, ua[k].w, ub[k].x, ub[k].y}; const v32f_t f = __builtin_amdgcn_cvt_scalef32_pk32_f32_fp6(q, 1.0f);
            float dk = 0.f;
#pragma unroll
            for (int i = 0; i < 32; ++i) dk += xf[FP6_IDX(i)] * f[i];
            d[k] = dk; __builtin_amdgcn_sched_barrier(0); }
        float a01 = (b5 ? d[1] : d[0]) + __shfl_xor(b5 ? d[0] : d[1], 32);
        float a23 = (b5 ? d[3] : d[2]) + __shfl_xor(b5 ? d[2] : d[3], 32);
        float t = (b4 ? a23 : a01) + __shfl_xor(b4 ? a01 : a23, 16);
        t += __shfl_xor(t, 8); t += __shfl_xor(t, 4); t += __shfl_xor(t, 2); t += __shfl_xor(t, 1);
        const float ius = b5 ? (b4 ? iu[3] : iu[1]) : (b4 ? iu[2] : iu[0]);
        const float ivs = b5 ? (b4 ? iv[3] : iv[1]) : (b4 ? iv[2] : iv[0]);
        const float gts = b5 ? (b4 ? gt[3] : gt[1]) : (b4 ? gt[2] : gt[0]);
        const float wv = gts * gelu_tanh(t * ius) * ivs;
        float w[4];
        w[0] = __uint_as_float(__builtin_amdgcn_readlane(__float_as_uint(wv), 0));
        w[2] = __uint_as_float(__builtin_amdgcn_readlane(__float_as_uint(wv), 16));
        w[1] = __uint_as_float(__builtin_amdgcn_readlane(__float_as_uint(wv), 32));
        w[3] = __uint_as_float(__builtin_amdgcn_readlane(__float_as_uint(wv), 48));
#pragma unroll
        for (int k = 0; k < 4; ++k) { const v6u_t q = {va[k].x, va[k].y, va[k].z, va[k].w, vb[k].x, vb[k].y}; const v32f_t f = __builtin_amdgcn_cvt_scalef32_pk32_f32_fp6(q, 1.0f);
#pragma unroll
            for (int i = 0; i < 32; ++i) acc[FP6_IDX(i)] += w[k] * f[i]; __builtin_amdgcn_sched_barrier(0); }
    }
    float sq = 0.f;
#pragma unroll
    for (int j = 0; j < 2; ++j)
#pragma unroll
        for (int c = 0; c < 4; ++c) { const f32x4 hv_ = *(const f32x4*)(H + (size_t)n * 2048 + j * 1024 + lane * 16 + 4 * c);
            acc[16 * j + 4 * c + 0] += hv_.x; acc[16 * j + 4 * c + 1] += hv_.y; acc[16 * j + 4 * c + 2] += hv_.z; acc[16 * j + 4 * c + 3] += hv_.w; }
#pragma unroll
    for (int j = 0; j < 32; ++j) sq += acc[j] * acc[j];
    const float r_ = rsqrtf(wave_sum(sq) * (1.f / D_MODEL) + EPS);
#pragma unroll
    for (int j = 0; j < 2; ++j)
#pragma unroll
        for (int c = 0; c < 4; ++c) { const f32x4 gv_ = *(const f32x4*)(gfin + j * 1024 + lane * 16 + 4 * c);
            *(f32x4*)(out + (size_t)n * 2048 + j * 1024 + lane * 16 + 4 * c) = (f32x4){acc[16 * j + 4 * c + 0] * r_ * gv_.x, acc[16 * j + 4 * c + 1] * r_ * gv_.y, acc[16 * j + 4 * c + 2] * r_ * gv_.z, acc[16 * j + 4 * c + 3] * r_ * gv_.w}; }
}

__device__ __forceinline__ void peer_phase(const bf16* QP, const bf16* SKB, const float* H, const float* SS, const float* gffn, const unsigned char* U8, const unsigned char* V8, const float* IU, const float* IV,
                                           const float* gfin, float* out, __attribute__((address_space(3))) unsigned char* lds3, int bid, int G) {
    int tid = threadIdx.x; asm volatile("" : "+v"(tid));
    const int lane = tid & 63, wid = __builtin_amdgcn_readfirstlane(tid >> 6);
    const unsigned rot = (xb_xcc_id() & 7u) * 2048u;
    for (int unit = bid; unit < NTOK / 32; unit += G) {
        const int tok0 = unit * 32;
        route_head(QP, SKB, wid, tok0, lane, lds3);
        asm volatile("s_waitcnt lgkmcnt(0)" ::: "memory"); __syncthreads();
#if defined(PEER_SORTED_SWEEPS)
        ffn_wave(tok0, wid, lane, H, SS, gffn, U8, V8, IU, IV, gfin, out, lds3, rot);
#else
        { int ln = lane; asm volatile("" : "+v"(ln));
#pragma unroll 1
#if defined(PEER_FP8)
          for (int tk = 0; tk < 4; ++tk) ffn_token8(tok0 + wid * 4 + tk, wid * 4 + tk, ln, H, SS, gffn, U8, V8, IU, IV, gfin, out, lds3); }
#else
          for (int tk = 0; tk < 4; ++tk) ffn_token6(tok0 + wid * 4 + tk, wid * 4 + tk, ln, H, SS, gffn, U8, V8, IU, IV, gfin, out, lds3); }
#endif
#endif
        __syncthreads();
    }
}
#undef PEER_CE
}
constexpr int RING_BYTES = 131072, LDS_BYTES = 163840, LDSCTL_OFF = LDS_BYTES - 1024, MISC_OFF = LDSCTL_OFF + 320;
constexpr int N_PHASES = 8;
#ifndef MK_N_LAUNCHES
#define MK_N_LAUNCHES 1
#endif

__global__ void __launch_bounds__(NTHR, 2) fwd_megakernel(Args args) {
    extern __shared__ __attribute__((aligned(16))) unsigned char lds[];
    LAS unsigned char* lds3 = (LAS unsigned char*)lds;
    int tid_ = threadIdx.x; asm volatile("" : "+v"(tid_));
    const int tid = tid_, lane = tid & 63, wave = __builtin_amdgcn_readfirstlane(tid >> 6);
    const int G = gridDim.x, bid = blockIdx.x;
    unsigned char* ws = args.ws;
    unsigned* ctl = (unsigned*)(ws + WS_CTL);
    const float* x = args.in[0];
    bf16* WinT = (bf16*)(ws + WS_WIN); bf16* WbnT = (bf16*)(ws + WS_WBN); bf16* WbsT = (bf16*)(ws + WS_WBS); bf16* WoutT = (bf16*)(ws + WS_WOUT); bf16* WpqT = (bf16*)(ws + WS_WPQ);
    bf16* XN = (bf16*)(ws + WS_XN); bf16* MERGED = XN; bf16* PROJ = (bf16*)(ws + WS_PROJ);
    bf16* ONSA = (bf16*)(ws + WS_ONSA); bf16* OSB = (bf16*)(ws + WS_OSB);
    float* H = (float*)(ws + WS_H); bf16* HB = (bf16*)(ws + WS_HB);
    unsigned char* U8 = ws + WS_UB; unsigned char* V8 = ws + WS_VB; float* IU = (float*)(ws + WS_UB + 48 * MiB); float* IV = (float*)(ws + WS_VB + 48 * MiB); bf16* QP = (bf16*)(ws + WS_QP);
    int* EXPERT = (int*)(ws + WS_EXP); float* GATE = (float*)(ws + WS_GATE);
    bf16* KCB = (bf16*)(ws + WS_MISC + MISC_KCB); bf16* VCB = (bf16*)(ws + WS_MISC + MISC_VCB);
    float* SS = (float*)(ctl + CW_SS);
    bf16* W1T = (bf16*)(ws + WS_MISC + MISC_W1T); float* BIAS1 = (float*)(ws + WS_MISC + MISC_B1);
    bf16* SKB = (bf16*)(ws + WS_MISC + MISC_SKB);

    for (int u = tid; u < (LDS_BYTES - LDSCTL_OFF) / 4; u += NTHR) ((LAS unsigned*)(lds3 + LDSCTL_OFF))[u] = 0u;
    __syncthreads();
    const int lo = args.ph_lo, hi = args.ph_hi;
    XcdBarrier bar; bar.bar = ctl + CW_BAR; bar.x = 0; bar.st = nullptr;
    if (hi - lo > 1) bar = xcd_barrier_post(ctl + CW_BAR, (volatile LAS unsigned*)(lds3 + MISC_OFF) + 8);
#define IN(k) (lo <= (k) && (k) < hi)
#ifndef REP_BAR
#define REP_BAR 1
#endif
#define SEAM(k) do { if (IN(k) && IN((k) + 1)) for (int rb_ = 0; rb_ < REP_BAR; ++rb_) xcd_barrier(bar); } while (0)
    const int gw = bid * NWAVES + wave, NGW = G * NWAVES;
    const int vcu = (G % 8 == 0) ? (bid % 8) * (G / 8) + bid / 8 : bid;

#if defined(TS_PHASE)
    unsigned long long ts0_ = 0;
#define TS_BEGIN(k) do { if (TS_PHASE == (k)) ts0_ = __builtin_amdgcn_s_memrealtime(); } while (0)
#define TS_END(k) do { if (TS_PHASE == (k)) { const unsigned dt_ = (unsigned)(__builtin_amdgcn_s_memrealtime() - ts0_); if (tid == 0) atomicMax(ctl + 64, dt_); } } while (0)
#else
#define TS_BEGIN(k) do {} while (0)
#define TS_END(k) do {} while (0)
#endif
#ifndef REP_P0
#define REP_P0 1
#endif
#ifndef REP_P1
#define REP_P1 1
#endif
#ifndef REP_P4
#define REP_P4 1
#endif
#ifndef REP_P6
#define REP_P6 1
#endif
#ifndef REP_P5C
#define REP_P5C 1
#endif
    TS_BEGIN(0);
    if (IN(0)) for (int rep_ = 0; rep_ < REP_P0; ++rep_) {
        LAS float* scr = (LAS float*)(lds3 + wave * 16384);
        constexpr int I_IN = (D_MODEL / 64) * ((IN_COLS + 31) / 32), I_BR = (1024 / 64) * (D_MODEL / 32), I_SQ = (D_MODEL / 64) * (D_MODEL / 32);
        constexpr int I_C1 = (2048 / 64) * (CMP_HID / 32);
        constexpr int NITEMS = I_IN + 2 * I_BR + 2 * I_SQ + 2 * I_C1;
        for (int it = gw; it < NITEMS; it += NGW) {
            int r = it;
            if (r < I_IN) { p0_transpose_item(args.in[2], D_MODEL, IN_COLS, WinT, nullptr, scr, r, lane, C_SHIFT_FROM, C_SHIFT); continue; } r -= I_IN;
            if (r < I_BR) { p0_transpose_item(args.in[10], 1024, D_MODEL, WbnT, nullptr, scr, r, lane); continue; } r -= I_BR;
            if (r < I_BR) { p0_transpose_item(args.in[11], 1024, D_MODEL, WbsT, nullptr, scr, r, lane); continue; } r -= I_BR;
            if (r < I_SQ) { p0_transpose_item(args.in[12], D_MODEL, D_MODEL, WoutT, nullptr, scr, r, lane); continue; } r -= I_SQ;
            if (r < I_SQ) { p0_transpose_item(args.in[14], D_MODEL, D_MODEL, WpqT, args.in[13], scr, r, lane); continue; } r -= I_SQ;
            if (r < I_C1) { p0_transpose_item(args.in[4], 2048, CMP_HID, W1T, nullptr, scr, r, lane); continue; } r -= I_C1;
            p0_transpose_item(args.in[7], 2048, CMP_HID, W1T + (size_t)CMP_HID * 2048, nullptr, scr, r, lane);
        }
        {
            v4u z = {0u, 0u, 0u, 0u}; bf16* p = WinT + (size_t)C_SHIFT_FROM * D_MODEL; const size_t nz = (size_t)C_SHIFT * D_MODEL;
            for (size_t i = ((size_t)bid * NTHR + tid) * 8; i < nz; i += (size_t)G * NTHR * 8) *(v4u*)(p + i) = z;
        }
        if (gw < 2 * CMP_HID) {
            const int kv = gw >> 7, j = gw & 127; const float* pe = args.in[kv ? 6 : 3]; const float* w1 = args.in[kv ? 7 : 4];
            float s = 0.f;
            for (int k2 = lane; k2 < 2048; k2 += 64) s += pe[k2] * w1[(size_t)k2 * CMP_HID + j];
            s = wave_sum(s);
            if (lane == 0) BIAS1[gw] = s;
        }
        cvt_flat(args.in[15], SKB, (size_t)16 * 128 * 128, (size_t)bid * NTHR + tid, (size_t)G * NTHR);
        for (int m = gw; m < NTOK; m += NGW) rms_row_to_bf16(x + (size_t)m * D_MODEL, args.in[1], XN + (size_t)m * D_MODEL, lane);
    }
    TS_END(0);
    SEAM(0);
    TS_BEGIN(1);
    if (IN(1)) for (int rep_ = 0; rep_ < REP_P1; ++rep_) {
        pg8::Gemm g{XN, WinT, NTOK, PLD, D_MODEL}; pg8::StaticOrder S; S.init(NTOK, PLD, G, bid);
        pg8::EpiBf16<0> E{PROJ, PP, nullptr, PP, (size_t)NTOK * PP, 1.f};
        pg8::gemm_phase<pg8::EpiBf16<0>, pg8::StaticOrder, true, true>(lds3, g, S, E);
    }
    TS_END(1);
    SEAM(1);
    TS_BEGIN(2);
    if (IN(2)) cmpr::compress_phase(PROJ, W1T, BIAS1, args.in, KCB, VCB, lds3, bid, G);
    TS_END(2);
    SEAM(2);
    TS_BEGIN(3);
    if (IN(3)) {
        TS_BEGIN(30);
        nsa::nsa_phase(PROJ, KCB, VCB, args.in[9], ONSA, lds3, vcu, G, args.variant);
        TS_END(30);
#if defined(PROBE_P3A)
        nsa::nsa_phase(PROJ, KCB, VCB, args.in[9], ONSA, lds3, vcu, G);
#endif
        TS_BEGIN(31);
        if (!(args.variant & 32)) nsa::stick_phase(PROJ, OSB, lds3, vcu, G);
        TS_END(31);
#if defined(PROBE_P3B)
        nsa::stick_phase(PROJ, OSB, lds3, vcu, G);
#endif
    }
    TS_END(3);
    SEAM(3);
    TS_BEGIN(4);
    if (IN(4)) for (int rep_ = 0; rep_ < REP_P4; ++rep_) {
        static_assert(WS_OSB == WS_ONSA + (size_t)NTOK * NSA_Q * 2 && WS_WBS == WS_WBN + (size_t)D_MODEL * 1024 * 2, "branch operands must be contiguous");
        pg8::Gemm g{ONSA, WbnT, 2 * NTOK, 2 * D_MODEL, 1024}; pg8::BranchOrder S; S.init(NTOK, D_MODEL, G, bid);
        pg8::EpiGate2 E{MERGED, D_MODEL, PNL(PROJ, P_GA), PNL(PROJ, P_GB), PP, (size_t)NTOK * PP - PP, NTOK / 256, D_MODEL / 256};
        pg8::gemm_phase<pg8::EpiGate2, pg8::BranchOrder, true, true>(lds3, g, S, E);
    }
    TS_END(4);
    SEAM(4);
    TS_BEGIN(5);
    if (IN(5)) {
        { pg8::Gemm g{MERGED, WoutT, NTOK, D_MODEL, D_MODEL}; pg8::StaticOrder S; S.init(NTOK, D_MODEL, G, bid);
          pg8::EpiResid E{x, H, HB, SS, D_MODEL};
          pg8::gemm_phase<pg8::EpiResid, pg8::StaticOrder, false, true>(lds3, g, S, E); }
        int t5 = threadIdx.x; asm volatile("" : "+v"(t5));
        const int lane5 = t5 & 63, gw5 = bid * NWAVES + __builtin_amdgcn_readfirstlane(t5 >> 6);
        for (int rep_ = 0; rep_ < REP_P5C; ++rep_) for (int r = gw5; r < 2 * 16384; r += NGW) {
#if defined(PEER_FP8)
            if (r < 16384) peer::cvt_row_fp8(args.in[16], U8, IU, r, lane5); else peer::cvt_row_fp8(args.in[17], V8, IV, r - 16384, lane5);
#else
            if (r < 16384) peer::cvt_row_fp6(args.in[16], U8, IU, r, lane5); else peer::cvt_row_fp6(args.in[17], V8, IV, r - 16384, lane5);
#endif
        }
    }
    TS_END(5);
    SEAM(5);
    TS_BEGIN(6);
    if (IN(6)) for (int rep_ = 0; rep_ < REP_P6; ++rep_) {
        pg8::Gemm g{HB, WpqT, NTOK, D_MODEL, D_MODEL}; pg8::StaticOrder S; S.init(NTOK, D_MODEL, G, bid);
        pg8::EpiRowScale E{QP, D_MODEL, SS, 1.f / D_MODEL, EPS};
        pg8::gemm_phase<pg8::EpiRowScale, pg8::StaticOrder, false, true>(lds3, g, S, E);
    }
    TS_END(6);
    SEAM(6);
    TS_BEGIN(7);
    if (IN(7)) {
        peer::peer_phase(QP, SKB, H, SS, args.in[13], U8, V8, IU, IV, args.in[18], args.out, lds3, bid, G);
#if defined(PROBE_P7)
        peer::peer_phase(QP, SKB, H, SS, args.in[13], U8, V8, IU, IV, args.in[18], args.out, lds3, bid, G);
#endif
    }
    TS_END(7);
#if defined(TS_PHASE)
    xcd_barrier(bar);
    if (bid == 0) { const unsigned dt_ = __hip_atomic_load(ctl + 64, RLX_AGENT); const int K_ = (int)((float)dt_ * 0.01f * 16.777216f * 2.f);
        for (int i = tid; i < K_; i += NTHR) args.out[i] += 1.0f; }
#endif
#undef IN
#undef SEAM
}

extern "C" void kernel_launch(void* const* d_in, const int* in_sizes, int n_in, void* d_out, int out_size, void* d_ws, size_t ws_size, hipStream_t stream) {
    static int grid = 0;
    if (grid == 0) {
        if (n_in != 19 || ws_size < WS_END) { fprintf(stderr, "kernel_launch: unexpected inputs (%d) or workspace (%zu < %zu)\n", n_in, ws_size, (size_t)WS_END); grid = -1; return; }
        int dev = 0, cus = 0, per_cu = 0;
        hipGetDevice(&dev); hipDeviceGetAttribute(&cus, hipDeviceAttributeMultiprocessorCount, dev);
        if (hipFuncSetAttribute((const void*)fwd_megakernel, hipFuncAttributeMaxDynamicSharedMemorySize, LDS_BYTES) != hipSuccess) { fprintf(stderr, "hipFuncSetAttribute failed\n"); grid = -1; return; }
        if (hipOccupancyMaxActiveBlocksPerMultiprocessor(&per_cu, (const void*)fwd_megakernel, NTHR, LDS_BYTES) != hipSuccess || per_cu < 1) { fprintf(stderr, "occupancy query: %d\n", per_cu); per_cu = 1; }
        (void)hipGetLastError();
        grid = cus;
        if (grid > cus * per_cu) grid = cus * per_cu;
    }
    if (grid < 0) return;
    hipMemsetAsync((char*)d_ws + WS_CTL, 0, (size_t)(CW_SS + NTOK) * 4, stream);
    Args a{};
    for (int i = 0; i < 19; ++i) a.in[i] = (const float*)d_in[i];
    a.out = (float*)d_out; a.ws = (unsigned char*)d_ws;
#if defined(PROBE_SPLIT_LO2)
#ifndef PROBE_VARIANT
#define PROBE_VARIANT 0
#endif
    {
        a.ph_lo = 0; a.ph_hi = PROBE_SPLIT_HI1; a.variant = PROBE_VARIANT; hipLaunchKernelGGL(fwd_megakernel, dim3(grid), dim3(NTHR), LDS_BYTES, stream, a);
        hipMemsetAsync((char*)d_ws + WS_CTL + CW_BAR * 4, 0, XCD_BAR_WORDS * 4, stream);
        a.ph_lo = PROBE_SPLIT_LO2; a.ph_hi = N_PHASES; a.variant = 0; hipLaunchKernelGGL(fwd_megakernel, dim3(grid), dim3(NTHR), LDS_BYTES, stream, a);
        return;
    }
#endif
    if (MK_N_LAUNCHES == 1) {
        a.ph_lo = 0; a.ph_hi = N_PHASES;
        void* kargs[] = {&a};
#if defined(USE_COOP_LAUNCH)
        hipError_t e = hipLaunchCooperativeKernel((const void*)fwd_megakernel, dim3(grid), dim3(NTHR), kargs, LDS_BYTES, stream);
        if (e != hipSuccess) fprintf(stderr, "cooperative launch failed: %s (grid %d)\n", hipGetErrorString(e), grid);
#else
        (void)kargs;
        hipLaunchKernelGGL(fwd_megakernel, dim3(grid), dim3(NTHR), LDS_BYTES, stream, a);
#endif
    } else {
        for (int p = 0; p < N_PHASES; ++p) { a.ph_lo = p; a.ph_hi = p + 1; hipLaunchKernelGGL(fwd_megakernel, dim3(grid), dim3(NTHR), LDS_BYTES, stream, a); }
    }
}
```

```cpp
#include <hip/hip_runtime.h>
#include <cstdio>
#include <cstdint>
#include <cmath>
namespace pg8 {
#define PG8_LAS __attribute__((address_space(3)))
typedef unsigned short bf16_t;
typedef short bf16x8 __attribute__((ext_vector_type(8)));
typedef float f32x4 __attribute__((ext_vector_type(4)));
typedef unsigned u32x4 __attribute__((ext_vector_type(4)));
constexpr int BM = 256, BK = 64, HALF = 128, HTB = HALF * BK * 2  , STAGE_BYTES = 8 * HTB, NXCD = 8, WGM = 8;

__host__ __device__ __forceinline__ int lds_byte(int r, int c) { const int st = (r >> 4) * 2 + (c >> 5), rr = r & 15, cc = c & 31, ob = rr * 64 + cc * 2; return st * 1024 + (ob ^ (((ob >> 9) & 1) << 5)); }
__host__ __device__ __forceinline__ void stage_rc(int b, int& R, int& C) { const int st = b / 1024, sb = b % 1024, swz = sb ^ (((sb >> 9) & 1) << 5); R = (st >> 1) * 16 + swz / 64; C = (st & 1) * 32 + (swz % 64) / 2; }
__host__ __device__ __forceinline__ int perm32(int rho) { const int n = rho >> 4, i = rho & 15; return 8 * (i >> 2) + 4 * n + (i & 3); }

struct Unit { int pm, pn; };
struct Gemm { const bf16_t* A; const bf16_t* Bt; int M, N, K; };

struct StaticOrder {
    int nM, nN, nwg, G, c;
    __host__ __device__ void init(int M, int N, int G_, int c_) { nM = M / BM; nN = N / BM; nwg = nM * nN; G = G_; c = c_; }
    __host__ __device__ bool next(int i, Unit& u) const {
        const long L = (long)i * G + c; if (L >= nwg) return false;
        int wgid = (int)L; { const int q = nwg / NXCD, r = nwg % NXCD, xcd = wgid % NXCD, off = wgid / NXCD; wgid = (xcd < r ? xcd * (q + 1) : r * (q + 1) + (xcd - r) * q) + off; }
        const int nig = WGM * nN, gid = wgid / nig, fm = gid * WGM, gsz = (nM - fm) < WGM ? (nM - fm) : WGM;
        u.pm = fm + ((wgid % nig) % gsz); u.pn = (wgid % nig) / gsz; return true;
    }
    __device__ __forceinline__ void a_ready(const Unit&) const {}
    __device__ __forceinline__ void done(const Unit&) const {}
};

__device__ __forceinline__ unsigned cvt_pk_bf16(float lo, float hi) { unsigned r; asm volatile("v_cvt_pk_bf16_f32 %0, %1, %2" : "=v"(r) : "v"(lo), "v"(hi)); return r; }
typedef float f32x2 __attribute__((ext_vector_type(2)));
__device__ __forceinline__ f32x2 gelu_pk(f32x2 v) {
    const f32x2 av = __builtin_elementwise_abs(v), d = av * 0.2316418882f + 1.0f;
    f32x2 t; t.x = __builtin_amdgcn_rcpf(d.x); t.y = __builtin_amdgcn_rcpf(d.y);
    f32x2 q = t * 0.5307027145f + (-0.7265760135f); q = q * t + 0.7107068705f; q = q * t + (-0.142248368f); q = q * t + 0.127414796f; q = q * t;
    const f32x2 s = (v * v) * (-0.72134752044f);
    f32x2 e; e.x = __builtin_amdgcn_exp2f(s.x); e.y = __builtin_amdgcn_exp2f(s.y);
    const f32x2 m = v * (q * e), r = v - m;
    f32x2 o; o.x = v.x < 0.f ? m.x : r.x; o.y = v.y < 0.f ? m.y : r.y; return o;
}

template <int ACT  > struct EpiBf16 {
    static constexpr bool PERM = true, AFTER_DRAIN = false; static_assert(ACT == 0 || ACT == 1, "EpiBf16: ACT is 0 (none) or 1 (gelu_pk)");
    bf16_t* O; int ldc; const float* bias; int split_cols; size_t split_stride; float scale0;
    __device__ __forceinline__ void operator()(const f32x4 (&acc)[2][2][4][2], const Unit& u, int wr, int wc, int fr, int fq) const {
        const int row0 = u.pm * BM + wr * 64 + fr; int colt = u.pn * BM; bf16_t* base = O;
        float sc = 1.f; if (split_cols) { const int t = colt / split_cols; base += (size_t)t * split_stride; colt -= t * split_cols; if (t == 0) sc = scale0; }
        const int col0 = colt + wc * 32 + 8 * fq, bcol0 = u.pn * BM + wc * 32 + 8 * fq;
        f32x4 bv[2][2];
#pragma unroll
        for (int bj = 0; bj < 2; ++bj)
#pragma unroll
            for (int n = 0; n < 2; ++n) bv[bj][n] = bias ? *(const f32x4*)(bias + bcol0 + bj * HALF + 4 * n) : (f32x4){0.f, 0.f, 0.f, 0.f};
#pragma unroll
        for (int ai = 0; ai < 2; ++ai)
#pragma unroll
            for (int m = 0; m < 4; ++m) { bf16_t* rowp = base + (size_t)(row0 + ai * HALF + m * 16) * ldc + col0;
#pragma unroll
                for (int bj = 0; bj < 2; ++bj) { f32x4 v0 = acc[ai][bj][m][0] + bv[bj][0], v1 = acc[ai][bj][m][1] + bv[bj][1];
                    if (ACT == 1) { f32x2 a = gelu_pk((f32x2){v0[0], v0[1]}), b = gelu_pk((f32x2){v0[2], v0[3]}), c = gelu_pk((f32x2){v1[0], v1[1]}), d = gelu_pk((f32x2){v1[2], v1[3]});
                        v0 = (f32x4){a.x, a.y, b.x, b.y}; v1 = (f32x4){c.x, c.y, d.x, d.y}; }
                    v0 = v0 * sc; v1 = v1 * sc; u32x4 w; w.x = cvt_pk_bf16(v0[0], v0[1]); w.y = cvt_pk_bf16(v0[2], v0[3]); w.z = cvt_pk_bf16(v1[0], v1[1]); w.w = cvt_pk_bf16(v1[2], v1[3]);
                    *(u32x4*)(rowp + bj * HALF) = w; } }
    }
};

struct PanelStats {
    unsigned* xbuf;
    unsigned* cnt;
    unsigned* tmo;
    int ntn; float eps;
    unsigned code;
    __device__ __forceinline__ bool run(const f32x4 (&v)[2][2][4][2], const Unit& u, int wr, int wc, int fr, int fq, PG8_LAS unsigned char* lds, int wid, int lane) const {
        typedef float f32x2v __attribute__((ext_vector_type(2)));
        PG8_LAS f32x2v* P = (PG8_LAS f32x2v*)lds;
        PG8_LAS f32x2v* S = (PG8_LAS f32x2v*)(lds + 8192);
        PG8_LAS unsigned* flag = (PG8_LAS unsigned*)(lds + 8192 + 2048);
#pragma unroll
        for (int ai = 0; ai < 2; ++ai)
#pragma unroll
            for (int m = 0; m < 4; ++m) {
                float s = 0.f;
#pragma unroll
                for (int bj = 0; bj < 2; ++bj)
#pragma unroll
                    for (int n = 0; n < 2; ++n) { const f32x4 x = v[ai][bj][m][n]; s += (x[0] + x[1]) + (x[2] + x[3]); }
                s += __shfl_xor(s, 16); s += __shfl_xor(s, 32);
                const float mw = s * (1.0f / 64.0f); float q = 0.f;
#pragma unroll
                for (int bj = 0; bj < 2; ++bj)
#pragma unroll
                    for (int n = 0; n < 2; ++n) { const f32x4 d = v[ai][bj][m][n] - mw; q += (d[0] * d[0] + d[1] * d[1]) + (d[2] * d[2] + d[3] * d[3]); }
                q += __shfl_xor(q, 16); q += __shfl_xor(q, 32);
                if (fq == 0) P[(ai * HALF + wr * 64 + m * 16 + fr) * 4 + wc] = (f32x2v){mw, q};
            }
        asm volatile("s_waitcnt lgkmcnt(0)" ::: "memory"); __builtin_amdgcn_s_barrier(); asm volatile("" ::: "memory");
#if defined(BROKEN_EXCHANGE_NO_WAIT)
#warning BROKEN CONTROL BUILD: the row-statistics exchange does not wait; results are wrong by design
        if (blockIdx.x >= 64) { const long long t0_ = clock64(); while (clock64() - t0_ < 60000) __builtin_amdgcn_s_sleep(8); }
#endif
        const int row = wid * 32 + (lane & 31);
        if (lane < 32) {
            const f32x2v a = P[row * 4 + 0], b = P[row * 4 + 1], c = P[row * 4 + 2], d = P[row * 4 + 3];
            const float mt = (a.x + b.x + c.x + d.x) * 0.25f;
            const float da = a.x - mt, db = b.x - mt, dc = c.x - mt, dd = d.x - mt;
            const float m2 = (a.y + b.y) + (c.y + d.y) + 64.0f * ((da * da + db * db) + (dc * dc + dd * dd));
            unsigned long long* slot = (unsigned long long*)xbuf + ((size_t)(u.pm * BM + row) * 4 + u.pn);
            __hip_atomic_store(slot, ((unsigned long long)__float_as_uint(m2) << 32) | __float_as_uint(mt), __ATOMIC_RELAXED, __HIP_MEMORY_SCOPE_AGENT);
        }
        asm volatile("s_waitcnt vmcnt(0)" ::: "memory");
        if (lane == 0) __hip_atomic_fetch_add(cnt + 64 * u.pm, 1u, __ATOMIC_RELAXED, __HIP_MEMORY_SCOPE_AGENT);
        if (wid == 0) {
            bool dead = false; const unsigned long long t0 = __builtin_amdgcn_s_memrealtime(); const unsigned want = 8u * (unsigned)ntn;
            for (;;) {
#if defined(BROKEN_EXCHANGE_NO_WAIT)
                break;
#endif
                if ((unsigned)__builtin_amdgcn_readfirstlane(__hip_atomic_load(cnt + 64 * u.pm, __ATOMIC_RELAXED, __HIP_MEMORY_SCOPE_AGENT)) >= want) break;
                if (__builtin_amdgcn_s_memrealtime() - t0 > 2000000ull) {
                    if (lane == 0) { unsigned expect = 0u; __hip_atomic_compare_exchange_strong(tmo + 1, &expect, code | (unsigned)(u.pm & 0xff), __ATOMIC_RELAXED, __ATOMIC_RELAXED, __HIP_MEMORY_SCOPE_AGENT);
                                     __hip_atomic_store(tmo, 1u, __ATOMIC_RELAXED, __HIP_MEMORY_SCOPE_AGENT); }
                    dead = true; break; }
                __builtin_amdgcn_s_sleep(2);
            }
            __builtin_amdgcn_fence(__ATOMIC_ACQUIRE, "agent");
            if (lane == 0) flag[0] = dead ? 1u : 0u;
        }
        asm volatile("s_waitcnt vmcnt(0) lgkmcnt(0)" ::: "memory"); __builtin_amdgcn_s_barrier(); asm volatile("" ::: "memory");
        const bool bad = flag[0] != 0u;
        if (lane < 32) {
            const unsigned long long* slot = (const unsigned long long*)xbuf + (size_t)(u.pm * BM + row) * 4; float mt[4], m2[4]; float ms = 0.f;
#pragma unroll
            for (int t = 0; t < 4; ++t) { if (t < ntn) { const unsigned long long w = __hip_atomic_load(slot + t, __ATOMIC_RELAXED, __HIP_MEMORY_SCOPE_AGENT); mt[t] = __uint_as_float((unsigned)w); m2[t] = __uint_as_float((unsigned)(w >> 32)); } else { mt[t] = 0.f; m2[t] = 0.f; } ms += mt[t]; }
            const float mean = ms / (float)ntn; float q = 0.f;
#pragma unroll
            for (int t = 0; t < 4; ++t) if (t < ntn) { const float dm = mt[t] - mean; q += m2[t] + 256.0f * dm * dm; }
            S[row] = (f32x2v){mean, 1.0f / sqrtf(q / (256.0f * (float)ntn) + eps)};
        }
        asm volatile("s_waitcnt lgkmcnt(0)" ::: "memory"); __builtin_amdgcn_s_barrier(); asm volatile("" ::: "memory");
        return bad;
    }
};
struct EpiLnRes {
    static constexpr bool PERM = false, AFTER_DRAIN = true;
    const float* base; float* out; int ldc; const float* bias; PanelStats st; unsigned poison;
    __device__ __forceinline__ void fused(f32x4 (&acc)[2][2][4][2], const Unit& u, int wr, int wc, int fr, int fq, PG8_LAS unsigned char* lds, int wid, int lane) const {
        typedef float f32x2v __attribute__((ext_vector_type(2)));
        const PG8_LAS f32x2v* S = (const PG8_LAS f32x2v*)(lds + 8192);
        const int col0 = u.pn * BM + wc * 32 + 4 * fq;
#pragma unroll
        for (int bj = 0; bj < 2; ++bj)
#pragma unroll
            for (int n = 0; n < 2; ++n) { const f32x4 bv = bias ? *(const f32x4*)(bias + col0 + bj * HALF + n * 16) : (f32x4){0.f, 0.f, 0.f, 0.f};
#pragma unroll
                for (int ai = 0; ai < 2; ++ai)
#pragma unroll
                    for (int m = 0; m < 4; ++m) acc[ai][bj][m][n] += bv; }
        f32x4 pre[4][2][2];
#pragma unroll
        for (int m = 0; m < 4; ++m) { const size_t off = (size_t)(u.pm * BM + wr * 64 + m * 16 + fr) * ldc + col0;
#pragma unroll
            for (int bj = 0; bj < 2; ++bj)
#pragma unroll
                for (int n = 0; n < 2; ++n) pre[m][bj][n] = *(const f32x4*)(base + off + bj * HALF + n * 16); }
        const bool bad = st.run(acc, u, wr, wc, fr, fq, lds, wid, lane) || poison != 0u;
        const float qnan = __builtin_nanf("");
#pragma unroll
        for (int ai = 0; ai < 2; ++ai)
#pragma unroll
            for (int m = 0; m < 4; ++m) { const int r = ai * HALF + wr * 64 + m * 16 + fr; const f32x2v sr = S[r]; const size_t off = (size_t)(u.pm * BM + r) * ldc + col0;
#pragma unroll
                for (int bj = 0; bj < 2; ++bj)
#pragma unroll
                    for (int n = 0; n < 2; ++n) { const f32x4 bs = ai == 0 ? pre[m][bj][n] : *(const f32x4*)(base + off + bj * HALF + n * 16); f32x4 o = bs + (acc[ai][bj][m][n] - sr.x) * sr.y;
                        if (bad) o = (f32x4){qnan, qnan, qnan, qnan}; *(f32x4*)(out + off + bj * HALF + n * 16) = o; }
                if (m & 1) asm volatile("" ::: "memory"); }
    }
};
struct EpiLnResLn {
    static constexpr bool PERM = false, AFTER_DRAIN = true;
    const float* base; float* out; bf16_t* xn; int ldc; const float* bias; PanelStats st1, st2; unsigned poison;
    __device__ __forceinline__ void fused(f32x4 (&acc)[2][2][4][2], const Unit& u, int wr, int wc, int fr, int fq, PG8_LAS unsigned char* lds, int wid, int lane) const {
        typedef float f32x2v __attribute__((ext_vector_type(2))); typedef unsigned u32x2v __attribute__((ext_vector_type(2)));
        const PG8_LAS f32x2v* S = (const PG8_LAS f32x2v*)(lds + 8192);
        const int col0 = u.pn * BM + wc * 32 + 4 * fq;
#pragma unroll
        for (int bj = 0; bj < 2; ++bj)
#pragma unroll
            for (int n = 0; n < 2; ++n) { const f32x4 bv = bias ? *(const f32x4*)(bias + col0 + bj * HALF + n * 16) : (f32x4){0.f, 0.f, 0.f, 0.f};
#pragma unroll
                for (int ai = 0; ai < 2; ++ai)
#pragma unroll
                    for (int m = 0; m < 4; ++m) acc[ai][bj][m][n] += bv; }
        bool bad = st1.run(acc, u, wr, wc, fr, fq, lds, wid, lane) || poison != 0u;
        const float qnan = __builtin_nanf("");
#pragma unroll
        for (int ai = 0; ai < 2; ++ai)
#pragma unroll
            for (int m = 0; m < 4; ++m) { const int r = ai * HALF + wr * 64 + m * 16 + fr; const f32x2v sr = S[r]; const size_t off = (size_t)(u.pm * BM + r) * ldc + col0;
#pragma unroll
                for (int bj = 0; bj < 2; ++bj)
#pragma unroll
                    for (int n = 0; n < 2; ++n) { const f32x4 bs = *(const f32x4*)(base + off + bj * HALF + n * 16); acc[ai][bj][m][n] = bs + (acc[ai][bj][m][n] - sr.x) * sr.y; }
                asm volatile("" : "+v"(acc[ai][0][m][0]), "+v"(acc[ai][0][m][1]), "+v"(acc[ai][1][m][0]), "+v"(acc[ai][1][m][1]));
                if (m & 1) asm volatile("" ::: "memory"); }
        const bool bad1 = bad;
        bad = st2.run(acc, u, wr, wc, fr, fq, lds, wid, lane) || bad;
#pragma unroll
        for (int ai = 0; ai < 2; ++ai)
#pragma unroll
            for (int m = 0; m < 4; ++m) { const int r = ai * HALF + wr * 64 + m * 16 + fr; const f32x2v sr = S[r]; const size_t off = (size_t)(u.pm * BM + r) * ldc + col0;
#pragma unroll
                for (int bj = 0; bj < 2; ++bj)
#pragma unroll
                    for (int n = 0; n < 2; ++n) { const f32x4 x1 = acc[ai][bj][m][n]; *(f32x4*)(out + off + bj * HALF + n * 16) = bad1 ? (f32x4){qnan, qnan, qnan, qnan} : x1;
                        const f32x4 o = (x1 - sr.x) * sr.y; u32x2v w; w.x = cvt_pk_bf16(o[0], o[1]); w.y = cvt_pk_bf16(o[2], o[3]);
                        if (bad) { w.x = 0x7fc07fc0u; w.y = 0x7fc07fc0u; } *(u32x2v*)(xn + off + bj * HALF + n * 16) = w; }
                asm volatile("" ::: "memory"); }
    }
};

template <class Epi, class Sched, bool ALIGN_EPI = false, bool SP2 = false>
__device__ __forceinline__ void gemm_phase(PG8_LAS unsigned char* lds, const Gemm g, const Sched& S, const Epi& E) {
    const int tid = threadIdx.x, wid = __builtin_amdgcn_readfirstlane(tid >> 6), lane = tid & 63, wr = wid >> 2, wc = wid & 3, fr = lane & 15, fq = lane >> 4;
    const int K = g.K, nt = K / BK;
    unsigned voffA[2], voffB[2];
#pragma unroll
    for (int i = 0; i < 2; ++i) { int R, C; stage_rc(tid * 16 + i * 8192, R, C); const int Rb = Epi::PERM ? ((R & ~31) + perm32(R & 31)) : R;
        voffA[i] = (unsigned)(R * K + C) * 2u; voffB[i] = (unsigned)(Rb * K + C) * 2u; }
    const size_t kstep = (size_t)(BK * 2);
    const size_t hstep = (size_t)HALF * K * 2;
    const size_t tstep = 2 * hstep;
    const unsigned ldsw = (unsigned)wid * 1024u;
    const int aoff = lds_byte(wr * 64 + fr, fq * 8), boff = lds_byte(wc * 32 + fr, fq * 8);
#define PG8_SA(b, h) (((b) * 2 + (h)) * HTB)
#define PG8_SB(b, h) ((4 + (b) * 2 + (h)) * HTB)
#define PG8_STAGE(bufoff, gbase, voff) do { _Pragma("unroll") for (int _i = 0; _i < 2; ++_i) \
        __builtin_amdgcn_global_load_lds((const unsigned*)((const char*)(gbase) + (voff)[_i]), (PG8_LAS unsigned*)(lds + (bufoff) + ldsw + _i * 8192), 16, 0, 0); } while (0)
#define PG8_LDA(dst, b, h) do { _Pragma("unroll") for (int m = 0; m < 4; ++m) _Pragma("unroll") for (int k = 0; k < 2; ++k) dst[m][k] = *(const PG8_LAS bf16x8*)(lds + PG8_SA(b, h) + aoff + m * 2048 + k * 1024); } while (0)
#define PG8_LDB(dst, b, h) do { _Pragma("unroll") for (int n = 0; n < 2; ++n) _Pragma("unroll") for (int k = 0; k < 2; ++k) dst[n][k] = *(const PG8_LAS bf16x8*)(lds + PG8_SB(b, h) + boff + n * 2048 + k * 1024); } while (0)
#define PG8_MMA(ai, bj, At, Bt) do { __builtin_amdgcn_s_setprio(1); _Pragma("unroll") for (int m = 0; m < 4; ++m) _Pragma("unroll") for (int n = 0; n < 2; ++n) _Pragma("unroll") for (int k = 0; k < 2; ++k) \
        acc[ai][bj][m][n] = __builtin_amdgcn_mfma_f32_16x16x32_bf16(Bt[n][k], At[m][k], acc[ai][bj][m][n], 0, 0, 0); __builtin_amdgcn_s_setprio(0); } while (0)
#define PG8_WAIT_V(n) asm volatile("s_waitcnt vmcnt(" #n ")" ::: "memory")
#define PG8_WAIT_L(n) asm volatile("s_waitcnt lgkmcnt(" #n ")" ::: "memory")
#define PG8_BAR __builtin_amdgcn_s_barrier()
#define PG8_SCHED __builtin_amdgcn_sched_barrier(0)
    Unit cur, nxt; int ui = 0;
    if (!S.next(0, cur)) return;
    f32x4 acc[2][2][4][2];
#pragma unroll
    for (int a = 0; a < 2; ++a)
#pragma unroll
        for (int b = 0; b < 2; ++b)
#pragma unroll
            for (int m = 0; m < 4; ++m)
#pragma unroll
                for (int n = 0; n < 2; ++n) acc[a][b][m][n] = (f32x4){0.f, 0.f, 0.f, 0.f};
    bf16x8 At[4][2], B0[2][2], B1[2][2];
    const char* cA = (const char*)g.A + (size_t)cur.pm * tstep; const char* cB = (const char*)g.Bt + (size_t)cur.pn * tstep;
    S.a_ready(cur);
    if constexpr (SP2) {
        PG8_STAGE(PG8_SB(0, 0), cB, voffB); PG8_STAGE(PG8_SB(0, 1), cB + hstep, voffB); PG8_STAGE(PG8_SA(0, 0), cA, voffA); PG8_STAGE(PG8_SA(0, 1), cA + hstep, voffA);
        if (wr == 1) PG8_BAR;
        PG8_WAIT_V(2); PG8_BAR;
        PG8_STAGE(PG8_SB(1, 0), cB + kstep, voffB); PG8_STAGE(PG8_SA(1, 0), cA + kstep, voffA); PG8_STAGE(PG8_SB(1, 1), cB + hstep + kstep, voffB);
        PG8_WAIT_V(6); PG8_BAR;
    } else {
        PG8_STAGE(PG8_SB(0, 0), cB, voffB); PG8_STAGE(PG8_SA(0, 0), cA, voffA); PG8_STAGE(PG8_SB(0, 1), cB + hstep, voffB); PG8_STAGE(PG8_SA(0, 1), cA + hstep, voffA);
        if (wr == 1) PG8_BAR;
        PG8_WAIT_V(4); PG8_BAR;
        PG8_STAGE(PG8_SB(1, 0), cB + kstep, voffB); PG8_STAGE(PG8_SA(1, 0), cA + kstep, voffA); PG8_STAGE(PG8_SB(1, 1), cB + hstep + kstep, voffB);
        PG8_WAIT_V(6); PG8_BAR;
    }
    for (;;) {
        const bool has_next = S.next(ui + 1, nxt);
        const char* nA = has_next ? (const char*)g.A + (size_t)nxt.pm * tstep : cA; const char* nB = has_next ? (const char*)g.Bt + (size_t)nxt.pn * tstep : cB;
        for (int t = 0; t < nt; t += 2) {
            const bool last = (t == nt - 2);
            const char* a1 = cA + (size_t)(t + 1) * kstep;
            const char* a2 = last ? nA : cA + (size_t)(t + 2) * kstep; const char* b2 = last ? nB : cB + (size_t)(t + 2) * kstep;
            const char* a3 = a2 + kstep; const char* b3 = b2 + kstep;
            if (last && has_next) S.a_ready(nxt);
            if constexpr (SP2) {
            PG8_LDB(B0, 0, 0); PG8_LDB(B1, 0, 1); PG8_SCHED; PG8_LDA(At, 0, 0); PG8_STAGE(PG8_SA(1, 1), a1 + hstep, voffA);
            PG8_WAIT_V(8); PG8_WAIT_L(0); PG8_BAR; PG8_MMA(0, 0, At, B0); PG8_MMA(0, 1, At, B1); PG8_BAR; PG8_SCHED;
            PG8_LDA(At, 0, 1); PG8_STAGE(PG8_SB(0, 0), b2, voffB); PG8_STAGE(PG8_SB(0, 1), b2 + hstep, voffB); PG8_STAGE(PG8_SA(0, 0), a2, voffA);
            PG8_WAIT_V(8); PG8_WAIT_L(0); PG8_BAR; PG8_MMA(1, 0, At, B0); PG8_MMA(1, 1, At, B1); PG8_BAR; PG8_SCHED;
            PG8_LDB(B0, 1, 0); PG8_LDB(B1, 1, 1); PG8_SCHED; PG8_LDA(At, 1, 0); PG8_STAGE(PG8_SA(0, 1), a2 + hstep, voffA);
            PG8_WAIT_V(8); PG8_WAIT_L(0); PG8_BAR; PG8_MMA(0, 0, At, B0); PG8_MMA(0, 1, At, B1); PG8_BAR; PG8_SCHED;
            PG8_LDA(At, 1, 1); PG8_STAGE(PG8_SB(1, 0), b3, voffB); PG8_STAGE(PG8_SB(1, 1), b3 + hstep, voffB); PG8_STAGE(PG8_SA(1, 0), a3, voffA);
            PG8_WAIT_V(8); PG8_WAIT_L(0); PG8_BAR; PG8_MMA(1, 0, At, B0); PG8_MMA(1, 1, At, B1); PG8_BAR; PG8_SCHED;
            } else {
            PG8_LDB(B0, 0, 0); PG8_SCHED; PG8_LDA(At, 0, 0); PG8_STAGE(PG8_SA(1, 1), a1 + hstep, voffA);
            PG8_WAIT_L(8); PG8_BAR; PG8_WAIT_L(0); PG8_MMA(0, 0, At, B0); PG8_BAR; PG8_SCHED;
            PG8_LDB(B1, 0, 1); PG8_STAGE(PG8_SB(0, 0), b2, voffB);
            PG8_BAR; PG8_WAIT_L(0); PG8_MMA(0, 1, At, B1); PG8_BAR;
            PG8_LDA(At, 0, 1); PG8_STAGE(PG8_SA(0, 0), a2, voffA);
            PG8_BAR; PG8_WAIT_L(0); PG8_MMA(1, 0, At, B0); PG8_BAR; PG8_SCHED;
            PG8_STAGE(PG8_SB(0, 1), b2 + hstep, voffB);
            PG8_WAIT_V(6); PG8_BAR; PG8_MMA(1, 1, At, B1); PG8_BAR;
            PG8_LDB(B0, 1, 0); PG8_SCHED; PG8_LDA(At, 1, 0); PG8_STAGE(PG8_SA(0, 1), a2 + hstep, voffA);
            PG8_WAIT_L(8); PG8_BAR; PG8_WAIT_L(0); PG8_MMA(0, 0, At, B0); PG8_BAR; PG8_SCHED;
            PG8_LDB(B1, 1, 1); PG8_STAGE(PG8_SB(1, 0), b3, voffB);
            PG8_BAR; PG8_WAIT_L(0); PG8_MMA(0, 1, At, B1); PG8_BAR;
            PG8_LDA(At, 1, 1); PG8_STAGE(PG8_SA(1, 0), a3, voffA);
            PG8_BAR; PG8_WAIT_L(0); PG8_MMA(1, 0, At, B0); PG8_BAR; PG8_SCHED;
            PG8_STAGE(PG8_SB(1, 1), b3 + hstep, voffB);
            PG8_WAIT_V(6); PG8_BAR; PG8_MMA(1, 1, At, B1); PG8_BAR;
            }
        }
        if constexpr (ALIGN_EPI) { if (wr == 0) PG8_BAR; }
        if constexpr (!Epi::AFTER_DRAIN) { E(acc, cur, wr, wc, fr, fq); S.done(cur); }
        if (!has_next) break;
#pragma unroll
        for (int a = 0; a < 2; ++a)
#pragma unroll
            for (int b = 0; b < 2; ++b)
#pragma unroll
                for (int m = 0; m < 4; ++m)
#pragma unroll
                    for (int n = 0; n < 2; ++n) acc[a][b][m][n] = (f32x4){0.f, 0.f, 0.f, 0.f};
        cur = nxt; cA = nA; cB = nB; ++ui;
        if constexpr (ALIGN_EPI) { if (wr == 1) PG8_BAR; }
    }
    PG8_WAIT_V(0);
    if constexpr (!ALIGN_EPI) { if (wr == 0) PG8_BAR; }
    PG8_BAR;
    if constexpr (Epi::AFTER_DRAIN) { E.fused(acc, cur, wr, wc, fr, fq, lds, wid, lane); S.done(cur); }
#undef PG8_SA
#undef PG8_SB
#undef PG8_STAGE
#undef PG8_LDA
#undef PG8_LDB
#undef PG8_MMA
#undef PG8_WAIT_V
#undef PG8_WAIT_L
#undef PG8_BAR
#undef PG8_SCHED
}
}
namespace pg8 {
__device__ __forceinline__ float bf2f(unsigned short b) { return __uint_as_float(((unsigned)b) << 16); }
__device__ __forceinline__ float bflo(unsigned w) { return __uint_as_float(w << 16); }
__device__ __forceinline__ float bfhi(unsigned w) { return __uint_as_float(w & 0xffff0000u); }
__device__ __forceinline__ float sigm(float x) { return 1.f / (1.f + __expf(-x)); }
template <int MODE> struct EpiGate {
    static constexpr bool PERM = true, AFTER_DRAIN = false;
    bf16_t* O; int ldc; const bf16_t* G; int ldg; size_t gtile;
    __device__ __forceinline__ void operator()(const f32x4 (&acc)[2][2][4][2], const Unit& u, int wr, int wc, int fr, int fq) const {
        const int row0 = u.pm * BM + wr * 64 + fr, col0 = u.pn * BM + wc * 32 + 8 * fq;
#pragma unroll
        for (int ai = 0; ai < 2; ++ai)
#pragma unroll
            for (int m = 0; m < 4; ++m) { const size_t row = (size_t)(row0 + ai * HALF + m * 16);
#pragma unroll
                for (int bj = 0; bj < 2; ++bj) {
                    const u32x4 gw = *(const u32x4*)(G + (size_t)u.pn * gtile + row * ldg + col0 + bj * HALF);
                    f32x4 v0 = acc[ai][bj][m][0], v1 = acc[ai][bj][m][1];
                    v0[0] *= sigm(bflo(gw.x)); v0[1] *= sigm(bfhi(gw.x)); v0[2] *= sigm(bflo(gw.y)); v0[3] *= sigm(bfhi(gw.y));
                    v1[0] *= sigm(bflo(gw.z)); v1[1] *= sigm(bfhi(gw.z)); v1[2] *= sigm(bflo(gw.w)); v1[3] *= sigm(bfhi(gw.w));
                    bf16_t* op = O + row * ldc + col0 + bj * HALF;
                    if (MODE == 1) { const u32x4 ow = *(const u32x4*)op;
                        v0[0] += bflo(ow.x); v0[1] += bfhi(ow.x); v0[2] += bflo(ow.y); v0[3] += bfhi(ow.y);
                        v1[0] += bflo(ow.z); v1[1] += bfhi(ow.z); v1[2] += bflo(ow.w); v1[3] += bfhi(ow.w); }
                    u32x4 w; w.x = cvt_pk_bf16(v0[0], v0[1]); w.y = cvt_pk_bf16(v0[2], v0[3]); w.z = cvt_pk_bf16(v1[0], v1[1]); w.w = cvt_pk_bf16(v1[2], v1[3]);
                    *(u32x4*)op = w; } }
    }
};
struct BranchOrder {
    StaticOrder base; int dm, dn;
    __host__ __device__ void init(int M, int N, int G_, int c_) { base.init(M, N, G_, c_); dm = M / BM; dn = N / BM; }
    __host__ __device__ bool next(int i, Unit& u) const { if (!base.next(i >> 1, u)) return false; if (i & 1) { u.pm += dm; u.pn += dn; } return true; }
    __device__ __forceinline__ void a_ready(const Unit&) const {}
    __device__ __forceinline__ void done(const Unit&) const {}
};
struct EpiGate2 {
    static constexpr bool PERM = true, AFTER_DRAIN = false;
    bf16_t* O; int ldc; const bf16_t* G0; const bf16_t* G1; int ldg; size_t gtile; int dm, dn;
    __device__ __forceinline__ void operator()(const f32x4 (&acc)[2][2][4][2], const Unit& u, int wr, int wc, int fr, int fq) const {
        const bool second = u.pm >= dm;
        Unit v = u; if (second) { v.pm -= dm; v.pn -= dn; }
        if (second) { EpiGate<1> e{O, ldc, G1, ldg, gtile}; e(acc, v, wr, wc, fr, fq); } else { EpiGate<0> e{O, ldc, G0, ldg, gtile}; e(acc, v, wr, wc, fr, fq); }
    }
};
struct EpiResid {
    static constexpr bool PERM = true, AFTER_DRAIN = false;
    const float* R; float* Hf; bf16_t* Hb; float* ss; int ldc;
    __device__ __forceinline__ void operator()(const f32x4 (&acc)[2][2][4][2], const Unit& u, int wr, int wc, int fr, int fq) const {
        const int row0 = u.pm * BM + wr * 64 + fr, col0 = u.pn * BM + wc * 32 + 8 * fq;
#pragma unroll
        for (int ai = 0; ai < 2; ++ai)
#pragma unroll
            for (int m = 0; m < 4; ++m) { const size_t row = (size_t)(row0 + ai * HALF + m * 16); float sq = 0.f;
#pragma unroll
                for (int bj = 0; bj < 2; ++bj) {
                    const size_t off = row * ldc + col0 + bj * HALF;
                    const f32x4 r0 = *(const f32x4*)(R + off), r1 = *(const f32x4*)(R + off + 4);
                    const f32x4 v0 = acc[ai][bj][m][0] + r0, v1 = acc[ai][bj][m][1] + r1;
                    *(f32x4*)(Hf + off) = v0; *(f32x4*)(Hf + off + 4) = v1;
                    u32x4 w; w.x = cvt_pk_bf16(v0[0], v0[1]); w.y = cvt_pk_bf16(v0[2], v0[3]); w.z = cvt_pk_bf16(v1[0], v1[1]); w.w = cvt_pk_bf16(v1[2], v1[3]);
                    *(u32x4*)(Hb + off) = w;
                    sq += (v0[0] * v0[0] + v0[1] * v0[1]) + (v0[2] * v0[2] + v0[3] * v0[3]) + (v1[0] * v1[0] + v1[1] * v1[1]) + (v1[2] * v1[2] + v1[3] * v1[3]); }
                sq += __shfl_xor(sq, 16); sq += __shfl_xor(sq, 32);
                if (fq == 0) atomicAdd(ss + row, sq); }
    }
};
struct EpiRowScale {
    static constexpr bool PERM = true, AFTER_DRAIN = false;
    bf16_t* O; int ldc; const float* ss; float inv_n, eps;
    __device__ __forceinline__ void operator()(const f32x4 (&acc)[2][2][4][2], const Unit& u, int wr, int wc, int fr, int fq) const {
        const int row0 = u.pm * BM + wr * 64 + fr, col0 = u.pn * BM + wc * 32 + 8 * fq;
#pragma unroll
        for (int ai = 0; ai < 2; ++ai)
#pragma unroll
            for (int m = 0; m < 4; ++m) { const size_t row = (size_t)(row0 + ai * HALF + m * 16);
                const float sc = rsqrtf(__hip_atomic_load(ss + row, __ATOMIC_RELAXED, __HIP_MEMORY_SCOPE_AGENT) * inv_n + eps);
#pragma unroll
                for (int bj = 0; bj < 2; ++bj) { const f32x4 v0 = acc[ai][bj][m][0] * sc, v1 = acc[ai][bj][m][1] * sc;
                    u32x4 w; w.x = cvt_pk_bf16(v0[0], v0[1]); w.y = cvt_pk_bf16(v0[2], v0[3]); w.z = cvt_pk_bf16(v1[0], v1[1]); w.w = cvt_pk_bf16(v1[2], v1[3]);
                    *(u32x4*)(O + row * ldc + col0 + bj * HALF) = w; } }
    }
};
}
constexpr int D_MODEL = 2048, BATCH = 2, SEQ = 4096, NTOK = BATCH * SEQ;
constexpr int HD = 64, NCMP = 255, CMP_STRIDE = 16, CMP_LEN = 32, CMP_HID = 128;
constexpr int SEL_LEN = 64, SEL_TOPK = 16, WINDOW = 512;
constexpr int PEER_KEYS = 128, PEER_E = 128;
constexpr int NSA_Q = 1024, SB_W = 1024;
constexpr int IN_COLS = 9776, PLD = 9984;
constexpr int C_SHIFT_FROM = 2608, C_SHIFT = 208, PP = 256;
constexpr int P_QN = 0, P_KC = 4, P_VC = 5, P_KS = 6, P_VS = 7, P_KW = 8, P_VW = 9, P_GBR = 10, P_QB = 11, P_KB = 15, P_VB = 19, P_GA = 23, P_GB = 31;
#define PNL(P, p) ((P) + (size_t)(p) * NTOK * PP)
constexpr float EPS = 1e-6f, NEGF = -1e30f;
constexpr int NWAVES = 8, NTHR = 512;

constexpr size_t MiB = 1u << 20;
constexpr size_t WS_CTL = 0, CTL_ZERO_BYTES = 1 * MiB;
constexpr size_t WS_WIN = 2 * MiB;
constexpr size_t WS_WBN = 42 * MiB, WS_WBS = 46 * MiB;
constexpr size_t WS_WOUT = 50 * MiB, WS_WPQ = 58 * MiB;
constexpr size_t WS_MISC = 66 * MiB;
constexpr size_t WS_XN = 70 * MiB;
constexpr size_t WS_PROJ = 102 * MiB;
constexpr size_t WS_ONSA = 258 * MiB, WS_OSB = 274 * MiB;
constexpr size_t WS_H = 290 * MiB;
constexpr size_t WS_HB = 354 * MiB;
constexpr size_t WS_END = 386 * MiB;
constexpr size_t WS_UB = 102 * MiB, WS_VB = 166 * MiB, WS_QP = 230 * MiB, WS_EXP = 262 * MiB, WS_GATE = 266 * MiB;
constexpr size_t MISC_KCB = 0, MISC_VCB = 1 * MiB, MISC_SKB = 2 * MiB, MISC_W1T = 2 * MiB + 512 * 1024, MISC_B1 = 3 * MiB + 512 * 1024;
constexpr int CW_BAR = 4096;
constexpr int CW_SS = 32768;

#define GAS __attribute__((address_space(1)))
#define LAS __attribute__((address_space(3)))
typedef unsigned short bf16;
typedef unsigned v4u __attribute__((ext_vector_type(4)));
typedef unsigned v2u __attribute__((ext_vector_type(2)));
typedef float f32x4 __attribute__((ext_vector_type(4)));
#define RLX_AGENT __ATOMIC_RELAXED, __HIP_MEMORY_SCOPE_AGENT
__device__ __forceinline__ unsigned f2bf(float f) { unsigned u = __builtin_bit_cast(unsigned, f); return (u + 0x7fffu + ((u >> 16) & 1u)) >> 16; }
__device__ __forceinline__ unsigned pk2(float lo, float hi) { return f2bf(lo) | (f2bf(hi) << 16); }
__device__ __forceinline__ float bf2f(bf16 b) { return __uint_as_float(((unsigned)b) << 16); }
__device__ __forceinline__ float bflo(unsigned w) { return __uint_as_float(w << 16); }
__device__ __forceinline__ float bfhi(unsigned w) { return __uint_as_float(w & 0xffff0000u); }

#define XB_TMO      128
#define XB_XCNT(j)  (256  + 64 * (j))
#define XB_XSUB(j)  (1280 + 64 * (j))
#define XB_XGEN(j)  (2304 + 64 * (j))
#define XB_TOP      3328
#define XB_TOPGEN   3392
#define XCD_BAR_WORDS 3456
#define XB_SPIN_CAP (1u << 24)
__device__ __forceinline__ unsigned xb_ld(unsigned* p)              { return __hip_atomic_load(p, __ATOMIC_RELAXED, __HIP_MEMORY_SCOPE_AGENT); }
__device__ __forceinline__ unsigned xb_add(unsigned* p, unsigned v) { return __hip_atomic_fetch_add(p, v, __ATOMIC_RELAXED, __HIP_MEMORY_SCOPE_AGENT); }
__device__ __forceinline__ unsigned xb_xcc_id() { return (unsigned)__builtin_amdgcn_s_getreg((3 << 11) | 20) & 0xFu; }
#define XB_SPIN(cond, bar) do { unsigned _sp = 0; while (cond) { __builtin_amdgcn_s_sleep(1); \
    if ((++_sp & 255u) == 0u) { if (xb_ld(&(bar)[XB_TMO])) break; if (_sp > XB_SPIN_CAP) { atomicAdd(&(bar)[XB_TMO], 1u); break; } } } } while (0)
struct XcdBarrier { unsigned* bar; unsigned x; volatile LAS unsigned* st; };
__device__ __forceinline__ XcdBarrier xcd_barrier_post(unsigned* bar, volatile LAS unsigned* st) {
    XcdBarrier b; b.bar = bar; b.x = xb_xcc_id(); b.st = st;
    if (threadIdx.x == 0) (void)xb_add(&bar[XB_XCNT(b.x)], 1u);
    return b;
}
__device__ __forceinline__ void xcd_barrier_complete(unsigned* bar, unsigned x, unsigned& nloc, unsigned& nx) {
    const unsigned G = gridDim.x * gridDim.y * gridDim.z;
    unsigned sum, cnt, mine, sp = 0u;
    for (;;) {
        sum = 0u; cnt = 0u; mine = 0u;
#pragma unroll
        for (unsigned j = 0; j < 16; ++j) { const unsigned c = xb_ld(&bar[XB_XCNT(j)]); sum += c; cnt += (c > 0u) ? 1u : 0u; mine = (j == x) ? c : mine; }
        if (sum == G) break;
        __builtin_amdgcn_s_sleep(1);
        if ((++sp & 255u) == 0u) { if (xb_ld(&bar[XB_TMO])) break; if (sp > XB_SPIN_CAP) { atomicAdd(&bar[XB_TMO], 1u); break; } }
    }
    nloc = mine > 0u ? mine : 1u; nx = cnt > 0u ? cnt : 1u;
}
__device__ __forceinline__ void xcd_barrier(const XcdBarrier& b) {
    asm volatile("s_waitcnt vmcnt(0)" ::: "memory");
    __syncthreads();
    if (threadIdx.x == 0) {
        unsigned* bar = b.bar;
        const unsigned bx = xb_xcc_id();
        __builtin_amdgcn_s_waitcnt(0);
        unsigned nloc = b.st[0], nx = b.st[1];
        if (nloc == 0u) { xcd_barrier_complete(bar, bx, nloc, nx); b.st[0] = nloc; b.st[1] = nx; }
        const unsigned old = xb_add(&bar[XB_XSUB(bx)], 1u);
        const unsigned gen = old / nloc;
        if (old + 1u == (gen + 1u) * nloc) {
            __builtin_amdgcn_fence(__ATOMIC_RELEASE, "agent");
            asm volatile("s_waitcnt vmcnt(0)" ::: "memory");
            const unsigned og = xb_add(&bar[XB_TOP], 1u);
            const unsigned tg = og / nx;
            if (og + 1u == (tg + 1u) * nx) xb_add(&bar[XB_TOPGEN], 1u);
            else XB_SPIN(xb_ld(&bar[XB_TOPGEN]) == tg, bar);
            __builtin_amdgcn_fence(__ATOMIC_ACQUIRE, "agent");
            xb_add(&bar[XB_XGEN(bx)], 1u);
            asm volatile("s_waitcnt vmcnt(0)" ::: "memory");
        } else {
            XB_SPIN(xb_ld(&bar[XB_XGEN(bx)]) == gen, bar);
            __builtin_amdgcn_fence(__ATOMIC_ACQUIRE, "agent");
            asm volatile("s_waitcnt vmcnt(0)" ::: "memory");
        }
    }
    __syncthreads();
}

__device__ __forceinline__ int rel_bucket(int d) {
    if (d < 16) return d < 0 ? 0 : d;
    int b = 16;
    b += (d >= 21); b += (d >= 27); b += (d >= 35); b += (d >= 46); b += (d >= 59); b += (d >= 77); b += (d >= 99); b += (d >= 128);
    b += (d >= 166); b += (d >= 216); b += (d >= 280); b += (d >= 363); b += (d >= 470); b += (d >= 609); b += (d >= 790);
    return b;
}
__device__ __forceinline__ float gelu_tanh(float x) { const float k = 0.7978845608028654f; return 0.5f * x * (1.f + tanhf(k * (x + 0.044715f * x * x * x))); }
__device__ __forceinline__ float sigmoidf_(float x) { return 1.f / (1.f + expf(-x)); }
__device__ __forceinline__ float wave_sum(float v) {
#pragma unroll
    for (int o = 32; o >= 1; o >>= 1) v += __shfl_xor(v, o);
    return v;
}
__device__ __forceinline__ float wave_max(float v) {
#pragma unroll
    for (int o = 32; o >= 1; o >>= 1) v = fmaxf(v, __shfl_xor(v, o));
    return v;
}
__device__ __forceinline__ float half_sum(float v, float* red) {
    v = wave_sum(v);
    __syncthreads();
    if ((threadIdx.x & 63) == 0) red[(threadIdx.x >> 6) & 3] = v;
    __syncthreads();
    return red[0] + red[1] + red[2] + red[3];
}
__device__ __forceinline__ float half_max(float v, float* red) {
    v = wave_max(v);
    __syncthreads();
    if ((threadIdx.x & 63) == 0) red[(threadIdx.x >> 6) & 3] = v;
    __syncthreads();
    return fmaxf(fmaxf(red[0], red[1]), fmaxf(red[2], red[3]));
}

struct Args {
    const float* in[19]; float* out; unsigned char* ws; int ph_lo, ph_hi; int variant, pad;
};

__device__ __forceinline__ void p0_transpose_item(const float* W, int K, int N, bf16* WT, const float* gk, LAS float* scr, int item, int lane, int shift_from = 0x7fffffff, int shift = 0) {
    const int nblk = (N + 31) / 32, kb = item / nblk, nb = item % nblk, k0 = 64 * kb, n0 = 32 * nb;
    const int c4 = (lane & 7) * 4, r8 = lane >> 3;
    const bool cok = (n0 + c4) < N;
    f32x4 v[8];
#pragma unroll
    for (int i = 0; i < 8; ++i) { const int kk = 8 * i + r8; v[i] = cok ? *(const f32x4*)(W + (size_t)(k0 + kk) * N + n0 + c4) : (f32x4){0.f, 0.f, 0.f, 0.f}; }
#pragma unroll
    for (int i = 0; i < 8; ++i) { const int kk = 8 * i + r8; const float g = gk ? gk[k0 + kk] : 1.f;
        scr[kk * 33 + c4 + 0] = v[i].x * g; scr[kk * 33 + c4 + 1] = v[i].y * g; scr[kk * 33 + c4 + 2] = v[i].z * g; scr[kk * 33 + c4 + 3] = v[i].w * g; }
    asm volatile("s_waitcnt lgkmcnt(0)" ::: "memory");
    const int c = lane & 7;
#pragma unroll
    for (int j = 0; j < 4; ++j) { const int n = (lane >> 3) + 8 * j; const LAS float* s = scr + (8 * c) * 33 + n;
        v4u o; o.x = pk2(s[0 * 33], s[1 * 33]); o.y = pk2(s[2 * 33], s[3 * 33]); o.z = pk2(s[4 * 33], s[5 * 33]); o.w = pk2(s[6 * 33], s[7 * 33]);
        const int nd = n0 + n + ((n0 + n >= shift_from) ? shift : 0);
        if (n0 + n < N) *(v4u*)(WT + (size_t)nd * K + k0 + 8 * c) = o; }
    asm volatile("s_waitcnt lgkmcnt(0)" ::: "memory");
}
__device__ __forceinline__ void rms_row_to_bf16(const float* xrow, const float* g, bf16* orow, int lane) {
    const f32x4* xr = (const f32x4*)xrow + lane; const f32x4* gr = (const f32x4*)g + lane;
    f32x4 v[8]; float s = 0.f;
#pragma unroll
    for (int j = 0; j < 8; ++j) { v[j] = xr[64 * j]; s += (v[j].x * v[j].x + v[j].y * v[j].y) + (v[j].z * v[j].z + v[j].w * v[j].w); }
    const float r = rsqrtf(wave_sum(s) * (1.f / D_MODEL) + EPS);
    v2u* o8 = (v2u*)orow + lane;
#pragma unroll
    for (int j = 0; j < 8; ++j) { const f32x4 gv = gr[64 * j]; v2u w; w.x = pk2(v[j].x * r * gv.x, v[j].y * r * gv.y); w.y = pk2(v[j].z * r * gv.z, v[j].w * r * gv.w); o8[64 * j] = w; }
}
__device__ __forceinline__ void cvt_flat(const float* src, bf16* dst, size_t n, size_t gthread, size_t nthreads) {
    for (size_t i = gthread * 8; i < n; i += nthreads * 8) {
        const f32x4 a = *(const f32x4*)(src + i), b = *(const f32x4*)(src + i + 4);
        v4u o; o.x = pk2(a.x, a.y); o.y = pk2(a.z, a.w); o.z = pk2(b.x, b.y); o.w = pk2(b.z, b.w);
        *(v4u*)(dst + i) = o;
    }
}
namespace cmpr {
typedef short bf16x8 __attribute__((ext_vector_type(8)));
typedef float f32x4v __attribute__((ext_vector_type(4)));
__device__ __forceinline__ void compress_phase(const bf16* PROJ, const bf16* W1T, const float* BIAS1, const float* const* in, bf16* KCB, bf16* VCB,
                                               __attribute__((address_space(3))) unsigned char* lds3, int bid, int G) {
    int tid = threadIdx.x; asm volatile("" : "+v"(tid));
    const int lane = tid & 63, wid = __builtin_amdgcn_readfirstlane(tid >> 6), r16 = lane & 15, kq = lane >> 4;
    __attribute__((address_space(3))) float* PART = (__attribute__((address_space(3))) float*)lds3;
    __attribute__((address_space(3))) float* HID = (__attribute__((address_space(3))) float*)(lds3 + 65536);
    for (int unit = bid; unit < 256; unit += G) {
        const int c = unit & 15, g = (unit >> 4) & 3, b = (unit >> 6) & 1, kv = unit >> 7, n0 = 16 * c;
        int nn = n0 + r16; if (nn > NCMP - 1) nn = NCMP - 1;
        const bf16* ap = PNL(PROJ, kv ? P_VC : P_KC) + (size_t)(b * SEQ + 16 * nn + 4 * wid) * PP + g * HD + 8 * kq;
        const bf16* bp = W1T + (size_t)kv * CMP_HID * 2048 + (size_t)r16 * 2048 + 256 * wid + 8 * kq;
        f32x4v acc[8] = {};
        bf16x8 af[8];
#pragma unroll
        for (int ks = 0; ks < 8; ++ks) af[ks] = *(const bf16x8*)(ap + (size_t)(ks >> 1) * PP + (ks & 1) * 32);
        bf16x8 wa[8], wb[8];
#define CMP_LOADW(W, KS) do { _Pragma("unroll") for (int nt = 0; nt < 8; ++nt) W[nt] = *(const bf16x8*)(bp + (size_t)nt * 16 * 2048 + (KS) * 32); } while (0)
#define CMP_MMA(W, KS) do { _Pragma("unroll") for (int nt = 0; nt < 8; ++nt) acc[nt] = __builtin_amdgcn_mfma_f32_16x16x32_bf16(af[KS], W[nt], acc[nt], 0, 0, 0); } while (0)
        CMP_LOADW(wa, 0);
#pragma unroll
        for (int ks = 0; ks < 8; ks += 2) {
            CMP_LOADW(wb, ks + 1); __builtin_amdgcn_sched_barrier(0);
            CMP_MMA(wa, ks); __builtin_amdgcn_sched_barrier(0);
            if (ks + 2 < 8) CMP_LOADW(wa, ks + 2);
            __builtin_amdgcn_sched_barrier(0);
            CMP_MMA(wb, ks + 1); __builtin_amdgcn_sched_barrier(0);
        }
#undef CMP_LOADW
#undef CMP_MMA
#pragma unroll
        for (int nt = 0; nt < 8; ++nt)
#pragma unroll
            for (int r = 0; r < 4; ++r) PART[wid * 2048 + (kq * 4 + r) * 128 + nt * 16 + r16] = acc[nt][r];
        asm volatile("s_waitcnt lgkmcnt(0)" ::: "memory"); __syncthreads();
#pragma unroll
        for (int i = 0; i < 4; ++i) { const int e = tid + NTHR * i; float s = BIAS1[kv * CMP_HID + (e & 127)];
#pragma unroll
            for (int w = 0; w < 8; ++w) s += PART[w * 2048 + e];
            HID[e] = gelu_tanh(s); }
        asm volatile("s_waitcnt lgkmcnt(0)" ::: "memory"); __syncthreads();
        {
            const int nl = tid >> 5, d = (tid & 31) * 2; const float* w2 = in[kv ? 8 : 5];
            float o0 = 0.f, o1 = 0.f;
#pragma unroll 8
            for (int j = 0; j < CMP_HID; ++j) { const float hv = HID[nl * 128 + j]; const float2 wv = *(const float2*)(w2 + j * HD + d); o0 += hv * wv.x; o1 += hv * wv.y; }
            const int n = n0 + nl;
            const unsigned pk = (n < NCMP) ? pk2(o0, o1) : 0u;
            *(unsigned*)((kv ? VCB : KCB) + (size_t)((b * 4 + g) * 256 + n) * HD + d) = pk;
        }
        __syncthreads();
    }
}
}
#ifndef NSA_FAR
#define NSA_FAR 1
#endif
namespace nsa {
typedef short bf16x8 __attribute__((ext_vector_type(8)));
typedef short s16x4 __attribute__((ext_vector_type(4)));
typedef float f32x16 __attribute__((ext_vector_type(16)));
typedef unsigned u32x4 __attribute__((ext_vector_type(4)));
typedef __attribute__((address_space(3))) const char* lds_cptr;
typedef __attribute__((address_space(3))) unsigned char* lds_ptr;
constexpr int SLOTB = 16384;
constexpr int NSLOT = 4;
constexpr int L_RING = 0, L_OV = 65536, L_BT = 98304, L_WSF = 111104, L_MASK = 113152, L_MISC = 113664, L_X = 113792, L_END = L_X + 32768;
constexpr int BT_N = 800;
constexpr float LOG2E = 1.4426950408889634f, SC2 = 0.125f * LOG2E, NEG2 = -1e30f;
static_assert(L_END <= 162816, "nsa LDS map");
__device__ __forceinline__ int crow(int r, int hi) { return (r & 3) + 8 * (r >> 2) + 4 * hi; }
__device__ __forceinline__ void glds16(const void* gsrc, unsigned lds_dst) { unsigned keep;
    asm volatile("s_mov_b32 %0, m0\n\ts_mov_b32 m0, %2\n\ts_nop 0\n\tglobal_load_lds_dwordx4 %1, off\n\ts_mov_b32 m0, %0" : "=&s"(keep) : "v"(gsrc), "s"(lds_dst) : "memory"); }
typedef float f32x2_t __attribute__((ext_vector_type(2))); typedef __bf16 bf16x2_t __attribute__((ext_vector_type(2)));
__device__ __forceinline__ unsigned cvtpk_s(float lo, float hi) { f32x2_t v = {lo, hi}; bf16x2_t b = __builtin_convertvector(v, bf16x2_t); return __builtin_bit_cast(unsigned, b); }
#define NSA_WAIT_BAR(N) asm volatile("s_waitcnt vmcnt(" #N ") lgkmcnt(0)\n\ts_barrier" ::: "memory")
#define NSA_SBAR() __builtin_amdgcn_sched_barrier(0)

__device__ __forceinline__ void qkt(f32x16& p0, f32x16& p1, lds_cptr Kslot, const bf16x8* qr, int r32, int hi) {
    lds_cptr kb = Kslot + hi * 1024 + r32 * 16;
    const f32x16 z = {};
#pragma unroll
    for (int d0 = 0; d0 < 4; ++d0) {
        const bf16x8 b0 = *(const __attribute__((address_space(3))) bf16x8*)(kb + d0 * 2048);
        const bf16x8 b1 = *(const __attribute__((address_space(3))) bf16x8*)(kb + d0 * 2048 + 512);
        if (d0 == 0) { p0 = __builtin_amdgcn_mfma_f32_32x32x16_bf16(b0, qr[0], z, 0, 0, 0); p1 = __builtin_amdgcn_mfma_f32_32x32x16_bf16(b1, qr[0], z, 0, 0, 0); }
        else { p0 = __builtin_amdgcn_mfma_f32_32x32x16_bf16(b0, qr[d0], p0, 0, 0, 0); p1 = __builtin_amdgcn_mfma_f32_32x32x16_bf16(b1, qr[d0], p1, 0, 0, 0); }
    }
}
__device__ __forceinline__ void pv(f32x16* o, int vb, bf16x8 pa0, bf16x8 pa1, bf16x8 pa2, bf16x8 pa3) {
#pragma unroll
    for (int d0 = 0; d0 < 2; ++d0) { s16x4 lo[4], hi[4];
#pragma unroll
        for (int ks = 0; ks < 4; ++ks) {
            asm volatile("ds_read_b64_tr_b16 %0,%1 offset:%c2" : "=&v"(lo[ks]) : "v"(vb), "i"(d0 * 4096 + ks * 1024) : "memory");
            asm volatile("ds_read_b64_tr_b16 %0,%1 offset:%c2" : "=&v"(hi[ks]) : "v"(vb), "i"(d0 * 4096 + ks * 1024 + 512) : "memory"); }
        asm volatile("s_waitcnt lgkmcnt(0)" ::: "memory"); NSA_SBAR();
#define NSA_PK(k) (bf16x8){lo[k][0], lo[k][1], lo[k][2], lo[k][3], hi[k][0], hi[k][1], hi[k][2], hi[k][3]}
        o[d0] = __builtin_amdgcn_mfma_f32_32x32x16_bf16(pa0, NSA_PK(0), o[d0], 0, 0, 0);
        o[d0] = __builtin_amdgcn_mfma_f32_32x32x16_bf16(pa1, NSA_PK(1), o[d0], 0, 0, 0);
        o[d0] = __builtin_amdgcn_mfma_f32_32x32x16_bf16(pa2, NSA_PK(2), o[d0], 0, 0, 0);
        o[d0] = __builtin_amdgcn_mfma_f32_32x32x16_bf16(pa3, NSA_PK(3), o[d0], 0, 0, 0);
#undef NSA_PK
    }
}
__device__ __forceinline__ float rowmax32(const f32x16& p0, const f32x16& p1) {
    float a = fmaxf(p0[0], p1[0]), b = fmaxf(p0[1], p1[1]);
#pragma unroll
    for (int r = 2; r < 16; r += 2) { a = fmaxf(fmaxf(a, p0[r]), p1[r]); b = fmaxf(fmaxf(b, p0[r + 1]), p1[r + 1]); }
    a = fmaxf(a, b);
    auto rr = __builtin_amdgcn_permlane32_swap(__float_as_uint(a), __float_as_uint(a), false, false);
    return fmaxf(__uint_as_float(rr[0]), __uint_as_float(rr[1]));
}
__device__ __forceinline__ float swap_add(float v) {
    auto rr = __builtin_amdgcn_permlane32_swap(__float_as_uint(v), __float_as_uint(v), false, false);
    return __uint_as_float(rr[0]) + __uint_as_float(rr[1]);
}

struct PassCtx {
    lds_ptr lds3; unsigned lds0;
    int lane, r32, hi, wid;
    int tq;
    const __attribute__((address_space(3))) float* bt;
    __attribute__((address_space(3))) float* wsf;
    int vboff;
};

template <int MODE>
__device__ __forceinline__ void run_pass(const PassCtx& c, int NT, int first, const bf16* Kb, const bf16* Vb, int pitch, const bf16x8* qr,
                                         unsigned mask_lo, unsigned mask_hi, f32x16 (&o)[2], f32x16 (&im)[2], float& m, float& l) {
    const __attribute__((address_space(3))) unsigned char* TL = (const __attribute__((address_space(3))) unsigned char*)(c.lds3 + L_MISC);
#define NSA_TID(i) ((MODE == 0) ? (i) : (MODE == 2) ? (first + (i)) : (int)TL[NT - 1 - (i)])
#define NSA_ISSUE(i, slot) do { const int id_ = __builtin_amdgcn_readfirstlane(NSA_TID(i)); \
        const bf16* ks_ = Kb + (size_t)(64 * id_ + c.lane) * pitch + 8 * c.wid; \
        const bf16* vs_ = Vb + (size_t)(64 * id_ + 16 * (c.wid & 3) + (c.lane >> 2)) * pitch + 32 * (c.wid >> 2) + 8 * (c.lane & 3); \
        glds16(ks_, (unsigned)__builtin_amdgcn_readfirstlane(c.lds0 + L_RING + (slot) * SLOTB + c.wid * 1024)); \
        glds16(vs_, (unsigned)__builtin_amdgcn_readfirstlane(c.lds0 + L_RING + (slot) * SLOTB + 8192 + c.wid * 1024)); } while (0)
    if (NT > 0) NSA_ISSUE(0, 0);
    if (NT > 1) NSA_ISSUE(1, 1);
    if (NT > 2) NSA_ISSUE(2, 2);
    int slot = 0;
    for (int i = 0; i < NT; ++i) {
        if (i + 2 < NT) NSA_WAIT_BAR(4); else if (i + 1 < NT) NSA_WAIT_BAR(2); else NSA_WAIT_BAR(0);
        if (i + 3 < NT) { const int s3 = (slot == 0) ? 3 : slot - 1; NSA_ISSUE(i + 3, s3); }
        const int id = __builtin_amdgcn_readfirstlane(NSA_TID(i));
        f32x16 p0, p1;
        qkt(p0, p1, (lds_cptr)(c.lds3 + L_RING + slot * SLOTB), qr, c.r32, c.hi);
        const int dbase = (MODE == 0) ? (c.tq - 31 - 1024 * id) : (c.tq - 64 * id);
        bool selb = true;
        if (MODE == 1) selb = ((id < 32 ? (mask_lo >> id) : (mask_hi >> (id - 32))) & 1u) != 0u;
        float alpha, rs = 0.f;
        if (NSA_FAR && MODE == 1 && __builtin_amdgcn_readfirstlane(c.tq - c.r32) - (64 * id + 63) >= 790) {
            const float lofs = selb ? c.bt[790] : -INFINITY;
            const float mt = rowmax32(p0, p1) * SC2 + lofs;
            const float mnew = fmaxf(m, mt);
            alpha = __builtin_amdgcn_exp2f(m - mnew);
            m = mnew;
            const float off = lofs - mnew;
#pragma unroll
            for (int r = 0; r < 16; ++r) { p0[r] = __builtin_amdgcn_exp2f(p0[r] * SC2 + off); p1[r] = __builtin_amdgcn_exp2f(p1[r] * SC2 + off); rs += p0[r] + p1[r]; }
        } else {
        int dbh = dbase - ((MODE == 0) ? 64 * c.hi : 4 * c.hi);
        asm volatile("" : "+v"(dbh));
#pragma unroll
        for (int r = 0; r < 16; ++r) {
            const int d0 = dbh - ((MODE == 0) ? 16 * ((r & 3) + 8 * (r >> 2)) : ((r & 3) + 8 * (r >> 2)));
            const int d1 = (MODE == 0) ? (d0 - 512) : (d0 - 32);
            bool v0 = d0 >= 0, v1 = d1 >= 0;
            if (MODE == 2) { v0 = v0 && d0 < WINDOW; v1 = v1 && d1 < WINDOW; }
            if (MODE == 1) { v0 = v0 && selb; v1 = v1 && selb; }
            const int i0 = d0 < 0 ? 0 : (d0 > 790 ? 790 : d0), i1 = d1 < 0 ? 0 : (d1 > 790 ? 790 : d1);
            const float s0 = p0[r] * SC2 + c.bt[i0], s1 = p1[r] * SC2 + c.bt[i1];
            p0[r] = v0 ? s0 : -INFINITY; p1[r] = v1 ? s1 : -INFINITY;
        }
        const float mt = rowmax32(p0, p1);
        const float mnew = fmaxf(m, mt);
        alpha = __builtin_amdgcn_exp2f(m - mnew);
        m = mnew;
#pragma unroll
        for (int r = 0; r < 16; ++r) {
            const float e0 = __builtin_amdgcn_exp2f(p0[r] - mnew), e1 = __builtin_amdgcn_exp2f(p1[r] - mnew);
            p0[r] = e0; p1[r] = e1; rs += e0 + e1;
        }
        }
        l = l * alpha + rs;
        if (!__all(alpha == 1.f)) {
            if (c.hi == 0) c.wsf[c.r32] = alpha;
            asm volatile("s_waitcnt lgkmcnt(0)" ::: "memory");
#pragma unroll
            for (int r = 0; r < 16; ++r) { const float a = c.wsf[crow(r, c.hi)]; o[0][r] *= a; o[1][r] *= a; if (MODE == 0) { im[0][r] *= a; im[1][r] *= a; } }
        }
        u32x4 pw0, pw1, pw2, pw3;
        pw0 = (u32x4){cvtpk_s(p0[0], p0[1]), cvtpk_s(p0[2], p0[3]), cvtpk_s(p0[4], p0[5]), cvtpk_s(p0[6], p0[7])};
        pw1 = (u32x4){cvtpk_s(p0[8], p0[9]), cvtpk_s(p0[10], p0[11]), cvtpk_s(p0[12], p0[13]), cvtpk_s(p0[14], p0[15])};
        pw2 = (u32x4){cvtpk_s(p1[0], p1[1]), cvtpk_s(p1[2], p1[3]), cvtpk_s(p1[4], p1[5]), cvtpk_s(p1[6], p1[7])};
        pw3 = (u32x4){cvtpk_s(p1[8], p1[9]), cvtpk_s(p1[10], p1[11]), cvtpk_s(p1[12], p1[13]), cvtpk_s(p1[14], p1[15])};
        NSA_SBAR();
        pv(o, (int)(c.lds0 + L_RING + slot * SLOTB + 8192) + c.vboff, __builtin_bit_cast(bf16x8, pw0), __builtin_bit_cast(bf16x8, pw1), __builtin_bit_cast(bf16x8, pw2), __builtin_bit_cast(bf16x8, pw3));
        if (MODE == 0) pv(im, (int)(c.lds0 + L_OV + id * 8192) + c.vboff, __builtin_bit_cast(bf16x8, pw0), __builtin_bit_cast(bf16x8, pw1), __builtin_bit_cast(bf16x8, pw2), __builtin_bit_cast(bf16x8, pw3));
        slot = (slot == NSLOT - 1) ? 0 : slot + 1;
    }
    asm volatile("s_waitcnt vmcnt(0) lgkmcnt(0)\n\ts_barrier" ::: "memory");
#undef NSA_TID
#undef NSA_ISSUE
}

__device__ __forceinline__ void build_ov(lds_ptr lds3) {
    for (int idx = threadIdx.x; idx < 4 * 4096; idx += NTHR) {
        const int kt = idx >> 12, nl = (idx >> 6) & 63, jc = idx & 63, n = 64 * kt + nl;
        unsigned short v = 0;
        if ((n & 3) != 3) { if (jc == (n >> 2)) v = 0x3F80; } else { if (jc == (n >> 2) || jc == (n >> 2) + 1) v = 0x3F00; }
        *(__attribute__((address_space(3))) unsigned short*)(lds3 + L_OV + kt * 8192 + ((jc >> 5) * 4 + (nl >> 4)) * 1024 + (nl & 15) * 64 + (jc & 31) * 2) = v;
    }
}

__device__ __forceinline__ void nsa_unit(int variant, bool build_bt, int b, int g, int qt, const bf16* PROJ, const bf16* KCBb, const bf16* VCBb, const float* rel, bf16* ONSA, lds_ptr lds3, unsigned lds0) {
    const int tid = threadIdx.x, lane = tid & 63, r32 = lane & 31, hi = lane >> 5;
    const int wid = __builtin_amdgcn_readfirstlane(tid >> 6), hh = wid & 3, th = wid >> 2;
    const int t0 = qt * 64, tq = t0 + 32 * th + r32, cur = qt;
    __attribute__((address_space(3))) float* BT = (__attribute__((address_space(3))) float*)(lds3 + L_BT);
    __attribute__((address_space(3))) unsigned* MASK = (__attribute__((address_space(3))) unsigned*)(lds3 + L_MASK);
    if (build_bt) for (int i = tid; i < 4 * BT_N; i += NTHR) { const int hq = i / BT_N, d = i - hq * BT_N; BT[i] = rel[rel_bucket(d) * 16 + g * 4 + hq] * LOG2E; }
    if (tid < 128) MASK[tid] = 0u;
    PassCtx c; c.lds3 = lds3; c.lds0 = lds0; c.lane = lane; c.r32 = r32; c.hi = hi; c.wid = wid; c.tq = tq;
    c.bt = BT + hh * BT_N; c.wsf = (__attribute__((address_space(3))) float*)(lds3 + L_WSF) + wid * 64;
    c.vboff = ((lane >> 4) & 1) * 32 + (lane & 3) * 8 + (4 * hi + ((lane & 15) >> 2)) * 64;
    const size_t qrow = (size_t)(b * SEQ + tq) * PP;
    bf16x8 qr[4];
#pragma unroll
    for (int d0 = 0; d0 < 4; ++d0) qr[d0] = *(const bf16x8*)(PNL(PROJ, P_QN + g) + qrow + hh * HD + d0 * 16 + hi * 8);
    const float gate0 = 1.f / (1.f + __expf(-bf2f(PNL(PROJ, P_GBR)[qrow + 0 * 16 + g * 4 + hh])));
    const float gate1 = 1.f / (1.f + __expf(-bf2f(PNL(PROJ, P_GBR)[qrow + 1 * 16 + g * 4 + hh])));
    const float gate2 = 1.f / (1.f + __expf(-bf2f(PNL(PROJ, P_GBR)[qrow + 2 * 16 + g * 4 + hh])));
    asm volatile("s_waitcnt vmcnt(0) lgkmcnt(0)" ::: "memory");
    __syncthreads();
    f32x16 oc[2] = {}, o[2] = {}, im[2] = {};
    float m = NEG2, l = 0.f;
    {
        int cnt = (t0 + 32) / 16 + 1; if (cnt > NCMP) cnt = NCMP;
        const int NT = (variant & 4) ? 0 : ((cnt + 63) >> 6);
#if defined(PROBE_NSA_CMP2)
        run_pass<0>(c, NT, 0, KCBb + (size_t)(b * 4 + g) * 256 * HD, VCBb + (size_t)(b * 4 + g) * 256 * HD, HD, qr, 0u, 0u, o, im, m, l);
        o[0] = f32x16{}; o[1] = f32x16{}; im[0] = f32x16{}; im[1] = f32x16{}; m = NEG2; l = 0.f;
#endif
        run_pass<0>(c, NT, 0, KCBb + (size_t)(b * 4 + g) * 256 * HD, VCBb + (size_t)(b * 4 + g) * 256 * HD, HD, qr, 0u, 0u, o, im, m, l);
        const float lt = swap_add(l);
        const float inv = lt > 0.f ? 1.f / lt : 0.f;
        if (hi == 0) { c.wsf[r32] = inv * gate0; c.wsf[32 + r32] = inv; }
        asm volatile("s_waitcnt lgkmcnt(0)" ::: "memory");
#pragma unroll
        for (int r = 0; r < 16; ++r) { const float a = c.wsf[crow(r, hi)], a2 = c.wsf[32 + crow(r, hi)]; oc[0][r] = o[0][r] * a; oc[1][r] = o[1][r] * a; im[0][r] *= a2; im[1][r] *= a2; }
        if (!(variant & 8)) {
        {
            __attribute__((address_space(3))) float* PW = (__attribute__((address_space(3))) float*)(lds3 + L_RING) + wid * 2048;
#pragma unroll
            for (int d0 = 0; d0 < 2; ++d0)
#pragma unroll
                for (int r = 0; r < 16; ++r) PW[crow(r, hi) * 64 + d0 * 32 + r32] = im[d0][r];
        }
        asm volatile("s_waitcnt lgkmcnt(0)" ::: "memory"); __syncthreads();
        __attribute__((address_space(3))) float* T = (__attribute__((address_space(3))) float*)(lds3 + L_X);
        {
            const __attribute__((address_space(3))) float* PA = (const __attribute__((address_space(3))) float*)(lds3 + L_RING);
            int tx = tid; asm volatile("" : "+v"(tx));
            const int j = tx & 63, tb = (tx >> 6) * 8;
#pragma unroll
            for (int e = 0; e < 8; ++e) { const int tok = tb + e, w0 = (tok >> 5) * 4, q = tok & 31;
                T[tok * 65 + j] = (PA[(w0 + 0) * 2048 + q * 64 + j] + PA[(w0 + 1) * 2048 + q * 64 + j]) + (PA[(w0 + 2) * 2048 + q * 64 + j] + PA[(w0 + 3) * 2048 + q * 64 + j]); }
        }
        asm volatile("s_waitcnt lgkmcnt(0)" ::: "memory"); __syncthreads();
        {
            int ty = tid; asm volatile("" : "+v"(ty));
            const int tok = ty & 63, jg = wid, jlo = 8 * jg;
            float v[8]; int rank[8];
#pragma unroll
            for (int e = 0; e < 8; ++e) { const int j = jlo + e; const bool forced = (j == 0) || (j == cur) || (j == cur - 1);
                v[e] = (j <= cur) ? T[tok * 65 + j] + (forced ? 1e4f : 0.f) : -INFINITY; rank[e] = 0; }
            const int nA = jlo < cur + 1 ? jlo : cur + 1, nB = (jlo + 8) < cur + 1 ? (jlo + 8) : cur + 1;
#pragma unroll 2
            for (int j2 = 0; j2 < nA; ++j2) {
                const float sv = T[tok * 65 + j2] + (((j2 == 0) || (j2 == cur) || (j2 == cur - 1)) ? 1e4f : 0.f);
#pragma unroll
                for (int e = 0; e < 8; ++e) rank[e] += (sv >= v[e]) ? 1 : 0;
            }
            for (int j2 = jlo; j2 < nB; ++j2) {
                const float sv = T[tok * 65 + j2] + (((j2 == 0) || (j2 == cur) || (j2 == cur - 1)) ? 1e4f : 0.f);
#pragma unroll
                for (int e = 0; e < 8; ++e) rank[e] += (sv > v[e] || (sv == v[e] && j2 < jlo + e)) ? 1 : 0;
            }
#pragma unroll 2
            for (int j2 = jlo + 8; j2 <= cur; ++j2) {
                const float sv = T[tok * 65 + j2] + (((j2 == 0) || (j2 == cur) || (j2 == cur - 1)) ? 1e4f : 0.f);
#pragma unroll
                for (int e = 0; e < 8; ++e) rank[e] += (sv > v[e]) ? 1 : 0;
            }
            unsigned bits = 0u;
#pragma unroll
            for (int e = 0; e < 8; ++e) { const int j = jlo + e; if (j <= cur && rank[e] < SEL_TOPK) bits |= 1u << e; }
            if (bits) atomicOr((unsigned*)(MASK + tok * 2 + (jg >> 2)), bits << ((jg & 3) * 8));
        }
        asm volatile("s_waitcnt lgkmcnt(0)" ::: "memory"); __syncthreads();
        if (wid == 0) {
            unsigned ulo = MASK[lane * 2], uhi = MASK[lane * 2 + 1];
#pragma unroll
            for (int ofs = 32; ofs >= 1; ofs >>= 1) { ulo |= __shfl_xor(ulo, ofs); uhi |= __shfl_xor(uhi, ofs); }
            {
                __attribute__((address_space(3))) unsigned char* TL = (__attribute__((address_space(3))) unsigned char*)(lds3 + L_MISC);
                const unsigned long long mm = ((unsigned long long)uhi << 32) | ulo;
                int ln = lane; asm volatile("" : "+v"(ln));
                if ((mm >> ln) & 1ull) TL[__popcll(mm & ((1ull << ln) - 1ull))] = (unsigned char)ln;
                if (lane == 0) *(__attribute__((address_space(3))) int*)(lds3 + L_MISC + 64) = __popcll(mm);
            }
        }
        asm volatile("s_waitcnt lgkmcnt(0)" ::: "memory"); __syncthreads();
        }
    }
    {
        const unsigned mlo = MASK[(32 * th + r32) * 2], mhi = MASK[(32 * th + r32) * 2 + 1];
        const int NT = (variant & 1) ? 0 : __builtin_amdgcn_readfirstlane(*(__attribute__((address_space(3))) int*)(lds3 + L_MISC + 64));
#if defined(PROBE_NSA_SEL2)
        o[0] = f32x16{}; o[1] = f32x16{}; m = NEG2; l = 0.f;
        run_pass<1>(c, NT, 0, PNL(PROJ, P_KS) + (size_t)b * SEQ * PP + g * HD, PNL(PROJ, P_VS) + (size_t)b * SEQ * PP + g * HD, PP, qr, mlo, mhi, o, im, m, l);
#endif
        o[0] = f32x16{}; o[1] = f32x16{}; m = NEG2; l = 0.f;
        run_pass<1>(c, NT, 0, PNL(PROJ, P_KS) + (size_t)b * SEQ * PP + g * HD, PNL(PROJ, P_VS) + (size_t)b * SEQ * PP + g * HD, PP, qr, mlo, mhi, o, im, m, l);
        const float lt = swap_add(l);
        const float inv = lt > 0.f ? 1.f / lt : 0.f;
        if (hi == 0) c.wsf[r32] = inv * gate1;
        asm volatile("s_waitcnt lgkmcnt(0)" ::: "memory");
#pragma unroll
        for (int r = 0; r < 16; ++r) { const float a = c.wsf[crow(r, hi)]; oc[0][r] += o[0][r] * a; oc[1][r] += o[1][r] * a; }
    }
    {
        const int jlo = (qt - 8) > 0 ? (qt - 8) : 0, NT = (variant & 2) ? 0 : (qt - jlo + 1);
#if defined(PROBE_NSA_WIN2)
        o[0] = f32x16{}; o[1] = f32x16{}; m = NEG2; l = 0.f;
        run_pass<2>(c, NT, jlo, PNL(PROJ, P_KW) + (size_t)b * SEQ * PP + g * HD, PNL(PROJ, P_VW) + (size_t)b * SEQ * PP + g * HD, PP, qr, 0u, 0u, o, im, m, l);
#endif
        o[0] = f32x16{}; o[1] = f32x16{}; m = NEG2; l = 0.f;
        run_pass<2>(c, NT, jlo, PNL(PROJ, P_KW) + (size_t)b * SEQ * PP + g * HD, PNL(PROJ, P_VW) + (size_t)b * SEQ * PP + g * HD, PP, qr, 0u, 0u, o, im, m, l);
        const float lt = swap_add(l);
        const float inv = lt > 0.f ? 1.f / lt : 0.f;
        if (hi == 0) c.wsf[r32] = inv * gate2;
        asm volatile("s_waitcnt lgkmcnt(0)" ::: "memory");
#pragma unroll
        for (int r = 0; r < 16; ++r) { const float a = c.wsf[crow(r, hi)]; oc[0][r] += o[0][r] * a; oc[1][r] += o[1][r] * a; }
    }
    {
        __attribute__((address_space(3))) unsigned short* stg = (__attribute__((address_space(3))) unsigned short*)(lds3 + L_X) + wid * 2048;
#pragma unroll
        for (int r = 0; r < 16; ++r) { const int orow = crow(r, hi);
#pragma unroll
            for (int d0 = 0; d0 < 2; ++d0) stg[orow * 64 + d0 * 32 + r32] = (unsigned short)f2bf(oc[d0][r]); }
        asm volatile("s_waitcnt lgkmcnt(0)" ::: "memory");
        bf16* Ow = ONSA + (size_t)(b * SEQ + t0 + 32 * th) * NSA_Q + (g * 4 + hh) * HD;
#pragma unroll
        for (int i = 0; i < 4; ++i) { const int row = i * 8 + (lane >> 3), ch = lane & 7;
            const u32x4 vv = *(const __attribute__((address_space(3))) u32x4*)(stg + row * 64 + ch * 8);
            *(u32x4*)(Ow + (size_t)row * NSA_Q + ch * 8) = vv; }
    }
    asm volatile("s_waitcnt vmcnt(0) lgkmcnt(0)" ::: "memory");
    __syncthreads();
}

__device__ __forceinline__ void nsa_phase(const bf16* PROJ, const bf16* KCBb, const bf16* VCBb, const float* rel, bf16* ONSA, lds_ptr lds3, int vcu, int G, int variant) {
    const unsigned lds0 = (unsigned)(uintptr_t)lds3;
    build_ov(lds3);
    __syncthreads();
    int last_g = -1;
#ifndef NSA_REP
#define NSA_REP 1
#endif
#pragma unroll 1
    for (int rep_ = 0; rep_ < NSA_REP; ++rep_)
#pragma unroll 1
    for (int i = vcu; i < 512; i += G) {
        const int k = i & 255, bg = k >> 5, s = k & 31, qt = (i < 256) ? s : 63 - s;
        if (!(variant & 16)) nsa_unit(variant, (bg & 3) != last_g, bg >> 2, bg & 3, qt, PROJ, KCBb, VCBb, rel, ONSA, lds3, lds0);
        last_g = bg & 3;
    }
}
#undef NSA_WAIT_BAR
#undef NSA_SBAR
}
namespace nsa {
constexpr float STICK_THR = 50.f, LN2F = 0.6931471805599453f;
constexpr int STK_SLOTB = 32768;
static_assert(3 * STK_SLOTB <= L_WSF, "stick ring vs the LDS words it shares with the NSA map");
#define NSA_WAIT_BAR(N) asm volatile("s_waitcnt vmcnt(" #N ") lgkmcnt(0)\n\ts_barrier" ::: "memory")
__device__ __forceinline__ void stick_unit(int tid, int b, int hp, int qb, const bf16* PROJ, bf16* OSB, lds_ptr lds3, unsigned lds0, const bf16x8 (&tri)[2]) {
    const int lane = tid & 63, r32 = lane & 31, hi = lane >> 5;
    const int wid = __builtin_amdgcn_readfirstlane(tid >> 6);
    const int hs = wid >> 2, qw = wid & 3, h = 2 * hp + hs;
    const int q0 = qb * 128, t = q0 + 32 * qw + r32;
    const bf16* Kb = PNL(PROJ, P_KB + (hp >> 1)) + (size_t)b * SEQ * PP + (hp & 1) * 128;
    const bf16* Vb = PNL(PROJ, P_VB + (hp >> 1)) + (size_t)b * SEQ * PP + (hp & 1) * 128;
    __attribute__((address_space(3))) int* DONE = (__attribute__((address_space(3))) int*)(lds3 + L_MISC);
    bf16x8 qr[4];
#pragma unroll
    for (int d0 = 0; d0 < 4; ++d0) qr[d0] = *(const bf16x8*)(PNL(PROJ, P_QB + (h >> 2)) + (size_t)(b * SEQ + t) * PP + (h & 3) * HD + d0 * 16 + hi * 8);
    if (tid < 8) DONE[tid] = 0x7fffffff;
    asm volatile("s_waitcnt vmcnt(0) lgkmcnt(0)" ::: "memory");
    __syncthreads();
    const int jhi = 2 * qb + 1, NT = jhi + 1;
    const int jw = (q0 + 32 * qw + 30) >> 6;
    const int vboff = ((lane >> 4) & 1) * 32 + (lane & 3) * 8 + (4 * hi + ((lane & 15) >> 2)) * 64;
    f32x16 o[2] = {};
    float carry = 0.f; bool mydone = false;
#define STK_ISSUE(i, slot) do { const int id_ = jhi - (i); \
        const bf16* ks_ = Kb + (size_t)(64 * id_ + lane) * PP + 8 * wid; \
        const bf16* vs_ = Vb + (size_t)(64 * id_ + 16 * (wid & 3) + (lane >> 2)) * PP + 32 * (wid >> 2) + 8 * (lane & 3); \
        glds16(ks_, (unsigned)__builtin_amdgcn_readfirstlane(lds0 + L_RING + (slot) * STK_SLOTB + wid * 1024)); \
        glds16(vs_, (unsigned)__builtin_amdgcn_readfirstlane(lds0 + L_RING + (slot) * STK_SLOTB + 8192 + wid * 1024)); \
        glds16(ks_ + 64, (unsigned)__builtin_amdgcn_readfirstlane(lds0 + L_RING + (slot) * STK_SLOTB + 16384 + wid * 1024)); \
        glds16(vs_ + 64, (unsigned)__builtin_amdgcn_readfirstlane(lds0 + L_RING + (slot) * STK_SLOTB + 24576 + wid * 1024)); } while (0)
    STK_ISSUE(0, 0);
    if (NT > 1) STK_ISSUE(1, 1);
    int slot = 0;
    for (int i = 0; i < NT; ++i) {
        if (i + 1 < NT) NSA_WAIT_BAR(4); else NSA_WAIT_BAR(0);
        bool alld = true;
#pragma unroll
        for (int w = 0; w < 8; ++w) alld = alld && (DONE[w] < i);
        if (__builtin_amdgcn_readfirstlane((int)alld)) break;
        if (i + 2 < NT) { const int s2 = (slot == 0) ? 2 : slot - 1; STK_ISSUE(i + 2, s2); }
        const int j = jhi - i;
        if (!mydone && j <= jw) {
            f32x16 p0, p1, x0, x1;
            qkt(p0, p1, (lds_cptr)(lds3 + L_RING + slot * STK_SLOTB + hs * 16384), qr, r32, hi);
            float s0 = 0.f, s1 = 0.f;
#pragma unroll
            for (int r = 0; r < 16; ++r) {
                const int pos0 = 64 * j + crow(r, hi);
                const float z0 = p0[r] * 0.125f, z1 = p1[r] * 0.125f;
                const float L0 = __builtin_amdgcn_logf(1.f + __builtin_amdgcn_exp2f(-fabsf(z0) * LOG2E)) * LN2F;
                const float L1 = __builtin_amdgcn_logf(1.f + __builtin_amdgcn_exp2f(-fabsf(z1) * LOG2E)) * LN2F;
                p0[r] = fminf(z0, 0.f) - L0; p1[r] = fminf(z1, 0.f) - L1;
                x0[r] = (pos0 < t) ? (-fmaxf(z0, 0.f) - L0) : 0.f; x1[r] = (pos0 + 32 < t) ? (-fmaxf(z1, 0.f) - L1) : 0.f;
                s0 += x0[r]; s1 += x1[r];
            }
            const float tot0 = swap_add(s0), tot1 = swap_add(s1);
            u32x4 h0a, h0b, l0a, l0b, h1a, h1b, l1a, l1b;
#define STK_SPLIT(X, HA, HB, LA, LB) do { unsigned hw_[8]; float lo_[16]; \
                _Pragma("unroll") for (int q_ = 0; q_ < 8; ++q_) { hw_[q_] = cvtpk_s(X[2 * q_], X[2 * q_ + 1]); \
                    lo_[2 * q_] = X[2 * q_] - __uint_as_float(hw_[q_] << 16); lo_[2 * q_ + 1] = X[2 * q_ + 1] - __uint_as_float(hw_[q_] & 0xffff0000u); } \
                HA = (u32x4){hw_[0], hw_[1], hw_[2], hw_[3]}; HB = (u32x4){hw_[4], hw_[5], hw_[6], hw_[7]}; \
                LA = (u32x4){cvtpk_s(lo_[0], lo_[1]), cvtpk_s(lo_[2], lo_[3]), cvtpk_s(lo_[4], lo_[5]), cvtpk_s(lo_[6], lo_[7])}; \
                LB = (u32x4){cvtpk_s(lo_[8], lo_[9]), cvtpk_s(lo_[10], lo_[11]), cvtpk_s(lo_[12], lo_[13]), cvtpk_s(lo_[14], lo_[15])}; } while (0)
            STK_SPLIT(x0, h0a, h0b, l0a, l0b);
            STK_SPLIT(x1, h1a, h1b, l1a, l1b);
#undef STK_SPLIT
            f32x16 y0, y1;
#pragma unroll
            for (int r = 0; r < 16; ++r) { y0[r] = carry + tot1; y1[r] = carry; }
            y0 = __builtin_amdgcn_mfma_f32_32x32x16_bf16(tri[0], __builtin_bit_cast(bf16x8, h0a), y0, 0, 0, 0);
            y0 = __builtin_amdgcn_mfma_f32_32x32x16_bf16(tri[1], __builtin_bit_cast(bf16x8, h0b), y0, 0, 0, 0);
            y0 = __builtin_amdgcn_mfma_f32_32x32x16_bf16(tri[0], __builtin_bit_cast(bf16x8, l0a), y0, 0, 0, 0);
            y0 = __builtin_amdgcn_mfma_f32_32x32x16_bf16(tri[1], __builtin_bit_cast(bf16x8, l0b), y0, 0, 0, 0);
            y1 = __builtin_amdgcn_mfma_f32_32x32x16_bf16(tri[0], __builtin_bit_cast(bf16x8, h1a), y1, 0, 0, 0);
            y1 = __builtin_amdgcn_mfma_f32_32x32x16_bf16(tri[1], __builtin_bit_cast(bf16x8, h1b), y1, 0, 0, 0);
            y1 = __builtin_amdgcn_mfma_f32_32x32x16_bf16(tri[0], __builtin_bit_cast(bf16x8, l1a), y1, 0, 0, 0);
            y1 = __builtin_amdgcn_mfma_f32_32x32x16_bf16(tri[1], __builtin_bit_cast(bf16x8, l1b), y1, 0, 0, 0);
#pragma unroll
            for (int r = 0; r < 16; ++r) {
                const int pos0 = 64 * j + crow(r, hi);
                y0[r] = (pos0 < t) ? __builtin_amdgcn_exp2f((p0[r] + y0[r]) * LOG2E) : 0.f;
                y1[r] = (pos0 + 32 < t) ? __builtin_amdgcn_exp2f((p1[r] + y1[r]) * LOG2E) : 0.f;
            }
            carry += tot0 + tot1;
            u32x4 pw0, pw1, pw2, pw3;
            pw0 = (u32x4){cvtpk_s(y0[0], y0[1]), cvtpk_s(y0[2], y0[3]), cvtpk_s(y0[4], y0[5]), cvtpk_s(y0[6], y0[7])};
            pw1 = (u32x4){cvtpk_s(y0[8], y0[9]), cvtpk_s(y0[10], y0[11]), cvtpk_s(y0[12], y0[13]), cvtpk_s(y0[14], y0[15])};
            pw2 = (u32x4){cvtpk_s(y1[0], y1[1]), cvtpk_s(y1[2], y1[3]), cvtpk_s(y1[4], y1[5]), cvtpk_s(y1[6], y1[7])};
            pw3 = (u32x4){cvtpk_s(y1[8], y1[9]), cvtpk_s(y1[10], y1[11]), cvtpk_s(y1[12], y1[13]), cvtpk_s(y1[14], y1[15])};
            __builtin_amdgcn_sched_barrier(0);
            pv(o, (int)(lds0 + L_RING + slot * STK_SLOTB + hs * 16384 + 8192) + vboff, __builtin_bit_cast(bf16x8, pw0), __builtin_bit_cast(bf16x8, pw1), __builtin_bit_cast(bf16x8, pw2), __builtin_bit_cast(bf16x8, pw3));
            mydone = __all(carry < -STICK_THR) != 0;
            if (mydone && lane == 0) DONE[wid] = i;
        }
        slot = (slot == 2) ? 0 : slot + 1;
    }
    asm volatile("s_waitcnt vmcnt(0) lgkmcnt(0)\n\ts_barrier" ::: "memory");
#undef STK_ISSUE
    {
        __attribute__((address_space(3))) unsigned short* stg = (__attribute__((address_space(3))) unsigned short*)(lds3 + L_X) + wid * 2048;
#pragma unroll
        for (int r = 0; r < 16; ++r) { const int orow = crow(r, hi);
#pragma unroll
            for (int d0 = 0; d0 < 2; ++d0) stg[orow * 64 + d0 * 32 + r32] = (unsigned short)f2bf(o[d0][r]); }
        asm volatile("s_waitcnt lgkmcnt(0)" ::: "memory");
        bf16* Ow = OSB + (size_t)(b * SEQ + q0 + 32 * qw) * SB_W + h * HD;
#pragma unroll
        for (int i = 0; i < 4; ++i) { const int row = i * 8 + (lane >> 3), ch = lane & 7;
            const u32x4 vv = *(const __attribute__((address_space(3))) u32x4*)(stg + row * 64 + ch * 8);
            *(u32x4*)(Ow + (size_t)row * SB_W + ch * 8) = vv; }
    }
    asm volatile("s_waitcnt vmcnt(0) lgkmcnt(0)" ::: "memory");
    __syncthreads();
}
__device__ __forceinline__ void stick_phase(const bf16* PROJ, bf16* OSB, lds_ptr lds3, int vcu, int G) {
    const unsigned lds0 = (unsigned)(uintptr_t)lds3;
    int tid = threadIdx.x; asm volatile("" : "+v"(tid));
    const int lane = tid & 63, r32 = lane & 31, hi = lane >> 5;
    bf16x8 tri[2];
#pragma unroll
    for (int s = 0; s < 2; ++s)
#pragma unroll
        for (int j = 0; j < 8; ++j) tri[s][j] = ((16 * s + 8 * (j >> 2) + 4 * hi + (j & 3)) > r32) ? (short)0x3F80 : (short)0;
    for (int i = vcu; i < 512; i += G) {
        const int bp = i >> 5, qb = i & 31;
        stick_unit(tid, bp >> 3, bp & 7, qb, PROJ, OSB, lds3, lds0, tri);
    }
}
#undef NSA_WAIT_BAR
}
namespace peer {
typedef short bf16x8 __attribute__((ext_vector_type(8)));
typedef float f32x16 __attribute__((ext_vector_type(16)));
typedef __bf16 b2_t __attribute__((ext_vector_type(2)));
constexpr int L_EX = 0, L_GT = 16384;
__device__ __forceinline__ int crow(int r, int hi) { return (r & 3) + 8 * (r >> 2) + 4 * hi; }
__device__ __forceinline__ unsigned mono(float f) { const unsigned u = __float_as_uint(f); return (u & 0x80000000u) ? ~u : (u | 0x80000000u); }
__device__ __forceinline__ float unmono(unsigned k) { return __uint_as_float((k & 0x80000000u) ? (k & 0x7fffffffu) : ~k); }
__device__ __forceinline__ float dot2(unsigned a, unsigned b, float c) { return __builtin_amdgcn_fdot2_f32_bf16(__builtin_bit_cast(b2_t, a), __builtin_bit_cast(b2_t, b), c, false); }
#define PEER_CE(key, slot) do { const unsigned hi_ = (key) > (slot) ? (key) : (slot); (key) = (key) > (slot) ? (slot) : (key); (slot) = hi_; } while (0)

__device__ __forceinline__ void route_list(const bf16* QP, const bf16* SKB, int L, int tok0, int r32, int hi, unsigned (&out)[16]) {
    f32x16 acc[4] = {};
    const bf16* qp = QP + (size_t)(tok0 + r32) * 2048 + L * 128 + hi * 8;
    const bf16* kp = SKB + ((size_t)L * 128 + r32) * 128 + hi * 8;
    int hi4 = 4 * hi;
    asm volatile("" : "+v"(qp), "+v"(kp), "+v"(hi4));
#pragma unroll
    for (int ks = 0; ks < 8; ++ks) {
        const bf16x8 bq = *(const bf16x8*)(qp + ks * 16);
#pragma unroll
        for (int kt = 0; kt < 4; ++kt) { const bf16x8 a = *(const bf16x8*)(kp + (size_t)kt * 32 * 128 + ks * 16); acc[kt] = __builtin_amdgcn_mfma_f32_32x32x16_bf16(a, bq, acc[kt], 0, 0, 0); }
    }
    unsigned t[16];
#pragma unroll
    for (int k = 0; k < 16; ++k) t[k] = 0u;
#pragma unroll
    for (int kt = 0; kt < 4; ++kt)
#pragma unroll
        for (int r = 0; r < 16; ++r) {
            unsigned key = ((mono(acc[kt][r]) & ~127u) | (unsigned)(127 - (32 * kt + (r & 3) + 8 * (r >> 2)))) - (unsigned)hi4;
#pragma unroll
            for (int k = 0; k < 16; ++k) PEER_CE(key, t[k]);
            __builtin_amdgcn_sched_barrier(0);
        }
    unsigned u[16];
#pragma unroll
    for (int k = 0; k < 16; ++k) { auto rr = __builtin_amdgcn_permlane32_swap(t[k], t[k], false, false); u[k] = hi ? rr[0] : rr[1]; }
#pragma unroll
    for (int k = 0; k < 16; ++k) out[k] = t[k] > u[15 - k] ? t[k] : u[15 - k];
#pragma unroll
    for (int st = 8; st >= 1; st >>= 1)
#pragma unroll
        for (int k = 0; k < 16; ++k) if ((k & st) == 0) { const unsigned a = out[k], b = out[k | st]; out[k] = a > b ? a : b; out[k | st] = a > b ? b : a; }
}

__device__ __forceinline__ void route_head(const bf16* QP, const bf16* SKB, int h, int tok0, int lane, __attribute__((address_space(3))) unsigned char* lds3) {
    asm volatile("" : "+v"(lane));
    const int r32 = lane & 31, hi = lane >> 5;
    unsigned A[16], B[16];
    route_list(QP, SKB, 2 * h, tok0, r32, hi, A);
    route_list(QP, SKB, 2 * h + 1, tok0, r32, hi, B);
    float va[16], vb[16]; int ia[16], ib[16];
#pragma unroll
    for (int k = 0; k < 16; ++k) { va[k] = unmono((A[k] & ~127u) | 64u); vb[k] = unmono((B[k] & ~127u) | 64u); ia[k] = 127 - (int)(A[k] & 127u); ib[k] = 127 - (int)(B[k] & 127u); }
    unsigned s[16], sp[16];
#pragma unroll
    for (int k = 0; k < 16; ++k) { s[k] = 0u; sp[k] = 0u; }
#pragma unroll
    for (int i = 0; i < 16; ++i)
#pragma unroll
        for (int j = 0; j < 16; ++j) if ((i + 1) * (j + 1) <= 16) {
            unsigned key = mono(va[i] + vb[j]); unsigned pay = (unsigned)(ia[i] * PEER_KEYS + ib[j]);
#pragma unroll
            for (int k = (i + 1) * (j + 1) - 1; k < 16; ++k) { const bool gt = key > s[k]; const unsigned ts = s[k], tp = sp[k]; s[k] = gt ? key : ts; sp[k] = gt ? pay : tp; key = gt ? ts : key; pay = gt ? tp : pay; }
            __builtin_amdgcn_sched_barrier(0);
        }
    const float mx = unmono(s[0]);
    float e[16], sum = 0.f;
#pragma unroll
    for (int k = 0; k < 16; ++k) { e[k] = __expf(unmono(s[k]) - mx); sum += e[k]; }
    const float inv = 1.f / sum;
    if (hi == 0) {
        __attribute__((address_space(3))) int* EX = (__attribute__((address_space(3))) int*)(lds3 + L_EX);
        __attribute__((address_space(3))) float* GT = (__attribute__((address_space(3))) float*)(lds3 + L_GT);
#pragma unroll
        for (int k = 0; k < 16; ++k) { EX[(h * 16 + k) * 32 + r32] = (int)sp[k]; GT[(h * 16 + k) * 32 + r32] = e[k] * inv; }
    }
}

#ifndef FP6_IDX
#define FP6_IDX(i) (((i) & 1) ? 16 + ((i) >> 1) : ((i) >> 1))
#endif
typedef float v16f_t __attribute__((ext_vector_type(16)));
typedef float v32f_t __attribute__((ext_vector_type(32)));
typedef unsigned v6u_t __attribute__((ext_vector_type(6)));
__device__ __forceinline__ void cvt_row_fp6(const float* src, unsigned char* dst, float* inv_scale, int row, int lane) {
    const float* p = src + (size_t)row * 2048 + lane * 16;
    f32x4 v[8]; float am = 0.f;
#pragma unroll
    for (int j = 0; j < 2; ++j)
#pragma unroll
        for (int c = 0; c < 4; ++c) { v[4 * j + c] = *(const f32x4*)(p + j * 1024 + 4 * c);
            am = fmaxf(am, fmaxf(fmaxf(fabsf(v[4 * j + c].x), fabsf(v[4 * j + c].y)), fmaxf(fabsf(v[4 * j + c].z), fabsf(v[4 * j + c].w)))); }
    am = wave_max(am);
    const float sc = am > 0.f ? 7.f / am : 1.f;
    v16f_t a, b;
#pragma unroll
    for (int c = 0; c < 4; ++c) { a[4 * c + 0] = v[c].x * sc; a[4 * c + 1] = v[c].y * sc; a[4 * c + 2] = v[c].z * sc; a[4 * c + 3] = v[c].w * sc;
        b[4 * c + 0] = v[4 + c].x * sc; b[4 * c + 1] = v[4 + c].y * sc; b[4 * c + 2] = v[4 + c].z * sc; b[4 * c + 3] = v[4 + c].w * sc; }
    const v6u_t q = __builtin_amdgcn_cvt_scalef32_2xpk16_fp6_f32(a, b, 1.0f);
    unsigned char* d = dst + (size_t)row * 1536;
    *(v4u*)(d + lane * 16) = (v4u){q[0], q[1], q[2], q[3]};
    *(v2u*)(d + 1024 + lane * 8) = (v2u){q[4], q[5]};
    if (lane == 0) inv_scale[row] = am > 0.f ? am / 7.f : 1.f;
}
__device__ __forceinline__ void ffn_token6(int n, int tl, int lane, const float* H, const float* SS, const float* gffn, const unsigned char* U6, const unsigned char* V6,
                                           const float* IU, const float* IV, const float* gfin, float* out, __attribute__((address_space(3))) unsigned char* lds3) {
    const __attribute__((address_space(3))) int* EX = (const __attribute__((address_space(3))) int*)(lds3 + L_EX);
    const __attribute__((address_space(3))) float* GT = (const __attribute__((address_space(3))) float*)(lds3 + L_GT);
    float xf[32];
    { const float rs_ = rsqrtf(SS[n] * (1.f / D_MODEL) + EPS);
#pragma unroll
      for (int j = 0; j < 2; ++j)
#pragma unroll
        for (int c = 0; c < 4; ++c) { const f32x4 hv_ = *(const f32x4*)(H + (size_t)n * 2048 + j * 1024 + lane * 16 + 4 * c), gv_ = *(const f32x4*)(gffn + j * 1024 + lane * 16 + 4 * c);
            xf[16 * j + 4 * c + 0] = hv_.x * rs_ * gv_.x; xf[16 * j + 4 * c + 1] = hv_.y * rs_ * gv_.y; xf[16 * j + 4 * c + 2] = hv_.z * rs_ * gv_.z; xf[16 * j + 4 * c + 3] = hv_.w * rs_ * gv_.w; } }
    float acc[32];
#pragma unroll
    for (int j = 0; j < 32; ++j) acc[j] = 0.f;
    const bool b5 = (lane & 32) != 0, b4 = (lane & 16) != 0;
#pragma unroll 1
    for (int e0 = 0; e0 < PEER_E; e0 += 4) {
        int ei[4]; float gt[4], iu[4], iv[4]; v4u ua[4], va[4]; v2u ub[4], vb[4];
#pragma unroll
        for (int k = 0; k < 4; ++k) { ei[k] = __builtin_amdgcn_readfirstlane(EX[(e0 + k) * 32 + tl]); gt[k] = GT[(e0 + k) * 32 + tl];
            const unsigned char* ur = U6 + (size_t)ei[k] * 1536; ua[k] = *(const v4u*)(ur + lane * 16); ub[k] = *(const v2u*)(ur + 1024 + lane * 8);
            const unsigned char* vr = V6 + (size_t)ei[k] * 1536; va[k] = *(const v4u*)(vr + lane * 16); vb[k] = *(const v2u*)(vr + 1024 + lane * 8);
            iu[k] = IU[ei[k]]; iv[k] = IV[ei[k]]; }
        float d[4];
#pragma unroll
        for (int k = 0; k < 4; ++k) { const v6u_t q = {ua[k].x, ua[k].y, ua[k].z, ua[k].w, ub[k].x, ub[k].y}; const v32f_t f = __builtin_amdgcn_cvt_scalef32_pk32_f32_fp6(q, 1.0f);
            float dk = 0.f;
#pragma unroll
            for (int i = 0; i < 32; ++i) dk += xf[FP6_IDX(i)] * f[i];
            d[k] = dk; __builtin_amdgcn_sched_barrier(0); }
        float a01 = (b5 ? d[1] : d[0]) + __shfl_xor(b5 ? d[0] : d[1], 32);
        float a23 = (b5 ? d[3] : d[2]) + __shfl_xor(b5 ? d[2] : d[3], 32);
        float t = (b4 ? a23 : a01) + __shfl_xor(b4 ? a01 : a23, 16);
        t += __shfl_xor(t, 8); t += __shfl_xor(t, 4); t += __shfl_xor(t, 2); t += __shfl_xor(t, 1);
        const float ius = b5 ? (b4 ? iu[3] : iu[1]) : (b4 ? iu[2] : iu[0]);
        const float ivs = b5 ? (b4 ? iv[3] : iv[1]) : (b4 ? iv[2] : iv[0]);
        const float gts = b5 ? (b4 ? gt[3] : gt[1]) : (b4 ? gt[2] : gt[0]);
        const float wv = gts * gelu_tanh(t * ius) * ivs;
        float w[4];
        w[0] = __uint_as_float(__builtin_amdgcn_readlane(__float_as_uint(wv), 0));
        w[2] = __uint_as_float(__builtin_amdgcn_readlane(__float_as_uint(wv), 16));
        w[1] = __uint_as_float(__builtin_amdgcn_readlane(__float_as_uint(wv), 32));
        w[3] = __uint_as_float(__builtin_amdgcn_readlane(__float_as_uint(wv), 48));
#pragma unroll
        for (int k = 0; k < 4; ++k) { const v6u_t q = {va[k].x, va[k].y, va[k].z, va[k].w, vb[k].x, vb[k].y}; const v32f_t f = __builtin_amdgcn_cvt_scalef32_pk32_f32_fp6(q, 1.0f);
#pragma unroll
            for (int i = 0; i < 32; ++i) acc[FP6_IDX(i)] += w[k] * f[i]; __builtin_amdgcn_sched_barrier(0); }
    }
    float sq = 0.f;
#pragma unroll
    for (int j = 0; j < 2; ++j)
#pragma unroll
        for (int c = 0; c < 4; ++c) { const f32x4 hv_ = *(const f32x4*)(H + (size_t)n * 2048 + j * 1024 + lane * 16 + 4 * c);
            acc[16 * j + 4 * c + 0] += hv_.x; acc[16 * j + 4 * c + 1] += hv_.y; acc[16 * j + 4 * c + 2] += hv_.z; acc[16 * j + 4 * c + 3] += hv_.w; }
#pragma unroll
    for (int j = 0; j < 32; ++j) sq += acc[j] * acc[j];
    const float r_ = rsqrtf(wave_sum(sq) * (1.f / D_MODEL) + EPS);
#pragma unroll
    for (int j = 0; j < 2; ++j)
#pragma unroll
        for (int c = 0; c < 4; ++c) { const f32x4 gv_ = *(const f32x4*)(gfin + j * 1024 + lane * 16 + 4 * c);
            *(f32x4*)(out + (size_t)n * 2048 + j * 1024 + lane * 16 + 4 * c) = (f32x4){acc[16 * j + 4 * c + 0] * r_ * gv_.x, acc[16 * j + 4 * c + 1] * r_ * gv_.y, acc[16 * j + 4 * c + 2] * r_ * gv_.z, acc[16 * j + 4 * c + 3] * r_ * gv_.w}; }
}

__device__ __forceinline__ void peer_phase(const bf16* QP, const bf16* SKB, const float* H, const float* SS, const float* gffn, const unsigned char* U8, const unsigned char* V8, const float* IU, const float* IV,
                                           const float* gfin, float* out, __attribute__((address_space(3))) unsigned char* lds3, int bid, int G) {
    int tid = threadIdx.x; asm volatile("" : "+v"(tid));
    const int lane = tid & 63, wid = __builtin_amdgcn_readfirstlane(tid >> 6);
    for (int unit = bid; unit < NTOK / 32; unit += G) {
        const int tok0 = unit * 32;
        route_head(QP, SKB, wid, tok0, lane, lds3);
        asm volatile("s_waitcnt lgkmcnt(0)" ::: "memory"); __syncthreads();
        { int ln = lane; asm volatile("" : "+v"(ln));
#pragma unroll 1
          for (int tk = 0; tk < 4; ++tk) ffn_token6(tok0 + wid * 4 + tk, wid * 4 + tk, ln, H, SS, gffn, U8, V8, IU, IV, gfin, out, lds3); }
        __syncthreads();
    }
}
#undef PEER_CE
}
constexpr int RING_BYTES = 131072, LDS_BYTES = 163840, LDSCTL_OFF = LDS_BYTES - 1024, MISC_OFF = LDSCTL_OFF + 320;
constexpr int N_PHASES = 8;
#ifndef MK_N_LAUNCHES
#define MK_N_LAUNCHES 1
#endif

__global__ void __launch_bounds__(NTHR, 2) fwd_megakernel(Args args) {
    extern __shared__ __attribute__((aligned(16))) unsigned char lds[];
    LAS unsigned char* lds3 = (LAS unsigned char*)lds;
    int tid_ = threadIdx.x; asm volatile("" : "+v"(tid_));
    const int tid = tid_, lane = tid & 63, wave = __builtin_amdgcn_readfirstlane(tid >> 6);
    const int G = gridDim.x, bid = blockIdx.x;
    unsigned char* ws = args.ws;
    unsigned* ctl = (unsigned*)(ws + WS_CTL);
    const float* x = args.in[0];
    bf16* WinT = (bf16*)(ws + WS_WIN); bf16* WbnT = (bf16*)(ws + WS_WBN); bf16* WbsT = (bf16*)(ws + WS_WBS); bf16* WoutT = (bf16*)(ws + WS_WOUT); bf16* WpqT = (bf16*)(ws + WS_WPQ);
    bf16* XN = (bf16*)(ws + WS_XN); bf16* MERGED = XN; bf16* PROJ = (bf16*)(ws + WS_PROJ);
    bf16* ONSA = (bf16*)(ws + WS_ONSA); bf16* OSB = (bf16*)(ws + WS_OSB);
    float* H = (float*)(ws + WS_H); bf16* HB = (bf16*)(ws + WS_HB);
    unsigned char* U8 = ws + WS_UB; unsigned char* V8 = ws + WS_VB; float* IU = (float*)(ws + WS_UB + 48 * MiB); float* IV = (float*)(ws + WS_VB + 48 * MiB); bf16* QP = (bf16*)(ws + WS_QP);
    int* EXPERT = (int*)(ws + WS_EXP); float* GATE = (float*)(ws + WS_GATE);
    bf16* KCB = (bf16*)(ws + WS_MISC + MISC_KCB); bf16* VCB = (bf16*)(ws + WS_MISC + MISC_VCB);
    float* SS = (float*)(ctl + CW_SS);
    bf16* W1T = (bf16*)(ws + WS_MISC + MISC_W1T); float* BIAS1 = (float*)(ws + WS_MISC + MISC_B1);
    bf16* SKB = (bf16*)(ws + WS_MISC + MISC_SKB);

    for (int u = tid; u < (LDS_BYTES - LDSCTL_OFF) / 4; u += NTHR) ((LAS unsigned*)(lds3 + LDSCTL_OFF))[u] = 0u;
    __syncthreads();
    const int lo = args.ph_lo, hi = args.ph_hi;
    XcdBarrier bar; bar.bar = ctl + CW_BAR; bar.x = 0; bar.st = nullptr;
    if (hi - lo > 1) bar = xcd_barrier_post(ctl + CW_BAR, (volatile LAS unsigned*)(lds3 + MISC_OFF) + 8);
#define IN(k) (lo <= (k) && (k) < hi)
#ifndef REP_BAR
#define REP_BAR 1
#endif
#define SEAM(k) do { if (IN(k) && IN((k) + 1)) for (int rb_ = 0; rb_ < REP_BAR; ++rb_) xcd_barrier(bar); } while (0)
    const int gw = bid * NWAVES + wave, NGW = G * NWAVES;
    const int vcu = (G % 8 == 0) ? (bid % 8) * (G / 8) + bid / 8 : bid;

#if defined(TS_PHASE)
    unsigned long long ts0_ = 0;
#define TS_BEGIN(k) do { if (TS_PHASE == (k)) ts0_ = __builtin_amdgcn_s_memrealtime(); } while (0)
#define TS_END(k) do { if (TS_PHASE == (k)) { const unsigned dt_ = (unsigned)(__builtin_amdgcn_s_memrealtime() - ts0_); if (tid == 0) atomicMax(ctl + 64, dt_); } } while (0)
#else
#define TS_BEGIN(k) do {} while (0)
#define TS_END(k) do {} while (0)
#endif
#ifndef REP_P0
#define REP_P0 1
#endif
#ifndef REP_P1
#define REP_P1 1
#endif
#ifndef REP_P4
#define REP_P4 1
#endif
#ifndef REP_P6
#define REP_P6 1
#endif
#ifndef REP_P5C
#define REP_P5C 1
#endif
    TS_BEGIN(0);
    if (IN(0)) for (int rep_ = 0; rep_ < REP_P0; ++rep_) {
        LAS float* scr = (LAS float*)(lds3 + wave * 16384);
        constexpr int I_IN = (D_MODEL / 64) * ((IN_COLS + 31) / 32), I_BR = (1024 / 64) * (D_MODEL / 32), I_SQ = (D_MODEL / 64) * (D_MODEL / 32);
        constexpr int I_C1 = (2048 / 64) * (CMP_HID / 32);
        constexpr int NITEMS = I_IN + 2 * I_BR + 2 * I_SQ + 2 * I_C1;
        for (int it = gw; it < NITEMS; it += NGW) {
            int r = it;
            if (r < I_IN) { p0_transpose_item(args.in[2], D_MODEL, IN_COLS, WinT, nullptr, scr, r, lane, C_SHIFT_FROM, C_SHIFT); continue; } r -= I_IN;
            if (r < I_BR) { p0_transpose_item(args.in[10], 1024, D_MODEL, WbnT, nullptr, scr, r, lane); continue; } r -= I_BR;
            if (r < I_BR) { p0_transpose_item(args.in[11], 1024, D_MODEL, WbsT, nullptr, scr, r, lane); continue; } r -= I_BR;
            if (r < I_SQ) { p0_transpose_item(args.in[12], D_MODEL, D_MODEL, WoutT, nullptr, scr, r, lane); continue; } r -= I_SQ;
            if (r < I_SQ) { p0_transpose_item(args.in[14], D_MODEL, D_MODEL, WpqT, args.in[13], scr, r, lane); continue; } r -= I_SQ;
            if (r < I_C1) { p0_transpose_item(args.in[4], 2048, CMP_HID, W1T, nullptr, scr, r, lane); continue; } r -= I_C1;
            p0_transpose_item(args.in[7], 2048, CMP_HID, W1T + (size_t)CMP_HID * 2048, nullptr, scr, r, lane);
        }
        {
            v4u z = {0u, 0u, 0u, 0u}; bf16* p = WinT + (size_t)C_SHIFT_FROM * D_MODEL; const size_t nz = (size_t)C_SHIFT * D_MODEL;
            for (size_t i = ((size_t)bid * NTHR + tid) * 8; i < nz; i += (size_t)G * NTHR * 8) *(v4u*)(p + i) = z;
        }
        if (gw < 2 * CMP_HID) {
            const int kv = gw >> 7, j = gw & 127; const float* pe = args.in[kv ? 6 : 3]; const float* w1 = args.in[kv ? 7 : 4];
            float s = 0.f;
            for (int k2 = lane; k2 < 2048; k2 += 64) s += pe[k2] * w1[(size_t)k2 * CMP_HID + j];
            s = wave_sum(s);
            if (lane == 0) BIAS1[gw] = s;
        }
        cvt_flat(args.in[15], SKB, (size_t)16 * 128 * 128, (size_t)bid * NTHR + tid, (size_t)G * NTHR);
        for (int m = gw; m < NTOK; m += NGW) rms_row_to_bf16(x + (size_t)m * D_MODEL, args.in[1], XN + (size_t)m * D_MODEL, lane);
    }
    TS_END(0);
    SEAM(0);
    TS_BEGIN(1);
    if (IN(1)) for (int rep_ = 0; rep_ < REP_P1; ++rep_) {
        pg8::Gemm g{XN, WinT, NTOK, PLD, D_MODEL}; pg8::StaticOrder S; S.init(NTOK, PLD, G, bid);
        pg8::EpiBf16<0> E{PROJ, PP, nullptr, PP, (size_t)NTOK * PP, 1.f};
        pg8::gemm_phase<pg8::EpiBf16<0>, pg8::StaticOrder, true, true>(lds3, g, S, E);
    }
    TS_END(1);
    SEAM(1);
    TS_BEGIN(2);
    if (IN(2)) cmpr::compress_phase(PROJ, W1T, BIAS1, args.in, KCB, VCB, lds3, bid, G);
    TS_END(2);
    SEAM(2);
    TS_BEGIN(3);
    if (IN(3)) {
        TS_BEGIN(30);
        nsa::nsa_phase(PROJ, KCB, VCB, args.in[9], ONSA, lds3, vcu, G, args.variant);
        TS_END(30);
#if defined(PROBE_P3A)
        nsa::nsa_phase(PROJ, KCB, VCB, args.in[9], ONSA, lds3, vcu, G);
#endif
        TS_BEGIN(31);
        if (!(args.variant & 32)) nsa::stick_phase(PROJ, OSB, lds3, vcu, G);
        TS_END(31);
#if defined(PROBE_P3B)
        nsa::stick_phase(PROJ, OSB, lds3, vcu, G);
#endif
    }
    TS_END(3);
    SEAM(3);
    TS_BEGIN(4);
    if (IN(4)) for (int rep_ = 0; rep_ < REP_P4; ++rep_) {
        static_assert(WS_OSB == WS_ONSA + (size_t)NTOK * NSA_Q * 2 && WS_WBS == WS_WBN + (size_t)D_MODEL * 1024 * 2, "branch operands must be contiguous");
        pg8::Gemm g{ONSA, WbnT, 2 * NTOK, 2 * D_MODEL, 1024}; pg8::BranchOrder S; S.init(NTOK, D_MODEL, G, bid);
        pg8::EpiGate2 E{MERGED, D_MODEL, PNL(PROJ, P_GA), PNL(PROJ, P_GB), PP, (size_t)NTOK * PP - PP, NTOK / 256, D_MODEL / 256};
        pg8::gemm_phase<pg8::EpiGate2, pg8::BranchOrder, true, true>(lds3, g, S, E);
    }
    TS_END(4);
    SEAM(4);
    TS_BEGIN(5);
    if (IN(5)) {
        { pg8::Gemm g{MERGED, WoutT, NTOK, D_MODEL, D_MODEL}; pg8::StaticOrder S; S.init(NTOK, D_MODEL, G, bid);
          pg8::EpiResid E{x, H, HB, SS, D_MODEL};
          pg8::gemm_phase<pg8::EpiResid, pg8::StaticOrder, true, true>(lds3, g, S, E); }
        int t5 = threadIdx.x; asm volatile("" : "+v"(t5));
        const int lane5 = t5 & 63, gw5 = bid * NWAVES + __builtin_amdgcn_readfirstlane(t5 >> 6);
        for (int rep_ = 0; rep_ < REP_P5C; ++rep_) for (int r = gw5; r < 2 * 16384; r += NGW) { if (r < 16384) peer::cvt_row_fp6(args.in[16], U8, IU, r, lane5); else peer::cvt_row_fp6(args.in[17], V8, IV, r - 16384, lane5); }
    }
    TS_END(5);
    SEAM(5);
    TS_BEGIN(6);
    if (IN(6)) for (int rep_ = 0; rep_ < REP_P6; ++rep_) {
        pg8::Gemm g{HB, WpqT, NTOK, D_MODEL, D_MODEL}; pg8::StaticOrder S; S.init(NTOK, D_MODEL, G, bid);
        pg8::EpiRowScale E{QP, D_MODEL, SS, 1.f / D_MODEL, EPS};
        pg8::gemm_phase<pg8::EpiRowScale, pg8::StaticOrder, true, true>(lds3, g, S, E);
    }
    TS_END(6);
    SEAM(6);
    TS_BEGIN(7);
    if (IN(7)) {
        peer::peer_phase(QP, SKB, H, SS, args.in[13], U8, V8, IU, IV, args.in[18], args.out, lds3, bid, G);
    }
    TS_END(7);
#if defined(TS_PHASE)
    xcd_barrier(bar);
    if (bid == 0) { const unsigned dt_ = __hip_atomic_load(ctl + 64, RLX_AGENT); const int K_ = (int)((float)dt_ * 0.01f * 16.777216f * 2.f);
        for (int i = tid; i < K_; i += NTHR) args.out[i] += 1.0f; }
#endif
#undef IN
#undef SEAM
}

extern "C" void kernel_launch(void* const* d_in, const int* in_sizes, int n_in, void* d_out, int out_size, void* d_ws, size_t ws_size, hipStream_t stream) {
    static int grid = 0;
    if (grid == 0) {
        if (n_in != 19 || ws_size < WS_END) { fprintf(stderr, "kernel_launch: unexpected inputs (%d) or workspace (%zu < %zu)\n", n_in, ws_size, (size_t)WS_END); grid = -1; return; }
        int dev = 0, cus = 0, per_cu = 0;
        hipGetDevice(&dev); hipDeviceGetAttribute(&cus, hipDeviceAttributeMultiprocessorCount, dev);
        if (hipFuncSetAttribute((const void*)fwd_megakernel, hipFuncAttributeMaxDynamicSharedMemorySize, LDS_BYTES) != hipSuccess) { fprintf(stderr, "hipFuncSetAttribute failed\n"); grid = -1; return; }
        if (hipOccupancyMaxActiveBlocksPerMultiprocessor(&per_cu, (const void*)fwd_megakernel, NTHR, LDS_BYTES) != hipSuccess || per_cu < 1) { fprintf(stderr, "occupancy query: %d\n", per_cu); per_cu = 1; }
        (void)hipGetLastError();
        grid = cus;
        if (grid > cus * per_cu) grid = cus * per_cu;
    }
    if (grid < 0) return;
    hipMemsetAsync((char*)d_ws + WS_CTL, 0, (size_t)(CW_SS + NTOK) * 4, stream);
    Args a{};
    for (int i = 0; i < 19; ++i) a.in[i] = (const float*)d_in[i];
    a.out = (float*)d_out; a.ws = (unsigned char*)d_ws;
#if defined(PROBE_SPLIT_LO2)
#ifndef PROBE_VARIANT
#define PROBE_VARIANT 0
#endif
    {
        a.ph_lo = 0; a.ph_hi = PROBE_SPLIT_HI1; a.variant = PROBE_VARIANT; hipLaunchKernelGGL(fwd_megakernel, dim3(grid), dim3(NTHR), LDS_BYTES, stream, a);
        hipMemsetAsync((char*)d_ws + WS_CTL + CW_BAR * 4, 0, XCD_BAR_WORDS * 4, stream);
        a.ph_lo = PROBE_SPLIT_LO2; a.ph_hi = N_PHASES; a.variant = 0; hipLaunchKernelGGL(fwd_megakernel, dim3(grid), dim3(NTHR), LDS_BYTES, stream, a);
        return;
    }
#endif
    if (MK_N_LAUNCHES == 1) {
        a.ph_lo = 0; a.ph_hi = N_PHASES;
        void* kargs[] = {&a};
#if defined(USE_COOP_LAUNCH)
        hipError_t e = hipLaunchCooperativeKernel((const void*)fwd_megakernel, dim3(grid), dim3(NTHR), kargs, LDS_BYTES, stream);
        if (e != hipSuccess) fprintf(stderr, "cooperative launch failed: %s (grid %d)\n", hipGetErrorString(e), grid);
#else
        (void)kargs;
        hipLaunchKernelGGL(fwd_megakernel, dim3(grid), dim3(NTHR), LDS_BYTES, stream, a);
#endif
    } else {
        for (int p = 0; p < N_PHASES; ++p) { a.ph_lo = p; a.ph_hi = p + 1; hipLaunchKernelGGL(fwd_megakernel, dim3(grid), dim3(NTHR), LDS_BYTES, stream, a); }
    }
}
```

```cpp
#include <hip/hip_runtime.h>
#include <cstdio>
#include <cstdint>
#include <cmath>
namespace pg8 {
#define PG8_LAS __attribute__((address_space(3)))
typedef unsigned short bf16_t;
typedef short bf16x8 __attribute__((ext_vector_type(8)));
typedef float f32x4 __attribute__((ext_vector_type(4)));
typedef unsigned u32x4 __attribute__((ext_vector_type(4)));
constexpr int BM = 256, BK = 64, HALF = 128, HTB = HALF * BK * 2  , STAGE_BYTES = 8 * HTB, NXCD = 8, WGM = 8;

__host__ __device__ __forceinline__ int lds_byte(int r, int c) { const int st = (r >> 4) * 2 + (c >> 5), rr = r & 15, cc = c & 31, ob = rr * 64 + cc * 2; return st * 1024 + (ob ^ (((ob >> 9) & 1) << 5)); }
__host__ __device__ __forceinline__ void stage_rc(int b, int& R, int& C) { const int st = b / 1024, sb = b % 1024, swz = sb ^ (((sb >> 9) & 1) << 5); R = (st >> 1) * 16 + swz / 64; C = (st & 1) * 32 + (swz % 64) / 2; }
__host__ __device__ __forceinline__ int perm32(int rho) { const int n = rho >> 4, i = rho & 15; return 8 * (i >> 2) + 4 * n + (i & 3); }

struct Unit { int pm, pn; };
struct Gemm { const bf16_t* A; const bf16_t* Bt; int M, N, K; };

struct StaticOrder {
    int nM, nN, nwg, G, c;
    __host__ __device__ void init(int M, int N, int G_, int c_) { nM = M / BM; nN = N / BM; nwg = nM * nN; G = G_; c = c_; }
    __host__ __device__ bool next(int i, Unit& u) const {
        const long L = (long)i * G + c; if (L >= nwg) return false;
        int wgid = (int)L; { const int q = nwg / NXCD, r = nwg % NXCD, xcd = wgid % NXCD, off = wgid / NXCD; wgid = (xcd < r ? xcd * (q + 1) : r * (q + 1) + (xcd - r) * q) + off; }
        const int nig = WGM * nN, gid = wgid / nig, fm = gid * WGM, gsz = (nM - fm) < WGM ? (nM - fm) : WGM;
        u.pm = fm + ((wgid % nig) % gsz); u.pn = (wgid % nig) / gsz; return true;
    }
    __device__ __forceinline__ void a_ready(const Unit&) const {}
    __device__ __forceinline__ void done(const Unit&) const {}
};

__device__ __forceinline__ unsigned cvt_pk_bf16(float lo, float hi) { unsigned r; asm volatile("v_cvt_pk_bf16_f32 %0, %1, %2" : "=v"(r) : "v"(lo), "v"(hi)); return r; }
typedef float f32x2 __attribute__((ext_vector_type(2)));
__device__ __forceinline__ f32x2 gelu_pk(f32x2 v) {
    const f32x2 av = __builtin_elementwise_abs(v), d = av * 0.2316418882f + 1.0f;
    f32x2 t; t.x = __builtin_amdgcn_rcpf(d.x); t.y = __builtin_amdgcn_rcpf(d.y);
    f32x2 q = t * 0.5307027145f + (-0.7265760135f); q = q * t + 0.7107068705f; q = q * t + (-0.142248368f); q = q * t + 0.127414796f; q = q * t;
    const f32x2 s = (v * v) * (-0.72134752044f);
    f32x2 e; e.x = __builtin_amdgcn_exp2f(s.x); e.y = __builtin_amdgcn_exp2f(s.y);
    const f32x2 m = v * (q * e), r = v - m;
    f32x2 o; o.x = v.x < 0.f ? m.x : r.x; o.y = v.y < 0.f ? m.y : r.y; return o;
}

template <int ACT  > struct EpiBf16 {
    static constexpr bool PERM = true, AFTER_DRAIN = false; static_assert(ACT == 0 || ACT == 1, "EpiBf16: ACT is 0 (none) or 1 (gelu_pk)");
    bf16_t* O; int ldc; const float* bias; int split_cols; size_t split_stride; float scale0;
    __device__ __forceinline__ void operator()(const f32x4 (&acc)[2][2][4][2], const Unit& u, int wr, int wc, int fr, int fq) const {
        const int row0 = u.pm * BM + wr * 64 + fr; int colt = u.pn * BM; bf16_t* base = O;
        float sc = 1.f; if (split_cols) { const int t = colt / split_cols; base += (size_t)t * split_stride; colt -= t * split_cols; if (t == 0) sc = scale0; }
        const int col0 = colt + wc * 32 + 8 * fq, bcol0 = u.pn * BM + wc * 32 + 8 * fq;
        f32x4 bv[2][2];
#pragma unroll
        for (int bj = 0; bj < 2; ++bj)
#pragma unroll
            for (int n = 0; n < 2; ++n) bv[bj][n] = bias ? *(const f32x4*)(bias + bcol0 + bj * HALF + 4 * n) : (f32x4){0.f, 0.f, 0.f, 0.f};
#pragma unroll
        for (int ai = 0; ai < 2; ++ai)
#pragma unroll
            for (int m = 0; m < 4; ++m) { bf16_t* rowp = base + (size_t)(row0 + ai * HALF + m * 16) * ldc + col0;
#pragma unroll
                for (int bj = 0; bj < 2; ++bj) { f32x4 v0 = acc[ai][bj][m][0] + bv[bj][0], v1 = acc[ai][bj][m][1] + bv[bj][1];
                    if (ACT == 1) { f32x2 a = gelu_pk((f32x2){v0[0], v0[1]}), b = gelu_pk((f32x2){v0[2], v0[3]}), c = gelu_pk((f32x2){v1[0], v1[1]}), d = gelu_pk((f32x2){v1[2], v1[3]});
                        v0 = (f32x4){a.x, a.y, b.x, b.y}; v1 = (f32x4){c.x, c.y, d.x, d.y}; }
                    v0 = v0 * sc; v1 = v1 * sc; u32x4 w; w.x = cvt_pk_bf16(v0[0], v0[1]); w.y = cvt_pk_bf16(v0[2], v0[3]); w.z = cvt_pk_bf16(v1[0], v1[1]); w.w = cvt_pk_bf16(v1[2], v1[3]);
                    *(u32x4*)(rowp + bj * HALF) = w; } }
    }
};

struct PanelStats {
    unsigned* xbuf;
    unsigned* cnt;
    unsigned* tmo;
    int ntn; float eps;
    unsigned code;
    __device__ __forceinline__ bool run(const f32x4 (&v)[2][2][4][2], const Unit& u, int wr, int wc, int fr, int fq, PG8_LAS unsigned char* lds, int wid, int lane) const {
        typedef float f32x2v __attribute__((ext_vector_type(2)));
        PG8_LAS f32x2v* P = (PG8_LAS f32x2v*)lds;
        PG8_LAS f32x2v* S = (PG8_LAS f32x2v*)(lds + 8192);
        PG8_LAS unsigned* flag = (PG8_LAS unsigned*)(lds + 8192 + 2048);
#pragma unroll
        for (int ai = 0; ai < 2; ++ai)
#pragma unroll
            for (int m = 0; m < 4; ++m) {
                float s = 0.f;
#pragma unroll
                for (int bj = 0; bj < 2; ++bj)
#pragma unroll
                    for (int n = 0; n < 2; ++n) { const f32x4 x = v[ai][bj][m][n]; s += (x[0] + x[1]) + (x[2] + x[3]); }
                s += __shfl_xor(s, 16); s += __shfl_xor(s, 32);
                const float mw = s * (1.0f / 64.0f); float q = 0.f;
#pragma unroll
                for (int bj = 0; bj < 2; ++bj)
#pragma unroll
                    for (int n = 0; n < 2; ++n) { const f32x4 d = v[ai][bj][m][n] - mw; q += (d[0] * d[0] + d[1] * d[1]) + (d[2] * d[2] + d[3] * d[3]); }
                q += __shfl_xor(q, 16); q += __shfl_xor(q, 32);
                if (fq == 0) P[(ai * HALF + wr * 64 + m * 16 + fr) * 4 + wc] = (f32x2v){mw, q};
            }
        asm volatile("s_waitcnt lgkmcnt(0)" ::: "memory"); __builtin_amdgcn_s_barrier(); asm volatile("" ::: "memory");
#if defined(BROKEN_EXCHANGE_NO_WAIT)
#warning BROKEN CONTROL BUILD: the row-statistics exchange does not wait; results are wrong by design
        if (blockIdx.x >= 64) { const long long t0_ = clock64(); while (clock64() - t0_ < 60000) __builtin_amdgcn_s_sleep(8); }
#endif
        const int row = wid * 32 + (lane & 31);
        if (lane < 32) {
            const f32x2v a = P[row * 4 + 0], b = P[row * 4 + 1], c = P[row * 4 + 2], d = P[row * 4 + 3];
            const float mt = (a.x + b.x + c.x + d.x) * 0.25f;
            const float da = a.x - mt, db = b.x - mt, dc = c.x - mt, dd = d.x - mt;
            const float m2 = (a.y + b.y) + (c.y + d.y) + 64.0f * ((da * da + db * db) + (dc * dc + dd * dd));
            unsigned long long* slot = (unsigned long long*)xbuf + ((size_t)(u.pm * BM + row) * 4 + u.pn);
            __hip_atomic_store(slot, ((unsigned long long)__float_as_uint(m2) << 32) | __float_as_uint(mt), __ATOMIC_RELAXED, __HIP_MEMORY_SCOPE_AGENT);
        }
        asm volatile("s_waitcnt vmcnt(0)" ::: "memory");
        if (lane == 0) __hip_atomic_fetch_add(cnt + 64 * u.pm, 1u, __ATOMIC_RELAXED, __HIP_MEMORY_SCOPE_AGENT);
        if (wid == 0) {
            bool dead = false; const unsigned long long t0 = __builtin_amdgcn_s_memrealtime(); const unsigned want = 8u * (unsigned)ntn;
            for (;;) {
#if defined(BROKEN_EXCHANGE_NO_WAIT)
                break;
#endif
                if ((unsigned)__builtin_amdgcn_readfirstlane(__hip_atomic_load(cnt + 64 * u.pm, __ATOMIC_RELAXED, __HIP_MEMORY_SCOPE_AGENT)) >= want) break;
                if (__builtin_amdgcn_s_memrealtime() - t0 > 2000000ull) {
                    if (lane == 0) { unsigned expect = 0u; __hip_atomic_compare_exchange_strong(tmo + 1, &expect, code | (unsigned)(u.pm & 0xff), __ATOMIC_RELAXED, __ATOMIC_RELAXED, __HIP_MEMORY_SCOPE_AGENT);
                                     __hip_atomic_store(tmo, 1u, __ATOMIC_RELAXED, __HIP_MEMORY_SCOPE_AGENT); }
                    dead = true; break; }
                __builtin_amdgcn_s_sleep(2);
            }
            __builtin_amdgcn_fence(__ATOMIC_ACQUIRE, "agent");
            if (lane == 0) flag[0] = dead ? 1u : 0u;
        }
        asm volatile("s_waitcnt vmcnt(0) lgkmcnt(0)" ::: "memory"); __builtin_amdgcn_s_barrier(); asm volatile("" ::: "memory");
        const bool bad = flag[0] != 0u;
        if (lane < 32) {
            const unsigned long long* slot = (const unsigned long long*)xbuf + (size_t)(u.pm * BM + row) * 4; float mt[4], m2[4]; float ms = 0.f;
#pragma unroll
            for (int t = 0; t < 4; ++t) { if (t < ntn) { const unsigned long long w = __hip_atomic_load(slot + t, __ATOMIC_RELAXED, __HIP_MEMORY_SCOPE_AGENT); mt[t] = __uint_as_float((unsigned)w); m2[t] = __uint_as_float((unsigned)(w >> 32)); } else { mt[t] = 0.f; m2[t] = 0.f; } ms += mt[t]; }
            const float mean = ms / (float)ntn; float q = 0.f;
#pragma unroll
            for (int t = 0; t < 4; ++t) if (t < ntn) { const float dm = mt[t] - mean; q += m2[t] + 256.0f * dm * dm; }
            S[row] = (f32x2v){mean, 1.0f / sqrtf(q / (256.0f * (float)ntn) + eps)};
        }
        asm volatile("s_waitcnt lgkmcnt(0)" ::: "memory"); __builtin_amdgcn_s_barrier(); asm volatile("" ::: "memory");
        return bad;
    }
};
struct EpiLnRes {
    static constexpr bool PERM = false, AFTER_DRAIN = true;
    const float* base; float* out; int ldc; const float* bias; PanelStats st; unsigned poison;
    __device__ __forceinline__ void fused(f32x4 (&acc)[2][2][4][2], const Unit& u, int wr, int wc, int fr, int fq, PG8_LAS unsigned char* lds, int wid, int lane) const {
        typedef float f32x2v __attribute__((ext_vector_type(2)));
        const PG8_LAS f32x2v* S = (const PG8_LAS f32x2v*)(lds + 8192);
        const int col0 = u.pn * BM + wc * 32 + 4 * fq;
#pragma unroll
        for (int bj = 0; bj < 2; ++bj)
#pragma unroll
            for (int n = 0; n < 2; ++n) { const f32x4 bv = bias ? *(const f32x4*)(bias + col0 + bj * HALF + n * 16) : (f32x4){0.f, 0.f, 0.f, 0.f};
#pragma unroll
                for (int ai = 0; ai < 2; ++ai)
#pragma unroll
                    for (int m = 0; m < 4; ++m) acc[ai][bj][m][n] += bv; }
        f32x4 pre[4][2][2];
#pragma unroll
        for (int m = 0; m < 4; ++m) { const size_t off = (size_t)(u.pm * BM + wr * 64 + m * 16 + fr) * ldc + col0;
#pragma unroll
            for (int bj = 0; bj < 2; ++bj)
#pragma unroll
                for (int n = 0; n < 2; ++n) pre[m][bj][n] = *(const f32x4*)(base + off + bj * HALF + n * 16); }
        const bool bad = st.run(acc, u, wr, wc, fr, fq, lds, wid, lane) || poison != 0u;
        const float qnan = __builtin_nanf("");
#pragma unroll
        for (int ai = 0; ai < 2; ++ai)
#pragma unroll
            for (int m = 0; m < 4; ++m) { const int r = ai * HALF + wr * 64 + m * 16 + fr; const f32x2v sr = S[r]; const size_t off = (size_t)(u.pm * BM + r) * ldc + col0;
#pragma unroll
                for (int bj = 0; bj < 2; ++bj)
#pragma unroll
                    for (int n = 0; n < 2; ++n) { const f32x4 bs = ai == 0 ? pre[m][bj][n] : *(const f32x4*)(base + off + bj * HALF + n * 16); f32x4 o = bs + (acc[ai][bj][m][n] - sr.x) * sr.y;
                        if (bad) o = (f32x4){qnan, qnan, qnan, qnan}; *(f32x4*)(out + off + bj * HALF + n * 16) = o; }
                if (m & 1) asm volatile("" ::: "memory"); }
    }
};
struct EpiLnResLn {
    static constexpr bool PERM = false, AFTER_DRAIN = true;
    const float* base; float* out; bf16_t* xn; int ldc; const float* bias; PanelStats st1, st2; unsigned poison;
    __device__ __forceinline__ void fused(f32x4 (&acc)[2][2][4][2], const Unit& u, int wr, int wc, int fr, int fq, PG8_LAS unsigned char* lds, int wid, int lane) const {
        typedef float f32x2v __attribute__((ext_vector_type(2))); typedef unsigned u32x2v __attribute__((ext_vector_type(2)));
        const PG8_LAS f32x2v* S = (const PG8_LAS f32x2v*)(lds + 8192);
        const int col0 = u.pn * BM + wc * 32 + 4 * fq;
#pragma unroll
        for (int bj = 0; bj < 2; ++bj)
#pragma unroll
            for (int n = 0; n < 2; ++n) { const f32x4 bv = bias ? *(const f32x4*)(bias + col0 + bj * HALF + n * 16) : (f32x4){0.f, 0.f, 0.f, 0.f};
#pragma unroll
                for (int ai = 0; ai < 2; ++ai)
#pragma unroll
                    for (int m = 0; m < 4; ++m) acc[ai][bj][m][n] += bv; }
        bool bad = st1.run(acc, u, wr, wc, fr, fq, lds, wid, lane) || poison != 0u;
        const float qnan = __builtin_nanf("");
#pragma unroll
        for (int ai = 0; ai < 2; ++ai)
#pragma unroll
            for (int m = 0; m < 4; ++m) { const int r = ai * HALF + wr * 64 + m * 16 + fr; const f32x2v sr = S[r]; const size_t off = (size_t)(u.pm * BM + r) * ldc + col0;
#pragma unroll
                for (int bj = 0; bj < 2; ++bj)
#pragma unroll
                    for (int n = 0; n < 2; ++n) { const f32x4 bs = *(const f32x4*)(base + off + bj * HALF + n * 16); acc[ai][bj][m][n] = bs + (acc[ai][bj][m][n] - sr.x) * sr.y; }
                asm volatile("" : "+v"(acc[ai][0][m][0]), "+v"(acc[ai][0][m][1]), "+v"(acc[ai][1][m][0]), "+v"(acc[ai][1][m][1]));
                if (m & 1) asm volatile("" ::: "memory"); }
        const bool bad1 = bad;
        bad = st2.run(acc, u, wr, wc, fr, fq, lds, wid, lane) || bad;
#pragma unroll
        for (int ai = 0; ai < 2; ++ai)
#pragma unroll
            for (int m = 0; m < 4; ++m) { const int r = ai * HALF + wr * 64 + m * 16 + fr; const f32x2v sr = S[r]; const size_t off = (size_t)(u.pm * BM + r) * ldc + col0;
#pragma unroll
                for (int bj = 0; bj < 2; ++bj)
#pragma unroll
                    for (int n = 0; n < 2; ++n) { const f32x4 x1 = acc[ai][bj][m][n]; *(f32x4*)(out + off + bj * HALF + n * 16) = bad1 ? (f32x4){qnan, qnan, qnan, qnan} : x1;
                        const f32x4 o = (x1 - sr.x) * sr.y; u32x2v w; w.x = cvt_pk_bf16(o[0], o[1]); w.y = cvt_pk_bf16(o[2], o[3]);
                        if (bad) { w.x = 0x7fc07fc0u; w.y = 0x7fc07fc0u; } *(u32x2v*)(xn + off + bj * HALF + n * 16) = w; }
                asm volatile("" ::: "memory"); }
    }
};

template <class Epi, class Sched, bool ALIGN_EPI = false, bool SP2 = false>
__device__ __forceinline__ void gemm_phase(PG8_LAS unsigned char* lds, const Gemm g, const Sched& S, const Epi& E) {
    const int tid = threadIdx.x, wid = __builtin_amdgcn_readfirstlane(tid >> 6), lane = tid & 63, wr = wid >> 2, wc = wid & 3, fr = lane & 15, fq = lane >> 4;
    const int K = g.K, nt = K / BK;
    unsigned voffA[2], voffB[2];
#pragma unroll
    for (int i = 0; i < 2; ++i) { int R, C; stage_rc(tid * 16 + i * 8192, R, C); const int Rb = Epi::PERM ? ((R & ~31) + perm32(R & 31)) : R;
        voffA[i] = (unsigned)(R * K + C) * 2u; voffB[i] = (unsigned)(Rb * K + C) * 2u; }
    const size_t kstep = (size_t)(BK * 2);
    const size_t hstep = (size_t)HALF * K * 2;
    const size_t tstep = 2 * hstep;
    const unsigned ldsw = (unsigned)wid * 1024u;
    const int aoff = lds_byte(wr * 64 + fr, fq * 8), boff = lds_byte(wc * 32 + fr, fq * 8);
#define PG8_SA(b, h) (((b) * 2 + (h)) * HTB)
#define PG8_SB(b, h) ((4 + (b) * 2 + (h)) * HTB)
#define PG8_STAGE(bufoff, gbase, voff) do { _Pragma("unroll") for (int _i = 0; _i < 2; ++_i) \
        __builtin_amdgcn_global_load_lds((const unsigned*)((const char*)(gbase) + (voff)[_i]), (PG8_LAS unsigned*)(lds + (bufoff) + ldsw + _i * 8192), 16, 0, 0); } while (0)
#define PG8_LDA(dst, b, h) do { _Pragma("unroll") for (int m = 0; m < 4; ++m) _Pragma("unroll") for (int k = 0; k < 2; ++k) dst[m][k] = *(const PG8_LAS bf16x8*)(lds + PG8_SA(b, h) + aoff + m * 2048 + k * 1024); } while (0)
#define PG8_LDB(dst, b, h) do { _Pragma("unroll") for (int n = 0; n < 2; ++n) _Pragma("unroll") for (int k = 0; k < 2; ++k) dst[n][k] = *(const PG8_LAS bf16x8*)(lds + PG8_SB(b, h) + boff + n * 2048 + k * 1024); } while (0)
#define PG8_MMA(ai, bj, At, Bt) do { __builtin_amdgcn_s_setprio(1); _Pragma("unroll") for (int m = 0; m < 4; ++m) _Pragma("unroll") for (int n = 0; n < 2; ++n) _Pragma("unroll") for (int k = 0; k < 2; ++k) \
        acc[ai][bj][m][n] = __builtin_amdgcn_mfma_f32_16x16x32_bf16(Bt[n][k], At[m][k], acc[ai][bj][m][n], 0, 0, 0); __builtin_amdgcn_s_setprio(0); } while (0)
#define PG8_WAIT_V(n) asm volatile("s_waitcnt vmcnt(" #n ")" ::: "memory")
#define PG8_WAIT_L(n) asm volatile("s_waitcnt lgkmcnt(" #n ")" ::: "memory")
#define PG8_BAR __builtin_amdgcn_s_barrier()
#define PG8_SCHED __builtin_amdgcn_sched_barrier(0)
    Unit cur, nxt; int ui = 0;
    if (!S.next(0, cur)) return;
    f32x4 acc[2][2][4][2];
#pragma unroll
    for (int a = 0; a < 2; ++a)
#pragma unroll
        for (int b = 0; b < 2; ++b)
#pragma unroll
            for (int m = 0; m < 4; ++m)
#pragma unroll
                for (int n = 0; n < 2; ++n) acc[a][b][m][n] = (f32x4){0.f, 0.f, 0.f, 0.f};
    bf16x8 At[4][2], B0[2][2], B1[2][2];
    const char* cA = (const char*)g.A + (size_t)cur.pm * tstep; const char* cB = (const char*)g.Bt + (size_t)cur.pn * tstep;
    S.a_ready(cur);
    if constexpr (SP2) {
        PG8_STAGE(PG8_SB(0, 0), cB, voffB); PG8_STAGE(PG8_SB(0, 1), cB + hstep, voffB); PG8_STAGE(PG8_SA(0, 0), cA, voffA); PG8_STAGE(PG8_SA(0, 1), cA + hstep, voffA);
        if (wr == 1) PG8_BAR;
        PG8_WAIT_V(2); PG8_BAR;
        PG8_STAGE(PG8_SB(1, 0), cB + kstep, voffB); PG8_STAGE(PG8_SA(1, 0), cA + kstep, voffA); PG8_STAGE(PG8_SB(1, 1), cB + hstep + kstep, voffB);
        PG8_WAIT_V(6); PG8_BAR;
    } else {
        PG8_STAGE(PG8_SB(0, 0), cB, voffB); PG8_STAGE(PG8_SA(0, 0), cA, voffA); PG8_STAGE(PG8_SB(0, 1), cB + hstep, voffB); PG8_STAGE(PG8_SA(0, 1), cA + hstep, voffA);
        if (wr == 1) PG8_BAR;
        PG8_WAIT_V(4); PG8_BAR;
        PG8_STAGE(PG8_SB(1, 0), cB + kstep, voffB); PG8_STAGE(PG8_SA(1, 0), cA + kstep, voffA); PG8_STAGE(PG8_SB(1, 1), cB + hstep + kstep, voffB);
        PG8_WAIT_V(6); PG8_BAR;
    }
    for (;;) {
        const bool has_next = S.next(ui + 1, nxt);
        const char* nA = has_next ? (const char*)g.A + (size_t)nxt.pm * tstep : cA; const char* nB = has_next ? (const char*)g.Bt + (size_t)nxt.pn * tstep : cB;
        for (int t = 0; t < nt; t += 2) {
            const bool last = (t == nt - 2);
            const char* a1 = cA + (size_t)(t + 1) * kstep;
            const char* a2 = last ? nA : cA + (size_t)(t + 2) * kstep; const char* b2 = last ? nB : cB + (size_t)(t + 2) * kstep;
            const char* a3 = a2 + kstep; const char* b3 = b2 + kstep;
            if (last && has_next) S.a_ready(nxt);
            if constexpr (SP2) {
            PG8_LDB(B0, 0, 0); PG8_LDB(B1, 0, 1); PG8_SCHED; PG8_LDA(At, 0, 0); PG8_STAGE(PG8_SA(1, 1), a1 + hstep, voffA);
            PG8_WAIT_V(8); PG8_WAIT_L(0); PG8_BAR; PG8_MMA(0, 0, At, B0); PG8_MMA(0, 1, At, B1); PG8_BAR; PG8_SCHED;
            PG8_LDA(At, 0, 1); PG8_STAGE(PG8_SB(0, 0), b2, voffB); PG8_STAGE(PG8_SB(0, 1), b2 + hstep, voffB); PG8_STAGE(PG8_SA(0, 0), a2, voffA);
            PG8_WAIT_V(8); PG8_WAIT_L(0); PG8_BAR; PG8_MMA(1, 0, At, B0); PG8_MMA(1, 1, At, B1); PG8_BAR; PG8_SCHED;
            PG8_LDB(B0, 1, 0); PG8_LDB(B1, 1, 1); PG8_SCHED; PG8_LDA(At, 1, 0); PG8_STAGE(PG8_SA(0, 1), a2 + hstep, voffA);
            PG8_WAIT_V(8); PG8_WAIT_L(0); PG8_BAR; PG8_MMA(0, 0, At, B0); PG8_MMA(0, 1, At, B1); PG8_BAR; PG8_SCHED;
            PG8_LDA(At, 1, 1); PG8_STAGE(PG8_SB(1, 0), b3, voffB); PG8_STAGE(PG8_SB(1, 1), b3 + hstep, voffB); PG8_STAGE(PG8_SA(1, 0), a3, voffA);
            PG8_WAIT_V(8); PG8_WAIT_L(0); PG8_BAR; PG8_MMA(1, 0, At, B0); PG8_MMA(1, 1, At, B1); PG8_BAR; PG8_SCHED;
            } else {
            PG8_LDB(B0, 0, 0); PG8_SCHED; PG8_LDA(At, 0, 0); PG8_STAGE(PG8_SA(1, 1), a1 + hstep, voffA);
            PG8_WAIT_L(8); PG8_BAR; PG8_WAIT_L(0); PG8_MMA(0, 0, At, B0); PG8_BAR; PG8_SCHED;
            PG8_LDB(B1, 0, 1); PG8_STAGE(PG8_SB(0, 0), b2, voffB);
            PG8_BAR; PG8_WAIT_L(0); PG8_MMA(0, 1, At, B1); PG8_BAR;
            PG8_LDA(At, 0, 1); PG8_STAGE(PG8_SA(0, 0), a2, voffA);
            PG8_BAR; PG8_WAIT_L(0); PG8_MMA(1, 0, At, B0); PG8_BAR; PG8_SCHED;
            PG8_STAGE(PG8_SB(0, 1), b2 + hstep, voffB);
            PG8_WAIT_V(6); PG8_BAR; PG8_MMA(1, 1, At, B1); PG8_BAR;
            PG8_LDB(B0, 1, 0); PG8_SCHED; PG8_LDA(At, 1, 0); PG8_STAGE(PG8_SA(0, 1), a2 + hstep, voffA);
            PG8_WAIT_L(8); PG8_BAR; PG8_WAIT_L(0); PG8_MMA(0, 0, At, B0); PG8_BAR; PG8_SCHED;
            PG8_LDB(B1, 1, 1); PG8_STAGE(PG8_SB(1, 0), b3, voffB);
            PG8_BAR; PG8_WAIT_L(0); PG8_MMA(0, 1, At, B1); PG8_BAR;
            PG8_LDA(At, 1, 1); PG8_STAGE(PG8_SA(1, 0), a3, voffA);
            PG8_BAR; PG8_WAIT_L(0); PG8_MMA(1, 0, At, B0); PG8_BAR; PG8_SCHED;
            PG8_STAGE(PG8_SB(1, 1), b3 + hstep, voffB);
            PG8_WAIT_V(6); PG8_BAR; PG8_MMA(1, 1, At, B1); PG8_BAR;
            }
        }
        if constexpr (ALIGN_EPI) { if (wr == 0) PG8_BAR; }
        if constexpr (!Epi::AFTER_DRAIN) { E(acc, cur, wr, wc, fr, fq); S.done(cur); }
        if (!has_next) break;
#pragma unroll
        for (int a = 0; a < 2; ++a)
#pragma unroll
            for (int b = 0; b < 2; ++b)
#pragma unroll
                for (int m = 0; m < 4; ++m)
#pragma unroll
                    for (int n = 0; n < 2; ++n) acc[a][b][m][n] = (f32x4){0.f, 0.f, 0.f, 0.f};
        cur = nxt; cA = nA; cB = nB; ++ui;
        if constexpr (ALIGN_EPI) { if (wr == 1) PG8_BAR; }
    }
    PG8_WAIT_V(0);
    if constexpr (!ALIGN_EPI) { if (wr == 0) PG8_BAR; }
    PG8_BAR;
    if constexpr (Epi::AFTER_DRAIN) { E.fused(acc, cur, wr, wc, fr, fq, lds, wid, lane); S.done(cur); }
#undef PG8_SA
#undef PG8_SB
#undef PG8_STAGE
#undef PG8_LDA
#undef PG8_LDB
#undef PG8_MMA
#undef PG8_WAIT_V
#undef PG8_WAIT_L
#undef PG8_BAR
#undef PG8_SCHED
}
}
namespace pg8 {
__device__ __forceinline__ float bf2f(unsigned short b) { return __uint_as_float(((unsigned)b) << 16); }
__device__ __forceinline__ float bflo(unsigned w) { return __uint_as_float(w << 16); }
__device__ __forceinline__ float bfhi(unsigned w) { return __uint_as_float(w & 0xffff0000u); }
__device__ __forceinline__ float sigm(float x) { return 1.f / (1.f + __expf(-x)); }
template <int MODE> struct EpiGate {
    static constexpr bool PERM = true, AFTER_DRAIN = false;
    bf16_t* O; int ldc; const bf16_t* G; int ldg; size_t gtile;
    __device__ __forceinline__ void operator()(const f32x4 (&acc)[2][2][4][2], const Unit& u, int wr, int wc, int fr, int fq) const {
        const int row0 = u.pm * BM + wr * 64 + fr, col0 = u.pn * BM + wc * 32 + 8 * fq;
#pragma unroll
        for (int ai = 0; ai < 2; ++ai)
#pragma unroll
            for (int m = 0; m < 4; ++m) { const size_t row = (size_t)(row0 + ai * HALF + m * 16);
#pragma unroll
                for (int bj = 0; bj < 2; ++bj) {
                    const u32x4 gw = *(const u32x4*)(G + (size_t)u.pn * gtile + row * ldg + col0 + bj * HALF);
                    f32x4 v0 = acc[ai][bj][m][0], v1 = acc[ai][bj][m][1];
                    v0[0] *= sigm(bflo(gw.x)); v0[1] *= sigm(bfhi(gw.x)); v0[2] *= sigm(bflo(gw.y)); v0[3] *= sigm(bfhi(gw.y));
                    v1[0] *= sigm(bflo(gw.z)); v1[1] *= sigm(bfhi(gw.z)); v1[2] *= sigm(bflo(gw.w)); v1[3] *= sigm(bfhi(gw.w));
                    bf16_t* op = O + row * ldc + col0 + bj * HALF;
                    if (MODE == 1) { const u32x4 ow = *(const u32x4*)op;
                        v0[0] += bflo(ow.x); v0[1] += bfhi(ow.x); v0[2] += bflo(ow.y); v0[3] += bfhi(ow.y);
                        v1[0] += bflo(ow.z); v1[1] += bfhi(ow.z); v1[2] += bflo(ow.w); v1[3] += bfhi(ow.w); }
                    u32x4 w; w.x = cvt_pk_bf16(v0[0], v0[1]); w.y = cvt_pk_bf16(v0[2], v0[3]); w.z = cvt_pk_bf16(v1[0], v1[1]); w.w = cvt_pk_bf16(v1[2], v1[3]);
                    *(u32x4*)op = w; } }
    }
};
struct BranchOrder {
    StaticOrder base; int dm, dn;
    __host__ __device__ void init(int M, int N, int G_, int c_) { base.init(M, N, G_, c_); dm = M / BM; dn = N / BM; }
    __host__ __device__ bool next(int i, Unit& u) const { if (!base.next(i >> 1, u)) return false; if (i & 1) { u.pm += dm; u.pn += dn; } return true; }
    __device__ __forceinline__ void a_ready(const Unit&) const {}
    __device__ __forceinline__ void done(const Unit&) const {}
};
struct EpiGate2 {
    static constexpr bool PERM = true, AFTER_DRAIN = false;
    bf16_t* O; int ldc; const bf16_t* G0; const bf16_t* G1; int ldg; size_t gtile; int dm, dn;
    __device__ __forceinline__ void operator()(const f32x4 (&acc)[2][2][4][2], const Unit& u, int wr, int wc, int fr, int fq) const {
        const bool second = u.pm >= dm;
        Unit v = u; if (second) { v.pm -= dm; v.pn -= dn; }
        if (second) { EpiGate<1> e{O, ldc, G1, ldg, gtile}; e(acc, v, wr, wc, fr, fq); } else { EpiGate<0> e{O, ldc, G0, ldg, gtile}; e(acc, v, wr, wc, fr, fq); }
    }
};
struct EpiResid {
    static constexpr bool PERM = true, AFTER_DRAIN = false;
    const float* R; float* Hf; bf16_t* Hb; float* ss; int ldc;
    __device__ __forceinline__ void operator()(const f32x4 (&acc)[2][2][4][2], const Unit& u, int wr, int wc, int fr, int fq) const {
        const int row0 = u.pm * BM + wr * 64 + fr, col0 = u.pn * BM + wc * 32 + 8 * fq;
#pragma unroll
        for (int ai = 0; ai < 2; ++ai)
#pragma unroll
            for (int m = 0; m < 4; ++m) { const size_t row = (size_t)(row0 + ai * HALF + m * 16); float sq = 0.f;
#pragma unroll
                for (int bj = 0; bj < 2; ++bj) {
                    const size_t off = row * ldc + col0 + bj * HALF;
                    const f32x4 r0 = *(const f32x4*)(R + off), r1 = *(const f32x4*)(R + off + 4);
                    const f32x4 v0 = acc[ai][bj][m][0] + r0, v1 = acc[ai][bj][m][1] + r1;
                    *(f32x4*)(Hf + off) = v0; *(f32x4*)(Hf + off + 4) = v1;
                    u32x4 w; w.x = cvt_pk_bf16(v0[0], v0[1]); w.y = cvt_pk_bf16(v0[2], v0[3]); w.z = cvt_pk_bf16(v1[0], v1[1]); w.w = cvt_pk_bf16(v1[2], v1[3]);
                    *(u32x4*)(Hb + off) = w;
                    sq += (v0[0] * v0[0] + v0[1] * v0[1]) + (v0[2] * v0[2] + v0[3] * v0[3]) + (v1[0] * v1[0] + v1[1] * v1[1]) + (v1[2] * v1[2] + v1[3] * v1[3]); }
                sq += __shfl_xor(sq, 16); sq += __shfl_xor(sq, 32);
                if (fq == 0) atomicAdd(ss + row, sq); }
    }
};
struct EpiRowScale {
    static constexpr bool PERM = true, AFTER_DRAIN = false;
    bf16_t* O; int ldc; const float* ss; float inv_n, eps;
    __device__ __forceinline__ void operator()(const f32x4 (&acc)[2][2][4][2], const Unit& u, int wr, int wc, int fr, int fq) const {
        const int row0 = u.pm * BM + wr * 64 + fr, col0 = u.pn * BM + wc * 32 + 8 * fq;
#pragma unroll
        for (int ai = 0; ai < 2; ++ai)
#pragma unroll
            for (int m = 0; m < 4; ++m) { const size_t row = (size_t)(row0 + ai * HALF + m * 16);
                const float sc = rsqrtf(__hip_atomic_load(ss + row, __ATOMIC_RELAXED, __HIP_MEMORY_SCOPE_AGENT) * inv_n + eps);
#pragma unroll
                for (int bj = 0; bj < 2; ++bj) { const f32x4 v0 = acc[ai][bj][m][0] * sc, v1 = acc[ai][bj][m][1] * sc;
                    u32x4 w; w.x = cvt_pk_bf16(v0[0], v0[1]); w.y = cvt_pk_bf16(v0[2], v0[3]); w.z = cvt_pk_bf16(v1[0], v1[1]); w.w = cvt_pk_bf16(v1[2], v1[3]);
                    *(u32x4*)(O + row * ldc + col0 + bj * HALF) = w; } }
    }
};
}
constexpr int D_MODEL = 2048, BATCH = 2, SEQ = 4096, NTOK = BATCH * SEQ;
constexpr int HD = 64, NCMP = 255, CMP_STRIDE = 16, CMP_LEN = 32, CMP_HID = 128;
constexpr int SEL_LEN = 64, SEL_TOPK = 16, WINDOW = 512;
constexpr int PEER_KEYS = 128, PEER_E = 128;
constexpr int NSA_Q = 1024, SB_W = 1024;
constexpr int IN_COLS = 9776, PLD = 9984;
constexpr int C_SHIFT_FROM = 2608, C_SHIFT = 208, PP = 256;
constexpr int P_QN = 0, P_KC = 4, P_VC = 5, P_KS = 6, P_VS = 7, P_KW = 8, P_VW = 9, P_GBR = 10, P_QB = 11, P_KB = 15, P_VB = 19, P_GA = 23, P_GB = 31;
#define PNL(P, p) ((P) + (size_t)(p) * NTOK * PP)
constexpr float EPS = 1e-6f, NEGF = -1e30f;
constexpr int NWAVES = 8, NTHR = 512;

constexpr size_t MiB = 1u << 20;
constexpr size_t WS_CTL = 0, CTL_ZERO_BYTES = 1 * MiB;
constexpr size_t WS_WIN = 2 * MiB;
constexpr size_t WS_WBN = 42 * MiB, WS_WBS = 46 * MiB;
constexpr size_t WS_WOUT = 50 * MiB, WS_WPQ = 58 * MiB;
constexpr size_t WS_MISC = 66 * MiB;
constexpr size_t WS_XN = 70 * MiB;
constexpr size_t WS_PROJ = 102 * MiB;
constexpr size_t WS_ONSA = 258 * MiB, WS_OSB = 274 * MiB;
constexpr size_t WS_H = 290 * MiB;
constexpr size_t WS_HB = 354 * MiB;
constexpr size_t WS_END = 386 * MiB;
constexpr size_t WS_UB = 102 * MiB, WS_VB = 166 * MiB, WS_QP = 230 * MiB, WS_EXP = 262 * MiB, WS_GATE = 266 * MiB;
constexpr size_t MISC_KCB = 0, MISC_VCB = 1 * MiB, MISC_SKB = 2 * MiB, MISC_W1T = 2 * MiB + 512 * 1024, MISC_B1 = 3 * MiB + 512 * 1024;
constexpr int CW_BAR = 4096;
constexpr int CW_SS = 32768;

#define GAS __attribute__((address_space(1)))
#define LAS __attribute__((address_space(3)))
typedef unsigned short bf16;
typedef unsigned v4u __attribute__((ext_vector_type(4)));
typedef unsigned v2u __attribute__((ext_vector_type(2)));
typedef float f32x4 __attribute__((ext_vector_type(4)));
#define RLX_AGENT __ATOMIC_RELAXED, __HIP_MEMORY_SCOPE_AGENT
__device__ __forceinline__ unsigned f2bf(float f) { unsigned u = __builtin_bit_cast(unsigned, f); return (u + 0x7fffu + ((u >> 16) & 1u)) >> 16; }
__device__ __forceinline__ unsigned pk2(float lo, float hi) { return f2bf(lo) | (f2bf(hi) << 16); }
__device__ __forceinline__ float bf2f(bf16 b) { return __uint_as_float(((unsigned)b) << 16); }
__device__ __forceinline__ float bflo(unsigned w) { return __uint_as_float(w << 16); }
__device__ __forceinline__ float bfhi(unsigned w) { return __uint_as_float(w & 0xffff0000u); }

#define XB_TMO      128
#define XB_XCNT(j)  (256  + 64 * (j))
#define XB_XSUB(j)  (1280 + 64 * (j))
#define XB_XGEN(j)  (2304 + 64 * (j))
#define XB_TOP      3328
#define XB_TOPGEN   3392
#define XCD_BAR_WORDS 3456
#define XB_SPIN_CAP (1u << 24)
__device__ __forceinline__ unsigned xb_ld(unsigned* p)              { return __hip_atomic_load(p, __ATOMIC_RELAXED, __HIP_MEMORY_SCOPE_AGENT); }
__device__ __forceinline__ unsigned xb_add(unsigned* p, unsigned v) { return __hip_atomic_fetch_add(p, v, __ATOMIC_RELAXED, __HIP_MEMORY_SCOPE_AGENT); }
__device__ __forceinline__ unsigned xb_xcc_id() { return (unsigned)__builtin_amdgcn_s_getreg((3 << 11) | 20) & 0xFu; }
#define XB_SPIN(cond, bar) do { unsigned _sp = 0; while (cond) { __builtin_amdgcn_s_sleep(1); \
    if ((++_sp & 255u) == 0u) { if (xb_ld(&(bar)[XB_TMO])) break; if (_sp > XB_SPIN_CAP) { atomicAdd(&(bar)[XB_TMO], 1u); break; } } } } while (0)
struct XcdBarrier { unsigned* bar; unsigned x; volatile LAS unsigned* st; };
__device__ __forceinline__ XcdBarrier xcd_barrier_post(unsigned* bar, volatile LAS unsigned* st) {
    XcdBarrier b; b.bar = bar; b.x = xb_xcc_id(); b.st = st;
    if (threadIdx.x == 0) (void)xb_add(&bar[XB_XCNT(b.x)], 1u);
    return b;
}
__device__ __forceinline__ void xcd_barrier_complete(unsigned* bar, unsigned x, unsigned& nloc, unsigned& nx) {
    const unsigned G = gridDim.x * gridDim.y * gridDim.z;
    unsigned sum, cnt, mine, sp = 0u;
    for (;;) {
        sum = 0u; cnt = 0u; mine = 0u;
#pragma unroll
        for (unsigned j = 0; j < 16; ++j) { const unsigned c = xb_ld(&bar[XB_XCNT(j)]); sum += c; cnt += (c > 0u) ? 1u : 0u; mine = (j == x) ? c : mine; }
        if (sum == G) break;
        __builtin_amdgcn_s_sleep(1);
        if ((++sp & 255u) == 0u) { if (xb_ld(&bar[XB_TMO])) break; if (sp > XB_SPIN_CAP) { atomicAdd(&bar[XB_TMO], 1u); break; } }
    }
    nloc = mine > 0u ? mine : 1u; nx = cnt > 0u ? cnt : 1u;
}
__device__ __forceinline__ void xcd_barrier(const XcdBarrier& b) {
    asm volatile("s_waitcnt vmcnt(0)" ::: "memory");
    __syncthreads();
    if (threadIdx.x == 0) {
        unsigned* bar = b.bar;
        const unsigned bx = xb_xcc_id();
        __builtin_amdgcn_s_waitcnt(0);
        unsigned nloc = b.st[0], nx = b.st[1];
        if (nloc == 0u) { xcd_barrier_complete(bar, bx, nloc, nx); b.st[0] = nloc; b.st[1] = nx; }
        const unsigned old = xb_add(&bar[XB_XSUB(bx)], 1u);
        const unsigned gen = old / nloc;
        if (old + 1u == (gen + 1u) * nloc) {
            __builtin_amdgcn_fence(__ATOMIC_RELEASE, "agent");
            asm volatile("s_waitcnt vmcnt(0)" ::: "memory");
            const unsigned og = xb_add(&bar[XB_TOP], 1u);
            const unsigned tg = og / nx;
            if (og + 1u == (tg + 1u) * nx) xb_add(&bar[XB_TOPGEN], 1u);
            else XB_SPIN(xb_ld(&bar[XB_TOPGEN]) == tg, bar);
            __builtin_amdgcn_fence(__ATOMIC_ACQUIRE, "agent");
            xb_add(&bar[XB_XGEN(bx)], 1u);
            asm volatile("s_waitcnt vmcnt(0)" ::: "memory");
        } else {
            XB_SPIN(xb_ld(&bar[XB_XGEN(bx)]) == gen, bar);
            __builtin_amdgcn_fence(__ATOMIC_ACQUIRE, "agent");
            asm volatile("s_waitcnt vmcnt(0)" ::: "memory");
        }
    }
    __syncthreads();
}

__device__ __forceinline__ int rel_bucket(int d) {
    if (d < 16) return d < 0 ? 0 : d;
    int b = 16;
    b += (d >= 21); b += (d >= 27); b += (d >= 35); b += (d >= 46); b += (d >= 59); b += (d >= 77); b += (d >= 99); b += (d >= 128);
    b += (d >= 166); b += (d >= 216); b += (d >= 280); b += (d >= 363); b += (d >= 470); b += (d >= 609); b += (d >= 790);
    return b;
}
__device__ __forceinline__ float gelu_tanh(float x) { const float k = 0.7978845608028654f; return 0.5f * x * (1.f + tanhf(k * (x + 0.044715f * x * x * x))); }
__device__ __forceinline__ float sigmoidf_(float x) { return 1.f / (1.f + expf(-x)); }
__device__ __forceinline__ float wave_sum(float v) {
#pragma unroll
    for (int o = 32; o >= 1; o >>= 1) v += __shfl_xor(v, o);
    return v;
}
__device__ __forceinline__ float wave_max(float v) {
#pragma unroll
    for (int o = 32; o >= 1; o >>= 1) v = fmaxf(v, __shfl_xor(v, o));
    return v;
}
__device__ __forceinline__ float half_sum(float v, float* red) {
    v = wave_sum(v);
    __syncthreads();
    if ((threadIdx.x & 63) == 0) red[(threadIdx.x >> 6) & 3] = v;
    __syncthreads();
    return red[0] + red[1] + red[2] + red[3];
}
__device__ __forceinline__ float half_max(float v, float* red) {
    v = wave_max(v);
    __syncthreads();
    if ((threadIdx.x & 63) == 0) red[(threadIdx.x >> 6) & 3] = v;
    __syncthreads();
    return fmaxf(fmaxf(red[0], red[1]), fmaxf(red[2], red[3]));
}

struct Args {
    const float* in[19]; float* out; unsigned char* ws; int ph_lo, ph_hi; int variant, pad;
};

__device__ __forceinline__ void p0_transpose_item(const float* W, int K, int N, bf16* WT, const float* gk, LAS float* scr, int item, int lane, int shift_from = 0x7fffffff, int shift = 0) {
    const int nblk = (N + 31) / 32, kb = item / nblk, nb = item % nblk, k0 = 64 * kb, n0 = 32 * nb;
    const int c4 = (lane & 7) * 4, r8 = lane >> 3;
    const bool cok = (n0 + c4) < N;
    f32x4 v[8];
#pragma unroll
    for (int i = 0; i < 8; ++i) { const int kk = 8 * i + r8; v[i] = cok ? *(const f32x4*)(W + (size_t)(k0 + kk) * N + n0 + c4) : (f32x4){0.f, 0.f, 0.f, 0.f}; }
#pragma unroll
    for (int i = 0; i < 8; ++i) { const int kk = 8 * i + r8; const float g = gk ? gk[k0 + kk] : 1.f;
        scr[kk * 33 + c4 + 0] = v[i].x * g; scr[kk * 33 + c4 + 1] = v[i].y * g; scr[kk * 33 + c4 + 2] = v[i].z * g; scr[kk * 33 + c4 + 3] = v[i].w * g; }
    asm volatile("s_waitcnt lgkmcnt(0)" ::: "memory");
    const int c = lane & 7;
#pragma unroll
    for (int j = 0; j < 4; ++j) { const int n = (lane >> 3) + 8 * j; const LAS float* s = scr + (8 * c) * 33 + n;
        v4u o; o.x = pk2(s[0 * 33], s[1 * 33]); o.y = pk2(s[2 * 33], s[3 * 33]); o.z = pk2(s[4 * 33], s[5 * 33]); o.w = pk2(s[6 * 33], s[7 * 33]);
        const int nd = n0 + n + ((n0 + n >= shift_from) ? shift : 0);
        if (n0 + n < N) *(v4u*)(WT + (size_t)nd * K + k0 + 8 * c) = o; }
    asm volatile("s_waitcnt lgkmcnt(0)" ::: "memory");
}
__device__ __forceinline__ void rms_row_to_bf16(const float* xrow, const float* g, bf16* orow, int lane) {
    const f32x4* xr = (const f32x4*)xrow + lane; const f32x4* gr = (const f32x4*)g + lane;
    f32x4 v[8]; float s = 0.f;
#pragma unroll
    for (int j = 0; j < 8; ++j) { v[j] = xr[64 * j]; s += (v[j].x * v[j].x + v[j].y * v[j].y) + (v[j].z * v[j].z + v[j].w * v[j].w); }
    const float r = rsqrtf(wave_sum(s) * (1.f / D_MODEL) + EPS);
    v2u* o8 = (v2u*)orow + lane;
#pragma unroll
    for (int j = 0; j < 8; ++j) { const f32x4 gv = gr[64 * j]; v2u w; w.x = pk2(v[j].x * r * gv.x, v[j].y * r * gv.y); w.y = pk2(v[j].z * r * gv.z, v[j].w * r * gv.w); o8[64 * j] = w; }
}
__device__ __forceinline__ void cvt_flat(const float* src, bf16* dst, size_t n, size_t gthread, size_t nthreads) {
    for (size_t i = gthread * 8; i < n; i += nthreads * 8) {
        const f32x4 a = *(const f32x4*)(src + i), b = *(const f32x4*)(src + i + 4);
        v4u o; o.x = pk2(a.x, a.y); o.y = pk2(a.z, a.w); o.z = pk2(b.x, b.y); o.w = pk2(b.z, b.w);
        *(v4u*)(dst + i) = o;
    }
}
namespace cmpr {
typedef short bf16x8 __attribute__((ext_vector_type(8)));
typedef float f32x4v __attribute__((ext_vector_type(4)));
__device__ __forceinline__ void compress_phase(const bf16* PROJ, const bf16* W1T, const float* BIAS1, const float* const* in, bf16* KCB, bf16* VCB,
                                               __attribute__((address_space(3))) unsigned char* lds3, int bid, int G) {
    int tid = threadIdx.x; asm volatile("" : "+v"(tid));
    const int lane = tid & 63, wid = __builtin_amdgcn_readfirstlane(tid >> 6), r16 = lane & 15, kq = lane >> 4;
    __attribute__((address_space(3))) float* PART = (__attribute__((address_space(3))) float*)lds3;
    __attribute__((address_space(3))) float* HID = (__attribute__((address_space(3))) float*)(lds3 + 65536);
    __attribute__((address_space(3))) float* W2S = (__attribute__((address_space(3))) float*)(lds3 + 73728);
    for (int unit = bid; unit < 256; unit += G) {
        const int c = unit & 15, g = (unit >> 4) & 3, b = (unit >> 6) & 1, kv = unit >> 7, n0 = 16 * c;
        int nn = n0 + r16; if (nn > NCMP - 1) nn = NCMP - 1;
        const bf16* ap = PNL(PROJ, kv ? P_VC : P_KC) + (size_t)(b * SEQ + 16 * nn + 4 * wid) * PP + g * HD + 8 * kq;
        const bf16* bp = W1T + (size_t)kv * CMP_HID * 2048 + (size_t)r16 * 2048 + 256 * wid + 8 * kq;
        { const float* w2g = in[kv ? 8 : 5];
#pragma unroll
          for (int i = 0; i < 4; ++i) *(__attribute__((address_space(3))) f32x4v*)(W2S + (tid + NTHR * i) * 4) = *(const f32x4v*)(w2g + (tid + NTHR * i) * 4); }
        f32x4v acc[8] = {};
        bf16x8 af[8];
#pragma unroll
        for (int ks = 0; ks < 8; ++ks) af[ks] = *(const bf16x8*)(ap + (size_t)(ks >> 1) * PP + (ks & 1) * 32);
        bf16x8 wa[8], wb[8];
#define CMP_LOADW(W, KS) do { _Pragma("unroll") for (int nt = 0; nt < 8; ++nt) W[nt] = *(const bf16x8*)(bp + (size_t)nt * 16 * 2048 + (KS) * 32); } while (0)
#define CMP_MMA(W, KS) do { _Pragma("unroll") for (int nt = 0; nt < 8; ++nt) acc[nt] = __builtin_amdgcn_mfma_f32_16x16x32_bf16(af[KS], W[nt], acc[nt], 0, 0, 0); } while (0)
        CMP_LOADW(wa, 0);
#pragma unroll
        for (int ks = 0; ks < 8; ks += 2) {
            CMP_LOADW(wb, ks + 1); __builtin_amdgcn_sched_barrier(0);
            CMP_MMA(wa, ks); __builtin_amdgcn_sched_barrier(0);
            if (ks + 2 < 8) CMP_LOADW(wa, ks + 2);
            __builtin_amdgcn_sched_barrier(0);
            CMP_MMA(wb, ks + 1); __builtin_amdgcn_sched_barrier(0);
        }
#undef CMP_LOADW
#undef CMP_MMA
#pragma unroll
        for (int nt = 0; nt < 8; ++nt)
#pragma unroll
            for (int r = 0; r < 4; ++r) PART[wid * 2048 + (kq * 4 + r) * 128 + nt * 16 + r16] = acc[nt][r];
        asm volatile("s_waitcnt lgkmcnt(0)" ::: "memory"); __syncthreads();
#pragma unroll
        for (int i = 0; i < 4; ++i) { const int e = tid + NTHR * i; float s = BIAS1[kv * CMP_HID + (e & 127)];
#pragma unroll
            for (int w = 0; w < 8; ++w) s += PART[w * 2048 + e];
            HID[e] = gelu_tanh(s); }
        asm volatile("s_waitcnt lgkmcnt(0)" ::: "memory"); __syncthreads();
        {
            const int nl = tid >> 5, d = (tid & 31) * 2;
            float o0 = 0.f, o1 = 0.f;
#pragma unroll 8
            for (int j = 0; j < CMP_HID; ++j) { const float hv = HID[nl * 128 + j]; const float wx = W2S[j * HD + d], wy = W2S[j * HD + d + 1]; o0 += hv * wx; o1 += hv * wy; }
            const int n = n0 + nl;
            const unsigned pk = (n < NCMP) ? pk2(o0, o1) : 0u;
            *(unsigned*)((kv ? VCB : KCB) + (size_t)((b * 4 + g) * 256 + n) * HD + d) = pk;
        }
        __syncthreads();
    }
}
}
#ifndef NSA_FAR
#define NSA_FAR 1
#endif
namespace nsa {
typedef short bf16x8 __attribute__((ext_vector_type(8)));
typedef short s16x4 __attribute__((ext_vector_type(4)));
typedef float f32x16 __attribute__((ext_vector_type(16)));
typedef unsigned u32x4 __attribute__((ext_vector_type(4)));
typedef __attribute__((address_space(3))) const char* lds_cptr;
typedef __attribute__((address_space(3))) unsigned char* lds_ptr;
constexpr int SLOTB = 16384;
constexpr int NSLOT = 4;
constexpr int L_RING = 0, L_OV = 65536, L_BT = 98304, L_WSF = 111104, L_MASK = 113152, L_MISC = 113664, L_X = 113792, L_END = L_X + 32768;
constexpr int BT_N = 800;
constexpr float LOG2E = 1.4426950408889634f, SC2 = 0.125f * LOG2E, NEG2 = -1e30f;
static_assert(L_END <= 162816, "nsa LDS map");
__device__ __forceinline__ int crow(int r, int hi) { return (r & 3) + 8 * (r >> 2) + 4 * hi; }
__device__ __forceinline__ void glds16(const void* gsrc, unsigned lds_dst) { unsigned keep;
    asm volatile("s_mov_b32 %0, m0\n\ts_mov_b32 m0, %2\n\ts_nop 0\n\tglobal_load_lds_dwordx4 %1, off\n\ts_mov_b32 m0, %0" : "=&s"(keep) : "v"(gsrc), "s"(lds_dst) : "memory"); }
typedef float f32x2_t __attribute__((ext_vector_type(2))); typedef __bf16 bf16x2_t __attribute__((ext_vector_type(2)));
__device__ __forceinline__ unsigned cvtpk_s(float lo, float hi) { f32x2_t v = {lo, hi}; bf16x2_t b = __builtin_convertvector(v, bf16x2_t); return __builtin_bit_cast(unsigned, b); }
#define NSA_WAIT_BAR(N) asm volatile("s_waitcnt vmcnt(" #N ") lgkmcnt(0)\n\ts_barrier" ::: "memory")
#define NSA_SBAR() __builtin_amdgcn_sched_barrier(0)

__device__ __forceinline__ void qkt(f32x16& p0, f32x16& p1, lds_cptr Kslot, const bf16x8* qr, int r32, int hi) {
    lds_cptr kb = Kslot + hi * 1024 + r32 * 16;
    const f32x16 z = {};
#pragma unroll
    for (int d0 = 0; d0 < 4; ++d0) {
        const bf16x8 b0 = *(const __attribute__((address_space(3))) bf16x8*)(kb + d0 * 2048);
        const bf16x8 b1 = *(const __attribute__((address_space(3))) bf16x8*)(kb + d0 * 2048 + 512);
        if (d0 == 0) { p0 = __builtin_amdgcn_mfma_f32_32x32x16_bf16(b0, qr[0], z, 0, 0, 0); p1 = __builtin_amdgcn_mfma_f32_32x32x16_bf16(b1, qr[0], z, 0, 0, 0); }
        else { p0 = __builtin_amdgcn_mfma_f32_32x32x16_bf16(b0, qr[d0], p0, 0, 0, 0); p1 = __builtin_amdgcn_mfma_f32_32x32x16_bf16(b1, qr[d0], p1, 0, 0, 0); }
    }
}
__device__ __forceinline__ void pv(f32x16* o, int vb, bf16x8 pa0, bf16x8 pa1, bf16x8 pa2, bf16x8 pa3) {
#pragma unroll
    for (int d0 = 0; d0 < 2; ++d0) { s16x4 lo[4], hi[4];
#pragma unroll
        for (int ks = 0; ks < 4; ++ks) {
            asm volatile("ds_read_b64_tr_b16 %0,%1 offset:%c2" : "=&v"(lo[ks]) : "v"(vb), "i"(d0 * 4096 + ks * 1024) : "memory");
            asm volatile("ds_read_b64_tr_b16 %0,%1 offset:%c2" : "=&v"(hi[ks]) : "v"(vb), "i"(d0 * 4096 + ks * 1024 + 512) : "memory"); }
        asm volatile("s_waitcnt lgkmcnt(0)" ::: "memory"); NSA_SBAR();
#define NSA_PK(k) (bf16x8){lo[k][0], lo[k][1], lo[k][2], lo[k][3], hi[k][0], hi[k][1], hi[k][2], hi[k][3]}
        o[d0] = __builtin_amdgcn_mfma_f32_32x32x16_bf16(pa0, NSA_PK(0), o[d0], 0, 0, 0);
        o[d0] = __builtin_amdgcn_mfma_f32_32x32x16_bf16(pa1, NSA_PK(1), o[d0], 0, 0, 0);
        o[d0] = __builtin_amdgcn_mfma_f32_32x32x16_bf16(pa2, NSA_PK(2), o[d0], 0, 0, 0);
        o[d0] = __builtin_amdgcn_mfma_f32_32x32x16_bf16(pa3, NSA_PK(3), o[d0], 0, 0, 0);
#undef NSA_PK
    }
}
__device__ __forceinline__ float rowmax32(const f32x16& p0, const f32x16& p1) {
    float a = fmaxf(p0[0], p1[0]), b = fmaxf(p0[1], p1[1]);
#pragma unroll
    for (int r = 2; r < 16; r += 2) { a = fmaxf(fmaxf(a, p0[r]), p1[r]); b = fmaxf(fmaxf(b, p0[r + 1]), p1[r + 1]); }
    a = fmaxf(a, b);
    auto rr = __builtin_amdgcn_permlane32_swap(__float_as_uint(a), __float_as_uint(a), false, false);
    return fmaxf(__uint_as_float(rr[0]), __uint_as_float(rr[1]));
}
__device__ __forceinline__ float swap_add(float v) {
    auto rr = __builtin_amdgcn_permlane32_swap(__float_as_uint(v), __float_as_uint(v), false, false);
    return __uint_as_float(rr[0]) + __uint_as_float(rr[1]);
}

struct PassCtx {
    lds_ptr lds3; unsigned lds0;
    int lane, r32, hi, wid;
    int tq;
    const __attribute__((address_space(3))) float* bt;
    __attribute__((address_space(3))) float* wsf;
    int vboff;
};

template <int MODE>
__device__ __forceinline__ void run_pass(const PassCtx& c, int NT, int first, const bf16* Kb, const bf16* Vb, int pitch, const bf16x8* qr,
                                         unsigned mask_lo, unsigned mask_hi, f32x16 (&o)[2], f32x16 (&im)[2], float& m, float& l) {
    const __attribute__((address_space(3))) unsigned char* TL = (const __attribute__((address_space(3))) unsigned char*)(c.lds3 + L_MISC);
#define NSA_TID(i) ((MODE == 0) ? (i) : (MODE == 2) ? (first + (i)) : (int)TL[NT - 1 - (i)])
#define NSA_ISSUE(i, slot) do { const int id_ = __builtin_amdgcn_readfirstlane(NSA_TID(i)); \
        const bf16* ks_ = Kb + (size_t)(64 * id_ + c.lane) * pitch + 8 * c.wid; \
        const bf16* vs_ = Vb + (size_t)(64 * id_ + 16 * (c.wid & 3) + (c.lane >> 2)) * pitch + 32 * (c.wid >> 2) + 8 * (c.lane & 3); \
        glds16(ks_, (unsigned)__builtin_amdgcn_readfirstlane(c.lds0 + L_RING + (slot) * SLOTB + c.wid * 1024)); \
        glds16(vs_, (unsigned)__builtin_amdgcn_readfirstlane(c.lds0 + L_RING + (slot) * SLOTB + 8192 + c.wid * 1024)); } while (0)
    if (NT > 0) NSA_ISSUE(0, 0);
    if (NT > 1) NSA_ISSUE(1, 1);
    if (NT > 2) NSA_ISSUE(2, 2);
    int slot = 0;
    for (int i = 0; i < NT; ++i) {
        if (i + 2 < NT) NSA_WAIT_BAR(4); else if (i + 1 < NT) NSA_WAIT_BAR(2); else NSA_WAIT_BAR(0);
        if (i + 3 < NT) { const int s3 = (slot == 0) ? 3 : slot - 1; NSA_ISSUE(i + 3, s3); }
        const int id = __builtin_amdgcn_readfirstlane(NSA_TID(i));
        f32x16 p0, p1;
        qkt(p0, p1, (lds_cptr)(c.lds3 + L_RING + slot * SLOTB), qr, c.r32, c.hi);
        const int dbase = (MODE == 0) ? (c.tq - 31 - 1024 * id) : (c.tq - 64 * id);
        bool selb = true;
        if (MODE == 1) selb = ((id < 32 ? (mask_lo >> id) : (mask_hi >> (id - 32))) & 1u) != 0u;
        float alpha, rs = 0.f;
        if (NSA_FAR && MODE == 1 && __builtin_amdgcn_readfirstlane(c.tq - c.r32) - (64 * id + 63) >= 790) {
            const float lofs = selb ? c.bt[790] : -INFINITY;
            const float mt = rowmax32(p0, p1) * SC2 + lofs;
            const float mnew = fmaxf(m, mt);
            alpha = __builtin_amdgcn_exp2f(m - mnew);
            m = mnew;
            const float off = lofs - mnew;
#pragma unroll
            for (int r = 0; r < 16; ++r) { p0[r] = __builtin_amdgcn_exp2f(p0[r] * SC2 + off); p1[r] = __builtin_amdgcn_exp2f(p1[r] * SC2 + off); rs += p0[r] + p1[r]; }
        } else {
        int dbh = dbase - ((MODE == 0) ? 64 * c.hi : 4 * c.hi);
        asm volatile("" : "+v"(dbh));
#pragma unroll
        for (int r = 0; r < 16; ++r) {
            const int d0 = dbh - ((MODE == 0) ? 16 * ((r & 3) + 8 * (r >> 2)) : ((r & 3) + 8 * (r >> 2)));
            const int d1 = (MODE == 0) ? (d0 - 512) : (d0 - 32);
            bool v0 = d0 >= 0, v1 = d1 >= 0;
            if (MODE == 2) { v0 = v0 && d0 < WINDOW; v1 = v1 && d1 < WINDOW; }
            if (MODE == 1) { v0 = v0 && selb; v1 = v1 && selb; }
            const int i0 = d0 < 0 ? 0 : (d0 > 790 ? 790 : d0), i1 = d1 < 0 ? 0 : (d1 > 790 ? 790 : d1);
            const float s0 = p0[r] * SC2 + c.bt[i0], s1 = p1[r] * SC2 + c.bt[i1];
            p0[r] = v0 ? s0 : -INFINITY; p1[r] = v1 ? s1 : -INFINITY;
        }
        const float mt = rowmax32(p0, p1);
        const float mnew = fmaxf(m, mt);
        alpha = __builtin_amdgcn_exp2f(m - mnew);
        m = mnew;
#pragma unroll
        for (int r = 0; r < 16; ++r) {
            const float e0 = __builtin_amdgcn_exp2f(p0[r] - mnew), e1 = __builtin_amdgcn_exp2f(p1[r] - mnew);
            p0[r] = e0; p1[r] = e1; rs += e0 + e1;
        }
        }
        l = l * alpha + rs;
        if (!__all(alpha == 1.f)) {
            if (c.hi == 0) c.wsf[c.r32] = alpha;
            asm volatile("s_waitcnt lgkmcnt(0)" ::: "memory");
#pragma unroll
            for (int r = 0; r < 16; ++r) { const float a = c.wsf[crow(r, c.hi)]; o[0][r] *= a; o[1][r] *= a; if (MODE == 0) { im[0][r] *= a; im[1][r] *= a; } }
        }
        u32x4 pw0, pw1, pw2, pw3;
        pw0 = (u32x4){cvtpk_s(p0[0], p0[1]), cvtpk_s(p0[2], p0[3]), cvtpk_s(p0[4], p0[5]), cvtpk_s(p0[6], p0[7])};
        pw1 = (u32x4){cvtpk_s(p0[8], p0[9]), cvtpk_s(p0[10], p0[11]), cvtpk_s(p0[12], p0[13]), cvtpk_s(p0[14], p0[15])};
        pw2 = (u32x4){cvtpk_s(p1[0], p1[1]), cvtpk_s(p1[2], p1[3]), cvtpk_s(p1[4], p1[5]), cvtpk_s(p1[6], p1[7])};
        pw3 = (u32x4){cvtpk_s(p1[8], p1[9]), cvtpk_s(p1[10], p1[11]), cvtpk_s(p1[12], p1[13]), cvtpk_s(p1[14], p1[15])};
        NSA_SBAR();
        pv(o, (int)(c.lds0 + L_RING + slot * SLOTB + 8192) + c.vboff, __builtin_bit_cast(bf16x8, pw0), __builtin_bit_cast(bf16x8, pw1), __builtin_bit_cast(bf16x8, pw2), __builtin_bit_cast(bf16x8, pw3));
        if (MODE == 0) pv(im, (int)(c.lds0 + L_OV + id * 8192) + c.vboff, __builtin_bit_cast(bf16x8, pw0), __builtin_bit_cast(bf16x8, pw1), __builtin_bit_cast(bf16x8, pw2), __builtin_bit_cast(bf16x8, pw3));
        slot = (slot == NSLOT - 1) ? 0 : slot + 1;
    }
    asm volatile("s_waitcnt vmcnt(0) lgkmcnt(0)\n\ts_barrier" ::: "memory");
#undef NSA_TID
#undef NSA_ISSUE
}

__device__ __forceinline__ void build_ov(lds_ptr lds3) {
    for (int idx = threadIdx.x; idx < 4 * 4096; idx += NTHR) {
        const int kt = idx >> 12, nl = (idx >> 6) & 63, jc = idx & 63, n = 64 * kt + nl;
        unsigned short v = 0;
        if ((n & 3) != 3) { if (jc == (n >> 2)) v = 0x3F80; } else { if (jc == (n >> 2) || jc == (n >> 2) + 1) v = 0x3F00; }
        *(__attribute__((address_space(3))) unsigned short*)(lds3 + L_OV + kt * 8192 + ((jc >> 5) * 4 + (nl >> 4)) * 1024 + (nl & 15) * 64 + (jc & 31) * 2) = v;
    }
}

__device__ __forceinline__ void nsa_unit(int variant, bool build_bt, int b, int g, int qt, const bf16* PROJ, const bf16* KCBb, const bf16* VCBb, const float* rel, bf16* ONSA, lds_ptr lds3, unsigned lds0) {
    const int tid = threadIdx.x, lane = tid & 63, r32 = lane & 31, hi = lane >> 5;
    const int wid = __builtin_amdgcn_readfirstlane(tid >> 6), hh = wid & 3, th = wid >> 2;
    const int t0 = qt * 64, tq = t0 + 32 * th + r32, cur = qt;
    __attribute__((address_space(3))) float* BT = (__attribute__((address_space(3))) float*)(lds3 + L_BT);
    __attribute__((address_space(3))) unsigned* MASK = (__attribute__((address_space(3))) unsigned*)(lds3 + L_MASK);
    if (build_bt) for (int i = tid; i < 4 * BT_N; i += NTHR) BT[i] = rel[g * 4 * BT_N + i];
    if (tid < 128) MASK[tid] = 0u;
    PassCtx c; c.lds3 = lds3; c.lds0 = lds0; c.lane = lane; c.r32 = r32; c.hi = hi; c.wid = wid; c.tq = tq;
    c.bt = BT + hh * BT_N; c.wsf = (__attribute__((address_space(3))) float*)(lds3 + L_WSF) + wid * 64;
    c.vboff = ((lane >> 4) & 1) * 32 + (lane & 3) * 8 + (4 * hi + ((lane & 15) >> 2)) * 64;
    const size_t qrow = (size_t)(b * SEQ + tq) * PP;
    bf16x8 qr[4];
#pragma unroll
    for (int d0 = 0; d0 < 4; ++d0) qr[d0] = *(const bf16x8*)(PNL(PROJ, P_QN + g) + qrow + hh * HD + d0 * 16 + hi * 8);
    const float gate0 = 1.f / (1.f + __expf(-bf2f(PNL(PROJ, P_GBR)[qrow + 0 * 16 + g * 4 + hh])));
    const float gate1 = 1.f / (1.f + __expf(-bf2f(PNL(PROJ, P_GBR)[qrow + 1 * 16 + g * 4 + hh])));
    const float gate2 = 1.f / (1.f + __expf(-bf2f(PNL(PROJ, P_GBR)[qrow + 2 * 16 + g * 4 + hh])));
    asm volatile("s_waitcnt vmcnt(0) lgkmcnt(0)" ::: "memory");
    __syncthreads();
    f32x16 oc[2] = {}, o[2] = {}, im[2] = {};
    float m = NEG2, l = 0.f;
    {
        int cnt = (t0 + 32) / 16 + 1; if (cnt > NCMP) cnt = NCMP;
        const int NT = (variant & 4) ? 0 : ((cnt + 63) >> 6);
#if defined(PROBE_NSA_CMP2)
        run_pass<0>(c, NT, 0, KCBb + (size_t)(b * 4 + g) * 256 * HD, VCBb + (size_t)(b * 4 + g) * 256 * HD, HD, qr, 0u, 0u, o, im, m, l);
        o[0] = f32x16{}; o[1] = f32x16{}; im[0] = f32x16{}; im[1] = f32x16{}; m = NEG2; l = 0.f;
#endif
        run_pass<0>(c, NT, 0, KCBb + (size_t)(b * 4 + g) * 256 * HD, VCBb + (size_t)(b * 4 + g) * 256 * HD, HD, qr, 0u, 0u, o, im, m, l);
        const float lt = swap_add(l);
        const float inv = lt > 0.f ? 1.f / lt : 0.f;
        if (hi == 0) { c.wsf[r32] = inv * gate0; c.wsf[32 + r32] = inv; }
        asm volatile("s_waitcnt lgkmcnt(0)" ::: "memory");
#pragma unroll
        for (int r = 0; r < 16; ++r) { const float a = c.wsf[crow(r, hi)], a2 = c.wsf[32 + crow(r, hi)]; oc[0][r] = o[0][r] * a; oc[1][r] = o[1][r] * a; im[0][r] *= a2; im[1][r] *= a2; }
        if (!(variant & 8)) {
        {
            __attribute__((address_space(3))) float* PW = (__attribute__((address_space(3))) float*)(lds3 + L_RING) + wid * 2048;
#pragma unroll
            for (int d0 = 0; d0 < 2; ++d0)
#pragma unroll
                for (int r = 0; r < 16; ++r) PW[crow(r, hi) * 64 + d0 * 32 + r32] = im[d0][r];
        }
        asm volatile("s_waitcnt lgkmcnt(0)" ::: "memory"); __syncthreads();
        __attribute__((address_space(3))) float* T = (__attribute__((address_space(3))) float*)(lds3 + L_X);
        {
            const __attribute__((address_space(3))) float* PA = (const __attribute__((address_space(3))) float*)(lds3 + L_RING);
            int tx = tid; asm volatile("" : "+v"(tx));
            const int j = tx & 63, tb = (tx >> 6) * 8;
#pragma unroll
            for (int e = 0; e < 8; ++e) { const int tok = tb + e, w0 = (tok >> 5) * 4, q = tok & 31;
                T[tok * 65 + j] = (PA[(w0 + 0) * 2048 + q * 64 + j] + PA[(w0 + 1) * 2048 + q * 64 + j]) + (PA[(w0 + 2) * 2048 + q * 64 + j] + PA[(w0 + 3) * 2048 + q * 64 + j]); }
        }
        asm volatile("s_waitcnt lgkmcnt(0)" ::: "memory"); __syncthreads();
        {
            int ty = tid; asm volatile("" : "+v"(ty));
            const int tok = ty & 63, jg = wid, jlo = 8 * jg;
            float v[8]; int rank[8];
#pragma unroll
            for (int e = 0; e < 8; ++e) { const int j = jlo + e; const bool forced = (j == 0) || (j == cur) || (j == cur - 1);
                v[e] = (j <= cur) ? T[tok * 65 + j] + (forced ? 1e4f : 0.f) : -INFINITY; rank[e] = 0; }
            const int nA = jlo < cur + 1 ? jlo : cur + 1, nB = (jlo + 8) < cur + 1 ? (jlo + 8) : cur + 1;
#pragma unroll 2
            for (int j2 = 0; j2 < nA; ++j2) {
                const float sv = T[tok * 65 + j2] + (((j2 == 0) || (j2 == cur) || (j2 == cur - 1)) ? 1e4f : 0.f);
#pragma unroll
                for (int e = 0; e < 8; ++e) rank[e] += (sv >= v[e]) ? 1 : 0;
            }
            for (int j2 = jlo; j2 < nB; ++j2) {
                const float sv = T[tok * 65 + j2] + (((j2 == 0) || (j2 == cur) || (j2 == cur - 1)) ? 1e4f : 0.f);
#pragma unroll
                for (int e = 0; e < 8; ++e) rank[e] += (sv > v[e] || (sv == v[e] && j2 < jlo + e)) ? 1 : 0;
            }
#pragma unroll 2
            for (int j2 = jlo + 8; j2 <= cur; ++j2) {
                const float sv = T[tok * 65 + j2] + (((j2 == 0) || (j2 == cur) || (j2 == cur - 1)) ? 1e4f : 0.f);
#pragma unroll
                for (int e = 0; e < 8; ++e) rank[e] += (sv > v[e]) ? 1 : 0;
            }
            unsigned bits = 0u;
#pragma unroll
            for (int e = 0; e < 8; ++e) { const int j = jlo + e; if (j <= cur && rank[e] < SEL_TOPK) bits |= 1u << e; }
            if (bits) atomicOr((unsigned*)(MASK + tok * 2 + (jg >> 2)), bits << ((jg & 3) * 8));
        }
        asm volatile("s_waitcnt lgkmcnt(0)" ::: "memory"); __syncthreads();
        if (wid == 0) {
            unsigned ulo = MASK[lane * 2], uhi = MASK[lane * 2 + 1];
#pragma unroll
            for (int ofs = 32; ofs >= 1; ofs >>= 1) { ulo |= __shfl_xor(ulo, ofs); uhi |= __shfl_xor(uhi, ofs); }
            {
                __attribute__((address_space(3))) unsigned char* TL = (__attribute__((address_space(3))) unsigned char*)(lds3 + L_MISC);
                const unsigned long long mm = ((unsigned long long)uhi << 32) | ulo;
                int ln = lane; asm volatile("" : "+v"(ln));
                if ((mm >> ln) & 1ull) TL[__popcll(mm & ((1ull << ln) - 1ull))] = (unsigned char)ln;
                if (lane == 0) *(__attribute__((address_space(3))) int*)(lds3 + L_MISC + 64) = __popcll(mm);
            }
        }
        asm volatile("s_waitcnt lgkmcnt(0)" ::: "memory"); __syncthreads();
        }
    }
    {
        const unsigned mlo = MASK[(32 * th + r32) * 2], mhi = MASK[(32 * th + r32) * 2 + 1];
        const int NT = (variant & 1) ? 0 : __builtin_amdgcn_readfirstlane(*(__attribute__((address_space(3))) int*)(lds3 + L_MISC + 64));
#if defined(PROBE_NSA_SEL2)
        o[0] = f32x16{}; o[1] = f32x16{}; m = NEG2; l = 0.f;
        run_pass<1>(c, NT, 0, PNL(PROJ, P_KS) + (size_t)b * SEQ * PP + g * HD, PNL(PROJ, P_VS) + (size_t)b * SEQ * PP + g * HD, PP, qr, mlo, mhi, o, im, m, l);
#endif
        o[0] = f32x16{}; o[1] = f32x16{}; m = NEG2; l = 0.f;
        run_pass<1>(c, NT, 0, PNL(PROJ, P_KS) + (size_t)b * SEQ * PP + g * HD, PNL(PROJ, P_VS) + (size_t)b * SEQ * PP + g * HD, PP, qr, mlo, mhi, o, im, m, l);
        const float lt = swap_add(l);
        const float inv = lt > 0.f ? 1.f / lt : 0.f;
        if (hi == 0) c.wsf[r32] = inv * gate1;
        asm volatile("s_waitcnt lgkmcnt(0)" ::: "memory");
#pragma unroll
        for (int r = 0; r < 16; ++r) { const float a = c.wsf[crow(r, hi)]; oc[0][r] += o[0][r] * a; oc[1][r] += o[1][r] * a; }
    }
    {
        const int jlo = (qt - 8) > 0 ? (qt - 8) : 0, NT = (variant & 2) ? 0 : (qt - jlo + 1);
#if defined(PROBE_NSA_WIN2)
        o[0] = f32x16{}; o[1] = f32x16{}; m = NEG2; l = 0.f;
        run_pass<2>(c, NT, jlo, PNL(PROJ, P_KW) + (size_t)b * SEQ * PP + g * HD, PNL(PROJ, P_VW) + (size_t)b * SEQ * PP + g * HD, PP, qr, 0u, 0u, o, im, m, l);
#endif
        o[0] = f32x16{}; o[1] = f32x16{}; m = NEG2; l = 0.f;
        run_pass<2>(c, NT, jlo, PNL(PROJ, P_KW) + (size_t)b * SEQ * PP + g * HD, PNL(PROJ, P_VW) + (size_t)b * SEQ * PP + g * HD, PP, qr, 0u, 0u, o, im, m, l);
        const float lt = swap_add(l);
        const float inv = lt > 0.f ? 1.f / lt : 0.f;
        if (hi == 0) c.wsf[r32] = inv * gate2;
        asm volatile("s_waitcnt lgkmcnt(0)" ::: "memory");
#pragma unroll
        for (int r = 0; r < 16; ++r) { const float a = c.wsf[crow(r, hi)]; oc[0][r] += o[0][r] * a; oc[1][r] += o[1][r] * a; }
    }
    {
        __attribute__((address_space(3))) unsigned short* stg = (__attribute__((address_space(3))) unsigned short*)(lds3 + L_X) + wid * 2048;
#pragma unroll
        for (int r = 0; r < 16; ++r) { const int orow = crow(r, hi);
#pragma unroll
            for (int d0 = 0; d0 < 2; ++d0) stg[orow * 64 + d0 * 32 + r32] = (unsigned short)f2bf(oc[d0][r]); }
        asm volatile("s_waitcnt lgkmcnt(0)" ::: "memory");
        bf16* Ow = ONSA + (size_t)(b * SEQ + t0 + 32 * th) * NSA_Q + (g * 4 + hh) * HD;
#pragma unroll
        for (int i = 0; i < 4; ++i) { const int row = i * 8 + (lane >> 3), ch = lane & 7;
            const u32x4 vv = *(const __attribute__((address_space(3))) u32x4*)(stg + row * 64 + ch * 8);
            *(u32x4*)(Ow + (size_t)row * NSA_Q + ch * 8) = vv; }
    }
    asm volatile("s_waitcnt vmcnt(0) lgkmcnt(0)" ::: "memory");
    __syncthreads();
}

__device__ __forceinline__ void nsa_phase(const bf16* PROJ, const bf16* KCBb, const bf16* VCBb, const float* rel, bf16* ONSA, lds_ptr lds3, int vcu, int G, int variant) {
    const unsigned lds0 = (unsigned)(uintptr_t)lds3;
    build_ov(lds3);
    __syncthreads();
    int last_g = -1;
#ifndef NSA_REP
#define NSA_REP 1
#endif
#pragma unroll 1
    for (int rep_ = 0; rep_ < NSA_REP; ++rep_)
#pragma unroll 1
    for (int i = vcu; i < 512; i += G) {
        const int k = i & 255, bg = k >> 5, s = k & 31, qt = (i < 256) ? s : 63 - s;
        if (!(variant & 16)) nsa_unit(variant, (bg & 3) != last_g, bg >> 2, bg & 3, qt, PROJ, KCBb, VCBb, rel, ONSA, lds3, lds0);
        last_g = bg & 3;
    }
}
#undef NSA_WAIT_BAR
#undef NSA_SBAR
}
namespace nsa {
constexpr float STICK_THR = 50.f, LN2F = 0.6931471805599453f;
constexpr int STK_SLOTB = 32768;
static_assert(3 * STK_SLOTB <= L_WSF, "stick ring vs the LDS words it shares with the NSA map");
#define NSA_WAIT_BAR(N) asm volatile("s_waitcnt vmcnt(" #N ") lgkmcnt(0)\n\ts_barrier" ::: "memory")
__device__ __forceinline__ void stick_unit(int tid, int b, int hp, int qb, const bf16* PROJ, bf16* OSB, lds_ptr lds3, unsigned lds0, const bf16x8 (&tri)[2]) {
    const int lane = tid & 63, r32 = lane & 31, hi = lane >> 5;
    const int wid = __builtin_amdgcn_readfirstlane(tid >> 6);
    const int hs = wid >> 2, qw = wid & 3, h = 2 * hp + hs;
    const int q0 = qb * 128, t = q0 + 32 * qw + r32;
    const bf16* Kb = PNL(PROJ, P_KB + (hp >> 1)) + (size_t)b * SEQ * PP + (hp & 1) * 128;
    const bf16* Vb = PNL(PROJ, P_VB + (hp >> 1)) + (size_t)b * SEQ * PP + (hp & 1) * 128;
    __attribute__((address_space(3))) int* DONE = (__attribute__((address_space(3))) int*)(lds3 + L_MISC);
    bf16x8 qr[4];
#pragma unroll
    for (int d0 = 0; d0 < 4; ++d0) qr[d0] = *(const bf16x8*)(PNL(PROJ, P_QB + (h >> 2)) + (size_t)(b * SEQ + t) * PP + (h & 3) * HD + d0 * 16 + hi * 8);
    if (tid < 8) DONE[tid] = 0x7fffffff;
    asm volatile("s_waitcnt vmcnt(0) lgkmcnt(0)" ::: "memory");
    __syncthreads();
    const int jhi = 2 * qb + 1, NT = jhi + 1;
    const int jw = (q0 + 32 * qw + 30) >> 6;
    const int vboff = ((lane >> 4) & 1) * 32 + (lane & 3) * 8 + (4 * hi + ((lane & 15) >> 2)) * 64;
    f32x16 o[2] = {};
    float carry = 0.f; bool mydone = false;
#define STK_ISSUE(i, slot) do { const int id_ = jhi - (i); \
        const bf16* ks_ = Kb + (size_t)(64 * id_ + lane) * PP + 8 * wid; \
        const bf16* vs_ = Vb + (size_t)(64 * id_ + 16 * (wid & 3) + (lane >> 2)) * PP + 32 * (wid >> 2) + 8 * (lane & 3); \
        glds16(ks_, (unsigned)__builtin_amdgcn_readfirstlane(lds0 + L_RING + (slot) * STK_SLOTB + wid * 1024)); \
        glds16(vs_, (unsigned)__builtin_amdgcn_readfirstlane(lds0 + L_RING + (slot) * STK_SLOTB + 8192 + wid * 1024)); \
        glds16(ks_ + 64, (unsigned)__builtin_amdgcn_readfirstlane(lds0 + L_RING + (slot) * STK_SLOTB + 16384 + wid * 1024)); \
        glds16(vs_ + 64, (unsigned)__builtin_amdgcn_readfirstlane(lds0 + L_RING + (slot) * STK_SLOTB + 24576 + wid * 1024)); } while (0)
    STK_ISSUE(0, 0);
    if (NT > 1) STK_ISSUE(1, 1);
    int slot = 0;
    for (int i = 0; i < NT; ++i) {
        if (i + 1 < NT) NSA_WAIT_BAR(4); else NSA_WAIT_BAR(0);
        bool alld = true;
#pragma unroll
        for (int w = 0; w < 8; ++w) alld = alld && (DONE[w] < i);
        if (__builtin_amdgcn_readfirstlane((int)alld)) break;
        if (i + 2 < NT) { const int s2 = (slot == 0) ? 2 : slot - 1; STK_ISSUE(i + 2, s2); }
        const int j = jhi - i;
        if (!mydone && j <= jw) {
            f32x16 p0, p1, x0, x1;
            qkt(p0, p1, (lds_cptr)(lds3 + L_RING + slot * STK_SLOTB + hs * 16384), qr, r32, hi);
            float s0 = 0.f, s1 = 0.f;
#pragma unroll
            for (int r = 0; r < 16; ++r) {
                const int pos0 = 64 * j + crow(r, hi);
                const float z0 = p0[r] * 0.125f, z1 = p1[r] * 0.125f;
                const float L0 = __builtin_amdgcn_logf(1.f + __builtin_amdgcn_exp2f(-fabsf(z0) * LOG2E)) * LN2F;
                const float L1 = __builtin_amdgcn_logf(1.f + __builtin_amdgcn_exp2f(-fabsf(z1) * LOG2E)) * LN2F;
                p0[r] = fminf(z0, 0.f) - L0; p1[r] = fminf(z1, 0.f) - L1;
                x0[r] = (pos0 < t) ? (-fmaxf(z0, 0.f) - L0) : 0.f; x1[r] = (pos0 + 32 < t) ? (-fmaxf(z1, 0.f) - L1) : 0.f;
                s0 += x0[r]; s1 += x1[r];
            }
            const float tot0 = swap_add(s0), tot1 = swap_add(s1);
            u32x4 h0a, h0b, l0a, l0b, h1a, h1b, l1a, l1b;
#define STK_SPLIT(X, HA, HB, LA, LB) do { unsigned hw_[8]; float lo_[16]; \
                _Pragma("unroll") for (int q_ = 0; q_ < 8; ++q_) { hw_[q_] = cvtpk_s(X[2 * q_], X[2 * q_ + 1]); \
                    lo_[2 * q_] = X[2 * q_] - __uint_as_float(hw_[q_] << 16); lo_[2 * q_ + 1] = X[2 * q_ + 1] - __uint_as_float(hw_[q_] & 0xffff0000u); } \
                HA = (u32x4){hw_[0], hw_[1], hw_[2], hw_[3]}; HB = (u32x4){hw_[4], hw_[5], hw_[6], hw_[7]}; \
                LA = (u32x4){cvtpk_s(lo_[0], lo_[1]), cvtpk_s(lo_[2], lo_[3]), cvtpk_s(lo_[4], lo_[5]), cvtpk_s(lo_[6], lo_[7])}; \
                LB = (u32x4){cvtpk_s(lo_[8], lo_[9]), cvtpk_s(lo_[10], lo_[11]), cvtpk_s(lo_[12], lo_[13]), cvtpk_s(lo_[14], lo_[15])}; } while (0)
            STK_SPLIT(x0, h0a, h0b, l0a, l0b);
            STK_SPLIT(x1, h1a, h1b, l1a, l1b);
#undef STK_SPLIT
            f32x16 y0, y1;
#pragma unroll
            for (int r = 0; r < 16; ++r) { y0[r] = carry + tot1; y1[r] = carry; }
            y0 = __builtin_amdgcn_mfma_f32_32x32x16_bf16(tri[0], __builtin_bit_cast(bf16x8, h0a), y0, 0, 0, 0);
            y0 = __builtin_amdgcn_mfma_f32_32x32x16_bf16(tri[1], __builtin_bit_cast(bf16x8, h0b), y0, 0, 0, 0);
            y0 = __builtin_amdgcn_mfma_f32_32x32x16_bf16(tri[0], __builtin_bit_cast(bf16x8, l0a), y0, 0, 0, 0);
            y0 = __builtin_amdgcn_mfma_f32_32x32x16_bf16(tri[1], __builtin_bit_cast(bf16x8, l0b), y0, 0, 0, 0);
            y1 = __builtin_amdgcn_mfma_f32_32x32x16_bf16(tri[0], __builtin_bit_cast(bf16x8, h1a), y1, 0, 0, 0);
            y1 = __builtin_amdgcn_mfma_f32_32x32x16_bf16(tri[1], __builtin_bit_cast(bf16x8, h1b), y1, 0, 0, 0);
            y1 = __builtin_amdgcn_mfma_f32_32x32x16_bf16(tri[0], __builtin_bit_cast(bf16x8, l1a), y1, 0, 0, 0);
            y1 = __builtin_amdgcn_mfma_f32_32x32x16_bf16(tri[1], __builtin_bit_cast(bf16x8, l1b), y1, 0, 0, 0);
#pragma unroll
            for (int r = 0; r < 16; ++r) {
                const int pos0 = 64 * j + crow(r, hi);
                y0[r] = (pos0 < t) ? __builtin_amdgcn_exp2f((p0[r] + y0[r]) * LOG2E) : 0.f;
                y1[r] = (pos0 + 32 < t) ? __builtin_amdgcn_exp2f((p1[r] + y1[r]) * LOG2E) : 0.f;
            }
            carry += tot0 + tot1;
            u32x4 pw0, pw1, pw2, pw3;
            pw0 = (u32x4){cvtpk_s(y0[0], y0[1]), cvtpk_s(y0[2], y0[3]), cvtpk_s(y0[4], y0[5]), cvtpk_s(y0[6], y0[7])};
            pw1 = (u32x4){cvtpk_s(y0[8], y0[9]), cvtpk_s(y0[10], y0[11]), cvtpk_s(y0[12], y0[13]), cvtpk_s(y0[14], y0[15])};
            pw2 = (u32x4){cvtpk_s(y1[0], y1[1]), cvtpk_s(y1[2], y1[3]), cvtpk_s(y1[4], y1[5]), cvtpk_s(y1[6], y1[7])};
            pw3 = (u32x4){cvtpk_s(y1[8], y1[9]), cvtpk_s(y1[10], y1[11]), cvtpk_s(y1[12], y1[13]), cvtpk_s(y1[14], y1[15])};
            __builtin_amdgcn_sched_barrier(0);
            pv(o, (int)(lds0 + L_RING + slot * STK_SLOTB + hs * 16384 + 8192) + vboff, __builtin_bit_cast(bf16x8, pw0), __builtin_bit_cast(bf16x8, pw1), __builtin_bit_cast(bf16x8, pw2), __builtin_bit_cast(bf16x8, pw3));
            mydone = __all(carry < -STICK_THR) != 0;
            if (mydone && lane == 0) DONE[wid] = i;
        }
        slot = (slot == 2) ? 0 : slot + 1;
    }
    asm volatile("s_waitcnt vmcnt(0) lgkmcnt(0)\n\ts_barrier" ::: "memory");
#undef STK_ISSUE
    {
        __attribute__((address_space(3))) unsigned short* stg = (__attribute__((address_space(3))) unsigned short*)(lds3 + L_X) + wid * 2048;
#pragma unroll
        for (int r = 0; r < 16; ++r) { const int orow = crow(r, hi);
#pragma unroll
            for (int d0 = 0; d0 < 2; ++d0) stg[orow * 64 + d0 * 32 + r32] = (unsigned short)f2bf(o[d0][r]); }
        asm volatile("s_waitcnt lgkmcnt(0)" ::: "memory");
        bf16* Ow = OSB + (size_t)(b * SEQ + q0 + 32 * qw) * SB_W + h * HD;
#pragma unroll
        for (int i = 0; i < 4; ++i) { const int row = i * 8 + (lane >> 3), ch = lane & 7;
            const u32x4 vv = *(const __attribute__((address_space(3))) u32x4*)(stg + row * 64 + ch * 8);
            *(u32x4*)(Ow + (size_t)row * SB_W + ch * 8) = vv; }
    }
    asm volatile("s_waitcnt vmcnt(0) lgkmcnt(0)" ::: "memory");
    __syncthreads();
}
__device__ __forceinline__ void stick_phase(const bf16* PROJ, bf16* OSB, lds_ptr lds3, int vcu, int G) {
    const unsigned lds0 = (unsigned)(uintptr_t)lds3;
    int tid = threadIdx.x; asm volatile("" : "+v"(tid));
    const int lane = tid & 63, r32 = lane & 31, hi = lane >> 5;
    bf16x8 tri[2];
#pragma unroll
    for (int s = 0; s < 2; ++s)
#pragma unroll
        for (int j = 0; j < 8; ++j) tri[s][j] = ((16 * s + 8 * (j >> 2) + 4 * hi + (j & 3)) > r32) ? (short)0x3F80 : (short)0;
    for (int i = vcu; i < 512; i += G) {
        const int bp = i >> 5, qb = i & 31;
        stick_unit(tid, bp >> 3, bp & 7, qb, PROJ, OSB, lds3, lds0, tri);
    }
}
#undef NSA_WAIT_BAR
}
namespace peer {
typedef short bf16x8 __attribute__((ext_vector_type(8)));
typedef float f32x16 __attribute__((ext_vector_type(16)));
typedef __bf16 b2_t __attribute__((ext_vector_type(2)));
constexpr int L_EX = 0, L_GT = 16384;
__device__ __forceinline__ int crow(int r, int hi) { return (r & 3) + 8 * (r >> 2) + 4 * hi; }
__device__ __forceinline__ unsigned mono(float f) { const unsigned u = __float_as_uint(f); return (u & 0x80000000u) ? ~u : (u | 0x80000000u); }
__device__ __forceinline__ float unmono(unsigned k) { return __uint_as_float((k & 0x80000000u) ? (k & 0x7fffffffu) : ~k); }
__device__ __forceinline__ float dot2(unsigned a, unsigned b, float c) { return __builtin_amdgcn_fdot2_f32_bf16(__builtin_bit_cast(b2_t, a), __builtin_bit_cast(b2_t, b), c, false); }
#define PEER_CE(key, slot) do { const unsigned hi_ = (key) > (slot) ? (key) : (slot); (key) = (key) > (slot) ? (slot) : (key); (slot) = hi_; } while (0)

__device__ __forceinline__ void route_list(const bf16* QP, const bf16* SKB, int L, int tok0, int r32, int hi, unsigned (&out)[16]) {
    f32x16 acc[4] = {};
    const bf16* qp = QP + (size_t)(tok0 + r32) * 2048 + L * 128 + hi * 8;
    const bf16* kp = SKB + ((size_t)L * 128 + r32) * 128 + hi * 8;
    int hi4 = 4 * hi;
    asm volatile("" : "+v"(qp), "+v"(kp), "+v"(hi4));
#pragma unroll
    for (int ks = 0; ks < 8; ++ks) {
        const bf16x8 bq = *(const bf16x8*)(qp + ks * 16);
#pragma unroll
        for (int kt = 0; kt < 4; ++kt) { const bf16x8 a = *(const bf16x8*)(kp + (size_t)kt * 32 * 128 + ks * 16); acc[kt] = __builtin_amdgcn_mfma_f32_32x32x16_bf16(a, bq, acc[kt], 0, 0, 0); }
    }
    unsigned t[16];
#pragma unroll
    for (int k = 0; k < 16; ++k) t[k] = 0u;
#pragma unroll
    for (int kt = 0; kt < 4; ++kt)
#pragma unroll
        for (int r = 0; r < 16; ++r) {
            unsigned key = ((mono(acc[kt][r]) & ~127u) | (unsigned)(127 - (32 * kt + (r & 3) + 8 * (r >> 2)))) - (unsigned)hi4;
#pragma unroll
            for (int k = 0; k < 16; ++k) PEER_CE(key, t[k]);
            __builtin_amdgcn_sched_barrier(0);
        }
    unsigned u[16];
#pragma unroll
    for (int k = 0; k < 16; ++k) { auto rr = __builtin_amdgcn_permlane32_swap(t[k], t[k], false, false); u[k] = hi ? rr[0] : rr[1]; }
#pragma unroll
    for (int k = 0; k < 16; ++k) out[k] = t[k] > u[15 - k] ? t[k] : u[15 - k];
#pragma unroll
    for (int st = 8; st >= 1; st >>= 1)
#pragma unroll
        for (int k = 0; k < 16; ++k) if ((k & st) == 0) { const unsigned a = out[k], b = out[k | st]; out[k] = a > b ? a : b; out[k | st] = a > b ? b : a; }
}

__device__ __forceinline__ void route_head(const bf16* QP, const bf16* SKB, int h, int tok0, int lane, __attribute__((address_space(3))) unsigned char* lds3) {
    asm volatile("" : "+v"(lane));
    const int r32 = lane & 31, hi = lane >> 5;
    unsigned A[16], B[16];
    route_list(QP, SKB, 2 * h, tok0, r32, hi, A);
    route_list(QP, SKB, 2 * h + 1, tok0, r32, hi, B);
    float va[16], vb[16]; int ia[16], ib[16];
#pragma unroll
    for (int k = 0; k < 16; ++k) { va[k] = unmono((A[k] & ~127u) | 64u); vb[k] = unmono((B[k] & ~127u) | 64u); ia[k] = 127 - (int)(A[k] & 127u); ib[k] = 127 - (int)(B[k] & 127u); }
    unsigned s[16], sp[16];
#pragma unroll
    for (int k = 0; k < 16; ++k) { s[k] = 0u; sp[k] = 0u; }
#pragma unroll
    for (int i = 0; i < 16; ++i)
#pragma unroll
        for (int j = 0; j < 16; ++j) if ((i + 1) * (j + 1) <= 16) {
            unsigned key = mono(va[i] + vb[j]); unsigned pay = (unsigned)(ia[i] * PEER_KEYS + ib[j]);
#pragma unroll
            for (int k = (i + 1) * (j + 1) - 1; k < 16; ++k) { const bool gt = key > s[k]; const unsigned ts = s[k], tp = sp[k]; s[k] = gt ? key : ts; sp[k] = gt ? pay : tp; key = gt ? ts : key; pay = gt ? tp : pay; }
            __builtin_amdgcn_sched_barrier(0);
        }
    const float mx = unmono(s[0]);
    float e[16], sum = 0.f;
#pragma unroll
    for (int k = 0; k < 16; ++k) { e[k] = __expf(unmono(s[k]) - mx); sum += e[k]; }
    const float inv = 1.f / sum;
    if (hi == 0) {
        __attribute__((address_space(3))) int* EX = (__attribute__((address_space(3))) int*)(lds3 + L_EX);
        __attribute__((address_space(3))) float* GT = (__attribute__((address_space(3))) float*)(lds3 + L_GT);
#pragma unroll
        for (int k = 0; k < 16; ++k) { EX[(h * 16 + k) * 32 + r32] = (int)sp[k]; GT[(h * 16 + k) * 32 + r32] = e[k] * inv; }
    }
}

#ifndef FP6_IDX
#define FP6_IDX(i) (((i) & 1) ? 16 + ((i) >> 1) : ((i) >> 1))
#endif
constexpr int FP6_PITCH = 3072;
typedef float v16f_t __attribute__((ext_vector_type(16)));
typedef float v32f_t __attribute__((ext_vector_type(32)));
typedef unsigned v6u_t __attribute__((ext_vector_type(6)));
__device__ __forceinline__ void cvt_row_fp6(const float* src, unsigned char* dst, float* inv_scale, int row, int lane) {
    const float* p = src + (size_t)row * 2048 + lane * 16;
    f32x4 v[8]; float am = 0.f;
#pragma unroll
    for (int j = 0; j < 2; ++j)
#pragma unroll
        for (int c = 0; c < 4; ++c) { v[4 * j + c] = *(const f32x4*)(p + j * 1024 + 4 * c);
            am = fmaxf(am, fmaxf(fmaxf(fabsf(v[4 * j + c].x), fabsf(v[4 * j + c].y)), fmaxf(fabsf(v[4 * j + c].z), fabsf(v[4 * j + c].w)))); }
    am = wave_max(am);
    const float sc = am > 0.f ? 7.f / am : 1.f;
    v16f_t a, b;
#pragma unroll
    for (int c = 0; c < 4; ++c) { a[4 * c + 0] = v[c].x * sc; a[4 * c + 1] = v[c].y * sc; a[4 * c + 2] = v[c].z * sc; a[4 * c + 3] = v[c].w * sc;
        b[4 * c + 0] = v[4 + c].x * sc; b[4 * c + 1] = v[4 + c].y * sc; b[4 * c + 2] = v[4 + c].z * sc; b[4 * c + 3] = v[4 + c].w * sc; }
    const v6u_t q = __builtin_amdgcn_cvt_scalef32_2xpk16_fp6_f32(a, b, 1.0f);
    unsigned char* d = dst + (size_t)row * FP6_PITCH;
    *(v4u*)(d + lane * 16) = (v4u){q[0], q[1], q[2], q[3]};
    *(v2u*)(d + 1024 + lane * 8) = (v2u){q[4], q[5]};
    if (lane == 0) inv_scale[row] = am > 0.f ? am / 7.f : 1.f;
}
__device__ __forceinline__ void ffn_token6(int n, int tl, int lane, const float* H, const float* SS, const float* gffn, const unsigned char* U6, const unsigned char* V6,
                                           const float* IU, const float* IV, const float* gfin, float* out, __attribute__((address_space(3))) unsigned char* lds3) {
    const __attribute__((address_space(3))) int* EX = (const __attribute__((address_space(3))) int*)(lds3 + L_EX);
    const __attribute__((address_space(3))) float* GT = (const __attribute__((address_space(3))) float*)(lds3 + L_GT);
    float xf[32];
    { const float rs_ = rsqrtf(SS[n] * (1.f / D_MODEL) + EPS);
#pragma unroll
      for (int j = 0; j < 2; ++j)
#pragma unroll
        for (int c = 0; c < 4; ++c) { const f32x4 hv_ = *(const f32x4*)(H + (size_t)n * 2048 + j * 1024 + lane * 16 + 4 * c), gv_ = *(const f32x4*)(gffn + j * 1024 + lane * 16 + 4 * c);
            xf[16 * j + 4 * c + 0] = hv_.x * rs_ * gv_.x; xf[16 * j + 4 * c + 1] = hv_.y * rs_ * gv_.y; xf[16 * j + 4 * c + 2] = hv_.z * rs_ * gv_.z; xf[16 * j + 4 * c + 3] = hv_.w * rs_ * gv_.w; } }
    float acc[32];
#pragma unroll
    for (int j = 0; j < 32; ++j) acc[j] = 0.f;
    const bool b5 = (lane & 32) != 0, b4 = (lane & 16) != 0;
#pragma unroll 1
    for (int e0 = 0; e0 < PEER_E; e0 += 4) {
        int ei[4]; float gt[4], iu[4], iv[4]; v4u ua[4], va[4]; v2u ub[4], vb[4];
#pragma unroll
        for (int k = 0; k < 4; ++k) { ei[k] = __builtin_amdgcn_readfirstlane(EX[(e0 + k) * 32 + tl]); gt[k] = GT[(e0 + k) * 32 + tl];
            const unsigned char* ur = U6 + (size_t)ei[k] * FP6_PITCH; ua[k] = *(const v4u*)(ur + lane * 16); ub[k] = *(const v2u*)(ur + 1024 + lane * 8);
            const unsigned char* vr = V6 + (size_t)ei[k] * FP6_PITCH; va[k] = *(const v4u*)(vr + lane * 16); vb[k] = *(const v2u*)(vr + 1024 + lane * 8);
            iu[k] = IU[ei[k]]; iv[k] = IV[ei[k]]; }
        float d[4];
#pragma unroll
        for (int k = 0; k < 4; ++k) { const v6u_t q = {ua[k].x, ua[k].y, ua[k].z, ua[k].w, ub[k].x, ub[k].y}; const v32f_t f = __builtin_amdgcn_cvt_scalef32_pk32_f32_fp6(q, 1.0f);
            float dk = 0.f;
#pragma unroll
            for (int i = 0; i < 32; ++i) dk += xf[FP6_IDX(i)] * f[i];
            d[k] = dk; __builtin_amdgcn_sched_barrier(0); }
        float a01 = (b5 ? d[1] : d[0]) + __shfl_xor(b5 ? d[0] : d[1], 32);
        float a23 = (b5 ? d[3] : d[2]) + __shfl_xor(b5 ? d[2] : d[3], 32);
        float t = (b4 ? a23 : a01) + __shfl_xor(b4 ? a01 : a23, 16);
        t += __shfl_xor(t, 8); t += __shfl_xor(t, 4); t += __shfl_xor(t, 2); t += __shfl_xor(t, 1);
        const float ius = b5 ? (b4 ? iu[3] : iu[1]) : (b4 ? iu[2] : iu[0]);
        const float ivs = b5 ? (b4 ? iv[3] : iv[1]) : (b4 ? iv[2] : iv[0]);
        const float gts = b5 ? (b4 ? gt[3] : gt[1]) : (b4 ? gt[2] : gt[0]);
        const float wv = gts * gelu_tanh(t * ius) * ivs;
        float w[4];
        w[0] = __uint_as_float(__builtin_amdgcn_readlane(__float_as_uint(wv), 0));
        w[2] = __uint_as_float(__builtin_amdgcn_readlane(__float_as_uint(wv), 16));
        w[1] = __uint_as_float(__builtin_amdgcn_readlane(__float_as_uint(wv), 32));
        w[3] = __uint_as_float(__builtin_amdgcn_readlane(__float_as_uint(wv), 48));
#pragma unroll
        for (int k = 0; k < 4; ++k) { const v6u_t q = {va[k].x, va[k].y, va[k].z, va[k].w, vb[k].x, vb[k].y}; const v32f_t f = __builtin_amdgcn_cvt_scalef32_pk32_f32_fp6(q, 1.0f);
#pragma unroll
            for (int i = 0; i < 32; ++i) acc[FP6_IDX(i)] += w[k] * f[i]; __builtin_amdgcn_sched_barrier(0); }
    }
    float sq = 0.f;
#pragma unroll
    for (int j = 0; j < 2; ++j)
#pragma unroll
        for (int c = 0; c < 4; ++c) { const f32x4 hv_ = *(const f32x4*)(H + (size_t)n * 2048 + j * 1024 + lane * 16 + 4 * c);
            acc[16 * j + 4 * c + 0] += hv_.x; acc[16 * j + 4 * c + 1] += hv_.y; acc[16 * j + 4 * c + 2] += hv_.z; acc[16 * j + 4 * c + 3] += hv_.w; }
#pragma unroll
    for (int j = 0; j < 32; ++j) sq += acc[j] * acc[j];
    const float r_ = rsqrtf(wave_sum(sq) * (1.f / D_MODEL) + EPS);
#pragma unroll
    for (int j = 0; j < 2; ++j)
#pragma unroll
        for (int c = 0; c < 4; ++c) { const f32x4 gv_ = *(const f32x4*)(gfin + j * 1024 + lane * 16 + 4 * c);
            *(f32x4*)(out + (size_t)n * 2048 + j * 1024 + lane * 16 + 4 * c) = (f32x4){acc[16 * j + 4 * c + 0] * r_ * gv_.x, acc[16 * j + 4 * c + 1] * r_ * gv_.y, acc[16 * j + 4 * c + 2] * r_ * gv_.z, acc[16 * j + 4 * c + 3] * r_ * gv_.w}; }
}

__device__ __forceinline__ void peer_phase(const bf16* QP, const bf16* SKB, const float* H, const float* SS, const float* gffn, const unsigned char* U8, const unsigned char* V8, const float* IU, const float* IV,
                                           const float* gfin, float* out, __attribute__((address_space(3))) unsigned char* lds3, int bid, int G) {
    int tid = threadIdx.x; asm volatile("" : "+v"(tid));
    const int lane = tid & 63, wid = __builtin_amdgcn_readfirstlane(tid >> 6);
    for (int unit = bid; unit < NTOK / 32; unit += G) {
        const int tok0 = unit * 32;
        route_head(QP, SKB, wid, tok0, lane, lds3);
        asm volatile("s_waitcnt lgkmcnt(0)" ::: "memory"); __syncthreads();
        { int ln = lane; asm volatile("" : "+v"(ln));
#pragma unroll 1
          for (int tk = 0; tk < 4; ++tk) ffn_token6(tok0 + wid * 4 + tk, wid * 4 + tk, ln, H, SS, gffn, U8, V8, IU, IV, gfin, out, lds3); }
        __syncthreads();
    }
}
#undef PEER_CE
}
constexpr int RING_BYTES = 131072, LDS_BYTES = 163840, LDSCTL_OFF = LDS_BYTES - 1024, MISC_OFF = LDSCTL_OFF + 320;
constexpr int N_PHASES = 8;
#ifndef MK_N_LAUNCHES
#define MK_N_LAUNCHES 1
#endif

__global__ void __launch_bounds__(NTHR, 2) fwd_megakernel(Args args) {
    extern __shared__ __attribute__((aligned(16))) unsigned char lds[];
    LAS unsigned char* lds3 = (LAS unsigned char*)lds;
    int tid_ = threadIdx.x; asm volatile("" : "+v"(tid_));
    const int tid = tid_, lane = tid & 63, wave = __builtin_amdgcn_readfirstlane(tid >> 6);
    const int G = gridDim.x, bid = blockIdx.x;
    unsigned char* ws = args.ws;
    unsigned* ctl = (unsigned*)(ws + WS_CTL);
    const float* x = args.in[0];
    bf16* WinT = (bf16*)(ws + WS_WIN); bf16* WbnT = (bf16*)(ws + WS_WBN); bf16* WbsT = (bf16*)(ws + WS_WBS); bf16* WoutT = (bf16*)(ws + WS_WOUT); bf16* WpqT = (bf16*)(ws + WS_WPQ);
    bf16* XN = (bf16*)(ws + WS_XN); bf16* MERGED = XN; bf16* PROJ = (bf16*)(ws + WS_PROJ);
    bf16* ONSA = (bf16*)(ws + WS_ONSA); bf16* OSB = (bf16*)(ws + WS_OSB);
    float* H = (float*)(ws + WS_H); bf16* HB = (bf16*)(ws + WS_HB);
    unsigned char* U8 = ws + WS_UB; unsigned char* V8 = ws + WS_UB + 1536; float* IU = (float*)(ws + WS_UB + 48 * MiB); float* IV = (float*)(ws + WS_VB + 48 * MiB); bf16* QP = (bf16*)(ws + WS_QP);
    int* EXPERT = (int*)(ws + WS_EXP); float* GATE = (float*)(ws + WS_GATE);
    bf16* KCB = (bf16*)(ws + WS_MISC + MISC_KCB); bf16* VCB = (bf16*)(ws + WS_MISC + MISC_VCB);
    float* SS = (float*)(ctl + CW_SS);
    float* BTG = (float*)(ws + WS_MISC + MISC_B1 + 4096);
    bf16* W1T = (bf16*)(ws + WS_MISC + MISC_W1T); float* BIAS1 = (float*)(ws + WS_MISC + MISC_B1);
    bf16* SKB = (bf16*)(ws + WS_MISC + MISC_SKB);

    for (int u = tid; u < (LDS_BYTES - LDSCTL_OFF) / 4; u += NTHR) ((LAS unsigned*)(lds3 + LDSCTL_OFF))[u] = 0u;
    __syncthreads();
    const int lo = args.ph_lo, hi = args.ph_hi;
    XcdBarrier bar; bar.bar = ctl + CW_BAR; bar.x = 0; bar.st = nullptr;
    if (hi - lo > 1) bar = xcd_barrier_post(ctl + CW_BAR, (volatile LAS unsigned*)(lds3 + MISC_OFF) + 8);
#define IN(k) (lo <= (k) && (k) < hi)
#ifndef REP_BAR
#define REP_BAR 1
#endif
#define SEAM(k) do { if (IN(k) && IN((k) + 1)) for (int rb_ = 0; rb_ < REP_BAR; ++rb_) xcd_barrier(bar); } while (0)
    const int gw = bid * NWAVES + wave, NGW = G * NWAVES;
    const int vcu = (G % 8 == 0) ? (bid % 8) * (G / 8) + bid / 8 : bid;

#if defined(TS_PHASE)
    unsigned long long ts0_ = 0;
#define TS_BEGIN(k) do { if (TS_PHASE == (k)) ts0_ = __builtin_amdgcn_s_memrealtime(); } while (0)
#define TS_END(k) do { if (TS_PHASE == (k)) { const unsigned dt_ = (unsigned)(__builtin_amdgcn_s_memrealtime() - ts0_); if (tid == 0) atomicMax(ctl + 64, dt_); } } while (0)
#else
#define TS_BEGIN(k) do {} while (0)
#define TS_END(k) do {} while (0)
#endif
#ifndef REP_P0
#define REP_P0 1
#endif
#ifndef REP_P1
#define REP_P1 1
#endif
#ifndef REP_P4
#define REP_P4 1
#endif
#ifndef REP_P6
#define REP_P6 1
#endif
#ifndef REP_P5C
#define REP_P5C 1
#endif
    TS_BEGIN(0);
    if (IN(0)) for (int rep_ = 0; rep_ < REP_P0; ++rep_) {
        LAS float* scr = (LAS float*)(lds3 + wave * 16384);
        constexpr int I_IN = (D_MODEL / 64) * ((IN_COLS + 31) / 32), I_BR = (1024 / 64) * (D_MODEL / 32), I_SQ = (D_MODEL / 64) * (D_MODEL / 32);
        constexpr int I_C1 = (2048 / 64) * (CMP_HID / 32);
        constexpr int NITEMS = I_IN + 2 * I_BR + 2 * I_SQ + 2 * I_C1;
        for (int it = gw; it < NITEMS; it += NGW) {
            int r = it;
            if (r < I_IN) { p0_transpose_item(args.in[2], D_MODEL, IN_COLS, WinT, nullptr, scr, r, lane, C_SHIFT_FROM, C_SHIFT); continue; } r -= I_IN;
            if (r < I_BR) { p0_transpose_item(args.in[10], 1024, D_MODEL, WbnT, nullptr, scr, r, lane); continue; } r -= I_BR;
            if (r < I_BR) { p0_transpose_item(args.in[11], 1024, D_MODEL, WbsT, nullptr, scr, r, lane); continue; } r -= I_BR;
            if (r < I_SQ) { p0_transpose_item(args.in[12], D_MODEL, D_MODEL, WoutT, nullptr, scr, r, lane); continue; } r -= I_SQ;
            if (r < I_SQ) { p0_transpose_item(args.in[14], D_MODEL, D_MODEL, WpqT, args.in[13], scr, r, lane); continue; } r -= I_SQ;
            if (r < I_C1) { p0_transpose_item(args.in[4], 2048, CMP_HID, W1T, nullptr, scr, r, lane); continue; } r -= I_C1;
            p0_transpose_item(args.in[7], 2048, CMP_HID, W1T + (size_t)CMP_HID * 2048, nullptr, scr, r, lane);
        }
        {
            v4u z = {0u, 0u, 0u, 0u}; bf16* p = WinT + (size_t)C_SHIFT_FROM * D_MODEL; const size_t nz = (size_t)C_SHIFT * D_MODEL;
            for (size_t i = ((size_t)bid * NTHR + tid) * 8; i < nz; i += (size_t)G * NTHR * 8) *(v4u*)(p + i) = z;
        }
        if (gw < 2 * CMP_HID) {
            const int kv = gw >> 7, j = gw & 127; const float* pe = args.in[kv ? 6 : 3]; const float* w1 = args.in[kv ? 7 : 4];
            float s = 0.f;
            for (int k2 = lane; k2 < 2048; k2 += 64) s += pe[k2] * w1[(size_t)k2 * CMP_HID + j];
            s = wave_sum(s);
            if (lane == 0) BIAS1[gw] = s;
        }
        for (int i = bid * NTHR + tid; i < 4 * 4 * 800; i += G * NTHR) { const int gq = i / 800, d = i - gq * 800; BTG[i] = args.in[9][rel_bucket(d) * 16 + gq] * 1.4426950408889634f; }
        cvt_flat(args.in[15], SKB, (size_t)16 * 128 * 128, (size_t)bid * NTHR + tid, (size_t)G * NTHR);
        for (int m = gw; m < NTOK; m += NGW) rms_row_to_bf16(x + (size_t)m * D_MODEL, args.in[1], XN + (size_t)m * D_MODEL, lane);
    }
    TS_END(0);
    SEAM(0);
    TS_BEGIN(1);
    if (IN(1)) for (int rep_ = 0; rep_ < REP_P1; ++rep_) {
        pg8::Gemm g{XN, WinT, NTOK, PLD, D_MODEL}; pg8::StaticOrder S; S.init(NTOK, PLD, G, bid);
        pg8::EpiBf16<0> E{PROJ, PP, nullptr, PP, (size_t)NTOK * PP, 1.f};
        pg8::gemm_phase<pg8::EpiBf16<0>, pg8::StaticOrder, true, true>(lds3, g, S, E);
    }
    TS_END(1);
    SEAM(1);
    TS_BEGIN(2);
    if (IN(2)) cmpr::compress_phase(PROJ, W1T, BIAS1, args.in, KCB, VCB, lds3, bid, G);
    TS_END(2);
    SEAM(2);
    TS_BEGIN(3);
    if (IN(3)) {
        TS_BEGIN(30);
        nsa::nsa_phase(PROJ, KCB, VCB, BTG, ONSA, lds3, vcu, G, args.variant);
        TS_END(30);
#if defined(PROBE_P3A)
        nsa::nsa_phase(PROJ, KCB, VCB, args.in[9], ONSA, lds3, vcu, G);
#endif
        TS_BEGIN(31);
        if (!(args.variant & 32)) nsa::stick_phase(PROJ, OSB, lds3, vcu, G);
        TS_END(31);
#if defined(PROBE_P3B)
        nsa::stick_phase(PROJ, OSB, lds3, vcu, G);
#endif
    }
    TS_END(3);
    SEAM(3);
    TS_BEGIN(4);
    if (IN(4)) for (int rep_ = 0; rep_ < REP_P4; ++rep_) {
        static_assert(WS_OSB == WS_ONSA + (size_t)NTOK * NSA_Q * 2 && WS_WBS == WS_WBN + (size_t)D_MODEL * 1024 * 2, "branch operands must be contiguous");
        pg8::Gemm g{ONSA, WbnT, 2 * NTOK, 2 * D_MODEL, 1024}; pg8::BranchOrder S; S.init(NTOK, D_MODEL, G, bid);
        pg8::EpiGate2 E{MERGED, D_MODEL, PNL(PROJ, P_GA), PNL(PROJ, P_GB), PP, (size_t)NTOK * PP - PP, NTOK / 256, D_MODEL / 256};
        pg8::gemm_phase<pg8::EpiGate2, pg8::BranchOrder, true, true>(lds3, g, S, E);
    }
    TS_END(4);
    SEAM(4);
    TS_BEGIN(5);
    if (IN(5)) {
        { pg8::Gemm g{MERGED, WoutT, NTOK, D_MODEL, D_MODEL}; pg8::StaticOrder S; S.init(NTOK, D_MODEL, G, bid);
          pg8::EpiResid E{x, H, HB, SS, D_MODEL};
          pg8::gemm_phase<pg8::EpiResid, pg8::StaticOrder, true, true>(lds3, g, S, E); }
        int t5 = threadIdx.x; asm volatile("" : "+v"(t5));
        const int lane5 = t5 & 63, gw5 = bid * NWAVES + __builtin_amdgcn_readfirstlane(t5 >> 6);
        for (int rep_ = 0; rep_ < REP_P5C; ++rep_) for (int r = gw5; r < 2 * 16384; r += NGW) { if (r < 16384) peer::cvt_row_fp6(args.in[16], U8, IU, r, lane5); else peer::cvt_row_fp6(args.in[17], V8, IV, r - 16384, lane5); }
    }
    TS_END(5);
    SEAM(5);
    TS_BEGIN(6);
    if (IN(6)) for (int rep_ = 0; rep_ < REP_P6; ++rep_) {
        pg8::Gemm g{HB, WpqT, NTOK, D_MODEL, D_MODEL}; pg8::StaticOrder S; S.init(NTOK, D_MODEL, G, bid);
        pg8::EpiRowScale E{QP, D_MODEL, SS, 1.f / D_MODEL, EPS};
        pg8::gemm_phase<pg8::EpiRowScale, pg8::StaticOrder, true, true>(lds3, g, S, E);
    }
    TS_END(6);
    SEAM(6);
    TS_BEGIN(7);
    if (IN(7)) {
        peer::peer_phase(QP, SKB, H, SS, args.in[13], U8, V8, IU, IV, args.in[18], args.out, lds3, bid, G);
    }
    TS_END(7);
#if defined(TS_PHASE)
    xcd_barrier(bar);
    if (bid == 0) { const unsigned dt_ = __hip_atomic_load(ctl + 64, RLX_AGENT); const int K_ = (int)((float)dt_ * 0.01f * 16.777216f * 2.f);
        for (int i = tid; i < K_; i += NTHR) args.out[i] += 1.0f; }
#endif
#undef IN
#undef SEAM
}

extern "C" void kernel_launch(void* const* d_in, const int* in_sizes, int n_in, void* d_out, int out_size, void* d_ws, size_t ws_size, hipStream_t stream) {
    static int grid = 0;
    if (grid == 0) {
        if (n_in != 19 || ws_size < WS_END) { fprintf(stderr, "kernel_launch: unexpected inputs (%d) or workspace (%zu < %zu)\n", n_in, ws_size, (size_t)WS_END); grid = -1; return; }
        int dev = 0, cus = 0, per_cu = 0;
        hipGetDevice(&dev); hipDeviceGetAttribute(&cus, hipDeviceAttributeMultiprocessorCount, dev);
        if (hipFuncSetAttribute((const void*)fwd_megakernel, hipFuncAttributeMaxDynamicSharedMemorySize, LDS_BYTES) != hipSuccess) { fprintf(stderr, "hipFuncSetAttribute failed\n"); grid = -1; return; }
        if (hipOccupancyMaxActiveBlocksPerMultiprocessor(&per_cu, (const void*)fwd_megakernel, NTHR, LDS_BYTES) != hipSuccess || per_cu < 1) { fprintf(stderr, "occupancy query: %d\n", per_cu); per_cu = 1; }
        (void)hipGetLastError();
        grid = cus;
        if (grid > cus * per_cu) grid = cus * per_cu;
    }
    if (grid < 0) return;
    hipMemsetAsync((char*)d_ws + WS_CTL, 0, (size_t)(CW_SS + NTOK) * 4, stream);
    Args a{};
    for (int i = 0; i < 19; ++i) a.in[i] = (const float*)d_in[i];
    a.out = (float*)d_out; a.ws = (unsigned char*)d_ws;
#if defined(PROBE_SPLIT_LO2)
#ifndef PROBE_VARIANT
#define PROBE_VARIANT 0
#endif
    {
        a.ph_lo = 0; a.ph_hi = PROBE_SPLIT_HI1; a.variant = PROBE_VARIANT; hipLaunchKernelGGL(fwd_megakernel, dim3(grid), dim3(NTHR), LDS_BYTES, stream, a);
        hipMemsetAsync((char*)d_ws + WS_CTL + CW_BAR * 4, 0, XCD_BAR_WORDS * 4, stream);
        a.ph_lo = PROBE_SPLIT_LO2; a.ph_hi = N_PHASES; a.variant = 0; hipLaunchKernelGGL(fwd_megakernel, dim3(grid), dim3(NTHR), LDS_BYTES, stream, a);
        return;
    }
#endif
    if (MK_N_LAUNCHES == 1) {
        a.ph_lo = 0; a.ph_hi = N_PHASES;
        void* kargs[] = {&a};
#if defined(USE_COOP_LAUNCH)
        hipError_t e = hipLaunchCooperativeKernel((const void*)fwd_megakernel, dim3(grid), dim3(NTHR), kargs, LDS_BYTES, stream);
        if (e != hipSuccess) fprintf(stderr, "cooperative launch failed: %s (grid %d)\n", hipGetErrorString(e), grid);
#else
        (void)kargs;
        hipLaunchKernelGGL(fwd_megakernel, dim3(grid), dim3(NTHR), LDS_BYTES, stream, a);
#endif
    } else {
        for (int p = 0; p < N_PHASES; ++p) { a.ph_lo = p; a.ph_hi = p + 1; hipLaunchKernelGGL(fwd_megakernel, dim3(grid), dim3(NTHR), LDS_BYTES, stream, a); }
    }
}
```

```cpp
#include <hip/hip_runtime.h>
#include <cstdio>
#include <cstdint>
#include <cmath>
namespace pg8 {
#define PG8_LAS __attribute__((address_space(3)))
typedef unsigned short bf16_t;
typedef short bf16x8 __attribute__((ext_vector_type(8)));
typedef float f32x4 __attribute__((ext_vector_type(4)));
typedef unsigned u32x4 __attribute__((ext_vector_type(4)));
constexpr int BM = 256, BK = 64, HALF = 128, HTB = HALF * BK * 2  , STAGE_BYTES = 8 * HTB, NXCD = 8, WGM = 8;

__host__ __device__ __forceinline__ int lds_byte(int r, int c) { const int st = (r >> 4) * 2 + (c >> 5), rr = r & 15, cc = c & 31, ob = rr * 64 + cc * 2; return st * 1024 + (ob ^ (((ob >> 9) & 1) << 5)); }
__host__ __device__ __forceinline__ void stage_rc(int b, int& R, int& C) { const int st = b / 1024, sb = b % 1024, swz = sb ^ (((sb >> 9) & 1) << 5); R = (st >> 1) * 16 + swz / 64; C = (st & 1) * 32 + (swz % 64) / 2; }
__host__ __device__ __forceinline__ int perm32(int rho) { const int n = rho >> 4, i = rho & 15; return 8 * (i >> 2) + 4 * n + (i & 3); }

struct Unit { int pm, pn; };
struct Gemm { const bf16_t* A; const bf16_t* Bt; int M, N, K; };

struct StaticOrder {
    int nM, nN, nwg, G, c;
    __host__ __device__ void init(int M, int N, int G_, int c_) { nM = M / BM; nN = N / BM; nwg = nM * nN; G = G_; c = c_; }
    __host__ __device__ bool next(int i, Unit& u) const {
        const long L = (long)i * G + c; if (L >= nwg) return false;
        int wgid = (int)L; { const int q = nwg / NXCD, r = nwg % NXCD, xcd = wgid % NXCD, off = wgid / NXCD; wgid = (xcd < r ? xcd * (q + 1) : r * (q + 1) + (xcd - r) * q) + off; }
        const int nig = WGM * nN, gid = wgid / nig, fm = gid * WGM, gsz = (nM - fm) < WGM ? (nM - fm) : WGM;
        u.pm = fm + ((wgid % nig) % gsz); u.pn = (wgid % nig) / gsz; return true;
    }
    __device__ __forceinline__ void a_ready(const Unit&) const {}
    __device__ __forceinline__ void done(const Unit&) const {}
};

__device__ __forceinline__ unsigned cvt_pk_bf16(float lo, float hi) { unsigned r; asm volatile("v_cvt_pk_bf16_f32 %0, %1, %2" : "=v"(r) : "v"(lo), "v"(hi)); return r; }
typedef float f32x2 __attribute__((ext_vector_type(2)));
__device__ __forceinline__ f32x2 gelu_pk(f32x2 v) {
    const f32x2 av = __builtin_elementwise_abs(v), d = av * 0.2316418882f + 1.0f;
    f32x2 t; t.x = __builtin_amdgcn_rcpf(d.x); t.y = __builtin_amdgcn_rcpf(d.y);
    f32x2 q = t * 0.5307027145f + (-0.7265760135f); q = q * t + 0.7107068705f; q = q * t + (-0.142248368f); q = q * t + 0.127414796f; q = q * t;
    const f32x2 s = (v * v) * (-0.72134752044f);
    f32x2 e; e.x = __builtin_amdgcn_exp2f(s.x); e.y = __builtin_amdgcn_exp2f(s.y);
    const f32x2 m = v * (q * e), r = v - m;
    f32x2 o; o.x = v.x < 0.f ? m.x : r.x; o.y = v.y < 0.f ? m.y : r.y; return o;
}

template <int ACT  > struct EpiBf16 {
    static constexpr bool PERM = true, AFTER_DRAIN = false; static_assert(ACT == 0 || ACT == 1, "EpiBf16: ACT is 0 (none) or 1 (gelu_pk)");
    bf16_t* O; int ldc; const float* bias; int split_cols; size_t split_stride; float scale0;
    __device__ __forceinline__ void operator()(const f32x4 (&acc)[2][2][4][2], const Unit& u, int wr, int wc, int fr, int fq) const {
        const int row0 = u.pm * BM + wr * 64 + fr; int colt = u.pn * BM; bf16_t* base = O;
        float sc = 1.f; if (split_cols) { const int t = colt / split_cols; base += (size_t)t * split_stride; colt -= t * split_cols; if (t == 0) sc = scale0; }
        const int col0 = colt + wc * 32 + 8 * fq, bcol0 = u.pn * BM + wc * 32 + 8 * fq;
        f32x4 bv[2][2];
#pragma unroll
        for (int bj = 0; bj < 2; ++bj)
#pragma unroll
            for (int n = 0; n < 2; ++n) bv[bj][n] = bias ? *(const f32x4*)(bias + bcol0 + bj * HALF + 4 * n) : (f32x4){0.f, 0.f, 0.f, 0.f};
#pragma unroll
        for (int ai = 0; ai < 2; ++ai)
#pragma unroll
            for (int m = 0; m < 4; ++m) { bf16_t* rowp = base + (size_t)(row0 + ai * HALF + m * 16) * ldc + col0;
#pragma unroll
                for (int bj = 0; bj < 2; ++bj) { f32x4 v0 = acc[ai][bj][m][0] + bv[bj][0], v1 = acc[ai][bj][m][1] + bv[bj][1];
                    if (ACT == 1) { f32x2 a = gelu_pk((f32x2){v0[0], v0[1]}), b = gelu_pk((f32x2){v0[2], v0[3]}), c = gelu_pk((f32x2){v1[0], v1[1]}), d = gelu_pk((f32x2){v1[2], v1[3]});
                        v0 = (f32x4){a.x, a.y, b.x, b.y}; v1 = (f32x4){c.x, c.y, d.x, d.y}; }
                    v0 = v0 * sc; v1 = v1 * sc; u32x4 w; w.x = cvt_pk_bf16(v0[0], v0[1]); w.y = cvt_pk_bf16(v0[2], v0[3]); w.z = cvt_pk_bf16(v1[0], v1[1]); w.w = cvt_pk_bf16(v1[2], v1[3]);
                    *(u32x4*)(rowp + bj * HALF) = w; } }
    }
};

struct PanelStats {
    unsigned* xbuf;
    unsigned* cnt;
    unsigned* tmo;
    int ntn; float eps;
    unsigned code;
    __device__ __forceinline__ bool run(const f32x4 (&v)[2][2][4][2], const Unit& u, int wr, int wc, int fr, int fq, PG8_LAS unsigned char* lds, int wid, int lane) const {
        typedef float f32x2v __attribute__((ext_vector_type(2)));
        PG8_LAS f32x2v* P = (PG8_LAS f32x2v*)lds;
        PG8_LAS f32x2v* S = (PG8_LAS f32x2v*)(lds + 8192);
        PG8_LAS unsigned* flag = (PG8_LAS unsigned*)(lds + 8192 + 2048);
#pragma unroll
        for (int ai = 0; ai < 2; ++ai)
#pragma unroll
            for (int m = 0; m < 4; ++m) {
                float s = 0.f;
#pragma unroll
                for (int bj = 0; bj < 2; ++bj)
#pragma unroll
                    for (int n = 0; n < 2; ++n) { const f32x4 x = v[ai][bj][m][n]; s += (x[0] + x[1]) + (x[2] + x[3]); }
                s += __shfl_xor(s, 16); s += __shfl_xor(s, 32);
                const float mw = s * (1.0f / 64.0f); float q = 0.f;
#pragma unroll
                for (int bj = 0; bj < 2; ++bj)
#pragma unroll
                    for (int n = 0; n < 2; ++n) { const f32x4 d = v[ai][bj][m][n] - mw; q += (d[0] * d[0] + d[1] * d[1]) + (d[2] * d[2] + d[3] * d[3]); }
                q += __shfl_xor(q, 16); q += __shfl_xor(q, 32);
                if (fq == 0) P[(ai * HALF + wr * 64 + m * 16 + fr) * 4 + wc] = (f32x2v){mw, q};
            }
        asm volatile("s_waitcnt lgkmcnt(0)" ::: "memory"); __builtin_amdgcn_s_barrier(); asm volatile("" ::: "memory");
#if defined(BROKEN_EXCHANGE_NO_WAIT)
#warning BROKEN CONTROL BUILD: the row-statistics exchange does not wait; results are wrong by design
        if (blockIdx.x >= 64) { const long long t0_ = clock64(); while (clock64() - t0_ < 60000) __builtin_amdgcn_s_sleep(8); }
#endif
        const int row = wid * 32 + (lane & 31);
        if (lane < 32) {
            const f32x2v a = P[row * 4 + 0], b = P[row * 4 + 1], c = P[row * 4 + 2], d = P[row * 4 + 3];
            const float mt = (a.x + b.x + c.x + d.x) * 0.25f;
            const float da = a.x - mt, db = b.x - mt, dc = c.x - mt, dd = d.x - mt;
            const float m2 = (a.y + b.y) + (c.y + d.y) + 64.0f * ((da * da + db * db) + (dc * dc + dd * dd));
            unsigned long long* slot = (unsigned long long*)xbuf + ((size_t)(u.pm * BM + row) * 4 + u.pn);
            __hip_atomic_store(slot, ((unsigned long long)__float_as_uint(m2) << 32) | __float_as_uint(mt), __ATOMIC_RELAXED, __HIP_MEMORY_SCOPE_AGENT);
        }
        asm volatile("s_waitcnt vmcnt(0)" ::: "memory");
        if (lane == 0) __hip_atomic_fetch_add(cnt + 64 * u.pm, 1u, __ATOMIC_RELAXED, __HIP_MEMORY_SCOPE_AGENT);
        if (wid == 0) {
            bool dead = false; const unsigned long long t0 = __builtin_amdgcn_s_memrealtime(); const unsigned want = 8u * (unsigned)ntn;
            for (;;) {
#if defined(BROKEN_EXCHANGE_NO_WAIT)
                break;
#endif
                if ((unsigned)__builtin_amdgcn_readfirstlane(__hip_atomic_load(cnt + 64 * u.pm, __ATOMIC_RELAXED, __HIP_MEMORY_SCOPE_AGENT)) >= want) break;
                if (__builtin_amdgcn_s_memrealtime() - t0 > 2000000ull) {
                    if (lane == 0) { unsigned expect = 0u; __hip_atomic_compare_exchange_strong(tmo + 1, &expect, code | (unsigned)(u.pm & 0xff), __ATOMIC_RELAXED, __ATOMIC_RELAXED, __HIP_MEMORY_SCOPE_AGENT);
                                     __hip_atomic_store(tmo, 1u, __ATOMIC_RELAXED, __HIP_MEMORY_SCOPE_AGENT); }
                    dead = true; break; }
                __builtin_amdgcn_s_sleep(2);
            }
            __builtin_amdgcn_fence(__ATOMIC_ACQUIRE, "agent");
            if (lane == 0) flag[0] = dead ? 1u : 0u;
        }
        asm volatile("s_waitcnt vmcnt(0) lgkmcnt(0)" ::: "memory"); __builtin_amdgcn_s_barrier(); asm volatile("" ::: "memory");
        const bool bad = flag[0] != 0u;
        if (lane < 32) {
            const unsigned long long* slot = (const unsigned long long*)xbuf + (size_t)(u.pm * BM + row) * 4; float mt[4], m2[4]; float ms = 0.f;
#pragma unroll
            for (int t = 0; t < 4; ++t) { if (t < ntn) { const unsigned long long w = __hip_atomic_load(slot + t, __ATOMIC_RELAXED, __HIP_MEMORY_SCOPE_AGENT); mt[t] = __uint_as_float((unsigned)w); m2[t] = __uint_as_float((unsigned)(w >> 32)); } else { mt[t] = 0.f; m2[t] = 0.f; } ms += mt[t]; }
            const float mean = ms / (float)ntn; float q = 0.f;
#pragma unroll
            for (int t = 0; t < 4; ++t) if (t < ntn) { const float dm = mt[t] - mean; q += m2[t] + 256.0f * dm * dm; }
            S[row] = (f32x2v){mean, 1.0f / sqrtf(q / (256.0f * (float)ntn) + eps)};
        }
        asm volatile("s_waitcnt lgkmcnt(0)" ::: "memory"); __builtin_amdgcn_s_barrier(); asm volatile("" ::: "memory");
        return bad;
    }
};
struct EpiLnRes {
    static constexpr bool PERM = false, AFTER_DRAIN = true;
    const float* base; float* out; int ldc; const float* bias; PanelStats st; unsigned poison;
    __device__ __forceinline__ void fused(f32x4 (&acc)[2][2][4][2], const Unit& u, int wr, int wc, int fr, int fq, PG8_LAS unsigned char* lds, int wid, int lane) const {
        typedef float f32x2v __attribute__((ext_vector_type(2)));
        const PG8_LAS f32x2v* S = (const PG8_LAS f32x2v*)(lds + 8192);
        const int col0 = u.pn * BM + wc * 32 + 4 * fq;
#pragma unroll
        for (int bj = 0; bj < 2; ++bj)
#pragma unroll
            for (int n = 0; n < 2; ++n) { const f32x4 bv = bias ? *(const f32x4*)(bias + col0 + bj * HALF + n * 16) : (f32x4){0.f, 0.f, 0.f, 0.f};
#pragma unroll
                for (int ai = 0; ai < 2; ++ai)
#pragma unroll
                    for (int m = 0; m < 4; ++m) acc[ai][bj][m][n] += bv; }
        f32x4 pre[4][2][2];
#pragma unroll
        for (int m = 0; m < 4; ++m) { const size_t off = (size_t)(u.pm * BM + wr * 64 + m * 16 + fr) * ldc + col0;
#pragma unroll
            for (int bj = 0; bj < 2; ++bj)
#pragma unroll
                for (int n = 0; n < 2; ++n) pre[m][bj][n] = *(const f32x4*)(base + off + bj * HALF + n * 16); }
        const bool bad = st.run(acc, u, wr, wc, fr, fq, lds, wid, lane) || poison != 0u;
        const float qnan = __builtin_nanf("");
#pragma unroll
        for (int ai = 0; ai < 2; ++ai)
#pragma unroll
            for (int m = 0; m < 4; ++m) { const int r = ai * HALF + wr * 64 + m * 16 + fr; const f32x2v sr = S[r]; const size_t off = (size_t)(u.pm * BM + r) * ldc + col0;
#pragma unroll
                for (int bj = 0; bj < 2; ++bj)
#pragma unroll
                    for (int n = 0; n < 2; ++n) { const f32x4 bs = ai == 0 ? pre[m][bj][n] : *(const f32x4*)(base + off + bj * HALF + n * 16); f32x4 o = bs + (acc[ai][bj][m][n] - sr.x) * sr.y;
                        if (bad) o = (f32x4){qnan, qnan, qnan, qnan}; *(f32x4*)(out + off + bj * HALF + n * 16) = o; }
                if (m & 1) asm volatile("" ::: "memory"); }
    }
};
struct EpiLnResLn {
    static constexpr bool PERM = false, AFTER_DRAIN = true;
    const float* base; float* out; bf16_t* xn; int ldc; const float* bias; PanelStats st1, st2; unsigned poison;
    __device__ __forceinline__ void fused(f32x4 (&acc)[2][2][4][2], const Unit& u, int wr, int wc, int fr, int fq, PG8_LAS unsigned char* lds, int wid, int lane) const {
        typedef float f32x2v __attribute__((ext_vector_type(2))); typedef unsigned u32x2v __attribute__((ext_vector_type(2)));
        const PG8_LAS f32x2v* S = (const PG8_LAS f32x2v*)(lds + 8192);
        const int col0 = u.pn * BM + wc * 32 + 4 * fq;
#pragma unroll
        for (int bj = 0; bj < 2; ++bj)
#pragma unroll
            for (int n = 0; n < 2; ++n) { const f32x4 bv = bias ? *(const f32x4*)(bias + col0 + bj * HALF + n * 16) : (f32x4){0.f, 0.f, 0.f, 0.f};
#pragma unroll
                for (int ai = 0; ai < 2; ++ai)
#pragma unroll
                    for (int m = 0; m < 4; ++m) acc[ai][bj][m][n] += bv; }
        bool bad = st1.run(acc, u, wr, wc, fr, fq, lds, wid, lane) || poison != 0u;
        const float qnan = __builtin_nanf("");
#pragma unroll
        for (int ai = 0; ai < 2; ++ai)
#pragma unroll
            for (int m = 0; m < 4; ++m) { const int r = ai * HALF + wr * 64 + m * 16 + fr; const f32x2v sr = S[r]; const size_t off = (size_t)(u.pm * BM + r) * ldc + col0;
#pragma unroll
                for (int bj = 0; bj < 2; ++bj)
#pragma unroll
                    for (int n = 0; n < 2; ++n) { const f32x4 bs = *(const f32x4*)(base + off + bj * HALF + n * 16); acc[ai][bj][m][n] = bs + (acc[ai][bj][m][n] - sr.x) * sr.y; }
                asm volatile("" : "+v"(acc[ai][0][m][0]), "+v"(acc[ai][0][m][1]), "+v"(acc[ai][1][m][0]), "+v"(acc[ai][1][m][1]));
                if (m & 1) asm volatile("" ::: "memory"); }
        const bool bad1 = bad;
        bad = st2.run(acc, u, wr, wc, fr, fq, lds, wid, lane) || bad;
#pragma unroll
        for (int ai = 0; ai < 2; ++ai)
#pragma unroll
            for (int m = 0; m < 4; ++m) { const int r = ai * HALF + wr * 64 + m * 16 + fr; const f32x2v sr = S[r]; const size_t off = (size_t)(u.pm * BM + r) * ldc + col0;
#pragma unroll
                for (int bj = 0; bj < 2; ++bj)
#pragma unroll
                    for (int n = 0; n < 2; ++n) { const f32x4 x1 = acc[ai][bj][m][n]; *(f32x4*)(out + off + bj * HALF + n * 16) = bad1 ? (f32x4){qnan, qnan, qnan, qnan} : x1;
                        const f32x4 o = (x1 - sr.x) * sr.y; u32x2v w; w.x = cvt_pk_bf16(o[0], o[1]); w.y = cvt_pk_bf16(o[2], o[3]);
                        if (bad) { w.x = 0x7fc07fc0u; w.y = 0x7fc07fc0u; } *(u32x2v*)(xn + off + bj * HALF + n * 16) = w; }
                asm volatile("" ::: "memory"); }
    }
};

template <class Epi, class Sched, bool ALIGN_EPI = false, bool SP2 = false>
__device__ __forceinline__ void gemm_phase(PG8_LAS unsigned char* lds, const Gemm g, const Sched& S, const Epi& E) {
    const int tid = threadIdx.x, wid = __builtin_amdgcn_readfirstlane(tid >> 6), lane = tid & 63, wr = wid >> 2, wc = wid & 3, fr = lane & 15, fq = lane >> 4;
    const int K = g.K, nt = K / BK;
    unsigned voffA[2], voffB[2];
#pragma unroll
    for (int i = 0; i < 2; ++i) { int R, C; stage_rc(tid * 16 + i * 8192, R, C); const int Rb = Epi::PERM ? ((R & ~31) + perm32(R & 31)) : R;
        voffA[i] = (unsigned)(R * K + C) * 2u; voffB[i] = (unsigned)(Rb * K + C) * 2u; }
    const size_t kstep = (size_t)(BK * 2);
    const size_t hstep = (size_t)HALF * K * 2;
    const size_t tstep = 2 * hstep;
    const unsigned ldsw = (unsigned)wid * 1024u;
    const int aoff = lds_byte(wr * 64 + fr, fq * 8), boff = lds_byte(wc * 32 + fr, fq * 8);
#define PG8_SA(b, h) (((b) * 2 + (h)) * HTB)
#define PG8_SB(b, h) ((4 + (b) * 2 + (h)) * HTB)
#define PG8_STAGE(bufoff, gbase, voff) do { _Pragma("unroll") for (int _i = 0; _i < 2; ++_i) \
        __builtin_amdgcn_global_load_lds((const unsigned*)((const char*)(gbase) + (voff)[_i]), (PG8_LAS unsigned*)(lds + (bufoff) + ldsw + _i * 8192), 16, 0, 0); } while (0)
#define PG8_LDA(dst, b, h) do { _Pragma("unroll") for (int m = 0; m < 4; ++m) _Pragma("unroll") for (int k = 0; k < 2; ++k) dst[m][k] = *(const PG8_LAS bf16x8*)(lds + PG8_SA(b, h) + aoff + m * 2048 + k * 1024); } while (0)
#define PG8_LDB(dst, b, h) do { _Pragma("unroll") for (int n = 0; n < 2; ++n) _Pragma("unroll") for (int k = 0; k < 2; ++k) dst[n][k] = *(const PG8_LAS bf16x8*)(lds + PG8_SB(b, h) + boff + n * 2048 + k * 1024); } while (0)
#define PG8_MMA(ai, bj, At, Bt) do { __builtin_amdgcn_s_setprio(1); _Pragma("unroll") for (int m = 0; m < 4; ++m) _Pragma("unroll") for (int n = 0; n < 2; ++n) _Pragma("unroll") for (int k = 0; k < 2; ++k) \
        acc[ai][bj][m][n] = __builtin_amdgcn_mfma_f32_16x16x32_bf16(Bt[n][k], At[m][k], acc[ai][bj][m][n], 0, 0, 0); __builtin_amdgcn_s_setprio(0); } while (0)
#define PG8_WAIT_V(n) asm volatile("s_waitcnt vmcnt(" #n ")" ::: "memory")
#define PG8_WAIT_L(n) asm volatile("s_waitcnt lgkmcnt(" #n ")" ::: "memory")
#define PG8_BAR __builtin_amdgcn_s_barrier()
#define PG8_SCHED __builtin_amdgcn_sched_barrier(0)
    Unit cur, nxt; int ui = 0;
    if (!S.next(0, cur)) return;
    f32x4 acc[2][2][4][2];
#pragma unroll
    for (int a = 0; a < 2; ++a)
#pragma unroll
        for (int b = 0; b < 2; ++b)
#pragma unroll
            for (int m = 0; m < 4; ++m)
#pragma unroll
                for (int n = 0; n < 2; ++n) acc[a][b][m][n] = (f32x4){0.f, 0.f, 0.f, 0.f};
    bf16x8 At[4][2], B0[2][2], B1[2][2];
    const char* cA = (const char*)g.A + (size_t)cur.pm * tstep; const char* cB = (const char*)g.Bt + (size_t)cur.pn * tstep;
    S.a_ready(cur);
    if constexpr (SP2) {
        PG8_STAGE(PG8_SB(0, 0), cB, voffB); PG8_STAGE(PG8_SB(0, 1), cB + hstep, voffB); PG8_STAGE(PG8_SA(0, 0), cA, voffA); PG8_STAGE(PG8_SA(0, 1), cA + hstep, voffA);
        if (wr == 1) PG8_BAR;
        PG8_WAIT_V(2); PG8_BAR;
        PG8_STAGE(PG8_SB(1, 0), cB + kstep, voffB); PG8_STAGE(PG8_SA(1, 0), cA + kstep, voffA); PG8_STAGE(PG8_SB(1, 1), cB + hstep + kstep, voffB);
        PG8_WAIT_V(6); PG8_BAR;
    } else {
        PG8_STAGE(PG8_SB(0, 0), cB, voffB); PG8_STAGE(PG8_SA(0, 0), cA, voffA); PG8_STAGE(PG8_SB(0, 1), cB + hstep, voffB); PG8_STAGE(PG8_SA(0, 1), cA + hstep, voffA);
        if (wr == 1) PG8_BAR;
        PG8_WAIT_V(4); PG8_BAR;
        PG8_STAGE(PG8_SB(1, 0), cB + kstep, voffB); PG8_STAGE(PG8_SA(1, 0), cA + kstep, voffA); PG8_STAGE(PG8_SB(1, 1), cB + hstep + kstep, voffB);
        PG8_WAIT_V(6); PG8_BAR;
    }
    for (;;) {
        const bool has_next = S.next(ui + 1, nxt);
        const char* nA = has_next ? (const char*)g.A + (size_t)nxt.pm * tstep : cA; const char* nB = has_next ? (const char*)g.Bt + (size_t)nxt.pn * tstep : cB;
        for (int t = 0; t < nt; t += 2) {
            const bool last = (t == nt - 2);
            const char* a1 = cA + (size_t)(t + 1) * kstep;
            const char* a2 = last ? nA : cA + (size_t)(t + 2) * kstep; const char* b2 = last ? nB : cB + (size_t)(t + 2) * kstep;
            const char* a3 = a2 + kstep; const char* b3 = b2 + kstep;
            if (last && has_next) S.a_ready(nxt);
            if constexpr (SP2) {
            PG8_LDB(B0, 0, 0); PG8_LDB(B1, 0, 1); PG8_SCHED; PG8_LDA(At, 0, 0); PG8_STAGE(PG8_SA(1, 1), a1 + hstep, voffA);
            PG8_WAIT_V(8); PG8_WAIT_L(0); PG8_BAR; PG8_MMA(0, 0, At, B0); PG8_MMA(0, 1, At, B1); PG8_BAR; PG8_SCHED;
            PG8_LDA(At, 0, 1); PG8_STAGE(PG8_SB(0, 0), b2, voffB); PG8_STAGE(PG8_SB(0, 1), b2 + hstep, voffB); PG8_STAGE(PG8_SA(0, 0), a2, voffA);
            PG8_WAIT_V(8); PG8_WAIT_L(0); PG8_BAR; PG8_MMA(1, 0, At, B0); PG8_MMA(1, 1, At, B1); PG8_BAR; PG8_SCHED;
            PG8_LDB(B0, 1, 0); PG8_LDB(B1, 1, 1); PG8_SCHED; PG8_LDA(At, 1, 0); PG8_STAGE(PG8_SA(0, 1), a2 + hstep, voffA);
            PG8_WAIT_V(8); PG8_WAIT_L(0); PG8_BAR; PG8_MMA(0, 0, At, B0); PG8_MMA(0, 1, At, B1); PG8_BAR; PG8_SCHED;
            PG8_LDA(At, 1, 1); PG8_STAGE(PG8_SB(1, 0), b3, voffB); PG8_STAGE(PG8_SB(1, 1), b3 + hstep, voffB); PG8_STAGE(PG8_SA(1, 0), a3, voffA);
            PG8_WAIT_V(8); PG8_WAIT_L(0); PG8_BAR; PG8_MMA(1, 0, At, B0); PG8_MMA(1, 1, At, B1); PG8_BAR; PG8_SCHED;
            } else {
            PG8_LDB(B0, 0, 0); PG8_SCHED; PG8_LDA(At, 0, 0); PG8_STAGE(PG8_SA(1, 1), a1 + hstep, voffA);
            PG8_WAIT_L(8); PG8_BAR; PG8_WAIT_L(0); PG8_MMA(0, 0, At, B0); PG8_BAR; PG8_SCHED;
            PG8_LDB(B1, 0, 1); PG8_STAGE(PG8_SB(0, 0), b2, voffB);
            PG8_BAR; PG8_WAIT_L(0); PG8_MMA(0, 1, At, B1); PG8_BAR;
            PG8_LDA(At, 0, 1); PG8_STAGE(PG8_SA(0, 0), a2, voffA);
            PG8_BAR; PG8_WAIT_L(0); PG8_MMA(1, 0, At, B0); PG8_BAR; PG8_SCHED;
            PG8_STAGE(PG8_SB(0, 1), b2 + hstep, voffB);
            PG8_WAIT_V(6); PG8_BAR; PG8_MMA(1, 1, At, B1); PG8_BAR;
            PG8_LDB(B0, 1, 0); PG8_SCHED; PG8_LDA(At, 1, 0); PG8_STAGE(PG8_SA(0, 1), a2 + hstep, voffA);
            PG8_WAIT_L(8); PG8_BAR; PG8_WAIT_L(0); PG8_MMA(0, 0, At, B0); PG8_BAR; PG8_SCHED;
            PG8_LDB(B1, 1, 1); PG8_STAGE(PG8_SB(1, 0), b3, voffB);
            PG8_BAR; PG8_WAIT_L(0); PG8_MMA(0, 1, At, B1); PG8_BAR;
            PG8_LDA(At, 1, 1); PG8_STAGE(PG8_SA(1, 0), a3, voffA);
            PG8_BAR; PG8_WAIT_L(0); PG8_MMA(1, 0, At, B0); PG8_BAR; PG8_SCHED;
            PG8_STAGE(PG8_SB(1, 1), b3 + hstep, voffB);
            PG8_WAIT_V(6); PG8_BAR; PG8_MMA(1, 1, At, B1); PG8_BAR;
            }
        }
        if constexpr (ALIGN_EPI) { if (wr == 0) PG8_BAR; }
        if constexpr (!Epi::AFTER_DRAIN) { E(acc, cur, wr, wc, fr, fq); S.done(cur); }
        if (!has_next) break;
#pragma unroll
        for (int a = 0; a < 2; ++a)
#pragma unroll
            for (int b = 0; b < 2; ++b)
#pragma unroll
                for (int m = 0; m < 4; ++m)
#pragma unroll
                    for (int n = 0; n < 2; ++n) acc[a][b][m][n] = (f32x4){0.f, 0.f, 0.f, 0.f};
        cur = nxt; cA = nA; cB = nB; ++ui;
        if constexpr (ALIGN_EPI) { if (wr == 1) PG8_BAR; }
    }
    PG8_WAIT_V(0);
    if constexpr (!ALIGN_EPI) { if (wr == 0) PG8_BAR; }
    PG8_BAR;
    if constexpr (Epi::AFTER_DRAIN) { E.fused(acc, cur, wr, wc, fr, fq, lds, wid, lane); S.done(cur); }
#undef PG8_SA
#undef PG8_SB
#undef PG8_STAGE
#undef PG8_LDA
#undef PG8_LDB
#undef PG8_MMA
#undef PG8_WAIT_V
#undef PG8_WAIT_L
#undef PG8_BAR
#undef PG8_SCHED
}
}
namespace pg8 {
__device__ __forceinline__ float bf2f(unsigned short b) { return __uint_as_float(((unsigned)b) << 16); }
__device__ __forceinline__ float bflo(unsigned w) { return __uint_as_float(w << 16); }
__device__ __forceinline__ float bfhi(unsigned w) { return __uint_as_float(w & 0xffff0000u); }
__device__ __forceinline__ float sigm(float x) { return 1.f / (1.f + __expf(-x)); }
template <int MODE> struct EpiGate {
    static constexpr bool PERM = true, AFTER_DRAIN = false;
    bf16_t* O; int ldc; const bf16_t* G; int ldg; size_t gtile;
    __device__ __forceinline__ void operator()(const f32x4 (&acc)[2][2][4][2], const Unit& u, int wr, int wc, int fr, int fq) const {
        const int row0 = u.pm * BM + wr * 64 + fr, col0 = u.pn * BM + wc * 32 + 8 * fq;
#pragma unroll
        for (int ai = 0; ai < 2; ++ai)
#pragma unroll
            for (int m = 0; m < 4; ++m) { const size_t row = (size_t)(row0 + ai * HALF + m * 16);
#pragma unroll
                for (int bj = 0; bj < 2; ++bj) {
                    const u32x4 gw = *(const u32x4*)(G + (size_t)u.pn * gtile + row * ldg + col0 + bj * HALF);
                    f32x4 v0 = acc[ai][bj][m][0], v1 = acc[ai][bj][m][1];
                    v0[0] *= sigm(bflo(gw.x)); v0[1] *= sigm(bfhi(gw.x)); v0[2] *= sigm(bflo(gw.y)); v0[3] *= sigm(bfhi(gw.y));
                    v1[0] *= sigm(bflo(gw.z)); v1[1] *= sigm(bfhi(gw.z)); v1[2] *= sigm(bflo(gw.w)); v1[3] *= sigm(bfhi(gw.w));
                    bf16_t* op = O + row * ldc + col0 + bj * HALF;
                    if (MODE == 1) { const u32x4 ow = *(const u32x4*)op;
                        v0[0] += bflo(ow.x); v0[1] += bfhi(ow.x); v0[2] += bflo(ow.y); v0[3] += bfhi(ow.y);
                        v1[0] += bflo(ow.z); v1[1] += bfhi(ow.z); v1[2] += bflo(ow.w); v1[3] += bfhi(ow.w); }
                    u32x4 w; w.x = cvt_pk_bf16(v0[0], v0[1]); w.y = cvt_pk_bf16(v0[2], v0[3]); w.z = cvt_pk_bf16(v1[0], v1[1]); w.w = cvt_pk_bf16(v1[2], v1[3]);
                    *(u32x4*)op = w; } }
    }
};
struct BranchOrder {
    StaticOrder base; int dm, dn;
    __host__ __device__ void init(int M, int N, int G_, int c_) { base.init(M, N, G_, c_); dm = M / BM; dn = N / BM; }
    __host__ __device__ bool next(int i, Unit& u) const { if (!base.next(i >> 1, u)) return false; if (i & 1) { u.pm += dm; u.pn += dn; } return true; }
    __device__ __forceinline__ void a_ready(const Unit&) const {}
    __device__ __forceinline__ void done(const Unit&) const {}
};
struct EpiGate2 {
    static constexpr bool PERM = true, AFTER_DRAIN = false;
    bf16_t* O; int ldc; const bf16_t* G0; const bf16_t* G1; int ldg; size_t gtile; int dm, dn;
    __device__ __forceinline__ void operator()(const f32x4 (&acc)[2][2][4][2], const Unit& u, int wr, int wc, int fr, int fq) const {
        const bool second = u.pm >= dm;
        Unit v = u; if (second) { v.pm -= dm; v.pn -= dn; }
        if (second) { EpiGate<1> e{O, ldc, G1, ldg, gtile}; e(acc, v, wr, wc, fr, fq); } else { EpiGate<0> e{O, ldc, G0, ldg, gtile}; e(acc, v, wr, wc, fr, fq); }
    }
};
struct EpiResid {
    static constexpr bool PERM = true, AFTER_DRAIN = false;
    const float* R; bf16_t* Hb; float* ss; int ldc;
    __device__ __forceinline__ void operator()(const f32x4 (&acc)[2][2][4][2], const Unit& u, int wr, int wc, int fr, int fq) const {
        const int row0 = u.pm * BM + wr * 64 + fr, col0 = u.pn * BM + wc * 32 + 8 * fq;
#pragma unroll
        for (int ai = 0; ai < 2; ++ai)
#pragma unroll
            for (int m = 0; m < 4; ++m) { const size_t row = (size_t)(row0 + ai * HALF + m * 16); float sq = 0.f;
#pragma unroll
                for (int bj = 0; bj < 2; ++bj) {
                    const size_t off = row * ldc + col0 + bj * HALF;
                    const f32x4 r0 = *(const f32x4*)(R + off), r1 = *(const f32x4*)(R + off + 4);
                    const f32x4 v0 = acc[ai][bj][m][0] + r0, v1 = acc[ai][bj][m][1] + r1;
                    u32x4 w; w.x = cvt_pk_bf16(v0[0], v0[1]); w.y = cvt_pk_bf16(v0[2], v0[3]); w.z = cvt_pk_bf16(v1[0], v1[1]); w.w = cvt_pk_bf16(v1[2], v1[3]);
                    *(u32x4*)(Hb + off) = w;
                    sq += (v0[0] * v0[0] + v0[1] * v0[1]) + (v0[2] * v0[2] + v0[3] * v0[3]) + (v1[0] * v1[0] + v1[1] * v1[1]) + (v1[2] * v1[2] + v1[3] * v1[3]); }
                sq += __shfl_xor(sq, 16); sq += __shfl_xor(sq, 32);
                if (fq == 0) atomicAdd(ss + row, sq); }
    }
};
struct EpiRowScale {
    static constexpr bool PERM = true, AFTER_DRAIN = false;
    bf16_t* O; int ldc; const float* ss; float inv_n, eps;
    __device__ __forceinline__ void operator()(const f32x4 (&acc)[2][2][4][2], const Unit& u, int wr, int wc, int fr, int fq) const {
        const int row0 = u.pm * BM + wr * 64 + fr, col0 = u.pn * BM + wc * 32 + 8 * fq;
#pragma unroll
        for (int ai = 0; ai < 2; ++ai)
#pragma unroll
            for (int m = 0; m < 4; ++m) { const size_t row = (size_t)(row0 + ai * HALF + m * 16);
                const float sc = rsqrtf(__hip_atomic_load(ss + row, __ATOMIC_RELAXED, __HIP_MEMORY_SCOPE_AGENT) * inv_n + eps);
#pragma unroll
                for (int bj = 0; bj < 2; ++bj) { const f32x4 v0 = acc[ai][bj][m][0] * sc, v1 = acc[ai][bj][m][1] * sc;
                    u32x4 w; w.x = cvt_pk_bf16(v0[0], v0[1]); w.y = cvt_pk_bf16(v0[2], v0[3]); w.z = cvt_pk_bf16(v1[0], v1[1]); w.w = cvt_pk_bf16(v1[2], v1[3]);
                    *(u32x4*)(O + row * ldc + col0 + bj * HALF) = w; } }
    }
};
}
constexpr int D_MODEL = 2048, BATCH = 2, SEQ = 4096, NTOK = BATCH * SEQ;
constexpr int HD = 64, NCMP = 255, CMP_STRIDE = 16, CMP_LEN = 32, CMP_HID = 128;
constexpr int SEL_LEN = 64, SEL_TOPK = 16, WINDOW = 512;
constexpr int PEER_KEYS = 128, PEER_E = 128;
constexpr int NSA_Q = 1024, SB_W = 1024;
constexpr int IN_COLS = 9776, PLD = 9984;
constexpr int C_SHIFT_FROM = 2608, C_SHIFT = 208, PP = 256;
constexpr int P_QN = 0, P_KC = 4, P_VC = 5, P_KS = 6, P_VS = 7, P_KW = 8, P_VW = 9, P_GBR = 10, P_QB = 11, P_KB = 15, P_VB = 19, P_GA = 23, P_GB = 31;
#define PNL(P, p) ((P) + (size_t)(p) * NTOK * PP)
constexpr float EPS = 1e-6f, NEGF = -1e30f;
constexpr int NWAVES = 8, NTHR = 512;

constexpr size_t MiB = 1u << 20;
constexpr size_t WS_CTL = 0, CTL_ZERO_BYTES = 1 * MiB;
constexpr size_t WS_WIN = 2 * MiB;
constexpr size_t WS_WBN = 42 * MiB, WS_WBS = 46 * MiB;
constexpr size_t WS_WOUT = 50 * MiB, WS_WPQ = 58 * MiB;
constexpr size_t WS_MISC = 66 * MiB;
constexpr size_t WS_XN = 70 * MiB;
constexpr size_t WS_PROJ = 102 * MiB;
constexpr size_t WS_ONSA = 258 * MiB, WS_OSB = 274 * MiB;
constexpr size_t WS_H = 290 * MiB;
constexpr size_t WS_HB = 354 * MiB;
constexpr size_t WS_END = 386 * MiB;
constexpr size_t WS_UB = 102 * MiB, WS_VB = 166 * MiB, WS_QP = 230 * MiB, WS_EXP = 262 * MiB, WS_GATE = 266 * MiB;
constexpr size_t MISC_KCB = 0, MISC_VCB = 1 * MiB, MISC_SKB = 2 * MiB, MISC_W1T = 2 * MiB + 512 * 1024, MISC_B1 = 3 * MiB + 512 * 1024;
constexpr int CW_BAR = 4096;
constexpr int CW_SS = 32768;

#define GAS __attribute__((address_space(1)))
#define LAS __attribute__((address_space(3)))
typedef unsigned short bf16;
typedef unsigned v4u __attribute__((ext_vector_type(4)));
typedef unsigned v2u __attribute__((ext_vector_type(2)));
typedef float f32x4 __attribute__((ext_vector_type(4)));
#define RLX_AGENT __ATOMIC_RELAXED, __HIP_MEMORY_SCOPE_AGENT
__device__ __forceinline__ unsigned f2bf(float f) { unsigned u = __builtin_bit_cast(unsigned, f); return (u + 0x7fffu + ((u >> 16) & 1u)) >> 16; }
__device__ __forceinline__ unsigned pk2(float lo, float hi) { return f2bf(lo) | (f2bf(hi) << 16); }
__device__ __forceinline__ float bf2f(bf16 b) { return __uint_as_float(((unsigned)b) << 16); }
__device__ __forceinline__ float bflo(unsigned w) { return __uint_as_float(w << 16); }
__device__ __forceinline__ float bfhi(unsigned w) { return __uint_as_float(w & 0xffff0000u); }

#define XB_TMO      128
#define XB_XCNT(j)  (256  + 64 * (j))
#define XB_XSUB(j)  (1280 + 64 * (j))
#define XB_XGEN(j)  (2304 + 64 * (j))
#define XB_TOP      3328
#define XB_TOPGEN   3392
#define XCD_BAR_WORDS 3456
#define XB_SPIN_CAP (1u << 24)
__device__ __forceinline__ unsigned xb_ld(unsigned* p)              { return __hip_atomic_load(p, __ATOMIC_RELAXED, __HIP_MEMORY_SCOPE_AGENT); }
__device__ __forceinline__ unsigned xb_add(unsigned* p, unsigned v) { return __hip_atomic_fetch_add(p, v, __ATOMIC_RELAXED, __HIP_MEMORY_SCOPE_AGENT); }
__device__ __forceinline__ unsigned xb_xcc_id() { return (unsigned)__builtin_amdgcn_s_getreg((3 << 11) | 20) & 0xFu; }
#define XB_SPIN(cond, bar) do { unsigned _sp = 0; while (cond) { __builtin_amdgcn_s_sleep(1); \
    if ((++_sp & 255u) == 0u) { if (xb_ld(&(bar)[XB_TMO])) break; if (_sp > XB_SPIN_CAP) { atomicAdd(&(bar)[XB_TMO], 1u); break; } } } } while (0)
struct XcdBarrier { unsigned* bar; unsigned x; volatile LAS unsigned* st; };
__device__ __forceinline__ XcdBarrier xcd_barrier_post(unsigned* bar, volatile LAS unsigned* st) {
    XcdBarrier b; b.bar = bar; b.x = xb_xcc_id(); b.st = st;
    if (threadIdx.x == 0) (void)xb_add(&bar[XB_XCNT(b.x)], 1u);
    return b;
}
__device__ __forceinline__ void xcd_barrier_complete(unsigned* bar, unsigned x, unsigned& nloc, unsigned& nx) {
    const unsigned G = gridDim.x * gridDim.y * gridDim.z;
    unsigned sum, cnt, mine, sp = 0u;
    for (;;) {
        sum = 0u; cnt = 0u; mine = 0u;
#pragma unroll
        for (unsigned j = 0; j < 16; ++j) { const unsigned c = xb_ld(&bar[XB_XCNT(j)]); sum += c; cnt += (c > 0u) ? 1u : 0u; mine = (j == x) ? c : mine; }
        if (sum == G) break;
        __builtin_amdgcn_s_sleep(1);
        if ((++sp & 255u) == 0u) { if (xb_ld(&bar[XB_TMO])) break; if (sp > XB_SPIN_CAP) { atomicAdd(&bar[XB_TMO], 1u); break; } }
    }
    nloc = mine > 0u ? mine : 1u; nx = cnt > 0u ? cnt : 1u;
}
__device__ __forceinline__ void xcd_barrier(const XcdBarrier& b) {
    asm volatile("s_waitcnt vmcnt(0)" ::: "memory");
    __syncthreads();
    if (threadIdx.x == 0) {
        unsigned* bar = b.bar;
        const unsigned bx = xb_xcc_id();
        __builtin_amdgcn_s_waitcnt(0);
        unsigned nloc = b.st[0], nx = b.st[1];
        if (nloc == 0u) { xcd_barrier_complete(bar, bx, nloc, nx); b.st[0] = nloc; b.st[1] = nx; }
        const unsigned old = xb_add(&bar[XB_XSUB(bx)], 1u);
        const unsigned gen = old / nloc;
        if (old + 1u == (gen + 1u) * nloc) {
            __builtin_amdgcn_fence(__ATOMIC_RELEASE, "agent");
            asm volatile("s_waitcnt vmcnt(0)" ::: "memory");
            const unsigned og = xb_add(&bar[XB_TOP], 1u);
            const unsigned tg = og / nx;
            if (og + 1u == (tg + 1u) * nx) xb_add(&bar[XB_TOPGEN], 1u);
            else XB_SPIN(xb_ld(&bar[XB_TOPGEN]) == tg, bar);
            __builtin_amdgcn_fence(__ATOMIC_ACQUIRE, "agent");
            xb_add(&bar[XB_XGEN(bx)], 1u);
            asm volatile("s_waitcnt vmcnt(0)" ::: "memory");
        } else {
            XB_SPIN(xb_ld(&bar[XB_XGEN(bx)]) == gen, bar);
            __builtin_amdgcn_fence(__ATOMIC_ACQUIRE, "agent");
            asm volatile("s_waitcnt vmcnt(0)" ::: "memory");
        }
    }
    __syncthreads();
}

__device__ __forceinline__ int rel_bucket(int d) {
    if (d < 16) return d < 0 ? 0 : d;
    int b = 16;
    b += (d >= 21); b += (d >= 27); b += (d >= 35); b += (d >= 46); b += (d >= 59); b += (d >= 77); b += (d >= 99); b += (d >= 128);
    b += (d >= 166); b += (d >= 216); b += (d >= 280); b += (d >= 363); b += (d >= 470); b += (d >= 609); b += (d >= 790);
    return b;
}
__device__ __forceinline__ float gelu_tanh(float x) { const float k = 0.7978845608028654f; return 0.5f * x * (1.f + tanhf(k * (x + 0.044715f * x * x * x))); }
__device__ __forceinline__ float sigmoidf_(float x) { return 1.f / (1.f + expf(-x)); }
__device__ __forceinline__ float wave_sum(float v) {
#pragma unroll
    for (int o = 32; o >= 1; o >>= 1) v += __shfl_xor(v, o);
    return v;
}
__device__ __forceinline__ float wave_max(float v) {
#pragma unroll
    for (int o = 32; o >= 1; o >>= 1) v = fmaxf(v, __shfl_xor(v, o));
    return v;
}
__device__ __forceinline__ float half_sum(float v, float* red) {
    v = wave_sum(v);
    __syncthreads();
    if ((threadIdx.x & 63) == 0) red[(threadIdx.x >> 6) & 3] = v;
    __syncthreads();
    return red[0] + red[1] + red[2] + red[3];
}
__device__ __forceinline__ float half_max(float v, float* red) {
    v = wave_max(v);
    __syncthreads();
    if ((threadIdx.x & 63) == 0) red[(threadIdx.x >> 6) & 3] = v;
    __syncthreads();
    return fmaxf(fmaxf(red[0], red[1]), fmaxf(red[2], red[3]));
}

struct Args {
    const float* in[19]; float* out; unsigned char* ws; int ph_lo, ph_hi; int variant, pad;
};

__device__ __forceinline__ void p0_transpose_item(const float* W, int K, int N, bf16* WT, const float* gk, LAS float* scr, int item, int lane, int shift_from = 0x7fffffff, int shift = 0) {
    const int nblk = (N + 31) / 32, kb = item / nblk, nb = item % nblk, k0 = 64 * kb, n0 = 32 * nb;
    const int c4 = (lane & 7) * 4, r8 = lane >> 3;
    const bool cok = (n0 + c4) < N;
    f32x4 v[8];
#pragma unroll
    for (int i = 0; i < 8; ++i) { const int kk = 8 * i + r8; v[i] = cok ? *(const f32x4*)(W + (size_t)(k0 + kk) * N + n0 + c4) : (f32x4){0.f, 0.f, 0.f, 0.f}; }
#pragma unroll
    for (int i = 0; i < 8; ++i) { const int kk = 8 * i + r8; const float g = gk ? gk[k0 + kk] : 1.f;
        scr[kk * 33 + c4 + 0] = v[i].x * g; scr[kk * 33 + c4 + 1] = v[i].y * g; scr[kk * 33 + c4 + 2] = v[i].z * g; scr[kk * 33 + c4 + 3] = v[i].w * g; }
    asm volatile("s_waitcnt lgkmcnt(0)" ::: "memory");
    const int c = lane & 7;
#pragma unroll
    for (int j = 0; j < 4; ++j) { const int n = (lane >> 3) + 8 * j; const LAS float* s = scr + (8 * c) * 33 + n;
        v4u o; o.x = pk2(s[0 * 33], s[1 * 33]); o.y = pk2(s[2 * 33], s[3 * 33]); o.z = pk2(s[4 * 33], s[5 * 33]); o.w = pk2(s[6 * 33], s[7 * 33]);
        const int nd = n0 + n + ((n0 + n >= shift_from) ? shift : 0);
        if (n0 + n < N) *(v4u*)(WT + (size_t)nd * K + k0 + 8 * c) = o; }
    asm volatile("s_waitcnt lgkmcnt(0)" ::: "memory");
}
__device__ __forceinline__ void rms_row_to_bf16(const float* xrow, const float* g, bf16* orow, int lane) {
    const f32x4* xr = (const f32x4*)xrow + lane; const f32x4* gr = (const f32x4*)g + lane;
    f32x4 v[8]; float s = 0.f;
#pragma unroll
    for (int j = 0; j < 8; ++j) { v[j] = xr[64 * j]; s += (v[j].x * v[j].x + v[j].y * v[j].y) + (v[j].z * v[j].z + v[j].w * v[j].w); }
    const float r = rsqrtf(wave_sum(s) * (1.f / D_MODEL) + EPS);
    v2u* o8 = (v2u*)orow + lane;
#pragma unroll
    for (int j = 0; j < 8; ++j) { const f32x4 gv = gr[64 * j]; v2u w; w.x = pk2(v[j].x * r * gv.x, v[j].y * r * gv.y); w.y = pk2(v[j].z * r * gv.z, v[j].w * r * gv.w); o8[64 * j] = w; }
}
__device__ __forceinline__ void cvt_flat(const float* src, bf16* dst, size_t n, size_t gthread, size_t nthreads) {
    for (size_t i = gthread * 8; i < n; i += nthreads * 8) {
        const f32x4 a = *(const f32x4*)(src + i), b = *(const f32x4*)(src + i + 4);
        v4u o; o.x = pk2(a.x, a.y); o.y = pk2(a.z, a.w); o.z = pk2(b.x, b.y); o.w = pk2(b.z, b.w);
        *(v4u*)(dst + i) = o;
    }
}
namespace cmpr {
typedef short bf16x8 __attribute__((ext_vector_type(8)));
typedef float f32x4v __attribute__((ext_vector_type(4)));
__device__ __forceinline__ void compress_phase(const bf16* PROJ, const bf16* W1T, const float* BIAS1, const float* const* in, bf16* KCB, bf16* VCB,
                                               __attribute__((address_space(3))) unsigned char* lds3, int bid, int G) {
    int tid = threadIdx.x; asm volatile("" : "+v"(tid));
    const int lane = tid & 63, wid = __builtin_amdgcn_readfirstlane(tid >> 6), r16 = lane & 15, kq = lane >> 4;
    __attribute__((address_space(3))) float* PART = (__attribute__((address_space(3))) float*)lds3;
    __attribute__((address_space(3))) float* HID = (__attribute__((address_space(3))) float*)(lds3 + 65536);
    __attribute__((address_space(3))) float* W2S = (__attribute__((address_space(3))) float*)(lds3 + 73728);
    for (int unit = bid; unit < 256; unit += G) {
        const int c = unit & 15, g = (unit >> 4) & 3, b = (unit >> 6) & 1, kv = unit >> 7, n0 = 16 * c;
        int nn = n0 + r16; if (nn > NCMP - 1) nn = NCMP - 1;
        const bf16* ap = PNL(PROJ, kv ? P_VC : P_KC) + (size_t)(b * SEQ + 16 * nn + 4 * wid) * PP + g * HD + 8 * kq;
        const bf16* bp = W1T + (size_t)kv * CMP_HID * 2048 + (size_t)r16 * 2048 + 256 * wid + 8 * kq;
        { const float* w2g = in[kv ? 8 : 5];
#pragma unroll
          for (int i = 0; i < 4; ++i) *(__attribute__((address_space(3))) f32x4v*)(W2S + (tid + NTHR * i) * 4) = *(const f32x4v*)(w2g + (tid + NTHR * i) * 4); }
        f32x4v acc[8] = {};
        bf16x8 af[8];
#pragma unroll
        for (int ks = 0; ks < 8; ++ks) af[ks] = *(const bf16x8*)(ap + (size_t)(ks >> 1) * PP + (ks & 1) * 32);
        bf16x8 wa[8], wb[8];
#define CMP_LOADW(W, KS) do { _Pragma("unroll") for (int nt = 0; nt < 8; ++nt) W[nt] = *(const bf16x8*)(bp + (size_t)nt * 16 * 2048 + (KS) * 32); } while (0)
#define CMP_MMA(W, KS) do { _Pragma("unroll") for (int nt = 0; nt < 8; ++nt) acc[nt] = __builtin_amdgcn_mfma_f32_16x16x32_bf16(af[KS], W[nt], acc[nt], 0, 0, 0); } while (0)
        CMP_LOADW(wa, 0);
#pragma unroll
        for (int ks = 0; ks < 8; ks += 2) {
            CMP_LOADW(wb, ks + 1); __builtin_amdgcn_sched_barrier(0);
            CMP_MMA(wa, ks); __builtin_amdgcn_sched_barrier(0);
            if (ks + 2 < 8) CMP_LOADW(wa, ks + 2);
            __builtin_amdgcn_sched_barrier(0);
            CMP_MMA(wb, ks + 1); __builtin_amdgcn_sched_barrier(0);
        }
#undef CMP_LOADW
#undef CMP_MMA
#pragma unroll
        for (int nt = 0; nt < 8; ++nt)
#pragma unroll
            for (int r = 0; r < 4; ++r) PART[wid * 2048 + (kq * 4 + r) * 128 + nt * 16 + r16] = acc[nt][r];
        asm volatile("s_waitcnt lgkmcnt(0)" ::: "memory"); __syncthreads();
#pragma unroll
        for (int i = 0; i < 4; ++i) { const int e = tid + NTHR * i; float s = BIAS1[kv * CMP_HID + (e & 127)];
#pragma unroll
            for (int w = 0; w < 8; ++w) s += PART[w * 2048 + e];
            HID[e] = gelu_tanh(s); }
        asm volatile("s_waitcnt lgkmcnt(0)" ::: "memory"); __syncthreads();
        {
            const int nl = tid >> 5, d = (tid & 31) * 2;
            float o0 = 0.f, o1 = 0.f;
#pragma unroll 8
            for (int j = 0; j < CMP_HID; ++j) { const float hv = HID[nl * 128 + j]; const float wx = W2S[j * HD + d], wy = W2S[j * HD + d + 1]; o0 += hv * wx; o1 += hv * wy; }
            const int n = n0 + nl;
            const unsigned pk = (n < NCMP) ? pk2(o0, o1) : 0u;
            *(unsigned*)((kv ? VCB : KCB) + (size_t)((b * 4 + g) * 256 + n) * HD + d) = pk;
        }
        __syncthreads();
    }
}
}
#ifndef NSA_FAR
#define NSA_FAR 1
#endif
namespace nsa {
typedef short bf16x8 __attribute__((ext_vector_type(8)));
typedef short s16x4 __attribute__((ext_vector_type(4)));
typedef float f32x16 __attribute__((ext_vector_type(16)));
typedef unsigned u32x4 __attribute__((ext_vector_type(4)));
typedef __attribute__((address_space(3))) const char* lds_cptr;
typedef __attribute__((address_space(3))) unsigned char* lds_ptr;
constexpr int SLOTB = 16384;
constexpr int NSLOT = 4;
constexpr int L_RING = 0, L_OV = 65536, L_BT = 98304, L_WSF = 111104, L_MASK = 113152, L_MISC = 113664, L_X = 113792, L_END = L_X + 32768;
constexpr int BT_N = 800;
constexpr float LOG2E = 1.4426950408889634f, SC2 = 0.125f * LOG2E, NEG2 = -1e30f;
static_assert(L_END <= 162816, "nsa LDS map");
__device__ __forceinline__ int crow(int r, int hi) { return (r & 3) + 8 * (r >> 2) + 4 * hi; }
__device__ __forceinline__ void glds16(const void* gsrc, unsigned lds_dst) { unsigned keep;
    asm volatile("s_mov_b32 %0, m0\n\ts_mov_b32 m0, %2\n\ts_nop 0\n\tglobal_load_lds_dwordx4 %1, off\n\ts_mov_b32 m0, %0" : "=&s"(keep) : "v"(gsrc), "s"(lds_dst) : "memory"); }
typedef float f32x2_t __attribute__((ext_vector_type(2))); typedef __bf16 bf16x2_t __attribute__((ext_vector_type(2)));
__device__ __forceinline__ unsigned cvtpk_s(float lo, float hi) { f32x2_t v = {lo, hi}; bf16x2_t b = __builtin_convertvector(v, bf16x2_t); return __builtin_bit_cast(unsigned, b); }
#define NSA_WAIT_BAR(N) asm volatile("s_waitcnt vmcnt(" #N ") lgkmcnt(0)\n\ts_barrier" ::: "memory")
#define NSA_SBAR() __builtin_amdgcn_sched_barrier(0)

__device__ __forceinline__ void qkt(f32x16& p0, f32x16& p1, lds_cptr Kslot, const bf16x8* qr, int r32, int hi) {
    lds_cptr kb = Kslot + hi * 1024 + r32 * 16;
    const f32x16 z = {};
#pragma unroll
    for (int d0 = 0; d0 < 4; ++d0) {
        const bf16x8 b0 = *(const __attribute__((address_space(3))) bf16x8*)(kb + d0 * 2048);
        const bf16x8 b1 = *(const __attribute__((address_space(3))) bf16x8*)(kb + d0 * 2048 + 512);
        if (d0 == 0) { p0 = __builtin_amdgcn_mfma_f32_32x32x16_bf16(b0, qr[0], z, 0, 0, 0); p1 = __builtin_amdgcn_mfma_f32_32x32x16_bf16(b1, qr[0], z, 0, 0, 0); }
        else { p0 = __builtin_amdgcn_mfma_f32_32x32x16_bf16(b0, qr[d0], p0, 0, 0, 0); p1 = __builtin_amdgcn_mfma_f32_32x32x16_bf16(b1, qr[d0], p1, 0, 0, 0); }
    }
}
__device__ __forceinline__ void pv(f32x16* o, int vb, bf16x8 pa0, bf16x8 pa1, bf16x8 pa2, bf16x8 pa3) {
#pragma unroll
    for (int d0 = 0; d0 < 2; ++d0) { s16x4 lo[4], hi[4];
#pragma unroll
        for (int ks = 0; ks < 4; ++ks) {
            asm volatile("ds_read_b64_tr_b16 %0,%1 offset:%c2" : "=&v"(lo[ks]) : "v"(vb), "i"(d0 * 4096 + ks * 1024) : "memory");
            asm volatile("ds_read_b64_tr_b16 %0,%1 offset:%c2" : "=&v"(hi[ks]) : "v"(vb), "i"(d0 * 4096 + ks * 1024 + 512) : "memory"); }
        asm volatile("s_waitcnt lgkmcnt(0)" ::: "memory"); NSA_SBAR();
#define NSA_PK(k) (bf16x8){lo[k][0], lo[k][1], lo[k][2], lo[k][3], hi[k][0], hi[k][1], hi[k][2], hi[k][3]}
        o[d0] = __builtin_amdgcn_mfma_f32_32x32x16_bf16(pa0, NSA_PK(0), o[d0], 0, 0, 0);
        o[d0] = __builtin_amdgcn_mfma_f32_32x32x16_bf16(pa1, NSA_PK(1), o[d0], 0, 0, 0);
        o[d0] = __builtin_amdgcn_mfma_f32_32x32x16_bf16(pa2, NSA_PK(2), o[d0], 0, 0, 0);
        o[d0] = __builtin_amdgcn_mfma_f32_32x32x16_bf16(pa3, NSA_PK(3), o[d0], 0, 0, 0);
#undef NSA_PK
    }
}
__device__ __forceinline__ float rowmax32(const f32x16& p0, const f32x16& p1) {
    float a = fmaxf(p0[0], p1[0]), b = fmaxf(p0[1], p1[1]);
#pragma unroll
    for (int r = 2; r < 16; r += 2) { a = fmaxf(fmaxf(a, p0[r]), p1[r]); b = fmaxf(fmaxf(b, p0[r + 1]), p1[r + 1]); }
    a = fmaxf(a, b);
    auto rr = __builtin_amdgcn_permlane32_swap(__float_as_uint(a), __float_as_uint(a), false, false);
    return fmaxf(__uint_as_float(rr[0]), __uint_as_float(rr[1]));
}
__device__ __forceinline__ float swap_add(float v) {
    auto rr = __builtin_amdgcn_permlane32_swap(__float_as_uint(v), __float_as_uint(v), false, false);
    return __uint_as_float(rr[0]) + __uint_as_float(rr[1]);
}

struct PassCtx {
    lds_ptr lds3; unsigned lds0;
    int lane, r32, hi, wid;
    int tq;
    const __attribute__((address_space(3))) float* bt;
    __attribute__((address_space(3))) float* wsf;
    int vboff;
};

template <int MODE>
__device__ __forceinline__ void run_pass(const PassCtx& c, int NT, int first, const bf16* Kb, const bf16* Vb, int pitch, const bf16x8* qr,
                                         unsigned mask_lo, unsigned mask_hi, f32x16 (&o)[2], f32x16 (&im)[2], float& m, float& l) {
    const __attribute__((address_space(3))) unsigned char* TL = (const __attribute__((address_space(3))) unsigned char*)(c.lds3 + L_MISC);
#define NSA_TID(i) ((MODE == 0) ? (i) : (MODE == 2) ? (first + (i)) : (int)TL[NT - 1 - (i)])
#define NSA_ISSUE(i, slot) do { const int id_ = __builtin_amdgcn_readfirstlane(NSA_TID(i)); \
        const bf16* ks_ = Kb + (size_t)(64 * id_ + c.lane) * pitch + 8 * c.wid; \
        const bf16* vs_ = Vb + (size_t)(64 * id_ + 16 * (c.wid & 3) + (c.lane >> 2)) * pitch + 32 * (c.wid >> 2) + 8 * (c.lane & 3); \
        glds16(ks_, (unsigned)__builtin_amdgcn_readfirstlane(c.lds0 + L_RING + (slot) * SLOTB + c.wid * 1024)); \
        glds16(vs_, (unsigned)__builtin_amdgcn_readfirstlane(c.lds0 + L_RING + (slot) * SLOTB + 8192 + c.wid * 1024)); } while (0)
    if (NT > 0) NSA_ISSUE(0, 0);
    if (NT > 1) NSA_ISSUE(1, 1);
    if (NT > 2) NSA_ISSUE(2, 2);
    int slot = 0;
    for (int i = 0; i < NT; ++i) {
        if (i + 2 < NT) NSA_WAIT_BAR(4); else if (i + 1 < NT) NSA_WAIT_BAR(2); else NSA_WAIT_BAR(0);
        if (i + 3 < NT) { const int s3 = (slot == 0) ? 3 : slot - 1; NSA_ISSUE(i + 3, s3); }
        const int id = __builtin_amdgcn_readfirstlane(NSA_TID(i));
        f32x16 p0, p1;
        qkt(p0, p1, (lds_cptr)(c.lds3 + L_RING + slot * SLOTB), qr, c.r32, c.hi);
        const int dbase = (MODE == 0) ? (c.tq - 31 - 1024 * id) : (c.tq - 64 * id);
        bool selb = true;
        if (MODE == 1) selb = ((id < 32 ? (mask_lo >> id) : (mask_hi >> (id - 32))) & 1u) != 0u;
        float alpha, rs = 0.f;
        if (NSA_FAR && MODE == 1 && __builtin_amdgcn_readfirstlane(c.tq - c.r32) - (64 * id + 63) >= 790) {
            const float lofs = selb ? c.bt[790] : -INFINITY;
            const float mt = rowmax32(p0, p1) * SC2 + lofs;
            const float mnew = fmaxf(m, mt);
            alpha = __builtin_amdgcn_exp2f(m - mnew);
            m = mnew;
            const float off = lofs - mnew;
#pragma unroll
            for (int r = 0; r < 16; ++r) { p0[r] = __builtin_amdgcn_exp2f(p0[r] * SC2 + off); p1[r] = __builtin_amdgcn_exp2f(p1[r] * SC2 + off); rs += p0[r] + p1[r]; }
        } else {
        int dbh = dbase - ((MODE == 0) ? 64 * c.hi : 4 * c.hi);
        asm volatile("" : "+v"(dbh));
#pragma unroll
        for (int r = 0; r < 16; ++r) {
            const int d0 = dbh - ((MODE == 0) ? 16 * ((r & 3) + 8 * (r >> 2)) : ((r & 3) + 8 * (r >> 2)));
            const int d1 = (MODE == 0) ? (d0 - 512) : (d0 - 32);
            bool v0 = d0 >= 0, v1 = d1 >= 0;
            if (MODE == 2) { v0 = v0 && d0 < WINDOW; v1 = v1 && d1 < WINDOW; }
            if (MODE == 1) { v0 = v0 && selb; v1 = v1 && selb; }
            const int i0 = d0 < 0 ? 0 : (d0 > 790 ? 790 : d0), i1 = d1 < 0 ? 0 : (d1 > 790 ? 790 : d1);
            const float s0 = p0[r] * SC2 + c.bt[i0], s1 = p1[r] * SC2 + c.bt[i1];
            p0[r] = v0 ? s0 : -INFINITY; p1[r] = v1 ? s1 : -INFINITY;
        }
        const float mt = rowmax32(p0, p1);
        const float mnew = fmaxf(m, mt);
        alpha = __builtin_amdgcn_exp2f(m - mnew);
        m = mnew;
#pragma unroll
        for (int r = 0; r < 16; ++r) {
            const float e0 = __builtin_amdgcn_exp2f(p0[r] - mnew), e1 = __builtin_amdgcn_exp2f(p1[r] - mnew);
            p0[r] = e0; p1[r] = e1; rs += e0 + e1;
        }
        }
        l = l * alpha + rs;
        if (!__all(alpha == 1.f)) {
            if (c.hi == 0) c.wsf[c.r32] = alpha;
            asm volatile("s_waitcnt lgkmcnt(0)" ::: "memory");
#pragma unroll
            for (int r = 0; r < 16; ++r) { const float a = c.wsf[crow(r, c.hi)]; o[0][r] *= a; o[1][r] *= a; if (MODE == 0) { im[0][r] *= a; im[1][r] *= a; } }
        }
        u32x4 pw0, pw1, pw2, pw3;
        pw0 = (u32x4){cvtpk_s(p0[0], p0[1]), cvtpk_s(p0[2], p0[3]), cvtpk_s(p0[4], p0[5]), cvtpk_s(p0[6], p0[7])};
        pw1 = (u32x4){cvtpk_s(p0[8], p0[9]), cvtpk_s(p0[10], p0[11]), cvtpk_s(p0[12], p0[13]), cvtpk_s(p0[14], p0[15])};
        pw2 = (u32x4){cvtpk_s(p1[0], p1[1]), cvtpk_s(p1[2], p1[3]), cvtpk_s(p1[4], p1[5]), cvtpk_s(p1[6], p1[7])};
        pw3 = (u32x4){cvtpk_s(p1[8], p1[9]), cvtpk_s(p1[10], p1[11]), cvtpk_s(p1[12], p1[13]), cvtpk_s(p1[14], p1[15])};
        NSA_SBAR();
        pv(o, (int)(c.lds0 + L_RING + slot * SLOTB + 8192) + c.vboff, __builtin_bit_cast(bf16x8, pw0), __builtin_bit_cast(bf16x8, pw1), __builtin_bit_cast(bf16x8, pw2), __builtin_bit_cast(bf16x8, pw3));
        if (MODE == 0) pv(im, (int)(c.lds0 + L_OV + id * 8192) + c.vboff, __builtin_bit_cast(bf16x8, pw0), __builtin_bit_cast(bf16x8, pw1), __builtin_bit_cast(bf16x8, pw2), __builtin_bit_cast(bf16x8, pw3));
        slot = (slot == NSLOT - 1) ? 0 : slot + 1;
    }
    asm volatile("s_waitcnt vmcnt(0) lgkmcnt(0)\n\ts_barrier" ::: "memory");
#undef NSA_TID
#undef NSA_ISSUE
}

__device__ __forceinline__ void build_ov(lds_ptr lds3) {
    for (int idx = threadIdx.x; idx < 4 * 4096; idx += NTHR) {
        const int kt = idx >> 12, nl = (idx >> 6) & 63, jc = idx & 63, n = 64 * kt + nl;
        unsigned short v = 0;
        if ((n & 3) != 3) { if (jc == (n >> 2)) v = 0x3F80; } else { if (jc == (n >> 2) || jc == (n >> 2) + 1) v = 0x3F00; }
        *(__attribute__((address_space(3))) unsigned short*)(lds3 + L_OV + kt * 8192 + ((jc >> 5) * 4 + (nl >> 4)) * 1024 + (nl & 15) * 64 + (jc & 31) * 2) = v;
    }
}

__device__ __forceinline__ void nsa_unit(int variant, bool build_bt, int b, int g, int qt, const bf16* PROJ, const bf16* KCBb, const bf16* VCBb, const float* rel, bf16* ONSA, lds_ptr lds3, unsigned lds0) {
    const int tid = threadIdx.x, lane = tid & 63, r32 = lane & 31, hi = lane >> 5;
    const int wid = __builtin_amdgcn_readfirstlane(tid >> 6), hh = wid & 3, th = wid >> 2;
    const int t0 = qt * 64, tq = t0 + 32 * th + r32, cur = qt;
    __attribute__((address_space(3))) float* BT = (__attribute__((address_space(3))) float*)(lds3 + L_BT);
    __attribute__((address_space(3))) unsigned* MASK = (__attribute__((address_space(3))) unsigned*)(lds3 + L_MASK);
    if (build_bt) for (int i = tid; i < 4 * BT_N; i += NTHR) BT[i] = rel[g * 4 * BT_N + i];
    if (tid < 128) MASK[tid] = 0u;
    PassCtx c; c.lds3 = lds3; c.lds0 = lds0; c.lane = lane; c.r32 = r32; c.hi = hi; c.wid = wid; c.tq = tq;
    c.bt = BT + hh * BT_N; c.wsf = (__attribute__((address_space(3))) float*)(lds3 + L_WSF) + wid * 64;
    c.vboff = ((lane >> 4) & 1) * 32 + (lane & 3) * 8 + (4 * hi + ((lane & 15) >> 2)) * 64;
    const size_t qrow = (size_t)(b * SEQ + tq) * PP;
    bf16x8 qr[4];
#pragma unroll
    for (int d0 = 0; d0 < 4; ++d0) qr[d0] = *(const bf16x8*)(PNL(PROJ, P_QN + g) + qrow + hh * HD + d0 * 16 + hi * 8);
    const float gate0 = 1.f / (1.f + __expf(-bf2f(PNL(PROJ, P_GBR)[qrow + 0 * 16 + g * 4 + hh])));
    const float gate1 = 1.f / (1.f + __expf(-bf2f(PNL(PROJ, P_GBR)[qrow + 1 * 16 + g * 4 + hh])));
    const float gate2 = 1.f / (1.f + __expf(-bf2f(PNL(PROJ, P_GBR)[qrow + 2 * 16 + g * 4 + hh])));
    asm volatile("s_waitcnt vmcnt(0) lgkmcnt(0)" ::: "memory");
    __syncthreads();
    f32x16 oc[2] = {}, o[2] = {}, im[2] = {};
    float m = NEG2, l = 0.f;
    {
        int cnt = (t0 + 32) / 16 + 1; if (cnt > NCMP) cnt = NCMP;
        const int NT = (variant & 4) ? 0 : ((cnt + 63) >> 6);
#if defined(PROBE_NSA_CMP2)
        run_pass<0>(c, NT, 0, KCBb + (size_t)(b * 4 + g) * 256 * HD, VCBb + (size_t)(b * 4 + g) * 256 * HD, HD, qr, 0u, 0u, o, im, m, l);
        o[0] = f32x16{}; o[1] = f32x16{}; im[0] = f32x16{}; im[1] = f32x16{}; m = NEG2; l = 0.f;
#endif
        run_pass<0>(c, NT, 0, KCBb + (size_t)(b * 4 + g) * 256 * HD, VCBb + (size_t)(b * 4 + g) * 256 * HD, HD, qr, 0u, 0u, o, im, m, l);
        const float lt = swap_add(l);
        const float inv = lt > 0.f ? 1.f / lt : 0.f;
        if (hi == 0) { c.wsf[r32] = inv * gate0; c.wsf[32 + r32] = inv; }
        asm volatile("s_waitcnt lgkmcnt(0)" ::: "memory");
#pragma unroll
        for (int r = 0; r < 16; ++r) { const float a = c.wsf[crow(r, hi)], a2 = c.wsf[32 + crow(r, hi)]; oc[0][r] = o[0][r] * a; oc[1][r] = o[1][r] * a; im[0][r] *= a2; im[1][r] *= a2; }
        if (!(variant & 8)) {
        {
            __attribute__((address_space(3))) float* PW = (__attribute__((address_space(3))) float*)(lds3 + L_RING) + wid * 2048;
#pragma unroll
            for (int d0 = 0; d0 < 2; ++d0)
#pragma unroll
                for (int r = 0; r < 16; ++r) PW[crow(r, hi) * 64 + d0 * 32 + r32] = im[d0][r];
        }
        asm volatile("s_waitcnt lgkmcnt(0)" ::: "memory"); __syncthreads();
        __attribute__((address_space(3))) float* T = (__attribute__((address_space(3))) float*)(lds3 + L_X);
        {
            const __attribute__((address_space(3))) float* PA = (const __attribute__((address_space(3))) float*)(lds3 + L_RING);
            int tx = tid; asm volatile("" : "+v"(tx));
            const int j = tx & 63, tb = (tx >> 6) * 8;
#pragma unroll
            for (int e = 0; e < 8; ++e) { const int tok = tb + e, w0 = (tok >> 5) * 4, q = tok & 31;
                T[tok * 65 + j] = (PA[(w0 + 0) * 2048 + q * 64 + j] + PA[(w0 + 1) * 2048 + q * 64 + j]) + (PA[(w0 + 2) * 2048 + q * 64 + j] + PA[(w0 + 3) * 2048 + q * 64 + j]); }
        }
        asm volatile("s_waitcnt lgkmcnt(0)" ::: "memory"); __syncthreads();
        {
            int ty = tid; asm volatile("" : "+v"(ty));
            const int tok = ty & 63, jg = wid, jlo = 8 * jg;
            float v[8]; int rank[8];
#pragma unroll
            for (int e = 0; e < 8; ++e) { const int j = jlo + e; const bool forced = (j == 0) || (j == cur) || (j == cur - 1);
                v[e] = (j <= cur) ? T[tok * 65 + j] + (forced ? 1e4f : 0.f) : -INFINITY; rank[e] = 0; }
            const int nA = jlo < cur + 1 ? jlo : cur + 1, nB = (jlo + 8) < cur + 1 ? (jlo + 8) : cur + 1;
#pragma unroll 2
            for (int j2 = 0; j2 < nA; ++j2) {
                const float sv = T[tok * 65 + j2] + (((j2 == 0) || (j2 == cur) || (j2 == cur - 1)) ? 1e4f : 0.f);
#pragma unroll
                for (int e = 0; e < 8; ++e) rank[e] += (sv >= v[e]) ? 1 : 0;
            }
            for (int j2 = jlo; j2 < nB; ++j2) {
                const float sv = T[tok * 65 + j2] + (((j2 == 0) || (j2 == cur) || (j2 == cur - 1)) ? 1e4f : 0.f);
#pragma unroll
                for (int e = 0; e < 8; ++e) rank[e] += (sv > v[e] || (sv == v[e] && j2 < jlo + e)) ? 1 : 0;
            }
#pragma unroll 2
            for (int j2 = jlo + 8; j2 <= cur; ++j2) {
                const float sv = T[tok * 65 + j2] + (((j2 == 0) || (j2 == cur) || (j2 == cur - 1)) ? 1e4f : 0.f);
#pragma unroll
                for (int e = 0; e < 8; ++e) rank[e] += (sv > v[e]) ? 1 : 0;
            }
            unsigned bits = 0u;
#pragma unroll
            for (int e = 0; e < 8; ++e) { const int j = jlo + e; if (j <= cur && rank[e] < SEL_TOPK) bits |= 1u << e; }
            if (bits) atomicOr((unsigned*)(MASK + tok * 2 + (jg >> 2)), bits << ((jg & 3) * 8));
        }
        asm volatile("s_waitcnt lgkmcnt(0)" ::: "memory"); __syncthreads();
        if (wid == 0) {
            unsigned ulo = MASK[lane * 2], uhi = MASK[lane * 2 + 1];
#pragma unroll
            for (int ofs = 32; ofs >= 1; ofs >>= 1) { ulo |= __shfl_xor(ulo, ofs); uhi |= __shfl_xor(uhi, ofs); }
            {
                __attribute__((address_space(3))) unsigned char* TL = (__attribute__((address_space(3))) unsigned char*)(lds3 + L_MISC);
                const unsigned long long mm = ((unsigned long long)uhi << 32) | ulo;
                int ln = lane; asm volatile("" : "+v"(ln));
                if ((mm >> ln) & 1ull) TL[__popcll(mm & ((1ull << ln) - 1ull))] = (unsigned char)ln;
                if (lane == 0) *(__attribute__((address_space(3))) int*)(lds3 + L_MISC + 64) = __popcll(mm);
            }
        }
        asm volatile("s_waitcnt lgkmcnt(0)" ::: "memory"); __syncthreads();
        }
    }
    {
        const unsigned mlo = MASK[(32 * th + r32) * 2], mhi = MASK[(32 * th + r32) * 2 + 1];
        const int NT = (variant & 1) ? 0 : __builtin_amdgcn_readfirstlane(*(__attribute__((address_space(3))) int*)(lds3 + L_MISC + 64));
#if defined(PROBE_NSA_SEL2)
        o[0] = f32x16{}; o[1] = f32x16{}; m = NEG2; l = 0.f;
        run_pass<1>(c, NT, 0, PNL(PROJ, P_KS) + (size_t)b * SEQ * PP + g * HD, PNL(PROJ, P_VS) + (size_t)b * SEQ * PP + g * HD, PP, qr, mlo, mhi, o, im, m, l);
#endif
        o[0] = f32x16{}; o[1] = f32x16{}; m = NEG2; l = 0.f;
        run_pass<1>(c, NT, 0, PNL(PROJ, P_KS) + (size_t)b * SEQ * PP + g * HD, PNL(PROJ, P_VS) + (size_t)b * SEQ * PP + g * HD, PP, qr, mlo, mhi, o, im, m, l);
        const float lt = swap_add(l);
        const float inv = lt > 0.f ? 1.f / lt : 0.f;
        if (hi == 0) c.wsf[r32] = inv * gate1;
        asm volatile("s_waitcnt lgkmcnt(0)" ::: "memory");
#pragma unroll
        for (int r = 0; r < 16; ++r) { const float a = c.wsf[crow(r, hi)]; oc[0][r] += o[0][r] * a; oc[1][r] += o[1][r] * a; }
    }
    {
        const int jlo = (qt - 8) > 0 ? (qt - 8) : 0, NT = (variant & 2) ? 0 : (qt - jlo + 1);
#if defined(PROBE_NSA_WIN2)
        o[0] = f32x16{}; o[1] = f32x16{}; m = NEG2; l = 0.f;
        run_pass<2>(c, NT, jlo, PNL(PROJ, P_KW) + (size_t)b * SEQ * PP + g * HD, PNL(PROJ, P_VW) + (size_t)b * SEQ * PP + g * HD, PP, qr, 0u, 0u, o, im, m, l);
#endif
        o[0] = f32x16{}; o[1] = f32x16{}; m = NEG2; l = 0.f;
        run_pass<2>(c, NT, jlo, PNL(PROJ, P_KW) + (size_t)b * SEQ * PP + g * HD, PNL(PROJ, P_VW) + (size_t)b * SEQ * PP + g * HD, PP, qr, 0u, 0u, o, im, m, l);
        const float lt = swap_add(l);
        const float inv = lt > 0.f ? 1.f / lt : 0.f;
        if (hi == 0) c.wsf[r32] = inv * gate2;
        asm volatile("s_waitcnt lgkmcnt(0)" ::: "memory");
#pragma unroll
        for (int r = 0; r < 16; ++r) { const float a = c.wsf[crow(r, hi)]; oc[0][r] += o[0][r] * a; oc[1][r] += o[1][r] * a; }
    }
    {
        __attribute__((address_space(3))) unsigned short* stg = (__attribute__((address_space(3))) unsigned short*)(lds3 + L_X) + wid * 2048;
#pragma unroll
        for (int r = 0; r < 16; ++r) { const int orow = crow(r, hi);
#pragma unroll
            for (int d0 = 0; d0 < 2; ++d0) stg[orow * 64 + d0 * 32 + r32] = (unsigned short)f2bf(oc[d0][r]); }
        asm volatile("s_waitcnt lgkmcnt(0)" ::: "memory");
        bf16* Ow = ONSA + (size_t)(b * SEQ + t0 + 32 * th) * NSA_Q + (g * 4 + hh) * HD;
#pragma unroll
        for (int i = 0; i < 4; ++i) { const int row = i * 8 + (lane >> 3), ch = lane & 7;
            const u32x4 vv = *(const __attribute__((address_space(3))) u32x4*)(stg + row * 64 + ch * 8);
            *(u32x4*)(Ow + (size_t)row * NSA_Q + ch * 8) = vv; }
    }
    asm volatile("s_waitcnt vmcnt(0) lgkmcnt(0)" ::: "memory");
    __syncthreads();
}

__device__ __forceinline__ void nsa_phase(const bf16* PROJ, const bf16* KCBb, const bf16* VCBb, const float* rel, bf16* ONSA, lds_ptr lds3, int vcu, int G, int variant) {
    const unsigned lds0 = (unsigned)(uintptr_t)lds3;
    build_ov(lds3);
    __syncthreads();
    int last_g = -1;
#ifndef NSA_REP
#define NSA_REP 1
#endif
#pragma unroll 1
    for (int rep_ = 0; rep_ < NSA_REP; ++rep_)
#pragma unroll 1
    for (int i = vcu; i < 512; i += G) {
        const int k = i & 255, bg = k >> 5, s = k & 31, qt = (i < 256) ? s : 63 - s;
        if (!(variant & 16)) nsa_unit(variant, (bg & 3) != last_g, bg >> 2, bg & 3, qt, PROJ, KCBb, VCBb, rel, ONSA, lds3, lds0);
        last_g = bg & 3;
    }
}
#undef NSA_WAIT_BAR
#undef NSA_SBAR
}
namespace nsa {
constexpr float STICK_THR = 50.f, LN2F = 0.6931471805599453f;
constexpr int STK_SLOTB = 32768;
static_assert(3 * STK_SLOTB <= L_WSF, "stick ring vs the LDS words it shares with the NSA map");
#define NSA_WAIT_BAR(N) asm volatile("s_waitcnt vmcnt(" #N ") lgkmcnt(0)\n\ts_barrier" ::: "memory")
__device__ __forceinline__ void stick_unit(int tid, int b, int hp, int qb, const bf16* PROJ, bf16* OSB, lds_ptr lds3, unsigned lds0, const bf16x8 (&tri)[2]) {
    const int lane = tid & 63, r32 = lane & 31, hi = lane >> 5;
    const int wid = __builtin_amdgcn_readfirstlane(tid >> 6);
    const int hs = wid >> 2, qw = wid & 3, h = 2 * hp + hs;
    const int q0 = qb * 128, t = q0 + 32 * qw + r32;
    const bf16* Kb = PNL(PROJ, P_KB + (hp >> 1)) + (size_t)b * SEQ * PP + (hp & 1) * 128;
    const bf16* Vb = PNL(PROJ, P_VB + (hp >> 1)) + (size_t)b * SEQ * PP + (hp & 1) * 128;
    __attribute__((address_space(3))) int* DONE = (__attribute__((address_space(3))) int*)(lds3 + L_MISC);
    bf16x8 qr[4];
#pragma unroll
    for (int d0 = 0; d0 < 4; ++d0) qr[d0] = *(const bf16x8*)(PNL(PROJ, P_QB + (h >> 2)) + (size_t)(b * SEQ + t) * PP + (h & 3) * HD + d0 * 16 + hi * 8);
    if (tid < 8) DONE[tid] = 0x7fffffff;
    asm volatile("s_waitcnt vmcnt(0) lgkmcnt(0)" ::: "memory");
    __syncthreads();
    const int jhi = 2 * qb + 1, NT = jhi + 1;
    const int jw = (q0 + 32 * qw + 30) >> 6;
    const int vboff = ((lane >> 4) & 1) * 32 + (lane & 3) * 8 + (4 * hi + ((lane & 15) >> 2)) * 64;
    f32x16 o[2] = {};
    float carry = 0.f; bool mydone = false;
#define STK_ISSUE(i, slot) do { const int id_ = jhi - (i); \
        const bf16* ks_ = Kb + (size_t)(64 * id_ + lane) * PP + 8 * wid; \
        const bf16* vs_ = Vb + (size_t)(64 * id_ + 16 * (wid & 3) + (lane >> 2)) * PP + 32 * (wid >> 2) + 8 * (lane & 3); \
        glds16(ks_, (unsigned)__builtin_amdgcn_readfirstlane(lds0 + L_RING + (slot) * STK_SLOTB + wid * 1024)); \
        glds16(vs_, (unsigned)__builtin_amdgcn_readfirstlane(lds0 + L_RING + (slot) * STK_SLOTB + 8192 + wid * 1024)); \
        glds16(ks_ + 64, (unsigned)__builtin_amdgcn_readfirstlane(lds0 + L_RING + (slot) * STK_SLOTB + 16384 + wid * 1024)); \
        glds16(vs_ + 64, (unsigned)__builtin_amdgcn_readfirstlane(lds0 + L_RING + (slot) * STK_SLOTB + 24576 + wid * 1024)); } while (0)
    STK_ISSUE(0, 0);
    if (NT > 1) STK_ISSUE(1, 1);
    int slot = 0;
    for (int i = 0; i < NT; ++i) {
        if (i + 1 < NT) NSA_WAIT_BAR(4); else NSA_WAIT_BAR(0);
        bool alld = true;
#pragma unroll
        for (int w = 0; w < 8; ++w) alld = alld && (DONE[w] < i);
        if (__builtin_amdgcn_readfirstlane((int)alld)) break;
        if (i + 2 < NT) { const int s2 = (slot == 0) ? 2 : slot - 1; STK_ISSUE(i + 2, s2); }
        const int j = jhi - i;
        if (!mydone && j <= jw) {
            f32x16 p0, p1, x0, x1;
            qkt(p0, p1, (lds_cptr)(lds3 + L_RING + slot * STK_SLOTB + hs * 16384), qr, r32, hi);
            float s0 = 0.f, s1 = 0.f;
#pragma unroll
            for (int r = 0; r < 16; ++r) {
                const int pos0 = 64 * j + crow(r, hi);
                const float z0 = p0[r] * 0.125f, z1 = p1[r] * 0.125f;
                const float L0 = __builtin_amdgcn_logf(1.f + __builtin_amdgcn_exp2f(-fabsf(z0) * LOG2E)) * LN2F;
                const float L1 = __builtin_amdgcn_logf(1.f + __builtin_amdgcn_exp2f(-fabsf(z1) * LOG2E)) * LN2F;
                p0[r] = fminf(z0, 0.f) - L0; p1[r] = fminf(z1, 0.f) - L1;
                x0[r] = (pos0 < t) ? (-fmaxf(z0, 0.f) - L0) : 0.f; x1[r] = (pos0 + 32 < t) ? (-fmaxf(z1, 0.f) - L1) : 0.f;
                s0 += x0[r]; s1 += x1[r];
            }
            const float tot0 = swap_add(s0), tot1 = swap_add(s1);
            u32x4 h0a, h0b, l0a, l0b, h1a, h1b, l1a, l1b;
#define STK_SPLIT(X, HA, HB, LA, LB) do { unsigned hw_[8]; float lo_[16]; \
                _Pragma("unroll") for (int q_ = 0; q_ < 8; ++q_) { hw_[q_] = cvtpk_s(X[2 * q_], X[2 * q_ + 1]); \
                    lo_[2 * q_] = X[2 * q_] - __uint_as_float(hw_[q_] << 16); lo_[2 * q_ + 1] = X[2 * q_ + 1] - __uint_as_float(hw_[q_] & 0xffff0000u); } \
                HA = (u32x4){hw_[0], hw_[1], hw_[2], hw_[3]}; HB = (u32x4){hw_[4], hw_[5], hw_[6], hw_[7]}; \
                LA = (u32x4){cvtpk_s(lo_[0], lo_[1]), cvtpk_s(lo_[2], lo_[3]), cvtpk_s(lo_[4], lo_[5]), cvtpk_s(lo_[6], lo_[7])}; \
                LB = (u32x4){cvtpk_s(lo_[8], lo_[9]), cvtpk_s(lo_[10], lo_[11]), cvtpk_s(lo_[12], lo_[13]), cvtpk_s(lo_[14], lo_[15])}; } while (0)
            STK_SPLIT(x0, h0a, h0b, l0a, l0b);
            STK_SPLIT(x1, h1a, h1b, l1a, l1b);
#undef STK_SPLIT
            f32x16 y0, y1;
#pragma unroll
            for (int r = 0; r < 16; ++r) { y0[r] = carry + tot1; y1[r] = carry; }
            y0 = __builtin_amdgcn_mfma_f32_32x32x16_bf16(tri[0], __builtin_bit_cast(bf16x8, h0a), y0, 0, 0, 0);
            y0 = __builtin_amdgcn_mfma_f32_32x32x16_bf16(tri[1], __builtin_bit_cast(bf16x8, h0b), y0, 0, 0, 0);
            y0 = __builtin_amdgcn_mfma_f32_32x32x16_bf16(tri[0], __builtin_bit_cast(bf16x8, l0a), y0, 0, 0, 0);
            y0 = __builtin_amdgcn_mfma_f32_32x32x16_bf16(tri[1], __builtin_bit_cast(bf16x8, l0b), y0, 0, 0, 0);
            y1 = __builtin_amdgcn_mfma_f32_32x32x16_bf16(tri[0], __builtin_bit_cast(bf16x8, h1a), y1, 0, 0, 0);
            y1 = __builtin_amdgcn_mfma_f32_32x32x16_bf16(tri[1], __builtin_bit_cast(bf16x8, h1b), y1, 0, 0, 0);
            y1 = __builtin_amdgcn_mfma_f32_32x32x16_bf16(tri[0], __builtin_bit_cast(bf16x8, l1a), y1, 0, 0, 0);
            y1 = __builtin_amdgcn_mfma_f32_32x32x16_bf16(tri[1], __builtin_bit_cast(bf16x8, l1b), y1, 0, 0, 0);
#pragma unroll
            for (int r = 0; r < 16; ++r) {
                const int pos0 = 64 * j + crow(r, hi);
                y0[r] = (pos0 < t) ? __builtin_amdgcn_exp2f((p0[r] + y0[r]) * LOG2E) : 0.f;
                y1[r] = (pos0 + 32 < t) ? __builtin_amdgcn_exp2f((p1[r] + y1[r]) * LOG2E) : 0.f;
            }
            carry += tot0 + tot1;
            u32x4 pw0, pw1, pw2, pw3;
            pw0 = (u32x4){cvtpk_s(y0[0], y0[1]), cvtpk_s(y0[2], y0[3]), cvtpk_s(y0[4], y0[5]), cvtpk_s(y0[6], y0[7])};
            pw1 = (u32x4){cvtpk_s(y0[8], y0[9]), cvtpk_s(y0[10], y0[11]), cvtpk_s(y0[12], y0[13]), cvtpk_s(y0[14], y0[15])};
            pw2 = (u32x4){cvtpk_s(y1[0], y1[1]), cvtpk_s(y1[2], y1[3]), cvtpk_s(y1[4], y1[5]), cvtpk_s(y1[6], y1[7])};
            pw3 = (u32x4){cvtpk_s(y1[8], y1[9]), cvtpk_s(y1[10], y1[11]), cvtpk_s(y1[12], y1[13]), cvtpk_s(y1[14], y1[15])};
            __builtin_amdgcn_sched_barrier(0);
            pv(o, (int)(lds0 + L_RING + slot * STK_SLOTB + hs * 16384 + 8192) + vboff, __builtin_bit_cast(bf16x8, pw0), __builtin_bit_cast(bf16x8, pw1), __builtin_bit_cast(bf16x8, pw2), __builtin_bit_cast(bf16x8, pw3));
            mydone = __all(carry < -STICK_THR) != 0;
            if (mydone && lane == 0) DONE[wid] = i;
        }
        slot = (slot == 2) ? 0 : slot + 1;
    }
    asm volatile("s_waitcnt vmcnt(0) lgkmcnt(0)\n\ts_barrier" ::: "memory");
#undef STK_ISSUE
    {
        __attribute__((address_space(3))) unsigned short* stg = (__attribute__((address_space(3))) unsigned short*)(lds3 + L_X) + wid * 2048;
#pragma unroll
        for (int r = 0; r < 16; ++r) { const int orow = crow(r, hi);
#pragma unroll
            for (int d0 = 0; d0 < 2; ++d0) stg[orow * 64 + d0 * 32 + r32] = (unsigned short)f2bf(o[d0][r]); }
        asm volatile("s_waitcnt lgkmcnt(0)" ::: "memory");
        bf16* Ow = OSB + (size_t)(b * SEQ + q0 + 32 * qw) * SB_W + h * HD;
#pragma unroll
        for (int i = 0; i < 4; ++i) { const int row = i * 8 + (lane >> 3), ch = lane & 7;
            const u32x4 vv = *(const __attribute__((address_space(3))) u32x4*)(stg + row * 64 + ch * 8);
            *(u32x4*)(Ow + (size_t)row * SB_W + ch * 8) = vv; }
    }
    asm volatile("s_waitcnt vmcnt(0) lgkmcnt(0)" ::: "memory");
    __syncthreads();
}
__device__ __forceinline__ void stick_phase(const bf16* PROJ, bf16* OSB, lds_ptr lds3, int vcu, int G) {
    const unsigned lds0 = (unsigned)(uintptr_t)lds3;
    int tid = threadIdx.x; asm volatile("" : "+v"(tid));
    const int lane = tid & 63, r32 = lane & 31, hi = lane >> 5;
    bf16x8 tri[2];
#pragma unroll
    for (int s = 0; s < 2; ++s)
#pragma unroll
        for (int j = 0; j < 8; ++j) tri[s][j] = ((16 * s + 8 * (j >> 2) + 4 * hi + (j & 3)) > r32) ? (short)0x3F80 : (short)0;
    for (int i = vcu; i < 512; i += G) {
        const int bp = i >> 5, qb = i & 31;
        stick_unit(tid, bp >> 3, bp & 7, qb, PROJ, OSB, lds3, lds0, tri);
    }
}
#undef NSA_WAIT_BAR
}
namespace peer {
typedef short bf16x8 __attribute__((ext_vector_type(8)));
typedef float f32x16 __attribute__((ext_vector_type(16)));
typedef __bf16 b2_t __attribute__((ext_vector_type(2)));
constexpr int L_EX = 0, L_GT = 16384;
__device__ __forceinline__ int crow(int r, int hi) { return (r & 3) + 8 * (r >> 2) + 4 * hi; }
__device__ __forceinline__ unsigned mono(float f) { const unsigned u = __float_as_uint(f); return (u & 0x80000000u) ? ~u : (u | 0x80000000u); }
__device__ __forceinline__ float unmono(unsigned k) { return __uint_as_float((k & 0x80000000u) ? (k & 0x7fffffffu) : ~k); }
__device__ __forceinline__ float dot2(unsigned a, unsigned b, float c) { return __builtin_amdgcn_fdot2_f32_bf16(__builtin_bit_cast(b2_t, a), __builtin_bit_cast(b2_t, b), c, false); }
#define PEER_CE(key, slot) do { const unsigned hi_ = (key) > (slot) ? (key) : (slot); (key) = (key) > (slot) ? (slot) : (key); (slot) = hi_; } while (0)

__device__ __forceinline__ void route_list(const bf16* QP, const bf16* SKB, int L, int tok0, int r32, int hi, unsigned (&out)[16]) {
    f32x16 acc[4] = {};
    const bf16* qp = QP + (size_t)(tok0 + r32) * 2048 + L * 128 + hi * 8;
    const bf16* kp = SKB + ((size_t)L * 128 + r32) * 128 + hi * 8;
    int hi4 = 4 * hi;
    asm volatile("" : "+v"(qp), "+v"(kp), "+v"(hi4));
#pragma unroll
    for (int ks = 0; ks < 8; ++ks) {
        const bf16x8 bq = *(const bf16x8*)(qp + ks * 16);
#pragma unroll
        for (int kt = 0; kt < 4; ++kt) { const bf16x8 a = *(const bf16x8*)(kp + (size_t)kt * 32 * 128 + ks * 16); acc[kt] = __builtin_amdgcn_mfma_f32_32x32x16_bf16(a, bq, acc[kt], 0, 0, 0); }
    }
    unsigned t[16];
#pragma unroll
    for (int k = 0; k < 16; ++k) t[k] = 0u;
#pragma unroll
    for (int kt = 0; kt < 4; ++kt)
#pragma unroll
        for (int r = 0; r < 16; ++r) {
            unsigned key = ((mono(acc[kt][r]) & ~127u) | (unsigned)(127 - (32 * kt + (r & 3) + 8 * (r >> 2)))) - (unsigned)hi4;
#pragma unroll
            for (int k = 0; k < 16; ++k) PEER_CE(key, t[k]);
            __builtin_amdgcn_sched_barrier(0);
        }
    unsigned u[16];
#pragma unroll
    for (int k = 0; k < 16; ++k) { auto rr = __builtin_amdgcn_permlane32_swap(t[k], t[k], false, false); u[k] = hi ? rr[0] : rr[1]; }
#pragma unroll
    for (int k = 0; k < 16; ++k) out[k] = t[k] > u[15 - k] ? t[k] : u[15 - k];
#pragma unroll
    for (int st = 8; st >= 1; st >>= 1)
#pragma unroll
        for (int k = 0; k < 16; ++k) if ((k & st) == 0) { const unsigned a = out[k], b = out[k | st]; out[k] = a > b ? a : b; out[k | st] = a > b ? b : a; }
}

__device__ __forceinline__ void route_head(const bf16* QP, const bf16* SKB, int h, int tok0, int lane, __attribute__((address_space(3))) unsigned char* lds3) {
    asm volatile("" : "+v"(lane));
    const int r32 = lane & 31, hi = lane >> 5;
    unsigned A[16], B[16];
    route_list(QP, SKB, 2 * h, tok0, r32, hi, A);
    route_list(QP, SKB, 2 * h + 1, tok0, r32, hi, B);
    float va[16], vb[16]; int ia[16], ib[16];
#pragma unroll
    for (int k = 0; k < 16; ++k) { va[k] = unmono((A[k] & ~127u) | 64u); vb[k] = unmono((B[k] & ~127u) | 64u); ia[k] = 127 - (int)(A[k] & 127u); ib[k] = 127 - (int)(B[k] & 127u); }
    unsigned s[16], sp[16];
#pragma unroll
    for (int k = 0; k < 16; ++k) { s[k] = 0u; sp[k] = 0u; }
#pragma unroll
    for (int i = 0; i < 16; ++i)
#pragma unroll
        for (int j = 0; j < 16; ++j) if ((i + 1) * (j + 1) <= 16) {
            unsigned key = mono(va[i] + vb[j]); unsigned pay = (unsigned)(ia[i] * PEER_KEYS + ib[j]);
#pragma unroll
            for (int k = (i + 1) * (j + 1) - 1; k < 16; ++k) { const bool gt = key > s[k]; const unsigned ts = s[k], tp = sp[k]; s[k] = gt ? key : ts; sp[k] = gt ? pay : tp; key = gt ? ts : key; pay = gt ? tp : pay; }
            __builtin_amdgcn_sched_barrier(0);
        }
    const float mx = unmono(s[0]);
    float e[16], sum = 0.f;
#pragma unroll
    for (int k = 0; k < 16; ++k) { e[k] = __expf(unmono(s[k]) - mx); sum += e[k]; }
    const float inv = 1.f / sum;
    if (hi == 0) {
        __attribute__((address_space(3))) int* EX = (__attribute__((address_space(3))) int*)(lds3 + L_EX);
        __attribute__((address_space(3))) float* GT = (__attribute__((address_space(3))) float*)(lds3 + L_GT);
#pragma unroll
        for (int k = 0; k < 16; ++k) { EX[(h * 16 + k) * 32 + r32] = (int)sp[k]; GT[(h * 16 + k) * 32 + r32] = e[k] * inv; }
    }
}

#ifndef FP6_IDX
#define FP6_IDX(i) (((i) & 1) ? 16 + ((i) >> 1) : ((i) >> 1))
#endif
constexpr int FP6_PITCH = 3072;
typedef float v16f_t __attribute__((ext_vector_type(16)));
typedef float v32f_t __attribute__((ext_vector_type(32)));
typedef unsigned v6u_t __attribute__((ext_vector_type(6)));
__device__ __forceinline__ void cvt_row_fp6_load(const float* src, int row, int lane, f32x4 (&v)[8]) {
    const float* p = src + (size_t)row * 2048 + lane * 4;
#pragma unroll
    for (int i = 0; i < 8; ++i) v[i] = *(const f32x4*)(p + i * 256);
}
__device__ __forceinline__ void cvt_row_fp6_store(const f32x4 (&v)[8], unsigned char* dst, float* inv_scale, int row, int lane) {
    float am = 0.f;
#pragma unroll
    for (int i = 0; i < 8; ++i) am = fmaxf(am, fmaxf(fmaxf(fabsf(v[i].x), fabsf(v[i].y)), fmaxf(fabsf(v[i].z), fabsf(v[i].w))));
    am = wave_max(am);
    const float sc = am > 0.f ? 7.f / am : 1.f;
    v16f_t a, b;
#pragma unroll
    for (int c = 0; c < 4; ++c) { a[4 * c + 0] = v[c].x * sc; a[4 * c + 1] = v[c].y * sc; a[4 * c + 2] = v[c].z * sc; a[4 * c + 3] = v[c].w * sc;
        b[4 * c + 0] = v[4 + c].x * sc; b[4 * c + 1] = v[4 + c].y * sc; b[4 * c + 2] = v[4 + c].z * sc; b[4 * c + 3] = v[4 + c].w * sc; }
    const v6u_t q = __builtin_amdgcn_cvt_scalef32_2xpk16_fp6_f32(a, b, 1.0f);
    unsigned char* d = dst + (size_t)row * FP6_PITCH;
    *(v4u*)(d + lane * 16) = (v4u){q[0], q[1], q[2], q[3]};
    *(v2u*)(d + 1024 + lane * 8) = (v2u){q[4], q[5]};
    if (lane == 0) inv_scale[row] = am > 0.f ? am / 7.f : 1.f;
}
__device__ __forceinline__ void cvt_tables_fp6(const float* Uf, const float* Vf, unsigned char* U6, unsigned char* V6, float* IU, float* IV, int first, int stride, int lane) {
    f32x4 va[8], vb[8];
#define PEER_SRC(r) ((r) < 16384 ? Uf : Vf), ((r) < 16384 ? (r) : (r) - 16384)
#define PEER_DST(r) ((r) < 16384 ? U6 : V6), ((r) < 16384 ? IU : IV), ((r) < 16384 ? (r) : (r) - 16384)
    int r = first;
    if (r < 32768) cvt_row_fp6_load(PEER_SRC(r), lane, va);
#pragma unroll 1
    for (; r < 32768; r += 2 * stride) {
        const int r1 = r + stride, r2 = r + 2 * stride;
        if (r1 < 32768) cvt_row_fp6_load(PEER_SRC(r1), lane, vb);
        __builtin_amdgcn_sched_barrier(0);
        cvt_row_fp6_store(va, PEER_DST(r), lane);
        __builtin_amdgcn_sched_barrier(0);
        if (r2 < 32768) cvt_row_fp6_load(PEER_SRC(r2), lane, va);
        __builtin_amdgcn_sched_barrier(0);
        if (r1 < 32768) cvt_row_fp6_store(vb, PEER_DST(r1), lane);
        __builtin_amdgcn_sched_barrier(0);
    }
#undef PEER_SRC
#undef PEER_DST
}
__device__ __forceinline__ void ffn_token6(int n, int tl, int lane, const bf16* H, const float* SS, const float* gffn, const unsigned char* U6, const unsigned char* V6,
                                           const float* IU, const float* IV, const float* gfin, float* out, __attribute__((address_space(3))) unsigned char* lds3) {
    const __attribute__((address_space(3))) int* EX = (const __attribute__((address_space(3))) int*)(lds3 + L_EX);
    const __attribute__((address_space(3))) float* GT = (const __attribute__((address_space(3))) float*)(lds3 + L_GT);
    float xf[32];
    { const float rs_ = rsqrtf(SS[n] * (1.f / D_MODEL) + EPS);
#pragma unroll
      for (int i = 0; i < 8; ++i) { const v2u hw_ = *(const v2u*)(H + (size_t)n * 2048 + i * 256 + lane * 4); const f32x4 gv_ = *(const f32x4*)(gffn + i * 256 + lane * 4);
            xf[4 * i + 0] = bflo(hw_.x) * rs_ * gv_.x; xf[4 * i + 1] = bfhi(hw_.x) * rs_ * gv_.y; xf[4 * i + 2] = bflo(hw_.y) * rs_ * gv_.z; xf[4 * i + 3] = bfhi(hw_.y) * rs_ * gv_.w; } }
    float acc[32];
#pragma unroll
    for (int j = 0; j < 32; ++j) acc[j] = 0.f;
    const bool b5 = (lane & 32) != 0, b4 = (lane & 16) != 0;
#pragma unroll 1
    for (int e0 = 0; e0 < PEER_E; e0 += 4) {
        int ei[4]; float gt[4], iu[4], iv[4]; v4u ua[4], va[4]; v2u ub[4], vb[4];
#pragma unroll
        for (int k = 0; k < 4; ++k) { ei[k] = __builtin_amdgcn_readfirstlane(EX[(e0 + k) * 32 + tl]); gt[k] = GT[(e0 + k) * 32 + tl];
            const unsigned char* ur = U6 + (size_t)ei[k] * FP6_PITCH; ua[k] = *(const v4u*)(ur + lane * 16); ub[k] = *(const v2u*)(ur + 1024 + lane * 8);
            const unsigned char* vr = V6 + (size_t)ei[k] * FP6_PITCH; va[k] = *(const v4u*)(vr + lane * 16); vb[k] = *(const v2u*)(vr + 1024 + lane * 8);
            iu[k] = IU[ei[k]]; iv[k] = IV[ei[k]]; }
        float d[4];
#pragma unroll
        for (int k = 0; k < 4; ++k) { const v6u_t q = {ua[k].x, ua[k].y, ua[k].z, ua[k].w, ub[k].x, ub[k].y}; const v32f_t f = __builtin_amdgcn_cvt_scalef32_pk32_f32_fp6(q, 1.0f);
            float dk = 0.f;
#pragma unroll
            for (int i = 0; i < 32; ++i) dk += xf[FP6_IDX(i)] * f[i];
            d[k] = dk; __builtin_amdgcn_sched_barrier(0); }
        float a01 = (b5 ? d[1] : d[0]) + __shfl_xor(b5 ? d[0] : d[1], 32);
        float a23 = (b5 ? d[3] : d[2]) + __shfl_xor(b5 ? d[2] : d[3], 32);
        float t = (b4 ? a23 : a01) + __shfl_xor(b4 ? a01 : a23, 16);
        t += __shfl_xor(t, 8); t += __shfl_xor(t, 4); t += __shfl_xor(t, 2); t += __shfl_xor(t, 1);
        const float ius = b5 ? (b4 ? iu[3] : iu[1]) : (b4 ? iu[2] : iu[0]);
        const float ivs = b5 ? (b4 ? iv[3] : iv[1]) : (b4 ? iv[2] : iv[0]);
        const float gts = b5 ? (b4 ? gt[3] : gt[1]) : (b4 ? gt[2] : gt[0]);
        const float wv = gts * gelu_tanh(t * ius) * ivs;
        float w[4];
        w[0] = __uint_as_float(__builtin_amdgcn_readlane(__float_as_uint(wv), 0));
        w[2] = __uint_as_float(__builtin_amdgcn_readlane(__float_as_uint(wv), 16));
        w[1] = __uint_as_float(__builtin_amdgcn_readlane(__float_as_uint(wv), 32));
        w[3] = __uint_as_float(__builtin_amdgcn_readlane(__float_as_uint(wv), 48));
#pragma unroll
        for (int k = 0; k < 4; ++k) { const v6u_t q = {va[k].x, va[k].y, va[k].z, va[k].w, vb[k].x, vb[k].y}; const v32f_t f = __builtin_amdgcn_cvt_scalef32_pk32_f32_fp6(q, 1.0f);
#pragma unroll
            for (int i = 0; i < 32; ++i) acc[FP6_IDX(i)] += w[k] * f[i]; __builtin_amdgcn_sched_barrier(0); }
    }
    float sq = 0.f;
#pragma unroll
    for (int i = 0; i < 8; ++i) { const v2u hw_ = *(const v2u*)(H + (size_t)n * 2048 + i * 256 + lane * 4);
        acc[4 * i + 0] += bflo(hw_.x); acc[4 * i + 1] += bfhi(hw_.x); acc[4 * i + 2] += bflo(hw_.y); acc[4 * i + 3] += bfhi(hw_.y); }
#pragma unroll
    for (int j = 0; j < 32; ++j) sq += acc[j] * acc[j];
    const float r_ = rsqrtf(wave_sum(sq) * (1.f / D_MODEL) + EPS);
#pragma unroll
    for (int i = 0; i < 8; ++i) { const f32x4 gv_ = *(const f32x4*)(gfin + i * 256 + lane * 4);
        *(f32x4*)(out + (size_t)n * 2048 + i * 256 + lane * 4) = (f32x4){acc[4 * i + 0] * r_ * gv_.x, acc[4 * i + 1] * r_ * gv_.y, acc[4 * i + 2] * r_ * gv_.z, acc[4 * i + 3] * r_ * gv_.w}; }
}

__device__ __forceinline__ void peer_phase(const bf16* QP, const bf16* SKB, const bf16* H, const float* SS, const float* gffn, const unsigned char* U8, const unsigned char* V8, const float* IU, const float* IV,
                                           const float* gfin, float* out, __attribute__((address_space(3))) unsigned char* lds3, int bid, int G) {
    int tid = threadIdx.x; asm volatile("" : "+v"(tid));
    const int lane = tid & 63, wid = __builtin_amdgcn_readfirstlane(tid >> 6);
    for (int unit = bid; unit < NTOK / 32; unit += G) {
        const int tok0 = unit * 32;
        route_head(QP, SKB, wid, tok0, lane, lds3);
        asm volatile("s_waitcnt lgkmcnt(0)" ::: "memory"); __syncthreads();
        { int ln = lane; asm volatile("" : "+v"(ln));
#pragma unroll 1
          for (int tk = 0; tk < 4; ++tk) ffn_token6(tok0 + wid * 4 + tk, wid * 4 + tk, ln, H, SS, gffn, U8, V8, IU, IV, gfin, out, lds3); }
        __syncthreads();
    }
}
#undef PEER_CE
}
constexpr int RING_BYTES = 131072, LDS_BYTES = 163840, LDSCTL_OFF = LDS_BYTES - 1024, MISC_OFF = LDSCTL_OFF + 320;
constexpr int N_PHASES = 8;
#ifndef MK_N_LAUNCHES
#define MK_N_LAUNCHES 1
#endif

__global__ void __launch_bounds__(NTHR, 2) fwd_megakernel(Args args) {
    extern __shared__ __attribute__((aligned(16))) unsigned char lds[];
    LAS unsigned char* lds3 = (LAS unsigned char*)lds;
    int tid_ = threadIdx.x; asm volatile("" : "+v"(tid_));
    const int tid = tid_, lane = tid & 63, wave = __builtin_amdgcn_readfirstlane(tid >> 6);
    const int G = gridDim.x, bid = blockIdx.x;
    unsigned char* ws = args.ws;
    unsigned* ctl = (unsigned*)(ws + WS_CTL);
    const float* x = args.in[0];
    bf16* WinT = (bf16*)(ws + WS_WIN); bf16* WbnT = (bf16*)(ws + WS_WBN); bf16* WbsT = (bf16*)(ws + WS_WBS); bf16* WoutT = (bf16*)(ws + WS_WOUT); bf16* WpqT = (bf16*)(ws + WS_WPQ);
    bf16* XN = (bf16*)(ws + WS_XN); bf16* MERGED = XN; bf16* PROJ = (bf16*)(ws + WS_PROJ);
    bf16* ONSA = (bf16*)(ws + WS_ONSA); bf16* OSB = (bf16*)(ws + WS_OSB);
    float* H = (float*)(ws + WS_H); bf16* HB = (bf16*)(ws + WS_HB);
    unsigned char* U8 = ws + WS_UB; unsigned char* V8 = ws + WS_UB + 1536; float* IU = (float*)(ws + WS_UB + 48 * MiB); float* IV = (float*)(ws + WS_VB + 48 * MiB); bf16* QP = (bf16*)(ws + WS_QP);
    int* EXPERT = (int*)(ws + WS_EXP); float* GATE = (float*)(ws + WS_GATE);
    bf16* KCB = (bf16*)(ws + WS_MISC + MISC_KCB); bf16* VCB = (bf16*)(ws + WS_MISC + MISC_VCB);
    float* SS = (float*)(ctl + CW_SS);
    float* BTG = (float*)(ws + WS_MISC + MISC_B1 + 4096);
    bf16* W1T = (bf16*)(ws + WS_MISC + MISC_W1T); float* BIAS1 = (float*)(ws + WS_MISC + MISC_B1);
    bf16* SKB = (bf16*)(ws + WS_MISC + MISC_SKB);

    for (int u = tid; u < (LDS_BYTES - LDSCTL_OFF) / 4; u += NTHR) ((LAS unsigned*)(lds3 + LDSCTL_OFF))[u] = 0u;
    __syncthreads();
    const int lo = args.ph_lo, hi = args.ph_hi;
    XcdBarrier bar; bar.bar = ctl + CW_BAR; bar.x = 0; bar.st = nullptr;
    if (hi - lo > 1) bar = xcd_barrier_post(ctl + CW_BAR, (volatile LAS unsigned*)(lds3 + MISC_OFF) + 8);
#define IN(k) (lo <= (k) && (k) < hi)
#ifndef REP_BAR
#define REP_BAR 1
#endif
#define SEAM(k) do { if (IN(k) && IN((k) + 1)) for (int rb_ = 0; rb_ < REP_BAR; ++rb_) xcd_barrier(bar); } while (0)
    const int gw = bid * NWAVES + wave, NGW = G * NWAVES;
    const int vcu = (G % 8 == 0) ? (bid % 8) * (G / 8) + bid / 8 : bid;

#if defined(TS_PHASE)
    unsigned long long ts0_ = 0;
#define TS_BEGIN(k) do { if (TS_PHASE == (k)) ts0_ = __builtin_amdgcn_s_memrealtime(); } while (0)
#define TS_END(k) do { if (TS_PHASE == (k)) { const unsigned dt_ = (unsigned)(__builtin_amdgcn_s_memrealtime() - ts0_); if (tid == 0) atomicMax(ctl + 64, dt_); } } while (0)
#else
#define TS_BEGIN(k) do {} while (0)
#define TS_END(k) do {} while (0)
#endif
#ifndef REP_P0
#define REP_P0 1
#endif
#ifndef REP_P1
#define REP_P1 1
#endif
#ifndef REP_P4
#define REP_P4 1
#endif
#ifndef REP_P6
#define REP_P6 1
#endif
#ifndef REP_P5C
#define REP_P5C 1
#endif
    TS_BEGIN(0);
    if (IN(0)) for (int rep_ = 0; rep_ < REP_P0; ++rep_) {
        LAS float* scr = (LAS float*)(lds3 + wave * 16384);
        constexpr int I_IN = (D_MODEL / 64) * ((IN_COLS + 31) / 32), I_BR = (1024 / 64) * (D_MODEL / 32), I_SQ = (D_MODEL / 64) * (D_MODEL / 32);
        constexpr int I_C1 = (2048 / 64) * (CMP_HID / 32);
        constexpr int NITEMS = I_IN + 2 * I_BR + 2 * I_SQ + 2 * I_C1;
        for (int it = gw; it < NITEMS; it += NGW) {
            int r = it;
            if (r < I_IN) { p0_transpose_item(args.in[2], D_MODEL, IN_COLS, WinT, nullptr, scr, r, lane, C_SHIFT_FROM, C_SHIFT); continue; } r -= I_IN;
            if (r < I_BR) { p0_transpose_item(args.in[10], 1024, D_MODEL, WbnT, nullptr, scr, r, lane); continue; } r -= I_BR;
            if (r < I_BR) { p0_transpose_item(args.in[11], 1024, D_MODEL, WbsT, nullptr, scr, r, lane); continue; } r -= I_BR;
            if (r < I_SQ) { p0_transpose_item(args.in[12], D_MODEL, D_MODEL, WoutT, nullptr, scr, r, lane); continue; } r -= I_SQ;
            if (r < I_SQ) { p0_transpose_item(args.in[14], D_MODEL, D_MODEL, WpqT, args.in[13], scr, r, lane); continue; } r -= I_SQ;
            if (r < I_C1) { p0_transpose_item(args.in[4], 2048, CMP_HID, W1T, nullptr, scr, r, lane); continue; } r -= I_C1;
            p0_transpose_item(args.in[7], 2048, CMP_HID, W1T + (size_t)CMP_HID * 2048, nullptr, scr, r, lane);
        }
        {
            v4u z = {0u, 0u, 0u, 0u}; bf16* p = WinT + (size_t)C_SHIFT_FROM * D_MODEL; const size_t nz = (size_t)C_SHIFT * D_MODEL;
            for (size_t i = ((size_t)bid * NTHR + tid) * 8; i < nz; i += (size_t)G * NTHR * 8) *(v4u*)(p + i) = z;
        }
        if (gw < 2 * CMP_HID) {
            const int kv = gw >> 7, j = gw & 127; const float* pe = args.in[kv ? 6 : 3]; const float* w1 = args.in[kv ? 7 : 4];
            float s = 0.f;
            for (int k2 = lane; k2 < 2048; k2 += 64) s += pe[k2] * w1[(size_t)k2 * CMP_HID + j];
            s = wave_sum(s);
            if (lane == 0) BIAS1[gw] = s;
        }
        for (int i = bid * NTHR + tid; i < 4 * 4 * 800; i += G * NTHR) { const int gq = i / 800, d = i - gq * 800; BTG[i] = args.in[9][rel_bucket(d) * 16 + gq] * 1.4426950408889634f; }
        cvt_flat(args.in[15], SKB, (size_t)16 * 128 * 128, (size_t)bid * NTHR + tid, (size_t)G * NTHR);
        for (int m = gw; m < NTOK; m += NGW) rms_row_to_bf16(x + (size_t)m * D_MODEL, args.in[1], XN + (size_t)m * D_MODEL, lane);
    }
    TS_END(0);
    SEAM(0);
    TS_BEGIN(1);
    if (IN(1)) for (int rep_ = 0; rep_ < REP_P1; ++rep_) {
        pg8::Gemm g{XN, WinT, NTOK, PLD, D_MODEL}; pg8::StaticOrder S; S.init(NTOK, PLD, G, bid);
        pg8::EpiBf16<0> E{PROJ, PP, nullptr, PP, (size_t)NTOK * PP, 1.f};
        pg8::gemm_phase<pg8::EpiBf16<0>, pg8::StaticOrder, true, true>(lds3, g, S, E);
    }
    TS_END(1);
    SEAM(1);
    TS_BEGIN(2);
    if (IN(2)) cmpr::compress_phase(PROJ, W1T, BIAS1, args.in, KCB, VCB, lds3, bid, G);
    TS_END(2);
    SEAM(2);
    TS_BEGIN(3);
    if (IN(3)) {
        TS_BEGIN(30);
        nsa::nsa_phase(PROJ, KCB, VCB, BTG, ONSA, lds3, vcu, G, args.variant);
        TS_END(30);
#if defined(PROBE_P3A)
        nsa::nsa_phase(PROJ, KCB, VCB, args.in[9], ONSA, lds3, vcu, G);
#endif
        TS_BEGIN(31);
        if (!(args.variant & 32)) nsa::stick_phase(PROJ, OSB, lds3, vcu, G);
        TS_END(31);
#if defined(PROBE_P3B)
        nsa::stick_phase(PROJ, OSB, lds3, vcu, G);
#endif
    }
    TS_END(3);
    SEAM(3);
    TS_BEGIN(4);
    if (IN(4)) for (int rep_ = 0; rep_ < REP_P4; ++rep_) {
        static_assert(WS_OSB == WS_ONSA + (size_t)NTOK * NSA_Q * 2 && WS_WBS == WS_WBN + (size_t)D_MODEL * 1024 * 2, "branch operands must be contiguous");
        pg8::Gemm g{ONSA, WbnT, 2 * NTOK, 2 * D_MODEL, 1024}; pg8::BranchOrder S; S.init(NTOK, D_MODEL, G, bid);
        pg8::EpiGate2 E{MERGED, D_MODEL, PNL(PROJ, P_GA), PNL(PROJ, P_GB), PP, (size_t)NTOK * PP - PP, NTOK / 256, D_MODEL / 256};
        pg8::gemm_phase<pg8::EpiGate2, pg8::BranchOrder, true, true>(lds3, g, S, E);
    }
    TS_END(4);
    SEAM(4);
    TS_BEGIN(5);
    if (IN(5)) {
        if (!(args.variant & 64)) { pg8::Gemm g{MERGED, WoutT, NTOK, D_MODEL, D_MODEL}; pg8::StaticOrder S; S.init(NTOK, D_MODEL, G, bid);
          pg8::EpiResid E{x, HB, SS, D_MODEL};
          pg8::gemm_phase<pg8::EpiResid, pg8::StaticOrder, true, true>(lds3, g, S, E); }
        int t5 = threadIdx.x; asm volatile("" : "+v"(t5));
        const int lane5 = t5 & 63, gw5 = bid * NWAVES + __builtin_amdgcn_readfirstlane(t5 >> 6);
        if (!(args.variant & 128)) peer::cvt_tables_fp6(args.in[16], args.in[17], U8, V8, IU, IV, gw5, NGW, lane5);
    }
    TS_END(5);
    SEAM(5);
    TS_BEGIN(6);
    if (IN(6)) for (int rep_ = 0; rep_ < REP_P6; ++rep_) {
        pg8::Gemm g{HB, WpqT, NTOK, D_MODEL, D_MODEL}; pg8::StaticOrder S; S.init(NTOK, D_MODEL, G, bid);
        pg8::EpiRowScale E{QP, D_MODEL, SS, 1.f / D_MODEL, EPS};
        pg8::gemm_phase<pg8::EpiRowScale, pg8::StaticOrder, true, true>(lds3, g, S, E);
    }
    TS_END(6);
    SEAM(6);
    TS_BEGIN(7);
    if (IN(7)) {
        peer::peer_phase(QP, SKB, HB, SS, args.in[13], U8, V8, IU, IV, args.in[18], args.out, lds3, bid, G);
    }
    TS_END(7);
#if defined(TS_PHASE)
    xcd_barrier(bar);
    if (bid == 0) { const unsigned dt_ = __hip_atomic_load(ctl + 64, RLX_AGENT); const int K_ = (int)((float)dt_ * 0.01f * 16.777216f * 2.f);
        for (int i = tid; i < K_; i += NTHR) args.out[i] += 1.0f; }
#endif
#undef IN
#undef SEAM
}

extern "C" void kernel_launch(void* const* d_in, const int* in_sizes, int n_in, void* d_out, int out_size, void* d_ws, size_t ws_size, hipStream_t stream) {
    static int grid = 0;
    if (grid == 0) {
        if (n_in != 19 || ws_size < WS_END) { fprintf(stderr, "kernel_launch: unexpected inputs (%d) or workspace (%zu < %zu)\n", n_in, ws_size, (size_t)WS_END); grid = -1; return; }
        int dev = 0, cus = 0, per_cu = 0;
        hipGetDevice(&dev); hipDeviceGetAttribute(&cus, hipDeviceAttributeMultiprocessorCount, dev);
        if (hipFuncSetAttribute((const void*)fwd_megakernel, hipFuncAttributeMaxDynamicSharedMemorySize, LDS_BYTES) != hipSuccess) { fprintf(stderr, "hipFuncSetAttribute failed\n"); grid = -1; return; }
        if (hipOccupancyMaxActiveBlocksPerMultiprocessor(&per_cu, (const void*)fwd_megakernel, NTHR, LDS_BYTES) != hipSuccess || per_cu < 1) { fprintf(stderr, "occupancy query: %d\n", per_cu); per_cu = 1; }
        (void)hipGetLastError();
        grid = cus;
        if (grid > cus * per_cu) grid = cus * per_cu;
    }
    if (grid < 0) return;
    hipMemsetAsync((char*)d_ws + WS_CTL, 0, (size_t)(CW_SS + NTOK) * 4, stream);
    Args a{};
    for (int i = 0; i < 19; ++i) a.in[i] = (const float*)d_in[i];
    a.out = (float*)d_out; a.ws = (unsigned char*)d_ws;
#if defined(PROBE_SPLIT_LO2)
#ifndef PROBE_VARIANT
#define PROBE_VARIANT 0
#endif
    {
        a.ph_lo = 0; a.ph_hi = PROBE_SPLIT_HI1; a.variant = PROBE_VARIANT; hipLaunchKernelGGL(fwd_megakernel, dim3(grid), dim3(NTHR), LDS_BYTES, stream, a);
        hipMemsetAsync((char*)d_ws + WS_CTL + CW_BAR * 4, 0, XCD_BAR_WORDS * 4, stream);
        if (PROBE_SPLIT_LO2 <= 5 && PROBE_SPLIT_HI1 > 5) hipMemsetAsync((char*)d_ws + WS_CTL + CW_SS * 4, 0, NTOK * 4, stream);
        a.ph_lo = PROBE_SPLIT_LO2; a.ph_hi = N_PHASES; a.variant = 0; hipLaunchKernelGGL(fwd_megakernel, dim3(grid), dim3(NTHR), LDS_BYTES, stream, a);
        return;
    }
#endif
    if (MK_N_LAUNCHES == 1) {
        a.ph_lo = 0; a.ph_hi = N_PHASES;
        void* kargs[] = {&a};
#if defined(USE_COOP_LAUNCH)
        hipError_t e = hipLaunchCooperativeKernel((const void*)fwd_megakernel, dim3(grid), dim3(NTHR), kargs, LDS_BYTES, stream);
        if (e != hipSuccess) fprintf(stderr, "cooperative launch failed: %s (grid %d)\n", hipGetErrorString(e), grid);
#else
        (void)kargs;
        hipLaunchKernelGGL(fwd_megakernel, dim3(grid), dim3(NTHR), LDS_BYTES, stream, a);
#endif
    } else {
        for (int p = 0; p < N_PHASES; ++p) { a.ph_lo = p; a.ph_hi = p + 1; hipLaunchKernelGGL(fwd_megakernel, dim3(grid), dim3(NTHR), LDS_BYTES, stream, a); }
    }
}
```

```cpp
#include <hip/hip_runtime.h>
#include <cstdio>
#include <cstdint>
#include <cmath>
#ifndef PG8_NT_STORES
#define PG8_NT_STORES 0
#endif
#if PG8_NT_STORES
#define PG8_STORE_OUT(p, v) __builtin_nontemporal_store((v), (p))
#else
#define PG8_STORE_OUT(p, v) (*(p) = (v))
#endif
namespace pg8 {
#define PG8_LAS __attribute__((address_space(3)))
typedef unsigned short bf16_t;
typedef short bf16x8 __attribute__((ext_vector_type(8)));
typedef float f32x4 __attribute__((ext_vector_type(4)));
typedef unsigned u32x4 __attribute__((ext_vector_type(4)));
constexpr int BM = 256, BK = 64, HALF = 128, HTB = HALF * BK * 2  , STAGE_BYTES = 8 * HTB, NXCD = 8, WGM = 8;

__host__ __device__ __forceinline__ int lds_byte(int r, int c) { const int st = (r >> 4) * 2 + (c >> 5), rr = r & 15, cc = c & 31, ob = rr * 64 + cc * 2; return st * 1024 + (ob ^ (((ob >> 9) & 1) << 5)); }
__host__ __device__ __forceinline__ void stage_rc(int b, int& R, int& C) { const int st = b / 1024, sb = b % 1024, swz = sb ^ (((sb >> 9) & 1) << 5); R = (st >> 1) * 16 + swz / 64; C = (st & 1) * 32 + (swz % 64) / 2; }
__host__ __device__ __forceinline__ int perm32(int rho) { const int n = rho >> 4, i = rho & 15; return 8 * (i >> 2) + 4 * n + (i & 3); }

struct Unit { int pm, pn; };
struct Gemm { const bf16_t* A; const bf16_t* Bt; int M, N, K; };

struct StaticOrder {
    int nM, nN, nwg, G, c;
    __host__ __device__ void init(int M, int N, int G_, int c_) { nM = M / BM; nN = N / BM; nwg = nM * nN; G = G_; c = c_; }
    __host__ __device__ bool next(int i, Unit& u) const {
        const long L = (long)i * G + c; if (L >= nwg) return false;
        int wgid = (int)L; { const int q = nwg / NXCD, r = nwg % NXCD, xcd = wgid % NXCD, off = wgid / NXCD; wgid = (xcd < r ? xcd * (q + 1) : r * (q + 1) + (xcd - r) * q) + off; }
        const int nig = WGM * nN, gid = wgid / nig, fm = gid * WGM, gsz = (nM - fm) < WGM ? (nM - fm) : WGM;
        u.pm = fm + ((wgid % nig) % gsz); u.pn = (wgid % nig) / gsz; return true;
    }
    __device__ __forceinline__ void a_ready(const Unit&) const {}
    __device__ __forceinline__ void done(const Unit&) const {}
};

__device__ __forceinline__ unsigned cvt_pk_bf16(float lo, float hi) { unsigned r; asm volatile("v_cvt_pk_bf16_f32 %0, %1, %2" : "=v"(r) : "v"(lo), "v"(hi)); return r; }
typedef float f32x2 __attribute__((ext_vector_type(2)));
__device__ __forceinline__ f32x2 gelu_pk(f32x2 v) {
    const f32x2 av = __builtin_elementwise_abs(v), d = av * 0.2316418882f + 1.0f;
    f32x2 t; t.x = __builtin_amdgcn_rcpf(d.x); t.y = __builtin_amdgcn_rcpf(d.y);
    f32x2 q = t * 0.5307027145f + (-0.7265760135f); q = q * t + 0.7107068705f; q = q * t + (-0.142248368f); q = q * t + 0.127414796f; q = q * t;
    const f32x2 s = (v * v) * (-0.72134752044f);
    f32x2 e; e.x = __builtin_amdgcn_exp2f(s.x); e.y = __builtin_amdgcn_exp2f(s.y);
    const f32x2 m = v * (q * e), r = v - m;
    f32x2 o; o.x = v.x < 0.f ? m.x : r.x; o.y = v.y < 0.f ? m.y : r.y; return o;
}

template <int ACT  > struct EpiBf16 {
    static constexpr bool PERM = true, AFTER_DRAIN = false; static_assert(ACT == 0 || ACT == 1, "EpiBf16: ACT is 0 (none) or 1 (gelu_pk)");
    bf16_t* O; int ldc; const float* bias; int split_cols; size_t split_stride; float scale0;
    __device__ __forceinline__ void operator()(const f32x4 (&acc)[2][2][4][2], const Unit& u, int wr, int wc, int fr, int fq) const {
        const int row0 = u.pm * BM + wr * 64 + fr; int colt = u.pn * BM; bf16_t* base = O;
        float sc = 1.f; if (split_cols) { const int t = colt / split_cols; base += (size_t)t * split_stride; colt -= t * split_cols; if (t == 0) sc = scale0; }
        const int col0 = colt + wc * 32 + 8 * fq, bcol0 = u.pn * BM + wc * 32 + 8 * fq;
        f32x4 bv[2][2];
#pragma unroll
        for (int bj = 0; bj < 2; ++bj)
#pragma unroll
            for (int n = 0; n < 2; ++n) bv[bj][n] = bias ? *(const f32x4*)(bias + bcol0 + bj * HALF + 4 * n) : (f32x4){0.f, 0.f, 0.f, 0.f};
#pragma unroll
        for (int ai = 0; ai < 2; ++ai)
#pragma unroll
            for (int m = 0; m < 4; ++m) { bf16_t* rowp = base + (size_t)(row0 + ai * HALF + m * 16) * ldc + col0;
#pragma unroll
                for (int bj = 0; bj < 2; ++bj) { f32x4 v0 = acc[ai][bj][m][0] + bv[bj][0], v1 = acc[ai][bj][m][1] + bv[bj][1];
                    if (ACT == 1) { f32x2 a = gelu_pk((f32x2){v0[0], v0[1]}), b = gelu_pk((f32x2){v0[2], v0[3]}), c = gelu_pk((f32x2){v1[0], v1[1]}), d = gelu_pk((f32x2){v1[2], v1[3]});
                        v0 = (f32x4){a.x, a.y, b.x, b.y}; v1 = (f32x4){c.x, c.y, d.x, d.y}; }
                    v0 = v0 * sc; v1 = v1 * sc; u32x4 w; w.x = cvt_pk_bf16(v0[0], v0[1]); w.y = cvt_pk_bf16(v0[2], v0[3]); w.z = cvt_pk_bf16(v1[0], v1[1]); w.w = cvt_pk_bf16(v1[2], v1[3]);
                    PG8_STORE_OUT((u32x4*)(rowp + bj * HALF), w); } }
    }
};

struct PanelStats {
    unsigned* xbuf;
    unsigned* cnt;
    unsigned* tmo;
    int ntn; float eps;
    unsigned code;
    __device__ __forceinline__ bool run(const f32x4 (&v)[2][2][4][2], const Unit& u, int wr, int wc, int fr, int fq, PG8_LAS unsigned char* lds, int wid, int lane) const {
        typedef float f32x2v __attribute__((ext_vector_type(2)));
        PG8_LAS f32x2v* P = (PG8_LAS f32x2v*)lds;
        PG8_LAS f32x2v* S = (PG8_LAS f32x2v*)(lds + 8192);
        PG8_LAS unsigned* flag = (PG8_LAS unsigned*)(lds + 8192 + 2048);
#pragma unroll
        for (int ai = 0; ai < 2; ++ai)
#pragma unroll
            for (int m = 0; m < 4; ++m) {
                float s = 0.f;
#pragma unroll
                for (int bj = 0; bj < 2; ++bj)
#pragma unroll
                    for (int n = 0; n < 2; ++n) { const f32x4 x = v[ai][bj][m][n]; s += (x[0] + x[1]) + (x[2] + x[3]); }
                s += __shfl_xor(s, 16); s += __shfl_xor(s, 32);
                const float mw = s * (1.0f / 64.0f); float q = 0.f;
#pragma unroll
                for (int bj = 0; bj < 2; ++bj)
#pragma unroll
                    for (int n = 0; n < 2; ++n) { const f32x4 d = v[ai][bj][m][n] - mw; q += (d[0] * d[0] + d[1] * d[1]) + (d[2] * d[2] + d[3] * d[3]); }
                q += __shfl_xor(q, 16); q += __shfl_xor(q, 32);
                if (fq == 0) P[(ai * HALF + wr * 64 + m * 16 + fr) * 4 + wc] = (f32x2v){mw, q};
            }
        asm volatile("s_waitcnt lgkmcnt(0)" ::: "memory"); __builtin_amdgcn_s_barrier(); asm volatile("" ::: "memory");
#if defined(BROKEN_EXCHANGE_NO_WAIT)
#warning BROKEN CONTROL BUILD: the row-statistics exchange does not wait; results are wrong by design
        if (blockIdx.x >= 64) { const long long t0_ = clock64(); while (clock64() - t0_ < 60000) __builtin_amdgcn_s_sleep(8); }
#endif
        const int row = wid * 32 + (lane & 31);
        if (lane < 32) {
            const f32x2v a = P[row * 4 + 0], b = P[row * 4 + 1], c = P[row * 4 + 2], d = P[row * 4 + 3];
            const float mt = (a.x + b.x + c.x + d.x) * 0.25f;
            const float da = a.x - mt, db = b.x - mt, dc = c.x - mt, dd = d.x - mt;
            const float m2 = (a.y + b.y) + (c.y + d.y) + 64.0f * ((da * da + db * db) + (dc * dc + dd * dd));
            unsigned long long* slot = (unsigned long long*)xbuf + ((size_t)(u.pm * BM + row) * 4 + u.pn);
            __hip_atomic_store(slot, ((unsigned long long)__float_as_uint(m2) << 32) | __float_as_uint(mt), __ATOMIC_RELAXED, __HIP_MEMORY_SCOPE_AGENT);
        }
        asm volatile("s_waitcnt vmcnt(0)" ::: "memory");
        if (lane == 0) __hip_atomic_fetch_add(cnt + 64 * u.pm, 1u, __ATOMIC_RELAXED, __HIP_MEMORY_SCOPE_AGENT);
        if (wid == 0) {
            bool dead = false; const unsigned long long t0 = __builtin_amdgcn_s_memrealtime(); const unsigned want = 8u * (unsigned)ntn;
            for (;;) {
#if defined(BROKEN_EXCHANGE_NO_WAIT)
                break;
#endif
                if ((unsigned)__builtin_amdgcn_readfirstlane(__hip_atomic_load(cnt + 64 * u.pm, __ATOMIC_RELAXED, __HIP_MEMORY_SCOPE_AGENT)) >= want) break;
                if (__builtin_amdgcn_s_memrealtime() - t0 > 2000000ull) {
                    if (lane == 0) { unsigned expect = 0u; __hip_atomic_compare_exchange_strong(tmo + 1, &expect, code | (unsigned)(u.pm & 0xff), __ATOMIC_RELAXED, __ATOMIC_RELAXED, __HIP_MEMORY_SCOPE_AGENT);
                                     __hip_atomic_store(tmo, 1u, __ATOMIC_RELAXED, __HIP_MEMORY_SCOPE_AGENT); }
                    dead = true; break; }
                __builtin_amdgcn_s_sleep(2);
            }
            __builtin_amdgcn_fence(__ATOMIC_ACQUIRE, "agent");
            if (lane == 0) flag[0] = dead ? 1u : 0u;
        }
        asm volatile("s_waitcnt vmcnt(0) lgkmcnt(0)" ::: "memory"); __builtin_amdgcn_s_barrier(); asm volatile("" ::: "memory");
        const bool bad = flag[0] != 0u;
        if (lane < 32) {
            const unsigned long long* slot = (const unsigned long long*)xbuf + (size_t)(u.pm * BM + row) * 4; float mt[4], m2[4]; float ms = 0.f;
#pragma unroll
            for (int t = 0; t < 4; ++t) { if (t < ntn) { const unsigned long long w = __hip_atomic_load(slot + t, __ATOMIC_RELAXED, __HIP_MEMORY_SCOPE_AGENT); mt[t] = __uint_as_float((unsigned)w); m2[t] = __uint_as_float((unsigned)(w >> 32)); } else { mt[t] = 0.f; m2[t] = 0.f; } ms += mt[t]; }
            const float mean = ms / (float)ntn; float q = 0.f;
#pragma unroll
            for (int t = 0; t < 4; ++t) if (t < ntn) { const float dm = mt[t] - mean; q += m2[t] + 256.0f * dm * dm; }
            S[row] = (f32x2v){mean, 1.0f / sqrtf(q / (256.0f * (float)ntn) + eps)};
        }
        asm volatile("s_waitcnt lgkmcnt(0)" ::: "memory"); __builtin_amdgcn_s_barrier(); asm volatile("" ::: "memory");
        return bad;
    }
};
struct EpiLnRes {
    static constexpr bool PERM = false, AFTER_DRAIN = true;
    const float* base; float* out; int ldc; const float* bias; PanelStats st; unsigned poison;
    __device__ __forceinline__ void fused(f32x4 (&acc)[2][2][4][2], const Unit& u, int wr, int wc, int fr, int fq, PG8_LAS unsigned char* lds, int wid, int lane) const {
        typedef float f32x2v __attribute__((ext_vector_type(2)));
        const PG8_LAS f32x2v* S = (const PG8_LAS f32x2v*)(lds + 8192);
        const int col0 = u.pn * BM + wc * 32 + 4 * fq;
#pragma unroll
        for (int bj = 0; bj < 2; ++bj)
#pragma unroll
            for (int n = 0; n < 2; ++n) { const f32x4 bv = bias ? *(const f32x4*)(bias + col0 + bj * HALF + n * 16) : (f32x4){0.f, 0.f, 0.f, 0.f};
#pragma unroll
                for (int ai = 0; ai < 2; ++ai)
#pragma unroll
                    for (int m = 0; m < 4; ++m) acc[ai][bj][m][n] += bv; }
        f32x4 pre[4][2][2];
#pragma unroll
        for (int m = 0; m < 4; ++m) { const size_t off = (size_t)(u.pm * BM + wr * 64 + m * 16 + fr) * ldc + col0;
#pragma unroll
            for (int bj = 0; bj < 2; ++bj)
#pragma unroll
                for (int n = 0; n < 2; ++n) pre[m][bj][n] = *(const f32x4*)(base + off + bj * HALF + n * 16); }
        const bool bad = st.run(acc, u, wr, wc, fr, fq, lds, wid, lane) || poison != 0u;
        const float qnan = __builtin_nanf("");
#pragma unroll
        for (int ai = 0; ai < 2; ++ai)
#pragma unroll
            for (int m = 0; m < 4; ++m) { const int r = ai * HALF + wr * 64 + m * 16 + fr; const f32x2v sr = S[r]; const size_t off = (size_t)(u.pm * BM + r) * ldc + col0;
#pragma unroll
                for (int bj = 0; bj < 2; ++bj)
#pragma unroll
                    for (int n = 0; n < 2; ++n) { const f32x4 bs = ai == 0 ? pre[m][bj][n] : *(const f32x4*)(base + off + bj * HALF + n * 16); f32x4 o = bs + (acc[ai][bj][m][n] - sr.x) * sr.y;
                        if (bad) o = (f32x4){qnan, qnan, qnan, qnan}; *(f32x4*)(out + off + bj * HALF + n * 16) = o; }
                if (m & 1) asm volatile("" ::: "memory"); }
    }
};
struct EpiLnResLn {
    static constexpr bool PERM = false, AFTER_DRAIN = true;
    const float* base; float* out; bf16_t* xn; int ldc; const float* bias; PanelStats st1, st2; unsigned poison;
    __device__ __forceinline__ void fused(f32x4 (&acc)[2][2][4][2], const Unit& u, int wr, int wc, int fr, int fq, PG8_LAS unsigned char* lds, int wid, int lane) const {
        typedef float f32x2v __attribute__((ext_vector_type(2))); typedef unsigned u32x2v __attribute__((ext_vector_type(2)));
        const PG8_LAS f32x2v* S = (const PG8_LAS f32x2v*)(lds + 8192);
        const int col0 = u.pn * BM + wc * 32 + 4 * fq;
#pragma unroll
        for (int bj = 0; bj < 2; ++bj)
#pragma unroll
            for (int n = 0; n < 2; ++n) { const f32x4 bv = bias ? *(const f32x4*)(bias + col0 + bj * HALF + n * 16) : (f32x4){0.f, 0.f, 0.f, 0.f};
#pragma unroll
                for (int ai = 0; ai < 2; ++ai)
#pragma unroll
                    for (int m = 0; m < 4; ++m) acc[ai][bj][m][n] += bv; }
        bool bad = st1.run(acc, u, wr, wc, fr, fq, lds, wid, lane) || poison != 0u;
        const float qnan = __builtin_nanf("");
#pragma unroll
        for (int ai = 0; ai < 2; ++ai)
#pragma unroll
            for (int m = 0; m < 4; ++m) { const int r = ai * HALF + wr * 64 + m * 16 + fr; const f32x2v sr = S[r]; const size_t off = (size_t)(u.pm * BM + r) * ldc + col0;
#pragma unroll
                for (int bj = 0; bj < 2; ++bj)
#pragma unroll
                    for (int n = 0; n < 2; ++n) { const f32x4 bs = *(const f32x4*)(base + off + bj * HALF + n * 16); acc[ai][bj][m][n] = bs + (acc[ai][bj][m][n] - sr.x) * sr.y; }
                asm volatile("" : "+v"(acc[ai][0][m][0]), "+v"(acc[ai][0][m][1]), "+v"(acc[ai][1][m][0]), "+v"(acc[ai][1][m][1]));
                if (m & 1) asm volatile("" ::: "memory"); }
        const bool bad1 = bad;
        bad = st2.run(acc, u, wr, wc, fr, fq, lds, wid, lane) || bad;
#pragma unroll
        for (int ai = 0; ai < 2; ++ai)
#pragma unroll
            for (int m = 0; m < 4; ++m) { const int r = ai * HALF + wr * 64 + m * 16 + fr; const f32x2v sr = S[r]; const size_t off = (size_t)(u.pm * BM + r) * ldc + col0;
#pragma unroll
                for (int bj = 0; bj < 2; ++bj)
#pragma unroll
                    for (int n = 0; n < 2; ++n) { const f32x4 x1 = acc[ai][bj][m][n]; *(f32x4*)(out + off + bj * HALF + n * 16) = bad1 ? (f32x4){qnan, qnan, qnan, qnan} : x1;
                        const f32x4 o = (x1 - sr.x) * sr.y; u32x2v w; w.x = cvt_pk_bf16(o[0], o[1]); w.y = cvt_pk_bf16(o[2], o[3]);
                        if (bad) { w.x = 0x7fc07fc0u; w.y = 0x7fc07fc0u; } *(u32x2v*)(xn + off + bj * HALF + n * 16) = w; }
                asm volatile("" ::: "memory"); }
    }
};

template <class Epi, class Sched, bool ALIGN_EPI = false, bool SP2 = false>
__device__ __forceinline__ void gemm_phase(PG8_LAS unsigned char* lds, const Gemm g, const Sched& S, const Epi& E) {
    const int tid = threadIdx.x, wid = __builtin_amdgcn_readfirstlane(tid >> 6), lane = tid & 63, wr = wid >> 2, wc = wid & 3, fr = lane & 15, fq = lane >> 4;
    const int K = g.K, nt = K / BK;
    unsigned voffA[2], voffB[2];
#pragma unroll
    for (int i = 0; i < 2; ++i) { int R, C; stage_rc(tid * 16 + i * 8192, R, C); const int Rb = Epi::PERM ? ((R & ~31) + perm32(R & 31)) : R;
        voffA[i] = (unsigned)(R * K + C) * 2u; voffB[i] = (unsigned)(Rb * K + C) * 2u; }
    const size_t kstep = (size_t)(BK * 2);
    const size_t hstep = (size_t)HALF * K * 2;
    const size_t tstep = 2 * hstep;
    const unsigned ldsw = (unsigned)wid * 1024u;
    const int aoff = lds_byte(wr * 64 + fr, fq * 8), boff = lds_byte(wc * 32 + fr, fq * 8);
#define PG8_SA(b, h) (((b) * 2 + (h)) * HTB)
#define PG8_SB(b, h) ((4 + (b) * 2 + (h)) * HTB)
#define PG8_STAGE(bufoff, gbase, voff) do { _Pragma("unroll") for (int _i = 0; _i < 2; ++_i) \
        __builtin_amdgcn_global_load_lds((const unsigned*)((const char*)(gbase) + (voff)[_i]), (PG8_LAS unsigned*)(lds + (bufoff) + ldsw + _i * 8192), 16, 0, 0); } while (0)
#define PG8_LDA(dst, b, h) do { _Pragma("unroll") for (int m = 0; m < 4; ++m) _Pragma("unroll") for (int k = 0; k < 2; ++k) dst[m][k] = *(const PG8_LAS bf16x8*)(lds + PG8_SA(b, h) + aoff + m * 2048 + k * 1024); } while (0)
#define PG8_LDB(dst, b, h) do { _Pragma("unroll") for (int n = 0; n < 2; ++n) _Pragma("unroll") for (int k = 0; k < 2; ++k) dst[n][k] = *(const PG8_LAS bf16x8*)(lds + PG8_SB(b, h) + boff + n * 2048 + k * 1024); } while (0)
#define PG8_MMA(ai, bj, At, Bt) do { __builtin_amdgcn_s_setprio(1); _Pragma("unroll") for (int m = 0; m < 4; ++m) _Pragma("unroll") for (int n = 0; n < 2; ++n) _Pragma("unroll") for (int k = 0; k < 2; ++k) \
        acc[ai][bj][m][n] = __builtin_amdgcn_mfma_f32_16x16x32_bf16(Bt[n][k], At[m][k], acc[ai][bj][m][n], 0, 0, 0); __builtin_amdgcn_s_setprio(0); } while (0)
#define PG8_WAIT_V(n) asm volatile("s_waitcnt vmcnt(" #n ")" ::: "memory")
#define PG8_WAIT_L(n) asm volatile("s_waitcnt lgkmcnt(" #n ")" ::: "memory")
#define PG8_BAR __builtin_amdgcn_s_barrier()
#define PG8_SCHED __builtin_amdgcn_sched_barrier(0)
    Unit cur, nxt; int ui = 0;
    if (!S.next(0, cur)) return;
    f32x4 acc[2][2][4][2];
#pragma unroll
    for (int a = 0; a < 2; ++a)
#pragma unroll
        for (int b = 0; b < 2; ++b)
#pragma unroll
            for (int m = 0; m < 4; ++m)
#pragma unroll
                for (int n = 0; n < 2; ++n) acc[a][b][m][n] = (f32x4){0.f, 0.f, 0.f, 0.f};
    bf16x8 At[4][2], B0[2][2], B1[2][2];
    const char* cA = (const char*)g.A + (size_t)cur.pm * tstep; const char* cB = (const char*)g.Bt + (size_t)cur.pn * tstep;
    S.a_ready(cur);
    if constexpr (SP2) {
        PG8_STAGE(PG8_SB(0, 0), cB, voffB); PG8_STAGE(PG8_SB(0, 1), cB + hstep, voffB); PG8_STAGE(PG8_SA(0, 0), cA, voffA); PG8_STAGE(PG8_SA(0, 1), cA + hstep, voffA);
        if (wr == 1) PG8_BAR;
        PG8_WAIT_V(2); PG8_BAR;
        PG8_STAGE(PG8_SB(1, 0), cB + kstep, voffB); PG8_STAGE(PG8_SA(1, 0), cA + kstep, voffA); PG8_STAGE(PG8_SB(1, 1), cB + hstep + kstep, voffB);
        PG8_WAIT_V(6); PG8_BAR;
    } else {
        PG8_STAGE(PG8_SB(0, 0), cB, voffB); PG8_STAGE(PG8_SA(0, 0), cA, voffA); PG8_STAGE(PG8_SB(0, 1), cB + hstep, voffB); PG8_STAGE(PG8_SA(0, 1), cA + hstep, voffA);
        if (wr == 1) PG8_BAR;
        PG8_WAIT_V(4); PG8_BAR;
        PG8_STAGE(PG8_SB(1, 0), cB + kstep, voffB); PG8_STAGE(PG8_SA(1, 0), cA + kstep, voffA); PG8_STAGE(PG8_SB(1, 1), cB + hstep + kstep, voffB);
        PG8_WAIT_V(6); PG8_BAR;
    }
    for (;;) {
        const bool has_next = S.next(ui + 1, nxt);
        const char* nA = has_next ? (const char*)g.A + (size_t)nxt.pm * tstep : cA; const char* nB = has_next ? (const char*)g.Bt + (size_t)nxt.pn * tstep : cB;
        for (int t = 0; t < nt; t += 2) {
            const bool last = (t == nt - 2);
            const char* a1 = cA + (size_t)(t + 1) * kstep;
            const char* a2 = last ? nA : cA + (size_t)(t + 2) * kstep; const char* b2 = last ? nB : cB + (size_t)(t + 2) * kstep;
            const char* a3 = a2 + kstep; const char* b3 = b2 + kstep;
            if (last && has_next) S.a_ready(nxt);
            if constexpr (SP2) {
            PG8_LDB(B0, 0, 0); PG8_LDB(B1, 0, 1); PG8_SCHED; PG8_LDA(At, 0, 0); PG8_STAGE(PG8_SA(1, 1), a1 + hstep, voffA);
            PG8_WAIT_V(8); PG8_WAIT_L(0); PG8_BAR; PG8_MMA(0, 0, At, B0); PG8_MMA(0, 1, At, B1); PG8_BAR; PG8_SCHED;
            PG8_LDA(At, 0, 1); PG8_STAGE(PG8_SB(0, 0), b2, voffB); PG8_STAGE(PG8_SB(0, 1), b2 + hstep, voffB); PG8_STAGE(PG8_SA(0, 0), a2, voffA);
            PG8_WAIT_V(8); PG8_WAIT_L(0); PG8_BAR; PG8_MMA(1, 0, At, B0); PG8_MMA(1, 1, At, B1); PG8_BAR; PG8_SCHED;
            PG8_LDB(B0, 1, 0); PG8_LDB(B1, 1, 1); PG8_SCHED; PG8_LDA(At, 1, 0); PG8_STAGE(PG8_SA(0, 1), a2 + hstep, voffA);
            PG8_WAIT_V(8); PG8_WAIT_L(0); PG8_BAR; PG8_MMA(0, 0, At, B0); PG8_MMA(0, 1, At, B1); PG8_BAR; PG8_SCHED;
            PG8_LDA(At, 1, 1); PG8_STAGE(PG8_SB(1, 0), b3, voffB); PG8_STAGE(PG8_SB(1, 1), b3 + hstep, voffB); PG8_STAGE(PG8_SA(1, 0), a3, voffA);
            PG8_WAIT_V(8); PG8_WAIT_L(0); PG8_BAR; PG8_MMA(1, 0, At, B0); PG8_MMA(1, 1, At, B1); PG8_BAR; PG8_SCHED;
            } else {
            PG8_LDB(B0, 0, 0); PG8_SCHED; PG8_LDA(At, 0, 0); PG8_STAGE(PG8_SA(1, 1), a1 + hstep, voffA);
            PG8_WAIT_L(8); PG8_BAR; PG8_WAIT_L(0); PG8_MMA(0, 0, At, B0); PG8_BAR; PG8_SCHED;
            PG8_LDB(B1, 0, 1); PG8_STAGE(PG8_SB(0, 0), b2, voffB);
            PG8_BAR; PG8_WAIT_L(0); PG8_MMA(0, 1, At, B1); PG8_BAR;
            PG8_LDA(At, 0, 1); PG8_STAGE(PG8_SA(0, 0), a2, voffA);
            PG8_BAR; PG8_WAIT_L(0); PG8_MMA(1, 0, At, B0); PG8_BAR; PG8_SCHED;
            PG8_STAGE(PG8_SB(0, 1), b2 + hstep, voffB);
            PG8_WAIT_V(6); PG8_BAR; PG8_MMA(1, 1, At, B1); PG8_BAR;
            PG8_LDB(B0, 1, 0); PG8_SCHED; PG8_LDA(At, 1, 0); PG8_STAGE(PG8_SA(0, 1), a2 + hstep, voffA);
            PG8_WAIT_L(8); PG8_BAR; PG8_WAIT_L(0); PG8_MMA(0, 0, At, B0); PG8_BAR; PG8_SCHED;
            PG8_LDB(B1, 1, 1); PG8_STAGE(PG8_SB(1, 0), b3, voffB);
            PG8_BAR; PG8_WAIT_L(0); PG8_MMA(0, 1, At, B1); PG8_BAR;
            PG8_LDA(At, 1, 1); PG8_STAGE(PG8_SA(1, 0), a3, voffA);
            PG8_BAR; PG8_WAIT_L(0); PG8_MMA(1, 0, At, B0); PG8_BAR; PG8_SCHED;
            PG8_STAGE(PG8_SB(1, 1), b3 + hstep, voffB);
            PG8_WAIT_V(6); PG8_BAR; PG8_MMA(1, 1, At, B1); PG8_BAR;
            }
        }
        if constexpr (ALIGN_EPI) { if (wr == 0) PG8_BAR; }
        if constexpr (!Epi::AFTER_DRAIN) { E(acc, cur, wr, wc, fr, fq); S.done(cur); }
        if (!has_next) break;
#pragma unroll
        for (int a = 0; a < 2; ++a)
#pragma unroll
            for (int b = 0; b < 2; ++b)
#pragma unroll
                for (int m = 0; m < 4; ++m)
#pragma unroll
                    for (int n = 0; n < 2; ++n) acc[a][b][m][n] = (f32x4){0.f, 0.f, 0.f, 0.f};
        cur = nxt; cA = nA; cB = nB; ++ui;
        if constexpr (ALIGN_EPI) { if (wr == 1) PG8_BAR; }
    }
    PG8_WAIT_V(0);
    if constexpr (!ALIGN_EPI) { if (wr == 0) PG8_BAR; }
    PG8_BAR;
    if constexpr (Epi::AFTER_DRAIN) { E.fused(acc, cur, wr, wc, fr, fq, lds, wid, lane); S.done(cur); }
#undef PG8_SA
#undef PG8_SB
#undef PG8_STAGE
#undef PG8_LDA
#undef PG8_LDB
#undef PG8_MMA
#undef PG8_WAIT_V
#undef PG8_WAIT_L
#undef PG8_BAR
#undef PG8_SCHED
}
}
namespace pg8 {
__device__ __forceinline__ float bf2f(unsigned short b) { return __uint_as_float(((unsigned)b) << 16); }
__device__ __forceinline__ float bflo(unsigned w) { return __uint_as_float(w << 16); }
__device__ __forceinline__ float bfhi(unsigned w) { return __uint_as_float(w & 0xffff0000u); }
__device__ __forceinline__ float sigm(float x) { return 1.f / (1.f + __expf(-x)); }
template <int MODE> struct EpiGate {
    static constexpr bool PERM = true, AFTER_DRAIN = false;
    bf16_t* O; int ldc; const bf16_t* G; int ldg; size_t gtile;
    __device__ __forceinline__ void operator()(const f32x4 (&acc)[2][2][4][2], const Unit& u, int wr, int wc, int fr, int fq) const {
        const int row0 = u.pm * BM + wr * 64 + fr, col0 = u.pn * BM + wc * 32 + 8 * fq;
#pragma unroll
        for (int ai = 0; ai < 2; ++ai)
#pragma unroll
            for (int m = 0; m < 4; ++m) { const size_t row = (size_t)(row0 + ai * HALF + m * 16);
#pragma unroll
                for (int bj = 0; bj < 2; ++bj) {
                    const u32x4 gw = __builtin_nontemporal_load((const u32x4*)(G + (size_t)u.pn * gtile + row * ldg + col0 + bj * HALF));
                    f32x4 v0 = acc[ai][bj][m][0], v1 = acc[ai][bj][m][1];
                    v0[0] *= sigm(bflo(gw.x)); v0[1] *= sigm(bfhi(gw.x)); v0[2] *= sigm(bflo(gw.y)); v0[3] *= sigm(bfhi(gw.y));
                    v1[0] *= sigm(bflo(gw.z)); v1[1] *= sigm(bfhi(gw.z)); v1[2] *= sigm(bflo(gw.w)); v1[3] *= sigm(bfhi(gw.w));
                    bf16_t* op = O + row * ldc + col0 + bj * HALF;
                    if (MODE == 1) { const u32x4 ow = *(const u32x4*)op;
                        v0[0] += bflo(ow.x); v0[1] += bfhi(ow.x); v0[2] += bflo(ow.y); v0[3] += bfhi(ow.y);
                        v1[0] += bflo(ow.z); v1[1] += bfhi(ow.z); v1[2] += bflo(ow.w); v1[3] += bfhi(ow.w); }
                    u32x4 w; w.x = cvt_pk_bf16(v0[0], v0[1]); w.y = cvt_pk_bf16(v0[2], v0[3]); w.z = cvt_pk_bf16(v1[0], v1[1]); w.w = cvt_pk_bf16(v1[2], v1[3]);
                    *(u32x4*)op = w; } }
    }
};
struct BranchOrder {
    StaticOrder base; int dm, dn;
    __host__ __device__ void init(int M, int N, int G_, int c_) { base.init(M, N, G_, c_); dm = M / BM; dn = N / BM; }
    __host__ __device__ bool next(int i, Unit& u) const { if (!base.next(i >> 1, u)) return false; if (i & 1) { u.pm += dm; u.pn += dn; } return true; }
    __device__ __forceinline__ void a_ready(const Unit&) const {}
    __device__ __forceinline__ void done(const Unit&) const {}
};
struct EpiGate2 {
    static constexpr bool PERM = true, AFTER_DRAIN = false;
    bf16_t* O; int ldc; const bf16_t* G0; const bf16_t* G1; int ldg; size_t gtile; int dm, dn;
    __device__ __forceinline__ void operator()(const f32x4 (&acc)[2][2][4][2], const Unit& u, int wr, int wc, int fr, int fq) const {
        const bool second = u.pm >= dm;
        Unit v = u; if (second) { v.pm -= dm; v.pn -= dn; }
        if (second) { EpiGate<1> e{O, ldc, G1, ldg, gtile}; e(acc, v, wr, wc, fr, fq); } else { EpiGate<0> e{O, ldc, G0, ldg, gtile}; e(acc, v, wr, wc, fr, fq); }
    }
};
struct EpiResid {
    static constexpr bool PERM = true, AFTER_DRAIN = false;
    const float* R; bf16_t* Hb; float* ss; int ldc;
    __device__ __forceinline__ void operator()(const f32x4 (&acc)[2][2][4][2], const Unit& u, int wr, int wc, int fr, int fq) const {
        const int row0 = u.pm * BM + wr * 64 + fr, col0 = u.pn * BM + wc * 32 + 8 * fq;
#pragma unroll
        for (int ai = 0; ai < 2; ++ai)
#pragma unroll
            for (int m = 0; m < 4; ++m) { const size_t row = (size_t)(row0 + ai * HALF + m * 16); float sq = 0.f;
#pragma unroll
                for (int bj = 0; bj < 2; ++bj) {
                    const size_t off = row * ldc + col0 + bj * HALF;
                    const f32x4 r0 = __builtin_nontemporal_load((const f32x4*)(R + off)), r1 = __builtin_nontemporal_load((const f32x4*)(R + off + 4));
                    const f32x4 v0 = acc[ai][bj][m][0] + r0, v1 = acc[ai][bj][m][1] + r1;
                    u32x4 w; w.x = cvt_pk_bf16(v0[0], v0[1]); w.y = cvt_pk_bf16(v0[2], v0[3]); w.z = cvt_pk_bf16(v1[0], v1[1]); w.w = cvt_pk_bf16(v1[2], v1[3]);
                    *(u32x4*)(Hb + off) = w;
                    sq += (v0[0] * v0[0] + v0[1] * v0[1]) + (v0[2] * v0[2] + v0[3] * v0[3]) + (v1[0] * v1[0] + v1[1] * v1[1]) + (v1[2] * v1[2] + v1[3] * v1[3]); }
                sq += __shfl_xor(sq, 16); sq += __shfl_xor(sq, 32);
                if (fq == 0) atomicAdd(ss + row, sq); }
    }
};
struct EpiRowScale {
    static constexpr bool PERM = true, AFTER_DRAIN = false;
    bf16_t* O; int ldc; const float* ss; float inv_n, eps;
    __device__ __forceinline__ void operator()(const f32x4 (&acc)[2][2][4][2], const Unit& u, int wr, int wc, int fr, int fq) const {
        const int row0 = u.pm * BM + wr * 64 + fr, col0 = u.pn * BM + wc * 32 + 8 * fq;
#pragma unroll
        for (int ai = 0; ai < 2; ++ai)
#pragma unroll
            for (int m = 0; m < 4; ++m) { const size_t row = (size_t)(row0 + ai * HALF + m * 16);
                const float sc = rsqrtf(__hip_atomic_load(ss + row, __ATOMIC_RELAXED, __HIP_MEMORY_SCOPE_AGENT) * inv_n + eps);
#pragma unroll
                for (int bj = 0; bj < 2; ++bj) { const f32x4 v0 = acc[ai][bj][m][0] * sc, v1 = acc[ai][bj][m][1] * sc;
                    u32x4 w; w.x = cvt_pk_bf16(v0[0], v0[1]); w.y = cvt_pk_bf16(v0[2], v0[3]); w.z = cvt_pk_bf16(v1[0], v1[1]); w.w = cvt_pk_bf16(v1[2], v1[3]);
                    *(u32x4*)(O + row * ldc + col0 + bj * HALF) = w; } }
    }
};
}
constexpr int D_MODEL = 2048, BATCH = 2, SEQ = 4096, NTOK = BATCH * SEQ;
constexpr int HD = 64, NCMP = 255, CMP_STRIDE = 16, CMP_LEN = 32, CMP_HID = 128;
constexpr int SEL_LEN = 64, SEL_TOPK = 16, WINDOW = 512;
constexpr int PEER_KEYS = 128, PEER_E = 128;
constexpr int NSA_Q = 1024, SB_W = 1024;
constexpr int IN_COLS = 9776, PLD = 9984;
constexpr int C_SHIFT_FROM = 2608, C_SHIFT = 208, PP = 256;
constexpr int P_QN = 0, P_KC = 4, P_VC = 5, P_KS = 6, P_VS = 7, P_KW = 8, P_VW = 9, P_GBR = 10, P_QB = 11, P_KB = 15, P_VB = 19, P_GA = 23, P_GB = 31;
#define PNL(P, p) ((P) + (size_t)(p) * NTOK * PP)
constexpr float EPS = 1e-6f, NEGF = -1e30f;
constexpr int NWAVES = 8, NTHR = 512;

constexpr size_t MiB = 1u << 20;
constexpr size_t WS_CTL = 0, CTL_ZERO_BYTES = 1 * MiB;
constexpr size_t WS_WIN = 2 * MiB;
constexpr size_t WS_WBN = 42 * MiB, WS_WBS = 46 * MiB;
constexpr size_t WS_WOUT = 50 * MiB, WS_WPQ = 58 * MiB;
constexpr size_t WS_MISC = 66 * MiB;
constexpr size_t WS_XN = 70 * MiB;
constexpr size_t WS_PROJ = 102 * MiB;
constexpr size_t WS_ONSA = 258 * MiB, WS_OSB = 274 * MiB;
constexpr size_t WS_H = 290 * MiB;
constexpr size_t WS_HB = 354 * MiB;
constexpr size_t WS_END = 386 * MiB;
constexpr size_t WS_UB = 102 * MiB, WS_VB = 166 * MiB, WS_QP = 230 * MiB, WS_EXP = 262 * MiB, WS_GATE = 266 * MiB;
constexpr size_t MISC_KCB = 0, MISC_VCB = 1 * MiB, MISC_SKB = 2 * MiB, MISC_W1T = 2 * MiB + 512 * 1024, MISC_B1 = 3 * MiB + 512 * 1024;
constexpr int CW_BAR = 4096;
constexpr int CW_SS = 32768;

#define GAS __attribute__((address_space(1)))
#define LAS __attribute__((address_space(3)))
typedef unsigned short bf16;
typedef unsigned v4u __attribute__((ext_vector_type(4)));
typedef unsigned v2u __attribute__((ext_vector_type(2)));
typedef float f32x4 __attribute__((ext_vector_type(4)));
#define RLX_AGENT __ATOMIC_RELAXED, __HIP_MEMORY_SCOPE_AGENT
__device__ __forceinline__ unsigned f2bf(float f) { unsigned u = __builtin_bit_cast(unsigned, f); return (u + 0x7fffu + ((u >> 16) & 1u)) >> 16; }
__device__ __forceinline__ unsigned pk2(float lo, float hi) { return f2bf(lo) | (f2bf(hi) << 16); }
__device__ __forceinline__ float bf2f(bf16 b) { return __uint_as_float(((unsigned)b) << 16); }
__device__ __forceinline__ float bflo(unsigned w) { return __uint_as_float(w << 16); }
__device__ __forceinline__ float bfhi(unsigned w) { return __uint_as_float(w & 0xffff0000u); }

#define XB_TMO      128
#define XB_XCNT(j)  (256  + 64 * (j))
#define XB_XSUB(j)  (1280 + 64 * (j))
#define XB_XGEN(j)  (2304 + 64 * (j))
#define XB_TOP      3328
#define XB_TOPGEN   3392
#define XCD_BAR_WORDS 3456
#define XB_SPIN_CAP (1u << 24)
__device__ __forceinline__ unsigned xb_ld(unsigned* p)              { return __hip_atomic_load(p, __ATOMIC_RELAXED, __HIP_MEMORY_SCOPE_AGENT); }
__device__ __forceinline__ unsigned xb_add(unsigned* p, unsigned v) { return __hip_atomic_fetch_add(p, v, __ATOMIC_RELAXED, __HIP_MEMORY_SCOPE_AGENT); }
__device__ __forceinline__ unsigned xb_xcc_id() { return (unsigned)__builtin_amdgcn_s_getreg((3 << 11) | 20) & 0xFu; }
#define XB_SPIN(cond, bar) do { unsigned _sp = 0; while (cond) { __builtin_amdgcn_s_sleep(1); \
    if ((++_sp & 255u) == 0u) { if (xb_ld(&(bar)[XB_TMO])) break; if (_sp > XB_SPIN_CAP) { atomicAdd(&(bar)[XB_TMO], 1u); break; } } } } while (0)
struct XcdBarrier { unsigned* bar; unsigned x; volatile LAS unsigned* st; };
__device__ __forceinline__ XcdBarrier xcd_barrier_post(unsigned* bar, volatile LAS unsigned* st) {
    XcdBarrier b; b.bar = bar; b.x = xb_xcc_id(); b.st = st;
    if (threadIdx.x == 0) (void)xb_add(&bar[XB_XCNT(b.x)], 1u);
    return b;
}
__device__ __forceinline__ void xcd_barrier_complete(unsigned* bar, unsigned x, unsigned& nloc, unsigned& nx) {
    const unsigned G = gridDim.x * gridDim.y * gridDim.z;
    unsigned sum, cnt, mine, sp = 0u;
    for (;;) {
        sum = 0u; cnt = 0u; mine = 0u;
#pragma unroll
        for (unsigned j = 0; j < 16; ++j) { const unsigned c = xb_ld(&bar[XB_XCNT(j)]); sum += c; cnt += (c > 0u) ? 1u : 0u; mine = (j == x) ? c : mine; }
        if (sum == G) break;
        __builtin_amdgcn_s_sleep(1);
        if ((++sp & 255u) == 0u) { if (xb_ld(&bar[XB_TMO])) break; if (sp > XB_SPIN_CAP) { atomicAdd(&bar[XB_TMO], 1u); break; } }
    }
    nloc = mine > 0u ? mine : 1u; nx = cnt > 0u ? cnt : 1u;
}
__device__ __forceinline__ void xcd_barrier(const XcdBarrier& b) {
    asm volatile("s_waitcnt vmcnt(0)" ::: "memory");
    __syncthreads();
    if (threadIdx.x == 0) {
        unsigned* bar = b.bar;
        const unsigned bx = xb_xcc_id();
        __builtin_amdgcn_s_waitcnt(0);
        unsigned nloc = b.st[0], nx = b.st[1];
        if (nloc == 0u) { xcd_barrier_complete(bar, bx, nloc, nx); b.st[0] = nloc; b.st[1] = nx; }
        const unsigned old = xb_add(&bar[XB_XSUB(bx)], 1u);
        const unsigned gen = old / nloc;
        if (old + 1u == (gen + 1u) * nloc) {
            __builtin_amdgcn_fence(__ATOMIC_RELEASE, "agent");
            asm volatile("s_waitcnt vmcnt(0)" ::: "memory");
            const unsigned og = xb_add(&bar[XB_TOP], 1u);
            const unsigned tg = og / nx;
            if (og + 1u == (tg + 1u) * nx) xb_add(&bar[XB_TOPGEN], 1u);
            else XB_SPIN(xb_ld(&bar[XB_TOPGEN]) == tg, bar);
            __builtin_amdgcn_fence(__ATOMIC_ACQUIRE, "agent");
            xb_add(&bar[XB_XGEN(bx)], 1u);
            asm volatile("s_waitcnt vmcnt(0)" ::: "memory");
        } else {
            XB_SPIN(xb_ld(&bar[XB_XGEN(bx)]) == gen, bar);
            __builtin_amdgcn_fence(__ATOMIC_ACQUIRE, "agent");
            asm volatile("s_waitcnt vmcnt(0)" ::: "memory");
        }
    }
    __syncthreads();
}

__device__ __forceinline__ int rel_bucket(int d) {
    if (d < 16) return d < 0 ? 0 : d;
    int b = 16;
    b += (d >= 21); b += (d >= 27); b += (d >= 35); b += (d >= 46); b += (d >= 59); b += (d >= 77); b += (d >= 99); b += (d >= 128);
    b += (d >= 166); b += (d >= 216); b += (d >= 280); b += (d >= 363); b += (d >= 470); b += (d >= 609); b += (d >= 790);
    return b;
}
__device__ __forceinline__ float gelu_tanh(float x) { const float k = 0.7978845608028654f; return 0.5f * x * (1.f + tanhf(k * (x + 0.044715f * x * x * x))); }
__device__ __forceinline__ float sigmoidf_(float x) { return 1.f / (1.f + expf(-x)); }
#define DPP_ROR(v, n) __builtin_bit_cast(float, __builtin_amdgcn_update_dpp(0, __builtin_bit_cast(int, (v)), 0x120 + (n), 0xf, 0xf, false))
__device__ __forceinline__ float row_sum16(float v) { v += DPP_ROR(v, 8); v += DPP_ROR(v, 4); v += DPP_ROR(v, 2); v += DPP_ROR(v, 1); return v; }
__device__ __forceinline__ float row_max16(float v) { v = fmaxf(v, DPP_ROR(v, 8)); v = fmaxf(v, DPP_ROR(v, 4)); v = fmaxf(v, DPP_ROR(v, 2)); v = fmaxf(v, DPP_ROR(v, 1)); return v; }
__device__ __forceinline__ float wave_sum(float v) {
    v = row_sum16(v);
    { const auto r = __builtin_amdgcn_permlane16_swap(__float_as_uint(v), __float_as_uint(v), false, false); v = __uint_as_float(r[0]) + __uint_as_float(r[1]); }
    { const auto r = __builtin_amdgcn_permlane32_swap(__float_as_uint(v), __float_as_uint(v), false, false); v = __uint_as_float(r[0]) + __uint_as_float(r[1]); }
    return v;
}
__device__ __forceinline__ float wave_max(float v) {
    v = row_max16(v);
    { const auto r = __builtin_amdgcn_permlane16_swap(__float_as_uint(v), __float_as_uint(v), false, false); v = fmaxf(__uint_as_float(r[0]), __uint_as_float(r[1])); }
    { const auto r = __builtin_amdgcn_permlane32_swap(__float_as_uint(v), __float_as_uint(v), false, false); v = fmaxf(__uint_as_float(r[0]), __uint_as_float(r[1])); }
    return v;
}
__device__ __forceinline__ float gelu_tanh_fast(float x) { const float y2 = x * (1.5957691216057308f + 0.0713548162726f * x * x);
    return x * __builtin_amdgcn_rcpf(1.f + __builtin_amdgcn_exp2f(-1.4426950408889634f * y2)); }
__device__ __forceinline__ float half_sum(float v, float* red) {
    v = wave_sum(v);
    __syncthreads();
    if ((threadIdx.x & 63) == 0) red[(threadIdx.x >> 6) & 3] = v;
    __syncthreads();
    return red[0] + red[1] + red[2] + red[3];
}
__device__ __forceinline__ float half_max(float v, float* red) {
    v = wave_max(v);
    __syncthreads();
    if ((threadIdx.x & 63) == 0) red[(threadIdx.x >> 6) & 3] = v;
    __syncthreads();
    return fmaxf(fmaxf(red[0], red[1]), fmaxf(red[2], red[3]));
}

struct Args {
    const float* in[19]; float* out; unsigned char* ws; int ph_lo, ph_hi; int variant, pad;
};

struct P0Item { const float* W; bf16* WT; const float* gk; int K, N, item, shift_from, shift; };
__device__ __forceinline__ void p0_item_load(const P0Item& d, int lane, f32x4 (&v)[8]) {
    const int nblk = (d.N + 31) / 32, kb = d.item / nblk, nb = d.item % nblk, k0 = 64 * kb, n0 = 32 * nb;
    const int c4 = (lane & 7) * 4, r8 = lane >> 3;
    const bool cok = (n0 + c4) < d.N;
#pragma unroll
    for (int i = 0; i < 8; ++i) { const int kk = 8 * i + r8; v[i] = cok ? __builtin_nontemporal_load((const f32x4*)(d.W + (size_t)(k0 + kk) * d.N + n0 + c4)) : (f32x4){0.f, 0.f, 0.f, 0.f}; }
}
__device__ __forceinline__ void p0_item_store(const P0Item& d, int lane, const f32x4 (&v)[8], LAS float* scr) {
    const int nblk = (d.N + 31) / 32, kb = d.item / nblk, nb = d.item % nblk, k0 = 64 * kb, n0 = 32 * nb;
    const int c4 = (lane & 7) * 4, r8 = lane >> 3;
#pragma unroll
    for (int i = 0; i < 8; ++i) { const int kk = 8 * i + r8; const float g = d.gk ? d.gk[k0 + kk] : 1.f;
        scr[kk * 33 + c4 + 0] = v[i].x * g; scr[kk * 33 + c4 + 1] = v[i].y * g; scr[kk * 33 + c4 + 2] = v[i].z * g; scr[kk * 33 + c4 + 3] = v[i].w * g; }
    asm volatile("s_waitcnt lgkmcnt(0)" ::: "memory");
    const int c = lane & 7;
#pragma unroll
    for (int j = 0; j < 4; ++j) { const int n = (lane >> 3) + 8 * j; const LAS float* s = scr + (8 * c) * 33 + n;
        v4u o; o.x = pk2(s[0 * 33], s[1 * 33]); o.y = pk2(s[2 * 33], s[3 * 33]); o.z = pk2(s[4 * 33], s[5 * 33]); o.w = pk2(s[6 * 33], s[7 * 33]);
        const int nd = n0 + n + ((n0 + n >= d.shift_from) ? d.shift : 0);
        if (n0 + n < d.N) *(v4u*)(d.WT + (size_t)nd * d.K + k0 + 8 * c) = o; }
    asm volatile("s_waitcnt lgkmcnt(0)" ::: "memory");
}
__device__ __forceinline__ void rms_row_to_bf16(const float* xrow, const float* g, bf16* orow, int lane) {
    const f32x4* xr = (const f32x4*)xrow + lane; const f32x4* gr = (const f32x4*)g + lane;
    f32x4 v[8]; float s = 0.f;
#pragma unroll
    for (int j = 0; j < 8; ++j) { v[j] = __builtin_nontemporal_load(xr + 64 * j); s += (v[j].x * v[j].x + v[j].y * v[j].y) + (v[j].z * v[j].z + v[j].w * v[j].w); }
    const float r = rsqrtf(wave_sum(s) * (1.f / D_MODEL) + EPS);
    v2u* o8 = (v2u*)orow + lane;
#pragma unroll
    for (int j = 0; j < 8; ++j) { const f32x4 gv = gr[64 * j]; v2u w; w.x = pk2(v[j].x * r * gv.x, v[j].y * r * gv.y); w.y = pk2(v[j].z * r * gv.z, v[j].w * r * gv.w); o8[64 * j] = w; }
}
__device__ __forceinline__ void cvt_flat(const float* src, bf16* dst, size_t n, size_t gthread, size_t nthreads) {
    for (size_t i = gthread * 8; i < n; i += nthreads * 8) {
        const f32x4 a = *(const f32x4*)(src + i), b = *(const f32x4*)(src + i + 4);
        v4u o; o.x = pk2(a.x, a.y); o.y = pk2(a.z, a.w); o.z = pk2(b.x, b.y); o.w = pk2(b.z, b.w);
        *(v4u*)(dst + i) = o;
    }
}
namespace cmpr {
typedef short bf16x8 __attribute__((ext_vector_type(8)));
typedef float f32x4v __attribute__((ext_vector_type(4)));
__device__ __forceinline__ void compress_phase(const bf16* PROJ, const bf16* W1T, const float* BIAS1, const float* const* in, bf16* KCB, bf16* VCB,
                                               __attribute__((address_space(3))) unsigned char* lds3, int bid, int G) {
    int tid = threadIdx.x; asm volatile("" : "+v"(tid));
    const int lane = tid & 63, wid = __builtin_amdgcn_readfirstlane(tid >> 6), r16 = lane & 15, kq = lane >> 4;
    __attribute__((address_space(3))) float* PART = (__attribute__((address_space(3))) float*)lds3;
    __attribute__((address_space(3))) float* HID = (__attribute__((address_space(3))) float*)(lds3 + 65536);
    __attribute__((address_space(3))) float* W2S = (__attribute__((address_space(3))) float*)(lds3 + 73728);
    for (int unit = bid; unit < 256; unit += G) {
        const int c = unit & 15, g = (unit >> 4) & 3, b = (unit >> 6) & 1, kv = unit >> 7, n0 = 16 * c;
        int nn = n0 + r16; if (nn > NCMP - 1) nn = NCMP - 1;
        const bf16* ap = PNL(PROJ, kv ? P_VC : P_KC) + (size_t)(b * SEQ + 16 * nn + 4 * wid) * PP + g * HD + 8 * kq;
        const bf16* bp = W1T + (size_t)kv * CMP_HID * 2048 + (size_t)r16 * 2048 + 256 * wid + 8 * kq;
        { const float* w2g = in[kv ? 8 : 5];
#pragma unroll
          for (int i = 0; i < 4; ++i) *(__attribute__((address_space(3))) f32x4v*)(W2S + (tid + NTHR * i) * 4) = *(const f32x4v*)(w2g + (tid + NTHR * i) * 4); }
        f32x4v acc[8] = {};
        bf16x8 af[8];
#pragma unroll
        for (int ks = 0; ks < 8; ++ks) af[ks] = *(const bf16x8*)(ap + (size_t)(ks >> 1) * PP + (ks & 1) * 32);
        bf16x8 wa[8], wb[8];
#define CMP_LOADW(W, KS) do { _Pragma("unroll") for (int nt = 0; nt < 8; ++nt) W[nt] = *(const bf16x8*)(bp + (size_t)nt * 16 * 2048 + (KS) * 32); } while (0)
#define CMP_MMA(W, KS) do { _Pragma("unroll") for (int nt = 0; nt < 8; ++nt) acc[nt] = __builtin_amdgcn_mfma_f32_16x16x32_bf16(af[KS], W[nt], acc[nt], 0, 0, 0); } while (0)
        CMP_LOADW(wa, 0);
#pragma unroll
        for (int ks = 0; ks < 8; ks += 2) {
            CMP_LOADW(wb, ks + 1); __builtin_amdgcn_sched_barrier(0);
            CMP_MMA(wa, ks); __builtin_amdgcn_sched_barrier(0);
            if (ks + 2 < 8) CMP_LOADW(wa, ks + 2);
            __builtin_amdgcn_sched_barrier(0);
            CMP_MMA(wb, ks + 1); __builtin_amdgcn_sched_barrier(0);
        }
#undef CMP_LOADW
#undef CMP_MMA
#pragma unroll
        for (int nt = 0; nt < 8; ++nt)
#pragma unroll
            for (int r = 0; r < 4; ++r) PART[wid * 2048 + (kq * 4 + r) * 128 + nt * 16 + r16] = acc[nt][r];
        asm volatile("s_waitcnt lgkmcnt(0)" ::: "memory"); __syncthreads();
#pragma unroll
        for (int i = 0; i < 4; ++i) { const int e = tid + NTHR * i; float s = BIAS1[kv * CMP_HID + (e & 127)];
#pragma unroll
            for (int w = 0; w < 8; ++w) s += PART[w * 2048 + e];
            HID[e] = gelu_tanh(s); }
        asm volatile("s_waitcnt lgkmcnt(0)" ::: "memory"); __syncthreads();
        {
            const int nl = tid >> 5, d = (tid & 31) * 2;
            float o0 = 0.f, o1 = 0.f;
#pragma unroll 8
            for (int j = 0; j < CMP_HID; ++j) { const float hv = HID[nl * 128 + j]; const float wx = W2S[j * HD + d], wy = W2S[j * HD + d + 1]; o0 += hv * wx; o1 += hv * wy; }
            const int n = n0 + nl;
            const unsigned pk = (n < NCMP) ? pk2(o0, o1) : 0u;
            *(unsigned*)((kv ? VCB : KCB) + (size_t)((b * 4 + g) * 256 + n) * HD + d) = pk;
        }
        __syncthreads();
    }
}
}
#ifndef NSA_FAR
#define NSA_FAR 1
#endif
namespace nsa {
typedef short bf16x8 __attribute__((ext_vector_type(8)));
typedef short s16x4 __attribute__((ext_vector_type(4)));
typedef float f32x16 __attribute__((ext_vector_type(16)));
typedef unsigned u32x4 __attribute__((ext_vector_type(4)));
typedef __attribute__((address_space(3))) const char* lds_cptr;
typedef __attribute__((address_space(3))) unsigned char* lds_ptr;
constexpr int SLOTB = 16384;
constexpr int NSLOT = 4;
constexpr int L_RING = 0, L_OV = 65536, L_BT = 98304, L_WSF = 111104, L_MASK = 113152, L_MISC = 113664, L_X = 113792, L_END = L_X + 32768;
constexpr int BT_N = 800;
constexpr float LOG2E = 1.4426950408889634f, SC2 = 0.125f * LOG2E, NEG2 = -1e30f;
static_assert(L_END <= 162816, "nsa LDS map");
__device__ __forceinline__ int crow(int r, int hi) { return (r & 3) + 8 * (r >> 2) + 4 * hi; }
__device__ __forceinline__ void glds16(const void* gsrc, unsigned lds_dst) { unsigned keep;
    asm volatile("s_mov_b32 %0, m0\n\ts_mov_b32 m0, %2\n\ts_nop 0\n\tglobal_load_lds_dwordx4 %1, off\n\ts_mov_b32 m0, %0" : "=&s"(keep) : "v"(gsrc), "s"(lds_dst) : "memory"); }
typedef float f32x2_t __attribute__((ext_vector_type(2))); typedef __bf16 bf16x2_t __attribute__((ext_vector_type(2)));
__device__ __forceinline__ unsigned cvtpk_s(float lo, float hi) { f32x2_t v = {lo, hi}; bf16x2_t b = __builtin_convertvector(v, bf16x2_t); return __builtin_bit_cast(unsigned, b); }
#define NSA_WAIT_BAR(N) asm volatile("s_waitcnt vmcnt(" #N ") lgkmcnt(0)\n\ts_barrier" ::: "memory")
#define NSA_SBAR() __builtin_amdgcn_sched_barrier(0)

__device__ __forceinline__ void qkt(f32x16& p0, f32x16& p1, lds_cptr Kslot, const bf16x8* qr, int r32, int hi) {
    lds_cptr kb = Kslot + hi * 1024 + r32 * 16;
    const f32x16 z = {};
#pragma unroll
    for (int d0 = 0; d0 < 4; ++d0) {
        const bf16x8 b0 = *(const __attribute__((address_space(3))) bf16x8*)(kb + d0 * 2048);
        const bf16x8 b1 = *(const __attribute__((address_space(3))) bf16x8*)(kb + d0 * 2048 + 512);
        if (d0 == 0) { p0 = __builtin_amdgcn_mfma_f32_32x32x16_bf16(b0, qr[0], z, 0, 0, 0); p1 = __builtin_amdgcn_mfma_f32_32x32x16_bf16(b1, qr[0], z, 0, 0, 0); }
        else { p0 = __builtin_amdgcn_mfma_f32_32x32x16_bf16(b0, qr[d0], p0, 0, 0, 0); p1 = __builtin_amdgcn_mfma_f32_32x32x16_bf16(b1, qr[d0], p1, 0, 0, 0); }
    }
}
__device__ __forceinline__ void pv(f32x16* o, int vb, bf16x8 pa0, bf16x8 pa1, bf16x8 pa2, bf16x8 pa3) {
#pragma unroll
    for (int d0 = 0; d0 < 2; ++d0) { s16x4 lo[4], hi[4];
#pragma unroll
        for (int ks = 0; ks < 4; ++ks) {
            asm volatile("ds_read_b64_tr_b16 %0,%1 offset:%c2" : "=&v"(lo[ks]) : "v"(vb), "i"(d0 * 4096 + ks * 1024) : "memory");
            asm volatile("ds_read_b64_tr_b16 %0,%1 offset:%c2" : "=&v"(hi[ks]) : "v"(vb), "i"(d0 * 4096 + ks * 1024 + 512) : "memory"); }
        asm volatile("s_waitcnt lgkmcnt(0)" ::: "memory"); NSA_SBAR();
#define NSA_PK(k) (bf16x8){lo[k][0], lo[k][1], lo[k][2], lo[k][3], hi[k][0], hi[k][1], hi[k][2], hi[k][3]}
        o[d0] = __builtin_amdgcn_mfma_f32_32x32x16_bf16(pa0, NSA_PK(0), o[d0], 0, 0, 0);
        o[d0] = __builtin_amdgcn_mfma_f32_32x32x16_bf16(pa1, NSA_PK(1), o[d0], 0, 0, 0);
        o[d0] = __builtin_amdgcn_mfma_f32_32x32x16_bf16(pa2, NSA_PK(2), o[d0], 0, 0, 0);
        o[d0] = __builtin_amdgcn_mfma_f32_32x32x16_bf16(pa3, NSA_PK(3), o[d0], 0, 0, 0);
#undef NSA_PK
    }
}
__device__ __forceinline__ float rowmax32(const f32x16& p0, const f32x16& p1) {
    float a = fmaxf(p0[0], p1[0]), b = fmaxf(p0[1], p1[1]);
#pragma unroll
    for (int r = 2; r < 16; r += 2) { a = fmaxf(fmaxf(a, p0[r]), p1[r]); b = fmaxf(fmaxf(b, p0[r + 1]), p1[r + 1]); }
    a = fmaxf(a, b);
    auto rr = __builtin_amdgcn_permlane32_swap(__float_as_uint(a), __float_as_uint(a), false, false);
    return fmaxf(__uint_as_float(rr[0]), __uint_as_float(rr[1]));
}
__device__ __forceinline__ float sum16(const f32x16& p) {
    float a, b;
    asm volatile("s_nop 0\n\tv_add_f32 %0, %2, %3\n\tv_add_f32 %1, %4, %5\n\tv_add_f32 %0, %0, %6\n\tv_add_f32 %1, %1, %7\n\tv_add_f32 %0, %0, %8\n\tv_add_f32 %1, %1, %9\n\t"
                 "v_add_f32 %0, %0, %10\n\tv_add_f32 %1, %1, %11\n\tv_add_f32 %0, %0, %12\n\tv_add_f32 %1, %1, %13\n\tv_add_f32 %0, %0, %14\n\tv_add_f32 %1, %1, %15\n\t"
                 "v_add_f32 %0, %0, %16\n\tv_add_f32 %1, %1, %17\n\tv_add_f32 %0, %0, %1"
                 : "=&v"(a), "=&v"(b)
                 : "v"(p[0]), "v"(p[1]), "v"(p[2]), "v"(p[3]), "v"(p[4]), "v"(p[5]), "v"(p[6]), "v"(p[7]), "v"(p[8]), "v"(p[9]), "v"(p[10]), "v"(p[11]), "v"(p[12]), "v"(p[13]), "v"(p[14]), "v"(p[15]));
    return a;
}
__device__ __forceinline__ float swap_add(float v) {
    auto rr = __builtin_amdgcn_permlane32_swap(__float_as_uint(v), __float_as_uint(v), false, false);
    return __uint_as_float(rr[0]) + __uint_as_float(rr[1]);
}

struct PassCtx {
    lds_ptr lds3; unsigned lds0;
    int lane, r32, hi, wid;
    int tq;
    const __attribute__((address_space(3))) float* bt;
    __attribute__((address_space(3))) float* wsf;
    int vboff;
};

template <int MODE>
__device__ __forceinline__ void run_pass(const PassCtx& c, int NT, int first, const bf16* Kb, const bf16* Vb, int pitch, const bf16x8* qr,
                                         unsigned mask_lo, unsigned mask_hi, f32x16 (&o)[2], f32x16 (&im)[2], float& m, float& l) {
    const __attribute__((address_space(3))) unsigned char* TL = (const __attribute__((address_space(3))) unsigned char*)(c.lds3 + L_MISC);
#define NSA_TID(i) ((MODE == 0) ? (i) : (MODE == 2) ? (first + (i)) : (int)TL[NT - 1 - (i)])
#define NSA_ISSUE(i, slot) do { const int id_ = __builtin_amdgcn_readfirstlane(NSA_TID(i)); \
        const bf16* ks_ = Kb + (size_t)(64 * id_ + c.lane) * pitch + 8 * c.wid; \
        const bf16* vs_ = Vb + (size_t)(64 * id_ + 16 * (c.wid & 3) + (c.lane >> 2)) * pitch + 32 * (c.wid >> 2) + 8 * (c.lane & 3); \
        glds16(ks_, (unsigned)__builtin_amdgcn_readfirstlane(c.lds0 + L_RING + (slot) * SLOTB + c.wid * 1024)); \
        glds16(vs_, (unsigned)__builtin_amdgcn_readfirstlane(c.lds0 + L_RING + (slot) * SLOTB + 8192 + c.wid * 1024)); } while (0)
    if (NT > 0) NSA_ISSUE(0, 0);
    if (NT > 1) NSA_ISSUE(1, 1);
    if (NT > 2) NSA_ISSUE(2, 2);
    int slot = 0;
    for (int i = 0; i < NT; ++i) {
        if (i + 2 < NT) NSA_WAIT_BAR(4); else if (i + 1 < NT) NSA_WAIT_BAR(2); else NSA_WAIT_BAR(0);
        if (i + 3 < NT) { const int s3 = (slot == 0) ? 3 : slot - 1; NSA_ISSUE(i + 3, s3); }
        const int id = __builtin_amdgcn_readfirstlane(NSA_TID(i));
        f32x16 p0, p1;
        qkt(p0, p1, (lds_cptr)(c.lds3 + L_RING + slot * SLOTB), qr, c.r32, c.hi);
        const int dbase = (MODE == 0) ? (c.tq - 31 - 1024 * id) : (c.tq - 64 * id);
        bool selb = true;
        if (MODE == 1) selb = ((id < 32 ? (mask_lo >> id) : (mask_hi >> (id - 32))) & 1u) != 0u;
        float alpha, rs;
        if (NSA_FAR && MODE == 1 && __builtin_amdgcn_readfirstlane(c.tq - c.r32) - (64 * id + 63) >= 790) {
            const float lofs = selb ? c.bt[790] : -INFINITY;
            const float mt = rowmax32(p0, p1) * SC2 + lofs;
            const float mnew = fmaxf(m, mt);
            alpha = __builtin_amdgcn_exp2f(m - mnew);
            m = mnew;
            const float off = lofs - mnew;
#pragma unroll
            for (int r = 0; r < 16; ++r) { p0[r] = __builtin_amdgcn_exp2f(p0[r] * SC2 + off); p1[r] = __builtin_amdgcn_exp2f(p1[r] * SC2 + off); }
        } else {
        int dbh = dbase - ((MODE == 0) ? 64 * c.hi : 4 * c.hi);
        asm volatile("" : "+v"(dbh));
#pragma unroll
        for (int r = 0; r < 16; ++r) {
            const int d0 = dbh - ((MODE == 0) ? 16 * ((r & 3) + 8 * (r >> 2)) : ((r & 3) + 8 * (r >> 2)));
            const int d1 = (MODE == 0) ? (d0 - 512) : (d0 - 32);
            bool v0 = d0 >= 0, v1 = d1 >= 0;
            if (MODE == 2) { v0 = v0 && d0 < WINDOW; v1 = v1 && d1 < WINDOW; }
            if (MODE == 1) { v0 = v0 && selb; v1 = v1 && selb; }
            const int i0 = d0 < 0 ? 0 : (d0 > 790 ? 790 : d0), i1 = d1 < 0 ? 0 : (d1 > 790 ? 790 : d1);
            const float s0 = p0[r] * SC2 + c.bt[i0], s1 = p1[r] * SC2 + c.bt[i1];
            p0[r] = v0 ? s0 : -INFINITY; p1[r] = v1 ? s1 : -INFINITY;
        }
        const float mt = rowmax32(p0, p1);
        const float mnew = fmaxf(m, mt);
        alpha = __builtin_amdgcn_exp2f(m - mnew);
        m = mnew;
#pragma unroll
        for (int r = 0; r < 16; ++r) {
            const float e0 = __builtin_amdgcn_exp2f(p0[r] - mnew), e1 = __builtin_amdgcn_exp2f(p1[r] - mnew);
            p0[r] = e0; p1[r] = e1;
        }
        }
        rs = sum16(p0) + sum16(p1);
        l = l * alpha + rs;
        if (!__all(alpha == 1.f)) {
            if (c.hi == 0) c.wsf[c.r32] = alpha;
            asm volatile("s_waitcnt lgkmcnt(0)" ::: "memory");
#pragma unroll
            for (int r = 0; r < 16; ++r) { const float a = c.wsf[crow(r, c.hi)]; o[0][r] *= a; o[1][r] *= a; if (MODE == 0) { im[0][r] *= a; im[1][r] *= a; } }
        }
        u32x4 pw0, pw1, pw2, pw3;
        pw0 = (u32x4){cvtpk_s(p0[0], p0[1]), cvtpk_s(p0[2], p0[3]), cvtpk_s(p0[4], p0[5]), cvtpk_s(p0[6], p0[7])};
        pw1 = (u32x4){cvtpk_s(p0[8], p0[9]), cvtpk_s(p0[10], p0[11]), cvtpk_s(p0[12], p0[13]), cvtpk_s(p0[14], p0[15])};
        pw2 = (u32x4){cvtpk_s(p1[0], p1[1]), cvtpk_s(p1[2], p1[3]), cvtpk_s(p1[4], p1[5]), cvtpk_s(p1[6], p1[7])};
        pw3 = (u32x4){cvtpk_s(p1[8], p1[9]), cvtpk_s(p1[10], p1[11]), cvtpk_s(p1[12], p1[13]), cvtpk_s(p1[14], p1[15])};
        NSA_SBAR();
        pv(o, (int)(c.lds0 + L_RING + slot * SLOTB + 8192) + c.vboff, __builtin_bit_cast(bf16x8, pw0), __builtin_bit_cast(bf16x8, pw1), __builtin_bit_cast(bf16x8, pw2), __builtin_bit_cast(bf16x8, pw3));
        if (MODE == 0) pv(im, (int)(c.lds0 + L_OV + id * 8192) + c.vboff, __builtin_bit_cast(bf16x8, pw0), __builtin_bit_cast(bf16x8, pw1), __builtin_bit_cast(bf16x8, pw2), __builtin_bit_cast(bf16x8, pw3));
        slot = (slot == NSLOT - 1) ? 0 : slot + 1;
    }
    asm volatile("s_waitcnt vmcnt(0) lgkmcnt(0)\n\ts_barrier" ::: "memory");
#undef NSA_TID
#undef NSA_ISSUE
}

__device__ __forceinline__ void build_ov(lds_ptr lds3) {
    for (int idx = threadIdx.x; idx < 4 * 4096; idx += NTHR) {
        const int kt = idx >> 12, nl = (idx >> 6) & 63, jc = idx & 63, n = 64 * kt + nl;
        unsigned short v = 0;
        if ((n & 3) != 3) { if (jc == (n >> 2)) v = 0x3F80; } else { if (jc == (n >> 2) || jc == (n >> 2) + 1) v = 0x3F00; }
        *(__attribute__((address_space(3))) unsigned short*)(lds3 + L_OV + kt * 8192 + ((jc >> 5) * 4 + (nl >> 4)) * 1024 + (nl & 15) * 64 + (jc & 31) * 2) = v;
    }
}

__device__ __forceinline__ void nsa_unit(int variant, bool build_bt, int b, int g, int qt, const bf16* PROJ, const bf16* KCBb, const bf16* VCBb, const float* rel, bf16* ONSA, lds_ptr lds3, unsigned lds0) {
    const int tid = threadIdx.x, lane = tid & 63, r32 = lane & 31, hi = lane >> 5;
    const int wid = __builtin_amdgcn_readfirstlane(tid >> 6), hh = wid & 3, th = wid >> 2;
    const int t0 = qt * 64, tq = t0 + 32 * th + r32, cur = qt;
    __attribute__((address_space(3))) float* BT = (__attribute__((address_space(3))) float*)(lds3 + L_BT);
    __attribute__((address_space(3))) unsigned* MASK = (__attribute__((address_space(3))) unsigned*)(lds3 + L_MASK);
    if (build_bt) for (int i = tid; i < 4 * BT_N; i += NTHR) BT[i] = rel[g * 4 * BT_N + i];
    if (tid < 128) MASK[tid] = 0u;
    PassCtx c; c.lds3 = lds3; c.lds0 = lds0; c.lane = lane; c.r32 = r32; c.hi = hi; c.wid = wid; c.tq = tq;
    c.bt = BT + hh * BT_N; c.wsf = (__attribute__((address_space(3))) float*)(lds3 + L_WSF) + wid * 64;
    c.vboff = ((lane >> 4) & 1) * 32 + (lane & 3) * 8 + (4 * hi + ((lane & 15) >> 2)) * 64;
    const size_t qrow = (size_t)(b * SEQ + tq) * PP;
    bf16x8 qr[4];
#pragma unroll
    for (int d0 = 0; d0 < 4; ++d0) qr[d0] = *(const bf16x8*)(PNL(PROJ, P_QN + g) + qrow + hh * HD + d0 * 16 + hi * 8);
    const float gate0 = 1.f / (1.f + __expf(-bf2f(PNL(PROJ, P_GBR)[qrow + 0 * 16 + g * 4 + hh])));
    const float gate1 = 1.f / (1.f + __expf(-bf2f(PNL(PROJ, P_GBR)[qrow + 1 * 16 + g * 4 + hh])));
    const float gate2 = 1.f / (1.f + __expf(-bf2f(PNL(PROJ, P_GBR)[qrow + 2 * 16 + g * 4 + hh])));
    asm volatile("s_waitcnt vmcnt(0) lgkmcnt(0)" ::: "memory");
    __syncthreads();
    f32x16 oc[2] = {}, o[2] = {}, im[2] = {};
    float m = NEG2, l = 0.f;
    {
        int cnt = (t0 + 32) / 16 + 1; if (cnt > NCMP) cnt = NCMP;
        const int NT = (variant & 4) ? 0 : ((cnt + 63) >> 6);
#if defined(PROBE_NSA_CMP2)
        run_pass<0>(c, NT, 0, KCBb + (size_t)(b * 4 + g) * 256 * HD, VCBb + (size_t)(b * 4 + g) * 256 * HD, HD, qr, 0u, 0u, o, im, m, l);
        o[0] = f32x16{}; o[1] = f32x16{}; im[0] = f32x16{}; im[1] = f32x16{}; m = NEG2; l = 0.f;
#endif
        run_pass<0>(c, NT, 0, KCBb + (size_t)(b * 4 + g) * 256 * HD, VCBb + (size_t)(b * 4 + g) * 256 * HD, HD, qr, 0u, 0u, o, im, m, l);
        const float lt = swap_add(l);
        const float inv = lt > 0.f ? 1.f / lt : 0.f;
        if (hi == 0) { c.wsf[r32] = inv * gate0; c.wsf[32 + r32] = inv; }
        asm volatile("s_waitcnt lgkmcnt(0)" ::: "memory");
#pragma unroll
        for (int r = 0; r < 16; ++r) { const float a = c.wsf[crow(r, hi)], a2 = c.wsf[32 + crow(r, hi)]; oc[0][r] = o[0][r] * a; oc[1][r] = o[1][r] * a; im[0][r] *= a2; im[1][r] *= a2; }
        if (!(variant & 8)) {
        {
            __attribute__((address_space(3))) float* PW = (__attribute__((address_space(3))) float*)(lds3 + L_RING) + wid * 2048;
#pragma unroll
            for (int d0 = 0; d0 < 2; ++d0)
#pragma unroll
                for (int r = 0; r < 16; ++r) PW[crow(r, hi) * 64 + d0 * 32 + r32] = im[d0][r];
        }
        asm volatile("s_waitcnt lgkmcnt(0)" ::: "memory"); __syncthreads();
        __attribute__((address_space(3))) float* T = (__attribute__((address_space(3))) float*)(lds3 + L_X);
        {
            const __attribute__((address_space(3))) float* PA = (const __attribute__((address_space(3))) float*)(lds3 + L_RING);
            int tx = tid; asm volatile("" : "+v"(tx));
            const int j = tx & 63, tb = (tx >> 6) * 8;
#pragma unroll
            for (int e = 0; e < 8; ++e) { const int tok = tb + e, w0 = (tok >> 5) * 4, q = tok & 31;
                T[tok * 65 + j] = (PA[(w0 + 0) * 2048 + q * 64 + j] + PA[(w0 + 1) * 2048 + q * 64 + j]) + (PA[(w0 + 2) * 2048 + q * 64 + j] + PA[(w0 + 3) * 2048 + q * 64 + j]); }
        }
        asm volatile("s_waitcnt lgkmcnt(0)" ::: "memory"); __syncthreads();
        {
            int ty = tid; asm volatile("" : "+v"(ty));
            const int tok = ty & 63, jg = wid, jlo = 8 * jg;
            float v[8]; int rank[8];
#pragma unroll
            for (int e = 0; e < 8; ++e) { const int j = jlo + e; const bool forced = (j == 0) || (j == cur) || (j == cur - 1);
                v[e] = (j <= cur) ? T[tok * 65 + j] + (forced ? 1e4f : 0.f) : -INFINITY; rank[e] = 0; }
            const int nA = jlo < cur + 1 ? jlo : cur + 1, nB = (jlo + 8) < cur + 1 ? (jlo + 8) : cur + 1;
#pragma unroll 2
            for (int j2 = 0; j2 < nA; ++j2) {
                const float sv = T[tok * 65 + j2] + (((j2 == 0) || (j2 == cur) || (j2 == cur - 1)) ? 1e4f : 0.f);
#pragma unroll
                for (int e = 0; e < 8; ++e) rank[e] += (sv >= v[e]) ? 1 : 0;
            }
            for (int j2 = jlo; j2 < nB; ++j2) {
                const float sv = T[tok * 65 + j2] + (((j2 == 0) || (j2 == cur) || (j2 == cur - 1)) ? 1e4f : 0.f);
#pragma unroll
                for (int e = 0; e < 8; ++e) rank[e] += (sv > v[e] || (sv == v[e] && j2 < jlo + e)) ? 1 : 0;
            }
#pragma unroll 2
            for (int j2 = jlo + 8; j2 <= cur; ++j2) {
                const float sv = T[tok * 65 + j2] + (((j2 == 0) || (j2 == cur) || (j2 == cur - 1)) ? 1e4f : 0.f);
#pragma unroll
                for (int e = 0; e < 8; ++e) rank[e] += (sv > v[e]) ? 1 : 0;
            }
            unsigned bits = 0u;
#pragma unroll
            for (int e = 0; e < 8; ++e) { const int j = jlo + e; if (j <= cur && rank[e] < SEL_TOPK) bits |= 1u << e; }
            if (bits) atomicOr((unsigned*)(MASK + tok * 2 + (jg >> 2)), bits << ((jg & 3) * 8));
        }
        asm volatile("s_waitcnt lgkmcnt(0)" ::: "memory"); __syncthreads();
        if (wid == 0) {
            unsigned ulo = MASK[lane * 2], uhi = MASK[lane * 2 + 1];
#pragma unroll
            for (int ofs = 32; ofs >= 1; ofs >>= 1) { ulo |= __shfl_xor(ulo, ofs); uhi |= __shfl_xor(uhi, ofs); }
            {
                __attribute__((address_space(3))) unsigned char* TL = (__attribute__((address_space(3))) unsigned char*)(lds3 + L_MISC);
                const unsigned long long mm = ((unsigned long long)uhi << 32) | ulo;
                int ln = lane; asm volatile("" : "+v"(ln));
                if ((mm >> ln) & 1ull) TL[__popcll(mm & ((1ull << ln) - 1ull))] = (unsigned char)ln;
                if (lane == 0) *(__attribute__((address_space(3))) int*)(lds3 + L_MISC + 64) = __popcll(mm);
            }
        }
        asm volatile("s_waitcnt lgkmcnt(0)" ::: "memory"); __syncthreads();
        }
    }
    {
        const unsigned mlo = MASK[(32 * th + r32) * 2], mhi = MASK[(32 * th + r32) * 2 + 1];
        const int NT = (variant & 1) ? 0 : __builtin_amdgcn_readfirstlane(*(__attribute__((address_space(3))) int*)(lds3 + L_MISC + 64));
#if defined(PROBE_NSA_SEL2)
        o[0] = f32x16{}; o[1] = f32x16{}; m = NEG2; l = 0.f;
        run_pass<1>(c, NT, 0, PNL(PROJ, P_KS) + (size_t)b * SEQ * PP + g * HD, PNL(PROJ, P_VS) + (size_t)b * SEQ * PP + g * HD, PP, qr, mlo, mhi, o, im, m, l);
#endif
        o[0] = f32x16{}; o[1] = f32x16{}; m = NEG2; l = 0.f;
        run_pass<1>(c, NT, 0, PNL(PROJ, P_KS) + (size_t)b * SEQ * PP + g * HD, PNL(PROJ, P_VS) + (size_t)b * SEQ * PP + g * HD, PP, qr, mlo, mhi, o, im, m, l);
        const float lt = swap_add(l);
        const float inv = lt > 0.f ? 1.f / lt : 0.f;
        if (hi == 0) c.wsf[r32] = inv * gate1;
        asm volatile("s_waitcnt lgkmcnt(0)" ::: "memory");
#pragma unroll
        for (int r = 0; r < 16; ++r) { const float a = c.wsf[crow(r, hi)]; oc[0][r] += o[0][r] * a; oc[1][r] += o[1][r] * a; }
    }
    {
        const int jlo = (qt - 8) > 0 ? (qt - 8) : 0, NT = (variant & 2) ? 0 : (qt - jlo + 1);
#if defined(PROBE_NSA_WIN2)
        o[0] = f32x16{}; o[1] = f32x16{}; m = NEG2; l = 0.f;
        run_pass<2>(c, NT, jlo, PNL(PROJ, P_KW) + (size_t)b * SEQ * PP + g * HD, PNL(PROJ, P_VW) + (size_t)b * SEQ * PP + g * HD, PP, qr, 0u, 0u, o, im, m, l);
#endif
        o[0] = f32x16{}; o[1] = f32x16{}; m = NEG2; l = 0.f;
        run_pass<2>(c, NT, jlo, PNL(PROJ, P_KW) + (size_t)b * SEQ * PP + g * HD, PNL(PROJ, P_VW) + (size_t)b * SEQ * PP + g * HD, PP, qr, 0u, 0u, o, im, m, l);
        const float lt = swap_add(l);
        const float inv = lt > 0.f ? 1.f / lt : 0.f;
        if (hi == 0) c.wsf[r32] = inv * gate2;
        asm volatile("s_waitcnt lgkmcnt(0)" ::: "memory");
#pragma unroll
        for (int r = 0; r < 16; ++r) { const float a = c.wsf[crow(r, hi)]; oc[0][r] += o[0][r] * a; oc[1][r] += o[1][r] * a; }
    }
    {
        __attribute__((address_space(3))) unsigned short* stg = (__attribute__((address_space(3))) unsigned short*)(lds3 + L_X) + wid * 2048;
#pragma unroll
        for (int r = 0; r < 16; ++r) { const int orow = crow(r, hi);
#pragma unroll
            for (int d0 = 0; d0 < 2; ++d0) stg[orow * 64 + d0 * 32 + r32] = (unsigned short)f2bf(oc[d0][r]); }
        asm volatile("s_waitcnt lgkmcnt(0)" ::: "memory");
        bf16* Ow = ONSA + (size_t)(b * SEQ + t0 + 32 * th) * NSA_Q + (g * 4 + hh) * HD;
#pragma unroll
        for (int i = 0; i < 4; ++i) { const int row = i * 8 + (lane >> 3), ch = lane & 7;
            const u32x4 vv = *(const __attribute__((address_space(3))) u32x4*)(stg + row * 64 + ch * 8);
            *(u32x4*)(Ow + (size_t)row * NSA_Q + ch * 8) = vv; }
    }
    asm volatile("s_waitcnt vmcnt(0) lgkmcnt(0)" ::: "memory");
    __syncthreads();
}

__device__ __forceinline__ void nsa_phase(const bf16* PROJ, const bf16* KCBb, const bf16* VCBb, const float* rel, bf16* ONSA, lds_ptr lds3, int vcu, int G, int variant) {
    const unsigned lds0 = (unsigned)(uintptr_t)lds3;
    build_ov(lds3);
    __syncthreads();
    int last_g = -1;
#ifndef NSA_REP
#define NSA_REP 1
#endif
#pragma unroll 1
    for (int rep_ = 0; rep_ < NSA_REP; ++rep_)
#pragma unroll 1
    for (int i = vcu; i < 512; i += G) {
        const int k = i & 255, bg = k >> 5, s = k & 31, qt = (i < 256) ? s : 63 - s;
        if (!(variant & 16)) nsa_unit(variant, (bg & 3) != last_g, bg >> 2, bg & 3, qt, PROJ, KCBb, VCBb, rel, ONSA, lds3, lds0);
        last_g = bg & 3;
    }
}
#undef NSA_WAIT_BAR
#undef NSA_SBAR
}
namespace nsa {
constexpr float STICK_THR = 50.f, LN2F = 0.6931471805599453f;
constexpr int STK_SLOTB = 32768;
static_assert(3 * STK_SLOTB <= L_WSF, "stick ring vs the LDS words it shares with the NSA map");
#define NSA_WAIT_BAR(N) asm volatile("s_waitcnt vmcnt(" #N ") lgkmcnt(0)\n\ts_barrier" ::: "memory")
__device__ __forceinline__ void stick_unit(int tid, int b, int hp, int qb, const bf16* PROJ, bf16* OSB, lds_ptr lds3, unsigned lds0, const bf16x8 (&tri)[2]) {
    const int lane = tid & 63, r32 = lane & 31, hi = lane >> 5;
    const int wid = __builtin_amdgcn_readfirstlane(tid >> 6);
    const int hs = wid >> 2, qw = wid & 3, h = 2 * hp + hs;
    const int q0 = qb * 128, t = q0 + 32 * qw + r32;
    const bf16* Kb = PNL(PROJ, P_KB + (hp >> 1)) + (size_t)b * SEQ * PP + (hp & 1) * 128;
    const bf16* Vb = PNL(PROJ, P_VB + (hp >> 1)) + (size_t)b * SEQ * PP + (hp & 1) * 128;
    __attribute__((address_space(3))) int* DONE = (__attribute__((address_space(3))) int*)(lds3 + L_MISC);
    bf16x8 qr[4];
#pragma unroll
    for (int d0 = 0; d0 < 4; ++d0) qr[d0] = *(const bf16x8*)(PNL(PROJ, P_QB + (h >> 2)) + (size_t)(b * SEQ + t) * PP + (h & 3) * HD + d0 * 16 + hi * 8);
    if (tid < 8) DONE[tid] = 0x7fffffff;
    asm volatile("s_waitcnt vmcnt(0) lgkmcnt(0)" ::: "memory");
    __syncthreads();
    const int jhi = 2 * qb + 1, NT = jhi + 1;
    const int jw = (q0 + 32 * qw + 30) >> 6;
    const int vboff = ((lane >> 4) & 1) * 32 + (lane & 3) * 8 + (4 * hi + ((lane & 15) >> 2)) * 64;
    f32x16 o[2] = {};
    float carry = 0.f; bool mydone = false;
#define STK_ISSUE(i, slot) do { const int id_ = jhi - (i); \
        const bf16* ks_ = Kb + (size_t)(64 * id_ + lane) * PP + 8 * wid; \
        const bf16* vs_ = Vb + (size_t)(64 * id_ + 16 * (wid & 3) + (lane >> 2)) * PP + 32 * (wid >> 2) + 8 * (lane & 3); \
        glds16(ks_, (unsigned)__builtin_amdgcn_readfirstlane(lds0 + L_RING + (slot) * STK_SLOTB + wid * 1024)); \
        glds16(vs_, (unsigned)__builtin_amdgcn_readfirstlane(lds0 + L_RING + (slot) * STK_SLOTB + 8192 + wid * 1024)); \
        glds16(ks_ + 64, (unsigned)__builtin_amdgcn_readfirstlane(lds0 + L_RING + (slot) * STK_SLOTB + 16384 + wid * 1024)); \
        glds16(vs_ + 64, (unsigned)__builtin_amdgcn_readfirstlane(lds0 + L_RING + (slot) * STK_SLOTB + 24576 + wid * 1024)); } while (0)
    STK_ISSUE(0, 0);
    if (NT > 1) STK_ISSUE(1, 1);
    int slot = 0;
    for (int i = 0; i < NT; ++i) {
        if (i + 1 < NT) NSA_WAIT_BAR(4); else NSA_WAIT_BAR(0);
        bool alld = true;
#pragma unroll
        for (int w = 0; w < 8; ++w) alld = alld && (DONE[w] < i);
        if (__builtin_amdgcn_readfirstlane((int)alld)) break;
        if (i + 2 < NT) { const int s2 = (slot == 0) ? 2 : slot - 1; STK_ISSUE(i + 2, s2); }
        const int j = jhi - i;
        if (!mydone && j <= jw) {
            f32x16 p0, p1, x0, x1;
            qkt(p0, p1, (lds_cptr)(lds3 + L_RING + slot * STK_SLOTB + hs * 16384), qr, r32, hi);
            float s0 = 0.f, s1 = 0.f;
#pragma unroll
            for (int r = 0; r < 16; ++r) {
                const int pos0 = 64 * j + crow(r, hi);
                const float z0 = p0[r] * 0.125f, z1 = p1[r] * 0.125f;
                const float L0 = __builtin_amdgcn_logf(1.f + __builtin_amdgcn_exp2f(-fabsf(z0) * LOG2E)) * LN2F;
                const float L1 = __builtin_amdgcn_logf(1.f + __builtin_amdgcn_exp2f(-fabsf(z1) * LOG2E)) * LN2F;
                p0[r] = fminf(z0, 0.f) - L0; p1[r] = fminf(z1, 0.f) - L1;
                x0[r] = (pos0 < t) ? (-fmaxf(z0, 0.f) - L0) : 0.f; x1[r] = (pos0 + 32 < t) ? (-fmaxf(z1, 0.f) - L1) : 0.f;
                s0 += x0[r]; s1 += x1[r];
            }
            const float tot0 = swap_add(s0), tot1 = swap_add(s1);
            u32x4 h0a, h0b, l0a, l0b, h1a, h1b, l1a, l1b;
#define STK_SPLIT(X, HA, HB, LA, LB) do { unsigned hw_[8]; float lo_[16]; \
                _Pragma("unroll") for (int q_ = 0; q_ < 8; ++q_) { hw_[q_] = cvtpk_s(X[2 * q_], X[2 * q_ + 1]); \
                    lo_[2 * q_] = X[2 * q_] - __uint_as_float(hw_[q_] << 16); lo_[2 * q_ + 1] = X[2 * q_ + 1] - __uint_as_float(hw_[q_] & 0xffff0000u); } \
                HA = (u32x4){hw_[0], hw_[1], hw_[2], hw_[3]}; HB = (u32x4){hw_[4], hw_[5], hw_[6], hw_[7]}; \
                LA = (u32x4){cvtpk_s(lo_[0], lo_[1]), cvtpk_s(lo_[2], lo_[3]), cvtpk_s(lo_[4], lo_[5]), cvtpk_s(lo_[6], lo_[7])}; \
                LB = (u32x4){cvtpk_s(lo_[8], lo_[9]), cvtpk_s(lo_[10], lo_[11]), cvtpk_s(lo_[12], lo_[13]), cvtpk_s(lo_[14], lo_[15])}; } while (0)
            STK_SPLIT(x0, h0a, h0b, l0a, l0b);
            STK_SPLIT(x1, h1a, h1b, l1a, l1b);
#undef STK_SPLIT
            f32x16 y0, y1;
#pragma unroll
            for (int r = 0; r < 16; ++r) { y0[r] = carry + tot1; y1[r] = carry; }
            y0 = __builtin_amdgcn_mfma_f32_32x32x16_bf16(tri[0], __builtin_bit_cast(bf16x8, h0a), y0, 0, 0, 0);
            y0 = __builtin_amdgcn_mfma_f32_32x32x16_bf16(tri[1], __builtin_bit_cast(bf16x8, h0b), y0, 0, 0, 0);
            y0 = __builtin_amdgcn_mfma_f32_32x32x16_bf16(tri[0], __builtin_bit_cast(bf16x8, l0a), y0, 0, 0, 0);
            y0 = __builtin_amdgcn_mfma_f32_32x32x16_bf16(tri[1], __builtin_bit_cast(bf16x8, l0b), y0, 0, 0, 0);
            y1 = __builtin_amdgcn_mfma_f32_32x32x16_bf16(tri[0], __builtin_bit_cast(bf16x8, h1a), y1, 0, 0, 0);
            y1 = __builtin_amdgcn_mfma_f32_32x32x16_bf16(tri[1], __builtin_bit_cast(bf16x8, h1b), y1, 0, 0, 0);
            y1 = __builtin_amdgcn_mfma_f32_32x32x16_bf16(tri[0], __builtin_bit_cast(bf16x8, l1a), y1, 0, 0, 0);
            y1 = __builtin_amdgcn_mfma_f32_32x32x16_bf16(tri[1], __builtin_bit_cast(bf16x8, l1b), y1, 0, 0, 0);
#pragma unroll
            for (int r = 0; r < 16; ++r) {
                const int pos0 = 64 * j + crow(r, hi);
                y0[r] = (pos0 < t) ? __builtin_amdgcn_exp2f((p0[r] + y0[r]) * LOG2E) : 0.f;
                y1[r] = (pos0 + 32 < t) ? __builtin_amdgcn_exp2f((p1[r] + y1[r]) * LOG2E) : 0.f;
            }
            carry += tot0 + tot1;
            u32x4 pw0, pw1, pw2, pw3;
            pw0 = (u32x4){cvtpk_s(y0[0], y0[1]), cvtpk_s(y0[2], y0[3]), cvtpk_s(y0[4], y0[5]), cvtpk_s(y0[6], y0[7])};
            pw1 = (u32x4){cvtpk_s(y0[8], y0[9]), cvtpk_s(y0[10], y0[11]), cvtpk_s(y0[12], y0[13]), cvtpk_s(y0[14], y0[15])};
            pw2 = (u32x4){cvtpk_s(y1[0], y1[1]), cvtpk_s(y1[2], y1[3]), cvtpk_s(y1[4], y1[5]), cvtpk_s(y1[6], y1[7])};
            pw3 = (u32x4){cvtpk_s(y1[8], y1[9]), cvtpk_s(y1[10], y1[11]), cvtpk_s(y1[12], y1[13]), cvtpk_s(y1[14], y1[15])};
            __builtin_amdgcn_sched_barrier(0);
            pv(o, (int)(lds0 + L_RING + slot * STK_SLOTB + hs * 16384 + 8192) + vboff, __builtin_bit_cast(bf16x8, pw0), __builtin_bit_cast(bf16x8, pw1), __builtin_bit_cast(bf16x8, pw2), __builtin_bit_cast(bf16x8, pw3));
            mydone = __all(carry < -STICK_THR) != 0;
            if (mydone && lane == 0) DONE[wid] = i;
        }
        slot = (slot == 2) ? 0 : slot + 1;
    }
    asm volatile("s_waitcnt vmcnt(0) lgkmcnt(0)\n\ts_barrier" ::: "memory");
#undef STK_ISSUE
    {
        __attribute__((address_space(3))) unsigned short* stg = (__attribute__((address_space(3))) unsigned short*)(lds3 + L_X) + wid * 2048;
#pragma unroll
        for (int r = 0; r < 16; ++r) { const int orow = crow(r, hi);
#pragma unroll
            for (int d0 = 0; d0 < 2; ++d0) stg[orow * 64 + d0 * 32 + r32] = (unsigned short)f2bf(o[d0][r]); }
        asm volatile("s_waitcnt lgkmcnt(0)" ::: "memory");
        bf16* Ow = OSB + (size_t)(b * SEQ + q0 + 32 * qw) * SB_W + h * HD;
#pragma unroll
        for (int i = 0; i < 4; ++i) { const int row = i * 8 + (lane >> 3), ch = lane & 7;
            const u32x4 vv = *(const __attribute__((address_space(3))) u32x4*)(stg + row * 64 + ch * 8);
            *(u32x4*)(Ow + (size_t)row * SB_W + ch * 8) = vv; }
    }
    asm volatile("s_waitcnt vmcnt(0) lgkmcnt(0)" ::: "memory");
    __syncthreads();
}
__device__ __forceinline__ void stick_phase(const bf16* PROJ, bf16* OSB, lds_ptr lds3, int vcu, int G) {
    const unsigned lds0 = (unsigned)(uintptr_t)lds3;
    int tid = threadIdx.x; asm volatile("" : "+v"(tid));
    const int lane = tid & 63, r32 = lane & 31, hi = lane >> 5;
    bf16x8 tri[2];
#pragma unroll
    for (int s = 0; s < 2; ++s)
#pragma unroll
        for (int j = 0; j < 8; ++j) tri[s][j] = ((16 * s + 8 * (j >> 2) + 4 * hi + (j & 3)) > r32) ? (short)0x3F80 : (short)0;
    for (int i = vcu; i < 512; i += G) {
        const int bp = i >> 5, qb = i & 31;
        stick_unit(tid, bp >> 3, bp & 7, qb, PROJ, OSB, lds3, lds0, tri);
    }
}
#undef NSA_WAIT_BAR
}
namespace peer {
typedef short bf16x8 __attribute__((ext_vector_type(8)));
typedef float f32x16 __attribute__((ext_vector_type(16)));
typedef __bf16 b2_t __attribute__((ext_vector_type(2)));
constexpr int L_EX = 0, L_GT = 16384, L_GN = 32768;
__device__ __forceinline__ int crow(int r, int hi) { return (r & 3) + 8 * (r >> 2) + 4 * hi; }
__device__ __forceinline__ unsigned mono(float f) { const unsigned u = __float_as_uint(f); return (u & 0x80000000u) ? ~u : (u | 0x80000000u); }
__device__ __forceinline__ float unmono(unsigned k) { return __uint_as_float((k & 0x80000000u) ? (k & 0x7fffffffu) : ~k); }
__device__ __forceinline__ float dot2(unsigned a, unsigned b, float c) { return __builtin_amdgcn_fdot2_f32_bf16(__builtin_bit_cast(b2_t, a), __builtin_bit_cast(b2_t, b), c, false); }
#define PEER_CE(key, slot) do { const unsigned hi_ = (key) > (slot) ? (key) : (slot); (key) = (key) > (slot) ? (slot) : (key); (slot) = hi_; } while (0)

__device__ __forceinline__ void route_list(const bf16* QP, const bf16* SKB, int L, int tok0, int r32, int hi, unsigned (&out)[16]) {
    f32x16 acc[4] = {};
    const bf16* qp = QP + (size_t)(tok0 + r32) * 2048 + L * 128 + hi * 8;
    const bf16* kp = SKB + ((size_t)L * 128 + r32) * 128 + hi * 8;
    int hi4 = 4 * hi;
    asm volatile("" : "+v"(qp), "+v"(kp), "+v"(hi4));
#pragma unroll
    for (int ks = 0; ks < 8; ++ks) {
        const bf16x8 bq = __builtin_nontemporal_load((const bf16x8*)(qp + ks * 16));
#pragma unroll
        for (int kt = 0; kt < 4; ++kt) { const bf16x8 a = *(const bf16x8*)(kp + (size_t)kt * 32 * 128 + ks * 16); acc[kt] = __builtin_amdgcn_mfma_f32_32x32x16_bf16(a, bq, acc[kt], 0, 0, 0); }
    }
    unsigned t[16];
#pragma unroll
    for (int k = 0; k < 16; ++k) t[k] = 0u;
#pragma unroll
    for (int kt = 0; kt < 4; ++kt)
#pragma unroll
        for (int r = 0; r < 16; ++r) {
            unsigned key = ((mono(acc[kt][r]) & ~127u) | (unsigned)(127 - (32 * kt + (r & 3) + 8 * (r >> 2)))) - (unsigned)hi4;
#pragma unroll
            for (int k = 0; k < 16; ++k) PEER_CE(key, t[k]);
            __builtin_amdgcn_sched_barrier(0);
        }
    unsigned u[16];
#pragma unroll
    for (int k = 0; k < 16; ++k) { auto rr = __builtin_amdgcn_permlane32_swap(t[k], t[k], false, false); u[k] = hi ? rr[0] : rr[1]; }
#pragma unroll
    for (int k = 0; k < 16; ++k) out[k] = t[k] > u[15 - k] ? t[k] : u[15 - k];
#pragma unroll
    for (int st = 8; st >= 1; st >>= 1)
#pragma unroll
        for (int k = 0; k < 16; ++k) if ((k & st) == 0) { const unsigned a = out[k], b = out[k | st]; out[k] = a > b ? a : b; out[k | st] = a > b ? b : a; }
}

__device__ __forceinline__ void route_head(const bf16* QP, const bf16* SKB, int h, int tok0, int lane, __attribute__((address_space(3))) unsigned char* lds3) {
    asm volatile("" : "+v"(lane));
    const int r32 = lane & 31, hi = lane >> 5;
    unsigned A[16], B[16];
    route_list(QP, SKB, 2 * h, tok0, r32, hi, A);
    route_list(QP, SKB, 2 * h + 1, tok0, r32, hi, B);
    float va[16], vb[16]; int ia[16], ib[16];
#pragma unroll
    for (int k = 0; k < 16; ++k) { va[k] = unmono((A[k] & ~127u) | 64u); vb[k] = unmono((B[k] & ~127u) | 64u); ia[k] = 127 - (int)(A[k] & 127u); ib[k] = 127 - (int)(B[k] & 127u); }
    unsigned s[16], sp[16];
#pragma unroll
    for (int k = 0; k < 16; ++k) { s[k] = 0u; sp[k] = 0u; }
#pragma unroll
    for (int i = 0; i < 16; ++i)
#pragma unroll
        for (int j = 0; j < 16; ++j) if ((i + 1) * (j + 1) <= 16) {
            unsigned key = mono(va[i] + vb[j]); unsigned pay = (unsigned)(ia[i] * PEER_KEYS + ib[j]);
#pragma unroll
            for (int k = (i + 1) * (j + 1) - 1; k < 16; ++k) { const bool gt = key > s[k]; const unsigned ts = s[k], tp = sp[k]; s[k] = gt ? key : ts; sp[k] = gt ? pay : tp; key = gt ? ts : key; pay = gt ? tp : pay; }
            __builtin_amdgcn_sched_barrier(0);
        }
    const float mx = unmono(s[0]);
    float e[16], sum = 0.f;
#pragma unroll
    for (int k = 0; k < 16; ++k) { e[k] = __expf(unmono(s[k]) - mx); sum += e[k]; }
    const float inv = 1.f / sum;
    if (hi == 0) {
        __attribute__((address_space(3))) int* EX = (__attribute__((address_space(3))) int*)(lds3 + L_EX);
        __attribute__((address_space(3))) float* GT = (__attribute__((address_space(3))) float*)(lds3 + L_GT);
#pragma unroll
        for (int k = 0; k < 16; ++k) { EX[(h * 16 + k) * 32 + r32] = (int)sp[k]; GT[(h * 16 + k) * 32 + r32] = e[k] * inv; }
    }
}

#ifndef PEER_FAKE
#define PEER_FAKE 0
#endif
#ifndef PEER_FAKE_MODE
#define PEER_FAKE_MODE 0
#endif
#ifndef PEER_FAKE_EMASK
#define PEER_FAKE_EMASK 0xffff
#endif
constexpr int FP6_PITCH = 2048;
typedef float v2f_t __attribute__((ext_vector_type(2)));
__device__ __forceinline__ void cvt_row_load(const float* src, int row, int lane, f32x4 (&v)[8]) {
    const float* p = src + (size_t)row * 2048 + lane * 4;
#pragma unroll
    for (int i = 0; i < 8; ++i) v[i] = __builtin_nontemporal_load((const f32x4*)(p + i * 256));
}
__device__ __forceinline__ float clamp6(float x) { return __builtin_amdgcn_fmed3f(x, -6.f, 6.f); }
__device__ __forceinline__ float elem4(const f32x4& a, int m) { return m == 0 ? a.x : m == 1 ? a.y : m == 2 ? a.z : a.w; }
__device__ __forceinline__ void cvt_row_store(const f32x4 (&v)[8], unsigned char* REC, float* ISC, int r, int lane) {
    float am = 0.f, ss = 0.f;
#pragma unroll
    for (int i = 0; i < 8; ++i) { am = fmaxf(am, fmaxf(fmaxf(fabsf(v[i].x), fabsf(v[i].y)), fmaxf(fabsf(v[i].z), fabsf(v[i].w))));
        ss += v[i].x * v[i].x + v[i].y * v[i].y + v[i].z * v[i].z + v[i].w * v[i].w; }
    am = wave_max(am);
    const bool is_u = r < 16384; const int e = r & 16383;
    v4u q; float isc;
    if (is_u) {
        ss = wave_sum(ss);
        const float step = am > 0.f ? fminf(0.3352f * sqrtf(ss * (1.f / 2048.f)), am * (1.f / 7.5f)) : 1.f, inv = 1.f / step;
#pragma unroll
        for (int j = 0; j < 4; ++j) { unsigned w = 0;
#pragma unroll
            for (int t = 0; t < 8; ++t) { const float val = elem4(v[2 * j + (t >> 2)], t & 3);
                int n = (int)floorf(val * inv); n = n < -8 ? -8 : n > 7 ? 7 : n;
                w |= (unsigned)(n & 15) << (4 * t); }
            q[j] = w; }
        isc = step;
    } else {
        const float sc = am > 0.f ? 7.5f / am : 1.f;
#pragma unroll
        for (int j = 0; j < 4; ++j) { unsigned w = 0;
            w = __builtin_amdgcn_cvt_scalef32_pk_fp4_f32(w, clamp6(v[2 * j].x * sc), clamp6(v[2 * j].y * sc), 1.0f, 0);
            w = __builtin_amdgcn_cvt_scalef32_pk_fp4_f32(w, clamp6(v[2 * j].z * sc), clamp6(v[2 * j].w * sc), 1.0f, 1);
            w = __builtin_amdgcn_cvt_scalef32_pk_fp4_f32(w, clamp6(v[2 * j + 1].x * sc), clamp6(v[2 * j + 1].y * sc), 1.0f, 2);
            w = __builtin_amdgcn_cvt_scalef32_pk_fp4_f32(w, clamp6(v[2 * j + 1].z * sc), clamp6(v[2 * j + 1].w * sc), 1.0f, 3);
            q[j] = w; }
        isc = am > 0.f ? am / 7.5f : 1.f;
    }
    *(v4u*)(REC + (size_t)e * FP6_PITCH + (is_u ? 0 : 1024) + lane * 16) = q;
    if (lane == 0) ISC[2 * e + (is_u ? 0 : 1)] = isc;
}
#ifndef PEER_CVT_DEPTH4
#define PEER_CVT_DEPTH4 1
#endif
__device__ __forceinline__ void cvt_tables(const float* Uf, const float* Vf, unsigned char* REC, float* ISC, int first, int stride, int lane) {
#define PEER_SRC(r) ((r) < 16384 ? Uf : Vf), ((r) < 16384 ? (r) : (r) - 16384)
#if PEER_CVT_DEPTH4
    f32x4 va[8], vb[8], vc[8], vd[8];
    int r = first;
    if (r < 32768) cvt_row_load(PEER_SRC(r), lane, va);
    if (r + stride < 32768) cvt_row_load(PEER_SRC(r + stride), lane, vb);
    if (r + 2 * stride < 32768) cvt_row_load(PEER_SRC(r + 2 * stride), lane, vc);
#pragma unroll 1
    for (; r < 32768; r += 4 * stride) {
#define PEER_STEP(LD, ST, K) { const int rl_ = r + ((K) + 3) * stride, rs_ = r + (K) * stride; if (rl_ < 32768) cvt_row_load(PEER_SRC(rl_), lane, LD); __builtin_amdgcn_sched_barrier(0); \
            if (rs_ < 32768) cvt_row_store(ST, REC, ISC, rs_, lane); __builtin_amdgcn_sched_barrier(0); }
        PEER_STEP(vd, va, 0) PEER_STEP(va, vb, 1) PEER_STEP(vb, vc, 2) PEER_STEP(vc, vd, 3)
#undef PEER_STEP
    }
#else
    f32x4 va[8], vb[8];
    int r = first;
    if (r < 32768) cvt_row_load(PEER_SRC(r), lane, va);
#pragma unroll 1
    for (; r < 32768; r += 2 * stride) {
        const int r1 = r + stride, r2 = r + 2 * stride;
        if (r1 < 32768) cvt_row_load(PEER_SRC(r1), lane, vb);
        __builtin_amdgcn_sched_barrier(0);
        cvt_row_store(va, REC, ISC, r, lane);
        __builtin_amdgcn_sched_barrier(0);
        if (r2 < 32768) cvt_row_load(PEER_SRC(r2), lane, va);
        __builtin_amdgcn_sched_barrier(0);
        if (r1 < 32768) cvt_row_store(vb, REC, ISC, r1, lane);
        __builtin_amdgcn_sched_barrier(0);
    }
#endif
#undef PEER_SRC
}
__device__ __forceinline__ void ffn_token(int emask, bool fake, int n, int tl, int lane, const bf16* H, const float* SS, const unsigned char* REC, const float* ISC,
                                          float* out, __attribute__((address_space(3))) unsigned char* lds3) {
    const __attribute__((address_space(3))) float* gffn = (const __attribute__((address_space(3))) float*)(lds3 + L_GN);
    const __attribute__((address_space(3))) float* gfin = gffn + 2048;
    const __attribute__((address_space(3))) int* EX = (const __attribute__((address_space(3))) int*)(lds3 + L_EX);
    const __attribute__((address_space(3))) float* GT = (const __attribute__((address_space(3))) float*)(lds3 + L_GT);
    v2u hrow[8];
    unsigned xlo[4], xhi[4]; float sx, halfX;
    { const float rs_ = rsqrtf(SS[n] * (1.f / D_MODEL) + EPS);
      float xf[32]; float amx = 0.f;
#pragma unroll
      for (int i = 0; i < 8; ++i) { const v2u hw_ = *(const v2u*)(H + (size_t)n * 2048 + i * 256 + lane * 4); const f32x4 gv_ = *(const __attribute__((address_space(3))) f32x4*)(gffn + i * 256 + lane * 4);
            hrow[i] = hw_;
            xf[4 * i + 0] = bflo(hw_.x) * rs_ * gv_.x; xf[4 * i + 1] = bfhi(hw_.x) * rs_ * gv_.y; xf[4 * i + 2] = bflo(hw_.y) * rs_ * gv_.z; xf[4 * i + 3] = bfhi(hw_.y) * rs_ * gv_.w;
            amx = fmaxf(amx, fmaxf(fmaxf(fabsf(xf[4 * i + 0]), fabsf(xf[4 * i + 1])), fmaxf(fabsf(xf[4 * i + 2]), fabsf(xf[4 * i + 3])))); }
      amx = wave_max(amx);
      sx = amx > 0.f ? amx * (1.f / 119.f) : 1.f; const float isx = amx > 0.f ? 119.f / amx : 1.f;
      int xs = 0;
#pragma unroll
      for (int j = 0; j < 4; ++j) { unsigned wl = 0, wh = 0;
#pragma unroll
          for (int t = 0; t < 8; ++t) { const int q = (int)rintf(xf[8 * j + t] * isx); xs += q;
              const int q8 = q + 8;
              wl |= (unsigned)((q8 & 15) ^ 8) << (4 * t); wh |= (unsigned)((q8 >> 4) & 15) << (4 * t); }
          xlo[j] = wl; xhi[j] = wh; }
      halfX = 0.5f * wave_sum((float)xs); }
    v2f_t acc2[16];
#pragma unroll
    for (int j = 0; j < 16; ++j) acc2[j] = (v2f_t){0.f, 0.f};
    const bool b5 = (lane & 32) != 0, b4 = (lane & 16) != 0;
    v4u uaA[4], vaA[4], uaB[4], vaB[4]; v2f_t scA[4], scB[4]; float gtA[4], gtB[4];
#define PEER_LOADB(UA, VA, SC, GTV, E0) { _Pragma("unroll") for (int k = 0; k < 4; ++k) { \
        const int ei_ = __builtin_amdgcn_readfirstlane(EX[((E0) + k) * 32 + tl]) & emask; GTV[k] = GT[((E0) + k) * 32 + tl]; \
        const unsigned char* rec_ = REC + (size_t)ei_ * FP6_PITCH + lane * 16; \
        if (!(fake && PEER_FAKE_MODE == 2)) { UA[k] = *(const v4u*)rec_; VA[k] = *(const v4u*)(rec_ + 1024); SC[k] = *(const v2f_t*)(ISC + 2 * ei_); } \
        else { UA[k][0] ^= (unsigned)ei_; VA[k][1] += (unsigned)ei_; } } }
#define PEER_DEC(q, b) __builtin_amdgcn_cvt_scalef32_pk_f32_fp4(q, 1.0f, b)
#define PEER_EVALB(UA, VA, SC, GTV) if (fake && PEER_FAKE_MODE == 1) { _Pragma("unroll") for (int k = 0; k < 4; ++k) { \
            acc2[k].x += __uint_as_float((UA[k][0] ^ UA[k][1]) + (UA[k][2] ^ UA[k][3])) * SC[k].x; acc2[k].y += __uint_as_float((VA[k][0] ^ VA[k][1]) + (VA[k][2] ^ VA[k][3])) * GTV[k]; } } else { float d[4]; \
        _Pragma("unroll") for (int k = 0; k < 4; ++k) { int sh = 0, sl = 0; \
            _Pragma("unroll") for (int j = 0; j < 4; ++j) { sh = __builtin_amdgcn_sdot8((int)UA[k][j], (int)xhi[j], sh, false); sl = __builtin_amdgcn_sdot8((int)UA[k][j], (int)xlo[j], sl, false); } \
            d[k] = (float)(sh * 16 + sl); } \
        __builtin_amdgcn_sched_barrier(0); \
          \
        float t; { const auto r01 = __builtin_amdgcn_permlane32_swap(__float_as_uint(d[0]), __float_as_uint(d[1]), false, false); \
                   const auto r23 = __builtin_amdgcn_permlane32_swap(__float_as_uint(d[2]), __float_as_uint(d[3]), false, false); \
                   const float a01 = __uint_as_float(r01[0]) + __uint_as_float(r01[1]), a23 = __uint_as_float(r23[0]) + __uint_as_float(r23[1]); \
                   const auto rr = __builtin_amdgcn_permlane16_swap(__float_as_uint(a01), __float_as_uint(a23), false, false); \
                   t = row_sum16(__uint_as_float(rr[0]) + __uint_as_float(rr[1])); } \
        const float ius = b5 ? (b4 ? SC[3].x : SC[1].x) : (b4 ? SC[2].x : SC[0].x); \
        const float ivs = b5 ? (b4 ? SC[3].y : SC[1].y) : (b4 ? SC[2].y : SC[0].y); \
        const float gts = b5 ? (b4 ? GTV[3] : GTV[1]) : (b4 ? GTV[2] : GTV[0]); \
        const float wv = gts * gelu_tanh_fast((t + halfX) * (sx * ius)) * ivs; \
        float w[4]; \
        w[0] = __uint_as_float(__builtin_amdgcn_readlane(__float_as_uint(wv), 0)); w[2] = __uint_as_float(__builtin_amdgcn_readlane(__float_as_uint(wv), 16)); \
        w[1] = __uint_as_float(__builtin_amdgcn_readlane(__float_as_uint(wv), 32)); w[3] = __uint_as_float(__builtin_amdgcn_readlane(__float_as_uint(wv), 48)); \
        _Pragma("unroll") for (int k = 0; k < 4; ++k) { const v2f_t wk = {w[k], w[k]}; \
            _Pragma("unroll") for (int j = 0; j < 4; ++j) { const unsigned qw = VA[k][j]; \
                acc2[4 * j + 0] += wk * PEER_DEC(qw, 0); acc2[4 * j + 1] += wk * PEER_DEC(qw, 1); acc2[4 * j + 2] += wk * PEER_DEC(qw, 2); acc2[4 * j + 3] += wk * PEER_DEC(qw, 3); } \
            __builtin_amdgcn_sched_barrier(0); } }
    if (fake && PEER_FAKE_MODE == 2) {
#pragma unroll
        for (int k = 0; k < 4; ++k) { uaA[k] = (v4u){(unsigned)lane, 1u, 2u, 3u}; vaA[k] = uaA[k]; uaB[k] = uaA[k]; vaB[k] = uaA[k]; scA[k] = (v2f_t){1.f, 1.f}; scB[k] = scA[k]; } }
    PEER_LOADB(uaA, vaA, scA, gtA, 0)
#pragma unroll 1
    for (int e0 = 0; e0 < PEER_E; e0 += 8) {
        PEER_LOADB(uaB, vaB, scB, gtB, e0 + 4)
        __builtin_amdgcn_sched_barrier(0);
        PEER_EVALB(uaA, vaA, scA, gtA)
        __builtin_amdgcn_sched_barrier(0);
        { const int en = e0 + 8 < PEER_E ? e0 + 8 : 0;
          PEER_LOADB(uaA, vaA, scA, gtA, en) }
        __builtin_amdgcn_sched_barrier(0);
        PEER_EVALB(uaB, vaB, scB, gtB)
        __builtin_amdgcn_sched_barrier(0);
    }
#undef PEER_LOADB
#undef PEER_EVALB
#undef PEER_DEC
    float sq = 0.f;
#pragma unroll
    for (int i = 0; i < 8; ++i) { const v2u hw_ = hrow[i];
        acc2[2 * i].x += bflo(hw_.x); acc2[2 * i].y += bfhi(hw_.x); acc2[2 * i + 1].x += bflo(hw_.y); acc2[2 * i + 1].y += bfhi(hw_.y); }
#pragma unroll
    for (int j = 0; j < 16; ++j) sq += acc2[j].x * acc2[j].x + acc2[j].y * acc2[j].y;
    const float r_ = rsqrtf(wave_sum(sq) * (1.f / D_MODEL) + EPS);
    if (fake && r_ != 12345.678f) return;
#pragma unroll
    for (int i = 0; i < 8; ++i) { const f32x4 gv_ = *(const __attribute__((address_space(3))) f32x4*)(gfin + i * 256 + lane * 4);
        *(f32x4*)(out + (size_t)n * 2048 + i * 256 + lane * 4) = (f32x4){acc2[2 * i].x * r_ * gv_.x, acc2[2 * i].y * r_ * gv_.y, acc2[2 * i + 1].x * r_ * gv_.z, acc2[2 * i + 1].y * r_ * gv_.w}; }
}

#ifndef PEER_SLICED
#define PEER_SLICED 2
#endif
#ifndef PEER_SLICE_SHIFT_V
#define PEER_SLICE_SHIFT_V 10
#endif
constexpr int L_SCH = 49152, SCH_CAP = 384, PEER_SLICE_SHIFT = PEER_SLICE_SHIFT_V, L_PARK = 73728;
__device__ __forceinline__ int mbcnt64(unsigned long long m) { return __builtin_amdgcn_mbcnt_hi((unsigned)(m >> 32), __builtin_amdgcn_mbcnt_lo((unsigned)m, 0u)); }
__device__ __forceinline__ int build_schedule(int lane, int tl0, __attribute__((address_space(3))) unsigned char* lds3, __attribute__((address_space(3))) v2u* SCH) {
    const __attribute__((address_space(3))) int* EX = (const __attribute__((address_space(3))) int*)(lds3 + L_EX);
    const __attribute__((address_space(3))) float* GT = (const __attribute__((address_space(3))) float*)(lds3 + L_GT);
    int e00 = EX[lane * 32 + tl0], e01 = EX[(lane + 64) * 32 + tl0], e10 = EX[lane * 32 + tl0 + 1], e11 = EX[(lane + 64) * 32 + tl0 + 1];
    const unsigned g00 = __float_as_uint(GT[lane * 32 + tl0]), g01 = __float_as_uint(GT[(lane + 64) * 32 + tl0]), g10 = __float_as_uint(GT[lane * 32 + tl0 + 1]), g11 = __float_as_uint(GT[(lane + 64) * 32 + tl0 + 1]);
    int run = 0;
#pragma unroll 1
    for (int b = 0; b < (16384 >> PEER_SLICE_SHIFT); ++b) {
        const bool h00 = (e00 >> PEER_SLICE_SHIFT) == b, h01 = (e01 >> PEER_SLICE_SHIFT) == b, h10 = (e10 >> PEER_SLICE_SHIFT) == b, h11 = (e11 >> PEER_SLICE_SHIFT) == b;
        const unsigned long long m00 = __ballot(h00), m01 = __ballot(h01), m10 = __ballot(h10), m11 = __ballot(h11);
        const int c00 = __popcll(m00), c0 = c00 + __popcll(m01), c10 = __popcll(m10), c1 = c10 + __popcll(m11);
        const int p0 = (c0 + 3) & ~3, p1 = (c1 + 3) & ~3, o0 = run, o1 = run + p0;
        run += p0 + p1;
        if (h00) SCH[o0 + mbcnt64(m00)] = (v2u){(unsigned)e00, g00};
        if (h01) SCH[o0 + c00 + mbcnt64(m01)] = (v2u){(unsigned)e01, g01};
        if (h10) SCH[o1 + mbcnt64(m10)] = (v2u){(unsigned)e10 | 0x10000u, g10};
        if (h11) SCH[o1 + c10 + mbcnt64(m11)] = (v2u){(unsigned)e11 | 0x10000u, g11};
        if (lane < p0 - c0) SCH[o0 + c0 + lane] = (v2u){(unsigned)(b << PEER_SLICE_SHIFT), 0u};
        if (lane < p1 - c1) SCH[o1 + c1 + lane] = (v2u){(unsigned)(b << PEER_SLICE_SHIFT) | 0x10000u, 0u};
    }
    return run >> 2;
}
struct TokX { unsigned xlo[4], xhi[4]; float sx, halfX; };
__device__ __forceinline__ void token_prologue(int n, int lane, const bf16* H, const float* SS, const __attribute__((address_space(3))) float* gffn, TokX& X) {
    const float rs_ = rsqrtf(SS[n] * (1.f / D_MODEL) + EPS);
    float xf[32]; float amx = 0.f;
#pragma unroll
    for (int i = 0; i < 8; ++i) { const v2u hw_ = *(const v2u*)(H + (size_t)n * 2048 + i * 256 + lane * 4); const f32x4 gv_ = *(const __attribute__((address_space(3))) f32x4*)(gffn + i * 256 + lane * 4);
        xf[4 * i + 0] = bflo(hw_.x) * rs_ * gv_.x; xf[4 * i + 1] = bfhi(hw_.x) * rs_ * gv_.y; xf[4 * i + 2] = bflo(hw_.y) * rs_ * gv_.z; xf[4 * i + 3] = bfhi(hw_.y) * rs_ * gv_.w;
        amx = fmaxf(amx, fmaxf(fmaxf(fabsf(xf[4 * i + 0]), fabsf(xf[4 * i + 1])), fmaxf(fabsf(xf[4 * i + 2]), fabsf(xf[4 * i + 3])))); }
    amx = wave_max(amx);
    X.sx = amx > 0.f ? amx * (1.f / 119.f) : 1.f; const float isx = amx > 0.f ? 119.f / amx : 1.f;
    int xs = 0;
#pragma unroll
    for (int j = 0; j < 4; ++j) { unsigned wl = 0, wh = 0;
#pragma unroll
        for (int t = 0; t < 8; ++t) { const int q = (int)rintf(xf[8 * j + t] * isx); xs += q;
            const int q8 = q + 8;
            wl |= (unsigned)((q8 & 15) ^ 8) << (4 * t); wh |= (unsigned)((q8 >> 4) & 15) << (4 * t); }
        X.xlo[j] = wl; X.xhi[j] = wh; }
    X.halfX = 0.5f * wave_sum((float)xs);
}
__device__ __forceinline__ void token_epilogue(int n, int lane, const bf16* H, const __attribute__((address_space(3))) float* gfin, v2f_t (&acc2)[16], float* out) {
    float sq = 0.f;
#pragma unroll
    for (int i = 0; i < 8; ++i) { const v2u hw_ = __builtin_nontemporal_load((const v2u*)(H + (size_t)n * 2048 + i * 256 + lane * 4));
        acc2[2 * i].x += bflo(hw_.x); acc2[2 * i].y += bfhi(hw_.x); acc2[2 * i + 1].x += bflo(hw_.y); acc2[2 * i + 1].y += bfhi(hw_.y); }
#pragma unroll
    for (int j = 0; j < 16; ++j) sq += acc2[j].x * acc2[j].x + acc2[j].y * acc2[j].y;
    const float r_ = rsqrtf(wave_sum(sq) * (1.f / D_MODEL) + EPS);
#pragma unroll
    for (int i = 0; i < 8; ++i) { const f32x4 gv_ = *(const __attribute__((address_space(3))) f32x4*)(gfin + i * 256 + lane * 4);
        __builtin_nontemporal_store((f32x4){acc2[2 * i].x * r_ * gv_.x, acc2[2 * i].y * r_ * gv_.y, acc2[2 * i + 1].x * r_ * gv_.z, acc2[2 * i + 1].y * r_ * gv_.w}, (f32x4*)(out + (size_t)n * 2048 + i * 256 + lane * 4)); }
}
__device__ __forceinline__ void ffn_pair(bool fake, int n0, int tl0, int lane, int wid, const bf16* H, const float* SS, const unsigned char* REC, const float* ISC, float* out, __attribute__((address_space(3))) unsigned char* lds3) {
    const __attribute__((address_space(3))) float* gffn = (const __attribute__((address_space(3))) float*)(lds3 + L_GN);
    const __attribute__((address_space(3))) float* gfin = gffn + 2048;
    __attribute__((address_space(3))) v2u* SCH = (__attribute__((address_space(3))) v2u*)(lds3 + L_SCH) + wid * SCH_CAP;
    const int nb = __builtin_amdgcn_readfirstlane(build_schedule(lane, tl0, lds3, SCH));
    TokX X0, X1;
    token_prologue(n0, lane, H, SS, gffn, X0);
    token_prologue(n0 + 1, lane, H, SS, gffn, X1);
    __attribute__((address_space(3))) f32x4* PARK = (__attribute__((address_space(3))) f32x4*)(lds3 + L_PARK) + wid * 512;
    v2f_t acc[16]; int cur = 0;
#pragma unroll
    for (int j = 0; j < 16; ++j) acc[j] = (v2f_t){0.f, 0.f};
#pragma unroll
    for (int j = 0; j < 8; ++j) PARK[j * 64 + lane] = (f32x4){0.f, 0.f, 0.f, 0.f};
    const bool b5 = (lane & 32) != 0, b4 = (lane & 16) != 0;
    v4u uaA[4], vaA[4], uaB[4], vaB[4]; v2f_t scA[4], scB[4]; float gtA[4], gtB[4]; int tkA, tkB;
#define PEER_LOADB(UA, VA, SC, GTV, TK, BI) { _Pragma("unroll") for (int k = 0; k < 4; ++k) { const v2u en_ = SCH[4 * (BI) + k]; \
        const int ek_ = __builtin_amdgcn_readfirstlane((int)en_.x); if (k == 0) TK = ek_ >> 16; GTV[k] = __uint_as_float(en_.y); \
        const int ei_ = fake ? (ek_ & 0xffff & PEER_FAKE_EMASK) : (ek_ & 0xffff); const unsigned char* rec_ = REC + (size_t)ei_ * FP6_PITCH + lane * 16; \
        if (!(fake && PEER_FAKE_MODE == 2)) { UA[k] = *(const v4u*)rec_; VA[k] = *(const v4u*)(rec_ + 1024); SC[k] = *(const v2f_t*)(ISC + 2 * ei_); } \
        else { UA[k][0] ^= (unsigned)ei_; VA[k][1] += (unsigned)ei_; } } }
#define PEER_DEC(q, b) __builtin_amdgcn_cvt_scalef32_pk_f32_fp4(q, 1.0f, b)
#define PEER_VSIDE(VA, ACC) { _Pragma("unroll") for (int k = 0; k < 4; ++k) { const v2f_t wk = {w[k], w[k]}; \
            _Pragma("unroll") for (int j = 0; j < 4; ++j) { const unsigned qw = VA[k][j]; \
                ACC[4 * j + 0] += wk * PEER_DEC(qw, 0); ACC[4 * j + 1] += wk * PEER_DEC(qw, 1); ACC[4 * j + 2] += wk * PEER_DEC(qw, 2); ACC[4 * j + 3] += wk * PEER_DEC(qw, 3); } \
            __builtin_amdgcn_sched_barrier(0); } }
#define PEER_EVALB(UA, VA, SC, GTV, TK) if (fake && PEER_FAKE_MODE == 1) { _Pragma("unroll") for (int k = 0; k < 4; ++k) { \
            acc[k].x += __uint_as_float((UA[k][0] ^ UA[k][1]) + (UA[k][2] ^ UA[k][3])) * SC[k].x; acc[k].y += __uint_as_float((VA[k][0] ^ VA[k][1]) + (VA[k][2] ^ VA[k][3])) * GTV[k]; } } else { float d[4]; const bool t1_ = (TK) != 0; \
        unsigned xh_[4], xl_[4]; _Pragma("unroll") for (int j = 0; j < 4; ++j) { xh_[j] = t1_ ? X1.xhi[j] : X0.xhi[j]; xl_[j] = t1_ ? X1.xlo[j] : X0.xlo[j]; } \
        const float hx_ = t1_ ? X1.halfX : X0.halfX, sx_ = t1_ ? X1.sx : X0.sx; \
        _Pragma("unroll") for (int k = 0; k < 4; ++k) { int sh = 0, sl = 0; \
            _Pragma("unroll") for (int j = 0; j < 4; ++j) { sh = __builtin_amdgcn_sdot8((int)UA[k][j], (int)xh_[j], sh, false); sl = __builtin_amdgcn_sdot8((int)UA[k][j], (int)xl_[j], sl, false); } \
            d[k] = (float)(sh * 16 + sl); } \
        __builtin_amdgcn_sched_barrier(0); \
        float t; { const auto r01 = __builtin_amdgcn_permlane32_swap(__float_as_uint(d[0]), __float_as_uint(d[1]), false, false); \
                   const auto r23 = __builtin_amdgcn_permlane32_swap(__float_as_uint(d[2]), __float_as_uint(d[3]), false, false); \
                   const float a01 = __uint_as_float(r01[0]) + __uint_as_float(r01[1]), a23 = __uint_as_float(r23[0]) + __uint_as_float(r23[1]); \
                   const auto rr = __builtin_amdgcn_permlane16_swap(__float_as_uint(a01), __float_as_uint(a23), false, false); \
                   t = row_sum16(__uint_as_float(rr[0]) + __uint_as_float(rr[1])); } \
        const float ius = b5 ? (b4 ? SC[3].x : SC[1].x) : (b4 ? SC[2].x : SC[0].x); \
        const float ivs = b5 ? (b4 ? SC[3].y : SC[1].y) : (b4 ? SC[2].y : SC[0].y); \
        const float gts = b5 ? (b4 ? GTV[3] : GTV[1]) : (b4 ? GTV[2] : GTV[0]); \
        const float wv = gts * gelu_tanh_fast((t + hx_) * (sx_ * ius)) * ivs; \
        float w[4]; \
        w[0] = __uint_as_float(__builtin_amdgcn_readlane(__float_as_uint(wv), 0)); w[2] = __uint_as_float(__builtin_amdgcn_readlane(__float_as_uint(wv), 16)); \
        w[1] = __uint_as_float(__builtin_amdgcn_readlane(__float_as_uint(wv), 32)); w[3] = __uint_as_float(__builtin_amdgcn_readlane(__float_as_uint(wv), 48)); \
        __builtin_amdgcn_sched_barrier(0); \
        if ((TK) != cur) {            \
            _Pragma("unroll") for (int j = 0; j < 8; ++j) { const f32x4 o_ = PARK[j * 64 + lane]; PARK[j * 64 + lane] = (f32x4){acc[2 * j].x, acc[2 * j].y, acc[2 * j + 1].x, acc[2 * j + 1].y}; \
                acc[2 * j] = (v2f_t){o_.x, o_.y}; acc[2 * j + 1] = (v2f_t){o_.z, o_.w}; } \
            cur = (TK); } \
        PEER_VSIDE(VA, acc) }
    if (fake && PEER_FAKE_MODE == 2) {
#pragma unroll
        for (int k = 0; k < 4; ++k) { uaA[k] = (v4u){(unsigned)lane, 1u, 2u, 3u}; vaA[k] = uaA[k]; uaB[k] = uaA[k]; vaB[k] = uaA[k]; scA[k] = (v2f_t){1.f, 1.f}; scB[k] = scA[k]; } }
    PEER_LOADB(uaA, vaA, scA, gtA, tkA, 0)
#pragma unroll 1
    for (int i = 0; i < nb; i += 2) {
        { const int bn = i + 1 < nb ? i + 1 : nb - 1; PEER_LOADB(uaB, vaB, scB, gtB, tkB, bn) }
        __builtin_amdgcn_sched_barrier(0);
        PEER_EVALB(uaA, vaA, scA, gtA, tkA)
        __builtin_amdgcn_sched_barrier(0);
        { const int bn = i + 2 < nb ? i + 2 : nb - 1; PEER_LOADB(uaA, vaA, scA, gtA, tkA, bn) }
        __builtin_amdgcn_sched_barrier(0);
        if (i + 1 < nb) { PEER_EVALB(uaB, vaB, scB, gtB, tkB) }
        __builtin_amdgcn_sched_barrier(0);
    }
#undef PEER_LOADB
#undef PEER_EVALB
#undef PEER_VSIDE
#undef PEER_DEC
    if (fake) { float sq_ = 0.f;
#pragma unroll
        for (int j = 0; j < 16; ++j) sq_ += acc[j].x + acc[j].y;
        if (sq_ != 12345.678f) return; }
    token_epilogue(n0 + cur, lane, H, gfin, acc, out);
#pragma unroll
    for (int j = 0; j < 8; ++j) { const f32x4 o_ = PARK[j * 64 + lane]; acc[2 * j] = (v2f_t){o_.x, o_.y}; acc[2 * j + 1] = (v2f_t){o_.z, o_.w}; }
    token_epilogue(n0 + 1 - cur, lane, H, gfin, acc, out);
}

#ifndef PEER_SYNC_SLICES
#define PEER_SYNC_SLICES 0
#endif
constexpr int SCH4_CAP = 704, L_PARK4B = L_SCH + NWAVES * SCH4_CAP * 8;
static_assert(L_PARK4B + 16 * 4096 <= 162816, "LDS overflow");
__device__ __forceinline__ int build_schedule4(int lane, int tl0, __attribute__((address_space(3))) unsigned char* lds3, __attribute__((address_space(3))) v2u* SCH) {
    const __attribute__((address_space(3))) int* EX = (const __attribute__((address_space(3))) int*)(lds3 + L_EX);
    const __attribute__((address_space(3))) float* GT = (const __attribute__((address_space(3))) float*)(lds3 + L_GT);
    int e[4][2]; unsigned g[4][2];
#pragma unroll
    for (int t = 0; t < 4; ++t)
#pragma unroll
        for (int h = 0; h < 2; ++h) { e[t][h] = EX[(lane + 64 * h) * 32 + tl0 + t]; g[t][h] = __float_as_uint(GT[(lane + 64 * h) * 32 + tl0 + t]); }
    int run = 0;
#define PEER_RUN(T, SA, SB, PADR) { const int s0_ = e[T][0] >> PEER_SLICE_SHIFT, s1_ = e[T][1] >> PEER_SLICE_SHIFT; const bool h0_ = s0_ == (SA) || s0_ == (SB), h1_ = s1_ == (SA) || s1_ == (SB); \
        const unsigned long long m0_ = __ballot(h0_), m1_ = __ballot(h1_); const int c0_ = __popcll(m0_), c_ = c0_ + __popcll(m1_), p_ = (c_ + 3) & ~3; \
        if (h0_) SCH[run + mbcnt64(m0_)] = (v2u){(unsigned)e[T][0] | ((unsigned)(T) << 16), g[T][0]}; \
        if (h1_) SCH[run + c0_ + mbcnt64(m1_)] = (v2u){(unsigned)e[T][1] | ((unsigned)(T) << 16), g[T][1]}; \
        if (lane < p_ - c_) SCH[run + c_ + lane] = (v2u){(unsigned)(PADR) | ((unsigned)(T) << 16), 0u}; \
        run += p_; }
#pragma unroll 1
    for (int s = 0; s < (16384 >> PEER_SLICE_SHIFT); s += 2) {
        const int pad0 = s << PEER_SLICE_SHIFT, pad1 = (s + 1) << PEER_SLICE_SHIFT;
        if (lane == 0) SCH[SCH4_CAP - 8 + (s >> 1)] = (v2u){(unsigned)(run >> 2), 0u};
        PEER_RUN(0, s - 1, s, pad0)
        PEER_RUN(1, s, s, pad0)
        PEER_RUN(2, s, s, pad0)
        PEER_RUN(3, s, s + 1, pad1)
        PEER_RUN(2, s + 1, s + 1, pad1)
        PEER_RUN(1, s + 1, s + 1, pad1)
    }
    PEER_RUN(0, (16384 >> PEER_SLICE_SHIFT) - 1, (16384 >> PEER_SLICE_SHIFT) - 1, 16383)
#undef PEER_RUN
    return run >> 2;
}
__device__ __forceinline__ void ffn_quad(bool fake, int n0, int tl0, int lane, int wid, const bf16* H, const float* SS, const unsigned char* REC, const float* ISC, float* out, __attribute__((address_space(3))) unsigned char* lds3) {
    const __attribute__((address_space(3))) float* gffn = (const __attribute__((address_space(3))) float*)(lds3 + L_GN);
    const __attribute__((address_space(3))) float* gfin = gffn + 2048;
    __attribute__((address_space(3))) v2u* SCH = (__attribute__((address_space(3))) v2u*)(lds3 + L_SCH) + wid * SCH4_CAP;
    const int nb = __builtin_amdgcn_readfirstlane(build_schedule4(lane, tl0, lds3, SCH));
    TokX X0, X1, X2, X3;
    token_prologue(n0, lane, H, SS, gffn, X0); token_prologue(n0 + 1, lane, H, SS, gffn, X1); token_prologue(n0 + 2, lane, H, SS, gffn, X2); token_prologue(n0 + 3, lane, H, SS, gffn, X3);
    __syncthreads();
#define PEER_PSLOT(q) ((__attribute__((address_space(3))) v4u*)(lds3 + ((q) < 8 ? (q) * 4096 : L_PARK4B + ((q) - 8) * 4096)) + lane)
    TokX Xc = X0;
    v2f_t acc[16]; int cur = 0; unsigned pmap = ((unsigned)(3 * wid) << 8) | ((unsigned)(3 * wid + 1) << 16) | ((unsigned)(3 * wid + 2) << 24);
#pragma unroll
    for (int j = 0; j < 16; ++j) acc[j] = (v2f_t){0.f, 0.f};
    if (!fake)
#pragma unroll
    for (int q = 0; q < 3; ++q) { __attribute__((address_space(3))) v4u* ps_ = PEER_PSLOT(3 * wid + q);
#pragma unroll
        for (int j = 0; j < 4; ++j) ps_[j * 64] = (v4u){0u, 0u, 0u, 0u}; }
    const bool b5 = (lane & 32) != 0, b4 = (lane & 16) != 0;
    v4u uaA[4], vaA[4], uaB[4], vaB[4]; v2f_t scA[4], scB[4]; float gtA[4], gtB[4]; int tkA, tkB;
#define PEER_LOADB(UA, VA, SC, GTV, TK, BI) { _Pragma("unroll") for (int k = 0; k < 4; ++k) { const v2u en_ = SCH[4 * (BI) + k]; \
        const int ek_ = __builtin_amdgcn_readfirstlane((int)en_.x); if (k == 0) TK = ek_ >> 16; GTV[k] = __uint_as_float(en_.y); \
        const int ei_ = fake ? (ek_ & 0xffff & PEER_FAKE_EMASK) : (ek_ & 0xffff); const unsigned char* rec_ = REC + (size_t)ei_ * FP6_PITCH + lane * 16; \
        if (!(fake && PEER_FAKE_MODE == 2)) { UA[k] = *(const v4u*)rec_; VA[k] = *(const v4u*)(rec_ + 1024); SC[k] = *(const v2f_t*)(ISC + 2 * ei_); } \
        else { UA[k][0] ^= (unsigned)ei_; VA[k][1] += (unsigned)ei_; } } }
#define PEER_DEC(q, b) __builtin_amdgcn_cvt_scalef32_pk_f32_fp4(q, 1.0f, b)
#define PEER_SEL4(F) (t2_ ? (t1_ ? X3.F : X2.F) : (t1_ ? X1.F : X0.F))
#define PEER_UNPARK(PS) { _Pragma("unroll") for (int j = 0; j < 4; ++j) { const v4u o_ = (PS)[j * 64]; \
        acc[4 * j + 0] = (v2f_t){bflo(o_.x), bfhi(o_.x)}; acc[4 * j + 1] = (v2f_t){bflo(o_.y), bfhi(o_.y)}; acc[4 * j + 2] = (v2f_t){bflo(o_.z), bfhi(o_.z)}; acc[4 * j + 3] = (v2f_t){bflo(o_.w), bfhi(o_.w)}; } }
#define PEER_EVALB(UA, VA, SC, GTV, TK) if (fake && PEER_FAKE_MODE == 1) { _Pragma("unroll") for (int k = 0; k < 4; ++k) { \
            acc[k].x += __uint_as_float((UA[k][0] ^ UA[k][1]) + (UA[k][2] ^ UA[k][3])) * SC[k].x; acc[k].y += __uint_as_float((VA[k][0] ^ VA[k][1]) + (VA[k][2] ^ VA[k][3])) * GTV[k]; } } else { float d[4]; \
        const bool t1_ = ((TK) & 1) != 0, t2_ = ((TK) & 2) != 0; \
        if (!fake && (TK) != cur) {            \
            const int q_ = (int)((pmap >> (8 * (TK))) & 255u); __attribute__((address_space(3))) v4u* ps_ = PEER_PSLOT(q_); \
            _Pragma("unroll") for (int j = 0; j < 4; ++j) { const v4u o_ = ps_[j * 64]; \
                ps_[j * 64] = (v4u){pg8::cvt_pk_bf16(acc[4 * j].x, acc[4 * j].y), pg8::cvt_pk_bf16(acc[4 * j + 1].x, acc[4 * j + 1].y), pg8::cvt_pk_bf16(acc[4 * j + 2].x, acc[4 * j + 2].y), pg8::cvt_pk_bf16(acc[4 * j + 3].x, acc[4 * j + 3].y)}; \
                acc[4 * j + 0] = (v2f_t){bflo(o_.x), bfhi(o_.x)}; acc[4 * j + 1] = (v2f_t){bflo(o_.y), bfhi(o_.y)}; acc[4 * j + 2] = (v2f_t){bflo(o_.z), bfhi(o_.z)}; acc[4 * j + 3] = (v2f_t){bflo(o_.w), bfhi(o_.w)}; } \
            pmap = (pmap & ~(255u << (8 * cur))) | ((unsigned)q_ << (8 * cur)); cur = (TK); \
            _Pragma("unroll") for (int j = 0; j < 4; ++j) { Xc.xhi[j] = PEER_SEL4(xhi[j]); Xc.xlo[j] = PEER_SEL4(xlo[j]); } Xc.halfX = PEER_SEL4(halfX); Xc.sx = PEER_SEL4(sx); } \
        _Pragma("unroll") for (int k = 0; k < 4; ++k) { int sh = 0, sl = 0; \
            _Pragma("unroll") for (int j = 0; j < 4; ++j) { sh = __builtin_amdgcn_sdot8((int)UA[k][j], (int)Xc.xhi[j], sh, false); sl = __builtin_amdgcn_sdot8((int)UA[k][j], (int)Xc.xlo[j], sl, false); } \
            d[k] = (float)(sh * 16 + sl); } \
        __builtin_amdgcn_sched_barrier(0); \
        float t; { const auto r01 = __builtin_amdgcn_permlane32_swap(__float_as_uint(d[0]), __float_as_uint(d[1]), false, false); \
                   const auto r23 = __builtin_amdgcn_permlane32_swap(__float_as_uint(d[2]), __float_as_uint(d[3]), false, false); \
                   const float a01 = __uint_as_float(r01[0]) + __uint_as_float(r01[1]), a23 = __uint_as_float(r23[0]) + __uint_as_float(r23[1]); \
                   const auto rr = __builtin_amdgcn_permlane16_swap(__float_as_uint(a01), __float_as_uint(a23), false, false); \
                   t = row_sum16(__uint_as_float(rr[0]) + __uint_as_float(rr[1])); } \
        const float ius = b5 ? (b4 ? SC[3].x : SC[1].x) : (b4 ? SC[2].x : SC[0].x); \
        const float ivs = b5 ? (b4 ? SC[3].y : SC[1].y) : (b4 ? SC[2].y : SC[0].y); \
        const float gts = b5 ? (b4 ? GTV[3] : GTV[1]) : (b4 ? GTV[2] : GTV[0]); \
        const float wv = gts * gelu_tanh_fast((t + Xc.halfX) * (Xc.sx * ius)) * ivs; \
        float w[4]; \
        w[0] = __uint_as_float(__builtin_amdgcn_readlane(__float_as_uint(wv), 0)); w[2] = __uint_as_float(__builtin_amdgcn_readlane(__float_as_uint(wv), 16)); \
        w[1] = __uint_as_float(__builtin_amdgcn_readlane(__float_as_uint(wv), 32)); w[3] = __uint_as_float(__builtin_amdgcn_readlane(__float_as_uint(wv), 48)); \
        __builtin_amdgcn_sched_barrier(0); \
        _Pragma("unroll") for (int k = 0; k < 4; ++k) { const v2f_t wk = {w[k], w[k]}; \
            _Pragma("unroll") for (int j = 0; j < 4; ++j) { const unsigned qw = VA[k][j]; \
                acc[4 * j + 0] += wk * PEER_DEC(qw, 0); acc[4 * j + 1] += wk * PEER_DEC(qw, 1); acc[4 * j + 2] += wk * PEER_DEC(qw, 2); acc[4 * j + 3] += wk * PEER_DEC(qw, 3); } \
            __builtin_amdgcn_sched_barrier(0); } }
    if (fake && PEER_FAKE_MODE == 2) {
#pragma unroll
        for (int k = 0; k < 4; ++k) { uaA[k] = (v4u){(unsigned)lane, 1u, 2u, 3u}; vaA[k] = uaA[k]; uaB[k] = uaA[k]; vaB[k] = uaA[k]; scA[k] = (v2f_t){1.f, 1.f}; scB[k] = scA[k]; } }
    PEER_LOADB(uaA, vaA, scA, gtA, tkA, 0)
    int kb = 1, nbnd = PEER_SYNC_SLICES ? __builtin_amdgcn_readfirstlane((int)SCH[SCH4_CAP - 8 + 1].x) : 0x7fffffff;
#pragma unroll 1
    for (int i = 0; i < nb; i += 2) {
#if PEER_SYNC_SLICES
        while (i >= nbnd) { __builtin_amdgcn_s_barrier(); ++kb; nbnd = kb < 8 ? __builtin_amdgcn_readfirstlane((int)SCH[SCH4_CAP - 8 + (kb & 7)].x) : 0x7fffffff; }
#endif
        { const int bn = i + 1 < nb ? i + 1 : nb - 1; PEER_LOADB(uaB, vaB, scB, gtB, tkB, bn) }
        __builtin_amdgcn_sched_barrier(0);
        PEER_EVALB(uaA, vaA, scA, gtA, tkA)
        __builtin_amdgcn_sched_barrier(0);
        { const int bn = i + 2 < nb ? i + 2 : nb - 1; PEER_LOADB(uaA, vaA, scA, gtA, tkA, bn) }
        __builtin_amdgcn_sched_barrier(0);
        if (i + 1 < nb) { PEER_EVALB(uaB, vaB, scB, gtB, tkB) }
        __builtin_amdgcn_sched_barrier(0);
    }
#if PEER_SYNC_SLICES
    while (kb < 8) { __builtin_amdgcn_s_barrier(); ++kb; }
#endif
    if (fake) { float sq_ = 0.f;
#pragma unroll
        for (int j = 0; j < 16; ++j) sq_ += acc[j].x + acc[j].y;
        if (sq_ != 12345.678f) return; }
    token_epilogue(n0 + cur, lane, H, gfin, acc, out);
#pragma unroll 1
    for (int t = 0; t < 4; ++t) if (t != cur) { const int q_ = (int)((pmap >> (8 * t)) & 255u); __attribute__((address_space(3))) v4u* ps_ = PEER_PSLOT(q_);
        PEER_UNPARK(ps_)
        token_epilogue(n0 + t, lane, H, gfin, acc, out); }
#undef PEER_LOADB
#undef PEER_EVALB
#undef PEER_DEC
#undef PEER_SEL4
#undef PEER_UNPARK
#undef PEER_PSLOT
}

__device__ __forceinline__ void peer_phase(const bf16* QP, const bf16* SKB, const bf16* H, const float* SS, const float* gffn, const unsigned char* REC, const float* ISC,
                                           const float* gfin, float* out, __attribute__((address_space(3))) unsigned char* lds3, int bid, int G) {
    int tid = threadIdx.x; asm volatile("" : "+v"(tid));
    const int lane = tid & 63, wid = __builtin_amdgcn_readfirstlane(tid >> 6);
    { __attribute__((address_space(3))) float* gl = (__attribute__((address_space(3))) float*)(lds3 + L_GN);
      for (int i = tid; i < 2048; i += NTHR) { gl[i] = gffn[i]; gl[2048 + i] = gfin[i]; } }
    for (int unit = bid; unit < NTOK / 32; unit += G) {
        const int tok0 = unit * 32;
        route_head(QP, SKB, wid, tok0, lane, lds3);
        asm volatile("s_waitcnt lgkmcnt(0)" ::: "memory"); __syncthreads();
        { int ln = lane; asm volatile("" : "+v"(ln));
#if PEER_SLICED == 2
#if PEER_FAKE
          ffn_quad(true, tok0 + wid * 4, wid * 4, ln, wid, H, SS, REC, ISC, out, lds3);
          __syncthreads();
#endif
          ffn_quad(false, tok0 + wid * 4, wid * 4, ln, wid, H, SS, REC, ISC, out, lds3);
#elif PEER_SLICED
#pragma unroll 1
#if PEER_FAKE
          for (int rd = 0; rd < 2; ++rd) ffn_pair(true, tok0 + wid * 4 + 2 * rd, wid * 4 + 2 * rd, ln, wid, H, SS, REC, ISC, out, lds3);
#pragma unroll 1
#endif
          for (int rd = 0; rd < 2; ++rd) ffn_pair(false, tok0 + wid * 4 + 2 * rd, wid * 4 + 2 * rd, ln, wid, H, SS, REC, ISC, out, lds3);
#else
#if PEER_FAKE
#pragma unroll 1
          for (int tk = 0; tk < 4; ++tk) ffn_token(PEER_FAKE, true, tok0 + wid * 4 + tk, wid * 4 + tk, ln, H, SS, REC, ISC, out, lds3);
#endif
#pragma unroll 1
          for (int tk = 0; tk < 4; ++tk) ffn_token(0xffffff, false, tok0 + wid * 4 + tk, wid * 4 + tk, ln, H, SS, REC, ISC, out, lds3);
#endif
        }
        __syncthreads();
    }
}
#undef PEER_CE
}
constexpr int RING_BYTES = 131072, LDS_BYTES = 163840, LDSCTL_OFF = LDS_BYTES - 1024, MISC_OFF = LDSCTL_OFF + 320;
constexpr int N_PHASES = 8;
#ifndef PG8_SP2_SMALL
#define PG8_SP2_SMALL true
#endif
#ifndef MK_N_LAUNCHES
#define MK_N_LAUNCHES 1
#endif

__global__ void __launch_bounds__(NTHR, 2) fwd_megakernel(Args args) {
    extern __shared__ __attribute__((aligned(16))) unsigned char lds[];
    LAS unsigned char* lds3 = (LAS unsigned char*)lds;
    int tid_ = threadIdx.x; asm volatile("" : "+v"(tid_));
    const int tid = tid_, lane = tid & 63, wave = __builtin_amdgcn_readfirstlane(tid >> 6);
    const int G = gridDim.x, bid = blockIdx.x;
    unsigned char* ws = args.ws;
    unsigned* ctl = (unsigned*)(ws + WS_CTL);
    const float* x = args.in[0];
    bf16* WinT = (bf16*)(ws + WS_WIN); bf16* WbnT = (bf16*)(ws + WS_WBN); bf16* WbsT = (bf16*)(ws + WS_WBS); bf16* WoutT = (bf16*)(ws + WS_WOUT); bf16* WpqT = (bf16*)(ws + WS_WPQ);
    bf16* XN = (bf16*)(ws + WS_XN); bf16* MERGED = XN; bf16* PROJ = (bf16*)(ws + WS_PROJ);
    bf16* ONSA = (bf16*)(ws + WS_ONSA); bf16* OSB = (bf16*)(ws + WS_OSB);
    float* H = (float*)(ws + WS_H); bf16* HB = (bf16*)(ws + WS_HB);
    unsigned char* REC = ws + WS_UB; float* ISC = (float*)(ws + WS_UB + 48 * MiB); bf16* QP = (bf16*)(ws + WS_QP);
    int* EXPERT = (int*)(ws + WS_EXP); float* GATE = (float*)(ws + WS_GATE);
    bf16* KCB = (bf16*)(ws + WS_MISC + MISC_KCB); bf16* VCB = (bf16*)(ws + WS_MISC + MISC_VCB);
    float* SS = (float*)(ctl + CW_SS);
    float* BTG = (float*)(ws + WS_MISC + MISC_B1 + 4096);
    bf16* W1T = (bf16*)(ws + WS_MISC + MISC_W1T); float* BIAS1 = (float*)(ws + WS_MISC + MISC_B1);
    bf16* SKB = (bf16*)(ws + WS_MISC + MISC_SKB);

    for (int u = tid; u < (LDS_BYTES - LDSCTL_OFF) / 4; u += NTHR) ((LAS unsigned*)(lds3 + LDSCTL_OFF))[u] = 0u;
    __syncthreads();
    const int lo = args.ph_lo, hi = args.ph_hi;
    XcdBarrier bar; bar.bar = ctl + CW_BAR; bar.x = 0; bar.st = nullptr;
    if (hi - lo > 1) bar = xcd_barrier_post(ctl + CW_BAR, (volatile LAS unsigned*)(lds3 + MISC_OFF) + 8);
#define IN(k) (lo <= (k) && (k) < hi)
#ifndef REP_BAR
#define REP_BAR 1
#endif
#define SEAM(k) do { if (IN(k) && IN((k) + 1)) for (int rb_ = 0; rb_ < REP_BAR; ++rb_) xcd_barrier(bar); } while (0)
    const int gw = bid * NWAVES + wave, NGW = G * NWAVES;
    const int vcu = (G % 8 == 0) ? (bid % 8) * (G / 8) + bid / 8 : bid;

#if defined(TS_PHASE)
    unsigned long long ts0_ = 0;
#define TS_BEGIN(k) do { if (TS_PHASE == (k)) ts0_ = __builtin_amdgcn_s_memrealtime(); } while (0)
#define TS_END(k) do { if (TS_PHASE == (k)) { const unsigned dt_ = (unsigned)(__builtin_amdgcn_s_memrealtime() - ts0_); if (tid == 0) atomicMax(ctl + 64, dt_); } } while (0)
#else
#define TS_BEGIN(k) do {} while (0)
#define TS_END(k) do {} while (0)
#endif
#ifndef REP_P0
#define REP_P0 1
#endif
#ifndef REP_P1
#define REP_P1 1
#endif
#ifndef REP_P4
#define REP_P4 1
#endif
#ifndef REP_P6
#define REP_P6 1
#endif
#ifndef REP_P5C
#define REP_P5C 1
#endif
    TS_BEGIN(0);
    if (IN(0)) for (int rep_ = 0; rep_ < REP_P0; ++rep_) {
        LAS float* scr = (LAS float*)(lds3 + wave * 16384);
        constexpr int I_IN = (D_MODEL / 64) * ((IN_COLS + 31) / 32), I_BR = (1024 / 64) * (D_MODEL / 32), I_SQ = (D_MODEL / 64) * (D_MODEL / 32);
        constexpr int I_C1 = (2048 / 64) * (CMP_HID / 32);
        constexpr int NITEMS = I_IN + 2 * I_BR + 2 * I_SQ + 2 * I_C1;
        auto p0_desc = [&](int it) -> P0Item {
            int r = it;
            if (r < I_IN) return P0Item{args.in[2], WinT, nullptr, D_MODEL, IN_COLS, r, C_SHIFT_FROM, C_SHIFT}; r -= I_IN;
            if (r < I_BR) return P0Item{args.in[10], WbnT, nullptr, 1024, D_MODEL, r, 0x7fffffff, 0}; r -= I_BR;
            if (r < I_BR) return P0Item{args.in[11], WbsT, nullptr, 1024, D_MODEL, r, 0x7fffffff, 0}; r -= I_BR;
            if (r < I_SQ) return P0Item{args.in[12], WoutT, nullptr, D_MODEL, D_MODEL, r, 0x7fffffff, 0}; r -= I_SQ;
            if (r < I_SQ) return P0Item{args.in[14], WpqT, args.in[13], D_MODEL, D_MODEL, r, 0x7fffffff, 0}; r -= I_SQ;
            if (r < I_C1) return P0Item{args.in[4], W1T, nullptr, 2048, CMP_HID, r, 0x7fffffff, 0}; r -= I_C1;
            return P0Item{args.in[7], W1T + (size_t)CMP_HID * 2048, nullptr, 2048, CMP_HID, r, 0x7fffffff, 0};
        };
        {
            f32x4 va[8], vb[8];
            int it = gw;
            P0Item da = p0_desc(it < NITEMS ? it : 0), db = da;
            if (it < NITEMS) p0_item_load(da, lane, va);
#pragma unroll 1
            for (; it < NITEMS; it += 2 * NGW) {
                const int i1 = it + NGW, i2 = it + 2 * NGW;
                if (i1 < NITEMS) { db = p0_desc(i1); p0_item_load(db, lane, vb); }
                __builtin_amdgcn_sched_barrier(0);
                p0_item_store(da, lane, va, scr);
                __builtin_amdgcn_sched_barrier(0);
                if (i2 < NITEMS) { da = p0_desc(i2); p0_item_load(da, lane, va); }
                __builtin_amdgcn_sched_barrier(0);
                if (i1 < NITEMS) p0_item_store(db, lane, vb, scr);
                __builtin_amdgcn_sched_barrier(0);
            }
        }
        {
            v4u z = {0u, 0u, 0u, 0u}; bf16* p = WinT + (size_t)C_SHIFT_FROM * D_MODEL; const size_t nz = (size_t)C_SHIFT * D_MODEL;
            for (size_t i = ((size_t)bid * NTHR + tid) * 8; i < nz; i += (size_t)G * NTHR * 8) *(v4u*)(p + i) = z;
        }
        if (gw < 2 * CMP_HID) {
            const int kv = gw >> 7, j = gw & 127; const float* pe = args.in[kv ? 6 : 3]; const float* w1 = args.in[kv ? 7 : 4];
            float s = 0.f;
            for (int k2 = lane; k2 < 2048; k2 += 64) s += pe[k2] * w1[(size_t)k2 * CMP_HID + j];
            s = wave_sum(s);
            if (lane == 0) BIAS1[gw] = s;
        }
        for (int i = bid * NTHR + tid; i < 4 * 4 * 800; i += G * NTHR) { const int gq = i / 800, d = i - gq * 800; BTG[i] = args.in[9][rel_bucket(d) * 16 + gq] * 1.4426950408889634f; }
        cvt_flat(args.in[15], SKB, (size_t)16 * 128 * 128, (size_t)bid * NTHR + tid, (size_t)G * NTHR);
        for (int m = gw; m < NTOK; m += NGW) rms_row_to_bf16(x + (size_t)m * D_MODEL, args.in[1], XN + (size_t)m * D_MODEL, lane);
    }
    TS_END(0);
    SEAM(0);
    TS_BEGIN(1);
    if (IN(1)) for (int rep_ = 0; rep_ < REP_P1; ++rep_) {
        pg8::Gemm g{XN, WinT, NTOK, PLD, D_MODEL}; pg8::StaticOrder S; S.init(NTOK, PLD, G, bid);
        pg8::EpiBf16<0> E{PROJ, PP, nullptr, PP, (size_t)NTOK * PP, 1.f};
        pg8::gemm_phase<pg8::EpiBf16<0>, pg8::StaticOrder, true, true>(lds3, g, S, E);
    }
    TS_END(1);
    SEAM(1);
    TS_BEGIN(2);
    if (IN(2)) cmpr::compress_phase(PROJ, W1T, BIAS1, args.in, KCB, VCB, lds3, bid, G);
    TS_END(2);
    SEAM(2);
    TS_BEGIN(3);
    if (IN(3)) {
        TS_BEGIN(30);
        nsa::nsa_phase(PROJ, KCB, VCB, BTG, ONSA, lds3, vcu, G, args.variant);
        TS_END(30);
#if defined(PROBE_P3A)
        nsa::nsa_phase(PROJ, KCB, VCB, args.in[9], ONSA, lds3, vcu, G);
#endif
        TS_BEGIN(31);
        if (!(args.variant & 32)) nsa::stick_phase(PROJ, OSB, lds3, vcu, G);
        TS_END(31);
#if defined(PROBE_P3B)
        nsa::stick_phase(PROJ, OSB, lds3, vcu, G);
#endif
    }
    TS_END(3);
    SEAM(3);
    TS_BEGIN(4);
    if (IN(4)) for (int rep_ = 0; rep_ < REP_P4; ++rep_) {
        static_assert(WS_OSB == WS_ONSA + (size_t)NTOK * NSA_Q * 2 && WS_WBS == WS_WBN + (size_t)D_MODEL * 1024 * 2, "branch operands must be contiguous");
        pg8::Gemm g{ONSA, WbnT, 2 * NTOK, 2 * D_MODEL, 1024}; pg8::BranchOrder S; S.init(NTOK, D_MODEL, G, bid);
        pg8::EpiGate2 E{MERGED, D_MODEL, PNL(PROJ, P_GA), PNL(PROJ, P_GB), PP, (size_t)NTOK * PP - PP, NTOK / 256, D_MODEL / 256};
        pg8::gemm_phase<pg8::EpiGate2, pg8::BranchOrder, true, PG8_SP2_SMALL>(lds3, g, S, E);
    }
    TS_END(4);
    SEAM(4);
    TS_BEGIN(5);
    if (IN(5)) {
        if (!(args.variant & 64)) { pg8::Gemm g{MERGED, WoutT, NTOK, D_MODEL, D_MODEL}; pg8::StaticOrder S; S.init(NTOK, D_MODEL, G, bid);
          pg8::EpiResid E{x, HB, SS, D_MODEL};
          pg8::gemm_phase<pg8::EpiResid, pg8::StaticOrder, true, PG8_SP2_SMALL>(lds3, g, S, E); }
        int t5 = threadIdx.x; asm volatile("" : "+v"(t5));
        const int lane5 = t5 & 63, gw5 = bid * NWAVES + __builtin_amdgcn_readfirstlane(t5 >> 6);
        if (!(args.variant & 128)) peer::cvt_tables(args.in[16], args.in[17], REC, ISC, gw5, NGW, lane5);
    }
    TS_END(5);
    SEAM(5);
    TS_BEGIN(6);
    if (IN(6)) for (int rep_ = 0; rep_ < REP_P6; ++rep_) {
        pg8::Gemm g{HB, WpqT, NTOK, D_MODEL, D_MODEL}; pg8::StaticOrder S; S.init(NTOK, D_MODEL, G, bid);
        pg8::EpiRowScale E{QP, D_MODEL, SS, 1.f / D_MODEL, EPS};
        pg8::gemm_phase<pg8::EpiRowScale, pg8::StaticOrder, true, PG8_SP2_SMALL>(lds3, g, S, E);
    }
    TS_END(6);
    SEAM(6);
    TS_BEGIN(7);
    if (IN(7)) {
        peer::peer_phase(QP, SKB, HB, SS, args.in[13], REC, ISC, args.in[18], args.out, lds3, bid, G);
    }
    TS_END(7);
#if defined(TS_PHASE)
    xcd_barrier(bar);
    if (bid == 0) { const unsigned dt_ = __hip_atomic_load(ctl + 64, RLX_AGENT); const int K_ = (int)((float)dt_ * 0.01f * 16.777216f * 2.f);
        for (int i = tid; i < K_; i += NTHR) args.out[i] += 1.0f; }
#endif
#undef IN
#undef SEAM
}

extern "C" void kernel_launch(void* const* d_in, const int* in_sizes, int n_in, void* d_out, int out_size, void* d_ws, size_t ws_size, hipStream_t stream) {
    static int grid = 0;
    if (grid == 0) {
        if (n_in != 19 || ws_size < WS_END) { fprintf(stderr, "kernel_launch: unexpected inputs (%d) or workspace (%zu < %zu)\n", n_in, ws_size, (size_t)WS_END); grid = -1; return; }
        int dev = 0, cus = 0, per_cu = 0;
        hipGetDevice(&dev); hipDeviceGetAttribute(&cus, hipDeviceAttributeMultiprocessorCount, dev);
        if (hipFuncSetAttribute((const void*)fwd_megakernel, hipFuncAttributeMaxDynamicSharedMemorySize, LDS_BYTES) != hipSuccess) { fprintf(stderr, "hipFuncSetAttribute failed\n"); grid = -1; return; }
        if (hipOccupancyMaxActiveBlocksPerMultiprocessor(&per_cu, (const void*)fwd_megakernel, NTHR, LDS_BYTES) != hipSuccess || per_cu < 1) { fprintf(stderr, "occupancy query: %d\n", per_cu); per_cu = 1; }
        (void)hipGetLastError();
        grid = cus;
        if (grid > cus * per_cu) grid = cus * per_cu;
    }
    if (grid < 0) return;
    hipMemsetAsync((char*)d_ws + WS_CTL, 0, (size_t)(CW_SS + NTOK) * 4, stream);
    Args a{};
    for (int i = 0; i < 19; ++i) a.in[i] = (const float*)d_in[i];
    a.out = (float*)d_out; a.ws = (unsigned char*)d_ws;
#if defined(PROBE_SPLIT_LO2)
#ifndef PROBE_VARIANT
#define PROBE_VARIANT 0
#endif
    {
        a.ph_lo = 0; a.ph_hi = PROBE_SPLIT_HI1; a.variant = PROBE_VARIANT; hipLaunchKernelGGL(fwd_megakernel, dim3(grid), dim3(NTHR), LDS_BYTES, stream, a);
        hipMemsetAsync((char*)d_ws + WS_CTL + CW_BAR * 4, 0, XCD_BAR_WORDS * 4, stream);
        if (PROBE_SPLIT_LO2 <= 5 && PROBE_SPLIT_HI1 > 5) hipMemsetAsync((char*)d_ws + WS_CTL + CW_SS * 4, 0, NTOK * 4, stream);
        a.ph_lo = PROBE_SPLIT_LO2; a.ph_hi = N_PHASES; a.variant = 0; hipLaunchKernelGGL(fwd_megakernel, dim3(grid), dim3(NTHR), LDS_BYTES, stream, a);
        return;
    }
#endif
    if (MK_N_LAUNCHES == 1) {
        a.ph_lo = 0; a.ph_hi = N_PHASES;
        void* kargs[] = {&a};
#if defined(USE_COOP_LAUNCH)
        hipError_t e = hipLaunchCooperativeKernel((const void*)fwd_megakernel, dim3(grid), dim3(NTHR), kargs, LDS_BYTES, stream);
        if (e != hipSuccess) fprintf(stderr, "cooperative launch failed: %s (grid %d)\n", hipGetErrorString(e), grid);
#else
        (void)kargs;
        hipLaunchKernelGGL(fwd_megakernel, dim3(grid), dim3(NTHR), LDS_BYTES, stream, a);
#endif
    } else {
        for (int p = 0; p < N_PHASES; ++p) { a.ph_lo = p; a.ph_hi = p + 1; hipLaunchKernelGGL(fwd_megakernel, dim3(grid), dim3(NTHR), LDS_BYTES, stream, a); }
    }
}
```

```cpp
#include <hip/hip_runtime.h>
#include <cstdio>
#include <cstdint>
#include <cmath>
#ifndef PG8_NT_STORES
#define PG8_NT_STORES 0
#endif
#if PG8_NT_STORES
#define PG8_STORE_OUT(p, v) __builtin_nontemporal_store((v), (p))
#else
#define PG8_STORE_OUT(p, v) (*(p) = (v))
#endif
namespace pg8 {
#define PG8_LAS __attribute__((address_space(3)))
typedef unsigned short bf16_t;
typedef short bf16x8 __attribute__((ext_vector_type(8)));
typedef float f32x4 __attribute__((ext_vector_type(4)));
typedef unsigned u32x4 __attribute__((ext_vector_type(4)));
constexpr int BM = 256, BK = 64, HALF = 128, HTB = HALF * BK * 2  , STAGE_BYTES = 8 * HTB, NXCD = 8, WGM = 8;

__host__ __device__ __forceinline__ int lds_byte(int r, int c) { const int st = (r >> 4) * 2 + (c >> 5), rr = r & 15, cc = c & 31, ob = rr * 64 + cc * 2; return st * 1024 + (ob ^ (((ob >> 9) & 1) << 5)); }
__host__ __device__ __forceinline__ void stage_rc(int b, int& R, int& C) { const int st = b / 1024, sb = b % 1024, swz = sb ^ (((sb >> 9) & 1) << 5); R = (st >> 1) * 16 + swz / 64; C = (st & 1) * 32 + (swz % 64) / 2; }
__host__ __device__ __forceinline__ int perm32(int rho) { const int n = rho >> 4, i = rho & 15; return 8 * (i >> 2) + 4 * n + (i & 3); }

struct Unit { int pm, pn; };
struct Gemm { const bf16_t* A; const bf16_t* Bt; int M, N, K; };

struct StaticOrder {
    int nM, nN, nwg, G, c;
    __host__ __device__ void init(int M, int N, int G_, int c_) { nM = M / BM; nN = N / BM; nwg = nM * nN; G = G_; c = c_; }
    __host__ __device__ bool next(int i, Unit& u) const {
        const long L = (long)i * G + c; if (L >= nwg) return false;
        int wgid = (int)L; { const int q = nwg / NXCD, r = nwg % NXCD, xcd = wgid % NXCD, off = wgid / NXCD; wgid = (xcd < r ? xcd * (q + 1) : r * (q + 1) + (xcd - r) * q) + off; }
        const int nig = WGM * nN, gid = wgid / nig, fm = gid * WGM, gsz = (nM - fm) < WGM ? (nM - fm) : WGM;
        u.pm = fm + ((wgid % nig) % gsz); u.pn = (wgid % nig) / gsz; return true;
    }
    __device__ __forceinline__ void a_ready(const Unit&) const {}
    __device__ __forceinline__ void done(const Unit&) const {}
};

__device__ __forceinline__ unsigned cvt_pk_bf16(float lo, float hi) { unsigned r; asm volatile("v_cvt_pk_bf16_f32 %0, %1, %2" : "=v"(r) : "v"(lo), "v"(hi)); return r; }
typedef float f32x2 __attribute__((ext_vector_type(2)));
__device__ __forceinline__ f32x2 gelu_pk(f32x2 v) {
    const f32x2 av = __builtin_elementwise_abs(v), d = av * 0.2316418882f + 1.0f;
    f32x2 t; t.x = __builtin_amdgcn_rcpf(d.x); t.y = __builtin_amdgcn_rcpf(d.y);
    f32x2 q = t * 0.5307027145f + (-0.7265760135f); q = q * t + 0.7107068705f; q = q * t + (-0.142248368f); q = q * t + 0.127414796f; q = q * t;
    const f32x2 s = (v * v) * (-0.72134752044f);
    f32x2 e; e.x = __builtin_amdgcn_exp2f(s.x); e.y = __builtin_amdgcn_exp2f(s.y);
    const f32x2 m = v * (q * e), r = v - m;
    f32x2 o; o.x = v.x < 0.f ? m.x : r.x; o.y = v.y < 0.f ? m.y : r.y; return o;
}

template <int ACT  > struct EpiBf16 {
    static constexpr bool PERM = true, AFTER_DRAIN = false; static_assert(ACT == 0 || ACT == 1, "EpiBf16: ACT is 0 (none) or 1 (gelu_pk)");
    bf16_t* O; int ldc; const float* bias; int split_cols; size_t split_stride; float scale0;
    __device__ __forceinline__ void operator()(const f32x4 (&acc)[2][2][4][2], const Unit& u, int wr, int wc, int fr, int fq) const {
        const int row0 = u.pm * BM + wr * 64 + fr; int colt = u.pn * BM; bf16_t* base = O;
        float sc = 1.f; if (split_cols) { const int t = colt / split_cols; base += (size_t)t * split_stride; colt -= t * split_cols; if (t == 0) sc = scale0; }
        const int col0 = colt + wc * 32 + 8 * fq, bcol0 = u.pn * BM + wc * 32 + 8 * fq;
        f32x4 bv[2][2];
#pragma unroll
        for (int bj = 0; bj < 2; ++bj)
#pragma unroll
            for (int n = 0; n < 2; ++n) bv[bj][n] = bias ? *(const f32x4*)(bias + bcol0 + bj * HALF + 4 * n) : (f32x4){0.f, 0.f, 0.f, 0.f};
#pragma unroll
        for (int ai = 0; ai < 2; ++ai)
#pragma unroll
            for (int m = 0; m < 4; ++m) { bf16_t* rowp = base + (size_t)(row0 + ai * HALF + m * 16) * ldc + col0;
#pragma unroll
                for (int bj = 0; bj < 2; ++bj) { f32x4 v0 = acc[ai][bj][m][0] + bv[bj][0], v1 = acc[ai][bj][m][1] + bv[bj][1];
                    if (ACT == 1) { f32x2 a = gelu_pk((f32x2){v0[0], v0[1]}), b = gelu_pk((f32x2){v0[2], v0[3]}), c = gelu_pk((f32x2){v1[0], v1[1]}), d = gelu_pk((f32x2){v1[2], v1[3]});
                        v0 = (f32x4){a.x, a.y, b.x, b.y}; v1 = (f32x4){c.x, c.y, d.x, d.y}; }
                    v0 = v0 * sc; v1 = v1 * sc; u32x4 w; w.x = cvt_pk_bf16(v0[0], v0[1]); w.y = cvt_pk_bf16(v0[2], v0[3]); w.z = cvt_pk_bf16(v1[0], v1[1]); w.w = cvt_pk_bf16(v1[2], v1[3]);
                    PG8_STORE_OUT((u32x4*)(rowp + bj * HALF), w); } }
    }
};

struct PanelStats {
    unsigned* xbuf;
    unsigned* cnt;
    unsigned* tmo;
    int ntn; float eps;
    unsigned code;
    __device__ __forceinline__ bool run(const f32x4 (&v)[2][2][4][2], const Unit& u, int wr, int wc, int fr, int fq, PG8_LAS unsigned char* lds, int wid, int lane) const {
        typedef float f32x2v __attribute__((ext_vector_type(2)));
        PG8_LAS f32x2v* P = (PG8_LAS f32x2v*)lds;
        PG8_LAS f32x2v* S = (PG8_LAS f32x2v*)(lds + 8192);
        PG8_LAS unsigned* flag = (PG8_LAS unsigned*)(lds + 8192 + 2048);
#pragma unroll
        for (int ai = 0; ai < 2; ++ai)
#pragma unroll
            for (int m = 0; m < 4; ++m) {
                float s = 0.f;
#pragma unroll
                for (int bj = 0; bj < 2; ++bj)
#pragma unroll
                    for (int n = 0; n < 2; ++n) { const f32x4 x = v[ai][bj][m][n]; s += (x[0] + x[1]) + (x[2] + x[3]); }
                s += __shfl_xor(s, 16); s += __shfl_xor(s, 32);
                const float mw = s * (1.0f / 64.0f); float q = 0.f;
#pragma unroll
                for (int bj = 0; bj < 2; ++bj)
#pragma unroll
                    for (int n = 0; n < 2; ++n) { const f32x4 d = v[ai][bj][m][n] - mw; q += (d[0] * d[0] + d[1] * d[1]) + (d[2] * d[2] + d[3] * d[3]); }
                q += __shfl_xor(q, 16); q += __shfl_xor(q, 32);
                if (fq == 0) P[(ai * HALF + wr * 64 + m * 16 + fr) * 4 + wc] = (f32x2v){mw, q};
            }
        asm volatile("s_waitcnt lgkmcnt(0)" ::: "memory"); __builtin_amdgcn_s_barrier(); asm volatile("" ::: "memory");
#if defined(BROKEN_EXCHANGE_NO_WAIT)
#warning BROKEN CONTROL BUILD: the row-statistics exchange does not wait; results are wrong by design
        if (blockIdx.x >= 64) { const long long t0_ = clock64(); while (clock64() - t0_ < 60000) __builtin_amdgcn_s_sleep(8); }
#endif
        const int row = wid * 32 + (lane & 31);
        if (lane < 32) {
            const f32x2v a = P[row * 4 + 0], b = P[row * 4 + 1], c = P[row * 4 + 2], d = P[row * 4 + 3];
            const float mt = (a.x + b.x + c.x + d.x) * 0.25f;
            const float da = a.x - mt, db = b.x - mt, dc = c.x - mt, dd = d.x - mt;
            const float m2 = (a.y + b.y) + (c.y + d.y) + 64.0f * ((da * da + db * db) + (dc * dc + dd * dd));
            unsigned long long* slot = (unsigned long long*)xbuf + ((size_t)(u.pm * BM + row) * 4 + u.pn);
            __hip_atomic_store(slot, ((unsigned long long)__float_as_uint(m2) << 32) | __float_as_uint(mt), __ATOMIC_RELAXED, __HIP_MEMORY_SCOPE_AGENT);
        }
        asm volatile("s_waitcnt vmcnt(0)" ::: "memory");
        if (lane == 0) __hip_atomic_fetch_add(cnt + 64 * u.pm, 1u, __ATOMIC_RELAXED, __HIP_MEMORY_SCOPE_AGENT);
        if (wid == 0) {
            bool dead = false; const unsigned long long t0 = __builtin_amdgcn_s_memrealtime(); const unsigned want = 8u * (unsigned)ntn;
            for (;;) {
#if defined(BROKEN_EXCHANGE_NO_WAIT)
                break;
#endif
                if ((unsigned)__builtin_amdgcn_readfirstlane(__hip_atomic_load(cnt + 64 * u.pm, __ATOMIC_RELAXED, __HIP_MEMORY_SCOPE_AGENT)) >= want) break;
                if (__builtin_amdgcn_s_memrealtime() - t0 > 2000000ull) {
                    if (lane == 0) { unsigned expect = 0u; __hip_atomic_compare_exchange_strong(tmo + 1, &expect, code | (unsigned)(u.pm & 0xff), __ATOMIC_RELAXED, __ATOMIC_RELAXED, __HIP_MEMORY_SCOPE_AGENT);
                                     __hip_atomic_store(tmo, 1u, __ATOMIC_RELAXED, __HIP_MEMORY_SCOPE_AGENT); }
                    dead = true; break; }
                __builtin_amdgcn_s_sleep(2);
            }
            __builtin_amdgcn_fence(__ATOMIC_ACQUIRE, "agent");
            if (lane == 0) flag[0] = dead ? 1u : 0u;
        }
        asm volatile("s_waitcnt vmcnt(0) lgkmcnt(0)" ::: "memory"); __builtin_amdgcn_s_barrier(); asm volatile("" ::: "memory");
        const bool bad = flag[0] != 0u;
        if (lane < 32) {
            const unsigned long long* slot = (const unsigned long long*)xbuf + (size_t)(u.pm * BM + row) * 4; float mt[4], m2[4]; float ms = 0.f;
#pragma unroll
            for (int t = 0; t < 4; ++t) { if (t < ntn) { const unsigned long long w = __hip_atomic_load(slot + t, __ATOMIC_RELAXED, __HIP_MEMORY_SCOPE_AGENT); mt[t] = __uint_as_float((unsigned)w); m2[t] = __uint_as_float((unsigned)(w >> 32)); } else { mt[t] = 0.f; m2[t] = 0.f; } ms += mt[t]; }
            const float mean = ms / (float)ntn; float q = 0.f;
#pragma unroll
            for (int t = 0; t < 4; ++t) if (t < ntn) { const float dm = mt[t] - mean; q += m2[t] + 256.0f * dm * dm; }
            S[row] = (f32x2v){mean, 1.0f / sqrtf(q / (256.0f * (float)ntn) + eps)};
        }
        asm volatile("s_waitcnt lgkmcnt(0)" ::: "memory"); __builtin_amdgcn_s_barrier(); asm volatile("" ::: "memory");
        return bad;
    }
};
struct EpiLnRes {
    static constexpr bool PERM = false, AFTER_DRAIN = true;
    const float* base; float* out; int ldc; const float* bias; PanelStats st; unsigned poison;
    __device__ __forceinline__ void fused(f32x4 (&acc)[2][2][4][2], const Unit& u, int wr, int wc, int fr, int fq, PG8_LAS unsigned char* lds, int wid, int lane) const {
        typedef float f32x2v __attribute__((ext_vector_type(2)));
        const PG8_LAS f32x2v* S = (const PG8_LAS f32x2v*)(lds + 8192);
        const int col0 = u.pn * BM + wc * 32 + 4 * fq;
#pragma unroll
        for (int bj = 0; bj < 2; ++bj)
#pragma unroll
            for (int n = 0; n < 2; ++n) { const f32x4 bv = bias ? *(const f32x4*)(bias + col0 + bj * HALF + n * 16) : (f32x4){0.f, 0.f, 0.f, 0.f};
#pragma unroll
                for (int ai = 0; ai < 2; ++ai)
#pragma unroll
                    for (int m = 0; m < 4; ++m) acc[ai][bj][m][n] += bv; }
        f32x4 pre[4][2][2];
#pragma unroll
        for (int m = 0; m < 4; ++m) { const size_t off = (size_t)(u.pm * BM + wr * 64 + m * 16 + fr) * ldc + col0;
#pragma unroll
            for (int bj = 0; bj < 2; ++bj)
#pragma unroll
                for (int n = 0; n < 2; ++n) pre[m][bj][n] = *(const f32x4*)(base + off + bj * HALF + n * 16); }
        const bool bad = st.run(acc, u, wr, wc, fr, fq, lds, wid, lane) || poison != 0u;
        const float qnan = __builtin_nanf("");
#pragma unroll
        for (int ai = 0; ai < 2; ++ai)
#pragma unroll
            for (int m = 0; m < 4; ++m) { const int r = ai * HALF + wr * 64 + m * 16 + fr; const f32x2v sr = S[r]; const size_t off = (size_t)(u.pm * BM + r) * ldc + col0;
#pragma unroll
                for (int bj = 0; bj < 2; ++bj)
#pragma unroll
                    for (int n = 0; n < 2; ++n) { const f32x4 bs = ai == 0 ? pre[m][bj][n] : *(const f32x4*)(base + off + bj * HALF + n * 16); f32x4 o = bs + (acc[ai][bj][m][n] - sr.x) * sr.y;
                        if (bad) o = (f32x4){qnan, qnan, qnan, qnan}; *(f32x4*)(out + off + bj * HALF + n * 16) = o; }
                if (m & 1) asm volatile("" ::: "memory"); }
    }
};
struct EpiLnResLn {
    static constexpr bool PERM = false, AFTER_DRAIN = true;
    const float* base; float* out; bf16_t* xn; int ldc; const float* bias; PanelStats st1, st2; unsigned poison;
    __device__ __forceinline__ void fused(f32x4 (&acc)[2][2][4][2], const Unit& u, int wr, int wc, int fr, int fq, PG8_LAS unsigned char* lds, int wid, int lane) const {
        typedef float f32x2v __attribute__((ext_vector_type(2))); typedef unsigned u32x2v __attribute__((ext_vector_type(2)));
        const PG8_LAS f32x2v* S = (const PG8_LAS f32x2v*)(lds + 8192);
        const int col0 = u.pn * BM + wc * 32 + 4 * fq;
#pragma unroll
        for (int bj = 0; bj < 2; ++bj)
#pragma unroll
            for (int n = 0; n < 2; ++n) { const f32x4 bv = bias ? *(const f32x4*)(bias + col0 + bj * HALF + n * 16) : (f32x4){0.f, 0.f, 0.f, 0.f};
#pragma unroll
                for (int ai = 0; ai < 2; ++ai)
#pragma unroll
                    for (int m = 0; m < 4; ++m) acc[ai][bj][m][n] += bv; }
        bool bad = st1.run(acc, u, wr, wc, fr, fq, lds, wid, lane) || poison != 0u;
        const float qnan = __builtin_nanf("");
#pragma unroll
        for (int ai = 0; ai < 2; ++ai)
#pragma unroll
            for (int m = 0; m < 4; ++m) { const int r = ai * HALF + wr * 64 + m * 16 + fr; const f32x2v sr = S[r]; const size_t off = (size_t)(u.pm * BM + r) * ldc + col0;
#pragma unroll
                for (int bj = 0; bj < 2; ++bj)
#pragma unroll
                    for (int n = 0; n < 2; ++n) { const f32x4 bs = *(const f32x4*)(base + off + bj * HALF + n * 16); acc[ai][bj][m][n] = bs + (acc[ai][bj][m][n] - sr.x) * sr.y; }
                asm volatile("" : "+v"(acc[ai][0][m][0]), "+v"(acc[ai][0][m][1]), "+v"(acc[ai][1][m][0]), "+v"(acc[ai][1][m][1]));
                if (m & 1) asm volatile("" ::: "memory"); }
        const bool bad1 = bad;
        bad = st2.run(acc, u, wr, wc, fr, fq, lds, wid, lane) || bad;
#pragma unroll
        for (int ai = 0; ai < 2; ++ai)
#pragma unroll
            for (int m = 0; m < 4; ++m) { const int r = ai * HALF + wr * 64 + m * 16 + fr; const f32x2v sr = S[r]; const size_t off = (size_t)(u.pm * BM + r) * ldc + col0;
#pragma unroll
                for (int bj = 0; bj < 2; ++bj)
#pragma unroll
                    for (int n = 0; n < 2; ++n) { const f32x4 x1 = acc[ai][bj][m][n]; *(f32x4*)(out + off + bj * HALF + n * 16) = bad1 ? (f32x4){qnan, qnan, qnan, qnan} : x1;
                        const f32x4 o = (x1 - sr.x) * sr.y; u32x2v w; w.x = cvt_pk_bf16(o[0], o[1]); w.y = cvt_pk_bf16(o[2], o[3]);
                        if (bad) { w.x = 0x7fc07fc0u; w.y = 0x7fc07fc0u; } *(u32x2v*)(xn + off + bj * HALF + n * 16) = w; }
                asm volatile("" ::: "memory"); }
    }
};

template <class Epi, class Sched, bool ALIGN_EPI = false, bool SP2 = false>
__device__ __forceinline__ void gemm_phase(PG8_LAS unsigned char* lds, const Gemm g, const Sched& S, const Epi& E) {
    const int tid = threadIdx.x, wid = __builtin_amdgcn_readfirstlane(tid >> 6), lane = tid & 63, wr = wid >> 2, wc = wid & 3, fr = lane & 15, fq = lane >> 4;
    const int K = g.K, nt = K / BK;
    unsigned voffA[2], voffB[2];
#pragma unroll
    for (int i = 0; i < 2; ++i) { int R, C; stage_rc(tid * 16 + i * 8192, R, C); const int Rb = Epi::PERM ? ((R & ~31) + perm32(R & 31)) : R;
        voffA[i] = (unsigned)(R * K + C) * 2u; voffB[i] = (unsigned)(Rb * K + C) * 2u; }
    const size_t kstep = (size_t)(BK * 2);
    const size_t hstep = (size_t)HALF * K * 2;
    const size_t tstep = 2 * hstep;
    const unsigned ldsw = (unsigned)wid * 1024u;
    const int aoff = lds_byte(wr * 64 + fr, fq * 8), boff = lds_byte(wc * 32 + fr, fq * 8);
#define PG8_SA(b, h) (((b) * 2 + (h)) * HTB)
#define PG8_SB(b, h) ((4 + (b) * 2 + (h)) * HTB)
#define PG8_STAGE(bufoff, gbase, voff) do { _Pragma("unroll") for (int _i = 0; _i < 2; ++_i) \
        __builtin_amdgcn_global_load_lds((const unsigned*)((const char*)(gbase) + (voff)[_i]), (PG8_LAS unsigned*)(lds + (bufoff) + ldsw + _i * 8192), 16, 0, 0); } while (0)
#define PG8_LDA(dst, b, h) do { _Pragma("unroll") for (int m = 0; m < 4; ++m) _Pragma("unroll") for (int k = 0; k < 2; ++k) dst[m][k] = *(const PG8_LAS bf16x8*)(lds + PG8_SA(b, h) + aoff + m * 2048 + k * 1024); } while (0)
#define PG8_LDB(dst, b, h) do { _Pragma("unroll") for (int n = 0; n < 2; ++n) _Pragma("unroll") for (int k = 0; k < 2; ++k) dst[n][k] = *(const PG8_LAS bf16x8*)(lds + PG8_SB(b, h) + boff + n * 2048 + k * 1024); } while (0)
#define PG8_MMA(ai, bj, At, Bt) do { __builtin_amdgcn_s_setprio(1); _Pragma("unroll") for (int m = 0; m < 4; ++m) _Pragma("unroll") for (int n = 0; n < 2; ++n) _Pragma("unroll") for (int k = 0; k < 2; ++k) \
        acc[ai][bj][m][n] = __builtin_amdgcn_mfma_f32_16x16x32_bf16(Bt[n][k], At[m][k], acc[ai][bj][m][n], 0, 0, 0); __builtin_amdgcn_s_setprio(0); } while (0)
#define PG8_WAIT_V(n) asm volatile("s_waitcnt vmcnt(" #n ")" ::: "memory")
#define PG8_WAIT_L(n) asm volatile("s_waitcnt lgkmcnt(" #n ")" ::: "memory")
#define PG8_BAR __builtin_amdgcn_s_barrier()
#define PG8_SCHED __builtin_amdgcn_sched_barrier(0)
    Unit cur, nxt; int ui = 0;
    if (!S.next(0, cur)) return;
    f32x4 acc[2][2][4][2];
#pragma unroll
    for (int a = 0; a < 2; ++a)
#pragma unroll
        for (int b = 0; b < 2; ++b)
#pragma unroll
            for (int m = 0; m < 4; ++m)
#pragma unroll
                for (int n = 0; n < 2; ++n) acc[a][b][m][n] = (f32x4){0.f, 0.f, 0.f, 0.f};
    bf16x8 At[4][2], B0[2][2], B1[2][2];
    const char* cA = (const char*)g.A + (size_t)cur.pm * tstep; const char* cB = (const char*)g.Bt + (size_t)cur.pn * tstep;
    S.a_ready(cur);
    if constexpr (SP2) {
        PG8_STAGE(PG8_SB(0, 0), cB, voffB); PG8_STAGE(PG8_SB(0, 1), cB + hstep, voffB); PG8_STAGE(PG8_SA(0, 0), cA, voffA); PG8_STAGE(PG8_SA(0, 1), cA + hstep, voffA);
        if (wr == 1) PG8_BAR;
        PG8_WAIT_V(2); PG8_BAR;
        PG8_STAGE(PG8_SB(1, 0), cB + kstep, voffB); PG8_STAGE(PG8_SA(1, 0), cA + kstep, voffA); PG8_STAGE(PG8_SB(1, 1), cB + hstep + kstep, voffB);
        PG8_WAIT_V(6); PG8_BAR;
    } else {
        PG8_STAGE(PG8_SB(0, 0), cB, voffB); PG8_STAGE(PG8_SA(0, 0), cA, voffA); PG8_STAGE(PG8_SB(0, 1), cB + hstep, voffB); PG8_STAGE(PG8_SA(0, 1), cA + hstep, voffA);
        if (wr == 1) PG8_BAR;
        PG8_WAIT_V(4); PG8_BAR;
        PG8_STAGE(PG8_SB(1, 0), cB + kstep, voffB); PG8_STAGE(PG8_SA(1, 0), cA + kstep, voffA); PG8_STAGE(PG8_SB(1, 1), cB + hstep + kstep, voffB);
        PG8_WAIT_V(6); PG8_BAR;
    }
    for (;;) {
        const bool has_next = S.next(ui + 1, nxt);
        const char* nA = has_next ? (const char*)g.A + (size_t)nxt.pm * tstep : cA; const char* nB = has_next ? (const char*)g.Bt + (size_t)nxt.pn * tstep : cB;
        for (int t = 0; t < nt; t += 2) {
            const bool last = (t == nt - 2);
            const char* a1 = cA + (size_t)(t + 1) * kstep;
            const char* a2 = last ? nA : cA + (size_t)(t + 2) * kstep; const char* b2 = last ? nB : cB + (size_t)(t + 2) * kstep;
            const char* a3 = a2 + kstep; const char* b3 = b2 + kstep;
            if (last && has_next) S.a_ready(nxt);
            if constexpr (SP2) {
            PG8_LDB(B0, 0, 0); PG8_LDB(B1, 0, 1); PG8_SCHED; PG8_LDA(At, 0, 0); PG8_STAGE(PG8_SA(1, 1), a1 + hstep, voffA);
            PG8_WAIT_V(8); PG8_WAIT_L(0); PG8_BAR; PG8_MMA(0, 0, At, B0); PG8_MMA(0, 1, At, B1); PG8_BAR; PG8_SCHED;
            PG8_LDA(At, 0, 1); PG8_STAGE(PG8_SB(0, 0), b2, voffB); PG8_STAGE(PG8_SB(0, 1), b2 + hstep, voffB); PG8_STAGE(PG8_SA(0, 0), a2, voffA);
            PG8_WAIT_V(8); PG8_WAIT_L(0); PG8_BAR; PG8_MMA(1, 0, At, B0); PG8_MMA(1, 1, At, B1); PG8_BAR; PG8_SCHED;
            PG8_LDB(B0, 1, 0); PG8_LDB(B1, 1, 1); PG8_SCHED; PG8_LDA(At, 1, 0); PG8_STAGE(PG8_SA(0, 1), a2 + hstep, voffA);
            PG8_WAIT_V(8); PG8_WAIT_L(0); PG8_BAR; PG8_MMA(0, 0, At, B0); PG8_MMA(0, 1, At, B1); PG8_BAR; PG8_SCHED;
            PG8_LDA(At, 1, 1); PG8_STAGE(PG8_SB(1, 0), b3, voffB); PG8_STAGE(PG8_SB(1, 1), b3 + hstep, voffB); PG8_STAGE(PG8_SA(1, 0), a3, voffA);
            PG8_WAIT_V(8); PG8_WAIT_L(0); PG8_BAR; PG8_MMA(1, 0, At, B0); PG8_MMA(1, 1, At, B1); PG8_BAR; PG8_SCHED;
            } else {
            PG8_LDB(B0, 0, 0); PG8_SCHED; PG8_LDA(At, 0, 0); PG8_STAGE(PG8_SA(1, 1), a1 + hstep, voffA);
            PG8_WAIT_L(8); PG8_BAR; PG8_WAIT_L(0); PG8_MMA(0, 0, At, B0); PG8_BAR; PG8_SCHED;
            PG8_LDB(B1, 0, 1); PG8_STAGE(PG8_SB(0, 0), b2, voffB);
            PG8_BAR; PG8_WAIT_L(0); PG8_MMA(0, 1, At, B1); PG8_BAR;
            PG8_LDA(At, 0, 1); PG8_STAGE(PG8_SA(0, 0), a2, voffA);
            PG8_BAR; PG8_WAIT_L(0); PG8_MMA(1, 0, At, B0); PG8_BAR; PG8_SCHED;
            PG8_STAGE(PG8_SB(0, 1), b2 + hstep, voffB);
            PG8_WAIT_V(6); PG8_BAR; PG8_MMA(1, 1, At, B1); PG8_BAR;
            PG8_LDB(B0, 1, 0); PG8_SCHED; PG8_LDA(At, 1, 0); PG8_STAGE(PG8_SA(0, 1), a2 + hstep, voffA);
            PG8_WAIT_L(8); PG8_BAR; PG8_WAIT_L(0); PG8_MMA(0, 0, At, B0); PG8_BAR; PG8_SCHED;
            PG8_LDB(B1, 1, 1); PG8_STAGE(PG8_SB(1, 0), b3, voffB);
            PG8_BAR; PG8_WAIT_L(0); PG8_MMA(0, 1, At, B1); PG8_BAR;
            PG8_LDA(At, 1, 1); PG8_STAGE(PG8_SA(1, 0), a3, voffA);
            PG8_BAR; PG8_WAIT_L(0); PG8_MMA(1, 0, At, B0); PG8_BAR; PG8_SCHED;
            PG8_STAGE(PG8_SB(1, 1), b3 + hstep, voffB);
            PG8_WAIT_V(6); PG8_BAR; PG8_MMA(1, 1, At, B1); PG8_BAR;
            }
        }
        if constexpr (ALIGN_EPI) { if (wr == 0) PG8_BAR; }
        if constexpr (!Epi::AFTER_DRAIN) { E(acc, cur, wr, wc, fr, fq); S.done(cur); }
        if (!has_next) break;
#pragma unroll
        for (int a = 0; a < 2; ++a)
#pragma unroll
            for (int b = 0; b < 2; ++b)
#pragma unroll
                for (int m = 0; m < 4; ++m)
#pragma unroll
                    for (int n = 0; n < 2; ++n) acc[a][b][m][n] = (f32x4){0.f, 0.f, 0.f, 0.f};
        cur = nxt; cA = nA; cB = nB; ++ui;
        if constexpr (ALIGN_EPI) { if (wr == 1) PG8_BAR; }
    }
    PG8_WAIT_V(0);
    if constexpr (!ALIGN_EPI) { if (wr == 0) PG8_BAR; }
    PG8_BAR;
    if constexpr (Epi::AFTER_DRAIN) { E.fused(acc, cur, wr, wc, fr, fq, lds, wid, lane); S.done(cur); }
#undef PG8_SA
#undef PG8_SB
#undef PG8_STAGE
#undef PG8_LDA
#undef PG8_LDB
#undef PG8_MMA
#undef PG8_WAIT_V
#undef PG8_WAIT_L
#undef PG8_BAR
#undef PG8_SCHED
}
}
namespace pg8 {
__device__ __forceinline__ float bf2f(unsigned short b) { return __uint_as_float(((unsigned)b) << 16); }
__device__ __forceinline__ float bflo(unsigned w) { return __uint_as_float(w << 16); }
__device__ __forceinline__ float bfhi(unsigned w) { return __uint_as_float(w & 0xffff0000u); }
__device__ __forceinline__ float sigm(float x) { return 1.f / (1.f + __expf(-x)); }
template <int MODE> struct EpiGate {
    static constexpr bool PERM = true, AFTER_DRAIN = false;
    bf16_t* O; int ldc; const bf16_t* G; int ldg; size_t gtile;
    __device__ __forceinline__ void operator()(const f32x4 (&acc)[2][2][4][2], const Unit& u, int wr, int wc, int fr, int fq) const {
        const int row0 = u.pm * BM + wr * 64 + fr, col0 = u.pn * BM + wc * 32 + 8 * fq;
#pragma unroll
        for (int ai = 0; ai < 2; ++ai)
#pragma unroll
            for (int m = 0; m < 4; ++m) { const size_t row = (size_t)(row0 + ai * HALF + m * 16);
#pragma unroll
                for (int bj = 0; bj < 2; ++bj) {
                    const u32x4 gw = __builtin_nontemporal_load((const u32x4*)(G + (size_t)u.pn * gtile + row * ldg + col0 + bj * HALF));
                    f32x4 v0 = acc[ai][bj][m][0], v1 = acc[ai][bj][m][1];
                    v0[0] *= sigm(bflo(gw.x)); v0[1] *= sigm(bfhi(gw.x)); v0[2] *= sigm(bflo(gw.y)); v0[3] *= sigm(bfhi(gw.y));
                    v1[0] *= sigm(bflo(gw.z)); v1[1] *= sigm(bfhi(gw.z)); v1[2] *= sigm(bflo(gw.w)); v1[3] *= sigm(bfhi(gw.w));
                    bf16_t* op = O + row * ldc + col0 + bj * HALF;
                    if (MODE == 1) { const u32x4 ow = *(const u32x4*)op;
                        v0[0] += bflo(ow.x); v0[1] += bfhi(ow.x); v0[2] += bflo(ow.y); v0[3] += bfhi(ow.y);
                        v1[0] += bflo(ow.z); v1[1] += bfhi(ow.z); v1[2] += bflo(ow.w); v1[3] += bfhi(ow.w); }
                    u32x4 w; w.x = cvt_pk_bf16(v0[0], v0[1]); w.y = cvt_pk_bf16(v0[2], v0[3]); w.z = cvt_pk_bf16(v1[0], v1[1]); w.w = cvt_pk_bf16(v1[2], v1[3]);
                    *(u32x4*)op = w; } }
    }
};
struct BranchOrder {
    StaticOrder base; int dm, dn;
    __host__ __device__ void init(int M, int N, int G_, int c_) { base.init(M, N, G_, c_); dm = M / BM; dn = N / BM; }
    __host__ __device__ bool next(int i, Unit& u) const { if (!base.next(i >> 1, u)) return false; if (i & 1) { u.pm += dm; u.pn += dn; } return true; }
    __device__ __forceinline__ void a_ready(const Unit&) const {}
    __device__ __forceinline__ void done(const Unit&) const {}
};
struct EpiGate2 {
    static constexpr bool PERM = true, AFTER_DRAIN = false;
    bf16_t* O; int ldc; const bf16_t* G0; const bf16_t* G1; int ldg; size_t gtile; int dm, dn;
    __device__ __forceinline__ void operator()(const f32x4 (&acc)[2][2][4][2], const Unit& u, int wr, int wc, int fr, int fq) const {
        const bool second = u.pm >= dm;
        Unit v = u; if (second) { v.pm -= dm; v.pn -= dn; }
        if (second) { EpiGate<1> e{O, ldc, G1, ldg, gtile}; e(acc, v, wr, wc, fr, fq); } else { EpiGate<0> e{O, ldc, G0, ldg, gtile}; e(acc, v, wr, wc, fr, fq); }
    }
};
struct EpiResid {
    static constexpr bool PERM = true, AFTER_DRAIN = false;
    const float* R; bf16_t* Hb; float* ss; int ldc;
    __device__ __forceinline__ void operator()(const f32x4 (&acc)[2][2][4][2], const Unit& u, int wr, int wc, int fr, int fq) const {
        const int row0 = u.pm * BM + wr * 64 + fr, col0 = u.pn * BM + wc * 32 + 8 * fq;
#pragma unroll
        for (int ai = 0; ai < 2; ++ai)
#pragma unroll
            for (int m = 0; m < 4; ++m) { const size_t row = (size_t)(row0 + ai * HALF + m * 16); float sq = 0.f;
#pragma unroll
                for (int bj = 0; bj < 2; ++bj) {
                    const size_t off = row * ldc + col0 + bj * HALF;
                    const f32x4 r0 = __builtin_nontemporal_load((const f32x4*)(R + off)), r1 = __builtin_nontemporal_load((const f32x4*)(R + off + 4));
                    const f32x4 v0 = acc[ai][bj][m][0] + r0, v1 = acc[ai][bj][m][1] + r1;
                    u32x4 w; w.x = cvt_pk_bf16(v0[0], v0[1]); w.y = cvt_pk_bf16(v0[2], v0[3]); w.z = cvt_pk_bf16(v1[0], v1[1]); w.w = cvt_pk_bf16(v1[2], v1[3]);
                    *(u32x4*)(Hb + off) = w;
                    sq += (v0[0] * v0[0] + v0[1] * v0[1]) + (v0[2] * v0[2] + v0[3] * v0[3]) + (v1[0] * v1[0] + v1[1] * v1[1]) + (v1[2] * v1[2] + v1[3] * v1[3]); }
                sq += __shfl_xor(sq, 16); sq += __shfl_xor(sq, 32);
                if (fq == 0) atomicAdd(ss + row, sq); }
    }
};
struct EpiRowScale {
    static constexpr bool PERM = true, AFTER_DRAIN = false;
    bf16_t* O; int ldc; const float* ss; float inv_n, eps;
    __device__ __forceinline__ void operator()(const f32x4 (&acc)[2][2][4][2], const Unit& u, int wr, int wc, int fr, int fq) const {
        const int row0 = u.pm * BM + wr * 64 + fr, col0 = u.pn * BM + wc * 32 + 8 * fq;
#pragma unroll
        for (int ai = 0; ai < 2; ++ai)
#pragma unroll
            for (int m = 0; m < 4; ++m) { const size_t row = (size_t)(row0 + ai * HALF + m * 16);
                const float sc = rsqrtf(__hip_atomic_load(ss + row, __ATOMIC_RELAXED, __HIP_MEMORY_SCOPE_AGENT) * inv_n + eps);
#pragma unroll
                for (int bj = 0; bj < 2; ++bj) { const f32x4 v0 = acc[ai][bj][m][0] * sc, v1 = acc[ai][bj][m][1] * sc;
                    u32x4 w; w.x = cvt_pk_bf16(v0[0], v0[1]); w.y = cvt_pk_bf16(v0[2], v0[3]); w.z = cvt_pk_bf16(v1[0], v1[1]); w.w = cvt_pk_bf16(v1[2], v1[3]);
                    *(u32x4*)(O + row * ldc + col0 + bj * HALF) = w; } }
    }
};
}
constexpr int D_MODEL = 2048, BATCH = 2, SEQ = 4096, NTOK = BATCH * SEQ;
constexpr int HD = 64, NCMP = 255, CMP_STRIDE = 16, CMP_LEN = 32, CMP_HID = 128;
constexpr int SEL_LEN = 64, SEL_TOPK = 16, WINDOW = 512;
constexpr int PEER_KEYS = 128, PEER_E = 128;
constexpr int NSA_Q = 1024, SB_W = 1024;
constexpr int IN_COLS = 9776, PLD = 9984;
constexpr int C_SHIFT_FROM = 2608, C_SHIFT = 208, PP = 256;
constexpr int P_QN = 0, P_KC = 4, P_VC = 5, P_KS = 6, P_VS = 7, P_KW = 8, P_VW = 9, P_GBR = 10, P_QB = 11, P_KB = 15, P_VB = 19, P_GA = 23, P_GB = 31;
#define PNL(P, p) ((P) + (size_t)(p) * NTOK * PP)
constexpr float EPS = 1e-6f, NEGF = -1e30f;
constexpr int NWAVES = 8, NTHR = 512;

constexpr size_t MiB = 1u << 20;
constexpr size_t WS_CTL = 0, CTL_ZERO_BYTES = 1 * MiB;
constexpr size_t WS_WIN = 2 * MiB;
constexpr size_t WS_WBN = 42 * MiB, WS_WBS = 46 * MiB;
constexpr size_t WS_WOUT = 50 * MiB, WS_WPQ = 58 * MiB;
constexpr size_t WS_MISC = 66 * MiB;
constexpr size_t WS_XN = 70 * MiB;
constexpr size_t WS_PROJ = 102 * MiB;
constexpr size_t WS_ONSA = 258 * MiB, WS_OSB = 274 * MiB;
constexpr size_t WS_H = 290 * MiB;
constexpr size_t WS_HB = 354 * MiB;
constexpr size_t WS_END = 386 * MiB;
constexpr size_t WS_UB = 102 * MiB, WS_VB = 166 * MiB, WS_QP = 230 * MiB, WS_EXP = 262 * MiB, WS_GATE = 266 * MiB;
constexpr size_t MISC_KCB = 0, MISC_VCB = 1 * MiB, MISC_SKB = 2 * MiB, MISC_W1T = 2 * MiB + 512 * 1024, MISC_B1 = 3 * MiB + 512 * 1024;
constexpr int CW_BAR = 4096;
constexpr int CW_SS = 32768;

#define GAS __attribute__((address_space(1)))
#define LAS __attribute__((address_space(3)))
typedef unsigned short bf16;
typedef unsigned v4u __attribute__((ext_vector_type(4)));
typedef unsigned v2u __attribute__((ext_vector_type(2)));
typedef float f32x4 __attribute__((ext_vector_type(4)));
#define RLX_AGENT __ATOMIC_RELAXED, __HIP_MEMORY_SCOPE_AGENT
__device__ __forceinline__ unsigned f2bf(float f) { unsigned u = __builtin_bit_cast(unsigned, f); return (u + 0x7fffu + ((u >> 16) & 1u)) >> 16; }
__device__ __forceinline__ unsigned pk2(float lo, float hi) { return f2bf(lo) | (f2bf(hi) << 16); }
__device__ __forceinline__ float bf2f(bf16 b) { return __uint_as_float(((unsigned)b) << 16); }
__device__ __forceinline__ float bflo(unsigned w) { return __uint_as_float(w << 16); }
__device__ __forceinline__ float bfhi(unsigned w) { return __uint_as_float(w & 0xffff0000u); }

#define XB_TMO      128
#define XB_XCNT(j)  (256  + 64 * (j))
#define XB_XSUB(j)  (1280 + 64 * (j))
#define XB_XGEN(j)  (2304 + 64 * (j))
#define XB_TOP      3328
#define XB_TOPGEN   3392
#define XCD_BAR_WORDS 3456
#define XB_SPIN_CAP (1u << 24)
__device__ __forceinline__ unsigned xb_ld(unsigned* p)              { return __hip_atomic_load(p, __ATOMIC_RELAXED, __HIP_MEMORY_SCOPE_AGENT); }
__device__ __forceinline__ unsigned xb_add(unsigned* p, unsigned v) { return __hip_atomic_fetch_add(p, v, __ATOMIC_RELAXED, __HIP_MEMORY_SCOPE_AGENT); }
__device__ __forceinline__ unsigned xb_xcc_id() { return (unsigned)__builtin_amdgcn_s_getreg((3 << 11) | 20) & 0xFu; }
#define XB_SPIN(cond, bar) do { unsigned _sp = 0; while (cond) { __builtin_amdgcn_s_sleep(1); \
    if ((++_sp & 255u) == 0u) { if (xb_ld(&(bar)[XB_TMO])) break; if (_sp > XB_SPIN_CAP) { atomicAdd(&(bar)[XB_TMO], 1u); break; } } } } while (0)
struct XcdBarrier { unsigned* bar; unsigned x; volatile LAS unsigned* st; };
__device__ __forceinline__ XcdBarrier xcd_barrier_post(unsigned* bar, volatile LAS unsigned* st) {
    XcdBarrier b; b.bar = bar; b.x = xb_xcc_id(); b.st = st;
    if (threadIdx.x == 0) (void)xb_add(&bar[XB_XCNT(b.x)], 1u);
    return b;
}
__device__ __forceinline__ void xcd_barrier_complete(unsigned* bar, unsigned x, unsigned& nloc, unsigned& nx) {
    const unsigned G = gridDim.x * gridDim.y * gridDim.z;
    unsigned sum, cnt, mine, sp = 0u;
    for (;;) {
        sum = 0u; cnt = 0u; mine = 0u;
#pragma unroll
        for (unsigned j = 0; j < 16; ++j) { const unsigned c = xb_ld(&bar[XB_XCNT(j)]); sum += c; cnt += (c > 0u) ? 1u : 0u; mine = (j == x) ? c : mine; }
        if (sum == G) break;
        __builtin_amdgcn_s_sleep(1);
        if ((++sp & 255u) == 0u) { if (xb_ld(&bar[XB_TMO])) break; if (sp > XB_SPIN_CAP) { atomicAdd(&bar[XB_TMO], 1u); break; } }
    }
    nloc = mine > 0u ? mine : 1u; nx = cnt > 0u ? cnt : 1u;
}
__device__ __forceinline__ void xcd_barrier(const XcdBarrier& b) {
    asm volatile("s_waitcnt vmcnt(0)" ::: "memory");
    __syncthreads();
    if (threadIdx.x == 0) {
        unsigned* bar = b.bar;
        const unsigned bx = xb_xcc_id();
        __builtin_amdgcn_s_waitcnt(0);
        unsigned nloc = b.st[0], nx = b.st[1];
        if (nloc == 0u) { xcd_barrier_complete(bar, bx, nloc, nx); b.st[0] = nloc; b.st[1] = nx; }
        const unsigned old = xb_add(&bar[XB_XSUB(bx)], 1u);
        const unsigned gen = old / nloc;
        if (old + 1u == (gen + 1u) * nloc) {
            __builtin_amdgcn_fence(__ATOMIC_RELEASE, "agent");
            asm volatile("s_waitcnt vmcnt(0)" ::: "memory");
            const unsigned og = xb_add(&bar[XB_TOP], 1u);
            const unsigned tg = og / nx;
            if (og + 1u == (tg + 1u) * nx) xb_add(&bar[XB_TOPGEN], 1u);
            else XB_SPIN(xb_ld(&bar[XB_TOPGEN]) == tg, bar);
            __builtin_amdgcn_fence(__ATOMIC_ACQUIRE, "agent");
            xb_add(&bar[XB_XGEN(bx)], 1u);
            asm volatile("s_waitcnt vmcnt(0)" ::: "memory");
        } else {
            XB_SPIN(xb_ld(&bar[XB_XGEN(bx)]) == gen, bar);
            __builtin_amdgcn_fence(__ATOMIC_ACQUIRE, "agent");
            asm volatile("s_waitcnt vmcnt(0)" ::: "memory");
        }
    }
    __syncthreads();
}

__device__ __forceinline__ int rel_bucket(int d) {
    if (d < 16) return d < 0 ? 0 : d;
    int b = 16;
    b += (d >= 21); b += (d >= 27); b += (d >= 35); b += (d >= 46); b += (d >= 59); b += (d >= 77); b += (d >= 99); b += (d >= 128);
    b += (d >= 166); b += (d >= 216); b += (d >= 280); b += (d >= 363); b += (d >= 470); b += (d >= 609); b += (d >= 790);
    return b;
}
__device__ __forceinline__ float gelu_tanh(float x) { const float k = 0.7978845608028654f; return 0.5f * x * (1.f + tanhf(k * (x + 0.044715f * x * x * x))); }
__device__ __forceinline__ float sigmoidf_(float x) { return 1.f / (1.f + expf(-x)); }
#define DPP_ROR(v, n) __builtin_bit_cast(float, __builtin_amdgcn_update_dpp(0, __builtin_bit_cast(int, (v)), 0x120 + (n), 0xf, 0xf, false))
__device__ __forceinline__ float row_sum16(float v) { v += DPP_ROR(v, 8); v += DPP_ROR(v, 4); v += DPP_ROR(v, 2); v += DPP_ROR(v, 1); return v; }
__device__ __forceinline__ float row_max16(float v) { v = fmaxf(v, DPP_ROR(v, 8)); v = fmaxf(v, DPP_ROR(v, 4)); v = fmaxf(v, DPP_ROR(v, 2)); v = fmaxf(v, DPP_ROR(v, 1)); return v; }
__device__ __forceinline__ float wave_sum(float v) {
    v = row_sum16(v);
    { const auto r = __builtin_amdgcn_permlane16_swap(__float_as_uint(v), __float_as_uint(v), false, false); v = __uint_as_float(r[0]) + __uint_as_float(r[1]); }
    { const auto r = __builtin_amdgcn_permlane32_swap(__float_as_uint(v), __float_as_uint(v), false, false); v = __uint_as_float(r[0]) + __uint_as_float(r[1]); }
    return v;
}
__device__ __forceinline__ float wave_max(float v) {
    v = row_max16(v);
    { const auto r = __builtin_amdgcn_permlane16_swap(__float_as_uint(v), __float_as_uint(v), false, false); v = fmaxf(__uint_as_float(r[0]), __uint_as_float(r[1])); }
    { const auto r = __builtin_amdgcn_permlane32_swap(__float_as_uint(v), __float_as_uint(v), false, false); v = fmaxf(__uint_as_float(r[0]), __uint_as_float(r[1])); }
    return v;
}
__device__ __forceinline__ float gelu_tanh_fast(float x) { const float y2 = x * (1.5957691216057308f + 0.0713548162726f * x * x);
    return x * __builtin_amdgcn_rcpf(1.f + __builtin_amdgcn_exp2f(-1.4426950408889634f * y2)); }
__device__ __forceinline__ float half_sum(float v, float* red) {
    v = wave_sum(v);
    __syncthreads();
    if ((threadIdx.x & 63) == 0) red[(threadIdx.x >> 6) & 3] = v;
    __syncthreads();
    return red[0] + red[1] + red[2] + red[3];
}
__device__ __forceinline__ float half_max(float v, float* red) {
    v = wave_max(v);
    __syncthreads();
    if ((threadIdx.x & 63) == 0) red[(threadIdx.x >> 6) & 3] = v;
    __syncthreads();
    return fmaxf(fmaxf(red[0], red[1]), fmaxf(red[2], red[3]));
}

struct Args {
    const float* in[19]; float* out; unsigned char* ws; int ph_lo, ph_hi; int variant, pad;
};

struct P0Item { const float* W; bf16* WT; const float* gk; int K, N, item, shift_from, shift; };
__device__ __forceinline__ void p0_item_load(const P0Item& d, int lane, f32x4 (&v)[8]) {
    const int nblk = (d.N + 31) / 32, kb = d.item / nblk, nb = d.item % nblk, k0 = 64 * kb, n0 = 32 * nb;
    const int c4 = (lane & 7) * 4, r8 = lane >> 3;
    const bool cok = (n0 + c4) < d.N;
#pragma unroll
    for (int i = 0; i < 8; ++i) { const int kk = 8 * i + r8; v[i] = cok ? __builtin_nontemporal_load((const f32x4*)(d.W + (size_t)(k0 + kk) * d.N + n0 + c4)) : (f32x4){0.f, 0.f, 0.f, 0.f}; }
}
__device__ __forceinline__ void p0_item_store(const P0Item& d, int lane, const f32x4 (&v)[8], LAS float* scr) {
    const int nblk = (d.N + 31) / 32, kb = d.item / nblk, nb = d.item % nblk, k0 = 64 * kb, n0 = 32 * nb;
    const int c4 = (lane & 7) * 4, r8 = lane >> 3;
#pragma unroll
    for (int i = 0; i < 8; ++i) { const int kk = 8 * i + r8; const float g = d.gk ? d.gk[k0 + kk] : 1.f;
        scr[kk * 33 + c4 + 0] = v[i].x * g; scr[kk * 33 + c4 + 1] = v[i].y * g; scr[kk * 33 + c4 + 2] = v[i].z * g; scr[kk * 33 + c4 + 3] = v[i].w * g; }
    asm volatile("s_waitcnt lgkmcnt(0)" ::: "memory");
    const int c = lane & 7;
#pragma unroll
    for (int j = 0; j < 4; ++j) { const int n = (lane >> 3) + 8 * j; const LAS float* s = scr + (8 * c) * 33 + n;
        v4u o; o.x = pk2(s[0 * 33], s[1 * 33]); o.y = pk2(s[2 * 33], s[3 * 33]); o.z = pk2(s[4 * 33], s[5 * 33]); o.w = pk2(s[6 * 33], s[7 * 33]);
        const int nd = n0 + n + ((n0 + n >= d.shift_from) ? d.shift : 0);
        if (n0 + n < d.N) *(v4u*)(d.WT + (size_t)nd * d.K + k0 + 8 * c) = o; }
    asm volatile("s_waitcnt lgkmcnt(0)" ::: "memory");
}
__device__ __forceinline__ void rms_row_to_bf16(const float* xrow, const float* g, bf16* orow, int lane) {
    const f32x4* xr = (const f32x4*)xrow + lane; const f32x4* gr = (const f32x4*)g + lane;
    f32x4 v[8]; float s = 0.f;
#pragma unroll
    for (int j = 0; j < 8; ++j) { v[j] = __builtin_nontemporal_load(xr + 64 * j); s += (v[j].x * v[j].x + v[j].y * v[j].y) + (v[j].z * v[j].z + v[j].w * v[j].w); }
    const float r = rsqrtf(wave_sum(s) * (1.f / D_MODEL) + EPS);
    v2u* o8 = (v2u*)orow + lane;
#pragma unroll
    for (int j = 0; j < 8; ++j) { const f32x4 gv = gr[64 * j]; v2u w; w.x = pk2(v[j].x * r * gv.x, v[j].y * r * gv.y); w.y = pk2(v[j].z * r * gv.z, v[j].w * r * gv.w); o8[64 * j] = w; }
}
__device__ __forceinline__ void cvt_flat(const float* src, bf16* dst, size_t n, size_t gthread, size_t nthreads) {
    for (size_t i = gthread * 8; i < n; i += nthreads * 8) {
        const f32x4 a = *(const f32x4*)(src + i), b = *(const f32x4*)(src + i + 4);
        v4u o; o.x = pk2(a.x, a.y); o.y = pk2(a.z, a.w); o.z = pk2(b.x, b.y); o.w = pk2(b.z, b.w);
        *(v4u*)(dst + i) = o;
    }
}
namespace cmpr {
typedef short bf16x8 __attribute__((ext_vector_type(8)));
typedef float f32x4v __attribute__((ext_vector_type(4)));
__device__ __forceinline__ void compress_phase(const bf16* PROJ, const bf16* W1T, const float* BIAS1, const float* const* in, bf16* KCB, bf16* VCB,
                                               __attribute__((address_space(3))) unsigned char* lds3, int bid, int G) {
    int tid = threadIdx.x; asm volatile("" : "+v"(tid));
    const int lane = tid & 63, wid = __builtin_amdgcn_readfirstlane(tid >> 6), r16 = lane & 15, kq = lane >> 4;
    __attribute__((address_space(3))) float* PART = (__attribute__((address_space(3))) float*)lds3;
    __attribute__((address_space(3))) float* HID = (__attribute__((address_space(3))) float*)(lds3 + 65536);
    __attribute__((address_space(3))) float* W2S = (__attribute__((address_space(3))) float*)(lds3 + 73728);
    for (int unit = bid; unit < 256; unit += G) {
        const int c = unit & 15, g = (unit >> 4) & 3, b = (unit >> 6) & 1, kv = unit >> 7, n0 = 16 * c;
        int nn = n0 + r16; if (nn > NCMP - 1) nn = NCMP - 1;
        const bf16* ap = PNL(PROJ, kv ? P_VC : P_KC) + (size_t)(b * SEQ + 16 * nn + 4 * wid) * PP + g * HD + 8 * kq;
        const bf16* bp = W1T + (size_t)kv * CMP_HID * 2048 + (size_t)r16 * 2048 + 256 * wid + 8 * kq;
        { const float* w2g = in[kv ? 8 : 5];
#pragma unroll
          for (int i = 0; i < 4; ++i) *(__attribute__((address_space(3))) f32x4v*)(W2S + (tid + NTHR * i) * 4) = *(const f32x4v*)(w2g + (tid + NTHR * i) * 4); }
        f32x4v acc[8] = {};
        bf16x8 af[8];
#pragma unroll
        for (int ks = 0; ks < 8; ++ks) af[ks] = *(const bf16x8*)(ap + (size_t)(ks >> 1) * PP + (ks & 1) * 32);
        bf16x8 wa[8], wb[8];
#define CMP_LOADW(W, KS) do { _Pragma("unroll") for (int nt = 0; nt < 8; ++nt) W[nt] = *(const bf16x8*)(bp + (size_t)nt * 16 * 2048 + (KS) * 32); } while (0)
#define CMP_MMA(W, KS) do { _Pragma("unroll") for (int nt = 0; nt < 8; ++nt) acc[nt] = __builtin_amdgcn_mfma_f32_16x16x32_bf16(af[KS], W[nt], acc[nt], 0, 0, 0); } while (0)
        CMP_LOADW(wa, 0);
#pragma unroll
        for (int ks = 0; ks < 8; ks += 2) {
            CMP_LOADW(wb, ks + 1); __builtin_amdgcn_sched_barrier(0);
            CMP_MMA(wa, ks); __builtin_amdgcn_sched_barrier(0);
            if (ks + 2 < 8) CMP_LOADW(wa, ks + 2);
            __builtin_amdgcn_sched_barrier(0);
            CMP_MMA(wb, ks + 1); __builtin_amdgcn_sched_barrier(0);
        }
#undef CMP_LOADW
#undef CMP_MMA
#pragma unroll
        for (int nt = 0; nt < 8; ++nt)
#pragma unroll
            for (int r = 0; r < 4; ++r) PART[wid * 2048 + (kq * 4 + r) * 128 + nt * 16 + r16] = acc[nt][r];
        asm volatile("s_waitcnt lgkmcnt(0)" ::: "memory"); __syncthreads();
#pragma unroll
        for (int i = 0; i < 4; ++i) { const int e = tid + NTHR * i; float s = BIAS1[kv * CMP_HID + (e & 127)];
#pragma unroll
            for (int w = 0; w < 8; ++w) s += PART[w * 2048 + e];
            HID[e] = gelu_tanh(s); }
        asm volatile("s_waitcnt lgkmcnt(0)" ::: "memory"); __syncthreads();
        {
            const int nl = tid >> 5, d = (tid & 31) * 2;
            float o0 = 0.f, o1 = 0.f;
#pragma unroll 8
            for (int j = 0; j < CMP_HID; ++j) { const float hv = HID[nl * 128 + j]; const float wx = W2S[j * HD + d], wy = W2S[j * HD + d + 1]; o0 += hv * wx; o1 += hv * wy; }
            const int n = n0 + nl;
            const unsigned pk = (n < NCMP) ? pk2(o0, o1) : 0u;
            *(unsigned*)((kv ? VCB : KCB) + (size_t)((b * 4 + g) * 256 + n) * HD + d) = pk;
        }
        __syncthreads();
    }
}
}
#ifndef NSA_FAR
#define NSA_FAR 1
#endif
namespace nsa {
typedef short bf16x8 __attribute__((ext_vector_type(8)));
typedef short s16x4 __attribute__((ext_vector_type(4)));
typedef float f32x16 __attribute__((ext_vector_type(16)));
typedef unsigned u32x4 __attribute__((ext_vector_type(4)));
typedef __attribute__((address_space(3))) const char* lds_cptr;
typedef __attribute__((address_space(3))) unsigned char* lds_ptr;
constexpr int SLOTB = 16384;
constexpr int NSLOT = 4;
constexpr int L_RING = 0, L_OV = 65536, L_BT = 98304, L_WSF = 111104, L_MASK = 113152, L_MISC = 113664, L_X = 113792, L_END = L_X + 32768;
constexpr int BT_N = 800;
constexpr int BT_LO = 96, BT_HI = 96, BT_P = BT_LO + BT_N + BT_HI, BT_NEG = 96, L_BTP = L_END;
static_assert(L_BTP + (4 * BT_P + BT_NEG) * 4 <= 162816, "LDS overflow");
constexpr float LOG2E = 1.4426950408889634f, SC2 = 0.125f * LOG2E, NEG2 = -1e30f;
static_assert(L_END <= 162816, "nsa LDS map");
__device__ __forceinline__ int crow(int r, int hi) { return (r & 3) + 8 * (r >> 2) + 4 * hi; }
__device__ __forceinline__ void glds16(const void* gsrc, unsigned lds_dst) { unsigned keep;
    asm volatile("s_mov_b32 %0, m0\n\ts_mov_b32 m0, %2\n\ts_nop 0\n\tglobal_load_lds_dwordx4 %1, off\n\ts_mov_b32 m0, %0" : "=&s"(keep) : "v"(gsrc), "s"(lds_dst) : "memory"); }
typedef float f32x2_t __attribute__((ext_vector_type(2))); typedef __bf16 bf16x2_t __attribute__((ext_vector_type(2)));
__device__ __forceinline__ unsigned cvtpk_s(float lo, float hi) { f32x2_t v = {lo, hi}; bf16x2_t b = __builtin_convertvector(v, bf16x2_t); return __builtin_bit_cast(unsigned, b); }
#define NSA_WAIT_BAR(N) asm volatile("s_waitcnt vmcnt(" #N ") lgkmcnt(0)\n\ts_barrier" ::: "memory")
#define NSA_SBAR() __builtin_amdgcn_sched_barrier(0)

__device__ __forceinline__ void qkt(f32x16& p0, f32x16& p1, lds_cptr Kslot, const bf16x8* qr, int r32, int hi) {
    lds_cptr kb = Kslot + hi * 1024 + r32 * 16;
    const f32x16 z = {};
#pragma unroll
    for (int d0 = 0; d0 < 4; ++d0) {
        const bf16x8 b0 = *(const __attribute__((address_space(3))) bf16x8*)(kb + d0 * 2048);
        const bf16x8 b1 = *(const __attribute__((address_space(3))) bf16x8*)(kb + d0 * 2048 + 512);
        if (d0 == 0) { p0 = __builtin_amdgcn_mfma_f32_32x32x16_bf16(b0, qr[0], z, 0, 0, 0); p1 = __builtin_amdgcn_mfma_f32_32x32x16_bf16(b1, qr[0], z, 0, 0, 0); }
        else { p0 = __builtin_amdgcn_mfma_f32_32x32x16_bf16(b0, qr[d0], p0, 0, 0, 0); p1 = __builtin_amdgcn_mfma_f32_32x32x16_bf16(b1, qr[d0], p1, 0, 0, 0); }
    }
}
__device__ __forceinline__ void pv(f32x16* o, int vb, bf16x8 pa0, bf16x8 pa1, bf16x8 pa2, bf16x8 pa3) {
#pragma unroll
    for (int d0 = 0; d0 < 2; ++d0) { s16x4 lo[4], hi[4];
#pragma unroll
        for (int ks = 0; ks < 4; ++ks) {
            asm volatile("ds_read_b64_tr_b16 %0,%1 offset:%c2" : "=&v"(lo[ks]) : "v"(vb), "i"(d0 * 4096 + ks * 1024) : "memory");
            asm volatile("ds_read_b64_tr_b16 %0,%1 offset:%c2" : "=&v"(hi[ks]) : "v"(vb), "i"(d0 * 4096 + ks * 1024 + 512) : "memory"); }
        asm volatile("s_waitcnt lgkmcnt(0)" ::: "memory"); NSA_SBAR();
#define NSA_PK(k) (bf16x8){lo[k][0], lo[k][1], lo[k][2], lo[k][3], hi[k][0], hi[k][1], hi[k][2], hi[k][3]}
        o[d0] = __builtin_amdgcn_mfma_f32_32x32x16_bf16(pa0, NSA_PK(0), o[d0], 0, 0, 0);
        o[d0] = __builtin_amdgcn_mfma_f32_32x32x16_bf16(pa1, NSA_PK(1), o[d0], 0, 0, 0);
        o[d0] = __builtin_amdgcn_mfma_f32_32x32x16_bf16(pa2, NSA_PK(2), o[d0], 0, 0, 0);
        o[d0] = __builtin_amdgcn_mfma_f32_32x32x16_bf16(pa3, NSA_PK(3), o[d0], 0, 0, 0);
#undef NSA_PK
    }
}
__device__ __forceinline__ float rowmax32(const f32x16& p0, const f32x16& p1) {
    float a = fmaxf(p0[0], p1[0]), b = fmaxf(p0[1], p1[1]);
#pragma unroll
    for (int r = 2; r < 16; r += 2) { a = fmaxf(fmaxf(a, p0[r]), p1[r]); b = fmaxf(fmaxf(b, p0[r + 1]), p1[r + 1]); }
    a = fmaxf(a, b);
    auto rr = __builtin_amdgcn_permlane32_swap(__float_as_uint(a), __float_as_uint(a), false, false);
    return fmaxf(__uint_as_float(rr[0]), __uint_as_float(rr[1]));
}
__device__ __forceinline__ float sum16(const f32x16& p) {
    float a, b;
    asm volatile("s_nop 0\n\tv_add_f32 %0, %2, %3\n\tv_add_f32 %1, %4, %5\n\tv_add_f32 %0, %0, %6\n\tv_add_f32 %1, %1, %7\n\tv_add_f32 %0, %0, %8\n\tv_add_f32 %1, %1, %9\n\t"
                 "v_add_f32 %0, %0, %10\n\tv_add_f32 %1, %1, %11\n\tv_add_f32 %0, %0, %12\n\tv_add_f32 %1, %1, %13\n\tv_add_f32 %0, %0, %14\n\tv_add_f32 %1, %1, %15\n\t"
                 "v_add_f32 %0, %0, %16\n\tv_add_f32 %1, %1, %17\n\tv_add_f32 %0, %0, %1"
                 : "=&v"(a), "=&v"(b)
                 : "v"(p[0]), "v"(p[1]), "v"(p[2]), "v"(p[3]), "v"(p[4]), "v"(p[5]), "v"(p[6]), "v"(p[7]), "v"(p[8]), "v"(p[9]), "v"(p[10]), "v"(p[11]), "v"(p[12]), "v"(p[13]), "v"(p[14]), "v"(p[15]));
    return a;
}
__device__ __forceinline__ float swap_add(float v) {
    auto rr = __builtin_amdgcn_permlane32_swap(__float_as_uint(v), __float_as_uint(v), false, false);
    return __uint_as_float(rr[0]) + __uint_as_float(rr[1]);
}

struct PassCtx {
    lds_ptr lds3; unsigned lds0;
    int lane, r32, hi, wid;
    int tq;
    const __attribute__((address_space(3))) float* bt;
    __attribute__((address_space(3))) float* wsf;
    int vboff;
};

template <int MODE>
__device__ __forceinline__ void run_pass(const PassCtx& c, int NT, int first, const bf16* Kb, const bf16* Vb, int pitch, const bf16x8* qr,
                                         unsigned mask_lo, unsigned mask_hi, f32x16 (&o)[2], f32x16 (&im)[2], float& m, float& l) {
    const __attribute__((address_space(3))) unsigned char* TL = (const __attribute__((address_space(3))) unsigned char*)(c.lds3 + L_MISC);
#define NSA_TID(i) ((MODE == 0) ? (i) : (MODE == 2) ? (first + (i)) : (int)TL[NT - 1 - (i)])
#define NSA_ISSUE(i, slot) do { const int id_ = __builtin_amdgcn_readfirstlane(NSA_TID(i)); \
        const bf16* ks_ = Kb + (size_t)(64 * id_ + c.lane) * pitch + 8 * c.wid; \
        const bf16* vs_ = Vb + (size_t)(64 * id_ + 16 * (c.wid & 3) + (c.lane >> 2)) * pitch + 32 * (c.wid >> 2) + 8 * (c.lane & 3); \
        glds16(ks_, (unsigned)__builtin_amdgcn_readfirstlane(c.lds0 + L_RING + (slot) * SLOTB + c.wid * 1024)); \
        glds16(vs_, (unsigned)__builtin_amdgcn_readfirstlane(c.lds0 + L_RING + (slot) * SLOTB + 8192 + c.wid * 1024)); } while (0)
    if (NT > 0) NSA_ISSUE(0, 0);
    if (NT > 1) NSA_ISSUE(1, 1);
    if (NT > 2) NSA_ISSUE(2, 2);
    int slot = 0;
    for (int i = 0; i < NT; ++i) {
        if (i + 2 < NT) NSA_WAIT_BAR(4); else if (i + 1 < NT) NSA_WAIT_BAR(2); else NSA_WAIT_BAR(0);
        if (i + 3 < NT) { const int s3 = (slot == 0) ? 3 : slot - 1; NSA_ISSUE(i + 3, s3); }
        const int id = __builtin_amdgcn_readfirstlane(NSA_TID(i));
        f32x16 p0, p1;
        qkt(p0, p1, (lds_cptr)(c.lds3 + L_RING + slot * SLOTB), qr, c.r32, c.hi);
        const int dbase = (MODE == 0) ? (c.tq - 31 - 1024 * id) : (c.tq - 64 * id);
        bool selb = true;
        if (MODE == 1) selb = ((id < 32 ? (mask_lo >> id) : (mask_hi >> (id - 32))) & 1u) != 0u;
        float alpha, rs;
        if (NSA_FAR && MODE == 1 && __builtin_amdgcn_readfirstlane(c.tq - c.r32) - (64 * id + 63) >= 790) {
            const float lofs = selb ? c.bt[790] : -INFINITY;
            const float mt = rowmax32(p0, p1) * SC2 + lofs;
            const float mnew = fmaxf(m, mt);
            alpha = __builtin_amdgcn_exp2f(m - mnew);
            m = mnew;
            const float off = lofs - mnew;
#pragma unroll
            for (int r = 0; r < 16; ++r) { p0[r] = __builtin_amdgcn_exp2f(p0[r] * SC2 + off); p1[r] = __builtin_amdgcn_exp2f(p1[r] * SC2 + off); }
        } else {
        if (MODE != 0 && NSA_FAR) {
        int dbh = dbase - 4 * c.hi;
        asm volatile("" : "+v"(dbh));
        unsigned ba = (unsigned)(uintptr_t)c.bt + 4u * (unsigned)dbh;
        if (MODE == 1) ba = selb ? ba : (c.lds0 + L_BTP + 4u * (4 * BT_P + BT_NEG - 1));
        ba -= 236u;
        asm volatile("" : "+v"(ba));
        const __attribute__((address_space(3))) float* bp = (const __attribute__((address_space(3))) float*)(uintptr_t)ba;
#pragma unroll
        for (int r = 0; r < 16; ++r) {
            const int cr = (r & 3) + 8 * (r >> 2);
            const float b0 = bp[59 - cr], b1 = bp[27 - cr];
            float s0 = p0[r] * SC2 + b0, s1 = p1[r] * SC2 + b1;
            if (MODE == 2) { const int d0 = dbh - cr, d1 = d0 - 32; s0 = (unsigned)d0 < (unsigned)WINDOW ? s0 : -INFINITY; s1 = (unsigned)d1 < (unsigned)WINDOW ? s1 : -INFINITY; }
            p0[r] = s0; p1[r] = s1;
        }
        } else {
        int dbh = dbase - ((MODE == 0) ? 64 * c.hi : 4 * c.hi);
        asm volatile("" : "+v"(dbh));
#pragma unroll
        for (int r = 0; r < 16; ++r) {
            const int d0 = dbh - ((MODE == 0) ? 16 * ((r & 3) + 8 * (r >> 2)) : ((r & 3) + 8 * (r >> 2)));
            const int d1 = (MODE == 0) ? (d0 - 512) : (d0 - 32);
            bool v0 = d0 >= 0, v1 = d1 >= 0;
            if (MODE == 2) { v0 = (unsigned)d0 < (unsigned)WINDOW; v1 = (unsigned)d1 < (unsigned)WINDOW; }
            if (MODE == 1) { v0 = v0 && selb; v1 = v1 && selb; }
            const bool clampd = (MODE == 0) || !NSA_FAR;
            const int i0 = clampd ? (d0 < 0 ? 0 : (d0 > 790 ? 790 : d0)) : d0, i1 = clampd ? (d1 < 0 ? 0 : (d1 > 790 ? 790 : d1)) : d1;
            const float s0 = p0[r] * SC2 + c.bt[i0], s1 = p1[r] * SC2 + c.bt[i1];
            p0[r] = v0 ? s0 : -INFINITY; p1[r] = v1 ? s1 : -INFINITY;
        }
        }
        const float mt = rowmax32(p0, p1);
        const float mnew = fmaxf(m, mt);
        alpha = __builtin_amdgcn_exp2f(m - mnew);
        m = mnew;
#pragma unroll
        for (int r = 0; r < 16; ++r) {
            const float e0 = __builtin_amdgcn_exp2f(p0[r] - mnew), e1 = __builtin_amdgcn_exp2f(p1[r] - mnew);
            p0[r] = e0; p1[r] = e1;
        }
        }
        rs = sum16(p0) + sum16(p1);
        l = l * alpha + rs;
        if (!__all(alpha == 1.f)) {
            if (c.hi == 0) c.wsf[c.r32] = alpha;
            asm volatile("s_waitcnt lgkmcnt(0)" ::: "memory");
#pragma unroll
            for (int r = 0; r < 16; ++r) { const float a = c.wsf[crow(r, c.hi)]; o[0][r] *= a; o[1][r] *= a; if (MODE == 0) { im[0][r] *= a; im[1][r] *= a; } }
        }
        u32x4 pw0, pw1, pw2, pw3;
        pw0 = (u32x4){cvtpk_s(p0[0], p0[1]), cvtpk_s(p0[2], p0[3]), cvtpk_s(p0[4], p0[5]), cvtpk_s(p0[6], p0[7])};
        pw1 = (u32x4){cvtpk_s(p0[8], p0[9]), cvtpk_s(p0[10], p0[11]), cvtpk_s(p0[12], p0[13]), cvtpk_s(p0[14], p0[15])};
        pw2 = (u32x4){cvtpk_s(p1[0], p1[1]), cvtpk_s(p1[2], p1[3]), cvtpk_s(p1[4], p1[5]), cvtpk_s(p1[6], p1[7])};
        pw3 = (u32x4){cvtpk_s(p1[8], p1[9]), cvtpk_s(p1[10], p1[11]), cvtpk_s(p1[12], p1[13]), cvtpk_s(p1[14], p1[15])};
        NSA_SBAR();
        pv(o, (int)(c.lds0 + L_RING + slot * SLOTB + 8192) + c.vboff, __builtin_bit_cast(bf16x8, pw0), __builtin_bit_cast(bf16x8, pw1), __builtin_bit_cast(bf16x8, pw2), __builtin_bit_cast(bf16x8, pw3));
        if (MODE == 0) pv(im, (int)(c.lds0 + L_OV + id * 8192) + c.vboff, __builtin_bit_cast(bf16x8, pw0), __builtin_bit_cast(bf16x8, pw1), __builtin_bit_cast(bf16x8, pw2), __builtin_bit_cast(bf16x8, pw3));
        slot = (slot == NSLOT - 1) ? 0 : slot + 1;
    }
    asm volatile("s_waitcnt vmcnt(0) lgkmcnt(0)\n\ts_barrier" ::: "memory");
#undef NSA_TID
#undef NSA_ISSUE
}

__device__ __forceinline__ void build_ov(lds_ptr lds3) {
    for (int idx = threadIdx.x; idx < 4 * 4096; idx += NTHR) {
        const int kt = idx >> 12, nl = (idx >> 6) & 63, jc = idx & 63, n = 64 * kt + nl;
        unsigned short v = 0;
        if ((n & 3) != 3) { if (jc == (n >> 2)) v = 0x3F80; } else { if (jc == (n >> 2) || jc == (n >> 2) + 1) v = 0x3F00; }
        *(__attribute__((address_space(3))) unsigned short*)(lds3 + L_OV + kt * 8192 + ((jc >> 5) * 4 + (nl >> 4)) * 1024 + (nl & 15) * 64 + (jc & 31) * 2) = v;
    }
}

__device__ __forceinline__ void nsa_unit(int variant, bool build_bt, int b, int g, int qt, const bf16* PROJ, const bf16* KCBb, const bf16* VCBb, const float* rel, bf16* ONSA, lds_ptr lds3, unsigned lds0) {
    const int tid = threadIdx.x, lane = tid & 63, r32 = lane & 31, hi = lane >> 5;
    const int wid = __builtin_amdgcn_readfirstlane(tid >> 6), hh = wid & 3, th = wid >> 2;
    const int t0 = qt * 64, tq = t0 + 32 * th + r32, cur = qt;
    __attribute__((address_space(3))) float* BT = (__attribute__((address_space(3))) float*)(lds3 + L_BTP);
    __attribute__((address_space(3))) unsigned* MASK = (__attribute__((address_space(3))) unsigned*)(lds3 + L_MASK);
    if (build_bt) for (int i = tid; i < 4 * BT_P; i += NTHR) { const int hq_ = i / BT_P, d_ = i - hq_ * BT_P - BT_LO;
        BT[i] = d_ < 0 ? -INFINITY : rel[(g * 4 + hq_) * BT_N + (d_ > 790 ? 790 : d_)]; }
    if (build_bt && tid < BT_NEG) BT[4 * BT_P + tid] = -INFINITY;
    if (tid < 128) MASK[tid] = 0u;
    PassCtx c; c.lds3 = lds3; c.lds0 = lds0; c.lane = lane; c.r32 = r32; c.hi = hi; c.wid = wid; c.tq = tq;
    c.bt = BT + hh * BT_P + BT_LO; c.wsf = (__attribute__((address_space(3))) float*)(lds3 + L_WSF) + wid * 64;
    c.vboff = ((lane >> 4) & 1) * 32 + (lane & 3) * 8 + (4 * hi + ((lane & 15) >> 2)) * 64;
    const size_t qrow = (size_t)(b * SEQ + tq) * PP;
    bf16x8 qr[4];
#pragma unroll
    for (int d0 = 0; d0 < 4; ++d0) qr[d0] = *(const bf16x8*)(PNL(PROJ, P_QN + g) + qrow + hh * HD + d0 * 16 + hi * 8);
    const float gate0 = 1.f / (1.f + __expf(-bf2f(PNL(PROJ, P_GBR)[qrow + 0 * 16 + g * 4 + hh])));
    const float gate1 = 1.f / (1.f + __expf(-bf2f(PNL(PROJ, P_GBR)[qrow + 1 * 16 + g * 4 + hh])));
    const float gate2 = 1.f / (1.f + __expf(-bf2f(PNL(PROJ, P_GBR)[qrow + 2 * 16 + g * 4 + hh])));
    asm volatile("s_waitcnt vmcnt(0) lgkmcnt(0)" ::: "memory");
    __syncthreads();
    f32x16 oc[2] = {}, o[2] = {}, im[2] = {};
    float m = NEG2, l = 0.f;
    {
        int cnt = (t0 + 32) / 16 + 1; if (cnt > NCMP) cnt = NCMP;
        const int NT = (variant & 4) ? 0 : ((cnt + 63) >> 6);
#if defined(PROBE_NSA_CMP2)
        run_pass<0>(c, NT, 0, KCBb + (size_t)(b * 4 + g) * 256 * HD, VCBb + (size_t)(b * 4 + g) * 256 * HD, HD, qr, 0u, 0u, o, im, m, l);
        o[0] = f32x16{}; o[1] = f32x16{}; im[0] = f32x16{}; im[1] = f32x16{}; m = NEG2; l = 0.f;
#endif
        run_pass<0>(c, NT, 0, KCBb + (size_t)(b * 4 + g) * 256 * HD, VCBb + (size_t)(b * 4 + g) * 256 * HD, HD, qr, 0u, 0u, o, im, m, l);
        const float lt = swap_add(l);
        const float inv = lt > 0.f ? 1.f / lt : 0.f;
        if (hi == 0) { c.wsf[r32] = inv * gate0; c.wsf[32 + r32] = inv; }
        asm volatile("s_waitcnt lgkmcnt(0)" ::: "memory");
#pragma unroll
        for (int r = 0; r < 16; ++r) { const float a = c.wsf[crow(r, hi)], a2 = c.wsf[32 + crow(r, hi)]; oc[0][r] = o[0][r] * a; oc[1][r] = o[1][r] * a; im[0][r] *= a2; im[1][r] *= a2; }
        if (!(variant & 8)) {
        {
            __attribute__((address_space(3))) float* PW = (__attribute__((address_space(3))) float*)(lds3 + L_RING) + wid * 2048;
#pragma unroll
            for (int d0 = 0; d0 < 2; ++d0)
#pragma unroll
                for (int r = 0; r < 16; ++r) PW[crow(r, hi) * 64 + d0 * 32 + r32] = im[d0][r];
        }
        asm volatile("s_waitcnt lgkmcnt(0)" ::: "memory"); __syncthreads();
        __attribute__((address_space(3))) float* T = (__attribute__((address_space(3))) float*)(lds3 + L_X);
        {
            const __attribute__((address_space(3))) float* PA = (const __attribute__((address_space(3))) float*)(lds3 + L_RING);
            int tx = tid; asm volatile("" : "+v"(tx));
            const int j = tx & 63, tb = (tx >> 6) * 8;
#pragma unroll
            for (int e = 0; e < 8; ++e) { const int tok = tb + e, w0 = (tok >> 5) * 4, q = tok & 31;
                T[tok * 65 + j] = (PA[(w0 + 0) * 2048 + q * 64 + j] + PA[(w0 + 1) * 2048 + q * 64 + j]) + (PA[(w0 + 2) * 2048 + q * 64 + j] + PA[(w0 + 3) * 2048 + q * 64 + j]); }
        }
        asm volatile("s_waitcnt lgkmcnt(0)" ::: "memory"); __syncthreads();
        {
            int ty = tid; asm volatile("" : "+v"(ty));
            const int tok = ty & 63, jg = wid, jlo = 8 * jg;
            float v[8]; int rank[8];
#pragma unroll
            for (int e = 0; e < 8; ++e) { const int j = jlo + e; const bool forced = (j == 0) || (j == cur) || (j == cur - 1);
                v[e] = (j <= cur) ? T[tok * 65 + j] + (forced ? 1e4f : 0.f) : -INFINITY; rank[e] = 0; }
            const int nA = jlo < cur + 1 ? jlo : cur + 1, nB = (jlo + 8) < cur + 1 ? (jlo + 8) : cur + 1;
#pragma unroll 2
            for (int j2 = 0; j2 < nA; ++j2) {
                const float sv = T[tok * 65 + j2] + (((j2 == 0) || (j2 == cur) || (j2 == cur - 1)) ? 1e4f : 0.f);
#pragma unroll
                for (int e = 0; e < 8; ++e) rank[e] += (sv >= v[e]) ? 1 : 0;
            }
            for (int j2 = jlo; j2 < nB; ++j2) {
                const float sv = T[tok * 65 + j2] + (((j2 == 0) || (j2 == cur) || (j2 == cur - 1)) ? 1e4f : 0.f);
#pragma unroll
                for (int e = 0; e < 8; ++e) rank[e] += (sv > v[e] || (sv == v[e] && j2 < jlo + e)) ? 1 : 0;
            }
#pragma unroll 2
            for (int j2 = jlo + 8; j2 <= cur; ++j2) {
                const float sv = T[tok * 65 + j2] + (((j2 == 0) || (j2 == cur) || (j2 == cur - 1)) ? 1e4f : 0.f);
#pragma unroll
                for (int e = 0; e < 8; ++e) rank[e] += (sv > v[e]) ? 1 : 0;
            }
            unsigned bits = 0u;
#pragma unroll
            for (int e = 0; e < 8; ++e) { const int j = jlo + e; if (j <= cur && rank[e] < SEL_TOPK) bits |= 1u << e; }
            if (bits) atomicOr((unsigned*)(MASK + tok * 2 + (jg >> 2)), bits << ((jg & 3) * 8));
        }
        asm volatile("s_waitcnt lgkmcnt(0)" ::: "memory"); __syncthreads();
        if (wid == 0) {
            unsigned ulo = MASK[lane * 2], uhi = MASK[lane * 2 + 1];
#pragma unroll
            for (int ofs = 32; ofs >= 1; ofs >>= 1) { ulo |= __shfl_xor(ulo, ofs); uhi |= __shfl_xor(uhi, ofs); }
            {
                __attribute__((address_space(3))) unsigned char* TL = (__attribute__((address_space(3))) unsigned char*)(lds3 + L_MISC);
                const unsigned long long mm = ((unsigned long long)uhi << 32) | ulo;
                int ln = lane; asm volatile("" : "+v"(ln));
                if ((mm >> ln) & 1ull) TL[__popcll(mm & ((1ull << ln) - 1ull))] = (unsigned char)ln;
                if (lane == 0) *(__attribute__((address_space(3))) int*)(lds3 + L_MISC + 64) = __popcll(mm);
            }
        }
        asm volatile("s_waitcnt lgkmcnt(0)" ::: "memory"); __syncthreads();
        }
    }
    {
        const unsigned mlo = MASK[(32 * th + r32) * 2], mhi = MASK[(32 * th + r32) * 2 + 1];
        const int NT = (variant & 1) ? 0 : __builtin_amdgcn_readfirstlane(*(__attribute__((address_space(3))) int*)(lds3 + L_MISC + 64));
#if defined(PROBE_NSA_SEL2)
        o[0] = f32x16{}; o[1] = f32x16{}; m = NEG2; l = 0.f;
        run_pass<1>(c, NT, 0, PNL(PROJ, P_KS) + (size_t)b * SEQ * PP + g * HD, PNL(PROJ, P_VS) + (size_t)b * SEQ * PP + g * HD, PP, qr, mlo, mhi, o, im, m, l);
#endif
        o[0] = f32x16{}; o[1] = f32x16{}; m = NEG2; l = 0.f;
        run_pass<1>(c, NT, 0, PNL(PROJ, P_KS) + (size_t)b * SEQ * PP + g * HD, PNL(PROJ, P_VS) + (size_t)b * SEQ * PP + g * HD, PP, qr, mlo, mhi, o, im, m, l);
        const float lt = swap_add(l);
        const float inv = lt > 0.f ? 1.f / lt : 0.f;
        if (hi == 0) c.wsf[r32] = inv * gate1;
        asm volatile("s_waitcnt lgkmcnt(0)" ::: "memory");
#pragma unroll
        for (int r = 0; r < 16; ++r) { const float a = c.wsf[crow(r, hi)]; oc[0][r] += o[0][r] * a; oc[1][r] += o[1][r] * a; }
    }
    {
        const int jlo = (qt - 8) > 0 ? (qt - 8) : 0, NT = (variant & 2) ? 0 : (qt - jlo + 1);
#if defined(PROBE_NSA_WIN2)
        o[0] = f32x16{}; o[1] = f32x16{}; m = NEG2; l = 0.f;
        run_pass<2>(c, NT, jlo, PNL(PROJ, P_KW) + (size_t)b * SEQ * PP + g * HD, PNL(PROJ, P_VW) + (size_t)b * SEQ * PP + g * HD, PP, qr, 0u, 0u, o, im, m, l);
#endif
        o[0] = f32x16{}; o[1] = f32x16{}; m = NEG2; l = 0.f;
        run_pass<2>(c, NT, jlo, PNL(PROJ, P_KW) + (size_t)b * SEQ * PP + g * HD, PNL(PROJ, P_VW) + (size_t)b * SEQ * PP + g * HD, PP, qr, 0u, 0u, o, im, m, l);
        const float lt = swap_add(l);
        const float inv = lt > 0.f ? 1.f / lt : 0.f;
        if (hi == 0) c.wsf[r32] = inv * gate2;
        asm volatile("s_waitcnt lgkmcnt(0)" ::: "memory");
#pragma unroll
        for (int r = 0; r < 16; ++r) { const float a = c.wsf[crow(r, hi)]; oc[0][r] += o[0][r] * a; oc[1][r] += o[1][r] * a; }
    }
    {
        __attribute__((address_space(3))) unsigned short* stg = (__attribute__((address_space(3))) unsigned short*)(lds3 + L_X) + wid * 2048;
#pragma unroll
        for (int r = 0; r < 16; ++r) { const int orow = crow(r, hi);
#pragma unroll
            for (int d0 = 0; d0 < 2; ++d0) stg[orow * 64 + d0 * 32 + r32] = (unsigned short)f2bf(oc[d0][r]); }
        asm volatile("s_waitcnt lgkmcnt(0)" ::: "memory");
        bf16* Ow = ONSA + (size_t)(b * SEQ + t0 + 32 * th) * NSA_Q + (g * 4 + hh) * HD;
#pragma unroll
        for (int i = 0; i < 4; ++i) { const int row = i * 8 + (lane >> 3), ch = lane & 7;
            const u32x4 vv = *(const __attribute__((address_space(3))) u32x4*)(stg + row * 64 + ch * 8);
            *(u32x4*)(Ow + (size_t)row * NSA_Q + ch * 8) = vv; }
    }
    asm volatile("s_waitcnt vmcnt(0) lgkmcnt(0)" ::: "memory");
    __syncthreads();
}

__device__ __forceinline__ void nsa_phase(const bf16* PROJ, const bf16* KCBb, const bf16* VCBb, const float* rel, bf16* ONSA, lds_ptr lds3, int vcu, int G, int variant) {
    const unsigned lds0 = (unsigned)(uintptr_t)lds3;
    build_ov(lds3);
    __syncthreads();
    int last_g = -1;
#ifndef NSA_REP
#define NSA_REP 1
#endif
#pragma unroll 1
    for (int rep_ = 0; rep_ < NSA_REP; ++rep_)
#pragma unroll 1
    for (int i = vcu; i < 512; i += G) {
        const int k = i & 255, bg = k >> 5, s = k & 31, qt = (i < 256) ? s : 63 - s;
        if (!(variant & 16)) nsa_unit(variant, (bg & 3) != last_g, bg >> 2, bg & 3, qt, PROJ, KCBb, VCBb, rel, ONSA, lds3, lds0);
        last_g = bg & 3;
    }
}
#undef NSA_WAIT_BAR
#undef NSA_SBAR
}
namespace nsa {
constexpr float STICK_THR = 50.f, LN2F = 0.6931471805599453f;
constexpr int STK_SLOTB = 32768;
static_assert(3 * STK_SLOTB <= L_WSF, "stick ring vs the LDS words it shares with the NSA map");
#define NSA_WAIT_BAR(N) asm volatile("s_waitcnt vmcnt(" #N ") lgkmcnt(0)\n\ts_barrier" ::: "memory")
__device__ __forceinline__ void stick_unit(int tid, int b, int hp, int qb, const bf16* PROJ, bf16* OSB, lds_ptr lds3, unsigned lds0, const bf16x8 (&tri)[2]) {
    const int lane = tid & 63, r32 = lane & 31, hi = lane >> 5;
    const int wid = __builtin_amdgcn_readfirstlane(tid >> 6);
    const int hs = wid >> 2, qw = wid & 3, h = 2 * hp + hs;
    const int q0 = qb * 128, t = q0 + 32 * qw + r32;
    const bf16* Kb = PNL(PROJ, P_KB + (hp >> 1)) + (size_t)b * SEQ * PP + (hp & 1) * 128;
    const bf16* Vb = PNL(PROJ, P_VB + (hp >> 1)) + (size_t)b * SEQ * PP + (hp & 1) * 128;
    __attribute__((address_space(3))) int* DONE = (__attribute__((address_space(3))) int*)(lds3 + L_MISC);
    bf16x8 qr[4];
#pragma unroll
    for (int d0 = 0; d0 < 4; ++d0) qr[d0] = *(const bf16x8*)(PNL(PROJ, P_QB + (h >> 2)) + (size_t)(b * SEQ + t) * PP + (h & 3) * HD + d0 * 16 + hi * 8);
    if (tid < 8) DONE[tid] = 0x7fffffff;
    asm volatile("s_waitcnt vmcnt(0) lgkmcnt(0)" ::: "memory");
    __syncthreads();
    const int jhi = 2 * qb + 1, NT = jhi + 1;
    const int jw = (q0 + 32 * qw + 30) >> 6;
    const int vboff = ((lane >> 4) & 1) * 32 + (lane & 3) * 8 + (4 * hi + ((lane & 15) >> 2)) * 64;
    f32x16 o[2] = {};
    float carry = 0.f; bool mydone = false;
#define STK_ISSUE(i, slot) do { const int id_ = jhi - (i); \
        const bf16* ks_ = Kb + (size_t)(64 * id_ + lane) * PP + 8 * wid; \
        const bf16* vs_ = Vb + (size_t)(64 * id_ + 16 * (wid & 3) + (lane >> 2)) * PP + 32 * (wid >> 2) + 8 * (lane & 3); \
        glds16(ks_, (unsigned)__builtin_amdgcn_readfirstlane(lds0 + L_RING + (slot) * STK_SLOTB + wid * 1024)); \
        glds16(vs_, (unsigned)__builtin_amdgcn_readfirstlane(lds0 + L_RING + (slot) * STK_SLOTB + 8192 + wid * 1024)); \
        glds16(ks_ + 64, (unsigned)__builtin_amdgcn_readfirstlane(lds0 + L_RING + (slot) * STK_SLOTB + 16384 + wid * 1024)); \
        glds16(vs_ + 64, (unsigned)__builtin_amdgcn_readfirstlane(lds0 + L_RING + (slot) * STK_SLOTB + 24576 + wid * 1024)); } while (0)
    STK_ISSUE(0, 0);
    if (NT > 1) STK_ISSUE(1, 1);
    int slot = 0;
    for (int i = 0; i < NT; ++i) {
        if (i + 1 < NT) NSA_WAIT_BAR(4); else NSA_WAIT_BAR(0);
        bool alld = true;
#pragma unroll
        for (int w = 0; w < 8; ++w) alld = alld && (DONE[w] < i);
        if (__builtin_amdgcn_readfirstlane((int)alld)) break;
        if (i + 2 < NT) { const int s2 = (slot == 0) ? 2 : slot - 1; STK_ISSUE(i + 2, s2); }
        const int j = jhi - i;
        if (!mydone && j <= jw) {
            f32x16 p0, p1, x0, x1;
            qkt(p0, p1, (lds_cptr)(lds3 + L_RING + slot * STK_SLOTB + hs * 16384), qr, r32, hi);
            float s0 = 0.f, s1 = 0.f;
#pragma unroll
            for (int r = 0; r < 16; ++r) {
                const int pos0 = 64 * j + crow(r, hi);
                const float z0 = p0[r] * 0.125f, z1 = p1[r] * 0.125f;
                const float L0 = __builtin_amdgcn_logf(1.f + __builtin_amdgcn_exp2f(-fabsf(z0) * LOG2E)) * LN2F;
                const float L1 = __builtin_amdgcn_logf(1.f + __builtin_amdgcn_exp2f(-fabsf(z1) * LOG2E)) * LN2F;
                p0[r] = fminf(z0, 0.f) - L0; p1[r] = fminf(z1, 0.f) - L1;
                x0[r] = (pos0 < t) ? (-fmaxf(z0, 0.f) - L0) : 0.f; x1[r] = (pos0 + 32 < t) ? (-fmaxf(z1, 0.f) - L1) : 0.f;
                s0 += x0[r]; s1 += x1[r];
            }
            const float tot0 = swap_add(s0), tot1 = swap_add(s1);
            u32x4 h0a, h0b, l0a, l0b, h1a, h1b, l1a, l1b;
#define STK_SPLIT(X, HA, HB, LA, LB) do { unsigned hw_[8]; float lo_[16]; \
                _Pragma("unroll") for (int q_ = 0; q_ < 8; ++q_) { hw_[q_] = cvtpk_s(X[2 * q_], X[2 * q_ + 1]); \
                    lo_[2 * q_] = X[2 * q_] - __uint_as_float(hw_[q_] << 16); lo_[2 * q_ + 1] = X[2 * q_ + 1] - __uint_as_float(hw_[q_] & 0xffff0000u); } \
                HA = (u32x4){hw_[0], hw_[1], hw_[2], hw_[3]}; HB = (u32x4){hw_[4], hw_[5], hw_[6], hw_[7]}; \
                LA = (u32x4){cvtpk_s(lo_[0], lo_[1]), cvtpk_s(lo_[2], lo_[3]), cvtpk_s(lo_[4], lo_[5]), cvtpk_s(lo_[6], lo_[7])}; \
                LB = (u32x4){cvtpk_s(lo_[8], lo_[9]), cvtpk_s(lo_[10], lo_[11]), cvtpk_s(lo_[12], lo_[13]), cvtpk_s(lo_[14], lo_[15])}; } while (0)
            STK_SPLIT(x0, h0a, h0b, l0a, l0b);
            STK_SPLIT(x1, h1a, h1b, l1a, l1b);
#undef STK_SPLIT
            f32x16 y0, y1;
#pragma unroll
            for (int r = 0; r < 16; ++r) { y0[r] = carry + tot1; y1[r] = carry; }
            y0 = __builtin_amdgcn_mfma_f32_32x32x16_bf16(tri[0], __builtin_bit_cast(bf16x8, h0a), y0, 0, 0, 0);
            y0 = __builtin_amdgcn_mfma_f32_32x32x16_bf16(tri[1], __builtin_bit_cast(bf16x8, h0b), y0, 0, 0, 0);
            y0 = __builtin_amdgcn_mfma_f32_32x32x16_bf16(tri[0], __builtin_bit_cast(bf16x8, l0a), y0, 0, 0, 0);
            y0 = __builtin_amdgcn_mfma_f32_32x32x16_bf16(tri[1], __builtin_bit_cast(bf16x8, l0b), y0, 0, 0, 0);
            y1 = __builtin_amdgcn_mfma_f32_32x32x16_bf16(tri[0], __builtin_bit_cast(bf16x8, h1a), y1, 0, 0, 0);
            y1 = __builtin_amdgcn_mfma_f32_32x32x16_bf16(tri[1], __builtin_bit_cast(bf16x8, h1b), y1, 0, 0, 0);
            y1 = __builtin_amdgcn_mfma_f32_32x32x16_bf16(tri[0], __builtin_bit_cast(bf16x8, l1a), y1, 0, 0, 0);
            y1 = __builtin_amdgcn_mfma_f32_32x32x16_bf16(tri[1], __builtin_bit_cast(bf16x8, l1b), y1, 0, 0, 0);
#pragma unroll
            for (int r = 0; r < 16; ++r) {
                const int pos0 = 64 * j + crow(r, hi);
                y0[r] = (pos0 < t) ? __builtin_amdgcn_exp2f((p0[r] + y0[r]) * LOG2E) : 0.f;
                y1[r] = (pos0 + 32 < t) ? __builtin_amdgcn_exp2f((p1[r] + y1[r]) * LOG2E) : 0.f;
            }
            carry += tot0 + tot1;
            u32x4 pw0, pw1, pw2, pw3;
            pw0 = (u32x4){cvtpk_s(y0[0], y0[1]), cvtpk_s(y0[2], y0[3]), cvtpk_s(y0[4], y0[5]), cvtpk_s(y0[6], y0[7])};
            pw1 = (u32x4){cvtpk_s(y0[8], y0[9]), cvtpk_s(y0[10], y0[11]), cvtpk_s(y0[12], y0[13]), cvtpk_s(y0[14], y0[15])};
            pw2 = (u32x4){cvtpk_s(y1[0], y1[1]), cvtpk_s(y1[2], y1[3]), cvtpk_s(y1[4], y1[5]), cvtpk_s(y1[6], y1[7])};
            pw3 = (u32x4){cvtpk_s(y1[8], y1[9]), cvtpk_s(y1[10], y1[11]), cvtpk_s(y1[12], y1[13]), cvtpk_s(y1[14], y1[15])};
            __builtin_amdgcn_sched_barrier(0);
            pv(o, (int)(lds0 + L_RING + slot * STK_SLOTB + hs * 16384 + 8192) + vboff, __builtin_bit_cast(bf16x8, pw0), __builtin_bit_cast(bf16x8, pw1), __builtin_bit_cast(bf16x8, pw2), __builtin_bit_cast(bf16x8, pw3));
            mydone = __all(carry < -STICK_THR) != 0;
            if (mydone && lane == 0) DONE[wid] = i;
        }
        slot = (slot == 2) ? 0 : slot + 1;
    }
    asm volatile("s_waitcnt vmcnt(0) lgkmcnt(0)\n\ts_barrier" ::: "memory");
#undef STK_ISSUE
    {
        __attribute__((address_space(3))) unsigned short* stg = (__attribute__((address_space(3))) unsigned short*)(lds3 + L_X) + wid * 2048;
#pragma unroll
        for (int r = 0; r < 16; ++r) { const int orow = crow(r, hi);
#pragma unroll
            for (int d0 = 0; d0 < 2; ++d0) stg[orow * 64 + d0 * 32 + r32] = (unsigned short)f2bf(o[d0][r]); }
        asm volatile("s_waitcnt lgkmcnt(0)" ::: "memory");
        bf16* Ow = OSB + (size_t)(b * SEQ + q0 + 32 * qw) * SB_W + h * HD;
#pragma unroll
        for (int i = 0; i < 4; ++i) { const int row = i * 8 + (lane >> 3), ch = lane & 7;
            const u32x4 vv = *(const __attribute__((address_space(3))) u32x4*)(stg + row * 64 + ch * 8);
            *(u32x4*)(Ow + (size_t)row * SB_W + ch * 8) = vv; }
    }
    asm volatile("s_waitcnt vmcnt(0) lgkmcnt(0)" ::: "memory");
    __syncthreads();
}
__device__ __forceinline__ void stick_phase(const bf16* PROJ, bf16* OSB, lds_ptr lds3, int vcu, int G) {
    const unsigned lds0 = (unsigned)(uintptr_t)lds3;
    int tid = threadIdx.x; asm volatile("" : "+v"(tid));
    const int lane = tid & 63, r32 = lane & 31, hi = lane >> 5;
    bf16x8 tri[2];
#pragma unroll
    for (int s = 0; s < 2; ++s)
#pragma unroll
        for (int j = 0; j < 8; ++j) tri[s][j] = ((16 * s + 8 * (j >> 2) + 4 * hi + (j & 3)) > r32) ? (short)0x3F80 : (short)0;
    for (int i = vcu; i < 512; i += G) {
        const int bp = i >> 5, qb = i & 31;
        stick_unit(tid, bp >> 3, bp & 7, qb, PROJ, OSB, lds3, lds0, tri);
    }
}
#undef NSA_WAIT_BAR
}
namespace peer {
typedef short bf16x8 __attribute__((ext_vector_type(8)));
typedef float f32x16 __attribute__((ext_vector_type(16)));
typedef __bf16 b2_t __attribute__((ext_vector_type(2)));
constexpr int L_EX = 0, L_GT = 16384, L_GN = 32768;
__device__ __forceinline__ int crow(int r, int hi) { return (r & 3) + 8 * (r >> 2) + 4 * hi; }
__device__ __forceinline__ unsigned mono(float f) { const unsigned u = __float_as_uint(f); return (u & 0x80000000u) ? ~u : (u | 0x80000000u); }
__device__ __forceinline__ float unmono(unsigned k) { return __uint_as_float((k & 0x80000000u) ? (k & 0x7fffffffu) : ~k); }
__device__ __forceinline__ float dot2(unsigned a, unsigned b, float c) { return __builtin_amdgcn_fdot2_f32_bf16(__builtin_bit_cast(b2_t, a), __builtin_bit_cast(b2_t, b), c, false); }
#define PEER_CE(key, slot) do { const unsigned hi_ = (key) > (slot) ? (key) : (slot); (key) = (key) > (slot) ? (slot) : (key); (slot) = hi_; } while (0)

__device__ __forceinline__ void route_list(const bf16* QP, const bf16* SKB, int L, int tok0, int r32, int hi, unsigned (&out)[16]) {
    f32x16 acc[4] = {};
    const bf16* qp = QP + (size_t)(tok0 + r32) * 2048 + L * 128 + hi * 8;
    const bf16* kp = SKB + ((size_t)L * 128 + r32) * 128 + hi * 8;
    int hi4 = 4 * hi;
    asm volatile("" : "+v"(qp), "+v"(kp), "+v"(hi4));
#pragma unroll
    for (int ks = 0; ks < 8; ++ks) {
        const bf16x8 bq = __builtin_nontemporal_load((const bf16x8*)(qp + ks * 16));
#pragma unroll
        for (int kt = 0; kt < 4; ++kt) { const bf16x8 a = *(const bf16x8*)(kp + (size_t)kt * 32 * 128 + ks * 16); acc[kt] = __builtin_amdgcn_mfma_f32_32x32x16_bf16(a, bq, acc[kt], 0, 0, 0); }
    }
    unsigned t[16];
#pragma unroll
    for (int k = 0; k < 16; ++k) t[k] = 0u;
#pragma unroll
    for (int kt = 0; kt < 4; ++kt)
#pragma unroll
        for (int r = 0; r < 16; ++r) {
            unsigned key = ((mono(acc[kt][r]) & ~127u) | (unsigned)(127 - (32 * kt + (r & 3) + 8 * (r >> 2)))) - (unsigned)hi4;
#pragma unroll
            for (int k = 0; k < 16; ++k) PEER_CE(key, t[k]);
            __builtin_amdgcn_sched_barrier(0);
        }
    unsigned u[16];
#pragma unroll
    for (int k = 0; k < 16; ++k) { auto rr = __builtin_amdgcn_permlane32_swap(t[k], t[k], false, false); u[k] = hi ? rr[0] : rr[1]; }
#pragma unroll
    for (int k = 0; k < 16; ++k) out[k] = t[k] > u[15 - k] ? t[k] : u[15 - k];
#pragma unroll
    for (int st = 8; st >= 1; st >>= 1)
#pragma unroll
        for (int k = 0; k < 16; ++k) if ((k & st) == 0) { const unsigned a = out[k], b = out[k | st]; out[k] = a > b ? a : b; out[k | st] = a > b ? b : a; }
}

__device__ __forceinline__ void route_head(const bf16* QP, const bf16* SKB, int h, int tok0, int lane, __attribute__((address_space(3))) unsigned char* lds3) {
    asm volatile("" : "+v"(lane));
    const int r32 = lane & 31, hi = lane >> 5;
    unsigned A[16], B[16];
    route_list(QP, SKB, 2 * h, tok0, r32, hi, A);
    route_list(QP, SKB, 2 * h + 1, tok0, r32, hi, B);
    float va[16], vb[16]; int ia[16], ib[16];
#pragma unroll
    for (int k = 0; k < 16; ++k) { va[k] = unmono((A[k] & ~127u) | 64u); vb[k] = unmono((B[k] & ~127u) | 64u); ia[k] = 127 - (int)(A[k] & 127u); ib[k] = 127 - (int)(B[k] & 127u); }
    unsigned s[16], sp[16];
#pragma unroll
    for (int k = 0; k < 16; ++k) { s[k] = 0u; sp[k] = 0u; }
#pragma unroll
    for (int i = 0; i < 16; ++i)
#pragma unroll
        for (int j = 0; j < 16; ++j) if ((i + 1) * (j + 1) <= 16) {
            unsigned key = mono(va[i] + vb[j]); unsigned pay = (unsigned)(ia[i] * PEER_KEYS + ib[j]);
#pragma unroll
            for (int k = (i + 1) * (j + 1) - 1; k < 16; ++k) { const bool gt = key > s[k]; const unsigned ts = s[k], tp = sp[k]; s[k] = gt ? key : ts; sp[k] = gt ? pay : tp; key = gt ? ts : key; pay = gt ? tp : pay; }
            __builtin_amdgcn_sched_barrier(0);
        }
    const float mx = unmono(s[0]);
    float e[16], sum = 0.f;
#pragma unroll
    for (int k = 0; k < 16; ++k) { e[k] = __expf(unmono(s[k]) - mx); sum += e[k]; }
    const float inv = 1.f / sum;
    if (hi == 0) {
        __attribute__((address_space(3))) int* EX = (__attribute__((address_space(3))) int*)(lds3 + L_EX);
        __attribute__((address_space(3))) float* GT = (__attribute__((address_space(3))) float*)(lds3 + L_GT);
#pragma unroll
        for (int k = 0; k < 16; ++k) { EX[(h * 16 + k) * 32 + r32] = (int)sp[k]; GT[(h * 16 + k) * 32 + r32] = e[k] * inv; }
    }
}

#ifndef PEER_FAKE
#define PEER_FAKE 0
#endif
#ifndef PEER_FAKE_MODE
#define PEER_FAKE_MODE 0
#endif
#ifndef PEER_FAKE_EMASK
#define PEER_FAKE_EMASK 0xffff
#endif
constexpr int FP6_PITCH = 2048;
typedef float v2f_t __attribute__((ext_vector_type(2)));
__device__ __forceinline__ void cvt_row_load(const float* src, int row, int lane, f32x4 (&v)[8]) {
    const float* p = src + (size_t)row * 2048 + lane * 4;
#pragma unroll
    for (int i = 0; i < 8; ++i) v[i] = __builtin_nontemporal_load((const f32x4*)(p + i * 256));
}
__device__ __forceinline__ float clamp6(float x) { return __builtin_amdgcn_fmed3f(x, -6.f, 6.f); }
__device__ __forceinline__ float elem4(const f32x4& a, int m) { return m == 0 ? a.x : m == 1 ? a.y : m == 2 ? a.z : a.w; }
__device__ __forceinline__ void cvt_row_store(const f32x4 (&v)[8], unsigned char* REC, float* ISC, int r, int lane) {
    float am = 0.f, ss = 0.f;
#pragma unroll
    for (int i = 0; i < 8; ++i) { am = fmaxf(am, fmaxf(fmaxf(fabsf(v[i].x), fabsf(v[i].y)), fmaxf(fabsf(v[i].z), fabsf(v[i].w))));
        ss += v[i].x * v[i].x + v[i].y * v[i].y + v[i].z * v[i].z + v[i].w * v[i].w; }
    am = wave_max(am);
    const bool is_u = r < 16384; const int e = r & 16383;
    v4u q; float isc;
    if (is_u) {
        ss = wave_sum(ss);
        const float step = am > 0.f ? fminf(0.3352f * sqrtf(ss * (1.f / 2048.f)), am * (1.f / 7.5f)) : 1.f, inv = 1.f / step;
#pragma unroll
        for (int j = 0; j < 4; ++j) { unsigned w = 0;
#pragma unroll
            for (int t = 0; t < 8; ++t) { const float val = elem4(v[2 * j + (t >> 2)], t & 3);
                int n = (int)floorf(val * inv); n = n < -8 ? -8 : n > 7 ? 7 : n;
                w |= (unsigned)(n & 15) << (4 * t); }
            q[j] = w; }
        isc = step;
    } else {
        const float sc = am > 0.f ? 7.5f / am : 1.f;
#pragma unroll
        for (int j = 0; j < 4; ++j) { unsigned w = 0;
            w = __builtin_amdgcn_cvt_scalef32_pk_fp4_f32(w, clamp6(v[2 * j].x * sc), clamp6(v[2 * j].y * sc), 1.0f, 0);
            w = __builtin_amdgcn_cvt_scalef32_pk_fp4_f32(w, clamp6(v[2 * j].z * sc), clamp6(v[2 * j].w * sc), 1.0f, 1);
            w = __builtin_amdgcn_cvt_scalef32_pk_fp4_f32(w, clamp6(v[2 * j + 1].x * sc), clamp6(v[2 * j + 1].y * sc), 1.0f, 2);
            w = __builtin_amdgcn_cvt_scalef32_pk_fp4_f32(w, clamp6(v[2 * j + 1].z * sc), clamp6(v[2 * j + 1].w * sc), 1.0f, 3);
            q[j] = w; }
        isc = am > 0.f ? am / 7.5f : 1.f;
    }
    *(v4u*)(REC + (size_t)e * FP6_PITCH + (is_u ? 0 : 1024) + lane * 16) = q;
    if (lane == 0) ISC[2 * e + (is_u ? 0 : 1)] = isc;
}
#ifndef PEER_CVT_DEPTH4
#define PEER_CVT_DEPTH4 1
#endif
__device__ __forceinline__ void cvt_tables(const float* Uf, const float* Vf, unsigned char* REC, float* ISC, int first, int stride, int lane) {
#define PEER_SRC(r) ((r) < 16384 ? Uf : Vf), ((r) < 16384 ? (r) : (r) - 16384)
#if PEER_CVT_DEPTH4
    f32x4 va[8], vb[8], vc[8], vd[8];
    int r = first;
    if (r < 32768) cvt_row_load(PEER_SRC(r), lane, va);
    if (r + stride < 32768) cvt_row_load(PEER_SRC(r + stride), lane, vb);
    if (r + 2 * stride < 32768) cvt_row_load(PEER_SRC(r + 2 * stride), lane, vc);
#pragma unroll 1
    for (; r < 32768; r += 4 * stride) {
#define PEER_STEP(LD, ST, K) { const int rl_ = r + ((K) + 3) * stride, rs_ = r + (K) * stride; if (rl_ < 32768) cvt_row_load(PEER_SRC(rl_), lane, LD); __builtin_amdgcn_sched_barrier(0); \
            if (rs_ < 32768) cvt_row_store(ST, REC, ISC, rs_, lane); __builtin_amdgcn_sched_barrier(0); }
        PEER_STEP(vd, va, 0) PEER_STEP(va, vb, 1) PEER_STEP(vb, vc, 2) PEER_STEP(vc, vd, 3)
#undef PEER_STEP
    }
#else
    f32x4 va[8], vb[8];
    int r = first;
    if (r < 32768) cvt_row_load(PEER_SRC(r), lane, va);
#pragma unroll 1
    for (; r < 32768; r += 2 * stride) {
        const int r1 = r + stride, r2 = r + 2 * stride;
        if (r1 < 32768) cvt_row_load(PEER_SRC(r1), lane, vb);
        __builtin_amdgcn_sched_barrier(0);
        cvt_row_store(va, REC, ISC, r, lane);
        __builtin_amdgcn_sched_barrier(0);
        if (r2 < 32768) cvt_row_load(PEER_SRC(r2), lane, va);
        __builtin_amdgcn_sched_barrier(0);
        if (r1 < 32768) cvt_row_store(vb, REC, ISC, r1, lane);
        __builtin_amdgcn_sched_barrier(0);
    }
#endif
#undef PEER_SRC
}
__device__ __forceinline__ void ffn_token(int emask, bool fake, int n, int tl, int lane, const bf16* H, const float* SS, const unsigned char* REC, const float* ISC,
                                          float* out, __attribute__((address_space(3))) unsigned char* lds3) {
    const __attribute__((address_space(3))) float* gffn = (const __attribute__((address_space(3))) float*)(lds3 + L_GN);
    const __attribute__((address_space(3))) float* gfin = gffn + 2048;
    const __attribute__((address_space(3))) int* EX = (const __attribute__((address_space(3))) int*)(lds3 + L_EX);
    const __attribute__((address_space(3))) float* GT = (const __attribute__((address_space(3))) float*)(lds3 + L_GT);
    v2u hrow[8];
    unsigned xlo[4], xhi[4]; float sx, halfX;
    { const float rs_ = rsqrtf(SS[n] * (1.f / D_MODEL) + EPS);
      float xf[32]; float amx = 0.f;
#pragma unroll
      for (int i = 0; i < 8; ++i) { const v2u hw_ = *(const v2u*)(H + (size_t)n * 2048 + i * 256 + lane * 4); const f32x4 gv_ = *(const __attribute__((address_space(3))) f32x4*)(gffn + i * 256 + lane * 4);
            hrow[i] = hw_;
            xf[4 * i + 0] = bflo(hw_.x) * rs_ * gv_.x; xf[4 * i + 1] = bfhi(hw_.x) * rs_ * gv_.y; xf[4 * i + 2] = bflo(hw_.y) * rs_ * gv_.z; xf[4 * i + 3] = bfhi(hw_.y) * rs_ * gv_.w;
            amx = fmaxf(amx, fmaxf(fmaxf(fabsf(xf[4 * i + 0]), fabsf(xf[4 * i + 1])), fmaxf(fabsf(xf[4 * i + 2]), fabsf(xf[4 * i + 3])))); }
      amx = wave_max(amx);
      sx = amx > 0.f ? amx * (1.f / 119.f) : 1.f; const float isx = amx > 0.f ? 119.f / amx : 1.f;
      int xs = 0;
#pragma unroll
      for (int j = 0; j < 4; ++j) { unsigned wl = 0, wh = 0;
#pragma unroll
          for (int t = 0; t < 8; ++t) { const int q = (int)rintf(xf[8 * j + t] * isx); xs += q;
              const int q8 = q + 8;
              wl |= (unsigned)((q8 & 15) ^ 8) << (4 * t); wh |= (unsigned)((q8 >> 4) & 15) << (4 * t); }
          xlo[j] = wl; xhi[j] = wh; }
      halfX = 0.5f * wave_sum((float)xs); }
    v2f_t acc2[16];
#pragma unroll
    for (int j = 0; j < 16; ++j) acc2[j] = (v2f_t){0.f, 0.f};
    const bool b5 = (lane & 32) != 0, b4 = (lane & 16) != 0;
    v4u uaA[4], vaA[4], uaB[4], vaB[4]; v2f_t scA[4], scB[4]; float gtA[4], gtB[4];
#define PEER_LOADB(UA, VA, SC, GTV, E0) { _Pragma("unroll") for (int k = 0; k < 4; ++k) { \
        const int ei_ = __builtin_amdgcn_readfirstlane(EX[((E0) + k) * 32 + tl]) & emask; GTV[k] = GT[((E0) + k) * 32 + tl]; \
        const unsigned char* rec_ = REC + (size_t)ei_ * FP6_PITCH + lane * 16; \
        if (!(fake && PEER_FAKE_MODE == 2)) { UA[k] = *(const v4u*)rec_; VA[k] = *(const v4u*)(rec_ + 1024); SC[k] = *(const v2f_t*)(ISC + 2 * ei_); } \
        else { UA[k][0] ^= (unsigned)ei_; VA[k][1] += (unsigned)ei_; } } }
#define PEER_DEC(q, b) __builtin_amdgcn_cvt_scalef32_pk_f32_fp4(q, 1.0f, b)
#define PEER_EVALB(UA, VA, SC, GTV) if (fake && PEER_FAKE_MODE == 1) { _Pragma("unroll") for (int k = 0; k < 4; ++k) { \
            acc2[k].x += __uint_as_float((UA[k][0] ^ UA[k][1]) + (UA[k][2] ^ UA[k][3])) * SC[k].x; acc2[k].y += __uint_as_float((VA[k][0] ^ VA[k][1]) + (VA[k][2] ^ VA[k][3])) * GTV[k]; } } else { float d[4]; \
        _Pragma("unroll") for (int k = 0; k < 4; ++k) { int sh = 0, sl = 0; \
            _Pragma("unroll") for (int j = 0; j < 4; ++j) { sh = __builtin_amdgcn_sdot8((int)UA[k][j], (int)xhi[j], sh, false); sl = __builtin_amdgcn_sdot8((int)UA[k][j], (int)xlo[j], sl, false); } \
            d[k] = (float)(sh * 16 + sl); } \
        __builtin_amdgcn_sched_barrier(0); \
          \
        float t; { const auto r01 = __builtin_amdgcn_permlane32_swap(__float_as_uint(d[0]), __float_as_uint(d[1]), false, false); \
                   const auto r23 = __builtin_amdgcn_permlane32_swap(__float_as_uint(d[2]), __float_as_uint(d[3]), false, false); \
                   const float a01 = __uint_as_float(r01[0]) + __uint_as_float(r01[1]), a23 = __uint_as_float(r23[0]) + __uint_as_float(r23[1]); \
                   const auto rr = __builtin_amdgcn_permlane16_swap(__float_as_uint(a01), __float_as_uint(a23), false, false); \
                   t = row_sum16(__uint_as_float(rr[0]) + __uint_as_float(rr[1])); } \
        const float ius = b5 ? (b4 ? SC[3].x : SC[1].x) : (b4 ? SC[2].x : SC[0].x); \
        const float ivs = b5 ? (b4 ? SC[3].y : SC[1].y) : (b4 ? SC[2].y : SC[0].y); \
        const float gts = b5 ? (b4 ? GTV[3] : GTV[1]) : (b4 ? GTV[2] : GTV[0]); \
        const float wv = gts * gelu_tanh_fast((t + halfX) * (sx * ius)) * ivs; \
        float w[4]; \
        w[0] = __uint_as_float(__builtin_amdgcn_readlane(__float_as_uint(wv), 0)); w[2] = __uint_as_float(__builtin_amdgcn_readlane(__float_as_uint(wv), 16)); \
        w[1] = __uint_as_float(__builtin_amdgcn_readlane(__float_as_uint(wv), 32)); w[3] = __uint_as_float(__builtin_amdgcn_readlane(__float_as_uint(wv), 48)); \
        _Pragma("unroll") for (int k = 0; k < 4; ++k) { const v2f_t wk = {w[k], w[k]}; \
            _Pragma("unroll") for (int j = 0; j < 4; ++j) { const unsigned qw = VA[k][j]; \
                acc2[4 * j + 0] += wk * PEER_DEC(qw, 0); acc2[4 * j + 1] += wk * PEER_DEC(qw, 1); acc2[4 * j + 2] += wk * PEER_DEC(qw, 2); acc2[4 * j + 3] += wk * PEER_DEC(qw, 3); } \
            __builtin_amdgcn_sched_barrier(0); } }
    if (fake && PEER_FAKE_MODE == 2) {
#pragma unroll
        for (int k = 0; k < 4; ++k) { uaA[k] = (v4u){(unsigned)lane, 1u, 2u, 3u}; vaA[k] = uaA[k]; uaB[k] = uaA[k]; vaB[k] = uaA[k]; scA[k] = (v2f_t){1.f, 1.f}; scB[k] = scA[k]; } }
    PEER_LOADB(uaA, vaA, scA, gtA, 0)
#pragma unroll 1
    for (int e0 = 0; e0 < PEER_E; e0 += 8) {
        PEER_LOADB(uaB, vaB, scB, gtB, e0 + 4)
        __builtin_amdgcn_sched_barrier(0);
        PEER_EVALB(uaA, vaA, scA, gtA)
        __builtin_amdgcn_sched_barrier(0);
        { const int en = e0 + 8 < PEER_E ? e0 + 8 : 0;
          PEER_LOADB(uaA, vaA, scA, gtA, en) }
        __builtin_amdgcn_sched_barrier(0);
        PEER_EVALB(uaB, vaB, scB, gtB)
        __builtin_amdgcn_sched_barrier(0);
    }
#undef PEER_LOADB
#undef PEER_EVALB
#undef PEER_DEC
    float sq = 0.f;
#pragma unroll
    for (int i = 0; i < 8; ++i) { const v2u hw_ = hrow[i];
        acc2[2 * i].x += bflo(hw_.x); acc2[2 * i].y += bfhi(hw_.x); acc2[2 * i + 1].x += bflo(hw_.y); acc2[2 * i + 1].y += bfhi(hw_.y); }
#pragma unroll
    for (int j = 0; j < 16; ++j) sq += acc2[j].x * acc2[j].x + acc2[j].y * acc2[j].y;
    const float r_ = rsqrtf(wave_sum(sq) * (1.f / D_MODEL) + EPS);
    if (fake && r_ != 12345.678f) return;
#pragma unroll
    for (int i = 0; i < 8; ++i) { const f32x4 gv_ = *(const __attribute__((address_space(3))) f32x4*)(gfin + i * 256 + lane * 4);
        *(f32x4*)(out + (size_t)n * 2048 + i * 256 + lane * 4) = (f32x4){acc2[2 * i].x * r_ * gv_.x, acc2[2 * i].y * r_ * gv_.y, acc2[2 * i + 1].x * r_ * gv_.z, acc2[2 * i + 1].y * r_ * gv_.w}; }
}

#ifndef PEER_SLICED
#define PEER_SLICED 2
#endif
#ifndef PEER_SLICE_SHIFT_V
#define PEER_SLICE_SHIFT_V 10
#endif
constexpr int L_SCH = 49152, SCH_CAP = 384, PEER_SLICE_SHIFT = PEER_SLICE_SHIFT_V, L_PARK = 73728;
__device__ __forceinline__ int mbcnt64(unsigned long long m) { return __builtin_amdgcn_mbcnt_hi((unsigned)(m >> 32), __builtin_amdgcn_mbcnt_lo((unsigned)m, 0u)); }
__device__ __forceinline__ int build_schedule(int lane, int tl0, __attribute__((address_space(3))) unsigned char* lds3, __attribute__((address_space(3))) v2u* SCH) {
    const __attribute__((address_space(3))) int* EX = (const __attribute__((address_space(3))) int*)(lds3 + L_EX);
    const __attribute__((address_space(3))) float* GT = (const __attribute__((address_space(3))) float*)(lds3 + L_GT);
    int e00 = EX[lane * 32 + tl0], e01 = EX[(lane + 64) * 32 + tl0], e10 = EX[lane * 32 + tl0 + 1], e11 = EX[(lane + 64) * 32 + tl0 + 1];
    const unsigned g00 = __float_as_uint(GT[lane * 32 + tl0]), g01 = __float_as_uint(GT[(lane + 64) * 32 + tl0]), g10 = __float_as_uint(GT[lane * 32 + tl0 + 1]), g11 = __float_as_uint(GT[(lane + 64) * 32 + tl0 + 1]);
    int run = 0;
#pragma unroll 1
    for (int b = 0; b < (16384 >> PEER_SLICE_SHIFT); ++b) {
        const bool h00 = (e00 >> PEER_SLICE_SHIFT) == b, h01 = (e01 >> PEER_SLICE_SHIFT) == b, h10 = (e10 >> PEER_SLICE_SHIFT) == b, h11 = (e11 >> PEER_SLICE_SHIFT) == b;
        const unsigned long long m00 = __ballot(h00), m01 = __ballot(h01), m10 = __ballot(h10), m11 = __ballot(h11);
        const int c00 = __popcll(m00), c0 = c00 + __popcll(m01), c10 = __popcll(m10), c1 = c10 + __popcll(m11);
        const int p0 = (c0 + 3) & ~3, p1 = (c1 + 3) & ~3, o0 = run, o1 = run + p0;
        run += p0 + p1;
        if (h00) SCH[o0 + mbcnt64(m00)] = (v2u){(unsigned)e00, g00};
        if (h01) SCH[o0 + c00 + mbcnt64(m01)] = (v2u){(unsigned)e01, g01};
        if (h10) SCH[o1 + mbcnt64(m10)] = (v2u){(unsigned)e10 | 0x10000u, g10};
        if (h11) SCH[o1 + c10 + mbcnt64(m11)] = (v2u){(unsigned)e11 | 0x10000u, g11};
        if (lane < p0 - c0) SCH[o0 + c0 + lane] = (v2u){(unsigned)(b << PEER_SLICE_SHIFT), 0u};
        if (lane < p1 - c1) SCH[o1 + c1 + lane] = (v2u){(unsigned)(b << PEER_SLICE_SHIFT) | 0x10000u, 0u};
    }
    return run >> 2;
}
struct TokX { unsigned xlo[4], xhi[4]; float sx, halfX; };
__device__ __forceinline__ void token_prologue(int n, int lane, const bf16* H, const float* SS, const __attribute__((address_space(3))) float* gffn, TokX& X) {
    const float rs_ = rsqrtf(SS[n] * (1.f / D_MODEL) + EPS);
    float xf[32]; float amx = 0.f;
#pragma unroll
    for (int i = 0; i < 8; ++i) { const v2u hw_ = *(const v2u*)(H + (size_t)n * 2048 + i * 256 + lane * 4); const f32x4 gv_ = *(const __attribute__((address_space(3))) f32x4*)(gffn + i * 256 + lane * 4);
        xf[4 * i + 0] = bflo(hw_.x) * rs_ * gv_.x; xf[4 * i + 1] = bfhi(hw_.x) * rs_ * gv_.y; xf[4 * i + 2] = bflo(hw_.y) * rs_ * gv_.z; xf[4 * i + 3] = bfhi(hw_.y) * rs_ * gv_.w;
        amx = fmaxf(amx, fmaxf(fmaxf(fabsf(xf[4 * i + 0]), fabsf(xf[4 * i + 1])), fmaxf(fabsf(xf[4 * i + 2]), fabsf(xf[4 * i + 3])))); }
    amx = wave_max(amx);
    X.sx = amx > 0.f ? amx * (1.f / 119.f) : 1.f; const float isx = amx > 0.f ? 119.f / amx : 1.f;
    int xs = 0;
#pragma unroll
    for (int j = 0; j < 4; ++j) { unsigned wl = 0, wh = 0;
#pragma unroll
        for (int t = 0; t < 8; ++t) { const int q = (int)rintf(xf[8 * j + t] * isx); xs += q;
            const int q8 = q + 8;
            wl |= (unsigned)((q8 & 15) ^ 8) << (4 * t); wh |= (unsigned)((q8 >> 4) & 15) << (4 * t); }
        X.xlo[j] = wl; X.xhi[j] = wh; }
    X.halfX = 0.5f * wave_sum((float)xs);
}
__device__ __forceinline__ void token_epilogue(int n, int lane, const bf16* H, const __attribute__((address_space(3))) float* gfin, v2f_t (&acc2)[16], float* out) {
    float sq = 0.f;
#pragma unroll
    for (int i = 0; i < 8; ++i) { const v2u hw_ = __builtin_nontemporal_load((const v2u*)(H + (size_t)n * 2048 + i * 256 + lane * 4));
        acc2[2 * i].x += bflo(hw_.x); acc2[2 * i].y += bfhi(hw_.x); acc2[2 * i + 1].x += bflo(hw_.y); acc2[2 * i + 1].y += bfhi(hw_.y); }
#pragma unroll
    for (int j = 0; j < 16; ++j) sq += acc2[j].x * acc2[j].x + acc2[j].y * acc2[j].y;
    const float r_ = rsqrtf(wave_sum(sq) * (1.f / D_MODEL) + EPS);
#pragma unroll
    for (int i = 0; i < 8; ++i) { const f32x4 gv_ = *(const __attribute__((address_space(3))) f32x4*)(gfin + i * 256 + lane * 4);
        __builtin_nontemporal_store((f32x4){acc2[2 * i].x * r_ * gv_.x, acc2[2 * i].y * r_ * gv_.y, acc2[2 * i + 1].x * r_ * gv_.z, acc2[2 * i + 1].y * r_ * gv_.w}, (f32x4*)(out + (size_t)n * 2048 + i * 256 + lane * 4)); }
}
__device__ __forceinline__ void ffn_pair(bool fake, int n0, int tl0, int lane, int wid, const bf16* H, const float* SS, const unsigned char* REC, const float* ISC, float* out, __attribute__((address_space(3))) unsigned char* lds3) {
    const __attribute__((address_space(3))) float* gffn = (const __attribute__((address_space(3))) float*)(lds3 + L_GN);
    const __attribute__((address_space(3))) float* gfin = gffn + 2048;
    __attribute__((address_space(3))) v2u* SCH = (__attribute__((address_space(3))) v2u*)(lds3 + L_SCH) + wid * SCH_CAP;
    const int nb = __builtin_amdgcn_readfirstlane(build_schedule(lane, tl0, lds3, SCH));
    TokX X0, X1;
    token_prologue(n0, lane, H, SS, gffn, X0);
    token_prologue(n0 + 1, lane, H, SS, gffn, X1);
    __attribute__((address_space(3))) f32x4* PARK = (__attribute__((address_space(3))) f32x4*)(lds3 + L_PARK) + wid * 512;
    v2f_t acc[16]; int cur = 0;
#pragma unroll
    for (int j = 0; j < 16; ++j) acc[j] = (v2f_t){0.f, 0.f};
#pragma unroll
    for (int j = 0; j < 8; ++j) PARK[j * 64 + lane] = (f32x4){0.f, 0.f, 0.f, 0.f};
    const bool b5 = (lane & 32) != 0, b4 = (lane & 16) != 0;
    v4u uaA[4], vaA[4], uaB[4], vaB[4]; v2f_t scA[4], scB[4]; float gtA[4], gtB[4]; int tkA, tkB;
#define PEER_LOADB(UA, VA, SC, GTV, TK, BI) { _Pragma("unroll") for (int k = 0; k < 4; ++k) { const v2u en_ = SCH[4 * (BI) + k]; \
        const int ek_ = __builtin_amdgcn_readfirstlane((int)en_.x); if (k == 0) TK = ek_ >> 16; GTV[k] = __uint_as_float(en_.y); \
        const int ei_ = fake ? (ek_ & 0xffff & PEER_FAKE_EMASK) : (ek_ & 0xffff); const unsigned char* rec_ = REC + (size_t)ei_ * FP6_PITCH + lane * 16; \
        if (!(fake && PEER_FAKE_MODE == 2)) { UA[k] = *(const v4u*)rec_; VA[k] = *(const v4u*)(rec_ + 1024); SC[k] = *(const v2f_t*)(ISC + 2 * ei_); } \
        else { UA[k][0] ^= (unsigned)ei_; VA[k][1] += (unsigned)ei_; } } }
#define PEER_DEC(q, b) __builtin_amdgcn_cvt_scalef32_pk_f32_fp4(q, 1.0f, b)
#define PEER_VSIDE(VA, ACC) { _Pragma("unroll") for (int k = 0; k < 4; ++k) { const v2f_t wk = {w[k], w[k]}; \
            _Pragma("unroll") for (int j = 0; j < 4; ++j) { const unsigned qw = VA[k][j]; \
                ACC[4 * j + 0] += wk * PEER_DEC(qw, 0); ACC[4 * j + 1] += wk * PEER_DEC(qw, 1); ACC[4 * j + 2] += wk * PEER_DEC(qw, 2); ACC[4 * j + 3] += wk * PEER_DEC(qw, 3); } \
            __builtin_amdgcn_sched_barrier(0); } }
#define PEER_EVALB(UA, VA, SC, GTV, TK) if (fake && PEER_FAKE_MODE == 1) { _Pragma("unroll") for (int k = 0; k < 4; ++k) { \
            acc[k].x += __uint_as_float((UA[k][0] ^ UA[k][1]) + (UA[k][2] ^ UA[k][3])) * SC[k].x; acc[k].y += __uint_as_float((VA[k][0] ^ VA[k][1]) + (VA[k][2] ^ VA[k][3])) * GTV[k]; } } else { float d[4]; const bool t1_ = (TK) != 0; \
        unsigned xh_[4], xl_[4]; _Pragma("unroll") for (int j = 0; j < 4; ++j) { xh_[j] = t1_ ? X1.xhi[j] : X0.xhi[j]; xl_[j] = t1_ ? X1.xlo[j] : X0.xlo[j]; } \
        const float hx_ = t1_ ? X1.halfX : X0.halfX, sx_ = t1_ ? X1.sx : X0.sx; \
        _Pragma("unroll") for (int k = 0; k < 4; ++k) { int sh = 0, sl = 0; \
            _Pragma("unroll") for (int j = 0; j < 4; ++j) { sh = __builtin_amdgcn_sdot8((int)UA[k][j], (int)xh_[j], sh, false); sl = __builtin_amdgcn_sdot8((int)UA[k][j], (int)xl_[j], sl, false); } \
            d[k] = (float)(sh * 16 + sl); } \
        __builtin_amdgcn_sched_barrier(0); \
        float t; { const auto r01 = __builtin_amdgcn_permlane32_swap(__float_as_uint(d[0]), __float_as_uint(d[1]), false, false); \
                   const auto r23 = __builtin_amdgcn_permlane32_swap(__float_as_uint(d[2]), __float_as_uint(d[3]), false, false); \
                   const float a01 = __uint_as_float(r01[0]) + __uint_as_float(r01[1]), a23 = __uint_as_float(r23[0]) + __uint_as_float(r23[1]); \
                   const auto rr = __builtin_amdgcn_permlane16_swap(__float_as_uint(a01), __float_as_uint(a23), false, false); \
                   t = row_sum16(__uint_as_float(rr[0]) + __uint_as_float(rr[1])); } \
        const float ius = b5 ? (b4 ? SC[3].x : SC[1].x) : (b4 ? SC[2].x : SC[0].x); \
        const float ivs = b5 ? (b4 ? SC[3].y : SC[1].y) : (b4 ? SC[2].y : SC[0].y); \
        const float gts = b5 ? (b4 ? GTV[3] : GTV[1]) : (b4 ? GTV[2] : GTV[0]); \
        const float wv = gts * gelu_tanh_fast((t + hx_) * (sx_ * ius)) * ivs; \
        float w[4]; \
        w[0] = __uint_as_float(__builtin_amdgcn_readlane(__float_as_uint(wv), 0)); w[2] = __uint_as_float(__builtin_amdgcn_readlane(__float_as_uint(wv), 16)); \
        w[1] = __uint_as_float(__builtin_amdgcn_readlane(__float_as_uint(wv), 32)); w[3] = __uint_as_float(__builtin_amdgcn_readlane(__float_as_uint(wv), 48)); \
        __builtin_amdgcn_sched_barrier(0); \
        if ((TK) != cur) {            \
            _Pragma("unroll") for (int j = 0; j < 8; ++j) { const f32x4 o_ = PARK[j * 64 + lane]; PARK[j * 64 + lane] = (f32x4){acc[2 * j].x, acc[2 * j].y, acc[2 * j + 1].x, acc[2 * j + 1].y}; \
                acc[2 * j] = (v2f_t){o_.x, o_.y}; acc[2 * j + 1] = (v2f_t){o_.z, o_.w}; } \
            cur = (TK); } \
        PEER_VSIDE(VA, acc) }
    if (fake && PEER_FAKE_MODE == 2) {
#pragma unroll
        for (int k = 0; k < 4; ++k) { uaA[k] = (v4u){(unsigned)lane, 1u, 2u, 3u}; vaA[k] = uaA[k]; uaB[k] = uaA[k]; vaB[k] = uaA[k]; scA[k] = (v2f_t){1.f, 1.f}; scB[k] = scA[k]; } }
    PEER_LOADB(uaA, vaA, scA, gtA, tkA, 0)
#pragma unroll 1
    for (int i = 0; i < nb; i += 2) {
        { const int bn = i + 1 < nb ? i + 1 : nb - 1; PEER_LOADB(uaB, vaB, scB, gtB, tkB, bn) }
        __builtin_amdgcn_sched_barrier(0);
        PEER_EVALB(uaA, vaA, scA, gtA, tkA)
        __builtin_amdgcn_sched_barrier(0);
        { const int bn = i + 2 < nb ? i + 2 : nb - 1; PEER_LOADB(uaA, vaA, scA, gtA, tkA, bn) }
        __builtin_amdgcn_sched_barrier(0);
        if (i + 1 < nb) { PEER_EVALB(uaB, vaB, scB, gtB, tkB) }
        __builtin_amdgcn_sched_barrier(0);
    }
#undef PEER_LOADB
#undef PEER_EVALB
#undef PEER_VSIDE
#undef PEER_DEC
    if (fake) { float sq_ = 0.f;
#pragma unroll
        for (int j = 0; j < 16; ++j) sq_ += acc[j].x + acc[j].y;
        if (sq_ != 12345.678f) return; }
    token_epilogue(n0 + cur, lane, H, gfin, acc, out);
#pragma unroll
    for (int j = 0; j < 8; ++j) { const f32x4 o_ = PARK[j * 64 + lane]; acc[2 * j] = (v2f_t){o_.x, o_.y}; acc[2 * j + 1] = (v2f_t){o_.z, o_.w}; }
    token_epilogue(n0 + 1 - cur, lane, H, gfin, acc, out);
}

#ifndef PEER_SYNC_SLICES
#define PEER_SYNC_SLICES 0
#endif
constexpr int SCH4_CAP = 704, L_PARK4B = L_SCH + NWAVES * SCH4_CAP * 8;
static_assert(L_PARK4B + 16 * 4096 <= 162816, "LDS overflow");
__device__ __forceinline__ int build_schedule4(int lane, int tl0, __attribute__((address_space(3))) unsigned char* lds3, __attribute__((address_space(3))) v2u* SCH) {
    const __attribute__((address_space(3))) int* EX = (const __attribute__((address_space(3))) int*)(lds3 + L_EX);
    const __attribute__((address_space(3))) float* GT = (const __attribute__((address_space(3))) float*)(lds3 + L_GT);
    int e[4][2]; unsigned g[4][2];
#pragma unroll
    for (int t = 0; t < 4; ++t)
#pragma unroll
        for (int h = 0; h < 2; ++h) { e[t][h] = EX[(lane + 64 * h) * 32 + tl0 + t]; g[t][h] = __float_as_uint(GT[(lane + 64 * h) * 32 + tl0 + t]); }
    int run = 0;
#define PEER_RUN(T, SA, SB, PADR) { const int s0_ = e[T][0] >> PEER_SLICE_SHIFT, s1_ = e[T][1] >> PEER_SLICE_SHIFT; const bool h0_ = s0_ == (SA) || s0_ == (SB), h1_ = s1_ == (SA) || s1_ == (SB); \
        const unsigned long long m0_ = __ballot(h0_), m1_ = __ballot(h1_); const int c0_ = __popcll(m0_), c_ = c0_ + __popcll(m1_), p_ = (c_ + 3) & ~3; \
        if (h0_) SCH[run + mbcnt64(m0_)] = (v2u){(unsigned)e[T][0] | ((unsigned)(T) << 16), g[T][0]}; \
        if (h1_) SCH[run + c0_ + mbcnt64(m1_)] = (v2u){(unsigned)e[T][1] | ((unsigned)(T) << 16), g[T][1]}; \
        if (lane < p_ - c_) SCH[run + c_ + lane] = (v2u){(unsigned)(PADR) | ((unsigned)(T) << 16), 0u}; \
        run += p_; }
#pragma unroll 1
    for (int s = 0; s < (16384 >> PEER_SLICE_SHIFT); s += 2) {
        const int pad0 = s << PEER_SLICE_SHIFT, pad1 = (s + 1) << PEER_SLICE_SHIFT;
        if (lane == 0) SCH[SCH4_CAP - 8 + (s >> 1)] = (v2u){(unsigned)(run >> 2), 0u};
        PEER_RUN(0, s - 1, s, pad0)
        PEER_RUN(1, s, s, pad0)
        PEER_RUN(2, s, s, pad0)
        PEER_RUN(3, s, s + 1, pad1)
        PEER_RUN(2, s + 1, s + 1, pad1)
        PEER_RUN(1, s + 1, s + 1, pad1)
    }
    PEER_RUN(0, (16384 >> PEER_SLICE_SHIFT) - 1, (16384 >> PEER_SLICE_SHIFT) - 1, 16383)
#undef PEER_RUN
    return run >> 2;
}
__device__ __forceinline__ void ffn_quad(bool fake, int n0, int tl0, int lane, int wid, const bf16* H, const float* SS, const unsigned char* REC, const float* ISC, float* out, __attribute__((address_space(3))) unsigned char* lds3) {
    const __attribute__((address_space(3))) float* gffn = (const __attribute__((address_space(3))) float*)(lds3 + L_GN);
    const __attribute__((address_space(3))) float* gfin = gffn + 2048;
    __attribute__((address_space(3))) v2u* SCH = (__attribute__((address_space(3))) v2u*)(lds3 + L_SCH) + wid * SCH4_CAP;
    const int nb = __builtin_amdgcn_readfirstlane(build_schedule4(lane, tl0, lds3, SCH));
    TokX X0, X1, X2, X3;
    token_prologue(n0, lane, H, SS, gffn, X0); token_prologue(n0 + 1, lane, H, SS, gffn, X1); token_prologue(n0 + 2, lane, H, SS, gffn, X2); token_prologue(n0 + 3, lane, H, SS, gffn, X3);
    __syncthreads();
#define PEER_PSLOT(q) ((__attribute__((address_space(3))) v4u*)(lds3 + ((q) < 8 ? (q) * 4096 : L_PARK4B + ((q) - 8) * 4096)) + lane)
    TokX Xc = X0;
    v2f_t acc[16]; int cur = 0; unsigned pmap = ((unsigned)(3 * wid) << 8) | ((unsigned)(3 * wid + 1) << 16) | ((unsigned)(3 * wid + 2) << 24);
#pragma unroll
    for (int j = 0; j < 16; ++j) acc[j] = (v2f_t){0.f, 0.f};
    if (!fake)
#pragma unroll
    for (int q = 0; q < 3; ++q) { __attribute__((address_space(3))) v4u* ps_ = PEER_PSLOT(3 * wid + q);
#pragma unroll
        for (int j = 0; j < 4; ++j) ps_[j * 64] = (v4u){0u, 0u, 0u, 0u}; }
    const bool b5 = (lane & 32) != 0, b4 = (lane & 16) != 0;
    v4u uaA[4], vaA[4], uaB[4], vaB[4]; v2f_t scA[4], scB[4]; float gtA[4], gtB[4]; int tkA, tkB;
#define PEER_LOADB(UA, VA, SC, GTV, TK, BI) { _Pragma("unroll") for (int k = 0; k < 4; ++k) { const v2u en_ = SCH[4 * (BI) + k]; \
        const int ek_ = __builtin_amdgcn_readfirstlane((int)en_.x); if (k == 0) TK = ek_ >> 16; GTV[k] = __uint_as_float(en_.y); \
        const int ei_ = fake ? (ek_ & 0xffff & PEER_FAKE_EMASK) : (ek_ & 0xffff); const unsigned char* rec_ = REC + (size_t)ei_ * FP6_PITCH + lane * 16; \
        if (!(fake && PEER_FAKE_MODE == 2)) { UA[k] = *(const v4u*)rec_; VA[k] = *(const v4u*)(rec_ + 1024); SC[k] = *(const v2f_t*)(ISC + 2 * ei_); } \
        else { UA[k][0] ^= (unsigned)ei_; VA[k][1] += (unsigned)ei_; } } }
#define PEER_DEC(q, b) __builtin_amdgcn_cvt_scalef32_pk_f32_fp4(q, 1.0f, b)
#define PEER_SEL4(F) (t2_ ? (t1_ ? X3.F : X2.F) : (t1_ ? X1.F : X0.F))
#define PEER_UNPARK(PS) { _Pragma("unroll") for (int j = 0; j < 4; ++j) { const v4u o_ = (PS)[j * 64]; \
        acc[4 * j + 0] = (v2f_t){bflo(o_.x), bfhi(o_.x)}; acc[4 * j + 1] = (v2f_t){bflo(o_.y), bfhi(o_.y)}; acc[4 * j + 2] = (v2f_t){bflo(o_.z), bfhi(o_.z)}; acc[4 * j + 3] = (v2f_t){bflo(o_.w), bfhi(o_.w)}; } }
#define PEER_EVALB(UA, VA, SC, GTV, TK) if (fake && PEER_FAKE_MODE == 1) { _Pragma("unroll") for (int k = 0; k < 4; ++k) { \
            acc[k].x += __uint_as_float((UA[k][0] ^ UA[k][1]) + (UA[k][2] ^ UA[k][3])) * SC[k].x; acc[k].y += __uint_as_float((VA[k][0] ^ VA[k][1]) + (VA[k][2] ^ VA[k][3])) * GTV[k]; } } else { float d[4]; \
        const bool t1_ = ((TK) & 1) != 0, t2_ = ((TK) & 2) != 0; \
        if (!fake && (TK) != cur) {            \
            const int q_ = (int)((pmap >> (8 * (TK))) & 255u); __attribute__((address_space(3))) v4u* ps_ = PEER_PSLOT(q_); \
            _Pragma("unroll") for (int j = 0; j < 4; ++j) { const v4u o_ = ps_[j * 64]; \
                ps_[j * 64] = (v4u){pg8::cvt_pk_bf16(acc[4 * j].x, acc[4 * j].y), pg8::cvt_pk_bf16(acc[4 * j + 1].x, acc[4 * j + 1].y), pg8::cvt_pk_bf16(acc[4 * j + 2].x, acc[4 * j + 2].y), pg8::cvt_pk_bf16(acc[4 * j + 3].x, acc[4 * j + 3].y)}; \
                acc[4 * j + 0] = (v2f_t){bflo(o_.x), bfhi(o_.x)}; acc[4 * j + 1] = (v2f_t){bflo(o_.y), bfhi(o_.y)}; acc[4 * j + 2] = (v2f_t){bflo(o_.z), bfhi(o_.z)}; acc[4 * j + 3] = (v2f_t){bflo(o_.w), bfhi(o_.w)}; } \
            pmap = (pmap & ~(255u << (8 * cur))) | ((unsigned)q_ << (8 * cur)); cur = (TK); \
            _Pragma("unroll") for (int j = 0; j < 4; ++j) { Xc.xhi[j] = PEER_SEL4(xhi[j]); Xc.xlo[j] = PEER_SEL4(xlo[j]); } Xc.halfX = PEER_SEL4(halfX); Xc.sx = PEER_SEL4(sx); } \
        _Pragma("unroll") for (int k = 0; k < 4; ++k) { int sh = 0, sl = 0; \
            _Pragma("unroll") for (int j = 0; j < 4; ++j) { sh = __builtin_amdgcn_sdot8((int)UA[k][j], (int)Xc.xhi[j], sh, false); sl = __builtin_amdgcn_sdot8((int)UA[k][j], (int)Xc.xlo[j], sl, false); } \
            d[k] = (float)(sh * 16 + sl); } \
        __builtin_amdgcn_sched_barrier(0); \
        float t; { const auto r01 = __builtin_amdgcn_permlane32_swap(__float_as_uint(d[0]), __float_as_uint(d[1]), false, false); \
                   const auto r23 = __builtin_amdgcn_permlane32_swap(__float_as_uint(d[2]), __float_as_uint(d[3]), false, false); \
                   const float a01 = __uint_as_float(r01[0]) + __uint_as_float(r01[1]), a23 = __uint_as_float(r23[0]) + __uint_as_float(r23[1]); \
                   const auto rr = __builtin_amdgcn_permlane16_swap(__float_as_uint(a01), __float_as_uint(a23), false, false); \
                   t = row_sum16(__uint_as_float(rr[0]) + __uint_as_float(rr[1])); } \
        const float ius = b5 ? (b4 ? SC[3].x : SC[1].x) : (b4 ? SC[2].x : SC[0].x); \
        const float ivs = b5 ? (b4 ? SC[3].y : SC[1].y) : (b4 ? SC[2].y : SC[0].y); \
        const float gts = b5 ? (b4 ? GTV[3] : GTV[1]) : (b4 ? GTV[2] : GTV[0]); \
        const float wv = gts * gelu_tanh_fast((t + Xc.halfX) * (Xc.sx * ius)) * ivs; \
        float w[4]; \
        w[0] = __uint_as_float(__builtin_amdgcn_readlane(__float_as_uint(wv), 0)); w[2] = __uint_as_float(__builtin_amdgcn_readlane(__float_as_uint(wv), 16)); \
        w[1] = __uint_as_float(__builtin_amdgcn_readlane(__float_as_uint(wv), 32)); w[3] = __uint_as_float(__builtin_amdgcn_readlane(__float_as_uint(wv), 48)); \
        __builtin_amdgcn_sched_barrier(0); \
        _Pragma("unroll") for (int k = 0; k < 4; ++k) { const v2f_t wk = {w[k], w[k]}; \
            _Pragma("unroll") for (int j = 0; j < 4; ++j) { const unsigned qw = VA[k][j]; \
                acc[4 * j + 0] += wk * PEER_DEC(qw, 0); acc[4 * j + 1] += wk * PEER_DEC(qw, 1); acc[4 * j + 2] += wk * PEER_DEC(qw, 2); acc[4 * j + 3] += wk * PEER_DEC(qw, 3); } \
            __builtin_amdgcn_sched_barrier(0); } }
    if (fake && PEER_FAKE_MODE == 2) {
#pragma unroll
        for (int k = 0; k < 4; ++k) { uaA[k] = (v4u){(unsigned)lane, 1u, 2u, 3u}; vaA[k] = uaA[k]; uaB[k] = uaA[k]; vaB[k] = uaA[k]; scA[k] = (v2f_t){1.f, 1.f}; scB[k] = scA[k]; } }
    PEER_LOADB(uaA, vaA, scA, gtA, tkA, 0)
    int kb = 1, nbnd = PEER_SYNC_SLICES ? __builtin_amdgcn_readfirstlane((int)SCH[SCH4_CAP - 8 + 1].x) : 0x7fffffff;
#pragma unroll 1
    for (int i = 0; i < nb; i += 2) {
#if PEER_SYNC_SLICES
        while (i >= nbnd) { __builtin_amdgcn_s_barrier(); ++kb; nbnd = kb < 8 ? __builtin_amdgcn_readfirstlane((int)SCH[SCH4_CAP - 8 + (kb & 7)].x) : 0x7fffffff; }
#endif
        { const int bn = i + 1 < nb ? i + 1 : nb - 1; PEER_LOADB(uaB, vaB, scB, gtB, tkB, bn) }
        __builtin_amdgcn_sched_barrier(0);
        PEER_EVALB(uaA, vaA, scA, gtA, tkA)
        __builtin_amdgcn_sched_barrier(0);
        { const int bn = i + 2 < nb ? i + 2 : nb - 1; PEER_LOADB(uaA, vaA, scA, gtA, tkA, bn) }
        __builtin_amdgcn_sched_barrier(0);
        if (i + 1 < nb) { PEER_EVALB(uaB, vaB, scB, gtB, tkB) }
        __builtin_amdgcn_sched_barrier(0);
    }
#if PEER_SYNC_SLICES
    while (kb < 8) { __builtin_amdgcn_s_barrier(); ++kb; }
#endif
    if (fake) { float sq_ = 0.f;
#pragma unroll
        for (int j = 0; j < 16; ++j) sq_ += acc[j].x + acc[j].y;
        if (sq_ != 12345.678f) return; }
    token_epilogue(n0 + cur, lane, H, gfin, acc, out);
#pragma unroll 1
    for (int t = 0; t < 4; ++t) if (t != cur) { const int q_ = (int)((pmap >> (8 * t)) & 255u); __attribute__((address_space(3))) v4u* ps_ = PEER_PSLOT(q_);
        PEER_UNPARK(ps_)
        token_epilogue(n0 + t, lane, H, gfin, acc, out); }
#undef PEER_LOADB
#undef PEER_EVALB
#undef PEER_DEC
#undef PEER_SEL4
#undef PEER_UNPARK
#undef PEER_PSLOT
}

__device__ __forceinline__ void peer_phase(const bf16* QP, const bf16* SKB, const bf16* H, const float* SS, const float* gffn, const unsigned char* REC, const float* ISC,
                                           const float* gfin, float* out, __attribute__((address_space(3))) unsigned char* lds3, int bid, int G) {
    int tid = threadIdx.x; asm volatile("" : "+v"(tid));
    const int lane = tid & 63, wid = __builtin_amdgcn_readfirstlane(tid >> 6);
    { __attribute__((address_space(3))) float* gl = (__attribute__((address_space(3))) float*)(lds3 + L_GN);
      for (int i = tid; i < 2048; i += NTHR) { gl[i] = gffn[i]; gl[2048 + i] = gfin[i]; } }
    for (int unit = bid; unit < NTOK / 32; unit += G) {
        const int tok0 = unit * 32;
        route_head(QP, SKB, wid, tok0, lane, lds3);
        asm volatile("s_waitcnt lgkmcnt(0)" ::: "memory"); __syncthreads();
        { int ln = lane; asm volatile("" : "+v"(ln));
#if PEER_SLICED == 2
#if PEER_FAKE
          ffn_quad(true, tok0 + wid * 4, wid * 4, ln, wid, H, SS, REC, ISC, out, lds3);
          __syncthreads();
#endif
          ffn_quad(false, tok0 + wid * 4, wid * 4, ln, wid, H, SS, REC, ISC, out, lds3);
#elif PEER_SLICED
#pragma unroll 1
#if PEER_FAKE
          for (int rd = 0; rd < 2; ++rd) ffn_pair(true, tok0 + wid * 4 + 2 * rd, wid * 4 + 2 * rd, ln, wid, H, SS, REC, ISC, out, lds3);
#pragma unroll 1
#endif
          for (int rd = 0; rd < 2; ++rd) ffn_pair(false, tok0 + wid * 4 + 2 * rd, wid * 4 + 2 * rd, ln, wid, H, SS, REC, ISC, out, lds3);
#else
#if PEER_FAKE
#pragma unroll 1
          for (int tk = 0; tk < 4; ++tk) ffn_token(PEER_FAKE, true, tok0 + wid * 4 + tk, wid * 4 + tk, ln, H, SS, REC, ISC, out, lds3);
#endif
#pragma unroll 1
          for (int tk = 0; tk < 4; ++tk) ffn_token(0xffffff, false, tok0 + wid * 4 + tk, wid * 4 + tk, ln, H, SS, REC, ISC, out, lds3);
#endif
        }
        __syncthreads();
    }
}
#undef PEER_CE
}
constexpr int RING_BYTES = 131072, LDS_BYTES = 163840, LDSCTL_OFF = LDS_BYTES - 1024, MISC_OFF = LDSCTL_OFF + 320;
constexpr int N_PHASES = 8;
#ifndef PG8_SP2_SMALL
#define PG8_SP2_SMALL true
#endif
#ifndef MK_N_LAUNCHES
#define MK_N_LAUNCHES 1
#endif

__global__ void __launch_bounds__(NTHR, 2) fwd_megakernel(Args args) {
    extern __shared__ __attribute__((aligned(16))) unsigned char lds[];
    LAS unsigned char* lds3 = (LAS unsigned char*)lds;
    int tid_ = threadIdx.x; asm volatile("" : "+v"(tid_));
    const int tid = tid_, lane = tid & 63, wave = __builtin_amdgcn_readfirstlane(tid >> 6);
    const int G = gridDim.x, bid = blockIdx.x;
    unsigned char* ws = args.ws;
    unsigned* ctl = (unsigned*)(ws + WS_CTL);
    const float* x = args.in[0];
    bf16* WinT = (bf16*)(ws + WS_WIN); bf16* WbnT = (bf16*)(ws + WS_WBN); bf16* WbsT = (bf16*)(ws + WS_WBS); bf16* WoutT = (bf16*)(ws + WS_WOUT); bf16* WpqT = (bf16*)(ws + WS_WPQ);
    bf16* XN = (bf16*)(ws + WS_XN); bf16* MERGED = XN; bf16* PROJ = (bf16*)(ws + WS_PROJ);
    bf16* ONSA = (bf16*)(ws + WS_ONSA); bf16* OSB = (bf16*)(ws + WS_OSB);
    float* H = (float*)(ws + WS_H); bf16* HB = (bf16*)(ws + WS_HB);
    unsigned char* REC = ws + WS_UB; float* ISC = (float*)(ws + WS_UB + 48 * MiB); bf16* QP = (bf16*)(ws + WS_QP);
    int* EXPERT = (int*)(ws + WS_EXP); float* GATE = (float*)(ws + WS_GATE);
    bf16* KCB = (bf16*)(ws + WS_MISC + MISC_KCB); bf16* VCB = (bf16*)(ws + WS_MISC + MISC_VCB);
    float* SS = (float*)(ctl + CW_SS);
    float* BTG = (float*)(ws + WS_MISC + MISC_B1 + 4096);
    bf16* W1T = (bf16*)(ws + WS_MISC + MISC_W1T); float* BIAS1 = (float*)(ws + WS_MISC + MISC_B1);
    bf16* SKB = (bf16*)(ws + WS_MISC + MISC_SKB);

    for (int u = tid; u < (LDS_BYTES - LDSCTL_OFF) / 4; u += NTHR) ((LAS unsigned*)(lds3 + LDSCTL_OFF))[u] = 0u;
    __syncthreads();
    const int lo = args.ph_lo, hi = args.ph_hi;
    XcdBarrier bar; bar.bar = ctl + CW_BAR; bar.x = 0; bar.st = nullptr;
    if (hi - lo > 1) bar = xcd_barrier_post(ctl + CW_BAR, (volatile LAS unsigned*)(lds3 + MISC_OFF) + 8);
#define IN(k) (lo <= (k) && (k) < hi)
#ifndef REP_BAR
#define REP_BAR 1
#endif
#define SEAM(k) do { if (IN(k) && IN((k) + 1)) for (int rb_ = 0; rb_ < REP_BAR; ++rb_) xcd_barrier(bar); } while (0)
    const int gw = bid * NWAVES + wave, NGW = G * NWAVES;
    const int vcu = (G % 8 == 0) ? (bid % 8) * (G / 8) + bid / 8 : bid;

#if defined(TS_PHASE)
    unsigned long long ts0_ = 0;
#define TS_BEGIN(k) do { if (TS_PHASE == (k)) ts0_ = __builtin_amdgcn_s_memrealtime(); } while (0)
#define TS_END(k) do { if (TS_PHASE == (k)) { const unsigned dt_ = (unsigned)(__builtin_amdgcn_s_memrealtime() - ts0_); if (tid == 0) atomicMax(ctl + 64, dt_); } } while (0)
#else
#define TS_BEGIN(k) do {} while (0)
#define TS_END(k) do {} while (0)
#endif
#ifndef REP_P0
#define REP_P0 1
#endif
#ifndef REP_P1
#define REP_P1 1
#endif
#ifndef REP_P4
#define REP_P4 1
#endif
#ifndef REP_P6
#define REP_P6 1
#endif
#ifndef REP_P5C
#define REP_P5C 1
#endif
    TS_BEGIN(0);
    if (IN(0)) for (int rep_ = 0; rep_ < REP_P0; ++rep_) {
        LAS float* scr = (LAS float*)(lds3 + wave * 16384);
        constexpr int I_IN = (D_MODEL / 64) * ((IN_COLS + 31) / 32), I_BR = (1024 / 64) * (D_MODEL / 32), I_SQ = (D_MODEL / 64) * (D_MODEL / 32);
        constexpr int I_C1 = (2048 / 64) * (CMP_HID / 32);
        constexpr int NITEMS = I_IN + 2 * I_BR + 2 * I_SQ + 2 * I_C1;
        auto p0_desc = [&](int it) -> P0Item {
            int r = it;
            if (r < I_IN) return P0Item{args.in[2], WinT, nullptr, D_MODEL, IN_COLS, r, C_SHIFT_FROM, C_SHIFT}; r -= I_IN;
            if (r < I_BR) return P0Item{args.in[10], WbnT, nullptr, 1024, D_MODEL, r, 0x7fffffff, 0}; r -= I_BR;
            if (r < I_BR) return P0Item{args.in[11], WbsT, nullptr, 1024, D_MODEL, r, 0x7fffffff, 0}; r -= I_BR;
            if (r < I_SQ) return P0Item{args.in[12], WoutT, nullptr, D_MODEL, D_MODEL, r, 0x7fffffff, 0}; r -= I_SQ;
            if (r < I_SQ) return P0Item{args.in[14], WpqT, args.in[13], D_MODEL, D_MODEL, r, 0x7fffffff, 0}; r -= I_SQ;
            if (r < I_C1) return P0Item{args.in[4], W1T, nullptr, 2048, CMP_HID, r, 0x7fffffff, 0}; r -= I_C1;
            return P0Item{args.in[7], W1T + (size_t)CMP_HID * 2048, nullptr, 2048, CMP_HID, r, 0x7fffffff, 0};
        };
        {
            f32x4 va[8], vb[8];
            int it = gw;
            P0Item da = p0_desc(it < NITEMS ? it : 0), db = da;
            if (it < NITEMS) p0_item_load(da, lane, va);
#pragma unroll 1
            for (; it < NITEMS; it += 2 * NGW) {
                const int i1 = it + NGW, i2 = it + 2 * NGW;
                if (i1 < NITEMS) { db = p0_desc(i1); p0_item_load(db, lane, vb); }
                __builtin_amdgcn_sched_barrier(0);
                p0_item_store(da, lane, va, scr);
                __builtin_amdgcn_sched_barrier(0);
                if (i2 < NITEMS) { da = p0_desc(i2); p0_item_load(da, lane, va); }
                __builtin_amdgcn_sched_barrier(0);
                if (i1 < NITEMS) p0_item_store(db, lane, vb, scr);
                __builtin_amdgcn_sched_barrier(0);
            }
        }
        {
            v4u z = {0u, 0u, 0u, 0u}; bf16* p = WinT + (size_t)C_SHIFT_FROM * D_MODEL; const size_t nz = (size_t)C_SHIFT * D_MODEL;
            for (size_t i = ((size_t)bid * NTHR + tid) * 8; i < nz; i += (size_t)G * NTHR * 8) *(v4u*)(p + i) = z;
        }
        if (gw < 2 * CMP_HID) {
            const int kv = gw >> 7, j = gw & 127; const float* pe = args.in[kv ? 6 : 3]; const float* w1 = args.in[kv ? 7 : 4];
            float s = 0.f;
            for (int k2 = lane; k2 < 2048; k2 += 64) s += pe[k2] * w1[(size_t)k2 * CMP_HID + j];
            s = wave_sum(s);
            if (lane == 0) BIAS1[gw] = s;
        }
        for (int i = bid * NTHR + tid; i < 4 * 4 * 800; i += G * NTHR) { const int gq = i / 800, d = i - gq * 800; BTG[i] = args.in[9][rel_bucket(d) * 16 + gq] * 1.4426950408889634f; }
        cvt_flat(args.in[15], SKB, (size_t)16 * 128 * 128, (size_t)bid * NTHR + tid, (size_t)G * NTHR);
        for (int m = gw; m < NTOK; m += NGW) rms_row_to_bf16(x + (size_t)m * D_MODEL, args.in[1], XN + (size_t)m * D_MODEL, lane);
    }
    TS_END(0);
    SEAM(0);
    TS_BEGIN(1);
    if (IN(1)) for (int rep_ = 0; rep_ < REP_P1; ++rep_) {
        pg8::Gemm g{XN, WinT, NTOK, PLD, D_MODEL}; pg8::StaticOrder S; S.init(NTOK, PLD, G, bid);
        pg8::EpiBf16<0> E{PROJ, PP, nullptr, PP, (size_t)NTOK * PP, 1.f};
        pg8::gemm_phase<pg8::EpiBf16<0>, pg8::StaticOrder, true, true>(lds3, g, S, E);
    }
    TS_END(1);
    SEAM(1);
    TS_BEGIN(2);
    if (IN(2)) cmpr::compress_phase(PROJ, W1T, BIAS1, args.in, KCB, VCB, lds3, bid, G);
    TS_END(2);
    SEAM(2);
    TS_BEGIN(3);
    if (IN(3)) {
        TS_BEGIN(30);
        nsa::nsa_phase(PROJ, KCB, VCB, BTG, ONSA, lds3, vcu, G, args.variant);
        TS_END(30);
#if defined(PROBE_P3A)
        nsa::nsa_phase(PROJ, KCB, VCB, args.in[9], ONSA, lds3, vcu, G);
#endif
        TS_BEGIN(31);
        if (!(args.variant & 32)) nsa::stick_phase(PROJ, OSB, lds3, vcu, G);
        TS_END(31);
#if defined(PROBE_P3B)
        nsa::stick_phase(PROJ, OSB, lds3, vcu, G);
#endif
    }
    TS_END(3);
    SEAM(3);
    TS_BEGIN(4);
    if (IN(4)) for (int rep_ = 0; rep_ < REP_P4; ++rep_) {
        static_assert(WS_OSB == WS_ONSA + (size_t)NTOK * NSA_Q * 2 && WS_WBS == WS_WBN + (size_t)D_MODEL * 1024 * 2, "branch operands must be contiguous");
        pg8::Gemm g{ONSA, WbnT, 2 * NTOK, 2 * D_MODEL, 1024}; pg8::BranchOrder S; S.init(NTOK, D_MODEL, G, bid);
        pg8::EpiGate2 E{MERGED, D_MODEL, PNL(PROJ, P_GA), PNL(PROJ, P_GB), PP, (size_t)NTOK * PP - PP, NTOK / 256, D_MODEL / 256};
        pg8::gemm_phase<pg8::EpiGate2, pg8::BranchOrder, true, PG8_SP2_SMALL>(lds3, g, S, E);
    }
    TS_END(4);
    SEAM(4);
    TS_BEGIN(5);
    if (IN(5)) {
        if (!(args.variant & 64)) { pg8::Gemm g{MERGED, WoutT, NTOK, D_MODEL, D_MODEL}; pg8::StaticOrder S; S.init(NTOK, D_MODEL, G, bid);
          pg8::EpiResid E{x, HB, SS, D_MODEL};
          pg8::gemm_phase<pg8::EpiResid, pg8::StaticOrder, true, PG8_SP2_SMALL>(lds3, g, S, E); }
        int t5 = threadIdx.x; asm volatile("" : "+v"(t5));
        const int lane5 = t5 & 63, gw5 = bid * NWAVES + __builtin_amdgcn_readfirstlane(t5 >> 6);
        if (!(args.variant & 128)) peer::cvt_tables(args.in[16], args.in[17], REC, ISC, gw5, NGW, lane5);
    }
    TS_END(5);
    SEAM(5);
    TS_BEGIN(6);
    if (IN(6)) for (int rep_ = 0; rep_ < REP_P6; ++rep_) {
        pg8::Gemm g{HB, WpqT, NTOK, D_MODEL, D_MODEL}; pg8::StaticOrder S; S.init(NTOK, D_MODEL, G, bid);
        pg8::EpiRowScale E{QP, D_MODEL, SS, 1.f / D_MODEL, EPS};
        pg8::gemm_phase<pg8::EpiRowScale, pg8::StaticOrder, true, PG8_SP2_SMALL>(lds3, g, S, E);
    }
    TS_END(6);
    SEAM(6);
    TS_BEGIN(7);
    if (IN(7)) {
        peer::peer_phase(QP, SKB, HB, SS, args.in[13], REC, ISC, args.in[18], args.out, lds3, bid, G);
    }
    TS_END(7);
#if defined(TS_PHASE)
    xcd_barrier(bar);
    if (bid == 0) { const unsigned dt_ = __hip_atomic_load(ctl + 64, RLX_AGENT); const int K_ = (int)((float)dt_ * 0.01f * 16.777216f * 2.f);
        for (int i = tid; i < K_; i += NTHR) args.out[i] += 1.0f; }
#endif
#undef IN
#undef SEAM
}

extern "C" void kernel_launch(void* const* d_in, const int* in_sizes, int n_in, void* d_out, int out_size, void* d_ws, size_t ws_size, hipStream_t stream) {
    static int grid = 0;
    if (grid == 0) {
        if (n_in != 19 || ws_size < WS_END) { fprintf(stderr, "kernel_launch: unexpected inputs (%d) or workspace (%zu < %zu)\n", n_in, ws_size, (size_t)WS_END); grid = -1; return; }
        int dev = 0, cus = 0, per_cu = 0;
        hipGetDevice(&dev); hipDeviceGetAttribute(&cus, hipDeviceAttributeMultiprocessorCount, dev);
        if (hipFuncSetAttribute((const void*)fwd_megakernel, hipFuncAttributeMaxDynamicSharedMemorySize, LDS_BYTES) != hipSuccess) { fprintf(stderr, "hipFuncSetAttribute failed\n"); grid = -1; return; }
        if (hipOccupancyMaxActiveBlocksPerMultiprocessor(&per_cu, (const void*)fwd_megakernel, NTHR, LDS_BYTES) != hipSuccess || per_cu < 1) { fprintf(stderr, "occupancy query: %d\n", per_cu); per_cu = 1; }
        (void)hipGetLastError();
        grid = cus;
        if (grid > cus * per_cu) grid = cus * per_cu;
    }
    if (grid < 0) return;
    hipMemsetAsync((char*)d_ws + WS_CTL, 0, (size_t)(CW_SS + NTOK) * 4, stream);
    Args a{};
    for (int i = 0; i < 19; ++i) a.in[i] = (const float*)d_in[i];
    a.out = (float*)d_out; a.ws = (unsigned char*)d_ws;
#if defined(PROBE_SPLIT_LO2)
#ifndef PROBE_VARIANT
#define PROBE_VARIANT 0
#endif
    {
        a.ph_lo = 0; a.ph_hi = PROBE_SPLIT_HI1; a.variant = PROBE_VARIANT; hipLaunchKernelGGL(fwd_megakernel, dim3(grid), dim3(NTHR), LDS_BYTES, stream, a);
        hipMemsetAsync((char*)d_ws + WS_CTL + CW_BAR * 4, 0, XCD_BAR_WORDS * 4, stream);
        if (PROBE_SPLIT_LO2 <= 5 && PROBE_SPLIT_HI1 > 5) hipMemsetAsync((char*)d_ws + WS_CTL + CW_SS * 4, 0, NTOK * 4, stream);
        a.ph_lo = PROBE_SPLIT_LO2; a.ph_hi = N_PHASES; a.variant = 0; hipLaunchKernelGGL(fwd_megakernel, dim3(grid), dim3(NTHR), LDS_BYTES, stream, a);
        return;
    }
#endif
    if (MK_N_LAUNCHES == 1) {
        a.ph_lo = 0; a.ph_hi = N_PHASES;
        void* kargs[] = {&a};
#if defined(USE_COOP_LAUNCH)
        hipError_t e = hipLaunchCooperativeKernel((const void*)fwd_megakernel, dim3(grid), dim3(NTHR), kargs, LDS_BYTES, stream);
        if (e != hipSuccess) fprintf(stderr, "cooperative launch failed: %s (grid %d)\n", hipGetErrorString(e), grid);
#else
        (void)kargs;
        hipLaunchKernelGGL(fwd_megakernel, dim3(grid), dim3(NTHR), LDS_BYTES, stream, a);
#endif
    } else {
        for (int p = 0; p < N_PHASES; ++p) { a.ph_lo = p; a.ph_hi = p + 1; hipLaunchKernelGGL(fwd_megakernel, dim3(grid), dim3(NTHR), LDS_BYTES, stream, a); }
    }
}
```

```cpp
#include <hip/hip_runtime.h>
#include <cstdio>
#include <cstdint>
#include <cmath>
#ifndef PG8_NT_STORES
#define PG8_NT_STORES 0
#endif
#if PG8_NT_STORES
#define PG8_STORE_OUT(p, v) __builtin_nontemporal_store((v), (p))
#else
#define PG8_STORE_OUT(p, v) (*(p) = (v))
#endif
namespace pg8 {
#define PG8_LAS __attribute__((address_space(3)))
typedef unsigned short bf16_t;
typedef short bf16x8 __attribute__((ext_vector_type(8)));
typedef float f32x4 __attribute__((ext_vector_type(4)));
typedef unsigned u32x4 __attribute__((ext_vector_type(4)));
constexpr int BM = 256, BK = 64, HALF = 128, HTB = HALF * BK * 2  , STAGE_BYTES = 8 * HTB, NXCD = 8, WGM = 8;

__host__ __device__ __forceinline__ int lds_byte(int r, int c) { const int st = (r >> 4) * 2 + (c >> 5), rr = r & 15, cc = c & 31, ob = rr * 64 + cc * 2; return st * 1024 + (ob ^ (((ob >> 9) & 1) << 5)); }
__host__ __device__ __forceinline__ void stage_rc(int b, int& R, int& C) { const int st = b / 1024, sb = b % 1024, swz = sb ^ (((sb >> 9) & 1) << 5); R = (st >> 1) * 16 + swz / 64; C = (st & 1) * 32 + (swz % 64) / 2; }
__host__ __device__ __forceinline__ int perm32(int rho) { const int n = rho >> 4, i = rho & 15; return 8 * (i >> 2) + 4 * n + (i & 3); }

struct Unit { int pm, pn; };
struct Gemm { const bf16_t* A; const bf16_t* Bt; int M, N, K; };

struct StaticOrder {
    int nM, nN, nwg, G, c;
    __host__ __device__ void init(int M, int N, int G_, int c_) { nM = M / BM; nN = N / BM; nwg = nM * nN; G = G_; c = c_; }
    __host__ __device__ bool next(int i, Unit& u) const {
        const long L = (long)i * G + c; if (L >= nwg) return false;
        int wgid = (int)L; { const int q = nwg / NXCD, r = nwg % NXCD, xcd = wgid % NXCD, off = wgid / NXCD; wgid = (xcd < r ? xcd * (q + 1) : r * (q + 1) + (xcd - r) * q) + off; }
        const int nig = WGM * nN, gid = wgid / nig, fm = gid * WGM, gsz = (nM - fm) < WGM ? (nM - fm) : WGM;
        u.pm = fm + ((wgid % nig) % gsz); u.pn = (wgid % nig) / gsz; return true;
    }
    __device__ __forceinline__ void a_ready(const Unit&) const {}
    __device__ __forceinline__ void done(const Unit&) const {}
};

__device__ __forceinline__ unsigned cvt_pk_bf16(float lo, float hi) { unsigned r; asm volatile("v_cvt_pk_bf16_f32 %0, %1, %2" : "=v"(r) : "v"(lo), "v"(hi)); return r; }
typedef float f32x2 __attribute__((ext_vector_type(2)));
__device__ __forceinline__ f32x2 gelu_pk(f32x2 v) {
    const f32x2 av = __builtin_elementwise_abs(v), d = av * 0.2316418882f + 1.0f;
    f32x2 t; t.x = __builtin_amdgcn_rcpf(d.x); t.y = __builtin_amdgcn_rcpf(d.y);
    f32x2 q = t * 0.5307027145f + (-0.7265760135f); q = q * t + 0.7107068705f; q = q * t + (-0.142248368f); q = q * t + 0.127414796f; q = q * t;
    const f32x2 s = (v * v) * (-0.72134752044f);
    f32x2 e; e.x = __builtin_amdgcn_exp2f(s.x); e.y = __builtin_amdgcn_exp2f(s.y);
    const f32x2 m = v * (q * e), r = v - m;
    f32x2 o; o.x = v.x < 0.f ? m.x : r.x; o.y = v.y < 0.f ? m.y : r.y; return o;
}

template <int ACT  > struct EpiBf16 {
    static constexpr bool PERM = true, AFTER_DRAIN = false; static_assert(ACT == 0 || ACT == 1, "EpiBf16: ACT is 0 (none) or 1 (gelu_pk)");
    bf16_t* O; int ldc; const float* bias; int split_cols; size_t split_stride; float scale0;
    __device__ __forceinline__ void operator()(const f32x4 (&acc)[2][2][4][2], const Unit& u, int wr, int wc, int fr, int fq) const {
        const int row0 = u.pm * BM + wr * 64 + fr; int colt = u.pn * BM; bf16_t* base = O;
        float sc = 1.f; if (split_cols) { const int t = colt / split_cols; base += (size_t)t * split_stride; colt -= t * split_cols; if (t == 0) sc = scale0; }
        const int col0 = colt + wc * 32 + 8 * fq, bcol0 = u.pn * BM + wc * 32 + 8 * fq;
        f32x4 bv[2][2];
#pragma unroll
        for (int bj = 0; bj < 2; ++bj)
#pragma unroll
            for (int n = 0; n < 2; ++n) bv[bj][n] = bias ? *(const f32x4*)(bias + bcol0 + bj * HALF + 4 * n) : (f32x4){0.f, 0.f, 0.f, 0.f};
#pragma unroll
        for (int ai = 0; ai < 2; ++ai)
#pragma unroll
            for (int m = 0; m < 4; ++m) { bf16_t* rowp = base + (size_t)(row0 + ai * HALF + m * 16) * ldc + col0;
#pragma unroll
                for (int bj = 0; bj < 2; ++bj) { f32x4 v0 = acc[ai][bj][m][0] + bv[bj][0], v1 = acc[ai][bj][m][1] + bv[bj][1];
                    if (ACT == 1) { f32x2 a = gelu_pk((f32x2){v0[0], v0[1]}), b = gelu_pk((f32x2){v0[2], v0[3]}), c = gelu_pk((f32x2){v1[0], v1[1]}), d = gelu_pk((f32x2){v1[2], v1[3]});
                        v0 = (f32x4){a.x, a.y, b.x, b.y}; v1 = (f32x4){c.x, c.y, d.x, d.y}; }
                    v0 = v0 * sc; v1 = v1 * sc; u32x4 w; w.x = cvt_pk_bf16(v0[0], v0[1]); w.y = cvt_pk_bf16(v0[2], v0[3]); w.z = cvt_pk_bf16(v1[0], v1[1]); w.w = cvt_pk_bf16(v1[2], v1[3]);
                    PG8_STORE_OUT((u32x4*)(rowp + bj * HALF), w); } }
    }
};

struct PanelStats {
    unsigned* xbuf;
    unsigned* cnt;
    unsigned* tmo;
    int ntn; float eps;
    unsigned code;
    __device__ __forceinline__ bool run(const f32x4 (&v)[2][2][4][2], const Unit& u, int wr, int wc, int fr, int fq, PG8_LAS unsigned char* lds, int wid, int lane) const {
        typedef float f32x2v __attribute__((ext_vector_type(2)));
        PG8_LAS f32x2v* P = (PG8_LAS f32x2v*)lds;
        PG8_LAS f32x2v* S = (PG8_LAS f32x2v*)(lds + 8192);
        PG8_LAS unsigned* flag = (PG8_LAS unsigned*)(lds + 8192 + 2048);
#pragma unroll
        for (int ai = 0; ai < 2; ++ai)
#pragma unroll
            for (int m = 0; m < 4; ++m) {
                float s = 0.f;
#pragma unroll
                for (int bj = 0; bj < 2; ++bj)
#pragma unroll
                    for (int n = 0; n < 2; ++n) { const f32x4 x = v[ai][bj][m][n]; s += (x[0] + x[1]) + (x[2] + x[3]); }
                s += __shfl_xor(s, 16); s += __shfl_xor(s, 32);
                const float mw = s * (1.0f / 64.0f); float q = 0.f;
#pragma unroll
                for (int bj = 0; bj < 2; ++bj)
#pragma unroll
                    for (int n = 0; n < 2; ++n) { const f32x4 d = v[ai][bj][m][n] - mw; q += (d[0] * d[0] + d[1] * d[1]) + (d[2] * d[2] + d[3] * d[3]); }
                q += __shfl_xor(q, 16); q += __shfl_xor(q, 32);
                if (fq == 0) P[(ai * HALF + wr * 64 + m * 16 + fr) * 4 + wc] = (f32x2v){mw, q};
            }
        asm volatile("s_waitcnt lgkmcnt(0)" ::: "memory"); __builtin_amdgcn_s_barrier(); asm volatile("" ::: "memory");
#if defined(BROKEN_EXCHANGE_NO_WAIT)
#warning BROKEN CONTROL BUILD: the row-statistics exchange does not wait; results are wrong by design
        if (blockIdx.x >= 64) { const long long t0_ = clock64(); while (clock64() - t0_ < 60000) __builtin_amdgcn_s_sleep(8); }
#endif
        const int row = wid * 32 + (lane & 31);
        if (lane < 32) {
            const f32x2v a = P[row * 4 + 0], b = P[row * 4 + 1], c = P[row * 4 + 2], d = P[row * 4 + 3];
            const float mt = (a.x + b.x + c.x + d.x) * 0.25f;
            const float da = a.x - mt, db = b.x - mt, dc = c.x - mt, dd = d.x - mt;
            const float m2 = (a.y + b.y) + (c.y + d.y) + 64.0f * ((da * da + db * db) + (dc * dc + dd * dd));
            unsigned long long* slot = (unsigned long long*)xbuf + ((size_t)(u.pm * BM + row) * 4 + u.pn);
            __hip_atomic_store(slot, ((unsigned long long)__float_as_uint(m2) << 32) | __float_as_uint(mt), __ATOMIC_RELAXED, __HIP_MEMORY_SCOPE_AGENT);
        }
        asm volatile("s_waitcnt vmcnt(0)" ::: "memory");
        if (lane == 0) __hip_atomic_fetch_add(cnt + 64 * u.pm, 1u, __ATOMIC_RELAXED, __HIP_MEMORY_SCOPE_AGENT);
        if (wid == 0) {
            bool dead = false; const unsigned long long t0 = __builtin_amdgcn_s_memrealtime(); const unsigned want = 8u * (unsigned)ntn;
            for (;;) {
#if defined(BROKEN_EXCHANGE_NO_WAIT)
                break;
#endif
                if ((unsigned)__builtin_amdgcn_readfirstlane(__hip_atomic_load(cnt + 64 * u.pm, __ATOMIC_RELAXED, __HIP_MEMORY_SCOPE_AGENT)) >= want) break;
                if (__builtin_amdgcn_s_memrealtime() - t0 > 2000000ull) {
                    if (lane == 0) { unsigned expect = 0u; __hip_atomic_compare_exchange_strong(tmo + 1, &expect, code | (unsigned)(u.pm & 0xff), __ATOMIC_RELAXED, __ATOMIC_RELAXED, __HIP_MEMORY_SCOPE_AGENT);
                                     __hip_atomic_store(tmo, 1u, __ATOMIC_RELAXED, __HIP_MEMORY_SCOPE_AGENT); }
                    dead = true; break; }
                __builtin_amdgcn_s_sleep(2);
            }
            __builtin_amdgcn_fence(__ATOMIC_ACQUIRE, "agent");
            if (lane == 0) flag[0] = dead ? 1u : 0u;
        }
        asm volatile("s_waitcnt vmcnt(0) lgkmcnt(0)" ::: "memory"); __builtin_amdgcn_s_barrier(); asm volatile("" ::: "memory");
        const bool bad = flag[0] != 0u;
        if (lane < 32) {
            const unsigned long long* slot = (const unsigned long long*)xbuf + (size_t)(u.pm * BM + row) * 4; float mt[4], m2[4]; float ms = 0.f;
#pragma unroll
            for (int t = 0; t < 4; ++t) { if (t < ntn) { const unsigned long long w = __hip_atomic_load(slot + t, __ATOMIC_RELAXED, __HIP_MEMORY_SCOPE_AGENT); mt[t] = __uint_as_float((unsigned)w); m2[t] = __uint_as_float((unsigned)(w >> 32)); } else { mt[t] = 0.f; m2[t] = 0.f; } ms += mt[t]; }
            const float mean = ms / (float)ntn; float q = 0.f;
#pragma unroll
            for (int t = 0; t < 4; ++t) if (t < ntn) { const float dm = mt[t] - mean; q += m2[t] + 256.0f * dm * dm; }
            S[row] = (f32x2v){mean, 1.0f / sqrtf(q / (256.0f * (float)ntn) + eps)};
        }
        asm volatile("s_waitcnt lgkmcnt(0)" ::: "memory"); __builtin_amdgcn_s_barrier(); asm volatile("" ::: "memory");
        return bad;
    }
};
struct EpiLnRes {
    static constexpr bool PERM = false, AFTER_DRAIN = true;
    const float* base; float* out; int ldc; const float* bias; PanelStats st; unsigned poison;
    __device__ __forceinline__ void fused(f32x4 (&acc)[2][2][4][2], const Unit& u, int wr, int wc, int fr, int fq, PG8_LAS unsigned char* lds, int wid, int lane) const {
        typedef float f32x2v __attribute__((ext_vector_type(2)));
        const PG8_LAS f32x2v* S = (const PG8_LAS f32x2v*)(lds + 8192);
        const int col0 = u.pn * BM + wc * 32 + 4 * fq;
#pragma unroll
        for (int bj = 0; bj < 2; ++bj)
#pragma unroll
            for (int n = 0; n < 2; ++n) { const f32x4 bv = bias ? *(const f32x4*)(bias + col0 + bj * HALF + n * 16) : (f32x4){0.f, 0.f, 0.f, 0.f};
#pragma unroll
                for (int ai = 0; ai < 2; ++ai)
#pragma unroll
                    for (int m = 0; m < 4; ++m) acc[ai][bj][m][n] += bv; }
        f32x4 pre[4][2][2];
#pragma unroll
        for (int m = 0; m < 4; ++m) { const size_t off = (size_t)(u.pm * BM + wr * 64 + m * 16 + fr) * ldc + col0;
#pragma unroll
            for (int bj = 0; bj < 2; ++bj)
#pragma unroll
                for (int n = 0; n < 2; ++n) pre[m][bj][n] = *(const f32x4*)(base + off + bj * HALF + n * 16); }
        const bool bad = st.run(acc, u, wr, wc, fr, fq, lds, wid, lane) || poison != 0u;
        const float qnan = __builtin_nanf("");
#pragma unroll
        for (int ai = 0; ai < 2; ++ai)
#pragma unroll
            for (int m = 0; m < 4; ++m) { const int r = ai * HALF + wr * 64 + m * 16 + fr; const f32x2v sr = S[r]; const size_t off = (size_t)(u.pm * BM + r) * ldc + col0;
#pragma unroll
                for (int bj = 0; bj < 2; ++bj)
#pragma unroll
                    for (int n = 0; n < 2; ++n) { const f32x4 bs = ai == 0 ? pre[m][bj][n] : *(const f32x4*)(base + off + bj * HALF + n * 16); f32x4 o = bs + (acc[ai][bj][m][n] - sr.x) * sr.y;
                        if (bad) o = (f32x4){qnan, qnan, qnan, qnan}; *(f32x4*)(out + off + bj * HALF + n * 16) = o; }
                if (m & 1) asm volatile("" ::: "memory"); }
    }
};
struct EpiLnResLn {
    static constexpr bool PERM = false, AFTER_DRAIN = true;
    const float* base; float* out; bf16_t* xn; int ldc; const float* bias; PanelStats st1, st2; unsigned poison;
    __device__ __forceinline__ void fused(f32x4 (&acc)[2][2][4][2], const Unit& u, int wr, int wc, int fr, int fq, PG8_LAS unsigned char* lds, int wid, int lane) const {
        typedef float f32x2v __attribute__((ext_vector_type(2))); typedef unsigned u32x2v __attribute__((ext_vector_type(2)));
        const PG8_LAS f32x2v* S = (const PG8_LAS f32x2v*)(lds + 8192);
        const int col0 = u.pn * BM + wc * 32 + 4 * fq;
#pragma unroll
        for (int bj = 0; bj < 2; ++bj)
#pragma unroll
            for (int n = 0; n < 2; ++n) { const f32x4 bv = bias ? *(const f32x4*)(bias + col0 + bj * HALF + n * 16) : (f32x4){0.f, 0.f, 0.f, 0.f};
#pragma unroll
                for (int ai = 0; ai < 2; ++ai)
#pragma unroll
                    for (int m = 0; m < 4; ++m) acc[ai][bj][m][n] += bv; }
        bool bad = st1.run(acc, u, wr, wc, fr, fq, lds, wid, lane) || poison != 0u;
        const float qnan = __builtin_nanf("");
#pragma unroll
        for (int ai = 0; ai < 2; ++ai)
#pragma unroll
            for (int m = 0; m < 4; ++m) { const int r = ai * HALF + wr * 64 + m * 16 + fr; const f32x2v sr = S[r]; const size_t off = (size_t)(u.pm * BM + r) * ldc + col0;
#pragma unroll
                for (int bj = 0; bj < 2; ++bj)
#pragma unroll
                    for (int n = 0; n < 2; ++n) { const f32x4 bs = *(const f32x4*)(base + off + bj * HALF + n * 16); acc[ai][bj][m][n] = bs + (acc[ai][bj][m][n] - sr.x) * sr.y; }
                asm volatile("" : "+v"(acc[ai][0][m][0]), "+v"(acc[ai][0][m][1]), "+v"(acc[ai][1][m][0]), "+v"(acc[ai][1][m][1]));
                if (m & 1) asm volatile("" ::: "memory"); }
        const bool bad1 = bad;
        bad = st2.run(acc, u, wr, wc, fr, fq, lds, wid, lane) || bad;
#pragma unroll
        for (int ai = 0; ai < 2; ++ai)
#pragma unroll
            for (int m = 0; m < 4; ++m) { const int r = ai * HALF + wr * 64 + m * 16 + fr; const f32x2v sr = S[r]; const size_t off = (size_t)(u.pm * BM + r) * ldc + col0;
#pragma unroll
                for (int bj = 0; bj < 2; ++bj)
#pragma unroll
                    for (int n = 0; n < 2; ++n) { const f32x4 x1 = acc[ai][bj][m][n]; *(f32x4*)(out + off + bj * HALF + n * 16) = bad1 ? (f32x4){qnan, qnan, qnan, qnan} : x1;
                        const f32x4 o = (x1 - sr.x) * sr.y; u32x2v w; w.x = cvt_pk_bf16(o[0], o[1]); w.y = cvt_pk_bf16(o[2], o[3]);
                        if (bad) { w.x = 0x7fc07fc0u; w.y = 0x7fc07fc0u; } *(u32x2v*)(xn + off + bj * HALF + n * 16) = w; }
                asm volatile("" ::: "memory"); }
    }
};

template <class Epi, class Sched, bool ALIGN_EPI = false, bool SP2 = false>
__device__ __forceinline__ void gemm_phase(PG8_LAS unsigned char* lds, const Gemm g, const Sched& S, const Epi& E) {
    const int tid = threadIdx.x, wid = __builtin_amdgcn_readfirstlane(tid >> 6), lane = tid & 63, wr = wid >> 2, wc = wid & 3, fr = lane & 15, fq = lane >> 4;
    const int K = g.K, nt = K / BK;
    unsigned voffA[2], voffB[2];
#pragma unroll
    for (int i = 0; i < 2; ++i) { int R, C; stage_rc(tid * 16 + i * 8192, R, C); const int Rb = Epi::PERM ? ((R & ~31) + perm32(R & 31)) : R;
        voffA[i] = (unsigned)(R * K + C) * 2u; voffB[i] = (unsigned)(Rb * K + C) * 2u; }
    const size_t kstep = (size_t)(BK * 2);
    const size_t hstep = (size_t)HALF * K * 2;
    const size_t tstep = 2 * hstep;
    const unsigned ldsw = (unsigned)wid * 1024u;
    const int aoff = lds_byte(wr * 64 + fr, fq * 8), boff = lds_byte(wc * 32 + fr, fq * 8);
#define PG8_SA(b, h) (((b) * 2 + (h)) * HTB)
#define PG8_SB(b, h) ((4 + (b) * 2 + (h)) * HTB)
#define PG8_STAGE(bufoff, gbase, voff) do { _Pragma("unroll") for (int _i = 0; _i < 2; ++_i) \
        __builtin_amdgcn_global_load_lds((const unsigned*)((const char*)(gbase) + (voff)[_i]), (PG8_LAS unsigned*)(lds + (bufoff) + ldsw + _i * 8192), 16, 0, 0); } while (0)
#define PG8_LDA(dst, b, h) do { _Pragma("unroll") for (int m = 0; m < 4; ++m) _Pragma("unroll") for (int k = 0; k < 2; ++k) dst[m][k] = *(const PG8_LAS bf16x8*)(lds + PG8_SA(b, h) + aoff + m * 2048 + k * 1024); } while (0)
#define PG8_LDB(dst, b, h) do { _Pragma("unroll") for (int n = 0; n < 2; ++n) _Pragma("unroll") for (int k = 0; k < 2; ++k) dst[n][k] = *(const PG8_LAS bf16x8*)(lds + PG8_SB(b, h) + boff + n * 2048 + k * 1024); } while (0)
#define PG8_MMA(ai, bj, At, Bt) do { __builtin_amdgcn_s_setprio(1); _Pragma("unroll") for (int m = 0; m < 4; ++m) _Pragma("unroll") for (int n = 0; n < 2; ++n) _Pragma("unroll") for (int k = 0; k < 2; ++k) \
        acc[ai][bj][m][n] = __builtin_amdgcn_mfma_f32_16x16x32_bf16(Bt[n][k], At[m][k], acc[ai][bj][m][n], 0, 0, 0); __builtin_amdgcn_s_setprio(0); } while (0)
#define PG8_WAIT_V(n) asm volatile("s_waitcnt vmcnt(" #n ")" ::: "memory")
#define PG8_WAIT_L(n) asm volatile("s_waitcnt lgkmcnt(" #n ")" ::: "memory")
#define PG8_BAR __builtin_amdgcn_s_barrier()
#define PG8_SCHED __builtin_amdgcn_sched_barrier(0)
    Unit cur, nxt; int ui = 0;
    if (!S.next(0, cur)) return;
    f32x4 acc[2][2][4][2];
#pragma unroll
    for (int a = 0; a < 2; ++a)
#pragma unroll
        for (int b = 0; b < 2; ++b)
#pragma unroll
            for (int m = 0; m < 4; ++m)
#pragma unroll
                for (int n = 0; n < 2; ++n) acc[a][b][m][n] = (f32x4){0.f, 0.f, 0.f, 0.f};
    bf16x8 At[4][2], B0[2][2], B1[2][2];
    const char* cA = (const char*)g.A + (size_t)cur.pm * tstep; const char* cB = (const char*)g.Bt + (size_t)cur.pn * tstep;
    S.a_ready(cur);
    if constexpr (SP2) {
        PG8_STAGE(PG8_SB(0, 0), cB, voffB); PG8_STAGE(PG8_SB(0, 1), cB + hstep, voffB); PG8_STAGE(PG8_SA(0, 0), cA, voffA); PG8_STAGE(PG8_SA(0, 1), cA + hstep, voffA);
        if (wr == 1) PG8_BAR;
        PG8_WAIT_V(2); PG8_BAR;
        PG8_STAGE(PG8_SB(1, 0), cB + kstep, voffB); PG8_STAGE(PG8_SA(1, 0), cA + kstep, voffA); PG8_STAGE(PG8_SB(1, 1), cB + hstep + kstep, voffB);
        PG8_WAIT_V(6); PG8_BAR;
    } else {
        PG8_STAGE(PG8_SB(0, 0), cB, voffB); PG8_STAGE(PG8_SA(0, 0), cA, voffA); PG8_STAGE(PG8_SB(0, 1), cB + hstep, voffB); PG8_STAGE(PG8_SA(0, 1), cA + hstep, voffA);
        if (wr == 1) PG8_BAR;
        PG8_WAIT_V(4); PG8_BAR;
        PG8_STAGE(PG8_SB(1, 0), cB + kstep, voffB); PG8_STAGE(PG8_SA(1, 0), cA + kstep, voffA); PG8_STAGE(PG8_SB(1, 1), cB + hstep + kstep, voffB);
        PG8_WAIT_V(6); PG8_BAR;
    }
    for (;;) {
        const bool has_next = S.next(ui + 1, nxt);
        const char* nA = has_next ? (const char*)g.A + (size_t)nxt.pm * tstep : cA; const char* nB = has_next ? (const char*)g.Bt + (size_t)nxt.pn * tstep : cB;
        for (int t = 0; t < nt; t += 2) {
            const bool last = (t == nt - 2);
            const char* a1 = cA + (size_t)(t + 1) * kstep;
            const char* a2 = last ? nA : cA + (size_t)(t + 2) * kstep; const char* b2 = last ? nB : cB + (size_t)(t + 2) * kstep;
            const char* a3 = a2 + kstep; const char* b3 = b2 + kstep;
            if (last && has_next) S.a_ready(nxt);
            if constexpr (SP2) {
            PG8_LDB(B0, 0, 0); PG8_LDB(B1, 0, 1); PG8_SCHED; PG8_LDA(At, 0, 0); PG8_STAGE(PG8_SA(1, 1), a1 + hstep, voffA);
            PG8_WAIT_V(8); PG8_WAIT_L(0); PG8_BAR; PG8_MMA(0, 0, At, B0); PG8_MMA(0, 1, At, B1); PG8_BAR; PG8_SCHED;
            PG8_LDA(At, 0, 1); PG8_STAGE(PG8_SB(0, 0), b2, voffB); PG8_STAGE(PG8_SB(0, 1), b2 + hstep, voffB); PG8_STAGE(PG8_SA(0, 0), a2, voffA);
            PG8_WAIT_V(8); PG8_WAIT_L(0); PG8_BAR; PG8_MMA(1, 0, At, B0); PG8_MMA(1, 1, At, B1); PG8_BAR; PG8_SCHED;
            PG8_LDB(B0, 1, 0); PG8_LDB(B1, 1, 1); PG8_SCHED; PG8_LDA(At, 1, 0); PG8_STAGE(PG8_SA(0, 1), a2 + hstep, voffA);
            PG8_WAIT_V(8); PG8_WAIT_L(0); PG8_BAR; PG8_MMA(0, 0, At, B0); PG8_MMA(0, 1, At, B1); PG8_BAR; PG8_SCHED;
            PG8_LDA(At, 1, 1); PG8_STAGE(PG8_SB(1, 0), b3, voffB); PG8_STAGE(PG8_SB(1, 1), b3 + hstep, voffB); PG8_STAGE(PG8_SA(1, 0), a3, voffA);
            PG8_WAIT_V(8); PG8_WAIT_L(0); PG8_BAR; PG8_MMA(1, 0, At, B0); PG8_MMA(1, 1, At, B1); PG8_BAR; PG8_SCHED;
            } else {
            PG8_LDB(B0, 0, 0); PG8_SCHED; PG8_LDA(At, 0, 0); PG8_STAGE(PG8_SA(1, 1), a1 + hstep, voffA);
            PG8_WAIT_L(8); PG8_BAR; PG8_WAIT_L(0); PG8_MMA(0, 0, At, B0); PG8_BAR; PG8_SCHED;
            PG8_LDB(B1, 0, 1); PG8_STAGE(PG8_SB(0, 0), b2, voffB);
            PG8_BAR; PG8_WAIT_L(0); PG8_MMA(0, 1, At, B1); PG8_BAR;
            PG8_LDA(At, 0, 1); PG8_STAGE(PG8_SA(0, 0), a2, voffA);
            PG8_BAR; PG8_WAIT_L(0); PG8_MMA(1, 0, At, B0); PG8_BAR; PG8_SCHED;
            PG8_STAGE(PG8_SB(0, 1), b2 + hstep, voffB);
            PG8_WAIT_V(6); PG8_BAR; PG8_MMA(1, 1, At, B1); PG8_BAR;
            PG8_LDB(B0, 1, 0); PG8_SCHED; PG8_LDA(At, 1, 0); PG8_STAGE(PG8_SA(0, 1), a2 + hstep, voffA);
            PG8_WAIT_L(8); PG8_BAR; PG8_WAIT_L(0); PG8_MMA(0, 0, At, B0); PG8_BAR; PG8_SCHED;
            PG8_LDB(B1, 1, 1); PG8_STAGE(PG8_SB(1, 0), b3, voffB);
            PG8_BAR; PG8_WAIT_L(0); PG8_MMA(0, 1, At, B1); PG8_BAR;
            PG8_LDA(At, 1, 1); PG8_STAGE(PG8_SA(1, 0), a3, voffA);
            PG8_BAR; PG8_WAIT_L(0); PG8_MMA(1, 0, At, B0); PG8_BAR; PG8_SCHED;
            PG8_STAGE(PG8_SB(1, 1), b3 + hstep, voffB);
            PG8_WAIT_V(6); PG8_BAR; PG8_MMA(1, 1, At, B1); PG8_BAR;
            }
        }
        if constexpr (ALIGN_EPI) { if (wr == 0) PG8_BAR; }
        if constexpr (!Epi::AFTER_DRAIN) { E(acc, cur, wr, wc, fr, fq); S.done(cur); }
        if (!has_next) break;
#pragma unroll
        for (int a = 0; a < 2; ++a)
#pragma unroll
            for (int b = 0; b < 2; ++b)
#pragma unroll
                for (int m = 0; m < 4; ++m)
#pragma unroll
                    for (int n = 0; n < 2; ++n) acc[a][b][m][n] = (f32x4){0.f, 0.f, 0.f, 0.f};
        cur = nxt; cA = nA; cB = nB; ++ui;
        if constexpr (ALIGN_EPI) { if (wr == 1) PG8_BAR; }
    }
    PG8_WAIT_V(0);
    if constexpr (!ALIGN_EPI) { if (wr == 0) PG8_BAR; }
    PG8_BAR;
    if constexpr (Epi::AFTER_DRAIN) { E.fused(acc, cur, wr, wc, fr, fq, lds, wid, lane); S.done(cur); }
#undef PG8_SA
#undef PG8_SB
#undef PG8_STAGE
#undef PG8_LDA
#undef PG8_LDB
#undef PG8_MMA
#undef PG8_WAIT_V
#undef PG8_WAIT_L
#undef PG8_BAR
#undef PG8_SCHED
}
}
namespace pg8 {
__device__ __forceinline__ float bf2f(unsigned short b) { return __uint_as_float(((unsigned)b) << 16); }
__device__ __forceinline__ float bflo(unsigned w) { return __uint_as_float(w << 16); }
__device__ __forceinline__ float bfhi(unsigned w) { return __uint_as_float(w & 0xffff0000u); }
__device__ __forceinline__ float sigm(float x) { return 1.f / (1.f + __expf(-x)); }
template <int MODE> struct EpiGate {
    static constexpr bool PERM = true, AFTER_DRAIN = false;
    bf16_t* O; int ldc; const bf16_t* G; int ldg; size_t gtile;
    __device__ __forceinline__ void operator()(const f32x4 (&acc)[2][2][4][2], const Unit& u, int wr, int wc, int fr, int fq) const {
        const int row0 = u.pm * BM + wr * 64 + fr, col0 = u.pn * BM + wc * 32 + 8 * fq;
#pragma unroll
        for (int ai = 0; ai < 2; ++ai)
#pragma unroll
            for (int m = 0; m < 4; ++m) { const size_t row = (size_t)(row0 + ai * HALF + m * 16);
#pragma unroll
                for (int bj = 0; bj < 2; ++bj) {
                    const u32x4 gw = __builtin_nontemporal_load((const u32x4*)(G + (size_t)u.pn * gtile + row * ldg + col0 + bj * HALF));
                    f32x4 v0 = acc[ai][bj][m][0], v1 = acc[ai][bj][m][1];
                    v0[0] *= sigm(bflo(gw.x)); v0[1] *= sigm(bfhi(gw.x)); v0[2] *= sigm(bflo(gw.y)); v0[3] *= sigm(bfhi(gw.y));
                    v1[0] *= sigm(bflo(gw.z)); v1[1] *= sigm(bfhi(gw.z)); v1[2] *= sigm(bflo(gw.w)); v1[3] *= sigm(bfhi(gw.w));
                    bf16_t* op = O + row * ldc + col0 + bj * HALF;
                    if (MODE == 1) { const u32x4 ow = *(const u32x4*)op;
                        v0[0] += bflo(ow.x); v0[1] += bfhi(ow.x); v0[2] += bflo(ow.y); v0[3] += bfhi(ow.y);
                        v1[0] += bflo(ow.z); v1[1] += bfhi(ow.z); v1[2] += bflo(ow.w); v1[3] += bfhi(ow.w); }
                    u32x4 w; w.x = cvt_pk_bf16(v0[0], v0[1]); w.y = cvt_pk_bf16(v0[2], v0[3]); w.z = cvt_pk_bf16(v1[0], v1[1]); w.w = cvt_pk_bf16(v1[2], v1[3]);
                    *(u32x4*)op = w; } }
    }
};
struct BranchOrder {
    StaticOrder base; int dm, dn;
    __host__ __device__ void init(int M, int N, int G_, int c_) { base.init(M, N, G_, c_); dm = M / BM; dn = N / BM; }
    __host__ __device__ bool next(int i, Unit& u) const { if (!base.next(i >> 1, u)) return false; if (i & 1) { u.pm += dm; u.pn += dn; } return true; }
    __device__ __forceinline__ void a_ready(const Unit&) const {}
    __device__ __forceinline__ void done(const Unit&) const {}
};
struct EpiGate2 {
    static constexpr bool PERM = true, AFTER_DRAIN = false;
    bf16_t* O; int ldc; const bf16_t* G0; const bf16_t* G1; int ldg; size_t gtile; int dm, dn;
    __device__ __forceinline__ void operator()(const f32x4 (&acc)[2][2][4][2], const Unit& u, int wr, int wc, int fr, int fq) const {
        const bool second = u.pm >= dm;
        Unit v = u; if (second) { v.pm -= dm; v.pn -= dn; }
        if (second) { EpiGate<1> e{O, ldc, G1, ldg, gtile}; e(acc, v, wr, wc, fr, fq); } else { EpiGate<0> e{O, ldc, G0, ldg, gtile}; e(acc, v, wr, wc, fr, fq); }
    }
};
struct EpiResid {
    static constexpr bool PERM = true, AFTER_DRAIN = false;
    const float* R; bf16_t* Hb; float* ss; int ldc;
    __device__ __forceinline__ void operator()(const f32x4 (&acc)[2][2][4][2], const Unit& u, int wr, int wc, int fr, int fq) const {
        const int row0 = u.pm * BM + wr * 64 + fr, col0 = u.pn * BM + wc * 32 + 8 * fq;
#pragma unroll
        for (int ai = 0; ai < 2; ++ai)
#pragma unroll
            for (int m = 0; m < 4; ++m) { const size_t row = (size_t)(row0 + ai * HALF + m * 16); float sq = 0.f;
#pragma unroll
                for (int bj = 0; bj < 2; ++bj) {
                    const size_t off = row * ldc + col0 + bj * HALF;
                    const f32x4 r0 = __builtin_nontemporal_load((const f32x4*)(R + off)), r1 = __builtin_nontemporal_load((const f32x4*)(R + off + 4));
                    const f32x4 v0 = acc[ai][bj][m][0] + r0, v1 = acc[ai][bj][m][1] + r1;
                    u32x4 w; w.x = cvt_pk_bf16(v0[0], v0[1]); w.y = cvt_pk_bf16(v0[2], v0[3]); w.z = cvt_pk_bf16(v1[0], v1[1]); w.w = cvt_pk_bf16(v1[2], v1[3]);
                    *(u32x4*)(Hb + off) = w;
                    sq += (v0[0] * v0[0] + v0[1] * v0[1]) + (v0[2] * v0[2] + v0[3] * v0[3]) + (v1[0] * v1[0] + v1[1] * v1[1]) + (v1[2] * v1[2] + v1[3] * v1[3]); }
                sq += __shfl_xor(sq, 16); sq += __shfl_xor(sq, 32);
                if (fq == 0) atomicAdd(ss + row, sq); }
    }
};
struct EpiRowScale {
    static constexpr bool PERM = true, AFTER_DRAIN = false;
    bf16_t* O; int ldc; const float* ss; float inv_n, eps;
    __device__ __forceinline__ void operator()(const f32x4 (&acc)[2][2][4][2], const Unit& u, int wr, int wc, int fr, int fq) const {
        const int row0 = u.pm * BM + wr * 64 + fr, col0 = u.pn * BM + wc * 32 + 8 * fq;
#pragma unroll
        for (int ai = 0; ai < 2; ++ai)
#pragma unroll
            for (int m = 0; m < 4; ++m) { const size_t row = (size_t)(row0 + ai * HALF + m * 16);
                const float sc = rsqrtf(__hip_atomic_load(ss + row, __ATOMIC_RELAXED, __HIP_MEMORY_SCOPE_AGENT) * inv_n + eps);
#pragma unroll
                for (int bj = 0; bj < 2; ++bj) { const f32x4 v0 = acc[ai][bj][m][0] * sc, v1 = acc[ai][bj][m][1] * sc;
                    u32x4 w; w.x = cvt_pk_bf16(v0[0], v0[1]); w.y = cvt_pk_bf16(v0[2], v0[3]); w.z = cvt_pk_bf16(v1[0], v1[1]); w.w = cvt_pk_bf16(v1[2], v1[3]);
                    *(u32x4*)(O + row * ldc + col0 + bj * HALF) = w; } }
    }
};
}
constexpr int D_MODEL = 2048, BATCH = 2, SEQ = 4096, NTOK = BATCH * SEQ;
constexpr int HD = 64, NCMP = 255, CMP_STRIDE = 16, CMP_LEN = 32, CMP_HID = 128;
constexpr int SEL_LEN = 64, SEL_TOPK = 16, WINDOW = 512;
constexpr int PEER_KEYS = 128, PEER_E = 128;
constexpr int NSA_Q = 1024, SB_W = 1024;
constexpr int IN_COLS = 9776, PLD = 9984;
constexpr int C_SHIFT_FROM = 2608, C_SHIFT = 208, PP = 256;
constexpr int P_QN = 0, P_KC = 4, P_VC = 5, P_KS = 6, P_VS = 7, P_KW = 8, P_VW = 9, P_GBR = 10, P_QB = 11, P_KB = 15, P_VB = 19, P_GA = 23, P_GB = 31;
#define PNL(P, p) ((P) + (size_t)(p) * NTOK * PP)
constexpr float EPS = 1e-6f, NEGF = -1e30f;
constexpr int NWAVES = 8, NTHR = 512;

constexpr size_t MiB = 1u << 20;
constexpr size_t WS_CTL = 0, CTL_ZERO_BYTES = 1 * MiB;
constexpr size_t WS_WIN = 2 * MiB;
constexpr size_t WS_WBN = 42 * MiB, WS_WBS = 46 * MiB;
constexpr size_t WS_WOUT = 50 * MiB, WS_WPQ = 58 * MiB;
constexpr size_t WS_MISC = 66 * MiB;
constexpr size_t WS_XN = 70 * MiB;
constexpr size_t WS_PROJ = 102 * MiB;
constexpr size_t WS_ONSA = 258 * MiB, WS_OSB = 274 * MiB;
constexpr size_t WS_H = 290 * MiB;
constexpr size_t WS_HB = 354 * MiB;
constexpr size_t WS_END = 386 * MiB;
constexpr size_t WS_UB = 102 * MiB, WS_VB = 166 * MiB, WS_QP = 230 * MiB, WS_EXP = 262 * MiB, WS_GATE = 266 * MiB;
constexpr size_t MISC_KCB = 0, MISC_VCB = 1 * MiB, MISC_SKB = 2 * MiB, MISC_W1T = 2 * MiB + 512 * 1024, MISC_B1 = 3 * MiB + 512 * 1024;
constexpr int CW_BAR = 4096;
constexpr int CW_SS = 32768;

#define GAS __attribute__((address_space(1)))
#define LAS __attribute__((address_space(3)))
typedef unsigned short bf16;
typedef unsigned v4u __attribute__((ext_vector_type(4)));
typedef unsigned v2u __attribute__((ext_vector_type(2)));
typedef float f32x4 __attribute__((ext_vector_type(4)));
#define RLX_AGENT __ATOMIC_RELAXED, __HIP_MEMORY_SCOPE_AGENT
__device__ __forceinline__ unsigned f2bf(float f) { unsigned u = __builtin_bit_cast(unsigned, f); return (u + 0x7fffu + ((u >> 16) & 1u)) >> 16; }
__device__ __forceinline__ unsigned pk2(float lo, float hi) { return f2bf(lo) | (f2bf(hi) << 16); }
__device__ __forceinline__ float bf2f(bf16 b) { return __uint_as_float(((unsigned)b) << 16); }
__device__ __forceinline__ float bflo(unsigned w) { return __uint_as_float(w << 16); }
__device__ __forceinline__ float bfhi(unsigned w) { return __uint_as_float(w & 0xffff0000u); }

#define XB_TMO      128
#define XB_XCNT(j)  (256  + 64 * (j))
#define XB_XSUB(j)  (1280 + 64 * (j))
#define XB_XGEN(j)  (2304 + 64 * (j))
#define XB_TOP      3328
#define XB_TOPGEN   3392
#define XCD_BAR_WORDS 3456
#define XB_SPIN_CAP (1u << 24)
__device__ __forceinline__ unsigned xb_ld(unsigned* p)              { return __hip_atomic_load(p, __ATOMIC_RELAXED, __HIP_MEMORY_SCOPE_AGENT); }
__device__ __forceinline__ unsigned xb_add(unsigned* p, unsigned v) { return __hip_atomic_fetch_add(p, v, __ATOMIC_RELAXED, __HIP_MEMORY_SCOPE_AGENT); }
__device__ __forceinline__ unsigned xb_xcc_id() { return (unsigned)__builtin_amdgcn_s_getreg((3 << 11) | 20) & 0xFu; }
#define XB_SPIN(cond, bar) do { unsigned _sp = 0; while (cond) { __builtin_amdgcn_s_sleep(1); \
    if ((++_sp & 255u) == 0u) { if (xb_ld(&(bar)[XB_TMO])) break; if (_sp > XB_SPIN_CAP) { atomicAdd(&(bar)[XB_TMO], 1u); break; } } } } while (0)
struct XcdBarrier { unsigned* bar; unsigned x; volatile LAS unsigned* st; };
__device__ __forceinline__ XcdBarrier xcd_barrier_post(unsigned* bar, volatile LAS unsigned* st) {
    XcdBarrier b; b.bar = bar; b.x = xb_xcc_id(); b.st = st;
    if (threadIdx.x == 0) (void)xb_add(&bar[XB_XCNT(b.x)], 1u);
    return b;
}
__device__ __forceinline__ void xcd_barrier_complete(unsigned* bar, unsigned x, unsigned& nloc, unsigned& nx) {
    const unsigned G = gridDim.x * gridDim.y * gridDim.z;
    unsigned sum, cnt, mine, sp = 0u;
    for (;;) {
        sum = 0u; cnt = 0u; mine = 0u;
#pragma unroll
        for (unsigned j = 0; j < 16; ++j) { const unsigned c = xb_ld(&bar[XB_XCNT(j)]); sum += c; cnt += (c > 0u) ? 1u : 0u; mine = (j == x) ? c : mine; }
        if (sum == G) break;
        __builtin_amdgcn_s_sleep(1);
        if ((++sp & 255u) == 0u) { if (xb_ld(&bar[XB_TMO])) break; if (sp > XB_SPIN_CAP) { atomicAdd(&bar[XB_TMO], 1u); break; } }
    }
    nloc = mine > 0u ? mine : 1u; nx = cnt > 0u ? cnt : 1u;
}
__device__ __forceinline__ void xcd_barrier(const XcdBarrier& b) {
    asm volatile("s_waitcnt vmcnt(0)" ::: "memory");
    __syncthreads();
    if (threadIdx.x == 0) {
        unsigned* bar = b.bar;
        const unsigned bx = xb_xcc_id();
        __builtin_amdgcn_s_waitcnt(0);
        unsigned nloc = b.st[0], nx = b.st[1];
        if (nloc == 0u) { xcd_barrier_complete(bar, bx, nloc, nx); b.st[0] = nloc; b.st[1] = nx; }
        const unsigned old = xb_add(&bar[XB_XSUB(bx)], 1u);
        const unsigned gen = old / nloc;
        if (old + 1u == (gen + 1u) * nloc) {
            __builtin_amdgcn_fence(__ATOMIC_RELEASE, "agent");
            asm volatile("s_waitcnt vmcnt(0)" ::: "memory");
            const unsigned og = xb_add(&bar[XB_TOP], 1u);
            const unsigned tg = og / nx;
            if (og + 1u == (tg + 1u) * nx) xb_add(&bar[XB_TOPGEN], 1u);
            else XB_SPIN(xb_ld(&bar[XB_TOPGEN]) == tg, bar);
            __builtin_amdgcn_fence(__ATOMIC_ACQUIRE, "agent");
            xb_add(&bar[XB_XGEN(bx)], 1u);
            asm volatile("s_waitcnt vmcnt(0)" ::: "memory");
        } else {
            XB_SPIN(xb_ld(&bar[XB_XGEN(bx)]) == gen, bar);
            __builtin_amdgcn_fence(__ATOMIC_ACQUIRE, "agent");
            asm volatile("s_waitcnt vmcnt(0)" ::: "memory");
        }
    }
    __syncthreads();
}

__device__ __forceinline__ int rel_bucket(int d) {
    if (d < 16) return d < 0 ? 0 : d;
    int b = 16;
    b += (d >= 21); b += (d >= 27); b += (d >= 35); b += (d >= 46); b += (d >= 59); b += (d >= 77); b += (d >= 99); b += (d >= 128);
    b += (d >= 166); b += (d >= 216); b += (d >= 280); b += (d >= 363); b += (d >= 470); b += (d >= 609); b += (d >= 790);
    return b;
}
__device__ __forceinline__ float gelu_tanh(float x) { const float k = 0.7978845608028654f; return 0.5f * x * (1.f + tanhf(k * (x + 0.044715f * x * x * x))); }
__device__ __forceinline__ float sigmoidf_(float x) { return 1.f / (1.f + expf(-x)); }
#define DPP_ROR(v, n) __builtin_bit_cast(float, __builtin_amdgcn_update_dpp(0, __builtin_bit_cast(int, (v)), 0x120 + (n), 0xf, 0xf, false))
__device__ __forceinline__ float row_sum16(float v) { v += DPP_ROR(v, 8); v += DPP_ROR(v, 4); v += DPP_ROR(v, 2); v += DPP_ROR(v, 1); return v; }
__device__ __forceinline__ float row_max16(float v) { v = fmaxf(v, DPP_ROR(v, 8)); v = fmaxf(v, DPP_ROR(v, 4)); v = fmaxf(v, DPP_ROR(v, 2)); v = fmaxf(v, DPP_ROR(v, 1)); return v; }
__device__ __forceinline__ float wave_sum(float v) {
    v = row_sum16(v);
    { const auto r = __builtin_amdgcn_permlane16_swap(__float_as_uint(v), __float_as_uint(v), false, false); v = __uint_as_float(r[0]) + __uint_as_float(r[1]); }
    { const auto r = __builtin_amdgcn_permlane32_swap(__float_as_uint(v), __float_as_uint(v), false, false); v = __uint_as_float(r[0]) + __uint_as_float(r[1]); }
    return v;
}
__device__ __forceinline__ float wave_max(float v) {
    v = row_max16(v);
    { const auto r = __builtin_amdgcn_permlane16_swap(__float_as_uint(v), __float_as_uint(v), false, false); v = fmaxf(__uint_as_float(r[0]), __uint_as_float(r[1])); }
    { const auto r = __builtin_amdgcn_permlane32_swap(__float_as_uint(v), __float_as_uint(v), false, false); v = fmaxf(__uint_as_float(r[0]), __uint_as_float(r[1])); }
    return v;
}
__device__ __forceinline__ float gelu_tanh_fast(float x) { const float y2 = x * (1.5957691216057308f + 0.0713548162726f * x * x);
    return x * __builtin_amdgcn_rcpf(1.f + __builtin_amdgcn_exp2f(-1.4426950408889634f * y2)); }
__device__ __forceinline__ float half_sum(float v, float* red) {
    v = wave_sum(v);
    __syncthreads();
    if ((threadIdx.x & 63) == 0) red[(threadIdx.x >> 6) & 3] = v;
    __syncthreads();
    return red[0] + red[1] + red[2] + red[3];
}
__device__ __forceinline__ float half_max(float v, float* red) {
    v = wave_max(v);
    __syncthreads();
    if ((threadIdx.x & 63) == 0) red[(threadIdx.x >> 6) & 3] = v;
    __syncthreads();
    return fmaxf(fmaxf(red[0], red[1]), fmaxf(red[2], red[3]));
}

struct Args {
    const float* in[19]; float* out; unsigned char* ws; int ph_lo, ph_hi; int variant, pad;
};

struct P0Item { const float* W; bf16* WT; const float* gk; int K, N, item, shift_from, shift; };
__device__ __forceinline__ void p0_item_load(const P0Item& d, int lane, f32x4 (&v)[8]) {
    const int nblk = (d.N + 31) / 32, kb = d.item / nblk, nb = d.item % nblk, k0 = 64 * kb, n0 = 32 * nb;
    const int c4 = (lane & 7) * 4, r8 = lane >> 3;
    const bool cok = (n0 + c4) < d.N;
#pragma unroll
    for (int i = 0; i < 8; ++i) { const int kk = 8 * i + r8; v[i] = cok ? __builtin_nontemporal_load((const f32x4*)(d.W + (size_t)(k0 + kk) * d.N + n0 + c4)) : (f32x4){0.f, 0.f, 0.f, 0.f}; }
}
__device__ __forceinline__ void p0_item_store(const P0Item& d, int lane, const f32x4 (&v)[8], LAS float* scr) {
    const int nblk = (d.N + 31) / 32, kb = d.item / nblk, nb = d.item % nblk, k0 = 64 * kb, n0 = 32 * nb;
    const int c4 = (lane & 7) * 4, r8 = lane >> 3;
#pragma unroll
    for (int i = 0; i < 8; ++i) { const int kk = 8 * i + r8; const float g = d.gk ? d.gk[k0 + kk] : 1.f;
        scr[kk * 33 + c4 + 0] = v[i].x * g; scr[kk * 33 + c4 + 1] = v[i].y * g; scr[kk * 33 + c4 + 2] = v[i].z * g; scr[kk * 33 + c4 + 3] = v[i].w * g; }
    asm volatile("s_waitcnt lgkmcnt(0)" ::: "memory");
    const int c = lane & 7;
#pragma unroll
    for (int j = 0; j < 4; ++j) { const int n = (lane >> 3) + 8 * j; const LAS float* s = scr + (8 * c) * 33 + n;
        v4u o; o.x = pk2(s[0 * 33], s[1 * 33]); o.y = pk2(s[2 * 33], s[3 * 33]); o.z = pk2(s[4 * 33], s[5 * 33]); o.w = pk2(s[6 * 33], s[7 * 33]);
        const int nd = n0 + n + ((n0 + n >= d.shift_from) ? d.shift : 0);
        if (n0 + n < d.N) *(v4u*)(d.WT + (size_t)nd * d.K + k0 + 8 * c) = o; }
    asm volatile("s_waitcnt lgkmcnt(0)" ::: "memory");
}
__device__ __forceinline__ void rms_row_load(const float* xrow, int lane, f32x4 (&v)[8]) {
    const f32x4* xr = (const f32x4*)xrow + lane;
#pragma unroll
    for (int j = 0; j < 8; ++j) v[j] = __builtin_nontemporal_load(xr + 64 * j);
}
__device__ __forceinline__ void rms_row_finish(const f32x4 (&v)[8], const float* g, bf16* orow, int lane) {
    const f32x4* gr = (const f32x4*)g + lane;
    float s = 0.f;
#pragma unroll
    for (int j = 0; j < 8; ++j) s += (v[j].x * v[j].x + v[j].y * v[j].y) + (v[j].z * v[j].z + v[j].w * v[j].w);
    const float r = rsqrtf(wave_sum(s) * (1.f / D_MODEL) + EPS);
    v2u* o8 = (v2u*)orow + lane;
#pragma unroll
    for (int j = 0; j < 8; ++j) { const f32x4 gv = gr[64 * j]; v2u w; w.x = pk2(v[j].x * r * gv.x, v[j].y * r * gv.y); w.y = pk2(v[j].z * r * gv.z, v[j].w * r * gv.w); o8[64 * j] = w; }
}
__device__ __forceinline__ void rms_row_to_bf16(const float* xrow, const float* g, bf16* orow, int lane) {
    f32x4 v[8]; rms_row_load(xrow, lane, v); rms_row_finish(v, g, orow, lane);
}
__device__ __forceinline__ void cvt_flat(const float* src, bf16* dst, size_t n, size_t gthread, size_t nthreads) {
    for (size_t i = gthread * 8; i < n; i += nthreads * 8) {
        const f32x4 a = *(const f32x4*)(src + i), b = *(const f32x4*)(src + i + 4);
        v4u o; o.x = pk2(a.x, a.y); o.y = pk2(a.z, a.w); o.z = pk2(b.x, b.y); o.w = pk2(b.z, b.w);
        *(v4u*)(dst + i) = o;
    }
}
namespace cmpr {
typedef short bf16x8 __attribute__((ext_vector_type(8)));
typedef float f32x4v __attribute__((ext_vector_type(4)));
__device__ __forceinline__ void compress_phase(const bf16* PROJ, const bf16* W1T, const float* BIAS1, const float* const* in, bf16* KCB, bf16* VCB,
                                               __attribute__((address_space(3))) unsigned char* lds3, int bid, int G) {
    int tid = threadIdx.x; asm volatile("" : "+v"(tid));
    const int lane = tid & 63, wid = __builtin_amdgcn_readfirstlane(tid >> 6), r16 = lane & 15, kq = lane >> 4;
    __attribute__((address_space(3))) float* PART = (__attribute__((address_space(3))) float*)lds3;
    __attribute__((address_space(3))) float* HID = (__attribute__((address_space(3))) float*)(lds3 + 65536);
    __attribute__((address_space(3))) float* W2S = (__attribute__((address_space(3))) float*)(lds3 + 73728);
    for (int unit = bid; unit < 256; unit += G) {
        const int c = unit & 15, g = (unit >> 4) & 3, b = (unit >> 6) & 1, kv = unit >> 7, n0 = 16 * c;
        int nn = n0 + r16; if (nn > NCMP - 1) nn = NCMP - 1;
        const bf16* ap = PNL(PROJ, kv ? P_VC : P_KC) + (size_t)(b * SEQ + 16 * nn + 4 * wid) * PP + g * HD + 8 * kq;
        const bf16* bp = W1T + (size_t)kv * CMP_HID * 2048 + (size_t)r16 * 2048 + 256 * wid + 8 * kq;
        { const float* w2g = in[kv ? 8 : 5];
#pragma unroll
          for (int i = 0; i < 4; ++i) *(__attribute__((address_space(3))) f32x4v*)(W2S + (tid + NTHR * i) * 4) = *(const f32x4v*)(w2g + (tid + NTHR * i) * 4); }
        f32x4v acc[8] = {};
        bf16x8 af[8];
#pragma unroll
        for (int ks = 0; ks < 8; ++ks) af[ks] = *(const bf16x8*)(ap + (size_t)(ks >> 1) * PP + (ks & 1) * 32);
        bf16x8 wa[8], wb[8];
#define CMP_LOADW(W, KS) do { _Pragma("unroll") for (int nt = 0; nt < 8; ++nt) W[nt] = *(const bf16x8*)(bp + (size_t)nt * 16 * 2048 + (KS) * 32); } while (0)
#define CMP_MMA(W, KS) do { _Pragma("unroll") for (int nt = 0; nt < 8; ++nt) acc[nt] = __builtin_amdgcn_mfma_f32_16x16x32_bf16(af[KS], W[nt], acc[nt], 0, 0, 0); } while (0)
        CMP_LOADW(wa, 0);
#pragma unroll
        for (int ks = 0; ks < 8; ks += 2) {
            CMP_LOADW(wb, ks + 1); __builtin_amdgcn_sched_barrier(0);
            CMP_MMA(wa, ks); __builtin_amdgcn_sched_barrier(0);
            if (ks + 2 < 8) CMP_LOADW(wa, ks + 2);
            __builtin_amdgcn_sched_barrier(0);
            CMP_MMA(wb, ks + 1); __builtin_amdgcn_sched_barrier(0);
        }
#undef CMP_LOADW
#undef CMP_MMA
#pragma unroll
        for (int nt = 0; nt < 8; ++nt)
#pragma unroll
            for (int r = 0; r < 4; ++r) PART[wid * 2048 + (kq * 4 + r) * 128 + nt * 16 + r16] = acc[nt][r];
        asm volatile("s_waitcnt lgkmcnt(0)" ::: "memory"); __syncthreads();
#pragma unroll
        for (int i = 0; i < 4; ++i) { const int e = tid + NTHR * i; float s = BIAS1[kv * CMP_HID + (e & 127)];
#pragma unroll
            for (int w = 0; w < 8; ++w) s += PART[w * 2048 + e];
            HID[e] = gelu_tanh(s); }
        asm volatile("s_waitcnt lgkmcnt(0)" ::: "memory"); __syncthreads();
        {
            const int nl = tid >> 5, d = (tid & 31) * 2;
            float o0 = 0.f, o1 = 0.f;
#pragma unroll 8
            for (int j = 0; j < CMP_HID; ++j) { const float hv = HID[nl * 128 + j]; const float wx = W2S[j * HD + d], wy = W2S[j * HD + d + 1]; o0 += hv * wx; o1 += hv * wy; }
            const int n = n0 + nl;
            const unsigned pk = (n < NCMP) ? pk2(o0, o1) : 0u;
            *(unsigned*)((kv ? VCB : KCB) + (size_t)((b * 4 + g) * 256 + n) * HD + d) = pk;
        }
        __syncthreads();
    }
}
}
#ifndef NSA_FAR
#define NSA_FAR 1
#endif
namespace nsa {
typedef short bf16x8 __attribute__((ext_vector_type(8)));
typedef short s16x4 __attribute__((ext_vector_type(4)));
typedef float f32x16 __attribute__((ext_vector_type(16)));
typedef unsigned u32x4 __attribute__((ext_vector_type(4)));
typedef __attribute__((address_space(3))) const char* lds_cptr;
typedef __attribute__((address_space(3))) unsigned char* lds_ptr;
constexpr int SLOTB = 16384;
constexpr int NSLOT = 4;
constexpr int L_RING = 0, L_OV = 65536, L_BT = 98304, L_WSF = 111104, L_MASK = 113152, L_MISC = 113664, L_X = 113792, L_END = L_X + 32768;
constexpr int BT_N = 800;
constexpr int BT_LO = 96, BT_HI = 96, BT_P = BT_LO + BT_N + BT_HI, BT_NEG = 96, L_BTP = L_END;
static_assert(L_BTP + (4 * BT_P + BT_NEG) * 4 <= 162816, "LDS overflow");
constexpr float LOG2E = 1.4426950408889634f, SC2 = 0.125f * LOG2E, NEG2 = -1e30f;
static_assert(L_END <= 162816, "nsa LDS map");
__device__ __forceinline__ int crow(int r, int hi) { return (r & 3) + 8 * (r >> 2) + 4 * hi; }
__device__ __forceinline__ void glds16(const void* gsrc, unsigned lds_dst) { unsigned keep;
    asm volatile("s_mov_b32 %0, m0\n\ts_mov_b32 m0, %2\n\ts_nop 0\n\tglobal_load_lds_dwordx4 %1, off\n\ts_mov_b32 m0, %0" : "=&s"(keep) : "v"(gsrc), "s"(lds_dst) : "memory"); }
typedef float f32x2_t __attribute__((ext_vector_type(2))); typedef __bf16 bf16x2_t __attribute__((ext_vector_type(2)));
__device__ __forceinline__ unsigned cvtpk_s(float lo, float hi) { f32x2_t v = {lo, hi}; bf16x2_t b = __builtin_convertvector(v, bf16x2_t); return __builtin_bit_cast(unsigned, b); }
#define NSA_WAIT_BAR(N) asm volatile("s_waitcnt vmcnt(" #N ") lgkmcnt(0)\n\ts_barrier" ::: "memory")
#define NSA_SBAR() __builtin_amdgcn_sched_barrier(0)

__device__ __forceinline__ void qkt(f32x16& p0, f32x16& p1, lds_cptr Kslot, const bf16x8* qr, int r32, int hi) {
    lds_cptr kb = Kslot + hi * 1024 + r32 * 16;
    const f32x16 z = {};
#pragma unroll
    for (int d0 = 0; d0 < 4; ++d0) {
        const bf16x8 b0 = *(const __attribute__((address_space(3))) bf16x8*)(kb + d0 * 2048);
        const bf16x8 b1 = *(const __attribute__((address_space(3))) bf16x8*)(kb + d0 * 2048 + 512);
        if (d0 == 0) { p0 = __builtin_amdgcn_mfma_f32_32x32x16_bf16(b0, qr[0], z, 0, 0, 0); p1 = __builtin_amdgcn_mfma_f32_32x32x16_bf16(b1, qr[0], z, 0, 0, 0); }
        else { p0 = __builtin_amdgcn_mfma_f32_32x32x16_bf16(b0, qr[d0], p0, 0, 0, 0); p1 = __builtin_amdgcn_mfma_f32_32x32x16_bf16(b1, qr[d0], p1, 0, 0, 0); }
    }
}
__device__ __forceinline__ void pv(f32x16* o, int vb, bf16x8 pa0, bf16x8 pa1, bf16x8 pa2, bf16x8 pa3) {
#pragma unroll
    for (int d0 = 0; d0 < 2; ++d0) { s16x4 lo[4], hi[4];
#pragma unroll
        for (int ks = 0; ks < 4; ++ks) {
            asm volatile("ds_read_b64_tr_b16 %0,%1 offset:%c2" : "=&v"(lo[ks]) : "v"(vb), "i"(d0 * 4096 + ks * 1024) : "memory");
            asm volatile("ds_read_b64_tr_b16 %0,%1 offset:%c2" : "=&v"(hi[ks]) : "v"(vb), "i"(d0 * 4096 + ks * 1024 + 512) : "memory"); }
        asm volatile("s_waitcnt lgkmcnt(0)" ::: "memory"); NSA_SBAR();
#define NSA_PK(k) (bf16x8){lo[k][0], lo[k][1], lo[k][2], lo[k][3], hi[k][0], hi[k][1], hi[k][2], hi[k][3]}
        o[d0] = __builtin_amdgcn_mfma_f32_32x32x16_bf16(pa0, NSA_PK(0), o[d0], 0, 0, 0);
        o[d0] = __builtin_amdgcn_mfma_f32_32x32x16_bf16(pa1, NSA_PK(1), o[d0], 0, 0, 0);
        o[d0] = __builtin_amdgcn_mfma_f32_32x32x16_bf16(pa2, NSA_PK(2), o[d0], 0, 0, 0);
        o[d0] = __builtin_amdgcn_mfma_f32_32x32x16_bf16(pa3, NSA_PK(3), o[d0], 0, 0, 0);
#undef NSA_PK
    }
}
__device__ __forceinline__ float rowmax32(const f32x16& p0, const f32x16& p1) {
    float a = fmaxf(p0[0], p1[0]), b = fmaxf(p0[1], p1[1]);
#pragma unroll
    for (int r = 2; r < 16; r += 2) { a = fmaxf(fmaxf(a, p0[r]), p1[r]); b = fmaxf(fmaxf(b, p0[r + 1]), p1[r + 1]); }
    a = fmaxf(a, b);
    auto rr = __builtin_amdgcn_permlane32_swap(__float_as_uint(a), __float_as_uint(a), false, false);
    return fmaxf(__uint_as_float(rr[0]), __uint_as_float(rr[1]));
}
__device__ __forceinline__ float sum16(const f32x16& p) {
    float a, b;
    asm volatile("s_nop 0\n\tv_add_f32 %0, %2, %3\n\tv_add_f32 %1, %4, %5\n\tv_add_f32 %0, %0, %6\n\tv_add_f32 %1, %1, %7\n\tv_add_f32 %0, %0, %8\n\tv_add_f32 %1, %1, %9\n\t"
                 "v_add_f32 %0, %0, %10\n\tv_add_f32 %1, %1, %11\n\tv_add_f32 %0, %0, %12\n\tv_add_f32 %1, %1, %13\n\tv_add_f32 %0, %0, %14\n\tv_add_f32 %1, %1, %15\n\t"
                 "v_add_f32 %0, %0, %16\n\tv_add_f32 %1, %1, %17\n\tv_add_f32 %0, %0, %1"
                 : "=&v"(a), "=&v"(b)
                 : "v"(p[0]), "v"(p[1]), "v"(p[2]), "v"(p[3]), "v"(p[4]), "v"(p[5]), "v"(p[6]), "v"(p[7]), "v"(p[8]), "v"(p[9]), "v"(p[10]), "v"(p[11]), "v"(p[12]), "v"(p[13]), "v"(p[14]), "v"(p[15]));
    return a;
}
__device__ __forceinline__ float swap_add(float v) {
    auto rr = __builtin_amdgcn_permlane32_swap(__float_as_uint(v), __float_as_uint(v), false, false);
    return __uint_as_float(rr[0]) + __uint_as_float(rr[1]);
}

struct PassCtx {
    lds_ptr lds3; unsigned lds0;
    int lane, r32, hi, wid;
    int tq;
    const __attribute__((address_space(3))) float* bt;
    __attribute__((address_space(3))) float* wsf;
    int vboff;
};

template <int MODE>
__device__ __forceinline__ void run_pass(const PassCtx& c, int NT, int first, const bf16* Kb, const bf16* Vb, int pitch, const bf16x8* qr,
                                         unsigned mask_lo, unsigned mask_hi, f32x16 (&o)[2], f32x16 (&im)[2], float& m, float& l) {
    const __attribute__((address_space(3))) unsigned char* TL = (const __attribute__((address_space(3))) unsigned char*)(c.lds3 + L_MISC);
#define NSA_TID(i) ((MODE == 0) ? (i) : (MODE == 2) ? (first + (i)) : (int)TL[NT - 1 - (i)])
#define NSA_ISSUE(i, slot) do { const int id_ = __builtin_amdgcn_readfirstlane(NSA_TID(i)); \
        const bf16* ks_ = Kb + (size_t)(64 * id_ + c.lane) * pitch + 8 * c.wid; \
        const bf16* vs_ = Vb + (size_t)(64 * id_ + 16 * (c.wid & 3) + (c.lane >> 2)) * pitch + 32 * (c.wid >> 2) + 8 * (c.lane & 3); \
        glds16(ks_, (unsigned)__builtin_amdgcn_readfirstlane(c.lds0 + L_RING + (slot) * SLOTB + c.wid * 1024)); \
        glds16(vs_, (unsigned)__builtin_amdgcn_readfirstlane(c.lds0 + L_RING + (slot) * SLOTB + 8192 + c.wid * 1024)); } while (0)
    if (NT > 0) NSA_ISSUE(0, 0);
    if (NT > 1) NSA_ISSUE(1, 1);
    if (NT > 2) NSA_ISSUE(2, 2);
    int slot = 0;
    for (int i = 0; i < NT; ++i) {
        if (i + 2 < NT) NSA_WAIT_BAR(4); else if (i + 1 < NT) NSA_WAIT_BAR(2); else NSA_WAIT_BAR(0);
        if (i + 3 < NT) { const int s3 = (slot == 0) ? 3 : slot - 1; NSA_ISSUE(i + 3, s3); }
        const int id = __builtin_amdgcn_readfirstlane(NSA_TID(i));
        f32x16 p0, p1;
        qkt(p0, p1, (lds_cptr)(c.lds3 + L_RING + slot * SLOTB), qr, c.r32, c.hi);
        const int dbase = (MODE == 0) ? (c.tq - 31 - 1024 * id) : (c.tq - 64 * id);
        bool selb = true;
        if (MODE == 1) selb = ((id < 32 ? (mask_lo >> id) : (mask_hi >> (id - 32))) & 1u) != 0u;
        float alpha, rs;
        if (NSA_FAR && MODE == 1 && __builtin_amdgcn_readfirstlane(c.tq - c.r32) - (64 * id + 63) >= 790) {
            const float lofs = selb ? c.bt[790] : -INFINITY;
            const float mt = rowmax32(p0, p1) * SC2 + lofs;
            const float mnew = fmaxf(m, mt);
            alpha = __builtin_amdgcn_exp2f(m - mnew);
            m = mnew;
            const float off = lofs - mnew;
#pragma unroll
            for (int r = 0; r < 16; ++r) { p0[r] = __builtin_amdgcn_exp2f(p0[r] * SC2 + off); p1[r] = __builtin_amdgcn_exp2f(p1[r] * SC2 + off); }
        } else {
        if (MODE != 0 && NSA_FAR) {
        int dbh = dbase - 4 * c.hi;
        asm volatile("" : "+v"(dbh));
        unsigned ba = (unsigned)(uintptr_t)c.bt + 4u * (unsigned)dbh;
        if (MODE == 1) ba = selb ? ba : (c.lds0 + L_BTP + 4u * (4 * BT_P + BT_NEG - 1));
        ba -= 236u;
        asm volatile("" : "+v"(ba));
        const __attribute__((address_space(3))) float* bp = (const __attribute__((address_space(3))) float*)(uintptr_t)ba;
#pragma unroll
        for (int r = 0; r < 16; ++r) {
            const int cr = (r & 3) + 8 * (r >> 2);
            const float b0 = bp[59 - cr], b1 = bp[27 - cr];
            float s0 = p0[r] * SC2 + b0, s1 = p1[r] * SC2 + b1;
            if (MODE == 2) { const int d0 = dbh - cr, d1 = d0 - 32; s0 = (unsigned)d0 < (unsigned)WINDOW ? s0 : -INFINITY; s1 = (unsigned)d1 < (unsigned)WINDOW ? s1 : -INFINITY; }
            p0[r] = s0; p1[r] = s1;
        }
        } else {
        int dbh = dbase - ((MODE == 0) ? 64 * c.hi : 4 * c.hi);
        asm volatile("" : "+v"(dbh));
#pragma unroll
        for (int r = 0; r < 16; ++r) {
            const int d0 = dbh - ((MODE == 0) ? 16 * ((r & 3) + 8 * (r >> 2)) : ((r & 3) + 8 * (r >> 2)));
            const int d1 = (MODE == 0) ? (d0 - 512) : (d0 - 32);
            bool v0 = d0 >= 0, v1 = d1 >= 0;
            if (MODE == 2) { v0 = (unsigned)d0 < (unsigned)WINDOW; v1 = (unsigned)d1 < (unsigned)WINDOW; }
            if (MODE == 1) { v0 = v0 && selb; v1 = v1 && selb; }
            const bool clampd = (MODE == 0) || !NSA_FAR;
            const int i0 = clampd ? (d0 < 0 ? 0 : (d0 > 790 ? 790 : d0)) : d0, i1 = clampd ? (d1 < 0 ? 0 : (d1 > 790 ? 790 : d1)) : d1;
            const float s0 = p0[r] * SC2 + c.bt[i0], s1 = p1[r] * SC2 + c.bt[i1];
            p0[r] = v0 ? s0 : -INFINITY; p1[r] = v1 ? s1 : -INFINITY;
        }
        }
        const float mt = rowmax32(p0, p1);
        const float mnew = fmaxf(m, mt);
        alpha = __builtin_amdgcn_exp2f(m - mnew);
        m = mnew;
#pragma unroll
        for (int r = 0; r < 16; ++r) {
            const float e0 = __builtin_amdgcn_exp2f(p0[r] - mnew), e1 = __builtin_amdgcn_exp2f(p1[r] - mnew);
            p0[r] = e0; p1[r] = e1;
        }
        }
        rs = sum16(p0) + sum16(p1);
        l = l * alpha + rs;
        if (!__all(alpha == 1.f)) {
            if (c.hi == 0) c.wsf[c.r32] = alpha;
            asm volatile("s_waitcnt lgkmcnt(0)" ::: "memory");
#pragma unroll
            for (int r = 0; r < 16; ++r) { const float a = c.wsf[crow(r, c.hi)]; o[0][r] *= a; o[1][r] *= a; if (MODE == 0) { im[0][r] *= a; im[1][r] *= a; } }
        }
        u32x4 pw0, pw1, pw2, pw3;
        pw0 = (u32x4){cvtpk_s(p0[0], p0[1]), cvtpk_s(p0[2], p0[3]), cvtpk_s(p0[4], p0[5]), cvtpk_s(p0[6], p0[7])};
        pw1 = (u32x4){cvtpk_s(p0[8], p0[9]), cvtpk_s(p0[10], p0[11]), cvtpk_s(p0[12], p0[13]), cvtpk_s(p0[14], p0[15])};
        pw2 = (u32x4){cvtpk_s(p1[0], p1[1]), cvtpk_s(p1[2], p1[3]), cvtpk_s(p1[4], p1[5]), cvtpk_s(p1[6], p1[7])};
        pw3 = (u32x4){cvtpk_s(p1[8], p1[9]), cvtpk_s(p1[10], p1[11]), cvtpk_s(p1[12], p1[13]), cvtpk_s(p1[14], p1[15])};
        NSA_SBAR();
        pv(o, (int)(c.lds0 + L_RING + slot * SLOTB + 8192) + c.vboff, __builtin_bit_cast(bf16x8, pw0), __builtin_bit_cast(bf16x8, pw1), __builtin_bit_cast(bf16x8, pw2), __builtin_bit_cast(bf16x8, pw3));
        if (MODE == 0) pv(im, (int)(c.lds0 + L_OV + id * 8192) + c.vboff, __builtin_bit_cast(bf16x8, pw0), __builtin_bit_cast(bf16x8, pw1), __builtin_bit_cast(bf16x8, pw2), __builtin_bit_cast(bf16x8, pw3));
        slot = (slot == NSLOT - 1) ? 0 : slot + 1;
    }
    asm volatile("s_waitcnt vmcnt(0) lgkmcnt(0)\n\ts_barrier" ::: "memory");
#undef NSA_TID
#undef NSA_ISSUE
}

__device__ __forceinline__ void build_ov(lds_ptr lds3) {
    for (int idx = threadIdx.x; idx < 4 * 4096; idx += NTHR) {
        const int kt = idx >> 12, nl = (idx >> 6) & 63, jc = idx & 63, n = 64 * kt + nl;
        unsigned short v = 0;
        if ((n & 3) != 3) { if (jc == (n >> 2)) v = 0x3F80; } else { if (jc == (n >> 2) || jc == (n >> 2) + 1) v = 0x3F00; }
        *(__attribute__((address_space(3))) unsigned short*)(lds3 + L_OV + kt * 8192 + ((jc >> 5) * 4 + (nl >> 4)) * 1024 + (nl & 15) * 64 + (jc & 31) * 2) = v;
    }
}

__device__ __forceinline__ void nsa_unit(int variant, bool build_bt, int b, int g, int qt, const bf16* PROJ, const bf16* KCBb, const bf16* VCBb, const float* rel, bf16* ONSA, lds_ptr lds3, unsigned lds0) {
    const int tid = threadIdx.x, lane = tid & 63, r32 = lane & 31, hi = lane >> 5;
    const int wid = __builtin_amdgcn_readfirstlane(tid >> 6), hh = wid & 3, th = wid >> 2;
    const int t0 = qt * 64, tq = t0 + 32 * th + r32, cur = qt;
    __attribute__((address_space(3))) float* BT = (__attribute__((address_space(3))) float*)(lds3 + L_BTP);
    __attribute__((address_space(3))) unsigned* MASK = (__attribute__((address_space(3))) unsigned*)(lds3 + L_MASK);
    if (build_bt) for (int i = tid; i < 4 * BT_P; i += NTHR) { const int hq_ = i / BT_P, d_ = i - hq_ * BT_P - BT_LO;
        BT[i] = d_ < 0 ? -INFINITY : rel[(g * 4 + hq_) * BT_N + (d_ > 790 ? 790 : d_)]; }
    if (build_bt && tid < BT_NEG) BT[4 * BT_P + tid] = -INFINITY;
    if (tid < 128) MASK[tid] = 0u;
    PassCtx c; c.lds3 = lds3; c.lds0 = lds0; c.lane = lane; c.r32 = r32; c.hi = hi; c.wid = wid; c.tq = tq;
    c.bt = BT + hh * BT_P + BT_LO; c.wsf = (__attribute__((address_space(3))) float*)(lds3 + L_WSF) + wid * 64;
    c.vboff = ((lane >> 4) & 1) * 32 + (lane & 3) * 8 + (4 * hi + ((lane & 15) >> 2)) * 64;
    const size_t qrow = (size_t)(b * SEQ + tq) * PP;
    bf16x8 qr[4];
#pragma unroll
    for (int d0 = 0; d0 < 4; ++d0) qr[d0] = *(const bf16x8*)(PNL(PROJ, P_QN + g) + qrow + hh * HD + d0 * 16 + hi * 8);
    const float gate0 = 1.f / (1.f + __expf(-bf2f(PNL(PROJ, P_GBR)[qrow + 0 * 16 + g * 4 + hh])));
    const float gate1 = 1.f / (1.f + __expf(-bf2f(PNL(PROJ, P_GBR)[qrow + 1 * 16 + g * 4 + hh])));
    const float gate2 = 1.f / (1.f + __expf(-bf2f(PNL(PROJ, P_GBR)[qrow + 2 * 16 + g * 4 + hh])));
    asm volatile("s_waitcnt vmcnt(0) lgkmcnt(0)" ::: "memory");
    __syncthreads();
    f32x16 oc[2] = {}, o[2] = {}, im[2] = {};
    float m = NEG2, l = 0.f;
    {
        int cnt = (t0 + 32) / 16 + 1; if (cnt > NCMP) cnt = NCMP;
        const int NT = (variant & 4) ? 0 : ((cnt + 63) >> 6);
#if defined(PROBE_NSA_CMP2)
        run_pass<0>(c, NT, 0, KCBb + (size_t)(b * 4 + g) * 256 * HD, VCBb + (size_t)(b * 4 + g) * 256 * HD, HD, qr, 0u, 0u, o, im, m, l);
        o[0] = f32x16{}; o[1] = f32x16{}; im[0] = f32x16{}; im[1] = f32x16{}; m = NEG2; l = 0.f;
#endif
        run_pass<0>(c, NT, 0, KCBb + (size_t)(b * 4 + g) * 256 * HD, VCBb + (size_t)(b * 4 + g) * 256 * HD, HD, qr, 0u, 0u, o, im, m, l);
        const float lt = swap_add(l);
        const float inv = lt > 0.f ? 1.f / lt : 0.f;
        if (hi == 0) { c.wsf[r32] = inv * gate0; c.wsf[32 + r32] = inv; }
        asm volatile("s_waitcnt lgkmcnt(0)" ::: "memory");
#pragma unroll
        for (int r = 0; r < 16; ++r) { const float a = c.wsf[crow(r, hi)], a2 = c.wsf[32 + crow(r, hi)]; oc[0][r] = o[0][r] * a; oc[1][r] = o[1][r] * a; im[0][r] *= a2; im[1][r] *= a2; }
        if (!(variant & 8)) {
        {
            __attribute__((address_space(3))) float* PW = (__attribute__((address_space(3))) float*)(lds3 + L_RING) + wid * 2048;
#pragma unroll
            for (int d0 = 0; d0 < 2; ++d0)
#pragma unroll
                for (int r = 0; r < 16; ++r) PW[crow(r, hi) * 64 + d0 * 32 + r32] = im[d0][r];
        }
        asm volatile("s_waitcnt lgkmcnt(0)" ::: "memory"); __syncthreads();
        __attribute__((address_space(3))) float* T = (__attribute__((address_space(3))) float*)(lds3 + L_X);
        {
            const __attribute__((address_space(3))) float* PA = (const __attribute__((address_space(3))) float*)(lds3 + L_RING);
            int tx = tid; asm volatile("" : "+v"(tx));
            const int j = tx & 63, tb = (tx >> 6) * 8;
#pragma unroll
            for (int e = 0; e < 8; ++e) { const int tok = tb + e, w0 = (tok >> 5) * 4, q = tok & 31;
                T[tok * 65 + j] = (PA[(w0 + 0) * 2048 + q * 64 + j] + PA[(w0 + 1) * 2048 + q * 64 + j]) + (PA[(w0 + 2) * 2048 + q * 64 + j] + PA[(w0 + 3) * 2048 + q * 64 + j]); }
        }
        asm volatile("s_waitcnt lgkmcnt(0)" ::: "memory"); __syncthreads();
        {
            int ty = tid; asm volatile("" : "+v"(ty));
            const int tok = ty & 63, jg = wid, jlo = 8 * jg;
            float v[8]; int rank[8];
#pragma unroll
            for (int e = 0; e < 8; ++e) { const int j = jlo + e; const bool forced = (j == 0) || (j == cur) || (j == cur - 1);
                v[e] = (j <= cur) ? T[tok * 65 + j] + (forced ? 1e4f : 0.f) : -INFINITY; rank[e] = 0; }
            const int nA = jlo < cur + 1 ? jlo : cur + 1, nB = (jlo + 8) < cur + 1 ? (jlo + 8) : cur + 1;
#pragma unroll 2
            for (int j2 = 0; j2 < nA; ++j2) {
                const float sv = T[tok * 65 + j2] + (((j2 == 0) || (j2 == cur) || (j2 == cur - 1)) ? 1e4f : 0.f);
#pragma unroll
                for (int e = 0; e < 8; ++e) rank[e] += (sv >= v[e]) ? 1 : 0;
            }
            for (int j2 = jlo; j2 < nB; ++j2) {
                const float sv = T[tok * 65 + j2] + (((j2 == 0) || (j2 == cur) || (j2 == cur - 1)) ? 1e4f : 0.f);
#pragma unroll
                for (int e = 0; e < 8; ++e) rank[e] += (sv > v[e] || (sv == v[e] && j2 < jlo + e)) ? 1 : 0;
            }
#pragma unroll 2
            for (int j2 = jlo + 8; j2 <= cur; ++j2) {
                const float sv = T[tok * 65 + j2] + (((j2 == 0) || (j2 == cur) || (j2 == cur - 1)) ? 1e4f : 0.f);
#pragma unroll
                for (int e = 0; e < 8; ++e) rank[e] += (sv > v[e]) ? 1 : 0;
            }
            unsigned bits = 0u;
#pragma unroll
            for (int e = 0; e < 8; ++e) { const int j = jlo + e; if (j <= cur && rank[e] < SEL_TOPK) bits |= 1u << e; }
            if (bits) atomicOr((unsigned*)(MASK + tok * 2 + (jg >> 2)), bits << ((jg & 3) * 8));
        }
        asm volatile("s_waitcnt lgkmcnt(0)" ::: "memory"); __syncthreads();
        if (wid == 0) {
            unsigned ulo = MASK[lane * 2], uhi = MASK[lane * 2 + 1];
#pragma unroll
            for (int ofs = 32; ofs >= 1; ofs >>= 1) { ulo |= __shfl_xor(ulo, ofs); uhi |= __shfl_xor(uhi, ofs); }
            {
                __attribute__((address_space(3))) unsigned char* TL = (__attribute__((address_space(3))) unsigned char*)(lds3 + L_MISC);
                const unsigned long long mm = ((unsigned long long)uhi << 32) | ulo;
                int ln = lane; asm volatile("" : "+v"(ln));
                if ((mm >> ln) & 1ull) TL[__popcll(mm & ((1ull << ln) - 1ull))] = (unsigned char)ln;
                if (lane == 0) *(__attribute__((address_space(3))) int*)(lds3 + L_MISC + 64) = __popcll(mm);
            }
        }
        asm volatile("s_waitcnt lgkmcnt(0)" ::: "memory"); __syncthreads();
        }
    }
    {
        const unsigned mlo = MASK[(32 * th + r32) * 2], mhi = MASK[(32 * th + r32) * 2 + 1];
        const int NT = (variant & 1) ? 0 : __builtin_amdgcn_readfirstlane(*(__attribute__((address_space(3))) int*)(lds3 + L_MISC + 64));
#if defined(PROBE_NSA_SEL2)
        o[0] = f32x16{}; o[1] = f32x16{}; m = NEG2; l = 0.f;
        run_pass<1>(c, NT, 0, PNL(PROJ, P_KS) + (size_t)b * SEQ * PP + g * HD, PNL(PROJ, P_VS) + (size_t)b * SEQ * PP + g * HD, PP, qr, mlo, mhi, o, im, m, l);
#endif
        o[0] = f32x16{}; o[1] = f32x16{}; m = NEG2; l = 0.f;
        run_pass<1>(c, NT, 0, PNL(PROJ, P_KS) + (size_t)b * SEQ * PP + g * HD, PNL(PROJ, P_VS) + (size_t)b * SEQ * PP + g * HD, PP, qr, mlo, mhi, o, im, m, l);
        const float lt = swap_add(l);
        const float inv = lt > 0.f ? 1.f / lt : 0.f;
        if (hi == 0) c.wsf[r32] = inv * gate1;
        asm volatile("s_waitcnt lgkmcnt(0)" ::: "memory");
#pragma unroll
        for (int r = 0; r < 16; ++r) { const float a = c.wsf[crow(r, hi)]; oc[0][r] += o[0][r] * a; oc[1][r] += o[1][r] * a; }
    }
    {
        const int jlo = (qt - 8) > 0 ? (qt - 8) : 0, NT = (variant & 2) ? 0 : (qt - jlo + 1);
#if defined(PROBE_NSA_WIN2)
        o[0] = f32x16{}; o[1] = f32x16{}; m = NEG2; l = 0.f;
        run_pass<2>(c, NT, jlo, PNL(PROJ, P_KW) + (size_t)b * SEQ * PP + g * HD, PNL(PROJ, P_VW) + (size_t)b * SEQ * PP + g * HD, PP, qr, 0u, 0u, o, im, m, l);
#endif
        o[0] = f32x16{}; o[1] = f32x16{}; m = NEG2; l = 0.f;
        run_pass<2>(c, NT, jlo, PNL(PROJ, P_KW) + (size_t)b * SEQ * PP + g * HD, PNL(PROJ, P_VW) + (size_t)b * SEQ * PP + g * HD, PP, qr, 0u, 0u, o, im, m, l);
        const float lt = swap_add(l);
        const float inv = lt > 0.f ? 1.f / lt : 0.f;
        if (hi == 0) c.wsf[r32] = inv * gate2;
        asm volatile("s_waitcnt lgkmcnt(0)" ::: "memory");
#pragma unroll
        for (int r = 0; r < 16; ++r) { const float a = c.wsf[crow(r, hi)]; oc[0][r] += o[0][r] * a; oc[1][r] += o[1][r] * a; }
    }
    {
        __attribute__((address_space(3))) unsigned short* stg = (__attribute__((address_space(3))) unsigned short*)(lds3 + L_X) + wid * 2048;
#pragma unroll
        for (int r = 0; r < 16; ++r) { const int orow = crow(r, hi);
#pragma unroll
            for (int d0 = 0; d0 < 2; ++d0) stg[orow * 64 + d0 * 32 + r32] = (unsigned short)f2bf(oc[d0][r]); }
        asm volatile("s_waitcnt lgkmcnt(0)" ::: "memory");
        bf16* Ow = ONSA + (size_t)(b * SEQ + t0 + 32 * th) * NSA_Q + (g * 4 + hh) * HD;
#pragma unroll
        for (int i = 0; i < 4; ++i) { const int row = i * 8 + (lane >> 3), ch = lane & 7;
            const u32x4 vv = *(const __attribute__((address_space(3))) u32x4*)(stg + row * 64 + ch * 8);
            *(u32x4*)(Ow + (size_t)row * NSA_Q + ch * 8) = vv; }
    }
    asm volatile("s_waitcnt vmcnt(0) lgkmcnt(0)" ::: "memory");
    __syncthreads();
}

__device__ __forceinline__ void nsa_phase(const bf16* PROJ, const bf16* KCBb, const bf16* VCBb, const float* rel, bf16* ONSA, lds_ptr lds3, int vcu, int G, int variant) {
    const unsigned lds0 = (unsigned)(uintptr_t)lds3;
    build_ov(lds3);
    __syncthreads();
    int last_g = -1;
#ifndef NSA_REP
#define NSA_REP 1
#endif
#pragma unroll 1
    for (int rep_ = 0; rep_ < NSA_REP; ++rep_)
#pragma unroll 1
    for (int i = vcu; i < 512; i += G) {
        const int k = i & 255, bg = k >> 5, s = k & 31, qt = (i < 256) ? s : 63 - s;
        if (!(variant & 16)) nsa_unit(variant, (bg & 3) != last_g, bg >> 2, bg & 3, qt, PROJ, KCBb, VCBb, rel, ONSA, lds3, lds0);
        last_g = bg & 3;
    }
}
#undef NSA_WAIT_BAR
#undef NSA_SBAR
}
namespace nsa {
constexpr float STICK_THR = 50.f, LN2F = 0.6931471805599453f;
constexpr int STK_SLOTB = 32768;
static_assert(3 * STK_SLOTB <= L_WSF, "stick ring vs the LDS words it shares with the NSA map");
#define NSA_WAIT_BAR(N) asm volatile("s_waitcnt vmcnt(" #N ") lgkmcnt(0)\n\ts_barrier" ::: "memory")
__device__ __forceinline__ void stick_unit(int tid, int b, int hp, int qb, const bf16* PROJ, bf16* OSB, lds_ptr lds3, unsigned lds0, const bf16x8 (&tri)[2]) {
    const int lane = tid & 63, r32 = lane & 31, hi = lane >> 5;
    const int wid = __builtin_amdgcn_readfirstlane(tid >> 6);
    const int hs = wid >> 2, qw = wid & 3, h = 2 * hp + hs;
    const int q0 = qb * 128, t = q0 + 32 * qw + r32;
    const bf16* Kb = PNL(PROJ, P_KB + (hp >> 1)) + (size_t)b * SEQ * PP + (hp & 1) * 128;
    const bf16* Vb = PNL(PROJ, P_VB + (hp >> 1)) + (size_t)b * SEQ * PP + (hp & 1) * 128;
    __attribute__((address_space(3))) int* DONE = (__attribute__((address_space(3))) int*)(lds3 + L_MISC);
    bf16x8 qr[4];
#pragma unroll
    for (int d0 = 0; d0 < 4; ++d0) qr[d0] = *(const bf16x8*)(PNL(PROJ, P_QB + (h >> 2)) + (size_t)(b * SEQ + t) * PP + (h & 3) * HD + d0 * 16 + hi * 8);
    if (tid < 8) DONE[tid] = 0x7fffffff;
    asm volatile("s_waitcnt vmcnt(0) lgkmcnt(0)" ::: "memory");
    __syncthreads();
    const int jhi = 2 * qb + 1, NT = jhi + 1;
    const int jw = (q0 + 32 * qw + 30) >> 6;
    const int vboff = ((lane >> 4) & 1) * 32 + (lane & 3) * 8 + (4 * hi + ((lane & 15) >> 2)) * 64;
    f32x16 o[2] = {};
    float carry = 0.f; bool mydone = false;
#define STK_ISSUE(i, slot) do { const int id_ = jhi - (i); \
        const bf16* ks_ = Kb + (size_t)(64 * id_ + lane) * PP + 8 * wid; \
        const bf16* vs_ = Vb + (size_t)(64 * id_ + 16 * (wid & 3) + (lane >> 2)) * PP + 32 * (wid >> 2) + 8 * (lane & 3); \
        glds16(ks_, (unsigned)__builtin_amdgcn_readfirstlane(lds0 + L_RING + (slot) * STK_SLOTB + wid * 1024)); \
        glds16(vs_, (unsigned)__builtin_amdgcn_readfirstlane(lds0 + L_RING + (slot) * STK_SLOTB + 8192 + wid * 1024)); \
        glds16(ks_ + 64, (unsigned)__builtin_amdgcn_readfirstlane(lds0 + L_RING + (slot) * STK_SLOTB + 16384 + wid * 1024)); \
        glds16(vs_ + 64, (unsigned)__builtin_amdgcn_readfirstlane(lds0 + L_RING + (slot) * STK_SLOTB + 24576 + wid * 1024)); } while (0)
    STK_ISSUE(0, 0);
    if (NT > 1) STK_ISSUE(1, 1);
    int slot = 0;
    for (int i = 0; i < NT; ++i) {
        if (i + 1 < NT) NSA_WAIT_BAR(4); else NSA_WAIT_BAR(0);
        bool alld = true;
#pragma unroll
        for (int w = 0; w < 8; ++w) alld = alld && (DONE[w] < i);
        if (__builtin_amdgcn_readfirstlane((int)alld)) break;
        if (i + 2 < NT) { const int s2 = (slot == 0) ? 2 : slot - 1; STK_ISSUE(i + 2, s2); }
        const int j = jhi - i;
        if (!mydone && j <= jw) {
            f32x16 p0, p1, x0, x1;
            qkt(p0, p1, (lds_cptr)(lds3 + L_RING + slot * STK_SLOTB + hs * 16384), qr, r32, hi);
            float s0 = 0.f, s1 = 0.f;
#pragma unroll
            for (int r = 0; r < 16; ++r) {
                const int pos0 = 64 * j + crow(r, hi);
                const float z0 = p0[r] * 0.125f, z1 = p1[r] * 0.125f;
                const float L0 = __builtin_amdgcn_logf(1.f + __builtin_amdgcn_exp2f(-fabsf(z0) * LOG2E)) * LN2F;
                const float L1 = __builtin_amdgcn_logf(1.f + __builtin_amdgcn_exp2f(-fabsf(z1) * LOG2E)) * LN2F;
                p0[r] = fminf(z0, 0.f) - L0; p1[r] = fminf(z1, 0.f) - L1;
                x0[r] = (pos0 < t) ? (-fmaxf(z0, 0.f) - L0) : 0.f; x1[r] = (pos0 + 32 < t) ? (-fmaxf(z1, 0.f) - L1) : 0.f;
                s0 += x0[r]; s1 += x1[r];
            }
            const float tot0 = swap_add(s0), tot1 = swap_add(s1);
            u32x4 h0a, h0b, l0a, l0b, h1a, h1b, l1a, l1b;
#define STK_SPLIT(X, HA, HB, LA, LB) do { unsigned hw_[8]; float lo_[16]; \
                _Pragma("unroll") for (int q_ = 0; q_ < 8; ++q_) { hw_[q_] = cvtpk_s(X[2 * q_], X[2 * q_ + 1]); \
                    lo_[2 * q_] = X[2 * q_] - __uint_as_float(hw_[q_] << 16); lo_[2 * q_ + 1] = X[2 * q_ + 1] - __uint_as_float(hw_[q_] & 0xffff0000u); } \
                HA = (u32x4){hw_[0], hw_[1], hw_[2], hw_[3]}; HB = (u32x4){hw_[4], hw_[5], hw_[6], hw_[7]}; \
                LA = (u32x4){cvtpk_s(lo_[0], lo_[1]), cvtpk_s(lo_[2], lo_[3]), cvtpk_s(lo_[4], lo_[5]), cvtpk_s(lo_[6], lo_[7])}; \
                LB = (u32x4){cvtpk_s(lo_[8], lo_[9]), cvtpk_s(lo_[10], lo_[11]), cvtpk_s(lo_[12], lo_[13]), cvtpk_s(lo_[14], lo_[15])}; } while (0)
            STK_SPLIT(x0, h0a, h0b, l0a, l0b);
            STK_SPLIT(x1, h1a, h1b, l1a, l1b);
#undef STK_SPLIT
            f32x16 y0, y1;
#pragma unroll
            for (int r = 0; r < 16; ++r) { y0[r] = carry + tot1; y1[r] = carry; }
            y0 = __builtin_amdgcn_mfma_f32_32x32x16_bf16(tri[0], __builtin_bit_cast(bf16x8, h0a), y0, 0, 0, 0);
            y0 = __builtin_amdgcn_mfma_f32_32x32x16_bf16(tri[1], __builtin_bit_cast(bf16x8, h0b), y0, 0, 0, 0);
            y0 = __builtin_amdgcn_mfma_f32_32x32x16_bf16(tri[0], __builtin_bit_cast(bf16x8, l0a), y0, 0, 0, 0);
            y0 = __builtin_amdgcn_mfma_f32_32x32x16_bf16(tri[1], __builtin_bit_cast(bf16x8, l0b), y0, 0, 0, 0);
            y1 = __builtin_amdgcn_mfma_f32_32x32x16_bf16(tri[0], __builtin_bit_cast(bf16x8, h1a), y1, 0, 0, 0);
            y1 = __builtin_amdgcn_mfma_f32_32x32x16_bf16(tri[1], __builtin_bit_cast(bf16x8, h1b), y1, 0, 0, 0);
            y1 = __builtin_amdgcn_mfma_f32_32x32x16_bf16(tri[0], __builtin_bit_cast(bf16x8, l1a), y1, 0, 0, 0);
            y1 = __builtin_amdgcn_mfma_f32_32x32x16_bf16(tri[1], __builtin_bit_cast(bf16x8, l1b), y1, 0, 0, 0);
#pragma unroll
            for (int r = 0; r < 16; ++r) {
                const int pos0 = 64 * j + crow(r, hi);
                y0[r] = (pos0 < t) ? __builtin_amdgcn_exp2f((p0[r] + y0[r]) * LOG2E) : 0.f;
                y1[r] = (pos0 + 32 < t) ? __builtin_amdgcn_exp2f((p1[r] + y1[r]) * LOG2E) : 0.f;
            }
            carry += tot0 + tot1;
            u32x4 pw0, pw1, pw2, pw3;
            pw0 = (u32x4){cvtpk_s(y0[0], y0[1]), cvtpk_s(y0[2], y0[3]), cvtpk_s(y0[4], y0[5]), cvtpk_s(y0[6], y0[7])};
            pw1 = (u32x4){cvtpk_s(y0[8], y0[9]), cvtpk_s(y0[10], y0[11]), cvtpk_s(y0[12], y0[13]), cvtpk_s(y0[14], y0[15])};
            pw2 = (u32x4){cvtpk_s(y1[0], y1[1]), cvtpk_s(y1[2], y1[3]), cvtpk_s(y1[4], y1[5]), cvtpk_s(y1[6], y1[7])};
            pw3 = (u32x4){cvtpk_s(y1[8], y1[9]), cvtpk_s(y1[10], y1[11]), cvtpk_s(y1[12], y1[13]), cvtpk_s(y1[14], y1[15])};
            __builtin_amdgcn_sched_barrier(0);
            pv(o, (int)(lds0 + L_RING + slot * STK_SLOTB + hs * 16384 + 8192) + vboff, __builtin_bit_cast(bf16x8, pw0), __builtin_bit_cast(bf16x8, pw1), __builtin_bit_cast(bf16x8, pw2), __builtin_bit_cast(bf16x8, pw3));
            mydone = __all(carry < -STICK_THR) != 0;
            if (mydone && lane == 0) DONE[wid] = i;
        }
        slot = (slot == 2) ? 0 : slot + 1;
    }
    asm volatile("s_waitcnt vmcnt(0) lgkmcnt(0)\n\ts_barrier" ::: "memory");
#undef STK_ISSUE
    {
        __attribute__((address_space(3))) unsigned short* stg = (__attribute__((address_space(3))) unsigned short*)(lds3 + L_X) + wid * 2048;
#pragma unroll
        for (int r = 0; r < 16; ++r) { const int orow = crow(r, hi);
#pragma unroll
            for (int d0 = 0; d0 < 2; ++d0) stg[orow * 64 + d0 * 32 + r32] = (unsigned short)f2bf(o[d0][r]); }
        asm volatile("s_waitcnt lgkmcnt(0)" ::: "memory");
        bf16* Ow = OSB + (size_t)(b * SEQ + q0 + 32 * qw) * SB_W + h * HD;
#pragma unroll
        for (int i = 0; i < 4; ++i) { const int row = i * 8 + (lane >> 3), ch = lane & 7;
            const u32x4 vv = *(const __attribute__((address_space(3))) u32x4*)(stg + row * 64 + ch * 8);
            *(u32x4*)(Ow + (size_t)row * SB_W + ch * 8) = vv; }
    }
    asm volatile("s_waitcnt vmcnt(0) lgkmcnt(0)" ::: "memory");
    __syncthreads();
}
__device__ __forceinline__ void stick_phase(const bf16* PROJ, bf16* OSB, lds_ptr lds3, int vcu, int G) {
    const unsigned lds0 = (unsigned)(uintptr_t)lds3;
    int tid = threadIdx.x; asm volatile("" : "+v"(tid));
    const int lane = tid & 63, r32 = lane & 31, hi = lane >> 5;
    bf16x8 tri[2];
#pragma unroll
    for (int s = 0; s < 2; ++s)
#pragma unroll
        for (int j = 0; j < 8; ++j) tri[s][j] = ((16 * s + 8 * (j >> 2) + 4 * hi + (j & 3)) > r32) ? (short)0x3F80 : (short)0;
    for (int i = vcu; i < 512; i += G) {
        const int bp = i >> 5, qb = i & 31;
        stick_unit(tid, bp >> 3, bp & 7, qb, PROJ, OSB, lds3, lds0, tri);
    }
}
#undef NSA_WAIT_BAR
}
namespace peer {
typedef short bf16x8 __attribute__((ext_vector_type(8)));
typedef float f32x16 __attribute__((ext_vector_type(16)));
typedef __bf16 b2_t __attribute__((ext_vector_type(2)));
constexpr int L_EX = 0, L_GT = 16384, L_GN = 32768;
__device__ __forceinline__ int crow(int r, int hi) { return (r & 3) + 8 * (r >> 2) + 4 * hi; }
__device__ __forceinline__ unsigned mono(float f) { const unsigned u = __float_as_uint(f); return (u & 0x80000000u) ? ~u : (u | 0x80000000u); }
__device__ __forceinline__ float unmono(unsigned k) { return __uint_as_float((k & 0x80000000u) ? (k & 0x7fffffffu) : ~k); }
__device__ __forceinline__ float dot2(unsigned a, unsigned b, float c) { return __builtin_amdgcn_fdot2_f32_bf16(__builtin_bit_cast(b2_t, a), __builtin_bit_cast(b2_t, b), c, false); }
#define PEER_CE(key, slot) do { const unsigned hi_ = (key) > (slot) ? (key) : (slot); (key) = (key) > (slot) ? (slot) : (key); (slot) = hi_; } while (0)

__device__ __forceinline__ void route_list(const bf16* QP, const bf16* SKB, int L, int tok0, int r32, int hi, unsigned (&out)[16]) {
    f32x16 acc[4] = {};
    const bf16* qp = QP + (size_t)(tok0 + r32) * 2048 + L * 128 + hi * 8;
    const bf16* kp = SKB + ((size_t)L * 128 + r32) * 128 + hi * 8;
    int hi4 = 4 * hi;
    asm volatile("" : "+v"(qp), "+v"(kp), "+v"(hi4));
#pragma unroll
    for (int ks = 0; ks < 8; ++ks) {
        const bf16x8 bq = __builtin_nontemporal_load((const bf16x8*)(qp + ks * 16));
#pragma unroll
        for (int kt = 0; kt < 4; ++kt) { const bf16x8 a = *(const bf16x8*)(kp + (size_t)kt * 32 * 128 + ks * 16); acc[kt] = __builtin_amdgcn_mfma_f32_32x32x16_bf16(a, bq, acc[kt], 0, 0, 0); }
    }
    unsigned t[16];
#pragma unroll
    for (int k = 0; k < 16; ++k) t[k] = 0u;
#pragma unroll
    for (int kt = 0; kt < 4; ++kt)
#pragma unroll
        for (int r = 0; r < 16; ++r) {
            unsigned key = ((mono(acc[kt][r]) & ~127u) | (unsigned)(127 - (32 * kt + (r & 3) + 8 * (r >> 2)))) - (unsigned)hi4;
#pragma unroll
            for (int k = 0; k < 16; ++k) PEER_CE(key, t[k]);
            __builtin_amdgcn_sched_barrier(0);
        }
    unsigned u[16];
#pragma unroll
    for (int k = 0; k < 16; ++k) { auto rr = __builtin_amdgcn_permlane32_swap(t[k], t[k], false, false); u[k] = hi ? rr[0] : rr[1]; }
#pragma unroll
    for (int k = 0; k < 16; ++k) out[k] = t[k] > u[15 - k] ? t[k] : u[15 - k];
#pragma unroll
    for (int st = 8; st >= 1; st >>= 1)
#pragma unroll
        for (int k = 0; k < 16; ++k) if ((k & st) == 0) { const unsigned a = out[k], b = out[k | st]; out[k] = a > b ? a : b; out[k | st] = a > b ? b : a; }
}

__device__ __forceinline__ void route_head(const bf16* QP, const bf16* SKB, int h, int tok0, int lane, __attribute__((address_space(3))) unsigned char* lds3) {
    asm volatile("" : "+v"(lane));
    const int r32 = lane & 31, hi = lane >> 5;
    unsigned A[16], B[16];
    route_list(QP, SKB, 2 * h, tok0, r32, hi, A);
    route_list(QP, SKB, 2 * h + 1, tok0, r32, hi, B);
    float va[16], vb[16]; int ia[16], ib[16];
#pragma unroll
    for (int k = 0; k < 16; ++k) { va[k] = unmono((A[k] & ~127u) | 64u); vb[k] = unmono((B[k] & ~127u) | 64u); ia[k] = 127 - (int)(A[k] & 127u); ib[k] = 127 - (int)(B[k] & 127u); }
    unsigned s[16], sp[16];
#pragma unroll
    for (int k = 0; k < 16; ++k) { s[k] = 0u; sp[k] = 0u; }
#pragma unroll
    for (int i = 0; i < 16; ++i)
#pragma unroll
        for (int j = 0; j < 16; ++j) if ((i + 1) * (j + 1) <= 16) {
            unsigned key = mono(va[i] + vb[j]); unsigned pay = (unsigned)(ia[i] * PEER_KEYS + ib[j]);
#pragma unroll
            for (int k = (i + 1) * (j + 1) - 1; k < 16; ++k) { const bool gt = key > s[k]; const unsigned ts = s[k], tp = sp[k]; s[k] = gt ? key : ts; sp[k] = gt ? pay : tp; key = gt ? ts : key; pay = gt ? tp : pay; }
            __builtin_amdgcn_sched_barrier(0);
        }
    const float mx = unmono(s[0]);
    float e[16], sum = 0.f;
#pragma unroll
    for (int k = 0; k < 16; ++k) { e[k] = __expf(unmono(s[k]) - mx); sum += e[k]; }
    const float inv = 1.f / sum;
    if (hi == 0) {
        __attribute__((address_space(3))) int* EX = (__attribute__((address_space(3))) int*)(lds3 + L_EX);
        __attribute__((address_space(3))) float* GT = (__attribute__((address_space(3))) float*)(lds3 + L_GT);
#pragma unroll
        for (int k = 0; k < 16; ++k) { EX[(h * 16 + k) * 32 + r32] = (int)sp[k]; GT[(h * 16 + k) * 32 + r32] = e[k] * inv; }
    }
}

#ifndef PEER_FAKE
#define PEER_FAKE 0
#endif
#ifndef PEER_FAKE_MODE
#define PEER_FAKE_MODE 0
#endif
#ifndef PEER_FAKE_EMASK
#define PEER_FAKE_EMASK 0xffff
#endif
constexpr int FP6_PITCH = 2048;
typedef float v2f_t __attribute__((ext_vector_type(2)));
__device__ __forceinline__ void cvt_row_load(const float* src, int row, int lane, f32x4 (&v)[8]) {
    const float* p = src + (size_t)row * 2048 + lane * 4;
#pragma unroll
    for (int i = 0; i < 8; ++i) v[i] = __builtin_nontemporal_load((const f32x4*)(p + i * 256));
}
__device__ __forceinline__ float clamp6(float x) { return __builtin_amdgcn_fmed3f(x, -6.f, 6.f); }
__device__ __forceinline__ float elem4(const f32x4& a, int m) { return m == 0 ? a.x : m == 1 ? a.y : m == 2 ? a.z : a.w; }
__device__ __forceinline__ void cvt_row_store(const f32x4 (&v)[8], unsigned char* REC, float* ISC, int r, int lane) {
    float am = 0.f, ss = 0.f;
#pragma unroll
    for (int i = 0; i < 8; ++i) { am = fmaxf(am, fmaxf(fmaxf(fabsf(v[i].x), fabsf(v[i].y)), fmaxf(fabsf(v[i].z), fabsf(v[i].w))));
        ss += v[i].x * v[i].x + v[i].y * v[i].y + v[i].z * v[i].z + v[i].w * v[i].w; }
    am = wave_max(am);
    const bool is_u = r < 16384; const int e = r & 16383;
    v4u q; float isc;
    if (is_u) {
        ss = wave_sum(ss);
        const float step = am > 0.f ? fminf(0.3352f * sqrtf(ss * (1.f / 2048.f)), am * (1.f / 7.5f)) : 1.f, inv = 1.f / step;
#pragma unroll
        for (int j = 0; j < 4; ++j) { unsigned w = 0;
#pragma unroll
            for (int t = 0; t < 8; ++t) { const float val = elem4(v[2 * j + (t >> 2)], t & 3);
                int n = (int)floorf(val * inv); n = n < -8 ? -8 : n > 7 ? 7 : n;
                w |= (unsigned)(n & 15) << (4 * t); }
            q[j] = w; }
        isc = step;
    } else {
        const float sc = am > 0.f ? 7.5f / am : 1.f;
#pragma unroll
        for (int j = 0; j < 4; ++j) { unsigned w = 0;
            w = __builtin_amdgcn_cvt_scalef32_pk_fp4_f32(w, clamp6(v[2 * j].x * sc), clamp6(v[2 * j].y * sc), 1.0f, 0);
            w = __builtin_amdgcn_cvt_scalef32_pk_fp4_f32(w, clamp6(v[2 * j].z * sc), clamp6(v[2 * j].w * sc), 1.0f, 1);
            w = __builtin_amdgcn_cvt_scalef32_pk_fp4_f32(w, clamp6(v[2 * j + 1].x * sc), clamp6(v[2 * j + 1].y * sc), 1.0f, 2);
            w = __builtin_amdgcn_cvt_scalef32_pk_fp4_f32(w, clamp6(v[2 * j + 1].z * sc), clamp6(v[2 * j + 1].w * sc), 1.0f, 3);
            q[j] = w; }
        isc = am > 0.f ? am / 7.5f : 1.f;
    }
    *(v4u*)(REC + (size_t)e * FP6_PITCH + (is_u ? 0 : 1024) + lane * 16) = q;
    if (lane == 0) ISC[2 * e + (is_u ? 0 : 1)] = isc;
}
#ifndef PEER_CVT_DEPTH4
#define PEER_CVT_DEPTH4 1
#endif
__device__ __forceinline__ void cvt_tables(const float* Uf, const float* Vf, unsigned char* REC, float* ISC, int first, int stride, int lane) {
#define PEER_SRC(r) ((r) < 16384 ? Uf : Vf), ((r) < 16384 ? (r) : (r) - 16384)
#if PEER_CVT_DEPTH4
    f32x4 va[8], vb[8], vc[8], vd[8];
    int r = first;
    if (r < 32768) cvt_row_load(PEER_SRC(r), lane, va);
    if (r + stride < 32768) cvt_row_load(PEER_SRC(r + stride), lane, vb);
    if (r + 2 * stride < 32768) cvt_row_load(PEER_SRC(r + 2 * stride), lane, vc);
#pragma unroll 1
    for (; r < 32768; r += 4 * stride) {
#define PEER_STEP(LD, ST, K) { const int rl_ = r + ((K) + 3) * stride, rs_ = r + (K) * stride; if (rl_ < 32768) cvt_row_load(PEER_SRC(rl_), lane, LD); __builtin_amdgcn_sched_barrier(0); \
            if (rs_ < 32768) cvt_row_store(ST, REC, ISC, rs_, lane); __builtin_amdgcn_sched_barrier(0); }
        PEER_STEP(vd, va, 0) PEER_STEP(va, vb, 1) PEER_STEP(vb, vc, 2) PEER_STEP(vc, vd, 3)
#undef PEER_STEP
    }
#else
    f32x4 va[8], vb[8];
    int r = first;
    if (r < 32768) cvt_row_load(PEER_SRC(r), lane, va);
#pragma unroll 1
    for (; r < 32768; r += 2 * stride) {
        const int r1 = r + stride, r2 = r + 2 * stride;
        if (r1 < 32768) cvt_row_load(PEER_SRC(r1), lane, vb);
        __builtin_amdgcn_sched_barrier(0);
        cvt_row_store(va, REC, ISC, r, lane);
        __builtin_amdgcn_sched_barrier(0);
        if (r2 < 32768) cvt_row_load(PEER_SRC(r2), lane, va);
        __builtin_amdgcn_sched_barrier(0);
        if (r1 < 32768) cvt_row_store(vb, REC, ISC, r1, lane);
        __builtin_amdgcn_sched_barrier(0);
    }
#endif
#undef PEER_SRC
}
__device__ __forceinline__ void ffn_token(int emask, bool fake, int n, int tl, int lane, const bf16* H, const float* SS, const unsigned char* REC, const float* ISC,
                                          float* out, __attribute__((address_space(3))) unsigned char* lds3) {
    const __attribute__((address_space(3))) float* gffn = (const __attribute__((address_space(3))) float*)(lds3 + L_GN);
    const __attribute__((address_space(3))) float* gfin = gffn + 2048;
    const __attribute__((address_space(3))) int* EX = (const __attribute__((address_space(3))) int*)(lds3 + L_EX);
    const __attribute__((address_space(3))) float* GT = (const __attribute__((address_space(3))) float*)(lds3 + L_GT);
    v2u hrow[8];
    unsigned xlo[4], xhi[4]; float sx, halfX;
    { const float rs_ = rsqrtf(SS[n] * (1.f / D_MODEL) + EPS);
      float xf[32]; float amx = 0.f;
#pragma unroll
      for (int i = 0; i < 8; ++i) { const v2u hw_ = *(const v2u*)(H + (size_t)n * 2048 + i * 256 + lane * 4); const f32x4 gv_ = *(const __attribute__((address_space(3))) f32x4*)(gffn + i * 256 + lane * 4);
            hrow[i] = hw_;
            xf[4 * i + 0] = bflo(hw_.x) * rs_ * gv_.x; xf[4 * i + 1] = bfhi(hw_.x) * rs_ * gv_.y; xf[4 * i + 2] = bflo(hw_.y) * rs_ * gv_.z; xf[4 * i + 3] = bfhi(hw_.y) * rs_ * gv_.w;
            amx = fmaxf(amx, fmaxf(fmaxf(fabsf(xf[4 * i + 0]), fabsf(xf[4 * i + 1])), fmaxf(fabsf(xf[4 * i + 2]), fabsf(xf[4 * i + 3])))); }
      amx = wave_max(amx);
      sx = amx > 0.f ? amx * (1.f / 119.f) : 1.f; const float isx = amx > 0.f ? 119.f / amx : 1.f;
      int xs = 0;
#pragma unroll
      for (int j = 0; j < 4; ++j) { unsigned wl = 0, wh = 0;
#pragma unroll
          for (int t = 0; t < 8; ++t) { const int q = (int)rintf(xf[8 * j + t] * isx); xs += q;
              const int q8 = q + 8;
              wl |= (unsigned)((q8 & 15) ^ 8) << (4 * t); wh |= (unsigned)((q8 >> 4) & 15) << (4 * t); }
          xlo[j] = wl; xhi[j] = wh; }
      halfX = 0.5f * wave_sum((float)xs); }
    v2f_t acc2[16];
#pragma unroll
    for (int j = 0; j < 16; ++j) acc2[j] = (v2f_t){0.f, 0.f};
    const bool b5 = (lane & 32) != 0, b4 = (lane & 16) != 0;
    v4u uaA[4], vaA[4], uaB[4], vaB[4]; v2f_t scA[4], scB[4]; float gtA[4], gtB[4];
#define PEER_LOADB(UA, VA, SC, GTV, E0) { _Pragma("unroll") for (int k = 0; k < 4; ++k) { \
        const int ei_ = __builtin_amdgcn_readfirstlane(EX[((E0) + k) * 32 + tl]) & emask; GTV[k] = GT[((E0) + k) * 32 + tl]; \
        const unsigned char* rec_ = REC + (size_t)ei_ * FP6_PITCH + lane * 16; \
        if (!(fake && PEER_FAKE_MODE == 2)) { UA[k] = *(const v4u*)rec_; VA[k] = *(const v4u*)(rec_ + 1024); SC[k] = *(const v2f_t*)(ISC + 2 * ei_); } \
        else { UA[k][0] ^= (unsigned)ei_; VA[k][1] += (unsigned)ei_; } } }
#define PEER_DEC(q, b) __builtin_amdgcn_cvt_scalef32_pk_f32_fp4(q, 1.0f, b)
#define PEER_EVALB(UA, VA, SC, GTV) if (fake && PEER_FAKE_MODE == 1) { _Pragma("unroll") for (int k = 0; k < 4; ++k) { \
            acc2[k].x += __uint_as_float((UA[k][0] ^ UA[k][1]) + (UA[k][2] ^ UA[k][3])) * SC[k].x; acc2[k].y += __uint_as_float((VA[k][0] ^ VA[k][1]) + (VA[k][2] ^ VA[k][3])) * GTV[k]; } } else { float d[4]; \
        _Pragma("unroll") for (int k = 0; k < 4; ++k) { int sh = 0, sl = 0; \
            _Pragma("unroll") for (int j = 0; j < 4; ++j) { sh = __builtin_amdgcn_sdot8((int)UA[k][j], (int)xhi[j], sh, false); sl = __builtin_amdgcn_sdot8((int)UA[k][j], (int)xlo[j], sl, false); } \
            d[k] = (float)(sh * 16 + sl); } \
        __builtin_amdgcn_sched_barrier(0); \
          \
        float t; { const auto r01 = __builtin_amdgcn_permlane32_swap(__float_as_uint(d[0]), __float_as_uint(d[1]), false, false); \
                   const auto r23 = __builtin_amdgcn_permlane32_swap(__float_as_uint(d[2]), __float_as_uint(d[3]), false, false); \
                   const float a01 = __uint_as_float(r01[0]) + __uint_as_float(r01[1]), a23 = __uint_as_float(r23[0]) + __uint_as_float(r23[1]); \
                   const auto rr = __builtin_amdgcn_permlane16_swap(__float_as_uint(a01), __float_as_uint(a23), false, false); \
                   t = row_sum16(__uint_as_float(rr[0]) + __uint_as_float(rr[1])); } \
        const float ius = b5 ? (b4 ? SC[3].x : SC[1].x) : (b4 ? SC[2].x : SC[0].x); \
        const float ivs = b5 ? (b4 ? SC[3].y : SC[1].y) : (b4 ? SC[2].y : SC[0].y); \
        const float gts = b5 ? (b4 ? GTV[3] : GTV[1]) : (b4 ? GTV[2] : GTV[0]); \
        const float wv = gts * gelu_tanh_fast((t + halfX) * (sx * ius)) * ivs; \
        float w[4]; \
        w[0] = __uint_as_float(__builtin_amdgcn_readlane(__float_as_uint(wv), 0)); w[2] = __uint_as_float(__builtin_amdgcn_readlane(__float_as_uint(wv), 16)); \
        w[1] = __uint_as_float(__builtin_amdgcn_readlane(__float_as_uint(wv), 32)); w[3] = __uint_as_float(__builtin_amdgcn_readlane(__float_as_uint(wv), 48)); \
        _Pragma("unroll") for (int k = 0; k < 4; ++k) { const v2f_t wk = {w[k], w[k]}; \
            _Pragma("unroll") for (int j = 0; j < 4; ++j) { const unsigned qw = VA[k][j]; \
                acc2[4 * j + 0] += wk * PEER_DEC(qw, 0); acc2[4 * j + 1] += wk * PEER_DEC(qw, 1); acc2[4 * j + 2] += wk * PEER_DEC(qw, 2); acc2[4 * j + 3] += wk * PEER_DEC(qw, 3); } \
            __builtin_amdgcn_sched_barrier(0); } }
    if (fake && PEER_FAKE_MODE == 2) {
#pragma unroll
        for (int k = 0; k < 4; ++k) { uaA[k] = (v4u){(unsigned)lane, 1u, 2u, 3u}; vaA[k] = uaA[k]; uaB[k] = uaA[k]; vaB[k] = uaA[k]; scA[k] = (v2f_t){1.f, 1.f}; scB[k] = scA[k]; } }
    PEER_LOADB(uaA, vaA, scA, gtA, 0)
#pragma unroll 1
    for (int e0 = 0; e0 < PEER_E; e0 += 8) {
        PEER_LOADB(uaB, vaB, scB, gtB, e0 + 4)
        __builtin_amdgcn_sched_barrier(0);
        PEER_EVALB(uaA, vaA, scA, gtA)
        __builtin_amdgcn_sched_barrier(0);
        { const int en = e0 + 8 < PEER_E ? e0 + 8 : 0;
          PEER_LOADB(uaA, vaA, scA, gtA, en) }
        __builtin_amdgcn_sched_barrier(0);
        PEER_EVALB(uaB, vaB, scB, gtB)
        __builtin_amdgcn_sched_barrier(0);
    }
#undef PEER_LOADB
#undef PEER_EVALB
#undef PEER_DEC
    float sq = 0.f;
#pragma unroll
    for (int i = 0; i < 8; ++i) { const v2u hw_ = hrow[i];
        acc2[2 * i].x += bflo(hw_.x); acc2[2 * i].y += bfhi(hw_.x); acc2[2 * i + 1].x += bflo(hw_.y); acc2[2 * i + 1].y += bfhi(hw_.y); }
#pragma unroll
    for (int j = 0; j < 16; ++j) sq += acc2[j].x * acc2[j].x + acc2[j].y * acc2[j].y;
    const float r_ = rsqrtf(wave_sum(sq) * (1.f / D_MODEL) + EPS);
    if (fake && r_ != 12345.678f) return;
#pragma unroll
    for (int i = 0; i < 8; ++i) { const f32x4 gv_ = *(const __attribute__((address_space(3))) f32x4*)(gfin + i * 256 + lane * 4);
        *(f32x4*)(out + (size_t)n * 2048 + i * 256 + lane * 4) = (f32x4){acc2[2 * i].x * r_ * gv_.x, acc2[2 * i].y * r_ * gv_.y, acc2[2 * i + 1].x * r_ * gv_.z, acc2[2 * i + 1].y * r_ * gv_.w}; }
}

#ifndef PEER_SLICED
#define PEER_SLICED 2
#endif
#ifndef PEER_SLICE_SHIFT_V
#define PEER_SLICE_SHIFT_V 10
#endif
constexpr int L_SCH = 49152, SCH_CAP = 384, PEER_SLICE_SHIFT = PEER_SLICE_SHIFT_V, L_PARK = 73728;
__device__ __forceinline__ int mbcnt64(unsigned long long m) { return __builtin_amdgcn_mbcnt_hi((unsigned)(m >> 32), __builtin_amdgcn_mbcnt_lo((unsigned)m, 0u)); }
__device__ __forceinline__ int build_schedule(int lane, int tl0, __attribute__((address_space(3))) unsigned char* lds3, __attribute__((address_space(3))) v2u* SCH) {
    const __attribute__((address_space(3))) int* EX = (const __attribute__((address_space(3))) int*)(lds3 + L_EX);
    const __attribute__((address_space(3))) float* GT = (const __attribute__((address_space(3))) float*)(lds3 + L_GT);
    int e00 = EX[lane * 32 + tl0], e01 = EX[(lane + 64) * 32 + tl0], e10 = EX[lane * 32 + tl0 + 1], e11 = EX[(lane + 64) * 32 + tl0 + 1];
    const unsigned g00 = __float_as_uint(GT[lane * 32 + tl0]), g01 = __float_as_uint(GT[(lane + 64) * 32 + tl0]), g10 = __float_as_uint(GT[lane * 32 + tl0 + 1]), g11 = __float_as_uint(GT[(lane + 64) * 32 + tl0 + 1]);
    int run = 0;
#pragma unroll 1
    for (int b = 0; b < (16384 >> PEER_SLICE_SHIFT); ++b) {
        const bool h00 = (e00 >> PEER_SLICE_SHIFT) == b, h01 = (e01 >> PEER_SLICE_SHIFT) == b, h10 = (e10 >> PEER_SLICE_SHIFT) == b, h11 = (e11 >> PEER_SLICE_SHIFT) == b;
        const unsigned long long m00 = __ballot(h00), m01 = __ballot(h01), m10 = __ballot(h10), m11 = __ballot(h11);
        const int c00 = __popcll(m00), c0 = c00 + __popcll(m01), c10 = __popcll(m10), c1 = c10 + __popcll(m11);
        const int p0 = (c0 + 3) & ~3, p1 = (c1 + 3) & ~3, o0 = run, o1 = run + p0;
        run += p0 + p1;
        if (h00) SCH[o0 + mbcnt64(m00)] = (v2u){(unsigned)e00, g00};
        if (h01) SCH[o0 + c00 + mbcnt64(m01)] = (v2u){(unsigned)e01, g01};
        if (h10) SCH[o1 + mbcnt64(m10)] = (v2u){(unsigned)e10 | 0x10000u, g10};
        if (h11) SCH[o1 + c10 + mbcnt64(m11)] = (v2u){(unsigned)e11 | 0x10000u, g11};
        if (lane < p0 - c0) SCH[o0 + c0 + lane] = (v2u){(unsigned)(b << PEER_SLICE_SHIFT), 0u};
        if (lane < p1 - c1) SCH[o1 + c1 + lane] = (v2u){(unsigned)(b << PEER_SLICE_SHIFT) | 0x10000u, 0u};
    }
    return run >> 2;
}
struct TokX { unsigned xlo[4], xhi[4]; float sx, halfX; };
__device__ __forceinline__ void token_prologue(int n, int lane, const bf16* H, const float* SS, const __attribute__((address_space(3))) float* gffn, TokX& X) {
    const float rs_ = rsqrtf(SS[n] * (1.f / D_MODEL) + EPS);
    float xf[32]; float amx = 0.f;
#pragma unroll
    for (int i = 0; i < 8; ++i) { const v2u hw_ = *(const v2u*)(H + (size_t)n * 2048 + i * 256 + lane * 4); const f32x4 gv_ = *(const __attribute__((address_space(3))) f32x4*)(gffn + i * 256 + lane * 4);
        xf[4 * i + 0] = bflo(hw_.x) * rs_ * gv_.x; xf[4 * i + 1] = bfhi(hw_.x) * rs_ * gv_.y; xf[4 * i + 2] = bflo(hw_.y) * rs_ * gv_.z; xf[4 * i + 3] = bfhi(hw_.y) * rs_ * gv_.w;
        amx = fmaxf(amx, fmaxf(fmaxf(fabsf(xf[4 * i + 0]), fabsf(xf[4 * i + 1])), fmaxf(fabsf(xf[4 * i + 2]), fabsf(xf[4 * i + 3])))); }
    amx = wave_max(amx);
    X.sx = amx > 0.f ? amx * (1.f / 119.f) : 1.f; const float isx = amx > 0.f ? 119.f / amx : 1.f;
    int xs = 0;
#pragma unroll
    for (int j = 0; j < 4; ++j) { unsigned wl = 0, wh = 0;
#pragma unroll
        for (int t = 0; t < 8; ++t) { const int q = (int)rintf(xf[8 * j + t] * isx); xs += q;
            const int q8 = q + 8;
            wl |= (unsigned)((q8 & 15) ^ 8) << (4 * t); wh |= (unsigned)((q8 >> 4) & 15) << (4 * t); }
        X.xlo[j] = wl; X.xhi[j] = wh; }
    X.halfX = 0.5f * wave_sum((float)xs);
}
__device__ __forceinline__ void token_epilogue(int n, int lane, const bf16* H, const __attribute__((address_space(3))) float* gfin, v2f_t (&acc2)[16], float* out) {
    float sq = 0.f;
#pragma unroll
    for (int i = 0; i < 8; ++i) { const v2u hw_ = __builtin_nontemporal_load((const v2u*)(H + (size_t)n * 2048 + i * 256 + lane * 4));
        acc2[2 * i].x += bflo(hw_.x); acc2[2 * i].y += bfhi(hw_.x); acc2[2 * i + 1].x += bflo(hw_.y); acc2[2 * i + 1].y += bfhi(hw_.y); }
#pragma unroll
    for (int j = 0; j < 16; ++j) sq += acc2[j].x * acc2[j].x + acc2[j].y * acc2[j].y;
    const float r_ = rsqrtf(wave_sum(sq) * (1.f / D_MODEL) + EPS);
#pragma unroll
    for (int i = 0; i < 8; ++i) { const f32x4 gv_ = *(const __attribute__((address_space(3))) f32x4*)(gfin + i * 256 + lane * 4);
        __builtin_nontemporal_store((f32x4){acc2[2 * i].x * r_ * gv_.x, acc2[2 * i].y * r_ * gv_.y, acc2[2 * i + 1].x * r_ * gv_.z, acc2[2 * i + 1].y * r_ * gv_.w}, (f32x4*)(out + (size_t)n * 2048 + i * 256 + lane * 4)); }
}
__device__ __forceinline__ void ffn_pair(bool fake, int n0, int tl0, int lane, int wid, const bf16* H, const float* SS, const unsigned char* REC, const float* ISC, float* out, __attribute__((address_space(3))) unsigned char* lds3) {
    const __attribute__((address_space(3))) float* gffn = (const __attribute__((address_space(3))) float*)(lds3 + L_GN);
    const __attribute__((address_space(3))) float* gfin = gffn + 2048;
    __attribute__((address_space(3))) v2u* SCH = (__attribute__((address_space(3))) v2u*)(lds3 + L_SCH) + wid * SCH_CAP;
    const int nb = __builtin_amdgcn_readfirstlane(build_schedule(lane, tl0, lds3, SCH));
    TokX X0, X1;
    token_prologue(n0, lane, H, SS, gffn, X0);
    token_prologue(n0 + 1, lane, H, SS, gffn, X1);
    __attribute__((address_space(3))) f32x4* PARK = (__attribute__((address_space(3))) f32x4*)(lds3 + L_PARK) + wid * 512;
    v2f_t acc[16]; int cur = 0;
#pragma unroll
    for (int j = 0; j < 16; ++j) acc[j] = (v2f_t){0.f, 0.f};
#pragma unroll
    for (int j = 0; j < 8; ++j) PARK[j * 64 + lane] = (f32x4){0.f, 0.f, 0.f, 0.f};
    const bool b5 = (lane & 32) != 0, b4 = (lane & 16) != 0;
    v4u uaA[4], vaA[4], uaB[4], vaB[4]; v2f_t scA[4], scB[4]; float gtA[4], gtB[4]; int tkA, tkB;
#define PEER_LOADB(UA, VA, SC, GTV, TK, BI) { _Pragma("unroll") for (int k = 0; k < 4; ++k) { const v2u en_ = SCH[4 * (BI) + k]; \
        const int ek_ = __builtin_amdgcn_readfirstlane((int)en_.x); if (k == 0) TK = ek_ >> 16; GTV[k] = __uint_as_float(en_.y); \
        const int ei_ = fake ? (ek_ & 0xffff & PEER_FAKE_EMASK) : (ek_ & 0xffff); const unsigned char* rec_ = REC + (size_t)ei_ * FP6_PITCH + lane * 16; \
        if (!(fake && PEER_FAKE_MODE == 2)) { UA[k] = *(const v4u*)rec_; VA[k] = *(const v4u*)(rec_ + 1024); SC[k] = *(const v2f_t*)(ISC + 2 * ei_); } \
        else { UA[k][0] ^= (unsigned)ei_; VA[k][1] += (unsigned)ei_; } } }
#define PEER_DEC(q, b) __builtin_amdgcn_cvt_scalef32_pk_f32_fp4(q, 1.0f, b)
#define PEER_VSIDE(VA, ACC) { _Pragma("unroll") for (int k = 0; k < 4; ++k) { const v2f_t wk = {w[k], w[k]}; \
            _Pragma("unroll") for (int j = 0; j < 4; ++j) { const unsigned qw = VA[k][j]; \
                ACC[4 * j + 0] += wk * PEER_DEC(qw, 0); ACC[4 * j + 1] += wk * PEER_DEC(qw, 1); ACC[4 * j + 2] += wk * PEER_DEC(qw, 2); ACC[4 * j + 3] += wk * PEER_DEC(qw, 3); } \
            __builtin_amdgcn_sched_barrier(0); } }
#define PEER_EVALB(UA, VA, SC, GTV, TK) if (fake && PEER_FAKE_MODE == 1) { _Pragma("unroll") for (int k = 0; k < 4; ++k) { \
            acc[k].x += __uint_as_float((UA[k][0] ^ UA[k][1]) + (UA[k][2] ^ UA[k][3])) * SC[k].x; acc[k].y += __uint_as_float((VA[k][0] ^ VA[k][1]) + (VA[k][2] ^ VA[k][3])) * GTV[k]; } } else { float d[4]; const bool t1_ = (TK) != 0; \
        unsigned xh_[4], xl_[4]; _Pragma("unroll") for (int j = 0; j < 4; ++j) { xh_[j] = t1_ ? X1.xhi[j] : X0.xhi[j]; xl_[j] = t1_ ? X1.xlo[j] : X0.xlo[j]; } \
        const float hx_ = t1_ ? X1.halfX : X0.halfX, sx_ = t1_ ? X1.sx : X0.sx; \
        _Pragma("unroll") for (int k = 0; k < 4; ++k) { int sh = 0, sl = 0; \
            _Pragma("unroll") for (int j = 0; j < 4; ++j) { sh = __builtin_amdgcn_sdot8((int)UA[k][j], (int)xh_[j], sh, false); sl = __builtin_amdgcn_sdot8((int)UA[k][j], (int)xl_[j], sl, false); } \
            d[k] = (float)(sh * 16 + sl); } \
        __builtin_amdgcn_sched_barrier(0); \
        float t; { const auto r01 = __builtin_amdgcn_permlane32_swap(__float_as_uint(d[0]), __float_as_uint(d[1]), false, false); \
                   const auto r23 = __builtin_amdgcn_permlane32_swap(__float_as_uint(d[2]), __float_as_uint(d[3]), false, false); \
                   const float a01 = __uint_as_float(r01[0]) + __uint_as_float(r01[1]), a23 = __uint_as_float(r23[0]) + __uint_as_float(r23[1]); \
                   const auto rr = __builtin_amdgcn_permlane16_swap(__float_as_uint(a01), __float_as_uint(a23), false, false); \
                   t = row_sum16(__uint_as_float(rr[0]) + __uint_as_float(rr[1])); } \
        const float ius = b5 ? (b4 ? SC[3].x : SC[1].x) : (b4 ? SC[2].x : SC[0].x); \
        const float ivs = b5 ? (b4 ? SC[3].y : SC[1].y) : (b4 ? SC[2].y : SC[0].y); \
        const float gts = b5 ? (b4 ? GTV[3] : GTV[1]) : (b4 ? GTV[2] : GTV[0]); \
        const float wv = gts * gelu_tanh_fast((t + hx_) * (sx_ * ius)) * ivs; \
        float w[4]; \
        w[0] = __uint_as_float(__builtin_amdgcn_readlane(__float_as_uint(wv), 0)); w[2] = __uint_as_float(__builtin_amdgcn_readlane(__float_as_uint(wv), 16)); \
        w[1] = __uint_as_float(__builtin_amdgcn_readlane(__float_as_uint(wv), 32)); w[3] = __uint_as_float(__builtin_amdgcn_readlane(__float_as_uint(wv), 48)); \
        __builtin_amdgcn_sched_barrier(0); \
        if ((TK) != cur) {            \
            _Pragma("unroll") for (int j = 0; j < 8; ++j) { const f32x4 o_ = PARK[j * 64 + lane]; PARK[j * 64 + lane] = (f32x4){acc[2 * j].x, acc[2 * j].y, acc[2 * j + 1].x, acc[2 * j + 1].y}; \
                acc[2 * j] = (v2f_t){o_.x, o_.y}; acc[2 * j + 1] = (v2f_t){o_.z, o_.w}; } \
            cur = (TK); } \
        PEER_VSIDE(VA, acc) }
    if (fake && PEER_FAKE_MODE == 2) {
#pragma unroll
        for (int k = 0; k < 4; ++k) { uaA[k] = (v4u){(unsigned)lane, 1u, 2u, 3u}; vaA[k] = uaA[k]; uaB[k] = uaA[k]; vaB[k] = uaA[k]; scA[k] = (v2f_t){1.f, 1.f}; scB[k] = scA[k]; } }
    PEER_LOADB(uaA, vaA, scA, gtA, tkA, 0)
#pragma unroll 1
    for (int i = 0; i < nb; i += 2) {
        { const int bn = i + 1 < nb ? i + 1 : nb - 1; PEER_LOADB(uaB, vaB, scB, gtB, tkB, bn) }
        __builtin_amdgcn_sched_barrier(0);
        PEER_EVALB(uaA, vaA, scA, gtA, tkA)
        __builtin_amdgcn_sched_barrier(0);
        { const int bn = i + 2 < nb ? i + 2 : nb - 1; PEER_LOADB(uaA, vaA, scA, gtA, tkA, bn) }
        __builtin_amdgcn_sched_barrier(0);
        if (i + 1 < nb) { PEER_EVALB(uaB, vaB, scB, gtB, tkB) }
        __builtin_amdgcn_sched_barrier(0);
    }
#undef PEER_LOADB
#undef PEER_EVALB
#undef PEER_VSIDE
#undef PEER_DEC
    if (fake) { float sq_ = 0.f;
#pragma unroll
        for (int j = 0; j < 16; ++j) sq_ += acc[j].x + acc[j].y;
        if (sq_ != 12345.678f) return; }
    token_epilogue(n0 + cur, lane, H, gfin, acc, out);
#pragma unroll
    for (int j = 0; j < 8; ++j) { const f32x4 o_ = PARK[j * 64 + lane]; acc[2 * j] = (v2f_t){o_.x, o_.y}; acc[2 * j + 1] = (v2f_t){o_.z, o_.w}; }
    token_epilogue(n0 + 1 - cur, lane, H, gfin, acc, out);
}

#ifndef PEER_SYNC_SLICES
#define PEER_SYNC_SLICES 0
#endif
constexpr int SCH4_CAP = 704, L_PARK4B = L_SCH + NWAVES * SCH4_CAP * 8;
static_assert(L_PARK4B + 16 * 4096 <= 162816, "LDS overflow");
__device__ __forceinline__ int build_schedule4(int lane, int tl0, __attribute__((address_space(3))) unsigned char* lds3, __attribute__((address_space(3))) v2u* SCH) {
    const __attribute__((address_space(3))) int* EX = (const __attribute__((address_space(3))) int*)(lds3 + L_EX);
    const __attribute__((address_space(3))) float* GT = (const __attribute__((address_space(3))) float*)(lds3 + L_GT);
    int e[4][2]; unsigned g[4][2];
#pragma unroll
    for (int t = 0; t < 4; ++t)
#pragma unroll
        for (int h = 0; h < 2; ++h) { e[t][h] = EX[(lane + 64 * h) * 32 + tl0 + t]; g[t][h] = __float_as_uint(GT[(lane + 64 * h) * 32 + tl0 + t]); }
    int run = 0;
#define PEER_RUN(T, SA, SB, PADR) { const int s0_ = e[T][0] >> PEER_SLICE_SHIFT, s1_ = e[T][1] >> PEER_SLICE_SHIFT; const bool h0_ = s0_ == (SA) || s0_ == (SB), h1_ = s1_ == (SA) || s1_ == (SB); \
        const unsigned long long m0_ = __ballot(h0_), m1_ = __ballot(h1_); const int c0_ = __popcll(m0_), c_ = c0_ + __popcll(m1_), p_ = (c_ + 3) & ~3; \
        if (h0_) SCH[run + mbcnt64(m0_)] = (v2u){(unsigned)e[T][0] | ((unsigned)(T) << 16), g[T][0]}; \
        if (h1_) SCH[run + c0_ + mbcnt64(m1_)] = (v2u){(unsigned)e[T][1] | ((unsigned)(T) << 16), g[T][1]}; \
        if (lane < p_ - c_) SCH[run + c_ + lane] = (v2u){(unsigned)(PADR) | ((unsigned)(T) << 16), 0u}; \
        run += p_; }
#pragma unroll 1
    for (int s = 0; s < (16384 >> PEER_SLICE_SHIFT); s += 2) {
        const int pad0 = s << PEER_SLICE_SHIFT, pad1 = (s + 1) << PEER_SLICE_SHIFT;
        if (lane == 0) SCH[SCH4_CAP - 8 + (s >> 1)] = (v2u){(unsigned)(run >> 2), 0u};
        PEER_RUN(0, s - 1, s, pad0)
        PEER_RUN(1, s, s, pad0)
        PEER_RUN(2, s, s, pad0)
        PEER_RUN(3, s, s + 1, pad1)
        PEER_RUN(2, s + 1, s + 1, pad1)
        PEER_RUN(1, s + 1, s + 1, pad1)
    }
    PEER_RUN(0, (16384 >> PEER_SLICE_SHIFT) - 1, (16384 >> PEER_SLICE_SHIFT) - 1, 16383)
#undef PEER_RUN
    return run >> 2;
}
__device__ __forceinline__ void ffn_quad(bool fake, int n0, int tl0, int lane, int wid, const bf16* H, const float* SS, const unsigned char* REC, const float* ISC, float* out, __attribute__((address_space(3))) unsigned char* lds3) {
    const __attribute__((address_space(3))) float* gffn = (const __attribute__((address_space(3))) float*)(lds3 + L_GN);
    const __attribute__((address_space(3))) float* gfin = gffn + 2048;
    __attribute__((address_space(3))) v2u* SCH = (__attribute__((address_space(3))) v2u*)(lds3 + L_SCH) + wid * SCH4_CAP;
    const int nb = __builtin_amdgcn_readfirstlane(build_schedule4(lane, tl0, lds3, SCH));
    TokX X0, X1, X2, X3;
    token_prologue(n0, lane, H, SS, gffn, X0); token_prologue(n0 + 1, lane, H, SS, gffn, X1); token_prologue(n0 + 2, lane, H, SS, gffn, X2); token_prologue(n0 + 3, lane, H, SS, gffn, X3);
    __syncthreads();
#define PEER_PSLOT(q) ((__attribute__((address_space(3))) v4u*)(lds3 + ((q) < 8 ? (q) * 4096 : L_PARK4B + ((q) - 8) * 4096)) + lane)
    TokX Xc = X0;
    v2f_t acc[16]; int cur = 0; unsigned pmap = ((unsigned)(3 * wid) << 8) | ((unsigned)(3 * wid + 1) << 16) | ((unsigned)(3 * wid + 2) << 24);
#pragma unroll
    for (int j = 0; j < 16; ++j) acc[j] = (v2f_t){0.f, 0.f};
    if (!fake)
#pragma unroll
    for (int q = 0; q < 3; ++q) { __attribute__((address_space(3))) v4u* ps_ = PEER_PSLOT(3 * wid + q);
#pragma unroll
        for (int j = 0; j < 4; ++j) ps_[j * 64] = (v4u){0u, 0u, 0u, 0u}; }
    const bool b5 = (lane & 32) != 0, b4 = (lane & 16) != 0;
    v4u uaA[4], vaA[4], uaB[4], vaB[4]; v2f_t scA[4], scB[4]; float gtA[4], gtB[4]; int tkA, tkB;
#define PEER_LOADB(UA, VA, SC, GTV, TK, BI) { _Pragma("unroll") for (int k = 0; k < 4; ++k) { const v2u en_ = SCH[4 * (BI) + k]; \
        const int ek_ = __builtin_amdgcn_readfirstlane((int)en_.x); if (k == 0) TK = ek_ >> 16; GTV[k] = __uint_as_float(en_.y); \
        const int ei_ = fake ? (ek_ & 0xffff & PEER_FAKE_EMASK) : (ek_ & 0xffff); const unsigned char* rec_ = REC + (size_t)ei_ * FP6_PITCH + lane * 16; \
        if (!(fake && PEER_FAKE_MODE == 2)) { UA[k] = *(const v4u*)rec_; VA[k] = *(const v4u*)(rec_ + 1024); SC[k] = *(const v2f_t*)(ISC + 2 * ei_); } \
        else { UA[k][0] ^= (unsigned)ei_; VA[k][1] += (unsigned)ei_; } } }
#define PEER_DEC(q, b) __builtin_amdgcn_cvt_scalef32_pk_f32_fp4(q, 1.0f, b)
#define PEER_SEL4(F) (t2_ ? (t1_ ? X3.F : X2.F) : (t1_ ? X1.F : X0.F))
#define PEER_UNPARK(PS) { _Pragma("unroll") for (int j = 0; j < 4; ++j) { const v4u o_ = (PS)[j * 64]; \
        acc[4 * j + 0] = (v2f_t){bflo(o_.x), bfhi(o_.x)}; acc[4 * j + 1] = (v2f_t){bflo(o_.y), bfhi(o_.y)}; acc[4 * j + 2] = (v2f_t){bflo(o_.z), bfhi(o_.z)}; acc[4 * j + 3] = (v2f_t){bflo(o_.w), bfhi(o_.w)}; } }
#define PEER_EVALB(UA, VA, SC, GTV, TK) if (fake && PEER_FAKE_MODE == 1) { _Pragma("unroll") for (int k = 0; k < 4; ++k) { \
            acc[k].x += __uint_as_float((UA[k][0] ^ UA[k][1]) + (UA[k][2] ^ UA[k][3])) * SC[k].x; acc[k].y += __uint_as_float((VA[k][0] ^ VA[k][1]) + (VA[k][2] ^ VA[k][3])) * GTV[k]; } } else { float d[4]; \
        const bool t1_ = ((TK) & 1) != 0, t2_ = ((TK) & 2) != 0; \
        if (!fake && (TK) != cur) {            \
            const int q_ = (int)((pmap >> (8 * (TK))) & 255u); __attribute__((address_space(3))) v4u* ps_ = PEER_PSLOT(q_); \
            _Pragma("unroll") for (int j = 0; j < 4; ++j) { const v4u o_ = ps_[j * 64]; \
                ps_[j * 64] = (v4u){pg8::cvt_pk_bf16(acc[4 * j].x, acc[4 * j].y), pg8::cvt_pk_bf16(acc[4 * j + 1].x, acc[4 * j + 1].y), pg8::cvt_pk_bf16(acc[4 * j + 2].x, acc[4 * j + 2].y), pg8::cvt_pk_bf16(acc[4 * j + 3].x, acc[4 * j + 3].y)}; \
                acc[4 * j + 0] = (v2f_t){bflo(o_.x), bfhi(o_.x)}; acc[4 * j + 1] = (v2f_t){bflo(o_.y), bfhi(o_.y)}; acc[4 * j + 2] = (v2f_t){bflo(o_.z), bfhi(o_.z)}; acc[4 * j + 3] = (v2f_t){bflo(o_.w), bfhi(o_.w)}; } \
            pmap = (pmap & ~(255u << (8 * cur))) | ((unsigned)q_ << (8 * cur)); cur = (TK); \
            _Pragma("unroll") for (int j = 0; j < 4; ++j) { Xc.xhi[j] = PEER_SEL4(xhi[j]); Xc.xlo[j] = PEER_SEL4(xlo[j]); } Xc.halfX = PEER_SEL4(halfX); Xc.sx = PEER_SEL4(sx); } \
        _Pragma("unroll") for (int k = 0; k < 4; ++k) { int sh = 0, sl = 0; \
            _Pragma("unroll") for (int j = 0; j < 4; ++j) { sh = __builtin_amdgcn_sdot8((int)UA[k][j], (int)Xc.xhi[j], sh, false); sl = __builtin_amdgcn_sdot8((int)UA[k][j], (int)Xc.xlo[j], sl, false); } \
            d[k] = (float)(sh * 16 + sl); } \
        __builtin_amdgcn_sched_barrier(0); \
        float t; { const auto r01 = __builtin_amdgcn_permlane32_swap(__float_as_uint(d[0]), __float_as_uint(d[1]), false, false); \
                   const auto r23 = __builtin_amdgcn_permlane32_swap(__float_as_uint(d[2]), __float_as_uint(d[3]), false, false); \
                   const float a01 = __uint_as_float(r01[0]) + __uint_as_float(r01[1]), a23 = __uint_as_float(r23[0]) + __uint_as_float(r23[1]); \
                   const auto rr = __builtin_amdgcn_permlane16_swap(__float_as_uint(a01), __float_as_uint(a23), false, false); \
                   t = row_sum16(__uint_as_float(rr[0]) + __uint_as_float(rr[1])); } \
        const float ius = b5 ? (b4 ? SC[3].x : SC[1].x) : (b4 ? SC[2].x : SC[0].x); \
        const float ivs = b5 ? (b4 ? SC[3].y : SC[1].y) : (b4 ? SC[2].y : SC[0].y); \
        const float gts = b5 ? (b4 ? GTV[3] : GTV[1]) : (b4 ? GTV[2] : GTV[0]); \
        const float wv = gts * gelu_tanh_fast((t + Xc.halfX) * (Xc.sx * ius)) * ivs; \
        float w[4]; \
        w[0] = __uint_as_float(__builtin_amdgcn_readlane(__float_as_uint(wv), 0)); w[2] = __uint_as_float(__builtin_amdgcn_readlane(__float_as_uint(wv), 16)); \
        w[1] = __uint_as_float(__builtin_amdgcn_readlane(__float_as_uint(wv), 32)); w[3] = __uint_as_float(__builtin_amdgcn_readlane(__float_as_uint(wv), 48)); \
        __builtin_amdgcn_sched_barrier(0); \
        _Pragma("unroll") for (int k = 0; k < 4; ++k) { const v2f_t wk = {w[k], w[k]}; \
            _Pragma("unroll") for (int j = 0; j < 4; ++j) { const unsigned qw = VA[k][j]; \
                acc[4 * j + 0] += wk * PEER_DEC(qw, 0); acc[4 * j + 1] += wk * PEER_DEC(qw, 1); acc[4 * j + 2] += wk * PEER_DEC(qw, 2); acc[4 * j + 3] += wk * PEER_DEC(qw, 3); } \
            __builtin_amdgcn_sched_barrier(0); } }
    if (fake && PEER_FAKE_MODE == 2) {
#pragma unroll
        for (int k = 0; k < 4; ++k) { uaA[k] = (v4u){(unsigned)lane, 1u, 2u, 3u}; vaA[k] = uaA[k]; uaB[k] = uaA[k]; vaB[k] = uaA[k]; scA[k] = (v2f_t){1.f, 1.f}; scB[k] = scA[k]; } }
    PEER_LOADB(uaA, vaA, scA, gtA, tkA, 0)
    int kb = 1, nbnd = PEER_SYNC_SLICES ? __builtin_amdgcn_readfirstlane((int)SCH[SCH4_CAP - 8 + 1].x) : 0x7fffffff;
#pragma unroll 1
    for (int i = 0; i < nb; i += 2) {
#if PEER_SYNC_SLICES
        while (i >= nbnd) { __builtin_amdgcn_s_barrier(); ++kb; nbnd = kb < 8 ? __builtin_amdgcn_readfirstlane((int)SCH[SCH4_CAP - 8 + (kb & 7)].x) : 0x7fffffff; }
#endif
        { const int bn = i + 1 < nb ? i + 1 : nb - 1; PEER_LOADB(uaB, vaB, scB, gtB, tkB, bn) }
        __builtin_amdgcn_sched_barrier(0);
        PEER_EVALB(uaA, vaA, scA, gtA, tkA)
        __builtin_amdgcn_sched_barrier(0);
        { const int bn = i + 2 < nb ? i + 2 : nb - 1; PEER_LOADB(uaA, vaA, scA, gtA, tkA, bn) }
        __builtin_amdgcn_sched_barrier(0);
        if (i + 1 < nb) { PEER_EVALB(uaB, vaB, scB, gtB, tkB) }
        __builtin_amdgcn_sched_barrier(0);
    }
#if PEER_SYNC_SLICES
    while (kb < 8) { __builtin_amdgcn_s_barrier(); ++kb; }
#endif
    if (fake) { float sq_ = 0.f;
#pragma unroll
        for (int j = 0; j < 16; ++j) sq_ += acc[j].x + acc[j].y;
        if (sq_ != 12345.678f) return; }
    token_epilogue(n0 + cur, lane, H, gfin, acc, out);
#pragma unroll 1
    for (int t = 0; t < 4; ++t) if (t != cur) { const int q_ = (int)((pmap >> (8 * t)) & 255u); __attribute__((address_space(3))) v4u* ps_ = PEER_PSLOT(q_);
        PEER_UNPARK(ps_)
        token_epilogue(n0 + t, lane, H, gfin, acc, out); }
#undef PEER_LOADB
#undef PEER_EVALB
#undef PEER_DEC
#undef PEER_SEL4
#undef PEER_UNPARK
#undef PEER_PSLOT
}

__device__ __forceinline__ void peer_phase(const bf16* QP, const bf16* SKB, const bf16* H, const float* SS, const float* gffn, const unsigned char* REC, const float* ISC,
                                           const float* gfin, float* out, __attribute__((address_space(3))) unsigned char* lds3, int bid, int G) {
    int tid = threadIdx.x; asm volatile("" : "+v"(tid));
    const int lane = tid & 63, wid = __builtin_amdgcn_readfirstlane(tid >> 6);
    { __attribute__((address_space(3))) float* gl = (__attribute__((address_space(3))) float*)(lds3 + L_GN);
      for (int i = tid; i < 2048; i += NTHR) { gl[i] = gffn[i]; gl[2048 + i] = gfin[i]; } }
    for (int unit = bid; unit < NTOK / 32; unit += G) {
        const int tok0 = unit * 32;
        route_head(QP, SKB, wid, tok0, lane, lds3);
        asm volatile("s_waitcnt lgkmcnt(0)" ::: "memory"); __syncthreads();
        { int ln = lane; asm volatile("" : "+v"(ln));
#if PEER_SLICED == 2
#if PEER_FAKE
          ffn_quad(true, tok0 + wid * 4, wid * 4, ln, wid, H, SS, REC, ISC, out, lds3);
          __syncthreads();
#endif
          ffn_quad(false, tok0 + wid * 4, wid * 4, ln, wid, H, SS, REC, ISC, out, lds3);
#elif PEER_SLICED
#pragma unroll 1
#if PEER_FAKE
          for (int rd = 0; rd < 2; ++rd) ffn_pair(true, tok0 + wid * 4 + 2 * rd, wid * 4 + 2 * rd, ln, wid, H, SS, REC, ISC, out, lds3);
#pragma unroll 1
#endif
          for (int rd = 0; rd < 2; ++rd) ffn_pair(false, tok0 + wid * 4 + 2 * rd, wid * 4 + 2 * rd, ln, wid, H, SS, REC, ISC, out, lds3);
#else
#if PEER_FAKE
#pragma unroll 1
          for (int tk = 0; tk < 4; ++tk) ffn_token(PEER_FAKE, true, tok0 + wid * 4 + tk, wid * 4 + tk, ln, H, SS, REC, ISC, out, lds3);
#endif
#pragma unroll 1
          for (int tk = 0; tk < 4; ++tk) ffn_token(0xffffff, false, tok0 + wid * 4 + tk, wid * 4 + tk, ln, H, SS, REC, ISC, out, lds3);
#endif
        }
        __syncthreads();
    }
}
#undef PEER_CE
}
constexpr int RING_BYTES = 131072, LDS_BYTES = 163840, LDSCTL_OFF = LDS_BYTES - 1024, MISC_OFF = LDSCTL_OFF + 320;
constexpr int N_PHASES = 8;
#ifndef PG8_SP2_SMALL
#define PG8_SP2_SMALL true
#endif
#ifndef MK_N_LAUNCHES
#define MK_N_LAUNCHES 1
#endif

__global__ void __launch_bounds__(NTHR, 2) fwd_megakernel(Args args) {
    extern __shared__ __attribute__((aligned(16))) unsigned char lds[];
    LAS unsigned char* lds3 = (LAS unsigned char*)lds;
    int tid_ = threadIdx.x; asm volatile("" : "+v"(tid_));
    const int tid = tid_, lane = tid & 63, wave = __builtin_amdgcn_readfirstlane(tid >> 6);
    const int G = gridDim.x, bid = blockIdx.x;
    unsigned char* ws = args.ws;
    unsigned* ctl = (unsigned*)(ws + WS_CTL);
    const float* x = args.in[0];
    bf16* WinT = (bf16*)(ws + WS_WIN); bf16* WbnT = (bf16*)(ws + WS_WBN); bf16* WbsT = (bf16*)(ws + WS_WBS); bf16* WoutT = (bf16*)(ws + WS_WOUT); bf16* WpqT = (bf16*)(ws + WS_WPQ);
    bf16* XN = (bf16*)(ws + WS_XN); bf16* MERGED = XN; bf16* PROJ = (bf16*)(ws + WS_PROJ);
    bf16* ONSA = (bf16*)(ws + WS_ONSA); bf16* OSB = (bf16*)(ws + WS_OSB);
    float* H = (float*)(ws + WS_H); bf16* HB = (bf16*)(ws + WS_HB);
    unsigned char* REC = ws + WS_UB; float* ISC = (float*)(ws + WS_UB + 48 * MiB); bf16* QP = (bf16*)(ws + WS_QP);
    int* EXPERT = (int*)(ws + WS_EXP); float* GATE = (float*)(ws + WS_GATE);
    bf16* KCB = (bf16*)(ws + WS_MISC + MISC_KCB); bf16* VCB = (bf16*)(ws + WS_MISC + MISC_VCB);
    float* SS = (float*)(ctl + CW_SS);
    float* BTG = (float*)(ws + WS_MISC + MISC_B1 + 4096);
    bf16* W1T = (bf16*)(ws + WS_MISC + MISC_W1T); float* BIAS1 = (float*)(ws + WS_MISC + MISC_B1);
    bf16* SKB = (bf16*)(ws + WS_MISC + MISC_SKB);

    for (int u = tid; u < (LDS_BYTES - LDSCTL_OFF) / 4; u += NTHR) ((LAS unsigned*)(lds3 + LDSCTL_OFF))[u] = 0u;
    __syncthreads();
    const int lo = args.ph_lo, hi = args.ph_hi;
    XcdBarrier bar; bar.bar = ctl + CW_BAR; bar.x = 0; bar.st = nullptr;
    if (hi - lo > 1) bar = xcd_barrier_post(ctl + CW_BAR, (volatile LAS unsigned*)(lds3 + MISC_OFF) + 8);
#define IN(k) (lo <= (k) && (k) < hi)
#ifndef REP_BAR
#define REP_BAR 1
#endif
#define SEAM(k) do { if (IN(k) && IN((k) + 1)) for (int rb_ = 0; rb_ < REP_BAR; ++rb_) xcd_barrier(bar); } while (0)
    const int gw = bid * NWAVES + wave, NGW = G * NWAVES;
    const int vcu = (G % 8 == 0) ? (bid % 8) * (G / 8) + bid / 8 : bid;

#if defined(TS_PHASE)
    unsigned long long ts0_ = 0;
#define TS_BEGIN(k) do { if (TS_PHASE == (k)) ts0_ = __builtin_amdgcn_s_memrealtime(); } while (0)
#define TS_END(k) do { if (TS_PHASE == (k)) { const unsigned dt_ = (unsigned)(__builtin_amdgcn_s_memrealtime() - ts0_); if (tid == 0) atomicMax(ctl + 64, dt_); } } while (0)
#else
#define TS_BEGIN(k) do {} while (0)
#define TS_END(k) do {} while (0)
#endif
#ifndef REP_P0
#define REP_P0 1
#endif
#ifndef REP_P1
#define REP_P1 1
#endif
#ifndef REP_P4
#define REP_P4 1
#endif
#ifndef REP_P6
#define REP_P6 1
#endif
#ifndef REP_P5C
#define REP_P5C 1
#endif
    TS_BEGIN(0);
    if (IN(0)) for (int rep_ = 0; rep_ < REP_P0; ++rep_) {
        LAS float* scr = (LAS float*)(lds3 + wave * 16384);
        constexpr int I_IN = (D_MODEL / 64) * ((IN_COLS + 31) / 32), I_BR = (1024 / 64) * (D_MODEL / 32), I_SQ = (D_MODEL / 64) * (D_MODEL / 32);
        constexpr int I_C1 = (2048 / 64) * (CMP_HID / 32);
        constexpr int NITEMS = I_IN + 2 * I_BR + 2 * I_SQ + 2 * I_C1;
        auto p0_desc = [&](int it) -> P0Item {
            int r = it;
            if (r < I_IN) return P0Item{args.in[2], WinT, nullptr, D_MODEL, IN_COLS, r, C_SHIFT_FROM, C_SHIFT}; r -= I_IN;
            if (r < I_BR) return P0Item{args.in[10], WbnT, nullptr, 1024, D_MODEL, r, 0x7fffffff, 0}; r -= I_BR;
            if (r < I_BR) return P0Item{args.in[11], WbsT, nullptr, 1024, D_MODEL, r, 0x7fffffff, 0}; r -= I_BR;
            if (r < I_SQ) return P0Item{args.in[12], WoutT, nullptr, D_MODEL, D_MODEL, r, 0x7fffffff, 0}; r -= I_SQ;
            if (r < I_SQ) return P0Item{args.in[14], WpqT, args.in[13], D_MODEL, D_MODEL, r, 0x7fffffff, 0}; r -= I_SQ;
            if (r < I_C1) return P0Item{args.in[4], W1T, nullptr, 2048, CMP_HID, r, 0x7fffffff, 0}; r -= I_C1;
            return P0Item{args.in[7], W1T + (size_t)CMP_HID * 2048, nullptr, 2048, CMP_HID, r, 0x7fffffff, 0};
        };
        {
            f32x4 va[8], vb[8];
            int it = gw;
            P0Item da = p0_desc(it < NITEMS ? it : 0), db = da;
            if (it < NITEMS) p0_item_load(da, lane, va);
#pragma unroll 1
            for (; it < NITEMS; it += 2 * NGW) {
                const int i1 = it + NGW, i2 = it + 2 * NGW;
                if (i1 < NITEMS) { db = p0_desc(i1); p0_item_load(db, lane, vb); }
                __builtin_amdgcn_sched_barrier(0);
                p0_item_store(da, lane, va, scr);
                __builtin_amdgcn_sched_barrier(0);
                if (i2 < NITEMS) { da = p0_desc(i2); p0_item_load(da, lane, va); }
                __builtin_amdgcn_sched_barrier(0);
                if (i1 < NITEMS) p0_item_store(db, lane, vb, scr);
                __builtin_amdgcn_sched_barrier(0);
            }
        }
        {
            v4u z = {0u, 0u, 0u, 0u}; bf16* p = WinT + (size_t)C_SHIFT_FROM * D_MODEL; const size_t nz = (size_t)C_SHIFT * D_MODEL;
            for (size_t i = ((size_t)bid * NTHR + tid) * 8; i < nz; i += (size_t)G * NTHR * 8) *(v4u*)(p + i) = z;
        }
        if (gw < 2 * CMP_HID) {
            const int kv = gw >> 7, j = gw & 127; const float* pe = args.in[kv ? 6 : 3]; const float* w1 = args.in[kv ? 7 : 4];
            float s = 0.f;
            for (int k2 = lane; k2 < 2048; k2 += 64) s += pe[k2] * w1[(size_t)k2 * CMP_HID + j];
            s = wave_sum(s);
            if (lane == 0) BIAS1[gw] = s;
        }
        for (int i = bid * NTHR + tid; i < 4 * 4 * 800; i += G * NTHR) { const int gq = i / 800, d = i - gq * 800; BTG[i] = args.in[9][rel_bucket(d) * 16 + gq] * 1.4426950408889634f; }
        cvt_flat(args.in[15], SKB, (size_t)16 * 128 * 128, (size_t)bid * NTHR + tid, (size_t)G * NTHR);
        {
            f32x4 ra[8], rb[8];
            int m = gw;
            if (m < NTOK) rms_row_load(x + (size_t)m * D_MODEL, lane, ra);
#pragma unroll 1
            for (; m < NTOK; m += 2 * NGW) {
                const int m1 = m + NGW, m2 = m + 2 * NGW;
                if (m1 < NTOK) rms_row_load(x + (size_t)m1 * D_MODEL, lane, rb);
                __builtin_amdgcn_sched_barrier(0);
                rms_row_finish(ra, args.in[1], XN + (size_t)m * D_MODEL, lane);
                __builtin_amdgcn_sched_barrier(0);
                if (m2 < NTOK) rms_row_load(x + (size_t)m2 * D_MODEL, lane, ra);
                __builtin_amdgcn_sched_barrier(0);
                if (m1 < NTOK) rms_row_finish(rb, args.in[1], XN + (size_t)m1 * D_MODEL, lane);
                __builtin_amdgcn_sched_barrier(0);
            }
        }
    }
    TS_END(0);
    SEAM(0);
    TS_BEGIN(1);
    if (IN(1)) for (int rep_ = 0; rep_ < REP_P1; ++rep_) {
        pg8::Gemm g{XN, WinT, NTOK, PLD, D_MODEL}; pg8::StaticOrder S; S.init(NTOK, PLD, G, bid);
        pg8::EpiBf16<0> E{PROJ, PP, nullptr, PP, (size_t)NTOK * PP, 1.f};
        pg8::gemm_phase<pg8::EpiBf16<0>, pg8::StaticOrder, true, true>(lds3, g, S, E);
    }
    TS_END(1);
    SEAM(1);
    TS_BEGIN(2);
    if (IN(2)) cmpr::compress_phase(PROJ, W1T, BIAS1, args.in, KCB, VCB, lds3, bid, G);
    TS_END(2);
    SEAM(2);
    TS_BEGIN(3);
    if (IN(3)) {
        TS_BEGIN(30);
        nsa::nsa_phase(PROJ, KCB, VCB, BTG, ONSA, lds3, vcu, G, args.variant);
        TS_END(30);
#if defined(PROBE_P3A)
        nsa::nsa_phase(PROJ, KCB, VCB, args.in[9], ONSA, lds3, vcu, G);
#endif
        TS_BEGIN(31);
        if (!(args.variant & 32)) nsa::stick_phase(PROJ, OSB, lds3, vcu, G);
        TS_END(31);
#if defined(PROBE_P3B)
        nsa::stick_phase(PROJ, OSB, lds3, vcu, G);
#endif
    }
    TS_END(3);
    SEAM(3);
    TS_BEGIN(4);
    if (IN(4)) for (int rep_ = 0; rep_ < REP_P4; ++rep_) {
        static_assert(WS_OSB == WS_ONSA + (size_t)NTOK * NSA_Q * 2 && WS_WBS == WS_WBN + (size_t)D_MODEL * 1024 * 2, "branch operands must be contiguous");
        pg8::Gemm g{ONSA, WbnT, 2 * NTOK, 2 * D_MODEL, 1024}; pg8::BranchOrder S; S.init(NTOK, D_MODEL, G, bid);
        pg8::EpiGate2 E{MERGED, D_MODEL, PNL(PROJ, P_GA), PNL(PROJ, P_GB), PP, (size_t)NTOK * PP - PP, NTOK / 256, D_MODEL / 256};
        pg8::gemm_phase<pg8::EpiGate2, pg8::BranchOrder, true, PG8_SP2_SMALL>(lds3, g, S, E);
    }
    TS_END(4);
    SEAM(4);
    TS_BEGIN(5);
    if (IN(5)) {
        if (!(args.variant & 64)) { pg8::Gemm g{MERGED, WoutT, NTOK, D_MODEL, D_MODEL}; pg8::StaticOrder S; S.init(NTOK, D_MODEL, G, bid);
          pg8::EpiResid E{x, HB, SS, D_MODEL};
          pg8::gemm_phase<pg8::EpiResid, pg8::StaticOrder, true, PG8_SP2_SMALL>(lds3, g, S, E); }
        int t5 = threadIdx.x; asm volatile("" : "+v"(t5));
        const int lane5 = t5 & 63, gw5 = bid * NWAVES + __builtin_amdgcn_readfirstlane(t5 >> 6);
        if (!(args.variant & 128)) peer::cvt_tables(args.in[16], args.in[17], REC, ISC, gw5, NGW, lane5);
    }
    TS_END(5);
    SEAM(5);
    TS_BEGIN(6);
    if (IN(6)) for (int rep_ = 0; rep_ < REP_P6; ++rep_) {
        pg8::Gemm g{HB, WpqT, NTOK, D_MODEL, D_MODEL}; pg8::StaticOrder S; S.init(NTOK, D_MODEL, G, bid);
        pg8::EpiRowScale E{QP, D_MODEL, SS, 1.f / D_MODEL, EPS};
        pg8::gemm_phase<pg8::EpiRowScale, pg8::StaticOrder, true, PG8_SP2_SMALL>(lds3, g, S, E);
    }
    TS_END(6);
    SEAM(6);
    TS_BEGIN(7);
    if (IN(7)) {
        peer::peer_phase(QP, SKB, HB, SS, args.in[13], REC, ISC, args.in[18], args.out, lds3, bid, G);
    }
    TS_END(7);
#if defined(TS_PHASE)
    xcd_barrier(bar);
    if (bid == 0) { const unsigned dt_ = __hip_atomic_load(ctl + 64, RLX_AGENT); const int K_ = (int)((float)dt_ * 0.01f * 16.777216f * 2.f);
        for (int i = tid; i < K_; i += NTHR) args.out[i] += 1.0f; }
#endif
#undef IN
#undef SEAM
}

extern "C" void kernel_launch(void* const* d_in, const int* in_sizes, int n_in, void* d_out, int out_size, void* d_ws, size_t ws_size, hipStream_t stream) {
    static int grid = 0;
    if (grid == 0) {
        if (n_in != 19 || ws_size < WS_END) { fprintf(stderr, "kernel_launch: unexpected inputs (%d) or workspace (%zu < %zu)\n", n_in, ws_size, (size_t)WS_END); grid = -1; return; }
        int dev = 0, cus = 0, per_cu = 0;
        hipGetDevice(&dev); hipDeviceGetAttribute(&cus, hipDeviceAttributeMultiprocessorCount, dev);
        if (hipFuncSetAttribute((const void*)fwd_megakernel, hipFuncAttributeMaxDynamicSharedMemorySize, LDS_BYTES) != hipSuccess) { fprintf(stderr, "hipFuncSetAttribute failed\n"); grid = -1; return; }
        if (hipOccupancyMaxActiveBlocksPerMultiprocessor(&per_cu, (const void*)fwd_megakernel, NTHR, LDS_BYTES) != hipSuccess || per_cu < 1) { fprintf(stderr, "occupancy query: %d\n", per_cu); per_cu = 1; }
        (void)hipGetLastError();
        grid = cus;
        if (grid > cus * per_cu) grid = cus * per_cu;
    }
    if (grid < 0) return;
    hipMemsetAsync((char*)d_ws + WS_CTL, 0, (size_t)(CW_SS + NTOK) * 4, stream);
    Args a{};
    for (int i = 0; i < 19; ++i) a.in[i] = (const float*)d_in[i];
    a.out = (float*)d_out; a.ws = (unsigned char*)d_ws;
#if defined(PROBE_SPLIT_LO2)
#ifndef PROBE_VARIANT
#define PROBE_VARIANT 0
#endif
    {
        a.ph_lo = 0; a.ph_hi = PROBE_SPLIT_HI1; a.variant = PROBE_VARIANT; hipLaunchKernelGGL(fwd_megakernel, dim3(grid), dim3(NTHR), LDS_BYTES, stream, a);
        hipMemsetAsync((char*)d_ws + WS_CTL + CW_BAR * 4, 0, XCD_BAR_WORDS * 4, stream);
        if (PROBE_SPLIT_LO2 <= 5 && PROBE_SPLIT_HI1 > 5) hipMemsetAsync((char*)d_ws + WS_CTL + CW_SS * 4, 0, NTOK * 4, stream);
        a.ph_lo = PROBE_SPLIT_LO2; a.ph_hi = N_PHASES; a.variant = 0; hipLaunchKernelGGL(fwd_megakernel, dim3(grid), dim3(NTHR), LDS_BYTES, stream, a);
        return;
    }
#endif
    if (MK_N_LAUNCHES == 1) {
        a.ph_lo = 0; a.ph_hi = N_PHASES;
        void* kargs[] = {&a};
#if defined(USE_COOP_LAUNCH)
        hipError_t e = hipLaunchCooperativeKernel((const void*)fwd_megakernel, dim3(grid), dim3(NTHR), kargs, LDS_BYTES, stream);
        if (e != hipSuccess) fprintf(stderr, "cooperative launch failed: %s (grid %d)\n", hipGetErrorString(e), grid);
#else
        (void)kargs;
        hipLaunchKernelGGL(fwd_megakernel, dim3(grid), dim3(NTHR), LDS_BYTES, stream, a);
#endif
    } else {
        for (int p = 0; p < N_PHASES; ++p) { a.ph_lo = p; a.ph_hi = p + 1; hipLaunchKernelGGL(fwd_megakernel, dim3(grid), dim3(NTHR), LDS_BYTES, stream, a); }
    }
}
```

```cpp
#include <hip/hip_runtime.h>
#include <cstdio>
#include <cstdint>
#include <cmath>
#ifndef PG8_NT_STORES
#define PG8_NT_STORES 0
#endif
#if PG8_NT_STORES
#define PG8_STORE_OUT(p, v) __builtin_nontemporal_store((v), (p))
#else
#define PG8_STORE_OUT(p, v) (*(p) = (v))
#endif
namespace pg8 {
#define PG8_LAS __attribute__((address_space(3)))
typedef unsigned short bf16_t;
typedef short bf16x8 __attribute__((ext_vector_type(8)));
typedef float f32x4 __attribute__((ext_vector_type(4)));
typedef unsigned u32x4 __attribute__((ext_vector_type(4)));
constexpr int BM = 256, BK = 64, HALF = 128, HTB = HALF * BK * 2  , STAGE_BYTES = 8 * HTB, NXCD = 8, WGM = 8;

__host__ __device__ __forceinline__ int lds_byte(int r, int c) { const int st = (r >> 4) * 2 + (c >> 5), rr = r & 15, cc = c & 31, ob = rr * 64 + cc * 2; return st * 1024 + (ob ^ (((ob >> 9) & 1) << 5)); }
__host__ __device__ __forceinline__ void stage_rc(int b, int& R, int& C) { const int st = b / 1024, sb = b % 1024, swz = sb ^ (((sb >> 9) & 1) << 5); R = (st >> 1) * 16 + swz / 64; C = (st & 1) * 32 + (swz % 64) / 2; }
__host__ __device__ __forceinline__ int perm32(int rho) { const int n = rho >> 4, i = rho & 15; return 8 * (i >> 2) + 4 * n + (i & 3); }

struct Unit { int pm, pn; };
struct Gemm { const bf16_t* A; const bf16_t* Bt; int M, N, K; };

struct StaticOrder {
    int nM, nN, nwg, G, c;
    __host__ __device__ void init(int M, int N, int G_, int c_) { nM = M / BM; nN = N / BM; nwg = nM * nN; G = G_; c = c_; }
    __host__ __device__ bool next(int i, Unit& u) const {
        const long L = (long)i * G + c; if (L >= nwg) return false;
        int wgid = (int)L; { const int q = nwg / NXCD, r = nwg % NXCD, xcd = wgid % NXCD, off = wgid / NXCD; wgid = (xcd < r ? xcd * (q + 1) : r * (q + 1) + (xcd - r) * q) + off; }
        const int nig = WGM * nN, gid = wgid / nig, fm = gid * WGM, gsz = (nM - fm) < WGM ? (nM - fm) : WGM;
        u.pm = fm + ((wgid % nig) % gsz); u.pn = (wgid % nig) / gsz; return true;
    }
    __device__ __forceinline__ void a_ready(const Unit&) const {}
    __device__ __forceinline__ void done(const Unit&) const {}
};

__device__ __forceinline__ unsigned cvt_pk_bf16(float lo, float hi) { unsigned r; asm volatile("v_cvt_pk_bf16_f32 %0, %1, %2" : "=v"(r) : "v"(lo), "v"(hi)); return r; }
typedef float f32x2 __attribute__((ext_vector_type(2)));
__device__ __forceinline__ f32x2 gelu_pk(f32x2 v) {
    const f32x2 av = __builtin_elementwise_abs(v), d = av * 0.2316418882f + 1.0f;
    f32x2 t; t.x = __builtin_amdgcn_rcpf(d.x); t.y = __builtin_amdgcn_rcpf(d.y);
    f32x2 q = t * 0.5307027145f + (-0.7265760135f); q = q * t + 0.7107068705f; q = q * t + (-0.142248368f); q = q * t + 0.127414796f; q = q * t;
    const f32x2 s = (v * v) * (-0.72134752044f);
    f32x2 e; e.x = __builtin_amdgcn_exp2f(s.x); e.y = __builtin_amdgcn_exp2f(s.y);
    const f32x2 m = v * (q * e), r = v - m;
    f32x2 o; o.x = v.x < 0.f ? m.x : r.x; o.y = v.y < 0.f ? m.y : r.y; return o;
}

template <int ACT  > struct EpiBf16 {
    static constexpr bool PERM = true, AFTER_DRAIN = false; static_assert(ACT == 0 || ACT == 1, "EpiBf16: ACT is 0 (none) or 1 (gelu_pk)");
    bf16_t* O; int ldc; const float* bias; int split_cols; size_t split_stride; float scale0;
    __device__ __forceinline__ void operator()(const f32x4 (&acc)[2][2][4][2], const Unit& u, int wr, int wc, int fr, int fq) const {
        const int row0 = u.pm * BM + wr * 64 + fr; int colt = u.pn * BM; bf16_t* base = O;
        float sc = 1.f; if (split_cols) { const int t = colt / split_cols; base += (size_t)t * split_stride; colt -= t * split_cols; if (t == 0) sc = scale0; }
        const int col0 = colt + wc * 32 + 8 * fq, bcol0 = u.pn * BM + wc * 32 + 8 * fq;
        f32x4 bv[2][2];
#pragma unroll
        for (int bj = 0; bj < 2; ++bj)
#pragma unroll
            for (int n = 0; n < 2; ++n) bv[bj][n] = bias ? *(const f32x4*)(bias + bcol0 + bj * HALF + 4 * n) : (f32x4){0.f, 0.f, 0.f, 0.f};
#pragma unroll
        for (int ai = 0; ai < 2; ++ai)
#pragma unroll
            for (int m = 0; m < 4; ++m) { bf16_t* rowp = base + (size_t)(row0 + ai * HALF + m * 16) * ldc + col0;
#pragma unroll
                for (int bj = 0; bj < 2; ++bj) { f32x4 v0 = acc[ai][bj][m][0] + bv[bj][0], v1 = acc[ai][bj][m][1] + bv[bj][1];
                    if (ACT == 1) { f32x2 a = gelu_pk((f32x2){v0[0], v0[1]}), b = gelu_pk((f32x2){v0[2], v0[3]}), c = gelu_pk((f32x2){v1[0], v1[1]}), d = gelu_pk((f32x2){v1[2], v1[3]});
                        v0 = (f32x4){a.x, a.y, b.x, b.y}; v1 = (f32x4){c.x, c.y, d.x, d.y}; }
                    v0 = v0 * sc; v1 = v1 * sc; u32x4 w; w.x = cvt_pk_bf16(v0[0], v0[1]); w.y = cvt_pk_bf16(v0[2], v0[3]); w.z = cvt_pk_bf16(v1[0], v1[1]); w.w = cvt_pk_bf16(v1[2], v1[3]);
                    PG8_STORE_OUT((u32x4*)(rowp + bj * HALF), w); } }
    }
};

struct PanelStats {
    unsigned* xbuf;
    unsigned* cnt;
    unsigned* tmo;
    int ntn; float eps;
    unsigned code;
    __device__ __forceinline__ bool run(const f32x4 (&v)[2][2][4][2], const Unit& u, int wr, int wc, int fr, int fq, PG8_LAS unsigned char* lds, int wid, int lane) const {
        typedef float f32x2v __attribute__((ext_vector_type(2)));
        PG8_LAS f32x2v* P = (PG8_LAS f32x2v*)lds;
        PG8_LAS f32x2v* S = (PG8_LAS f32x2v*)(lds + 8192);
        PG8_LAS unsigned* flag = (PG8_LAS unsigned*)(lds + 8192 + 2048);
#pragma unroll
        for (int ai = 0; ai < 2; ++ai)
#pragma unroll
            for (int m = 0; m < 4; ++m) {
                float s = 0.f;
#pragma unroll
                for (int bj = 0; bj < 2; ++bj)
#pragma unroll
                    for (int n = 0; n < 2; ++n) { const f32x4 x = v[ai][bj][m][n]; s += (x[0] + x[1]) + (x[2] + x[3]); }
                s += __shfl_xor(s, 16); s += __shfl_xor(s, 32);
                const float mw = s * (1.0f / 64.0f); float q = 0.f;
#pragma unroll
                for (int bj = 0; bj < 2; ++bj)
#pragma unroll
                    for (int n = 0; n < 2; ++n) { const f32x4 d = v[ai][bj][m][n] - mw; q += (d[0] * d[0] + d[1] * d[1]) + (d[2] * d[2] + d[3] * d[3]); }
                q += __shfl_xor(q, 16); q += __shfl_xor(q, 32);
                if (fq == 0) P[(ai * HALF + wr * 64 + m * 16 + fr) * 4 + wc] = (f32x2v){mw, q};
            }
        asm volatile("s_waitcnt lgkmcnt(0)" ::: "memory"); __builtin_amdgcn_s_barrier(); asm volatile("" ::: "memory");
#if defined(BROKEN_EXCHANGE_NO_WAIT)
#warning BROKEN CONTROL BUILD: the row-statistics exchange does not wait; results are wrong by design
        if (blockIdx.x >= 64) { const long long t0_ = clock64(); while (clock64() - t0_ < 60000) __builtin_amdgcn_s_sleep(8); }
#endif
        const int row = wid * 32 + (lane & 31);
        if (lane < 32) {
            const f32x2v a = P[row * 4 + 0], b = P[row * 4 + 1], c = P[row * 4 + 2], d = P[row * 4 + 3];
            const float mt = (a.x + b.x + c.x + d.x) * 0.25f;
            const float da = a.x - mt, db = b.x - mt, dc = c.x - mt, dd = d.x - mt;
            const float m2 = (a.y + b.y) + (c.y + d.y) + 64.0f * ((da * da + db * db) + (dc * dc + dd * dd));
            unsigned long long* slot = (unsigned long long*)xbuf + ((size_t)(u.pm * BM + row) * 4 + u.pn);
            __hip_atomic_store(slot, ((unsigned long long)__float_as_uint(m2) << 32) | __float_as_uint(mt), __ATOMIC_RELAXED, __HIP_MEMORY_SCOPE_AGENT);
        }
        asm volatile("s_waitcnt vmcnt(0)" ::: "memory");
        if (lane == 0) __hip_atomic_fetch_add(cnt + 64 * u.pm, 1u, __ATOMIC_RELAXED, __HIP_MEMORY_SCOPE_AGENT);
        if (wid == 0) {
            bool dead = false; const unsigned long long t0 = __builtin_amdgcn_s_memrealtime(); const unsigned want = 8u * (unsigned)ntn;
            for (;;) {
#if defined(BROKEN_EXCHANGE_NO_WAIT)
                break;
#endif
                if ((unsigned)__builtin_amdgcn_readfirstlane(__hip_atomic_load(cnt + 64 * u.pm, __ATOMIC_RELAXED, __HIP_MEMORY_SCOPE_AGENT)) >= want) break;
                if (__builtin_amdgcn_s_memrealtime() - t0 > 2000000ull) {
                    if (lane == 0) { unsigned expect = 0u; __hip_atomic_compare_exchange_strong(tmo + 1, &expect, code | (unsigned)(u.pm & 0xff), __ATOMIC_RELAXED, __ATOMIC_RELAXED, __HIP_MEMORY_SCOPE_AGENT);
                                     __hip_atomic_store(tmo, 1u, __ATOMIC_RELAXED, __HIP_MEMORY_SCOPE_AGENT); }
                    dead = true; break; }
                __builtin_amdgcn_s_sleep(2);
            }
            __builtin_amdgcn_fence(__ATOMIC_ACQUIRE, "agent");
            if (lane == 0) flag[0] = dead ? 1u : 0u;
        }
        asm volatile("s_waitcnt vmcnt(0) lgkmcnt(0)" ::: "memory"); __builtin_amdgcn_s_barrier(); asm volatile("" ::: "memory");
        const bool bad = flag[0] != 0u;
        if (lane < 32) {
            const unsigned long long* slot = (const unsigned long long*)xbuf + (size_t)(u.pm * BM + row) * 4; float mt[4], m2[4]; float ms = 0.f;
#pragma unroll
            for (int t = 0; t < 4; ++t) { if (t < ntn) { const unsigned long long w = __hip_atomic_load(slot + t, __ATOMIC_RELAXED, __HIP_MEMORY_SCOPE_AGENT); mt[t] = __uint_as_float((unsigned)w); m2[t] = __uint_as_float((unsigned)(w >> 32)); } else { mt[t] = 0.f; m2[t] = 0.f; } ms += mt[t]; }
            const float mean = ms / (float)ntn; float q = 0.f;
#pragma unroll
            for (int t = 0; t < 4; ++t) if (t < ntn) { const float dm = mt[t] - mean; q += m2[t] + 256.0f * dm * dm; }
            S[row] = (f32x2v){mean, 1.0f / sqrtf(q / (256.0f * (float)ntn) + eps)};
        }
        asm volatile("s_waitcnt lgkmcnt(0)" ::: "memory"); __builtin_amdgcn_s_barrier(); asm volatile("" ::: "memory");
        return bad;
    }
};
struct EpiLnRes {
    static constexpr bool PERM = false, AFTER_DRAIN = true;
    const float* base; float* out; int ldc; const float* bias; PanelStats st; unsigned poison;
    __device__ __forceinline__ void fused(f32x4 (&acc)[2][2][4][2], const Unit& u, int wr, int wc, int fr, int fq, PG8_LAS unsigned char* lds, int wid, int lane) const {
        typedef float f32x2v __attribute__((ext_vector_type(2)));
        const PG8_LAS f32x2v* S = (const PG8_LAS f32x2v*)(lds + 8192);
        const int col0 = u.pn * BM + wc * 32 + 4 * fq;
#pragma unroll
        for (int bj = 0; bj < 2; ++bj)
#pragma unroll
            for (int n = 0; n < 2; ++n) { const f32x4 bv = bias ? *(const f32x4*)(bias + col0 + bj * HALF + n * 16) : (f32x4){0.f, 0.f, 0.f, 0.f};
#pragma unroll
                for (int ai = 0; ai < 2; ++ai)
#pragma unroll
                    for (int m = 0; m < 4; ++m) acc[ai][bj][m][n] += bv; }
        f32x4 pre[4][2][2];
#pragma unroll
        for (int m = 0; m < 4; ++m) { const size_t off = (size_t)(u.pm * BM + wr * 64 + m * 16 + fr) * ldc + col0;
#pragma unroll
            for (int bj = 0; bj < 2; ++bj)
#pragma unroll
                for (int n = 0; n < 2; ++n) pre[m][bj][n] = *(const f32x4*)(base + off + bj * HALF + n * 16); }
        const bool bad = st.run(acc, u, wr, wc, fr, fq, lds, wid, lane) || poison != 0u;
        const float qnan = __builtin_nanf("");
#pragma unroll
        for (int ai = 0; ai < 2; ++ai)
#pragma unroll
            for (int m = 0; m < 4; ++m) { const int r = ai * HALF + wr * 64 + m * 16 + fr; const f32x2v sr = S[r]; const size_t off = (size_t)(u.pm * BM + r) * ldc + col0;
#pragma unroll
                for (int bj = 0; bj < 2; ++bj)
#pragma unroll
                    for (int n = 0; n < 2; ++n) { const f32x4 bs = ai == 0 ? pre[m][bj][n] : *(const f32x4*)(base + off + bj * HALF + n * 16); f32x4 o = bs + (acc[ai][bj][m][n] - sr.x) * sr.y;
                        if (bad) o = (f32x4){qnan, qnan, qnan, qnan}; *(f32x4*)(out + off + bj * HALF + n * 16) = o; }
                if (m & 1) asm volatile("" ::: "memory"); }
    }
};
struct EpiLnResLn {
    static constexpr bool PERM = false, AFTER_DRAIN = true;
    const float* base; float* out; bf16_t* xn; int ldc; const float* bias; PanelStats st1, st2; unsigned poison;
    __device__ __forceinline__ void fused(f32x4 (&acc)[2][2][4][2], const Unit& u, int wr, int wc, int fr, int fq, PG8_LAS unsigned char* lds, int wid, int lane) const {
        typedef float f32x2v __attribute__((ext_vector_type(2))); typedef unsigned u32x2v __attribute__((ext_vector_type(2)));
        const PG8_LAS f32x2v* S = (const PG8_LAS f32x2v*)(lds + 8192);
        const int col0 = u.pn * BM + wc * 32 + 4 * fq;
#pragma unroll
        for (int bj = 0; bj < 2; ++bj)
#pragma unroll
            for (int n = 0; n < 2; ++n) { const f32x4 bv = bias ? *(const f32x4*)(bias + col0 + bj * HALF + n * 16) : (f32x4){0.f, 0.f, 0.f, 0.f};
#pragma unroll
                for (int ai = 0; ai < 2; ++ai)
#pragma unroll
                    for (int m = 0; m < 4; ++m) acc[ai][bj][m][n] += bv; }
        bool bad = st1.run(acc, u, wr, wc, fr, fq, lds, wid, lane) || poison != 0u;
        const float qnan = __builtin_nanf("");
#pragma unroll
        for (int ai = 0; ai < 2; ++ai)
#pragma unroll
            for (int m = 0; m < 4; ++m) { const int r = ai * HALF + wr * 64 + m * 16 + fr; const f32x2v sr = S[r]; const size_t off = (size_t)(u.pm * BM + r) * ldc + col0;
#pragma unroll
                for (int bj = 0; bj < 2; ++bj)
#pragma unroll
                    for (int n = 0; n < 2; ++n) { const f32x4 bs = *(const f32x4*)(base + off + bj * HALF + n * 16); acc[ai][bj][m][n] = bs + (acc[ai][bj][m][n] - sr.x) * sr.y; }
                asm volatile("" : "+v"(acc[ai][0][m][0]), "+v"(acc[ai][0][m][1]), "+v"(acc[ai][1][m][0]), "+v"(acc[ai][1][m][1]));
                if (m & 1) asm volatile("" ::: "memory"); }
        const bool bad1 = bad;
        bad = st2.run(acc, u, wr, wc, fr, fq, lds, wid, lane) || bad;
#pragma unroll
        for (int ai = 0; ai < 2; ++ai)
#pragma unroll
            for (int m = 0; m < 4; ++m) { const int r = ai * HALF + wr * 64 + m * 16 + fr; const f32x2v sr = S[r]; const size_t off = (size_t)(u.pm * BM + r) * ldc + col0;
#pragma unroll
                for (int bj = 0; bj < 2; ++bj)
#pragma unroll
                    for (int n = 0; n < 2; ++n) { const f32x4 x1 = acc[ai][bj][m][n]; *(f32x4*)(out + off + bj * HALF + n * 16) = bad1 ? (f32x4){qnan, qnan, qnan, qnan} : x1;
                        const f32x4 o = (x1 - sr.x) * sr.y; u32x2v w; w.x = cvt_pk_bf16(o[0], o[1]); w.y = cvt_pk_bf16(o[2], o[3]);
                        if (bad) { w.x = 0x7fc07fc0u; w.y = 0x7fc07fc0u; } *(u32x2v*)(xn + off + bj * HALF + n * 16) = w; }
                asm volatile("" ::: "memory"); }
    }
};

template <class Epi, class Sched, bool ALIGN_EPI = false, bool SP2 = false>
__device__ __forceinline__ void gemm_phase(PG8_LAS unsigned char* lds, const Gemm g, const Sched& S, const Epi& E) {
    const int tid = threadIdx.x, wid = __builtin_amdgcn_readfirstlane(tid >> 6), lane = tid & 63, wr = wid >> 2, wc = wid & 3, fr = lane & 15, fq = lane >> 4;
    const int K = g.K, nt = K / BK;
    unsigned voffA[2], voffB[2];
#pragma unroll
    for (int i = 0; i < 2; ++i) { int R, C; stage_rc(tid * 16 + i * 8192, R, C); const int Rb = Epi::PERM ? ((R & ~31) + perm32(R & 31)) : R;
        voffA[i] = (unsigned)(R * K + C) * 2u; voffB[i] = (unsigned)(Rb * K + C) * 2u; }
    const size_t kstep = (size_t)(BK * 2);
    const size_t hstep = (size_t)HALF * K * 2;
    const size_t tstep = 2 * hstep;
    const unsigned ldsw = (unsigned)wid * 1024u;
    const int aoff = lds_byte(wr * 64 + fr, fq * 8), boff = lds_byte(wc * 32 + fr, fq * 8);
#define PG8_SA(b, h) (((b) * 2 + (h)) * HTB)
#define PG8_SB(b, h) ((4 + (b) * 2 + (h)) * HTB)
#define PG8_STAGE(bufoff, gbase, voff) do { _Pragma("unroll") for (int _i = 0; _i < 2; ++_i) \
        __builtin_amdgcn_global_load_lds((const unsigned*)((const char*)(gbase) + (voff)[_i]), (PG8_LAS unsigned*)(lds + (bufoff) + ldsw + _i * 8192), 16, 0, 0); } while (0)
#define PG8_LDA(dst, b, h) do { _Pragma("unroll") for (int m = 0; m < 4; ++m) _Pragma("unroll") for (int k = 0; k < 2; ++k) dst[m][k] = *(const PG8_LAS bf16x8*)(lds + PG8_SA(b, h) + aoff + m * 2048 + k * 1024); } while (0)
#define PG8_LDB(dst, b, h) do { _Pragma("unroll") for (int n = 0; n < 2; ++n) _Pragma("unroll") for (int k = 0; k < 2; ++k) dst[n][k] = *(const PG8_LAS bf16x8*)(lds + PG8_SB(b, h) + boff + n * 2048 + k * 1024); } while (0)
#define PG8_MMA(ai, bj, At, Bt) do { __builtin_amdgcn_s_setprio(1); _Pragma("unroll") for (int m = 0; m < 4; ++m) _Pragma("unroll") for (int n = 0; n < 2; ++n) _Pragma("unroll") for (int k = 0; k < 2; ++k) \
        acc[ai][bj][m][n] = __builtin_amdgcn_mfma_f32_16x16x32_bf16(Bt[n][k], At[m][k], acc[ai][bj][m][n], 0, 0, 0); __builtin_amdgcn_s_setprio(0); } while (0)
#define PG8_WAIT_V(n) asm volatile("s_waitcnt vmcnt(" #n ")" ::: "memory")
#define PG8_WAIT_L(n) asm volatile("s_waitcnt lgkmcnt(" #n ")" ::: "memory")
#define PG8_BAR __builtin_amdgcn_s_barrier()
#define PG8_SCHED __builtin_amdgcn_sched_barrier(0)
    Unit cur, nxt; int ui = 0;
    if (!S.next(0, cur)) return;
    f32x4 acc[2][2][4][2];
#pragma unroll
    for (int a = 0; a < 2; ++a)
#pragma unroll
        for (int b = 0; b < 2; ++b)
#pragma unroll
            for (int m = 0; m < 4; ++m)
#pragma unroll
                for (int n = 0; n < 2; ++n) acc[a][b][m][n] = (f32x4){0.f, 0.f, 0.f, 0.f};
    bf16x8 At[4][2], B0[2][2], B1[2][2];
    const char* cA = (const char*)g.A + (size_t)cur.pm * tstep; const char* cB = (const char*)g.Bt + (size_t)cur.pn * tstep;
    S.a_ready(cur);
    if constexpr (SP2) {
        PG8_STAGE(PG8_SB(0, 0), cB, voffB); PG8_STAGE(PG8_SB(0, 1), cB + hstep, voffB); PG8_STAGE(PG8_SA(0, 0), cA, voffA); PG8_STAGE(PG8_SA(0, 1), cA + hstep, voffA);
        if (wr == 1) PG8_BAR;
        PG8_WAIT_V(2); PG8_BAR;
        PG8_STAGE(PG8_SB(1, 0), cB + kstep, voffB); PG8_STAGE(PG8_SA(1, 0), cA + kstep, voffA); PG8_STAGE(PG8_SB(1, 1), cB + hstep + kstep, voffB);
        PG8_WAIT_V(6); PG8_BAR;
    } else {
        PG8_STAGE(PG8_SB(0, 0), cB, voffB); PG8_STAGE(PG8_SA(0, 0), cA, voffA); PG8_STAGE(PG8_SB(0, 1), cB + hstep, voffB); PG8_STAGE(PG8_SA(0, 1), cA + hstep, voffA);
        if (wr == 1) PG8_BAR;
        PG8_WAIT_V(4); PG8_BAR;
        PG8_STAGE(PG8_SB(1, 0), cB + kstep, voffB); PG8_STAGE(PG8_SA(1, 0), cA + kstep, voffA); PG8_STAGE(PG8_SB(1, 1), cB + hstep + kstep, voffB);
        PG8_WAIT_V(6); PG8_BAR;
    }
    for (;;) {
        const bool has_next = S.next(ui + 1, nxt);
        const char* nA = has_next ? (const char*)g.A + (size_t)nxt.pm * tstep : cA; const char* nB = has_next ? (const char*)g.Bt + (size_t)nxt.pn * tstep : cB;
        for (int t = 0; t < nt; t += 2) {
            const bool last = (t == nt - 2);
            const char* a1 = cA + (size_t)(t + 1) * kstep;
            const char* a2 = last ? nA : cA + (size_t)(t + 2) * kstep; const char* b2 = last ? nB : cB + (size_t)(t + 2) * kstep;
            const char* a3 = a2 + kstep; const char* b3 = b2 + kstep;
            if (last && has_next) S.a_ready(nxt);
            if constexpr (SP2) {
            PG8_LDB(B0, 0, 0); PG8_LDB(B1, 0, 1); PG8_SCHED; PG8_LDA(At, 0, 0); PG8_STAGE(PG8_SA(1, 1), a1 + hstep, voffA);
            PG8_WAIT_V(8); PG8_WAIT_L(0); PG8_BAR; PG8_MMA(0, 0, At, B0); PG8_MMA(0, 1, At, B1); PG8_BAR; PG8_SCHED;
            PG8_LDA(At, 0, 1); PG8_STAGE(PG8_SB(0, 0), b2, voffB); PG8_STAGE(PG8_SB(0, 1), b2 + hstep, voffB); PG8_STAGE(PG8_SA(0, 0), a2, voffA);
            PG8_WAIT_V(8); PG8_WAIT_L(0); PG8_BAR; PG8_MMA(1, 0, At, B0); PG8_MMA(1, 1, At, B1); PG8_BAR; PG8_SCHED;
            PG8_LDB(B0, 1, 0); PG8_LDB(B1, 1, 1); PG8_SCHED; PG8_LDA(At, 1, 0); PG8_STAGE(PG8_SA(0, 1), a2 + hstep, voffA);
            PG8_WAIT_V(8); PG8_WAIT_L(0); PG8_BAR; PG8_MMA(0, 0, At, B0); PG8_MMA(0, 1, At, B1); PG8_BAR; PG8_SCHED;
            PG8_LDA(At, 1, 1); PG8_STAGE(PG8_SB(1, 0), b3, voffB); PG8_STAGE(PG8_SB(1, 1), b3 + hstep, voffB); PG8_STAGE(PG8_SA(1, 0), a3, voffA);
            PG8_WAIT_V(8); PG8_WAIT_L(0); PG8_BAR; PG8_MMA(1, 0, At, B0); PG8_MMA(1, 1, At, B1); PG8_BAR; PG8_SCHED;
            } else {
            PG8_LDB(B0, 0, 0); PG8_SCHED; PG8_LDA(At, 0, 0); PG8_STAGE(PG8_SA(1, 1), a1 + hstep, voffA);
            PG8_WAIT_L(8); PG8_BAR; PG8_WAIT_L(0); PG8_MMA(0, 0, At, B0); PG8_BAR; PG8_SCHED;
            PG8_LDB(B1, 0, 1); PG8_STAGE(PG8_SB(0, 0), b2, voffB);
            PG8_BAR; PG8_WAIT_L(0); PG8_MMA(0, 1, At, B1); PG8_BAR;
            PG8_LDA(At, 0, 1); PG8_STAGE(PG8_SA(0, 0), a2, voffA);
            PG8_BAR; PG8_WAIT_L(0); PG8_MMA(1, 0, At, B0); PG8_BAR; PG8_SCHED;
            PG8_STAGE(PG8_SB(0, 1), b2 + hstep, voffB);
            PG8_WAIT_V(6); PG8_BAR; PG8_MMA(1, 1, At, B1); PG8_BAR;
            PG8_LDB(B0, 1, 0); PG8_SCHED; PG8_LDA(At, 1, 0); PG8_STAGE(PG8_SA(0, 1), a2 + hstep, voffA);
            PG8_WAIT_L(8); PG8_BAR; PG8_WAIT_L(0); PG8_MMA(0, 0, At, B0); PG8_BAR; PG8_SCHED;
            PG8_LDB(B1, 1, 1); PG8_STAGE(PG8_SB(1, 0), b3, voffB);
            PG8_BAR; PG8_WAIT_L(0); PG8_MMA(0, 1, At, B1); PG8_BAR;
            PG8_LDA(At, 1, 1); PG8_STAGE(PG8_SA(1, 0), a3, voffA);
            PG8_BAR; PG8_WAIT_L(0); PG8_MMA(1, 0, At, B0); PG8_BAR; PG8_SCHED;
            PG8_STAGE(PG8_SB(1, 1), b3 + hstep, voffB);
            PG8_WAIT_V(6); PG8_BAR; PG8_MMA(1, 1, At, B1); PG8_BAR;
            }
        }
        if constexpr (ALIGN_EPI) { if (wr == 0) PG8_BAR; }
        if constexpr (!Epi::AFTER_DRAIN) { E(acc, cur, wr, wc, fr, fq); S.done(cur); }
        if (!has_next) break;
#pragma unroll
        for (int a = 0; a < 2; ++a)
#pragma unroll
            for (int b = 0; b < 2; ++b)
#pragma unroll
                for (int m = 0; m < 4; ++m)
#pragma unroll
                    for (int n = 0; n < 2; ++n) acc[a][b][m][n] = (f32x4){0.f, 0.f, 0.f, 0.f};
        cur = nxt; cA = nA; cB = nB; ++ui;
        if constexpr (ALIGN_EPI) { if (wr == 1) PG8_BAR; }
    }
    PG8_WAIT_V(0);
    if constexpr (!ALIGN_EPI) { if (wr == 0) PG8_BAR; }
    PG8_BAR;
    if constexpr (Epi::AFTER_DRAIN) { E.fused(acc, cur, wr, wc, fr, fq, lds, wid, lane); S.done(cur); }
#undef PG8_SA
#undef PG8_SB
#undef PG8_STAGE
#undef PG8_LDA
#undef PG8_LDB
#undef PG8_MMA
#undef PG8_WAIT_V
#undef PG8_WAIT_L
#undef PG8_BAR
#undef PG8_SCHED
}
}
namespace pg8 {
__device__ __forceinline__ float bf2f(unsigned short b) { return __uint_as_float(((unsigned)b) << 16); }
__device__ __forceinline__ float bflo(unsigned w) { return __uint_as_float(w << 16); }
__device__ __forceinline__ float bfhi(unsigned w) { return __uint_as_float(w & 0xffff0000u); }
__device__ __forceinline__ float sigm(float x) { return 1.f / (1.f + __expf(-x)); }
template <int MODE> struct EpiGate {
    static constexpr bool PERM = true, AFTER_DRAIN = false;
    bf16_t* O; int ldc; const bf16_t* G; int ldg; size_t gtile;
    __device__ __forceinline__ void operator()(const f32x4 (&acc)[2][2][4][2], const Unit& u, int wr, int wc, int fr, int fq) const {
        const int row0 = u.pm * BM + wr * 64 + fr, col0 = u.pn * BM + wc * 32 + 8 * fq;
#pragma unroll
        for (int ai = 0; ai < 2; ++ai)
#pragma unroll
            for (int m = 0; m < 4; ++m) { const size_t row = (size_t)(row0 + ai * HALF + m * 16);
#pragma unroll
                for (int bj = 0; bj < 2; ++bj) {
                    const u32x4 gw = __builtin_nontemporal_load((const u32x4*)(G + (size_t)u.pn * gtile + row * ldg + col0 + bj * HALF));
                    f32x4 v0 = acc[ai][bj][m][0], v1 = acc[ai][bj][m][1];
                    v0[0] *= sigm(bflo(gw.x)); v0[1] *= sigm(bfhi(gw.x)); v0[2] *= sigm(bflo(gw.y)); v0[3] *= sigm(bfhi(gw.y));
                    v1[0] *= sigm(bflo(gw.z)); v1[1] *= sigm(bfhi(gw.z)); v1[2] *= sigm(bflo(gw.w)); v1[3] *= sigm(bfhi(gw.w));
                    bf16_t* op = O + row * ldc + col0 + bj * HALF;
                    if (MODE == 1) { const u32x4 ow = *(const u32x4*)op;
                        v0[0] += bflo(ow.x); v0[1] += bfhi(ow.x); v0[2] += bflo(ow.y); v0[3] += bfhi(ow.y);
                        v1[0] += bflo(ow.z); v1[1] += bfhi(ow.z); v1[2] += bflo(ow.w); v1[3] += bfhi(ow.w); }
                    u32x4 w; w.x = cvt_pk_bf16(v0[0], v0[1]); w.y = cvt_pk_bf16(v0[2], v0[3]); w.z = cvt_pk_bf16(v1[0], v1[1]); w.w = cvt_pk_bf16(v1[2], v1[3]);
                    *(u32x4*)op = w; } }
    }
};
struct BranchOrder {
    StaticOrder base; int dm, dn;
    __host__ __device__ void init(int M, int N, int G_, int c_) { base.init(M, N, G_, c_); dm = M / BM; dn = N / BM; }
    __host__ __device__ bool next(int i, Unit& u) const { if (!base.next(i >> 1, u)) return false; if (i & 1) { u.pm += dm; u.pn += dn; } return true; }
    __device__ __forceinline__ void a_ready(const Unit&) const {}
    __device__ __forceinline__ void done(const Unit&) const {}
};
struct EpiGate2 {
    static constexpr bool PERM = true, AFTER_DRAIN = false;
    bf16_t* O; int ldc; const bf16_t* G0; const bf16_t* G1; int ldg; size_t gtile; int dm, dn;
    __device__ __forceinline__ void operator()(const f32x4 (&acc)[2][2][4][2], const Unit& u, int wr, int wc, int fr, int fq) const {
        const bool second = u.pm >= dm;
        Unit v = u; if (second) { v.pm -= dm; v.pn -= dn; }
        if (second) { EpiGate<1> e{O, ldc, G1, ldg, gtile}; e(acc, v, wr, wc, fr, fq); } else { EpiGate<0> e{O, ldc, G0, ldg, gtile}; e(acc, v, wr, wc, fr, fq); }
    }
};
struct EpiResid {
    static constexpr bool PERM = true, AFTER_DRAIN = false;
    const float* R; bf16_t* Hb; float* ss; int ldc;
    __device__ __forceinline__ void operator()(const f32x4 (&acc)[2][2][4][2], const Unit& u, int wr, int wc, int fr, int fq) const {
        const int row0 = u.pm * BM + wr * 64 + fr, col0 = u.pn * BM + wc * 32 + 8 * fq;
#pragma unroll
        for (int ai = 0; ai < 2; ++ai)
#pragma unroll
            for (int m = 0; m < 4; ++m) { const size_t row = (size_t)(row0 + ai * HALF + m * 16); float sq = 0.f;
#pragma unroll
                for (int bj = 0; bj < 2; ++bj) {
                    const size_t off = row * ldc + col0 + bj * HALF;
                    const f32x4 r0 = __builtin_nontemporal_load((const f32x4*)(R + off)), r1 = __builtin_nontemporal_load((const f32x4*)(R + off + 4));
                    const f32x4 v0 = acc[ai][bj][m][0] + r0, v1 = acc[ai][bj][m][1] + r1;
                    u32x4 w; w.x = cvt_pk_bf16(v0[0], v0[1]); w.y = cvt_pk_bf16(v0[2], v0[3]); w.z = cvt_pk_bf16(v1[0], v1[1]); w.w = cvt_pk_bf16(v1[2], v1[3]);
                    *(u32x4*)(Hb + off) = w;
                    sq += (v0[0] * v0[0] + v0[1] * v0[1]) + (v0[2] * v0[2] + v0[3] * v0[3]) + (v1[0] * v1[0] + v1[1] * v1[1]) + (v1[2] * v1[2] + v1[3] * v1[3]); }
                sq += __shfl_xor(sq, 16); sq += __shfl_xor(sq, 32);
                if (fq == 0) atomicAdd(ss + row, sq); }
    }
};
struct EpiRowScale {
    static constexpr bool PERM = true, AFTER_DRAIN = false;
    bf16_t* O; int ldc; const float* ss; float inv_n, eps;
    __device__ __forceinline__ void operator()(const f32x4 (&acc)[2][2][4][2], const Unit& u, int wr, int wc, int fr, int fq) const {
        const int row0 = u.pm * BM + wr * 64 + fr, col0 = u.pn * BM + wc * 32 + 8 * fq;
#pragma unroll
        for (int ai = 0; ai < 2; ++ai)
#pragma unroll
            for (int m = 0; m < 4; ++m) { const size_t row = (size_t)(row0 + ai * HALF + m * 16);
                const float sc = rsqrtf(__hip_atomic_load(ss + row, __ATOMIC_RELAXED, __HIP_MEMORY_SCOPE_AGENT) * inv_n + eps);
#pragma unroll
                for (int bj = 0; bj < 2; ++bj) { const f32x4 v0 = acc[ai][bj][m][0] * sc, v1 = acc[ai][bj][m][1] * sc;
                    u32x4 w; w.x = cvt_pk_bf16(v0[0], v0[1]); w.y = cvt_pk_bf16(v0[2], v0[3]); w.z = cvt_pk_bf16(v1[0], v1[1]); w.w = cvt_pk_bf16(v1[2], v1[3]);
                    *(u32x4*)(O + row * ldc + col0 + bj * HALF) = w; } }
    }
};
}
constexpr int D_MODEL = 2048, BATCH = 2, SEQ = 4096, NTOK = BATCH * SEQ;
constexpr int HD = 64, NCMP = 255, CMP_STRIDE = 16, CMP_LEN = 32, CMP_HID = 128;
constexpr int SEL_LEN = 64, SEL_TOPK = 16, WINDOW = 512;
constexpr int PEER_KEYS = 128, PEER_E = 128;
constexpr int NSA_Q = 1024, SB_W = 1024;
constexpr int IN_COLS = 9776, PLD = 9984;
constexpr int C_SHIFT_FROM = 2608, C_SHIFT = 208, PP = 256;
constexpr int P_QN = 0, P_KC = 4, P_VC = 5, P_KS = 6, P_VS = 7, P_KW = 8, P_VW = 9, P_GBR = 10, P_QB = 11, P_KB = 15, P_VB = 19, P_GA = 23, P_GB = 31;
#define PNL(P, p) ((P) + (size_t)(p) * NTOK * PP)
constexpr float EPS = 1e-6f, NEGF = -1e30f;
constexpr int NWAVES = 8, NTHR = 512;

constexpr size_t MiB = 1u << 20;
constexpr size_t WS_CTL = 0, CTL_ZERO_BYTES = 1 * MiB;
constexpr size_t WS_WIN = 2 * MiB;
constexpr size_t WS_WBN = 42 * MiB, WS_WBS = 46 * MiB;
constexpr size_t WS_WOUT = 50 * MiB, WS_WPQ = 58 * MiB;
constexpr size_t WS_MISC = 66 * MiB;
constexpr size_t WS_XN = 70 * MiB;
constexpr size_t WS_PROJ = 102 * MiB;
constexpr size_t WS_ONSA = 258 * MiB, WS_OSB = 274 * MiB;
constexpr size_t WS_H = 290 * MiB;
constexpr size_t WS_HB = 354 * MiB;
constexpr size_t WS_END = 386 * MiB;
constexpr size_t WS_UB = 102 * MiB, WS_VB = 166 * MiB, WS_QP = 230 * MiB, WS_EXP = 262 * MiB, WS_GATE = 266 * MiB;
constexpr size_t MISC_KCB = 0, MISC_VCB = 1 * MiB, MISC_SKB = 2 * MiB, MISC_W1T = 2 * MiB + 512 * 1024, MISC_B1 = 3 * MiB + 512 * 1024;
constexpr int CW_BAR = 4096;
constexpr int CW_SS = 32768;

#define GAS __attribute__((address_space(1)))
#define LAS __attribute__((address_space(3)))
typedef unsigned short bf16;
typedef unsigned v4u __attribute__((ext_vector_type(4)));
typedef unsigned v2u __attribute__((ext_vector_type(2)));
typedef float f32x4 __attribute__((ext_vector_type(4)));
#define RLX_AGENT __ATOMIC_RELAXED, __HIP_MEMORY_SCOPE_AGENT
__device__ __forceinline__ unsigned f2bf(float f) { unsigned u = __builtin_bit_cast(unsigned, f); return (u + 0x7fffu + ((u >> 16) & 1u)) >> 16; }
__device__ __forceinline__ unsigned pk2(float lo, float hi) { return f2bf(lo) | (f2bf(hi) << 16); }
__device__ __forceinline__ float bf2f(bf16 b) { return __uint_as_float(((unsigned)b) << 16); }
__device__ __forceinline__ float bflo(unsigned w) { return __uint_as_float(w << 16); }
__device__ __forceinline__ float bfhi(unsigned w) { return __uint_as_float(w & 0xffff0000u); }

#define XB_TMO      128
#define XB_XCNT(j)  (256  + 64 * (j))
#define XB_XSUB(j)  (1280 + 64 * (j))
#define XB_XGEN(j)  (2304 + 64 * (j))
#define XB_TOP      3328
#define XB_TOPGEN   3392
#define XCD_BAR_WORDS 3456
#define XB_SPIN_CAP (1u << 24)
__device__ __forceinline__ unsigned xb_ld(unsigned* p)              { return __hip_atomic_load(p, __ATOMIC_RELAXED, __HIP_MEMORY_SCOPE_AGENT); }
__device__ __forceinline__ unsigned xb_add(unsigned* p, unsigned v) { return __hip_atomic_fetch_add(p, v, __ATOMIC_RELAXED, __HIP_MEMORY_SCOPE_AGENT); }
__device__ __forceinline__ unsigned xb_xcc_id() { return (unsigned)__builtin_amdgcn_s_getreg((3 << 11) | 20) & 0xFu; }
#define XB_SPIN(cond, bar) do { unsigned _sp = 0; while (cond) { __builtin_amdgcn_s_sleep(1); \
    if ((++_sp & 255u) == 0u) { if (xb_ld(&(bar)[XB_TMO])) break; if (_sp > XB_SPIN_CAP) { atomicAdd(&(bar)[XB_TMO], 1u); break; } } } } while (0)
struct XcdBarrier { unsigned* bar; unsigned x; volatile LAS unsigned* st; };
__device__ __forceinline__ XcdBarrier xcd_barrier_post(unsigned* bar, volatile LAS unsigned* st) {
    XcdBarrier b; b.bar = bar; b.x = xb_xcc_id(); b.st = st;
    if (threadIdx.x == 0) (void)xb_add(&bar[XB_XCNT(b.x)], 1u);
    return b;
}
__device__ __forceinline__ void xcd_barrier_complete(unsigned* bar, unsigned x, unsigned& nloc, unsigned& nx) {
    const unsigned G = gridDim.x * gridDim.y * gridDim.z;
    unsigned sum, cnt, mine, sp = 0u;
    for (;;) {
        sum = 0u; cnt = 0u; mine = 0u;
#pragma unroll
        for (unsigned j = 0; j < 16; ++j) { const unsigned c = xb_ld(&bar[XB_XCNT(j)]); sum += c; cnt += (c > 0u) ? 1u : 0u; mine = (j == x) ? c : mine; }
        if (sum == G) break;
        __builtin_amdgcn_s_sleep(1);
        if ((++sp & 255u) == 0u) { if (xb_ld(&bar[XB_TMO])) break; if (sp > XB_SPIN_CAP) { atomicAdd(&bar[XB_TMO], 1u); break; } }
    }
    nloc = mine > 0u ? mine : 1u; nx = cnt > 0u ? cnt : 1u;
}
__device__ __forceinline__ void xcd_barrier(const XcdBarrier& b) {
    asm volatile("s_waitcnt vmcnt(0)" ::: "memory");
    __syncthreads();
    if (threadIdx.x == 0) {
        unsigned* bar = b.bar;
        const unsigned bx = xb_xcc_id();
        __builtin_amdgcn_s_waitcnt(0);
        unsigned nloc = b.st[0], nx = b.st[1];
        if (nloc == 0u) { xcd_barrier_complete(bar, bx, nloc, nx); b.st[0] = nloc; b.st[1] = nx; }
        const unsigned old = xb_add(&bar[XB_XSUB(bx)], 1u);
        const unsigned gen = old / nloc;
        if (old + 1u == (gen + 1u) * nloc) {
            __builtin_amdgcn_fence(__ATOMIC_RELEASE, "agent");
            asm volatile("s_waitcnt vmcnt(0)" ::: "memory");
            const unsigned og = xb_add(&bar[XB_TOP], 1u);
            const unsigned tg = og / nx;
            if (og + 1u == (tg + 1u) * nx) xb_add(&bar[XB_TOPGEN], 1u);
            else XB_SPIN(xb_ld(&bar[XB_TOPGEN]) == tg, bar);
            __builtin_amdgcn_fence(__ATOMIC_ACQUIRE, "agent");
            xb_add(&bar[XB_XGEN(bx)], 1u);
            asm volatile("s_waitcnt vmcnt(0)" ::: "memory");
        } else {
            XB_SPIN(xb_ld(&bar[XB_XGEN(bx)]) == gen, bar);
            __builtin_amdgcn_fence(__ATOMIC_ACQUIRE, "agent");
            asm volatile("s_waitcnt vmcnt(0)" ::: "memory");
        }
    }
    __syncthreads();
}

__device__ __forceinline__ int rel_bucket(int d) {
    if (d < 16) return d < 0 ? 0 : d;
    int b = 16;
    b += (d >= 21); b += (d >= 27); b += (d >= 35); b += (d >= 46); b += (d >= 59); b += (d >= 77); b += (d >= 99); b += (d >= 128);
    b += (d >= 166); b += (d >= 216); b += (d >= 280); b += (d >= 363); b += (d >= 470); b += (d >= 609); b += (d >= 790);
    return b;
}
__device__ __forceinline__ float gelu_tanh(float x) { const float k = 0.7978845608028654f; return 0.5f * x * (1.f + tanhf(k * (x + 0.044715f * x * x * x))); }
__device__ __forceinline__ float sigmoidf_(float x) { return 1.f / (1.f + expf(-x)); }
#define DPP_ROR(v, n) __builtin_bit_cast(float, __builtin_amdgcn_update_dpp(0, __builtin_bit_cast(int, (v)), 0x120 + (n), 0xf, 0xf, false))
__device__ __forceinline__ float row_sum16(float v) { v += DPP_ROR(v, 8); v += DPP_ROR(v, 4); v += DPP_ROR(v, 2); v += DPP_ROR(v, 1); return v; }
__device__ __forceinline__ float row_max16(float v) { v = fmaxf(v, DPP_ROR(v, 8)); v = fmaxf(v, DPP_ROR(v, 4)); v = fmaxf(v, DPP_ROR(v, 2)); v = fmaxf(v, DPP_ROR(v, 1)); return v; }
__device__ __forceinline__ float wave_sum(float v) {
    v = row_sum16(v);
    { const auto r = __builtin_amdgcn_permlane16_swap(__float_as_uint(v), __float_as_uint(v), false, false); v = __uint_as_float(r[0]) + __uint_as_float(r[1]); }
    { const auto r = __builtin_amdgcn_permlane32_swap(__float_as_uint(v), __float_as_uint(v), false, false); v = __uint_as_float(r[0]) + __uint_as_float(r[1]); }
    return v;
}
__device__ __forceinline__ float wave_max(float v) {
    v = row_max16(v);
    { const auto r = __builtin_amdgcn_permlane16_swap(__float_as_uint(v), __float_as_uint(v), false, false); v = fmaxf(__uint_as_float(r[0]), __uint_as_float(r[1])); }
    { const auto r = __builtin_amdgcn_permlane32_swap(__float_as_uint(v), __float_as_uint(v), false, false); v = fmaxf(__uint_as_float(r[0]), __uint_as_float(r[1])); }
    return v;
}
__device__ __forceinline__ float gelu_tanh_fast(float x) { const float y2 = x * (1.5957691216057308f + 0.0713548162726f * x * x);
    return x * __builtin_amdgcn_rcpf(1.f + __builtin_amdgcn_exp2f(-1.4426950408889634f * y2)); }
__device__ __forceinline__ float half_sum(float v, float* red) {
    v = wave_sum(v);
    __syncthreads();
    if ((threadIdx.x & 63) == 0) red[(threadIdx.x >> 6) & 3] = v;
    __syncthreads();
    return red[0] + red[1] + red[2] + red[3];
}
__device__ __forceinline__ float half_max(float v, float* red) {
    v = wave_max(v);
    __syncthreads();
    if ((threadIdx.x & 63) == 0) red[(threadIdx.x >> 6) & 3] = v;
    __syncthreads();
    return fmaxf(fmaxf(red[0], red[1]), fmaxf(red[2], red[3]));
}

struct Args {
    const float* in[19]; float* out; unsigned char* ws; int ph_lo, ph_hi; int variant, pad;
};

struct P0Item { const float* W; bf16* WT; const float* gk; int K, N, item, shift_from, shift; };
__device__ __forceinline__ void p0_item_load(const P0Item& d, int lane, f32x4 (&v)[8]) {
    const int nblk = (d.N + 31) / 32, kb = d.item / nblk, nb = d.item % nblk, k0 = 64 * kb, n0 = 32 * nb;
    const int c4 = (lane & 7) * 4, r8 = lane >> 3;
    const bool cok = (n0 + c4) < d.N;
#pragma unroll
    for (int i = 0; i < 8; ++i) { const int kk = 8 * i + r8; v[i] = cok ? __builtin_nontemporal_load((const f32x4*)(d.W + (size_t)(k0 + kk) * d.N + n0 + c4)) : (f32x4){0.f, 0.f, 0.f, 0.f}; }
}
__device__ __forceinline__ void p0_item_store(const P0Item& d, int lane, const f32x4 (&v)[8], LAS float* scr) {
    const int nblk = (d.N + 31) / 32, kb = d.item / nblk, nb = d.item % nblk, k0 = 64 * kb, n0 = 32 * nb;
    const int c4 = (lane & 7) * 4, r8 = lane >> 3;
#pragma unroll
    for (int i = 0; i < 8; ++i) { const int kk = 8 * i + r8; const float g = d.gk ? d.gk[k0 + kk] : 1.f;
        scr[kk * 33 + c4 + 0] = v[i].x * g; scr[kk * 33 + c4 + 1] = v[i].y * g; scr[kk * 33 + c4 + 2] = v[i].z * g; scr[kk * 33 + c4 + 3] = v[i].w * g; }
    asm volatile("s_waitcnt lgkmcnt(0)" ::: "memory");
    const int c = lane & 7;
#pragma unroll
    for (int j = 0; j < 4; ++j) { const int n = (lane >> 3) + 8 * j; const LAS float* s = scr + (8 * c) * 33 + n;
        v4u o; o.x = pk2(s[0 * 33], s[1 * 33]); o.y = pk2(s[2 * 33], s[3 * 33]); o.z = pk2(s[4 * 33], s[5 * 33]); o.w = pk2(s[6 * 33], s[7 * 33]);
        const int nd = n0 + n + ((n0 + n >= d.shift_from) ? d.shift : 0);
        if (n0 + n < d.N) *(v4u*)(d.WT + (size_t)nd * d.K + k0 + 8 * c) = o; }
    asm volatile("s_waitcnt lgkmcnt(0)" ::: "memory");
}
__device__ __forceinline__ void rms_row_load(const float* xrow, int lane, f32x4 (&v)[8]) {
    const f32x4* xr = (const f32x4*)xrow + lane;
#pragma unroll
    for (int j = 0; j < 8; ++j) v[j] = __builtin_nontemporal_load(xr + 64 * j);
}
__device__ __forceinline__ void rms_row_finish(const f32x4 (&v)[8], const float* g, bf16* orow, int lane) {
    const f32x4* gr = (const f32x4*)g + lane;
    float s = 0.f;
#pragma unroll
    for (int j = 0; j < 8; ++j) s += (v[j].x * v[j].x + v[j].y * v[j].y) + (v[j].z * v[j].z + v[j].w * v[j].w);
    const float r = rsqrtf(wave_sum(s) * (1.f / D_MODEL) + EPS);
    v2u* o8 = (v2u*)orow + lane;
#pragma unroll
    for (int j = 0; j < 8; ++j) { const f32x4 gv = gr[64 * j]; v2u w; w.x = pk2(v[j].x * r * gv.x, v[j].y * r * gv.y); w.y = pk2(v[j].z * r * gv.z, v[j].w * r * gv.w); o8[64 * j] = w; }
}
__device__ __forceinline__ void rms_row_to_bf16(const float* xrow, const float* g, bf16* orow, int lane) {
    f32x4 v[8]; rms_row_load(xrow, lane, v); rms_row_finish(v, g, orow, lane);
}
__device__ __forceinline__ void cvt_flat(const float* src, bf16* dst, size_t n, size_t gthread, size_t nthreads) {
    for (size_t i = gthread * 8; i < n; i += nthreads * 8) {
        const f32x4 a = *(const f32x4*)(src + i), b = *(const f32x4*)(src + i + 4);
        v4u o; o.x = pk2(a.x, a.y); o.y = pk2(a.z, a.w); o.z = pk2(b.x, b.y); o.w = pk2(b.z, b.w);
        *(v4u*)(dst + i) = o;
    }
}
namespace cmpr {
typedef short bf16x8 __attribute__((ext_vector_type(8)));
typedef float f32x4v __attribute__((ext_vector_type(4)));
__device__ __forceinline__ void compress_phase(const bf16* PROJ, const bf16* W1T, const float* BIAS1, const float* const* in, bf16* KCB, bf16* VCB,
                                               __attribute__((address_space(3))) unsigned char* lds3, int bid, int G) {
    int tid = threadIdx.x; asm volatile("" : "+v"(tid));
    const int lane = tid & 63, wid = __builtin_amdgcn_readfirstlane(tid >> 6), r16 = lane & 15, kq = lane >> 4;
    __attribute__((address_space(3))) float* PART = (__attribute__((address_space(3))) float*)lds3;
    __attribute__((address_space(3))) float* HID = (__attribute__((address_space(3))) float*)(lds3 + 65536);
    __attribute__((address_space(3))) float* W2S = (__attribute__((address_space(3))) float*)(lds3 + 73728);
    for (int unit = bid; unit < 256; unit += G) {
        const int c = unit & 15, g = (unit >> 4) & 3, b = (unit >> 6) & 1, kv = unit >> 7, n0 = 16 * c;
        int nn = n0 + r16; if (nn > NCMP - 1) nn = NCMP - 1;
        const bf16* ap = PNL(PROJ, kv ? P_VC : P_KC) + (size_t)(b * SEQ + 16 * nn + 4 * wid) * PP + g * HD + 8 * kq;
        const bf16* bp = W1T + (size_t)kv * CMP_HID * 2048 + (size_t)r16 * 2048 + 256 * wid + 8 * kq;
        { const float* w2g = in[kv ? 8 : 5];
#pragma unroll
          for (int i = 0; i < 4; ++i) *(__attribute__((address_space(3))) f32x4v*)(W2S + (tid + NTHR * i) * 4) = *(const f32x4v*)(w2g + (tid + NTHR * i) * 4); }
        f32x4v acc[8] = {};
        bf16x8 af[8];
#pragma unroll
        for (int ks = 0; ks < 8; ++ks) af[ks] = *(const bf16x8*)(ap + (size_t)(ks >> 1) * PP + (ks & 1) * 32);
        bf16x8 wa[8], wb[8];
#define CMP_LOADW(W, KS) do { _Pragma("unroll") for (int nt = 0; nt < 8; ++nt) W[nt] = *(const bf16x8*)(bp + (size_t)nt * 16 * 2048 + (KS) * 32); } while (0)
#define CMP_MMA(W, KS) do { _Pragma("unroll") for (int nt = 0; nt < 8; ++nt) acc[nt] = __builtin_amdgcn_mfma_f32_16x16x32_bf16(af[KS], W[nt], acc[nt], 0, 0, 0); } while (0)
        CMP_LOADW(wa, 0);
#pragma unroll
        for (int ks = 0; ks < 8; ks += 2) {
            CMP_LOADW(wb, ks + 1); __builtin_amdgcn_sched_barrier(0);
            CMP_MMA(wa, ks); __builtin_amdgcn_sched_barrier(0);
            if (ks + 2 < 8) CMP_LOADW(wa, ks + 2);
            __builtin_amdgcn_sched_barrier(0);
            CMP_MMA(wb, ks + 1); __builtin_amdgcn_sched_barrier(0);
        }
#undef CMP_LOADW
#undef CMP_MMA
#pragma unroll
        for (int nt = 0; nt < 8; ++nt)
#pragma unroll
            for (int r = 0; r < 4; ++r) PART[wid * 2048 + (kq * 4 + r) * 128 + nt * 16 + r16] = acc[nt][r];
        asm volatile("s_waitcnt lgkmcnt(0)" ::: "memory"); __syncthreads();
#pragma unroll
        for (int i = 0; i < 4; ++i) { const int e = tid + NTHR * i; float s = BIAS1[kv * CMP_HID + (e & 127)];
#pragma unroll
            for (int w = 0; w < 8; ++w) s += PART[w * 2048 + e];
            HID[e] = gelu_tanh(s); }
        asm volatile("s_waitcnt lgkmcnt(0)" ::: "memory"); __syncthreads();
        {
            const int nl = tid >> 5, d = (tid & 31) * 2;
            float o0 = 0.f, o1 = 0.f;
#pragma unroll 8
            for (int j = 0; j < CMP_HID; ++j) { const float hv = HID[nl * 128 + j]; const float wx = W2S[j * HD + d], wy = W2S[j * HD + d + 1]; o0 += hv * wx; o1 += hv * wy; }
            const int n = n0 + nl;
            const unsigned pk = (n < NCMP) ? pk2(o0, o1) : 0u;
            *(unsigned*)((kv ? VCB : KCB) + (size_t)((b * 4 + g) * 256 + n) * HD + d) = pk;
        }
        __syncthreads();
    }
}
}
#ifndef NSA_FAR
#define NSA_FAR 1
#endif
namespace nsa {
typedef short bf16x8 __attribute__((ext_vector_type(8)));
typedef short s16x4 __attribute__((ext_vector_type(4)));
typedef float f32x16 __attribute__((ext_vector_type(16)));
typedef unsigned u32x4 __attribute__((ext_vector_type(4)));
typedef __attribute__((address_space(3))) const char* lds_cptr;
typedef __attribute__((address_space(3))) unsigned char* lds_ptr;
constexpr int SLOTB = 16384;
constexpr int NSLOT = 4;
constexpr int L_RING = 0, L_OV = 65536, L_BT = 98304, L_WSF = 111104, L_MASK = 113152, L_MISC = 113664, L_X = 113792, L_END = L_X + 32768;
constexpr int BT_N = 800;
constexpr int BT_LO = 96, BT_HI = 96, BT_P = BT_LO + BT_N + BT_HI, BT_NEG = 96, L_BTP = L_END;
static_assert(L_BTP + (4 * BT_P + BT_NEG) * 4 <= 162816, "LDS overflow");
constexpr float LOG2E = 1.4426950408889634f, SC2 = 0.125f * LOG2E, NEG2 = -1e30f;
static_assert(L_END <= 162816, "nsa LDS map");
__device__ __forceinline__ int crow(int r, int hi) { return (r & 3) + 8 * (r >> 2) + 4 * hi; }
__device__ __forceinline__ void glds16(const void* gsrc, unsigned lds_dst) { unsigned keep;
    asm volatile("s_mov_b32 %0, m0\n\ts_mov_b32 m0, %2\n\ts_nop 0\n\tglobal_load_lds_dwordx4 %1, off\n\ts_mov_b32 m0, %0" : "=&s"(keep) : "v"(gsrc), "s"(lds_dst) : "memory"); }
typedef float f32x2_t __attribute__((ext_vector_type(2))); typedef __bf16 bf16x2_t __attribute__((ext_vector_type(2)));
__device__ __forceinline__ unsigned cvtpk_s(float lo, float hi) { f32x2_t v = {lo, hi}; bf16x2_t b = __builtin_convertvector(v, bf16x2_t); return __builtin_bit_cast(unsigned, b); }
#define NSA_WAIT_BAR(N) asm volatile("s_waitcnt vmcnt(" #N ") lgkmcnt(0)\n\ts_barrier" ::: "memory")
#define NSA_SBAR() __builtin_amdgcn_sched_barrier(0)
#ifndef NSA_DEFER
#define NSA_DEFER 8.f
#endif

__device__ __forceinline__ void qkt(f32x16& p0, f32x16& p1, lds_cptr Kslot, const bf16x8* qr, int r32, int hi) {
    lds_cptr kb = Kslot + hi * 1024 + r32 * 16;
    const f32x16 z = {};
#pragma unroll
    for (int d0 = 0; d0 < 4; ++d0) {
        const bf16x8 b0 = *(const __attribute__((address_space(3))) bf16x8*)(kb + d0 * 2048);
        const bf16x8 b1 = *(const __attribute__((address_space(3))) bf16x8*)(kb + d0 * 2048 + 512);
        if (d0 == 0) { p0 = __builtin_amdgcn_mfma_f32_32x32x16_bf16(b0, qr[0], z, 0, 0, 0); p1 = __builtin_amdgcn_mfma_f32_32x32x16_bf16(b1, qr[0], z, 0, 0, 0); }
        else { p0 = __builtin_amdgcn_mfma_f32_32x32x16_bf16(b0, qr[d0], p0, 0, 0, 0); p1 = __builtin_amdgcn_mfma_f32_32x32x16_bf16(b1, qr[d0], p1, 0, 0, 0); }
    }
}
__device__ __forceinline__ void pv(f32x16* o, int vb, bf16x8 pa0, bf16x8 pa1, bf16x8 pa2, bf16x8 pa3) {
#pragma unroll
    for (int d0 = 0; d0 < 2; ++d0) { s16x4 lo[4], hi[4];
#pragma unroll
        for (int ks = 0; ks < 4; ++ks) {
            asm volatile("ds_read_b64_tr_b16 %0,%1 offset:%c2" : "=&v"(lo[ks]) : "v"(vb), "i"(d0 * 4096 + ks * 1024) : "memory");
            asm volatile("ds_read_b64_tr_b16 %0,%1 offset:%c2" : "=&v"(hi[ks]) : "v"(vb), "i"(d0 * 4096 + ks * 1024 + 512) : "memory"); }
        asm volatile("s_waitcnt lgkmcnt(0)" ::: "memory"); NSA_SBAR();
#define NSA_PK(k) (bf16x8){lo[k][0], lo[k][1], lo[k][2], lo[k][3], hi[k][0], hi[k][1], hi[k][2], hi[k][3]}
        o[d0] = __builtin_amdgcn_mfma_f32_32x32x16_bf16(pa0, NSA_PK(0), o[d0], 0, 0, 0);
        o[d0] = __builtin_amdgcn_mfma_f32_32x32x16_bf16(pa1, NSA_PK(1), o[d0], 0, 0, 0);
        o[d0] = __builtin_amdgcn_mfma_f32_32x32x16_bf16(pa2, NSA_PK(2), o[d0], 0, 0, 0);
        o[d0] = __builtin_amdgcn_mfma_f32_32x32x16_bf16(pa3, NSA_PK(3), o[d0], 0, 0, 0);
#undef NSA_PK
    }
}
__device__ __forceinline__ float rowmax32(const f32x16& p0, const f32x16& p1) {
    float a = fmaxf(p0[0], p1[0]), b = fmaxf(p0[1], p1[1]);
#pragma unroll
    for (int r = 2; r < 16; r += 2) { a = fmaxf(fmaxf(a, p0[r]), p1[r]); b = fmaxf(fmaxf(b, p0[r + 1]), p1[r + 1]); }
    a = fmaxf(a, b);
    auto rr = __builtin_amdgcn_permlane32_swap(__float_as_uint(a), __float_as_uint(a), false, false);
    return fmaxf(__uint_as_float(rr[0]), __uint_as_float(rr[1]));
}
__device__ __forceinline__ float sum16(const f32x16& p) {
    float a, b;
    asm volatile("s_nop 0\n\tv_add_f32 %0, %2, %3\n\tv_add_f32 %1, %4, %5\n\tv_add_f32 %0, %0, %6\n\tv_add_f32 %1, %1, %7\n\tv_add_f32 %0, %0, %8\n\tv_add_f32 %1, %1, %9\n\t"
                 "v_add_f32 %0, %0, %10\n\tv_add_f32 %1, %1, %11\n\tv_add_f32 %0, %0, %12\n\tv_add_f32 %1, %1, %13\n\tv_add_f32 %0, %0, %14\n\tv_add_f32 %1, %1, %15\n\t"
                 "v_add_f32 %0, %0, %16\n\tv_add_f32 %1, %1, %17\n\tv_add_f32 %0, %0, %1"
                 : "=&v"(a), "=&v"(b)
                 : "v"(p[0]), "v"(p[1]), "v"(p[2]), "v"(p[3]), "v"(p[4]), "v"(p[5]), "v"(p[6]), "v"(p[7]), "v"(p[8]), "v"(p[9]), "v"(p[10]), "v"(p[11]), "v"(p[12]), "v"(p[13]), "v"(p[14]), "v"(p[15]));
    return a;
}
__device__ __forceinline__ float swap_add(float v) {
    auto rr = __builtin_amdgcn_permlane32_swap(__float_as_uint(v), __float_as_uint(v), false, false);
    return __uint_as_float(rr[0]) + __uint_as_float(rr[1]);
}

struct PassCtx {
    lds_ptr lds3; unsigned lds0;
    int lane, r32, hi, wid;
    int tq;
    const __attribute__((address_space(3))) float* bt;
    __attribute__((address_space(3))) float* wsf;
    int vboff;
};

template <int MODE>
__device__ __forceinline__ void run_pass(const PassCtx& c, int NT, int first, const bf16* Kb, const bf16* Vb, int pitch, const bf16x8* qr,
                                         unsigned mask_lo, unsigned mask_hi, f32x16 (&o)[2], f32x16 (&im)[2], float& m, float& l) {
    const __attribute__((address_space(3))) unsigned char* TL = (const __attribute__((address_space(3))) unsigned char*)(c.lds3 + L_MISC);
#define NSA_TID(i) ((MODE == 0) ? (i) : (MODE == 2) ? (first + (i)) : (int)TL[NT - 1 - (i)])
#define NSA_ISSUE(i, slot) do { const int id_ = __builtin_amdgcn_readfirstlane(NSA_TID(i)); \
        const bf16* ks_ = Kb + (size_t)(64 * id_ + c.lane) * pitch + 8 * c.wid; \
        const bf16* vs_ = Vb + (size_t)(64 * id_ + 16 * (c.wid & 3) + (c.lane >> 2)) * pitch + 32 * (c.wid >> 2) + 8 * (c.lane & 3); \
        glds16(ks_, (unsigned)__builtin_amdgcn_readfirstlane(c.lds0 + L_RING + (slot) * SLOTB + c.wid * 1024)); \
        glds16(vs_, (unsigned)__builtin_amdgcn_readfirstlane(c.lds0 + L_RING + (slot) * SLOTB + 8192 + c.wid * 1024)); } while (0)
    if (NT > 0) NSA_ISSUE(0, 0);
    if (NT > 1) NSA_ISSUE(1, 1);
    if (NT > 2) NSA_ISSUE(2, 2);
    int slot = 0;
    for (int i = 0; i < NT; ++i) {
        if (i + 2 < NT) NSA_WAIT_BAR(4); else if (i + 1 < NT) NSA_WAIT_BAR(2); else NSA_WAIT_BAR(0);
        if (i + 3 < NT) { const int s3 = (slot == 0) ? 3 : slot - 1; NSA_ISSUE(i + 3, s3); }
        const int id = __builtin_amdgcn_readfirstlane(NSA_TID(i));
        f32x16 p0, p1;
        qkt(p0, p1, (lds_cptr)(c.lds3 + L_RING + slot * SLOTB), qr, c.r32, c.hi);
        const int dbase = (MODE == 0) ? (c.tq - 31 - 1024 * id) : (c.tq - 64 * id);
        bool selb = true;
        if (MODE == 1) selb = ((id < 32 ? (mask_lo >> id) : (mask_hi >> (id - 32))) & 1u) != 0u;
        float alpha, rs;
        bool need;
        if (NSA_FAR && MODE == 1 && __builtin_amdgcn_readfirstlane(c.tq - c.r32) - (64 * id + 63) >= 790) {
            const float lofs = selb ? c.bt[790] : -INFINITY;
            const float mt = rowmax32(p0, p1) * SC2 + lofs;
            need = !__all(mt <= m + NSA_DEFER);
            const float mnew = need ? fmaxf(m, mt) : m;
            alpha = need ? __builtin_amdgcn_exp2f(m - mnew) : 1.f;
            m = mnew;
            const float off = lofs - mnew;
#pragma unroll
            for (int r = 0; r < 16; ++r) { p0[r] = __builtin_amdgcn_exp2f(p0[r] * SC2 + off); p1[r] = __builtin_amdgcn_exp2f(p1[r] * SC2 + off); }
        } else {
        if (MODE != 0 && NSA_FAR) {
        int dbh = dbase - 4 * c.hi;
        asm volatile("" : "+v"(dbh));
        unsigned ba = (unsigned)(uintptr_t)c.bt + 4u * (unsigned)dbh;
        if (MODE == 1) ba = selb ? ba : (c.lds0 + L_BTP + 4u * (4 * BT_P + BT_NEG - 1));
        ba -= 236u;
        asm volatile("" : "+v"(ba));
        const __attribute__((address_space(3))) float* bp = (const __attribute__((address_space(3))) float*)(uintptr_t)ba;
#pragma unroll
        for (int r = 0; r < 16; ++r) {
            const int cr = (r & 3) + 8 * (r >> 2);
            const float b0 = bp[59 - cr], b1 = bp[27 - cr];
            float s0 = p0[r] * SC2 + b0, s1 = p1[r] * SC2 + b1;
            if (MODE == 2) { const int d0 = dbh - cr, d1 = d0 - 32; s0 = (unsigned)d0 < (unsigned)WINDOW ? s0 : -INFINITY; s1 = (unsigned)d1 < (unsigned)WINDOW ? s1 : -INFINITY; }
            p0[r] = s0; p1[r] = s1;
        }
        } else {
        int dbh = dbase - ((MODE == 0) ? 64 * c.hi : 4 * c.hi);
        asm volatile("" : "+v"(dbh));
#pragma unroll
        for (int r = 0; r < 16; ++r) {
            const int d0 = dbh - ((MODE == 0) ? 16 * ((r & 3) + 8 * (r >> 2)) : ((r & 3) + 8 * (r >> 2)));
            const int d1 = (MODE == 0) ? (d0 - 512) : (d0 - 32);
            bool v0 = d0 >= 0, v1 = d1 >= 0;
            if (MODE == 2) { v0 = (unsigned)d0 < (unsigned)WINDOW; v1 = (unsigned)d1 < (unsigned)WINDOW; }
            if (MODE == 1) { v0 = v0 && selb; v1 = v1 && selb; }
            const bool clampd = (MODE == 0) || !NSA_FAR;
            const int i0 = clampd ? (d0 < 0 ? 0 : (d0 > 790 ? 790 : d0)) : d0, i1 = clampd ? (d1 < 0 ? 0 : (d1 > 790 ? 790 : d1)) : d1;
            const float s0 = p0[r] * SC2 + c.bt[i0], s1 = p1[r] * SC2 + c.bt[i1];
            p0[r] = v0 ? s0 : -INFINITY; p1[r] = v1 ? s1 : -INFINITY;
        }
        }
        const float mt = rowmax32(p0, p1);
        need = !__all(mt <= m + NSA_DEFER);
        const float mnew = need ? fmaxf(m, mt) : m;
        alpha = need ? __builtin_amdgcn_exp2f(m - mnew) : 1.f;
        m = mnew;
#pragma unroll
        for (int r = 0; r < 16; ++r) {
            const float e0 = __builtin_amdgcn_exp2f(p0[r] - mnew), e1 = __builtin_amdgcn_exp2f(p1[r] - mnew);
            p0[r] = e0; p1[r] = e1;
        }
        }
        rs = sum16(p0) + sum16(p1);
        l = l * alpha + rs;
        if (need) {
            if (c.hi == 0) c.wsf[c.r32] = alpha;
            asm volatile("s_waitcnt lgkmcnt(0)" ::: "memory");
#pragma unroll
            for (int r = 0; r < 16; ++r) { const float a = c.wsf[crow(r, c.hi)]; o[0][r] *= a; o[1][r] *= a; if (MODE == 0) { im[0][r] *= a; im[1][r] *= a; } }
        }
        u32x4 pw0, pw1, pw2, pw3;
        pw0 = (u32x4){cvtpk_s(p0[0], p0[1]), cvtpk_s(p0[2], p0[3]), cvtpk_s(p0[4], p0[5]), cvtpk_s(p0[6], p0[7])};
        pw1 = (u32x4){cvtpk_s(p0[8], p0[9]), cvtpk_s(p0[10], p0[11]), cvtpk_s(p0[12], p0[13]), cvtpk_s(p0[14], p0[15])};
        pw2 = (u32x4){cvtpk_s(p1[0], p1[1]), cvtpk_s(p1[2], p1[3]), cvtpk_s(p1[4], p1[5]), cvtpk_s(p1[6], p1[7])};
        pw3 = (u32x4){cvtpk_s(p1[8], p1[9]), cvtpk_s(p1[10], p1[11]), cvtpk_s(p1[12], p1[13]), cvtpk_s(p1[14], p1[15])};
        NSA_SBAR();
        pv(o, (int)(c.lds0 + L_RING + slot * SLOTB + 8192) + c.vboff, __builtin_bit_cast(bf16x8, pw0), __builtin_bit_cast(bf16x8, pw1), __builtin_bit_cast(bf16x8, pw2), __builtin_bit_cast(bf16x8, pw3));
        if (MODE == 0) pv(im, (int)(c.lds0 + L_OV + id * 8192) + c.vboff, __builtin_bit_cast(bf16x8, pw0), __builtin_bit_cast(bf16x8, pw1), __builtin_bit_cast(bf16x8, pw2), __builtin_bit_cast(bf16x8, pw3));
        slot = (slot == NSLOT - 1) ? 0 : slot + 1;
    }
    asm volatile("s_waitcnt vmcnt(0) lgkmcnt(0)\n\ts_barrier" ::: "memory");
#undef NSA_TID
#undef NSA_ISSUE
}

__device__ __forceinline__ void build_ov(lds_ptr lds3) {
    for (int idx = threadIdx.x; idx < 4 * 4096; idx += NTHR) {
        const int kt = idx >> 12, nl = (idx >> 6) & 63, jc = idx & 63, n = 64 * kt + nl;
        unsigned short v = 0;
        if ((n & 3) != 3) { if (jc == (n >> 2)) v = 0x3F80; } else { if (jc == (n >> 2) || jc == (n >> 2) + 1) v = 0x3F00; }
        *(__attribute__((address_space(3))) unsigned short*)(lds3 + L_OV + kt * 8192 + ((jc >> 5) * 4 + (nl >> 4)) * 1024 + (nl & 15) * 64 + (jc & 31) * 2) = v;
    }
}

__device__ __forceinline__ void nsa_unit(int variant, bool build_bt, int b, int g, int qt, const bf16* PROJ, const bf16* KCBb, const bf16* VCBb, const float* rel, bf16* ONSA, lds_ptr lds3, unsigned lds0) {
    const int tid = threadIdx.x, lane = tid & 63, r32 = lane & 31, hi = lane >> 5;
    const int wid = __builtin_amdgcn_readfirstlane(tid >> 6), hh = wid & 3, th = wid >> 2;
    const int t0 = qt * 64, tq = t0 + 32 * th + r32, cur = qt;
    __attribute__((address_space(3))) float* BT = (__attribute__((address_space(3))) float*)(lds3 + L_BTP);
    __attribute__((address_space(3))) unsigned* MASK = (__attribute__((address_space(3))) unsigned*)(lds3 + L_MASK);
    if (build_bt) for (int i = tid; i < 4 * BT_P; i += NTHR) { const int hq_ = i / BT_P, d_ = i - hq_ * BT_P - BT_LO;
        BT[i] = d_ < 0 ? -INFINITY : rel[(g * 4 + hq_) * BT_N + (d_ > 790 ? 790 : d_)]; }
    if (build_bt && tid < BT_NEG) BT[4 * BT_P + tid] = -INFINITY;
    if (tid < 128) MASK[tid] = 0u;
    PassCtx c; c.lds3 = lds3; c.lds0 = lds0; c.lane = lane; c.r32 = r32; c.hi = hi; c.wid = wid; c.tq = tq;
    c.bt = BT + hh * BT_P + BT_LO; c.wsf = (__attribute__((address_space(3))) float*)(lds3 + L_WSF) + wid * 64;
    c.vboff = ((lane >> 4) & 1) * 32 + (lane & 3) * 8 + (4 * hi + ((lane & 15) >> 2)) * 64;
    const size_t qrow = (size_t)(b * SEQ + tq) * PP;
    bf16x8 qr[4];
#pragma unroll
    for (int d0 = 0; d0 < 4; ++d0) qr[d0] = *(const bf16x8*)(PNL(PROJ, P_QN + g) + qrow + hh * HD + d0 * 16 + hi * 8);
    const float gate0 = 1.f / (1.f + __expf(-bf2f(PNL(PROJ, P_GBR)[qrow + 0 * 16 + g * 4 + hh])));
    const float gate1 = 1.f / (1.f + __expf(-bf2f(PNL(PROJ, P_GBR)[qrow + 1 * 16 + g * 4 + hh])));
    const float gate2 = 1.f / (1.f + __expf(-bf2f(PNL(PROJ, P_GBR)[qrow + 2 * 16 + g * 4 + hh])));
    asm volatile("s_waitcnt vmcnt(0) lgkmcnt(0)" ::: "memory");
    __syncthreads();
    f32x16 oc[2] = {}, o[2] = {}, im[2] = {};
    float m = NEG2, l = 0.f;
    {
        int cnt = (t0 + 32) / 16 + 1; if (cnt > NCMP) cnt = NCMP;
        const int NT = (variant & 4) ? 0 : ((cnt + 63) >> 6);
#if defined(PROBE_NSA_CMP2)
        run_pass<0>(c, NT, 0, KCBb + (size_t)(b * 4 + g) * 256 * HD, VCBb + (size_t)(b * 4 + g) * 256 * HD, HD, qr, 0u, 0u, o, im, m, l);
        o[0] = f32x16{}; o[1] = f32x16{}; im[0] = f32x16{}; im[1] = f32x16{}; m = NEG2; l = 0.f;
#endif
        run_pass<0>(c, NT, 0, KCBb + (size_t)(b * 4 + g) * 256 * HD, VCBb + (size_t)(b * 4 + g) * 256 * HD, HD, qr, 0u, 0u, o, im, m, l);
        const float lt = swap_add(l);
        const float inv = lt > 0.f ? 1.f / lt : 0.f;
        if (hi == 0) { c.wsf[r32] = inv * gate0; c.wsf[32 + r32] = inv; }
        asm volatile("s_waitcnt lgkmcnt(0)" ::: "memory");
#pragma unroll
        for (int r = 0; r < 16; ++r) { const float a = c.wsf[crow(r, hi)], a2 = c.wsf[32 + crow(r, hi)]; oc[0][r] = o[0][r] * a; oc[1][r] = o[1][r] * a; im[0][r] *= a2; im[1][r] *= a2; }
        if (!(variant & 8)) {
        {
            __attribute__((address_space(3))) float* PW = (__attribute__((address_space(3))) float*)(lds3 + L_RING) + wid * 2048;
#pragma unroll
            for (int d0 = 0; d0 < 2; ++d0)
#pragma unroll
                for (int r = 0; r < 16; ++r) PW[crow(r, hi) * 64 + d0 * 32 + r32] = im[d0][r];
        }
        asm volatile("s_waitcnt lgkmcnt(0)" ::: "memory"); __syncthreads();
        __attribute__((address_space(3))) float* T = (__attribute__((address_space(3))) float*)(lds3 + L_X);
        {
            const __attribute__((address_space(3))) float* PA = (const __attribute__((address_space(3))) float*)(lds3 + L_RING);
            int tx = tid; asm volatile("" : "+v"(tx));
            const int j = tx & 63, tb = (tx >> 6) * 8;
#pragma unroll
            for (int e = 0; e < 8; ++e) { const int tok = tb + e, w0 = (tok >> 5) * 4, q = tok & 31;
                T[tok * 65 + j] = (PA[(w0 + 0) * 2048 + q * 64 + j] + PA[(w0 + 1) * 2048 + q * 64 + j]) + (PA[(w0 + 2) * 2048 + q * 64 + j] + PA[(w0 + 3) * 2048 + q * 64 + j]); }
        }
        asm volatile("s_waitcnt lgkmcnt(0)" ::: "memory"); __syncthreads();
        {
            int ty = tid; asm volatile("" : "+v"(ty));
            const int tok = ty & 63, jg = wid, jlo = 8 * jg;
            float v[8]; int rank[8];
#pragma unroll
            for (int e = 0; e < 8; ++e) { const int j = jlo + e; const bool forced = (j == 0) || (j == cur) || (j == cur - 1);
                v[e] = (j <= cur) ? T[tok * 65 + j] + (forced ? 1e4f : 0.f) : -INFINITY; rank[e] = 0; }
            const int nA = jlo < cur + 1 ? jlo : cur + 1, nB = (jlo + 8) < cur + 1 ? (jlo + 8) : cur + 1;
#pragma unroll 2
            for (int j2 = 0; j2 < nA; ++j2) {
                const float sv = T[tok * 65 + j2] + (((j2 == 0) || (j2 == cur) || (j2 == cur - 1)) ? 1e4f : 0.f);
#pragma unroll
                for (int e = 0; e < 8; ++e) rank[e] += (sv >= v[e]) ? 1 : 0;
            }
            for (int j2 = jlo; j2 < nB; ++j2) {
                const float sv = T[tok * 65 + j2] + (((j2 == 0) || (j2 == cur) || (j2 == cur - 1)) ? 1e4f : 0.f);
#pragma unroll
                for (int e = 0; e < 8; ++e) rank[e] += (sv > v[e] || (sv == v[e] && j2 < jlo + e)) ? 1 : 0;
            }
#pragma unroll 2
            for (int j2 = jlo + 8; j2 <= cur; ++j2) {
                const float sv = T[tok * 65 + j2] + (((j2 == 0) || (j2 == cur) || (j2 == cur - 1)) ? 1e4f : 0.f);
#pragma unroll
                for (int e = 0; e < 8; ++e) rank[e] += (sv > v[e]) ? 1 : 0;
            }
            unsigned bits = 0u;
#pragma unroll
            for (int e = 0; e < 8; ++e) { const int j = jlo + e; if (j <= cur && rank[e] < SEL_TOPK) bits |= 1u << e; }
            if (bits) atomicOr((unsigned*)(MASK + tok * 2 + (jg >> 2)), bits << ((jg & 3) * 8));
        }
        asm volatile("s_waitcnt lgkmcnt(0)" ::: "memory"); __syncthreads();
        if (wid == 0) {
            unsigned ulo = MASK[lane * 2], uhi = MASK[lane * 2 + 1];
#pragma unroll
            for (int ofs = 32; ofs >= 1; ofs >>= 1) { ulo |= __shfl_xor(ulo, ofs); uhi |= __shfl_xor(uhi, ofs); }
            {
                __attribute__((address_space(3))) unsigned char* TL = (__attribute__((address_space(3))) unsigned char*)(lds3 + L_MISC);
                const unsigned long long mm = ((unsigned long long)uhi << 32) | ulo;
                int ln = lane; asm volatile("" : "+v"(ln));
                if ((mm >> ln) & 1ull) TL[__popcll(mm & ((1ull << ln) - 1ull))] = (unsigned char)ln;
                if (lane == 0) *(__attribute__((address_space(3))) int*)(lds3 + L_MISC + 64) = __popcll(mm);
            }
        }
        asm volatile("s_waitcnt lgkmcnt(0)" ::: "memory"); __syncthreads();
        }
    }
    {
        const unsigned mlo = MASK[(32 * th + r32) * 2], mhi = MASK[(32 * th + r32) * 2 + 1];
        const int NT = (variant & 1) ? 0 : __builtin_amdgcn_readfirstlane(*(__attribute__((address_space(3))) int*)(lds3 + L_MISC + 64));
#if defined(PROBE_NSA_SEL2)
        o[0] = f32x16{}; o[1] = f32x16{}; m = NEG2; l = 0.f;
        run_pass<1>(c, NT, 0, PNL(PROJ, P_KS) + (size_t)b * SEQ * PP + g * HD, PNL(PROJ, P_VS) + (size_t)b * SEQ * PP + g * HD, PP, qr, mlo, mhi, o, im, m, l);
#endif
        o[0] = f32x16{}; o[1] = f32x16{}; m = NEG2; l = 0.f;
        run_pass<1>(c, NT, 0, PNL(PROJ, P_KS) + (size_t)b * SEQ * PP + g * HD, PNL(PROJ, P_VS) + (size_t)b * SEQ * PP + g * HD, PP, qr, mlo, mhi, o, im, m, l);
        const float lt = swap_add(l);
        const float inv = lt > 0.f ? 1.f / lt : 0.f;
        if (hi == 0) c.wsf[r32] = inv * gate1;
        asm volatile("s_waitcnt lgkmcnt(0)" ::: "memory");
#pragma unroll
        for (int r = 0; r < 16; ++r) { const float a = c.wsf[crow(r, hi)]; oc[0][r] += o[0][r] * a; oc[1][r] += o[1][r] * a; }
    }
    {
        const int jlo = (qt - 8) > 0 ? (qt - 8) : 0, NT = (variant & 2) ? 0 : (qt - jlo + 1);
#if defined(PROBE_NSA_WIN2)
        o[0] = f32x16{}; o[1] = f32x16{}; m = NEG2; l = 0.f;
        run_pass<2>(c, NT, jlo, PNL(PROJ, P_KW) + (size_t)b * SEQ * PP + g * HD, PNL(PROJ, P_VW) + (size_t)b * SEQ * PP + g * HD, PP, qr, 0u, 0u, o, im, m, l);
#endif
        o[0] = f32x16{}; o[1] = f32x16{}; m = NEG2; l = 0.f;
        run_pass<2>(c, NT, jlo, PNL(PROJ, P_KW) + (size_t)b * SEQ * PP + g * HD, PNL(PROJ, P_VW) + (size_t)b * SEQ * PP + g * HD, PP, qr, 0u, 0u, o, im, m, l);
        const float lt = swap_add(l);
        const float inv = lt > 0.f ? 1.f / lt : 0.f;
        if (hi == 0) c.wsf[r32] = inv * gate2;
        asm volatile("s_waitcnt lgkmcnt(0)" ::: "memory");
#pragma unroll
        for (int r = 0; r < 16; ++r) { const float a = c.wsf[crow(r, hi)]; oc[0][r] += o[0][r] * a; oc[1][r] += o[1][r] * a; }
    }
    {
        __attribute__((address_space(3))) unsigned short* stg = (__attribute__((address_space(3))) unsigned short*)(lds3 + L_X) + wid * 2048;
#pragma unroll
        for (int r = 0; r < 16; ++r) { const int orow = crow(r, hi);
#pragma unroll
            for (int d0 = 0; d0 < 2; ++d0) stg[orow * 64 + d0 * 32 + r32] = (unsigned short)f2bf(oc[d0][r]); }
        asm volatile("s_waitcnt lgkmcnt(0)" ::: "memory");
        bf16* Ow = ONSA + (size_t)(b * SEQ + t0 + 32 * th) * NSA_Q + (g * 4 + hh) * HD;
#pragma unroll
        for (int i = 0; i < 4; ++i) { const int row = i * 8 + (lane >> 3), ch = lane & 7;
            const u32x4 vv = *(const __attribute__((address_space(3))) u32x4*)(stg + row * 64 + ch * 8);
            *(u32x4*)(Ow + (size_t)row * NSA_Q + ch * 8) = vv; }
    }
    asm volatile("s_waitcnt vmcnt(0) lgkmcnt(0)" ::: "memory");
    __syncthreads();
}

__device__ __forceinline__ void nsa_phase(const bf16* PROJ, const bf16* KCBb, const bf16* VCBb, const float* rel, bf16* ONSA, lds_ptr lds3, int vcu, int G, int variant) {
    const unsigned lds0 = (unsigned)(uintptr_t)lds3;
    build_ov(lds3);
    __syncthreads();
    int last_g = -1;
#ifndef NSA_REP
#define NSA_REP 1
#endif
#pragma unroll 1
    for (int rep_ = 0; rep_ < NSA_REP; ++rep_)
#pragma unroll 1
    for (int i = vcu; i < 512; i += G) {
        const int k = i & 255, bg = k >> 5, s = k & 31, qt = (i < 256) ? s : 63 - s;
        if (!(variant & 16)) nsa_unit(variant, (bg & 3) != last_g, bg >> 2, bg & 3, qt, PROJ, KCBb, VCBb, rel, ONSA, lds3, lds0);
        last_g = bg & 3;
    }
}
#undef NSA_WAIT_BAR
#undef NSA_SBAR
}
namespace nsa {
constexpr float STICK_THR = 50.f, LN2F = 0.6931471805599453f;
constexpr int STK_SLOTB = 32768;
static_assert(3 * STK_SLOTB <= L_WSF, "stick ring vs the LDS words it shares with the NSA map");
#define NSA_WAIT_BAR(N) asm volatile("s_waitcnt vmcnt(" #N ") lgkmcnt(0)\n\ts_barrier" ::: "memory")
__device__ __forceinline__ void stick_unit(int tid, int b, int hp, int qb, const bf16* PROJ, bf16* OSB, lds_ptr lds3, unsigned lds0, const bf16x8 (&tri)[2]) {
    const int lane = tid & 63, r32 = lane & 31, hi = lane >> 5;
    const int wid = __builtin_amdgcn_readfirstlane(tid >> 6);
    const int hs = wid >> 2, qw = wid & 3, h = 2 * hp + hs;
    const int q0 = qb * 128, t = q0 + 32 * qw + r32;
    const bf16* Kb = PNL(PROJ, P_KB + (hp >> 1)) + (size_t)b * SEQ * PP + (hp & 1) * 128;
    const bf16* Vb = PNL(PROJ, P_VB + (hp >> 1)) + (size_t)b * SEQ * PP + (hp & 1) * 128;
    __attribute__((address_space(3))) int* DONE = (__attribute__((address_space(3))) int*)(lds3 + L_MISC);
    bf16x8 qr[4];
#pragma unroll
    for (int d0 = 0; d0 < 4; ++d0) qr[d0] = *(const bf16x8*)(PNL(PROJ, P_QB + (h >> 2)) + (size_t)(b * SEQ + t) * PP + (h & 3) * HD + d0 * 16 + hi * 8);
    if (tid < 8) DONE[tid] = 0x7fffffff;
    asm volatile("s_waitcnt vmcnt(0) lgkmcnt(0)" ::: "memory");
    __syncthreads();
    const int jhi = 2 * qb + 1, NT = jhi + 1;
    const int jw = (q0 + 32 * qw + 30) >> 6;
    const int vboff = ((lane >> 4) & 1) * 32 + (lane & 3) * 8 + (4 * hi + ((lane & 15) >> 2)) * 64;
    f32x16 o[2] = {};
    float carry = 0.f; bool mydone = false;
#define STK_ISSUE(i, slot) do { const int id_ = jhi - (i); \
        const bf16* ks_ = Kb + (size_t)(64 * id_ + lane) * PP + 8 * wid; \
        const bf16* vs_ = Vb + (size_t)(64 * id_ + 16 * (wid & 3) + (lane >> 2)) * PP + 32 * (wid >> 2) + 8 * (lane & 3); \
        glds16(ks_, (unsigned)__builtin_amdgcn_readfirstlane(lds0 + L_RING + (slot) * STK_SLOTB + wid * 1024)); \
        glds16(vs_, (unsigned)__builtin_amdgcn_readfirstlane(lds0 + L_RING + (slot) * STK_SLOTB + 8192 + wid * 1024)); \
        glds16(ks_ + 64, (unsigned)__builtin_amdgcn_readfirstlane(lds0 + L_RING + (slot) * STK_SLOTB + 16384 + wid * 1024)); \
        glds16(vs_ + 64, (unsigned)__builtin_amdgcn_readfirstlane(lds0 + L_RING + (slot) * STK_SLOTB + 24576 + wid * 1024)); } while (0)
    STK_ISSUE(0, 0);
    if (NT > 1) STK_ISSUE(1, 1);
    int slot = 0;
    for (int i = 0; i < NT; ++i) {
        if (i + 1 < NT) NSA_WAIT_BAR(4); else NSA_WAIT_BAR(0);
        bool alld = true;
#pragma unroll
        for (int w = 0; w < 8; ++w) alld = alld && (DONE[w] < i);
        if (__builtin_amdgcn_readfirstlane((int)alld)) break;
        if (i + 2 < NT) { const int s2 = (slot == 0) ? 2 : slot - 1; STK_ISSUE(i + 2, s2); }
        const int j = jhi - i;
        if (!mydone && j <= jw) {
            f32x16 p0, p1, x0, x1;
            qkt(p0, p1, (lds_cptr)(lds3 + L_RING + slot * STK_SLOTB + hs * 16384), qr, r32, hi);
            float s0 = 0.f, s1 = 0.f;
#pragma unroll
            for (int r = 0; r < 16; ++r) {
                const int pos0 = 64 * j + crow(r, hi);
                const float z0 = p0[r] * 0.125f, z1 = p1[r] * 0.125f;
                const float L0 = __builtin_amdgcn_logf(1.f + __builtin_amdgcn_exp2f(-fabsf(z0) * LOG2E)) * LN2F;
                const float L1 = __builtin_amdgcn_logf(1.f + __builtin_amdgcn_exp2f(-fabsf(z1) * LOG2E)) * LN2F;
                p0[r] = fminf(z0, 0.f) - L0; p1[r] = fminf(z1, 0.f) - L1;
                x0[r] = (pos0 < t) ? (-fmaxf(z0, 0.f) - L0) : 0.f; x1[r] = (pos0 + 32 < t) ? (-fmaxf(z1, 0.f) - L1) : 0.f;
                s0 += x0[r]; s1 += x1[r];
            }
            const float tot0 = swap_add(s0), tot1 = swap_add(s1);
            u32x4 h0a, h0b, l0a, l0b, h1a, h1b, l1a, l1b;
#define STK_SPLIT(X, HA, HB, LA, LB) do { unsigned hw_[8]; float lo_[16]; \
                _Pragma("unroll") for (int q_ = 0; q_ < 8; ++q_) { hw_[q_] = cvtpk_s(X[2 * q_], X[2 * q_ + 1]); \
                    lo_[2 * q_] = X[2 * q_] - __uint_as_float(hw_[q_] << 16); lo_[2 * q_ + 1] = X[2 * q_ + 1] - __uint_as_float(hw_[q_] & 0xffff0000u); } \
                HA = (u32x4){hw_[0], hw_[1], hw_[2], hw_[3]}; HB = (u32x4){hw_[4], hw_[5], hw_[6], hw_[7]}; \
                LA = (u32x4){cvtpk_s(lo_[0], lo_[1]), cvtpk_s(lo_[2], lo_[3]), cvtpk_s(lo_[4], lo_[5]), cvtpk_s(lo_[6], lo_[7])}; \
                LB = (u32x4){cvtpk_s(lo_[8], lo_[9]), cvtpk_s(lo_[10], lo_[11]), cvtpk_s(lo_[12], lo_[13]), cvtpk_s(lo_[14], lo_[15])}; } while (0)
            STK_SPLIT(x0, h0a, h0b, l0a, l0b);
            STK_SPLIT(x1, h1a, h1b, l1a, l1b);
#undef STK_SPLIT
            f32x16 y0, y1;
#pragma unroll
            for (int r = 0; r < 16; ++r) { y0[r] = carry + tot1; y1[r] = carry; }
            y0 = __builtin_amdgcn_mfma_f32_32x32x16_bf16(tri[0], __builtin_bit_cast(bf16x8, h0a), y0, 0, 0, 0);
            y0 = __builtin_amdgcn_mfma_f32_32x32x16_bf16(tri[1], __builtin_bit_cast(bf16x8, h0b), y0, 0, 0, 0);
            y0 = __builtin_amdgcn_mfma_f32_32x32x16_bf16(tri[0], __builtin_bit_cast(bf16x8, l0a), y0, 0, 0, 0);
            y0 = __builtin_amdgcn_mfma_f32_32x32x16_bf16(tri[1], __builtin_bit_cast(bf16x8, l0b), y0, 0, 0, 0);
            y1 = __builtin_amdgcn_mfma_f32_32x32x16_bf16(tri[0], __builtin_bit_cast(bf16x8, h1a), y1, 0, 0, 0);
            y1 = __builtin_amdgcn_mfma_f32_32x32x16_bf16(tri[1], __builtin_bit_cast(bf16x8, h1b), y1, 0, 0, 0);
            y1 = __builtin_amdgcn_mfma_f32_32x32x16_bf16(tri[0], __builtin_bit_cast(bf16x8, l1a), y1, 0, 0, 0);
            y1 = __builtin_amdgcn_mfma_f32_32x32x16_bf16(tri[1], __builtin_bit_cast(bf16x8, l1b), y1, 0, 0, 0);
#pragma unroll
            for (int r = 0; r < 16; ++r) {
                const int pos0 = 64 * j + crow(r, hi);
                y0[r] = (pos0 < t) ? __builtin_amdgcn_exp2f((p0[r] + y0[r]) * LOG2E) : 0.f;
                y1[r] = (pos0 + 32 < t) ? __builtin_amdgcn_exp2f((p1[r] + y1[r]) * LOG2E) : 0.f;
            }
            carry += tot0 + tot1;
            u32x4 pw0, pw1, pw2, pw3;
            pw0 = (u32x4){cvtpk_s(y0[0], y0[1]), cvtpk_s(y0[2], y0[3]), cvtpk_s(y0[4], y0[5]), cvtpk_s(y0[6], y0[7])};
            pw1 = (u32x4){cvtpk_s(y0[8], y0[9]), cvtpk_s(y0[10], y0[11]), cvtpk_s(y0[12], y0[13]), cvtpk_s(y0[14], y0[15])};
            pw2 = (u32x4){cvtpk_s(y1[0], y1[1]), cvtpk_s(y1[2], y1[3]), cvtpk_s(y1[4], y1[5]), cvtpk_s(y1[6], y1[7])};
            pw3 = (u32x4){cvtpk_s(y1[8], y1[9]), cvtpk_s(y1[10], y1[11]), cvtpk_s(y1[12], y1[13]), cvtpk_s(y1[14], y1[15])};
            __builtin_amdgcn_sched_barrier(0);
            pv(o, (int)(lds0 + L_RING + slot * STK_SLOTB + hs * 16384 + 8192) + vboff, __builtin_bit_cast(bf16x8, pw0), __builtin_bit_cast(bf16x8, pw1), __builtin_bit_cast(bf16x8, pw2), __builtin_bit_cast(bf16x8, pw3));
            mydone = __all(carry < -STICK_THR) != 0;
            if (mydone && lane == 0) DONE[wid] = i;
        }
        slot = (slot == 2) ? 0 : slot + 1;
    }
    asm volatile("s_waitcnt vmcnt(0) lgkmcnt(0)\n\ts_barrier" ::: "memory");
#undef STK_ISSUE
    {
        __attribute__((address_space(3))) unsigned short* stg = (__attribute__((address_space(3))) unsigned short*)(lds3 + L_X) + wid * 2048;
#pragma unroll
        for (int r = 0; r < 16; ++r) { const int orow = crow(r, hi);
#pragma unroll
            for (int d0 = 0; d0 < 2; ++d0) stg[orow * 64 + d0 * 32 + r32] = (unsigned short)f2bf(o[d0][r]); }
        asm volatile("s_waitcnt lgkmcnt(0)" ::: "memory");
        bf16* Ow = OSB + (size_t)(b * SEQ + q0 + 32 * qw) * SB_W + h * HD;
#pragma unroll
        for (int i = 0; i < 4; ++i) { const int row = i * 8 + (lane >> 3), ch = lane & 7;
            const u32x4 vv = *(const __attribute__((address_space(3))) u32x4*)(stg + row * 64 + ch * 8);
            *(u32x4*)(Ow + (size_t)row * SB_W + ch * 8) = vv; }
    }
    asm volatile("s_waitcnt vmcnt(0) lgkmcnt(0)" ::: "memory");
    __syncthreads();
}
__device__ __forceinline__ void stick_phase(const bf16* PROJ, bf16* OSB, lds_ptr lds3, int vcu, int G) {
    const unsigned lds0 = (unsigned)(uintptr_t)lds3;
    int tid = threadIdx.x; asm volatile("" : "+v"(tid));
    const int lane = tid & 63, r32 = lane & 31, hi = lane >> 5;
    bf16x8 tri[2];
#pragma unroll
    for (int s = 0; s < 2; ++s)
#pragma unroll
        for (int j = 0; j < 8; ++j) tri[s][j] = ((16 * s + 8 * (j >> 2) + 4 * hi + (j & 3)) > r32) ? (short)0x3F80 : (short)0;
    for (int i = vcu; i < 512; i += G) {
        const int bp = i >> 5, qb = i & 31;
        stick_unit(tid, bp >> 3, bp & 7, qb, PROJ, OSB, lds3, lds0, tri);
    }
}
#undef NSA_WAIT_BAR
}
namespace peer {
typedef short bf16x8 __attribute__((ext_vector_type(8)));
typedef float f32x16 __attribute__((ext_vector_type(16)));
typedef __bf16 b2_t __attribute__((ext_vector_type(2)));
constexpr int L_EX = 0, L_GT = 16384, L_GN = 32768;
__device__ __forceinline__ int crow(int r, int hi) { return (r & 3) + 8 * (r >> 2) + 4 * hi; }
__device__ __forceinline__ unsigned mono(float f) { const unsigned u = __float_as_uint(f); return (u & 0x80000000u) ? ~u : (u | 0x80000000u); }
__device__ __forceinline__ float unmono(unsigned k) { return __uint_as_float((k & 0x80000000u) ? (k & 0x7fffffffu) : ~k); }
__device__ __forceinline__ float dot2(unsigned a, unsigned b, float c) { return __builtin_amdgcn_fdot2_f32_bf16(__builtin_bit_cast(b2_t, a), __builtin_bit_cast(b2_t, b), c, false); }
#define PEER_CE(key, slot) do { const unsigned hi_ = (key) > (slot) ? (key) : (slot); (key) = (key) > (slot) ? (slot) : (key); (slot) = hi_; } while (0)

__device__ __forceinline__ void route_list(const bf16* QP, const bf16* SKB, int L, int tok0, int r32, int hi, unsigned (&out)[16]) {
    f32x16 acc[4] = {};
    const bf16* qp = QP + (size_t)(tok0 + r32) * 2048 + L * 128 + hi * 8;
    const bf16* kp = SKB + ((size_t)L * 128 + r32) * 128 + hi * 8;
    int hi4 = 4 * hi;
    asm volatile("" : "+v"(qp), "+v"(kp), "+v"(hi4));
#pragma unroll
    for (int ks = 0; ks < 8; ++ks) {
        const bf16x8 bq = __builtin_nontemporal_load((const bf16x8*)(qp + ks * 16));
#pragma unroll
        for (int kt = 0; kt < 4; ++kt) { const bf16x8 a = *(const bf16x8*)(kp + (size_t)kt * 32 * 128 + ks * 16); acc[kt] = __builtin_amdgcn_mfma_f32_32x32x16_bf16(a, bq, acc[kt], 0, 0, 0); }
    }
    unsigned t[16];
#pragma unroll
    for (int k = 0; k < 16; ++k) t[k] = 0u;
#pragma unroll
    for (int kt = 0; kt < 4; ++kt)
#pragma unroll
        for (int r = 0; r < 16; ++r) {
            unsigned key = ((mono(acc[kt][r]) & ~127u) | (unsigned)(127 - (32 * kt + (r & 3) + 8 * (r >> 2)))) - (unsigned)hi4;
#pragma unroll
            for (int k = 0; k < 16; ++k) PEER_CE(key, t[k]);
            __builtin_amdgcn_sched_barrier(0);
        }
    unsigned u[16];
#pragma unroll
    for (int k = 0; k < 16; ++k) { auto rr = __builtin_amdgcn_permlane32_swap(t[k], t[k], false, false); u[k] = hi ? rr[0] : rr[1]; }
#pragma unroll
    for (int k = 0; k < 16; ++k) out[k] = t[k] > u[15 - k] ? t[k] : u[15 - k];
#pragma unroll
    for (int st = 8; st >= 1; st >>= 1)
#pragma unroll
        for (int k = 0; k < 16; ++k) if ((k & st) == 0) { const unsigned a = out[k], b = out[k | st]; out[k] = a > b ? a : b; out[k | st] = a > b ? b : a; }
}

__device__ __forceinline__ void route_head(const bf16* QP, const bf16* SKB, int h, int tok0, int lane, __attribute__((address_space(3))) unsigned char* lds3) {
    asm volatile("" : "+v"(lane));
    const int r32 = lane & 31, hi = lane >> 5;
    unsigned A[16], B[16];
    route_list(QP, SKB, 2 * h, tok0, r32, hi, A);
    route_list(QP, SKB, 2 * h + 1, tok0, r32, hi, B);
    float va[16], vb[16]; int ia[16], ib[16];
#pragma unroll
    for (int k = 0; k < 16; ++k) { va[k] = unmono((A[k] & ~127u) | 64u); vb[k] = unmono((B[k] & ~127u) | 64u); ia[k] = 127 - (int)(A[k] & 127u); ib[k] = 127 - (int)(B[k] & 127u); }
    unsigned s[16], sp[16];
#pragma unroll
    for (int k = 0; k < 16; ++k) { s[k] = 0u; sp[k] = 0u; }
#pragma unroll
    for (int i = 0; i < 16; ++i)
#pragma unroll
        for (int j = 0; j < 16; ++j) if ((i + 1) * (j + 1) <= 16) {
            unsigned key = mono(va[i] + vb[j]); unsigned pay = (unsigned)(ia[i] * PEER_KEYS + ib[j]);
#pragma unroll
            for (int k = (i + 1) * (j + 1) - 1; k < 16; ++k) { const bool gt = key > s[k]; const unsigned ts = s[k], tp = sp[k]; s[k] = gt ? key : ts; sp[k] = gt ? pay : tp; key = gt ? ts : key; pay = gt ? tp : pay; }
            __builtin_amdgcn_sched_barrier(0);
        }
    const float mx = unmono(s[0]);
    float e[16], sum = 0.f;
#pragma unroll
    for (int k = 0; k < 16; ++k) { e[k] = __expf(unmono(s[k]) - mx); sum += e[k]; }
    const float inv = 1.f / sum;
    if (hi == 0) {
        __attribute__((address_space(3))) int* EX = (__attribute__((address_space(3))) int*)(lds3 + L_EX);
        __attribute__((address_space(3))) float* GT = (__attribute__((address_space(3))) float*)(lds3 + L_GT);
#pragma unroll
        for (int k = 0; k < 16; ++k) { EX[(h * 16 + k) * 32 + r32] = (int)sp[k]; GT[(h * 16 + k) * 32 + r32] = e[k] * inv; }
    }
}

#ifndef PEER_FAKE
#define PEER_FAKE 0
#endif
#ifndef PEER_FAKE_MODE
#define PEER_FAKE_MODE 0
#endif
#ifndef PEER_FAKE_EMASK
#define PEER_FAKE_EMASK 0xffff
#endif
constexpr int FP6_PITCH = 2048;
typedef float v2f_t __attribute__((ext_vector_type(2)));
__device__ __forceinline__ void cvt_row_load(const float* src, int row, int lane, f32x4 (&v)[8]) {
    const float* p = src + (size_t)row * 2048 + lane * 4;
#pragma unroll
    for (int i = 0; i < 8; ++i) v[i] = __builtin_nontemporal_load((const f32x4*)(p + i * 256));
}
__device__ __forceinline__ float clamp6(float x) { return __builtin_amdgcn_fmed3f(x, -6.f, 6.f); }
__device__ __forceinline__ float elem4(const f32x4& a, int m) { return m == 0 ? a.x : m == 1 ? a.y : m == 2 ? a.z : a.w; }
__device__ __forceinline__ void cvt_row_store(const f32x4 (&v)[8], unsigned char* REC, float* ISC, int r, int lane) {
    float am = 0.f, ss = 0.f;
#pragma unroll
    for (int i = 0; i < 8; ++i) { am = fmaxf(am, fmaxf(fmaxf(fabsf(v[i].x), fabsf(v[i].y)), fmaxf(fabsf(v[i].z), fabsf(v[i].w))));
        ss += v[i].x * v[i].x + v[i].y * v[i].y + v[i].z * v[i].z + v[i].w * v[i].w; }
    am = wave_max(am);
    const bool is_u = r < 16384; const int e = r & 16383;
    v4u q; float isc;
    if (is_u) {
        ss = wave_sum(ss);
        const float step = am > 0.f ? fminf(0.3352f * sqrtf(ss * (1.f / 2048.f)), am * (1.f / 7.5f)) : 1.f, inv = 1.f / step;
#pragma unroll
        for (int j = 0; j < 4; ++j) { unsigned w = 0;
#pragma unroll
            for (int t = 0; t < 8; ++t) { const float val = elem4(v[2 * j + (t >> 2)], t & 3);
                int n = (int)floorf(val * inv); n = n < -8 ? -8 : n > 7 ? 7 : n;
                w |= (unsigned)(n & 15) << (4 * t); }
            q[j] = w; }
        isc = step;
    } else {
        const float sc = am > 0.f ? 7.5f / am : 1.f;
#pragma unroll
        for (int j = 0; j < 4; ++j) { unsigned w = 0;
            w = __builtin_amdgcn_cvt_scalef32_pk_fp4_f32(w, clamp6(v[2 * j].x * sc), clamp6(v[2 * j].y * sc), 1.0f, 0);
            w = __builtin_amdgcn_cvt_scalef32_pk_fp4_f32(w, clamp6(v[2 * j].z * sc), clamp6(v[2 * j].w * sc), 1.0f, 1);
            w = __builtin_amdgcn_cvt_scalef32_pk_fp4_f32(w, clamp6(v[2 * j + 1].x * sc), clamp6(v[2 * j + 1].y * sc), 1.0f, 2);
            w = __builtin_amdgcn_cvt_scalef32_pk_fp4_f32(w, clamp6(v[2 * j + 1].z * sc), clamp6(v[2 * j + 1].w * sc), 1.0f, 3);
            q[j] = w; }
        isc = am > 0.f ? am / 7.5f : 1.f;
    }
    *(v4u*)(REC + (size_t)e * FP6_PITCH + (is_u ? 0 : 1024) + lane * 16) = q;
    if (lane == 0) ISC[2 * e + (is_u ? 0 : 1)] = isc;
}
#ifndef PEER_CVT_DEPTH4
#define PEER_CVT_DEPTH4 1
#endif
__device__ __forceinline__ void cvt_tables(const float* Uf, const float* Vf, unsigned char* REC, float* ISC, int first, int stride, int lane) {
#define PEER_SRC(r) ((r) < 16384 ? Uf : Vf), ((r) < 16384 ? (r) : (r) - 16384)
#if PEER_CVT_DEPTH4
    f32x4 va[8], vb[8], vc[8], vd[8];
    int r = first;
    if (r < 32768) cvt_row_load(PEER_SRC(r), lane, va);
    if (r + stride < 32768) cvt_row_load(PEER_SRC(r + stride), lane, vb);
    if (r + 2 * stride < 32768) cvt_row_load(PEER_SRC(r + 2 * stride), lane, vc);
#pragma unroll 1
    for (; r < 32768; r += 4 * stride) {
#define PEER_STEP(LD, ST, K) { const int rl_ = r + ((K) + 3) * stride, rs_ = r + (K) * stride; if (rl_ < 32768) cvt_row_load(PEER_SRC(rl_), lane, LD); __builtin_amdgcn_sched_barrier(0); \
            if (rs_ < 32768) cvt_row_store(ST, REC, ISC, rs_, lane); __builtin_amdgcn_sched_barrier(0); }
        PEER_STEP(vd, va, 0) PEER_STEP(va, vb, 1) PEER_STEP(vb, vc, 2) PEER_STEP(vc, vd, 3)
#undef PEER_STEP
    }
#else
    f32x4 va[8], vb[8];
    int r = first;
    if (r < 32768) cvt_row_load(PEER_SRC(r), lane, va);
#pragma unroll 1
    for (; r < 32768; r += 2 * stride) {
        const int r1 = r + stride, r2 = r + 2 * stride;
        if (r1 < 32768) cvt_row_load(PEER_SRC(r1), lane, vb);
        __builtin_amdgcn_sched_barrier(0);
        cvt_row_store(va, REC, ISC, r, lane);
        __builtin_amdgcn_sched_barrier(0);
        if (r2 < 32768) cvt_row_load(PEER_SRC(r2), lane, va);
        __builtin_amdgcn_sched_barrier(0);
        if (r1 < 32768) cvt_row_store(vb, REC, ISC, r1, lane);
        __builtin_amdgcn_sched_barrier(0);
    }
#endif
#undef PEER_SRC
}
__device__ __forceinline__ void ffn_token(int emask, bool fake, int n, int tl, int lane, const bf16* H, const float* SS, const unsigned char* REC, const float* ISC,
                                          float* out, __attribute__((address_space(3))) unsigned char* lds3) {
    const __attribute__((address_space(3))) float* gffn = (const __attribute__((address_space(3))) float*)(lds3 + L_GN);
    const __attribute__((address_space(3))) float* gfin = gffn + 2048;
    const __attribute__((address_space(3))) int* EX = (const __attribute__((address_space(3))) int*)(lds3 + L_EX);
    const __attribute__((address_space(3))) float* GT = (const __attribute__((address_space(3))) float*)(lds3 + L_GT);
    v2u hrow[8];
    unsigned xlo[4], xhi[4]; float sx, halfX;
    { const float rs_ = rsqrtf(SS[n] * (1.f / D_MODEL) + EPS);
      float xf[32]; float amx = 0.f;
#pragma unroll
      for (int i = 0; i < 8; ++i) { const v2u hw_ = *(const v2u*)(H + (size_t)n * 2048 + i * 256 + lane * 4); const f32x4 gv_ = *(const __attribute__((address_space(3))) f32x4*)(gffn + i * 256 + lane * 4);
            hrow[i] = hw_;
            xf[4 * i + 0] = bflo(hw_.x) * rs_ * gv_.x; xf[4 * i + 1] = bfhi(hw_.x) * rs_ * gv_.y; xf[4 * i + 2] = bflo(hw_.y) * rs_ * gv_.z; xf[4 * i + 3] = bfhi(hw_.y) * rs_ * gv_.w;
            amx = fmaxf(amx, fmaxf(fmaxf(fabsf(xf[4 * i + 0]), fabsf(xf[4 * i + 1])), fmaxf(fabsf(xf[4 * i + 2]), fabsf(xf[4 * i + 3])))); }
      amx = wave_max(amx);
      sx = amx > 0.f ? amx * (1.f / 119.f) : 1.f; const float isx = amx > 0.f ? 119.f / amx : 1.f;
      int xs = 0;
#pragma unroll
      for (int j = 0; j < 4; ++j) { unsigned wl = 0, wh = 0;
#pragma unroll
          for (int t = 0; t < 8; ++t) { const int q = (int)rintf(xf[8 * j + t] * isx); xs += q;
              const int q8 = q + 8;
              wl |= (unsigned)((q8 & 15) ^ 8) << (4 * t); wh |= (unsigned)((q8 >> 4) & 15) << (4 * t); }
          xlo[j] = wl; xhi[j] = wh; }
      halfX = 0.5f * wave_sum((float)xs); }
    v2f_t acc2[16];
#pragma unroll
    for (int j = 0; j < 16; ++j) acc2[j] = (v2f_t){0.f, 0.f};
    const bool b5 = (lane & 32) != 0, b4 = (lane & 16) != 0;
    v4u uaA[4], vaA[4], uaB[4], vaB[4]; v2f_t scA[4], scB[4]; float gtA[4], gtB[4];
#define PEER_LOADB(UA, VA, SC, GTV, E0) { _Pragma("unroll") for (int k = 0; k < 4; ++k) { \
        const int ei_ = __builtin_amdgcn_readfirstlane(EX[((E0) + k) * 32 + tl]) & emask; GTV[k] = GT[((E0) + k) * 32 + tl]; \
        const unsigned char* rec_ = REC + (size_t)ei_ * FP6_PITCH + lane * 16; \
        if (!(fake && PEER_FAKE_MODE == 2)) { UA[k] = *(const v4u*)rec_; VA[k] = *(const v4u*)(rec_ + 1024); SC[k] = *(const v2f_t*)(ISC + 2 * ei_); } \
        else { UA[k][0] ^= (unsigned)ei_; VA[k][1] += (unsigned)ei_; } } }
#define PEER_DEC(q, b) __builtin_amdgcn_cvt_scalef32_pk_f32_fp4(q, 1.0f, b)
#define PEER_EVALB(UA, VA, SC, GTV) if (fake && PEER_FAKE_MODE == 1) { _Pragma("unroll") for (int k = 0; k < 4; ++k) { \
            acc2[k].x += __uint_as_float((UA[k][0] ^ UA[k][1]) + (UA[k][2] ^ UA[k][3])) * SC[k].x; acc2[k].y += __uint_as_float((VA[k][0] ^ VA[k][1]) + (VA[k][2] ^ VA[k][3])) * GTV[k]; } } else { float d[4]; \
        _Pragma("unroll") for (int k = 0; k < 4; ++k) { int sh = 0, sl = 0; \
            _Pragma("unroll") for (int j = 0; j < 4; ++j) { sh = __builtin_amdgcn_sdot8((int)UA[k][j], (int)xhi[j], sh, false); sl = __builtin_amdgcn_sdot8((int)UA[k][j], (int)xlo[j], sl, false); } \
            d[k] = (float)(sh * 16 + sl); } \
        __builtin_amdgcn_sched_barrier(0); \
          \
        float t; { const auto r01 = __builtin_amdgcn_permlane32_swap(__float_as_uint(d[0]), __float_as_uint(d[1]), false, false); \
                   const auto r23 = __builtin_amdgcn_permlane32_swap(__float_as_uint(d[2]), __float_as_uint(d[3]), false, false); \
                   const float a01 = __uint_as_float(r01[0]) + __uint_as_float(r01[1]), a23 = __uint_as_float(r23[0]) + __uint_as_float(r23[1]); \
                   const auto rr = __builtin_amdgcn_permlane16_swap(__float_as_uint(a01), __float_as_uint(a23), false, false); \
                   t = row_sum16(__uint_as_float(rr[0]) + __uint_as_float(rr[1])); } \
        const float ius = b5 ? (b4 ? SC[3].x : SC[1].x) : (b4 ? SC[2].x : SC[0].x); \
        const float ivs = b5 ? (b4 ? SC[3].y : SC[1].y) : (b4 ? SC[2].y : SC[0].y); \
        const float gts = b5 ? (b4 ? GTV[3] : GTV[1]) : (b4 ? GTV[2] : GTV[0]); \
        const float wv = gts * gelu_tanh_fast((t + halfX) * (sx * ius)) * ivs; \
        float w[4]; \
        w[0] = __uint_as_float(__builtin_amdgcn_readlane(__float_as_uint(wv), 0)); w[2] = __uint_as_float(__builtin_amdgcn_readlane(__float_as_uint(wv), 16)); \
        w[1] = __uint_as_float(__builtin_amdgcn_readlane(__float_as_uint(wv), 32)); w[3] = __uint_as_float(__builtin_amdgcn_readlane(__float_as_uint(wv), 48)); \
        _Pragma("unroll") for (int k = 0; k < 4; ++k) { const v2f_t wk = {w[k], w[k]}; \
            _Pragma("unroll") for (int j = 0; j < 4; ++j) { const unsigned qw = VA[k][j]; \
                acc2[4 * j + 0] += wk * PEER_DEC(qw, 0); acc2[4 * j + 1] += wk * PEER_DEC(qw, 1); acc2[4 * j + 2] += wk * PEER_DEC(qw, 2); acc2[4 * j + 3] += wk * PEER_DEC(qw, 3); } \
            __builtin_amdgcn_sched_barrier(0); } }
    if (fake && PEER_FAKE_MODE == 2) {
#pragma unroll
        for (int k = 0; k < 4; ++k) { uaA[k] = (v4u){(unsigned)lane, 1u, 2u, 3u}; vaA[k] = uaA[k]; uaB[k] = uaA[k]; vaB[k] = uaA[k]; scA[k] = (v2f_t){1.f, 1.f}; scB[k] = scA[k]; } }
    PEER_LOADB(uaA, vaA, scA, gtA, 0)
#pragma unroll 1
    for (int e0 = 0; e0 < PEER_E; e0 += 8) {
        PEER_LOADB(uaB, vaB, scB, gtB, e0 + 4)
        __builtin_amdgcn_sched_barrier(0);
        PEER_EVALB(uaA, vaA, scA, gtA)
        __builtin_amdgcn_sched_barrier(0);
        { const int en = e0 + 8 < PEER_E ? e0 + 8 : 0;
          PEER_LOADB(uaA, vaA, scA, gtA, en) }
        __builtin_amdgcn_sched_barrier(0);
        PEER_EVALB(uaB, vaB, scB, gtB)
        __builtin_amdgcn_sched_barrier(0);
    }
#undef PEER_LOADB
#undef PEER_EVALB
#undef PEER_DEC
    float sq = 0.f;
#pragma unroll
    for (int i = 0; i < 8; ++i) { const v2u hw_ = hrow[i];
        acc2[2 * i].x += bflo(hw_.x); acc2[2 * i].y += bfhi(hw_.x); acc2[2 * i + 1].x += bflo(hw_.y); acc2[2 * i + 1].y += bfhi(hw_.y); }
#pragma unroll
    for (int j = 0; j < 16; ++j) sq += acc2[j].x * acc2[j].x + acc2[j].y * acc2[j].y;
    const float r_ = rsqrtf(wave_sum(sq) * (1.f / D_MODEL) + EPS);
    if (fake && r_ != 12345.678f) return;
#pragma unroll
    for (int i = 0; i < 8; ++i) { const f32x4 gv_ = *(const __attribute__((address_space(3))) f32x4*)(gfin + i * 256 + lane * 4);
        *(f32x4*)(out + (size_t)n * 2048 + i * 256 + lane * 4) = (f32x4){acc2[2 * i].x * r_ * gv_.x, acc2[2 * i].y * r_ * gv_.y, acc2[2 * i + 1].x * r_ * gv_.z, acc2[2 * i + 1].y * r_ * gv_.w}; }
}

#ifndef PEER_SLICED
#define PEER_SLICED 2
#endif
#ifndef PEER_SLICE_SHIFT_V
#define PEER_SLICE_SHIFT_V 10
#endif
constexpr int L_SCH = 49152, SCH_CAP = 384, PEER_SLICE_SHIFT = PEER_SLICE_SHIFT_V, L_PARK = 73728;
__device__ __forceinline__ int mbcnt64(unsigned long long m) { return __builtin_amdgcn_mbcnt_hi((unsigned)(m >> 32), __builtin_amdgcn_mbcnt_lo((unsigned)m, 0u)); }
__device__ __forceinline__ int build_schedule(int lane, int tl0, __attribute__((address_space(3))) unsigned char* lds3, __attribute__((address_space(3))) v2u* SCH) {
    const __attribute__((address_space(3))) int* EX = (const __attribute__((address_space(3))) int*)(lds3 + L_EX);
    const __attribute__((address_space(3))) float* GT = (const __attribute__((address_space(3))) float*)(lds3 + L_GT);
    int e00 = EX[lane * 32 + tl0], e01 = EX[(lane + 64) * 32 + tl0], e10 = EX[lane * 32 + tl0 + 1], e11 = EX[(lane + 64) * 32 + tl0 + 1];
    const unsigned g00 = __float_as_uint(GT[lane * 32 + tl0]), g01 = __float_as_uint(GT[(lane + 64) * 32 + tl0]), g10 = __float_as_uint(GT[lane * 32 + tl0 + 1]), g11 = __float_as_uint(GT[(lane + 64) * 32 + tl0 + 1]);
    int run = 0;
#pragma unroll 1
    for (int b = 0; b < (16384 >> PEER_SLICE_SHIFT); ++b) {
        const bool h00 = (e00 >> PEER_SLICE_SHIFT) == b, h01 = (e01 >> PEER_SLICE_SHIFT) == b, h10 = (e10 >> PEER_SLICE_SHIFT) == b, h11 = (e11 >> PEER_SLICE_SHIFT) == b;
        const unsigned long long m00 = __ballot(h00), m01 = __ballot(h01), m10 = __ballot(h10), m11 = __ballot(h11);
        const int c00 = __popcll(m00), c0 = c00 + __popcll(m01), c10 = __popcll(m10), c1 = c10 + __popcll(m11);
        const int p0 = (c0 + 3) & ~3, p1 = (c1 + 3) & ~3, o0 = run, o1 = run + p0;
        run += p0 + p1;
        if (h00) SCH[o0 + mbcnt64(m00)] = (v2u){(unsigned)e00, g00};
        if (h01) SCH[o0 + c00 + mbcnt64(m01)] = (v2u){(unsigned)e01, g01};
        if (h10) SCH[o1 + mbcnt64(m10)] = (v2u){(unsigned)e10 | 0x10000u, g10};
        if (h11) SCH[o1 + c10 + mbcnt64(m11)] = (v2u){(unsigned)e11 | 0x10000u, g11};
        if (lane < p0 - c0) SCH[o0 + c0 + lane] = (v2u){(unsigned)(b << PEER_SLICE_SHIFT), 0u};
        if (lane < p1 - c1) SCH[o1 + c1 + lane] = (v2u){(unsigned)(b << PEER_SLICE_SHIFT) | 0x10000u, 0u};
    }
    return run >> 2;
}
struct TokX { unsigned xlo[4], xhi[4]; float sx, halfX; };
__device__ __forceinline__ void token_prologue(int n, int lane, const bf16* H, const float* SS, const __attribute__((address_space(3))) float* gffn, TokX& X) {
    const float rs_ = rsqrtf(SS[n] * (1.f / D_MODEL) + EPS);
    float xf[32]; float amx = 0.f;
#pragma unroll
    for (int i = 0; i < 8; ++i) { const v2u hw_ = *(const v2u*)(H + (size_t)n * 2048 + i * 256 + lane * 4); const f32x4 gv_ = *(const __attribute__((address_space(3))) f32x4*)(gffn + i * 256 + lane * 4);
        xf[4 * i + 0] = bflo(hw_.x) * rs_ * gv_.x; xf[4 * i + 1] = bfhi(hw_.x) * rs_ * gv_.y; xf[4 * i + 2] = bflo(hw_.y) * rs_ * gv_.z; xf[4 * i + 3] = bfhi(hw_.y) * rs_ * gv_.w;
        amx = fmaxf(amx, fmaxf(fmaxf(fabsf(xf[4 * i + 0]), fabsf(xf[4 * i + 1])), fmaxf(fabsf(xf[4 * i + 2]), fabsf(xf[4 * i + 3])))); }
    amx = wave_max(amx);
    X.sx = amx > 0.f ? amx * (1.f / 119.f) : 1.f; const float isx = amx > 0.f ? 119.f / amx : 1.f;
    int xs = 0;
#pragma unroll
    for (int j = 0; j < 4; ++j) { unsigned wl = 0, wh = 0;
#pragma unroll
        for (int t = 0; t < 8; ++t) { const int q = (int)rintf(xf[8 * j + t] * isx); xs += q;
            const int q8 = q + 8;
            wl |= (unsigned)((q8 & 15) ^ 8) << (4 * t); wh |= (unsigned)((q8 >> 4) & 15) << (4 * t); }
        X.xlo[j] = wl; X.xhi[j] = wh; }
    X.halfX = 0.5f * wave_sum((float)xs);
}
__device__ __forceinline__ void token_epilogue(int n, int lane, const bf16* H, const __attribute__((address_space(3))) float* gfin, v2f_t (&acc2)[16], float* out) {
    float sq = 0.f;
#pragma unroll
    for (int i = 0; i < 8; ++i) { const v2u hw_ = __builtin_nontemporal_load((const v2u*)(H + (size_t)n * 2048 + i * 256 + lane * 4));
        acc2[2 * i].x += bflo(hw_.x); acc2[2 * i].y += bfhi(hw_.x); acc2[2 * i + 1].x += bflo(hw_.y); acc2[2 * i + 1].y += bfhi(hw_.y); }
#pragma unroll
    for (int j = 0; j < 16; ++j) sq += acc2[j].x * acc2[j].x + acc2[j].y * acc2[j].y;
    const float r_ = rsqrtf(wave_sum(sq) * (1.f / D_MODEL) + EPS);
#pragma unroll
    for (int i = 0; i < 8; ++i) { const f32x4 gv_ = *(const __attribute__((address_space(3))) f32x4*)(gfin + i * 256 + lane * 4);
        __builtin_nontemporal_store((f32x4){acc2[2 * i].x * r_ * gv_.x, acc2[2 * i].y * r_ * gv_.y, acc2[2 * i + 1].x * r_ * gv_.z, acc2[2 * i + 1].y * r_ * gv_.w}, (f32x4*)(out + (size_t)n * 2048 + i * 256 + lane * 4)); }
}
__device__ __forceinline__ void ffn_pair(bool fake, int n0, int tl0, int lane, int wid, const bf16* H, const float* SS, const unsigned char* REC, const float* ISC, float* out, __attribute__((address_space(3))) unsigned char* lds3) {
    const __attribute__((address_space(3))) float* gffn = (const __attribute__((address_space(3))) float*)(lds3 + L_GN);
    const __attribute__((address_space(3))) float* gfin = gffn + 2048;
    __attribute__((address_space(3))) v2u* SCH = (__attribute__((address_space(3))) v2u*)(lds3 + L_SCH) + wid * SCH_CAP;
    const int nb = __builtin_amdgcn_readfirstlane(build_schedule(lane, tl0, lds3, SCH));
    TokX X0, X1;
    token_prologue(n0, lane, H, SS, gffn, X0);
    token_prologue(n0 + 1, lane, H, SS, gffn, X1);
    __attribute__((address_space(3))) f32x4* PARK = (__attribute__((address_space(3))) f32x4*)(lds3 + L_PARK) + wid * 512;
    v2f_t acc[16]; int cur = 0;
#pragma unroll
    for (int j = 0; j < 16; ++j) acc[j] = (v2f_t){0.f, 0.f};
#pragma unroll
    for (int j = 0; j < 8; ++j) PARK[j * 64 + lane] = (f32x4){0.f, 0.f, 0.f, 0.f};
    const bool b5 = (lane & 32) != 0, b4 = (lane & 16) != 0;
    v4u uaA[4], vaA[4], uaB[4], vaB[4]; v2f_t scA[4], scB[4]; float gtA[4], gtB[4]; int tkA, tkB;
#define PEER_LOADB(UA, VA, SC, GTV, TK, BI) { _Pragma("unroll") for (int k = 0; k < 4; ++k) { const v2u en_ = SCH[4 * (BI) + k]; \
        const int ek_ = __builtin_amdgcn_readfirstlane((int)en_.x); if (k == 0) TK = ek_ >> 16; GTV[k] = __uint_as_float(en_.y); \
        const int ei_ = fake ? (ek_ & 0xffff & PEER_FAKE_EMASK) : (ek_ & 0xffff); const unsigned char* rec_ = REC + (size_t)ei_ * FP6_PITCH + lane * 16; \
        if (!(fake && PEER_FAKE_MODE == 2)) { UA[k] = *(const v4u*)rec_; VA[k] = *(const v4u*)(rec_ + 1024); SC[k] = *(const v2f_t*)(ISC + 2 * ei_); } \
        else { UA[k][0] ^= (unsigned)ei_; VA[k][1] += (unsigned)ei_; } } }
#define PEER_DEC(q, b) __builtin_amdgcn_cvt_scalef32_pk_f32_fp4(q, 1.0f, b)
#define PEER_VSIDE(VA, ACC) { _Pragma("unroll") for (int k = 0; k < 4; ++k) { const v2f_t wk = {w[k], w[k]}; \
            _Pragma("unroll") for (int j = 0; j < 4; ++j) { const unsigned qw = VA[k][j]; \
                ACC[4 * j + 0] += wk * PEER_DEC(qw, 0); ACC[4 * j + 1] += wk * PEER_DEC(qw, 1); ACC[4 * j + 2] += wk * PEER_DEC(qw, 2); ACC[4 * j + 3] += wk * PEER_DEC(qw, 3); } \
            __builtin_amdgcn_sched_barrier(0); } }
#define PEER_EVALB(UA, VA, SC, GTV, TK) if (fake && PEER_FAKE_MODE == 1) { _Pragma("unroll") for (int k = 0; k < 4; ++k) { \
            acc[k].x += __uint_as_float((UA[k][0] ^ UA[k][1]) + (UA[k][2] ^ UA[k][3])) * SC[k].x; acc[k].y += __uint_as_float((VA[k][0] ^ VA[k][1]) + (VA[k][2] ^ VA[k][3])) * GTV[k]; } } else { float d[4]; const bool t1_ = (TK) != 0; \
        unsigned xh_[4], xl_[4]; _Pragma("unroll") for (int j = 0; j < 4; ++j) { xh_[j] = t1_ ? X1.xhi[j] : X0.xhi[j]; xl_[j] = t1_ ? X1.xlo[j] : X0.xlo[j]; } \
        const float hx_ = t1_ ? X1.halfX : X0.halfX, sx_ = t1_ ? X1.sx : X0.sx; \
        _Pragma("unroll") for (int k = 0; k < 4; ++k) { int sh = 0, sl = 0; \
            _Pragma("unroll") for (int j = 0; j < 4; ++j) { sh = __builtin_amdgcn_sdot8((int)UA[k][j], (int)xh_[j], sh, false); sl = __builtin_amdgcn_sdot8((int)UA[k][j], (int)xl_[j], sl, false); } \
            d[k] = (float)(sh * 16 + sl); } \
        __builtin_amdgcn_sched_barrier(0); \
        float t; { const auto r01 = __builtin_amdgcn_permlane32_swap(__float_as_uint(d[0]), __float_as_uint(d[1]), false, false); \
                   const auto r23 = __builtin_amdgcn_permlane32_swap(__float_as_uint(d[2]), __float_as_uint(d[3]), false, false); \
                   const float a01 = __uint_as_float(r01[0]) + __uint_as_float(r01[1]), a23 = __uint_as_float(r23[0]) + __uint_as_float(r23[1]); \
                   const auto rr = __builtin_amdgcn_permlane16_swap(__float_as_uint(a01), __float_as_uint(a23), false, false); \
                   t = row_sum16(__uint_as_float(rr[0]) + __uint_as_float(rr[1])); } \
        const float ius = b5 ? (b4 ? SC[3].x : SC[1].x) : (b4 ? SC[2].x : SC[0].x); \
        const float ivs = b5 ? (b4 ? SC[3].y : SC[1].y) : (b4 ? SC[2].y : SC[0].y); \
        const float gts = b5 ? (b4 ? GTV[3] : GTV[1]) : (b4 ? GTV[2] : GTV[0]); \
        const float wv = gts * gelu_tanh_fast((t + hx_) * (sx_ * ius)) * ivs; \
        float w[4]; \
        w[0] = __uint_as_float(__builtin_amdgcn_readlane(__float_as_uint(wv), 0)); w[2] = __uint_as_float(__builtin_amdgcn_readlane(__float_as_uint(wv), 16)); \
        w[1] = __uint_as_float(__builtin_amdgcn_readlane(__float_as_uint(wv), 32)); w[3] = __uint_as_float(__builtin_amdgcn_readlane(__float_as_uint(wv), 48)); \
        __builtin_amdgcn_sched_barrier(0); \
        if ((TK) != cur) {            \
            _Pragma("unroll") for (int j = 0; j < 8; ++j) { const f32x4 o_ = PARK[j * 64 + lane]; PARK[j * 64 + lane] = (f32x4){acc[2 * j].x, acc[2 * j].y, acc[2 * j + 1].x, acc[2 * j + 1].y}; \
                acc[2 * j] = (v2f_t){o_.x, o_.y}; acc[2 * j + 1] = (v2f_t){o_.z, o_.w}; } \
            cur = (TK); } \
        PEER_VSIDE(VA, acc) }
    if (fake && PEER_FAKE_MODE == 2) {
#pragma unroll
        for (int k = 0; k < 4; ++k) { uaA[k] = (v4u){(unsigned)lane, 1u, 2u, 3u}; vaA[k] = uaA[k]; uaB[k] = uaA[k]; vaB[k] = uaA[k]; scA[k] = (v2f_t){1.f, 1.f}; scB[k] = scA[k]; } }
    PEER_LOADB(uaA, vaA, scA, gtA, tkA, 0)
#pragma unroll 1
    for (int i = 0; i < nb; i += 2) {
        { const int bn = i + 1 < nb ? i + 1 : nb - 1; PEER_LOADB(uaB, vaB, scB, gtB, tkB, bn) }
        __builtin_amdgcn_sched_barrier(0);
        PEER_EVALB(uaA, vaA, scA, gtA, tkA)
        __builtin_amdgcn_sched_barrier(0);
        { const int bn = i + 2 < nb ? i + 2 : nb - 1; PEER_LOADB(uaA, vaA, scA, gtA, tkA, bn) }
        __builtin_amdgcn_sched_barrier(0);
        if (i + 1 < nb) { PEER_EVALB(uaB, vaB, scB, gtB, tkB) }
        __builtin_amdgcn_sched_barrier(0);
    }
#undef PEER_LOADB
#undef PEER_EVALB
#undef PEER_VSIDE
#undef PEER_DEC
    if (fake) { float sq_ = 0.f;
#pragma unroll
        for (int j = 0; j < 16; ++j) sq_ += acc[j].x + acc[j].y;
        if (sq_ != 12345.678f) return; }
    token_epilogue(n0 + cur, lane, H, gfin, acc, out);
#pragma unroll
    for (int j = 0; j < 8; ++j) { const f32x4 o_ = PARK[j * 64 + lane]; acc[2 * j] = (v2f_t){o_.x, o_.y}; acc[2 * j + 1] = (v2f_t){o_.z, o_.w}; }
    token_epilogue(n0 + 1 - cur, lane, H, gfin, acc, out);
}

#ifndef PEER_SYNC_SLICES
#define PEER_SYNC_SLICES 0
#endif
constexpr int SCH4_CAP = 704, L_PARK4B = L_SCH + NWAVES * SCH4_CAP * 8;
static_assert(L_PARK4B + 16 * 4096 <= 162816, "LDS overflow");
__device__ __forceinline__ int build_schedule4(int lane, int tl0, __attribute__((address_space(3))) unsigned char* lds3, __attribute__((address_space(3))) v2u* SCH) {
    const __attribute__((address_space(3))) int* EX = (const __attribute__((address_space(3))) int*)(lds3 + L_EX);
    const __attribute__((address_space(3))) float* GT = (const __attribute__((address_space(3))) float*)(lds3 + L_GT);
    int e[4][2]; unsigned g[4][2];
#pragma unroll
    for (int t = 0; t < 4; ++t)
#pragma unroll
        for (int h = 0; h < 2; ++h) { e[t][h] = EX[(lane + 64 * h) * 32 + tl0 + t]; g[t][h] = __float_as_uint(GT[(lane + 64 * h) * 32 + tl0 + t]); }
    int run = 0;
#define PEER_RUN(T, SA, SB, PADR) { const int s0_ = e[T][0] >> PEER_SLICE_SHIFT, s1_ = e[T][1] >> PEER_SLICE_SHIFT; const bool h0_ = s0_ == (SA) || s0_ == (SB), h1_ = s1_ == (SA) || s1_ == (SB); \
        const unsigned long long m0_ = __ballot(h0_), m1_ = __ballot(h1_); const int c0_ = __popcll(m0_), c_ = c0_ + __popcll(m1_), p_ = (c_ + 3) & ~3; \
        if (h0_) SCH[run + mbcnt64(m0_)] = (v2u){(unsigned)e[T][0] | ((unsigned)(T) << 16), g[T][0]}; \
        if (h1_) SCH[run + c0_ + mbcnt64(m1_)] = (v2u){(unsigned)e[T][1] | ((unsigned)(T) << 16), g[T][1]}; \
        if (lane < p_ - c_) SCH[run + c_ + lane] = (v2u){(unsigned)(PADR) | ((unsigned)(T) << 16), 0u}; \
        run += p_; }
#pragma unroll 1
    for (int s = 0; s < (16384 >> PEER_SLICE_SHIFT); s += 2) {
        const int pad0 = s << PEER_SLICE_SHIFT, pad1 = (s + 1) << PEER_SLICE_SHIFT;
        if (lane == 0) SCH[SCH4_CAP - 8 + (s >> 1)] = (v2u){(unsigned)(run >> 2), 0u};
        PEER_RUN(0, s - 1, s, pad0)
        PEER_RUN(1, s, s, pad0)
        PEER_RUN(2, s, s, pad0)
        PEER_RUN(3, s, s + 1, pad1)
        PEER_RUN(2, s + 1, s + 1, pad1)
        PEER_RUN(1, s + 1, s + 1, pad1)
    }
    PEER_RUN(0, (16384 >> PEER_SLICE_SHIFT) - 1, (16384 >> PEER_SLICE_SHIFT) - 1, 16383)
#undef PEER_RUN
    return run >> 2;
}
__device__ __forceinline__ void ffn_quad(bool fake, int n0, int tl0, int lane, int wid, const bf16* H, const float* SS, const unsigned char* REC, const float* ISC, float* out, __attribute__((address_space(3))) unsigned char* lds3) {
    const __attribute__((address_space(3))) float* gffn = (const __attribute__((address_space(3))) float*)(lds3 + L_GN);
    const __attribute__((address_space(3))) float* gfin = gffn + 2048;
    __attribute__((address_space(3))) v2u* SCH = (__attribute__((address_space(3))) v2u*)(lds3 + L_SCH) + wid * SCH4_CAP;
    const int nb = __builtin_amdgcn_readfirstlane(build_schedule4(lane, tl0, lds3, SCH));
    TokX X0, X1, X2, X3;
    token_prologue(n0, lane, H, SS, gffn, X0); token_prologue(n0 + 1, lane, H, SS, gffn, X1); token_prologue(n0 + 2, lane, H, SS, gffn, X2); token_prologue(n0 + 3, lane, H, SS, gffn, X3);
    __syncthreads();
#define PEER_PSLOT(q) ((__attribute__((address_space(3))) v4u*)(lds3 + ((q) < 8 ? (q) * 4096 : L_PARK4B + ((q) - 8) * 4096)) + lane)
    TokX Xc = X0;
    v2f_t acc[16]; int cur = 0; unsigned pmap = ((unsigned)(3 * wid) << 8) | ((unsigned)(3 * wid + 1) << 16) | ((unsigned)(3 * wid + 2) << 24);
#pragma unroll
    for (int j = 0; j < 16; ++j) acc[j] = (v2f_t){0.f, 0.f};
    if (!fake)
#pragma unroll
    for (int q = 0; q < 3; ++q) { __attribute__((address_space(3))) v4u* ps_ = PEER_PSLOT(3 * wid + q);
#pragma unroll
        for (int j = 0; j < 4; ++j) ps_[j * 64] = (v4u){0u, 0u, 0u, 0u}; }
    const bool b5 = (lane & 32) != 0, b4 = (lane & 16) != 0;
    v4u uaA[4], vaA[4], uaB[4], vaB[4]; v2f_t scA[4], scB[4]; float gtA[4], gtB[4]; int tkA, tkB;
#define PEER_LOADB(UA, VA, SC, GTV, TK, BI) { _Pragma("unroll") for (int k = 0; k < 4; ++k) { const v2u en_ = SCH[4 * (BI) + k]; \
        const int ek_ = __builtin_amdgcn_readfirstlane((int)en_.x); if (k == 0) TK = ek_ >> 16; GTV[k] = __uint_as_float(en_.y); \
        const int ei_ = fake ? (ek_ & 0xffff & PEER_FAKE_EMASK) : (ek_ & 0xffff); const unsigned char* rec_ = REC + (size_t)ei_ * FP6_PITCH + lane * 16; \
        if (!(fake && PEER_FAKE_MODE == 2)) { UA[k] = *(const v4u*)rec_; VA[k] = *(const v4u*)(rec_ + 1024); SC[k] = *(const v2f_t*)(ISC + 2 * ei_); } \
        else { UA[k][0] ^= (unsigned)ei_; VA[k][1] += (unsigned)ei_; } } }
#define PEER_DEC(q, b) __builtin_amdgcn_cvt_scalef32_pk_f32_fp4(q, 1.0f, b)
#define PEER_SEL4(F) (t2_ ? (t1_ ? X3.F : X2.F) : (t1_ ? X1.F : X0.F))
#define PEER_UNPARK(PS) { _Pragma("unroll") for (int j = 0; j < 4; ++j) { const v4u o_ = (PS)[j * 64]; \
        acc[4 * j + 0] = (v2f_t){bflo(o_.x), bfhi(o_.x)}; acc[4 * j + 1] = (v2f_t){bflo(o_.y), bfhi(o_.y)}; acc[4 * j + 2] = (v2f_t){bflo(o_.z), bfhi(o_.z)}; acc[4 * j + 3] = (v2f_t){bflo(o_.w), bfhi(o_.w)}; } }
#define PEER_EVALB(UA, VA, SC, GTV, TK) if (fake && PEER_FAKE_MODE == 1) { _Pragma("unroll") for (int k = 0; k < 4; ++k) { \
            acc[k].x += __uint_as_float((UA[k][0] ^ UA[k][1]) + (UA[k][2] ^ UA[k][3])) * SC[k].x; acc[k].y += __uint_as_float((VA[k][0] ^ VA[k][1]) + (VA[k][2] ^ VA[k][3])) * GTV[k]; } } else { float d[4]; \
        const bool t1_ = ((TK) & 1) != 0, t2_ = ((TK) & 2) != 0; \
        if (!fake && (TK) != cur) {            \
            const int q_ = (int)((pmap >> (8 * (TK))) & 255u); __attribute__((address_space(3))) v4u* ps_ = PEER_PSLOT(q_); \
            _Pragma("unroll") for (int j = 0; j < 4; ++j) { const v4u o_ = ps_[j * 64]; \
                ps_[j * 64] = (v4u){pg8::cvt_pk_bf16(acc[4 * j].x, acc[4 * j].y), pg8::cvt_pk_bf16(acc[4 * j + 1].x, acc[4 * j + 1].y), pg8::cvt_pk_bf16(acc[4 * j + 2].x, acc[4 * j + 2].y), pg8::cvt_pk_bf16(acc[4 * j + 3].x, acc[4 * j + 3].y)}; \
                acc[4 * j + 0] = (v2f_t){bflo(o_.x), bfhi(o_.x)}; acc[4 * j + 1] = (v2f_t){bflo(o_.y), bfhi(o_.y)}; acc[4 * j + 2] = (v2f_t){bflo(o_.z), bfhi(o_.z)}; acc[4 * j + 3] = (v2f_t){bflo(o_.w), bfhi(o_.w)}; } \
            pmap = (pmap & ~(255u << (8 * cur))) | ((unsigned)q_ << (8 * cur)); cur = (TK); \
            _Pragma("unroll") for (int j = 0; j < 4; ++j) { Xc.xhi[j] = PEER_SEL4(xhi[j]); Xc.xlo[j] = PEER_SEL4(xlo[j]); } Xc.halfX = PEER_SEL4(halfX); Xc.sx = PEER_SEL4(sx); } \
        _Pragma("unroll") for (int k = 0; k < 4; ++k) { int sh = 0, sl = 0; \
            _Pragma("unroll") for (int j = 0; j < 4; ++j) { sh = __builtin_amdgcn_sdot8((int)UA[k][j], (int)Xc.xhi[j], sh, false); sl = __builtin_amdgcn_sdot8((int)UA[k][j], (int)Xc.xlo[j], sl, false); } \
            d[k] = (float)(sh * 16 + sl); } \
        __builtin_amdgcn_sched_barrier(0); \
        float t; { const auto r01 = __builtin_amdgcn_permlane32_swap(__float_as_uint(d[0]), __float_as_uint(d[1]), false, false); \
                   const auto r23 = __builtin_amdgcn_permlane32_swap(__float_as_uint(d[2]), __float_as_uint(d[3]), false, false); \
                   const float a01 = __uint_as_float(r01[0]) + __uint_as_float(r01[1]), a23 = __uint_as_float(r23[0]) + __uint_as_float(r23[1]); \
                   const auto rr = __builtin_amdgcn_permlane16_swap(__float_as_uint(a01), __float_as_uint(a23), false, false); \
                   t = row_sum16(__uint_as_float(rr[0]) + __uint_as_float(rr[1])); } \
        const float ius = b5 ? (b4 ? SC[3].x : SC[1].x) : (b4 ? SC[2].x : SC[0].x); \
        const float ivs = b5 ? (b4 ? SC[3].y : SC[1].y) : (b4 ? SC[2].y : SC[0].y); \
        const float gts = b5 ? (b4 ? GTV[3] : GTV[1]) : (b4 ? GTV[2] : GTV[0]); \
        const float wv = gts * gelu_tanh_fast((t + Xc.halfX) * (Xc.sx * ius)) * ivs; \
        float w[4]; \
        w[0] = __uint_as_float(__builtin_amdgcn_readlane(__float_as_uint(wv), 0)); w[2] = __uint_as_float(__builtin_amdgcn_readlane(__float_as_uint(wv), 16)); \
        w[1] = __uint_as_float(__builtin_amdgcn_readlane(__float_as_uint(wv), 32)); w[3] = __uint_as_float(__builtin_amdgcn_readlane(__float_as_uint(wv), 48)); \
        __builtin_amdgcn_sched_barrier(0); \
        _Pragma("unroll") for (int k = 0; k < 4; ++k) { const v2f_t wk = {w[k], w[k]}; \
            _Pragma("unroll") for (int j = 0; j < 4; ++j) { const unsigned qw = VA[k][j]; \
                acc[4 * j + 0] += wk * PEER_DEC(qw, 0); acc[4 * j + 1] += wk * PEER_DEC(qw, 1); acc[4 * j + 2] += wk * PEER_DEC(qw, 2); acc[4 * j + 3] += wk * PEER_DEC(qw, 3); } \
            __builtin_amdgcn_sched_barrier(0); } }
    if (fake && PEER_FAKE_MODE == 2) {
#pragma unroll
        for (int k = 0; k < 4; ++k) { uaA[k] = (v4u){(unsigned)lane, 1u, 2u, 3u}; vaA[k] = uaA[k]; uaB[k] = uaA[k]; vaB[k] = uaA[k]; scA[k] = (v2f_t){1.f, 1.f}; scB[k] = scA[k]; } }
    PEER_LOADB(uaA, vaA, scA, gtA, tkA, 0)
    int kb = 1, nbnd = PEER_SYNC_SLICES ? __builtin_amdgcn_readfirstlane((int)SCH[SCH4_CAP - 8 + 1].x) : 0x7fffffff;
#pragma unroll 1
    for (int i = 0; i < nb; i += 2) {
#if PEER_SYNC_SLICES
        while (i >= nbnd) { __builtin_amdgcn_s_barrier(); ++kb; nbnd = kb < 8 ? __builtin_amdgcn_readfirstlane((int)SCH[SCH4_CAP - 8 + (kb & 7)].x) : 0x7fffffff; }
#endif
        { const int bn = i + 1 < nb ? i + 1 : nb - 1; PEER_LOADB(uaB, vaB, scB, gtB, tkB, bn) }
        __builtin_amdgcn_sched_barrier(0);
        PEER_EVALB(uaA, vaA, scA, gtA, tkA)
        __builtin_amdgcn_sched_barrier(0);
        { const int bn = i + 2 < nb ? i + 2 : nb - 1; PEER_LOADB(uaA, vaA, scA, gtA, tkA, bn) }
        __builtin_amdgcn_sched_barrier(0);
        if (i + 1 < nb) { PEER_EVALB(uaB, vaB, scB, gtB, tkB) }
        __builtin_amdgcn_sched_barrier(0);
    }
#if PEER_SYNC_SLICES
    while (kb < 8) { __builtin_amdgcn_s_barrier(); ++kb; }
#endif
    if (fake) { float sq_ = 0.f;
#pragma unroll
        for (int j = 0; j < 16; ++j) sq_ += acc[j].x + acc[j].y;
        if (sq_ != 12345.678f) return; }
    token_epilogue(n0 + cur, lane, H, gfin, acc, out);
#pragma unroll 1
    for (int t = 0; t < 4; ++t) if (t != cur) { const int q_ = (int)((pmap >> (8 * t)) & 255u); __attribute__((address_space(3))) v4u* ps_ = PEER_PSLOT(q_);
        PEER_UNPARK(ps_)
        token_epilogue(n0 + t, lane, H, gfin, acc, out); }
#undef PEER_LOADB
#undef PEER_EVALB
#undef PEER_DEC
#undef PEER_SEL4
#undef PEER_UNPARK
#undef PEER_PSLOT
}

__device__ __forceinline__ void peer_phase(const bf16* QP, const bf16* SKB, const bf16* H, const float* SS, const float* gffn, const unsigned char* REC, const float* ISC,
                                           const float* gfin, float* out, __attribute__((address_space(3))) unsigned char* lds3, int bid, int G) {
    int tid = threadIdx.x; asm volatile("" : "+v"(tid));
    const int lane = tid & 63, wid = __builtin_amdgcn_readfirstlane(tid >> 6);
    { __attribute__((address_space(3))) float* gl = (__attribute__((address_space(3))) float*)(lds3 + L_GN);
      for (int i = tid; i < 2048; i += NTHR) { gl[i] = gffn[i]; gl[2048 + i] = gfin[i]; } }
    for (int unit = bid; unit < NTOK / 32; unit += G) {
        const int tok0 = unit * 32;
        route_head(QP, SKB, wid, tok0, lane, lds3);
        asm volatile("s_waitcnt lgkmcnt(0)" ::: "memory"); __syncthreads();
        { int ln = lane; asm volatile("" : "+v"(ln));
#if PEER_SLICED == 2
#if PEER_FAKE
          ffn_quad(true, tok0 + wid * 4, wid * 4, ln, wid, H, SS, REC, ISC, out, lds3);
          __syncthreads();
#endif
          ffn_quad(false, tok0 + wid * 4, wid * 4, ln, wid, H, SS, REC, ISC, out, lds3);
#elif PEER_SLICED
#pragma unroll 1
#if PEER_FAKE
          for (int rd = 0; rd < 2; ++rd) ffn_pair(true, tok0 + wid * 4 + 2 * rd, wid * 4 + 2 * rd, ln, wid, H, SS, REC, ISC, out, lds3);
#pragma unroll 1
#endif
          for (int rd = 0; rd < 2; ++rd) ffn_pair(false, tok0 + wid * 4 + 2 * rd, wid * 4 + 2 * rd, ln, wid, H, SS, REC, ISC, out, lds3);
#else
#if PEER_FAKE
#pragma unroll 1
          for (int tk = 0; tk < 4; ++tk) ffn_token(PEER_FAKE, true, tok0 + wid * 4 + tk, wid * 4 + tk, ln, H, SS, REC, ISC, out, lds3);
#endif
#pragma unroll 1
          for (int tk = 0; tk < 4; ++tk) ffn_token(0xffffff, false, tok0 + wid * 4 + tk, wid * 4 + tk, ln, H, SS, REC, ISC, out, lds3);
#endif
        }
        __syncthreads();
    }
}
#undef PEER_CE
}
constexpr int RING_BYTES = 131072, LDS_BYTES = 163840, LDSCTL_OFF = LDS_BYTES - 1024, MISC_OFF = LDSCTL_OFF + 320;
constexpr int N_PHASES = 8;
#ifndef PG8_SP2_SMALL
#define PG8_SP2_SMALL true
#endif
#ifndef MK_N_LAUNCHES
#define MK_N_LAUNCHES 1
#endif

__global__ void __launch_bounds__(NTHR, 2) fwd_megakernel(Args args) {
    extern __shared__ __attribute__((aligned(16))) unsigned char lds[];
    LAS unsigned char* lds3 = (LAS unsigned char*)lds;
    int tid_ = threadIdx.x; asm volatile("" : "+v"(tid_));
    const int tid = tid_, lane = tid & 63, wave = __builtin_amdgcn_readfirstlane(tid >> 6);
    const int G = gridDim.x, bid = blockIdx.x;
    unsigned char* ws = args.ws;
    unsigned* ctl = (unsigned*)(ws + WS_CTL);
    const float* x = args.in[0];
    bf16* WinT = (bf16*)(ws + WS_WIN); bf16* WbnT = (bf16*)(ws + WS_WBN); bf16* WbsT = (bf16*)(ws + WS_WBS); bf16* WoutT = (bf16*)(ws + WS_WOUT); bf16* WpqT = (bf16*)(ws + WS_WPQ);
    bf16* XN = (bf16*)(ws + WS_XN); bf16* MERGED = XN; bf16* PROJ = (bf16*)(ws + WS_PROJ);
    bf16* ONSA = (bf16*)(ws + WS_ONSA); bf16* OSB = (bf16*)(ws + WS_OSB);
    float* H = (float*)(ws + WS_H); bf16* HB = (bf16*)(ws + WS_HB);
    unsigned char* REC = ws + WS_UB; float* ISC = (float*)(ws + WS_UB + 48 * MiB); bf16* QP = (bf16*)(ws + WS_QP);
    int* EXPERT = (int*)(ws + WS_EXP); float* GATE = (float*)(ws + WS_GATE);
    bf16* KCB = (bf16*)(ws + WS_MISC + MISC_KCB); bf16* VCB = (bf16*)(ws + WS_MISC + MISC_VCB);
    float* SS = (float*)(ctl + CW_SS);
    float* BTG = (float*)(ws + WS_MISC + MISC_B1 + 4096);
    bf16* W1T = (bf16*)(ws + WS_MISC + MISC_W1T); float* BIAS1 = (float*)(ws + WS_MISC + MISC_B1);
    bf16* SKB = (bf16*)(ws + WS_MISC + MISC_SKB);

    for (int u = tid; u < (LDS_BYTES - LDSCTL_OFF) / 4; u += NTHR) ((LAS unsigned*)(lds3 + LDSCTL_OFF))[u] = 0u;
    __syncthreads();
    const int lo = args.ph_lo, hi = args.ph_hi;
    XcdBarrier bar; bar.bar = ctl + CW_BAR; bar.x = 0; bar.st = nullptr;
    if (hi - lo > 1) bar = xcd_barrier_post(ctl + CW_BAR, (volatile LAS unsigned*)(lds3 + MISC_OFF) + 8);
#define IN(k) (lo <= (k) && (k) < hi)
#ifndef REP_BAR
#define REP_BAR 1
#endif
#define SEAM(k) do { if (IN(k) && IN((k) + 1)) for (int rb_ = 0; rb_ < REP_BAR; ++rb_) xcd_barrier(bar); } while (0)
    const int gw = bid * NWAVES + wave, NGW = G * NWAVES;
    const int vcu = (G % 8 == 0) ? (bid % 8) * (G / 8) + bid / 8 : bid;

#if defined(TS_PHASE)
    unsigned long long ts0_ = 0;
#define TS_BEGIN(k) do { if (TS_PHASE == (k)) ts0_ = __builtin_amdgcn_s_memrealtime(); } while (0)
#define TS_END(k) do { if (TS_PHASE == (k)) { const unsigned dt_ = (unsigned)(__builtin_amdgcn_s_memrealtime() - ts0_); if (tid == 0) atomicMax(ctl + 64, dt_); } } while (0)
#else
#define TS_BEGIN(k) do {} while (0)
#define TS_END(k) do {} while (0)
#endif
#ifndef REP_P0
#define REP_P0 1
#endif
#ifndef REP_P1
#define REP_P1 1
#endif
#ifndef REP_P4
#define REP_P4 1
#endif
#ifndef REP_P6
#define REP_P6 1
#endif
#ifndef REP_P5C
#define REP_P5C 1
#endif
    TS_BEGIN(0);
    if (IN(0)) for (int rep_ = 0; rep_ < REP_P0; ++rep_) {
        LAS float* scr = (LAS float*)(lds3 + wave * 16384);
        constexpr int I_IN = (D_MODEL / 64) * ((IN_COLS + 31) / 32), I_BR = (1024 / 64) * (D_MODEL / 32), I_SQ = (D_MODEL / 64) * (D_MODEL / 32);
        constexpr int I_C1 = (2048 / 64) * (CMP_HID / 32);
        constexpr int NITEMS = I_IN + 2 * I_BR + 2 * I_SQ + 2 * I_C1;
        auto p0_desc = [&](int it) -> P0Item {
            int r = it;
            if (r < I_IN) return P0Item{args.in[2], WinT, nullptr, D_MODEL, IN_COLS, r, C_SHIFT_FROM, C_SHIFT}; r -= I_IN;
            if (r < I_BR) return P0Item{args.in[10], WbnT, nullptr, 1024, D_MODEL, r, 0x7fffffff, 0}; r -= I_BR;
            if (r < I_BR) return P0Item{args.in[11], WbsT, nullptr, 1024, D_MODEL, r, 0x7fffffff, 0}; r -= I_BR;
            if (r < I_SQ) return P0Item{args.in[12], WoutT, nullptr, D_MODEL, D_MODEL, r, 0x7fffffff, 0}; r -= I_SQ;
            if (r < I_SQ) return P0Item{args.in[14], WpqT, args.in[13], D_MODEL, D_MODEL, r, 0x7fffffff, 0}; r -= I_SQ;
            if (r < I_C1) return P0Item{args.in[4], W1T, nullptr, 2048, CMP_HID, r, 0x7fffffff, 0}; r -= I_C1;
            return P0Item{args.in[7], W1T + (size_t)CMP_HID * 2048, nullptr, 2048, CMP_HID, r, 0x7fffffff, 0};
        };
        {
            f32x4 va[8], vb[8];
            int it = gw;
            P0Item da = p0_desc(it < NITEMS ? it : 0), db = da;
            if (it < NITEMS) p0_item_load(da, lane, va);
#pragma unroll 1
            for (; it < NITEMS; it += 2 * NGW) {
                const int i1 = it + NGW, i2 = it + 2 * NGW;
                if (i1 < NITEMS) { db = p0_desc(i1); p0_item_load(db, lane, vb); }
                __builtin_amdgcn_sched_barrier(0);
                p0_item_store(da, lane, va, scr);
                __builtin_amdgcn_sched_barrier(0);
                if (i2 < NITEMS) { da = p0_desc(i2); p0_item_load(da, lane, va); }
                __builtin_amdgcn_sched_barrier(0);
                if (i1 < NITEMS) p0_item_store(db, lane, vb, scr);
                __builtin_amdgcn_sched_barrier(0);
            }
        }
        {
            v4u z = {0u, 0u, 0u, 0u}; bf16* p = WinT + (size_t)C_SHIFT_FROM * D_MODEL; const size_t nz = (size_t)C_SHIFT * D_MODEL;
            for (size_t i = ((size_t)bid * NTHR + tid) * 8; i < nz; i += (size_t)G * NTHR * 8) *(v4u*)(p + i) = z;
        }
        if (gw < 2 * CMP_HID) {
            const int kv = gw >> 7, j = gw & 127; const float* pe = args.in[kv ? 6 : 3]; const float* w1 = args.in[kv ? 7 : 4];
            float s = 0.f;
            for (int k2 = lane; k2 < 2048; k2 += 64) s += pe[k2] * w1[(size_t)k2 * CMP_HID + j];
            s = wave_sum(s);
            if (lane == 0) BIAS1[gw] = s;
        }
        for (int i = bid * NTHR + tid; i < 4 * 4 * 800; i += G * NTHR) { const int gq = i / 800, d = i - gq * 800; BTG[i] = args.in[9][rel_bucket(d) * 16 + gq] * 1.4426950408889634f; }
        cvt_flat(args.in[15], SKB, (size_t)16 * 128 * 128, (size_t)bid * NTHR + tid, (size_t)G * NTHR);
        {
            f32x4 ra[8], rb[8];
            int m = gw;
            if (m < NTOK) rms_row_load(x + (size_t)m * D_MODEL, lane, ra);
#pragma unroll 1
            for (; m < NTOK; m += 2 * NGW) {
                const int m1 = m + NGW, m2 = m + 2 * NGW;
                if (m1 < NTOK) rms_row_load(x + (size_t)m1 * D_MODEL, lane, rb);
                __builtin_amdgcn_sched_barrier(0);
                rms_row_finish(ra, args.in[1], XN + (size_t)m * D_MODEL, lane);
                __builtin_amdgcn_sched_barrier(0);
                if (m2 < NTOK) rms_row_load(x + (size_t)m2 * D_MODEL, lane, ra);
                __builtin_amdgcn_sched_barrier(0);
                if (m1 < NTOK) rms_row_finish(rb, args.in[1], XN + (size_t)m1 * D_MODEL, lane);
                __builtin_amdgcn_sched_barrier(0);
            }
        }
    }
    TS_END(0);
    SEAM(0);
    TS_BEGIN(1);
    if (IN(1)) for (int rep_ = 0; rep_ < REP_P1; ++rep_) {
        pg8::Gemm g{XN, WinT, NTOK, PLD, D_MODEL}; pg8::StaticOrder S; S.init(NTOK, PLD, G, bid);
        pg8::EpiBf16<0> E{PROJ, PP, nullptr, PP, (size_t)NTOK * PP, 1.f};
        pg8::gemm_phase<pg8::EpiBf16<0>, pg8::StaticOrder, true, true>(lds3, g, S, E);
    }
    TS_END(1);
    SEAM(1);
    TS_BEGIN(2);
    if (IN(2)) cmpr::compress_phase(PROJ, W1T, BIAS1, args.in, KCB, VCB, lds3, bid, G);
    TS_END(2);
    SEAM(2);
    TS_BEGIN(3);
    if (IN(3)) {
        TS_BEGIN(30);
        nsa::nsa_phase(PROJ, KCB, VCB, BTG, ONSA, lds3, vcu, G, args.variant);
        TS_END(30);
#if defined(PROBE_P3A)
        nsa::nsa_phase(PROJ, KCB, VCB, args.in[9], ONSA, lds3, vcu, G);
#endif
        TS_BEGIN(31);
        if (!(args.variant & 32)) nsa::stick_phase(PROJ, OSB, lds3, vcu, G);
        TS_END(31);
#if defined(PROBE_P3B)
        nsa::stick_phase(PROJ, OSB, lds3, vcu, G);
#endif
    }
    TS_END(3);
    SEAM(3);
    TS_BEGIN(4);
    if (IN(4)) for (int rep_ = 0; rep_ < REP_P4; ++rep_) {
        static_assert(WS_OSB == WS_ONSA + (size_t)NTOK * NSA_Q * 2 && WS_WBS == WS_WBN + (size_t)D_MODEL * 1024 * 2, "branch operands must be contiguous");
        pg8::Gemm g{ONSA, WbnT, 2 * NTOK, 2 * D_MODEL, 1024}; pg8::BranchOrder S; S.init(NTOK, D_MODEL, G, bid);
        pg8::EpiGate2 E{MERGED, D_MODEL, PNL(PROJ, P_GA), PNL(PROJ, P_GB), PP, (size_t)NTOK * PP - PP, NTOK / 256, D_MODEL / 256};
        pg8::gemm_phase<pg8::EpiGate2, pg8::BranchOrder, true, PG8_SP2_SMALL>(lds3, g, S, E);
    }
    TS_END(4);
    SEAM(4);
    TS_BEGIN(5);
    if (IN(5)) {
        if (!(args.variant & 64)) { pg8::Gemm g{MERGED, WoutT, NTOK, D_MODEL, D_MODEL}; pg8::StaticOrder S; S.init(NTOK, D_MODEL, G, bid);
          pg8::EpiResid E{x, HB, SS, D_MODEL};
          pg8::gemm_phase<pg8::EpiResid, pg8::StaticOrder, true, PG8_SP2_SMALL>(lds3, g, S, E); }
        int t5 = threadIdx.x; asm volatile("" : "+v"(t5));
        const int lane5 = t5 & 63, gw5 = bid * NWAVES + __builtin_amdgcn_readfirstlane(t5 >> 6);
        if (!(args.variant & 128)) peer::cvt_tables(args.in[16], args.in[17], REC, ISC, gw5, NGW, lane5);
    }
    TS_END(5);
    SEAM(5);
    TS_BEGIN(6);
    if (IN(6)) for (int rep_ = 0; rep_ < REP_P6; ++rep_) {
        pg8::Gemm g{HB, WpqT, NTOK, D_MODEL, D_MODEL}; pg8::StaticOrder S; S.init(NTOK, D_MODEL, G, bid);
        pg8::EpiRowScale E{QP, D_MODEL, SS, 1.f / D_MODEL, EPS};
        pg8::gemm_phase<pg8::EpiRowScale, pg8::StaticOrder, true, PG8_SP2_SMALL>(lds3, g, S, E);
    }
    TS_END(6);
    SEAM(6);
    TS_BEGIN(7);
    if (IN(7)) {
        peer::peer_phase(QP, SKB, HB, SS, args.in[13], REC, ISC, args.in[18], args.out, lds3, bid, G);
    }
    TS_END(7);
#if defined(TS_PHASE)
    xcd_barrier(bar);
    if (bid == 0) { const unsigned dt_ = __hip_atomic_load(ctl + 64, RLX_AGENT); const int K_ = (int)((float)dt_ * 0.01f * 16.777216f * 2.f);
        for (int i = tid; i < K_; i += NTHR) args.out[i] += 1.0f; }
#endif
#undef IN
#undef SEAM
}

extern "C" void kernel_launch(void* const* d_in, const int* in_sizes, int n_in, void* d_out, int out_size, void* d_ws, size_t ws_size, hipStream_t stream) {
    static int grid = 0;
    if (grid == 0) {
        if (n_in != 19 || ws_size < WS_END) { fprintf(stderr, "kernel_launch: unexpected inputs (%d) or workspace (%zu < %zu)\n", n_in, ws_size, (size_t)WS_END); grid = -1; return; }
        int dev = 0, cus = 0, per_cu = 0;
        hipGetDevice(&dev); hipDeviceGetAttribute(&cus, hipDeviceAttributeMultiprocessorCount, dev);
        if (hipFuncSetAttribute((const void*)fwd_megakernel, hipFuncAttributeMaxDynamicSharedMemorySize, LDS_BYTES) != hipSuccess) { fprintf(stderr, "hipFuncSetAttribute failed\n"); grid = -1; return; }
        if (hipOccupancyMaxActiveBlocksPerMultiprocessor(&per_cu, (const void*)fwd_megakernel, NTHR, LDS_BYTES) != hipSuccess || per_cu < 1) { fprintf(stderr, "occupancy query: %d\n", per_cu); per_cu = 1; }
        (void)hipGetLastError();
        grid = cus;
        if (grid > cus * per_cu) grid = cus * per_cu;
    }
    if (grid < 0) return;
    hipMemsetAsync((char*)d_ws + WS_CTL, 0, (size_t)(CW_SS + NTOK) * 4, stream);
    Args a{};
    for (int i = 0; i < 19; ++i) a.in[i] = (const float*)d_in[i];
    a.out = (float*)d_out; a.ws = (unsigned char*)d_ws;
#if defined(PROBE_SPLIT_LO2)
#ifndef PROBE_VARIANT
#define PROBE_VARIANT 0
#endif
    {
        a.ph_lo = 0; a.ph_hi = PROBE_SPLIT_HI1; a.variant = PROBE_VARIANT; hipLaunchKernelGGL(fwd_megakernel, dim3(grid), dim3(NTHR), LDS_BYTES, stream, a);
        hipMemsetAsync((char*)d_ws + WS_CTL + CW_BAR * 4, 0, XCD_BAR_WORDS * 4, stream);
        if (PROBE_SPLIT_LO2 <= 5 && PROBE_SPLIT_HI1 > 5) hipMemsetAsync((char*)d_ws + WS_CTL + CW_SS * 4, 0, NTOK * 4, stream);
        a.ph_lo = PROBE_SPLIT_LO2; a.ph_hi = N_PHASES; a.variant = 0; hipLaunchKernelGGL(fwd_megakernel, dim3(grid), dim3(NTHR), LDS_BYTES, stream, a);
        return;
    }
#endif
    if (MK_N_LAUNCHES == 1) {
        a.ph_lo = 0; a.ph_hi = N_PHASES;
        void* kargs[] = {&a};
#if defined(USE_COOP_LAUNCH)
        hipError_t e = hipLaunchCooperativeKernel((const void*)fwd_megakernel, dim3(grid), dim3(NTHR), kargs, LDS_BYTES, stream);
        if (e != hipSuccess) fprintf(stderr, "cooperative launch failed: %s (grid %d)\n", hipGetErrorString(e), grid);
#else
        (void)kargs;
        hipLaunchKernelGGL(fwd_megakernel, dim3(grid), dim3(NTHR), LDS_BYTES, stream, a);
#endif
    } else {
        for (int p = 0; p < N_PHASES; ++p) { a.ph_lo = p; a.ph_hi = p + 1; hipLaunchKernelGGL(fwd_megakernel, dim3(grid), dim3(NTHR), LDS_BYTES, stream, a); }
    }
}
```
